# Optimizing an MI355X kernel written in HIP

```python
import math
import jax, jax.numpy as jnp
from jax import lax
import numpy as np

D_MODEL = 2048
BATCH = 4
SEQ = 4096
DEPTH = 2

SB_HEADS = 8
SB_HEAD_DIM = 128
SB_WIDTH = SB_HEADS * SB_HEAD_DIM
Q_BLOCK = 128
HG_HEADS = 8
HG_DK = 128
HG_DV = 128
HG_WIDTH = HG_HEADS * HG_DK
HG_CHUNK = 64
CONV_CH = 1024
CONV_WIDTH = 31
N_BRANCH = 3
IN_WIDTH = 3 * SB_WIDTH + 4 * HG_WIDTH + 2 * CONV_CH + N_BRANCH * D_MODEL
PEER_HEADS = 8
PEER_NKEYS = 128
PEER_EXPERTS = PEER_NKEYS * PEER_NKEYS
PEER_QDIM = 256
PEER_HALF = PEER_QDIM // 2
PEER_TOPK = 16
PEER_TOKEN_BLOCK = 128
EPS = 1e-6

kernel_name = "hybrid_sb_hgrn2_conformer_peer"


def _split_points():
    widths = [SB_WIDTH] * 3 + [HG_WIDTH] * 4 + [CONV_CH] * 2 + [D_MODEL] * N_BRANCH
    pts, acc = [], 0
    for w in widths[:-1]:
        acc += w
        pts.append(acc)
    return pts


def rmsnorm(x, w):
    xf = x.astype(jnp.float32)
    y = xf * lax.rsqrt(jnp.mean(xf * xf, axis=-1, keepdims=True) + EPS)
    return (y * w.astype(jnp.float32)).astype(x.dtype)


def _heads(a, n_heads):
    B, S, W = a.shape
    return a.reshape(B, S, n_heads, W // n_heads).transpose(0, 2, 1, 3)


def _merge_heads(a):
    B, H, S, Dh = a.shape
    return a.transpose(0, 2, 1, 3).reshape(B, S, H * Dh)


def stick_breaking_attention(q, k, v):
    S = q.shape[2]
    scale = SB_HEAD_DIM ** -0.5
    outs = []
    for blk in range(S // Q_BLOCK):
        t0 = blk * Q_BLOCK
        kv_len = t0 + Q_BLOCK
        qb = q[:, :, t0:kv_len]
        kb = k[:, :, :kv_len]
        vb = v[:, :, :kv_len]
        z = jnp.einsum('bhtd,bhsd->bhts', qb, kb).astype(jnp.float32) * scale
        t_idx = t0 + jnp.arange(Q_BLOCK)[:, None]
        s_idx = jnp.arange(kv_len)[None, :]
        causal = s_idx < t_idx
        log_om = jnp.where(causal, jax.nn.log_sigmoid(-z), 0.0)
        log_rest = lax.cumsum(log_om, axis=3, reverse=True) - log_om
        w = jnp.where(causal, jnp.exp(jax.nn.log_sigmoid(z) + log_rest), 0.0)
        outs.append(jnp.einsum('bhts,bhsd->bhtd', w.astype(vb.dtype), vb))
    return jnp.concatenate(outs, axis=2)


def hgrn2_chunked(q, log_f, k, i):
    B, H, S, DK = q.shape
    DV = i.shape[-1]
    n = S // HG_CHUNK

    def to_chunks(a):
        return jnp.moveaxis(a.reshape(B, H, n, HG_CHUNK, a.shape[-1]), 2, 0)

    mask = jnp.tril(jnp.ones((HG_CHUNK, HG_CHUNK), dtype=bool))

    def step(state, inp):
        q_, lf, k_, i_ = inp
        b = jnp.cumsum(lf, axis=2)
        diff = b[:, :, :, None, :] - b[:, :, None, :, :]
        decay = jnp.exp(jnp.where(mask[:, :, None], diff, -jnp.inf))
        scores = jnp.einsum('bhtd,bhsd,bhtsd->bhts', q_, k_, decay)
        o = (jnp.einsum('bhts,bhsv->bhtv', scores, i_)
             + jnp.einsum('bhtd,bhdv->bhtv', q_ * jnp.exp(b), state))
        b_last = b[:, :, -1:, :]
        new_state = (jnp.swapaxes(jnp.exp(b_last), 2, 3) * state
                     + jnp.einsum('bhsd,bhsv->bhdv', k_ * jnp.exp(b_last - b), i_))
        return new_state, o

    state0 = jnp.zeros((B, H, DK, DV), jnp.float32)
    _, oc = lax.scan(step, state0, (to_chunks(q), to_chunks(log_f), to_chunks(k), to_chunks(i)))
    return jnp.moveaxis(oc, 0, 2).reshape(B, H, S, DV)


def conformer_conv(a, b, conv_w, conv_b, ln_w, ln_b):
    h = a * jax.nn.sigmoid(b)
    h = lax.conv_general_dilated(h, conv_w, window_strides=(1,), padding=[(CONV_WIDTH - 1, 0)],
                                 dimension_numbers=('NWC', 'WIO', 'NWC'),
                                 feature_group_count=CONV_CH) + conv_b
    hf = h.astype(jnp.float32)
    mu = jnp.mean(hf, axis=-1, keepdims=True)
    var = jnp.mean(jnp.square(hf - mu), axis=-1, keepdims=True)
    hn = (hf - mu) * lax.rsqrt(var + EPS) * ln_w.astype(jnp.float32) + ln_b.astype(jnp.float32)
    return jax.nn.silu(hn).astype(a.dtype)


def hgrn_lower_bounds(p):
    c = jnp.cumsum(jax.nn.softmax(p.astype(jnp.float32), axis=0), axis=0)
    return c - c[0:1]


def mixer_block(x, norm_w, w_in, sb_qn, sb_kn, lb, hg_norm_w, conv_w, conv_b, conv_ln_w,
                conv_ln_b, w_br_sb, w_br_hg, w_br_conv, w_o):
    h = rmsnorm(x, norm_w)
    proj = h @ w_in
    (q_sb, k_sb, v_sb, q_hg, f_hg, i_hg, g_hg, a_c, b_c,
     gate_sb, gate_hg, gate_c) = jnp.split(proj, _split_points(), axis=-1)

    qa = rmsnorm(_heads(q_sb, SB_HEADS), sb_qn)
    ka = rmsnorm(_heads(k_sb, SB_HEADS), sb_kn)
    va = _heads(v_sb, SB_HEADS)
    y_sb = _merge_heads(stick_breaking_attention(qa, ka, va)) @ w_br_sb

    lbh = lb.reshape(HG_HEADS, 1, HG_DK)
    f_logit = _heads(f_hg, HG_HEADS).astype(jnp.float32)
    log_f = jnp.logaddexp(jnp.log(lbh), jnp.log1p(-lbh) + jax.nn.log_sigmoid(f_logit))
    k_h = -jnp.expm1(log_f)
    o_h = hgrn2_chunked(_heads(q_hg, HG_HEADS).astype(jnp.float32), log_f, k_h,
                        _heads(i_hg, HG_HEADS).astype(jnp.float32))
    o_h = rmsnorm(o_h, hg_norm_w) * jax.nn.sigmoid(_heads(g_hg, HG_HEADS).astype(jnp.float32))
    y_hg = _merge_heads(o_h).astype(x.dtype) @ w_br_hg

    y_c = conformer_conv(a_c, b_c, conv_w, conv_b, conv_ln_w, conv_ln_b) @ w_br_conv

    merged = (jax.nn.sigmoid(gate_sb) * y_sb + jax.nn.sigmoid(gate_hg) * y_hg
              + jax.nn.sigmoid(gate_c) * y_c)
    return x + merged @ w_o


def peer_block(x, norm_w, w_query, keys1, keys2, u, v):
    B, S, D = x.shape
    N = B * S
    h = rmsnorm(x, norm_w).reshape(N, D)
    q = (h @ w_query).reshape(N, PEER_HEADS, PEER_QDIM)
    s1 = jnp.einsum('nhd,hkd->nhk', q[..., :PEER_HALF], keys1).astype(jnp.float32)
    s2 = jnp.einsum('nhd,hkd->nhk', q[..., PEER_HALF:], keys2).astype(jnp.float32)
    v1, i1 = lax.top_k(s1, PEER_TOPK)
    v2, i2 = lax.top_k(s2, PEER_TOPK)
    cand_s = (v1[..., :, None] + v2[..., None, :]).reshape(N, PEER_HEADS, PEER_TOPK * PEER_TOPK)
    cand_e = (i1[..., :, None] * PEER_NKEYS + i2[..., None, :]).reshape(N, PEER_HEADS, PEER_TOPK * PEER_TOPK)
    top_s, pos = lax.top_k(cand_s, PEER_TOPK)
    experts = jnp.take_along_axis(cand_e, pos, axis=-1)
    gates = jax.nn.softmax(top_s, axis=-1)

    nb = N // PEER_TOKEN_BLOCK

    def expert_block(args):
        hb, eb, gb = args
        ue = jnp.take(u, eb, axis=0)
        act = jax.nn.gelu(jnp.einsum('td,thkd->thk', hb, ue).astype(jnp.float32), approximate=False)
        ve = jnp.take(v, eb, axis=0)
        return jnp.einsum('thk,thkd->td', (gb * act).astype(ve.dtype), ve)

    y = lax.map(expert_block, (h.reshape(nb, PEER_TOKEN_BLOCK, D),
                               experts.reshape(nb, PEER_TOKEN_BLOCK, PEER_HEADS, PEER_TOPK),
                               gates.reshape(nb, PEER_TOKEN_BLOCK, PEER_HEADS, PEER_TOPK)))
    return x + y.reshape(B, S, D).astype(x.dtype)


def setup_inputs(seed: int = 0) -> dict:
    key = jax.random.key(seed)
    ks = jax.random.split(key, 24)

    def nrm(k, shape, scale):
        return jax.random.normal(k, shape, jnp.float32) * scale

    def gain(k, shape):
        return 1.0 + 0.02 * jax.random.normal(k, shape, jnp.float32)

    L = DEPTH
    return {
        "x": nrm(ks[0], (BATCH, SEQ, D_MODEL), 1.0),
        "attn_norm_w": gain(ks[1], (L, D_MODEL)),
        "w_in": nrm(ks[2], (L, D_MODEL, IN_WIDTH), D_MODEL ** -0.5),
        "sb_q_norm_w": gain(ks[3], (L, SB_HEAD_DIM)),
        "sb_k_norm_w": gain(ks[4], (L, SB_HEAD_DIM)),
        "hg_lower_bounds": nrm(ks[5], (L, HG_WIDTH), 0.1),
        "hg_norm_w": gain(ks[6], (L, HG_DV)),
        "conv_w": nrm(ks[7], (L, CONV_WIDTH, 1, CONV_CH), CONV_WIDTH ** -0.5),
        "conv_b": nrm(ks[8], (L, CONV_CH), 0.02),
        "conv_ln_w": gain(ks[9], (L, CONV_CH)),
        "conv_ln_b": nrm(ks[10], (L, CONV_CH), 0.02),
        "w_br_sb": nrm(ks[11], (L, SB_WIDTH, D_MODEL), SB_WIDTH ** -0.5),
        "w_br_hg": nrm(ks[12], (L, HG_WIDTH, D_MODEL), HG_WIDTH ** -0.5),
        "w_br_conv": nrm(ks[13], (L, CONV_CH, D_MODEL), CONV_CH ** -0.5),
        "w_o": nrm(ks[14], (L, D_MODEL, D_MODEL), D_MODEL ** -0.5),
        "ffn_norm_w": gain(ks[15], (L, D_MODEL)),
        "peer_w_query": nrm(ks[16], (L, D_MODEL, PEER_HEADS * PEER_QDIM), D_MODEL ** -0.5),
        "peer_keys1": nrm(ks[17], (L, PEER_HEADS, PEER_NKEYS, PEER_HALF), PEER_HALF ** -0.5),
        "peer_keys2": nrm(ks[18], (L, PEER_HEADS, PEER_NKEYS, PEER_HALF), PEER_HALF ** -0.5),
        "peer_u": nrm(ks[19], (L, PEER_EXPERTS, D_MODEL), D_MODEL ** -0.5),
        "peer_v": nrm(ks[20], (L, PEER_EXPERTS, D_MODEL), PEER_HEADS ** -0.5),
    }


def reference(x, attn_norm_w, w_in, sb_q_norm_w, sb_k_norm_w, hg_lower_bounds, hg_norm_w,
              conv_w, conv_b, conv_ln_w, conv_ln_b, w_br_sb, w_br_hg, w_br_conv, w_o,
              ffn_norm_w, peer_w_query, peer_keys1, peer_keys2, peer_u, peer_v):
    lbs = hgrn_lower_bounds(hg_lower_bounds)
    for l in range(DEPTH):
        x = mixer_block(x, attn_norm_w[l], w_in[l], sb_q_norm_w[l], sb_k_norm_w[l], lbs[l],
                        hg_norm_w[l], conv_w[l], conv_b[l], conv_ln_w[l], conv_ln_b[l],
                        w_br_sb[l], w_br_hg[l], w_br_conv[l], w_o[l])
        x = peer_block(x, ffn_norm_w[l], peer_w_query[l], peer_keys1[l], peer_keys2[l],
                       peer_u[l], peer_v[l])
    return x
```

```cpp
#include <hip/hip_runtime.h>
#include <cstdio>
#include <cstdint>
namespace pg8 {
#define PG8_LAS __attribute__((address_space(3)))
typedef unsigned short bf16_t;
typedef short bf16x8 __attribute__((ext_vector_type(8)));
typedef float f32x4 __attribute__((ext_vector_type(4)));
typedef unsigned u32x4 __attribute__((ext_vector_type(4)));
constexpr int BM = 256, BK = 64, HALF = 128, HTB = HALF * BK * 2  , STAGE_BYTES = 8 * HTB, NXCD = 8, WGM = 8;

__host__ __device__ __forceinline__ int lds_byte(int r, int c) { const int st = (r >> 4) * 2 + (c >> 5), rr = r & 15, cc = c & 31, ob = rr * 64 + cc * 2; return st * 1024 + (ob ^ (((ob >> 9) & 1) << 5)); }
__host__ __device__ __forceinline__ void stage_rc(int b, int& R, int& C) { const int st = b / 1024, sb = b % 1024, swz = sb ^ (((sb >> 9) & 1) << 5); R = (st >> 1) * 16 + swz / 64; C = (st & 1) * 32 + (swz % 64) / 2; }
__host__ __device__ __forceinline__ int perm32(int rho) { const int n = rho >> 4, i = rho & 15; return 8 * (i >> 2) + 4 * n + (i & 3); }

struct Unit { int pm, pn; };
struct Gemm { const bf16_t* A; const bf16_t* Bt; int M, N, K; };

struct StaticOrder {
    int nM, nN, nwg, G, c;
    __host__ __device__ void init(int M, int N, int G_, int c_) { nM = M / BM; nN = N / BM; nwg = nM * nN; G = G_; c = c_; }
    __host__ __device__ bool next(int i, Unit& u) const {
        const long L = (long)i * G + c; if (L >= nwg) return false;
        int wgid = (int)L; { const int q = nwg / NXCD, r = nwg % NXCD, xcd = wgid % NXCD, off = wgid / NXCD; wgid = (xcd < r ? xcd * (q + 1) : r * (q + 1) + (xcd - r) * q) + off; }
        const int nig = WGM * nN, gid = wgid / nig, fm = gid * WGM, gsz = (nM - fm) < WGM ? (nM - fm) : WGM;
        u.pm = fm + ((wgid % nig) % gsz); u.pn = (wgid % nig) / gsz; return true;
    }
    __device__ __forceinline__ void a_ready(const Unit&) const {}
    __device__ __forceinline__ void done(const Unit&) const {}
};

typedef float f32x2 __attribute__((ext_vector_type(2)));
template <class Epi, class Sched, bool ALIGN_EPI = false, bool SP2 = false>
__device__ __forceinline__ void gemm_phase(PG8_LAS unsigned char* lds, const Gemm g, const Sched& S, const Epi& E) {
    int tid_ = threadIdx.x; asm volatile("" : "+v"(tid_)); int K_ = g.K; asm volatile("" : "+s"(K_));
    const int tid = tid_, wid = __builtin_amdgcn_readfirstlane(tid >> 6), lane = tid & 63, wr = wid >> 2, wc = wid & 3, fr = lane & 15, fq = lane >> 4;
    const int K = K_, nt = K / BK;
    unsigned voffA[2], voffB[2];
#pragma unroll
    for (int i = 0; i < 2; ++i) { int R, C; stage_rc(tid * 16 + i * 8192, R, C); const int Rb = Epi::PERM ? ((R & ~31) + perm32(R & 31)) : R;
        voffA[i] = (unsigned)(R * K + C) * 2u; voffB[i] = (unsigned)(Rb * K + C) * 2u; }
    const size_t kstep = (size_t)(BK * 2);
    const size_t hstep = (size_t)HALF * K * 2;
    const size_t tstep = 2 * hstep;
    const unsigned ldsw = (unsigned)wid * 1024u;
    const int aoff = lds_byte(wr * 64 + fr, fq * 8), boff = lds_byte(wc * 32 + fr, fq * 8);
#define PG8_SA(b, h) (((b) * 2 + (h)) * HTB)
#define PG8_SB(b, h) ((4 + (b) * 2 + (h)) * HTB)
#define PG8_STAGE(bufoff, gbase, voff) do { _Pragma("unroll") for (int _i = 0; _i < 2; ++_i) \
        __builtin_amdgcn_global_load_lds((const unsigned*)((const char*)(gbase) + (voff)[_i]), (PG8_LAS unsigned*)(lds + (bufoff) + ldsw + _i * 8192), 16, 0, 0); } while (0)
#define PG8_LDA(dst, b, h) do { _Pragma("unroll") for (int m = 0; m < 4; ++m) _Pragma("unroll") for (int k = 0; k < 2; ++k) dst[m][k] = *(const PG8_LAS bf16x8*)(lds + PG8_SA(b, h) + aoff + m * 2048 + k * 1024); } while (0)
#define PG8_LDB(dst, b, h) do { _Pragma("unroll") for (int n = 0; n < 2; ++n) _Pragma("unroll") for (int k = 0; k < 2; ++k) dst[n][k] = *(const PG8_LAS bf16x8*)(lds + PG8_SB(b, h) + boff + n * 2048 + k * 1024); } while (0)
#define PG8_MMA(ai, bj, At, Bt) do { __builtin_amdgcn_s_setprio(1); _Pragma("unroll") for (int m = 0; m < 4; ++m) _Pragma("unroll") for (int n = 0; n < 2; ++n) _Pragma("unroll") for (int k = 0; k < 2; ++k) \
        acc[ai][bj][m][n] = __builtin_amdgcn_mfma_f32_16x16x32_bf16(Bt[n][k], At[m][k], acc[ai][bj][m][n], 0, 0, 0); __builtin_amdgcn_s_setprio(0); } while (0)
#define PG8_WAIT_V(n) asm volatile("s_waitcnt vmcnt(" #n ")" ::: "memory")
#define PG8_WAIT_L(n) asm volatile("s_waitcnt lgkmcnt(" #n ")" ::: "memory")
#define PG8_BAR __builtin_amdgcn_s_barrier()
#define PG8_SCHED __builtin_amdgcn_sched_barrier(0)
    Unit cur, nxt; int ui = 0;
    if (!S.next(0, cur)) return;
    f32x4 acc[2][2][4][2];
#pragma unroll
    for (int a = 0; a < 2; ++a)
#pragma unroll
        for (int b = 0; b < 2; ++b)
#pragma unroll
            for (int m = 0; m < 4; ++m)
#pragma unroll
                for (int n = 0; n < 2; ++n) acc[a][b][m][n] = (f32x4){0.f, 0.f, 0.f, 0.f};
    bf16x8 At[4][2], B0[2][2], B1[2][2];
    const char* cA = (const char*)g.A + (size_t)cur.pm * tstep; const char* cB = (const char*)g.Bt + (size_t)cur.pn * tstep;
    S.a_ready(cur);
    if constexpr (SP2) {
        PG8_STAGE(PG8_SB(0, 0), cB, voffB); PG8_STAGE(PG8_SB(0, 1), cB + hstep, voffB); PG8_STAGE(PG8_SA(0, 0), cA, voffA); PG8_STAGE(PG8_SA(0, 1), cA + hstep, voffA);
        if (wr == 1) PG8_BAR;
        PG8_WAIT_V(2); PG8_BAR;
        PG8_STAGE(PG8_SB(1, 0), cB + kstep, voffB); PG8_STAGE(PG8_SA(1, 0), cA + kstep, voffA); PG8_STAGE(PG8_SB(1, 1), cB + hstep + kstep, voffB);
        PG8_WAIT_V(6); PG8_BAR;
    } else {
        PG8_STAGE(PG8_SB(0, 0), cB, voffB); PG8_STAGE(PG8_SA(0, 0), cA, voffA); PG8_STAGE(PG8_SB(0, 1), cB + hstep, voffB); PG8_STAGE(PG8_SA(0, 1), cA + hstep, voffA);
        if (wr == 1) PG8_BAR;
        PG8_WAIT_V(4); PG8_BAR;
        PG8_STAGE(PG8_SB(1, 0), cB + kstep, voffB); PG8_STAGE(PG8_SA(1, 0), cA + kstep, voffA); PG8_STAGE(PG8_SB(1, 1), cB + hstep + kstep, voffB);
        PG8_WAIT_V(6); PG8_BAR;
    }
    for (;;) {
        const bool has_next = S.next(ui + 1, nxt);
        const char* nA = has_next ? (const char*)g.A + (size_t)nxt.pm * tstep : cA; const char* nB = has_next ? (const char*)g.Bt + (size_t)nxt.pn * tstep : cB;
        for (int t = 0; t < nt; t += 2) {
            const bool last = (t == nt - 2);
            const char* a1 = cA + (size_t)(t + 1) * kstep;
            const char* a2 = last ? nA : cA + (size_t)(t + 2) * kstep; const char* b2 = last ? nB : cB + (size_t)(t + 2) * kstep;
            const char* a3 = a2 + kstep; const char* b3 = b2 + kstep;
            if (last && has_next) S.a_ready(nxt);
            if constexpr (SP2) {
            PG8_LDB(B0, 0, 0); PG8_LDB(B1, 0, 1); PG8_SCHED; PG8_LDA(At, 0, 0); PG8_STAGE(PG8_SA(1, 1), a1 + hstep, voffA);
            PG8_WAIT_V(8); PG8_WAIT_L(0); PG8_BAR; PG8_MMA(0, 0, At, B0); PG8_MMA(0, 1, At, B1); PG8_BAR; PG8_SCHED;
            PG8_LDA(At, 0, 1); PG8_STAGE(PG8_SB(0, 0), b2, voffB); PG8_STAGE(PG8_SB(0, 1), b2 + hstep, voffB); PG8_STAGE(PG8_SA(0, 0), a2, voffA);
            PG8_WAIT_V(8); PG8_WAIT_L(0); PG8_BAR; PG8_MMA(1, 0, At, B0); PG8_MMA(1, 1, At, B1); PG8_BAR; PG8_SCHED;
            PG8_LDB(B0, 1, 0); PG8_LDB(B1, 1, 1); PG8_SCHED; PG8_LDA(At, 1, 0); PG8_STAGE(PG8_SA(0, 1), a2 + hstep, voffA);
            PG8_WAIT_V(8); PG8_WAIT_L(0); PG8_BAR; PG8_MMA(0, 0, At, B0); PG8_MMA(0, 1, At, B1); PG8_BAR; PG8_SCHED;
            PG8_LDA(At, 1, 1); PG8_STAGE(PG8_SB(1, 0), b3, voffB); PG8_STAGE(PG8_SB(1, 1), b3 + hstep, voffB); PG8_STAGE(PG8_SA(1, 0), a3, voffA);
            PG8_WAIT_V(8); PG8_WAIT_L(0); PG8_BAR; PG8_MMA(1, 0, At, B0); PG8_MMA(1, 1, At, B1); PG8_BAR; PG8_SCHED;
            } else {
            PG8_LDB(B0, 0, 0); PG8_SCHED; PG8_LDA(At, 0, 0); PG8_STAGE(PG8_SA(1, 1), a1 + hstep, voffA);
            PG8_WAIT_L(8); PG8_BAR; PG8_WAIT_L(0); PG8_MMA(0, 0, At, B0); PG8_BAR; PG8_SCHED;
            PG8_LDB(B1, 0, 1); PG8_STAGE(PG8_SB(0, 0), b2, voffB);
            PG8_BAR; PG8_WAIT_L(0); PG8_MMA(0, 1, At, B1); PG8_BAR;
            PG8_LDA(At, 0, 1); PG8_STAGE(PG8_SA(0, 0), a2, voffA);
            PG8_BAR; PG8_WAIT_L(0); PG8_MMA(1, 0, At, B0); PG8_BAR; PG8_SCHED;
            PG8_STAGE(PG8_SB(0, 1), b2 + hstep, voffB);
            PG8_WAIT_V(6); PG8_BAR; PG8_MMA(1, 1, At, B1); PG8_BAR;
            PG8_LDB(B0, 1, 0); PG8_SCHED; PG8_LDA(At, 1, 0); PG8_STAGE(PG8_SA(0, 1), a2 + hstep, voffA);
            PG8_WAIT_L(8); PG8_BAR; PG8_WAIT_L(0); PG8_MMA(0, 0, At, B0); PG8_BAR; PG8_SCHED;
            PG8_LDB(B1, 1, 1); PG8_STAGE(PG8_SB(1, 0), b3, voffB);
            PG8_BAR; PG8_WAIT_L(0); PG8_MMA(0, 1, At, B1); PG8_BAR;
            PG8_LDA(At, 1, 1); PG8_STAGE(PG8_SA(1, 0), a3, voffA);
            PG8_BAR; PG8_WAIT_L(0); PG8_MMA(1, 0, At, B0); PG8_BAR; PG8_SCHED;
            PG8_STAGE(PG8_SB(1, 1), b3 + hstep, voffB);
            PG8_WAIT_V(6); PG8_BAR; PG8_MMA(1, 1, At, B1); PG8_BAR;
            }
        }
        if constexpr (ALIGN_EPI) { if (wr == 0) PG8_BAR; }
        if constexpr (!Epi::AFTER_DRAIN) { E(acc, cur, wr, wc, fr, fq); S.done(cur); }
        if (!has_next) break;
#pragma unroll
        for (int a = 0; a < 2; ++a)
#pragma unroll
            for (int b = 0; b < 2; ++b)
#pragma unroll
                for (int m = 0; m < 4; ++m)
#pragma unroll
                    for (int n = 0; n < 2; ++n) acc[a][b][m][n] = (f32x4){0.f, 0.f, 0.f, 0.f};
        cur = nxt; cA = nA; cB = nB; ++ui;
        if constexpr (ALIGN_EPI) { if (wr == 1) PG8_BAR; }
    }
    PG8_WAIT_V(0);
    if constexpr (!ALIGN_EPI) { if (wr == 0) PG8_BAR; }
    PG8_BAR;
    if constexpr (Epi::AFTER_DRAIN) { E.fused(acc, cur, wr, wc, fr, fq, lds, wid, lane); S.done(cur); }
#undef PG8_SA
#undef PG8_SB
#undef PG8_STAGE
#undef PG8_LDA
#undef PG8_LDB
#undef PG8_MMA
#undef PG8_WAIT_V
#undef PG8_WAIT_L
#undef PG8_BAR
#undef PG8_SCHED
}
}
#define XB_TMO      128
#define XB_XCNT(j)  (256  + 64 * (j))
#define XB_XSUB(j)  (1280 + 64 * (j))
#define XB_XGEN(j)  (2304 + 64 * (j))
#define XB_TOP      3328
#define XB_TOPGEN   3392
#define XCD_BAR_WORDS 3456
#define XB_SPIN_CAP (1u << 24)
#define LAS __attribute__((address_space(3)))

__device__ __forceinline__ unsigned xb_ld(unsigned* p)              { return __hip_atomic_load(p, __ATOMIC_RELAXED, __HIP_MEMORY_SCOPE_AGENT); }
__device__ __forceinline__ unsigned xb_add(unsigned* p, unsigned v) { return __hip_atomic_fetch_add(p, v, __ATOMIC_RELAXED, __HIP_MEMORY_SCOPE_AGENT); }
__device__ __forceinline__ unsigned xb_xcc_id() { return (unsigned)__builtin_amdgcn_s_getreg((3 << 11) | 20) & 0xFu; }
#define XB_SPIN(cond, bar) do { unsigned _sp = 0; while (cond) { __builtin_amdgcn_s_sleep(1); \
    if ((++_sp & 255u) == 0u) { if (xb_ld(&(bar)[XB_TMO])) break; if (_sp > XB_SPIN_CAP) { atomicAdd(&(bar)[XB_TMO], 1u); break; } } } } while (0)

struct XcdBarrier {
    unsigned* bar; unsigned x;
    volatile LAS unsigned* st;
};

__device__ __forceinline__ XcdBarrier xcd_barrier_post(unsigned* bar, volatile LAS unsigned* st) {
    XcdBarrier b; b.bar = bar; b.x = xb_xcc_id(); b.st = st;
    if (threadIdx.x == 0) (void)xb_add(&bar[XB_XCNT(b.x)], 1u);
    return b;
}
__device__ __forceinline__ void xcd_barrier_complete(unsigned* bar, unsigned x, unsigned& nloc, unsigned& nx) {
    const unsigned G = gridDim.x * gridDim.y * gridDim.z;
    unsigned sum, cnt, mine, sp = 0u;
    for (;;) {
        sum = 0u; cnt = 0u; mine = 0u;
#pragma unroll
        for (unsigned j = 0; j < 16; ++j) { const unsigned c = xb_ld(&bar[XB_XCNT(j)]); sum += c; cnt += (c > 0u) ? 1u : 0u; mine = (j == x) ? c : mine; }
        if (sum == G) break;
        __builtin_amdgcn_s_sleep(1);
        if ((++sp & 255u) == 0u) { if (xb_ld(&bar[XB_TMO])) break; if (sp > XB_SPIN_CAP) { atomicAdd(&bar[XB_TMO], 1u); break; } }
    }
    nloc = mine > 0u ? mine : 1u; nx = cnt > 0u ? cnt : 1u;
}

__device__ __forceinline__ void xcd_barrier(const XcdBarrier& b) {
    asm volatile("s_waitcnt vmcnt(0)" ::: "memory");
    __syncthreads();
    if (threadIdx.x == 0) {
        unsigned* bar = b.bar;
        __builtin_amdgcn_s_waitcnt(0);
        unsigned nloc = b.st[0], nx = b.st[1];
        if (nloc == 0u) { xcd_barrier_complete(bar, b.x, nloc, nx); b.st[0] = nloc; b.st[1] = nx; }
        const unsigned old = xb_add(&bar[XB_XSUB(b.x)], 1u);
        const unsigned gen = old / nloc;
        if (old + 1u == (gen + 1u) * nloc) {
            __builtin_amdgcn_fence(__ATOMIC_RELEASE, "agent");
            asm volatile("s_waitcnt vmcnt(0)" ::: "memory");
            const unsigned og = xb_add(&bar[XB_TOP], 1u);
            const unsigned tg = og / nx;
            if (og + 1u == (tg + 1u) * nx) xb_add(&bar[XB_TOPGEN], 1u);
            else XB_SPIN(xb_ld(&bar[XB_TOPGEN]) == tg, bar);
            __builtin_amdgcn_fence(__ATOMIC_ACQUIRE, "agent");
            xb_add(&bar[XB_XGEN(b.x)], 1u);
            asm volatile("s_waitcnt vmcnt(0)" ::: "memory");
        } else {
            XB_SPIN(xb_ld(&bar[XB_XGEN(b.x)]) == gen, bar);
            __builtin_amdgcn_fence(__ATOMIC_ACQUIRE, "agent");
            asm volatile("s_waitcnt vmcnt(0)" ::: "memory");
        }
    }
    __syncthreads();
}


#define GAS __attribute__((address_space(1)))
typedef unsigned short bf16;
typedef unsigned v4u __attribute__((ext_vector_type(4)));
typedef unsigned v2u __attribute__((ext_vector_type(2)));
typedef float f32x4 __attribute__((ext_vector_type(4)));
typedef float f32x2v __attribute__((ext_vector_type(2)));
typedef float f32x16 __attribute__((ext_vector_type(16)));
typedef short bf16x8 __attribute__((ext_vector_type(8)));
typedef __bf16 bf16v2 __attribute__((ext_vector_type(2)));

constexpr int NTOK = 16384, DM = 2048, SEQ = 4096, INW = 15360, BW = 1024;
constexpr float EPS = 1e-6f;
constexpr int NPH = 10;
constexpr int NPHASES = 2 * NPH;

constexpr size_t MiB = 1u << 20;
constexpr size_t WS_CTL = 0;
constexpr size_t WS_LB = 1 * MiB;
constexpr size_t WS_WIN = 2 * MiB;
constexpr size_t WS_WBR = 62 * MiB;
constexpr size_t WS_WO = 74 * MiB;
constexpr size_t WS_WQ = 82 * MiB;
constexpr size_t WS_U = 91 * MiB;
constexpr size_t WS_V = 155 * MiB;
constexpr size_t WS_H = 219 * MiB;
constexpr size_t WS_SEG = 283 * MiB;
constexpr size_t WS_GATE = 539 * MiB;
constexpr size_t WS_X2 = 731 * MiB;
constexpr size_t WS_CONV = 859 * MiB;
constexpr size_t WS_HGR = 891 * MiB;
constexpr size_t WS_MERGED = 923 * MiB;
constexpr size_t WS_SEL = 987 * MiB;
constexpr size_t WS_END = 1003 * MiB;
constexpr size_t WS_QPEER = WS_SEG;
constexpr size_t SEGSZ = (size_t)NTOK * 1024;
constexpr int CW_BAR = 4096;

constexpr int RING_BYTES = 131072, MISC_OFF = RING_BYTES + 320, LDS_BYTES = 147456;

__device__ __forceinline__ unsigned pk2c(float lo, float hi) { f32x2v v = {lo, hi}; bf16v2 b = __builtin_convertvector(v, bf16v2); return __builtin_bit_cast(unsigned, b); }
__device__ __forceinline__ float bflo(unsigned x) { return __uint_as_float(x << 16); }
__device__ __forceinline__ float bfhi(unsigned x) { return __uint_as_float(x & 0xffff0000u); }
__device__ __forceinline__ float sigm(float x) { return __builtin_amdgcn_rcpf(1.0f + __expf(-x)); }
__device__ __forceinline__ float wave_sum(float v) {
#pragma unroll
    for (int o = 1; o < 64; o <<= 1) v += __shfl_xor(v, o);
    return v;
}
__device__ __forceinline__ float wave_max(float v) {
#pragma unroll
    for (int o = 1; o < 64; o <<= 1) v = fmaxf(v, __shfl_xor(v, o));
    return v;
}
#define LDS_WAIT() asm volatile("s_waitcnt lgkmcnt(0)" ::: "memory")
__device__ __forceinline__ int ridx16(int lane) { return ((lane >> 5) & 1) * 8 + ((lane >> 4) & 1) * 4 + ((lane >> 3) & 1) * 2 + ((lane >> 2) & 1); }
__device__ __forceinline__ void xreduce16(float (&v)[16], int lane) {
#pragma unroll
    for (int i = 0; i < 8; ++i) { const bool up = (lane & 32) != 0; const float snd = up ? v[i] : v[i + 8], kp = up ? v[i + 8] : v[i]; v[i] = kp + __shfl_xor(snd, 32); }
#pragma unroll
    for (int i = 0; i < 4; ++i) { const bool up = (lane & 16) != 0; const float snd = up ? v[i] : v[i + 4], kp = up ? v[i + 4] : v[i]; v[i] = kp + __shfl_xor(snd, 16); }
#pragma unroll
    for (int i = 0; i < 2; ++i) { const bool up = (lane & 8) != 0; const float snd = up ? v[i] : v[i + 2], kp = up ? v[i + 2] : v[i]; v[i] = kp + __shfl_xor(snd, 8); }
    { const bool up = (lane & 4) != 0; const float snd = up ? v[0] : v[1], kp = up ? v[1] : v[0]; v[0] = kp + __shfl_xor(snd, 4); }
    v[0] += __shfl_xor(v[0], 2); v[0] += __shfl_xor(v[0], 1);
}
__device__ __forceinline__ float gelu_exact(float v) {
    const float av = fabsf(v), t = __builtin_amdgcn_rcpf(av * 0.2316418882f + 1.0f);
    float q = t * 0.5307027145f + (-0.7265760135f); q = q * t + 0.7107068705f; q = q * t + (-0.142248368f); q = q * t + 0.127414796f; q = q * t;
    const float e = __builtin_amdgcn_exp2f((v * v) * (-0.72134752044f));
    const float m = v * (q * e);
    return v < 0.f ? m : v - m;
}

struct Ctx { LAS unsigned char* lds; int tid, lane, wave, G, gw, NGW; };

__device__ __forceinline__ void tr_item(const float* W, int K, int N, bf16* WT, int k0, int n0, int drow0, LAS float* scr, int lane) {
#pragma unroll 8
    for (int i = 0; i < 32; ++i) { const int kk = 2 * i + (lane >> 5); scr[kk * 33 + (lane & 31)] = ((const GAS float*)W)[(size_t)(k0 + kk) * N + n0 + (lane & 31)]; }
    LDS_WAIT();
    const int c = lane & 7;
#pragma unroll
    for (int j = 0; j < 4; ++j) { const int n = (lane >> 3) + 8 * j; const LAS float* s = scr + (8 * c) * 33 + n;
        v4u o; o.x = pk2c(s[0], s[33]); o.y = pk2c(s[66], s[99]); o.z = pk2c(s[132], s[165]); o.w = pk2c(s[198], s[231]);
        *(GAS v4u*)(WT + (size_t)(drow0 + n) * K + k0 + 8 * c) = o; }
    LDS_WAIT();
}
__device__ __forceinline__ int win_drow(int n) { if (n < 7168 || n >= 9216) return n; const int r = n - 7168, isb = r >> 10, c = r & 1023; return 7168 + (c >> 7) * 256 + isb * 128 + (c & 127); }
__device__ __forceinline__ void cvt_copy(const Ctx& c, const float* src, bf16* dst, size_t n8) {
    const size_t NT = (size_t)c.G * 512;
    for (size_t i = (size_t)blockIdx.x * 512 + c.tid; i < n8; i += NT) {
        const f32x4 a = ((const GAS f32x4*)src)[2 * i], b = ((const GAS f32x4*)src)[2 * i + 1];
        v4u o; o.x = pk2c(a.x, a.y); o.y = pk2c(a.z, a.w); o.z = pk2c(b.x, b.y); o.w = pk2c(b.z, b.w);
        ((GAS v4u*)dst)[i] = o;
    }
}
__device__ __forceinline__ void rms_row(const float* xr, const float* w, bf16* o, int lane) {
    const GAS f32x4* xp = (const GAS f32x4*)xr + lane; f32x4 v[8]; float s = 0.f;
#pragma unroll
    for (int j = 0; j < 8; ++j) { v[j] = xp[64 * j]; s += (v[j].x * v[j].x + v[j].y * v[j].y) + (v[j].z * v[j].z + v[j].w * v[j].w); }
    const float r = __builtin_amdgcn_rsqf(wave_sum(s) * (1.0f / DM) + EPS);
    const GAS f32x4* wp = (const GAS f32x4*)w + lane; GAS v2u* op = (GAS v2u*)o + lane;
#pragma unroll
    for (int j = 0; j < 8; ++j) { const f32x4 wv = wp[64 * j]; v2u q; q.x = pk2c(v[j].x * r * wv.x, v[j].y * r * wv.y); q.y = pk2c(v[j].z * r * wv.z, v[j].w * r * wv.w); op[64 * j] = q; }
}
__device__ __forceinline__ void rms_phase(const Ctx& c, const float* x, const float* w, bf16* H) {
    for (int m = c.gw; m < NTOK; m += c.NGW) rms_row(x + (size_t)m * DM, w, H + (size_t)m * DM, c.lane);
}
struct P0Args { const float *w_in, *w_br_sb, *w_br_hg, *w_br_conv, *w_o, *w_q, *u, *v, *lbp; bf16 *WinT, *WbrT, *WoT, *WqT, *U, *V; float* LB; int layer; };
__device__ __forceinline__ void p0_convert(const Ctx& c, const P0Args& a) {
    LAS float* scr = (LAS float*)(c.lds + c.wave * 16384);
    constexpr int I_IN = (DM / 64) * (INW / 32), I_BR = (BW / 64) * (DM / 32), I_SQ = (DM / 64) * (DM / 32);
    constexpr int NITEMS = I_IN + 3 * I_BR + 2 * I_SQ;
    for (int it = c.gw; it < NITEMS; it += c.NGW) {
        int r = it;
        if (r < I_IN) { const int kb = r / (INW / 32), nb = r % (INW / 32); tr_item(a.w_in, DM, INW, a.WinT, kb * 64, nb * 32, win_drow(nb * 32), scr, c.lane); continue; } r -= I_IN;
        if (r < I_BR) { const int kb = r / (DM / 32), nb = r % (DM / 32); tr_item(a.w_br_sb, BW, DM, a.WbrT, kb * 64, nb * 32, nb * 32, scr, c.lane); continue; } r -= I_BR;
        if (r < I_BR) { const int kb = r / (DM / 32), nb = r % (DM / 32); tr_item(a.w_br_hg, BW, DM, a.WbrT + (size_t)DM * BW, kb * 64, nb * 32, nb * 32, scr, c.lane); continue; } r -= I_BR;
        if (r < I_BR) { const int kb = r / (DM / 32), nb = r % (DM / 32); tr_item(a.w_br_conv, BW, DM, a.WbrT + (size_t)2 * DM * BW, kb * 64, nb * 32, nb * 32, scr, c.lane); continue; } r -= I_BR;
        if (r < I_SQ) { const int kb = r / (DM / 32), nb = r % (DM / 32); tr_item(a.w_o, DM, DM, a.WoT, kb * 64, nb * 32, nb * 32, scr, c.lane); continue; } r -= I_SQ;
        { const int kb = r / (DM / 32), nb = r % (DM / 32); tr_item(a.w_q, DM, DM, a.WqT, kb * 64, nb * 32, nb * 32, scr, c.lane); }
    }
    cvt_copy(c, a.u, a.U, (size_t)16384 * 2048 / 8);
    cvt_copy(c, a.v, a.V, (size_t)16384 * 2048 / 8);
    if (blockIdx.x == 0) for (int i = c.tid; i < 1024; i += 512) a.LB[i] = a.layer == 0 ? 0.f : sigm(a.lbp[1024 + i] - a.lbp[i]);
}

struct EpiIn {
    static constexpr bool PERM = true, AFTER_DRAIN = false;
    bf16* seg; bf16* gate; const float* lb;
    __device__ __forceinline__ void operator()(const pg8::f32x4 (&acc)[2][2][4][2], const pg8::Unit& u, int wr, int wc, int fr, int fq) const {
        const int pn = u.pn; const int row0 = u.pm * 256 + wr * 64 + fr;
        if (pn >= 28 && pn < 36) {
            bf16* dst = seg + (size_t)7 * SEGSZ; const int col0 = (pn - 28) * 128 + wc * 32 + 8 * fq;
#pragma unroll
            for (int ai = 0; ai < 2; ++ai)
#pragma unroll
                for (int m = 0; m < 4; ++m) {
                    const pg8::f32x4 a0 = acc[ai][0][m][0], a1 = acc[ai][0][m][1], b0 = acc[ai][1][m][0], b1 = acc[ai][1][m][1];
                    v4u w; w.x = pk2c(a0[0] * sigm(b0[0]), a0[1] * sigm(b0[1])); w.y = pk2c(a0[2] * sigm(b0[2]), a0[3] * sigm(b0[3]));
                    w.z = pk2c(a1[0] * sigm(b1[0]), a1[1] * sigm(b1[1])); w.w = pk2c(a1[2] * sigm(b1[2]), a1[3] * sigm(b1[3]));
                    *(GAS v4u*)(dst + (size_t)(row0 + ai * 128 + m * 16) * 1024 + col0) = w; }
            return;
        }
        bf16* dst; int ld, colt, mode;
        if (pn < 28) { const int sg = pn >> 2; dst = seg + (size_t)sg * SEGSZ; ld = 1024; colt = (pn & 3) * 256; mode = (sg == 4) ? 2 : (sg == 6 ? 1 : 0); }
        else { const int q = pn - 36; dst = gate + (size_t)(q >> 3) * ((size_t)NTOK * 2048); ld = 2048; colt = (q & 7) * 256; mode = 1; }
        const int col0 = colt + wc * 32 + 8 * fq;
        if (mode == 0) {
#pragma unroll
            for (int ai = 0; ai < 2; ++ai)
#pragma unroll
                for (int m = 0; m < 4; ++m)
#pragma unroll
                    for (int bj = 0; bj < 2; ++bj) { const pg8::f32x4 v0 = acc[ai][bj][m][0], v1 = acc[ai][bj][m][1];
                        v4u w; w.x = pk2c(v0[0], v0[1]); w.y = pk2c(v0[2], v0[3]); w.z = pk2c(v1[0], v1[1]); w.w = pk2c(v1[2], v1[3]);
                        *(GAS v4u*)(dst + (size_t)(row0 + ai * 128 + m * 16) * ld + col0 + bj * 128) = w; }
        } else if (mode == 1) {
#pragma unroll
            for (int ai = 0; ai < 2; ++ai)
#pragma unroll
                for (int m = 0; m < 4; ++m)
#pragma unroll
                    for (int bj = 0; bj < 2; ++bj) { const pg8::f32x4 v0 = acc[ai][bj][m][0], v1 = acc[ai][bj][m][1];
                        v4u w; w.x = pk2c(sigm(v0[0]), sigm(v0[1])); w.y = pk2c(sigm(v0[2]), sigm(v0[3])); w.z = pk2c(sigm(v1[0]), sigm(v1[1])); w.w = pk2c(sigm(v1[2]), sigm(v1[3]));
                        *(GAS v4u*)(dst + (size_t)(row0 + ai * 128 + m * 16) * ld + col0 + bj * 128) = w; }
        } else {
            f32x4 l0[2], l1[2];
#pragma unroll
            for (int bj = 0; bj < 2; ++bj) { l0[bj] = *(const GAS f32x4*)(lb + col0 + bj * 128); l1[bj] = *(const GAS f32x4*)(lb + col0 + bj * 128 + 4); }
#pragma unroll
            for (int ai = 0; ai < 2; ++ai)
#pragma unroll
                for (int m = 0; m < 4; ++m)
#pragma unroll
                    for (int bj = 0; bj < 2; ++bj) { const pg8::f32x4 v0 = acc[ai][bj][m][0], v1 = acc[ai][bj][m][1]; float r[8];
#pragma unroll
                        for (int j = 0; j < 4; ++j) { r[j] = __logf(l0[bj][j] + (1.0f - l0[bj][j]) * sigm(v0[j])); r[4 + j] = __logf(l1[bj][j] + (1.0f - l1[bj][j]) * sigm(v1[j])); }
                        v4u w; w.x = pk2c(r[0], r[1]); w.y = pk2c(r[2], r[3]); w.z = pk2c(r[4], r[5]); w.w = pk2c(r[6], r[7]);
                        *(GAS v4u*)(dst + (size_t)(row0 + ai * 128 + m * 16) * ld + col0 + bj * 128) = w; }
        }
    }
};

__device__ __forceinline__ void conv_phase(const Ctx& c, const bf16* glu, const float* cw, const float* cb, const float* lnw, const float* lnb, bf16* out) {
    const int c0 = 2 * c.tid;
    float w0[31], w1[31];
#pragma unroll
    for (int j = 0; j < 31; ++j) { const f32x2v t = *(const GAS f32x2v*)(cw + j * 1024 + c0); w0[j] = t.x; w1[j] = t.y; }
    const f32x2v bv = *(const GAS f32x2v*)(cb + c0), lwv = *(const GAS f32x2v*)(lnw + c0), lbv = *(const GAS f32x2v*)(lnb + c0);
    LAS float* red = (LAS float*)c.lds;
    for (int tile = blockIdx.x; tile < NTOK / 8; tile += c.G) {
        const int n0 = tile * 8, tseq0 = n0 & (SEQ - 1);
        float a0[8], a1[8];
#pragma unroll
        for (int t = 0; t < 8; ++t) { a0[t] = bv.x; a1[t] = bv.y; }
#pragma unroll
        for (int r = 0; r < 38; ++r) {
            unsigned xv = 0u;
            if (tseq0 + r - 30 >= 0) xv = *(const GAS unsigned*)(glu + (size_t)(n0 + r - 30) * 1024 + c0);
            const float x0 = bflo(xv), x1 = bfhi(xv);
#pragma unroll
            for (int t = 0; t < 8; ++t) { const int j = r - t; if (j >= 0 && j <= 30) { a0[t] += w0[j] * x0; a1[t] += w1[j] * x1; } }
        }
        float st[16];
#pragma unroll
        for (int t = 0; t < 8; ++t) { st[2 * t] = a0[t] + a1[t]; st[2 * t + 1] = a0[t] * a0[t] + a1[t] * a1[t]; }
        xreduce16(st, c.lane);
        if ((c.lane & 3) == 0) red[c.wave * 16 + ridx16(c.lane)] = st[0];
        __syncthreads();
        if (c.tid < 16) { float s = 0.f;
#pragma unroll
            for (int w = 0; w < 8; ++w) s += red[w * 16 + c.tid];
            red[128 + c.tid] = s; }
        __syncthreads();
#pragma unroll
        for (int t = 0; t < 8; ++t) {
            const float mean = red[128 + 2 * t] * (1.0f / 1024.0f), var = red[128 + 2 * t + 1] * (1.0f / 1024.0f) - mean * mean;
            const float rstd = __builtin_amdgcn_rsqf(var + EPS);
            const float h0 = (a0[t] - mean) * rstd * lwv.x + lbv.x, h1 = (a1[t] - mean) * rstd * lwv.y + lbv.y;
            *(GAS unsigned*)(out + (size_t)(n0 + t) * 1024 + c0) = pk2c(h0 * sigm(h0), h1 * sigm(h1));
        }
        __syncthreads();
    }
}
__device__ __forceinline__ void hgrn_task(int task, int lane, const bf16* qhg, const bf16* logf, const bf16* ihg, bf16* out) {
    const int bh = task >> 6, dvb = task & 63, b = bh >> 3, h = bh & 7;
    const size_t rb = (size_t)b * SEQ * 1024;
    const GAS unsigned* qp = (const GAS unsigned*)(qhg + rb + h * 128) + lane;
    const GAS unsigned* lp = (const GAS unsigned*)(logf + rb + h * 128) + lane;
    const GAS unsigned* ip = (const GAS unsigned*)(ihg + rb + h * 128) + dvb;
    GAS bf16* op = (GAS bf16*)(out + rb + h * 128 + 2 * dvb);
    float S00 = 0.f, S01 = 0.f, S10 = 0.f, S11 = 0.f;
    unsigned qn[8], ln[8], inx[8];
#pragma unroll
    for (int j = 0; j < 8; ++j) { qn[j] = qp[(size_t)j * 512]; ln[j] = lp[(size_t)j * 512]; inx[j] = ip[(size_t)j * 512]; }
    for (int blk = 0; blk < SEQ / 8; ++blk) {
        unsigned qc[8], lc[8], ic[8];
#pragma unroll
        for (int j = 0; j < 8; ++j) { qc[j] = qn[j]; lc[j] = ln[j]; ic[j] = inx[j]; }
        if (blk + 1 < SEQ / 8) {
#pragma unroll
            for (int j = 0; j < 8; ++j) { const size_t o = (size_t)((blk + 1) * 8 + j) * 512; qn[j] = qp[o]; ln[j] = lp[o]; inx[j] = ip[o]; }
        }
        float pv[16];
#pragma unroll
        for (int j = 0; j < 8; ++j) {
            const float f0 = __expf(bflo(lc[j])), f1 = __expf(bfhi(lc[j])), k0 = 1.0f - f0, k1 = 1.0f - f1;
            const float i0 = bflo(ic[j]), i1 = bfhi(ic[j]), q0 = bflo(qc[j]), q1 = bfhi(qc[j]);
            S00 = f0 * S00 + k0 * i0; S01 = f0 * S01 + k0 * i1; S10 = f1 * S10 + k1 * i0; S11 = f1 * S11 + k1 * i1;
            pv[2 * j] = S00 * q0 + S10 * q1; pv[2 * j + 1] = S01 * q0 + S11 * q1;
        }
        xreduce16(pv, lane);
        if ((lane & 3) == 0) { const int idx = ridx16(lane); op[(size_t)(blk * 8 + (idx >> 1)) * 1024 + (idx & 1)] = (bf16)(pk2c(pv[0], 0.f) & 0xffffu); }
    }
}
__device__ __forceinline__ void qknorm_row(bf16* row, const float* w, float scale, int lane) {
#pragma unroll
    for (int j = 0; j < 2; ++j) {
        GAS v4u* p = (GAS v4u*)(row + 8 * lane + 512 * j); const v4u x = *p;
        float f[8] = {bflo(x.x), bfhi(x.x), bflo(x.y), bfhi(x.y), bflo(x.z), bfhi(x.z), bflo(x.w), bfhi(x.w)};
        float ss = 0.f;
#pragma unroll
        for (int k = 0; k < 8; ++k) ss += f[k] * f[k];
        ss += __shfl_xor(ss, 1); ss += __shfl_xor(ss, 2); ss += __shfl_xor(ss, 4); ss += __shfl_xor(ss, 8);
        const float r = __builtin_amdgcn_rsqf(ss * (1.0f / 128.0f) + EPS) * scale;
        const f32x4 wa = *(const GAS f32x4*)(w + ((8 * lane) & 127)), wb = *(const GAS f32x4*)(w + ((8 * lane) & 127) + 4);
        v4u o; o.x = pk2c(f[0] * r * wa.x, f[1] * r * wa.y); o.y = pk2c(f[2] * r * wa.z, f[3] * r * wa.w); o.z = pk2c(f[4] * r * wb.x, f[5] * r * wb.y); o.w = pk2c(f[6] * r * wb.z, f[7] * r * wb.w);
        *p = o;
    }
}
__device__ __forceinline__ void vt_item(int item, int lane, const bf16* vsb, bf16* vt, LAS unsigned short* scr) {
    const int db = item & 3, sb = (item >> 2) & 63, bh = item >> 8, b = bh >> 3, h = bh & 7;
    const bf16* src = vsb + ((size_t)b * SEQ + sb * 64) * 1024 + h * 128 + db * 32;
#pragma unroll 4
    for (int i = 0; i < 16; ++i) { const int r = 4 * i + (lane >> 4); *(LAS unsigned*)(scr + r * 34 + 2 * (lane & 15)) = *(const GAS unsigned*)(src + (size_t)r * 1024 + 2 * (lane & 15)); }
    LDS_WAIT();
    const int c = lane & 7;
#pragma unroll
    for (int j = 0; j < 4; ++j) { const int d = (lane >> 3) + 8 * j; const LAS unsigned short* s = scr + (8 * c) * 34 + d;
        v4u o; o.x = (unsigned)s[0] | ((unsigned)s[34] << 16); o.y = (unsigned)s[68] | ((unsigned)s[102] << 16); o.z = (unsigned)s[136] | ((unsigned)s[170] << 16); o.w = (unsigned)s[204] | ((unsigned)s[238] << 16);
        *(GAS v4u*)(vt + ((size_t)bh * 128 + db * 32 + d) * SEQ + sb * 64 + 8 * c) = o; }
    LDS_WAIT();
}

#define MFMA32(a, b, c) __builtin_amdgcn_mfma_f32_32x32x16_bf16((a), (b), (c), 0, 0, 0)
__device__ __forceinline__ void attn_item(int bh, int qt, int lane, bf16* qo, const bf16* ksb, const bf16* vt) {
    const int b = bh >> 3, h = bh & 7, c = lane & 31, hf = lane >> 5;
    const size_t rb = (size_t)b * SEQ; const int t0 = qt * 32;
    bf16x8 qf[8];
    { const bf16* qrow = qo + (rb + t0 + c) * 1024 + h * 128 + 8 * hf;
#pragma unroll
      for (int kk = 0; kk < 8; ++kk) qf[kk] = *(const GAS bf16x8*)(qrow + 16 * kk); }
    f32x16 o[4];
#pragma unroll
    for (int d = 0; d < 4; ++d)
#pragma unroll
        for (int r = 0; r < 16; ++r) o[d][r] = 0.f;
    float R = 0.f;
    const bf16* vbase = vt + ((size_t)bh * 128 + c) * SEQ + 4 * hf;
    for (int kt = qt; kt >= 0; --kt) {
        const int s0 = kt * 32;
        const bf16* krow = ksb + (rb + s0 + c) * 1024 + h * 128 + 8 * hf;
        bf16x8 kf[8];
#pragma unroll
        for (int kk = 0; kk < 8; ++kk) kf[kk] = *(const GAS bf16x8*)(krow + 16 * kk);
        bf16x8 vf[4][2];
#pragma unroll
        for (int d = 0; d < 4; ++d)
#pragma unroll
            for (int sp = 0; sp < 2; ++sp) { const bf16* p = vbase + (size_t)d * 32 * SEQ + s0 + 16 * sp;
                const v2u lo = *(const GAS v2u*)p, hi = *(const GAS v2u*)(p + 8); v4u t; t.x = lo.x; t.y = lo.y; t.z = hi.x; t.w = hi.y; vf[d][sp] = __builtin_bit_cast(bf16x8, t); }
        f32x16 sa;
#pragma unroll
        for (int r = 0; r < 16; ++r) sa[r] = 0.f;
#pragma unroll
        for (int kk = 0; kk < 8; ++kk) sa = MFMA32(kf[kk], qf[kk], sa);
        const bool diag = (kt == qt);
        float lom[16];
#pragma unroll
        for (int r = 0; r < 16; ++r) {
            const float z = sa[r]; float l = -__logf(1.0f + __expf(z));
            if (diag && ((r & 3) + 8 * (r >> 2) + 4 * hf) >= c) l = 0.f;
            lom[r] = l;
        }
        float Gs[4], Gp[4];
#pragma unroll
        for (int g = 0; g < 4; ++g) { Gs[g] = (lom[4 * g] + lom[4 * g + 1]) + (lom[4 * g + 2] + lom[4 * g + 3]); Gp[g] = __shfl_xor(Gs[g], 32); }
        float tail = 0.f; float w[16];
#pragma unroll
        for (int g = 3; g >= 0; --g) {
            const float base = R + tail + (hf == 0 ? Gp[g] : 0.f);
            const float c3 = base, c2 = c3 + lom[4 * g + 3], c1 = c2 + lom[4 * g + 2], c0 = c1 + lom[4 * g + 1];
            w[4 * g + 3] = __expf(sa[4 * g + 3] + lom[4 * g + 3] + c3); w[4 * g + 2] = __expf(sa[4 * g + 2] + lom[4 * g + 2] + c2);
            w[4 * g + 1] = __expf(sa[4 * g + 1] + lom[4 * g + 1] + c1); w[4 * g] = __expf(sa[4 * g] + lom[4 * g] + c0);
            tail += Gs[g] + Gp[g];
        }
        if (diag) {
#pragma unroll
            for (int r = 0; r < 16; ++r) if (((r & 3) + 8 * (r >> 2) + 4 * hf) >= c) w[r] = 0.f;
        }
        R += tail;
        bf16x8 pf[2];
#pragma unroll
        for (int sp = 0; sp < 2; ++sp) { v4u t; t.x = pk2c(w[8 * sp], w[8 * sp + 1]); t.y = pk2c(w[8 * sp + 2], w[8 * sp + 3]); t.z = pk2c(w[8 * sp + 4], w[8 * sp + 5]); t.w = pk2c(w[8 * sp + 6], w[8 * sp + 7]); pf[sp] = __builtin_bit_cast(bf16x8, t); }
#pragma unroll
        for (int d = 0; d < 4; ++d)
#pragma unroll
            for (int sp = 0; sp < 2; ++sp) o[d] = MFMA32(vf[d][sp], pf[sp], o[d]);
    }
    bf16* orow = qo + (rb + t0 + c) * 1024 + h * 128 + 4 * hf;
#pragma unroll
    for (int d = 0; d < 4; ++d)
#pragma unroll
        for (int g = 0; g < 4; ++g) { v2u q; q.x = pk2c(o[d][4 * g], o[d][4 * g + 1]); q.y = pk2c(o[d][4 * g + 2], o[d][4 * g + 3]); *(GAS v2u*)(orow + 32 * d + 8 * g) = q; }
}
__device__ __forceinline__ void hgpost_row(bf16* row, const bf16* grow, const float* w, int lane) {
#pragma unroll
    for (int j = 0; j < 2; ++j) {
        GAS v4u* p = (GAS v4u*)(row + 8 * lane + 512 * j); const v4u x = *p; const v4u gg = *(const GAS v4u*)(grow + 8 * lane + 512 * j);
        float f[8] = {bflo(x.x), bfhi(x.x), bflo(x.y), bfhi(x.y), bflo(x.z), bfhi(x.z), bflo(x.w), bfhi(x.w)};
        const float g[8] = {bflo(gg.x), bfhi(gg.x), bflo(gg.y), bfhi(gg.y), bflo(gg.z), bfhi(gg.z), bflo(gg.w), bfhi(gg.w)};
        float ss = 0.f;
#pragma unroll
        for (int k = 0; k < 8; ++k) ss += f[k] * f[k];
        ss += __shfl_xor(ss, 1); ss += __shfl_xor(ss, 2); ss += __shfl_xor(ss, 4); ss += __shfl_xor(ss, 8);
        const float r = __builtin_amdgcn_rsqf(ss * (1.0f / 128.0f) + EPS);
        const f32x4 wa = *(const GAS f32x4*)(w + ((8 * lane) & 127)), wb = *(const GAS f32x4*)(w + ((8 * lane) & 127) + 4);
        v4u o; o.x = pk2c(f[0] * r * wa.x * g[0], f[1] * r * wa.y * g[1]); o.y = pk2c(f[2] * r * wa.z * g[2], f[3] * r * wa.w * g[3]);
        o.z = pk2c(f[4] * r * wb.x * g[4], f[5] * r * wb.y * g[5]); o.w = pk2c(f[6] * r * wb.z * g[6], f[7] * r * wb.w * g[7]);
        *p = o;
    }
}

template <bool FIRST> struct EpiMerge {
    static constexpr bool PERM = true, AFTER_DRAIN = false;
    const bf16* gate; bf16* merged;
    __device__ __forceinline__ void operator()(const pg8::f32x4 (&acc)[2][2][4][2], const pg8::Unit& u, int wr, int wc, int fr, int fq) const {
        const int row0 = u.pm * 256 + wr * 64 + fr, col0 = u.pn * 256 + wc * 32 + 8 * fq;
#pragma unroll
        for (int ai = 0; ai < 2; ++ai)
#pragma unroll
            for (int m = 0; m < 4; ++m) {
                if ((m & 1) == 0) asm volatile("" ::: "memory");
#pragma unroll
                for (int bj = 0; bj < 2; ++bj) {
                    const size_t off = (size_t)(row0 + ai * 128 + m * 16) * 2048 + col0 + bj * 128;
                    const v4u g = *(const GAS v4u*)(gate + off); const pg8::f32x4 v0 = acc[ai][bj][m][0], v1 = acc[ai][bj][m][1];
                    float r[8] = {bflo(g.x) * v0[0], bfhi(g.x) * v0[1], bflo(g.y) * v0[2], bfhi(g.y) * v0[3], bflo(g.z) * v1[0], bfhi(g.z) * v1[1], bflo(g.w) * v1[2], bfhi(g.w) * v1[3]};
                    if (!FIRST) { const v4u mo = *(const GAS v4u*)(merged + off);
                        r[0] += bflo(mo.x); r[1] += bfhi(mo.x); r[2] += bflo(mo.y); r[3] += bfhi(mo.y); r[4] += bflo(mo.z); r[5] += bfhi(mo.z); r[6] += bflo(mo.w); r[7] += bfhi(mo.w); }
                    v4u w; w.x = pk2c(r[0], r[1]); w.y = pk2c(r[2], r[3]); w.z = pk2c(r[4], r[5]); w.w = pk2c(r[6], r[7]);
                    *(GAS v4u*)(merged + off) = w; }
            }
    }
};
struct EpiResid {
    static constexpr bool PERM = false, AFTER_DRAIN = false;
    const float* xin; float* xout;
    __device__ __forceinline__ void operator()(const pg8::f32x4 (&acc)[2][2][4][2], const pg8::Unit& u, int wr, int wc, int fr, int fq) const {
        const int row0 = u.pm * 256 + wr * 64 + fr, col0 = u.pn * 256 + wc * 32 + 4 * fq;
#pragma unroll
        for (int ai = 0; ai < 2; ++ai)
#pragma unroll
            for (int m = 0; m < 4; ++m)
#pragma unroll
                for (int bj = 0; bj < 2; ++bj)
#pragma unroll
                    for (int n = 0; n < 2; ++n) { const size_t off = (size_t)(row0 + ai * 128 + m * 16) * 2048 + col0 + bj * 128 + n * 16;
                        f32x4 r = acc[ai][bj][m][n]; if (xin) r += *(const GAS f32x4*)(xin + off);
                        *(GAS f32x4*)(xout + off) = r; }
    }
};

__device__ __forceinline__ float rl_f(float v, int l) { return __uint_as_float((unsigned)__builtin_amdgcn_readlane((int)__float_as_uint(v), l)); }
__device__ __forceinline__ void peer_select_item(int item, int lane, int ca, int cb, const float* qpeer, const float* k1, const float* k2, int* sel_e, float* sel_g, LAS float* sc) {
    const int n = item >> 3, hd = item & 7;
    const float* q1 = qpeer + (size_t)n * 2048 + hd * 256; const float* q2 = q1 + 128;
    const float* ka = k1 + (size_t)hd * 16384 + (size_t)lane * 128; const float* kb = k2 + (size_t)hd * 16384 + (size_t)lane * 128;
    float s0 = 0.f, s1 = 0.f, s2 = 0.f, s3 = 0.f;
#pragma unroll 4
    for (int cc = 0; cc < 32; ++cc) {
        const f32x4 qa = *(const GAS f32x4*)(q1 + 4 * cc), qb = *(const GAS f32x4*)(q2 + 4 * cc);
        const f32x4 a0 = *(const GAS f32x4*)(ka + 4 * cc), a1 = *(const GAS f32x4*)(ka + 8192 + 4 * cc), b0 = *(const GAS f32x4*)(kb + 4 * cc), b1 = *(const GAS f32x4*)(kb + 8192 + 4 * cc);
        s0 += (qa.x * a0.x + qa.y * a0.y) + (qa.z * a0.z + qa.w * a0.w); s1 += (qa.x * a1.x + qa.y * a1.y) + (qa.z * a1.z + qa.w * a1.w);
        s2 += (qb.x * b0.x + qb.y * b0.y) + (qb.z * b0.z + qb.w * b0.w); s3 += (qb.x * b1.x + qb.y * b1.y) + (qb.z * b1.z + qb.w * b1.w);
    }
    int r0 = 0, r1 = 0, r2 = 0, r3 = 0;
    for (int j = 0; j < 64; ++j) {
        const float y0 = rl_f(s0, j), y1 = rl_f(s1, j), y2 = rl_f(s2, j), y3 = rl_f(s3, j);
        r0 += (y0 > s0 || (y0 == s0 && j < lane)) ? 1 : 0; r0 += (y1 > s0) ? 1 : 0;
        r1 += (y0 >= s1) ? 1 : 0;                           r1 += (y1 > s1 || (y1 == s1 && j < lane)) ? 1 : 0;
        r2 += (y2 > s2 || (y2 == s2 && j < lane)) ? 1 : 0; r2 += (y3 > s2) ? 1 : 0;
        r3 += (y2 >= s3) ? 1 : 0;                           r3 += (y3 > s3 || (y3 == s3 && j < lane)) ? 1 : 0;
    }
    LAS int* si = (LAS int*)sc;
    if (r0 < 16) { sc[r0] = s0; si[16 + r0] = lane; }
    if (r1 < 16) { sc[r1] = s1; si[16 + r1] = lane + 64; }
    if (r2 < 16) { sc[32 + r2] = s2; si[48 + r2] = lane; }
    if (r3 < 16) { sc[32 + r3] = s3; si[48 + r3] = lane + 64; }
    LDS_WAIT();
    float val = -3.0e38f; int eid = 0; const int flat = ca * 16 + cb;
    if (lane < 50) { val = sc[ca] + sc[32 + cb]; eid = si[16 + ca] * 128 + si[48 + cb]; }
    LDS_WAIT();
    int rk = 0;
    for (int j = 0; j < 50; ++j) { const float vv = rl_f(val, j); const int ff = __builtin_amdgcn_readlane(flat, j); rk += (vv > val || (vv == val && ff < flat)) ? 1 : 0; }
    const bool win = (lane < 50) && (rk < 16);
    const float mx = wave_max(win ? val : -3.0e38f);
    const float e = win ? __expf(val - mx) : 0.f;
    const float ssum = wave_sum(e);
    if (win) { sel_e[(size_t)n * 128 + hd * 16 + rk] = eid; sel_g[(size_t)n * 128 + hd * 16 + rk] = e / ssum; }
}

__device__ __forceinline__ float dot2bf(unsigned a, unsigned b, float acc) {
    return __builtin_amdgcn_fdot2_f32_bf16(__builtin_bit_cast(bf16v2, a), __builtin_bit_cast(bf16v2, b), acc, false);
}
__device__ __forceinline__ float dot8bf(const v4u a, const v4u b, float acc) {
    const unsigned a0 = a.x, a1 = a.y, a2 = a.z, a3 = a.w, b0 = b.x, b1 = b.y, b2 = b.z, b3 = b.w;
    acc = dot2bf(a0, b0, acc); acc = dot2bf(a1, b1, acc); acc = dot2bf(a2, b2, acc); acc = dot2bf(a3, b3, acc);
    return acc;
}
__device__ __forceinline__ void peer_token(int n, int lane, const bf16* H, const bf16* U, const bf16* V, const int* sel_e, const float* sel_g, const float* x1, float* xout) {
    v4u hv[4];
#pragma unroll
    for (int j = 0; j < 4; ++j) hv[j] = *(const GAS v4u*)(H + (size_t)n * 2048 + 8 * lane + 512 * j);
    const int e0 = ((const GAS int*)sel_e)[(size_t)n * 128 + lane], e1 = ((const GAS int*)sel_e)[(size_t)n * 128 + 64 + lane];
    const float g0 = ((const GAS float*)sel_g)[(size_t)n * 128 + lane], g1 = ((const GAS float*)sel_g)[(size_t)n * 128 + 64 + lane];
    float y[32];
#pragma unroll
    for (int i = 0; i < 32; ++i) y[i] = 0.f;
#pragma unroll 1
    for (int half = 0; half < 2; ++half) {
        const int ev = half ? e1 : e0; const float gv = half ? g1 : g0;
#pragma unroll 1
        for (int i = 0; i < 64; i += 4) {
            int e[4]; float g[4];
#pragma unroll
            for (int k = 0; k < 4; ++k) { e[k] = __builtin_amdgcn_readlane(ev, i + k); g[k] = rl_f(gv, i + k); }
            v4u uu[4][4], vv[4][4];
#pragma unroll
            for (int k = 0; k < 4; ++k)
#pragma unroll
                for (int j = 0; j < 4; ++j) uu[k][j] = *(const GAS v4u*)(U + (size_t)e[k] * 2048 + 8 * lane + 512 * j);
#pragma unroll
            for (int k = 0; k < 4; ++k)
#pragma unroll
                for (int j = 0; j < 4; ++j) vv[k][j] = *(const GAS v4u*)(V + (size_t)e[k] * 2048 + 8 * lane + 512 * j);
            float d[4];
#pragma unroll
            for (int k = 0; k < 4; ++k) { float a = 0.f;
#pragma unroll
                for (int j = 0; j < 4; ++j) a = dot8bf(hv[j], uu[k][j], a);
                d[k] = a; }
            { const bool up = (lane & 32) != 0; const float sA = up ? d[0] : d[2], kA = up ? d[2] : d[0], sB = up ? d[1] : d[3], kB = up ? d[3] : d[1];
              d[0] = kA + __shfl_xor(sA, 32); d[1] = kB + __shfl_xor(sB, 32); }
            { const bool up = (lane & 16) != 0; const float sA = up ? d[0] : d[1], kA = up ? d[1] : d[0]; d[0] = kA + __shfl_xor(sA, 16); }
            d[0] += __shfl_xor(d[0], 8); d[0] += __shfl_xor(d[0], 4); d[0] += __shfl_xor(d[0], 2); d[0] += __shfl_xor(d[0], 1);
#pragma unroll
            for (int k = 0; k < 4; ++k) {
                const float a = rl_f(d[0], 16 * k);
#ifdef DBG_SKIP_PEER
                const float cf = 0.f * a;
#else
                const float cf = g[k] * gelu_exact(a);
#endif
#pragma unroll
                for (int j = 0; j < 4; ++j) { const v4u t = vv[k][j];
                    y[8 * j + 0] += cf * bflo(t.x); y[8 * j + 1] += cf * bfhi(t.x); y[8 * j + 2] += cf * bflo(t.y); y[8 * j + 3] += cf * bfhi(t.y);
                    y[8 * j + 4] += cf * bflo(t.z); y[8 * j + 5] += cf * bfhi(t.z); y[8 * j + 6] += cf * bflo(t.w); y[8 * j + 7] += cf * bfhi(t.w); }
            }
        }
    }
#pragma unroll
    for (int j = 0; j < 4; ++j) {
        const size_t off = (size_t)n * 2048 + 8 * lane + 512 * j;
        const f32x4 a = *(const GAS f32x4*)(x1 + off), b = *(const GAS f32x4*)(x1 + off + 4);
        f32x4 oa, ob; oa.x = a.x + y[8 * j]; oa.y = a.y + y[8 * j + 1]; oa.z = a.z + y[8 * j + 2]; oa.w = a.w + y[8 * j + 3];
        ob.x = b.x + y[8 * j + 4]; ob.y = b.y + y[8 * j + 5]; ob.z = b.z + y[8 * j + 6]; ob.w = b.w + y[8 * j + 7];
        *(GAS f32x4*)(xout + off) = oa; *(GAS f32x4*)(xout + off + 4) = ob;
    }
}

struct Args { const float* in[21]; float* out; unsigned char* ws; int lo, hi, li, pad; };
__global__ void __launch_bounds__(512, 2) mk_fwd(Args args) {
    extern __shared__ __attribute__((aligned(16))) unsigned char lds_raw[];
    Ctx c; c.lds = (LAS unsigned char*)lds_raw; c.tid = threadIdx.x; c.lane = c.tid & 63; c.wave = __builtin_amdgcn_readfirstlane(c.tid >> 6);
    c.G = gridDim.x; c.gw = blockIdx.x * 8 + c.wave; c.NGW = c.G * 8;
    volatile LAS unsigned* MISC = (volatile LAS unsigned*)(c.lds + MISC_OFF);
    if (c.tid < 32) MISC[c.tid] = 0u;
    __syncthreads();
    unsigned char* ws = args.ws;
    const int lo = args.lo, hi = args.hi;
    XcdBarrier bar; bar.bar = (unsigned*)(ws + WS_CTL) + CW_BAR + args.li * XCD_BAR_WORDS; bar.x = 0; bar.st = nullptr;
    if (hi - lo > 1) bar = xcd_barrier_post((unsigned*)(ws + WS_CTL) + CW_BAR + args.li * XCD_BAR_WORDS, MISC + 8);
#ifndef PHMASK
#define PHMASK 0x3ff
#endif
#define IN(k) (((PHMASK >> ((k) % NPH)) & 1) && lo <= (k) && (k) < hi)
#define SEAM(k) do { if (IN(k) && IN((k) + 1)) xcd_barrier(bar); } while (0)
#define PH_BEGIN unsigned char* w = ws; float* outp = args.out; Ctx cc = c; int zi = 0; \
    asm volatile("" : "+s"(w), "+s"(outp), "+s"(zi), "+v"(cc.tid), "+v"(cc.lane)); (void)w; (void)outp;
#define INP(k) (args.in[(k) + zi])
#define WSP(T, off) ((T*)(w + (off)))
    for (int l = 0; l < 2; ++l) {
        const int pb = l * NPH;
        if (IN(pb + 0)) { PH_BEGIN
            P0Args a; a.w_in = INP(2) + (size_t)l * DM * INW; a.w_br_sb = INP(11) + (size_t)l * BW * DM; a.w_br_hg = INP(12) + (size_t)l * BW * DM; a.w_br_conv = INP(13) + (size_t)l * BW * DM;
            a.w_o = INP(14) + (size_t)l * DM * DM; a.w_q = INP(16) + (size_t)l * DM * DM; a.u = INP(19) + (size_t)l * 16384 * 2048; a.v = INP(20) + (size_t)l * 16384 * 2048; a.lbp = INP(5);
            a.WinT = WSP(bf16, WS_WIN); a.WbrT = WSP(bf16, WS_WBR); a.WoT = WSP(bf16, WS_WO); a.WqT = WSP(bf16, WS_WQ); a.U = WSP(bf16, WS_U); a.V = WSP(bf16, WS_V); a.LB = WSP(float, WS_LB); a.layer = l;
            p0_convert(cc, a);
            rms_phase(cc, l == 0 ? INP(0) : WSP(const float, WS_X2), INP(1) + (size_t)l * DM, WSP(bf16, WS_H));
        }
        SEAM(pb + 0);
        if (IN(pb + 1)) { PH_BEGIN
            pg8::Gemm g{WSP(bf16, WS_H), WSP(bf16, WS_WIN), NTOK, INW, DM}; pg8::StaticOrder S; S.init(NTOK, INW, cc.G, (int)blockIdx.x);
            EpiIn E{WSP(bf16, WS_SEG), WSP(bf16, WS_GATE), WSP(float, WS_LB)};
            pg8::gemm_phase<EpiIn, pg8::StaticOrder, true, true>(cc.lds, g, S, E);
        }
        SEAM(pb + 1);
        if (IN(pb + 2)) { PH_BEGIN
            bf16* SEG = WSP(bf16, WS_SEG);
            conv_phase(cc, SEG + 7 * SEGSZ, INP(7) + (size_t)l * 31 * 1024, INP(8) + (size_t)l * 1024, INP(9) + (size_t)l * 1024, INP(10) + (size_t)l * 1024, WSP(bf16, WS_CONV));
            for (int t = cc.gw; t < 2048; t += cc.NGW) hgrn_task(t, cc.lane, SEG + 3 * SEGSZ, SEG + 4 * SEGSZ, SEG + 5 * SEGSZ, WSP(bf16, WS_HGR));
            for (int r = cc.gw; r < 2 * NTOK; r += cc.NGW) {
                if (r < NTOK) qknorm_row(SEG + (size_t)r * 1024, INP(3) + (size_t)l * 128, 0.08838834764831845f, cc.lane);
                else qknorm_row(SEG + SEGSZ + (size_t)(r - NTOK) * 1024, INP(4) + (size_t)l * 128, 1.0f, cc.lane);
            }
            LAS unsigned short* scr = (LAS unsigned short*)(cc.lds + 4096 + cc.wave * 8192);
            for (int it = cc.gw; it < 8192; it += cc.NGW) vt_item(it, cc.lane, SEG + 2 * SEGSZ, WSP(bf16, WS_MERGED), scr);
        }
        SEAM(pb + 2);
        if (IN(pb + 3)) { PH_BEGIN
            bf16* SEG = WSP(bf16, WS_SEG);
            for (int p = cc.gw; p < 2048; p += cc.NGW) { const int bh = p >> 6, jj = p & 63; attn_item(bh, jj, cc.lane, SEG, SEG + SEGSZ, WSP(bf16, WS_MERGED)); attn_item(bh, 127 - jj, cc.lane, SEG, SEG + SEGSZ, WSP(bf16, WS_MERGED)); }
            for (int r = cc.gw; r < NTOK; r += cc.NGW) hgpost_row(WSP(bf16, WS_HGR) + (size_t)r * 1024, SEG + 6 * SEGSZ + (size_t)r * 1024, INP(6) + (size_t)l * 128, cc.lane);
        }
        SEAM(pb + 3);
        if (IN(pb + 4)) { PH_BEGIN
            pg8::StaticOrder S; S.init(NTOK, DM, cc.G, (int)blockIdx.x);
            { pg8::Gemm g{WSP(bf16, WS_SEG), WSP(bf16, WS_WBR), NTOK, DM, BW}; EpiMerge<true> E{WSP(bf16, WS_GATE), WSP(bf16, WS_MERGED)}; pg8::gemm_phase<EpiMerge<true>, pg8::StaticOrder, true, true>(cc.lds, g, S, E); }
            { pg8::Gemm g{WSP(bf16, WS_HGR), WSP(bf16, WS_WBR) + (size_t)DM * BW, NTOK, DM, BW}; EpiMerge<false> E{WSP(bf16, WS_GATE) + (size_t)NTOK * 2048, WSP(bf16, WS_MERGED)}; pg8::gemm_phase<EpiMerge<false>, pg8::StaticOrder, true, true>(cc.lds, g, S, E); }
            { pg8::Gemm g{WSP(bf16, WS_CONV), WSP(bf16, WS_WBR) + (size_t)2 * DM * BW, NTOK, DM, BW}; EpiMerge<false> E{WSP(bf16, WS_GATE) + (size_t)2 * NTOK * 2048, WSP(bf16, WS_MERGED)}; pg8::gemm_phase<EpiMerge<false>, pg8::StaticOrder, true, true>(cc.lds, g, S, E); }
        }
        SEAM(pb + 4);
        if (IN(pb + 5)) { PH_BEGIN
            pg8::Gemm g{WSP(bf16, WS_MERGED), WSP(bf16, WS_WO), NTOK, DM, DM}; pg8::StaticOrder S; S.init(NTOK, DM, cc.G, (int)blockIdx.x);
            EpiResid E{l == 0 ? INP(0) : WSP(const float, WS_X2), outp};
            pg8::gemm_phase<EpiResid, pg8::StaticOrder, true, true>(cc.lds, g, S, E);
        }
        SEAM(pb + 5);
        if (IN(pb + 6)) { PH_BEGIN rms_phase(cc, outp, INP(15) + (size_t)l * DM, WSP(bf16, WS_H)); }
        SEAM(pb + 6);
        if (IN(pb + 7)) { PH_BEGIN
            pg8::Gemm g{WSP(bf16, WS_H), WSP(bf16, WS_WQ), NTOK, DM, DM}; pg8::StaticOrder S; S.init(NTOK, DM, cc.G, (int)blockIdx.x);
            EpiResid E{nullptr, WSP(float, WS_QPEER)};
            pg8::gemm_phase<EpiResid, pg8::StaticOrder, true, true>(cc.lds, g, S, E);
        }
        SEAM(pb + 7);
        if (IN(pb + 8)) { PH_BEGIN
            int ca = 16, cb = 0;
            { int rem = cc.lane; for (int a = 0; a < 16; ++a) { const int cnt = 16 / (a + 1); if (rem < cnt) { ca = a; cb = rem; break; } rem -= cnt; } }
            LAS float* sc = (LAS float*)(cc.lds + cc.wave * 1024);
            for (int it = cc.gw; it < NTOK * 8; it += cc.NGW)
                peer_select_item(it, cc.lane, ca, cb, WSP(float, WS_QPEER), INP(17) + (size_t)l * 8 * 16384, INP(18) + (size_t)l * 8 * 16384, WSP(int, WS_SEL), WSP(float, WS_SEL + 8 * MiB), sc);
        }
        SEAM(pb + 8);
        if (IN(pb + 9)) { PH_BEGIN
            float* xo = l == 0 ? WSP(float, WS_X2) : outp;
            for (int n = cc.gw; n < NTOK; n += cc.NGW) peer_token(n, cc.lane, WSP(bf16, WS_H), WSP(bf16, WS_U), WSP(bf16, WS_V), WSP(int, WS_SEL), WSP(float, WS_SEL + 8 * MiB), outp, xo);
        }
        SEAM(pb + 9);
    }
#undef PH_BEGIN
#undef INP
#undef WSP
#undef IN
#undef SEAM
}

#ifndef MK_SPLIT
#define MK_SPLIT 0
#endif
extern "C" void kernel_launch(void* const* d_in, const int* in_sizes, int n_in, void* d_out, int out_size, void* d_ws, size_t ws_size, hipStream_t stream) {
    static int grid = 0;
    if (grid == 0) {
        if (n_in != 21 || out_size != NTOK * DM || ws_size < WS_END) { fprintf(stderr, "kernel_launch: unexpected shapes (n_in %d, out %d, ws %zu < %zu); nothing launched\n", n_in, out_size, ws_size, (size_t)WS_END); grid = -1; return; }
        int dev = 0, cus = 0, per_cu = 0;
        if (hipGetDevice(&dev) != hipSuccess || hipDeviceGetAttribute(&cus, hipDeviceAttributeMultiprocessorCount, dev) != hipSuccess) { grid = -1; return; }
        if (hipFuncSetAttribute((const void*)mk_fwd, hipFuncAttributeMaxDynamicSharedMemorySize, LDS_BYTES) != hipSuccess) { fprintf(stderr, "kernel_launch: hipFuncSetAttribute failed\n"); grid = -1; return; }
        if (hipOccupancyMaxActiveBlocksPerMultiprocessor(&per_cu, (const void*)mk_fwd, 512, LDS_BYTES) != hipSuccess || per_cu < 1) fprintf(stderr, "kernel_launch: occupancy query reports %d\n", per_cu);
        (void)hipGetLastError();
        grid = cus;
    }
    if (grid < 0) return;
    if (hipMemsetAsync((char*)d_ws + WS_CTL, 0, 1 * MiB, stream) != hipSuccess) { fprintf(stderr, "kernel_launch: memset failed\n"); return; }
    Args a{};
    for (int i = 0; i < 21; ++i) a.in[i] = (const float*)d_in[i];
    a.out = (float*)d_out; a.ws = (unsigned char*)d_ws; a.pad = 0;
#if MK_SPLIT
    for (int p = 0; p < NPHASES; ++p) { a.lo = p; a.hi = p + 1; a.li = p; hipLaunchKernelGGL(mk_fwd, dim3(grid), dim3(512), LDS_BYTES, stream, a); }
#else
    a.lo = 0; a.hi = NPHASES; a.li = 0;
    hipLaunchKernelGGL(mk_fwd, dim3(grid), dim3(512), LDS_BYTES, stream, a);
#endif
    const hipError_t le = hipPeekAtLastError();
    if (le != hipSuccess) fprintf(stderr, "kernel_launch: launch failed: %s\n", hipGetErrorName(le));
}
```

```cpp
#include <hip/hip_runtime.h>
#include <cstdio>
#include <cstdint>
namespace pg8 {
#define PG8_LAS __attribute__((address_space(3)))
typedef unsigned short bf16_t;
typedef short bf16x8 __attribute__((ext_vector_type(8)));
typedef float f32x4 __attribute__((ext_vector_type(4)));
typedef unsigned u32x4 __attribute__((ext_vector_type(4)));
constexpr int BM = 256, BK = 64, HALF = 128, HTB = HALF * BK * 2  , STAGE_BYTES = 8 * HTB, NXCD = 8, WGM = 8;

__host__ __device__ __forceinline__ int lds_byte(int r, int c) { const int st = (r >> 4) * 2 + (c >> 5), rr = r & 15, cc = c & 31, ob = rr * 64 + cc * 2; return st * 1024 + (ob ^ (((ob >> 9) & 1) << 5)); }
__host__ __device__ __forceinline__ void stage_rc(int b, int& R, int& C) { const int st = b / 1024, sb = b % 1024, swz = sb ^ (((sb >> 9) & 1) << 5); R = (st >> 1) * 16 + swz / 64; C = (st & 1) * 32 + (swz % 64) / 2; }
__host__ __device__ __forceinline__ int perm32(int rho) { const int n = rho >> 4, i = rho & 15; return 8 * (i >> 2) + 4 * n + (i & 3); }

struct Unit { int pm, pn; };
struct Gemm { const bf16_t* A; const bf16_t* Bt; int M, N, K; };

struct StaticOrder {
    int nM, nN, nwg, G, c;
    __host__ __device__ void init(int M, int N, int G_, int c_) { nM = M / BM; nN = N / BM; nwg = nM * nN; G = G_; c = c_; }
    __host__ __device__ bool next(int i, Unit& u) const {
        const long L = (long)i * G + c; if (L >= nwg) return false;
        int wgid = (int)L; { const int q = nwg / NXCD, r = nwg % NXCD, xcd = wgid % NXCD, off = wgid / NXCD; wgid = (xcd < r ? xcd * (q + 1) : r * (q + 1) + (xcd - r) * q) + off; }
        const int nig = WGM * nN, gid = wgid / nig, fm = gid * WGM, gsz = (nM - fm) < WGM ? (nM - fm) : WGM;
        u.pm = fm + ((wgid % nig) % gsz); u.pn = (wgid % nig) / gsz; return true;
    }
    __device__ __forceinline__ void a_ready(const Unit&) const {}
    __device__ __forceinline__ void done(const Unit&) const {}
};

typedef float f32x2 __attribute__((ext_vector_type(2)));
template <class Epi, class Sched, bool ALIGN_EPI = false, bool SP2 = false>
__device__ __forceinline__ void gemm_phase(PG8_LAS unsigned char* lds, const Gemm g, const Sched& S, const Epi& E) {
    int tid_ = threadIdx.x; asm volatile("" : "+v"(tid_)); int K_ = g.K; asm volatile("" : "+s"(K_));
    const int tid = tid_, wid = __builtin_amdgcn_readfirstlane(tid >> 6), lane = tid & 63, wr = wid >> 2, wc = wid & 3, fr = lane & 15, fq = lane >> 4;
    const int K = K_, nt = K / BK;
    unsigned voffA[2], voffB[2];
#pragma unroll
    for (int i = 0; i < 2; ++i) { int R, C; stage_rc(tid * 16 + i * 8192, R, C); const int Rb = Epi::PERM ? ((R & ~31) + perm32(R & 31)) : R;
        voffA[i] = (unsigned)(R * K + C) * 2u; voffB[i] = (unsigned)(Rb * K + C) * 2u; }
    const size_t kstep = (size_t)(BK * 2);
    const size_t hstep = (size_t)HALF * K * 2;
    const size_t tstep = 2 * hstep;
    const unsigned ldsw = (unsigned)wid * 1024u;
    const int aoff = lds_byte(wr * 64 + fr, fq * 8), boff = lds_byte(wc * 32 + fr, fq * 8);
#define PG8_SA(b, h) (((b) * 2 + (h)) * HTB)
#define PG8_SB(b, h) ((4 + (b) * 2 + (h)) * HTB)
#define PG8_STAGE(bufoff, gbase, voff) do { _Pragma("unroll") for (int _i = 0; _i < 2; ++_i) \
        __builtin_amdgcn_global_load_lds((const unsigned*)((const char*)(gbase) + (voff)[_i]), (PG8_LAS unsigned*)(lds + (bufoff) + ldsw + _i * 8192), 16, 0, 0); } while (0)
#define PG8_LDA(dst, b, h) do { _Pragma("unroll") for (int m = 0; m < 4; ++m) _Pragma("unroll") for (int k = 0; k < 2; ++k) dst[m][k] = *(const PG8_LAS bf16x8*)(lds + PG8_SA(b, h) + aoff + m * 2048 + k * 1024); } while (0)
#define PG8_LDB(dst, b, h) do { _Pragma("unroll") for (int n = 0; n < 2; ++n) _Pragma("unroll") for (int k = 0; k < 2; ++k) dst[n][k] = *(const PG8_LAS bf16x8*)(lds + PG8_SB(b, h) + boff + n * 2048 + k * 1024); } while (0)
#define PG8_MMA(ai, bj, At, Bt) do { __builtin_amdgcn_s_setprio(1); _Pragma("unroll") for (int m = 0; m < 4; ++m) _Pragma("unroll") for (int n = 0; n < 2; ++n) _Pragma("unroll") for (int k = 0; k < 2; ++k) \
        acc[ai][bj][m][n] = __builtin_amdgcn_mfma_f32_16x16x32_bf16(Bt[n][k], At[m][k], acc[ai][bj][m][n], 0, 0, 0); __builtin_amdgcn_s_setprio(0); } while (0)
#define PG8_WAIT_V(n) asm volatile("s_waitcnt vmcnt(" #n ")" ::: "memory")
#define PG8_WAIT_L(n) asm volatile("s_waitcnt lgkmcnt(" #n ")" ::: "memory")
#define PG8_BAR __builtin_amdgcn_s_barrier()
#define PG8_SCHED __builtin_amdgcn_sched_barrier(0)
    Unit cur, nxt; int ui = 0;
    if (!S.next(0, cur)) return;
    f32x4 acc[2][2][4][2];
#pragma unroll
    for (int a = 0; a < 2; ++a)
#pragma unroll
        for (int b = 0; b < 2; ++b)
#pragma unroll
            for (int m = 0; m < 4; ++m)
#pragma unroll
                for (int n = 0; n < 2; ++n) acc[a][b][m][n] = (f32x4){0.f, 0.f, 0.f, 0.f};
    bf16x8 At[4][2], B0[2][2], B1[2][2];
    const char* cA = (const char*)g.A + (size_t)cur.pm * tstep; const char* cB = (const char*)g.Bt + (size_t)cur.pn * tstep;
    S.a_ready(cur);
    if constexpr (SP2) {
        PG8_STAGE(PG8_SB(0, 0), cB, voffB); PG8_STAGE(PG8_SB(0, 1), cB + hstep, voffB); PG8_STAGE(PG8_SA(0, 0), cA, voffA); PG8_STAGE(PG8_SA(0, 1), cA + hstep, voffA);
        if (wr == 1) PG8_BAR;
        PG8_WAIT_V(2); PG8_BAR;
        PG8_STAGE(PG8_SB(1, 0), cB + kstep, voffB); PG8_STAGE(PG8_SA(1, 0), cA + kstep, voffA); PG8_STAGE(PG8_SB(1, 1), cB + hstep + kstep, voffB);
        PG8_WAIT_V(6); PG8_BAR;
    } else {
        PG8_STAGE(PG8_SB(0, 0), cB, voffB); PG8_STAGE(PG8_SA(0, 0), cA, voffA); PG8_STAGE(PG8_SB(0, 1), cB + hstep, voffB); PG8_STAGE(PG8_SA(0, 1), cA + hstep, voffA);
        if (wr == 1) PG8_BAR;
        PG8_WAIT_V(4); PG8_BAR;
        PG8_STAGE(PG8_SB(1, 0), cB + kstep, voffB); PG8_STAGE(PG8_SA(1, 0), cA + kstep, voffA); PG8_STAGE(PG8_SB(1, 1), cB + hstep + kstep, voffB);
        PG8_WAIT_V(6); PG8_BAR;
    }
    for (;;) {
        const bool has_next = S.next(ui + 1, nxt);
        const char* nA = has_next ? (const char*)g.A + (size_t)nxt.pm * tstep : cA; const char* nB = has_next ? (const char*)g.Bt + (size_t)nxt.pn * tstep : cB;
        for (int t = 0; t < nt; t += 2) {
            const bool last = (t == nt - 2);
            const char* a1 = cA + (size_t)(t + 1) * kstep;
            const char* a2 = last ? nA : cA + (size_t)(t + 2) * kstep; const char* b2 = last ? nB : cB + (size_t)(t + 2) * kstep;
            const char* a3 = a2 + kstep; const char* b3 = b2 + kstep;
            if (last && has_next) S.a_ready(nxt);
            if constexpr (SP2) {
            PG8_LDB(B0, 0, 0); PG8_LDB(B1, 0, 1); PG8_SCHED; PG8_LDA(At, 0, 0); PG8_STAGE(PG8_SA(1, 1), a1 + hstep, voffA);
            PG8_WAIT_V(8); PG8_WAIT_L(0); PG8_BAR; PG8_MMA(0, 0, At, B0); PG8_MMA(0, 1, At, B1); PG8_BAR; PG8_SCHED;
            PG8_LDA(At, 0, 1); PG8_STAGE(PG8_SB(0, 0), b2, voffB); PG8_STAGE(PG8_SB(0, 1), b2 + hstep, voffB); PG8_STAGE(PG8_SA(0, 0), a2, voffA);
            PG8_WAIT_V(8); PG8_WAIT_L(0); PG8_BAR; PG8_MMA(1, 0, At, B0); PG8_MMA(1, 1, At, B1); PG8_BAR; PG8_SCHED;
            PG8_LDB(B0, 1, 0); PG8_LDB(B1, 1, 1); PG8_SCHED; PG8_LDA(At, 1, 0); PG8_STAGE(PG8_SA(0, 1), a2 + hstep, voffA);
            PG8_WAIT_V(8); PG8_WAIT_L(0); PG8_BAR; PG8_MMA(0, 0, At, B0); PG8_MMA(0, 1, At, B1); PG8_BAR; PG8_SCHED;
            PG8_LDA(At, 1, 1); PG8_STAGE(PG8_SB(1, 0), b3, voffB); PG8_STAGE(PG8_SB(1, 1), b3 + hstep, voffB); PG8_STAGE(PG8_SA(1, 0), a3, voffA);
            PG8_WAIT_V(8); PG8_WAIT_L(0); PG8_BAR; PG8_MMA(1, 0, At, B0); PG8_MMA(1, 1, At, B1); PG8_BAR; PG8_SCHED;
            } else {
            PG8_LDB(B0, 0, 0); PG8_SCHED; PG8_LDA(At, 0, 0); PG8_STAGE(PG8_SA(1, 1), a1 + hstep, voffA);
            PG8_WAIT_L(8); PG8_BAR; PG8_WAIT_L(0); PG8_MMA(0, 0, At, B0); PG8_BAR; PG8_SCHED;
            PG8_LDB(B1, 0, 1); PG8_STAGE(PG8_SB(0, 0), b2, voffB);
            PG8_BAR; PG8_WAIT_L(0); PG8_MMA(0, 1, At, B1); PG8_BAR;
            PG8_LDA(At, 0, 1); PG8_STAGE(PG8_SA(0, 0), a2, voffA);
            PG8_BAR; PG8_WAIT_L(0); PG8_MMA(1, 0, At, B0); PG8_BAR; PG8_SCHED;
            PG8_STAGE(PG8_SB(0, 1), b2 + hstep, voffB);
            PG8_WAIT_V(6); PG8_BAR; PG8_MMA(1, 1, At, B1); PG8_BAR;
            PG8_LDB(B0, 1, 0); PG8_SCHED; PG8_LDA(At, 1, 0); PG8_STAGE(PG8_SA(0, 1), a2 + hstep, voffA);
            PG8_WAIT_L(8); PG8_BAR; PG8_WAIT_L(0); PG8_MMA(0, 0, At, B0); PG8_BAR; PG8_SCHED;
            PG8_LDB(B1, 1, 1); PG8_STAGE(PG8_SB(1, 0), b3, voffB);
            PG8_BAR; PG8_WAIT_L(0); PG8_MMA(0, 1, At, B1); PG8_BAR;
            PG8_LDA(At, 1, 1); PG8_STAGE(PG8_SA(1, 0), a3, voffA);
            PG8_BAR; PG8_WAIT_L(0); PG8_MMA(1, 0, At, B0); PG8_BAR; PG8_SCHED;
            PG8_STAGE(PG8_SB(1, 1), b3 + hstep, voffB);
            PG8_WAIT_V(6); PG8_BAR; PG8_MMA(1, 1, At, B1); PG8_BAR;
            }
        }
        if constexpr (ALIGN_EPI) { if (wr == 0) PG8_BAR; }
        if constexpr (!Epi::AFTER_DRAIN) { E(acc, cur, wr, wc, fr, fq); S.done(cur); }
        if (!has_next) break;
#pragma unroll
        for (int a = 0; a < 2; ++a)
#pragma unroll
            for (int b = 0; b < 2; ++b)
#pragma unroll
                for (int m = 0; m < 4; ++m)
#pragma unroll
                    for (int n = 0; n < 2; ++n) acc[a][b][m][n] = (f32x4){0.f, 0.f, 0.f, 0.f};
        cur = nxt; cA = nA; cB = nB; ++ui;
        if constexpr (ALIGN_EPI) { if (wr == 1) PG8_BAR; }
    }
    PG8_WAIT_V(0);
    if constexpr (!ALIGN_EPI) { if (wr == 0) PG8_BAR; }
    PG8_BAR;
    if constexpr (Epi::AFTER_DRAIN) { E.fused(acc, cur, wr, wc, fr, fq, lds, wid, lane); S.done(cur); }
#undef PG8_SA
#undef PG8_SB
#undef PG8_STAGE
#undef PG8_LDA
#undef PG8_LDB
#undef PG8_MMA
#undef PG8_WAIT_V
#undef PG8_WAIT_L
#undef PG8_BAR
#undef PG8_SCHED
}
}
#define XB_TMO      128
#define XB_XCNT(j)  (256  + 64 * (j))
#define XB_XSUB(j)  (1280 + 64 * (j))
#define XB_XGEN(j)  (2304 + 64 * (j))
#define XB_TOP      3328
#define XB_TOPGEN   3392
#define XCD_BAR_WORDS 3456
#define XB_SPIN_CAP (1u << 24)
#define LAS __attribute__((address_space(3)))

__device__ __forceinline__ unsigned xb_ld(unsigned* p)              { return __hip_atomic_load(p, __ATOMIC_RELAXED, __HIP_MEMORY_SCOPE_AGENT); }
__device__ __forceinline__ unsigned xb_add(unsigned* p, unsigned v) { return __hip_atomic_fetch_add(p, v, __ATOMIC_RELAXED, __HIP_MEMORY_SCOPE_AGENT); }
__device__ __forceinline__ unsigned xb_xcc_id() { return (unsigned)__builtin_amdgcn_s_getreg((3 << 11) | 20) & 0xFu; }
#define XB_SPIN(cond, bar) do { unsigned _sp = 0; while (cond) { __builtin_amdgcn_s_sleep(1); \
    if ((++_sp & 255u) == 0u) { if (xb_ld(&(bar)[XB_TMO])) break; if (_sp > XB_SPIN_CAP) { atomicAdd(&(bar)[XB_TMO], 1u); break; } } } } while (0)

struct XcdBarrier {
    unsigned* bar; unsigned x;
    volatile LAS unsigned* st;
};

__device__ __forceinline__ XcdBarrier xcd_barrier_post(unsigned* bar, volatile LAS unsigned* st) {
    XcdBarrier b; b.bar = bar; b.x = xb_xcc_id(); b.st = st;
    if (threadIdx.x == 0) (void)xb_add(&bar[XB_XCNT(b.x)], 1u);
    return b;
}
__device__ __forceinline__ void xcd_barrier_complete(unsigned* bar, unsigned x, unsigned& nloc, unsigned& nx) {
    const unsigned G = gridDim.x * gridDim.y * gridDim.z;
    unsigned sum, cnt, mine, sp = 0u;
    for (;;) {
        sum = 0u; cnt = 0u; mine = 0u;
#pragma unroll
        for (unsigned j = 0; j < 16; ++j) { const unsigned c = xb_ld(&bar[XB_XCNT(j)]); sum += c; cnt += (c > 0u) ? 1u : 0u; mine = (j == x) ? c : mine; }
        if (sum == G) break;
        __builtin_amdgcn_s_sleep(1);
        if ((++sp & 255u) == 0u) { if (xb_ld(&bar[XB_TMO])) break; if (sp > XB_SPIN_CAP) { atomicAdd(&bar[XB_TMO], 1u); break; } }
    }
    nloc = mine > 0u ? mine : 1u; nx = cnt > 0u ? cnt : 1u;
}

__device__ __forceinline__ void xcd_barrier(const XcdBarrier& b) {
    asm volatile("s_waitcnt vmcnt(0)" ::: "memory");
    __syncthreads();
    if (threadIdx.x == 0) {
        unsigned* bar = b.bar;
        __builtin_amdgcn_s_waitcnt(0);
        unsigned nloc = b.st[0], nx = b.st[1];
        if (nloc == 0u) { xcd_barrier_complete(bar, b.x, nloc, nx); b.st[0] = nloc; b.st[1] = nx; }
        const unsigned old = xb_add(&bar[XB_XSUB(b.x)], 1u);
        const unsigned gen = old / nloc;
        if (old + 1u == (gen + 1u) * nloc) {
            __builtin_amdgcn_fence(__ATOMIC_RELEASE, "agent");
            asm volatile("s_waitcnt vmcnt(0)" ::: "memory");
            const unsigned og = xb_add(&bar[XB_TOP], 1u);
            const unsigned tg = og / nx;
            if (og + 1u == (tg + 1u) * nx) xb_add(&bar[XB_TOPGEN], 1u);
            else XB_SPIN(xb_ld(&bar[XB_TOPGEN]) == tg, bar);
            __builtin_amdgcn_fence(__ATOMIC_ACQUIRE, "agent");
            xb_add(&bar[XB_XGEN(b.x)], 1u);
            asm volatile("s_waitcnt vmcnt(0)" ::: "memory");
        } else {
            XB_SPIN(xb_ld(&bar[XB_XGEN(b.x)]) == gen, bar);
            __builtin_amdgcn_fence(__ATOMIC_ACQUIRE, "agent");
            asm volatile("s_waitcnt vmcnt(0)" ::: "memory");
        }
    }
    __syncthreads();
}


#define GAS __attribute__((address_space(1)))
typedef unsigned short bf16;
typedef unsigned v4u __attribute__((ext_vector_type(4)));
typedef unsigned v2u __attribute__((ext_vector_type(2)));
typedef float f32x4 __attribute__((ext_vector_type(4)));
typedef float f32x2v __attribute__((ext_vector_type(2)));
typedef float f32x16 __attribute__((ext_vector_type(16)));
typedef short bf16x8 __attribute__((ext_vector_type(8)));
typedef __bf16 bf16v2 __attribute__((ext_vector_type(2)));

constexpr int NTOK = 16384, DM = 2048, SEQ = 4096, INW = 15360, BW = 1024;
constexpr float EPS = 1e-6f;
constexpr int NPH = 10;
constexpr int NPHASES = 2 * NPH;

constexpr size_t MiB = 1u << 20;
constexpr size_t WS_CTL = 0;
constexpr size_t WS_LB = 1 * MiB;
constexpr size_t WS_US = 1 * MiB + 64 * 1024, WS_VS = 1 * MiB + 128 * 1024;
constexpr size_t WS_WIN = 2 * MiB;
constexpr size_t WS_WBR = 62 * MiB;
constexpr size_t WS_WO = 74 * MiB;
constexpr size_t WS_WQ = 82 * MiB;
constexpr size_t WS_U = 91 * MiB;
constexpr size_t WS_V = 155 * MiB;
constexpr size_t WS_H = 219 * MiB;
constexpr size_t WS_SEG = 283 * MiB;
constexpr size_t WS_GATE = 539 * MiB;
constexpr size_t WS_X2 = 731 * MiB;
constexpr size_t WS_CONV = 859 * MiB;
constexpr size_t WS_HGR = 891 * MiB;
constexpr size_t WS_MERGED = 923 * MiB;
constexpr size_t WS_SEL = 987 * MiB;
constexpr size_t WS_SELS = 1003 * MiB;
constexpr size_t WS_END = 1004 * MiB;
constexpr size_t WS_KEYS = 90 * MiB;
constexpr size_t WS_QPEER = WS_SEG;
constexpr size_t SEGSZ = (size_t)NTOK * 1024;
constexpr int CW_BAR = 4096;

constexpr int RING_BYTES = 131072, MISC_OFF = RING_BYTES + 320, LDS_BYTES = 147456;

__device__ __forceinline__ unsigned pk2c(float lo, float hi) { f32x2v v = {lo, hi}; bf16v2 b = __builtin_convertvector(v, bf16v2); return __builtin_bit_cast(unsigned, b); }
__device__ __forceinline__ float bflo(unsigned x) { return __uint_as_float(x << 16); }
__device__ __forceinline__ float bfhi(unsigned x) { return __uint_as_float(x & 0xffff0000u); }
__device__ __forceinline__ float sigm(float x) { return __builtin_amdgcn_rcpf(1.0f + __expf(-x)); }
__device__ __forceinline__ float wave_sum(float v) {
#pragma unroll
    for (int o = 1; o < 64; o <<= 1) v += __shfl_xor(v, o);
    return v;
}
__device__ __forceinline__ float wave_max(float v) {
#pragma unroll
    for (int o = 1; o < 64; o <<= 1) v = fmaxf(v, __shfl_xor(v, o));
    return v;
}
#define LDS_WAIT() asm volatile("s_waitcnt lgkmcnt(0)" ::: "memory")
__device__ __forceinline__ int ridx16(int lane) { return ((lane >> 5) & 1) * 8 + ((lane >> 4) & 1) * 4 + ((lane >> 3) & 1) * 2 + ((lane >> 2) & 1); }
__device__ __forceinline__ void xreduce16(float (&v)[16], int lane) {
#pragma unroll
    for (int i = 0; i < 8; ++i) { const bool up = (lane & 32) != 0; const float snd = up ? v[i] : v[i + 8], kp = up ? v[i + 8] : v[i]; v[i] = kp + __shfl_xor(snd, 32); }
#pragma unroll
    for (int i = 0; i < 4; ++i) { const bool up = (lane & 16) != 0; const float snd = up ? v[i] : v[i + 4], kp = up ? v[i + 4] : v[i]; v[i] = kp + __shfl_xor(snd, 16); }
#pragma unroll
    for (int i = 0; i < 2; ++i) { const bool up = (lane & 8) != 0; const float snd = up ? v[i] : v[i + 2], kp = up ? v[i + 2] : v[i]; v[i] = kp + __shfl_xor(snd, 8); }
    { const bool up = (lane & 4) != 0; const float snd = up ? v[0] : v[1], kp = up ? v[1] : v[0]; v[0] = kp + __shfl_xor(snd, 4); }
    v[0] += __shfl_xor(v[0], 2); v[0] += __shfl_xor(v[0], 1);
}
__device__ __forceinline__ float gelu_exact(float v) {
    const float av = fabsf(v), t = __builtin_amdgcn_rcpf(av * 0.2316418882f + 1.0f);
    float q = t * 0.5307027145f + (-0.7265760135f); q = q * t + 0.7107068705f; q = q * t + (-0.142248368f); q = q * t + 0.127414796f; q = q * t;
    const float e = __builtin_amdgcn_exp2f((v * v) * (-0.72134752044f));
    const float m = v * (q * e);
    return v < 0.f ? m : v - m;
}

struct Ctx { LAS unsigned char* lds; int tid, lane, wave, G, gw, NGW; };

__device__ __forceinline__ void tr_item(const float* W, int K, int N, bf16* WT, int k0, int n0, int drow0, LAS float* scr, int lane) {
#pragma unroll 8
    for (int i = 0; i < 32; ++i) { const int kk = 2 * i + (lane >> 5); scr[kk * 33 + (lane & 31)] = ((const GAS float*)W)[(size_t)(k0 + kk) * N + n0 + (lane & 31)]; }
    LDS_WAIT();
    const int c = lane & 7;
#pragma unroll
    for (int j = 0; j < 4; ++j) { const int n = (lane >> 3) + 8 * j; const LAS float* s = scr + (8 * c) * 33 + n;
        v4u o; o.x = pk2c(s[0], s[33]); o.y = pk2c(s[66], s[99]); o.z = pk2c(s[132], s[165]); o.w = pk2c(s[198], s[231]);
        *(GAS v4u*)(WT + (size_t)(drow0 + n) * K + k0 + 8 * c) = o; }
    LDS_WAIT();
}
__device__ __forceinline__ int win_drow(int n) { if (n < 7168 || n >= 9216) return n; const int r = n - 7168, isb = r >> 10, c = r & 1023; return 7168 + (c >> 7) * 256 + isb * 128 + (c & 127); }
__device__ __forceinline__ void cvt_copy(const Ctx& c, const float* src, bf16* dst, size_t n8) {
    const size_t NT = (size_t)c.G * 512;
    for (size_t i = (size_t)blockIdx.x * 512 + c.tid; i < n8; i += NT) {
        const f32x4 a = ((const GAS f32x4*)src)[2 * i], b = ((const GAS f32x4*)src)[2 * i + 1];
        v4u o; o.x = pk2c(a.x, a.y); o.y = pk2c(a.z, a.w); o.z = pk2c(b.x, b.y); o.w = pk2c(b.z, b.w);
        ((GAS v4u*)dst)[i] = o;
    }
}
__device__ __forceinline__ void rms_row(const float* xr, const float* w, bf16* o, int lane) {
    const GAS f32x4* xp = (const GAS f32x4*)xr + lane; f32x4 v[8]; float s = 0.f;
#pragma unroll
    for (int j = 0; j < 8; ++j) { v[j] = xp[64 * j]; s += (v[j].x * v[j].x + v[j].y * v[j].y) + (v[j].z * v[j].z + v[j].w * v[j].w); }
    const float r = __builtin_amdgcn_rsqf(wave_sum(s) * (1.0f / DM) + EPS);
    const GAS f32x4* wp = (const GAS f32x4*)w + lane; GAS v2u* op = (GAS v2u*)o + lane;
#pragma unroll
    for (int j = 0; j < 8; ++j) { const f32x4 wv = wp[64 * j]; v2u q; q.x = pk2c(v[j].x * r * wv.x, v[j].y * r * wv.y); q.y = pk2c(v[j].z * r * wv.z, v[j].w * r * wv.w); op[64 * j] = q; }
}
__device__ __forceinline__ void rms_phase(const Ctx& c, const float* x, const float* w, bf16* H) {
    for (int m = c.gw; m < NTOK; m += c.NGW) rms_row(x + (size_t)m * DM, w, H + (size_t)m * DM, c.lane);
}
__device__ __forceinline__ void fp8_row(const float* src, unsigned char* dst, float* scale_out, int lane) {
    const GAS f32x4* xp = (const GAS f32x4*)src + lane; f32x4 v[8]; float m = 0.f;
#pragma unroll
    for (int j = 0; j < 8; ++j) { v[j] = xp[64 * j]; m = fmaxf(fmaxf(m, fmaxf(fabsf(v[j].x), fabsf(v[j].y))), fmaxf(fabsf(v[j].z), fabsf(v[j].w))); }
    m = wave_max(m);
    const float inv = m > 0.f ? 256.0f / m : 0.f;
    if (lane == 0) *(GAS float*)scale_out = m * (1.0f / 256.0f);
#pragma unroll
    for (int j = 0; j < 8; ++j) { int p = __builtin_amdgcn_cvt_pk_fp8_f32(v[j].x * inv, v[j].y * inv, 0, false); p = __builtin_amdgcn_cvt_pk_fp8_f32(v[j].z * inv, v[j].w * inv, p, true);
        ((GAS unsigned*)dst)[lane + 64 * j] = (unsigned)p; }
}
struct P0Args { const float *w_in, *w_br_sb, *w_br_hg, *w_br_conv, *w_o, *w_q, *u, *v, *lbp; bf16 *WinT, *WbrT, *WoT, *WqT; unsigned char *U, *V; float *US, *VS; float* LB; int layer; const float *k1, *k2; bf16* KB; };
__device__ __forceinline__ void p0_convert(const Ctx& c, const P0Args& a) {
    LAS float* scr = (LAS float*)(c.lds + c.wave * 16384);
    constexpr int I_IN = (DM / 64) * (INW / 32), I_BR = (BW / 64) * (DM / 32), I_SQ = (DM / 64) * (DM / 32);
    constexpr int NITEMS = I_IN + 3 * I_BR + 2 * I_SQ;
    for (int it = c.gw; it < NITEMS; it += c.NGW) {
        int r = it;
        if (r < I_IN) { const int kb = r / (INW / 32), nb = r % (INW / 32); tr_item(a.w_in, DM, INW, a.WinT, kb * 64, nb * 32, win_drow(nb * 32), scr, c.lane); continue; } r -= I_IN;
        if (r < I_BR) { const int kb = r / (DM / 32), nb = r % (DM / 32); tr_item(a.w_br_sb, BW, DM, a.WbrT, kb * 64, nb * 32, nb * 32, scr, c.lane); continue; } r -= I_BR;
        if (r < I_BR) { const int kb = r / (DM / 32), nb = r % (DM / 32); tr_item(a.w_br_hg, BW, DM, a.WbrT + (size_t)DM * BW, kb * 64, nb * 32, nb * 32, scr, c.lane); continue; } r -= I_BR;
        if (r < I_BR) { const int kb = r / (DM / 32), nb = r % (DM / 32); tr_item(a.w_br_conv, BW, DM, a.WbrT + (size_t)2 * DM * BW, kb * 64, nb * 32, nb * 32, scr, c.lane); continue; } r -= I_BR;
        if (r < I_SQ) { const int kb = r / (DM / 32), nb = r % (DM / 32); tr_item(a.w_o, DM, DM, a.WoT, kb * 64, nb * 32, nb * 32, scr, c.lane); continue; } r -= I_SQ;
        { const int kb = r / (DM / 32), nb = r % (DM / 32); tr_item(a.w_q, DM, DM, a.WqT, kb * 64, nb * 32, nb * 32, scr, c.lane); }
    }
    for (int r = c.gw; r < 2 * 16384; r += c.NGW) {
        if (r < 16384) fp8_row(a.u + (size_t)r * 2048, a.U + (size_t)r * 2048, a.US + r, c.lane);
        else fp8_row(a.v + (size_t)(r - 16384) * 2048, a.V + (size_t)(r - 16384) * 2048, a.VS + (r - 16384), c.lane);
    }
    cvt_copy(c, a.k1, a.KB, (size_t)8 * 16384 / 8);
    cvt_copy(c, a.k2, a.KB + 8 * 16384, (size_t)8 * 16384 / 8);
    if (blockIdx.x == 0) for (int i = c.tid; i < 1024; i += 512) a.LB[i] = a.layer == 0 ? 0.f : sigm(a.lbp[1024 + i] - a.lbp[i]);
}

struct EpiIn {
    static constexpr bool PERM = true, AFTER_DRAIN = false;
    bf16* seg; bf16* gate; const float* lb;
    __device__ __forceinline__ void operator()(const pg8::f32x4 (&acc)[2][2][4][2], const pg8::Unit& u, int wr, int wc, int fr, int fq) const {
        const int pn = u.pn; const int row0 = u.pm * 256 + wr * 64 + fr;
        if (pn >= 28 && pn < 36) {
            bf16* dst = seg + (size_t)7 * SEGSZ; const int col0 = (pn - 28) * 128 + wc * 32 + 8 * fq;
#pragma unroll
            for (int ai = 0; ai < 2; ++ai)
#pragma unroll
                for (int m = 0; m < 4; ++m) {
                    const pg8::f32x4 a0 = acc[ai][0][m][0], a1 = acc[ai][0][m][1], b0 = acc[ai][1][m][0], b1 = acc[ai][1][m][1];
                    v4u w; w.x = pk2c(a0[0] * sigm(b0[0]), a0[1] * sigm(b0[1])); w.y = pk2c(a0[2] * sigm(b0[2]), a0[3] * sigm(b0[3]));
                    w.z = pk2c(a1[0] * sigm(b1[0]), a1[1] * sigm(b1[1])); w.w = pk2c(a1[2] * sigm(b1[2]), a1[3] * sigm(b1[3]));
                    *(GAS v4u*)(dst + (size_t)(row0 + ai * 128 + m * 16) * 1024 + col0) = w; }
            return;
        }
        bf16* dst; int ld, colt, mode;
        if (pn < 28) { const int sg = pn >> 2; dst = seg + (size_t)sg * SEGSZ; ld = 1024; colt = (pn & 3) * 256; mode = (sg == 4) ? 2 : (sg == 6 ? 1 : 0); }
        else { const int q = pn - 36; dst = gate + (size_t)(q >> 3) * ((size_t)NTOK * 2048); ld = 2048; colt = (q & 7) * 256; mode = 1; }
        const int col0 = colt + wc * 32 + 8 * fq;
        if (mode == 0) {
#pragma unroll
            for (int ai = 0; ai < 2; ++ai)
#pragma unroll
                for (int m = 0; m < 4; ++m)
#pragma unroll
                    for (int bj = 0; bj < 2; ++bj) { const pg8::f32x4 v0 = acc[ai][bj][m][0], v1 = acc[ai][bj][m][1];
                        v4u w; w.x = pk2c(v0[0], v0[1]); w.y = pk2c(v0[2], v0[3]); w.z = pk2c(v1[0], v1[1]); w.w = pk2c(v1[2], v1[3]);
                        *(GAS v4u*)(dst + (size_t)(row0 + ai * 128 + m * 16) * ld + col0 + bj * 128) = w; }
        } else if (mode == 1) {
#pragma unroll
            for (int ai = 0; ai < 2; ++ai)
#pragma unroll
                for (int m = 0; m < 4; ++m)
#pragma unroll
                    for (int bj = 0; bj < 2; ++bj) { const pg8::f32x4 v0 = acc[ai][bj][m][0], v1 = acc[ai][bj][m][1];
                        v4u w; w.x = pk2c(sigm(v0[0]), sigm(v0[1])); w.y = pk2c(sigm(v0[2]), sigm(v0[3])); w.z = pk2c(sigm(v1[0]), sigm(v1[1])); w.w = pk2c(sigm(v1[2]), sigm(v1[3]));
                        *(GAS v4u*)(dst + (size_t)(row0 + ai * 128 + m * 16) * ld + col0 + bj * 128) = w; }
        } else {
            f32x4 l0[2], l1[2];
#pragma unroll
            for (int bj = 0; bj < 2; ++bj) { l0[bj] = *(const GAS f32x4*)(lb + col0 + bj * 128); l1[bj] = *(const GAS f32x4*)(lb + col0 + bj * 128 + 4); }
#pragma unroll
            for (int ai = 0; ai < 2; ++ai)
#pragma unroll
                for (int m = 0; m < 4; ++m)
#pragma unroll
                    for (int bj = 0; bj < 2; ++bj) { const pg8::f32x4 v0 = acc[ai][bj][m][0], v1 = acc[ai][bj][m][1]; float r[8];
#pragma unroll
                        for (int j = 0; j < 4; ++j) { r[j] = __logf(l0[bj][j] + (1.0f - l0[bj][j]) * sigm(v0[j])); r[4 + j] = __logf(l1[bj][j] + (1.0f - l1[bj][j]) * sigm(v1[j])); }
                        v4u w; w.x = pk2c(r[0], r[1]); w.y = pk2c(r[2], r[3]); w.z = pk2c(r[4], r[5]); w.w = pk2c(r[6], r[7]);
                        *(GAS v4u*)(dst + (size_t)(row0 + ai * 128 + m * 16) * ld + col0 + bj * 128) = w; }
        }
    }
};

__device__ __forceinline__ void conv_phase(const Ctx& c, const bf16* glu, const float* cw, const float* cb, const float* lnw, const float* lnb, bf16* out) {
    const int c0 = 2 * c.tid;
    float w0[31], w1[31];
#pragma unroll
    for (int j = 0; j < 31; ++j) { const f32x2v t = *(const GAS f32x2v*)(cw + j * 1024 + c0); w0[j] = t.x; w1[j] = t.y; }
    const f32x2v bv = *(const GAS f32x2v*)(cb + c0), lwv = *(const GAS f32x2v*)(lnw + c0), lbv = *(const GAS f32x2v*)(lnb + c0);
    LAS float* red = (LAS float*)c.lds;
    for (int tile = blockIdx.x; tile < NTOK / 8; tile += c.G) {
        const int n0 = tile * 8, tseq0 = n0 & (SEQ - 1);
        float a0[8], a1[8];
#pragma unroll
        for (int t = 0; t < 8; ++t) { a0[t] = bv.x; a1[t] = bv.y; }
#pragma unroll
        for (int r = 0; r < 38; ++r) {
            unsigned xv = 0u;
            if (tseq0 + r - 30 >= 0) xv = *(const GAS unsigned*)(glu + (size_t)(n0 + r - 30) * 1024 + c0);
            const float x0 = bflo(xv), x1 = bfhi(xv);
#pragma unroll
            for (int t = 0; t < 8; ++t) { const int j = r - t; if (j >= 0 && j <= 30) { a0[t] += w0[j] * x0; a1[t] += w1[j] * x1; } }
        }
        float st[16];
#pragma unroll
        for (int t = 0; t < 8; ++t) { st[2 * t] = a0[t] + a1[t]; st[2 * t + 1] = a0[t] * a0[t] + a1[t] * a1[t]; }
        xreduce16(st, c.lane);
        if ((c.lane & 3) == 0) red[c.wave * 16 + ridx16(c.lane)] = st[0];
        __syncthreads();
        if (c.tid < 16) { float s = 0.f;
#pragma unroll
            for (int w = 0; w < 8; ++w) s += red[w * 16 + c.tid];
            red[128 + c.tid] = s; }
        __syncthreads();
#pragma unroll
        for (int t = 0; t < 8; ++t) {
            const float mean = red[128 + 2 * t] * (1.0f / 1024.0f), var = red[128 + 2 * t + 1] * (1.0f / 1024.0f) - mean * mean;
            const float rstd = __builtin_amdgcn_rsqf(var + EPS);
            const float h0 = (a0[t] - mean) * rstd * lwv.x + lbv.x, h1 = (a1[t] - mean) * rstd * lwv.y + lbv.y;
            *(GAS unsigned*)(out + (size_t)(n0 + t) * 1024 + c0) = pk2c(h0 * sigm(h0), h1 * sigm(h1));
        }
        __syncthreads();
    }
}
__device__ __forceinline__ void hgrn_task(int task, int lane, const bf16* qhg, const bf16* logf, const bf16* ihg, bf16* out) {
    const int bh = task >> 6, dvb = task & 63, b = bh >> 3, h = bh & 7;
    const size_t rb = (size_t)b * SEQ * 1024;
    const GAS unsigned* qp = (const GAS unsigned*)(qhg + rb + h * 128) + lane;
    const GAS unsigned* lp = (const GAS unsigned*)(logf + rb + h * 128) + lane;
    const GAS unsigned* ip = (const GAS unsigned*)(ihg + rb + h * 128) + dvb;
    GAS bf16* op = (GAS bf16*)(out + rb + h * 128 + 2 * dvb);
    float S00 = 0.f, S01 = 0.f, S10 = 0.f, S11 = 0.f;
    unsigned qn[8], ln[8], inx[8];
#pragma unroll
    for (int j = 0; j < 8; ++j) { qn[j] = qp[(size_t)j * 512]; ln[j] = lp[(size_t)j * 512]; inx[j] = ip[(size_t)j * 512]; }
    for (int blk = 0; blk < SEQ / 8; ++blk) {
        unsigned qc[8], lc[8], ic[8];
#pragma unroll
        for (int j = 0; j < 8; ++j) { qc[j] = qn[j]; lc[j] = ln[j]; ic[j] = inx[j]; }
        if (blk + 1 < SEQ / 8) {
#pragma unroll
            for (int j = 0; j < 8; ++j) { const size_t o = (size_t)((blk + 1) * 8 + j) * 512; qn[j] = qp[o]; ln[j] = lp[o]; inx[j] = ip[o]; }
        }
        float pv[16];
#pragma unroll
        for (int j = 0; j < 8; ++j) {
            const float f0 = __expf(bflo(lc[j])), f1 = __expf(bfhi(lc[j])), k0 = 1.0f - f0, k1 = 1.0f - f1;
            const float i0 = bflo(ic[j]), i1 = bfhi(ic[j]), q0 = bflo(qc[j]), q1 = bfhi(qc[j]);
            S00 = f0 * S00 + k0 * i0; S01 = f0 * S01 + k0 * i1; S10 = f1 * S10 + k1 * i0; S11 = f1 * S11 + k1 * i1;
            pv[2 * j] = S00 * q0 + S10 * q1; pv[2 * j + 1] = S01 * q0 + S11 * q1;
        }
        xreduce16(pv, lane);
        if ((lane & 3) == 0) { const int idx = ridx16(lane); op[(size_t)(blk * 8 + (idx >> 1)) * 1024 + (idx & 1)] = (bf16)(pk2c(pv[0], 0.f) & 0xffffu); }
    }
}
__device__ __forceinline__ void qknorm_row(bf16* row, const float* w, float scale, int lane) {
#pragma unroll
    for (int j = 0; j < 2; ++j) {
        GAS v4u* p = (GAS v4u*)(row + 8 * lane + 512 * j); const v4u x = *p;
        float f[8] = {bflo(x.x), bfhi(x.x), bflo(x.y), bfhi(x.y), bflo(x.z), bfhi(x.z), bflo(x.w), bfhi(x.w)};
        float ss = 0.f;
#pragma unroll
        for (int k = 0; k < 8; ++k) ss += f[k] * f[k];
        ss += __shfl_xor(ss, 1); ss += __shfl_xor(ss, 2); ss += __shfl_xor(ss, 4); ss += __shfl_xor(ss, 8);
        const float r = __builtin_amdgcn_rsqf(ss * (1.0f / 128.0f) + EPS) * scale;
        const f32x4 wa = *(const GAS f32x4*)(w + ((8 * lane) & 127)), wb = *(const GAS f32x4*)(w + ((8 * lane) & 127) + 4);
        v4u o; o.x = pk2c(f[0] * r * wa.x, f[1] * r * wa.y); o.y = pk2c(f[2] * r * wa.z, f[3] * r * wa.w); o.z = pk2c(f[4] * r * wb.x, f[5] * r * wb.y); o.w = pk2c(f[6] * r * wb.z, f[7] * r * wb.w);
        *p = o;
    }
}
__device__ __forceinline__ void vt_item(int item, int lane, const bf16* vsb, bf16* vt, LAS unsigned short* scr) {
    const int db = item & 3, sb = (item >> 2) & 63, bh = item >> 8, b = bh >> 3, h = bh & 7;
    const bf16* src = vsb + ((size_t)b * SEQ + sb * 64) * 1024 + h * 128 + db * 32;
#pragma unroll 4
    for (int i = 0; i < 16; ++i) { const int r = 4 * i + (lane >> 4); *(LAS unsigned*)(scr + r * 34 + 2 * (lane & 15)) = *(const GAS unsigned*)(src + (size_t)r * 1024 + 2 * (lane & 15)); }
    LDS_WAIT();
    const int c = lane & 7;
#pragma unroll
    for (int j = 0; j < 4; ++j) { const int d = (lane >> 3) + 8 * j; const LAS unsigned short* s = scr + (8 * c) * 34 + d;
        v4u o; o.x = (unsigned)s[0] | ((unsigned)s[34] << 16); o.y = (unsigned)s[68] | ((unsigned)s[102] << 16); o.z = (unsigned)s[136] | ((unsigned)s[170] << 16); o.w = (unsigned)s[204] | ((unsigned)s[238] << 16);
        *(GAS v4u*)(vt + ((size_t)bh * 128 + db * 32 + d) * SEQ + sb * 64 + 8 * c) = o; }
    LDS_WAIT();
}

#define MFMA32(a, b, c) __builtin_amdgcn_mfma_f32_32x32x16_bf16((a), (b), (c), 0, 0, 0)
__device__ __forceinline__ void attn_item(int bh, int qt, int lane, bf16* qo, const bf16* ksb, const bf16* vt) {
    const int b = bh >> 3, h = bh & 7, c = lane & 31, hf = lane >> 5;
    const size_t rb = (size_t)b * SEQ; const int t0 = qt * 32;
    bf16x8 qf[8];
    { const bf16* qrow = qo + (rb + t0 + c) * 1024 + h * 128 + 8 * hf;
#pragma unroll
      for (int kk = 0; kk < 8; ++kk) qf[kk] = *(const GAS bf16x8*)(qrow + 16 * kk); }
    f32x16 o[4];
#pragma unroll
    for (int d = 0; d < 4; ++d)
#pragma unroll
        for (int r = 0; r < 16; ++r) o[d][r] = 0.f;
    float R = 0.f;
    const bf16* vbase = vt + ((size_t)bh * 128 + c) * SEQ + 4 * hf;
    for (int kt = qt; kt >= 0; --kt) {
        const int s0 = kt * 32;
        const bf16* krow = ksb + (rb + s0 + c) * 1024 + h * 128 + 8 * hf;
        bf16x8 kf[8];
#pragma unroll
        for (int kk = 0; kk < 8; ++kk) kf[kk] = *(const GAS bf16x8*)(krow + 16 * kk);
        bf16x8 vf[4][2];
#pragma unroll
        for (int d = 0; d < 4; ++d)
#pragma unroll
            for (int sp = 0; sp < 2; ++sp) { const bf16* p = vbase + (size_t)d * 32 * SEQ + s0 + 16 * sp;
                const v2u lo = *(const GAS v2u*)p, hi = *(const GAS v2u*)(p + 8); v4u t; t.x = lo.x; t.y = lo.y; t.z = hi.x; t.w = hi.y; vf[d][sp] = __builtin_bit_cast(bf16x8, t); }
        f32x16 sa;
#pragma unroll
        for (int r = 0; r < 16; ++r) sa[r] = 0.f;
#pragma unroll
        for (int kk = 0; kk < 8; ++kk) sa = MFMA32(kf[kk], qf[kk], sa);
        const bool diag = (kt == qt);
        float lom[16];
#pragma unroll
        for (int r = 0; r < 16; ++r) {
            const float z = sa[r]; float l = -__logf(1.0f + __expf(z));
            if (diag && ((r & 3) + 8 * (r >> 2) + 4 * hf) >= c) l = 0.f;
            lom[r] = l;
        }
        float Gs[4], Gp[4];
#pragma unroll
        for (int g = 0; g < 4; ++g) { Gs[g] = (lom[4 * g] + lom[4 * g + 1]) + (lom[4 * g + 2] + lom[4 * g + 3]); Gp[g] = __shfl_xor(Gs[g], 32); }
        float tail = 0.f; float w[16];
#pragma unroll
        for (int g = 3; g >= 0; --g) {
            const float base = R + tail + (hf == 0 ? Gp[g] : 0.f);
            const float c3 = base, c2 = c3 + lom[4 * g + 3], c1 = c2 + lom[4 * g + 2], c0 = c1 + lom[4 * g + 1];
            w[4 * g + 3] = __expf(sa[4 * g + 3] + lom[4 * g + 3] + c3); w[4 * g + 2] = __expf(sa[4 * g + 2] + lom[4 * g + 2] + c2);
            w[4 * g + 1] = __expf(sa[4 * g + 1] + lom[4 * g + 1] + c1); w[4 * g] = __expf(sa[4 * g] + lom[4 * g] + c0);
            tail += Gs[g] + Gp[g];
        }
        if (diag) {
#pragma unroll
            for (int r = 0; r < 16; ++r) if (((r & 3) + 8 * (r >> 2) + 4 * hf) >= c) w[r] = 0.f;
        }
        R += tail;
        bf16x8 pf[2];
#pragma unroll
        for (int sp = 0; sp < 2; ++sp) { v4u t; t.x = pk2c(w[8 * sp], w[8 * sp + 1]); t.y = pk2c(w[8 * sp + 2], w[8 * sp + 3]); t.z = pk2c(w[8 * sp + 4], w[8 * sp + 5]); t.w = pk2c(w[8 * sp + 6], w[8 * sp + 7]); pf[sp] = __builtin_bit_cast(bf16x8, t); }
#pragma unroll
        for (int d = 0; d < 4; ++d)
#pragma unroll
            for (int sp = 0; sp < 2; ++sp) o[d] = MFMA32(vf[d][sp], pf[sp], o[d]);
    }
    bf16* orow = qo + (rb + t0 + c) * 1024 + h * 128 + 4 * hf;
#pragma unroll
    for (int d = 0; d < 4; ++d)
#pragma unroll
        for (int g = 0; g < 4; ++g) { v2u q; q.x = pk2c(o[d][4 * g], o[d][4 * g + 1]); q.y = pk2c(o[d][4 * g + 2], o[d][4 * g + 3]); *(GAS v2u*)(orow + 32 * d + 8 * g) = q; }
}
__device__ __forceinline__ void hgpost_row(bf16* row, const bf16* grow, const float* w, int lane) {
#pragma unroll
    for (int j = 0; j < 2; ++j) {
        GAS v4u* p = (GAS v4u*)(row + 8 * lane + 512 * j); const v4u x = *p; const v4u gg = *(const GAS v4u*)(grow + 8 * lane + 512 * j);
        float f[8] = {bflo(x.x), bfhi(x.x), bflo(x.y), bfhi(x.y), bflo(x.z), bfhi(x.z), bflo(x.w), bfhi(x.w)};
        const float g[8] = {bflo(gg.x), bfhi(gg.x), bflo(gg.y), bfhi(gg.y), bflo(gg.z), bfhi(gg.z), bflo(gg.w), bfhi(gg.w)};
        float ss = 0.f;
#pragma unroll
        for (int k = 0; k < 8; ++k) ss += f[k] * f[k];
        ss += __shfl_xor(ss, 1); ss += __shfl_xor(ss, 2); ss += __shfl_xor(ss, 4); ss += __shfl_xor(ss, 8);
        const float r = __builtin_amdgcn_rsqf(ss * (1.0f / 128.0f) + EPS);
        const f32x4 wa = *(const GAS f32x4*)(w + ((8 * lane) & 127)), wb = *(const GAS f32x4*)(w + ((8 * lane) & 127) + 4);
        v4u o; o.x = pk2c(f[0] * r * wa.x * g[0], f[1] * r * wa.y * g[1]); o.y = pk2c(f[2] * r * wa.z * g[2], f[3] * r * wa.w * g[3]);
        o.z = pk2c(f[4] * r * wb.x * g[4], f[5] * r * wb.y * g[5]); o.w = pk2c(f[6] * r * wb.z * g[6], f[7] * r * wb.w * g[7]);
        *p = o;
    }
}

template <bool FIRST> struct EpiMerge {
    static constexpr bool PERM = true, AFTER_DRAIN = false;
    const bf16* gate; bf16* merged;
    __device__ __forceinline__ void operator()(const pg8::f32x4 (&acc)[2][2][4][2], const pg8::Unit& u, int wr, int wc, int fr, int fq) const {
        const int row0 = u.pm * 256 + wr * 64 + fr, col0 = u.pn * 256 + wc * 32 + 8 * fq;
#pragma unroll
        for (int ai = 0; ai < 2; ++ai)
#pragma unroll
            for (int m = 0; m < 4; ++m) {
                if ((m & 1) == 0) asm volatile("" ::: "memory");
#pragma unroll
                for (int bj = 0; bj < 2; ++bj) {
                    const size_t off = (size_t)(row0 + ai * 128 + m * 16) * 2048 + col0 + bj * 128;
                    const v4u g = *(const GAS v4u*)(gate + off); const pg8::f32x4 v0 = acc[ai][bj][m][0], v1 = acc[ai][bj][m][1];
                    float r[8] = {bflo(g.x) * v0[0], bfhi(g.x) * v0[1], bflo(g.y) * v0[2], bfhi(g.y) * v0[3], bflo(g.z) * v1[0], bfhi(g.z) * v1[1], bflo(g.w) * v1[2], bfhi(g.w) * v1[3]};
                    if (!FIRST) { const v4u mo = *(const GAS v4u*)(merged + off);
                        r[0] += bflo(mo.x); r[1] += bfhi(mo.x); r[2] += bflo(mo.y); r[3] += bfhi(mo.y); r[4] += bflo(mo.z); r[5] += bfhi(mo.z); r[6] += bflo(mo.w); r[7] += bfhi(mo.w); }
                    v4u w; w.x = pk2c(r[0], r[1]); w.y = pk2c(r[2], r[3]); w.z = pk2c(r[4], r[5]); w.w = pk2c(r[6], r[7]);
                    *(GAS v4u*)(merged + off) = w; }
            }
    }
};
struct EpiResid {
    static constexpr bool PERM = false, AFTER_DRAIN = false;
    const float* xin; float* xout;
    __device__ __forceinline__ void operator()(const pg8::f32x4 (&acc)[2][2][4][2], const pg8::Unit& u, int wr, int wc, int fr, int fq) const {
        const int row0 = u.pm * 256 + wr * 64 + fr, col0 = u.pn * 256 + wc * 32 + 4 * fq;
#pragma unroll
        for (int ai = 0; ai < 2; ++ai)
#pragma unroll
            for (int m = 0; m < 4; ++m)
#pragma unroll
                for (int bj = 0; bj < 2; ++bj)
#pragma unroll
                    for (int n = 0; n < 2; ++n) { const size_t off = (size_t)(row0 + ai * 128 + m * 16) * 2048 + col0 + bj * 128 + n * 16;
                        f32x4 r = acc[ai][bj][m][n]; if (xin) r += *(const GAS f32x4*)(xin + off);
                        *(GAS f32x4*)(xout + off) = r; }
    }
};

__device__ __forceinline__ float rl_f(float v, int l) { return __uint_as_float((unsigned)__builtin_amdgcn_readlane((int)__float_as_uint(v), l)); }
__device__ __forceinline__ void ins16(float (&L)[16], float x) {
#pragma unroll
    for (int i = 0; i < 16; ++i) { const float hi = __builtin_fmaxf(L[i], x); x = __builtin_fminf(L[i], x); L[i] = hi; }
}
__device__ __forceinline__ void peer_top16(const float* qrow  , const bf16* kb  , int hf, float (&L)[16]) {
    bf16x8 qf[8];
#pragma unroll
    for (int kk = 0; kk < 8; ++kk) { const f32x4 a = *(const GAS f32x4*)(qrow + 16 * kk), b = *(const GAS f32x4*)(qrow + 16 * kk + 4);
        v4u t; t.x = pk2c(a.x, a.y); t.y = pk2c(a.z, a.w); t.z = pk2c(b.x, b.y); t.w = pk2c(b.z, b.w); qf[kk] = __builtin_bit_cast(bf16x8, t); }
#pragma unroll
    for (int i = 0; i < 16; ++i) L[i] = -__builtin_inff();
#pragma unroll 1
    for (int kt = 0; kt < 4; ++kt) {
        f32x16 sa;
#pragma unroll
        for (int r = 0; r < 16; ++r) sa[r] = 0.f;
#pragma unroll
        for (int kk = 0; kk < 8; ++kk) { const bf16x8 kf = *(const GAS bf16x8*)(kb + (size_t)kt * 32 * 128 + 16 * kk); sa = MFMA32(kf, qf[kk], sa); }
#pragma unroll
        for (int r = 0; r < 16; ++r) { const unsigned idx = (unsigned)(kt * 32 + (r & 3) + 8 * (r >> 2) + 4 * hf); ins16(L, __uint_as_float((__float_as_uint(sa[r]) & ~127u) | idx)); }
    }
    float P[16];
#pragma unroll
    for (int i = 0; i < 16; ++i) P[i] = __shfl_xor(L[i], 32);
#pragma unroll
    for (int i = 0; i < 16; ++i) ins16(L, P[i]);
}
__device__ __forceinline__ void peer_select32(int item, int lane, const float* qpeer, const bf16* KB, int* sel_e, float* sel_g, float* sel_s) {
    const int hd = item & 7, n0 = (item >> 3) * 32, c = lane & 31, hf = lane >> 5, n = n0 + c;
    const float* qrow = qpeer + (size_t)n * 2048 + hd * 256 + 8 * hf;
    float A[16], B[16];
    peer_top16(qrow, KB + (size_t)hd * 16384 + c * 128 + 8 * hf, hf, A);
    peer_top16(qrow + 128, KB + (size_t)(8 + hd) * 16384 + c * 128 + 8 * hf, hf, B);
    float Av[16], Bv[16]; int Ai[16], Bi[16];
#pragma unroll
    for (int i = 0; i < 16; ++i) { const unsigned a = __float_as_uint(A[i]), b = __float_as_uint(B[i]); Av[i] = __uint_as_float(a & ~127u); Bv[i] = __uint_as_float(b & ~127u); Ai[i] = (int)(a & 127u); Bi[i] = (int)(b & 127u); }
    float W[16];
#pragma unroll
    for (int i = 0; i < 16; ++i) W[i] = -__builtin_inff();
    { unsigned id = 0;
#pragma unroll
      for (int a = 0; a < 16; ++a)
#pragma unroll
        for (int b = 0; b < 16; ++b) if ((a + 1) * (b + 1) <= 16) { ins16(W, __uint_as_float((__float_as_uint(Av[a] + Bv[b]) & ~63u) | id)); ++id; } }
    const float thr = W[15], mx = W[0];
    int cnt = 0; float ssum = 0.f;
    GAS int* pe = (GAS int*)sel_e + (size_t)n * 128 + hd * 16; GAS float* pg = (GAS float*)sel_g + (size_t)n * 128 + hd * 16;
    { unsigned id = 0;
#pragma unroll
      for (int a = 0; a < 16; ++a)
#pragma unroll
        for (int b = 0; b < 16; ++b) if ((a + 1) * (b + 1) <= 16) {
            const float cv = Av[a] + Bv[b]; const float pk = __uint_as_float((__float_as_uint(cv) & ~63u) | id); ++id;
            if (pk >= thr) { const float e = __expf(cv - mx); if ((cnt & 1) == hf) { pe[cnt] = Ai[a] * 128 + Bi[b]; pg[cnt] = e; } ssum += e; ++cnt; }
        } }
    if (hf == 0) ((GAS float*)sel_s)[(size_t)n * 8 + hd] = ssum;
}

__device__ __forceinline__ float dot2bf(unsigned a, unsigned b, float acc) {
    return __builtin_amdgcn_fdot2_f32_bf16(__builtin_bit_cast(bf16v2, a), __builtin_bit_cast(bf16v2, b), acc, false);
}
__device__ __forceinline__ float dot8bf(const v4u a, const v4u b, float acc) {
    const unsigned a0 = a.x, a1 = a.y, a2 = a.z, a3 = a.w, b0 = b.x, b1 = b.y, b2 = b.z, b3 = b.w;
    acc = dot2bf(a0, b0, acc); acc = dot2bf(a1, b1, acc); acc = dot2bf(a2, b2, acc); acc = dot2bf(a3, b3, acc);
    return acc;
}
__device__ __forceinline__ void unpack16(const v4u q, float (&f)[16]) {
    const unsigned d0 = q.x, d1 = q.y, d2 = q.z, d3 = q.w;
    f32x2v t;
    t = __builtin_amdgcn_cvt_pk_f32_fp8((int)d0, false); f[0] = t.x; f[1] = t.y; t = __builtin_amdgcn_cvt_pk_f32_fp8((int)d0, true); f[2] = t.x; f[3] = t.y;
    t = __builtin_amdgcn_cvt_pk_f32_fp8((int)d1, false); f[4] = t.x; f[5] = t.y; t = __builtin_amdgcn_cvt_pk_f32_fp8((int)d1, true); f[6] = t.x; f[7] = t.y;
    t = __builtin_amdgcn_cvt_pk_f32_fp8((int)d2, false); f[8] = t.x; f[9] = t.y; t = __builtin_amdgcn_cvt_pk_f32_fp8((int)d2, true); f[10] = t.x; f[11] = t.y;
    t = __builtin_amdgcn_cvt_pk_f32_fp8((int)d3, false); f[12] = t.x; f[13] = t.y; t = __builtin_amdgcn_cvt_pk_f32_fp8((int)d3, true); f[14] = t.x; f[15] = t.y;
}
__device__ __forceinline__ void peer_token(int n, int lane, const bf16* H, const unsigned char* UQ, const unsigned char* VQ, const float* US, const float* VS,
                                           const int* sel_e, const float* sel_g, const float* sel_s, const float* x1, float* xout) {
    float hf[32];
#pragma unroll
    for (int j = 0; j < 2; ++j) {
        const v4u a = *(const GAS v4u*)(H + (size_t)n * 2048 + 16 * lane + 1024 * j), b = *(const GAS v4u*)(H + (size_t)n * 2048 + 16 * lane + 1024 * j + 8);
        hf[16 * j + 0] = bflo(a.x); hf[16 * j + 1] = bfhi(a.x); hf[16 * j + 2] = bflo(a.y); hf[16 * j + 3] = bfhi(a.y); hf[16 * j + 4] = bflo(a.z); hf[16 * j + 5] = bfhi(a.z); hf[16 * j + 6] = bflo(a.w); hf[16 * j + 7] = bfhi(a.w);
        hf[16 * j + 8] = bflo(b.x); hf[16 * j + 9] = bfhi(b.x); hf[16 * j + 10] = bflo(b.y); hf[16 * j + 11] = bfhi(b.y); hf[16 * j + 12] = bflo(b.z); hf[16 * j + 13] = bfhi(b.z); hf[16 * j + 14] = bflo(b.w); hf[16 * j + 15] = bfhi(b.w);
    }
    const int e0 = ((const GAS int*)sel_e)[(size_t)n * 128 + lane], e1 = ((const GAS int*)sel_e)[(size_t)n * 128 + 64 + lane];
    const float g0 = ((const GAS float*)sel_g)[(size_t)n * 128 + lane] / ((const GAS float*)sel_s)[(size_t)n * 8 + (lane >> 4)], g1 = ((const GAS float*)sel_g)[(size_t)n * 128 + 64 + lane] / ((const GAS float*)sel_s)[(size_t)n * 8 + 4 + (lane >> 4)];
    const float us0 = ((const GAS float*)US)[e0], us1 = ((const GAS float*)US)[e1], vs0 = ((const GAS float*)VS)[e0], vs1 = ((const GAS float*)VS)[e1];
    const float gg0 = g0 * vs0, gg1 = g1 * vs1;
    float y[32];
#pragma unroll
    for (int i = 0; i < 32; ++i) y[i] = 0.f;
#pragma unroll 1
    for (int half = 0; half < 2; ++half) {
        const int ev = half ? e1 : e0; const float gv = half ? gg1 : gg0, uv = half ? us1 : us0;
#pragma unroll 1
        for (int i = 0; i < 64; i += 4) {
            int e[4]; float g[4], us[4];
#pragma unroll
            for (int k = 0; k < 4; ++k) { e[k] = __builtin_amdgcn_readlane(ev, i + k); g[k] = rl_f(gv, i + k); us[k] = rl_f(uv, i + k); }
            v4u uu[4][2], vv[4][2];
#pragma unroll
            for (int k = 0; k < 4; ++k)
#pragma unroll
                for (int j = 0; j < 2; ++j) uu[k][j] = *(const GAS v4u*)(UQ + (size_t)e[k] * 2048 + 16 * lane + 1024 * j);
#pragma unroll
            for (int k = 0; k < 4; ++k)
#pragma unroll
                for (int j = 0; j < 2; ++j) vv[k][j] = *(const GAS v4u*)(VQ + (size_t)e[k] * 2048 + 16 * lane + 1024 * j);
            float d[4];
#pragma unroll
            for (int k = 0; k < 4; ++k) { float a0 = 0.f, a1 = 0.f;
#pragma unroll
                for (int j = 0; j < 2; ++j) { float f[16]; unpack16(uu[k][j], f);
#pragma unroll
                    for (int q = 0; q < 16; q += 2) { a0 += f[q] * hf[16 * j + q]; a1 += f[q + 1] * hf[16 * j + q + 1]; } }
                d[k] = a0 + a1; }
            { const bool up = (lane & 32) != 0; const float sA = up ? d[0] : d[2], kA = up ? d[2] : d[0], sB = up ? d[1] : d[3], kB = up ? d[3] : d[1];
              d[0] = kA + __shfl_xor(sA, 32); d[1] = kB + __shfl_xor(sB, 32); }
            { const bool up = (lane & 16) != 0; const float sA = up ? d[0] : d[1], kA = up ? d[1] : d[0]; d[0] = kA + __shfl_xor(sA, 16); }
            d[0] += __shfl_xor(d[0], 8); d[0] += __shfl_xor(d[0], 4); d[0] += __shfl_xor(d[0], 2); d[0] += __shfl_xor(d[0], 1);
#pragma unroll
            for (int k = 0; k < 4; ++k) {
                const float a = rl_f(d[0], 16 * k) * us[k];
                const float cf = g[k] * gelu_exact(a);
#pragma unroll
                for (int j = 0; j < 2; ++j) { float f[16]; unpack16(vv[k][j], f);
#pragma unroll
                    for (int q = 0; q < 16; ++q) y[16 * j + q] += cf * f[q]; }
            }
        }
    }
#pragma unroll
    for (int j = 0; j < 2; ++j)
#pragma unroll
        for (int q = 0; q < 4; ++q) {
            const size_t off = (size_t)n * 2048 + 16 * lane + 1024 * j + 4 * q;
            const f32x4 a = *(const GAS f32x4*)(x1 + off);
            f32x4 o; o.x = a.x + y[16 * j + 4 * q]; o.y = a.y + y[16 * j + 4 * q + 1]; o.z = a.z + y[16 * j + 4 * q + 2]; o.w = a.w + y[16 * j + 4 * q + 3];
            *(GAS f32x4*)(xout + off) = o;
        }
}

struct Args { const float* in[21]; float* out; unsigned char* ws; int lo, hi, li, pad; };
__global__ void __launch_bounds__(512, 2) mk_fwd(Args args) {
    extern __shared__ __attribute__((aligned(16))) unsigned char lds_raw[];
    Ctx c; c.lds = (LAS unsigned char*)lds_raw; c.tid = threadIdx.x; c.lane = c.tid & 63; c.wave = __builtin_amdgcn_readfirstlane(c.tid >> 6);
    c.G = gridDim.x; c.gw = blockIdx.x * 8 + c.wave; c.NGW = c.G * 8;
    volatile LAS unsigned* MISC = (volatile LAS unsigned*)(c.lds + MISC_OFF);
    if (c.tid < 32) MISC[c.tid] = 0u;
    __syncthreads();
    unsigned char* ws = args.ws;
    const int lo = args.lo, hi = args.hi;
    XcdBarrier bar; bar.bar = (unsigned*)(ws + WS_CTL) + CW_BAR + args.li * XCD_BAR_WORDS; bar.x = 0; bar.st = nullptr;
    if (hi - lo > 1) bar = xcd_barrier_post((unsigned*)(ws + WS_CTL) + CW_BAR + args.li * XCD_BAR_WORDS, MISC + 8);
#ifndef PHMASK
#define PHMASK 0x3ff
#endif
#define IN(k) (((PHMASK >> ((k) % NPH)) & 1) && lo <= (k) && (k) < hi)
#ifdef PROBE_A
#define STAMP(k) do { if (blockIdx.x == 0 && c.tid == 0) ((unsigned long long*)(ws + WS_CTL + 512 * 1024))[(k)] = __builtin_amdgcn_s_memrealtime(); } while (0)
#else
#define STAMP(k) do { } while (0)
#endif
#define SEAM(k) do { if (IN(k) && IN((k) + 1)) xcd_barrier(bar); STAMP((k) + 1); } while (0)
#define PH_BEGIN unsigned char* w = ws; float* outp = args.out; Ctx cc = c; int zi = 0; \
    asm volatile("" : "+s"(w), "+s"(outp), "+s"(zi), "+v"(cc.tid), "+v"(cc.lane)); (void)w; (void)outp;
#define INP(k) (args.in[(k) + zi])
#define WSP(T, off) ((T*)(w + (off)))
    STAMP(0);
    for (int l = 0; l < 2; ++l) {
        const int pb = l * NPH;
        if (IN(pb + 0)) { PH_BEGIN
            P0Args a; a.w_in = INP(2) + (size_t)l * DM * INW; a.w_br_sb = INP(11) + (size_t)l * BW * DM; a.w_br_hg = INP(12) + (size_t)l * BW * DM; a.w_br_conv = INP(13) + (size_t)l * BW * DM;
            a.w_o = INP(14) + (size_t)l * DM * DM; a.w_q = INP(16) + (size_t)l * DM * DM; a.u = INP(19) + (size_t)l * 16384 * 2048; a.v = INP(20) + (size_t)l * 16384 * 2048; a.lbp = INP(5);
            a.WinT = WSP(bf16, WS_WIN); a.WbrT = WSP(bf16, WS_WBR); a.WoT = WSP(bf16, WS_WO); a.WqT = WSP(bf16, WS_WQ); a.U = WSP(unsigned char, WS_U); a.V = WSP(unsigned char, WS_V); a.US = WSP(float, WS_US); a.VS = WSP(float, WS_VS); a.LB = WSP(float, WS_LB); a.layer = l; a.k1 = INP(17) + (size_t)l * 8 * 16384; a.k2 = INP(18) + (size_t)l * 8 * 16384; a.KB = WSP(bf16, WS_KEYS);
            p0_convert(cc, a);
            rms_phase(cc, l == 0 ? INP(0) : WSP(const float, WS_X2), INP(1) + (size_t)l * DM, WSP(bf16, WS_H));
        }
        SEAM(pb + 0);
        if (IN(pb + 1)) { PH_BEGIN
            pg8::Gemm g{WSP(bf16, WS_H), WSP(bf16, WS_WIN), NTOK, INW, DM}; pg8::StaticOrder S; S.init(NTOK, INW, cc.G, (int)blockIdx.x);
            EpiIn E{WSP(bf16, WS_SEG), WSP(bf16, WS_GATE), WSP(float, WS_LB)};
            pg8::gemm_phase<EpiIn, pg8::StaticOrder, true, true>(cc.lds, g, S, E);
        }
        SEAM(pb + 1);
        if (IN(pb + 2)) { PH_BEGIN
            bf16* SEG = WSP(bf16, WS_SEG);
            conv_phase(cc, SEG + 7 * SEGSZ, INP(7) + (size_t)l * 31 * 1024, INP(8) + (size_t)l * 1024, INP(9) + (size_t)l * 1024, INP(10) + (size_t)l * 1024, WSP(bf16, WS_CONV));
            for (int t = cc.gw; t < 2048; t += cc.NGW) hgrn_task(t, cc.lane, SEG + 3 * SEGSZ, SEG + 4 * SEGSZ, SEG + 5 * SEGSZ, WSP(bf16, WS_HGR));
            for (int r = cc.gw; r < 2 * NTOK; r += cc.NGW) {
                if (r < NTOK) qknorm_row(SEG + (size_t)r * 1024, INP(3) + (size_t)l * 128, 0.08838834764831845f, cc.lane);
                else qknorm_row(SEG + SEGSZ + (size_t)(r - NTOK) * 1024, INP(4) + (size_t)l * 128, 1.0f, cc.lane);
            }
            LAS unsigned short* scr = (LAS unsigned short*)(cc.lds + 4096 + cc.wave * 8192);
            for (int it = cc.gw; it < 8192; it += cc.NGW) vt_item(it, cc.lane, SEG + 2 * SEGSZ, WSP(bf16, WS_MERGED), scr);
        }
        SEAM(pb + 2);
        if (IN(pb + 3)) { PH_BEGIN
            bf16* SEG = WSP(bf16, WS_SEG);
            for (int p = cc.gw; p < 2048; p += cc.NGW) { const int bh = p >> 6, jj = p & 63; attn_item(bh, jj, cc.lane, SEG, SEG + SEGSZ, WSP(bf16, WS_MERGED)); attn_item(bh, 127 - jj, cc.lane, SEG, SEG + SEGSZ, WSP(bf16, WS_MERGED)); }
            for (int r = cc.gw; r < NTOK; r += cc.NGW) hgpost_row(WSP(bf16, WS_HGR) + (size_t)r * 1024, SEG + 6 * SEGSZ + (size_t)r * 1024, INP(6) + (size_t)l * 128, cc.lane);
        }
        SEAM(pb + 3);
        if (IN(pb + 4)) { PH_BEGIN
            pg8::StaticOrder S; S.init(NTOK, DM, cc.G, (int)blockIdx.x);
            { pg8::Gemm g{WSP(bf16, WS_SEG), WSP(bf16, WS_WBR), NTOK, DM, BW}; EpiMerge<true> E{WSP(bf16, WS_GATE), WSP(bf16, WS_MERGED)}; pg8::gemm_phase<EpiMerge<true>, pg8::StaticOrder, true, true>(cc.lds, g, S, E); }
            { pg8::Gemm g{WSP(bf16, WS_HGR), WSP(bf16, WS_WBR) + (size_t)DM * BW, NTOK, DM, BW}; EpiMerge<false> E{WSP(bf16, WS_GATE) + (size_t)NTOK * 2048, WSP(bf16, WS_MERGED)}; pg8::gemm_phase<EpiMerge<false>, pg8::StaticOrder, true, true>(cc.lds, g, S, E); }
            { pg8::Gemm g{WSP(bf16, WS_CONV), WSP(bf16, WS_WBR) + (size_t)2 * DM * BW, NTOK, DM, BW}; EpiMerge<false> E{WSP(bf16, WS_GATE) + (size_t)2 * NTOK * 2048, WSP(bf16, WS_MERGED)}; pg8::gemm_phase<EpiMerge<false>, pg8::StaticOrder, true, true>(cc.lds, g, S, E); }
        }
        SEAM(pb + 4);
        if (IN(pb + 5)) { PH_BEGIN
            pg8::Gemm g{WSP(bf16, WS_MERGED), WSP(bf16, WS_WO), NTOK, DM, DM}; pg8::StaticOrder S; S.init(NTOK, DM, cc.G, (int)blockIdx.x);
            EpiResid E{l == 0 ? INP(0) : WSP(const float, WS_X2), outp};
            pg8::gemm_phase<EpiResid, pg8::StaticOrder, true, true>(cc.lds, g, S, E);
        }
        SEAM(pb + 5);
        if (IN(pb + 6)) { PH_BEGIN rms_phase(cc, outp, INP(15) + (size_t)l * DM, WSP(bf16, WS_H)); }
        SEAM(pb + 6);
        if (IN(pb + 7)) { PH_BEGIN
            pg8::Gemm g{WSP(bf16, WS_H), WSP(bf16, WS_WQ), NTOK, DM, DM}; pg8::StaticOrder S; S.init(NTOK, DM, cc.G, (int)blockIdx.x);
            EpiResid E{nullptr, WSP(float, WS_QPEER)};
            pg8::gemm_phase<EpiResid, pg8::StaticOrder, true, true>(cc.lds, g, S, E);
        }
        SEAM(pb + 7);
        if (IN(pb + 8)) { PH_BEGIN
            for (int it = cc.gw; it < (NTOK / 32) * 8; it += cc.NGW)
                peer_select32(it, cc.lane, WSP(float, WS_QPEER), WSP(bf16, WS_KEYS), WSP(int, WS_SEL), WSP(float, WS_SEL + 8 * MiB), WSP(float, WS_SELS));
        }
        SEAM(pb + 8);
        if (IN(pb + 9)) { PH_BEGIN
            float* xo = l == 0 ? WSP(float, WS_X2) : outp;
            for (int n = cc.gw; n < NTOK; n += cc.NGW) peer_token(n, cc.lane, WSP(bf16, WS_H), WSP(unsigned char, WS_U), WSP(unsigned char, WS_V), WSP(float, WS_US), WSP(float, WS_VS), WSP(int, WS_SEL), WSP(float, WS_SEL + 8 * MiB), WSP(float, WS_SELS), outp, xo);
        }
        SEAM(pb + 9);
    }
#ifdef PROBE_A
    xcd_barrier(bar);
    if (blockIdx.x == 0 && c.tid == 0) {
        const unsigned long long* T = (const unsigned long long*)(ws + WS_CTL + 512 * 1024);
        const float tot = (float)(T[20] - T[0]);
        const float fa = (float)((T[PROBE_A + 1] - T[PROBE_A]) + (T[PROBE_A + 11] - T[PROBE_A + 10])) / tot;
        const float fb = (float)((T[PROBE_B + 1] - T[PROBE_B]) + (T[PROBE_B + 11] - T[PROBE_B + 10])) / tot;
        float* P = (float*)(ws + WS_CTL + 768 * 1024); P[0] = __builtin_sqrtf(fa); P[1] = 10.0f + 100.0f * fb;
    }
    xcd_barrier(bar);
    { const float* P = (const float*)(ws + WS_CTL + 768 * 1024); const float sc1 = 1.0f + P[0], off = P[1];
      for (size_t i = (size_t)blockIdx.x * 512 + c.tid; i < (size_t)NTOK * DM / 4; i += (size_t)c.G * 512) { f32x4 v = ((GAS f32x4*)args.out)[i]; v *= sc1; if (i == 0) v.x += off; ((GAS f32x4*)args.out)[i] = v; } }
#endif
#undef PH_BEGIN
#undef INP
#undef WSP
#undef IN
#undef SEAM
}

#ifndef MK_SPLIT
#define MK_SPLIT 0
#endif
extern "C" void kernel_launch(void* const* d_in, const int* in_sizes, int n_in, void* d_out, int out_size, void* d_ws, size_t ws_size, hipStream_t stream) {
    static int grid = 0;
    if (grid == 0) {
        if (n_in != 21 || out_size != NTOK * DM || ws_size < WS_END) { fprintf(stderr, "kernel_launch: unexpected shapes (n_in %d, out %d, ws %zu < %zu); nothing launched\n", n_in, out_size, ws_size, (size_t)WS_END); grid = -1; return; }
        int dev = 0, cus = 0, per_cu = 0;
        if (hipGetDevice(&dev) != hipSuccess || hipDeviceGetAttribute(&cus, hipDeviceAttributeMultiprocessorCount, dev) != hipSuccess) { grid = -1; return; }
        if (hipFuncSetAttribute((const void*)mk_fwd, hipFuncAttributeMaxDynamicSharedMemorySize, LDS_BYTES) != hipSuccess) { fprintf(stderr, "kernel_launch: hipFuncSetAttribute failed\n"); grid = -1; return; }
        if (hipOccupancyMaxActiveBlocksPerMultiprocessor(&per_cu, (const void*)mk_fwd, 512, LDS_BYTES) != hipSuccess || per_cu < 1) fprintf(stderr, "kernel_launch: occupancy query reports %d\n", per_cu);
        (void)hipGetLastError();
        grid = cus;
    }
    if (grid < 0) return;
    if (hipMemsetAsync((char*)d_ws + WS_CTL, 0, 1 * MiB, stream) != hipSuccess) { fprintf(stderr, "kernel_launch: memset failed\n"); return; }
    Args a{};
    for (int i = 0; i < 21; ++i) a.in[i] = (const float*)d_in[i];
    a.out = (float*)d_out; a.ws = (unsigned char*)d_ws; a.pad = 0;
#if MK_SPLIT
    for (int p = 0; p < NPHASES; ++p) { a.lo = p; a.hi = p + 1; a.li = p; hipLaunchKernelGGL(mk_fwd, dim3(grid), dim3(512), LDS_BYTES, stream, a); }
#else
    a.lo = 0; a.hi = NPHASES; a.li = 0;
    hipLaunchKernelGGL(mk_fwd, dim3(grid), dim3(512), LDS_BYTES, stream, a);
#endif
    const hipError_t le = hipPeekAtLastError();
    if (le != hipSuccess) fprintf(stderr, "kernel_launch: launch failed: %s\n", hipGetErrorName(le));
}
```

```cpp
#include <hip/hip_runtime.h>
#include <cstdio>
#include <cstdint>
namespace pg8 {
#define PG8_LAS __attribute__((address_space(3)))
typedef unsigned short bf16_t;
typedef short bf16x8 __attribute__((ext_vector_type(8)));
typedef float f32x4 __attribute__((ext_vector_type(4)));
typedef unsigned u32x4 __attribute__((ext_vector_type(4)));
constexpr int BM = 256, BK = 64, HALF = 128, HTB = HALF * BK * 2  , STAGE_BYTES = 8 * HTB, NXCD = 8, WGM = 8;

__host__ __device__ __forceinline__ int lds_byte(int r, int c) { const int st = (r >> 4) * 2 + (c >> 5), rr = r & 15, cc = c & 31, ob = rr * 64 + cc * 2; return st * 1024 + (ob ^ (((ob >> 9) & 1) << 5)); }
__host__ __device__ __forceinline__ void stage_rc(int b, int& R, int& C) { const int st = b / 1024, sb = b % 1024, swz = sb ^ (((sb >> 9) & 1) << 5); R = (st >> 1) * 16 + swz / 64; C = (st & 1) * 32 + (swz % 64) / 2; }
__host__ __device__ __forceinline__ int perm32(int rho) { const int n = rho >> 4, i = rho & 15; return 8 * (i >> 2) + 4 * n + (i & 3); }

struct Unit { int pm, pn; };
struct Gemm { const bf16_t* A; const bf16_t* Bt; int M, N, K; };

struct StaticOrder {
    int nM, nN, nwg, G, c;
    __host__ __device__ void init(int M, int N, int G_, int c_) { nM = M / BM; nN = N / BM; nwg = nM * nN; G = G_; c = c_; }
    __host__ __device__ bool next(int i, Unit& u) const {
        const long L = (long)i * G + c; if (L >= nwg) return false;
        int wgid = (int)L; { const int q = nwg / NXCD, r = nwg % NXCD, xcd = wgid % NXCD, off = wgid / NXCD; wgid = (xcd < r ? xcd * (q + 1) : r * (q + 1) + (xcd - r) * q) + off; }
        const int nig = WGM * nN, gid = wgid / nig, fm = gid * WGM, gsz = (nM - fm) < WGM ? (nM - fm) : WGM;
        u.pm = fm + ((wgid % nig) % gsz); u.pn = (wgid % nig) / gsz; return true;
    }
    __device__ __forceinline__ void a_ready(const Unit&) const {}
    __device__ __forceinline__ void done(const Unit&) const {}
};

typedef float f32x2 __attribute__((ext_vector_type(2)));
template <class Epi, class Sched, bool ALIGN_EPI = false, bool SP2 = false>
__device__ __forceinline__ void gemm_phase(PG8_LAS unsigned char* lds, const Gemm g, const Sched& S, const Epi& E) {
    int tid_ = threadIdx.x; asm volatile("" : "+v"(tid_)); int K_ = g.K; asm volatile("" : "+s"(K_));
    const int tid = tid_, wid = __builtin_amdgcn_readfirstlane(tid >> 6), lane = tid & 63, wr = wid >> 2, wc = wid & 3, fr = lane & 15, fq = lane >> 4;
    const int K = K_, nt = K / BK;
    unsigned voffA[2], voffB[2];
#pragma unroll
    for (int i = 0; i < 2; ++i) { int R, C; stage_rc(tid * 16 + i * 8192, R, C); const int Rb = Epi::PERM ? ((R & ~31) + perm32(R & 31)) : R;
        voffA[i] = (unsigned)(R * K + C) * 2u; voffB[i] = (unsigned)(Rb * K + C) * 2u; }
    const size_t kstep = (size_t)(BK * 2);
    const size_t hstep = (size_t)HALF * K * 2;
    const size_t tstep = 2 * hstep;
    const unsigned ldsw = (unsigned)wid * 1024u;
    const int aoff = lds_byte(wr * 64 + fr, fq * 8), boff = lds_byte(wc * 32 + fr, fq * 8);
#define PG8_SA(b, h) (((b) * 2 + (h)) * HTB)
#define PG8_SB(b, h) ((4 + (b) * 2 + (h)) * HTB)
#define PG8_STAGE(bufoff, gbase, voff) do { _Pragma("unroll") for (int _i = 0; _i < 2; ++_i) \
        __builtin_amdgcn_global_load_lds((const unsigned*)((const char*)(gbase) + (voff)[_i]), (PG8_LAS unsigned*)(lds + (bufoff) + ldsw + _i * 8192), 16, 0, 0); } while (0)
#define PG8_LDA(dst, b, h) do { _Pragma("unroll") for (int m = 0; m < 4; ++m) _Pragma("unroll") for (int k = 0; k < 2; ++k) dst[m][k] = *(const PG8_LAS bf16x8*)(lds + PG8_SA(b, h) + aoff + m * 2048 + k * 1024); } while (0)
#define PG8_LDB(dst, b, h) do { _Pragma("unroll") for (int n = 0; n < 2; ++n) _Pragma("unroll") for (int k = 0; k < 2; ++k) dst[n][k] = *(const PG8_LAS bf16x8*)(lds + PG8_SB(b, h) + boff + n * 2048 + k * 1024); } while (0)
#define PG8_MMA(ai, bj, At, Bt) do { __builtin_amdgcn_s_setprio(1); _Pragma("unroll") for (int m = 0; m < 4; ++m) _Pragma("unroll") for (int n = 0; n < 2; ++n) _Pragma("unroll") for (int k = 0; k < 2; ++k) \
        acc[ai][bj][m][n] = __builtin_amdgcn_mfma_f32_16x16x32_bf16(Bt[n][k], At[m][k], acc[ai][bj][m][n], 0, 0, 0); __builtin_amdgcn_s_setprio(0); } while (0)
#define PG8_WAIT_V(n) asm volatile("s_waitcnt vmcnt(" #n ")" ::: "memory")
#define PG8_WAIT_L(n) asm volatile("s_waitcnt lgkmcnt(" #n ")" ::: "memory")
#define PG8_BAR __builtin_amdgcn_s_barrier()
#define PG8_SCHED __builtin_amdgcn_sched_barrier(0)
    Unit cur, nxt; int ui = 0;
    if (!S.next(0, cur)) return;
    f32x4 acc[2][2][4][2];
#pragma unroll
    for (int a = 0; a < 2; ++a)
#pragma unroll
        for (int b = 0; b < 2; ++b)
#pragma unroll
            for (int m = 0; m < 4; ++m)
#pragma unroll
                for (int n = 0; n < 2; ++n) acc[a][b][m][n] = (f32x4){0.f, 0.f, 0.f, 0.f};
    bf16x8 At[4][2], B0[2][2], B1[2][2];
    const char* cA = (const char*)g.A + (size_t)cur.pm * tstep; const char* cB = (const char*)g.Bt + (size_t)cur.pn * tstep;
    S.a_ready(cur);
    if constexpr (SP2) {
        PG8_STAGE(PG8_SB(0, 0), cB, voffB); PG8_STAGE(PG8_SB(0, 1), cB + hstep, voffB); PG8_STAGE(PG8_SA(0, 0), cA, voffA); PG8_STAGE(PG8_SA(0, 1), cA + hstep, voffA);
        if (wr == 1) PG8_BAR;
        PG8_WAIT_V(2); PG8_BAR;
        PG8_STAGE(PG8_SB(1, 0), cB + kstep, voffB); PG8_STAGE(PG8_SA(1, 0), cA + kstep, voffA); PG8_STAGE(PG8_SB(1, 1), cB + hstep + kstep, voffB);
        PG8_WAIT_V(6); PG8_BAR;
    } else {
        PG8_STAGE(PG8_SB(0, 0), cB, voffB); PG8_STAGE(PG8_SA(0, 0), cA, voffA); PG8_STAGE(PG8_SB(0, 1), cB + hstep, voffB); PG8_STAGE(PG8_SA(0, 1), cA + hstep, voffA);
        if (wr == 1) PG8_BAR;
        PG8_WAIT_V(4); PG8_BAR;
        PG8_STAGE(PG8_SB(1, 0), cB + kstep, voffB); PG8_STAGE(PG8_SA(1, 0), cA + kstep, voffA); PG8_STAGE(PG8_SB(1, 1), cB + hstep + kstep, voffB);
        PG8_WAIT_V(6); PG8_BAR;
    }
    for (;;) {
        const bool has_next = S.next(ui + 1, nxt);
        const char* nA = has_next ? (const char*)g.A + (size_t)nxt.pm * tstep : cA; const char* nB = has_next ? (const char*)g.Bt + (size_t)nxt.pn * tstep : cB;
        for (int t = 0; t < nt; t += 2) {
            const bool last = (t == nt - 2);
            const char* a1 = cA + (size_t)(t + 1) * kstep;
            const char* a2 = last ? nA : cA + (size_t)(t + 2) * kstep; const char* b2 = last ? nB : cB + (size_t)(t + 2) * kstep;
            const char* a3 = a2 + kstep; const char* b3 = b2 + kstep;
            if (last && has_next) S.a_ready(nxt);
            if constexpr (SP2) {
            PG8_LDB(B0, 0, 0); PG8_LDB(B1, 0, 1); PG8_SCHED; PG8_LDA(At, 0, 0); PG8_STAGE(PG8_SA(1, 1), a1 + hstep, voffA);
            PG8_WAIT_V(8); PG8_WAIT_L(0); PG8_BAR; PG8_MMA(0, 0, At, B0); PG8_MMA(0, 1, At, B1); PG8_BAR; PG8_SCHED;
            PG8_LDA(At, 0, 1); PG8_STAGE(PG8_SB(0, 0), b2, voffB); PG8_STAGE(PG8_SB(0, 1), b2 + hstep, voffB); PG8_STAGE(PG8_SA(0, 0), a2, voffA);
            PG8_WAIT_V(8); PG8_WAIT_L(0); PG8_BAR; PG8_MMA(1, 0, At, B0); PG8_MMA(1, 1, At, B1); PG8_BAR; PG8_SCHED;
            PG8_LDB(B0, 1, 0); PG8_LDB(B1, 1, 1); PG8_SCHED; PG8_LDA(At, 1, 0); PG8_STAGE(PG8_SA(0, 1), a2 + hstep, voffA);
            PG8_WAIT_V(8); PG8_WAIT_L(0); PG8_BAR; PG8_MMA(0, 0, At, B0); PG8_MMA(0, 1, At, B1); PG8_BAR; PG8_SCHED;
            PG8_LDA(At, 1, 1); PG8_STAGE(PG8_SB(1, 0), b3, voffB); PG8_STAGE(PG8_SB(1, 1), b3 + hstep, voffB); PG8_STAGE(PG8_SA(1, 0), a3, voffA);
            PG8_WAIT_V(8); PG8_WAIT_L(0); PG8_BAR; PG8_MMA(1, 0, At, B0); PG8_MMA(1, 1, At, B1); PG8_BAR; PG8_SCHED;
            } else {
            PG8_LDB(B0, 0, 0); PG8_SCHED; PG8_LDA(At, 0, 0); PG8_STAGE(PG8_SA(1, 1), a1 + hstep, voffA);
            PG8_WAIT_L(8); PG8_BAR; PG8_WAIT_L(0); PG8_MMA(0, 0, At, B0); PG8_BAR; PG8_SCHED;
            PG8_LDB(B1, 0, 1); PG8_STAGE(PG8_SB(0, 0), b2, voffB);
            PG8_BAR; PG8_WAIT_L(0); PG8_MMA(0, 1, At, B1); PG8_BAR;
            PG8_LDA(At, 0, 1); PG8_STAGE(PG8_SA(0, 0), a2, voffA);
            PG8_BAR; PG8_WAIT_L(0); PG8_MMA(1, 0, At, B0); PG8_BAR; PG8_SCHED;
            PG8_STAGE(PG8_SB(0, 1), b2 + hstep, voffB);
            PG8_WAIT_V(6); PG8_BAR; PG8_MMA(1, 1, At, B1); PG8_BAR;
            PG8_LDB(B0, 1, 0); PG8_SCHED; PG8_LDA(At, 1, 0); PG8_STAGE(PG8_SA(0, 1), a2 + hstep, voffA);
            PG8_WAIT_L(8); PG8_BAR; PG8_WAIT_L(0); PG8_MMA(0, 0, At, B0); PG8_BAR; PG8_SCHED;
            PG8_LDB(B1, 1, 1); PG8_STAGE(PG8_SB(1, 0), b3, voffB);
            PG8_BAR; PG8_WAIT_L(0); PG8_MMA(0, 1, At, B1); PG8_BAR;
            PG8_LDA(At, 1, 1); PG8_STAGE(PG8_SA(1, 0), a3, voffA);
            PG8_BAR; PG8_WAIT_L(0); PG8_MMA(1, 0, At, B0); PG8_BAR; PG8_SCHED;
            PG8_STAGE(PG8_SB(1, 1), b3 + hstep, voffB);
            PG8_WAIT_V(6); PG8_BAR; PG8_MMA(1, 1, At, B1); PG8_BAR;
            }
        }
        if constexpr (ALIGN_EPI) { if (wr == 0) PG8_BAR; }
        if constexpr (!Epi::AFTER_DRAIN) { E(acc, cur, wr, wc, fr, fq); S.done(cur); }
        if (!has_next) break;
#pragma unroll
        for (int a = 0; a < 2; ++a)
#pragma unroll
            for (int b = 0; b < 2; ++b)
#pragma unroll
                for (int m = 0; m < 4; ++m)
#pragma unroll
                    for (int n = 0; n < 2; ++n) acc[a][b][m][n] = (f32x4){0.f, 0.f, 0.f, 0.f};
        cur = nxt; cA = nA; cB = nB; ++ui;
        if constexpr (ALIGN_EPI) { if (wr == 1) PG8_BAR; }
    }
    PG8_WAIT_V(0);
    if constexpr (!ALIGN_EPI) { if (wr == 0) PG8_BAR; }
    PG8_BAR;
    if constexpr (Epi::AFTER_DRAIN) { E.fused(acc, cur, wr, wc, fr, fq, lds, wid, lane); S.done(cur); }
#undef PG8_SA
#undef PG8_SB
#undef PG8_STAGE
#undef PG8_LDA
#undef PG8_LDB
#undef PG8_MMA
#undef PG8_WAIT_V
#undef PG8_WAIT_L
#undef PG8_BAR
#undef PG8_SCHED
}
}
#define XB_TMO      128
#define XB_XCNT(j)  (256  + 64 * (j))
#define XB_XSUB(j)  (1280 + 64 * (j))
#define XB_XGEN(j)  (2304 + 64 * (j))
#define XB_TOP      3328
#define XB_TOPGEN   3392
#define XCD_BAR_WORDS 3456
#define XB_SPIN_CAP (1u << 24)
#define LAS __attribute__((address_space(3)))

__device__ __forceinline__ unsigned xb_ld(unsigned* p)              { return __hip_atomic_load(p, __ATOMIC_RELAXED, __HIP_MEMORY_SCOPE_AGENT); }
__device__ __forceinline__ unsigned xb_add(unsigned* p, unsigned v) { return __hip_atomic_fetch_add(p, v, __ATOMIC_RELAXED, __HIP_MEMORY_SCOPE_AGENT); }
__device__ __forceinline__ unsigned xb_xcc_id() { return (unsigned)__builtin_amdgcn_s_getreg((3 << 11) | 20) & 0xFu; }
#define XB_SPIN(cond, bar) do { unsigned _sp = 0; while (cond) { __builtin_amdgcn_s_sleep(1); \
    if ((++_sp & 255u) == 0u) { if (xb_ld(&(bar)[XB_TMO])) break; if (_sp > XB_SPIN_CAP) { atomicAdd(&(bar)[XB_TMO], 1u); break; } } } } while (0)

struct XcdBarrier {
    unsigned* bar; unsigned x;
    volatile LAS unsigned* st;
};

__device__ __forceinline__ XcdBarrier xcd_barrier_post(unsigned* bar, volatile LAS unsigned* st) {
    XcdBarrier b; b.bar = bar; b.x = xb_xcc_id(); b.st = st;
    if (threadIdx.x == 0) (void)xb_add(&bar[XB_XCNT(b.x)], 1u);
    return b;
}
__device__ __forceinline__ void xcd_barrier_complete(unsigned* bar, unsigned x, unsigned& nloc, unsigned& nx) {
    const unsigned G = gridDim.x * gridDim.y * gridDim.z;
    unsigned sum, cnt, mine, sp = 0u;
    for (;;) {
        sum = 0u; cnt = 0u; mine = 0u;
#pragma unroll
        for (unsigned j = 0; j < 16; ++j) { const unsigned c = xb_ld(&bar[XB_XCNT(j)]); sum += c; cnt += (c > 0u) ? 1u : 0u; mine = (j == x) ? c : mine; }
        if (sum == G) break;
        __builtin_amdgcn_s_sleep(1);
        if ((++sp & 255u) == 0u) { if (xb_ld(&bar[XB_TMO])) break; if (sp > XB_SPIN_CAP) { atomicAdd(&bar[XB_TMO], 1u); break; } }
    }
    nloc = mine > 0u ? mine : 1u; nx = cnt > 0u ? cnt : 1u;
}

__device__ __forceinline__ void xcd_barrier(const XcdBarrier& b) {
    asm volatile("s_waitcnt vmcnt(0)" ::: "memory");
    __syncthreads();
    if (threadIdx.x == 0) {
        unsigned* bar = b.bar;
        __builtin_amdgcn_s_waitcnt(0);
        unsigned nloc = b.st[0], nx = b.st[1];
        if (nloc == 0u) { xcd_barrier_complete(bar, b.x, nloc, nx); b.st[0] = nloc; b.st[1] = nx; }
        const unsigned old = xb_add(&bar[XB_XSUB(b.x)], 1u);
        const unsigned gen = old / nloc;
        if (old + 1u == (gen + 1u) * nloc) {
            __builtin_amdgcn_fence(__ATOMIC_RELEASE, "agent");
            asm volatile("s_waitcnt vmcnt(0)" ::: "memory");
            const unsigned og = xb_add(&bar[XB_TOP], 1u);
            const unsigned tg = og / nx;
            if (og + 1u == (tg + 1u) * nx) xb_add(&bar[XB_TOPGEN], 1u);
            else XB_SPIN(xb_ld(&bar[XB_TOPGEN]) == tg, bar);
            __builtin_amdgcn_fence(__ATOMIC_ACQUIRE, "agent");
            xb_add(&bar[XB_XGEN(b.x)], 1u);
            asm volatile("s_waitcnt vmcnt(0)" ::: "memory");
        } else {
            XB_SPIN(xb_ld(&bar[XB_XGEN(b.x)]) == gen, bar);
            __builtin_amdgcn_fence(__ATOMIC_ACQUIRE, "agent");
            asm volatile("s_waitcnt vmcnt(0)" ::: "memory");
        }
    }
    __syncthreads();
}


#define GAS __attribute__((address_space(1)))
typedef unsigned short bf16;
typedef unsigned v4u __attribute__((ext_vector_type(4)));
typedef unsigned v2u __attribute__((ext_vector_type(2)));
typedef float f32x4 __attribute__((ext_vector_type(4)));
typedef float f32x2v __attribute__((ext_vector_type(2)));
typedef float f32x16 __attribute__((ext_vector_type(16)));
typedef short bf16x8 __attribute__((ext_vector_type(8)));
typedef __bf16 bf16v2 __attribute__((ext_vector_type(2)));

constexpr int NTOK = 16384, DM = 2048, SEQ = 4096, INW = 15360, BW = 1024;
constexpr float EPS = 1e-6f;
constexpr int NPH = 13;
constexpr int NPHASES = 2 * NPH;

constexpr size_t MiB = 1u << 20;
constexpr size_t WS_CTL = 0;
constexpr size_t WS_LB = 1 * MiB;
constexpr size_t WS_US = 1 * MiB + 64 * 1024, WS_VS = 1 * MiB + 128 * 1024;
constexpr size_t WS_WIN = 2 * MiB;
constexpr size_t WS_WBR = 62 * MiB;
constexpr size_t WS_WO = 74 * MiB;
constexpr size_t WS_WQ = 82 * MiB;
constexpr size_t WS_U = 91 * MiB;
constexpr size_t WS_V = 155 * MiB;
constexpr size_t WS_H = 219 * MiB;
constexpr size_t WS_SEG = 283 * MiB;
constexpr size_t WS_GATE = 539 * MiB;
constexpr size_t WS_X2 = 731 * MiB;
constexpr size_t WS_CONV = 859 * MiB;
constexpr size_t WS_HGR = 891 * MiB;
constexpr size_t WS_MERGED = 923 * MiB;
constexpr size_t WS_SEL = 987 * MiB;
constexpr size_t WS_SELS = 1003 * MiB;
constexpr size_t WS_DEC = 1004 * MiB;
constexpr size_t WS_END = 1005 * MiB;
constexpr size_t WS_ST = WS_H;
constexpr size_t WS_KEYS = 90 * MiB;
constexpr size_t WS_PART = WS_GATE;
constexpr size_t WS_QPEER = WS_SEG;
constexpr size_t SEGSZ = (size_t)NTOK * 1024;
constexpr int CW_BAR = 4096;
constexpr int CW_RANK = 131072;

constexpr int RING_BYTES = 131072, MISC_OFF = RING_BYTES + 320, LDS_BYTES = 147456;

__device__ __forceinline__ unsigned pk2c(float lo, float hi) { f32x2v v = {lo, hi}; bf16v2 b = __builtin_convertvector(v, bf16v2); return __builtin_bit_cast(unsigned, b); }
__device__ __forceinline__ float bflo(unsigned x) { return __uint_as_float(x << 16); }
__device__ __forceinline__ float bfhi(unsigned x) { return __uint_as_float(x & 0xffff0000u); }
__device__ __forceinline__ float sigm(float x) { return __builtin_amdgcn_rcpf(1.0f + __expf(-x)); }
__device__ __forceinline__ float wave_sum(float v) {
#pragma unroll
    for (int o = 1; o < 64; o <<= 1) v += __shfl_xor(v, o);
    return v;
}
__device__ __forceinline__ float wave_max(float v) {
#pragma unroll
    for (int o = 1; o < 64; o <<= 1) v = fmaxf(v, __shfl_xor(v, o));
    return v;
}
#define LDS_WAIT() asm volatile("s_waitcnt lgkmcnt(0)" ::: "memory")
#define MFMA32(a, b, c) __builtin_amdgcn_mfma_f32_32x32x16_bf16((a), (b), (c), 0, 0, 0)
__device__ __forceinline__ int ridx16(int lane) { return ((lane >> 5) & 1) * 8 + ((lane >> 4) & 1) * 4 + ((lane >> 3) & 1) * 2 + ((lane >> 2) & 1); }
__device__ __forceinline__ void xreduce16(float (&v)[16], int lane) {
#pragma unroll
    for (int i = 0; i < 8; ++i) { const bool up = (lane & 32) != 0; const float snd = up ? v[i] : v[i + 8], kp = up ? v[i + 8] : v[i]; v[i] = kp + __shfl_xor(snd, 32); }
#pragma unroll
    for (int i = 0; i < 4; ++i) { const bool up = (lane & 16) != 0; const float snd = up ? v[i] : v[i + 4], kp = up ? v[i + 4] : v[i]; v[i] = kp + __shfl_xor(snd, 16); }
#pragma unroll
    for (int i = 0; i < 2; ++i) { const bool up = (lane & 8) != 0; const float snd = up ? v[i] : v[i + 2], kp = up ? v[i + 2] : v[i]; v[i] = kp + __shfl_xor(snd, 8); }
    { const bool up = (lane & 4) != 0; const float snd = up ? v[0] : v[1], kp = up ? v[1] : v[0]; v[0] = kp + __shfl_xor(snd, 4); }
    v[0] += __shfl_xor(v[0], 2); v[0] += __shfl_xor(v[0], 1);
}
__device__ __forceinline__ float gelu_exact(float v) {
    const float av = fabsf(v), t = __builtin_amdgcn_rcpf(av * 0.2316418882f + 1.0f);
    float q = t * 0.5307027145f + (-0.7265760135f); q = q * t + 0.7107068705f; q = q * t + (-0.142248368f); q = q * t + 0.127414796f; q = q * t;
    const float e = __builtin_amdgcn_exp2f((v * v) * (-0.72134752044f));
    const float m = v * (q * e);
    return v < 0.f ? m : v - m;
}

struct Ctx { LAS unsigned char* lds; int tid, lane, wave, G, gw, NGW; };

__device__ __forceinline__ void tr_item(const float* W, int K, int N, bf16* WT, int k0, int n0, int drow0, LAS float* scr, int lane) {
#pragma unroll 8
    for (int i = 0; i < 32; ++i) { const int kk = 2 * i + (lane >> 5); scr[kk * 33 + (lane & 31)] = ((const GAS float*)W)[(size_t)(k0 + kk) * N + n0 + (lane & 31)]; }
    LDS_WAIT();
    const int c = lane & 7;
#pragma unroll
    for (int j = 0; j < 4; ++j) { const int n = (lane >> 3) + 8 * j; const LAS float* s = scr + (8 * c) * 33 + n;
        v4u o; o.x = pk2c(s[0], s[33]); o.y = pk2c(s[66], s[99]); o.z = pk2c(s[132], s[165]); o.w = pk2c(s[198], s[231]);
        *(GAS v4u*)(WT + (size_t)(drow0 + n) * K + k0 + 8 * c) = o; }
    LDS_WAIT();
}
__device__ __forceinline__ int win_drow(int n) { if (n < 7168 || n >= 9216) return n; const int r = n - 7168, isb = r >> 10, c = r & 1023; return 7168 + (c >> 7) * 256 + isb * 128 + (c & 127); }
__device__ __forceinline__ void cvt_copy(const Ctx& c, const float* src, bf16* dst, size_t n8) {
    const size_t NT = (size_t)c.G * 512;
    for (size_t i = (size_t)blockIdx.x * 512 + c.tid; i < n8; i += NT) {
        const f32x4 a = ((const GAS f32x4*)src)[2 * i], b = ((const GAS f32x4*)src)[2 * i + 1];
        v4u o; o.x = pk2c(a.x, a.y); o.y = pk2c(a.z, a.w); o.z = pk2c(b.x, b.y); o.w = pk2c(b.z, b.w);
        ((GAS v4u*)dst)[i] = o;
    }
}
__device__ __forceinline__ void rms_row(const float* xr, const float* w, bf16* o, int lane) {
    const GAS f32x4* xp = (const GAS f32x4*)xr + lane; f32x4 v[8]; float s = 0.f;
#pragma unroll
    for (int j = 0; j < 8; ++j) { v[j] = xp[64 * j]; s += (v[j].x * v[j].x + v[j].y * v[j].y) + (v[j].z * v[j].z + v[j].w * v[j].w); }
    const float r = __builtin_amdgcn_rsqf(wave_sum(s) * (1.0f / DM) + EPS);
    const GAS f32x4* wp = (const GAS f32x4*)w + lane; GAS v2u* op = (GAS v2u*)o + lane;
#pragma unroll
    for (int j = 0; j < 8; ++j) { const f32x4 wv = wp[64 * j]; v2u q; q.x = pk2c(v[j].x * r * wv.x, v[j].y * r * wv.y); q.y = pk2c(v[j].z * r * wv.z, v[j].w * r * wv.w); op[64 * j] = q; }
}
__device__ __forceinline__ void rms_phase(const Ctx& c, const float* x, const float* w, bf16* H) {
    for (int m = c.gw; m < NTOK; m += c.NGW) rms_row(x + (size_t)m * DM, w, H + (size_t)m * DM, c.lane);
}
__device__ __forceinline__ void fp8_row(const float* src, unsigned char* dst, float* scale_out, int lane) {
    const GAS f32x4* xp = (const GAS f32x4*)src + lane; f32x4 v[8]; float m = 0.f;
#pragma unroll
    for (int j = 0; j < 8; ++j) { v[j] = xp[64 * j]; m = fmaxf(fmaxf(m, fmaxf(fabsf(v[j].x), fabsf(v[j].y))), fmaxf(fabsf(v[j].z), fabsf(v[j].w))); }
    m = wave_max(m);
    const float inv = m > 0.f ? 256.0f / m : 0.f;
    if (lane == 0) *(GAS float*)scale_out = m * (1.0f / 256.0f);
#pragma unroll
    for (int j = 0; j < 8; ++j) { int p = __builtin_amdgcn_cvt_pk_fp8_f32(v[j].x * inv, v[j].y * inv, 0, false); p = __builtin_amdgcn_cvt_pk_fp8_f32(v[j].z * inv, v[j].w * inv, p, true);
        ((GAS unsigned*)dst)[lane + 64 * j] = (unsigned)p; }
}
struct P0Args { const float *w_in, *w_br_sb, *w_br_hg, *w_br_conv, *w_o, *w_q, *u, *v, *lbp; bf16 *WinT, *WbrT, *WoT, *WqT; unsigned char *U, *V; float *US, *VS; float* LB; int layer; const float *k1, *k2; bf16* KB; };
__device__ __forceinline__ void p0_convert(const Ctx& c, const P0Args& a) {
    LAS float* scr = (LAS float*)(c.lds + c.wave * 16384);
    constexpr int I_IN = (DM / 64) * (INW / 32), I_BR = (BW / 64) * (DM / 32), I_SQ = (DM / 64) * (DM / 32);
    constexpr int NITEMS = I_IN + 3 * I_BR + 2 * I_SQ;
    for (int it = c.gw; it < NITEMS; it += c.NGW) {
        int r = it;
        if (r < I_IN) { const int kb = r / (INW / 32), nb = r % (INW / 32); tr_item(a.w_in, DM, INW, a.WinT, kb * 64, nb * 32, win_drow(nb * 32), scr, c.lane); continue; } r -= I_IN;
        if (r < I_BR) { const int kb = r / (DM / 32), nb = r % (DM / 32); tr_item(a.w_br_sb, BW, DM, a.WbrT, kb * 64, nb * 32, nb * 32, scr, c.lane); continue; } r -= I_BR;
        if (r < I_BR) { const int kb = r / (DM / 32), nb = r % (DM / 32); tr_item(a.w_br_hg, BW, DM, a.WbrT + (size_t)DM * BW, kb * 64, nb * 32, nb * 32, scr, c.lane); continue; } r -= I_BR;
        if (r < I_BR) { const int kb = r / (DM / 32), nb = r % (DM / 32); tr_item(a.w_br_conv, BW, DM, a.WbrT + (size_t)2 * DM * BW, kb * 64, nb * 32, nb * 32, scr, c.lane); continue; } r -= I_BR;
        if (r < I_SQ) { const int kb = r / (DM / 32), nb = r % (DM / 32); tr_item(a.w_o, DM, DM, a.WoT, kb * 64, nb * 32, nb * 32, scr, c.lane); continue; } r -= I_SQ;
        { const int kb = r / (DM / 32), nb = r % (DM / 32); tr_item(a.w_q, DM, DM, a.WqT, kb * 64, nb * 32, nb * 32, scr, c.lane); }
    }
    for (int r = c.gw; r < 2 * 16384; r += c.NGW) {
        if (r < 16384) fp8_row(a.u + (size_t)r * 2048, a.U + (size_t)r * 2048, a.US + r, c.lane);
        else fp8_row(a.v + (size_t)(r - 16384) * 2048, a.V + (size_t)(r - 16384) * 2048, a.VS + (r - 16384), c.lane);
    }
    cvt_copy(c, a.k1, a.KB, (size_t)8 * 16384 / 8);
    cvt_copy(c, a.k2, a.KB + 8 * 16384, (size_t)8 * 16384 / 8);
    if (blockIdx.x == 0) for (int i = c.tid; i < 1024; i += 512) a.LB[i] = a.layer == 0 ? 0.f : sigm(a.lbp[1024 + i] - a.lbp[i]);
}

struct EpiIn {
    static constexpr bool PERM = true, AFTER_DRAIN = false;
    bf16* seg; bf16* gate; const float* lb;
    __device__ __forceinline__ void operator()(const pg8::f32x4 (&acc)[2][2][4][2], const pg8::Unit& u, int wr, int wc, int fr, int fq) const {
        const int pn = u.pn; const int row0 = u.pm * 256 + wr * 64 + fr;
        if (pn >= 28 && pn < 36) {
            bf16* dst = seg + (size_t)7 * SEGSZ; const int col0 = (pn - 28) * 128 + wc * 32 + 8 * fq;
#pragma unroll
            for (int ai = 0; ai < 2; ++ai)
#pragma unroll
                for (int m = 0; m < 4; ++m) {
                    const pg8::f32x4 a0 = acc[ai][0][m][0], a1 = acc[ai][0][m][1], b0 = acc[ai][1][m][0], b1 = acc[ai][1][m][1];
                    v4u w; w.x = pk2c(a0[0] * sigm(b0[0]), a0[1] * sigm(b0[1])); w.y = pk2c(a0[2] * sigm(b0[2]), a0[3] * sigm(b0[3]));
                    w.z = pk2c(a1[0] * sigm(b1[0]), a1[1] * sigm(b1[1])); w.w = pk2c(a1[2] * sigm(b1[2]), a1[3] * sigm(b1[3]));
                    *(GAS v4u*)(dst + (size_t)(row0 + ai * 128 + m * 16) * 1024 + col0) = w; }
            return;
        }
        bf16* dst; int ld, colt, mode;
        if (pn < 28) { const int sg = pn >> 2; dst = seg + (size_t)sg * SEGSZ; ld = 1024; colt = (pn & 3) * 256; mode = (sg == 4) ? 2 : (sg == 6 ? 1 : 0); }
        else { const int q = pn - 36; dst = gate + (size_t)(q >> 3) * ((size_t)NTOK * 2048); ld = 2048; colt = (q & 7) * 256; mode = 1; }
        const int col0 = colt + wc * 32 + 8 * fq;
        if (mode == 0) {
#pragma unroll
            for (int ai = 0; ai < 2; ++ai)
#pragma unroll
                for (int m = 0; m < 4; ++m)
#pragma unroll
                    for (int bj = 0; bj < 2; ++bj) { const pg8::f32x4 v0 = acc[ai][bj][m][0], v1 = acc[ai][bj][m][1];
                        v4u w; w.x = pk2c(v0[0], v0[1]); w.y = pk2c(v0[2], v0[3]); w.z = pk2c(v1[0], v1[1]); w.w = pk2c(v1[2], v1[3]);
                        *(GAS v4u*)(dst + (size_t)(row0 + ai * 128 + m * 16) * ld + col0 + bj * 128) = w; }
        } else if (mode == 1) {
#pragma unroll
            for (int ai = 0; ai < 2; ++ai)
#pragma unroll
                for (int m = 0; m < 4; ++m)
#pragma unroll
                    for (int bj = 0; bj < 2; ++bj) { const pg8::f32x4 v0 = acc[ai][bj][m][0], v1 = acc[ai][bj][m][1];
                        v4u w; w.x = pk2c(sigm(v0[0]), sigm(v0[1])); w.y = pk2c(sigm(v0[2]), sigm(v0[3])); w.z = pk2c(sigm(v1[0]), sigm(v1[1])); w.w = pk2c(sigm(v1[2]), sigm(v1[3]));
                        *(GAS v4u*)(dst + (size_t)(row0 + ai * 128 + m * 16) * ld + col0 + bj * 128) = w; }
        } else {
            f32x4 l0[2], l1[2];
#pragma unroll
            for (int bj = 0; bj < 2; ++bj) { l0[bj] = *(const GAS f32x4*)(lb + col0 + bj * 128); l1[bj] = *(const GAS f32x4*)(lb + col0 + bj * 128 + 4); }
#pragma unroll
            for (int ai = 0; ai < 2; ++ai)
#pragma unroll
                for (int m = 0; m < 4; ++m)
#pragma unroll
                    for (int bj = 0; bj < 2; ++bj) { const pg8::f32x4 v0 = acc[ai][bj][m][0], v1 = acc[ai][bj][m][1]; float r[8];
#pragma unroll
                        for (int j = 0; j < 4; ++j) { r[j] = __logf(l0[bj][j] + (1.0f - l0[bj][j]) * sigm(v0[j])); r[4 + j] = __logf(l1[bj][j] + (1.0f - l1[bj][j]) * sigm(v1[j])); }
                        v4u w; w.x = pk2c(r[0], r[1]); w.y = pk2c(r[2], r[3]); w.z = pk2c(r[4], r[5]); w.w = pk2c(r[6], r[7]);
                        *(GAS v4u*)(dst + (size_t)(row0 + ai * 128 + m * 16) * ld + col0 + bj * 128) = w; }
        }
    }
};

__device__ __forceinline__ void conv_phase(const Ctx& c, const bf16* glu, const float* cw, const float* cb, const float* lnw, const float* lnb, bf16* out) {
    const int c0 = 2 * c.tid;
    float w0[31], w1[31];
#pragma unroll
    for (int j = 0; j < 31; ++j) { const f32x2v t = *(const GAS f32x2v*)(cw + j * 1024 + c0); w0[j] = t.x; w1[j] = t.y; }
    const f32x2v bv = *(const GAS f32x2v*)(cb + c0), lwv = *(const GAS f32x2v*)(lnw + c0), lbv = *(const GAS f32x2v*)(lnb + c0);
    LAS float* red = (LAS float*)c.lds;
    for (int tile = blockIdx.x; tile < NTOK / 8; tile += c.G) {
        const int n0 = tile * 8, tseq0 = n0 & (SEQ - 1);
        float a0[8], a1[8];
#pragma unroll
        for (int t = 0; t < 8; ++t) { a0[t] = bv.x; a1[t] = bv.y; }
#pragma unroll
        for (int r = 0; r < 38; ++r) {
            unsigned xv = 0u;
            if (tseq0 + r - 30 >= 0) xv = *(const GAS unsigned*)(glu + (size_t)(n0 + r - 30) * 1024 + c0);
            const float x0 = bflo(xv), x1 = bfhi(xv);
#pragma unroll
            for (int t = 0; t < 8; ++t) { const int j = r - t; if (j >= 0 && j <= 30) { a0[t] += w0[j] * x0; a1[t] += w1[j] * x1; } }
        }
        float st[16];
#pragma unroll
        for (int t = 0; t < 8; ++t) { st[2 * t] = a0[t] + a1[t]; st[2 * t + 1] = a0[t] * a0[t] + a1[t] * a1[t]; }
        xreduce16(st, c.lane);
        if ((c.lane & 3) == 0) red[c.wave * 16 + ridx16(c.lane)] = st[0];
        __syncthreads();
        if (c.tid < 16) { float s = 0.f;
#pragma unroll
            for (int w = 0; w < 8; ++w) s += red[w * 16 + c.tid];
            red[128 + c.tid] = s; }
        __syncthreads();
#pragma unroll
        for (int t = 0; t < 8; ++t) {
            const float mean = red[128 + 2 * t] * (1.0f / 1024.0f), var = red[128 + 2 * t + 1] * (1.0f / 1024.0f) - mean * mean;
            const float rstd = __builtin_amdgcn_rsqf(var + EPS);
            const float h0 = (a0[t] - mean) * rstd * lwv.x + lbv.x, h1 = (a1[t] - mean) * rstd * lwv.y + lbv.y;
            *(GAS unsigned*)(out + (size_t)(n0 + t) * 1024 + c0) = pk2c(h0 * sigm(h0), h1 * sigm(h1));
        }
        __syncthreads();
    }
}
__device__ __forceinline__ void hgrn_task(int task, int lane, const bf16* qhg, const bf16* logf, const bf16* ihg, bf16* out) {
    const int bh = task >> 6, dvb = task & 63, b = bh >> 3, h = bh & 7;
    const size_t rb = (size_t)b * SEQ * 1024;
    const GAS unsigned* qp = (const GAS unsigned*)(qhg + rb + h * 128) + lane;
    const GAS unsigned* lp = (const GAS unsigned*)(logf + rb + h * 128) + lane;
    const GAS unsigned* ip = (const GAS unsigned*)(ihg + rb + h * 128) + dvb;
    GAS bf16* op = (GAS bf16*)(out + rb + h * 128 + 2 * dvb);
    float S00 = 0.f, S01 = 0.f, S10 = 0.f, S11 = 0.f;
    unsigned qn[8], ln[8], inx[8];
#pragma unroll
    for (int j = 0; j < 8; ++j) { qn[j] = qp[(size_t)j * 512]; ln[j] = lp[(size_t)j * 512]; inx[j] = ip[(size_t)j * 512]; }
    for (int blk = 0; blk < SEQ / 8; ++blk) {
        unsigned qc[8], lc[8], ic[8];
#pragma unroll
        for (int j = 0; j < 8; ++j) { qc[j] = qn[j]; lc[j] = ln[j]; ic[j] = inx[j]; }
        if (blk + 1 < SEQ / 8) {
#pragma unroll
            for (int j = 0; j < 8; ++j) { const size_t o = (size_t)((blk + 1) * 8 + j) * 512; qn[j] = qp[o]; ln[j] = lp[o]; inx[j] = ip[o]; }
        }
        float pv[16];
#pragma unroll
        for (int j = 0; j < 8; ++j) {
            const float f0 = __expf(bflo(lc[j])), f1 = __expf(bfhi(lc[j])), k0 = 1.0f - f0, k1 = 1.0f - f1;
            const float i0 = bflo(ic[j]), i1 = bfhi(ic[j]), q0 = bflo(qc[j]), q1 = bfhi(qc[j]);
            S00 = f0 * S00 + k0 * i0; S01 = f0 * S01 + k0 * i1; S10 = f1 * S10 + k1 * i0; S11 = f1 * S11 + k1 * i1;
            pv[2 * j] = S00 * q0 + S10 * q1; pv[2 * j + 1] = S01 * q0 + S11 * q1;
        }
        xreduce16(pv, lane);
        if ((lane & 3) == 0) { const int idx = ridx16(lane); op[(size_t)(blk * 8 + (idx >> 1)) * 1024 + (idx & 1)] = (bf16)(pk2c(pv[0], 0.f) & 0xffffu); }
    }
}
constexpr int HG_TS = 272;
constexpr int HG_BS = 132;
__device__ __forceinline__ void hg_stage(LAS unsigned char* dst, const bf16* src, int tid) {
#pragma unroll
    for (int i = 0; i < 2; ++i) { const int p = tid + 512 * i, row = p >> 4, c16 = p & 15; *(LAS v4u*)(dst + row * HG_TS + c16 * 16) = *(const GAS v4u*)(src + (size_t)row * 1024 + c16 * 8); }
}
__device__ __forceinline__ void hg_scan(const LAS unsigned char* lft, int dk, int hf, float (&lf)[4][8], float (&b)[4][8], float& bl) {
    float bs[4], pb[4];
#pragma unroll
    for (int kk = 0; kk < 4; ++kk) { float run = 0.f;
#pragma unroll
        for (int j = 0; j < 8; ++j) { lf[kk][j] = __uint_as_float((unsigned)(*(const LAS unsigned short*)(lft + (16 * kk + 8 * hf + j) * HG_TS + dk * 2)) << 16); run += lf[kk][j]; b[kk][j] = run; }
        bs[kk] = run; }
#pragma unroll
    for (int kk = 0; kk < 4; ++kk) pb[kk] = __shfl_xor(bs[kk], 32);
    float pre = 0.f;
#pragma unroll
    for (int kk = 0; kk < 4; ++kk) { const float off = pre + (hf ? pb[kk] : 0.f);
#pragma unroll
        for (int j = 0; j < 8; ++j) b[kk][j] += off;
        pre += bs[kk] + pb[kk]; }
    bl = pre;
}
__device__ __forceinline__ bf16x8 pack8(const float (&v)[8]) { v4u t; t.x = pk2c(v[0], v[1]); t.y = pk2c(v[2], v[3]); t.z = pk2c(v[4], v[5]); t.w = pk2c(v[6], v[7]); return __builtin_bit_cast(bf16x8, t); }
__device__ __forceinline__ unsigned lds_u16(const LAS unsigned char* p) { return (unsigned)(*(const LAS unsigned short*)p); }
__device__ __forceinline__ void hgA_chunk(const Ctx& c, int ci, const bf16* LOGF, const bf16* IHG, bf16* ST, float* DEC) {
    const int bh = ci >> 6, ch = ci & 63, bb = bh >> 3, h = bh & 7; const size_t n0 = (size_t)bb * SEQ + ch * 64;
    LAS unsigned char* lft = c.lds; LAS unsigned char* itl = c.lds + 64 * HG_TS;
    hg_stage(lft, LOGF + n0 * 1024 + h * 128, c.tid); hg_stage(itl, IHG + n0 * 1024 + h * 128, c.tid);
    __syncthreads();
    const int dkt = c.wave & 3, dvh = c.wave >> 2, hf = c.lane >> 5, cl = c.lane & 31, dk = 32 * dkt + cl;
    float lf[4][8], b[4][8], bl; hg_scan(lft, dk, hf, lf, b, bl);
    bf16x8 kf[4];
#pragma unroll
    for (int kk = 0; kk < 4; ++kk) { float v[8];
#pragma unroll
        for (int j = 0; j < 8; ++j) v[j] = (1.0f - __expf(lf[kk][j])) * __expf(bl - b[kk][j]);
        kf[kk] = pack8(v); }
    if (dvh == 0 && hf == 0) ((GAS float*)DEC)[(size_t)ci * 128 + dk] = __expf(bl);
#pragma unroll
    for (int dvi = 0; dvi < 2; ++dvi) { const int dvt = dvh * 2 + dvi;
        f32x16 acc;
#pragma unroll
        for (int r = 0; r < 16; ++r) acc[r] = 0.f;
#pragma unroll
        for (int kk = 0; kk < 4; ++kk) { const LAS unsigned char* p = itl + (16 * kk + 8 * hf) * HG_TS + (32 * dvt + cl) * 2;
            v4u t; t.x = lds_u16(p) | (lds_u16(p + HG_TS) << 16); t.y = lds_u16(p + 2 * HG_TS) | (lds_u16(p + 3 * HG_TS) << 16); t.z = lds_u16(p + 4 * HG_TS) | (lds_u16(p + 5 * HG_TS) << 16); t.w = lds_u16(p + 6 * HG_TS) | (lds_u16(p + 7 * HG_TS) << 16);
            acc = MFMA32(kf[kk], __builtin_bit_cast(bf16x8, t), acc); }
        bf16* o = ST + (size_t)ci * 16384 + (size_t)(32 * dvt + cl) * 128 + 32 * dkt + 4 * hf;
#pragma unroll
        for (int g = 0; g < 4; ++g) { v2u q; q.x = pk2c(acc[4 * g], acc[4 * g + 1]); q.y = pk2c(acc[4 * g + 2], acc[4 * g + 3]); *(GAS v2u*)(o + 8 * g) = q; }
    }
    __syncthreads();
}
__device__ __forceinline__ void hgB(const Ctx& c, bf16* ST, const float* DEC) {
    for (int e = blockIdx.x * 512 + c.tid; e < 32 * 4096; e += c.G * 512) {
        const int bh = e >> 12, r = e & 4095, dv = r >> 5, dk4 = (r & 31) * 4;
        GAS v2u* p = (GAS v2u*)(ST + (size_t)bh * 64 * 16384 + (size_t)dv * 128 + dk4);
        const GAS f32x4* d = (const GAS f32x4*)(DEC + (size_t)bh * 64 * 128 + dk4);
        f32x4 S = {0.f, 0.f, 0.f, 0.f};
#pragma unroll 1
        for (int c0 = 0; c0 < 64; c0 += 8) {
            v2u Lv[8]; f32x4 D[8];
#pragma unroll
            for (int k = 0; k < 8; ++k) { Lv[k] = p[(size_t)(c0 + k) * 4096]; D[k] = d[(size_t)(c0 + k) * 32]; }
#pragma unroll
            for (int k = 0; k < 8; ++k) { v2u o; o.x = pk2c(S.x, S.y); o.y = pk2c(S.z, S.w); p[(size_t)(c0 + k) * 4096] = o;
                S.x = D[k].x * S.x + bflo(Lv[k].x); S.y = D[k].y * S.y + bfhi(Lv[k].x); S.z = D[k].z * S.z + bflo(Lv[k].y); S.w = D[k].w * S.w + bfhi(Lv[k].y); }
        }
    }
}
__device__ __forceinline__ void hgC_chunk(const Ctx& c, int ci, const bf16* QHG, const bf16* LOGF, const bf16* IHG, const bf16* GHG, const bf16* ST, const float* nw, bf16* OUT) {
    const int bh = ci >> 6, ch = ci & 63, bb = bh >> 3, h = bh & 7; const size_t n0 = (size_t)bb * SEQ + ch * 64;
    LAS unsigned char* lft = c.lds; LAS unsigned char* itl = c.lds + 64 * HG_TS; LAS float* bt = (LAS float*)(c.lds + 2 * 64 * HG_TS); LAS float* red = bt + 64 * HG_BS;
    hg_stage(lft, LOGF + n0 * 1024 + h * 128, c.tid); hg_stage(itl, IHG + n0 * 1024 + h * 128, c.tid);
    __syncthreads();
    const int hf = c.lane >> 5, cl = c.lane & 31;
    { const int dk = 32 * (c.wave & 3) + cl; float lf[4][8], b[4][8], bl; hg_scan(lft, dk, hf, lf, b, bl);
#pragma unroll
      for (int q = 0; q < 2; ++q) { const int kk = 2 * (c.wave >> 2) + q;
#pragma unroll
          for (int j = 0; j < 8; ++j) bt[(16 * kk + 8 * hf + j) * HG_BS + dk] = (c.wave >> 2) ? b[2 + q][j] : b[q][j]; } }
    __syncthreads();
    const int dvt = c.wave & 3, tt = c.wave >> 2, t = 32 * tt + cl;
    bf16x8 qm[8];
    const bf16* qrow = QHG + (n0 + t) * 1024 + h * 128 + 8 * hf;
#pragma unroll
    for (int kk = 0; kk < 8; ++kk) { const int d0 = 16 * kk + 8 * hf;
        asm volatile("" ::: "memory");
        const v4u qv = *(const GAS v4u*)(qrow + 16 * kk);
        const f32x4 b0 = *(const LAS f32x4*)(bt + t * HG_BS + d0), b1 = *(const LAS f32x4*)(bt + t * HG_BS + d0 + 4), m0 = *(const LAS f32x4*)(bt + 31 * HG_BS + d0), m1 = *(const LAS f32x4*)(bt + 31 * HG_BS + d0 + 4);
        const float q[8] = {bflo(qv.x), bfhi(qv.x), bflo(qv.y), bfhi(qv.y), bflo(qv.z), bfhi(qv.z), bflo(qv.w), bfhi(qv.w)};
        const float bv[8] = {b0.x, b0.y, b0.z, b0.w, b1.x, b1.y, b1.z, b1.w}, mv[8] = {m0.x, m0.y, m0.z, m0.w, m1.x, m1.y, m1.z, m1.w};
        float vm[8];
#pragma unroll
        for (int j = 0; j < 8; ++j) vm[j] = q[j] * __expf(bv[j] - mv[j]);
        qm[kk] = pack8(vm); }
    f32x16 o;
#pragma unroll
    for (int r = 0; r < 16; ++r) o[r] = 0.f;
#pragma unroll 1
    for (int st = 0; st <= tt; ++st) {
        const int s = 32 * st + cl;
        f32x16 sa;
#pragma unroll
        for (int r = 0; r < 16; ++r) sa[r] = 0.f;
#pragma unroll
        for (int kk = 0; kk < 8; ++kk) { const int d0 = 16 * kk + 8 * hf;
            asm volatile("" ::: "memory");
            const v4u lv = *(const LAS v4u*)(lft + s * HG_TS + d0 * 2);
            const f32x4 b0 = *(const LAS f32x4*)(bt + s * HG_BS + d0), b1 = *(const LAS f32x4*)(bt + s * HG_BS + d0 + 4), m0 = *(const LAS f32x4*)(bt + 31 * HG_BS + d0), m1 = *(const LAS f32x4*)(bt + 31 * HG_BS + d0 + 4);
            const float lfv[8] = {bflo(lv.x), bfhi(lv.x), bflo(lv.y), bfhi(lv.y), bflo(lv.z), bfhi(lv.z), bflo(lv.w), bfhi(lv.w)};
            const float bv[8] = {b0.x, b0.y, b0.z, b0.w, b1.x, b1.y, b1.z, b1.w}, mv[8] = {m0.x, m0.y, m0.z, m0.w, m1.x, m1.y, m1.z, m1.w};
            float vk[8];
#pragma unroll
            for (int j = 0; j < 8; ++j) vk[j] = (1.0f - __expf(lfv[j])) * __expf(mv[j] - bv[j]);
            sa = MFMA32(pack8(vk), qm[kk], sa); }
        if (st == tt) {
#pragma unroll
            for (int r = 0; r < 16; ++r) if (((r & 3) + 8 * (r >> 2) + 4 * hf) > cl) sa[r] = 0.f;
        }
#pragma unroll
        for (int sp = 0; sp < 2; ++sp) {
            const float pv[8] = {sa[8 * sp], sa[8 * sp + 1], sa[8 * sp + 2], sa[8 * sp + 3], sa[8 * sp + 4], sa[8 * sp + 5], sa[8 * sp + 6], sa[8 * sp + 7]};
            const LAS unsigned char* p = itl + (32 * st + 16 * sp + 4 * hf) * HG_TS + (32 * dvt + cl) * 2;
            v4u tq; tq.x = lds_u16(p) | (lds_u16(p + HG_TS) << 16); tq.y = lds_u16(p + 2 * HG_TS) | (lds_u16(p + 3 * HG_TS) << 16);
            tq.z = lds_u16(p + 8 * HG_TS) | (lds_u16(p + 9 * HG_TS) << 16); tq.w = lds_u16(p + 10 * HG_TS) | (lds_u16(p + 11 * HG_TS) << 16);
            o = MFMA32(__builtin_bit_cast(bf16x8, tq), pack8(pv), o); }
    }
    { const bf16* strow = ST + (size_t)ci * 16384 + (size_t)(32 * dvt + cl) * 128 + 8 * hf;
#pragma unroll
      for (int kk = 0; kk < 8; ++kk) { const int d0 = 16 * kk + 8 * hf;
          asm volatile("" ::: "memory");
          const v4u qv = *(const GAS v4u*)(qrow + 16 * kk); const bf16x8 sf = *(const GAS bf16x8*)(strow + 16 * kk);
          const f32x4 b0 = *(const LAS f32x4*)(bt + t * HG_BS + d0), b1 = *(const LAS f32x4*)(bt + t * HG_BS + d0 + 4);
          float ve[8] = {bflo(qv.x) * __expf(b0.x), bfhi(qv.x) * __expf(b0.y), bflo(qv.y) * __expf(b0.z), bfhi(qv.y) * __expf(b0.w), bflo(qv.z) * __expf(b1.x), bfhi(qv.z) * __expf(b1.y), bflo(qv.w) * __expf(b1.z), bfhi(qv.w) * __expf(b1.w)};
          o = MFMA32(sf, pack8(ve), o); } }
    float ss = 0.f;
#pragma unroll
    for (int r = 0; r < 16; ++r) ss += o[r] * o[r];
    ss += __shfl_xor(ss, 32);
    if (hf == 0) red[(tt * 4 + dvt) * 32 + cl] = ss;
    __syncthreads();
    const float rstd = __builtin_amdgcn_rsqf(((red[(tt * 4 + 0) * 32 + cl] + red[(tt * 4 + 1) * 32 + cl]) + (red[(tt * 4 + 2) * 32 + cl] + red[(tt * 4 + 3) * 32 + cl])) * (1.0f / 128.0f) + EPS);
#pragma unroll
    for (int g = 0; g < 4; ++g) { const int dv0 = 32 * dvt + 8 * g + 4 * hf; const size_t off = (n0 + t) * 1024 + h * 128 + dv0;
        const v2u gg = *(const GAS v2u*)(GHG + off); const f32x4 w4 = *(const GAS f32x4*)(nw + dv0);
        v2u q; q.x = pk2c(o[4 * g] * rstd * w4.x * bflo(gg.x), o[4 * g + 1] * rstd * w4.y * bfhi(gg.x)); q.y = pk2c(o[4 * g + 2] * rstd * w4.z * bflo(gg.y), o[4 * g + 3] * rstd * w4.w * bfhi(gg.y));
        *(GAS v2u*)(OUT + off) = q; }
    __syncthreads();
}
__device__ __forceinline__ void qknorm_row(bf16* row, const float* w, float scale, int lane) {
#pragma unroll
    for (int j = 0; j < 2; ++j) {
        GAS v4u* p = (GAS v4u*)(row + 8 * lane + 512 * j); const v4u x = *p;
        float f[8] = {bflo(x.x), bfhi(x.x), bflo(x.y), bfhi(x.y), bflo(x.z), bfhi(x.z), bflo(x.w), bfhi(x.w)};
        float ss = 0.f;
#pragma unroll
        for (int k = 0; k < 8; ++k) ss += f[k] * f[k];
        ss += __shfl_xor(ss, 1); ss += __shfl_xor(ss, 2); ss += __shfl_xor(ss, 4); ss += __shfl_xor(ss, 8);
        const float r = __builtin_amdgcn_rsqf(ss * (1.0f / 128.0f) + EPS) * scale;
        const f32x4 wa = *(const GAS f32x4*)(w + ((8 * lane) & 127)), wb = *(const GAS f32x4*)(w + ((8 * lane) & 127) + 4);
        v4u o; o.x = pk2c(f[0] * r * wa.x, f[1] * r * wa.y); o.y = pk2c(f[2] * r * wa.z, f[3] * r * wa.w); o.z = pk2c(f[4] * r * wb.x, f[5] * r * wb.y); o.w = pk2c(f[6] * r * wb.z, f[7] * r * wb.w);
        *p = o;
    }
}
__device__ __forceinline__ void vt_item(int item, int lane, const bf16* vsb, bf16* vt, LAS unsigned short* scr) {
    const int db = item & 3, sb = (item >> 2) & 63, bh = item >> 8, b = bh >> 3, h = bh & 7;
    const bf16* src = vsb + ((size_t)b * SEQ + sb * 64) * 1024 + h * 128 + db * 32;
#pragma unroll 4
    for (int i = 0; i < 16; ++i) { const int r = 4 * i + (lane >> 4); *(LAS unsigned*)(scr + r * 34 + 2 * (lane & 15)) = *(const GAS unsigned*)(src + (size_t)r * 1024 + 2 * (lane & 15)); }
    LDS_WAIT();
    const int c = lane & 7;
#pragma unroll
    for (int j = 0; j < 4; ++j) { const int d = (lane >> 3) + 8 * j; const LAS unsigned short* s = scr + (8 * c) * 34 + d;
        v4u o; o.x = (unsigned)s[0] | ((unsigned)s[34] << 16); o.y = (unsigned)s[68] | ((unsigned)s[102] << 16); o.z = (unsigned)s[136] | ((unsigned)s[170] << 16); o.w = (unsigned)s[204] | ((unsigned)s[238] << 16);
        *(GAS v4u*)(vt + ((size_t)bh * 128 + db * 32 + d) * SEQ + sb * 64 + 8 * c) = o; }
    LDS_WAIT();
}

__device__ __forceinline__ void attn_item(int bh, int qt, int lane, bf16* qo, const bf16* ksb, const bf16* vt) {
    const int b = bh >> 3, h = bh & 7, c = lane & 31, hf = lane >> 5;
    const size_t rb = (size_t)b * SEQ; const int t0 = qt * 32;
    bf16x8 qf[8];
    { const bf16* qrow = qo + (rb + t0 + c) * 1024 + h * 128 + 8 * hf;
#pragma unroll
      for (int kk = 0; kk < 8; ++kk) qf[kk] = *(const GAS bf16x8*)(qrow + 16 * kk); }
    f32x16 o[4];
#pragma unroll
    for (int d = 0; d < 4; ++d)
#pragma unroll
        for (int r = 0; r < 16; ++r) o[d][r] = 0.f;
    float R = 0.f;
    const bf16* vbase = vt + ((size_t)bh * 128 + c) * SEQ + 4 * hf;
    for (int kt = qt; kt >= 0; --kt) {
        const int s0 = kt * 32;
        const bf16* krow = ksb + (rb + s0 + c) * 1024 + h * 128 + 8 * hf;
        bf16x8 kf[8];
#pragma unroll
        for (int kk = 0; kk < 8; ++kk) kf[kk] = *(const GAS bf16x8*)(krow + 16 * kk);
        bf16x8 vf[4][2];
#pragma unroll
        for (int d = 0; d < 4; ++d)
#pragma unroll
            for (int sp = 0; sp < 2; ++sp) { const bf16* p = vbase + (size_t)d * 32 * SEQ + s0 + 16 * sp;
                const v2u lo = *(const GAS v2u*)p, hi = *(const GAS v2u*)(p + 8); v4u t; t.x = lo.x; t.y = lo.y; t.z = hi.x; t.w = hi.y; vf[d][sp] = __builtin_bit_cast(bf16x8, t); }
        f32x16 sa;
#pragma unroll
        for (int r = 0; r < 16; ++r) sa[r] = 0.f;
#pragma unroll
        for (int kk = 0; kk < 8; ++kk) sa = MFMA32(kf[kk], qf[kk], sa);
        const bool diag = (kt == qt);
        float lom[16];
#pragma unroll
        for (int r = 0; r < 16; ++r) {
            const float z = sa[r]; float l = -__logf(1.0f + __expf(z));
            if (diag && ((r & 3) + 8 * (r >> 2) + 4 * hf) >= c) l = 0.f;
            lom[r] = l;
        }
        float Gs[4], Gp[4];
#pragma unroll
        for (int g = 0; g < 4; ++g) { Gs[g] = (lom[4 * g] + lom[4 * g + 1]) + (lom[4 * g + 2] + lom[4 * g + 3]); Gp[g] = __shfl_xor(Gs[g], 32); }
        float tail = 0.f; float w[16];
#pragma unroll
        for (int g = 3; g >= 0; --g) {
            const float base = R + tail + (hf == 0 ? Gp[g] : 0.f);
            const float c3 = base, c2 = c3 + lom[4 * g + 3], c1 = c2 + lom[4 * g + 2], c0 = c1 + lom[4 * g + 1];
            w[4 * g + 3] = __expf(sa[4 * g + 3] + lom[4 * g + 3] + c3); w[4 * g + 2] = __expf(sa[4 * g + 2] + lom[4 * g + 2] + c2);
            w[4 * g + 1] = __expf(sa[4 * g + 1] + lom[4 * g + 1] + c1); w[4 * g] = __expf(sa[4 * g] + lom[4 * g] + c0);
            tail += Gs[g] + Gp[g];
        }
        if (diag) {
#pragma unroll
            for (int r = 0; r < 16; ++r) if (((r & 3) + 8 * (r >> 2) + 4 * hf) >= c) w[r] = 0.f;
        }
        R += tail;
        bf16x8 pf[2];
#pragma unroll
        for (int sp = 0; sp < 2; ++sp) { v4u t; t.x = pk2c(w[8 * sp], w[8 * sp + 1]); t.y = pk2c(w[8 * sp + 2], w[8 * sp + 3]); t.z = pk2c(w[8 * sp + 4], w[8 * sp + 5]); t.w = pk2c(w[8 * sp + 6], w[8 * sp + 7]); pf[sp] = __builtin_bit_cast(bf16x8, t); }
#pragma unroll
        for (int d = 0; d < 4; ++d)
#pragma unroll
            for (int sp = 0; sp < 2; ++sp) o[d] = MFMA32(vf[d][sp], pf[sp], o[d]);
    }
    bf16* orow = qo + (rb + t0 + c) * 1024 + h * 128 + 4 * hf;
#pragma unroll
    for (int d = 0; d < 4; ++d)
#pragma unroll
        for (int g = 0; g < 4; ++g) { v2u q; q.x = pk2c(o[d][4 * g], o[d][4 * g + 1]); q.y = pk2c(o[d][4 * g + 2], o[d][4 * g + 3]); *(GAS v2u*)(orow + 32 * d + 8 * g) = q; }
}
__device__ __forceinline__ void hgpost_row(bf16* row, const bf16* grow, const float* w, int lane) {
#pragma unroll
    for (int j = 0; j < 2; ++j) {
        GAS v4u* p = (GAS v4u*)(row + 8 * lane + 512 * j); const v4u x = *p; const v4u gg = *(const GAS v4u*)(grow + 8 * lane + 512 * j);
        float f[8] = {bflo(x.x), bfhi(x.x), bflo(x.y), bfhi(x.y), bflo(x.z), bfhi(x.z), bflo(x.w), bfhi(x.w)};
        const float g[8] = {bflo(gg.x), bfhi(gg.x), bflo(gg.y), bfhi(gg.y), bflo(gg.z), bfhi(gg.z), bflo(gg.w), bfhi(gg.w)};
        float ss = 0.f;
#pragma unroll
        for (int k = 0; k < 8; ++k) ss += f[k] * f[k];
        ss += __shfl_xor(ss, 1); ss += __shfl_xor(ss, 2); ss += __shfl_xor(ss, 4); ss += __shfl_xor(ss, 8);
        const float r = __builtin_amdgcn_rsqf(ss * (1.0f / 128.0f) + EPS);
        const f32x4 wa = *(const GAS f32x4*)(w + ((8 * lane) & 127)), wb = *(const GAS f32x4*)(w + ((8 * lane) & 127) + 4);
        v4u o; o.x = pk2c(f[0] * r * wa.x * g[0], f[1] * r * wa.y * g[1]); o.y = pk2c(f[2] * r * wa.z * g[2], f[3] * r * wa.w * g[3]);
        o.z = pk2c(f[4] * r * wb.x * g[4], f[5] * r * wb.y * g[5]); o.w = pk2c(f[6] * r * wb.z * g[6], f[7] * r * wb.w * g[7]);
        *p = o;
    }
}

template <bool FIRST> struct EpiMerge {
    static constexpr bool PERM = true, AFTER_DRAIN = false;
    const bf16* gate; bf16* merged;
    __device__ __forceinline__ void operator()(const pg8::f32x4 (&acc)[2][2][4][2], const pg8::Unit& u, int wr, int wc, int fr, int fq) const {
        const int row0 = u.pm * 256 + wr * 64 + fr, col0 = u.pn * 256 + wc * 32 + 8 * fq;
#pragma unroll
        for (int ai = 0; ai < 2; ++ai)
#pragma unroll
            for (int m = 0; m < 4; ++m) {
                if ((m & 1) == 0) asm volatile("" ::: "memory");
#pragma unroll
                for (int bj = 0; bj < 2; ++bj) {
                    const size_t off = (size_t)(row0 + ai * 128 + m * 16) * 2048 + col0 + bj * 128;
                    const v4u g = *(const GAS v4u*)(gate + off); const pg8::f32x4 v0 = acc[ai][bj][m][0], v1 = acc[ai][bj][m][1];
                    float r[8] = {bflo(g.x) * v0[0], bfhi(g.x) * v0[1], bflo(g.y) * v0[2], bfhi(g.y) * v0[3], bflo(g.z) * v1[0], bfhi(g.z) * v1[1], bflo(g.w) * v1[2], bfhi(g.w) * v1[3]};
                    if (!FIRST) { const v4u mo = *(const GAS v4u*)(merged + off);
                        r[0] += bflo(mo.x); r[1] += bfhi(mo.x); r[2] += bflo(mo.y); r[3] += bfhi(mo.y); r[4] += bflo(mo.z); r[5] += bfhi(mo.z); r[6] += bflo(mo.w); r[7] += bfhi(mo.w); }
                    v4u w; w.x = pk2c(r[0], r[1]); w.y = pk2c(r[2], r[3]); w.z = pk2c(r[4], r[5]); w.w = pk2c(r[6], r[7]);
                    *(GAS v4u*)(merged + off) = w; }
            }
    }
};
struct EpiResid {
    static constexpr bool PERM = false, AFTER_DRAIN = false;
    const float* xin; float* xout;
    __device__ __forceinline__ void operator()(const pg8::f32x4 (&acc)[2][2][4][2], const pg8::Unit& u, int wr, int wc, int fr, int fq) const {
        const int row0 = u.pm * 256 + wr * 64 + fr, col0 = u.pn * 256 + wc * 32 + 4 * fq;
#pragma unroll
        for (int ai = 0; ai < 2; ++ai)
#pragma unroll
            for (int m = 0; m < 4; ++m)
#pragma unroll
                for (int bj = 0; bj < 2; ++bj)
#pragma unroll
                    for (int n = 0; n < 2; ++n) { const size_t off = (size_t)(row0 + ai * 128 + m * 16) * 2048 + col0 + bj * 128 + n * 16;
                        f32x4 r = acc[ai][bj][m][n]; if (xin) r += *(const GAS f32x4*)(xin + off);
                        *(GAS f32x4*)(xout + off) = r; }
    }
};

__device__ __forceinline__ float rl_f(float v, int l) { return __uint_as_float((unsigned)__builtin_amdgcn_readlane((int)__float_as_uint(v), l)); }
__device__ __forceinline__ void ins16(float (&L)[16], float x) {
#pragma unroll
    for (int i = 0; i < 16; ++i) { const float hi = __builtin_fmaxf(L[i], x); x = __builtin_fminf(L[i], x); L[i] = hi; }
}
__device__ __forceinline__ void peer_top16(const float* qrow  , const bf16* kb  , int hf, float (&L)[16]) {
    bf16x8 qf[8];
#pragma unroll
    for (int kk = 0; kk < 8; ++kk) { const f32x4 a = *(const GAS f32x4*)(qrow + 16 * kk), b = *(const GAS f32x4*)(qrow + 16 * kk + 4);
        v4u t; t.x = pk2c(a.x, a.y); t.y = pk2c(a.z, a.w); t.z = pk2c(b.x, b.y); t.w = pk2c(b.z, b.w); qf[kk] = __builtin_bit_cast(bf16x8, t); }
#pragma unroll
    for (int i = 0; i < 16; ++i) L[i] = -__builtin_inff();
#pragma unroll 1
    for (int kt = 0; kt < 4; ++kt) {
        f32x16 sa;
#pragma unroll
        for (int r = 0; r < 16; ++r) sa[r] = 0.f;
#pragma unroll
        for (int kk = 0; kk < 8; ++kk) { const bf16x8 kf = *(const GAS bf16x8*)(kb + (size_t)kt * 32 * 128 + 16 * kk); sa = MFMA32(kf, qf[kk], sa); }
#pragma unroll
        for (int r = 0; r < 16; ++r) { const unsigned idx = (unsigned)(kt * 32 + (r & 3) + 8 * (r >> 2) + 4 * hf); ins16(L, __uint_as_float((__float_as_uint(sa[r]) & ~127u) | idx)); }
    }
    float P[16];
#pragma unroll
    for (int i = 0; i < 16; ++i) P[i] = __shfl_xor(L[i], 32);
#pragma unroll
    for (int i = 0; i < 16; ++i) ins16(L, P[i]);
}
__device__ __forceinline__ void peer_select32(int item, int lane, const float* qpeer, const bf16* KB, int* sel_e, float* sel_g, float* sel_s) {
    const int hd = item & 7, n0 = (item >> 3) * 32, c = lane & 31, hf = lane >> 5, n = n0 + c;
    const float* qrow = qpeer + (size_t)n * 2048 + hd * 256 + 8 * hf;
    float A[16], B[16];
    peer_top16(qrow, KB + (size_t)hd * 16384 + c * 128 + 8 * hf, hf, A);
    peer_top16(qrow + 128, KB + (size_t)(8 + hd) * 16384 + c * 128 + 8 * hf, hf, B);
    float Av[16], Bv[16]; int Ai[16], Bi[16];
#pragma unroll
    for (int i = 0; i < 16; ++i) { const unsigned a = __float_as_uint(A[i]), b = __float_as_uint(B[i]); Av[i] = __uint_as_float(a & ~127u); Bv[i] = __uint_as_float(b & ~127u); Ai[i] = (int)(a & 127u); Bi[i] = (int)(b & 127u); }
    float W[16];
#pragma unroll
    for (int i = 0; i < 16; ++i) W[i] = -__builtin_inff();
    { unsigned id = 0;
#pragma unroll
      for (int a = 0; a < 16; ++a)
#pragma unroll
        for (int b = 0; b < 16; ++b) if ((a + 1) * (b + 1) <= 16) { ins16(W, __uint_as_float((__float_as_uint(Av[a] + Bv[b]) & ~63u) | id)); ++id; } }
    const float thr = W[15], mx = W[0];
    int cnt = 0; float ssum = 0.f;
    GAS int* pe = (GAS int*)sel_e + (size_t)n * 128 + hd * 16; GAS float* pg = (GAS float*)sel_g + (size_t)n * 128 + hd * 16;
    { unsigned id = 0;
#pragma unroll
      for (int a = 0; a < 16; ++a)
#pragma unroll
        for (int b = 0; b < 16; ++b) if ((a + 1) * (b + 1) <= 16) {
            const float cv = Av[a] + Bv[b]; const float pk = __uint_as_float((__float_as_uint(cv) & ~63u) | id); ++id;
            if (pk >= thr) { const float e = __expf(cv - mx); if ((cnt & 1) == hf) { pe[cnt] = Ai[a] * 128 + Bi[b]; pg[cnt] = e; } ssum += e; ++cnt; }
        } }
    if (hf == 0) ((GAS float*)sel_s)[(size_t)n * 8 + hd] = ssum;
}

__device__ __forceinline__ float dot2bf(unsigned a, unsigned b, float acc) {
    return __builtin_amdgcn_fdot2_f32_bf16(__builtin_bit_cast(bf16v2, a), __builtin_bit_cast(bf16v2, b), acc, false);
}
__device__ __forceinline__ float dot8bf(const v4u a, const v4u b, float acc) {
    const unsigned a0 = a.x, a1 = a.y, a2 = a.z, a3 = a.w, b0 = b.x, b1 = b.y, b2 = b.z, b3 = b.w;
    acc = dot2bf(a0, b0, acc); acc = dot2bf(a1, b1, acc); acc = dot2bf(a2, b2, acc); acc = dot2bf(a3, b3, acc);
    return acc;
}
__device__ __forceinline__ void unpack16(const v4u q, float (&f)[16]) {
    const unsigned d0 = q.x, d1 = q.y, d2 = q.z, d3 = q.w;
    f32x2v t;
    t = __builtin_amdgcn_cvt_pk_f32_fp8((int)d0, false); f[0] = t.x; f[1] = t.y; t = __builtin_amdgcn_cvt_pk_f32_fp8((int)d0, true); f[2] = t.x; f[3] = t.y;
    t = __builtin_amdgcn_cvt_pk_f32_fp8((int)d1, false); f[4] = t.x; f[5] = t.y; t = __builtin_amdgcn_cvt_pk_f32_fp8((int)d1, true); f[6] = t.x; f[7] = t.y;
    t = __builtin_amdgcn_cvt_pk_f32_fp8((int)d2, false); f[8] = t.x; f[9] = t.y; t = __builtin_amdgcn_cvt_pk_f32_fp8((int)d2, true); f[10] = t.x; f[11] = t.y;
    t = __builtin_amdgcn_cvt_pk_f32_fp8((int)d3, false); f[12] = t.x; f[13] = t.y; t = __builtin_amdgcn_cvt_pk_f32_fp8((int)d3, true); f[14] = t.x; f[15] = t.y;
}
struct SliceSched { int mode, xcc, rank, nloc; };
__device__ __forceinline__ SliceSched slice_sched_init(const Ctx& c, unsigned* ctl, const XcdBarrier& bar, int use) {
    LAS int* sh = (LAS int*)(c.lds + 1024);
    if (c.tid == 0) {
        int ok = 1; unsigned tot = 0;
        for (int j = 0; j < 16; ++j) { const unsigned n = xb_ld(&bar.bar[XB_XCNT(j)]); tot += n; if ((j < 8) != (n > 0u)) ok = 0; }
        if (tot != (unsigned)c.G) ok = 0;
        const int xcc = (int)xb_xcc_id();
        int rank = 0, nloc = 1;
        if (ok) { nloc = (int)xb_ld(&bar.bar[XB_XCNT(xcc)]); rank = (int)xb_add(&ctl[CW_RANK + (use * 16 + xcc) * 64], 1u); if (rank >= nloc) ok = 0; }
        sh[0] = ok; sh[1] = xcc; sh[2] = rank; sh[3] = nloc;
    }
    __syncthreads();
    SliceSched S; S.mode = sh[0]; S.xcc = sh[1]; S.rank = sh[2]; S.nloc = sh[3];
    __syncthreads();
    return S;
}
__device__ __forceinline__ bool slice_item(const SliceSched& S, const Ctx& c, int i, int& slice, int& tb) {
    if (S.mode) { const int it = S.rank + i * S.nloc; if (it >= 512) return false; slice = S.xcc + 8 * (it >> 8); tb = it & 255; return true; }
    const int it = (int)blockIdx.x + i * c.G; if (it >= 4096) return false; slice = it >> 8; tb = it & 255; return true;
}
__device__ __forceinline__ void unpack16p(const v4u q, f32x2v (&f)[8]) {
    const unsigned d0 = q.x, d1 = q.y, d2 = q.z, d3 = q.w;
    f[0] = __builtin_amdgcn_cvt_pk_f32_fp8((int)d0, false); f[1] = __builtin_amdgcn_cvt_pk_f32_fp8((int)d0, true);
    f[2] = __builtin_amdgcn_cvt_pk_f32_fp8((int)d1, false); f[3] = __builtin_amdgcn_cvt_pk_f32_fp8((int)d1, true);
    f[4] = __builtin_amdgcn_cvt_pk_f32_fp8((int)d2, false); f[5] = __builtin_amdgcn_cvt_pk_f32_fp8((int)d2, true);
    f[6] = __builtin_amdgcn_cvt_pk_f32_fp8((int)d3, false); f[7] = __builtin_amdgcn_cvt_pk_f32_fp8((int)d3, true);
}
__device__ __forceinline__ void peer_sddmm_wave(int t0, int s, int lane, const bf16* H, const unsigned char* UQ, const int* sel_e, float* part, LAS unsigned* ldsw) {
    const int cg = lane & 7, sg = lane >> 3;
#pragma unroll
    for (int j = 0; j < 4; ++j) *(LAS v4u*)(ldsw + 4 * (lane + 64 * j)) = *(const GAS v4u*)(sel_e + (size_t)t0 * 128 + 4 * (lane + 64 * j));
    LDS_WAIT();
    const unsigned char* ubase = UQ + s * 128 + cg * 16;
    v4u qn[16];
    { int id[16];
#pragma unroll
      for (int q = 0; q < 4; ++q) { const v4u v = *(const LAS v4u*)(ldsw + sg * 16 + 4 * q); id[4 * q] = (int)v.x; id[4 * q + 1] = (int)v.y; id[4 * q + 2] = (int)v.z; id[4 * q + 3] = (int)v.w; }
#pragma unroll
      for (int it = 0; it < 16; ++it) qn[it] = *(const GAS v4u*)(ubase + (size_t)id[it] * 2048); }
#pragma unroll 1
    for (int k = 0; k < 8; ++k) {
        const int t = t0 + k;
        v4u qc[16];
#pragma unroll
        for (int it = 0; it < 16; ++it) qc[it] = qn[it];
        const v4u ha = *(const GAS v4u*)(H + (size_t)t * 2048 + s * 128 + cg * 16), hb = *(const GAS v4u*)(H + (size_t)t * 2048 + s * 128 + cg * 16 + 8);
        if (k < 7) { int id[16];
#pragma unroll
            for (int q = 0; q < 4; ++q) { const v4u v = *(const LAS v4u*)(ldsw + (k + 1) * 128 + sg * 16 + 4 * q); id[4 * q] = (int)v.x; id[4 * q + 1] = (int)v.y; id[4 * q + 2] = (int)v.z; id[4 * q + 3] = (int)v.w; }
#pragma unroll
            for (int it = 0; it < 16; ++it) qn[it] = *(const GAS v4u*)(ubase + (size_t)id[it] * 2048); }
        f32x2v h[8];
        h[0] = (f32x2v){bflo(ha.x), bfhi(ha.x)}; h[1] = (f32x2v){bflo(ha.y), bfhi(ha.y)}; h[2] = (f32x2v){bflo(ha.z), bfhi(ha.z)}; h[3] = (f32x2v){bflo(ha.w), bfhi(ha.w)};
        h[4] = (f32x2v){bflo(hb.x), bfhi(hb.x)}; h[5] = (f32x2v){bflo(hb.y), bfhi(hb.y)}; h[6] = (f32x2v){bflo(hb.z), bfhi(hb.z)}; h[7] = (f32x2v){bflo(hb.w), bfhi(hb.w)};
        float p[16];
#pragma unroll
        for (int it = 0; it < 16; ++it) { f32x2v f[8]; unpack16p(qc[it], f); f32x2v a = f[0] * h[0];
#pragma unroll
            for (int j = 1; j < 8; ++j) a = __builtin_elementwise_fma(f[j], h[j], a);
            p[it] = a.x + a.y; }
#pragma unroll
        for (int i = 0; i < 8; ++i) { const bool up = (lane & 4) != 0; const float snd = up ? p[i] : p[i + 8], kp = up ? p[i + 8] : p[i]; p[i] = kp + __shfl_xor(snd, 4); }
#pragma unroll
        for (int i = 0; i < 4; ++i) { const bool up = (lane & 2) != 0; const float snd = up ? p[i] : p[i + 4], kp = up ? p[i + 4] : p[i]; p[i] = kp + __shfl_xor(snd, 2); }
#pragma unroll
        for (int i = 0; i < 2; ++i) { const bool up = (lane & 1) != 0; const float snd = up ? p[i] : p[i + 2], kp = up ? p[i + 2] : p[i]; p[i] = kp + __shfl_xor(snd, 1); }
        f32x2v o; o.x = p[0]; o.y = p[1];
        *(GAS f32x2v*)(part + ((size_t)t * 16 + s) * 128 + 2 * lane) = o;
    }
    LDS_WAIT();
}
__device__ __forceinline__ void peer_coef_token(int t, int lane, const float* part, const int* sel_e, float* sel_g, const float* sel_s, const float* US, const float* VS) {
    float a0 = 0.f, a1 = 0.f;
#pragma unroll
    for (int s = 0; s < 16; ++s) { const f32x2v v = *(const GAS f32x2v*)(part + ((size_t)t * 16 + s) * 128 + 2 * lane); a0 += v.x; a1 += v.y; }
    const v2u e = *(const GAS v2u*)(sel_e + (size_t)t * 128 + 2 * lane);
    const f32x2v g = *(const GAS f32x2v*)(sel_g + (size_t)t * 128 + 2 * lane);
    const float inv = 1.0f / ((const GAS float*)sel_s)[(size_t)t * 8 + (lane >> 3)];
    f32x2v o; o.x = g.x * inv * gelu_exact(a0 * ((const GAS float*)US)[e.x]) * ((const GAS float*)VS)[e.x]; o.y = g.y * inv * gelu_exact(a1 * ((const GAS float*)US)[e.y]) * ((const GAS float*)VS)[e.y];
    *(GAS f32x2v*)(sel_g + (size_t)t * 128 + 2 * lane) = o;
}
__device__ __forceinline__ void peer_spmm_wave(int t0, int s, int lane, const unsigned char* VQ, const int* sel_e, const float* coef, const float* x1, float* xout, LAS unsigned* ldsw) {
    const int cg = lane & 7, sg = lane >> 3;
#pragma unroll
    for (int j = 0; j < 4; ++j) { *(LAS v4u*)(ldsw + 4 * (lane + 64 * j)) = *(const GAS v4u*)(sel_e + (size_t)t0 * 128 + 4 * (lane + 64 * j));
        *(LAS v4u*)(ldsw + 1024 + 4 * (lane + 64 * j)) = *(const GAS v4u*)(coef + (size_t)t0 * 128 + 4 * (lane + 64 * j)); }
    LDS_WAIT();
    const unsigned char* vbase = VQ + s * 128 + cg * 16;
    v4u qn[16];
    { int id[16];
#pragma unroll
      for (int q = 0; q < 4; ++q) { const v4u v = *(const LAS v4u*)(ldsw + sg * 16 + 4 * q); id[4 * q] = (int)v.x; id[4 * q + 1] = (int)v.y; id[4 * q + 2] = (int)v.z; id[4 * q + 3] = (int)v.w; }
#pragma unroll
      for (int it = 0; it < 16; ++it) qn[it] = *(const GAS v4u*)(vbase + (size_t)id[it] * 2048); }
#pragma unroll 1
    for (int k = 0; k < 8; ++k) {
        const int t = t0 + k;
        v4u qc[16];
#pragma unroll
        for (int it = 0; it < 16; ++it) qc[it] = qn[it];
        const size_t off = (size_t)t * 2048 + s * 128 + cg * 16 + 2 * sg;
        const f32x2v xv = *(const GAS f32x2v*)(x1 + off);
        float cf[16];
#pragma unroll
        for (int q = 0; q < 4; ++q) { const v4u w = *(const LAS v4u*)(ldsw + 1024 + k * 128 + sg * 16 + 4 * q); cf[4 * q] = __uint_as_float(w.x); cf[4 * q + 1] = __uint_as_float(w.y); cf[4 * q + 2] = __uint_as_float(w.z); cf[4 * q + 3] = __uint_as_float(w.w); }
        if (k < 7) { int id[16];
#pragma unroll
            for (int q = 0; q < 4; ++q) { const v4u v = *(const LAS v4u*)(ldsw + (k + 1) * 128 + sg * 16 + 4 * q); id[4 * q] = (int)v.x; id[4 * q + 1] = (int)v.y; id[4 * q + 2] = (int)v.z; id[4 * q + 3] = (int)v.w; }
#pragma unroll
            for (int it = 0; it < 16; ++it) qn[it] = *(const GAS v4u*)(vbase + (size_t)id[it] * 2048); }
        f32x2v y[8];
#pragma unroll
        for (int j = 0; j < 8; ++j) y[j] = (f32x2v){0.f, 0.f};
#pragma unroll
        for (int it = 0; it < 16; ++it) { f32x2v f[8]; unpack16p(qc[it], f); const f32x2v c2 = {cf[it], cf[it]};
#pragma unroll
            for (int j = 0; j < 8; ++j) y[j] = __builtin_elementwise_fma(f[j], c2, y[j]); }
        float yy[16];
#pragma unroll
        for (int j = 0; j < 8; ++j) { yy[2 * j] = y[j].x; yy[2 * j + 1] = y[j].y; }
#pragma unroll
        for (int i = 0; i < 8; ++i) { const bool up = (lane & 32) != 0; const float snd = up ? yy[i] : yy[i + 8], kp = up ? yy[i + 8] : yy[i]; yy[i] = kp + __shfl_xor(snd, 32); }
#pragma unroll
        for (int i = 0; i < 4; ++i) { const bool up = (lane & 16) != 0; const float snd = up ? yy[i] : yy[i + 4], kp = up ? yy[i + 4] : yy[i]; yy[i] = kp + __shfl_xor(snd, 16); }
#pragma unroll
        for (int i = 0; i < 2; ++i) { const bool up = (lane & 8) != 0; const float snd = up ? yy[i] : yy[i + 2], kp = up ? yy[i + 2] : yy[i]; yy[i] = kp + __shfl_xor(snd, 8); }
        f32x2v o; o.x = xv.x + yy[0]; o.y = xv.y + yy[1];
        *(GAS f32x2v*)(xout + off) = o;
    }
    LDS_WAIT();
}

struct Args { const float* in[21]; float* out; unsigned char* ws; int lo, hi, li, pad; };
__global__ void __launch_bounds__(512, 2) mk_fwd(Args args) {
    extern __shared__ __attribute__((aligned(16))) unsigned char lds_raw[];
    Ctx c; c.lds = (LAS unsigned char*)lds_raw; c.tid = threadIdx.x; c.lane = c.tid & 63; c.wave = __builtin_amdgcn_readfirstlane(c.tid >> 6);
    c.G = gridDim.x; c.gw = blockIdx.x * 8 + c.wave; c.NGW = c.G * 8;
    volatile LAS unsigned* MISC = (volatile LAS unsigned*)(c.lds + MISC_OFF);
    if (c.tid < 32) MISC[c.tid] = 0u;
    __syncthreads();
    unsigned char* ws = args.ws;
    const int lo = args.lo, hi = args.hi;
    XcdBarrier bar; bar.bar = (unsigned*)(ws + WS_CTL) + CW_BAR + args.li * XCD_BAR_WORDS; bar.x = 0; bar.st = nullptr;
    if (hi - lo > 1) bar = xcd_barrier_post((unsigned*)(ws + WS_CTL) + CW_BAR + args.li * XCD_BAR_WORDS, MISC + 8);
#ifndef PHMASK
#define PHMASK 0x1fff
#endif
#define IN(k) (((PHMASK >> ((k) % NPH)) & 1) && lo <= (k) && (k) < hi)
#define SEAM(k) do { if (IN(k) && IN((k) + 1)) xcd_barrier(bar); } while (0)
#define PH_BEGIN unsigned char* w = ws; float* outp = args.out; Ctx cc = c; int zi = 0; \
    asm volatile("" : "+s"(w), "+s"(outp), "+s"(zi), "+v"(cc.tid), "+v"(cc.lane)); (void)w; (void)outp;
#define INP(k) (args.in[(k) + zi])
#define WSP(T, off) ((T*)(w + (off)))
    for (int l = 0; l < 2; ++l) {
        const int pb = l * NPH;
        if (IN(pb + 0)) { PH_BEGIN
            P0Args a; a.w_in = INP(2) + (size_t)l * DM * INW; a.w_br_sb = INP(11) + (size_t)l * BW * DM; a.w_br_hg = INP(12) + (size_t)l * BW * DM; a.w_br_conv = INP(13) + (size_t)l * BW * DM;
            a.w_o = INP(14) + (size_t)l * DM * DM; a.w_q = INP(16) + (size_t)l * DM * DM; a.u = INP(19) + (size_t)l * 16384 * 2048; a.v = INP(20) + (size_t)l * 16384 * 2048; a.lbp = INP(5);
            a.WinT = WSP(bf16, WS_WIN); a.WbrT = WSP(bf16, WS_WBR); a.WoT = WSP(bf16, WS_WO); a.WqT = WSP(bf16, WS_WQ); a.U = WSP(unsigned char, WS_U); a.V = WSP(unsigned char, WS_V); a.US = WSP(float, WS_US); a.VS = WSP(float, WS_VS); a.LB = WSP(float, WS_LB); a.layer = l; a.k1 = INP(17) + (size_t)l * 8 * 16384; a.k2 = INP(18) + (size_t)l * 8 * 16384; a.KB = WSP(bf16, WS_KEYS);
            p0_convert(cc, a);
            rms_phase(cc, l == 0 ? INP(0) : WSP(const float, WS_X2), INP(1) + (size_t)l * DM, WSP(bf16, WS_H));
        }
        SEAM(pb + 0);
        if (IN(pb + 1)) { PH_BEGIN
            pg8::Gemm g{WSP(bf16, WS_H), WSP(bf16, WS_WIN), NTOK, INW, DM}; pg8::StaticOrder S; S.init(NTOK, INW, cc.G, (int)blockIdx.x);
            EpiIn E{WSP(bf16, WS_SEG), WSP(bf16, WS_GATE), WSP(float, WS_LB)};
            pg8::gemm_phase<EpiIn, pg8::StaticOrder, true, true>(cc.lds, g, S, E);
        }
        SEAM(pb + 1);
        if (IN(pb + 2)) { PH_BEGIN
            bf16* SEG = WSP(bf16, WS_SEG);
            conv_phase(cc, SEG + 7 * SEGSZ, INP(7) + (size_t)l * 31 * 1024, INP(8) + (size_t)l * 1024, INP(9) + (size_t)l * 1024, INP(10) + (size_t)l * 1024, WSP(bf16, WS_CONV));
            for (int ci = blockIdx.x; ci < 2048; ci += cc.G) hgA_chunk(cc, ci, SEG + 4 * SEGSZ, SEG + 5 * SEGSZ, WSP(bf16, WS_ST), WSP(float, WS_DEC));
            for (int r = cc.gw; r < 2 * NTOK; r += cc.NGW) {
                if (r < NTOK) qknorm_row(SEG + (size_t)r * 1024, INP(3) + (size_t)l * 128, 0.08838834764831845f, cc.lane);
                else qknorm_row(SEG + SEGSZ + (size_t)(r - NTOK) * 1024, INP(4) + (size_t)l * 128, 1.0f, cc.lane);
            }
            LAS unsigned short* scr = (LAS unsigned short*)(cc.lds + 4096 + cc.wave * 8192);
            for (int it = cc.gw; it < 8192; it += cc.NGW) vt_item(it, cc.lane, SEG + 2 * SEGSZ, WSP(bf16, WS_MERGED), scr);
        }
        SEAM(pb + 2);
        if (IN(pb + 3)) { PH_BEGIN
            bf16* SEG = WSP(bf16, WS_SEG);
            hgB(cc, WSP(bf16, WS_ST), WSP(float, WS_DEC));
            for (int p = cc.gw; p < 2048; p += cc.NGW) { const int bh = p >> 6, jj = p & 63; attn_item(bh, jj, cc.lane, SEG, SEG + SEGSZ, WSP(bf16, WS_MERGED)); attn_item(bh, 127 - jj, cc.lane, SEG, SEG + SEGSZ, WSP(bf16, WS_MERGED)); }
        }
        SEAM(pb + 3);
        if (IN(pb + 4)) { PH_BEGIN
            bf16* SEG = WSP(bf16, WS_SEG);
            for (int ci = blockIdx.x; ci < 2048; ci += cc.G) hgC_chunk(cc, ci, SEG + 3 * SEGSZ, SEG + 4 * SEGSZ, SEG + 5 * SEGSZ, SEG + 6 * SEGSZ, WSP(bf16, WS_ST), INP(6) + (size_t)l * 128, WSP(bf16, WS_HGR));
        }
        SEAM(pb + 4);
        if (IN(pb + 5)) { PH_BEGIN
            pg8::StaticOrder S; S.init(NTOK, DM, cc.G, (int)blockIdx.x);
            { pg8::Gemm g{WSP(bf16, WS_SEG), WSP(bf16, WS_WBR), NTOK, DM, BW}; EpiMerge<true> E{WSP(bf16, WS_GATE), WSP(bf16, WS_MERGED)}; pg8::gemm_phase<EpiMerge<true>, pg8::StaticOrder, true, true>(cc.lds, g, S, E); }
            { pg8::Gemm g{WSP(bf16, WS_HGR), WSP(bf16, WS_WBR) + (size_t)DM * BW, NTOK, DM, BW}; EpiMerge<false> E{WSP(bf16, WS_GATE) + (size_t)NTOK * 2048, WSP(bf16, WS_MERGED)}; pg8::gemm_phase<EpiMerge<false>, pg8::StaticOrder, true, true>(cc.lds, g, S, E); }
            { pg8::Gemm g{WSP(bf16, WS_CONV), WSP(bf16, WS_WBR) + (size_t)2 * DM * BW, NTOK, DM, BW}; EpiMerge<false> E{WSP(bf16, WS_GATE) + (size_t)2 * NTOK * 2048, WSP(bf16, WS_MERGED)}; pg8::gemm_phase<EpiMerge<false>, pg8::StaticOrder, true, true>(cc.lds, g, S, E); }
        }
        SEAM(pb + 5);
        if (IN(pb + 6)) { PH_BEGIN
            pg8::Gemm g{WSP(bf16, WS_MERGED), WSP(bf16, WS_WO), NTOK, DM, DM}; pg8::StaticOrder S; S.init(NTOK, DM, cc.G, (int)blockIdx.x);
            EpiResid E{l == 0 ? INP(0) : WSP(const float, WS_X2), outp};
            pg8::gemm_phase<EpiResid, pg8::StaticOrder, true, true>(cc.lds, g, S, E);
        }
        SEAM(pb + 6);
        if (IN(pb + 7)) { PH_BEGIN rms_phase(cc, outp, INP(15) + (size_t)l * DM, WSP(bf16, WS_H)); }
        SEAM(pb + 7);
        if (IN(pb + 8)) { PH_BEGIN
            pg8::Gemm g{WSP(bf16, WS_H), WSP(bf16, WS_WQ), NTOK, DM, DM}; pg8::StaticOrder S; S.init(NTOK, DM, cc.G, (int)blockIdx.x);
            EpiResid E{nullptr, WSP(float, WS_QPEER)};
            pg8::gemm_phase<EpiResid, pg8::StaticOrder, true, true>(cc.lds, g, S, E);
        }
        SEAM(pb + 8);
        if (IN(pb + 9)) { PH_BEGIN
            for (int it = cc.gw; it < (NTOK / 32) * 8; it += cc.NGW)
                peer_select32(it, cc.lane, WSP(float, WS_QPEER), WSP(bf16, WS_KEYS), WSP(int, WS_SEL), WSP(float, WS_SEL + 8 * MiB), WSP(float, WS_SELS));
        }
        SEAM(pb + 9);
        if (IN(pb + 10)) { PH_BEGIN
            const SliceSched SS = slice_sched_init(cc, (unsigned*)(w + WS_CTL), bar, l * 2 + 0);
            for (int i = 0;; ++i) { int sl, tb; if (!slice_item(SS, cc, i, sl, tb)) break;
                peer_sddmm_wave(tb * 64 + cc.wave * 8, sl, cc.lane, WSP(bf16, WS_H), WSP(unsigned char, WS_U), WSP(int, WS_SEL), WSP(float, WS_PART), (LAS unsigned*)(cc.lds + 4096 + cc.wave * 8192)); }
        }
        SEAM(pb + 10);
        if (IN(pb + 11)) { PH_BEGIN
            for (int n = cc.gw; n < NTOK; n += cc.NGW) peer_coef_token(n, cc.lane, WSP(float, WS_PART), WSP(int, WS_SEL), WSP(float, WS_SEL + 8 * MiB), WSP(float, WS_SELS), WSP(float, WS_US), WSP(float, WS_VS));
        }
        SEAM(pb + 11);
        if (IN(pb + 12)) { PH_BEGIN
            float* xo = l == 0 ? WSP(float, WS_X2) : outp;
            const SliceSched SS = slice_sched_init(cc, (unsigned*)(w + WS_CTL), bar, l * 2 + 1);
            for (int i = 0;; ++i) { int sl, tb; if (!slice_item(SS, cc, i, sl, tb)) break;
                peer_spmm_wave(tb * 64 + cc.wave * 8, sl, cc.lane, WSP(unsigned char, WS_V), WSP(int, WS_SEL), WSP(float, WS_SEL + 8 * MiB), outp, xo, (LAS unsigned*)(cc.lds + 4096 + cc.wave * 8192)); }
        }
        SEAM(pb + 12);
    }
#undef PH_BEGIN
#undef INP
#undef WSP
#undef IN
#undef SEAM
}

#ifndef MK_SPLIT
#define MK_SPLIT 0
#endif
extern "C" void kernel_launch(void* const* d_in, const int* in_sizes, int n_in, void* d_out, int out_size, void* d_ws, size_t ws_size, hipStream_t stream) {
    static int grid = 0;
    if (grid == 0) {
        if (n_in != 21 || out_size != NTOK * DM || ws_size < WS_END) { fprintf(stderr, "kernel_launch: unexpected shapes (n_in %d, out %d, ws %zu < %zu); nothing launched\n", n_in, out_size, ws_size, (size_t)WS_END); grid = -1; return; }
        int dev = 0, cus = 0, per_cu = 0;
        if (hipGetDevice(&dev) != hipSuccess || hipDeviceGetAttribute(&cus, hipDeviceAttributeMultiprocessorCount, dev) != hipSuccess) { grid = -1; return; }
        if (hipFuncSetAttribute((const void*)mk_fwd, hipFuncAttributeMaxDynamicSharedMemorySize, LDS_BYTES) != hipSuccess) { fprintf(stderr, "kernel_launch: hipFuncSetAttribute failed\n"); grid = -1; return; }
        if (hipOccupancyMaxActiveBlocksPerMultiprocessor(&per_cu, (const void*)mk_fwd, 512, LDS_BYTES) != hipSuccess || per_cu < 1) fprintf(stderr, "kernel_launch: occupancy query reports %d\n", per_cu);
        (void)hipGetLastError();
        grid = cus;
    }
    if (grid < 0) return;
    if (hipMemsetAsync((char*)d_ws + WS_CTL, 0, 1 * MiB, stream) != hipSuccess) { fprintf(stderr, "kernel_launch: memset failed\n"); return; }
    Args a{};
    for (int i = 0; i < 21; ++i) a.in[i] = (const float*)d_in[i];
    a.out = (float*)d_out; a.ws = (unsigned char*)d_ws; a.pad = 0;
#if MK_SPLIT
    for (int p = 0; p < NPHASES; ++p) { a.lo = p; a.hi = p + 1; a.li = p; hipLaunchKernelGGL(mk_fwd, dim3(grid), dim3(512), LDS_BYTES, stream, a); }
#else
    a.lo = 0; a.hi = NPHASES; a.li = 0;
    hipLaunchKernelGGL(mk_fwd, dim3(grid), dim3(512), LDS_BYTES, stream, a);
#endif
    const hipError_t le = hipPeekAtLastError();
    if (le != hipSuccess) fprintf(stderr, "kernel_launch: launch failed: %s\n", hipGetErrorName(le));
}
```

```cpp
#include <hip/hip_runtime.h>
#include <cstdio>
#include <cstdint>
namespace pg8 {
#define PG8_LAS __attribute__((address_space(3)))
typedef unsigned short bf16_t;
typedef short bf16x8 __attribute__((ext_vector_type(8)));
typedef float f32x4 __attribute__((ext_vector_type(4)));
typedef unsigned u32x4 __attribute__((ext_vector_type(4)));
constexpr int BM = 256, BK = 64, HALF = 128, HTB = HALF * BK * 2  , STAGE_BYTES = 8 * HTB, NXCD = 8, WGM = 8;

__host__ __device__ __forceinline__ int lds_byte(int r, int c) { const int st = (r >> 4) * 2 + (c >> 5), rr = r & 15, cc = c & 31, ob = rr * 64 + cc * 2; return st * 1024 + (ob ^ (((ob >> 9) & 1) << 5)); }
__host__ __device__ __forceinline__ void stage_rc(int b, int& R, int& C) { const int st = b / 1024, sb = b % 1024, swz = sb ^ (((sb >> 9) & 1) << 5); R = (st >> 1) * 16 + swz / 64; C = (st & 1) * 32 + (swz % 64) / 2; }
__host__ __device__ __forceinline__ int perm32(int rho) { const int n = rho >> 4, i = rho & 15; return 8 * (i >> 2) + 4 * n + (i & 3); }

struct Unit { int pm, pn; };
struct Gemm { const bf16_t* A; const bf16_t* Bt; int M, N, K; };

struct StaticOrder {
    int nM, nN, nwg, G, c;
    __host__ __device__ void init(int M, int N, int G_, int c_) { nM = M / BM; nN = N / BM; nwg = nM * nN; G = G_; c = c_; }
    __host__ __device__ bool next(int i, Unit& u) const {
        const long L = (long)i * G + c; if (L >= nwg) return false;
        int wgid = (int)L; { const int q = nwg / NXCD, r = nwg % NXCD, xcd = wgid % NXCD, off = wgid / NXCD; wgid = (xcd < r ? xcd * (q + 1) : r * (q + 1) + (xcd - r) * q) + off; }
        const int nig = WGM * nN, gid = wgid / nig, fm = gid * WGM, gsz = (nM - fm) < WGM ? (nM - fm) : WGM;
        u.pm = fm + ((wgid % nig) % gsz); u.pn = (wgid % nig) / gsz; return true;
    }
    __device__ __forceinline__ void a_ready(const Unit&) const {}
    __device__ __forceinline__ void done(const Unit&) const {}
};

typedef float f32x2 __attribute__((ext_vector_type(2)));
template <class Epi, class Sched, bool ALIGN_EPI = false, bool SP2 = false, bool I8 = false>
__device__ __forceinline__ void gemm_phase(PG8_LAS unsigned char* lds, const Gemm g, const Sched& S, const Epi& E) {
    int tid_ = threadIdx.x; asm volatile("" : "+v"(tid_)); int K_ = g.K; asm volatile("" : "+s"(K_));
    const int tid = tid_, wid = __builtin_amdgcn_readfirstlane(tid >> 6), lane = tid & 63, wr = wid >> 2, wc = wid & 3, fr = lane & 15, fq = lane >> 4;
    const int K = I8 ? (K_ >> 1) : K_, nt = K / BK;
    unsigned voffA[2], voffB[2];
#pragma unroll
    for (int i = 0; i < 2; ++i) { int R, C; stage_rc(tid * 16 + i * 8192, R, C); const int Rb = Epi::PERM ? ((R & ~31) + perm32(R & 31)) : R;
        voffA[i] = (unsigned)(R * K + C) * 2u; voffB[i] = (unsigned)(Rb * K + C) * 2u; }
    const size_t kstep = (size_t)(BK * 2);
    const size_t hstep = (size_t)HALF * K * 2;
    const size_t tstep = 2 * hstep;
    const unsigned ldsw = (unsigned)wid * 1024u;
    const int aoff = lds_byte(wr * 64 + fr, fq * 8), boff = lds_byte(wc * 32 + fr, fq * 8);
#define PG8_SA(b, h) (((b) * 2 + (h)) * HTB)
#define PG8_SB(b, h) ((4 + (b) * 2 + (h)) * HTB)
#define PG8_STAGE(bufoff, gbase, voff) do { _Pragma("unroll") for (int _i = 0; _i < 2; ++_i) \
        __builtin_amdgcn_global_load_lds((const unsigned*)((const char*)(gbase) + (voff)[_i]), (PG8_LAS unsigned*)(lds + (bufoff) + ldsw + _i * 8192), 16, 0, 0); } while (0)
#define PG8_LDA(dst, b, h) do { _Pragma("unroll") for (int m = 0; m < 4; ++m) _Pragma("unroll") for (int k = 0; k < 2; ++k) dst[m][k] = *(const PG8_LAS bf16x8*)(lds + PG8_SA(b, h) + aoff + m * 2048 + k * 1024); } while (0)
#define PG8_LDB(dst, b, h) do { _Pragma("unroll") for (int n = 0; n < 2; ++n) _Pragma("unroll") for (int k = 0; k < 2; ++k) dst[n][k] = *(const PG8_LAS bf16x8*)(lds + PG8_SB(b, h) + boff + n * 2048 + k * 1024); } while (0)
#define PG8_MMA(ai, bj, At, Bt) do { __builtin_amdgcn_s_setprio(1); _Pragma("unroll") for (int m = 0; m < 4; ++m) _Pragma("unroll") for (int n = 0; n < 2; ++n) _Pragma("unroll") for (int k = 0; k < 2; ++k) { \
        if constexpr (I8) { typedef int v4i_t __attribute__((ext_vector_type(4))); \
            acc[ai][bj][m][n] = __builtin_bit_cast(f32x4, __builtin_amdgcn_mfma_i32_16x16x64_i8(__builtin_bit_cast(v4i_t, Bt[n][k]), __builtin_bit_cast(v4i_t, At[m][k]), __builtin_bit_cast(v4i_t, acc[ai][bj][m][n]), 0, 0, 0)); } \
        else acc[ai][bj][m][n] = __builtin_amdgcn_mfma_f32_16x16x32_bf16(Bt[n][k], At[m][k], acc[ai][bj][m][n], 0, 0, 0); } __builtin_amdgcn_s_setprio(0); } while (0)
#define PG8_WAIT_V(n) asm volatile("s_waitcnt vmcnt(" #n ")" ::: "memory")
#define PG8_WAIT_L(n) asm volatile("s_waitcnt lgkmcnt(" #n ")" ::: "memory")
#define PG8_BAR __builtin_amdgcn_s_barrier()
#define PG8_SCHED __builtin_amdgcn_sched_barrier(0)
    Unit cur, nxt; int ui = 0;
    if (!S.next(0, cur)) return;
    f32x4 acc[2][2][4][2];
#pragma unroll
    for (int a = 0; a < 2; ++a)
#pragma unroll
        for (int b = 0; b < 2; ++b)
#pragma unroll
            for (int m = 0; m < 4; ++m)
#pragma unroll
                for (int n = 0; n < 2; ++n) acc[a][b][m][n] = (f32x4){0.f, 0.f, 0.f, 0.f};
    bf16x8 At[4][2], B0[2][2], B1[2][2];
    const char* cA = (const char*)g.A + (size_t)cur.pm * tstep; const char* cB = (const char*)g.Bt + (size_t)cur.pn * tstep;
    S.a_ready(cur);
    if constexpr (SP2) {
        PG8_STAGE(PG8_SB(0, 0), cB, voffB); PG8_STAGE(PG8_SB(0, 1), cB + hstep, voffB); PG8_STAGE(PG8_SA(0, 0), cA, voffA); PG8_STAGE(PG8_SA(0, 1), cA + hstep, voffA);
        if (wr == 1) PG8_BAR;
        PG8_WAIT_V(2); PG8_BAR;
        PG8_STAGE(PG8_SB(1, 0), cB + kstep, voffB); PG8_STAGE(PG8_SA(1, 0), cA + kstep, voffA); PG8_STAGE(PG8_SB(1, 1), cB + hstep + kstep, voffB);
        PG8_WAIT_V(6); PG8_BAR;
    } else {
        PG8_STAGE(PG8_SB(0, 0), cB, voffB); PG8_STAGE(PG8_SA(0, 0), cA, voffA); PG8_STAGE(PG8_SB(0, 1), cB + hstep, voffB); PG8_STAGE(PG8_SA(0, 1), cA + hstep, voffA);
        if (wr == 1) PG8_BAR;
        PG8_WAIT_V(4); PG8_BAR;
        PG8_STAGE(PG8_SB(1, 0), cB + kstep, voffB); PG8_STAGE(PG8_SA(1, 0), cA + kstep, voffA); PG8_STAGE(PG8_SB(1, 1), cB + hstep + kstep, voffB);
        PG8_WAIT_V(6); PG8_BAR;
    }
    for (;;) {
        const bool has_next = S.next(ui + 1, nxt);
        const char* nA = has_next ? (const char*)g.A + (size_t)nxt.pm * tstep : cA; const char* nB = has_next ? (const char*)g.Bt + (size_t)nxt.pn * tstep : cB;
        for (int t = 0; t < nt; t += 2) {
            const bool last = (t == nt - 2);
            const char* a1 = cA + (size_t)(t + 1) * kstep;
            const char* a2 = last ? nA : cA + (size_t)(t + 2) * kstep; const char* b2 = last ? nB : cB + (size_t)(t + 2) * kstep;
            const char* a3 = a2 + kstep; const char* b3 = b2 + kstep;
            if (last && has_next) S.a_ready(nxt);
            if constexpr (SP2) {
            PG8_LDB(B0, 0, 0); PG8_LDB(B1, 0, 1); PG8_SCHED; PG8_LDA(At, 0, 0); PG8_STAGE(PG8_SA(1, 1), a1 + hstep, voffA);
            PG8_WAIT_V(8); PG8_WAIT_L(0); PG8_BAR; PG8_MMA(0, 0, At, B0); PG8_MMA(0, 1, At, B1); PG8_BAR; PG8_SCHED;
            PG8_LDA(At, 0, 1); PG8_STAGE(PG8_SB(0, 0), b2, voffB); PG8_STAGE(PG8_SB(0, 1), b2 + hstep, voffB); PG8_STAGE(PG8_SA(0, 0), a2, voffA);
            PG8_WAIT_V(8); PG8_WAIT_L(0); PG8_BAR; PG8_MMA(1, 0, At, B0); PG8_MMA(1, 1, At, B1); PG8_BAR; PG8_SCHED;
            PG8_LDB(B0, 1, 0); PG8_LDB(B1, 1, 1); PG8_SCHED; PG8_LDA(At, 1, 0); PG8_STAGE(PG8_SA(0, 1), a2 + hstep, voffA);
            PG8_WAIT_V(8); PG8_WAIT_L(0); PG8_BAR; PG8_MMA(0, 0, At, B0); PG8_MMA(0, 1, At, B1); PG8_BAR; PG8_SCHED;
            PG8_LDA(At, 1, 1); PG8_STAGE(PG8_SB(1, 0), b3, voffB); PG8_STAGE(PG8_SB(1, 1), b3 + hstep, voffB); PG8_STAGE(PG8_SA(1, 0), a3, voffA);
            PG8_WAIT_V(8); PG8_WAIT_L(0); PG8_BAR; PG8_MMA(1, 0, At, B0); PG8_MMA(1, 1, At, B1); PG8_BAR; PG8_SCHED;
            } else {
            PG8_LDB(B0, 0, 0); PG8_SCHED; PG8_LDA(At, 0, 0); PG8_STAGE(PG8_SA(1, 1), a1 + hstep, voffA);
            PG8_WAIT_L(8); PG8_BAR; PG8_WAIT_L(0); PG8_MMA(0, 0, At, B0); PG8_BAR; PG8_SCHED;
            PG8_LDB(B1, 0, 1); PG8_STAGE(PG8_SB(0, 0), b2, voffB);
            PG8_BAR; PG8_WAIT_L(0); PG8_MMA(0, 1, At, B1); PG8_BAR;
            PG8_LDA(At, 0, 1); PG8_STAGE(PG8_SA(0, 0), a2, voffA);
            PG8_BAR; PG8_WAIT_L(0); PG8_MMA(1, 0, At, B0); PG8_BAR; PG8_SCHED;
            PG8_STAGE(PG8_SB(0, 1), b2 + hstep, voffB);
            PG8_WAIT_V(6); PG8_BAR; PG8_MMA(1, 1, At, B1); PG8_BAR;
            PG8_LDB(B0, 1, 0); PG8_SCHED; PG8_LDA(At, 1, 0); PG8_STAGE(PG8_SA(0, 1), a2 + hstep, voffA);
            PG8_WAIT_L(8); PG8_BAR; PG8_WAIT_L(0); PG8_MMA(0, 0, At, B0); PG8_BAR; PG8_SCHED;
            PG8_LDB(B1, 1, 1); PG8_STAGE(PG8_SB(1, 0), b3, voffB);
            PG8_BAR; PG8_WAIT_L(0); PG8_MMA(0, 1, At, B1); PG8_BAR;
            PG8_LDA(At, 1, 1); PG8_STAGE(PG8_SA(1, 0), a3, voffA);
            PG8_BAR; PG8_WAIT_L(0); PG8_MMA(1, 0, At, B0); PG8_BAR; PG8_SCHED;
            PG8_STAGE(PG8_SB(1, 1), b3 + hstep, voffB);
            PG8_WAIT_V(6); PG8_BAR; PG8_MMA(1, 1, At, B1); PG8_BAR;
            }
        }
        if constexpr (ALIGN_EPI) { if (wr == 0) PG8_BAR; }
        if constexpr (!Epi::AFTER_DRAIN) { E(acc, cur, wr, wc, fr, fq); S.done(cur); }
        if (!has_next) break;
#pragma unroll
        for (int a = 0; a < 2; ++a)
#pragma unroll
            for (int b = 0; b < 2; ++b)
#pragma unroll
                for (int m = 0; m < 4; ++m)
#pragma unroll
                    for (int n = 0; n < 2; ++n) acc[a][b][m][n] = (f32x4){0.f, 0.f, 0.f, 0.f};
        cur = nxt; cA = nA; cB = nB; ++ui;
        if constexpr (ALIGN_EPI) { if (wr == 1) PG8_BAR; }
    }
    PG8_WAIT_V(0);
    if constexpr (!ALIGN_EPI) { if (wr == 0) PG8_BAR; }
    PG8_BAR;
    if constexpr (Epi::AFTER_DRAIN) { E.fused(acc, cur, wr, wc, fr, fq, lds, wid, lane); S.done(cur); }
#undef PG8_SA
#undef PG8_SB
#undef PG8_STAGE
#undef PG8_LDA
#undef PG8_LDB
#undef PG8_MMA
#undef PG8_WAIT_V
#undef PG8_WAIT_L
#undef PG8_BAR
#undef PG8_SCHED
}
}
#define XB_TMO      128
#define XB_XCNT(j)  (256  + 64 * (j))
#define XB_XSUB(j)  (1280 + 64 * (j))
#define XB_XGEN(j)  (2304 + 64 * (j))
#define XB_TOP      3328
#define XB_TOPGEN   3392
#define XCD_BAR_WORDS 3456
#define XB_SPIN_CAP (1u << 24)
#define LAS __attribute__((address_space(3)))

__device__ __forceinline__ unsigned xb_ld(unsigned* p)              { return __hip_atomic_load(p, __ATOMIC_RELAXED, __HIP_MEMORY_SCOPE_AGENT); }
__device__ __forceinline__ unsigned xb_add(unsigned* p, unsigned v) { return __hip_atomic_fetch_add(p, v, __ATOMIC_RELAXED, __HIP_MEMORY_SCOPE_AGENT); }
__device__ __forceinline__ unsigned xb_xcc_id() { return (unsigned)__builtin_amdgcn_s_getreg((3 << 11) | 20) & 0xFu; }
#define XB_SPIN(cond, bar) do { unsigned _sp = 0; while (cond) { __builtin_amdgcn_s_sleep(1); \
    if ((++_sp & 255u) == 0u) { if (xb_ld(&(bar)[XB_TMO])) break; if (_sp > XB_SPIN_CAP) { atomicAdd(&(bar)[XB_TMO], 1u); break; } } } } while (0)

struct XcdBarrier {
    unsigned* bar; unsigned x;
    volatile LAS unsigned* st;
};

__device__ __forceinline__ XcdBarrier xcd_barrier_post(unsigned* bar, volatile LAS unsigned* st) {
    XcdBarrier b; b.bar = bar; b.x = xb_xcc_id(); b.st = st;
    if (threadIdx.x == 0) (void)xb_add(&bar[XB_XCNT(b.x)], 1u);
    return b;
}
__device__ __forceinline__ void xcd_barrier_complete(unsigned* bar, unsigned x, unsigned& nloc, unsigned& nx) {
    const unsigned G = gridDim.x * gridDim.y * gridDim.z;
    unsigned sum, cnt, mine, sp = 0u;
    for (;;) {
        sum = 0u; cnt = 0u; mine = 0u;
#pragma unroll
        for (unsigned j = 0; j < 16; ++j) { const unsigned c = xb_ld(&bar[XB_XCNT(j)]); sum += c; cnt += (c > 0u) ? 1u : 0u; mine = (j == x) ? c : mine; }
        if (sum == G) break;
        __builtin_amdgcn_s_sleep(1);
        if ((++sp & 255u) == 0u) { if (xb_ld(&bar[XB_TMO])) break; if (sp > XB_SPIN_CAP) { atomicAdd(&bar[XB_TMO], 1u); break; } }
    }
    nloc = mine > 0u ? mine : 1u; nx = cnt > 0u ? cnt : 1u;
}

__device__ __forceinline__ void xcd_barrier(const XcdBarrier& b) {
    asm volatile("s_waitcnt vmcnt(0)" ::: "memory");
    __syncthreads();
    if (threadIdx.x == 0) {
        unsigned* bar = b.bar;
        __builtin_amdgcn_s_waitcnt(0);
        unsigned nloc = b.st[0], nx = b.st[1];
        if (nloc == 0u) { xcd_barrier_complete(bar, b.x, nloc, nx); b.st[0] = nloc; b.st[1] = nx; }
        const unsigned old = xb_add(&bar[XB_XSUB(b.x)], 1u);
        const unsigned gen = old / nloc;
        if (old + 1u == (gen + 1u) * nloc) {
            __builtin_amdgcn_fence(__ATOMIC_RELEASE, "agent");
            asm volatile("s_waitcnt vmcnt(0)" ::: "memory");
            const unsigned og = xb_add(&bar[XB_TOP], 1u);
            const unsigned tg = og / nx;
            if (og + 1u == (tg + 1u) * nx) xb_add(&bar[XB_TOPGEN], 1u);
            else XB_SPIN(xb_ld(&bar[XB_TOPGEN]) == tg, bar);
            __builtin_amdgcn_fence(__ATOMIC_ACQUIRE, "agent");
            xb_add(&bar[XB_XGEN(b.x)], 1u);
            asm volatile("s_waitcnt vmcnt(0)" ::: "memory");
        } else {
            XB_SPIN(xb_ld(&bar[XB_XGEN(b.x)]) == gen, bar);
            __builtin_amdgcn_fence(__ATOMIC_ACQUIRE, "agent");
            asm volatile("s_waitcnt vmcnt(0)" ::: "memory");
        }
    }
    __syncthreads();
}


#define GAS __attribute__((address_space(1)))
typedef unsigned short bf16;
typedef unsigned v4u __attribute__((ext_vector_type(4)));
typedef unsigned v2u __attribute__((ext_vector_type(2)));
typedef float f32x4 __attribute__((ext_vector_type(4)));
typedef float f32x2v __attribute__((ext_vector_type(2)));
typedef float f32x16 __attribute__((ext_vector_type(16)));
typedef short bf16x8 __attribute__((ext_vector_type(8)));
typedef __bf16 bf16v2 __attribute__((ext_vector_type(2)));

constexpr int NTOK = 16384, DM = 2048, SEQ = 4096, INW = 15360, BW = 1024;
constexpr float EPS = 1e-6f;
constexpr float WIN_QS = 1024.0f;
constexpr int NPH = 13;
constexpr int NPHASES = 2 * NPH;

constexpr size_t MiB = 1u << 20;
constexpr size_t WS_CTL = 0;
constexpr size_t WS_LB = 1 * MiB;
constexpr size_t WS_SA = 1 * MiB + 192 * 1024;
constexpr size_t WS_US = 1 * MiB + 64 * 1024, WS_VS = 1 * MiB + 128 * 1024;
constexpr size_t WS_WIN = 2 * MiB;
constexpr size_t WS_WBR = 62 * MiB;
constexpr size_t WS_WO = 74 * MiB;
constexpr size_t WS_WQ = 82 * MiB;
constexpr size_t WS_U = 91 * MiB;
constexpr size_t WS_V = 155 * MiB;
constexpr size_t WS_H = 219 * MiB;
constexpr size_t WS_SEG = 283 * MiB;
constexpr size_t WS_GATE = 539 * MiB;
constexpr size_t WS_X2 = 731 * MiB;
constexpr size_t WS_CONV = 859 * MiB;
constexpr size_t WS_HGR = 891 * MiB;
constexpr size_t WS_MERGED = 923 * MiB;
constexpr size_t WS_SEL = 987 * MiB;
constexpr size_t WS_SELS = 1003 * MiB;
constexpr size_t WS_DEC = 1004 * MiB;
constexpr size_t WS_END = 1005 * MiB;
constexpr size_t WS_ST = WS_H;
constexpr size_t WS_KEYS = 90 * MiB;
constexpr size_t WS_PART = WS_GATE;
constexpr size_t WS_QPEER = WS_SEG;
constexpr size_t SEGSZ = (size_t)NTOK * 1024;
constexpr int CW_BAR = 4096;
constexpr int CW_RANK = 131072;

constexpr int RING_BYTES = 131072, MISC_OFF = RING_BYTES + 320, LDS_BYTES = 147456;

__device__ __forceinline__ unsigned pk2c(float lo, float hi) { f32x2v v = {lo, hi}; bf16v2 b = __builtin_convertvector(v, bf16v2); return __builtin_bit_cast(unsigned, b); }
__device__ __forceinline__ float bflo(unsigned x) { return __uint_as_float(x << 16); }
__device__ __forceinline__ float bfhi(unsigned x) { return __uint_as_float(x & 0xffff0000u); }
__device__ __forceinline__ float sigm(float x) { return __builtin_amdgcn_rcpf(1.0f + __expf(-x)); }
__device__ __forceinline__ float wave_sum(float v) {
#pragma unroll
    for (int o = 1; o < 64; o <<= 1) v += __shfl_xor(v, o);
    return v;
}
__device__ __forceinline__ float wave_max(float v) {
#pragma unroll
    for (int o = 1; o < 64; o <<= 1) v = fmaxf(v, __shfl_xor(v, o));
    return v;
}
#define LDS_WAIT() asm volatile("s_waitcnt lgkmcnt(0)" ::: "memory")
#define MFMA32(a, b, c) __builtin_amdgcn_mfma_f32_32x32x16_bf16((a), (b), (c), 0, 0, 0)
__device__ __forceinline__ int ridx16(int lane) { return ((lane >> 5) & 1) * 8 + ((lane >> 4) & 1) * 4 + ((lane >> 3) & 1) * 2 + ((lane >> 2) & 1); }
__device__ __forceinline__ void xreduce16(float (&v)[16], int lane) {
#pragma unroll
    for (int i = 0; i < 8; ++i) { const bool up = (lane & 32) != 0; const float snd = up ? v[i] : v[i + 8], kp = up ? v[i + 8] : v[i]; v[i] = kp + __shfl_xor(snd, 32); }
#pragma unroll
    for (int i = 0; i < 4; ++i) { const bool up = (lane & 16) != 0; const float snd = up ? v[i] : v[i + 4], kp = up ? v[i + 4] : v[i]; v[i] = kp + __shfl_xor(snd, 16); }
#pragma unroll
    for (int i = 0; i < 2; ++i) { const bool up = (lane & 8) != 0; const float snd = up ? v[i] : v[i + 2], kp = up ? v[i + 2] : v[i]; v[i] = kp + __shfl_xor(snd, 8); }
    { const bool up = (lane & 4) != 0; const float snd = up ? v[0] : v[1], kp = up ? v[1] : v[0]; v[0] = kp + __shfl_xor(snd, 4); }
    v[0] += __shfl_xor(v[0], 2); v[0] += __shfl_xor(v[0], 1);
}
__device__ __forceinline__ float gelu_exact(float v) {
    const float av = fabsf(v), t = __builtin_amdgcn_rcpf(av * 0.2316418882f + 1.0f);
    float q = t * 0.5307027145f + (-0.7265760135f); q = q * t + 0.7107068705f; q = q * t + (-0.142248368f); q = q * t + 0.127414796f; q = q * t;
    const float e = __builtin_amdgcn_exp2f((v * v) * (-0.72134752044f));
    const float m = v * (q * e);
    return v < 0.f ? m : v - m;
}

struct Ctx { LAS unsigned char* lds; int tid, lane, wave, G, gw, NGW; };

__device__ __forceinline__ void tr_item(const float* W, int K, int N, bf16* WT, int k0, int n0, int drow0, LAS float* scr, int lane) {
#pragma unroll 8
    for (int i = 0; i < 32; ++i) { const int kk = 2 * i + (lane >> 5); scr[kk * 33 + (lane & 31)] = ((const GAS float*)W)[(size_t)(k0 + kk) * N + n0 + (lane & 31)]; }
    LDS_WAIT();
    const int c = lane & 7;
#pragma unroll
    for (int j = 0; j < 4; ++j) { const int n = (lane >> 3) + 8 * j; const LAS float* s = scr + (8 * c) * 33 + n;
        v4u o; o.x = pk2c(s[0], s[33]); o.y = pk2c(s[66], s[99]); o.z = pk2c(s[132], s[165]); o.w = pk2c(s[198], s[231]);
        *(GAS v4u*)(WT + (size_t)(drow0 + n) * K + k0 + 8 * c) = o; }
    LDS_WAIT();
}
__device__ __forceinline__ unsigned pack_i8x4c(float a, float b, float c, float d) {
    const int ia = (int)__builtin_rintf(fminf(fmaxf(a, -127.f), 127.f)), ib = (int)__builtin_rintf(fminf(fmaxf(b, -127.f), 127.f)), ic = (int)__builtin_rintf(fminf(fmaxf(c, -127.f), 127.f)), id = (int)__builtin_rintf(fminf(fmaxf(d, -127.f), 127.f));
    return ((unsigned)ia & 255u) | (((unsigned)ib & 255u) << 8) | (((unsigned)ic & 255u) << 16) | ((unsigned)id << 24);
}
__device__ __forceinline__ void tr_item_i8(const float* W, int K, int N, unsigned char* WT, int k0, int n0, int drow0, float scale, LAS float* scr, int lane) {
#pragma unroll 8
    for (int i = 0; i < 32; ++i) { const int kk = 2 * i + (lane >> 5); scr[kk * 33 + (lane & 31)] = ((const GAS float*)W)[(size_t)(k0 + kk) * N + n0 + (lane & 31)]; }
    LDS_WAIT();
    const int c = lane & 7;
#pragma unroll
    for (int j = 0; j < 4; ++j) { const int n = (lane >> 3) + 8 * j; const LAS float* s = scr + (8 * c) * 33 + n;
        v2u o; o.x = pack_i8x4c(s[0] * scale, s[33] * scale, s[66] * scale, s[99] * scale); o.y = pack_i8x4c(s[132] * scale, s[165] * scale, s[198] * scale, s[231] * scale);
        *(GAS v2u*)(WT + (size_t)(drow0 + n) * K + k0 + 8 * c) = o; }
    LDS_WAIT();
}
__device__ __forceinline__ int win_drow(int n) { if (n < 7168 || n >= 9216) return n; const int r = n - 7168, isb = r >> 10, c = r & 1023; return 7168 + (c >> 7) * 256 + isb * 128 + (c & 127); }
__device__ __forceinline__ void cvt_copy(const Ctx& c, const float* src, bf16* dst, size_t n8) {
    const size_t NT = (size_t)c.G * 512;
    for (size_t i = (size_t)blockIdx.x * 512 + c.tid; i < n8; i += NT) {
        const f32x4 a = ((const GAS f32x4*)src)[2 * i], b = ((const GAS f32x4*)src)[2 * i + 1];
        v4u o; o.x = pk2c(a.x, a.y); o.y = pk2c(a.z, a.w); o.z = pk2c(b.x, b.y); o.w = pk2c(b.z, b.w);
        ((GAS v4u*)dst)[i] = o;
    }
}
__device__ __forceinline__ void rms_row(const float* xr, const float* w, bf16* o, int lane) {
    const GAS f32x4* xp = (const GAS f32x4*)xr + lane; f32x4 v[8]; float s = 0.f;
#pragma unroll
    for (int j = 0; j < 8; ++j) { v[j] = xp[64 * j]; s += (v[j].x * v[j].x + v[j].y * v[j].y) + (v[j].z * v[j].z + v[j].w * v[j].w); }
    const float r = __builtin_amdgcn_rsqf(wave_sum(s) * (1.0f / DM) + EPS);
    const GAS f32x4* wp = (const GAS f32x4*)w + lane; GAS v2u* op = (GAS v2u*)o + lane;
#pragma unroll
    for (int j = 0; j < 8; ++j) { const f32x4 wv = wp[64 * j]; v2u q; q.x = pk2c(v[j].x * r * wv.x, v[j].y * r * wv.y); q.y = pk2c(v[j].z * r * wv.z, v[j].w * r * wv.w); op[64 * j] = q; }
}
__device__ __forceinline__ void rms_row_i8(const float* xr, const float* w, unsigned char* o, float* sa, int lane) {
    const GAS f32x4* xp = (const GAS f32x4*)xr + lane; f32x4 v[8]; float s = 0.f;
#pragma unroll
    for (int j = 0; j < 8; ++j) { v[j] = xp[64 * j]; s += (v[j].x * v[j].x + v[j].y * v[j].y) + (v[j].z * v[j].z + v[j].w * v[j].w); }
    const float r = __builtin_amdgcn_rsqf(wave_sum(s) * (1.0f / DM) + EPS);
    const GAS f32x4* wp = (const GAS f32x4*)w + lane; float m = 0.f;
#pragma unroll
    for (int j = 0; j < 8; ++j) { const f32x4 wv = wp[64 * j]; v[j].x *= r * wv.x; v[j].y *= r * wv.y; v[j].z *= r * wv.z; v[j].w *= r * wv.w;
        m = fmaxf(fmaxf(m, fmaxf(fabsf(v[j].x), fabsf(v[j].y))), fmaxf(fabsf(v[j].z), fabsf(v[j].w))); }
    m = wave_max(m);
    const float inv = m > 0.f ? 127.0f / m : 0.f;
    if (lane == 0) *(GAS float*)sa = m * (1.0f / 127.0f);
#pragma unroll
    for (int j = 0; j < 8; ++j) ((GAS unsigned*)o)[lane + 64 * j] = pack_i8x4c(v[j].x * inv, v[j].y * inv, v[j].z * inv, v[j].w * inv);
}
__device__ __forceinline__ void rms_phase_i8(const Ctx& c, const float* x, const float* w, unsigned char* H8, float* SA) {
    for (int m = c.gw; m < NTOK; m += c.NGW) rms_row_i8(x + (size_t)m * DM, w, H8 + (size_t)m * DM, SA + m, c.lane);
}
__device__ __forceinline__ void rms_phase(const Ctx& c, const float* x, const float* w, bf16* H) {
    for (int m = c.gw; m < NTOK; m += c.NGW) rms_row(x + (size_t)m * DM, w, H + (size_t)m * DM, c.lane);
}
__device__ __forceinline__ void fp8_row(const float* src, unsigned char* dst, float* scale_out, int lane) {
    const GAS f32x4* xp = (const GAS f32x4*)src + lane; f32x4 v[8]; float m = 0.f;
#pragma unroll
    for (int j = 0; j < 8; ++j) { v[j] = xp[64 * j]; m = fmaxf(fmaxf(m, fmaxf(fabsf(v[j].x), fabsf(v[j].y))), fmaxf(fabsf(v[j].z), fabsf(v[j].w))); }
    m = wave_max(m);
    const float inv = m > 0.f ? 256.0f / m : 0.f;
    if (lane == 0) *(GAS float*)scale_out = m * (1.0f / 256.0f);
#pragma unroll
    for (int j = 0; j < 8; ++j) { int p = __builtin_amdgcn_cvt_pk_fp8_f32(v[j].x * inv, v[j].y * inv, 0, false); p = __builtin_amdgcn_cvt_pk_fp8_f32(v[j].z * inv, v[j].w * inv, p, true);
        ((GAS unsigned*)dst)[lane + 64 * j] = (unsigned)p; }
}
__device__ __forceinline__ unsigned pack_i8x4(float a, float b, float c, float d) {
    const int ia = (int)__builtin_rintf(a), ib = (int)__builtin_rintf(b), ic = (int)__builtin_rintf(c), id = (int)__builtin_rintf(d);
    return ((unsigned)ia & 255u) | (((unsigned)ib & 255u) << 8) | (((unsigned)ic & 255u) << 16) | ((unsigned)id << 24);
}
__device__ __forceinline__ void i8_row(const float* src, unsigned char* dst, float* scale_out, int lane) {
    const GAS f32x4* xp = (const GAS f32x4*)src + lane; f32x4 v[8]; float m = 0.f;
#pragma unroll
    for (int j = 0; j < 8; ++j) { v[j] = xp[64 * j]; m = fmaxf(fmaxf(m, fmaxf(fabsf(v[j].x), fabsf(v[j].y))), fmaxf(fabsf(v[j].z), fabsf(v[j].w))); }
    m = wave_max(m);
    const float inv = m > 0.f ? 127.0f / m : 0.f;
    if (lane == 0) *(GAS float*)scale_out = m * (1.0f / 127.0f);
#pragma unroll
    for (int j = 0; j < 8; ++j) ((GAS unsigned*)dst)[lane + 64 * j] = pack_i8x4(v[j].x * inv, v[j].y * inv, v[j].z * inv, v[j].w * inv);
}
struct P0Args { const float *w_in, *w_br_sb, *w_br_hg, *w_br_conv, *w_o, *w_q, *u, *v, *lbp; bf16 *WinT, *WbrT, *WoT, *WqT; unsigned char *U, *V; float *US, *VS; float* LB; int layer; const float *k1, *k2; bf16* KB; };
__device__ __forceinline__ void p0_convert(const Ctx& c, const P0Args& a) {
    LAS float* scr = (LAS float*)(c.lds + c.wave * 16384);
    constexpr int I_IN = (DM / 64) * (INW / 32), I_BR = (BW / 64) * (DM / 32), I_SQ = (DM / 64) * (DM / 32);
    constexpr int NITEMS = I_IN + 3 * I_BR + 2 * I_SQ;
    for (int it = c.gw; it < NITEMS; it += c.NGW) {
        int r = it;
        if (r < I_IN) { const int kb = r / (INW / 32), nb = r % (INW / 32); tr_item_i8(a.w_in, DM, INW, (unsigned char*)a.WinT, kb * 64, nb * 32, win_drow(nb * 32), WIN_QS, scr, c.lane); continue; } r -= I_IN;
        if (r < I_BR) { const int kb = r / (DM / 32), nb = r % (DM / 32); tr_item(a.w_br_sb, BW, DM, a.WbrT, kb * 64, nb * 32, nb * 32, scr, c.lane); continue; } r -= I_BR;
        if (r < I_BR) { const int kb = r / (DM / 32), nb = r % (DM / 32); tr_item(a.w_br_hg, BW, DM, a.WbrT + (size_t)DM * BW, kb * 64, nb * 32, nb * 32, scr, c.lane); continue; } r -= I_BR;
        if (r < I_BR) { const int kb = r / (DM / 32), nb = r % (DM / 32); tr_item(a.w_br_conv, BW, DM, a.WbrT + (size_t)2 * DM * BW, kb * 64, nb * 32, nb * 32, scr, c.lane); continue; } r -= I_BR;
        if (r < I_SQ) { const int kb = r / (DM / 32), nb = r % (DM / 32); tr_item(a.w_o, DM, DM, a.WoT, kb * 64, nb * 32, nb * 32, scr, c.lane); continue; } r -= I_SQ;
        { const int kb = r / (DM / 32), nb = r % (DM / 32); tr_item(a.w_q, DM, DM, a.WqT, kb * 64, nb * 32, nb * 32, scr, c.lane); }
    }
    for (int r = c.gw; r < 2 * 16384; r += c.NGW) {
        if (r < 16384) i8_row(a.u + (size_t)r * 2048, a.U + (size_t)r * 2048, a.US + r, c.lane);
        else fp8_row(a.v + (size_t)(r - 16384) * 2048, a.V + (size_t)(r - 16384) * 2048, a.VS + (r - 16384), c.lane);
    }
    cvt_copy(c, a.k1, a.KB, (size_t)8 * 16384 / 8);
    cvt_copy(c, a.k2, a.KB + 8 * 16384, (size_t)8 * 16384 / 8);
    if (blockIdx.x == 0) for (int i = c.tid; i < 1024; i += 512) a.LB[i] = a.layer == 0 ? 0.f : sigm(a.lbp[1024 + i] - a.lbp[i]);
}

struct EpiIn {
    static constexpr bool PERM = true, AFTER_DRAIN = false;
    bf16* seg; bf16* gate; const float* lb; const float* sa;
    static __device__ __forceinline__ pg8::f32x4 cv(const pg8::f32x4 a, float s) { return (pg8::f32x4){(float)__float_as_int(a[0]) * s, (float)__float_as_int(a[1]) * s, (float)__float_as_int(a[2]) * s, (float)__float_as_int(a[3]) * s}; }
    __device__ __forceinline__ void operator()(const pg8::f32x4 (&acc)[2][2][4][2], const pg8::Unit& u, int wr, int wc, int fr, int fq) const {
        const int pn = u.pn; const int row0 = u.pm * 256 + wr * 64 + fr;
        float rs[2][4];
#pragma unroll
        for (int ai = 0; ai < 2; ++ai)
#pragma unroll
            for (int m = 0; m < 4; ++m) rs[ai][m] = ((const GAS float*)sa)[row0 + ai * 128 + m * 16] * (1.0f / WIN_QS);
        if (pn >= 28 && pn < 36) {
            bf16* dst = seg + (size_t)7 * SEGSZ; const int col0 = (pn - 28) * 128 + wc * 32 + 8 * fq;
#pragma unroll
            for (int ai = 0; ai < 2; ++ai)
#pragma unroll
                for (int m = 0; m < 4; ++m) {
                    const pg8::f32x4 a0 = cv(acc[ai][0][m][0], rs[ai][m]), a1 = cv(acc[ai][0][m][1], rs[ai][m]), b0 = cv(acc[ai][1][m][0], rs[ai][m]), b1 = cv(acc[ai][1][m][1], rs[ai][m]);
                    v4u w; w.x = pk2c(a0[0] * sigm(b0[0]), a0[1] * sigm(b0[1])); w.y = pk2c(a0[2] * sigm(b0[2]), a0[3] * sigm(b0[3]));
                    w.z = pk2c(a1[0] * sigm(b1[0]), a1[1] * sigm(b1[1])); w.w = pk2c(a1[2] * sigm(b1[2]), a1[3] * sigm(b1[3]));
                    *(GAS v4u*)(dst + (size_t)(row0 + ai * 128 + m * 16) * 1024 + col0) = w; }
            return;
        }
        bf16* dst; int ld, colt, mode;
        if (pn < 28) { const int sg = pn >> 2; dst = seg + (size_t)sg * SEGSZ; ld = 1024; colt = (pn & 3) * 256; mode = (sg == 4) ? 2 : (sg == 6 ? 1 : 0); }
        else { const int q = pn - 36; dst = gate + (size_t)(q >> 3) * ((size_t)NTOK * 2048); ld = 2048; colt = (q & 7) * 256; mode = 1; }
        const int col0 = colt + wc * 32 + 8 * fq;
        if (mode == 0) {
#pragma unroll
            for (int ai = 0; ai < 2; ++ai)
#pragma unroll
                for (int m = 0; m < 4; ++m)
#pragma unroll
                    for (int bj = 0; bj < 2; ++bj) { const pg8::f32x4 v0 = cv(acc[ai][bj][m][0], rs[ai][m]), v1 = cv(acc[ai][bj][m][1], rs[ai][m]);
                        v4u w; w.x = pk2c(v0[0], v0[1]); w.y = pk2c(v0[2], v0[3]); w.z = pk2c(v1[0], v1[1]); w.w = pk2c(v1[2], v1[3]);
                        *(GAS v4u*)(dst + (size_t)(row0 + ai * 128 + m * 16) * ld + col0 + bj * 128) = w; }
        } else if (mode == 1) {
#pragma unroll
            for (int ai = 0; ai < 2; ++ai)
#pragma unroll
                for (int m = 0; m < 4; ++m)
#pragma unroll
                    for (int bj = 0; bj < 2; ++bj) { const pg8::f32x4 v0 = cv(acc[ai][bj][m][0], rs[ai][m]), v1 = cv(acc[ai][bj][m][1], rs[ai][m]);
                        v4u w; w.x = pk2c(sigm(v0[0]), sigm(v0[1])); w.y = pk2c(sigm(v0[2]), sigm(v0[3])); w.z = pk2c(sigm(v1[0]), sigm(v1[1])); w.w = pk2c(sigm(v1[2]), sigm(v1[3]));
                        *(GAS v4u*)(dst + (size_t)(row0 + ai * 128 + m * 16) * ld + col0 + bj * 128) = w; }
        } else {
            f32x4 l0[2], l1[2];
#pragma unroll
            for (int bj = 0; bj < 2; ++bj) { l0[bj] = *(const GAS f32x4*)(lb + col0 + bj * 128); l1[bj] = *(const GAS f32x4*)(lb + col0 + bj * 128 + 4); }
#pragma unroll
            for (int ai = 0; ai < 2; ++ai)
#pragma unroll
                for (int m = 0; m < 4; ++m)
#pragma unroll
                    for (int bj = 0; bj < 2; ++bj) { const pg8::f32x4 v0 = cv(acc[ai][bj][m][0], rs[ai][m]), v1 = cv(acc[ai][bj][m][1], rs[ai][m]); float r[8];
#pragma unroll
                        for (int j = 0; j < 4; ++j) { r[j] = __logf(l0[bj][j] + (1.0f - l0[bj][j]) * sigm(v0[j])); r[4 + j] = __logf(l1[bj][j] + (1.0f - l1[bj][j]) * sigm(v1[j])); }
                        v4u w; w.x = pk2c(r[0], r[1]); w.y = pk2c(r[2], r[3]); w.z = pk2c(r[4], r[5]); w.w = pk2c(r[6], r[7]);
                        *(GAS v4u*)(dst + (size_t)(row0 + ai * 128 + m * 16) * ld + col0 + bj * 128) = w; }
        }
    }
};

__device__ __forceinline__ void conv_phase(const Ctx& c, const bf16* glu, const float* cw, const float* cb, const float* lnw, const float* lnb, bf16* out) {
    const int c0 = 2 * c.tid;
    float w0[31], w1[31];
#pragma unroll
    for (int j = 0; j < 31; ++j) { const f32x2v t = *(const GAS f32x2v*)(cw + j * 1024 + c0); w0[j] = t.x; w1[j] = t.y; }
    const f32x2v bv = *(const GAS f32x2v*)(cb + c0), lwv = *(const GAS f32x2v*)(lnw + c0), lbv = *(const GAS f32x2v*)(lnb + c0);
    LAS float* red = (LAS float*)c.lds;
    for (int tile = blockIdx.x; tile < NTOK / 8; tile += c.G) {
        const int n0 = tile * 8, tseq0 = n0 & (SEQ - 1);
        float a0[8], a1[8];
#pragma unroll
        for (int t = 0; t < 8; ++t) { a0[t] = bv.x; a1[t] = bv.y; }
#pragma unroll
        for (int r = 0; r < 38; ++r) {
            unsigned xv = 0u;
            if (tseq0 + r - 30 >= 0) xv = *(const GAS unsigned*)(glu + (size_t)(n0 + r - 30) * 1024 + c0);
            const float x0 = bflo(xv), x1 = bfhi(xv);
#pragma unroll
            for (int t = 0; t < 8; ++t) { const int j = r - t; if (j >= 0 && j <= 30) { a0[t] += w0[j] * x0; a1[t] += w1[j] * x1; } }
        }
        float st[16];
#pragma unroll
        for (int t = 0; t < 8; ++t) { st[2 * t] = a0[t] + a1[t]; st[2 * t + 1] = a0[t] * a0[t] + a1[t] * a1[t]; }
        xreduce16(st, c.lane);
        if ((c.lane & 3) == 0) red[c.wave * 16 + ridx16(c.lane)] = st[0];
        __syncthreads();
        if (c.tid < 16) { float s = 0.f;
#pragma unroll
            for (int w = 0; w < 8; ++w) s += red[w * 16 + c.tid];
            red[128 + c.tid] = s; }
        __syncthreads();
#pragma unroll
        for (int t = 0; t < 8; ++t) {
            const float mean = red[128 + 2 * t] * (1.0f / 1024.0f), var = red[128 + 2 * t + 1] * (1.0f / 1024.0f) - mean * mean;
            const float rstd = __builtin_amdgcn_rsqf(var + EPS);
            const float h0 = (a0[t] - mean) * rstd * lwv.x + lbv.x, h1 = (a1[t] - mean) * rstd * lwv.y + lbv.y;
            *(GAS unsigned*)(out + (size_t)(n0 + t) * 1024 + c0) = pk2c(h0 * sigm(h0), h1 * sigm(h1));
        }
        __syncthreads();
    }
}
__device__ __forceinline__ void hgrn_task(int task, int lane, const bf16* qhg, const bf16* logf, const bf16* ihg, bf16* out) {
    const int bh = task >> 6, dvb = task & 63, b = bh >> 3, h = bh & 7;
    const size_t rb = (size_t)b * SEQ * 1024;
    const GAS unsigned* qp = (const GAS unsigned*)(qhg + rb + h * 128) + lane;
    const GAS unsigned* lp = (const GAS unsigned*)(logf + rb + h * 128) + lane;
    const GAS unsigned* ip = (const GAS unsigned*)(ihg + rb + h * 128) + dvb;
    GAS bf16* op = (GAS bf16*)(out + rb + h * 128 + 2 * dvb);
    float S00 = 0.f, S01 = 0.f, S10 = 0.f, S11 = 0.f;
    unsigned qn[8], ln[8], inx[8];
#pragma unroll
    for (int j = 0; j < 8; ++j) { qn[j] = qp[(size_t)j * 512]; ln[j] = lp[(size_t)j * 512]; inx[j] = ip[(size_t)j * 512]; }
    for (int blk = 0; blk < SEQ / 8; ++blk) {
        unsigned qc[8], lc[8], ic[8];
#pragma unroll
        for (int j = 0; j < 8; ++j) { qc[j] = qn[j]; lc[j] = ln[j]; ic[j] = inx[j]; }
        if (blk + 1 < SEQ / 8) {
#pragma unroll
            for (int j = 0; j < 8; ++j) { const size_t o = (size_t)((blk + 1) * 8 + j) * 512; qn[j] = qp[o]; ln[j] = lp[o]; inx[j] = ip[o]; }
        }
        float pv[16];
#pragma unroll
        for (int j = 0; j < 8; ++j) {
            const float f0 = __expf(bflo(lc[j])), f1 = __expf(bfhi(lc[j])), k0 = 1.0f - f0, k1 = 1.0f - f1;
            const float i0 = bflo(ic[j]), i1 = bfhi(ic[j]), q0 = bflo(qc[j]), q1 = bfhi(qc[j]);
            S00 = f0 * S00 + k0 * i0; S01 = f0 * S01 + k0 * i1; S10 = f1 * S10 + k1 * i0; S11 = f1 * S11 + k1 * i1;
            pv[2 * j] = S00 * q0 + S10 * q1; pv[2 * j + 1] = S01 * q0 + S11 * q1;
        }
        xreduce16(pv, lane);
        if ((lane & 3) == 0) { const int idx = ridx16(lane); op[(size_t)(blk * 8 + (idx >> 1)) * 1024 + (idx & 1)] = (bf16)(pk2c(pv[0], 0.f) & 0xffffu); }
    }
}
constexpr int HG_TS = 272;
constexpr int HG_BS = 132;
__device__ __forceinline__ void hg_stage(LAS unsigned char* dst, const bf16* src, int tid) {
#pragma unroll
    for (int i = 0; i < 2; ++i) { const int p = tid + 512 * i, row = p >> 4, c16 = p & 15; *(LAS v4u*)(dst + row * HG_TS + c16 * 16) = *(const GAS v4u*)(src + (size_t)row * 1024 + c16 * 8); }
}
__device__ __forceinline__ void hg_scan(const LAS unsigned char* lft, int dk, int hf, float (&lf)[4][8], float (&b)[4][8], float& bl) {
    float bs[4], pb[4];
#pragma unroll
    for (int kk = 0; kk < 4; ++kk) { float run = 0.f;
#pragma unroll
        for (int j = 0; j < 8; ++j) { lf[kk][j] = __uint_as_float((unsigned)(*(const LAS unsigned short*)(lft + (16 * kk + 8 * hf + j) * HG_TS + dk * 2)) << 16); run += lf[kk][j]; b[kk][j] = run; }
        bs[kk] = run; }
#pragma unroll
    for (int kk = 0; kk < 4; ++kk) pb[kk] = __shfl_xor(bs[kk], 32);
    float pre = 0.f;
#pragma unroll
    for (int kk = 0; kk < 4; ++kk) { const float off = pre + (hf ? pb[kk] : 0.f);
#pragma unroll
        for (int j = 0; j < 8; ++j) b[kk][j] += off;
        pre += bs[kk] + pb[kk]; }
    bl = pre;
}
__device__ __forceinline__ bf16x8 pack8(const float (&v)[8]) { v4u t; t.x = pk2c(v[0], v[1]); t.y = pk2c(v[2], v[3]); t.z = pk2c(v[4], v[5]); t.w = pk2c(v[6], v[7]); return __builtin_bit_cast(bf16x8, t); }
__device__ __forceinline__ unsigned lds_u16(const LAS unsigned char* p) { return (unsigned)(*(const LAS unsigned short*)p); }
__device__ __forceinline__ void hgA_chunk(const Ctx& c, int ci, const bf16* LOGF, const bf16* IHG, bf16* ST, float* DEC) {
    const int bh = ci >> 6, ch = ci & 63, bb = bh >> 3, h = bh & 7; const size_t n0 = (size_t)bb * SEQ + ch * 64;
    LAS unsigned char* lft = c.lds; LAS unsigned char* itl = c.lds + 64 * HG_TS;
    hg_stage(lft, LOGF + n0 * 1024 + h * 128, c.tid); hg_stage(itl, IHG + n0 * 1024 + h * 128, c.tid);
    __syncthreads();
    const int dkt = c.wave & 3, dvh = c.wave >> 2, hf = c.lane >> 5, cl = c.lane & 31, dk = 32 * dkt + cl;
    float lf[4][8], b[4][8], bl; hg_scan(lft, dk, hf, lf, b, bl);
    bf16x8 kf[4];
#pragma unroll
    for (int kk = 0; kk < 4; ++kk) { float v[8];
#pragma unroll
        for (int j = 0; j < 8; ++j) v[j] = (1.0f - __expf(lf[kk][j])) * __expf(bl - b[kk][j]);
        kf[kk] = pack8(v); }
    if (dvh == 0 && hf == 0) ((GAS float*)DEC)[(size_t)ci * 128 + dk] = __expf(bl);
#pragma unroll
    for (int dvi = 0; dvi < 2; ++dvi) { const int dvt = dvh * 2 + dvi;
        f32x16 acc;
#pragma unroll
        for (int r = 0; r < 16; ++r) acc[r] = 0.f;
#pragma unroll
        for (int kk = 0; kk < 4; ++kk) { const LAS unsigned char* p = itl + (16 * kk + 8 * hf) * HG_TS + (32 * dvt + cl) * 2;
            v4u t; t.x = lds_u16(p) | (lds_u16(p + HG_TS) << 16); t.y = lds_u16(p + 2 * HG_TS) | (lds_u16(p + 3 * HG_TS) << 16); t.z = lds_u16(p + 4 * HG_TS) | (lds_u16(p + 5 * HG_TS) << 16); t.w = lds_u16(p + 6 * HG_TS) | (lds_u16(p + 7 * HG_TS) << 16);
            acc = MFMA32(kf[kk], __builtin_bit_cast(bf16x8, t), acc); }
        bf16* o = ST + (size_t)ci * 16384 + (size_t)(32 * dvt + cl) * 128 + 32 * dkt + 4 * hf;
#pragma unroll
        for (int g = 0; g < 4; ++g) { v2u q; q.x = pk2c(acc[4 * g], acc[4 * g + 1]); q.y = pk2c(acc[4 * g + 2], acc[4 * g + 3]); *(GAS v2u*)(o + 8 * g) = q; }
    }
    __syncthreads();
}
__device__ __forceinline__ void hgB(const Ctx& c, bf16* ST, const float* DEC) {
    for (int e = blockIdx.x * 512 + c.tid; e < 32 * 4096; e += c.G * 512) {
        const int bh = e >> 12, r = e & 4095, dv = r >> 5, dk4 = (r & 31) * 4;
        GAS v2u* p = (GAS v2u*)(ST + (size_t)bh * 64 * 16384 + (size_t)dv * 128 + dk4);
        const GAS f32x4* d = (const GAS f32x4*)(DEC + (size_t)bh * 64 * 128 + dk4);
        f32x4 S = {0.f, 0.f, 0.f, 0.f};
#pragma unroll 1
        for (int c0 = 0; c0 < 64; c0 += 8) {
            v2u Lv[8]; f32x4 D[8];
#pragma unroll
            for (int k = 0; k < 8; ++k) { Lv[k] = p[(size_t)(c0 + k) * 4096]; D[k] = d[(size_t)(c0 + k) * 32]; }
#pragma unroll
            for (int k = 0; k < 8; ++k) { v2u o; o.x = pk2c(S.x, S.y); o.y = pk2c(S.z, S.w); p[(size_t)(c0 + k) * 4096] = o;
                S.x = D[k].x * S.x + bflo(Lv[k].x); S.y = D[k].y * S.y + bfhi(Lv[k].x); S.z = D[k].z * S.z + bflo(Lv[k].y); S.w = D[k].w * S.w + bfhi(Lv[k].y); }
        }
    }
}
__device__ __forceinline__ void hgC_chunk(const Ctx& c, int ci, const bf16* QHG, const bf16* LOGF, const bf16* IHG, const bf16* GHG, const bf16* ST, const float* nw, bf16* OUT) {
    const int bh = ci >> 6, ch = ci & 63, bb = bh >> 3, h = bh & 7; const size_t n0 = (size_t)bb * SEQ + ch * 64;
    LAS unsigned char* lft = c.lds; LAS unsigned char* itl = c.lds + 64 * HG_TS; LAS float* bt = (LAS float*)(c.lds + 2 * 64 * HG_TS); LAS float* red = bt + 64 * HG_BS;
    hg_stage(lft, LOGF + n0 * 1024 + h * 128, c.tid); hg_stage(itl, IHG + n0 * 1024 + h * 128, c.tid);
    __syncthreads();
    const int hf = c.lane >> 5, cl = c.lane & 31;
    { const int dk = 32 * (c.wave & 3) + cl; float lf[4][8], b[4][8], bl; hg_scan(lft, dk, hf, lf, b, bl);
#pragma unroll
      for (int q = 0; q < 2; ++q) { const int kk = 2 * (c.wave >> 2) + q;
#pragma unroll
          for (int j = 0; j < 8; ++j) bt[(16 * kk + 8 * hf + j) * HG_BS + dk] = (c.wave >> 2) ? b[2 + q][j] : b[q][j]; } }
    __syncthreads();
    const int dvt = c.wave & 3, tt = c.wave >> 2, t = 32 * tt + cl;
    bf16x8 qm[8];
    const bf16* qrow = QHG + (n0 + t) * 1024 + h * 128 + 8 * hf;
#pragma unroll
    for (int kk = 0; kk < 8; ++kk) { const int d0 = 16 * kk + 8 * hf;
        asm volatile("" ::: "memory");
        const v4u qv = *(const GAS v4u*)(qrow + 16 * kk);
        const f32x4 b0 = *(const LAS f32x4*)(bt + t * HG_BS + d0), b1 = *(const LAS f32x4*)(bt + t * HG_BS + d0 + 4), m0 = *(const LAS f32x4*)(bt + 31 * HG_BS + d0), m1 = *(const LAS f32x4*)(bt + 31 * HG_BS + d0 + 4);
        const float q[8] = {bflo(qv.x), bfhi(qv.x), bflo(qv.y), bfhi(qv.y), bflo(qv.z), bfhi(qv.z), bflo(qv.w), bfhi(qv.w)};
        const float bv[8] = {b0.x, b0.y, b0.z, b0.w, b1.x, b1.y, b1.z, b1.w}, mv[8] = {m0.x, m0.y, m0.z, m0.w, m1.x, m1.y, m1.z, m1.w};
        float vm[8];
#pragma unroll
        for (int j = 0; j < 8; ++j) vm[j] = q[j] * __expf(bv[j] - mv[j]);
        qm[kk] = pack8(vm); }
    f32x16 o;
#pragma unroll
    for (int r = 0; r < 16; ++r) o[r] = 0.f;
#pragma unroll 1
    for (int st = 0; st <= tt; ++st) {
        const int s = 32 * st + cl;
        f32x16 sa;
#pragma unroll
        for (int r = 0; r < 16; ++r) sa[r] = 0.f;
#pragma unroll
        for (int kk = 0; kk < 8; ++kk) { const int d0 = 16 * kk + 8 * hf;
            asm volatile("" ::: "memory");
            const v4u lv = *(const LAS v4u*)(lft + s * HG_TS + d0 * 2);
            const f32x4 b0 = *(const LAS f32x4*)(bt + s * HG_BS + d0), b1 = *(const LAS f32x4*)(bt + s * HG_BS + d0 + 4), m0 = *(const LAS f32x4*)(bt + 31 * HG_BS + d0), m1 = *(const LAS f32x4*)(bt + 31 * HG_BS + d0 + 4);
            const float lfv[8] = {bflo(lv.x), bfhi(lv.x), bflo(lv.y), bfhi(lv.y), bflo(lv.z), bfhi(lv.z), bflo(lv.w), bfhi(lv.w)};
            const float bv[8] = {b0.x, b0.y, b0.z, b0.w, b1.x, b1.y, b1.z, b1.w}, mv[8] = {m0.x, m0.y, m0.z, m0.w, m1.x, m1.y, m1.z, m1.w};
            float vk[8];
#pragma unroll
            for (int j = 0; j < 8; ++j) vk[j] = (1.0f - __expf(lfv[j])) * __expf(mv[j] - bv[j]);
            sa = MFMA32(pack8(vk), qm[kk], sa); }
        if (st == tt) {
#pragma unroll
            for (int r = 0; r < 16; ++r) if (((r & 3) + 8 * (r >> 2) + 4 * hf) > cl) sa[r] = 0.f;
        }
#pragma unroll
        for (int sp = 0; sp < 2; ++sp) {
            const float pv[8] = {sa[8 * sp], sa[8 * sp + 1], sa[8 * sp + 2], sa[8 * sp + 3], sa[8 * sp + 4], sa[8 * sp + 5], sa[8 * sp + 6], sa[8 * sp + 7]};
            const LAS unsigned char* p = itl + (32 * st + 16 * sp + 4 * hf) * HG_TS + (32 * dvt + cl) * 2;
            v4u tq; tq.x = lds_u16(p) | (lds_u16(p + HG_TS) << 16); tq.y = lds_u16(p + 2 * HG_TS) | (lds_u16(p + 3 * HG_TS) << 16);
            tq.z = lds_u16(p + 8 * HG_TS) | (lds_u16(p + 9 * HG_TS) << 16); tq.w = lds_u16(p + 10 * HG_TS) | (lds_u16(p + 11 * HG_TS) << 16);
            o = MFMA32(__builtin_bit_cast(bf16x8, tq), pack8(pv), o); }
    }
    { const bf16* strow = ST + (size_t)ci * 16384 + (size_t)(32 * dvt + cl) * 128 + 8 * hf;
#pragma unroll
      for (int kk = 0; kk < 8; ++kk) { const int d0 = 16 * kk + 8 * hf;
          asm volatile("" ::: "memory");
          const v4u qv = *(const GAS v4u*)(qrow + 16 * kk); const bf16x8 sf = *(const GAS bf16x8*)(strow + 16 * kk);
          const f32x4 b0 = *(const LAS f32x4*)(bt + t * HG_BS + d0), b1 = *(const LAS f32x4*)(bt + t * HG_BS + d0 + 4);
          float ve[8] = {bflo(qv.x) * __expf(b0.x), bfhi(qv.x) * __expf(b0.y), bflo(qv.y) * __expf(b0.z), bfhi(qv.y) * __expf(b0.w), bflo(qv.z) * __expf(b1.x), bfhi(qv.z) * __expf(b1.y), bflo(qv.w) * __expf(b1.z), bfhi(qv.w) * __expf(b1.w)};
          o = MFMA32(sf, pack8(ve), o); } }
    float ss = 0.f;
#pragma unroll
    for (int r = 0; r < 16; ++r) ss += o[r] * o[r];
    ss += __shfl_xor(ss, 32);
    if (hf == 0) red[(tt * 4 + dvt) * 32 + cl] = ss;
    __syncthreads();
    const float rstd = __builtin_amdgcn_rsqf(((red[(tt * 4 + 0) * 32 + cl] + red[(tt * 4 + 1) * 32 + cl]) + (red[(tt * 4 + 2) * 32 + cl] + red[(tt * 4 + 3) * 32 + cl])) * (1.0f / 128.0f) + EPS);
#pragma unroll
    for (int g = 0; g < 4; ++g) { const int dv0 = 32 * dvt + 8 * g + 4 * hf; const size_t off = (n0 + t) * 1024 + h * 128 + dv0;
        const v2u gg = *(const GAS v2u*)(GHG + off); const f32x4 w4 = *(const GAS f32x4*)(nw + dv0);
        v2u q; q.x = pk2c(o[4 * g] * rstd * w4.x * bflo(gg.x), o[4 * g + 1] * rstd * w4.y * bfhi(gg.x)); q.y = pk2c(o[4 * g + 2] * rstd * w4.z * bflo(gg.y), o[4 * g + 3] * rstd * w4.w * bfhi(gg.y));
        *(GAS v2u*)(OUT + off) = q; }
    __syncthreads();
}
__device__ __forceinline__ void qknorm_row(bf16* row, const float* w, float scale, int lane) {
#pragma unroll
    for (int j = 0; j < 2; ++j) {
        GAS v4u* p = (GAS v4u*)(row + 8 * lane + 512 * j); const v4u x = *p;
        float f[8] = {bflo(x.x), bfhi(x.x), bflo(x.y), bfhi(x.y), bflo(x.z), bfhi(x.z), bflo(x.w), bfhi(x.w)};
        float ss = 0.f;
#pragma unroll
        for (int k = 0; k < 8; ++k) ss += f[k] * f[k];
        ss += __shfl_xor(ss, 1); ss += __shfl_xor(ss, 2); ss += __shfl_xor(ss, 4); ss += __shfl_xor(ss, 8);
        const float r = __builtin_amdgcn_rsqf(ss * (1.0f / 128.0f) + EPS) * scale;
        const f32x4 wa = *(const GAS f32x4*)(w + ((8 * lane) & 127)), wb = *(const GAS f32x4*)(w + ((8 * lane) & 127) + 4);
        v4u o; o.x = pk2c(f[0] * r * wa.x, f[1] * r * wa.y); o.y = pk2c(f[2] * r * wa.z, f[3] * r * wa.w); o.z = pk2c(f[4] * r * wb.x, f[5] * r * wb.y); o.w = pk2c(f[6] * r * wb.z, f[7] * r * wb.w);
        *p = o;
    }
}
__device__ __forceinline__ void vt_item(int item, int lane, const bf16* vsb, bf16* vt, LAS unsigned short* scr) {
    const int db = item & 3, sb = (item >> 2) & 63, bh = item >> 8, b = bh >> 3, h = bh & 7;
    const bf16* src = vsb + ((size_t)b * SEQ + sb * 64) * 1024 + h * 128 + db * 32;
#pragma unroll 4
    for (int i = 0; i < 16; ++i) { const int r = 4 * i + (lane >> 4); *(LAS unsigned*)(scr + r * 34 + 2 * (lane & 15)) = *(const GAS unsigned*)(src + (size_t)r * 1024 + 2 * (lane & 15)); }
    LDS_WAIT();
    const int c = lane & 7;
#pragma unroll
    for (int j = 0; j < 4; ++j) { const int d = (lane >> 3) + 8 * j; const LAS unsigned short* s = scr + (8 * c) * 34 + d;
        v4u o; o.x = (unsigned)s[0] | ((unsigned)s[34] << 16); o.y = (unsigned)s[68] | ((unsigned)s[102] << 16); o.z = (unsigned)s[136] | ((unsigned)s[170] << 16); o.w = (unsigned)s[204] | ((unsigned)s[238] << 16);
        *(GAS v4u*)(vt + ((size_t)bh * 128 + db * 32 + d) * SEQ + sb * 64 + 8 * c) = o; }
    LDS_WAIT();
}

constexpr int AT_KS = 272, AT_VS = 136, AT_BUF = 64 * AT_KS + 128 * AT_VS;
__device__ __forceinline__ f32x16 attn_scores(const LAS unsigned char* kp, const bf16x8 (&qf)[8]) {
    f32x16 sa;
#pragma unroll
    for (int r = 0; r < 16; ++r) sa[r] = 0.f;
#pragma unroll
    for (int kk = 0; kk < 8; ++kk) sa = MFMA32(*(const LAS bf16x8*)(kp + 32 * kk), qf[kk], sa);
    return sa;
}
template <bool DIAG> __device__ __forceinline__ void attn_weights(const f32x16& sa, float& R, int hf, int cl, bf16x8 (&pf)[2]) {
    float om[16], be[16];
#pragma unroll
    for (int r = 0; r < 16; ++r) { const float e = __builtin_amdgcn_exp2f(sa[r] * 1.4426950408889634f); om[r] = __builtin_amdgcn_rcpf(1.0f + e); be[r] = e * om[r]; }
    if (DIAG) {
#pragma unroll
        for (int r = 0; r < 16; ++r) if (((r & 3) + 8 * (r >> 2) + 4 * hf) >= cl) { om[r] = 1.0f; be[r] = 0.f; }
    }
    float Gs[4], Gp[4];
#pragma unroll
    for (int g = 0; g < 4; ++g) { Gs[g] = (om[4 * g] * om[4 * g + 1]) * (om[4 * g + 2] * om[4 * g + 3]); Gp[g] = __shfl_xor(Gs[g], 32); }
    float tail = R; float w[16];
#pragma unroll
    for (int g = 3; g >= 0; --g) {
        const float c3 = tail * (hf == 0 ? Gp[g] : 1.0f), c2 = c3 * om[4 * g + 3], c1 = c2 * om[4 * g + 2], c0 = c1 * om[4 * g + 1];
        w[4 * g + 3] = be[4 * g + 3] * c3; w[4 * g + 2] = be[4 * g + 2] * c2; w[4 * g + 1] = be[4 * g + 1] * c1; w[4 * g] = be[4 * g] * c0;
        tail *= Gs[g] * Gp[g];
    }
    R = tail;
#pragma unroll
    for (int sp = 0; sp < 2; ++sp) { v4u t; t.x = pk2c(w[8 * sp], w[8 * sp + 1]); t.y = pk2c(w[8 * sp + 2], w[8 * sp + 3]); t.z = pk2c(w[8 * sp + 4], w[8 * sp + 5]); t.w = pk2c(w[8 * sp + 6], w[8 * sp + 7]); pf[sp] = __builtin_bit_cast(bf16x8, t); }
}
__device__ __forceinline__ void attn_pv(const LAS unsigned char* vp, const bf16x8 (&pf)[2], f32x16 (&o)[4]) {
#pragma unroll
    for (int d = 0; d < 4; ++d)
#pragma unroll
        for (int sp = 0; sp < 2; ++sp) { const v2u lo = *(const LAS v2u*)(vp + d * 32 * AT_VS + 32 * sp), hi = *(const LAS v2u*)(vp + d * 32 * AT_VS + 32 * sp + 16);
            v4u t; t.x = lo.x; t.y = lo.y; t.z = hi.x; t.w = hi.y; o[d] = MFMA32(__builtin_bit_cast(bf16x8, t), pf[sp], o[d]); }
}
__device__ __forceinline__ void attn_unit(const Ctx& c, int bh, int qb, const bf16* qsb, const bf16* ksb, const bf16* vt, bf16* outb) {
    const int b = bh >> 3, h = bh & 7, lane = c.lane, cl = lane & 31, hf = lane >> 5, tid = c.tid;
    const size_t rb = (size_t)b * SEQ; const int q0w = 256 * qb + 32 * c.wave;
    bf16x8 qf[8];
    { const bf16* qrow = qsb + (rb + q0w + cl) * 1024 + h * 128 + 8 * hf;
#pragma unroll
      for (int kk = 0; kk < 8; ++kk) qf[kk] = *(const GAS bf16x8*)(qrow + 16 * kk); }
    f32x16 o[4];
#pragma unroll
    for (int d = 0; d < 4; ++d)
#pragma unroll
        for (int r = 0; r < 16; ++r) o[d][r] = 0.f;
    float R = 1.0f;
    const bf16* kg = ksb + (rb + (tid >> 4)) * 1024 + h * 128 + (tid & 15) * 8;
    const bf16* vg = vt + ((size_t)bh * 128 + (tid >> 3)) * SEQ + (tid & 7) * 8;
    const int kl = (tid >> 4) * AT_KS + (tid & 15) * 16, vl = 64 * AT_KS + (tid >> 3) * AT_VS + (tid & 7) * 16;
    const int nkt = 4 * (qb + 1);
    v4u st[4];
    { const int kt = nkt - 1;
      st[0] = *(const GAS v4u*)(kg + (size_t)kt * 64 * 1024); st[1] = *(const GAS v4u*)(kg + (size_t)kt * 64 * 1024 + 32 * 1024);
      st[2] = *(const GAS v4u*)(vg + kt * 64); st[3] = *(const GAS v4u*)(vg + kt * 64 + (size_t)64 * SEQ);
      *(LAS v4u*)(c.lds + kl) = st[0]; *(LAS v4u*)(c.lds + kl + 32 * AT_KS) = st[1];
      *(LAS v2u*)(c.lds + vl) = (v2u){st[2].x, st[2].y}; *(LAS v2u*)(c.lds + vl + 8) = (v2u){st[2].z, st[2].w}; *(LAS v2u*)(c.lds + vl + 64 * AT_VS) = (v2u){st[3].x, st[3].y}; *(LAS v2u*)(c.lds + vl + 64 * AT_VS + 8) = (v2u){st[3].z, st[3].w}; }
    __syncthreads();
#pragma unroll 1
    for (int it = 0; it < nkt; ++it) {
        const int kt = nkt - 1 - it; LAS unsigned char* buf = c.lds + (it & 1) * AT_BUF; LAS unsigned char* nbuf = c.lds + ((it & 1) ^ 1) * AT_BUF;
        const bool more = (it + 1 < nkt);
        if (more) { const int k2 = kt - 1;
            st[0] = *(const GAS v4u*)(kg + (size_t)k2 * 64 * 1024); st[1] = *(const GAS v4u*)(kg + (size_t)k2 * 64 * 1024 + 32 * 1024);
            st[2] = *(const GAS v4u*)(vg + k2 * 64); st[3] = *(const GAS v4u*)(vg + k2 * 64 + (size_t)64 * SEQ); }
        const int rel = q0w - 64 * kt;
        const LAS unsigned char* kp0 = buf + cl * AT_KS + 16 * hf; const LAS unsigned char* kp1 = kp0 + 32 * AT_KS;
        const LAS unsigned char* vp0 = buf + 64 * AT_KS + cl * AT_VS + 8 * hf; const LAS unsigned char* vp1 = vp0 + 64;
        if (rel >= 64) {
            const f32x16 s1 = attn_scores(kp1, qf), s0 = attn_scores(kp0, qf);
            bf16x8 p1[2], p0[2];
            attn_weights<false>(s1, R, hf, cl, p1); attn_weights<false>(s0, R, hf, cl, p0);
            attn_pv(vp1, p1, o); attn_pv(vp0, p0, o);
        } else if (rel == 32) {
            const f32x16 s1 = attn_scores(kp1, qf), s0 = attn_scores(kp0, qf);
            bf16x8 p1[2], p0[2];
            attn_weights<true>(s1, R, hf, cl, p1); attn_weights<false>(s0, R, hf, cl, p0);
            attn_pv(vp1, p1, o); attn_pv(vp0, p0, o);
        } else if (rel == 0) {
            const f32x16 s0 = attn_scores(kp0, qf);
            bf16x8 p0[2];
            attn_weights<true>(s0, R, hf, cl, p0);
            attn_pv(vp0, p0, o);
        }
        if (more) { *(LAS v4u*)(nbuf + kl) = st[0]; *(LAS v4u*)(nbuf + kl + 32 * AT_KS) = st[1];
            *(LAS v2u*)(nbuf + vl) = (v2u){st[2].x, st[2].y}; *(LAS v2u*)(nbuf + vl + 8) = (v2u){st[2].z, st[2].w}; *(LAS v2u*)(nbuf + vl + 64 * AT_VS) = (v2u){st[3].x, st[3].y}; *(LAS v2u*)(nbuf + vl + 64 * AT_VS + 8) = (v2u){st[3].z, st[3].w}; }
        __syncthreads();
    }
    bf16* orow = outb + (rb + q0w + cl) * 1024 + h * 128 + 4 * hf;
#pragma unroll
    for (int d = 0; d < 4; ++d)
#pragma unroll
        for (int g = 0; g < 4; ++g) { v2u q; q.x = pk2c(o[d][4 * g], o[d][4 * g + 1]); q.y = pk2c(o[d][4 * g + 2], o[d][4 * g + 3]); *(GAS v2u*)(orow + 32 * d + 8 * g) = q; }
}
__device__ __forceinline__ void hgpost_row(bf16* row, const bf16* grow, const float* w, int lane) {
#pragma unroll
    for (int j = 0; j < 2; ++j) {
        GAS v4u* p = (GAS v4u*)(row + 8 * lane + 512 * j); const v4u x = *p; const v4u gg = *(const GAS v4u*)(grow + 8 * lane + 512 * j);
        float f[8] = {bflo(x.x), bfhi(x.x), bflo(x.y), bfhi(x.y), bflo(x.z), bfhi(x.z), bflo(x.w), bfhi(x.w)};
        const float g[8] = {bflo(gg.x), bfhi(gg.x), bflo(gg.y), bfhi(gg.y), bflo(gg.z), bfhi(gg.z), bflo(gg.w), bfhi(gg.w)};
        float ss = 0.f;
#pragma unroll
        for (int k = 0; k < 8; ++k) ss += f[k] * f[k];
        ss += __shfl_xor(ss, 1); ss += __shfl_xor(ss, 2); ss += __shfl_xor(ss, 4); ss += __shfl_xor(ss, 8);
        const float r = __builtin_amdgcn_rsqf(ss * (1.0f / 128.0f) + EPS);
        const f32x4 wa = *(const GAS f32x4*)(w + ((8 * lane) & 127)), wb = *(const GAS f32x4*)(w + ((8 * lane) & 127) + 4);
        v4u o; o.x = pk2c(f[0] * r * wa.x * g[0], f[1] * r * wa.y * g[1]); o.y = pk2c(f[2] * r * wa.z * g[2], f[3] * r * wa.w * g[3]);
        o.z = pk2c(f[4] * r * wb.x * g[4], f[5] * r * wb.y * g[5]); o.w = pk2c(f[6] * r * wb.z * g[6], f[7] * r * wb.w * g[7]);
        *p = o;
    }
}

template <bool FIRST> struct EpiMerge {
    static constexpr bool PERM = true, AFTER_DRAIN = false;
    const bf16* gate; bf16* merged;
    __device__ __forceinline__ void operator()(const pg8::f32x4 (&acc)[2][2][4][2], const pg8::Unit& u, int wr, int wc, int fr, int fq) const {
        const int row0 = u.pm * 256 + wr * 64 + fr, col0 = u.pn * 256 + wc * 32 + 8 * fq;
#pragma unroll
        for (int ai = 0; ai < 2; ++ai)
#pragma unroll
            for (int m = 0; m < 4; ++m) {
                if ((m & 1) == 0) asm volatile("" ::: "memory");
#pragma unroll
                for (int bj = 0; bj < 2; ++bj) {
                    const size_t off = (size_t)(row0 + ai * 128 + m * 16) * 2048 + col0 + bj * 128;
                    const v4u g = *(const GAS v4u*)(gate + off); const pg8::f32x4 v0 = acc[ai][bj][m][0], v1 = acc[ai][bj][m][1];
                    float r[8] = {bflo(g.x) * v0[0], bfhi(g.x) * v0[1], bflo(g.y) * v0[2], bfhi(g.y) * v0[3], bflo(g.z) * v1[0], bfhi(g.z) * v1[1], bflo(g.w) * v1[2], bfhi(g.w) * v1[3]};
                    if (!FIRST) { const v4u mo = *(const GAS v4u*)(merged + off);
                        r[0] += bflo(mo.x); r[1] += bfhi(mo.x); r[2] += bflo(mo.y); r[3] += bfhi(mo.y); r[4] += bflo(mo.z); r[5] += bfhi(mo.z); r[6] += bflo(mo.w); r[7] += bfhi(mo.w); }
                    v4u w; w.x = pk2c(r[0], r[1]); w.y = pk2c(r[2], r[3]); w.z = pk2c(r[4], r[5]); w.w = pk2c(r[6], r[7]);
                    *(GAS v4u*)(merged + off) = w; }
            }
    }
};
struct EpiResid {
    static constexpr bool PERM = false, AFTER_DRAIN = false;
    const float* xin; float* xout;
    __device__ __forceinline__ void operator()(const pg8::f32x4 (&acc)[2][2][4][2], const pg8::Unit& u, int wr, int wc, int fr, int fq) const {
        const int row0 = u.pm * 256 + wr * 64 + fr, col0 = u.pn * 256 + wc * 32 + 4 * fq;
#pragma unroll
        for (int ai = 0; ai < 2; ++ai)
#pragma unroll
            for (int m = 0; m < 4; ++m)
#pragma unroll
                for (int bj = 0; bj < 2; ++bj)
#pragma unroll
                    for (int n = 0; n < 2; ++n) { const size_t off = (size_t)(row0 + ai * 128 + m * 16) * 2048 + col0 + bj * 128 + n * 16;
                        f32x4 r = acc[ai][bj][m][n]; if (xin) r += *(const GAS f32x4*)(xin + off);
                        *(GAS f32x4*)(xout + off) = r; }
    }
};

__device__ __forceinline__ float rl_f(float v, int l) { return __uint_as_float((unsigned)__builtin_amdgcn_readlane((int)__float_as_uint(v), l)); }
__device__ __forceinline__ void ins16(float (&L)[16], float x) {
#pragma unroll
    for (int i = 0; i < 16; ++i) { const float hi = __builtin_fmaxf(L[i], x); x = __builtin_fminf(L[i], x); L[i] = hi; }
}
__device__ __forceinline__ void peer_top16(const float* qrow  , const bf16* kb  , int hf, float (&L)[16]) {
    bf16x8 qf[8];
#pragma unroll
    for (int kk = 0; kk < 8; ++kk) { const f32x4 a = *(const GAS f32x4*)(qrow + 16 * kk), b = *(const GAS f32x4*)(qrow + 16 * kk + 4);
        v4u t; t.x = pk2c(a.x, a.y); t.y = pk2c(a.z, a.w); t.z = pk2c(b.x, b.y); t.w = pk2c(b.z, b.w); qf[kk] = __builtin_bit_cast(bf16x8, t); }
#pragma unroll
    for (int i = 0; i < 16; ++i) L[i] = -__builtin_inff();
#pragma unroll 1
    for (int kt = 0; kt < 4; ++kt) {
        f32x16 sa;
#pragma unroll
        for (int r = 0; r < 16; ++r) sa[r] = 0.f;
#pragma unroll
        for (int kk = 0; kk < 8; ++kk) { const bf16x8 kf = *(const GAS bf16x8*)(kb + (size_t)kt * 32 * 128 + 16 * kk); sa = MFMA32(kf, qf[kk], sa); }
#pragma unroll
        for (int r = 0; r < 16; ++r) { const unsigned idx = (unsigned)(kt * 32 + (r & 3) + 8 * (r >> 2) + 4 * hf); ins16(L, __uint_as_float((__float_as_uint(sa[r]) & ~127u) | idx)); }
    }
    float P[16];
#pragma unroll
    for (int i = 0; i < 16; ++i) P[i] = __shfl_xor(L[i], 32);
#pragma unroll
    for (int i = 0; i < 16; ++i) ins16(L, P[i]);
}
__device__ __forceinline__ void peer_select32(int item, int lane, const float* qpeer, const bf16* KB, int* sel_e, float* sel_g, float* sel_s) {
    const int hd = item & 7, n0 = (item >> 3) * 32, c = lane & 31, hf = lane >> 5, n = n0 + c;
    const float* qrow = qpeer + (size_t)n * 2048 + hd * 256 + 8 * hf;
    float A[16], B[16];
    peer_top16(qrow, KB + (size_t)hd * 16384 + c * 128 + 8 * hf, hf, A);
    peer_top16(qrow + 128, KB + (size_t)(8 + hd) * 16384 + c * 128 + 8 * hf, hf, B);
    float Av[16], Bv[16]; int Ai[16], Bi[16];
#pragma unroll
    for (int i = 0; i < 16; ++i) { const unsigned a = __float_as_uint(A[i]), b = __float_as_uint(B[i]); Av[i] = __uint_as_float(a & ~127u); Bv[i] = __uint_as_float(b & ~127u); Ai[i] = (int)(a & 127u); Bi[i] = (int)(b & 127u); }
    float W[16];
#pragma unroll
    for (int i = 0; i < 16; ++i) W[i] = -__builtin_inff();
    { unsigned id = 0;
#pragma unroll
      for (int a = 0; a < 16; ++a)
#pragma unroll
        for (int b = 0; b < 16; ++b) if ((a + 1) * (b + 1) <= 16) { ins16(W, __uint_as_float((__float_as_uint(Av[a] + Bv[b]) & ~63u) | id)); ++id; } }
    const float thr = W[15], mx = W[0];
    int cnt = 0; float ssum = 0.f;
    GAS int* pe = (GAS int*)sel_e + (size_t)n * 128 + hd * 16; GAS float* pg = (GAS float*)sel_g + (size_t)n * 128 + hd * 16;
    { unsigned id = 0;
#pragma unroll
      for (int a = 0; a < 16; ++a)
#pragma unroll
        for (int b = 0; b < 16; ++b) if ((a + 1) * (b + 1) <= 16) {
            const float cv = Av[a] + Bv[b]; const float pk = __uint_as_float((__float_as_uint(cv) & ~63u) | id); ++id;
            if (pk >= thr) { const float e = __expf(cv - mx); if ((cnt & 1) == hf) { pe[cnt] = Ai[a] * 128 + Bi[b]; pg[cnt] = e; } ssum += e; ++cnt; }
        } }
    if (hf == 0) ((GAS float*)sel_s)[(size_t)n * 8 + hd] = ssum;
}

__device__ __forceinline__ float dot2bf(unsigned a, unsigned b, float acc) {
    return __builtin_amdgcn_fdot2_f32_bf16(__builtin_bit_cast(bf16v2, a), __builtin_bit_cast(bf16v2, b), acc, false);
}
__device__ __forceinline__ float dot8bf(const v4u a, const v4u b, float acc) {
    const unsigned a0 = a.x, a1 = a.y, a2 = a.z, a3 = a.w, b0 = b.x, b1 = b.y, b2 = b.z, b3 = b.w;
    acc = dot2bf(a0, b0, acc); acc = dot2bf(a1, b1, acc); acc = dot2bf(a2, b2, acc); acc = dot2bf(a3, b3, acc);
    return acc;
}
__device__ __forceinline__ void unpack16(const v4u q, float (&f)[16]) {
    const unsigned d0 = q.x, d1 = q.y, d2 = q.z, d3 = q.w;
    f32x2v t;
    t = __builtin_amdgcn_cvt_pk_f32_fp8((int)d0, false); f[0] = t.x; f[1] = t.y; t = __builtin_amdgcn_cvt_pk_f32_fp8((int)d0, true); f[2] = t.x; f[3] = t.y;
    t = __builtin_amdgcn_cvt_pk_f32_fp8((int)d1, false); f[4] = t.x; f[5] = t.y; t = __builtin_amdgcn_cvt_pk_f32_fp8((int)d1, true); f[6] = t.x; f[7] = t.y;
    t = __builtin_amdgcn_cvt_pk_f32_fp8((int)d2, false); f[8] = t.x; f[9] = t.y; t = __builtin_amdgcn_cvt_pk_f32_fp8((int)d2, true); f[10] = t.x; f[11] = t.y;
    t = __builtin_amdgcn_cvt_pk_f32_fp8((int)d3, false); f[12] = t.x; f[13] = t.y; t = __builtin_amdgcn_cvt_pk_f32_fp8((int)d3, true); f[14] = t.x; f[15] = t.y;
}
struct SliceSched { int mode, xcc, rank, nloc; };
__device__ __forceinline__ SliceSched slice_sched_init(const Ctx& c, unsigned* ctl, const XcdBarrier& bar, int use) {
    LAS int* sh = (LAS int*)(c.lds + 1024);
    if (c.tid == 0) {
        int ok = 1; unsigned tot = 0;
        for (int j = 0; j < 16; ++j) { const unsigned n = xb_ld(&bar.bar[XB_XCNT(j)]); tot += n; if ((j < 8) != (n > 0u)) ok = 0; }
        if (tot != (unsigned)c.G) ok = 0;
        const int xcc = (int)xb_xcc_id();
        int rank = 0, nloc = 1;
        if (ok) { nloc = (int)xb_ld(&bar.bar[XB_XCNT(xcc)]); rank = (int)xb_add(&ctl[CW_RANK + (use * 16 + xcc) * 64], 1u); if (rank >= nloc) ok = 0; }
        sh[0] = ok; sh[1] = xcc; sh[2] = rank; sh[3] = nloc;
    }
    __syncthreads();
    SliceSched S; S.mode = sh[0]; S.xcc = sh[1]; S.rank = sh[2]; S.nloc = sh[3];
    __syncthreads();
    return S;
}
__device__ __forceinline__ bool slice_item(const SliceSched& S, const Ctx& c, int i, int& slice, int& tb) {
    if (S.mode) { const int it = S.rank + i * S.nloc; if (it >= 512) return false; slice = S.xcc + 8 * (it >> 8); tb = it & 255; return true; }
    const int it = (int)blockIdx.x + i * c.G; if (it >= 4096) return false; slice = it >> 8; tb = it & 255; return true;
}
__device__ __forceinline__ void unpack16p(const v4u q, f32x2v (&f)[8]) {
    const unsigned d0 = q.x, d1 = q.y, d2 = q.z, d3 = q.w;
    f[0] = __builtin_amdgcn_cvt_pk_f32_fp8((int)d0, false); f[1] = __builtin_amdgcn_cvt_pk_f32_fp8((int)d0, true);
    f[2] = __builtin_amdgcn_cvt_pk_f32_fp8((int)d1, false); f[3] = __builtin_amdgcn_cvt_pk_f32_fp8((int)d1, true);
    f[4] = __builtin_amdgcn_cvt_pk_f32_fp8((int)d2, false); f[5] = __builtin_amdgcn_cvt_pk_f32_fp8((int)d2, true);
    f[6] = __builtin_amdgcn_cvt_pk_f32_fp8((int)d3, false); f[7] = __builtin_amdgcn_cvt_pk_f32_fp8((int)d3, true);
}
__device__ __forceinline__ void peer_sddmm_wave(int t0, int s, int lane, const bf16* H, const unsigned char* UQ, const int* sel_e, float* part, LAS unsigned* ldsw) {
    const int cg = lane & 7, sg = lane >> 3;
#pragma unroll
    for (int j = 0; j < 4; ++j) *(LAS v4u*)(ldsw + 4 * (lane + 64 * j)) = *(const GAS v4u*)(sel_e + (size_t)t0 * 128 + 4 * (lane + 64 * j));
    LDS_WAIT();
    const unsigned char* ubase = UQ + s * 128 + cg * 16;
    v4u qn[16];
    { int id[16];
#pragma unroll
      for (int q = 0; q < 4; ++q) { const v4u v = *(const LAS v4u*)(ldsw + sg * 16 + 4 * q); id[4 * q] = (int)v.x; id[4 * q + 1] = (int)v.y; id[4 * q + 2] = (int)v.z; id[4 * q + 3] = (int)v.w; }
#pragma unroll
      for (int it = 0; it < 16; ++it) qn[it] = *(const GAS v4u*)(ubase + (size_t)id[it] * 2048); }
    const bf16* hbase = H + (size_t)t0 * 2048 + s * 128 + cg * 16;
    v4u han = *(const GAS v4u*)(hbase), hbn = *(const GAS v4u*)(hbase + 8);
#pragma unroll 1
    for (int k = 0; k < 8; ++k) {
        const int t = t0 + k;
        v4u qc[16];
#pragma unroll
        for (int it = 0; it < 16; ++it) qc[it] = qn[it];
        const v4u ha = han, hb = hbn;
        if (k < 7) { han = *(const GAS v4u*)(hbase + (size_t)(k + 1) * 2048); hbn = *(const GAS v4u*)(hbase + (size_t)(k + 1) * 2048 + 8); }
        if (k < 7) { int id[16];
#pragma unroll
            for (int q = 0; q < 4; ++q) { const v4u v = *(const LAS v4u*)(ldsw + (k + 1) * 128 + sg * 16 + 4 * q); id[4 * q] = (int)v.x; id[4 * q + 1] = (int)v.y; id[4 * q + 2] = (int)v.z; id[4 * q + 3] = (int)v.w; }
#pragma unroll
            for (int it = 0; it < 16; ++it) qn[it] = *(const GAS v4u*)(ubase + (size_t)id[it] * 2048); }
        float h[16] = {bflo(ha.x), bfhi(ha.x), bflo(ha.y), bfhi(ha.y), bflo(ha.z), bfhi(ha.z), bflo(ha.w), bfhi(ha.w), bflo(hb.x), bfhi(hb.x), bflo(hb.y), bfhi(hb.y), bflo(hb.z), bfhi(hb.z), bflo(hb.w), bfhi(hb.w)};
        float hm = 0.f;
#pragma unroll
        for (int j = 0; j < 16; ++j) hm = fmaxf(hm, fabsf(h[j]));
        hm = fmaxf(hm, __shfl_xor(hm, 1)); hm = fmaxf(hm, __shfl_xor(hm, 2)); hm = fmaxf(hm, __shfl_xor(hm, 4));
        const float hinv = hm > 0.f ? 127.0f / hm : 0.f, hs = hm * (1.0f / 127.0f);
        int hq[4];
#pragma unroll
        for (int j = 0; j < 4; ++j) hq[j] = (int)pack_i8x4(h[4 * j] * hinv, h[4 * j + 1] * hinv, h[4 * j + 2] * hinv, h[4 * j + 3] * hinv);
        float p[16];
#pragma unroll
        for (int it = 0; it < 16; ++it) { int a = __builtin_amdgcn_sdot4((int)qc[it].x, hq[0], 0, false); a = __builtin_amdgcn_sdot4((int)qc[it].y, hq[1], a, false);
            a = __builtin_amdgcn_sdot4((int)qc[it].z, hq[2], a, false); a = __builtin_amdgcn_sdot4((int)qc[it].w, hq[3], a, false);
            p[it] = (float)a * hs; }
#pragma unroll
        for (int i = 0; i < 8; ++i) { const bool up = (lane & 4) != 0; const float snd = up ? p[i] : p[i + 8], kp = up ? p[i + 8] : p[i]; p[i] = kp + __shfl_xor(snd, 4); }
#pragma unroll
        for (int i = 0; i < 4; ++i) { const bool up = (lane & 2) != 0; const float snd = up ? p[i] : p[i + 4], kp = up ? p[i + 4] : p[i]; p[i] = kp + __shfl_xor(snd, 2); }
#pragma unroll
        for (int i = 0; i < 2; ++i) { const bool up = (lane & 1) != 0; const float snd = up ? p[i] : p[i + 2], kp = up ? p[i + 2] : p[i]; p[i] = kp + __shfl_xor(snd, 1); }
        f32x2v o; o.x = p[0]; o.y = p[1];
        *(GAS f32x2v*)(part + ((size_t)t * 16 + s) * 128 + 2 * lane) = o;
    }
    LDS_WAIT();
}
__device__ __forceinline__ void peer_coef_token(int t, int lane, const float* part, const int* sel_e, float* sel_g, const float* sel_s, const float* US, const float* VS) {
    float a0 = 0.f, a1 = 0.f;
#pragma unroll
    for (int s = 0; s < 16; ++s) { const f32x2v v = *(const GAS f32x2v*)(part + ((size_t)t * 16 + s) * 128 + 2 * lane); a0 += v.x; a1 += v.y; }
    const v2u e = *(const GAS v2u*)(sel_e + (size_t)t * 128 + 2 * lane);
    const f32x2v g = *(const GAS f32x2v*)(sel_g + (size_t)t * 128 + 2 * lane);
    const float inv = 1.0f / ((const GAS float*)sel_s)[(size_t)t * 8 + (lane >> 3)];
    f32x2v o; o.x = g.x * inv * gelu_exact(a0 * ((const GAS float*)US)[e.x]) * ((const GAS float*)VS)[e.x]; o.y = g.y * inv * gelu_exact(a1 * ((const GAS float*)US)[e.y]) * ((const GAS float*)VS)[e.y];
    *(GAS f32x2v*)(sel_g + (size_t)t * 128 + 2 * lane) = o;
}
__device__ __forceinline__ void peer_spmm_wave(int t0, int s, int lane, const unsigned char* VQ, const int* sel_e, const float* coef, const float* x1, float* xout, LAS unsigned* ldsw) {
    const int cg = lane & 7, sg = lane >> 3;
#pragma unroll
    for (int j = 0; j < 4; ++j) { *(LAS v4u*)(ldsw + 4 * (lane + 64 * j)) = *(const GAS v4u*)(sel_e + (size_t)t0 * 128 + 4 * (lane + 64 * j));
        *(LAS v4u*)(ldsw + 1024 + 4 * (lane + 64 * j)) = *(const GAS v4u*)(coef + (size_t)t0 * 128 + 4 * (lane + 64 * j)); }
    LDS_WAIT();
    const unsigned char* vbase = VQ + s * 128 + cg * 16;
    v4u qn[16];
    { int id[16];
#pragma unroll
      for (int q = 0; q < 4; ++q) { const v4u v = *(const LAS v4u*)(ldsw + sg * 16 + 4 * q); id[4 * q] = (int)v.x; id[4 * q + 1] = (int)v.y; id[4 * q + 2] = (int)v.z; id[4 * q + 3] = (int)v.w; }
#pragma unroll
      for (int it = 0; it < 16; ++it) qn[it] = *(const GAS v4u*)(vbase + (size_t)id[it] * 2048); }
    f32x2v xn = *(const GAS f32x2v*)(x1 + (size_t)t0 * 2048 + s * 128 + cg * 16 + 2 * sg);
#pragma unroll 1
    for (int k = 0; k < 8; ++k) {
        const int t = t0 + k;
        v4u qc[16];
#pragma unroll
        for (int it = 0; it < 16; ++it) qc[it] = qn[it];
        const size_t off = (size_t)t * 2048 + s * 128 + cg * 16 + 2 * sg;
        const f32x2v xv = xn;
        if (k < 7) xn = *(const GAS f32x2v*)(x1 + off + 2048);
        float cf[16];
#pragma unroll
        for (int q = 0; q < 4; ++q) { const v4u w = *(const LAS v4u*)(ldsw + 1024 + k * 128 + sg * 16 + 4 * q); cf[4 * q] = __uint_as_float(w.x); cf[4 * q + 1] = __uint_as_float(w.y); cf[4 * q + 2] = __uint_as_float(w.z); cf[4 * q + 3] = __uint_as_float(w.w); }
        if (k < 7) { int id[16];
#pragma unroll
            for (int q = 0; q < 4; ++q) { const v4u v = *(const LAS v4u*)(ldsw + (k + 1) * 128 + sg * 16 + 4 * q); id[4 * q] = (int)v.x; id[4 * q + 1] = (int)v.y; id[4 * q + 2] = (int)v.z; id[4 * q + 3] = (int)v.w; }
#pragma unroll
            for (int it = 0; it < 16; ++it) qn[it] = *(const GAS v4u*)(vbase + (size_t)id[it] * 2048); }
        f32x2v y[8];
#pragma unroll
        for (int j = 0; j < 8; ++j) y[j] = (f32x2v){0.f, 0.f};
#pragma unroll
        for (int it = 0; it < 16; ++it) { f32x2v f[8]; unpack16p(qc[it], f); const f32x2v c2 = {cf[it], cf[it]};
#pragma unroll
            for (int j = 0; j < 8; ++j) y[j] = __builtin_elementwise_fma(f[j], c2, y[j]); }
        float yy[16];
#pragma unroll
        for (int j = 0; j < 8; ++j) { yy[2 * j] = y[j].x; yy[2 * j + 1] = y[j].y; }
#pragma unroll
        for (int i = 0; i < 8; ++i) { const bool up = (lane & 32) != 0; const float snd = up ? yy[i] : yy[i + 8], kp = up ? yy[i + 8] : yy[i]; yy[i] = kp + __shfl_xor(snd, 32); }
#pragma unroll
        for (int i = 0; i < 4; ++i) { const bool up = (lane & 16) != 0; const float snd = up ? yy[i] : yy[i + 4], kp = up ? yy[i + 4] : yy[i]; yy[i] = kp + __shfl_xor(snd, 16); }
#pragma unroll
        for (int i = 0; i < 2; ++i) { const bool up = (lane & 8) != 0; const float snd = up ? yy[i] : yy[i + 2], kp = up ? yy[i + 2] : yy[i]; yy[i] = kp + __shfl_xor(snd, 8); }
        f32x2v o; o.x = xv.x + yy[0]; o.y = xv.y + yy[1];
        *(GAS f32x2v*)(xout + off) = o;
    }
    LDS_WAIT();
}

struct Args { const float* in[21]; float* out; unsigned char* ws; int lo, hi, li, pad; };
__global__ void __launch_bounds__(512, 2) mk_fwd(Args args) {
    extern __shared__ __attribute__((aligned(16))) unsigned char lds_raw[];
    Ctx c; c.lds = (LAS unsigned char*)lds_raw; c.tid = threadIdx.x; c.lane = c.tid & 63; c.wave = __builtin_amdgcn_readfirstlane(c.tid >> 6);
    c.G = gridDim.x; c.gw = blockIdx.x * 8 + c.wave; c.NGW = c.G * 8;
    volatile LAS unsigned* MISC = (volatile LAS unsigned*)(c.lds + MISC_OFF);
    if (c.tid < 32) MISC[c.tid] = 0u;
    __syncthreads();
    unsigned char* ws = args.ws;
    const int lo = args.lo, hi = args.hi;
    XcdBarrier bar; bar.bar = (unsigned*)(ws + WS_CTL) + CW_BAR + args.li * XCD_BAR_WORDS; bar.x = 0; bar.st = nullptr;
    if (hi - lo > 1) bar = xcd_barrier_post((unsigned*)(ws + WS_CTL) + CW_BAR + args.li * XCD_BAR_WORDS, MISC + 8);
#ifndef ATTN_REPS
#define ATTN_REPS 1
#endif
#ifndef PHMASK
#define PHMASK 0x1fff
#endif
#define IN(k) (((PHMASK >> ((k) % NPH)) & 1) && lo <= (k) && (k) < hi)
#define SEAM(k) do { if (IN(k) && IN((k) + 1)) xcd_barrier(bar); } while (0)
#define PH_BEGIN unsigned char* w = ws; float* outp = args.out; Ctx cc = c; int zi = 0; \
    asm volatile("" : "+s"(w), "+s"(outp), "+s"(zi), "+v"(cc.tid), "+v"(cc.lane)); (void)w; (void)outp;
#define INP(k) (args.in[(k) + zi])
#define WSP(T, off) ((T*)(w + (off)))
    for (int l = 0; l < 2; ++l) {
        const int pb = l * NPH;
        if (IN(pb + 0)) { PH_BEGIN
            P0Args a; a.w_in = INP(2) + (size_t)l * DM * INW; a.w_br_sb = INP(11) + (size_t)l * BW * DM; a.w_br_hg = INP(12) + (size_t)l * BW * DM; a.w_br_conv = INP(13) + (size_t)l * BW * DM;
            a.w_o = INP(14) + (size_t)l * DM * DM; a.w_q = INP(16) + (size_t)l * DM * DM; a.u = INP(19) + (size_t)l * 16384 * 2048; a.v = INP(20) + (size_t)l * 16384 * 2048; a.lbp = INP(5);
            a.WinT = WSP(bf16, WS_WIN); a.WbrT = WSP(bf16, WS_WBR); a.WoT = WSP(bf16, WS_WO); a.WqT = WSP(bf16, WS_WQ); a.U = WSP(unsigned char, WS_U); a.V = WSP(unsigned char, WS_V); a.US = WSP(float, WS_US); a.VS = WSP(float, WS_VS); a.LB = WSP(float, WS_LB); a.layer = l; a.k1 = INP(17) + (size_t)l * 8 * 16384; a.k2 = INP(18) + (size_t)l * 8 * 16384; a.KB = WSP(bf16, WS_KEYS);
            p0_convert(cc, a);
            rms_phase_i8(cc, l == 0 ? INP(0) : WSP(const float, WS_X2), INP(1) + (size_t)l * DM, WSP(unsigned char, WS_H), WSP(float, WS_SA));
        }
        SEAM(pb + 0);
        if (IN(pb + 1)) { PH_BEGIN
            pg8::Gemm g{WSP(bf16, WS_H), WSP(bf16, WS_WIN), NTOK, INW, DM}; pg8::StaticOrder S; S.init(NTOK, INW, cc.G, (int)blockIdx.x);
            EpiIn E{WSP(bf16, WS_SEG), WSP(bf16, WS_GATE), WSP(float, WS_LB), WSP(float, WS_SA)};
            pg8::gemm_phase<EpiIn, pg8::StaticOrder, true, true, true>(cc.lds, g, S, E);
        }
        SEAM(pb + 1);
        if (IN(pb + 2)) { PH_BEGIN
            bf16* SEG = WSP(bf16, WS_SEG);
            conv_phase(cc, SEG + 7 * SEGSZ, INP(7) + (size_t)l * 31 * 1024, INP(8) + (size_t)l * 1024, INP(9) + (size_t)l * 1024, INP(10) + (size_t)l * 1024, WSP(bf16, WS_CONV));
            for (int ci = blockIdx.x; ci < 2048; ci += cc.G) hgA_chunk(cc, ci, SEG + 4 * SEGSZ, SEG + 5 * SEGSZ, WSP(bf16, WS_ST), WSP(float, WS_DEC));
            for (int r = cc.gw; r < 2 * NTOK; r += cc.NGW) {
                if (r < NTOK) qknorm_row(SEG + (size_t)r * 1024, INP(3) + (size_t)l * 128, 0.08838834764831845f, cc.lane);
                else qknorm_row(SEG + SEGSZ + (size_t)(r - NTOK) * 1024, INP(4) + (size_t)l * 128, 1.0f, cc.lane);
            }
            LAS unsigned short* scr = (LAS unsigned short*)(cc.lds + 4096 + cc.wave * 8192);
            for (int it = cc.gw; it < 8192; it += cc.NGW) vt_item(it, cc.lane, SEG + 2 * SEGSZ, WSP(bf16, WS_MERGED), scr);
        }
        SEAM(pb + 2);
        if (IN(pb + 3)) { PH_BEGIN
            bf16* SEG = WSP(bf16, WS_SEG);
            hgB(cc, WSP(bf16, WS_ST), WSP(float, WS_DEC));
            for (int rep = 0; rep < ATTN_REPS; ++rep)
            for (int p = blockIdx.x; p < 256; p += cc.G) { const int bh = (p & 7) * 4 + (p >> 6), j = (p >> 3) & 7;
                attn_unit(cc, bh, 15 - j, SEG, SEG + SEGSZ, WSP(bf16, WS_MERGED), SEG + 2 * SEGSZ); attn_unit(cc, bh, j, SEG, SEG + SEGSZ, WSP(bf16, WS_MERGED), SEG + 2 * SEGSZ); }
        }
        SEAM(pb + 3);
        if (IN(pb + 4)) { PH_BEGIN
            bf16* SEG = WSP(bf16, WS_SEG);
            for (int ci = blockIdx.x; ci < 2048; ci += cc.G) hgC_chunk(cc, ci, SEG + 3 * SEGSZ, SEG + 4 * SEGSZ, SEG + 5 * SEGSZ, SEG + 6 * SEGSZ, WSP(bf16, WS_ST), INP(6) + (size_t)l * 128, WSP(bf16, WS_HGR));
        }
        SEAM(pb + 4);
        if (IN(pb + 5)) { PH_BEGIN
            pg8::StaticOrder S; S.init(NTOK, DM, cc.G, (int)blockIdx.x);
            { pg8::Gemm g{WSP(bf16, WS_SEG) + 2 * SEGSZ, WSP(bf16, WS_WBR), NTOK, DM, BW}; EpiMerge<true> E{WSP(bf16, WS_GATE), WSP(bf16, WS_MERGED)}; pg8::gemm_phase<EpiMerge<true>, pg8::StaticOrder, true, true>(cc.lds, g, S, E); }
            { pg8::Gemm g{WSP(bf16, WS_HGR), WSP(bf16, WS_WBR) + (size_t)DM * BW, NTOK, DM, BW}; EpiMerge<false> E{WSP(bf16, WS_GATE) + (size_t)NTOK * 2048, WSP(bf16, WS_MERGED)}; pg8::gemm_phase<EpiMerge<false>, pg8::StaticOrder, true, true>(cc.lds, g, S, E); }
            { pg8::Gemm g{WSP(bf16, WS_CONV), WSP(bf16, WS_WBR) + (size_t)2 * DM * BW, NTOK, DM, BW}; EpiMerge<false> E{WSP(bf16, WS_GATE) + (size_t)2 * NTOK * 2048, WSP(bf16, WS_MERGED)}; pg8::gemm_phase<EpiMerge<false>, pg8::StaticOrder, true, true>(cc.lds, g, S, E); }
        }
        SEAM(pb + 5);
        if (IN(pb + 6)) { PH_BEGIN
            pg8::Gemm g{WSP(bf16, WS_MERGED), WSP(bf16, WS_WO), NTOK, DM, DM}; pg8::StaticOrder S; S.init(NTOK, DM, cc.G, (int)blockIdx.x);
            EpiResid E{l == 0 ? INP(0) : WSP(const float, WS_X2), outp};
            pg8::gemm_phase<EpiResid, pg8::StaticOrder, true, true>(cc.lds, g, S, E);
        }
        SEAM(pb + 6);
        if (IN(pb + 7)) { PH_BEGIN rms_phase(cc, outp, INP(15) + (size_t)l * DM, WSP(bf16, WS_H)); }
        SEAM(pb + 7);
        if (IN(pb + 8)) { PH_BEGIN
            pg8::Gemm g{WSP(bf16, WS_H), WSP(bf16, WS_WQ), NTOK, DM, DM}; pg8::StaticOrder S; S.init(NTOK, DM, cc.G, (int)blockIdx.x);
            EpiResid E{nullptr, WSP(float, WS_QPEER)};
            pg8::gemm_phase<EpiResid, pg8::StaticOrder, true, true>(cc.lds, g, S, E);
        }
        SEAM(pb + 8);
        if (IN(pb + 9)) { PH_BEGIN
            for (int it = cc.gw; it < (NTOK / 32) * 8; it += cc.NGW)
                peer_select32(it, cc.lane, WSP(float, WS_QPEER), WSP(bf16, WS_KEYS), WSP(int, WS_SEL), WSP(float, WS_SEL + 8 * MiB), WSP(float, WS_SELS));
        }
        SEAM(pb + 9);
        if (IN(pb + 10)) { PH_BEGIN
            const SliceSched SS = slice_sched_init(cc, (unsigned*)(w + WS_CTL), bar, l * 2 + 0);
            for (int i = 0;; ++i) { int sl, tb; if (!slice_item(SS, cc, i, sl, tb)) break;
                peer_sddmm_wave(tb * 64 + cc.wave * 8, sl, cc.lane, WSP(bf16, WS_H), WSP(unsigned char, WS_U), WSP(int, WS_SEL), WSP(float, WS_PART), (LAS unsigned*)(cc.lds + 4096 + cc.wave * 8192)); }
        }
        SEAM(pb + 10);
        if (IN(pb + 11)) { PH_BEGIN
            for (int n = cc.gw; n < NTOK; n += cc.NGW) peer_coef_token(n, cc.lane, WSP(float, WS_PART), WSP(int, WS_SEL), WSP(float, WS_SEL + 8 * MiB), WSP(float, WS_SELS), WSP(float, WS_US), WSP(float, WS_VS));
        }
        SEAM(pb + 11);
        if (IN(pb + 12)) { PH_BEGIN
            float* xo = l == 0 ? WSP(float, WS_X2) : outp;
            const SliceSched SS = slice_sched_init(cc, (unsigned*)(w + WS_CTL), bar, l * 2 + 1);
            for (int i = 0;; ++i) { int sl, tb; if (!slice_item(SS, cc, i, sl, tb)) break;
                peer_spmm_wave(tb * 64 + cc.wave * 8, sl, cc.lane, WSP(unsigned char, WS_V), WSP(int, WS_SEL), WSP(float, WS_SEL + 8 * MiB), outp, xo, (LAS unsigned*)(cc.lds + 4096 + cc.wave * 8192)); }
        }
        SEAM(pb + 12);
    }
#undef PH_BEGIN
#undef INP
#undef WSP
#undef IN
#undef SEAM
}

#ifndef MK_SPLIT
#define MK_SPLIT 0
#endif
extern "C" void kernel_launch(void* const* d_in, const int* in_sizes, int n_in, void* d_out, int out_size, void* d_ws, size_t ws_size, hipStream_t stream) {
    static int grid = 0;
    if (grid == 0) {
        if (n_in != 21 || out_size != NTOK * DM || ws_size < WS_END) { fprintf(stderr, "kernel_launch: unexpected shapes (n_in %d, out %d, ws %zu < %zu); nothing launched\n", n_in, out_size, ws_size, (size_t)WS_END); grid = -1; return; }
        int dev = 0, cus = 0, per_cu = 0;
        if (hipGetDevice(&dev) != hipSuccess || hipDeviceGetAttribute(&cus, hipDeviceAttributeMultiprocessorCount, dev) != hipSuccess) { grid = -1; return; }
        if (hipFuncSetAttribute((const void*)mk_fwd, hipFuncAttributeMaxDynamicSharedMemorySize, LDS_BYTES) != hipSuccess) { fprintf(stderr, "kernel_launch: hipFuncSetAttribute failed\n"); grid = -1; return; }
        if (hipOccupancyMaxActiveBlocksPerMultiprocessor(&per_cu, (const void*)mk_fwd, 512, LDS_BYTES) != hipSuccess || per_cu < 1) fprintf(stderr, "kernel_launch: occupancy query reports %d\n", per_cu);
        (void)hipGetLastError();
        grid = cus;
    }
    if (grid < 0) return;
    if (hipMemsetAsync((char*)d_ws + WS_CTL, 0, 1 * MiB, stream) != hipSuccess) { fprintf(stderr, "kernel_launch: memset failed\n"); return; }
    Args a{};
    for (int i = 0; i < 21; ++i) a.in[i] = (const float*)d_in[i];
    a.out = (float*)d_out; a.ws = (unsigned char*)d_ws; a.pad = 0;
#if MK_SPLIT
    for (int p = 0; p < NPHASES; ++p) { a.lo = p; a.hi = p + 1; a.li = p; hipLaunchKernelGGL(mk_fwd, dim3(grid), dim3(512), LDS_BYTES, stream, a); }
#else
    a.lo = 0; a.hi = NPHASES; a.li = 0;
    hipLaunchKernelGGL(mk_fwd, dim3(grid), dim3(512), LDS_BYTES, stream, a);
#endif
    const hipError_t le = hipPeekAtLastError();
    if (le != hipSuccess) fprintf(stderr, "kernel_launch: launch failed: %s\n", hipGetErrorName(le));
}
```

```cpp
#include <hip/hip_runtime.h>
#include <cstdio>
#include <cstdint>
namespace pg8 {
#define PG8_LAS __attribute__((address_space(3)))
typedef unsigned short bf16_t;
typedef short bf16x8 __attribute__((ext_vector_type(8)));
typedef float f32x4 __attribute__((ext_vector_type(4)));
typedef unsigned u32x4 __attribute__((ext_vector_type(4)));
constexpr int BM = 256, BK = 64, HALF = 128, HTB = HALF * BK * 2  , STAGE_BYTES = 8 * HTB, NXCD = 8, WGM = 8;

__host__ __device__ __forceinline__ int lds_byte(int r, int c) { const int st = (r >> 4) * 2 + (c >> 5), rr = r & 15, cc = c & 31, ob = rr * 64 + cc * 2; return st * 1024 + (ob ^ (((ob >> 9) & 1) << 5)); }
__host__ __device__ __forceinline__ void stage_rc(int b, int& R, int& C) { const int st = b / 1024, sb = b % 1024, swz = sb ^ (((sb >> 9) & 1) << 5); R = (st >> 1) * 16 + swz / 64; C = (st & 1) * 32 + (swz % 64) / 2; }
__host__ __device__ __forceinline__ int perm32(int rho) { const int n = rho >> 4, i = rho & 15; return 8 * (i >> 2) + 4 * n + (i & 3); }

struct Unit { int pm, pn; };
struct Gemm { const bf16_t* A; const bf16_t* Bt; int M, N, K; };

struct StaticOrder {
    int nM, nN, nwg, G, c;
    __host__ __device__ void init(int M, int N, int G_, int c_) { nM = M / BM; nN = N / BM; nwg = nM * nN; G = G_; c = c_; }
    __host__ __device__ bool next(int i, Unit& u) const {
        const long L = (long)i * G + c; if (L >= nwg) return false;
        int wgid = (int)L; { const int q = nwg / NXCD, r = nwg % NXCD, xcd = wgid % NXCD, off = wgid / NXCD; wgid = (xcd < r ? xcd * (q + 1) : r * (q + 1) + (xcd - r) * q) + off; }
        const int nig = WGM * nN, gid = wgid / nig, fm = gid * WGM, gsz = (nM - fm) < WGM ? (nM - fm) : WGM;
        u.pm = fm + ((wgid % nig) % gsz); u.pn = (wgid % nig) / gsz; return true;
    }
    __device__ __forceinline__ void a_ready(const Unit&) const {}
    __device__ __forceinline__ void done(const Unit&) const {}
};

typedef float f32x2 __attribute__((ext_vector_type(2)));
template <class Epi, class Sched, bool ALIGN_EPI = false, bool SP2 = false, bool I8 = false>
__device__ __forceinline__ void gemm_phase(PG8_LAS unsigned char* lds, const Gemm g, const Sched& S, const Epi& E) {
    int tid_ = threadIdx.x; asm volatile("" : "+v"(tid_)); int K_ = g.K; asm volatile("" : "+s"(K_));
    const int tid = tid_, wid = __builtin_amdgcn_readfirstlane(tid >> 6), lane = tid & 63, wr = wid >> 2, wc = wid & 3, fr = lane & 15, fq = lane >> 4;
    const int K = I8 ? (K_ >> 1) : K_, nt = K / BK;
    unsigned voffA[2], voffB[2];
#pragma unroll
    for (int i = 0; i < 2; ++i) { int R, C; stage_rc(tid * 16 + i * 8192, R, C); const int Rb = Epi::PERM ? ((R & ~31) + perm32(R & 31)) : R;
        voffA[i] = (unsigned)(R * K + C) * 2u; voffB[i] = (unsigned)(Rb * K + C) * 2u; }
    const size_t kstep = (size_t)(BK * 2);
    const size_t hstep = (size_t)HALF * K * 2;
    const size_t tstep = 2 * hstep;
    const unsigned ldsw = (unsigned)wid * 1024u;
    const int aoff = lds_byte(wr * 64 + fr, fq * 8), boff = lds_byte(wc * 32 + fr, fq * 8);
#define PG8_SA(b, h) (((b) * 2 + (h)) * HTB)
#define PG8_SB(b, h) ((4 + (b) * 2 + (h)) * HTB)
#define PG8_STAGE(bufoff, gbase, voff) do { _Pragma("unroll") for (int _i = 0; _i < 2; ++_i) \
        __builtin_amdgcn_global_load_lds((const unsigned*)((const char*)(gbase) + (voff)[_i]), (PG8_LAS unsigned*)(lds + (bufoff) + ldsw + _i * 8192), 16, 0, 0); } while (0)
#define PG8_LDA(dst, b, h) do { _Pragma("unroll") for (int m = 0; m < 4; ++m) _Pragma("unroll") for (int k = 0; k < 2; ++k) dst[m][k] = *(const PG8_LAS bf16x8*)(lds + PG8_SA(b, h) + aoff + m * 2048 + k * 1024); } while (0)
#define PG8_LDB(dst, b, h) do { _Pragma("unroll") for (int n = 0; n < 2; ++n) _Pragma("unroll") for (int k = 0; k < 2; ++k) dst[n][k] = *(const PG8_LAS bf16x8*)(lds + PG8_SB(b, h) + boff + n * 2048 + k * 1024); } while (0)
#define PG8_MMA(ai, bj, At, Bt) do { __builtin_amdgcn_s_setprio(1); _Pragma("unroll") for (int m = 0; m < 4; ++m) _Pragma("unroll") for (int n = 0; n < 2; ++n) _Pragma("unroll") for (int k = 0; k < 2; ++k) { \
        if constexpr (I8) { typedef int v4i_t __attribute__((ext_vector_type(4))); \
            acc[ai][bj][m][n] = __builtin_bit_cast(f32x4, __builtin_amdgcn_mfma_i32_16x16x64_i8(__builtin_bit_cast(v4i_t, Bt[n][k]), __builtin_bit_cast(v4i_t, At[m][k]), __builtin_bit_cast(v4i_t, acc[ai][bj][m][n]), 0, 0, 0)); } \
        else acc[ai][bj][m][n] = __builtin_amdgcn_mfma_f32_16x16x32_bf16(Bt[n][k], At[m][k], acc[ai][bj][m][n], 0, 0, 0); } __builtin_amdgcn_s_setprio(0); } while (0)
#define PG8_WAIT_V(n) asm volatile("s_waitcnt vmcnt(" #n ")" ::: "memory")
#define PG8_WAIT_L(n) asm volatile("s_waitcnt lgkmcnt(" #n ")" ::: "memory")
#define PG8_BAR __builtin_amdgcn_s_barrier()
#define PG8_SCHED __builtin_amdgcn_sched_barrier(0)
    Unit cur, nxt; int ui = 0;
    if (!S.next(0, cur)) return;
    f32x4 acc[2][2][4][2];
#pragma unroll
    for (int a = 0; a < 2; ++a)
#pragma unroll
        for (int b = 0; b < 2; ++b)
#pragma unroll
            for (int m = 0; m < 4; ++m)
#pragma unroll
                for (int n = 0; n < 2; ++n) acc[a][b][m][n] = (f32x4){0.f, 0.f, 0.f, 0.f};
    bf16x8 At[4][2], B0[2][2], B1[2][2];
    const char* cA = (const char*)g.A + (size_t)cur.pm * tstep; const char* cB = (const char*)g.Bt + (size_t)cur.pn * tstep;
    S.a_ready(cur);
    if constexpr (SP2) {
        PG8_STAGE(PG8_SB(0, 0), cB, voffB); PG8_STAGE(PG8_SB(0, 1), cB + hstep, voffB); PG8_STAGE(PG8_SA(0, 0), cA, voffA); PG8_STAGE(PG8_SA(0, 1), cA + hstep, voffA);
        if (wr == 1) PG8_BAR;
        PG8_WAIT_V(2); PG8_BAR;
        PG8_STAGE(PG8_SB(1, 0), cB + kstep, voffB); PG8_STAGE(PG8_SA(1, 0), cA + kstep, voffA); PG8_STAGE(PG8_SB(1, 1), cB + hstep + kstep, voffB);
        PG8_WAIT_V(6); PG8_BAR;
    } else {
        PG8_STAGE(PG8_SB(0, 0), cB, voffB); PG8_STAGE(PG8_SA(0, 0), cA, voffA); PG8_STAGE(PG8_SB(0, 1), cB + hstep, voffB); PG8_STAGE(PG8_SA(0, 1), cA + hstep, voffA);
        if (wr == 1) PG8_BAR;
        PG8_WAIT_V(4); PG8_BAR;
        PG8_STAGE(PG8_SB(1, 0), cB + kstep, voffB); PG8_STAGE(PG8_SA(1, 0), cA + kstep, voffA); PG8_STAGE(PG8_SB(1, 1), cB + hstep + kstep, voffB);
        PG8_WAIT_V(6); PG8_BAR;
    }
    for (;;) {
        const bool has_next = S.next(ui + 1, nxt);
        const char* nA = has_next ? (const char*)g.A + (size_t)nxt.pm * tstep : cA; const char* nB = has_next ? (const char*)g.Bt + (size_t)nxt.pn * tstep : cB;
        for (int t = 0; t < nt; t += 2) {
            const bool last = (t == nt - 2);
            const char* a1 = cA + (size_t)(t + 1) * kstep;
            const char* a2 = last ? nA : cA + (size_t)(t + 2) * kstep; const char* b2 = last ? nB : cB + (size_t)(t + 2) * kstep;
            const char* a3 = a2 + kstep; const char* b3 = b2 + kstep;
            if (last && has_next) S.a_ready(nxt);
            if constexpr (SP2) {
            PG8_LDB(B0, 0, 0); PG8_LDB(B1, 0, 1); PG8_SCHED; PG8_LDA(At, 0, 0); PG8_STAGE(PG8_SA(1, 1), a1 + hstep, voffA);
            PG8_WAIT_V(8); PG8_WAIT_L(0); PG8_BAR; PG8_MMA(0, 0, At, B0); PG8_MMA(0, 1, At, B1); PG8_BAR; PG8_SCHED;
            PG8_LDA(At, 0, 1); PG8_STAGE(PG8_SB(0, 0), b2, voffB); PG8_STAGE(PG8_SB(0, 1), b2 + hstep, voffB); PG8_STAGE(PG8_SA(0, 0), a2, voffA);
            PG8_WAIT_V(8); PG8_WAIT_L(0); PG8_BAR; PG8_MMA(1, 0, At, B0); PG8_MMA(1, 1, At, B1); PG8_BAR; PG8_SCHED;
            PG8_LDB(B0, 1, 0); PG8_LDB(B1, 1, 1); PG8_SCHED; PG8_LDA(At, 1, 0); PG8_STAGE(PG8_SA(0, 1), a2 + hstep, voffA);
            PG8_WAIT_V(8); PG8_WAIT_L(0); PG8_BAR; PG8_MMA(0, 0, At, B0); PG8_MMA(0, 1, At, B1); PG8_BAR; PG8_SCHED;
            PG8_LDA(At, 1, 1); PG8_STAGE(PG8_SB(1, 0), b3, voffB); PG8_STAGE(PG8_SB(1, 1), b3 + hstep, voffB); PG8_STAGE(PG8_SA(1, 0), a3, voffA);
            PG8_WAIT_V(8); PG8_WAIT_L(0); PG8_BAR; PG8_MMA(1, 0, At, B0); PG8_MMA(1, 1, At, B1); PG8_BAR; PG8_SCHED;
            } else {
            PG8_LDB(B0, 0, 0); PG8_SCHED; PG8_LDA(At, 0, 0); PG8_STAGE(PG8_SA(1, 1), a1 + hstep, voffA);
            PG8_WAIT_L(8); PG8_BAR; PG8_WAIT_L(0); PG8_MMA(0, 0, At, B0); PG8_BAR; PG8_SCHED;
            PG8_LDB(B1, 0, 1); PG8_STAGE(PG8_SB(0, 0), b2, voffB);
            PG8_BAR; PG8_WAIT_L(0); PG8_MMA(0, 1, At, B1); PG8_BAR;
            PG8_LDA(At, 0, 1); PG8_STAGE(PG8_SA(0, 0), a2, voffA);
            PG8_BAR; PG8_WAIT_L(0); PG8_MMA(1, 0, At, B0); PG8_BAR; PG8_SCHED;
            PG8_STAGE(PG8_SB(0, 1), b2 + hstep, voffB);
            PG8_WAIT_V(6); PG8_BAR; PG8_MMA(1, 1, At, B1); PG8_BAR;
            PG8_LDB(B0, 1, 0); PG8_SCHED; PG8_LDA(At, 1, 0); PG8_STAGE(PG8_SA(0, 1), a2 + hstep, voffA);
            PG8_WAIT_L(8); PG8_BAR; PG8_WAIT_L(0); PG8_MMA(0, 0, At, B0); PG8_BAR; PG8_SCHED;
            PG8_LDB(B1, 1, 1); PG8_STAGE(PG8_SB(1, 0), b3, voffB);
            PG8_BAR; PG8_WAIT_L(0); PG8_MMA(0, 1, At, B1); PG8_BAR;
            PG8_LDA(At, 1, 1); PG8_STAGE(PG8_SA(1, 0), a3, voffA);
            PG8_BAR; PG8_WAIT_L(0); PG8_MMA(1, 0, At, B0); PG8_BAR; PG8_SCHED;
            PG8_STAGE(PG8_SB(1, 1), b3 + hstep, voffB);
            PG8_WAIT_V(6); PG8_BAR; PG8_MMA(1, 1, At, B1); PG8_BAR;
            }
        }
        if constexpr (ALIGN_EPI) { if (wr == 0) PG8_BAR; }
        if constexpr (!Epi::AFTER_DRAIN) { E(acc, cur, wr, wc, fr, fq); S.done(cur); }
        if (!has_next) break;
#pragma unroll
        for (int a = 0; a < 2; ++a)
#pragma unroll
            for (int b = 0; b < 2; ++b)
#pragma unroll
                for (int m = 0; m < 4; ++m)
#pragma unroll
                    for (int n = 0; n < 2; ++n) acc[a][b][m][n] = (f32x4){0.f, 0.f, 0.f, 0.f};
        cur = nxt; cA = nA; cB = nB; ++ui;
        if constexpr (ALIGN_EPI) { if (wr == 1) PG8_BAR; }
    }
    PG8_WAIT_V(0);
    if constexpr (!ALIGN_EPI) { if (wr == 0) PG8_BAR; }
    PG8_BAR;
    if constexpr (Epi::AFTER_DRAIN) { E.fused(acc, cur, wr, wc, fr, fq, lds, wid, lane); S.done(cur); }
#undef PG8_SA
#undef PG8_SB
#undef PG8_STAGE
#undef PG8_LDA
#undef PG8_LDB
#undef PG8_MMA
#undef PG8_WAIT_V
#undef PG8_WAIT_L
#undef PG8_BAR
#undef PG8_SCHED
}
}
#define XB_TMO      128
#define XB_XCNT(j)  (256  + 64 * (j))
#define XB_XSUB(j)  (1280 + 64 * (j))
#define XB_XGEN(j)  (2304 + 64 * (j))
#define XB_TOP      3328
#define XB_TOPGEN   3392
#define XCD_BAR_WORDS 3456
#define XB_SPIN_CAP (1u << 24)
#define LAS __attribute__((address_space(3)))

__device__ __forceinline__ unsigned xb_ld(unsigned* p)              { return __hip_atomic_load(p, __ATOMIC_RELAXED, __HIP_MEMORY_SCOPE_AGENT); }
__device__ __forceinline__ unsigned xb_add(unsigned* p, unsigned v) { return __hip_atomic_fetch_add(p, v, __ATOMIC_RELAXED, __HIP_MEMORY_SCOPE_AGENT); }
__device__ __forceinline__ unsigned xb_xcc_id() { return (unsigned)__builtin_amdgcn_s_getreg((3 << 11) | 20) & 0xFu; }
#define XB_SPIN(cond, bar) do { unsigned _sp = 0; while (cond) { __builtin_amdgcn_s_sleep(1); \
    if ((++_sp & 255u) == 0u) { if (xb_ld(&(bar)[XB_TMO])) break; if (_sp > XB_SPIN_CAP) { atomicAdd(&(bar)[XB_TMO], 1u); break; } } } } while (0)

struct XcdBarrier {
    unsigned* bar; unsigned x;
    volatile LAS unsigned* st;
};

__device__ __forceinline__ XcdBarrier xcd_barrier_post(unsigned* bar, volatile LAS unsigned* st) {
    XcdBarrier b; b.bar = bar; b.x = xb_xcc_id(); b.st = st;
    if (threadIdx.x == 0) (void)xb_add(&bar[XB_XCNT(b.x)], 1u);
    return b;
}
__device__ __forceinline__ void xcd_barrier_complete(unsigned* bar, unsigned x, unsigned& nloc, unsigned& nx) {
    const unsigned G = gridDim.x * gridDim.y * gridDim.z;
    unsigned sum, cnt, mine, sp = 0u;
    for (;;) {
        sum = 0u; cnt = 0u; mine = 0u;
#pragma unroll
        for (unsigned j = 0; j < 16; ++j) { const unsigned c = xb_ld(&bar[XB_XCNT(j)]); sum += c; cnt += (c > 0u) ? 1u : 0u; mine = (j == x) ? c : mine; }
        if (sum == G) break;
        __builtin_amdgcn_s_sleep(1);
        if ((++sp & 255u) == 0u) { if (xb_ld(&bar[XB_TMO])) break; if (sp > XB_SPIN_CAP) { atomicAdd(&bar[XB_TMO], 1u); break; } }
    }
    nloc = mine > 0u ? mine : 1u; nx = cnt > 0u ? cnt : 1u;
}

__device__ __forceinline__ void xcd_barrier(const XcdBarrier& b) {
    asm volatile("s_waitcnt vmcnt(0)" ::: "memory");
    __syncthreads();
    if (threadIdx.x == 0) {
        unsigned* bar = b.bar;
        __builtin_amdgcn_s_waitcnt(0);
        unsigned nloc = b.st[0], nx = b.st[1];
        if (nloc == 0u) { xcd_barrier_complete(bar, b.x, nloc, nx); b.st[0] = nloc; b.st[1] = nx; }
        const unsigned old = xb_add(&bar[XB_XSUB(b.x)], 1u);
        const unsigned gen = old / nloc;
        if (old + 1u == (gen + 1u) * nloc) {
            __builtin_amdgcn_fence(__ATOMIC_RELEASE, "agent");
            asm volatile("s_waitcnt vmcnt(0)" ::: "memory");
            const unsigned og = xb_add(&bar[XB_TOP], 1u);
            const unsigned tg = og / nx;
            if (og + 1u == (tg + 1u) * nx) xb_add(&bar[XB_TOPGEN], 1u);
            else XB_SPIN(xb_ld(&bar[XB_TOPGEN]) == tg, bar);
            __builtin_amdgcn_fence(__ATOMIC_ACQUIRE, "agent");
            xb_add(&bar[XB_XGEN(b.x)], 1u);
            asm volatile("s_waitcnt vmcnt(0)" ::: "memory");
        } else {
            XB_SPIN(xb_ld(&bar[XB_XGEN(b.x)]) == gen, bar);
            __builtin_amdgcn_fence(__ATOMIC_ACQUIRE, "agent");
            asm volatile("s_waitcnt vmcnt(0)" ::: "memory");
        }
    }
    __syncthreads();
}


#define GAS __attribute__((address_space(1)))
typedef unsigned short bf16;
typedef unsigned v4u __attribute__((ext_vector_type(4)));
typedef unsigned v2u __attribute__((ext_vector_type(2)));
typedef float f32x4 __attribute__((ext_vector_type(4)));
typedef float f32x2v __attribute__((ext_vector_type(2)));
typedef float f32x16 __attribute__((ext_vector_type(16)));
typedef short bf16x8 __attribute__((ext_vector_type(8)));
typedef __bf16 bf16v2 __attribute__((ext_vector_type(2)));

constexpr int NTOK = 16384, DM = 2048, SEQ = 4096, INW = 15360, BW = 1024;
constexpr float EPS = 1e-6f;
constexpr float WIN_QS = 1024.0f;
constexpr int NPH = 13;
constexpr int NPHASES = 2 * NPH;

constexpr size_t MiB = 1u << 20;
constexpr size_t WS_CTL = 0;
constexpr size_t WS_LB = 1 * MiB;
constexpr size_t WS_SA = 1 * MiB + 192 * 1024;
constexpr size_t WS_US = 1 * MiB + 64 * 1024, WS_VS = 1 * MiB + 128 * 1024;
constexpr size_t WS_WIN = 2 * MiB;
constexpr size_t WS_WBR = 62 * MiB;
constexpr size_t WS_WO = 74 * MiB;
constexpr size_t WS_WQ = 82 * MiB;
constexpr size_t WS_U = 91 * MiB;
constexpr size_t WS_V = 155 * MiB;
constexpr size_t WS_H = 219 * MiB;
constexpr size_t WS_SEG = 283 * MiB;
constexpr size_t WS_GATE = 539 * MiB;
constexpr size_t WS_X2 = 731 * MiB;
constexpr size_t WS_CONV = 859 * MiB;
constexpr size_t WS_HGR = 891 * MiB;
constexpr size_t WS_MERGED = 923 * MiB;
constexpr size_t WS_SEL = 987 * MiB;
constexpr size_t WS_SELS = 1003 * MiB;
constexpr size_t WS_DEC = 1004 * MiB;
constexpr size_t WS_END = 1005 * MiB;
constexpr size_t WS_ST = WS_H;
constexpr size_t WS_KEYS = 90 * MiB;
constexpr size_t WS_PART = WS_GATE;
constexpr size_t WS_QPEER = WS_SEG;
constexpr size_t SEGSZ = (size_t)NTOK * 1024;
constexpr int CW_BAR = 4096;
constexpr int CW_RANK = 131072;

constexpr int RING_BYTES = 131072, MISC_OFF = RING_BYTES + 320, LDS_BYTES = 147456;

__device__ __forceinline__ unsigned pk2c(float lo, float hi) { f32x2v v = {lo, hi}; bf16v2 b = __builtin_convertvector(v, bf16v2); return __builtin_bit_cast(unsigned, b); }
__device__ __forceinline__ float bflo(unsigned x) { return __uint_as_float(x << 16); }
__device__ __forceinline__ float bfhi(unsigned x) { return __uint_as_float(x & 0xffff0000u); }
__device__ __forceinline__ float sigm(float x) { return __builtin_amdgcn_rcpf(1.0f + __expf(-x)); }
__device__ __forceinline__ float wave_sum(float v) {
#pragma unroll
    for (int o = 1; o < 64; o <<= 1) v += __shfl_xor(v, o);
    return v;
}
__device__ __forceinline__ float wave_max(float v) {
#pragma unroll
    for (int o = 1; o < 64; o <<= 1) v = fmaxf(v, __shfl_xor(v, o));
    return v;
}
#define LDS_WAIT() asm volatile("s_waitcnt lgkmcnt(0)" ::: "memory")
#define MFMA32(a, b, c) __builtin_amdgcn_mfma_f32_32x32x16_bf16((a), (b), (c), 0, 0, 0)
__device__ __forceinline__ int ridx16(int lane) { return ((lane >> 5) & 1) * 8 + ((lane >> 4) & 1) * 4 + ((lane >> 3) & 1) * 2 + ((lane >> 2) & 1); }
__device__ __forceinline__ void xreduce16(float (&v)[16], int lane) {
#pragma unroll
    for (int i = 0; i < 8; ++i) { const bool up = (lane & 32) != 0; const float snd = up ? v[i] : v[i + 8], kp = up ? v[i + 8] : v[i]; v[i] = kp + __shfl_xor(snd, 32); }
#pragma unroll
    for (int i = 0; i < 4; ++i) { const bool up = (lane & 16) != 0; const float snd = up ? v[i] : v[i + 4], kp = up ? v[i + 4] : v[i]; v[i] = kp + __shfl_xor(snd, 16); }
#pragma unroll
    for (int i = 0; i < 2; ++i) { const bool up = (lane & 8) != 0; const float snd = up ? v[i] : v[i + 2], kp = up ? v[i + 2] : v[i]; v[i] = kp + __shfl_xor(snd, 8); }
    { const bool up = (lane & 4) != 0; const float snd = up ? v[0] : v[1], kp = up ? v[1] : v[0]; v[0] = kp + __shfl_xor(snd, 4); }
    v[0] += __shfl_xor(v[0], 2); v[0] += __shfl_xor(v[0], 1);
}
__device__ __forceinline__ float gelu_exact(float v) {
    const float av = fabsf(v), t = __builtin_amdgcn_rcpf(av * 0.2316418882f + 1.0f);
    float q = t * 0.5307027145f + (-0.7265760135f); q = q * t + 0.7107068705f; q = q * t + (-0.142248368f); q = q * t + 0.127414796f; q = q * t;
    const float e = __builtin_amdgcn_exp2f((v * v) * (-0.72134752044f));
    const float m = v * (q * e);
    return v < 0.f ? m : v - m;
}

struct Ctx { LAS unsigned char* lds; int tid, lane, wave, G, gw, NGW; };

__device__ __forceinline__ void tr_item(const float* W, int K, int N, bf16* WT, int k0, int n0, int drow0, LAS float* scr, int lane) {
#pragma unroll 8
    for (int i = 0; i < 32; ++i) { const int kk = 2 * i + (lane >> 5); scr[kk * 33 + (lane & 31)] = ((const GAS float*)W)[(size_t)(k0 + kk) * N + n0 + (lane & 31)]; }
    LDS_WAIT();
    const int c = lane & 7;
#pragma unroll
    for (int j = 0; j < 4; ++j) { const int n = (lane >> 3) + 8 * j; const LAS float* s = scr + (8 * c) * 33 + n;
        v4u o; o.x = pk2c(s[0], s[33]); o.y = pk2c(s[66], s[99]); o.z = pk2c(s[132], s[165]); o.w = pk2c(s[198], s[231]);
        *(GAS v4u*)(WT + (size_t)(drow0 + n) * K + k0 + 8 * c) = o; }
    LDS_WAIT();
}
__device__ __forceinline__ unsigned pack_i8x4c(float a, float b, float c, float d) {
    const int ia = (int)__builtin_rintf(fminf(fmaxf(a, -127.f), 127.f)), ib = (int)__builtin_rintf(fminf(fmaxf(b, -127.f), 127.f)), ic = (int)__builtin_rintf(fminf(fmaxf(c, -127.f), 127.f)), id = (int)__builtin_rintf(fminf(fmaxf(d, -127.f), 127.f));
    return ((unsigned)ia & 255u) | (((unsigned)ib & 255u) << 8) | (((unsigned)ic & 255u) << 16) | ((unsigned)id << 24);
}
__device__ __forceinline__ void tr_item_i8(const float* W, int K, int N, unsigned char* WT, int k0, int n0, int drow0, float scale, LAS float* scr, int lane) {
#pragma unroll 8
    for (int i = 0; i < 32; ++i) { const int kk = 2 * i + (lane >> 5); scr[kk * 33 + (lane & 31)] = ((const GAS float*)W)[(size_t)(k0 + kk) * N + n0 + (lane & 31)]; }
    LDS_WAIT();
    const int c = lane & 7;
#pragma unroll
    for (int j = 0; j < 4; ++j) { const int n = (lane >> 3) + 8 * j; const LAS float* s = scr + (8 * c) * 33 + n;
        v2u o; o.x = pack_i8x4c(s[0] * scale, s[33] * scale, s[66] * scale, s[99] * scale); o.y = pack_i8x4c(s[132] * scale, s[165] * scale, s[198] * scale, s[231] * scale);
        *(GAS v2u*)(WT + (size_t)(drow0 + n) * K + k0 + 8 * c) = o; }
    LDS_WAIT();
}
__device__ __forceinline__ int win_drow(int n) { if (n < 7168 || n >= 9216) return n; const int r = n - 7168, isb = r >> 10, c = r & 1023; return 7168 + (c >> 7) * 256 + isb * 128 + (c & 127); }
__device__ __forceinline__ void cvt_copy(const Ctx& c, const float* src, bf16* dst, size_t n8) {
    const size_t NT = (size_t)c.G * 512;
    for (size_t i = (size_t)blockIdx.x * 512 + c.tid; i < n8; i += NT) {
        const f32x4 a = ((const GAS f32x4*)src)[2 * i], b = ((const GAS f32x4*)src)[2 * i + 1];
        v4u o; o.x = pk2c(a.x, a.y); o.y = pk2c(a.z, a.w); o.z = pk2c(b.x, b.y); o.w = pk2c(b.z, b.w);
        ((GAS v4u*)dst)[i] = o;
    }
}
__device__ __forceinline__ void rms_row(const float* xr, const float* w, bf16* o, int lane) {
    const GAS f32x4* xp = (const GAS f32x4*)xr + lane; f32x4 v[8]; float s = 0.f;
#pragma unroll
    for (int j = 0; j < 8; ++j) { v[j] = xp[64 * j]; s += (v[j].x * v[j].x + v[j].y * v[j].y) + (v[j].z * v[j].z + v[j].w * v[j].w); }
    const float r = __builtin_amdgcn_rsqf(wave_sum(s) * (1.0f / DM) + EPS);
    const GAS f32x4* wp = (const GAS f32x4*)w + lane; GAS v2u* op = (GAS v2u*)o + lane;
#pragma unroll
    for (int j = 0; j < 8; ++j) { const f32x4 wv = wp[64 * j]; v2u q; q.x = pk2c(v[j].x * r * wv.x, v[j].y * r * wv.y); q.y = pk2c(v[j].z * r * wv.z, v[j].w * r * wv.w); op[64 * j] = q; }
}
__device__ __forceinline__ void rms_row_i8(const float* xr, const float* w, unsigned char* o, float* sa, int lane) {
    const GAS f32x4* xp = (const GAS f32x4*)xr + lane; f32x4 v[8]; float s = 0.f;
#pragma unroll
    for (int j = 0; j < 8; ++j) { v[j] = xp[64 * j]; s += (v[j].x * v[j].x + v[j].y * v[j].y) + (v[j].z * v[j].z + v[j].w * v[j].w); }
    const float r = __builtin_amdgcn_rsqf(wave_sum(s) * (1.0f / DM) + EPS);
    const GAS f32x4* wp = (const GAS f32x4*)w + lane; float m = 0.f;
#pragma unroll
    for (int j = 0; j < 8; ++j) { const f32x4 wv = wp[64 * j]; v[j].x *= r * wv.x; v[j].y *= r * wv.y; v[j].z *= r * wv.z; v[j].w *= r * wv.w;
        m = fmaxf(fmaxf(m, fmaxf(fabsf(v[j].x), fabsf(v[j].y))), fmaxf(fabsf(v[j].z), fabsf(v[j].w))); }
    m = wave_max(m);
    const float inv = m > 0.f ? 127.0f / m : 0.f;
    if (lane == 0) *(GAS float*)sa = m * (1.0f / 127.0f);
#pragma unroll
    for (int j = 0; j < 8; ++j) ((GAS unsigned*)o)[lane + 64 * j] = pack_i8x4c(v[j].x * inv, v[j].y * inv, v[j].z * inv, v[j].w * inv);
}
__device__ __forceinline__ void rms_phase_i8(const Ctx& c, const float* x, const float* w, unsigned char* H8, float* SA) {
    for (int m = c.gw; m < NTOK; m += c.NGW) rms_row_i8(x + (size_t)m * DM, w, H8 + (size_t)m * DM, SA + m, c.lane);
}
__device__ __forceinline__ void rms_phase(const Ctx& c, const float* x, const float* w, bf16* H) {
    for (int m = c.gw; m < NTOK; m += c.NGW) rms_row(x + (size_t)m * DM, w, H + (size_t)m * DM, c.lane);
}
__device__ __forceinline__ void fp8_row(const float* src, unsigned char* dst, float* scale_out, int lane) {
    const GAS f32x4* xp = (const GAS f32x4*)src + lane; f32x4 v[8]; float m = 0.f;
#pragma unroll
    for (int j = 0; j < 8; ++j) { v[j] = xp[64 * j]; m = fmaxf(fmaxf(m, fmaxf(fabsf(v[j].x), fabsf(v[j].y))), fmaxf(fabsf(v[j].z), fabsf(v[j].w))); }
    m = wave_max(m);
    const float inv = m > 0.f ? 256.0f / m : 0.f;
    if (lane == 0) *(GAS float*)scale_out = m * (1.0f / 256.0f);
#pragma unroll
    for (int j = 0; j < 8; ++j) { int p = __builtin_amdgcn_cvt_pk_fp8_f32(v[j].x * inv, v[j].y * inv, 0, false); p = __builtin_amdgcn_cvt_pk_fp8_f32(v[j].z * inv, v[j].w * inv, p, true);
        ((GAS unsigned*)dst)[lane + 64 * j] = (unsigned)p; }
}
__device__ __forceinline__ unsigned pack_i8x4(float a, float b, float c, float d) {
    const int ia = (int)__builtin_rintf(a), ib = (int)__builtin_rintf(b), ic = (int)__builtin_rintf(c), id = (int)__builtin_rintf(d);
    return ((unsigned)ia & 255u) | (((unsigned)ib & 255u) << 8) | (((unsigned)ic & 255u) << 16) | ((unsigned)id << 24);
}
__device__ __forceinline__ void i8_row(const float* src, unsigned char* dst, float* scale_out, int lane) {
    const GAS f32x4* xp = (const GAS f32x4*)src + lane; f32x4 v[8]; float m = 0.f;
#pragma unroll
    for (int j = 0; j < 8; ++j) { v[j] = xp[64 * j]; m = fmaxf(fmaxf(m, fmaxf(fabsf(v[j].x), fabsf(v[j].y))), fmaxf(fabsf(v[j].z), fabsf(v[j].w))); }
    m = wave_max(m);
    const float inv = m > 0.f ? 127.0f / m : 0.f;
    if (lane == 0) *(GAS float*)scale_out = m * (1.0f / 127.0f);
#pragma unroll
    for (int j = 0; j < 8; ++j) ((GAS unsigned*)dst)[lane + 64 * j] = pack_i8x4(v[j].x * inv, v[j].y * inv, v[j].z * inv, v[j].w * inv);
}
struct P0Args { const float *w_in, *w_br_sb, *w_br_hg, *w_br_conv, *w_o, *w_q, *u, *v, *lbp; bf16 *WinT, *WbrT, *WoT, *WqT; unsigned char *U, *V; float *US, *VS; float* LB; int layer; const float *k1, *k2; bf16* KB; };
__device__ __forceinline__ void p0_convert(const Ctx& c, const P0Args& a) {
    LAS float* scr = (LAS float*)(c.lds + c.wave * 16384);
    constexpr int I_IN = (DM / 64) * (INW / 32), I_BR = (BW / 64) * (DM / 32), I_SQ = (DM / 64) * (DM / 32);
    constexpr int NITEMS = I_IN + 3 * I_BR + 2 * I_SQ;
    for (int it = c.gw; it < NITEMS; it += c.NGW) {
        int r = it;
        if (r < I_IN) { const int kb = r / (INW / 32), nb = r % (INW / 32); tr_item_i8(a.w_in, DM, INW, (unsigned char*)a.WinT, kb * 64, nb * 32, win_drow(nb * 32), WIN_QS, scr, c.lane); continue; } r -= I_IN;
        if (r < I_BR) { const int kb = r / (DM / 32), nb = r % (DM / 32); tr_item(a.w_br_sb, BW, DM, a.WbrT, kb * 64, nb * 32, nb * 32, scr, c.lane); continue; } r -= I_BR;
        if (r < I_BR) { const int kb = r / (DM / 32), nb = r % (DM / 32); tr_item(a.w_br_hg, BW, DM, a.WbrT + (size_t)DM * BW, kb * 64, nb * 32, nb * 32, scr, c.lane); continue; } r -= I_BR;
        if (r < I_BR) { const int kb = r / (DM / 32), nb = r % (DM / 32); tr_item(a.w_br_conv, BW, DM, a.WbrT + (size_t)2 * DM * BW, kb * 64, nb * 32, nb * 32, scr, c.lane); continue; } r -= I_BR;
        if (r < I_SQ) { const int kb = r / (DM / 32), nb = r % (DM / 32); tr_item(a.w_o, DM, DM, a.WoT, kb * 64, nb * 32, nb * 32, scr, c.lane); continue; } r -= I_SQ;
        { const int kb = r / (DM / 32), nb = r % (DM / 32); tr_item(a.w_q, DM, DM, a.WqT, kb * 64, nb * 32, nb * 32, scr, c.lane); }
    }
    for (int r = c.gw; r < 2 * 16384; r += c.NGW) {
        if (r < 16384) i8_row(a.u + (size_t)r * 2048, a.U + (size_t)r * 2048, a.US + r, c.lane);
        else fp8_row(a.v + (size_t)(r - 16384) * 2048, a.V + (size_t)(r - 16384) * 2048, a.VS + (r - 16384), c.lane);
    }
    cvt_copy(c, a.k1, a.KB, (size_t)8 * 16384 / 8);
    cvt_copy(c, a.k2, a.KB + 8 * 16384, (size_t)8 * 16384 / 8);
    if (blockIdx.x == 0) for (int i = c.tid; i < 1024; i += 512) a.LB[i] = a.layer == 0 ? 0.f : sigm(a.lbp[1024 + i] - a.lbp[i]);
}

struct EpiIn {
    static constexpr bool PERM = true, AFTER_DRAIN = false;
    bf16* seg; bf16* gate; const float* lb; const float* sa;
    static __device__ __forceinline__ pg8::f32x4 cv(const pg8::f32x4 a, float s) { return (pg8::f32x4){(float)__float_as_int(a[0]) * s, (float)__float_as_int(a[1]) * s, (float)__float_as_int(a[2]) * s, (float)__float_as_int(a[3]) * s}; }
    __device__ __forceinline__ void operator()(const pg8::f32x4 (&acc)[2][2][4][2], const pg8::Unit& u, int wr, int wc, int fr, int fq) const {
        const int pn = u.pn; const int row0 = u.pm * 256 + wr * 64 + fr;
        float rs[2][4];
#pragma unroll
        for (int ai = 0; ai < 2; ++ai)
#pragma unroll
            for (int m = 0; m < 4; ++m) rs[ai][m] = ((const GAS float*)sa)[row0 + ai * 128 + m * 16] * (1.0f / WIN_QS);
        if (pn >= 28 && pn < 36) {
            bf16* dst = seg + (size_t)7 * SEGSZ; const int col0 = (pn - 28) * 128 + wc * 32 + 8 * fq;
#pragma unroll
            for (int ai = 0; ai < 2; ++ai)
#pragma unroll
                for (int m = 0; m < 4; ++m) {
                    const pg8::f32x4 a0 = cv(acc[ai][0][m][0], rs[ai][m]), a1 = cv(acc[ai][0][m][1], rs[ai][m]), b0 = cv(acc[ai][1][m][0], rs[ai][m]), b1 = cv(acc[ai][1][m][1], rs[ai][m]);
                    v4u w; w.x = pk2c(a0[0] * sigm(b0[0]), a0[1] * sigm(b0[1])); w.y = pk2c(a0[2] * sigm(b0[2]), a0[3] * sigm(b0[3]));
                    w.z = pk2c(a1[0] * sigm(b1[0]), a1[1] * sigm(b1[1])); w.w = pk2c(a1[2] * sigm(b1[2]), a1[3] * sigm(b1[3]));
                    *(GAS v4u*)(dst + (size_t)(row0 + ai * 128 + m * 16) * 1024 + col0) = w; }
            return;
        }
        bf16* dst; int ld, colt, mode;
        if (pn < 28) { const int sg = pn >> 2; dst = seg + (size_t)sg * SEGSZ; ld = 1024; colt = (pn & 3) * 256; mode = (sg == 4) ? 2 : (sg == 6 ? 1 : 0); }
        else { const int q = pn - 36; dst = gate + (size_t)(q >> 3) * ((size_t)NTOK * 2048); ld = 2048; colt = (q & 7) * 256; mode = 1; }
        const int col0 = colt + wc * 32 + 8 * fq;
        if (mode == 0) {
#pragma unroll
            for (int ai = 0; ai < 2; ++ai)
#pragma unroll
                for (int m = 0; m < 4; ++m)
#pragma unroll
                    for (int bj = 0; bj < 2; ++bj) { const pg8::f32x4 v0 = cv(acc[ai][bj][m][0], rs[ai][m]), v1 = cv(acc[ai][bj][m][1], rs[ai][m]);
                        v4u w; w.x = pk2c(v0[0], v0[1]); w.y = pk2c(v0[2], v0[3]); w.z = pk2c(v1[0], v1[1]); w.w = pk2c(v1[2], v1[3]);
                        *(GAS v4u*)(dst + (size_t)(row0 + ai * 128 + m * 16) * ld + col0 + bj * 128) = w; }
        } else if (mode == 1) {
#pragma unroll
            for (int ai = 0; ai < 2; ++ai)
#pragma unroll
                for (int m = 0; m < 4; ++m)
#pragma unroll
                    for (int bj = 0; bj < 2; ++bj) { const pg8::f32x4 v0 = cv(acc[ai][bj][m][0], rs[ai][m]), v1 = cv(acc[ai][bj][m][1], rs[ai][m]);
                        v4u w; w.x = pk2c(sigm(v0[0]), sigm(v0[1])); w.y = pk2c(sigm(v0[2]), sigm(v0[3])); w.z = pk2c(sigm(v1[0]), sigm(v1[1])); w.w = pk2c(sigm(v1[2]), sigm(v1[3]));
                        *(GAS v4u*)(dst + (size_t)(row0 + ai * 128 + m * 16) * ld + col0 + bj * 128) = w; }
        } else {
            f32x4 l0[2], l1[2];
#pragma unroll
            for (int bj = 0; bj < 2; ++bj) { l0[bj] = *(const GAS f32x4*)(lb + col0 + bj * 128); l1[bj] = *(const GAS f32x4*)(lb + col0 + bj * 128 + 4); }
#pragma unroll
            for (int ai = 0; ai < 2; ++ai)
#pragma unroll
                for (int m = 0; m < 4; ++m)
#pragma unroll
                    for (int bj = 0; bj < 2; ++bj) { const pg8::f32x4 v0 = cv(acc[ai][bj][m][0], rs[ai][m]), v1 = cv(acc[ai][bj][m][1], rs[ai][m]); float r[8];
#pragma unroll
                        for (int j = 0; j < 4; ++j) { r[j] = __logf(l0[bj][j] + (1.0f - l0[bj][j]) * sigm(v0[j])); r[4 + j] = __logf(l1[bj][j] + (1.0f - l1[bj][j]) * sigm(v1[j])); }
                        v4u w; w.x = pk2c(r[0], r[1]); w.y = pk2c(r[2], r[3]); w.z = pk2c(r[4], r[5]); w.w = pk2c(r[6], r[7]);
                        *(GAS v4u*)(dst + (size_t)(row0 + ai * 128 + m * 16) * ld + col0 + bj * 128) = w; }
        }
    }
};

__device__ __forceinline__ void conv_phase(const Ctx& c, const bf16* glu, const float* cw, const float* cb, const float* lnw, const float* lnb, bf16* out) {
    const int c0 = 2 * c.tid;
    float w0[31], w1[31];
#pragma unroll
    for (int j = 0; j < 31; ++j) { const f32x2v t = *(const GAS f32x2v*)(cw + j * 1024 + c0); w0[j] = t.x; w1[j] = t.y; }
    const f32x2v bv = *(const GAS f32x2v*)(cb + c0), lwv = *(const GAS f32x2v*)(lnw + c0), lbv = *(const GAS f32x2v*)(lnb + c0);
    LAS float* red = (LAS float*)c.lds;
    for (int tile = blockIdx.x; tile < NTOK / 8; tile += c.G) {
        const int n0 = tile * 8, tseq0 = n0 & (SEQ - 1);
        float a0[8], a1[8];
#pragma unroll
        for (int t = 0; t < 8; ++t) { a0[t] = bv.x; a1[t] = bv.y; }
#pragma unroll
        for (int r = 0; r < 38; ++r) {
            unsigned xv = 0u;
            if (tseq0 + r - 30 >= 0) xv = *(const GAS unsigned*)(glu + (size_t)(n0 + r - 30) * 1024 + c0);
            const float x0 = bflo(xv), x1 = bfhi(xv);
#pragma unroll
            for (int t = 0; t < 8; ++t) { const int j = r - t; if (j >= 0 && j <= 30) { a0[t] += w0[j] * x0; a1[t] += w1[j] * x1; } }
        }
        float st[16];
#pragma unroll
        for (int t = 0; t < 8; ++t) { st[2 * t] = a0[t] + a1[t]; st[2 * t + 1] = a0[t] * a0[t] + a1[t] * a1[t]; }
        xreduce16(st, c.lane);
        if ((c.lane & 3) == 0) red[c.wave * 16 + ridx16(c.lane)] = st[0];
        __syncthreads();
        if (c.tid < 16) { float s = 0.f;
#pragma unroll
            for (int w = 0; w < 8; ++w) s += red[w * 16 + c.tid];
            red[128 + c.tid] = s; }
        __syncthreads();
#pragma unroll
        for (int t = 0; t < 8; ++t) {
            const float mean = red[128 + 2 * t] * (1.0f / 1024.0f), var = red[128 + 2 * t + 1] * (1.0f / 1024.0f) - mean * mean;
            const float rstd = __builtin_amdgcn_rsqf(var + EPS);
            const float h0 = (a0[t] - mean) * rstd * lwv.x + lbv.x, h1 = (a1[t] - mean) * rstd * lwv.y + lbv.y;
            *(GAS unsigned*)(out + (size_t)(n0 + t) * 1024 + c0) = pk2c(h0 * sigm(h0), h1 * sigm(h1));
        }
        __syncthreads();
    }
}
__device__ __forceinline__ void hgrn_task(int task, int lane, const bf16* qhg, const bf16* logf, const bf16* ihg, bf16* out) {
    const int bh = task >> 6, dvb = task & 63, b = bh >> 3, h = bh & 7;
    const size_t rb = (size_t)b * SEQ * 1024;
    const GAS unsigned* qp = (const GAS unsigned*)(qhg + rb + h * 128) + lane;
    const GAS unsigned* lp = (const GAS unsigned*)(logf + rb + h * 128) + lane;
    const GAS unsigned* ip = (const GAS unsigned*)(ihg + rb + h * 128) + dvb;
    GAS bf16* op = (GAS bf16*)(out + rb + h * 128 + 2 * dvb);
    float S00 = 0.f, S01 = 0.f, S10 = 0.f, S11 = 0.f;
    unsigned qn[8], ln[8], inx[8];
#pragma unroll
    for (int j = 0; j < 8; ++j) { qn[j] = qp[(size_t)j * 512]; ln[j] = lp[(size_t)j * 512]; inx[j] = ip[(size_t)j * 512]; }
    for (int blk = 0; blk < SEQ / 8; ++blk) {
        unsigned qc[8], lc[8], ic[8];
#pragma unroll
        for (int j = 0; j < 8; ++j) { qc[j] = qn[j]; lc[j] = ln[j]; ic[j] = inx[j]; }
        if (blk + 1 < SEQ / 8) {
#pragma unroll
            for (int j = 0; j < 8; ++j) { const size_t o = (size_t)((blk + 1) * 8 + j) * 512; qn[j] = qp[o]; ln[j] = lp[o]; inx[j] = ip[o]; }
        }
        float pv[16];
#pragma unroll
        for (int j = 0; j < 8; ++j) {
            const float f0 = __expf(bflo(lc[j])), f1 = __expf(bfhi(lc[j])), k0 = 1.0f - f0, k1 = 1.0f - f1;
            const float i0 = bflo(ic[j]), i1 = bfhi(ic[j]), q0 = bflo(qc[j]), q1 = bfhi(qc[j]);
            S00 = f0 * S00 + k0 * i0; S01 = f0 * S01 + k0 * i1; S10 = f1 * S10 + k1 * i0; S11 = f1 * S11 + k1 * i1;
            pv[2 * j] = S00 * q0 + S10 * q1; pv[2 * j + 1] = S01 * q0 + S11 * q1;
        }
        xreduce16(pv, lane);
        if ((lane & 3) == 0) { const int idx = ridx16(lane); op[(size_t)(blk * 8 + (idx >> 1)) * 1024 + (idx & 1)] = (bf16)(pk2c(pv[0], 0.f) & 0xffffu); }
    }
}
constexpr int HG_TS = 272;
constexpr int HG_BS = 132;
__device__ __forceinline__ void hg_stage(LAS unsigned char* dst, const bf16* src, int tid) {
#pragma unroll
    for (int i = 0; i < 2; ++i) { const int p = tid + 512 * i, row = p >> 4, c16 = p & 15; *(LAS v4u*)(dst + row * HG_TS + c16 * 16) = *(const GAS v4u*)(src + (size_t)row * 1024 + c16 * 8); }
}
__device__ __forceinline__ void hg_scan(const LAS unsigned char* lft, int dk, int hf, float (&lf)[4][8], float (&b)[4][8], float& bl) {
    float bs[4], pb[4];
#pragma unroll
    for (int kk = 0; kk < 4; ++kk) { float run = 0.f;
#pragma unroll
        for (int j = 0; j < 8; ++j) { lf[kk][j] = __uint_as_float((unsigned)(*(const LAS unsigned short*)(lft + (16 * kk + 8 * hf + j) * HG_TS + dk * 2)) << 16); run += lf[kk][j]; b[kk][j] = run; }
        bs[kk] = run; }
#pragma unroll
    for (int kk = 0; kk < 4; ++kk) pb[kk] = __shfl_xor(bs[kk], 32);
    float pre = 0.f;
#pragma unroll
    for (int kk = 0; kk < 4; ++kk) { const float off = pre + (hf ? pb[kk] : 0.f);
#pragma unroll
        for (int j = 0; j < 8; ++j) b[kk][j] += off;
        pre += bs[kk] + pb[kk]; }
    bl = pre;
}
__device__ __forceinline__ bf16x8 pack8(const float (&v)[8]) { v4u t; t.x = pk2c(v[0], v[1]); t.y = pk2c(v[2], v[3]); t.z = pk2c(v[4], v[5]); t.w = pk2c(v[6], v[7]); return __builtin_bit_cast(bf16x8, t); }
__device__ __forceinline__ unsigned lds_u16(const LAS unsigned char* p) { return (unsigned)(*(const LAS unsigned short*)p); }
__device__ __forceinline__ void hgA_chunk(const Ctx& c, int ci, const bf16* LOGF, const bf16* IHG, bf16* ST, float* DEC) {
    const int bh = ci >> 6, ch = ci & 63, bb = bh >> 3, h = bh & 7; const size_t n0 = (size_t)bb * SEQ + ch * 64;
    LAS unsigned char* lft = c.lds; LAS unsigned char* itl = c.lds + 64 * HG_TS;
    hg_stage(lft, LOGF + n0 * 1024 + h * 128, c.tid); hg_stage(itl, IHG + n0 * 1024 + h * 128, c.tid);
    __syncthreads();
    const int dkt = c.wave & 3, dvh = c.wave >> 2, hf = c.lane >> 5, cl = c.lane & 31, dk = 32 * dkt + cl;
    float lf[4][8], b[4][8], bl; hg_scan(lft, dk, hf, lf, b, bl);
    bf16x8 kf[4];
#pragma unroll
    for (int kk = 0; kk < 4; ++kk) { float v[8];
#pragma unroll
        for (int j = 0; j < 8; ++j) v[j] = (1.0f - __expf(lf[kk][j])) * __expf(bl - b[kk][j]);
        kf[kk] = pack8(v); }
    if (dvh == 0 && hf == 0) ((GAS float*)DEC)[(size_t)ci * 128 + dk] = __expf(bl);
#pragma unroll
    for (int dvi = 0; dvi < 2; ++dvi) { const int dvt = dvh * 2 + dvi;
        f32x16 acc;
#pragma unroll
        for (int r = 0; r < 16; ++r) acc[r] = 0.f;
#pragma unroll
        for (int kk = 0; kk < 4; ++kk) { const LAS unsigned char* p = itl + (16 * kk + 8 * hf) * HG_TS + (32 * dvt + cl) * 2;
            v4u t; t.x = lds_u16(p) | (lds_u16(p + HG_TS) << 16); t.y = lds_u16(p + 2 * HG_TS) | (lds_u16(p + 3 * HG_TS) << 16); t.z = lds_u16(p + 4 * HG_TS) | (lds_u16(p + 5 * HG_TS) << 16); t.w = lds_u16(p + 6 * HG_TS) | (lds_u16(p + 7 * HG_TS) << 16);
            acc = MFMA32(kf[kk], __builtin_bit_cast(bf16x8, t), acc); }
        bf16* o = ST + (size_t)ci * 16384 + (size_t)(32 * dvt + cl) * 128 + 32 * dkt + 4 * hf;
#pragma unroll
        for (int g = 0; g < 4; ++g) { v2u q; q.x = pk2c(acc[4 * g], acc[4 * g + 1]); q.y = pk2c(acc[4 * g + 2], acc[4 * g + 3]); *(GAS v2u*)(o + 8 * g) = q; }
    }
    __syncthreads();
}
__device__ __forceinline__ void hgB(const Ctx& c, bf16* ST, const float* DEC) {
    for (int e = blockIdx.x * 512 + c.tid; e < 32 * 4096; e += c.G * 512) {
        const int bh = e >> 12, r = e & 4095, dv = r >> 5, dk4 = (r & 31) * 4;
        GAS v2u* p = (GAS v2u*)(ST + (size_t)bh * 64 * 16384 + (size_t)dv * 128 + dk4);
        const GAS f32x4* d = (const GAS f32x4*)(DEC + (size_t)bh * 64 * 128 + dk4);
        f32x4 S = {0.f, 0.f, 0.f, 0.f};
#pragma unroll 1
        for (int c0 = 0; c0 < 64; c0 += 8) {
            v2u Lv[8]; f32x4 D[8];
#pragma unroll
            for (int k = 0; k < 8; ++k) { Lv[k] = p[(size_t)(c0 + k) * 4096]; D[k] = d[(size_t)(c0 + k) * 32]; }
#pragma unroll
            for (int k = 0; k < 8; ++k) { v2u o; o.x = pk2c(S.x, S.y); o.y = pk2c(S.z, S.w); p[(size_t)(c0 + k) * 4096] = o;
                S.x = D[k].x * S.x + bflo(Lv[k].x); S.y = D[k].y * S.y + bfhi(Lv[k].x); S.z = D[k].z * S.z + bflo(Lv[k].y); S.w = D[k].w * S.w + bfhi(Lv[k].y); }
        }
    }
}
__device__ __forceinline__ void hgC_chunk(const Ctx& c, int ci, const bf16* QHG, const bf16* LOGF, const bf16* IHG, const bf16* GHG, const bf16* ST, const float* nw, bf16* OUT) {
    const int bh = ci >> 6, ch = ci & 63, bb = bh >> 3, h = bh & 7; const size_t n0 = (size_t)bb * SEQ + ch * 64;
    LAS unsigned char* lft = c.lds; LAS unsigned char* itl = c.lds + 64 * HG_TS; LAS float* bt = (LAS float*)(c.lds + 2 * 64 * HG_TS); LAS float* red = bt + 64 * HG_BS;
    hg_stage(lft, LOGF + n0 * 1024 + h * 128, c.tid); hg_stage(itl, IHG + n0 * 1024 + h * 128, c.tid);
    __syncthreads();
    const int hf = c.lane >> 5, cl = c.lane & 31;
    { const int dk = 32 * (c.wave & 3) + cl; float lf[4][8], b[4][8], bl; hg_scan(lft, dk, hf, lf, b, bl);
#pragma unroll
      for (int q = 0; q < 2; ++q) { const int kk = 2 * (c.wave >> 2) + q;
#pragma unroll
          for (int j = 0; j < 8; ++j) bt[(16 * kk + 8 * hf + j) * HG_BS + dk] = (c.wave >> 2) ? b[2 + q][j] : b[q][j]; } }
    __syncthreads();
    const int dvt = c.wave & 3, tt = c.wave >> 2, t = 32 * tt + cl;
    bf16x8 qm[8];
    const bf16* qrow = QHG + (n0 + t) * 1024 + h * 128 + 8 * hf;
#pragma unroll
    for (int kk = 0; kk < 8; ++kk) { const int d0 = 16 * kk + 8 * hf;
        asm volatile("" ::: "memory");
        const v4u qv = *(const GAS v4u*)(qrow + 16 * kk);
        const f32x4 b0 = *(const LAS f32x4*)(bt + t * HG_BS + d0), b1 = *(const LAS f32x4*)(bt + t * HG_BS + d0 + 4), m0 = *(const LAS f32x4*)(bt + 31 * HG_BS + d0), m1 = *(const LAS f32x4*)(bt + 31 * HG_BS + d0 + 4);
        const float q[8] = {bflo(qv.x), bfhi(qv.x), bflo(qv.y), bfhi(qv.y), bflo(qv.z), bfhi(qv.z), bflo(qv.w), bfhi(qv.w)};
        const float bv[8] = {b0.x, b0.y, b0.z, b0.w, b1.x, b1.y, b1.z, b1.w}, mv[8] = {m0.x, m0.y, m0.z, m0.w, m1.x, m1.y, m1.z, m1.w};
        float vm[8];
#pragma unroll
        for (int j = 0; j < 8; ++j) vm[j] = q[j] * __expf(bv[j] - mv[j]);
        qm[kk] = pack8(vm); }
    f32x16 o;
#pragma unroll
    for (int r = 0; r < 16; ++r) o[r] = 0.f;
#pragma unroll 1
    for (int st = 0; st <= tt; ++st) {
        const int s = 32 * st + cl;
        f32x16 sa;
#pragma unroll
        for (int r = 0; r < 16; ++r) sa[r] = 0.f;
#pragma unroll
        for (int kk = 0; kk < 8; ++kk) { const int d0 = 16 * kk + 8 * hf;
            asm volatile("" ::: "memory");
            const v4u lv = *(const LAS v4u*)(lft + s * HG_TS + d0 * 2);
            const f32x4 b0 = *(const LAS f32x4*)(bt + s * HG_BS + d0), b1 = *(const LAS f32x4*)(bt + s * HG_BS + d0 + 4), m0 = *(const LAS f32x4*)(bt + 31 * HG_BS + d0), m1 = *(const LAS f32x4*)(bt + 31 * HG_BS + d0 + 4);
            const float lfv[8] = {bflo(lv.x), bfhi(lv.x), bflo(lv.y), bfhi(lv.y), bflo(lv.z), bfhi(lv.z), bflo(lv.w), bfhi(lv.w)};
            const float bv[8] = {b0.x, b0.y, b0.z, b0.w, b1.x, b1.y, b1.z, b1.w}, mv[8] = {m0.x, m0.y, m0.z, m0.w, m1.x, m1.y, m1.z, m1.w};
            float vk[8];
#pragma unroll
            for (int j = 0; j < 8; ++j) vk[j] = (1.0f - __expf(lfv[j])) * __expf(mv[j] - bv[j]);
            sa = MFMA32(pack8(vk), qm[kk], sa); }
        if (st == tt) {
#pragma unroll
            for (int r = 0; r < 16; ++r) if (((r & 3) + 8 * (r >> 2) + 4 * hf) > cl) sa[r] = 0.f;
        }
#pragma unroll
        for (int sp = 0; sp < 2; ++sp) {
            const float pv[8] = {sa[8 * sp], sa[8 * sp + 1], sa[8 * sp + 2], sa[8 * sp + 3], sa[8 * sp + 4], sa[8 * sp + 5], sa[8 * sp + 6], sa[8 * sp + 7]};
            const LAS unsigned char* p = itl + (32 * st + 16 * sp + 4 * hf) * HG_TS + (32 * dvt + cl) * 2;
            v4u tq; tq.x = lds_u16(p) | (lds_u16(p + HG_TS) << 16); tq.y = lds_u16(p + 2 * HG_TS) | (lds_u16(p + 3 * HG_TS) << 16);
            tq.z = lds_u16(p + 8 * HG_TS) | (lds_u16(p + 9 * HG_TS) << 16); tq.w = lds_u16(p + 10 * HG_TS) | (lds_u16(p + 11 * HG_TS) << 16);
            o = MFMA32(__builtin_bit_cast(bf16x8, tq), pack8(pv), o); }
    }
    { const bf16* strow = ST + (size_t)ci * 16384 + (size_t)(32 * dvt + cl) * 128 + 8 * hf;
#pragma unroll
      for (int kk = 0; kk < 8; ++kk) { const int d0 = 16 * kk + 8 * hf;
          asm volatile("" ::: "memory");
          const v4u qv = *(const GAS v4u*)(qrow + 16 * kk); const bf16x8 sf = *(const GAS bf16x8*)(strow + 16 * kk);
          const f32x4 b0 = *(const LAS f32x4*)(bt + t * HG_BS + d0), b1 = *(const LAS f32x4*)(bt + t * HG_BS + d0 + 4);
          float ve[8] = {bflo(qv.x) * __expf(b0.x), bfhi(qv.x) * __expf(b0.y), bflo(qv.y) * __expf(b0.z), bfhi(qv.y) * __expf(b0.w), bflo(qv.z) * __expf(b1.x), bfhi(qv.z) * __expf(b1.y), bflo(qv.w) * __expf(b1.z), bfhi(qv.w) * __expf(b1.w)};
          o = MFMA32(sf, pack8(ve), o); } }
    float ss = 0.f;
#pragma unroll
    for (int r = 0; r < 16; ++r) ss += o[r] * o[r];
    ss += __shfl_xor(ss, 32);
    if (hf == 0) red[(tt * 4 + dvt) * 32 + cl] = ss;
    __syncthreads();
    const float rstd = __builtin_amdgcn_rsqf(((red[(tt * 4 + 0) * 32 + cl] + red[(tt * 4 + 1) * 32 + cl]) + (red[(tt * 4 + 2) * 32 + cl] + red[(tt * 4 + 3) * 32 + cl])) * (1.0f / 128.0f) + EPS);
#pragma unroll
    for (int g = 0; g < 4; ++g) { const int dv0 = 32 * dvt + 8 * g + 4 * hf; const size_t off = (n0 + t) * 1024 + h * 128 + dv0;
        const v2u gg = *(const GAS v2u*)(GHG + off); const f32x4 w4 = *(const GAS f32x4*)(nw + dv0);
        v2u q; q.x = pk2c(o[4 * g] * rstd * w4.x * bflo(gg.x), o[4 * g + 1] * rstd * w4.y * bfhi(gg.x)); q.y = pk2c(o[4 * g + 2] * rstd * w4.z * bflo(gg.y), o[4 * g + 3] * rstd * w4.w * bfhi(gg.y));
        *(GAS v2u*)(OUT + off) = q; }
    __syncthreads();
}
__device__ __forceinline__ void qknorm_row(bf16* row, const float* w, float scale, int lane) {
#pragma unroll
    for (int j = 0; j < 2; ++j) {
        GAS v4u* p = (GAS v4u*)(row + 8 * lane + 512 * j); const v4u x = *p;
        float f[8] = {bflo(x.x), bfhi(x.x), bflo(x.y), bfhi(x.y), bflo(x.z), bfhi(x.z), bflo(x.w), bfhi(x.w)};
        float ss = 0.f;
#pragma unroll
        for (int k = 0; k < 8; ++k) ss += f[k] * f[k];
        ss += __shfl_xor(ss, 1); ss += __shfl_xor(ss, 2); ss += __shfl_xor(ss, 4); ss += __shfl_xor(ss, 8);
        const float r = __builtin_amdgcn_rsqf(ss * (1.0f / 128.0f) + EPS) * scale;
        const f32x4 wa = *(const GAS f32x4*)(w + ((8 * lane) & 127)), wb = *(const GAS f32x4*)(w + ((8 * lane) & 127) + 4);
        v4u o; o.x = pk2c(f[0] * r * wa.x, f[1] * r * wa.y); o.y = pk2c(f[2] * r * wa.z, f[3] * r * wa.w); o.z = pk2c(f[4] * r * wb.x, f[5] * r * wb.y); o.w = pk2c(f[6] * r * wb.z, f[7] * r * wb.w);
        *p = o;
    }
}
__device__ __forceinline__ void vt_item(int item, int lane, const bf16* vsb, bf16* vt, LAS unsigned short* scr) {
    const int db = item & 3, sb = (item >> 2) & 63, bh = item >> 8, b = bh >> 3, h = bh & 7;
    const bf16* src = vsb + ((size_t)b * SEQ + sb * 64) * 1024 + h * 128 + db * 32;
#pragma unroll 4
    for (int i = 0; i < 16; ++i) { const int r = 4 * i + (lane >> 4); *(LAS unsigned*)(scr + r * 34 + 2 * (lane & 15)) = *(const GAS unsigned*)(src + (size_t)r * 1024 + 2 * (lane & 15)); }
    LDS_WAIT();
    const int c = lane & 7;
#pragma unroll
    for (int j = 0; j < 4; ++j) { const int d = (lane >> 3) + 8 * j; const LAS unsigned short* s = scr + (8 * c) * 34 + d;
        v4u o; o.x = (unsigned)s[0] | ((unsigned)s[34] << 16); o.y = (unsigned)s[68] | ((unsigned)s[102] << 16); o.z = (unsigned)s[136] | ((unsigned)s[170] << 16); o.w = (unsigned)s[204] | ((unsigned)s[238] << 16);
        *(GAS v4u*)(vt + ((size_t)bh * 128 + db * 32 + d) * SEQ + sb * 64 + 8 * c) = o; }
    LDS_WAIT();
}

constexpr int AT_KS = 272, AT_VS = 136, AT_BUF = 64 * AT_KS + 128 * AT_VS;
__device__ __forceinline__ f32x16 attn_scores(const LAS unsigned char* kp, const bf16x8 (&qf)[8]) {
    f32x16 sa;
#pragma unroll
    for (int r = 0; r < 16; ++r) sa[r] = 0.f;
#pragma unroll
    for (int kk = 0; kk < 8; ++kk) sa = MFMA32(*(const LAS bf16x8*)(kp + 32 * kk), qf[kk], sa);
    return sa;
}
template <bool DIAG> __device__ __forceinline__ void attn_weights(const f32x16& sa, float& R, int hf, int cl, bf16x8 (&pf)[2]) {
    float om[16], be[16];
#pragma unroll
    for (int r = 0; r < 16; ++r) { const float e = __builtin_amdgcn_exp2f(sa[r] * 1.4426950408889634f); om[r] = __builtin_amdgcn_rcpf(1.0f + e); be[r] = e * om[r]; }
    if (DIAG) {
#pragma unroll
        for (int r = 0; r < 16; ++r) if (((r & 3) + 8 * (r >> 2) + 4 * hf) >= cl) { om[r] = 1.0f; be[r] = 0.f; }
    }
    float Gs[4], Gp[4];
#pragma unroll
    for (int g = 0; g < 4; ++g) { Gs[g] = (om[4 * g] * om[4 * g + 1]) * (om[4 * g + 2] * om[4 * g + 3]); Gp[g] = __shfl_xor(Gs[g], 32); }
    float tail = R; float w[16];
#pragma unroll
    for (int g = 3; g >= 0; --g) {
        const float c3 = tail * (hf == 0 ? Gp[g] : 1.0f), c2 = c3 * om[4 * g + 3], c1 = c2 * om[4 * g + 2], c0 = c1 * om[4 * g + 1];
        w[4 * g + 3] = be[4 * g + 3] * c3; w[4 * g + 2] = be[4 * g + 2] * c2; w[4 * g + 1] = be[4 * g + 1] * c1; w[4 * g] = be[4 * g] * c0;
        tail *= Gs[g] * Gp[g];
    }
    R = tail;
#pragma unroll
    for (int sp = 0; sp < 2; ++sp) { v4u t; t.x = pk2c(w[8 * sp], w[8 * sp + 1]); t.y = pk2c(w[8 * sp + 2], w[8 * sp + 3]); t.z = pk2c(w[8 * sp + 4], w[8 * sp + 5]); t.w = pk2c(w[8 * sp + 6], w[8 * sp + 7]); pf[sp] = __builtin_bit_cast(bf16x8, t); }
}
__device__ __forceinline__ void attn_pv(const LAS unsigned char* vp, const bf16x8 (&pf)[2], f32x16 (&o)[4]) {
#pragma unroll
    for (int d = 0; d < 4; ++d)
#pragma unroll
        for (int sp = 0; sp < 2; ++sp) { const v2u lo = *(const LAS v2u*)(vp + d * 32 * AT_VS + 32 * sp), hi = *(const LAS v2u*)(vp + d * 32 * AT_VS + 32 * sp + 16);
            v4u t; t.x = lo.x; t.y = lo.y; t.z = hi.x; t.w = hi.y; o[d] = MFMA32(__builtin_bit_cast(bf16x8, t), pf[sp], o[d]); }
}
__device__ __forceinline__ void attn_unit(const Ctx& c, int bh, int qb, const bf16* qsb, const bf16* ksb, const bf16* vt, bf16* outb) {
    const int b = bh >> 3, h = bh & 7, lane = c.lane, cl = lane & 31, hf = lane >> 5, tid = c.tid;
    const size_t rb = (size_t)b * SEQ; const int q0w = 256 * qb + 32 * c.wave;
    bf16x8 qf[8];
    { const bf16* qrow = qsb + (rb + q0w + cl) * 1024 + h * 128 + 8 * hf;
#pragma unroll
      for (int kk = 0; kk < 8; ++kk) qf[kk] = *(const GAS bf16x8*)(qrow + 16 * kk); }
    f32x16 o[4];
#pragma unroll
    for (int d = 0; d < 4; ++d)
#pragma unroll
        for (int r = 0; r < 16; ++r) o[d][r] = 0.f;
    float R = 1.0f;
    const bf16* kg = ksb + (rb + (tid >> 4)) * 1024 + h * 128 + (tid & 15) * 8;
    const bf16* vg = vt + ((size_t)bh * 128 + (tid >> 3)) * SEQ + (tid & 7) * 8;
    const int kl = (tid >> 4) * AT_KS + (tid & 15) * 16, vl = 64 * AT_KS + (tid >> 3) * AT_VS + (tid & 7) * 16;
    const int nkt = 4 * (qb + 1);
    v4u st[4];
    { const int kt = nkt - 1;
      st[0] = *(const GAS v4u*)(kg + (size_t)kt * 64 * 1024); st[1] = *(const GAS v4u*)(kg + (size_t)kt * 64 * 1024 + 32 * 1024);
      st[2] = *(const GAS v4u*)(vg + kt * 64); st[3] = *(const GAS v4u*)(vg + kt * 64 + (size_t)64 * SEQ);
      *(LAS v4u*)(c.lds + kl) = st[0]; *(LAS v4u*)(c.lds + kl + 32 * AT_KS) = st[1];
      *(LAS v2u*)(c.lds + vl) = (v2u){st[2].x, st[2].y}; *(LAS v2u*)(c.lds + vl + 8) = (v2u){st[2].z, st[2].w}; *(LAS v2u*)(c.lds + vl + 64 * AT_VS) = (v2u){st[3].x, st[3].y}; *(LAS v2u*)(c.lds + vl + 64 * AT_VS + 8) = (v2u){st[3].z, st[3].w}; }
    __syncthreads();
#pragma unroll 1
    for (int it = 0; it < nkt; ++it) {
        const int kt = nkt - 1 - it; LAS unsigned char* buf = c.lds + (it & 1) * AT_BUF; LAS unsigned char* nbuf = c.lds + ((it & 1) ^ 1) * AT_BUF;
        const bool more = (it + 1 < nkt);
        if (more) { const int k2 = kt - 1;
            st[0] = *(const GAS v4u*)(kg + (size_t)k2 * 64 * 1024); st[1] = *(const GAS v4u*)(kg + (size_t)k2 * 64 * 1024 + 32 * 1024);
            st[2] = *(const GAS v4u*)(vg + k2 * 64); st[3] = *(const GAS v4u*)(vg + k2 * 64 + (size_t)64 * SEQ); }
        const int rel = q0w - 64 * kt;
        const LAS unsigned char* kp0 = buf + cl * AT_KS + 16 * hf; const LAS unsigned char* kp1 = kp0 + 32 * AT_KS;
        const LAS unsigned char* vp0 = buf + 64 * AT_KS + cl * AT_VS + 8 * hf; const LAS unsigned char* vp1 = vp0 + 64;
        if (rel >= 64) {
            const f32x16 s1 = attn_scores(kp1, qf), s0 = attn_scores(kp0, qf);
            bf16x8 p1[2], p0[2];
            attn_weights<false>(s1, R, hf, cl, p1); attn_weights<false>(s0, R, hf, cl, p0);
            attn_pv(vp1, p1, o); attn_pv(vp0, p0, o);
        } else if (rel == 32) {
            const f32x16 s1 = attn_scores(kp1, qf), s0 = attn_scores(kp0, qf);
            bf16x8 p1[2], p0[2];
            attn_weights<true>(s1, R, hf, cl, p1); attn_weights<false>(s0, R, hf, cl, p0);
            attn_pv(vp1, p1, o); attn_pv(vp0, p0, o);
        } else if (rel == 0) {
            const f32x16 s0 = attn_scores(kp0, qf);
            bf16x8 p0[2];
            attn_weights<true>(s0, R, hf, cl, p0);
            attn_pv(vp0, p0, o);
        }
        if (more) { *(LAS v4u*)(nbuf + kl) = st[0]; *(LAS v4u*)(nbuf + kl + 32 * AT_KS) = st[1];
            *(LAS v2u*)(nbuf + vl) = (v2u){st[2].x, st[2].y}; *(LAS v2u*)(nbuf + vl + 8) = (v2u){st[2].z, st[2].w}; *(LAS v2u*)(nbuf + vl + 64 * AT_VS) = (v2u){st[3].x, st[3].y}; *(LAS v2u*)(nbuf + vl + 64 * AT_VS + 8) = (v2u){st[3].z, st[3].w}; }
        __syncthreads();
    }
    bf16* orow = outb + (rb + q0w + cl) * 1024 + h * 128 + 4 * hf;
#pragma unroll
    for (int d = 0; d < 4; ++d)
#pragma unroll
        for (int g = 0; g < 4; ++g) { v2u q; q.x = pk2c(o[d][4 * g], o[d][4 * g + 1]); q.y = pk2c(o[d][4 * g + 2], o[d][4 * g + 3]); *(GAS v2u*)(orow + 32 * d + 8 * g) = q; }
}
__device__ __forceinline__ void hgpost_row(bf16* row, const bf16* grow, const float* w, int lane) {
#pragma unroll
    for (int j = 0; j < 2; ++j) {
        GAS v4u* p = (GAS v4u*)(row + 8 * lane + 512 * j); const v4u x = *p; const v4u gg = *(const GAS v4u*)(grow + 8 * lane + 512 * j);
        float f[8] = {bflo(x.x), bfhi(x.x), bflo(x.y), bfhi(x.y), bflo(x.z), bfhi(x.z), bflo(x.w), bfhi(x.w)};
        const float g[8] = {bflo(gg.x), bfhi(gg.x), bflo(gg.y), bfhi(gg.y), bflo(gg.z), bfhi(gg.z), bflo(gg.w), bfhi(gg.w)};
        float ss = 0.f;
#pragma unroll
        for (int k = 0; k < 8; ++k) ss += f[k] * f[k];
        ss += __shfl_xor(ss, 1); ss += __shfl_xor(ss, 2); ss += __shfl_xor(ss, 4); ss += __shfl_xor(ss, 8);
        const float r = __builtin_amdgcn_rsqf(ss * (1.0f / 128.0f) + EPS);
        const f32x4 wa = *(const GAS f32x4*)(w + ((8 * lane) & 127)), wb = *(const GAS f32x4*)(w + ((8 * lane) & 127) + 4);
        v4u o; o.x = pk2c(f[0] * r * wa.x * g[0], f[1] * r * wa.y * g[1]); o.y = pk2c(f[2] * r * wa.z * g[2], f[3] * r * wa.w * g[3]);
        o.z = pk2c(f[4] * r * wb.x * g[4], f[5] * r * wb.y * g[5]); o.w = pk2c(f[6] * r * wb.z * g[6], f[7] * r * wb.w * g[7]);
        *p = o;
    }
}

template <bool FIRST> struct EpiMerge {
    static constexpr bool PERM = true, AFTER_DRAIN = false;
    const bf16* gate; bf16* merged;
    __device__ __forceinline__ void operator()(const pg8::f32x4 (&acc)[2][2][4][2], const pg8::Unit& u, int wr, int wc, int fr, int fq) const {
        const int row0 = u.pm * 256 + wr * 64 + fr, col0 = u.pn * 256 + wc * 32 + 8 * fq;
#pragma unroll
        for (int ai = 0; ai < 2; ++ai)
#pragma unroll
            for (int m = 0; m < 4; ++m) {
                if ((m & 1) == 0) asm volatile("" ::: "memory");
#pragma unroll
                for (int bj = 0; bj < 2; ++bj) {
                    const size_t off = (size_t)(row0 + ai * 128 + m * 16) * 2048 + col0 + bj * 128;
                    const v4u g = *(const GAS v4u*)(gate + off); const pg8::f32x4 v0 = acc[ai][bj][m][0], v1 = acc[ai][bj][m][1];
                    float r[8] = {bflo(g.x) * v0[0], bfhi(g.x) * v0[1], bflo(g.y) * v0[2], bfhi(g.y) * v0[3], bflo(g.z) * v1[0], bfhi(g.z) * v1[1], bflo(g.w) * v1[2], bfhi(g.w) * v1[3]};
                    if (!FIRST) { const v4u mo = *(const GAS v4u*)(merged + off);
                        r[0] += bflo(mo.x); r[1] += bfhi(mo.x); r[2] += bflo(mo.y); r[3] += bfhi(mo.y); r[4] += bflo(mo.z); r[5] += bfhi(mo.z); r[6] += bflo(mo.w); r[7] += bfhi(mo.w); }
                    v4u w; w.x = pk2c(r[0], r[1]); w.y = pk2c(r[2], r[3]); w.z = pk2c(r[4], r[5]); w.w = pk2c(r[6], r[7]);
                    *(GAS v4u*)(merged + off) = w; }
            }
    }
};
struct EpiStoreBf16 {
    static constexpr bool PERM = true, AFTER_DRAIN = false;
    bf16* out;
    __device__ __forceinline__ void operator()(const pg8::f32x4 (&acc)[2][2][4][2], const pg8::Unit& u, int wr, int wc, int fr, int fq) const {
        const int row0 = u.pm * 256 + wr * 64 + fr, col0 = u.pn * 256 + wc * 32 + 8 * fq;
#pragma unroll
        for (int ai = 0; ai < 2; ++ai)
#pragma unroll
            for (int m = 0; m < 4; ++m)
#pragma unroll
                for (int bj = 0; bj < 2; ++bj) { const pg8::f32x4 v0 = acc[ai][bj][m][0], v1 = acc[ai][bj][m][1];
                    v4u w; w.x = pk2c(v0[0], v0[1]); w.y = pk2c(v0[2], v0[3]); w.z = pk2c(v1[0], v1[1]); w.w = pk2c(v1[2], v1[3]);
                    *(GAS v4u*)(out + (size_t)(row0 + ai * 128 + m * 16) * 2048 + col0 + bj * 128) = w; }
    }
};
struct EpiResid {
    static constexpr bool PERM = false, AFTER_DRAIN = false;
    const float* xin; float* xout;
    __device__ __forceinline__ void operator()(const pg8::f32x4 (&acc)[2][2][4][2], const pg8::Unit& u, int wr, int wc, int fr, int fq) const {
        const int row0 = u.pm * 256 + wr * 64 + fr, col0 = u.pn * 256 + wc * 32 + 4 * fq;
#pragma unroll
        for (int ai = 0; ai < 2; ++ai)
#pragma unroll
            for (int m = 0; m < 4; ++m)
#pragma unroll
                for (int bj = 0; bj < 2; ++bj)
#pragma unroll
                    for (int n = 0; n < 2; ++n) { const size_t off = (size_t)(row0 + ai * 128 + m * 16) * 2048 + col0 + bj * 128 + n * 16;
                        f32x4 r = acc[ai][bj][m][n]; if (xin) r += *(const GAS f32x4*)(xin + off);
                        *(GAS f32x4*)(xout + off) = r; }
    }
};

__device__ __forceinline__ float rl_f(float v, int l) { return __uint_as_float((unsigned)__builtin_amdgcn_readlane((int)__float_as_uint(v), l)); }
__device__ __forceinline__ void ins16(float (&L)[16], float x) {
#pragma unroll
    for (int i = 0; i < 16; ++i) { const float hi = __builtin_fmaxf(L[i], x); x = __builtin_fminf(L[i], x); L[i] = hi; }
}
__device__ __forceinline__ void peer_top16(const bf16* qrow  , const bf16* kb  , int hf, float (&L)[16]) {
    bf16x8 qf[8];
#pragma unroll
    for (int kk = 0; kk < 8; ++kk) qf[kk] = *(const GAS bf16x8*)(qrow + 16 * kk);
#pragma unroll
    for (int i = 0; i < 16; ++i) L[i] = -__builtin_inff();
#pragma unroll 1
    for (int kt = 0; kt < 4; ++kt) {
        f32x16 sa;
#pragma unroll
        for (int r = 0; r < 16; ++r) sa[r] = 0.f;
#pragma unroll
        for (int kk = 0; kk < 8; ++kk) { const bf16x8 kf = *(const GAS bf16x8*)(kb + (size_t)kt * 32 * 128 + 16 * kk); sa = MFMA32(kf, qf[kk], sa); }
#pragma unroll
        for (int r = 0; r < 16; ++r) { const unsigned idx = (unsigned)(kt * 32 + (r & 3) + 8 * (r >> 2) + 4 * hf); ins16(L, __uint_as_float((__float_as_uint(sa[r]) & ~127u) | idx)); }
    }
    float P[16];
#pragma unroll
    for (int i = 0; i < 16; ++i) P[i] = __shfl_xor(L[i], 32);
#pragma unroll
    for (int i = 0; i < 16; ++i) ins16(L, P[i]);
}
__device__ __forceinline__ void peer_select32(int item, int lane, const bf16* qpeer, const bf16* KB, int* sel_e, float* sel_g, float* sel_s) {
    const int hd = item & 7, n0 = (item >> 3) * 32, c = lane & 31, hf = lane >> 5, n = n0 + c;
    const bf16* qrow = qpeer + (size_t)n * 2048 + hd * 256 + 8 * hf;
    float A[16], B[16];
    peer_top16(qrow, KB + (size_t)hd * 16384 + c * 128 + 8 * hf, hf, A);
    peer_top16(qrow + 128, KB + (size_t)(8 + hd) * 16384 + c * 128 + 8 * hf, hf, B);
    float Av[16], Bv[16]; int Ai[16], Bi[16];
#pragma unroll
    for (int i = 0; i < 16; ++i) { const unsigned a = __float_as_uint(A[i]), b = __float_as_uint(B[i]); Av[i] = __uint_as_float(a & ~127u); Bv[i] = __uint_as_float(b & ~127u); Ai[i] = (int)(a & 127u); Bi[i] = (int)(b & 127u); }
    float W[16];
#pragma unroll
    for (int i = 0; i < 16; ++i) W[i] = -__builtin_inff();
    { unsigned id = 0;
#pragma unroll
      for (int a = 0; a < 16; ++a)
#pragma unroll
        for (int b = 0; b < 16; ++b) if ((a + 1) * (b + 1) <= 16) { ins16(W, __uint_as_float((__float_as_uint(Av[a] + Bv[b]) & ~63u) | id)); ++id; } }
    const float thr = W[15], mx = W[0];
    int cnt = 0; float ssum = 0.f;
    GAS int* pe = (GAS int*)sel_e + (size_t)n * 128 + hd * 16; GAS float* pg = (GAS float*)sel_g + (size_t)n * 128 + hd * 16;
    { unsigned id = 0;
#pragma unroll
      for (int a = 0; a < 16; ++a)
#pragma unroll
        for (int b = 0; b < 16; ++b) if ((a + 1) * (b + 1) <= 16) {
            const float cv = Av[a] + Bv[b]; const float pk = __uint_as_float((__float_as_uint(cv) & ~63u) | id); ++id;
            if (pk >= thr) { const float e = __expf(cv - mx); if ((cnt & 1) == hf) { pe[cnt] = Ai[a] * 128 + Bi[b]; pg[cnt] = e; } ssum += e; ++cnt; }
        } }
    if (hf == 0) ((GAS float*)sel_s)[(size_t)n * 8 + hd] = ssum;
}

__device__ __forceinline__ float dot2bf(unsigned a, unsigned b, float acc) {
    return __builtin_amdgcn_fdot2_f32_bf16(__builtin_bit_cast(bf16v2, a), __builtin_bit_cast(bf16v2, b), acc, false);
}
__device__ __forceinline__ float dot8bf(const v4u a, const v4u b, float acc) {
    const unsigned a0 = a.x, a1 = a.y, a2 = a.z, a3 = a.w, b0 = b.x, b1 = b.y, b2 = b.z, b3 = b.w;
    acc = dot2bf(a0, b0, acc); acc = dot2bf(a1, b1, acc); acc = dot2bf(a2, b2, acc); acc = dot2bf(a3, b3, acc);
    return acc;
}
__device__ __forceinline__ void unpack16(const v4u q, float (&f)[16]) {
    const unsigned d0 = q.x, d1 = q.y, d2 = q.z, d3 = q.w;
    f32x2v t;
    t = __builtin_amdgcn_cvt_pk_f32_fp8((int)d0, false); f[0] = t.x; f[1] = t.y; t = __builtin_amdgcn_cvt_pk_f32_fp8((int)d0, true); f[2] = t.x; f[3] = t.y;
    t = __builtin_amdgcn_cvt_pk_f32_fp8((int)d1, false); f[4] = t.x; f[5] = t.y; t = __builtin_amdgcn_cvt_pk_f32_fp8((int)d1, true); f[6] = t.x; f[7] = t.y;
    t = __builtin_amdgcn_cvt_pk_f32_fp8((int)d2, false); f[8] = t.x; f[9] = t.y; t = __builtin_amdgcn_cvt_pk_f32_fp8((int)d2, true); f[10] = t.x; f[11] = t.y;
    t = __builtin_amdgcn_cvt_pk_f32_fp8((int)d3, false); f[12] = t.x; f[13] = t.y; t = __builtin_amdgcn_cvt_pk_f32_fp8((int)d3, true); f[14] = t.x; f[15] = t.y;
}
struct SliceSched { int mode, xcc, rank, nloc; };
__device__ __forceinline__ SliceSched slice_sched_init(const Ctx& c, unsigned* ctl, const XcdBarrier& bar, int use) {
    LAS int* sh = (LAS int*)(c.lds + 1024);
    if (c.tid == 0) {
        int ok = 1; unsigned tot = 0;
        for (int j = 0; j < 16; ++j) { const unsigned n = xb_ld(&bar.bar[XB_XCNT(j)]); tot += n; if ((j < 8) != (n > 0u)) ok = 0; }
        if (tot != (unsigned)c.G) ok = 0;
        const int xcc = (int)xb_xcc_id();
        int rank = 0, nloc = 1;
        if (ok) { nloc = (int)xb_ld(&bar.bar[XB_XCNT(xcc)]); rank = (int)xb_add(&ctl[CW_RANK + (use * 16 + xcc) * 64], 1u); if (rank >= nloc) ok = 0; }
        sh[0] = ok; sh[1] = xcc; sh[2] = rank; sh[3] = nloc;
    }
    __syncthreads();
    SliceSched S; S.mode = sh[0]; S.xcc = sh[1]; S.rank = sh[2]; S.nloc = sh[3];
    __syncthreads();
    return S;
}
__device__ __forceinline__ bool slice_item(const SliceSched& S, const Ctx& c, int i, int& slice, int& tb) {
    if (S.mode) { const int it = S.rank + i * S.nloc; if (it >= 512) return false; slice = S.xcc + 8 * (it >> 8); tb = it & 255; return true; }
    const int it = (int)blockIdx.x + i * c.G; if (it >= 4096) return false; slice = it >> 8; tb = it & 255; return true;
}
__device__ __forceinline__ void unpack16p(const v4u q, f32x2v (&f)[8]) {
    const unsigned d0 = q.x, d1 = q.y, d2 = q.z, d3 = q.w;
    f[0] = __builtin_amdgcn_cvt_pk_f32_fp8((int)d0, false); f[1] = __builtin_amdgcn_cvt_pk_f32_fp8((int)d0, true);
    f[2] = __builtin_amdgcn_cvt_pk_f32_fp8((int)d1, false); f[3] = __builtin_amdgcn_cvt_pk_f32_fp8((int)d1, true);
    f[4] = __builtin_amdgcn_cvt_pk_f32_fp8((int)d2, false); f[5] = __builtin_amdgcn_cvt_pk_f32_fp8((int)d2, true);
    f[6] = __builtin_amdgcn_cvt_pk_f32_fp8((int)d3, false); f[7] = __builtin_amdgcn_cvt_pk_f32_fp8((int)d3, true);
}
__device__ __forceinline__ void peer_sddmm_wave(int t0, int s, int lane, const bf16* H, const unsigned char* UQ, const int* sel_e, float* part, LAS unsigned* ldsw) {
    const int cg = lane & 7, sg = lane >> 3;
#pragma unroll
    for (int j = 0; j < 4; ++j) *(LAS v4u*)(ldsw + 4 * (lane + 64 * j)) = *(const GAS v4u*)(sel_e + (size_t)t0 * 128 + 4 * (lane + 64 * j));
    LDS_WAIT();
    const unsigned char* ubase = UQ + s * 128 + cg * 16;
    v4u qn[16];
    { int id[16];
#pragma unroll
      for (int q = 0; q < 4; ++q) { const v4u v = *(const LAS v4u*)(ldsw + sg * 16 + 4 * q); id[4 * q] = (int)v.x; id[4 * q + 1] = (int)v.y; id[4 * q + 2] = (int)v.z; id[4 * q + 3] = (int)v.w; }
#pragma unroll
      for (int it = 0; it < 16; ++it) qn[it] = *(const GAS v4u*)(ubase + (size_t)id[it] * 2048); }
    const bf16* hbase = H + (size_t)t0 * 2048 + s * 128 + cg * 16;
    v4u han = *(const GAS v4u*)(hbase), hbn = *(const GAS v4u*)(hbase + 8);
#pragma unroll 1
    for (int k = 0; k < 8; ++k) {
        const int t = t0 + k;
        v4u qc[16];
#pragma unroll
        for (int it = 0; it < 16; ++it) qc[it] = qn[it];
        const v4u ha = han, hb = hbn;
        if (k < 7) { han = *(const GAS v4u*)(hbase + (size_t)(k + 1) * 2048); hbn = *(const GAS v4u*)(hbase + (size_t)(k + 1) * 2048 + 8); }
        if (k < 7) { int id[16];
#pragma unroll
            for (int q = 0; q < 4; ++q) { const v4u v = *(const LAS v4u*)(ldsw + (k + 1) * 128 + sg * 16 + 4 * q); id[4 * q] = (int)v.x; id[4 * q + 1] = (int)v.y; id[4 * q + 2] = (int)v.z; id[4 * q + 3] = (int)v.w; }
#pragma unroll
            for (int it = 0; it < 16; ++it) qn[it] = *(const GAS v4u*)(ubase + (size_t)id[it] * 2048); }
        float h[16] = {bflo(ha.x), bfhi(ha.x), bflo(ha.y), bfhi(ha.y), bflo(ha.z), bfhi(ha.z), bflo(ha.w), bfhi(ha.w), bflo(hb.x), bfhi(hb.x), bflo(hb.y), bfhi(hb.y), bflo(hb.z), bfhi(hb.z), bflo(hb.w), bfhi(hb.w)};
        float hm = 0.f;
#pragma unroll
        for (int j = 0; j < 16; ++j) hm = fmaxf(hm, fabsf(h[j]));
        hm = fmaxf(hm, __shfl_xor(hm, 1)); hm = fmaxf(hm, __shfl_xor(hm, 2)); hm = fmaxf(hm, __shfl_xor(hm, 4));
        const float hinv = hm > 0.f ? 127.0f / hm : 0.f, hs = hm * (1.0f / 127.0f);
        int hq[4];
#pragma unroll
        for (int j = 0; j < 4; ++j) hq[j] = (int)pack_i8x4(h[4 * j] * hinv, h[4 * j + 1] * hinv, h[4 * j + 2] * hinv, h[4 * j + 3] * hinv);
        float p[16];
#pragma unroll
        for (int it = 0; it < 16; ++it) { int a = __builtin_amdgcn_sdot4((int)qc[it].x, hq[0], 0, false); a = __builtin_amdgcn_sdot4((int)qc[it].y, hq[1], a, false);
            a = __builtin_amdgcn_sdot4((int)qc[it].z, hq[2], a, false); a = __builtin_amdgcn_sdot4((int)qc[it].w, hq[3], a, false);
            p[it] = (float)a * hs; }
#pragma unroll
        for (int i = 0; i < 8; ++i) { const bool up = (lane & 4) != 0; const float snd = up ? p[i] : p[i + 8], kp = up ? p[i + 8] : p[i]; p[i] = kp + __shfl_xor(snd, 4); }
#pragma unroll
        for (int i = 0; i < 4; ++i) { const bool up = (lane & 2) != 0; const float snd = up ? p[i] : p[i + 4], kp = up ? p[i + 4] : p[i]; p[i] = kp + __shfl_xor(snd, 2); }
#pragma unroll
        for (int i = 0; i < 2; ++i) { const bool up = (lane & 1) != 0; const float snd = up ? p[i] : p[i + 2], kp = up ? p[i + 2] : p[i]; p[i] = kp + __shfl_xor(snd, 1); }
        ((GAS unsigned*)part)[((size_t)t * 16 + s) * 64 + lane] = pk2c(p[0], p[1]);
    }
    LDS_WAIT();
}
__device__ __forceinline__ void peer_coef_token(int t, int lane, const float* part, const int* sel_e, float* sel_g, const float* sel_s, const float* US, const float* VS) {
    float a0 = 0.f, a1 = 0.f;
#pragma unroll
    for (int s = 0; s < 16; ++s) { const unsigned v = ((const GAS unsigned*)part)[((size_t)t * 16 + s) * 64 + lane]; a0 += bflo(v); a1 += bfhi(v); }
    const v2u e = *(const GAS v2u*)(sel_e + (size_t)t * 128 + 2 * lane);
    const f32x2v g = *(const GAS f32x2v*)(sel_g + (size_t)t * 128 + 2 * lane);
    const float inv = 1.0f / ((const GAS float*)sel_s)[(size_t)t * 8 + (lane >> 3)];
    f32x2v o; o.x = g.x * inv * gelu_exact(a0 * ((const GAS float*)US)[e.x]) * ((const GAS float*)VS)[e.x]; o.y = g.y * inv * gelu_exact(a1 * ((const GAS float*)US)[e.y]) * ((const GAS float*)VS)[e.y];
    *(GAS f32x2v*)(sel_g + (size_t)t * 128 + 2 * lane) = o;
}
__device__ __forceinline__ void peer_spmm_wave(int t0, int s, int lane, const unsigned char* VQ, const int* sel_e, const float* coef, const float* x1, float* xout, LAS unsigned* ldsw) {
    const int cg = lane & 7, sg = lane >> 3;
#pragma unroll
    for (int j = 0; j < 4; ++j) { *(LAS v4u*)(ldsw + 4 * (lane + 64 * j)) = *(const GAS v4u*)(sel_e + (size_t)t0 * 128 + 4 * (lane + 64 * j));
        *(LAS v4u*)(ldsw + 1024 + 4 * (lane + 64 * j)) = *(const GAS v4u*)(coef + (size_t)t0 * 128 + 4 * (lane + 64 * j)); }
    LDS_WAIT();
    const unsigned char* vbase = VQ + s * 128 + cg * 16;
    v4u qn[16];
    { int id[16];
#pragma unroll
      for (int q = 0; q < 4; ++q) { const v4u v = *(const LAS v4u*)(ldsw + sg * 16 + 4 * q); id[4 * q] = (int)v.x; id[4 * q + 1] = (int)v.y; id[4 * q + 2] = (int)v.z; id[4 * q + 3] = (int)v.w; }
#pragma unroll
      for (int it = 0; it < 16; ++it) qn[it] = *(const GAS v4u*)(vbase + (size_t)id[it] * 2048); }
    f32x2v xn = *(const GAS f32x2v*)(x1 + (size_t)t0 * 2048 + s * 128 + cg * 16 + 2 * sg);
#pragma unroll 1
    for (int k = 0; k < 8; ++k) {
        const int t = t0 + k;
        v4u qc[16];
#pragma unroll
        for (int it = 0; it < 16; ++it) qc[it] = qn[it];
        const size_t off = (size_t)t * 2048 + s * 128 + cg * 16 + 2 * sg;
        const f32x2v xv = xn;
        if (k < 7) xn = *(const GAS f32x2v*)(x1 + off + 2048);
        float cf[16];
#pragma unroll
        for (int q = 0; q < 4; ++q) { const v4u w = *(const LAS v4u*)(ldsw + 1024 + k * 128 + sg * 16 + 4 * q); cf[4 * q] = __uint_as_float(w.x); cf[4 * q + 1] = __uint_as_float(w.y); cf[4 * q + 2] = __uint_as_float(w.z); cf[4 * q + 3] = __uint_as_float(w.w); }
        if (k < 7) { int id[16];
#pragma unroll
            for (int q = 0; q < 4; ++q) { const v4u v = *(const LAS v4u*)(ldsw + (k + 1) * 128 + sg * 16 + 4 * q); id[4 * q] = (int)v.x; id[4 * q + 1] = (int)v.y; id[4 * q + 2] = (int)v.z; id[4 * q + 3] = (int)v.w; }
#pragma unroll
            for (int it = 0; it < 16; ++it) qn[it] = *(const GAS v4u*)(vbase + (size_t)id[it] * 2048); }
        f32x2v y[8];
#pragma unroll
        for (int j = 0; j < 8; ++j) y[j] = (f32x2v){0.f, 0.f};
#pragma unroll
        for (int it = 0; it < 16; ++it) { f32x2v f[8]; unpack16p(qc[it], f); const f32x2v c2 = {cf[it], cf[it]};
#pragma unroll
            for (int j = 0; j < 8; ++j) y[j] = __builtin_elementwise_fma(f[j], c2, y[j]); }
        float yy[16];
#pragma unroll
        for (int j = 0; j < 8; ++j) { yy[2 * j] = y[j].x; yy[2 * j + 1] = y[j].y; }
#pragma unroll
        for (int i = 0; i < 8; ++i) { const bool up = (lane & 32) != 0; const float snd = up ? yy[i] : yy[i + 8], kp = up ? yy[i + 8] : yy[i]; yy[i] = kp + __shfl_xor(snd, 32); }
#pragma unroll
        for (int i = 0; i < 4; ++i) { const bool up = (lane & 16) != 0; const float snd = up ? yy[i] : yy[i + 4], kp = up ? yy[i + 4] : yy[i]; yy[i] = kp + __shfl_xor(snd, 16); }
#pragma unroll
        for (int i = 0; i < 2; ++i) { const bool up = (lane & 8) != 0; const float snd = up ? yy[i] : yy[i + 2], kp = up ? yy[i + 2] : yy[i]; yy[i] = kp + __shfl_xor(snd, 8); }
        f32x2v o; o.x = xv.x + yy[0]; o.y = xv.y + yy[1];
        *(GAS f32x2v*)(xout + off) = o;
    }
    LDS_WAIT();
}

struct Args { const float* in[21]; float* out; unsigned char* ws; int lo, hi, li, pad; };
__global__ void __launch_bounds__(512, 2) mk_fwd(Args args) {
    extern __shared__ __attribute__((aligned(16))) unsigned char lds_raw[];
    Ctx c; c.lds = (LAS unsigned char*)lds_raw; c.tid = threadIdx.x; c.lane = c.tid & 63; c.wave = __builtin_amdgcn_readfirstlane(c.tid >> 6);
    c.G = gridDim.x; c.gw = blockIdx.x * 8 + c.wave; c.NGW = c.G * 8;
    volatile LAS unsigned* MISC = (volatile LAS unsigned*)(c.lds + MISC_OFF);
    if (c.tid < 32) MISC[c.tid] = 0u;
    __syncthreads();
    unsigned char* ws = args.ws;
    const int lo = args.lo, hi = args.hi;
    XcdBarrier bar; bar.bar = (unsigned*)(ws + WS_CTL) + CW_BAR + args.li * XCD_BAR_WORDS; bar.x = 0; bar.st = nullptr;
    if (hi - lo > 1) bar = xcd_barrier_post((unsigned*)(ws + WS_CTL) + CW_BAR + args.li * XCD_BAR_WORDS, MISC + 8);
#ifndef ATTN_REPS
#define ATTN_REPS 1
#endif
#ifndef PHMASK
#define PHMASK 0x1fff
#endif
#define IN(k) (((PHMASK >> ((k) % NPH)) & 1) && lo <= (k) && (k) < hi)
#define SEAM(k) do { if (IN(k) && IN((k) + 1)) xcd_barrier(bar); } while (0)
#define PH_BEGIN unsigned char* w = ws; float* outp = args.out; Ctx cc = c; int zi = 0; \
    asm volatile("" : "+s"(w), "+s"(outp), "+s"(zi), "+v"(cc.tid), "+v"(cc.lane)); (void)w; (void)outp;
#define INP(k) (args.in[(k) + zi])
#define WSP(T, off) ((T*)(w + (off)))
    for (int l = 0; l < 2; ++l) {
        const int pb = l * NPH;
        if (IN(pb + 0)) { PH_BEGIN
            P0Args a; a.w_in = INP(2) + (size_t)l * DM * INW; a.w_br_sb = INP(11) + (size_t)l * BW * DM; a.w_br_hg = INP(12) + (size_t)l * BW * DM; a.w_br_conv = INP(13) + (size_t)l * BW * DM;
            a.w_o = INP(14) + (size_t)l * DM * DM; a.w_q = INP(16) + (size_t)l * DM * DM; a.u = INP(19) + (size_t)l * 16384 * 2048; a.v = INP(20) + (size_t)l * 16384 * 2048; a.lbp = INP(5);
            a.WinT = WSP(bf16, WS_WIN); a.WbrT = WSP(bf16, WS_WBR); a.WoT = WSP(bf16, WS_WO); a.WqT = WSP(bf16, WS_WQ); a.U = WSP(unsigned char, WS_U); a.V = WSP(unsigned char, WS_V); a.US = WSP(float, WS_US); a.VS = WSP(float, WS_VS); a.LB = WSP(float, WS_LB); a.layer = l; a.k1 = INP(17) + (size_t)l * 8 * 16384; a.k2 = INP(18) + (size_t)l * 8 * 16384; a.KB = WSP(bf16, WS_KEYS);
            p0_convert(cc, a);
            rms_phase_i8(cc, l == 0 ? INP(0) : WSP(const float, WS_X2), INP(1) + (size_t)l * DM, WSP(unsigned char, WS_H), WSP(float, WS_SA));
        }
        SEAM(pb + 0);
        if (IN(pb + 1)) { PH_BEGIN
            pg8::Gemm g{WSP(bf16, WS_H), WSP(bf16, WS_WIN), NTOK, INW, DM}; pg8::StaticOrder S; S.init(NTOK, INW, cc.G, (int)blockIdx.x);
            EpiIn E{WSP(bf16, WS_SEG), WSP(bf16, WS_GATE), WSP(float, WS_LB), WSP(float, WS_SA)};
            pg8::gemm_phase<EpiIn, pg8::StaticOrder, true, true, true>(cc.lds, g, S, E);
        }
        SEAM(pb + 1);
        if (IN(pb + 2)) { PH_BEGIN
            bf16* SEG = WSP(bf16, WS_SEG);
            conv_phase(cc, SEG + 7 * SEGSZ, INP(7) + (size_t)l * 31 * 1024, INP(8) + (size_t)l * 1024, INP(9) + (size_t)l * 1024, INP(10) + (size_t)l * 1024, WSP(bf16, WS_CONV));
            for (int ci = blockIdx.x; ci < 2048; ci += cc.G) hgA_chunk(cc, ci, SEG + 4 * SEGSZ, SEG + 5 * SEGSZ, WSP(bf16, WS_ST), WSP(float, WS_DEC));
            for (int r = cc.gw; r < 2 * NTOK; r += cc.NGW) {
                if (r < NTOK) qknorm_row(SEG + (size_t)r * 1024, INP(3) + (size_t)l * 128, 0.08838834764831845f, cc.lane);
                else qknorm_row(SEG + SEGSZ + (size_t)(r - NTOK) * 1024, INP(4) + (size_t)l * 128, 1.0f, cc.lane);
            }
            LAS unsigned short* scr = (LAS unsigned short*)(cc.lds + 4096 + cc.wave * 8192);
            for (int it = cc.gw; it < 8192; it += cc.NGW) vt_item(it, cc.lane, SEG + 2 * SEGSZ, WSP(bf16, WS_MERGED), scr);
        }
        SEAM(pb + 2);
        if (IN(pb + 3)) { PH_BEGIN
            bf16* SEG = WSP(bf16, WS_SEG);
            hgB(cc, WSP(bf16, WS_ST), WSP(float, WS_DEC));
            for (int rep = 0; rep < ATTN_REPS; ++rep)
            for (int p = blockIdx.x; p < 256; p += cc.G) { const int bh = (p & 7) * 4 + (p >> 6), j = (p >> 3) & 7;
                attn_unit(cc, bh, 15 - j, SEG, SEG + SEGSZ, WSP(bf16, WS_MERGED), SEG + 2 * SEGSZ); attn_unit(cc, bh, j, SEG, SEG + SEGSZ, WSP(bf16, WS_MERGED), SEG + 2 * SEGSZ); }
        }
        SEAM(pb + 3);
        if (IN(pb + 4)) { PH_BEGIN
            bf16* SEG = WSP(bf16, WS_SEG);
            for (int ci = blockIdx.x; ci < 2048; ci += cc.G) hgC_chunk(cc, ci, SEG + 3 * SEGSZ, SEG + 4 * SEGSZ, SEG + 5 * SEGSZ, SEG + 6 * SEGSZ, WSP(bf16, WS_ST), INP(6) + (size_t)l * 128, WSP(bf16, WS_HGR));
        }
        SEAM(pb + 4);
        if (IN(pb + 5)) { PH_BEGIN
            pg8::StaticOrder S; S.init(NTOK, DM, cc.G, (int)blockIdx.x);
            { pg8::Gemm g{WSP(bf16, WS_SEG) + 2 * SEGSZ, WSP(bf16, WS_WBR), NTOK, DM, BW}; EpiMerge<true> E{WSP(bf16, WS_GATE), WSP(bf16, WS_MERGED)}; pg8::gemm_phase<EpiMerge<true>, pg8::StaticOrder, true, true>(cc.lds, g, S, E); }
            { pg8::Gemm g{WSP(bf16, WS_HGR), WSP(bf16, WS_WBR) + (size_t)DM * BW, NTOK, DM, BW}; EpiMerge<false> E{WSP(bf16, WS_GATE) + (size_t)NTOK * 2048, WSP(bf16, WS_MERGED)}; pg8::gemm_phase<EpiMerge<false>, pg8::StaticOrder, true, true>(cc.lds, g, S, E); }
            { pg8::Gemm g{WSP(bf16, WS_CONV), WSP(bf16, WS_WBR) + (size_t)2 * DM * BW, NTOK, DM, BW}; EpiMerge<false> E{WSP(bf16, WS_GATE) + (size_t)2 * NTOK * 2048, WSP(bf16, WS_MERGED)}; pg8::gemm_phase<EpiMerge<false>, pg8::StaticOrder, true, true>(cc.lds, g, S, E); }
        }
        SEAM(pb + 5);
        if (IN(pb + 6)) { PH_BEGIN
            pg8::Gemm g{WSP(bf16, WS_MERGED), WSP(bf16, WS_WO), NTOK, DM, DM}; pg8::StaticOrder S; S.init(NTOK, DM, cc.G, (int)blockIdx.x);
            EpiResid E{l == 0 ? INP(0) : WSP(const float, WS_X2), outp};
            pg8::gemm_phase<EpiResid, pg8::StaticOrder, true, true>(cc.lds, g, S, E);
        }
        SEAM(pb + 6);
        if (IN(pb + 7)) { PH_BEGIN rms_phase(cc, outp, INP(15) + (size_t)l * DM, WSP(bf16, WS_H)); }
        SEAM(pb + 7);
        if (IN(pb + 8)) { PH_BEGIN
            pg8::Gemm g{WSP(bf16, WS_H), WSP(bf16, WS_WQ), NTOK, DM, DM}; pg8::StaticOrder S; S.init(NTOK, DM, cc.G, (int)blockIdx.x);
            EpiStoreBf16 E{WSP(bf16, WS_QPEER)};
            pg8::gemm_phase<EpiStoreBf16, pg8::StaticOrder, true, true>(cc.lds, g, S, E);
        }
        SEAM(pb + 8);
        if (IN(pb + 9)) { PH_BEGIN
            for (int it = cc.gw; it < (NTOK / 32) * 8; it += cc.NGW)
                peer_select32(it, cc.lane, WSP(bf16, WS_QPEER), WSP(bf16, WS_KEYS), WSP(int, WS_SEL), WSP(float, WS_SEL + 8 * MiB), WSP(float, WS_SELS));
        }
        SEAM(pb + 9);
        if (IN(pb + 10)) { PH_BEGIN
            const SliceSched SS = slice_sched_init(cc, (unsigned*)(w + WS_CTL), bar, l * 2 + 0);
            for (int i = 0;; ++i) { int sl, tb; if (!slice_item(SS, cc, i, sl, tb)) break;
                peer_sddmm_wave(tb * 64 + cc.wave * 8, sl, cc.lane, WSP(bf16, WS_H), WSP(unsigned char, WS_U), WSP(int, WS_SEL), WSP(float, WS_PART), (LAS unsigned*)(cc.lds + 4096 + cc.wave * 8192)); }
        }
        SEAM(pb + 10);
        if (IN(pb + 11)) { PH_BEGIN
            for (int n = cc.gw; n < NTOK; n += cc.NGW) peer_coef_token(n, cc.lane, WSP(float, WS_PART), WSP(int, WS_SEL), WSP(float, WS_SEL + 8 * MiB), WSP(float, WS_SELS), WSP(float, WS_US), WSP(float, WS_VS));
        }
        SEAM(pb + 11);
        if (IN(pb + 12)) { PH_BEGIN
            float* xo = l == 0 ? WSP(float, WS_X2) : outp;
            const SliceSched SS = slice_sched_init(cc, (unsigned*)(w + WS_CTL), bar, l * 2 + 1);
            for (int i = 0;; ++i) { int sl, tb; if (!slice_item(SS, cc, i, sl, tb)) break;
                peer_spmm_wave(tb * 64 + cc.wave * 8, sl, cc.lane, WSP(unsigned char, WS_V), WSP(int, WS_SEL), WSP(float, WS_SEL + 8 * MiB), outp, xo, (LAS unsigned*)(cc.lds + 4096 + cc.wave * 8192)); }
        }
        SEAM(pb + 12);
    }
#undef PH_BEGIN
#undef INP
#undef WSP
#undef IN
#undef SEAM
}

#ifndef MK_SPLIT
#define MK_SPLIT 0
#endif
extern "C" void kernel_launch(void* const* d_in, const int* in_sizes, int n_in, void* d_out, int out_size, void* d_ws, size_t ws_size, hipStream_t stream) {
    static int grid = 0;
    if (grid == 0) {
        if (n_in != 21 || out_size != NTOK * DM || ws_size < WS_END) { fprintf(stderr, "kernel_launch: unexpected shapes (n_in %d, out %d, ws %zu < %zu); nothing launched\n", n_in, out_size, ws_size, (size_t)WS_END); grid = -1; return; }
        int dev = 0, cus = 0, per_cu = 0;
        if (hipGetDevice(&dev) != hipSuccess || hipDeviceGetAttribute(&cus, hipDeviceAttributeMultiprocessorCount, dev) != hipSuccess) { grid = -1; return; }
        if (hipFuncSetAttribute((const void*)mk_fwd, hipFuncAttributeMaxDynamicSharedMemorySize, LDS_BYTES) != hipSuccess) { fprintf(stderr, "kernel_launch: hipFuncSetAttribute failed\n"); grid = -1; return; }
        if (hipOccupancyMaxActiveBlocksPerMultiprocessor(&per_cu, (const void*)mk_fwd, 512, LDS_BYTES) != hipSuccess || per_cu < 1) fprintf(stderr, "kernel_launch: occupancy query reports %d\n", per_cu);
        (void)hipGetLastError();
        grid = cus;
    }
    if (grid < 0) return;
    if (hipMemsetAsync((char*)d_ws + WS_CTL, 0, 1 * MiB, stream) != hipSuccess) { fprintf(stderr, "kernel_launch: memset failed\n"); return; }
    Args a{};
    for (int i = 0; i < 21; ++i) a.in[i] = (const float*)d_in[i];
    a.out = (float*)d_out; a.ws = (unsigned char*)d_ws; a.pad = 0;
#if MK_SPLIT
    for (int p = 0; p < NPHASES; ++p) { a.lo = p; a.hi = p + 1; a.li = p; hipLaunchKernelGGL(mk_fwd, dim3(grid), dim3(512), LDS_BYTES, stream, a); }
#else
    a.lo = 0; a.hi = NPHASES; a.li = 0;
    hipLaunchKernelGGL(mk_fwd, dim3(grid), dim3(512), LDS_BYTES, stream, a);
#endif
    const hipError_t le = hipPeekAtLastError();
    if (le != hipSuccess) fprintf(stderr, "kernel_launch: launch failed: %s\n", hipGetErrorName(le));
}
```

```cpp
#include <hip/hip_runtime.h>
#include <cstdio>
#include <cstdint>
namespace pg8 {
#define PG8_LAS __attribute__((address_space(3)))
typedef unsigned short bf16_t;
typedef short bf16x8 __attribute__((ext_vector_type(8)));
typedef float f32x4 __attribute__((ext_vector_type(4)));
typedef unsigned u32x4 __attribute__((ext_vector_type(4)));
constexpr int BM = 256, BK = 64, HALF = 128, HTB = HALF * BK * 2  , STAGE_BYTES = 8 * HTB, NXCD = 8, WGM = 8;

__host__ __device__ __forceinline__ int lds_byte(int r, int c) { const int st = (r >> 4) * 2 + (c >> 5), rr = r & 15, cc = c & 31, ob = rr * 64 + cc * 2; return st * 1024 + (ob ^ (((ob >> 9) & 1) << 5)); }
__host__ __device__ __forceinline__ void stage_rc(int b, int& R, int& C) { const int st = b / 1024, sb = b % 1024, swz = sb ^ (((sb >> 9) & 1) << 5); R = (st >> 1) * 16 + swz / 64; C = (st & 1) * 32 + (swz % 64) / 2; }
__host__ __device__ __forceinline__ int perm32(int rho) { const int n = rho >> 4, i = rho & 15; return 8 * (i >> 2) + 4 * n + (i & 3); }

struct Unit { int pm, pn; };
struct Gemm { const bf16_t* A; const bf16_t* Bt; int M, N, K; };

struct StaticOrder {
    int nM, nN, nwg, G, c;
    __host__ __device__ void init(int M, int N, int G_, int c_) { nM = M / BM; nN = N / BM; nwg = nM * nN; G = G_; c = c_; }
    __host__ __device__ bool next(int i, Unit& u) const {
        const long L = (long)i * G + c; if (L >= nwg) return false;
        int wgid = (int)L; { const int q = nwg / NXCD, r = nwg % NXCD, xcd = wgid % NXCD, off = wgid / NXCD; wgid = (xcd < r ? xcd * (q + 1) : r * (q + 1) + (xcd - r) * q) + off; }
        const int nig = WGM * nN, gid = wgid / nig, fm = gid * WGM, gsz = (nM - fm) < WGM ? (nM - fm) : WGM;
        u.pm = fm + ((wgid % nig) % gsz); u.pn = (wgid % nig) / gsz; return true;
    }
    __device__ __forceinline__ void a_ready(const Unit&) const {}
    __device__ __forceinline__ void done(const Unit&) const {}
};

typedef float f32x2 __attribute__((ext_vector_type(2)));
template <class Epi, class Sched, bool ALIGN_EPI = false, bool SP2 = false, bool I8 = false>
__device__ __forceinline__ void gemm_phase(PG8_LAS unsigned char* lds, const Gemm g, const Sched& S, const Epi& E) {
    int tid_ = threadIdx.x; asm volatile("" : "+v"(tid_)); int K_ = g.K; asm volatile("" : "+s"(K_));
    const int tid = tid_, wid = __builtin_amdgcn_readfirstlane(tid >> 6), lane = tid & 63, wr = wid >> 2, wc = wid & 3, fr = lane & 15, fq = lane >> 4;
    const int K = I8 ? (K_ >> 1) : K_, nt = K / BK;
    unsigned voffA[2], voffB[2];
#pragma unroll
    for (int i = 0; i < 2; ++i) { int R, C; stage_rc(tid * 16 + i * 8192, R, C); const int Rb = Epi::PERM ? ((R & ~31) + perm32(R & 31)) : R;
        voffA[i] = (unsigned)(R * K + C) * 2u; voffB[i] = (unsigned)(Rb * K + C) * 2u; }
    const size_t kstep = (size_t)(BK * 2);
    const size_t hstep = (size_t)HALF * K * 2;
    const size_t tstep = 2 * hstep;
    const unsigned ldsw = (unsigned)wid * 1024u;
    const int aoff = lds_byte(wr * 64 + fr, fq * 8), boff = lds_byte(wc * 32 + fr, fq * 8);
#define PG8_SA(b, h) (((b) * 2 + (h)) * HTB)
#define PG8_SB(b, h) ((4 + (b) * 2 + (h)) * HTB)
#define PG8_STAGE(bufoff, gbase, voff) do { _Pragma("unroll") for (int _i = 0; _i < 2; ++_i) \
        __builtin_amdgcn_global_load_lds((const unsigned*)((const char*)(gbase) + (voff)[_i]), (PG8_LAS unsigned*)(lds + (bufoff) + ldsw + _i * 8192), 16, 0, 0); } while (0)
#define PG8_LDA(dst, b, h) do { _Pragma("unroll") for (int m = 0; m < 4; ++m) _Pragma("unroll") for (int k = 0; k < 2; ++k) dst[m][k] = *(const PG8_LAS bf16x8*)(lds + PG8_SA(b, h) + aoff + m * 2048 + k * 1024); } while (0)
#define PG8_LDB(dst, b, h) do { _Pragma("unroll") for (int n = 0; n < 2; ++n) _Pragma("unroll") for (int k = 0; k < 2; ++k) dst[n][k] = *(const PG8_LAS bf16x8*)(lds + PG8_SB(b, h) + boff + n * 2048 + k * 1024); } while (0)
#define PG8_MMA(ai, bj, At, Bt) do { __builtin_amdgcn_s_setprio(1); _Pragma("unroll") for (int m = 0; m < 4; ++m) _Pragma("unroll") for (int n = 0; n < 2; ++n) _Pragma("unroll") for (int k = 0; k < 2; ++k) { \
        if constexpr (I8) { typedef int v4i_t __attribute__((ext_vector_type(4))); \
            acc[ai][bj][m][n] = __builtin_bit_cast(f32x4, __builtin_amdgcn_mfma_i32_16x16x64_i8(__builtin_bit_cast(v4i_t, Bt[n][k]), __builtin_bit_cast(v4i_t, At[m][k]), __builtin_bit_cast(v4i_t, acc[ai][bj][m][n]), 0, 0, 0)); } \
        else acc[ai][bj][m][n] = __builtin_amdgcn_mfma_f32_16x16x32_bf16(Bt[n][k], At[m][k], acc[ai][bj][m][n], 0, 0, 0); } __builtin_amdgcn_s_setprio(0); } while (0)
#define PG8_WAIT_V(n) asm volatile("s_waitcnt vmcnt(" #n ")" ::: "memory")
#define PG8_WAIT_L(n) asm volatile("s_waitcnt lgkmcnt(" #n ")" ::: "memory")
#define PG8_BAR __builtin_amdgcn_s_barrier()
#define PG8_SCHED __builtin_amdgcn_sched_barrier(0)
    Unit cur, nxt; int ui = 0;
    if (!S.next(0, cur)) return;
    f32x4 acc[2][2][4][2];
#pragma unroll
    for (int a = 0; a < 2; ++a)
#pragma unroll
        for (int b = 0; b < 2; ++b)
#pragma unroll
            for (int m = 0; m < 4; ++m)
#pragma unroll
                for (int n = 0; n < 2; ++n) acc[a][b][m][n] = (f32x4){0.f, 0.f, 0.f, 0.f};
    bf16x8 At[4][2], B0[2][2], B1[2][2];
    const char* cA = (const char*)g.A + (size_t)cur.pm * tstep; const char* cB = (const char*)g.Bt + (size_t)cur.pn * tstep;
    S.a_ready(cur);
    if constexpr (SP2) {
        PG8_STAGE(PG8_SB(0, 0), cB, voffB); PG8_STAGE(PG8_SB(0, 1), cB + hstep, voffB); PG8_STAGE(PG8_SA(0, 0), cA, voffA); PG8_STAGE(PG8_SA(0, 1), cA + hstep, voffA);
        if (wr == 1) PG8_BAR;
        PG8_WAIT_V(2); PG8_BAR;
        PG8_STAGE(PG8_SB(1, 0), cB + kstep, voffB); PG8_STAGE(PG8_SA(1, 0), cA + kstep, voffA); PG8_STAGE(PG8_SB(1, 1), cB + hstep + kstep, voffB);
        PG8_WAIT_V(6); PG8_BAR;
    } else {
        PG8_STAGE(PG8_SB(0, 0), cB, voffB); PG8_STAGE(PG8_SA(0, 0), cA, voffA); PG8_STAGE(PG8_SB(0, 1), cB + hstep, voffB); PG8_STAGE(PG8_SA(0, 1), cA + hstep, voffA);
        if (wr == 1) PG8_BAR;
        PG8_WAIT_V(4); PG8_BAR;
        PG8_STAGE(PG8_SB(1, 0), cB + kstep, voffB); PG8_STAGE(PG8_SA(1, 0), cA + kstep, voffA); PG8_STAGE(PG8_SB(1, 1), cB + hstep + kstep, voffB);
        PG8_WAIT_V(6); PG8_BAR;
    }
    for (;;) {
        const bool has_next = S.next(ui + 1, nxt);
        const char* nA = has_next ? (const char*)g.A + (size_t)nxt.pm * tstep : cA; const char* nB = has_next ? (const char*)g.Bt + (size_t)nxt.pn * tstep : cB;
        for (int t = 0; t < nt; t += 2) {
            const bool last = (t == nt - 2);
            const char* a1 = cA + (size_t)(t + 1) * kstep;
            const char* a2 = last ? nA : cA + (size_t)(t + 2) * kstep; const char* b2 = last ? nB : cB + (size_t)(t + 2) * kstep;
            const char* a3 = a2 + kstep; const char* b3 = b2 + kstep;
            if (last && has_next) S.a_ready(nxt);
            if constexpr (SP2) {
            PG8_LDB(B0, 0, 0); PG8_LDB(B1, 0, 1); PG8_SCHED; PG8_LDA(At, 0, 0); PG8_STAGE(PG8_SA(1, 1), a1 + hstep, voffA);
            PG8_WAIT_V(8); PG8_WAIT_L(0); PG8_BAR; PG8_MMA(0, 0, At, B0); PG8_MMA(0, 1, At, B1); PG8_BAR; PG8_SCHED;
            PG8_LDA(At, 0, 1); PG8_STAGE(PG8_SB(0, 0), b2, voffB); PG8_STAGE(PG8_SB(0, 1), b2 + hstep, voffB); PG8_STAGE(PG8_SA(0, 0), a2, voffA);
            PG8_WAIT_V(8); PG8_WAIT_L(0); PG8_BAR; PG8_MMA(1, 0, At, B0); PG8_MMA(1, 1, At, B1); PG8_BAR; PG8_SCHED;
            PG8_LDB(B0, 1, 0); PG8_LDB(B1, 1, 1); PG8_SCHED; PG8_LDA(At, 1, 0); PG8_STAGE(PG8_SA(0, 1), a2 + hstep, voffA);
            PG8_WAIT_V(8); PG8_WAIT_L(0); PG8_BAR; PG8_MMA(0, 0, At, B0); PG8_MMA(0, 1, At, B1); PG8_BAR; PG8_SCHED;
            PG8_LDA(At, 1, 1); PG8_STAGE(PG8_SB(1, 0), b3, voffB); PG8_STAGE(PG8_SB(1, 1), b3 + hstep, voffB); PG8_STAGE(PG8_SA(1, 0), a3, voffA);
            PG8_WAIT_V(8); PG8_WAIT_L(0); PG8_BAR; PG8_MMA(1, 0, At, B0); PG8_MMA(1, 1, At, B1); PG8_BAR; PG8_SCHED;
            } else {
            PG8_LDB(B0, 0, 0); PG8_SCHED; PG8_LDA(At, 0, 0); PG8_STAGE(PG8_SA(1, 1), a1 + hstep, voffA);
            PG8_WAIT_L(8); PG8_BAR; PG8_WAIT_L(0); PG8_MMA(0, 0, At, B0); PG8_BAR; PG8_SCHED;
            PG8_LDB(B1, 0, 1); PG8_STAGE(PG8_SB(0, 0), b2, voffB);
            PG8_BAR; PG8_WAIT_L(0); PG8_MMA(0, 1, At, B1); PG8_BAR;
            PG8_LDA(At, 0, 1); PG8_STAGE(PG8_SA(0, 0), a2, voffA);
            PG8_BAR; PG8_WAIT_L(0); PG8_MMA(1, 0, At, B0); PG8_BAR; PG8_SCHED;
            PG8_STAGE(PG8_SB(0, 1), b2 + hstep, voffB);
            PG8_WAIT_V(6); PG8_BAR; PG8_MMA(1, 1, At, B1); PG8_BAR;
            PG8_LDB(B0, 1, 0); PG8_SCHED; PG8_LDA(At, 1, 0); PG8_STAGE(PG8_SA(0, 1), a2 + hstep, voffA);
            PG8_WAIT_L(8); PG8_BAR; PG8_WAIT_L(0); PG8_MMA(0, 0, At, B0); PG8_BAR; PG8_SCHED;
            PG8_LDB(B1, 1, 1); PG8_STAGE(PG8_SB(1, 0), b3, voffB);
            PG8_BAR; PG8_WAIT_L(0); PG8_MMA(0, 1, At, B1); PG8_BAR;
            PG8_LDA(At, 1, 1); PG8_STAGE(PG8_SA(1, 0), a3, voffA);
            PG8_BAR; PG8_WAIT_L(0); PG8_MMA(1, 0, At, B0); PG8_BAR; PG8_SCHED;
            PG8_STAGE(PG8_SB(1, 1), b3 + hstep, voffB);
            PG8_WAIT_V(6); PG8_BAR; PG8_MMA(1, 1, At, B1); PG8_BAR;
            }
        }
        if constexpr (ALIGN_EPI) { if (wr == 0) PG8_BAR; }
        if constexpr (!Epi::AFTER_DRAIN) { E(acc, cur, wr, wc, fr, fq); S.done(cur); }
        if (!has_next) break;
#pragma unroll
        for (int a = 0; a < 2; ++a)
#pragma unroll
            for (int b = 0; b < 2; ++b)
#pragma unroll
                for (int m = 0; m < 4; ++m)
#pragma unroll
                    for (int n = 0; n < 2; ++n) acc[a][b][m][n] = (f32x4){0.f, 0.f, 0.f, 0.f};
        cur = nxt; cA = nA; cB = nB; ++ui;
        if constexpr (ALIGN_EPI) { if (wr == 1) PG8_BAR; }
    }
    PG8_WAIT_V(0);
    if constexpr (!ALIGN_EPI) { if (wr == 0) PG8_BAR; }
    PG8_BAR;
    if constexpr (Epi::AFTER_DRAIN) { E.fused(acc, cur, wr, wc, fr, fq, lds, wid, lane); S.done(cur); }
#undef PG8_SA
#undef PG8_SB
#undef PG8_STAGE
#undef PG8_LDA
#undef PG8_LDB
#undef PG8_MMA
#undef PG8_WAIT_V
#undef PG8_WAIT_L
#undef PG8_BAR
#undef PG8_SCHED
}
}
#define XB_TMO      128
#define XB_XCNT(j)  (256  + 64 * (j))
#define XB_XSUB(j)  (1280 + 64 * (j))
#define XB_XGEN(j)  (2304 + 64 * (j))
#define XB_TOP      3328
#define XB_TOPGEN   3392
#define XCD_BAR_WORDS 3456
#define XB_SPIN_CAP (1u << 24)
#define LAS __attribute__((address_space(3)))

__device__ __forceinline__ unsigned xb_ld(unsigned* p)              { return __hip_atomic_load(p, __ATOMIC_RELAXED, __HIP_MEMORY_SCOPE_AGENT); }
__device__ __forceinline__ unsigned xb_add(unsigned* p, unsigned v) { return __hip_atomic_fetch_add(p, v, __ATOMIC_RELAXED, __HIP_MEMORY_SCOPE_AGENT); }
__device__ __forceinline__ unsigned xb_xcc_id() { return (unsigned)__builtin_amdgcn_s_getreg((3 << 11) | 20) & 0xFu; }
#define XB_SPIN(cond, bar) do { unsigned _sp = 0; while (cond) { __builtin_amdgcn_s_sleep(1); \
    if ((++_sp & 255u) == 0u) { if (xb_ld(&(bar)[XB_TMO])) break; if (_sp > XB_SPIN_CAP) { atomicAdd(&(bar)[XB_TMO], 1u); break; } } } } while (0)

struct XcdBarrier {
    unsigned* bar; unsigned x;
    volatile LAS unsigned* st;
};

__device__ __forceinline__ XcdBarrier xcd_barrier_post(unsigned* bar, volatile LAS unsigned* st) {
    XcdBarrier b; b.bar = bar; b.x = xb_xcc_id(); b.st = st;
    if (threadIdx.x == 0) (void)xb_add(&bar[XB_XCNT(b.x)], 1u);
    return b;
}
__device__ __forceinline__ void xcd_barrier_complete(unsigned* bar, unsigned x, unsigned& nloc, unsigned& nx) {
    const unsigned G = gridDim.x * gridDim.y * gridDim.z;
    unsigned sum, cnt, mine, sp = 0u;
    for (;;) {
        sum = 0u; cnt = 0u; mine = 0u;
#pragma unroll
        for (unsigned j = 0; j < 16; ++j) { const unsigned c = xb_ld(&bar[XB_XCNT(j)]); sum += c; cnt += (c > 0u) ? 1u : 0u; mine = (j == x) ? c : mine; }
        if (sum == G) break;
        __builtin_amdgcn_s_sleep(1);
        if ((++sp & 255u) == 0u) { if (xb_ld(&bar[XB_TMO])) break; if (sp > XB_SPIN_CAP) { atomicAdd(&bar[XB_TMO], 1u); break; } }
    }
    nloc = mine > 0u ? mine : 1u; nx = cnt > 0u ? cnt : 1u;
}

__device__ __forceinline__ void xcd_barrier(const XcdBarrier& b) {
    asm volatile("s_waitcnt vmcnt(0)" ::: "memory");
    __syncthreads();
    if (threadIdx.x == 0) {
        unsigned* bar = b.bar;
        __builtin_amdgcn_s_waitcnt(0);
        unsigned nloc = b.st[0], nx = b.st[1];
        if (nloc == 0u) { xcd_barrier_complete(bar, b.x, nloc, nx); b.st[0] = nloc; b.st[1] = nx; }
        const unsigned old = xb_add(&bar[XB_XSUB(b.x)], 1u);
        const unsigned gen = old / nloc;
        if (old + 1u == (gen + 1u) * nloc) {
            __builtin_amdgcn_fence(__ATOMIC_RELEASE, "agent");
            asm volatile("s_waitcnt vmcnt(0)" ::: "memory");
            const unsigned og = xb_add(&bar[XB_TOP], 1u);
            const unsigned tg = og / nx;
            if (og + 1u == (tg + 1u) * nx) xb_add(&bar[XB_TOPGEN], 1u);
            else XB_SPIN(xb_ld(&bar[XB_TOPGEN]) == tg, bar);
            __builtin_amdgcn_fence(__ATOMIC_ACQUIRE, "agent");
            xb_add(&bar[XB_XGEN(b.x)], 1u);
            asm volatile("s_waitcnt vmcnt(0)" ::: "memory");
        } else {
            XB_SPIN(xb_ld(&bar[XB_XGEN(b.x)]) == gen, bar);
            __builtin_amdgcn_fence(__ATOMIC_ACQUIRE, "agent");
            asm volatile("s_waitcnt vmcnt(0)" ::: "memory");
        }
    }
    __syncthreads();
}


#define GAS __attribute__((address_space(1)))
typedef unsigned short bf16;
typedef unsigned v4u __attribute__((ext_vector_type(4)));
typedef unsigned v2u __attribute__((ext_vector_type(2)));
typedef float f32x4 __attribute__((ext_vector_type(4)));
typedef float f32x2v __attribute__((ext_vector_type(2)));
typedef float f32x16 __attribute__((ext_vector_type(16)));
typedef short bf16x8 __attribute__((ext_vector_type(8)));
typedef __bf16 bf16v2 __attribute__((ext_vector_type(2)));

constexpr int NTOK = 16384, DM = 2048, SEQ = 4096, INW = 15360, BW = 1024;
constexpr float EPS = 1e-6f;
constexpr float WIN_QS = 1024.0f;
constexpr int NPH = 13;
constexpr int NPHASES = 2 * NPH;

constexpr size_t MiB = 1u << 20;
constexpr size_t WS_CTL = 0;
constexpr size_t WS_LB = 1 * MiB;
constexpr size_t WS_SA = 1 * MiB + 192 * 1024;
constexpr size_t WS_US = 1 * MiB + 64 * 1024, WS_VS = 1 * MiB + 128 * 1024;
constexpr size_t WS_WIN = 2 * MiB;
constexpr size_t WS_WBR = 62 * MiB;
constexpr size_t WS_WO = 74 * MiB;
constexpr size_t WS_WQ = 82 * MiB;
constexpr size_t WS_U = 91 * MiB;
constexpr size_t WS_V = 155 * MiB;
constexpr size_t WS_H = 219 * MiB;
constexpr size_t WS_SEG = 283 * MiB;
constexpr size_t WS_GATE = 539 * MiB;
constexpr size_t WS_X2 = 731 * MiB;
constexpr size_t WS_CONV = 859 * MiB;
constexpr size_t WS_HGR = 891 * MiB;
constexpr size_t WS_MERGED = 923 * MiB;
constexpr size_t WS_SEL = 987 * MiB;
constexpr size_t WS_SELS = 1003 * MiB;
constexpr size_t WS_DEC = 1004 * MiB;
constexpr size_t WS_END = 1005 * MiB;
constexpr size_t WS_ST = WS_H;
constexpr size_t WS_KEYS = 90 * MiB;
constexpr size_t WS_PART = WS_GATE;
constexpr size_t WS_QPEER = WS_SEG;
constexpr size_t SEGSZ = (size_t)NTOK * 1024;
constexpr int CW_BAR = 4096;
constexpr int CW_RANK = 131072;

constexpr int RING_BYTES = 131072, MISC_OFF = RING_BYTES + 320, LDS_BYTES = 147456;

__device__ __forceinline__ unsigned pk2c(float lo, float hi) { f32x2v v = {lo, hi}; bf16v2 b = __builtin_convertvector(v, bf16v2); return __builtin_bit_cast(unsigned, b); }
__device__ __forceinline__ float bflo(unsigned x) { return __uint_as_float(x << 16); }
__device__ __forceinline__ float bfhi(unsigned x) { return __uint_as_float(x & 0xffff0000u); }
__device__ __forceinline__ float sigm(float x) { return __builtin_amdgcn_rcpf(1.0f + __expf(-x)); }
__device__ __forceinline__ float wave_sum(float v) {
#pragma unroll
    for (int o = 1; o < 64; o <<= 1) v += __shfl_xor(v, o);
    return v;
}
__device__ __forceinline__ float wave_max(float v) {
#pragma unroll
    for (int o = 1; o < 64; o <<= 1) v = fmaxf(v, __shfl_xor(v, o));
    return v;
}
#define LDS_WAIT() asm volatile("s_waitcnt lgkmcnt(0)" ::: "memory")
#define MFMA32(a, b, c) __builtin_amdgcn_mfma_f32_32x32x16_bf16((a), (b), (c), 0, 0, 0)
__device__ __forceinline__ int ridx16(int lane) { return ((lane >> 5) & 1) * 8 + ((lane >> 4) & 1) * 4 + ((lane >> 3) & 1) * 2 + ((lane >> 2) & 1); }
__device__ __forceinline__ void xreduce16(float (&v)[16], int lane) {
#pragma unroll
    for (int i = 0; i < 8; ++i) { const bool up = (lane & 32) != 0; const float snd = up ? v[i] : v[i + 8], kp = up ? v[i + 8] : v[i]; v[i] = kp + __shfl_xor(snd, 32); }
#pragma unroll
    for (int i = 0; i < 4; ++i) { const bool up = (lane & 16) != 0; const float snd = up ? v[i] : v[i + 4], kp = up ? v[i + 4] : v[i]; v[i] = kp + __shfl_xor(snd, 16); }
#pragma unroll
    for (int i = 0; i < 2; ++i) { const bool up = (lane & 8) != 0; const float snd = up ? v[i] : v[i + 2], kp = up ? v[i + 2] : v[i]; v[i] = kp + __shfl_xor(snd, 8); }
    { const bool up = (lane & 4) != 0; const float snd = up ? v[0] : v[1], kp = up ? v[1] : v[0]; v[0] = kp + __shfl_xor(snd, 4); }
    v[0] += __shfl_xor(v[0], 2); v[0] += __shfl_xor(v[0], 1);
}
__device__ __forceinline__ float gelu_exact(float v) {
    const float av = fabsf(v), t = __builtin_amdgcn_rcpf(av * 0.2316418882f + 1.0f);
    float q = t * 0.5307027145f + (-0.7265760135f); q = q * t + 0.7107068705f; q = q * t + (-0.142248368f); q = q * t + 0.127414796f; q = q * t;
    const float e = __builtin_amdgcn_exp2f((v * v) * (-0.72134752044f));
    const float m = v * (q * e);
    return v < 0.f ? m : v - m;
}

struct Ctx { LAS unsigned char* lds; int tid, lane, wave, G, gw, NGW; };

__device__ __forceinline__ void tr_item(const float* W, int K, int N, bf16* WT, int k0, int n0, int drow0, LAS float* scr, int lane) {
#pragma unroll 8
    for (int i = 0; i < 32; ++i) { const int kk = 2 * i + (lane >> 5); scr[kk * 33 + (lane & 31)] = ((const GAS float*)W)[(size_t)(k0 + kk) * N + n0 + (lane & 31)]; }
    LDS_WAIT();
    const int c = lane & 7;
#pragma unroll
    for (int j = 0; j < 4; ++j) { const int n = (lane >> 3) + 8 * j; const LAS float* s = scr + (8 * c) * 33 + n;
        v4u o; o.x = pk2c(s[0], s[33]); o.y = pk2c(s[66], s[99]); o.z = pk2c(s[132], s[165]); o.w = pk2c(s[198], s[231]);
        *(GAS v4u*)(WT + (size_t)(drow0 + n) * K + k0 + 8 * c) = o; }
    LDS_WAIT();
}
__device__ __forceinline__ unsigned pack_i8x4c(float a, float b, float c, float d) {
    const int ia = (int)__builtin_rintf(fminf(fmaxf(a, -127.f), 127.f)), ib = (int)__builtin_rintf(fminf(fmaxf(b, -127.f), 127.f)), ic = (int)__builtin_rintf(fminf(fmaxf(c, -127.f), 127.f)), id = (int)__builtin_rintf(fminf(fmaxf(d, -127.f), 127.f));
    return ((unsigned)ia & 255u) | (((unsigned)ib & 255u) << 8) | (((unsigned)ic & 255u) << 16) | ((unsigned)id << 24);
}
__device__ __forceinline__ void tr_item_i8(const float* W, int K, int N, unsigned char* WT, int k0, int n0, int drow0, float scale, LAS float* scr, int lane) {
#pragma unroll 8
    for (int i = 0; i < 32; ++i) { const int kk = 2 * i + (lane >> 5); scr[kk * 33 + (lane & 31)] = ((const GAS float*)W)[(size_t)(k0 + kk) * N + n0 + (lane & 31)]; }
    LDS_WAIT();
    const int c = lane & 7;
#pragma unroll
    for (int j = 0; j < 4; ++j) { const int n = (lane >> 3) + 8 * j; const LAS float* s = scr + (8 * c) * 33 + n;
        v2u o; o.x = pack_i8x4c(s[0] * scale, s[33] * scale, s[66] * scale, s[99] * scale); o.y = pack_i8x4c(s[132] * scale, s[165] * scale, s[198] * scale, s[231] * scale);
        *(GAS v2u*)(WT + (size_t)(drow0 + n) * K + k0 + 8 * c) = o; }
    LDS_WAIT();
}
__device__ __forceinline__ int win_drow(int n) { if (n < 7168 || n >= 9216) return n; const int r = n - 7168, isb = r >> 10, c = r & 1023; return 7168 + (c >> 7) * 256 + isb * 128 + (c & 127); }
__device__ __forceinline__ void cvt_copy(const Ctx& c, const float* src, bf16* dst, size_t n8) {
    const size_t NT = (size_t)c.G * 512;
    for (size_t i = (size_t)blockIdx.x * 512 + c.tid; i < n8; i += NT) {
        const f32x4 a = ((const GAS f32x4*)src)[2 * i], b = ((const GAS f32x4*)src)[2 * i + 1];
        v4u o; o.x = pk2c(a.x, a.y); o.y = pk2c(a.z, a.w); o.z = pk2c(b.x, b.y); o.w = pk2c(b.z, b.w);
        ((GAS v4u*)dst)[i] = o;
    }
}
__device__ __forceinline__ void rms_row(const float* xr, const float* w, bf16* o, int lane) {
    const GAS f32x4* xp = (const GAS f32x4*)xr + lane; f32x4 v[8]; float s = 0.f;
#pragma unroll
    for (int j = 0; j < 8; ++j) { v[j] = xp[64 * j]; s += (v[j].x * v[j].x + v[j].y * v[j].y) + (v[j].z * v[j].z + v[j].w * v[j].w); }
    const float r = __builtin_amdgcn_rsqf(wave_sum(s) * (1.0f / DM) + EPS);
    const GAS f32x4* wp = (const GAS f32x4*)w + lane; GAS v2u* op = (GAS v2u*)o + lane;
#pragma unroll
    for (int j = 0; j < 8; ++j) { const f32x4 wv = wp[64 * j]; v2u q; q.x = pk2c(v[j].x * r * wv.x, v[j].y * r * wv.y); q.y = pk2c(v[j].z * r * wv.z, v[j].w * r * wv.w); op[64 * j] = q; }
}
__device__ __forceinline__ void rms_row_i8(const float* xr, const float* w, unsigned char* o, float* sa, int lane) {
    const GAS f32x4* xp = (const GAS f32x4*)xr + lane; f32x4 v[8]; float s = 0.f;
#pragma unroll
    for (int j = 0; j < 8; ++j) { v[j] = xp[64 * j]; s += (v[j].x * v[j].x + v[j].y * v[j].y) + (v[j].z * v[j].z + v[j].w * v[j].w); }
    const float r = __builtin_amdgcn_rsqf(wave_sum(s) * (1.0f / DM) + EPS);
    const GAS f32x4* wp = (const GAS f32x4*)w + lane; float m = 0.f;
#pragma unroll
    for (int j = 0; j < 8; ++j) { const f32x4 wv = wp[64 * j]; v[j].x *= r * wv.x; v[j].y *= r * wv.y; v[j].z *= r * wv.z; v[j].w *= r * wv.w;
        m = fmaxf(fmaxf(m, fmaxf(fabsf(v[j].x), fabsf(v[j].y))), fmaxf(fabsf(v[j].z), fabsf(v[j].w))); }
    m = wave_max(m);
    const float inv = m > 0.f ? 127.0f / m : 0.f;
    if (lane == 0) *(GAS float*)sa = m * (1.0f / 127.0f);
#pragma unroll
    for (int j = 0; j < 8; ++j) ((GAS unsigned*)o)[lane + 64 * j] = pack_i8x4c(v[j].x * inv, v[j].y * inv, v[j].z * inv, v[j].w * inv);
}
__device__ __forceinline__ void rms_phase_i8(const Ctx& c, const float* x, const float* w, unsigned char* H8, float* SA) {
    for (int m = c.gw; m < NTOK; m += c.NGW) rms_row_i8(x + (size_t)m * DM, w, H8 + (size_t)m * DM, SA + m, c.lane);
}
__device__ __forceinline__ void rms_phase(const Ctx& c, const float* x, const float* w, bf16* H) {
    for (int m = c.gw; m < NTOK; m += c.NGW) rms_row(x + (size_t)m * DM, w, H + (size_t)m * DM, c.lane);
}
__device__ __forceinline__ void fp8_row(const float* src, unsigned char* dst, float* scale_out, int lane) {
    const GAS f32x4* xp = (const GAS f32x4*)src + lane; f32x4 v[8]; float m = 0.f;
#pragma unroll
    for (int j = 0; j < 8; ++j) { v[j] = xp[64 * j]; m = fmaxf(fmaxf(m, fmaxf(fabsf(v[j].x), fabsf(v[j].y))), fmaxf(fabsf(v[j].z), fabsf(v[j].w))); }
    m = wave_max(m);
    const float inv = m > 0.f ? 256.0f / m : 0.f;
    if (lane == 0) *(GAS float*)scale_out = m * (1.0f / 256.0f);
#pragma unroll
    for (int j = 0; j < 8; ++j) { int p = __builtin_amdgcn_cvt_pk_fp8_f32(v[j].x * inv, v[j].y * inv, 0, false); p = __builtin_amdgcn_cvt_pk_fp8_f32(v[j].z * inv, v[j].w * inv, p, true);
        ((GAS unsigned*)dst)[lane + 64 * j] = (unsigned)p; }
}
__device__ __forceinline__ unsigned pack_i8x4(float a, float b, float c, float d) {
    const int ia = (int)__builtin_rintf(a), ib = (int)__builtin_rintf(b), ic = (int)__builtin_rintf(c), id = (int)__builtin_rintf(d);
    return ((unsigned)ia & 255u) | (((unsigned)ib & 255u) << 8) | (((unsigned)ic & 255u) << 16) | ((unsigned)id << 24);
}
__device__ __forceinline__ void i8_row(const float* src, unsigned char* dst, float* scale_out, int lane) {
    const GAS f32x4* xp = (const GAS f32x4*)src + lane; f32x4 v[8]; float m = 0.f;
#pragma unroll
    for (int j = 0; j < 8; ++j) { v[j] = xp[64 * j]; m = fmaxf(fmaxf(m, fmaxf(fabsf(v[j].x), fabsf(v[j].y))), fmaxf(fabsf(v[j].z), fabsf(v[j].w))); }
    m = wave_max(m);
    const float inv = m > 0.f ? 127.0f / m : 0.f;
    if (lane == 0) *(GAS float*)scale_out = m * (1.0f / 127.0f);
#pragma unroll
    for (int j = 0; j < 8; ++j) ((GAS unsigned*)dst)[lane + 64 * j] = pack_i8x4(v[j].x * inv, v[j].y * inv, v[j].z * inv, v[j].w * inv);
}
struct P0Args { const float *w_in, *w_br_sb, *w_br_hg, *w_br_conv, *w_o, *w_q, *u, *v, *lbp; bf16 *WinT, *WbrT, *WoT, *WqT; unsigned char *U, *V; float *US, *VS; float* LB; int layer; const float *k1, *k2; bf16* KB; };
__device__ __forceinline__ void p0_convert(const Ctx& c, const P0Args& a) {
    LAS float* scr = (LAS float*)(c.lds + c.wave * 16384);
    constexpr int I_IN = (DM / 64) * (INW / 32), I_BR = (BW / 64) * (DM / 32), I_SQ = (DM / 64) * (DM / 32);
    constexpr int NITEMS = I_IN + 3 * I_BR + 2 * I_SQ;
    for (int it = c.gw; it < NITEMS; it += c.NGW) {
        int r = it;
        if (r < I_IN) { const int kb = r / (INW / 32), nb = r % (INW / 32); tr_item_i8(a.w_in, DM, INW, (unsigned char*)a.WinT, kb * 64, nb * 32, win_drow(nb * 32), WIN_QS, scr, c.lane); continue; } r -= I_IN;
        if (r < I_BR) { const int kb = r / (DM / 32), nb = r % (DM / 32); tr_item(a.w_br_sb, BW, DM, a.WbrT, kb * 64, nb * 32, nb * 32, scr, c.lane); continue; } r -= I_BR;
        if (r < I_BR) { const int kb = r / (DM / 32), nb = r % (DM / 32); tr_item(a.w_br_hg, BW, DM, a.WbrT + (size_t)DM * BW, kb * 64, nb * 32, nb * 32, scr, c.lane); continue; } r -= I_BR;
        if (r < I_BR) { const int kb = r / (DM / 32), nb = r % (DM / 32); tr_item(a.w_br_conv, BW, DM, a.WbrT + (size_t)2 * DM * BW, kb * 64, nb * 32, nb * 32, scr, c.lane); continue; } r -= I_BR;
        if (r < I_SQ) { const int kb = r / (DM / 32), nb = r % (DM / 32); tr_item(a.w_o, DM, DM, a.WoT, kb * 64, nb * 32, nb * 32, scr, c.lane); continue; } r -= I_SQ;
        { const int kb = r / (DM / 32), nb = r % (DM / 32); tr_item(a.w_q, DM, DM, a.WqT, kb * 64, nb * 32, nb * 32, scr, c.lane); }
    }
    for (int r = c.gw; r < 2 * 16384; r += c.NGW) {
        if (r < 16384) i8_row(a.u + (size_t)r * 2048, a.U + (size_t)r * 2048, a.US + r, c.lane);
        else fp8_row(a.v + (size_t)(r - 16384) * 2048, a.V + (size_t)(r - 16384) * 2048, a.VS + (r - 16384), c.lane);
    }
    cvt_copy(c, a.k1, a.KB, (size_t)8 * 16384 / 8);
    cvt_copy(c, a.k2, a.KB + 8 * 16384, (size_t)8 * 16384 / 8);
    if (blockIdx.x == 0) for (int i = c.tid; i < 1024; i += 512) a.LB[i] = a.layer == 0 ? 0.f : sigm(a.lbp[1024 + i] - a.lbp[i]);
}

struct EpiIn {
    static constexpr bool PERM = true, AFTER_DRAIN = false;
    bf16* seg; bf16* gate; const float* lb; const float* sa;
    static __device__ __forceinline__ pg8::f32x4 cv(const pg8::f32x4 a, float s) { return (pg8::f32x4){(float)__float_as_int(a[0]) * s, (float)__float_as_int(a[1]) * s, (float)__float_as_int(a[2]) * s, (float)__float_as_int(a[3]) * s}; }
    __device__ __forceinline__ void operator()(const pg8::f32x4 (&acc)[2][2][4][2], const pg8::Unit& u, int wr, int wc, int fr, int fq) const {
        const int pn = u.pn; const int row0 = u.pm * 256 + wr * 64 + fr;
        float rs[2][4];
#pragma unroll
        for (int ai = 0; ai < 2; ++ai)
#pragma unroll
            for (int m = 0; m < 4; ++m) rs[ai][m] = ((const GAS float*)sa)[row0 + ai * 128 + m * 16] * (1.0f / WIN_QS);
        if (pn >= 28 && pn < 36) {
            bf16* dst = seg + (size_t)7 * SEGSZ; const int col0 = (pn - 28) * 128 + wc * 32 + 8 * fq;
#pragma unroll
            for (int ai = 0; ai < 2; ++ai)
#pragma unroll
                for (int m = 0; m < 4; ++m) {
                    const pg8::f32x4 a0 = cv(acc[ai][0][m][0], rs[ai][m]), a1 = cv(acc[ai][0][m][1], rs[ai][m]), b0 = cv(acc[ai][1][m][0], rs[ai][m]), b1 = cv(acc[ai][1][m][1], rs[ai][m]);
                    v4u w; w.x = pk2c(a0[0] * sigm(b0[0]), a0[1] * sigm(b0[1])); w.y = pk2c(a0[2] * sigm(b0[2]), a0[3] * sigm(b0[3]));
                    w.z = pk2c(a1[0] * sigm(b1[0]), a1[1] * sigm(b1[1])); w.w = pk2c(a1[2] * sigm(b1[2]), a1[3] * sigm(b1[3]));
                    *(GAS v4u*)(dst + (size_t)(row0 + ai * 128 + m * 16) * 1024 + col0) = w; }
            return;
        }
        bf16* dst; int ld, colt, mode;
        if (pn < 28) { const int sg = pn >> 2; dst = seg + (size_t)sg * SEGSZ; ld = 1024; colt = (pn & 3) * 256; mode = (sg == 4) ? 2 : (sg == 6 ? 1 : 0); }
        else { const int q = pn - 36; dst = gate + (size_t)(q >> 3) * ((size_t)NTOK * 2048); ld = 2048; colt = (q & 7) * 256; mode = 1; }
        const int col0 = colt + wc * 32 + 8 * fq;
        if (mode == 0) {
#pragma unroll
            for (int ai = 0; ai < 2; ++ai)
#pragma unroll
                for (int m = 0; m < 4; ++m)
#pragma unroll
                    for (int bj = 0; bj < 2; ++bj) { const pg8::f32x4 v0 = cv(acc[ai][bj][m][0], rs[ai][m]), v1 = cv(acc[ai][bj][m][1], rs[ai][m]);
                        v4u w; w.x = pk2c(v0[0], v0[1]); w.y = pk2c(v0[2], v0[3]); w.z = pk2c(v1[0], v1[1]); w.w = pk2c(v1[2], v1[3]);
                        *(GAS v4u*)(dst + (size_t)(row0 + ai * 128 + m * 16) * ld + col0 + bj * 128) = w; }
        } else if (mode == 1) {
#pragma unroll
            for (int ai = 0; ai < 2; ++ai)
#pragma unroll
                for (int m = 0; m < 4; ++m)
#pragma unroll
                    for (int bj = 0; bj < 2; ++bj) { const pg8::f32x4 v0 = cv(acc[ai][bj][m][0], rs[ai][m]), v1 = cv(acc[ai][bj][m][1], rs[ai][m]);
                        v4u w; w.x = pk2c(sigm(v0[0]), sigm(v0[1])); w.y = pk2c(sigm(v0[2]), sigm(v0[3])); w.z = pk2c(sigm(v1[0]), sigm(v1[1])); w.w = pk2c(sigm(v1[2]), sigm(v1[3]));
                        *(GAS v4u*)(dst + (size_t)(row0 + ai * 128 + m * 16) * ld + col0 + bj * 128) = w; }
        } else {
            f32x4 l0[2], l1[2];
#pragma unroll
            for (int bj = 0; bj < 2; ++bj) { l0[bj] = *(const GAS f32x4*)(lb + col0 + bj * 128); l1[bj] = *(const GAS f32x4*)(lb + col0 + bj * 128 + 4); }
#pragma unroll
            for (int ai = 0; ai < 2; ++ai)
#pragma unroll
                for (int m = 0; m < 4; ++m)
#pragma unroll
                    for (int bj = 0; bj < 2; ++bj) { const pg8::f32x4 v0 = cv(acc[ai][bj][m][0], rs[ai][m]), v1 = cv(acc[ai][bj][m][1], rs[ai][m]); float r[8];
#pragma unroll
                        for (int j = 0; j < 4; ++j) { r[j] = __logf(l0[bj][j] + (1.0f - l0[bj][j]) * sigm(v0[j])); r[4 + j] = __logf(l1[bj][j] + (1.0f - l1[bj][j]) * sigm(v1[j])); }
                        v4u w; w.x = pk2c(r[0], r[1]); w.y = pk2c(r[2], r[3]); w.z = pk2c(r[4], r[5]); w.w = pk2c(r[6], r[7]);
                        *(GAS v4u*)(dst + (size_t)(row0 + ai * 128 + m * 16) * ld + col0 + bj * 128) = w; }
        }
    }
};

__device__ __forceinline__ void conv_phase(const Ctx& c, const bf16* glu, const float* cw, const float* cb, const float* lnw, const float* lnb, bf16* out) {
    const int c0 = 2 * c.tid;
    float w0[31], w1[31];
#pragma unroll
    for (int j = 0; j < 31; ++j) { const f32x2v t = *(const GAS f32x2v*)(cw + j * 1024 + c0); w0[j] = t.x; w1[j] = t.y; }
    const f32x2v bv = *(const GAS f32x2v*)(cb + c0), lwv = *(const GAS f32x2v*)(lnw + c0), lbv = *(const GAS f32x2v*)(lnb + c0);
    LAS float* red = (LAS float*)c.lds;
    for (int tile = blockIdx.x; tile < NTOK / 8; tile += c.G) {
        const int n0 = tile * 8, tseq0 = n0 & (SEQ - 1);
        float a0[8], a1[8];
#pragma unroll
        for (int t = 0; t < 8; ++t) { a0[t] = bv.x; a1[t] = bv.y; }
#pragma unroll
        for (int r = 0; r < 38; ++r) {
            unsigned xv = 0u;
            if (tseq0 + r - 30 >= 0) xv = *(const GAS unsigned*)(glu + (size_t)(n0 + r - 30) * 1024 + c0);
            const float x0 = bflo(xv), x1 = bfhi(xv);
#pragma unroll
            for (int t = 0; t < 8; ++t) { const int j = r - t; if (j >= 0 && j <= 30) { a0[t] += w0[j] * x0; a1[t] += w1[j] * x1; } }
        }
        float st[16];
#pragma unroll
        for (int t = 0; t < 8; ++t) { st[2 * t] = a0[t] + a1[t]; st[2 * t + 1] = a0[t] * a0[t] + a1[t] * a1[t]; }
        xreduce16(st, c.lane);
        if ((c.lane & 3) == 0) red[c.wave * 16 + ridx16(c.lane)] = st[0];
        __syncthreads();
        if (c.tid < 16) { float s = 0.f;
#pragma unroll
            for (int w = 0; w < 8; ++w) s += red[w * 16 + c.tid];
            red[128 + c.tid] = s; }
        __syncthreads();
#pragma unroll
        for (int t = 0; t < 8; ++t) {
            const float mean = red[128 + 2 * t] * (1.0f / 1024.0f), var = red[128 + 2 * t + 1] * (1.0f / 1024.0f) - mean * mean;
            const float rstd = __builtin_amdgcn_rsqf(var + EPS);
            const float h0 = (a0[t] - mean) * rstd * lwv.x + lbv.x, h1 = (a1[t] - mean) * rstd * lwv.y + lbv.y;
            *(GAS unsigned*)(out + (size_t)(n0 + t) * 1024 + c0) = pk2c(h0 * sigm(h0), h1 * sigm(h1));
        }
        __syncthreads();
    }
}
__device__ __forceinline__ void hgrn_task(int task, int lane, const bf16* qhg, const bf16* logf, const bf16* ihg, bf16* out) {
    const int bh = task >> 6, dvb = task & 63, b = bh >> 3, h = bh & 7;
    const size_t rb = (size_t)b * SEQ * 1024;
    const GAS unsigned* qp = (const GAS unsigned*)(qhg + rb + h * 128) + lane;
    const GAS unsigned* lp = (const GAS unsigned*)(logf + rb + h * 128) + lane;
    const GAS unsigned* ip = (const GAS unsigned*)(ihg + rb + h * 128) + dvb;
    GAS bf16* op = (GAS bf16*)(out + rb + h * 128 + 2 * dvb);
    float S00 = 0.f, S01 = 0.f, S10 = 0.f, S11 = 0.f;
    unsigned qn[8], ln[8], inx[8];
#pragma unroll
    for (int j = 0; j < 8; ++j) { qn[j] = qp[(size_t)j * 512]; ln[j] = lp[(size_t)j * 512]; inx[j] = ip[(size_t)j * 512]; }
    for (int blk = 0; blk < SEQ / 8; ++blk) {
        unsigned qc[8], lc[8], ic[8];
#pragma unroll
        for (int j = 0; j < 8; ++j) { qc[j] = qn[j]; lc[j] = ln[j]; ic[j] = inx[j]; }
        if (blk + 1 < SEQ / 8) {
#pragma unroll
            for (int j = 0; j < 8; ++j) { const size_t o = (size_t)((blk + 1) * 8 + j) * 512; qn[j] = qp[o]; ln[j] = lp[o]; inx[j] = ip[o]; }
        }
        float pv[16];
#pragma unroll
        for (int j = 0; j < 8; ++j) {
            const float f0 = __expf(bflo(lc[j])), f1 = __expf(bfhi(lc[j])), k0 = 1.0f - f0, k1 = 1.0f - f1;
            const float i0 = bflo(ic[j]), i1 = bfhi(ic[j]), q0 = bflo(qc[j]), q1 = bfhi(qc[j]);
            S00 = f0 * S00 + k0 * i0; S01 = f0 * S01 + k0 * i1; S10 = f1 * S10 + k1 * i0; S11 = f1 * S11 + k1 * i1;
            pv[2 * j] = S00 * q0 + S10 * q1; pv[2 * j + 1] = S01 * q0 + S11 * q1;
        }
        xreduce16(pv, lane);
        if ((lane & 3) == 0) { const int idx = ridx16(lane); op[(size_t)(blk * 8 + (idx >> 1)) * 1024 + (idx & 1)] = (bf16)(pk2c(pv[0], 0.f) & 0xffffu); }
    }
}
constexpr int HG_TS = 272;
constexpr int HG_BS = 132;
__device__ __forceinline__ void hg_stage(LAS unsigned char* dst, const bf16* src, int tid) {
#pragma unroll
    for (int i = 0; i < 2; ++i) { const int p = tid + 512 * i, row = p >> 4, c16 = p & 15; *(LAS v4u*)(dst + row * HG_TS + c16 * 16) = *(const GAS v4u*)(src + (size_t)row * 1024 + c16 * 8); }
}
__device__ __forceinline__ void hg_scan(const LAS unsigned char* lft, int dk, int hf, float (&lf)[4][8], float (&b)[4][8], float& bl) {
    float bs[4], pb[4];
#pragma unroll
    for (int kk = 0; kk < 4; ++kk) { float run = 0.f;
#pragma unroll
        for (int j = 0; j < 8; ++j) { lf[kk][j] = __uint_as_float((unsigned)(*(const LAS unsigned short*)(lft + (16 * kk + 8 * hf + j) * HG_TS + dk * 2)) << 16); run += lf[kk][j]; b[kk][j] = run; }
        bs[kk] = run; }
#pragma unroll
    for (int kk = 0; kk < 4; ++kk) pb[kk] = __shfl_xor(bs[kk], 32);
    float pre = 0.f;
#pragma unroll
    for (int kk = 0; kk < 4; ++kk) { const float off = pre + (hf ? pb[kk] : 0.f);
#pragma unroll
        for (int j = 0; j < 8; ++j) b[kk][j] += off;
        pre += bs[kk] + pb[kk]; }
    bl = pre;
}
__device__ __forceinline__ bf16x8 pack8(const float (&v)[8]) { v4u t; t.x = pk2c(v[0], v[1]); t.y = pk2c(v[2], v[3]); t.z = pk2c(v[4], v[5]); t.w = pk2c(v[6], v[7]); return __builtin_bit_cast(bf16x8, t); }
__device__ __forceinline__ unsigned lds_u16(const LAS unsigned char* p) { return (unsigned)(*(const LAS unsigned short*)p); }
__device__ __forceinline__ void hgA_chunk(const Ctx& c, int ci, const bf16* LOGF, const bf16* IHG, bf16* ST, float* DEC) {
    const int bh = ci >> 6, ch = ci & 63, bb = bh >> 3, h = bh & 7; const size_t n0 = (size_t)bb * SEQ + ch * 64;
    LAS unsigned char* lft = c.lds; LAS unsigned char* itl = c.lds + 64 * HG_TS;
    hg_stage(lft, LOGF + n0 * 1024 + h * 128, c.tid); hg_stage(itl, IHG + n0 * 1024 + h * 128, c.tid);
    __syncthreads();
    const int dkt = c.wave & 3, dvh = c.wave >> 2, hf = c.lane >> 5, cl = c.lane & 31, dk = 32 * dkt + cl;
    float lf[4][8], b[4][8], bl; hg_scan(lft, dk, hf, lf, b, bl);
    bf16x8 kf[4];
#pragma unroll
    for (int kk = 0; kk < 4; ++kk) { float v[8];
#pragma unroll
        for (int j = 0; j < 8; ++j) v[j] = (1.0f - __expf(lf[kk][j])) * __expf(bl - b[kk][j]);
        kf[kk] = pack8(v); }
    if (dvh == 0 && hf == 0) ((GAS float*)DEC)[(size_t)ci * 128 + dk] = __expf(bl);
#pragma unroll
    for (int dvi = 0; dvi < 2; ++dvi) { const int dvt = dvh * 2 + dvi;
        f32x16 acc;
#pragma unroll
        for (int r = 0; r < 16; ++r) acc[r] = 0.f;
#pragma unroll
        for (int kk = 0; kk < 4; ++kk) { const LAS unsigned char* p = itl + (16 * kk + 8 * hf) * HG_TS + (32 * dvt + cl) * 2;
            v4u t; t.x = lds_u16(p) | (lds_u16(p + HG_TS) << 16); t.y = lds_u16(p + 2 * HG_TS) | (lds_u16(p + 3 * HG_TS) << 16); t.z = lds_u16(p + 4 * HG_TS) | (lds_u16(p + 5 * HG_TS) << 16); t.w = lds_u16(p + 6 * HG_TS) | (lds_u16(p + 7 * HG_TS) << 16);
            acc = MFMA32(kf[kk], __builtin_bit_cast(bf16x8, t), acc); }
        bf16* o = ST + (size_t)ci * 16384 + (size_t)(32 * dvt + cl) * 128 + 32 * dkt + 4 * hf;
#pragma unroll
        for (int g = 0; g < 4; ++g) { v2u q; q.x = pk2c(acc[4 * g], acc[4 * g + 1]); q.y = pk2c(acc[4 * g + 2], acc[4 * g + 3]); *(GAS v2u*)(o + 8 * g) = q; }
    }
    __syncthreads();
}
__device__ __forceinline__ void hgB(const Ctx& c, bf16* ST, const float* DEC) {
    for (int e = blockIdx.x * 512 + c.tid; e < 32 * 4096; e += c.G * 512) {
        const int bh = e >> 12, r = e & 4095, dv = r >> 5, dk4 = (r & 31) * 4;
        GAS v2u* p = (GAS v2u*)(ST + (size_t)bh * 64 * 16384 + (size_t)dv * 128 + dk4);
        const GAS f32x4* d = (const GAS f32x4*)(DEC + (size_t)bh * 64 * 128 + dk4);
        f32x4 S = {0.f, 0.f, 0.f, 0.f};
#pragma unroll 1
        for (int c0 = 0; c0 < 64; c0 += 8) {
            v2u Lv[8]; f32x4 D[8];
#pragma unroll
            for (int k = 0; k < 8; ++k) { Lv[k] = p[(size_t)(c0 + k) * 4096]; D[k] = d[(size_t)(c0 + k) * 32]; }
#pragma unroll
            for (int k = 0; k < 8; ++k) { v2u o; o.x = pk2c(S.x, S.y); o.y = pk2c(S.z, S.w); p[(size_t)(c0 + k) * 4096] = o;
                S.x = D[k].x * S.x + bflo(Lv[k].x); S.y = D[k].y * S.y + bfhi(Lv[k].x); S.z = D[k].z * S.z + bflo(Lv[k].y); S.w = D[k].w * S.w + bfhi(Lv[k].y); }
        }
    }
}
__device__ __forceinline__ void hgC_chunk(const Ctx& c, int ci, const bf16* QHG, const bf16* LOGF, const bf16* IHG, const bf16* GHG, const bf16* ST, const float* nw, bf16* OUT) {
    const int bh = ci >> 6, ch = ci & 63, bb = bh >> 3, h = bh & 7; const size_t n0 = (size_t)bb * SEQ + ch * 64;
    LAS unsigned char* lft = c.lds; LAS unsigned char* itl = c.lds + 64 * HG_TS; LAS float* bt = (LAS float*)(c.lds + 2 * 64 * HG_TS); LAS float* red = bt + 64 * HG_BS;
    LAS unsigned char* ktl = (LAS unsigned char*)(red + 256);
    hg_stage(lft, LOGF + n0 * 1024 + h * 128, c.tid); hg_stage(itl, IHG + n0 * 1024 + h * 128, c.tid);
    __syncthreads();
    const int hf = c.lane >> 5, cl = c.lane & 31;
    { const int dk = 32 * (c.wave & 3) + cl; float lf[4][8], b[4][8], bl; hg_scan(lft, dk, hf, lf, b, bl);
#pragma unroll
      for (int q = 0; q < 2; ++q) { const int kk = 2 * (c.wave >> 2) + q;
#pragma unroll
          for (int j = 0; j < 8; ++j) { bt[(16 * kk + 8 * hf + j) * HG_BS + dk] = (c.wave >> 2) ? b[2 + q][j] : b[q][j];
              *(LAS unsigned short*)(ktl + (16 * kk + 8 * hf + j) * HG_TS + dk * 2) = (unsigned short)(pk2c(1.0f - __expf((c.wave >> 2) ? lf[2 + q][j] : lf[q][j]), 0.f) & 0xffffu); } } }
    __syncthreads();
    const int dvt = c.wave & 3, tt = c.wave >> 2, t = 32 * tt + cl;
    bf16x8 qm[8];
    const bf16* qrow = QHG + (n0 + t) * 1024 + h * 128 + 8 * hf;
#pragma unroll
    for (int kk = 0; kk < 8; ++kk) { const int d0 = 16 * kk + 8 * hf;
        asm volatile("" ::: "memory");
        const v4u qv = *(const GAS v4u*)(qrow + 16 * kk);
        const f32x4 b0 = *(const LAS f32x4*)(bt + t * HG_BS + d0), b1 = *(const LAS f32x4*)(bt + t * HG_BS + d0 + 4), m0 = *(const LAS f32x4*)(bt + 31 * HG_BS + d0), m1 = *(const LAS f32x4*)(bt + 31 * HG_BS + d0 + 4);
        const float q[8] = {bflo(qv.x), bfhi(qv.x), bflo(qv.y), bfhi(qv.y), bflo(qv.z), bfhi(qv.z), bflo(qv.w), bfhi(qv.w)};
        const float bv[8] = {b0.x, b0.y, b0.z, b0.w, b1.x, b1.y, b1.z, b1.w}, mv[8] = {m0.x, m0.y, m0.z, m0.w, m1.x, m1.y, m1.z, m1.w};
        float vm[8];
#pragma unroll
        for (int j = 0; j < 8; ++j) vm[j] = q[j] * __expf(bv[j] - mv[j]);
        qm[kk] = pack8(vm); }
    f32x16 o;
#pragma unroll
    for (int r = 0; r < 16; ++r) o[r] = 0.f;
#pragma unroll 1
    for (int st = 0; st <= tt; ++st) {
        const int s = 32 * st + cl;
        f32x16 sa;
#pragma unroll
        for (int r = 0; r < 16; ++r) sa[r] = 0.f;
#pragma unroll
        for (int kk = 0; kk < 8; ++kk) { const int d0 = 16 * kk + 8 * hf;
            asm volatile("" ::: "memory");
            const v4u lv = *(const LAS v4u*)(ktl + s * HG_TS + d0 * 2);
            const f32x4 b0 = *(const LAS f32x4*)(bt + s * HG_BS + d0), b1 = *(const LAS f32x4*)(bt + s * HG_BS + d0 + 4), m0 = *(const LAS f32x4*)(bt + 31 * HG_BS + d0), m1 = *(const LAS f32x4*)(bt + 31 * HG_BS + d0 + 4);
            const float kv[8] = {bflo(lv.x), bfhi(lv.x), bflo(lv.y), bfhi(lv.y), bflo(lv.z), bfhi(lv.z), bflo(lv.w), bfhi(lv.w)};
            const float bv[8] = {b0.x, b0.y, b0.z, b0.w, b1.x, b1.y, b1.z, b1.w}, mv[8] = {m0.x, m0.y, m0.z, m0.w, m1.x, m1.y, m1.z, m1.w};
            float vk[8];
#pragma unroll
            for (int j = 0; j < 8; ++j) vk[j] = kv[j] * __expf(mv[j] - bv[j]);
            sa = MFMA32(pack8(vk), qm[kk], sa); }
        if (st == tt) {
#pragma unroll
            for (int r = 0; r < 16; ++r) if (((r & 3) + 8 * (r >> 2) + 4 * hf) > cl) sa[r] = 0.f;
        }
#pragma unroll
        for (int sp = 0; sp < 2; ++sp) {
            const float pv[8] = {sa[8 * sp], sa[8 * sp + 1], sa[8 * sp + 2], sa[8 * sp + 3], sa[8 * sp + 4], sa[8 * sp + 5], sa[8 * sp + 6], sa[8 * sp + 7]};
            const LAS unsigned char* p = itl + (32 * st + 16 * sp + 4 * hf) * HG_TS + (32 * dvt + cl) * 2;
            v4u tq; tq.x = lds_u16(p) | (lds_u16(p + HG_TS) << 16); tq.y = lds_u16(p + 2 * HG_TS) | (lds_u16(p + 3 * HG_TS) << 16);
            tq.z = lds_u16(p + 8 * HG_TS) | (lds_u16(p + 9 * HG_TS) << 16); tq.w = lds_u16(p + 10 * HG_TS) | (lds_u16(p + 11 * HG_TS) << 16);
            o = MFMA32(__builtin_bit_cast(bf16x8, tq), pack8(pv), o); }
    }
    { const bf16* strow = ST + (size_t)ci * 16384 + (size_t)(32 * dvt + cl) * 128 + 8 * hf;
#pragma unroll
      for (int kk = 0; kk < 8; ++kk) { const int d0 = 16 * kk + 8 * hf;
          asm volatile("" ::: "memory");
          const v4u qv = *(const GAS v4u*)(qrow + 16 * kk); const bf16x8 sf = *(const GAS bf16x8*)(strow + 16 * kk);
          const f32x4 b0 = *(const LAS f32x4*)(bt + t * HG_BS + d0), b1 = *(const LAS f32x4*)(bt + t * HG_BS + d0 + 4);
          float ve[8] = {bflo(qv.x) * __expf(b0.x), bfhi(qv.x) * __expf(b0.y), bflo(qv.y) * __expf(b0.z), bfhi(qv.y) * __expf(b0.w), bflo(qv.z) * __expf(b1.x), bfhi(qv.z) * __expf(b1.y), bflo(qv.w) * __expf(b1.z), bfhi(qv.w) * __expf(b1.w)};
          o = MFMA32(sf, pack8(ve), o); } }
    float ss = 0.f;
#pragma unroll
    for (int r = 0; r < 16; ++r) ss += o[r] * o[r];
    ss += __shfl_xor(ss, 32);
    if (hf == 0) red[(tt * 4 + dvt) * 32 + cl] = ss;
    __syncthreads();
    const float rstd = __builtin_amdgcn_rsqf(((red[(tt * 4 + 0) * 32 + cl] + red[(tt * 4 + 1) * 32 + cl]) + (red[(tt * 4 + 2) * 32 + cl] + red[(tt * 4 + 3) * 32 + cl])) * (1.0f / 128.0f) + EPS);
#pragma unroll
    for (int g = 0; g < 4; ++g) { const int dv0 = 32 * dvt + 8 * g + 4 * hf; const size_t off = (n0 + t) * 1024 + h * 128 + dv0;
        const v2u gg = *(const GAS v2u*)(GHG + off); const f32x4 w4 = *(const GAS f32x4*)(nw + dv0);
        v2u q; q.x = pk2c(o[4 * g] * rstd * w4.x * bflo(gg.x), o[4 * g + 1] * rstd * w4.y * bfhi(gg.x)); q.y = pk2c(o[4 * g + 2] * rstd * w4.z * bflo(gg.y), o[4 * g + 3] * rstd * w4.w * bfhi(gg.y));
        *(GAS v2u*)(OUT + off) = q; }
    __syncthreads();
}
__device__ __forceinline__ void qknorm_row(bf16* row, const float* w, float scale, int lane) {
#pragma unroll
    for (int j = 0; j < 2; ++j) {
        GAS v4u* p = (GAS v4u*)(row + 8 * lane + 512 * j); const v4u x = *p;
        float f[8] = {bflo(x.x), bfhi(x.x), bflo(x.y), bfhi(x.y), bflo(x.z), bfhi(x.z), bflo(x.w), bfhi(x.w)};
        float ss = 0.f;
#pragma unroll
        for (int k = 0; k < 8; ++k) ss += f[k] * f[k];
        ss += __shfl_xor(ss, 1); ss += __shfl_xor(ss, 2); ss += __shfl_xor(ss, 4); ss += __shfl_xor(ss, 8);
        const float r = __builtin_amdgcn_rsqf(ss * (1.0f / 128.0f) + EPS) * scale;
        const f32x4 wa = *(const GAS f32x4*)(w + ((8 * lane) & 127)), wb = *(const GAS f32x4*)(w + ((8 * lane) & 127) + 4);
        v4u o; o.x = pk2c(f[0] * r * wa.x, f[1] * r * wa.y); o.y = pk2c(f[2] * r * wa.z, f[3] * r * wa.w); o.z = pk2c(f[4] * r * wb.x, f[5] * r * wb.y); o.w = pk2c(f[6] * r * wb.z, f[7] * r * wb.w);
        *p = o;
    }
}
__device__ __forceinline__ void vt_item(int item, int lane, const bf16* vsb, bf16* vt, LAS unsigned short* scr) {
    const int db = item & 3, sb = (item >> 2) & 63, bh = item >> 8, b = bh >> 3, h = bh & 7;
    const bf16* src = vsb + ((size_t)b * SEQ + sb * 64) * 1024 + h * 128 + db * 32;
#pragma unroll 4
    for (int i = 0; i < 16; ++i) { const int r = 4 * i + (lane >> 4); *(LAS unsigned*)(scr + r * 34 + 2 * (lane & 15)) = *(const GAS unsigned*)(src + (size_t)r * 1024 + 2 * (lane & 15)); }
    LDS_WAIT();
    const int c = lane & 7;
#pragma unroll
    for (int j = 0; j < 4; ++j) { const int d = (lane >> 3) + 8 * j; const LAS unsigned short* s = scr + (8 * c) * 34 + d;
        v4u o; o.x = (unsigned)s[0] | ((unsigned)s[34] << 16); o.y = (unsigned)s[68] | ((unsigned)s[102] << 16); o.z = (unsigned)s[136] | ((unsigned)s[170] << 16); o.w = (unsigned)s[204] | ((unsigned)s[238] << 16);
        *(GAS v4u*)(vt + ((size_t)bh * 128 + db * 32 + d) * SEQ + sb * 64 + 8 * c) = o; }
    LDS_WAIT();
}

constexpr int AT_KS = 272, AT_VS = 136, AT_BUF = 64 * AT_KS + 128 * AT_VS;
__device__ __forceinline__ f32x16 attn_scores(const LAS unsigned char* kp, const bf16x8 (&qf)[8]) {
    f32x16 sa;
#pragma unroll
    for (int r = 0; r < 16; ++r) sa[r] = 0.f;
#pragma unroll
    for (int kk = 0; kk < 8; ++kk) sa = MFMA32(*(const LAS bf16x8*)(kp + 32 * kk), qf[kk], sa);
    return sa;
}
template <bool DIAG> __device__ __forceinline__ void attn_weights(const f32x16& sa, float& R, int hf, int cl, bf16x8 (&pf)[2]) {
    float om[16], be[16];
#pragma unroll
    for (int r = 0; r < 16; ++r) { const float e = __builtin_amdgcn_exp2f(sa[r] * 1.4426950408889634f); om[r] = __builtin_amdgcn_rcpf(1.0f + e); be[r] = e * om[r]; }
    if (DIAG) {
#pragma unroll
        for (int r = 0; r < 16; ++r) if (((r & 3) + 8 * (r >> 2) + 4 * hf) >= cl) { om[r] = 1.0f; be[r] = 0.f; }
    }
    float Gs[4], Gp[4];
#pragma unroll
    for (int g = 0; g < 4; ++g) { Gs[g] = (om[4 * g] * om[4 * g + 1]) * (om[4 * g + 2] * om[4 * g + 3]); Gp[g] = __shfl_xor(Gs[g], 32); }
    float tail = R; float w[16];
#pragma unroll
    for (int g = 3; g >= 0; --g) {
        const float c3 = tail * (hf == 0 ? Gp[g] : 1.0f), c2 = c3 * om[4 * g + 3], c1 = c2 * om[4 * g + 2], c0 = c1 * om[4 * g + 1];
        w[4 * g + 3] = be[4 * g + 3] * c3; w[4 * g + 2] = be[4 * g + 2] * c2; w[4 * g + 1] = be[4 * g + 1] * c1; w[4 * g] = be[4 * g] * c0;
        tail *= Gs[g] * Gp[g];
    }
    R = tail;
#pragma unroll
    for (int sp = 0; sp < 2; ++sp) { v4u t; t.x = pk2c(w[8 * sp], w[8 * sp + 1]); t.y = pk2c(w[8 * sp + 2], w[8 * sp + 3]); t.z = pk2c(w[8 * sp + 4], w[8 * sp + 5]); t.w = pk2c(w[8 * sp + 6], w[8 * sp + 7]); pf[sp] = __builtin_bit_cast(bf16x8, t); }
}
__device__ __forceinline__ void attn_pv(const LAS unsigned char* vp, const bf16x8 (&pf)[2], f32x16 (&o)[4]) {
#pragma unroll
    for (int d = 0; d < 4; ++d)
#pragma unroll
        for (int sp = 0; sp < 2; ++sp) { const v2u lo = *(const LAS v2u*)(vp + d * 32 * AT_VS + 32 * sp), hi = *(const LAS v2u*)(vp + d * 32 * AT_VS + 32 * sp + 16);
            v4u t; t.x = lo.x; t.y = lo.y; t.z = hi.x; t.w = hi.y; o[d] = MFMA32(__builtin_bit_cast(bf16x8, t), pf[sp], o[d]); }
}
__device__ __forceinline__ void attn_unit(const Ctx& c, int bh, int qb, const bf16* qsb, const bf16* ksb, const bf16* vt, bf16* outb) {
    const int b = bh >> 3, h = bh & 7, lane = c.lane, cl = lane & 31, hf = lane >> 5, tid = c.tid;
    const size_t rb = (size_t)b * SEQ; const int q0w = 256 * qb + 32 * c.wave;
    bf16x8 qf[8];
    { const bf16* qrow = qsb + (rb + q0w + cl) * 1024 + h * 128 + 8 * hf;
#pragma unroll
      for (int kk = 0; kk < 8; ++kk) qf[kk] = *(const GAS bf16x8*)(qrow + 16 * kk); }
    f32x16 o[4];
#pragma unroll
    for (int d = 0; d < 4; ++d)
#pragma unroll
        for (int r = 0; r < 16; ++r) o[d][r] = 0.f;
    float R = 1.0f;
    const bf16* kg = ksb + (rb + (tid >> 4)) * 1024 + h * 128 + (tid & 15) * 8;
    const bf16* vg = vt + ((size_t)bh * 128 + (tid >> 3)) * SEQ + (tid & 7) * 8;
    const int kl = (tid >> 4) * AT_KS + (tid & 15) * 16, vl = 64 * AT_KS + (tid >> 3) * AT_VS + (tid & 7) * 16;
    const int nkt = 4 * (qb + 1);
    v4u st[4];
    { const int kt = nkt - 1;
      st[0] = *(const GAS v4u*)(kg + (size_t)kt * 64 * 1024); st[1] = *(const GAS v4u*)(kg + (size_t)kt * 64 * 1024 + 32 * 1024);
      st[2] = *(const GAS v4u*)(vg + kt * 64); st[3] = *(const GAS v4u*)(vg + kt * 64 + (size_t)64 * SEQ);
      *(LAS v4u*)(c.lds + kl) = st[0]; *(LAS v4u*)(c.lds + kl + 32 * AT_KS) = st[1];
      *(LAS v2u*)(c.lds + vl) = (v2u){st[2].x, st[2].y}; *(LAS v2u*)(c.lds + vl + 8) = (v2u){st[2].z, st[2].w}; *(LAS v2u*)(c.lds + vl + 64 * AT_VS) = (v2u){st[3].x, st[3].y}; *(LAS v2u*)(c.lds + vl + 64 * AT_VS + 8) = (v2u){st[3].z, st[3].w}; }
    __syncthreads();
#pragma unroll 1
    for (int it = 0; it < nkt; ++it) {
        const int kt = nkt - 1 - it; LAS unsigned char* buf = c.lds + (it & 1) * AT_BUF; LAS unsigned char* nbuf = c.lds + ((it & 1) ^ 1) * AT_BUF;
        const bool more = (it + 1 < nkt);
        if (more) { const int k2 = kt - 1;
            st[0] = *(const GAS v4u*)(kg + (size_t)k2 * 64 * 1024); st[1] = *(const GAS v4u*)(kg + (size_t)k2 * 64 * 1024 + 32 * 1024);
            st[2] = *(const GAS v4u*)(vg + k2 * 64); st[3] = *(const GAS v4u*)(vg + k2 * 64 + (size_t)64 * SEQ); }
        const int rel = q0w - 64 * kt;
        const LAS unsigned char* kp0 = buf + cl * AT_KS + 16 * hf; const LAS unsigned char* kp1 = kp0 + 32 * AT_KS;
        const LAS unsigned char* vp0 = buf + 64 * AT_KS + cl * AT_VS + 8 * hf; const LAS unsigned char* vp1 = vp0 + 64;
        if (rel >= 64) {
            const f32x16 s1 = attn_scores(kp1, qf), s0 = attn_scores(kp0, qf);
            bf16x8 p1[2], p0[2];
            attn_weights<false>(s1, R, hf, cl, p1); attn_weights<false>(s0, R, hf, cl, p0);
            attn_pv(vp1, p1, o); attn_pv(vp0, p0, o);
        } else if (rel == 32) {
            const f32x16 s1 = attn_scores(kp1, qf), s0 = attn_scores(kp0, qf);
            bf16x8 p1[2], p0[2];
            attn_weights<true>(s1, R, hf, cl, p1); attn_weights<false>(s0, R, hf, cl, p0);
            attn_pv(vp1, p1, o); attn_pv(vp0, p0, o);
        } else if (rel == 0) {
            const f32x16 s0 = attn_scores(kp0, qf);
            bf16x8 p0[2];
            attn_weights<true>(s0, R, hf, cl, p0);
            attn_pv(vp0, p0, o);
        }
        if (more) { *(LAS v4u*)(nbuf + kl) = st[0]; *(LAS v4u*)(nbuf + kl + 32 * AT_KS) = st[1];
            *(LAS v2u*)(nbuf + vl) = (v2u){st[2].x, st[2].y}; *(LAS v2u*)(nbuf + vl + 8) = (v2u){st[2].z, st[2].w}; *(LAS v2u*)(nbuf + vl + 64 * AT_VS) = (v2u){st[3].x, st[3].y}; *(LAS v2u*)(nbuf + vl + 64 * AT_VS + 8) = (v2u){st[3].z, st[3].w}; }
        __syncthreads();
    }
    bf16* orow = outb + (rb + q0w + cl) * 1024 + h * 128 + 4 * hf;
#pragma unroll
    for (int d = 0; d < 4; ++d)
#pragma unroll
        for (int g = 0; g < 4; ++g) { v2u q; q.x = pk2c(o[d][4 * g], o[d][4 * g + 1]); q.y = pk2c(o[d][4 * g + 2], o[d][4 * g + 3]); *(GAS v2u*)(orow + 32 * d + 8 * g) = q; }
}
__device__ __forceinline__ void hgpost_row(bf16* row, const bf16* grow, const float* w, int lane) {
#pragma unroll
    for (int j = 0; j < 2; ++j) {
        GAS v4u* p = (GAS v4u*)(row + 8 * lane + 512 * j); const v4u x = *p; const v4u gg = *(const GAS v4u*)(grow + 8 * lane + 512 * j);
        float f[8] = {bflo(x.x), bfhi(x.x), bflo(x.y), bfhi(x.y), bflo(x.z), bfhi(x.z), bflo(x.w), bfhi(x.w)};
        const float g[8] = {bflo(gg.x), bfhi(gg.x), bflo(gg.y), bfhi(gg.y), bflo(gg.z), bfhi(gg.z), bflo(gg.w), bfhi(gg.w)};
        float ss = 0.f;
#pragma unroll
        for (int k = 0; k < 8; ++k) ss += f[k] * f[k];
        ss += __shfl_xor(ss, 1); ss += __shfl_xor(ss, 2); ss += __shfl_xor(ss, 4); ss += __shfl_xor(ss, 8);
        const float r = __builtin_amdgcn_rsqf(ss * (1.0f / 128.0f) + EPS);
        const f32x4 wa = *(const GAS f32x4*)(w + ((8 * lane) & 127)), wb = *(const GAS f32x4*)(w + ((8 * lane) & 127) + 4);
        v4u o; o.x = pk2c(f[0] * r * wa.x * g[0], f[1] * r * wa.y * g[1]); o.y = pk2c(f[2] * r * wa.z * g[2], f[3] * r * wa.w * g[3]);
        o.z = pk2c(f[4] * r * wb.x * g[4], f[5] * r * wb.y * g[5]); o.w = pk2c(f[6] * r * wb.z * g[6], f[7] * r * wb.w * g[7]);
        *p = o;
    }
}

template <bool FIRST> struct EpiMerge {
    static constexpr bool PERM = true, AFTER_DRAIN = false;
    const bf16* gate; bf16* merged;
    __device__ __forceinline__ void operator()(const pg8::f32x4 (&acc)[2][2][4][2], const pg8::Unit& u, int wr, int wc, int fr, int fq) const {
        const int row0 = u.pm * 256 + wr * 64 + fr, col0 = u.pn * 256 + wc * 32 + 8 * fq;
#pragma unroll
        for (int ai = 0; ai < 2; ++ai)
#pragma unroll
            for (int m = 0; m < 4; ++m) {
                if ((m & 1) == 0) asm volatile("" ::: "memory");
#pragma unroll
                for (int bj = 0; bj < 2; ++bj) {
                    const size_t off = (size_t)(row0 + ai * 128 + m * 16) * 2048 + col0 + bj * 128;
                    const v4u g = *(const GAS v4u*)(gate + off); const pg8::f32x4 v0 = acc[ai][bj][m][0], v1 = acc[ai][bj][m][1];
                    float r[8] = {bflo(g.x) * v0[0], bfhi(g.x) * v0[1], bflo(g.y) * v0[2], bfhi(g.y) * v0[3], bflo(g.z) * v1[0], bfhi(g.z) * v1[1], bflo(g.w) * v1[2], bfhi(g.w) * v1[3]};
                    if (!FIRST) { const v4u mo = *(const GAS v4u*)(merged + off);
                        r[0] += bflo(mo.x); r[1] += bfhi(mo.x); r[2] += bflo(mo.y); r[3] += bfhi(mo.y); r[4] += bflo(mo.z); r[5] += bfhi(mo.z); r[6] += bflo(mo.w); r[7] += bfhi(mo.w); }
                    v4u w; w.x = pk2c(r[0], r[1]); w.y = pk2c(r[2], r[3]); w.z = pk2c(r[4], r[5]); w.w = pk2c(r[6], r[7]);
                    *(GAS v4u*)(merged + off) = w; }
            }
    }
};
struct EpiStoreBf16 {
    static constexpr bool PERM = true, AFTER_DRAIN = false;
    bf16* out;
    __device__ __forceinline__ void operator()(const pg8::f32x4 (&acc)[2][2][4][2], const pg8::Unit& u, int wr, int wc, int fr, int fq) const {
        const int row0 = u.pm * 256 + wr * 64 + fr, col0 = u.pn * 256 + wc * 32 + 8 * fq;
#pragma unroll
        for (int ai = 0; ai < 2; ++ai)
#pragma unroll
            for (int m = 0; m < 4; ++m)
#pragma unroll
                for (int bj = 0; bj < 2; ++bj) { const pg8::f32x4 v0 = acc[ai][bj][m][0], v1 = acc[ai][bj][m][1];
                    v4u w; w.x = pk2c(v0[0], v0[1]); w.y = pk2c(v0[2], v0[3]); w.z = pk2c(v1[0], v1[1]); w.w = pk2c(v1[2], v1[3]);
                    *(GAS v4u*)(out + (size_t)(row0 + ai * 128 + m * 16) * 2048 + col0 + bj * 128) = w; }
    }
};
struct EpiResid {
    static constexpr bool PERM = false, AFTER_DRAIN = false;
    const float* xin; float* xout;
    __device__ __forceinline__ void operator()(const pg8::f32x4 (&acc)[2][2][4][2], const pg8::Unit& u, int wr, int wc, int fr, int fq) const {
        const int row0 = u.pm * 256 + wr * 64 + fr, col0 = u.pn * 256 + wc * 32 + 4 * fq;
#pragma unroll
        for (int ai = 0; ai < 2; ++ai)
#pragma unroll
            for (int m = 0; m < 4; ++m)
#pragma unroll
                for (int bj = 0; bj < 2; ++bj)
#pragma unroll
                    for (int n = 0; n < 2; ++n) { const size_t off = (size_t)(row0 + ai * 128 + m * 16) * 2048 + col0 + bj * 128 + n * 16;
                        f32x4 r = acc[ai][bj][m][n]; if (xin) r += *(const GAS f32x4*)(xin + off);
                        *(GAS f32x4*)(xout + off) = r; }
    }
};

__device__ __forceinline__ float rl_f(float v, int l) { return __uint_as_float((unsigned)__builtin_amdgcn_readlane((int)__float_as_uint(v), l)); }
__device__ __forceinline__ void ins16(float (&L)[16], float x) {
#pragma unroll
    for (int i = 0; i < 16; ++i) { const float hi = __builtin_fmaxf(L[i], x); x = __builtin_fminf(L[i], x); L[i] = hi; }
}
#define CE_DESC(a, b) do { const float hi_ = __builtin_fmaxf(a, b), lo_ = __builtin_fminf(a, b); a = hi_; b = lo_; } while (0)
__device__ __forceinline__ void sort16_desc(float (&v)[16]) {
#pragma unroll
    for (int k = 2; k <= 16; k <<= 1)
#pragma unroll
        for (int j = k >> 1; j > 0; j >>= 1)
#pragma unroll
            for (int i = 0; i < 16; ++i) { const int l = i ^ j; if (l > i) { if ((i & k) == 0) CE_DESC(v[i], v[l]); else CE_DESC(v[l], v[i]); } }
}
__device__ __forceinline__ void bitonic_merge16_desc(float (&v)[16]) {
#pragma unroll
    for (int j = 8; j > 0; j >>= 1)
#pragma unroll
        for (int i = 0; i < 16; ++i) { const int l = i ^ j; if (l > i) CE_DESC(v[i], v[l]); }
}
__device__ __forceinline__ void top16_merge(float (&L)[16], const float (&T)[16]) {
#pragma unroll
    for (int i = 0; i < 16; ++i) L[i] = __builtin_fmaxf(L[i], T[15 - i]);
    bitonic_merge16_desc(L);
}
__device__ __forceinline__ void peer_top16(const bf16* qrow  , const bf16* kb  , int hf, float (&L)[16]) {
    bf16x8 qf[8];
#pragma unroll
    for (int kk = 0; kk < 8; ++kk) qf[kk] = *(const GAS bf16x8*)(qrow + 16 * kk);
    bf16x8 kn[8];
#pragma unroll
    for (int kk = 0; kk < 8; ++kk) kn[kk] = *(const GAS bf16x8*)(kb + 16 * kk);
#pragma unroll 1
    for (int kt = 0; kt < 4; ++kt) {
        bf16x8 kc[8];
#pragma unroll
        for (int kk = 0; kk < 8; ++kk) kc[kk] = kn[kk];
        if (kt < 3) {
#pragma unroll
            for (int kk = 0; kk < 8; ++kk) kn[kk] = *(const GAS bf16x8*)(kb + (size_t)(kt + 1) * 32 * 128 + 16 * kk);
        }
        f32x16 sa;
#pragma unroll
        for (int r = 0; r < 16; ++r) sa[r] = 0.f;
#pragma unroll
        for (int kk = 0; kk < 8; ++kk) sa = MFMA32(kc[kk], qf[kk], sa);
        float T[16];
#pragma unroll
        for (int r = 0; r < 16; ++r) { const unsigned idx = (unsigned)(kt * 32 + (r & 3) + 8 * (r >> 2) + 4 * hf); T[r] = __uint_as_float((__float_as_uint(sa[r]) & ~127u) | idx); }
        sort16_desc(T);
        if (kt == 0) {
#pragma unroll
            for (int i = 0; i < 16; ++i) L[i] = T[i];
        } else top16_merge(L, T);
    }
    float P[16];
#pragma unroll
    for (int i = 0; i < 16; ++i) P[i] = __shfl_xor(L[i], 32);
    top16_merge(L, P);
}
__device__ __forceinline__ void peer_select32(int item, int lane, const bf16* qpeer, const bf16* KB, int* sel_e, float* sel_g, float* sel_s, LAS unsigned* ldsw) {
    const int hd = item & 7, n0 = (item >> 3) * 32, c = lane & 31, hf = lane >> 5, n = n0 + c;
    const bf16* qrow = qpeer + (size_t)n * 2048 + hd * 256 + 8 * hf;
    float A[16], B[16];
    peer_top16(qrow, KB + (size_t)hd * 16384 + c * 128 + 8 * hf, hf, A);
    peer_top16(qrow + 128, KB + (size_t)(8 + hd) * 16384 + c * 128 + 8 * hf, hf, B);
    float Av[16], Bv[16]; int Ai[16], Bi[16];
#pragma unroll
    for (int i = 0; i < 16; ++i) { const unsigned a = __float_as_uint(A[i]), b = __float_as_uint(B[i]); Av[i] = __uint_as_float(a & ~127u); Bv[i] = __uint_as_float(b & ~127u); Ai[i] = (int)(a & 127u); Bi[i] = (int)(b & 127u); }
    float W[16];
    { float C0[16], C1[16], C2[16], E0 = 0.f, E1 = 0.f; unsigned id = 0;
#pragma unroll
      for (int a = 0; a < 16; ++a)
#pragma unroll
        for (int b = 0; b < 16; ++b) if ((a + 1) * (b + 1) <= 16) { const float pk = __uint_as_float((__float_as_uint(Av[a] + Bv[b]) & ~63u) | id);
            if (id < 16) C0[id] = pk; else if (id < 32) C1[id - 16] = pk; else if (id < 48) C2[id - 32] = pk; else if (id == 48) E0 = pk; else E1 = pk;
            ++id; }
      sort16_desc(C0); sort16_desc(C1); sort16_desc(C2);
      top16_merge(C0, C1); top16_merge(C0, C2);
#pragma unroll
      for (int i = 0; i < 16; ++i) W[i] = C0[i];
      ins16(W, E0); ins16(W, E1); }
    const float thr = W[15], mx = W[0];
    int cnt = 0; float ssum = 0.f;
    LAS int* le = (LAS int*)ldsw + c * 16; LAS float* lg = (LAS float*)ldsw + 512 + c * 16;
    { unsigned id = 0;
#pragma unroll
      for (int a = 0; a < 16; ++a)
#pragma unroll
        for (int b = 0; b < 16; ++b) if ((a + 1) * (b + 1) <= 16) {
            const float cv = Av[a] + Bv[b]; const float pk = __uint_as_float((__float_as_uint(cv) & ~63u) | id); ++id;
            if (pk >= thr) { const float e = __expf(cv - mx); if (hf == 0) { le[cnt] = Ai[a] * 128 + Bi[b]; lg[cnt] = e; } ssum += e; ++cnt; }
        } }
    LDS_WAIT();
    { const int t = lane >> 1, part = lane & 1;
      const v4u e0 = *(const LAS v4u*)((LAS int*)ldsw + t * 16 + 8 * part), e1 = *(const LAS v4u*)((LAS int*)ldsw + t * 16 + 8 * part + 4);
      const v4u g0 = *(const LAS v4u*)((LAS int*)ldsw + 512 + t * 16 + 8 * part), g1 = *(const LAS v4u*)((LAS int*)ldsw + 512 + t * 16 + 8 * part + 4);
      GAS v4u* pe = (GAS v4u*)(sel_e + (size_t)(n0 + t) * 128 + hd * 16 + 8 * part); GAS v4u* pg = (GAS v4u*)(sel_g + (size_t)(n0 + t) * 128 + hd * 16 + 8 * part);
      pe[0] = e0; pe[1] = e1; pg[0] = g0; pg[1] = g1; }
    LDS_WAIT();
    if (hf == 0) ((GAS float*)sel_s)[(size_t)n * 8 + hd] = ssum;
}

__device__ __forceinline__ float dot2bf(unsigned a, unsigned b, float acc) {
    return __builtin_amdgcn_fdot2_f32_bf16(__builtin_bit_cast(bf16v2, a), __builtin_bit_cast(bf16v2, b), acc, false);
}
__device__ __forceinline__ float dot8bf(const v4u a, const v4u b, float acc) {
    const unsigned a0 = a.x, a1 = a.y, a2 = a.z, a3 = a.w, b0 = b.x, b1 = b.y, b2 = b.z, b3 = b.w;
    acc = dot2bf(a0, b0, acc); acc = dot2bf(a1, b1, acc); acc = dot2bf(a2, b2, acc); acc = dot2bf(a3, b3, acc);
    return acc;
}
__device__ __forceinline__ void unpack16(const v4u q, float (&f)[16]) {
    const unsigned d0 = q.x, d1 = q.y, d2 = q.z, d3 = q.w;
    f32x2v t;
    t = __builtin_amdgcn_cvt_pk_f32_fp8((int)d0, false); f[0] = t.x; f[1] = t.y; t = __builtin_amdgcn_cvt_pk_f32_fp8((int)d0, true); f[2] = t.x; f[3] = t.y;
    t = __builtin_amdgcn_cvt_pk_f32_fp8((int)d1, false); f[4] = t.x; f[5] = t.y; t = __builtin_amdgcn_cvt_pk_f32_fp8((int)d1, true); f[6] = t.x; f[7] = t.y;
    t = __builtin_amdgcn_cvt_pk_f32_fp8((int)d2, false); f[8] = t.x; f[9] = t.y; t = __builtin_amdgcn_cvt_pk_f32_fp8((int)d2, true); f[10] = t.x; f[11] = t.y;
    t = __builtin_amdgcn_cvt_pk_f32_fp8((int)d3, false); f[12] = t.x; f[13] = t.y; t = __builtin_amdgcn_cvt_pk_f32_fp8((int)d3, true); f[14] = t.x; f[15] = t.y;
}
struct SliceSched { int mode, xcc, rank, nloc; };
__device__ __forceinline__ SliceSched slice_sched_init(const Ctx& c, unsigned* ctl, const XcdBarrier& bar, int use) {
    LAS int* sh = (LAS int*)(c.lds + 1024);
    if (c.tid == 0) {
        int ok = 1; unsigned tot = 0;
        for (int j = 0; j < 16; ++j) { const unsigned n = xb_ld(&bar.bar[XB_XCNT(j)]); tot += n; if ((j < 8) != (n > 0u)) ok = 0; }
        if (tot != (unsigned)c.G) ok = 0;
        const int xcc = (int)xb_xcc_id();
        int rank = 0, nloc = 1;
        if (ok) { nloc = (int)xb_ld(&bar.bar[XB_XCNT(xcc)]); rank = (int)xb_add(&ctl[CW_RANK + (use * 16 + xcc) * 64], 1u); if (rank >= nloc) ok = 0; }
        sh[0] = ok; sh[1] = xcc; sh[2] = rank; sh[3] = nloc;
    }
    __syncthreads();
    SliceSched S; S.mode = sh[0]; S.xcc = sh[1]; S.rank = sh[2]; S.nloc = sh[3];
    __syncthreads();
    return S;
}
__device__ __forceinline__ bool slice_item(const SliceSched& S, const Ctx& c, int i, int& slice, int& tb) {
    if (S.mode) { const int it = S.rank + i * S.nloc; if (it >= 512) return false; slice = S.xcc + 8 * (it >> 8); tb = it & 255; return true; }
    const int it = (int)blockIdx.x + i * c.G; if (it >= 4096) return false; slice = it >> 8; tb = it & 255; return true;
}
__device__ __forceinline__ void unpack16p(const v4u q, f32x2v (&f)[8]) {
    const unsigned d0 = q.x, d1 = q.y, d2 = q.z, d3 = q.w;
    f[0] = __builtin_amdgcn_cvt_pk_f32_fp8((int)d0, false); f[1] = __builtin_amdgcn_cvt_pk_f32_fp8((int)d0, true);
    f[2] = __builtin_amdgcn_cvt_pk_f32_fp8((int)d1, false); f[3] = __builtin_amdgcn_cvt_pk_f32_fp8((int)d1, true);
    f[4] = __builtin_amdgcn_cvt_pk_f32_fp8((int)d2, false); f[5] = __builtin_amdgcn_cvt_pk_f32_fp8((int)d2, true);
    f[6] = __builtin_amdgcn_cvt_pk_f32_fp8((int)d3, false); f[7] = __builtin_amdgcn_cvt_pk_f32_fp8((int)d3, true);
}
__device__ __forceinline__ void peer_sddmm_wave(int t0, int s, int lane, const bf16* H, const unsigned char* UQ, const int* sel_e, float* part, LAS unsigned* ldsw) {
    const int cg = lane & 7, sg = lane >> 3;
#pragma unroll
    for (int j = 0; j < 4; ++j) *(LAS v4u*)(ldsw + 4 * (lane + 64 * j)) = *(const GAS v4u*)(sel_e + (size_t)t0 * 128 + 4 * (lane + 64 * j));
    LDS_WAIT();
    const unsigned char* ubase = UQ + s * 128 + cg * 16;
    v4u qn[16];
    { int id[16];
#pragma unroll
      for (int q = 0; q < 4; ++q) { const v4u v = *(const LAS v4u*)(ldsw + sg * 16 + 4 * q); id[4 * q] = (int)v.x; id[4 * q + 1] = (int)v.y; id[4 * q + 2] = (int)v.z; id[4 * q + 3] = (int)v.w; }
#pragma unroll
      for (int it = 0; it < 16; ++it) qn[it] = *(const GAS v4u*)(ubase + (size_t)id[it] * 2048); }
    const bf16* hbase = H + (size_t)t0 * 2048 + s * 128 + cg * 16;
    v4u han = *(const GAS v4u*)(hbase), hbn = *(const GAS v4u*)(hbase + 8);
#pragma unroll 1
    for (int k = 0; k < 8; ++k) {
        const int t = t0 + k;
        v4u qc[16];
#pragma unroll
        for (int it = 0; it < 16; ++it) qc[it] = qn[it];
        const v4u ha = han, hb = hbn;
        if (k < 7) { han = *(const GAS v4u*)(hbase + (size_t)(k + 1) * 2048); hbn = *(const GAS v4u*)(hbase + (size_t)(k + 1) * 2048 + 8); }
        if (k < 7) { int id[16];
#pragma unroll
            for (int q = 0; q < 4; ++q) { const v4u v = *(const LAS v4u*)(ldsw + (k + 1) * 128 + sg * 16 + 4 * q); id[4 * q] = (int)v.x; id[4 * q + 1] = (int)v.y; id[4 * q + 2] = (int)v.z; id[4 * q + 3] = (int)v.w; }
#pragma unroll
            for (int it = 0; it < 16; ++it) qn[it] = *(const GAS v4u*)(ubase + (size_t)id[it] * 2048); }
        float h[16] = {bflo(ha.x), bfhi(ha.x), bflo(ha.y), bfhi(ha.y), bflo(ha.z), bfhi(ha.z), bflo(ha.w), bfhi(ha.w), bflo(hb.x), bfhi(hb.x), bflo(hb.y), bfhi(hb.y), bflo(hb.z), bfhi(hb.z), bflo(hb.w), bfhi(hb.w)};
        float hm = 0.f;
#pragma unroll
        for (int j = 0; j < 16; ++j) hm = fmaxf(hm, fabsf(h[j]));
        hm = fmaxf(hm, __shfl_xor(hm, 1)); hm = fmaxf(hm, __shfl_xor(hm, 2)); hm = fmaxf(hm, __shfl_xor(hm, 4));
        const float hinv = hm > 0.f ? 127.0f / hm : 0.f, hs = hm * (1.0f / 127.0f);
        int hq[4];
#pragma unroll
        for (int j = 0; j < 4; ++j) hq[j] = (int)pack_i8x4(h[4 * j] * hinv, h[4 * j + 1] * hinv, h[4 * j + 2] * hinv, h[4 * j + 3] * hinv);
        float p[16];
#pragma unroll
        for (int it = 0; it < 16; ++it) { int a = __builtin_amdgcn_sdot4((int)qc[it].x, hq[0], 0, false); a = __builtin_amdgcn_sdot4((int)qc[it].y, hq[1], a, false);
            a = __builtin_amdgcn_sdot4((int)qc[it].z, hq[2], a, false); a = __builtin_amdgcn_sdot4((int)qc[it].w, hq[3], a, false);
            p[it] = (float)a * hs; }
#pragma unroll
        for (int i = 0; i < 8; ++i) { const bool up = (lane & 4) != 0; const float snd = up ? p[i] : p[i + 8], kp = up ? p[i + 8] : p[i]; p[i] = kp + __shfl_xor(snd, 4); }
#pragma unroll
        for (int i = 0; i < 4; ++i) { const bool up = (lane & 2) != 0; const float snd = up ? p[i] : p[i + 4], kp = up ? p[i + 4] : p[i]; p[i] = kp + __shfl_xor(snd, 2); }
#pragma unroll
        for (int i = 0; i < 2; ++i) { const bool up = (lane & 1) != 0; const float snd = up ? p[i] : p[i + 2], kp = up ? p[i + 2] : p[i]; p[i] = kp + __shfl_xor(snd, 1); }
        ((GAS unsigned*)part)[((size_t)t * 16 + s) * 64 + lane] = pk2c(p[0], p[1]);
    }
    LDS_WAIT();
}
__device__ __forceinline__ void peer_coef_token(int t, int lane, const float* part, const int* sel_e, float* sel_g, const float* sel_s, const float* US, const float* VS) {
    float a0 = 0.f, a1 = 0.f;
#pragma unroll
    for (int s = 0; s < 16; ++s) { const unsigned v = ((const GAS unsigned*)part)[((size_t)t * 16 + s) * 64 + lane]; a0 += bflo(v); a1 += bfhi(v); }
    const v2u e = *(const GAS v2u*)(sel_e + (size_t)t * 128 + 2 * lane);
    const f32x2v g = *(const GAS f32x2v*)(sel_g + (size_t)t * 128 + 2 * lane);
    const float inv = 1.0f / ((const GAS float*)sel_s)[(size_t)t * 8 + (lane >> 3)];
    f32x2v o; o.x = g.x * inv * gelu_exact(a0 * ((const GAS float*)US)[e.x]) * ((const GAS float*)VS)[e.x]; o.y = g.y * inv * gelu_exact(a1 * ((const GAS float*)US)[e.y]) * ((const GAS float*)VS)[e.y];
    *(GAS f32x2v*)(sel_g + (size_t)t * 128 + 2 * lane) = o;
}
__device__ __forceinline__ void peer_spmm_wave(int t0, int s, int lane, const unsigned char* VQ, const int* sel_e, const float* coef, const float* x1, float* xout, LAS unsigned* ldsw) {
    const int cg = lane & 7, sg = lane >> 3;
#pragma unroll
    for (int j = 0; j < 4; ++j) { *(LAS v4u*)(ldsw + 4 * (lane + 64 * j)) = *(const GAS v4u*)(sel_e + (size_t)t0 * 128 + 4 * (lane + 64 * j));
        *(LAS v4u*)(ldsw + 1024 + 4 * (lane + 64 * j)) = *(const GAS v4u*)(coef + (size_t)t0 * 128 + 4 * (lane + 64 * j)); }
    LDS_WAIT();
    const unsigned char* vbase = VQ + s * 128 + cg * 16;
    v4u qn[16];
    { int id[16];
#pragma unroll
      for (int q = 0; q < 4; ++q) { const v4u v = *(const LAS v4u*)(ldsw + sg * 16 + 4 * q); id[4 * q] = (int)v.x; id[4 * q + 1] = (int)v.y; id[4 * q + 2] = (int)v.z; id[4 * q + 3] = (int)v.w; }
#pragma unroll
      for (int it = 0; it < 16; ++it) qn[it] = *(const GAS v4u*)(vbase + (size_t)id[it] * 2048); }
    f32x2v xn = *(const GAS f32x2v*)(x1 + (size_t)t0 * 2048 + s * 128 + cg * 16 + 2 * sg);
#pragma unroll 1
    for (int k = 0; k < 8; ++k) {
        const int t = t0 + k;
        v4u qc[16];
#pragma unroll
        for (int it = 0; it < 16; ++it) qc[it] = qn[it];
        const size_t off = (size_t)t * 2048 + s * 128 + cg * 16 + 2 * sg;
        const f32x2v xv = xn;
        if (k < 7) xn = *(const GAS f32x2v*)(x1 + off + 2048);
        float cf[16];
#pragma unroll
        for (int q = 0; q < 4; ++q) { const v4u w = *(const LAS v4u*)(ldsw + 1024 + k * 128 + sg * 16 + 4 * q); cf[4 * q] = __uint_as_float(w.x); cf[4 * q + 1] = __uint_as_float(w.y); cf[4 * q + 2] = __uint_as_float(w.z); cf[4 * q + 3] = __uint_as_float(w.w); }
        if (k < 7) { int id[16];
#pragma unroll
            for (int q = 0; q < 4; ++q) { const v4u v = *(const LAS v4u*)(ldsw + (k + 1) * 128 + sg * 16 + 4 * q); id[4 * q] = (int)v.x; id[4 * q + 1] = (int)v.y; id[4 * q + 2] = (int)v.z; id[4 * q + 3] = (int)v.w; }
#pragma unroll
            for (int it = 0; it < 16; ++it) qn[it] = *(const GAS v4u*)(vbase + (size_t)id[it] * 2048); }
        f32x2v y[8];
#pragma unroll
        for (int j = 0; j < 8; ++j) y[j] = (f32x2v){0.f, 0.f};
#pragma unroll
        for (int it = 0; it < 16; ++it) { f32x2v f[8]; unpack16p(qc[it], f); const f32x2v c2 = {cf[it], cf[it]};
#pragma unroll
            for (int j = 0; j < 8; ++j) y[j] = __builtin_elementwise_fma(f[j], c2, y[j]); }
        float yy[16];
#pragma unroll
        for (int j = 0; j < 8; ++j) { yy[2 * j] = y[j].x; yy[2 * j + 1] = y[j].y; }
#pragma unroll
        for (int i = 0; i < 8; ++i) { const bool up = (lane & 32) != 0; const float snd = up ? yy[i] : yy[i + 8], kp = up ? yy[i + 8] : yy[i]; yy[i] = kp + __shfl_xor(snd, 32); }
#pragma unroll
        for (int i = 0; i < 4; ++i) { const bool up = (lane & 16) != 0; const float snd = up ? yy[i] : yy[i + 4], kp = up ? yy[i + 4] : yy[i]; yy[i] = kp + __shfl_xor(snd, 16); }
#pragma unroll
        for (int i = 0; i < 2; ++i) { const bool up = (lane & 8) != 0; const float snd = up ? yy[i] : yy[i + 2], kp = up ? yy[i + 2] : yy[i]; yy[i] = kp + __shfl_xor(snd, 8); }
        f32x2v o; o.x = xv.x + yy[0]; o.y = xv.y + yy[1];
        *(GAS f32x2v*)(xout + off) = o;
    }
    LDS_WAIT();
}

struct Args { const float* in[21]; float* out; unsigned char* ws; int lo, hi, li, pad; };
__global__ void __launch_bounds__(512, 2) mk_fwd(Args args) {
    extern __shared__ __attribute__((aligned(16))) unsigned char lds_raw[];
    Ctx c; c.lds = (LAS unsigned char*)lds_raw; c.tid = threadIdx.x; c.lane = c.tid & 63; c.wave = __builtin_amdgcn_readfirstlane(c.tid >> 6);
    c.G = gridDim.x; c.gw = blockIdx.x * 8 + c.wave; c.NGW = c.G * 8;
    volatile LAS unsigned* MISC = (volatile LAS unsigned*)(c.lds + MISC_OFF);
    if (c.tid < 32) MISC[c.tid] = 0u;
    __syncthreads();
    unsigned char* ws = args.ws;
    const int lo = args.lo, hi = args.hi;
    XcdBarrier bar; bar.bar = (unsigned*)(ws + WS_CTL) + CW_BAR + args.li * XCD_BAR_WORDS; bar.x = 0; bar.st = nullptr;
    if (hi - lo > 1) bar = xcd_barrier_post((unsigned*)(ws + WS_CTL) + CW_BAR + args.li * XCD_BAR_WORDS, MISC + 8);
#ifndef ATTN_REPS
#define ATTN_REPS 1
#endif
#ifndef PHMASK
#define PHMASK 0x1fff
#endif
#define IN(k) (((PHMASK >> ((k) % NPH)) & 1) && lo <= (k) && (k) < hi)
#define SEAM(k) do { if (IN(k) && IN((k) + 1)) xcd_barrier(bar); } while (0)
#define PH_BEGIN unsigned char* w = ws; float* outp = args.out; Ctx cc = c; int zi = 0; \
    asm volatile("" : "+s"(w), "+s"(outp), "+s"(zi), "+v"(cc.tid), "+v"(cc.lane)); (void)w; (void)outp;
#define INP(k) (args.in[(k) + zi])
#define WSP(T, off) ((T*)(w + (off)))
    for (int l = 0; l < 2; ++l) {
        const int pb = l * NPH;
        if (IN(pb + 0)) { PH_BEGIN
            P0Args a; a.w_in = INP(2) + (size_t)l * DM * INW; a.w_br_sb = INP(11) + (size_t)l * BW * DM; a.w_br_hg = INP(12) + (size_t)l * BW * DM; a.w_br_conv = INP(13) + (size_t)l * BW * DM;
            a.w_o = INP(14) + (size_t)l * DM * DM; a.w_q = INP(16) + (size_t)l * DM * DM; a.u = INP(19) + (size_t)l * 16384 * 2048; a.v = INP(20) + (size_t)l * 16384 * 2048; a.lbp = INP(5);
            a.WinT = WSP(bf16, WS_WIN); a.WbrT = WSP(bf16, WS_WBR); a.WoT = WSP(bf16, WS_WO); a.WqT = WSP(bf16, WS_WQ); a.U = WSP(unsigned char, WS_U); a.V = WSP(unsigned char, WS_V); a.US = WSP(float, WS_US); a.VS = WSP(float, WS_VS); a.LB = WSP(float, WS_LB); a.layer = l; a.k1 = INP(17) + (size_t)l * 8 * 16384; a.k2 = INP(18) + (size_t)l * 8 * 16384; a.KB = WSP(bf16, WS_KEYS);
            p0_convert(cc, a);
            rms_phase_i8(cc, l == 0 ? INP(0) : WSP(const float, WS_X2), INP(1) + (size_t)l * DM, WSP(unsigned char, WS_H), WSP(float, WS_SA));
        }
        SEAM(pb + 0);
        if (IN(pb + 1)) { PH_BEGIN
            pg8::Gemm g{WSP(bf16, WS_H), WSP(bf16, WS_WIN), NTOK, INW, DM}; pg8::StaticOrder S; S.init(NTOK, INW, cc.G, (int)blockIdx.x);
            EpiIn E{WSP(bf16, WS_SEG), WSP(bf16, WS_GATE), WSP(float, WS_LB), WSP(float, WS_SA)};
            pg8::gemm_phase<EpiIn, pg8::StaticOrder, true, true, true>(cc.lds, g, S, E);
        }
        SEAM(pb + 1);
        if (IN(pb + 2)) { PH_BEGIN
            bf16* SEG = WSP(bf16, WS_SEG);
            conv_phase(cc, SEG + 7 * SEGSZ, INP(7) + (size_t)l * 31 * 1024, INP(8) + (size_t)l * 1024, INP(9) + (size_t)l * 1024, INP(10) + (size_t)l * 1024, WSP(bf16, WS_CONV));
            for (int ci = blockIdx.x; ci < 2048; ci += cc.G) hgA_chunk(cc, ci, SEG + 4 * SEGSZ, SEG + 5 * SEGSZ, WSP(bf16, WS_ST), WSP(float, WS_DEC));
            for (int r = cc.gw; r < 2 * NTOK; r += cc.NGW) {
                if (r < NTOK) qknorm_row(SEG + (size_t)r * 1024, INP(3) + (size_t)l * 128, 0.08838834764831845f, cc.lane);
                else qknorm_row(SEG + SEGSZ + (size_t)(r - NTOK) * 1024, INP(4) + (size_t)l * 128, 1.0f, cc.lane);
            }
            LAS unsigned short* scr = (LAS unsigned short*)(cc.lds + 4096 + cc.wave * 8192);
            for (int it = cc.gw; it < 8192; it += cc.NGW) vt_item(it, cc.lane, SEG + 2 * SEGSZ, WSP(bf16, WS_MERGED), scr);
        }
        SEAM(pb + 2);
        if (IN(pb + 3)) { PH_BEGIN
            bf16* SEG = WSP(bf16, WS_SEG);
            hgB(cc, WSP(bf16, WS_ST), WSP(float, WS_DEC));
            for (int rep = 0; rep < ATTN_REPS; ++rep)
            for (int p = blockIdx.x; p < 256; p += cc.G) { const int bh = (p & 7) * 4 + (p >> 6), j = (p >> 3) & 7;
                attn_unit(cc, bh, 15 - j, SEG, SEG + SEGSZ, WSP(bf16, WS_MERGED), SEG + 2 * SEGSZ); attn_unit(cc, bh, j, SEG, SEG + SEGSZ, WSP(bf16, WS_MERGED), SEG + 2 * SEGSZ); }
        }
        SEAM(pb + 3);
        if (IN(pb + 4)) { PH_BEGIN
            bf16* SEG = WSP(bf16, WS_SEG);
            for (int ci = blockIdx.x; ci < 2048; ci += cc.G) hgC_chunk(cc, ci, SEG + 3 * SEGSZ, SEG + 4 * SEGSZ, SEG + 5 * SEGSZ, SEG + 6 * SEGSZ, WSP(bf16, WS_ST), INP(6) + (size_t)l * 128, WSP(bf16, WS_HGR));
        }
        SEAM(pb + 4);
        if (IN(pb + 5)) { PH_BEGIN
            pg8::StaticOrder S; S.init(NTOK, DM, cc.G, (int)blockIdx.x);
            { pg8::Gemm g{WSP(bf16, WS_SEG) + 2 * SEGSZ, WSP(bf16, WS_WBR), NTOK, DM, BW}; EpiMerge<true> E{WSP(bf16, WS_GATE), WSP(bf16, WS_MERGED)}; pg8::gemm_phase<EpiMerge<true>, pg8::StaticOrder, true, true>(cc.lds, g, S, E); }
            { pg8::Gemm g{WSP(bf16, WS_HGR), WSP(bf16, WS_WBR) + (size_t)DM * BW, NTOK, DM, BW}; EpiMerge<false> E{WSP(bf16, WS_GATE) + (size_t)NTOK * 2048, WSP(bf16, WS_MERGED)}; pg8::gemm_phase<EpiMerge<false>, pg8::StaticOrder, true, true>(cc.lds, g, S, E); }
            { pg8::Gemm g{WSP(bf16, WS_CONV), WSP(bf16, WS_WBR) + (size_t)2 * DM * BW, NTOK, DM, BW}; EpiMerge<false> E{WSP(bf16, WS_GATE) + (size_t)2 * NTOK * 2048, WSP(bf16, WS_MERGED)}; pg8::gemm_phase<EpiMerge<false>, pg8::StaticOrder, true, true>(cc.lds, g, S, E); }
        }
        SEAM(pb + 5);
        if (IN(pb + 6)) { PH_BEGIN
            pg8::Gemm g{WSP(bf16, WS_MERGED), WSP(bf16, WS_WO), NTOK, DM, DM}; pg8::StaticOrder S; S.init(NTOK, DM, cc.G, (int)blockIdx.x);
            EpiResid E{l == 0 ? INP(0) : WSP(const float, WS_X2), outp};
            pg8::gemm_phase<EpiResid, pg8::StaticOrder, true, true>(cc.lds, g, S, E);
        }
        SEAM(pb + 6);
        if (IN(pb + 7)) { PH_BEGIN rms_phase(cc, outp, INP(15) + (size_t)l * DM, WSP(bf16, WS_H)); }
        SEAM(pb + 7);
        if (IN(pb + 8)) { PH_BEGIN
            pg8::Gemm g{WSP(bf16, WS_H), WSP(bf16, WS_WQ), NTOK, DM, DM}; pg8::StaticOrder S; S.init(NTOK, DM, cc.G, (int)blockIdx.x);
            EpiStoreBf16 E{WSP(bf16, WS_QPEER)};
            pg8::gemm_phase<EpiStoreBf16, pg8::StaticOrder, true, true>(cc.lds, g, S, E);
        }
        SEAM(pb + 8);
        if (IN(pb + 9)) { PH_BEGIN
            for (int it = cc.gw; it < (NTOK / 32) * 8; it += cc.NGW)
                peer_select32(it, cc.lane, WSP(bf16, WS_QPEER), WSP(bf16, WS_KEYS), WSP(int, WS_SEL), WSP(float, WS_SEL + 8 * MiB), WSP(float, WS_SELS), (LAS unsigned*)(cc.lds + 4096 + cc.wave * 8192));
        }
        SEAM(pb + 9);
        if (IN(pb + 10)) { PH_BEGIN
            const SliceSched SS = slice_sched_init(cc, (unsigned*)(w + WS_CTL), bar, l * 2 + 0);
            for (int i = 0;; ++i) { int sl, tb; if (!slice_item(SS, cc, i, sl, tb)) break;
                peer_sddmm_wave(tb * 64 + cc.wave * 8, sl, cc.lane, WSP(bf16, WS_H), WSP(unsigned char, WS_U), WSP(int, WS_SEL), WSP(float, WS_PART), (LAS unsigned*)(cc.lds + 4096 + cc.wave * 8192)); }
        }
        SEAM(pb + 10);
        if (IN(pb + 11)) { PH_BEGIN
            for (int n = cc.gw; n < NTOK; n += cc.NGW) peer_coef_token(n, cc.lane, WSP(float, WS_PART), WSP(int, WS_SEL), WSP(float, WS_SEL + 8 * MiB), WSP(float, WS_SELS), WSP(float, WS_US), WSP(float, WS_VS));
        }
        SEAM(pb + 11);
        if (IN(pb + 12)) { PH_BEGIN
            float* xo = l == 0 ? WSP(float, WS_X2) : outp;
            const SliceSched SS = slice_sched_init(cc, (unsigned*)(w + WS_CTL), bar, l * 2 + 1);
            for (int i = 0;; ++i) { int sl, tb; if (!slice_item(SS, cc, i, sl, tb)) break;
                peer_spmm_wave(tb * 64 + cc.wave * 8, sl, cc.lane, WSP(unsigned char, WS_V), WSP(int, WS_SEL), WSP(float, WS_SEL + 8 * MiB), outp, xo, (LAS unsigned*)(cc.lds + 4096 + cc.wave * 8192)); }
        }
        SEAM(pb + 12);
    }
#undef PH_BEGIN
#undef INP
#undef WSP
#undef IN
#undef SEAM
}

#ifndef MK_SPLIT
#define MK_SPLIT 0
#endif
extern "C" void kernel_launch(void* const* d_in, const int* in_sizes, int n_in, void* d_out, int out_size, void* d_ws, size_t ws_size, hipStream_t stream) {
    static int grid = 0;
    if (grid == 0) {
        if (n_in != 21 || out_size != NTOK * DM || ws_size < WS_END) { fprintf(stderr, "kernel_launch: unexpected shapes (n_in %d, out %d, ws %zu < %zu); nothing launched\n", n_in, out_size, ws_size, (size_t)WS_END); grid = -1; return; }
        int dev = 0, cus = 0, per_cu = 0;
        if (hipGetDevice(&dev) != hipSuccess || hipDeviceGetAttribute(&cus, hipDeviceAttributeMultiprocessorCount, dev) != hipSuccess) { grid = -1; return; }
        if (hipFuncSetAttribute((const void*)mk_fwd, hipFuncAttributeMaxDynamicSharedMemorySize, LDS_BYTES) != hipSuccess) { fprintf(stderr, "kernel_launch: hipFuncSetAttribute failed\n"); grid = -1; return; }
        if (hipOccupancyMaxActiveBlocksPerMultiprocessor(&per_cu, (const void*)mk_fwd, 512, LDS_BYTES) != hipSuccess || per_cu < 1) fprintf(stderr, "kernel_launch: occupancy query reports %d\n", per_cu);
        (void)hipGetLastError();
        grid = cus;
    }
    if (grid < 0) return;
    if (hipMemsetAsync((char*)d_ws + WS_CTL, 0, 1 * MiB, stream) != hipSuccess) { fprintf(stderr, "kernel_launch: memset failed\n"); return; }
    Args a{};
    for (int i = 0; i < 21; ++i) a.in[i] = (const float*)d_in[i];
    a.out = (float*)d_out; a.ws = (unsigned char*)d_ws; a.pad = 0;
#if MK_SPLIT
    for (int p = 0; p < NPHASES; ++p) { a.lo = p; a.hi = p + 1; a.li = p; hipLaunchKernelGGL(mk_fwd, dim3(grid), dim3(512), LDS_BYTES, stream, a); }
#else
    a.lo = 0; a.hi = NPHASES; a.li = 0;
    hipLaunchKernelGGL(mk_fwd, dim3(grid), dim3(512), LDS_BYTES, stream, a);
#endif
    const hipError_t le = hipPeekAtLastError();
    if (le != hipSuccess) fprintf(stderr, "kernel_launch: launch failed: %s\n", hipGetErrorName(le));
}
```

```cpp
#include <hip/hip_runtime.h>
#include <cstdio>
#include <cstdint>
namespace pg8 {
#define PG8_LAS __attribute__((address_space(3)))
typedef unsigned short bf16_t;
typedef short bf16x8 __attribute__((ext_vector_type(8)));
typedef float f32x4 __attribute__((ext_vector_type(4)));
typedef unsigned u32x4 __attribute__((ext_vector_type(4)));
constexpr int BM = 256, BK = 64, HALF = 128, HTB = HALF * BK * 2  , STAGE_BYTES = 8 * HTB, NXCD = 8, WGM = 8;

__host__ __device__ __forceinline__ int lds_byte(int r, int c) { const int st = (r >> 4) * 2 + (c >> 5), rr = r & 15, cc = c & 31, ob = rr * 64 + cc * 2; return st * 1024 + (ob ^ (((ob >> 9) & 1) << 5)); }
__host__ __device__ __forceinline__ void stage_rc(int b, int& R, int& C) { const int st = b / 1024, sb = b % 1024, swz = sb ^ (((sb >> 9) & 1) << 5); R = (st >> 1) * 16 + swz / 64; C = (st & 1) * 32 + (swz % 64) / 2; }
__host__ __device__ __forceinline__ int perm32(int rho) { const int n = rho >> 4, i = rho & 15; return 8 * (i >> 2) + 4 * n + (i & 3); }

struct Unit { int pm, pn; };
struct Gemm { const bf16_t* A; const bf16_t* Bt; int M, N, K; };

struct StaticOrder {
    int nM, nN, nwg, G, c;
    __host__ __device__ void init(int M, int N, int G_, int c_) { nM = M / BM; nN = N / BM; nwg = nM * nN; G = G_; c = c_; }
    __host__ __device__ bool next(int i, Unit& u) const {
        const long L = (long)i * G + c; if (L >= nwg) return false;
        int wgid = (int)L; { const int q = nwg / NXCD, r = nwg % NXCD, xcd = wgid % NXCD, off = wgid / NXCD; wgid = (xcd < r ? xcd * (q + 1) : r * (q + 1) + (xcd - r) * q) + off; }
        const int nig = WGM * nN, gid = wgid / nig, fm = gid * WGM, gsz = (nM - fm) < WGM ? (nM - fm) : WGM;
        u.pm = fm + ((wgid % nig) % gsz); u.pn = (wgid % nig) / gsz; return true;
    }
    __device__ __forceinline__ void a_ready(const Unit&) const {}
    __device__ __forceinline__ void done(const Unit&) const {}
};

typedef float f32x2 __attribute__((ext_vector_type(2)));
template <class Epi, class Sched, bool ALIGN_EPI = false, bool SP2 = false, bool I8 = false>
__device__ __forceinline__ void gemm_phase(PG8_LAS unsigned char* lds, const Gemm g, const Sched& S, const Epi& E) {
    int tid_ = threadIdx.x; asm volatile("" : "+v"(tid_)); int K_ = g.K; asm volatile("" : "+s"(K_));
    const int tid = tid_, wid = __builtin_amdgcn_readfirstlane(tid >> 6), lane = tid & 63, wr = wid >> 2, wc = wid & 3, fr = lane & 15, fq = lane >> 4;
    const int K = I8 ? (K_ >> 1) : K_, nt = K / BK;
    unsigned voffA[2], voffB[2];
#pragma unroll
    for (int i = 0; i < 2; ++i) { int R, C; stage_rc(tid * 16 + i * 8192, R, C); const int Rb = Epi::PERM ? ((R & ~31) + perm32(R & 31)) : R;
        voffA[i] = (unsigned)(R * K + C) * 2u; voffB[i] = (unsigned)(Rb * K + C) * 2u; }
    const size_t kstep = (size_t)(BK * 2);
    const size_t hstep = (size_t)HALF * K * 2;
    const size_t tstep = 2 * hstep;
    const unsigned ldsw = (unsigned)wid * 1024u;
    const int aoff = lds_byte(wr * 64 + fr, fq * 8), boff = lds_byte(wc * 32 + fr, fq * 8);
#define PG8_SA(b, h) (((b) * 2 + (h)) * HTB)
#define PG8_SB(b, h) ((4 + (b) * 2 + (h)) * HTB)
#define PG8_STAGE(bufoff, gbase, voff) do { _Pragma("unroll") for (int _i = 0; _i < 2; ++_i) \
        __builtin_amdgcn_global_load_lds((const unsigned*)((const char*)(gbase) + (voff)[_i]), (PG8_LAS unsigned*)(lds + (bufoff) + ldsw + _i * 8192), 16, 0, 0); } while (0)
#define PG8_LDA(dst, b, h) do { _Pragma("unroll") for (int m = 0; m < 4; ++m) _Pragma("unroll") for (int k = 0; k < 2; ++k) dst[m][k] = *(const PG8_LAS bf16x8*)(lds + PG8_SA(b, h) + aoff + m * 2048 + k * 1024); } while (0)
#define PG8_LDB(dst, b, h) do { _Pragma("unroll") for (int n = 0; n < 2; ++n) _Pragma("unroll") for (int k = 0; k < 2; ++k) dst[n][k] = *(const PG8_LAS bf16x8*)(lds + PG8_SB(b, h) + boff + n * 2048 + k * 1024); } while (0)
#define PG8_MMA(ai, bj, At, Bt) do { __builtin_amdgcn_s_setprio(1); _Pragma("unroll") for (int m = 0; m < 4; ++m) _Pragma("unroll") for (int n = 0; n < 2; ++n) _Pragma("unroll") for (int k = 0; k < 2; ++k) { \
        if constexpr (I8) { typedef int v4i_t __attribute__((ext_vector_type(4))); \
            acc[ai][bj][m][n] = __builtin_bit_cast(f32x4, __builtin_amdgcn_mfma_i32_16x16x64_i8(__builtin_bit_cast(v4i_t, Bt[n][k]), __builtin_bit_cast(v4i_t, At[m][k]), __builtin_bit_cast(v4i_t, acc[ai][bj][m][n]), 0, 0, 0)); } \
        else acc[ai][bj][m][n] = __builtin_amdgcn_mfma_f32_16x16x32_bf16(Bt[n][k], At[m][k], acc[ai][bj][m][n], 0, 0, 0); } __builtin_amdgcn_s_setprio(0); } while (0)
#define PG8_WAIT_V(n) asm volatile("s_waitcnt vmcnt(" #n ")" ::: "memory")
#define PG8_WAIT_L(n) asm volatile("s_waitcnt lgkmcnt(" #n ")" ::: "memory")
#define PG8_BAR __builtin_amdgcn_s_barrier()
#define PG8_SCHED __builtin_amdgcn_sched_barrier(0)
    Unit cur, nxt; int ui = 0;
    if (!S.next(0, cur)) return;
    f32x4 acc[2][2][4][2];
#pragma unroll
    for (int a = 0; a < 2; ++a)
#pragma unroll
        for (int b = 0; b < 2; ++b)
#pragma unroll
            for (int m = 0; m < 4; ++m)
#pragma unroll
                for (int n = 0; n < 2; ++n) acc[a][b][m][n] = (f32x4){0.f, 0.f, 0.f, 0.f};
    bf16x8 At[4][2], B0[2][2], B1[2][2];
    const char* cA = (const char*)g.A + (size_t)cur.pm * tstep; const char* cB = (const char*)g.Bt + (size_t)cur.pn * tstep;
    S.a_ready(cur);
    if constexpr (SP2) {
        PG8_STAGE(PG8_SB(0, 0), cB, voffB); PG8_STAGE(PG8_SB(0, 1), cB + hstep, voffB); PG8_STAGE(PG8_SA(0, 0), cA, voffA); PG8_STAGE(PG8_SA(0, 1), cA + hstep, voffA);
        if (wr == 1) PG8_BAR;
        PG8_WAIT_V(2); PG8_BAR;
        PG8_STAGE(PG8_SB(1, 0), cB + kstep, voffB); PG8_STAGE(PG8_SA(1, 0), cA + kstep, voffA); PG8_STAGE(PG8_SB(1, 1), cB + hstep + kstep, voffB);
        PG8_WAIT_V(6); PG8_BAR;
    } else {
        PG8_STAGE(PG8_SB(0, 0), cB, voffB); PG8_STAGE(PG8_SA(0, 0), cA, voffA); PG8_STAGE(PG8_SB(0, 1), cB + hstep, voffB); PG8_STAGE(PG8_SA(0, 1), cA + hstep, voffA);
        if (wr == 1) PG8_BAR;
        PG8_WAIT_V(4); PG8_BAR;
        PG8_STAGE(PG8_SB(1, 0), cB + kstep, voffB); PG8_STAGE(PG8_SA(1, 0), cA + kstep, voffA); PG8_STAGE(PG8_SB(1, 1), cB + hstep + kstep, voffB);
        PG8_WAIT_V(6); PG8_BAR;
    }
    for (;;) {
        const bool has_next = S.next(ui + 1, nxt);
        const char* nA = has_next ? (const char*)g.A + (size_t)nxt.pm * tstep : cA; const char* nB = has_next ? (const char*)g.Bt + (size_t)nxt.pn * tstep : cB;
        for (int t = 0; t < nt; t += 2) {
            const bool last = (t == nt - 2);
            const char* a1 = cA + (size_t)(t + 1) * kstep;
            const char* a2 = last ? nA : cA + (size_t)(t + 2) * kstep; const char* b2 = last ? nB : cB + (size_t)(t + 2) * kstep;
            const char* a3 = a2 + kstep; const char* b3 = b2 + kstep;
            if (last && has_next) S.a_ready(nxt);
            if constexpr (SP2) {
            PG8_LDB(B0, 0, 0); PG8_LDB(B1, 0, 1); PG8_SCHED; PG8_LDA(At, 0, 0); PG8_STAGE(PG8_SA(1, 1), a1 + hstep, voffA);
            PG8_WAIT_V(8); PG8_WAIT_L(0); PG8_BAR; PG8_MMA(0, 0, At, B0); PG8_MMA(0, 1, At, B1); PG8_BAR; PG8_SCHED;
            PG8_LDA(At, 0, 1); PG8_STAGE(PG8_SB(0, 0), b2, voffB); PG8_STAGE(PG8_SB(0, 1), b2 + hstep, voffB); PG8_STAGE(PG8_SA(0, 0), a2, voffA);
            PG8_WAIT_V(8); PG8_WAIT_L(0); PG8_BAR; PG8_MMA(1, 0, At, B0); PG8_MMA(1, 1, At, B1); PG8_BAR; PG8_SCHED;
            PG8_LDB(B0, 1, 0); PG8_LDB(B1, 1, 1); PG8_SCHED; PG8_LDA(At, 1, 0); PG8_STAGE(PG8_SA(0, 1), a2 + hstep, voffA);
            PG8_WAIT_V(8); PG8_WAIT_L(0); PG8_BAR; PG8_MMA(0, 0, At, B0); PG8_MMA(0, 1, At, B1); PG8_BAR; PG8_SCHED;
            PG8_LDA(At, 1, 1); PG8_STAGE(PG8_SB(1, 0), b3, voffB); PG8_STAGE(PG8_SB(1, 1), b3 + hstep, voffB); PG8_STAGE(PG8_SA(1, 0), a3, voffA);
            PG8_WAIT_V(8); PG8_WAIT_L(0); PG8_BAR; PG8_MMA(1, 0, At, B0); PG8_MMA(1, 1, At, B1); PG8_BAR; PG8_SCHED;
            } else {
            PG8_LDB(B0, 0, 0); PG8_SCHED; PG8_LDA(At, 0, 0); PG8_STAGE(PG8_SA(1, 1), a1 + hstep, voffA);
            PG8_WAIT_L(8); PG8_BAR; PG8_WAIT_L(0); PG8_MMA(0, 0, At, B0); PG8_BAR; PG8_SCHED;
            PG8_LDB(B1, 0, 1); PG8_STAGE(PG8_SB(0, 0), b2, voffB);
            PG8_BAR; PG8_WAIT_L(0); PG8_MMA(0, 1, At, B1); PG8_BAR;
            PG8_LDA(At, 0, 1); PG8_STAGE(PG8_SA(0, 0), a2, voffA);
            PG8_BAR; PG8_WAIT_L(0); PG8_MMA(1, 0, At, B0); PG8_BAR; PG8_SCHED;
            PG8_STAGE(PG8_SB(0, 1), b2 + hstep, voffB);
            PG8_WAIT_V(6); PG8_BAR; PG8_MMA(1, 1, At, B1); PG8_BAR;
            PG8_LDB(B0, 1, 0); PG8_SCHED; PG8_LDA(At, 1, 0); PG8_STAGE(PG8_SA(0, 1), a2 + hstep, voffA);
            PG8_WAIT_L(8); PG8_BAR; PG8_WAIT_L(0); PG8_MMA(0, 0, At, B0); PG8_BAR; PG8_SCHED;
            PG8_LDB(B1, 1, 1); PG8_STAGE(PG8_SB(1, 0), b3, voffB);
            PG8_BAR; PG8_WAIT_L(0); PG8_MMA(0, 1, At, B1); PG8_BAR;
            PG8_LDA(At, 1, 1); PG8_STAGE(PG8_SA(1, 0), a3, voffA);
            PG8_BAR; PG8_WAIT_L(0); PG8_MMA(1, 0, At, B0); PG8_BAR; PG8_SCHED;
            PG8_STAGE(PG8_SB(1, 1), b3 + hstep, voffB);
            PG8_WAIT_V(6); PG8_BAR; PG8_MMA(1, 1, At, B1); PG8_BAR;
            }
        }
        if constexpr (ALIGN_EPI) { if (wr == 0) PG8_BAR; }
        if constexpr (I8) {
#pragma unroll
            for (int a = 0; a < 2; ++a)
#pragma unroll
                for (int m = 0; m < 4; ++m) { const float r_ = E.rowscale(cur.pm * BM + wr * 64 + fr + a * HALF + m * 16);
#pragma unroll
                    for (int b = 0; b < 2; ++b)
#pragma unroll
                        for (int n = 0; n < 2; ++n) { typedef int v4i2_t __attribute__((ext_vector_type(4))); const v4i2_t i_ = __builtin_bit_cast(v4i2_t, acc[a][b][m][n]);
                            acc[a][b][m][n] = (f32x4){(float)i_[0] * r_, (float)i_[1] * r_, (float)i_[2] * r_, (float)i_[3] * r_}; } }
        }
        if constexpr (!Epi::AFTER_DRAIN) { E(acc, cur, wr, wc, fr, fq); S.done(cur); }
        if (!has_next) break;
#pragma unroll
        for (int a = 0; a < 2; ++a)
#pragma unroll
            for (int b = 0; b < 2; ++b)
#pragma unroll
                for (int m = 0; m < 4; ++m)
#pragma unroll
                    for (int n = 0; n < 2; ++n) acc[a][b][m][n] = (f32x4){0.f, 0.f, 0.f, 0.f};
        cur = nxt; cA = nA; cB = nB; ++ui;
        if constexpr (ALIGN_EPI) { if (wr == 1) PG8_BAR; }
    }
    PG8_WAIT_V(0);
    if constexpr (!ALIGN_EPI) { if (wr == 0) PG8_BAR; }
    PG8_BAR;
    if constexpr (Epi::AFTER_DRAIN) { E.fused(acc, cur, wr, wc, fr, fq, lds, wid, lane); S.done(cur); }
#undef PG8_SA
#undef PG8_SB
#undef PG8_STAGE
#undef PG8_LDA
#undef PG8_LDB
#undef PG8_MMA
#undef PG8_WAIT_V
#undef PG8_WAIT_L
#undef PG8_BAR
#undef PG8_SCHED
}
}
#define XB_TMO      128
#define XB_XCNT(j)  (256  + 64 * (j))
#define XB_XSUB(j)  (1280 + 64 * (j))
#define XB_XGEN(j)  (2304 + 64 * (j))
#define XB_TOP      3328
#define XB_TOPGEN   3392
#define XCD_BAR_WORDS 3456
#define XB_SPIN_CAP (1u << 24)
#define LAS __attribute__((address_space(3)))

__device__ __forceinline__ unsigned xb_ld(unsigned* p)              { return __hip_atomic_load(p, __ATOMIC_RELAXED, __HIP_MEMORY_SCOPE_AGENT); }
__device__ __forceinline__ unsigned xb_add(unsigned* p, unsigned v) { return __hip_atomic_fetch_add(p, v, __ATOMIC_RELAXED, __HIP_MEMORY_SCOPE_AGENT); }
__device__ __forceinline__ unsigned xb_xcc_id() { return (unsigned)__builtin_amdgcn_s_getreg((3 << 11) | 20) & 0xFu; }
#define XB_SPIN(cond, bar) do { unsigned _sp = 0; while (cond) { __builtin_amdgcn_s_sleep(1); \
    if ((++_sp & 255u) == 0u) { if (xb_ld(&(bar)[XB_TMO])) break; if (_sp > XB_SPIN_CAP) { atomicAdd(&(bar)[XB_TMO], 1u); break; } } } } while (0)

struct XcdBarrier {
    unsigned* bar; unsigned x;
    volatile LAS unsigned* st;
};

__device__ __forceinline__ XcdBarrier xcd_barrier_post(unsigned* bar, volatile LAS unsigned* st) {
    XcdBarrier b; b.bar = bar; b.x = xb_xcc_id(); b.st = st;
    if (threadIdx.x == 0) (void)xb_add(&bar[XB_XCNT(b.x)], 1u);
    return b;
}
__device__ __forceinline__ void xcd_barrier_complete(unsigned* bar, unsigned x, unsigned& nloc, unsigned& nx) {
    const unsigned G = gridDim.x * gridDim.y * gridDim.z;
    unsigned sum, cnt, mine, sp = 0u;
    for (;;) {
        sum = 0u; cnt = 0u; mine = 0u;
#pragma unroll
        for (unsigned j = 0; j < 16; ++j) { const unsigned c = xb_ld(&bar[XB_XCNT(j)]); sum += c; cnt += (c > 0u) ? 1u : 0u; mine = (j == x) ? c : mine; }
        if (sum == G) break;
        __builtin_amdgcn_s_sleep(1);
        if ((++sp & 255u) == 0u) { if (xb_ld(&bar[XB_TMO])) break; if (sp > XB_SPIN_CAP) { atomicAdd(&bar[XB_TMO], 1u); break; } }
    }
    nloc = mine > 0u ? mine : 1u; nx = cnt > 0u ? cnt : 1u;
}

__device__ __forceinline__ void xcd_barrier(const XcdBarrier& b) {
    asm volatile("s_waitcnt vmcnt(0)" ::: "memory");
    __syncthreads();
    if (threadIdx.x == 0) {
        unsigned* bar = b.bar;
        __builtin_amdgcn_s_waitcnt(0);
        unsigned nloc = b.st[0], nx = b.st[1];
        if (nloc == 0u) { xcd_barrier_complete(bar, b.x, nloc, nx); b.st[0] = nloc; b.st[1] = nx; }
        const unsigned old = xb_add(&bar[XB_XSUB(b.x)], 1u);
        const unsigned gen = old / nloc;
        if (old + 1u == (gen + 1u) * nloc) {
            __builtin_amdgcn_fence(__ATOMIC_RELEASE, "agent");
            asm volatile("s_waitcnt vmcnt(0)" ::: "memory");
            const unsigned og = xb_add(&bar[XB_TOP], 1u);
            const unsigned tg = og / nx;
            if (og + 1u == (tg + 1u) * nx) xb_add(&bar[XB_TOPGEN], 1u);
            else XB_SPIN(xb_ld(&bar[XB_TOPGEN]) == tg, bar);
            __builtin_amdgcn_fence(__ATOMIC_ACQUIRE, "agent");
            xb_add(&bar[XB_XGEN(b.x)], 1u);
            asm volatile("s_waitcnt vmcnt(0)" ::: "memory");
        } else {
            XB_SPIN(xb_ld(&bar[XB_XGEN(b.x)]) == gen, bar);
            __builtin_amdgcn_fence(__ATOMIC_ACQUIRE, "agent");
            asm volatile("s_waitcnt vmcnt(0)" ::: "memory");
        }
    }
    __syncthreads();
}


#define GAS __attribute__((address_space(1)))
typedef unsigned short bf16;
typedef unsigned v4u __attribute__((ext_vector_type(4)));
typedef unsigned v2u __attribute__((ext_vector_type(2)));
typedef float f32x4 __attribute__((ext_vector_type(4)));
typedef float f32x2v __attribute__((ext_vector_type(2)));
typedef float f32x16 __attribute__((ext_vector_type(16)));
typedef short bf16x8 __attribute__((ext_vector_type(8)));
typedef __bf16 bf16v2 __attribute__((ext_vector_type(2)));
typedef _Float16 h2_t __attribute__((ext_vector_type(2)));
typedef _Float16 v32h_t __attribute__((ext_vector_type(32)));
typedef unsigned v6u __attribute__((ext_vector_type(6)));

constexpr int NTOK = 16384, DM = 2048, SEQ = 4096, INW = 15360, BW = 1024;
constexpr float EPS = 1e-6f;
constexpr float WIN_QS = 1024.0f;
constexpr int NPH = 13;
constexpr int NPHASES = 2 * NPH;

constexpr size_t MiB = 1u << 20;
constexpr size_t WS_CTL = 0;
constexpr size_t WS_LB = 1 * MiB;
constexpr size_t WS_SA = 1 * MiB + 192 * 1024;
constexpr size_t WS_US = 1 * MiB + 64 * 1024, WS_VS = 1 * MiB + 128 * 1024;
constexpr size_t WS_WIN = 2 * MiB;
constexpr size_t WS_WBR = 62 * MiB;
constexpr size_t WS_WO = 74 * MiB;
constexpr size_t WS_WQ = 82 * MiB;
constexpr size_t WS_U = 91 * MiB;
constexpr size_t WS_V = 155 * MiB;
constexpr size_t WS_H = 219 * MiB;
constexpr size_t WS_SEG = 283 * MiB;
constexpr size_t WS_GATE = 539 * MiB;
constexpr size_t WS_X2 = 731 * MiB;
constexpr size_t WS_CONV = 859 * MiB;
constexpr size_t WS_HGR = 891 * MiB;
constexpr size_t WS_MERGED = 923 * MiB;
constexpr size_t WS_SEL = 987 * MiB;
constexpr size_t WS_SELS = 1003 * MiB;
constexpr size_t WS_DEC = 1004 * MiB;
constexpr size_t WS_END = 1005 * MiB;
constexpr size_t WS_ST = WS_H;
constexpr size_t WS_KEYS = 90 * MiB;
constexpr size_t WS_PART = WS_GATE;
constexpr size_t WS_QPEER = WS_SEG;
constexpr size_t SEGSZ = (size_t)NTOK * 1024;
constexpr int CW_BAR = 4096;
constexpr int CW_RANK = 131072;

constexpr int RING_BYTES = 131072, MISC_OFF = RING_BYTES + 320, LDS_BYTES = 147456;

__device__ __forceinline__ unsigned pk2c(float lo, float hi) { f32x2v v = {lo, hi}; bf16v2 b = __builtin_convertvector(v, bf16v2); return __builtin_bit_cast(unsigned, b); }
__device__ __forceinline__ float bflo(unsigned x) { return __uint_as_float(x << 16); }
__device__ __forceinline__ float bfhi(unsigned x) { return __uint_as_float(x & 0xffff0000u); }
__device__ __forceinline__ float sigm(float x) { return __builtin_amdgcn_rcpf(1.0f + __expf(-x)); }
__device__ __forceinline__ float wave_sum(float v) {
#pragma unroll
    for (int o = 1; o < 64; o <<= 1) v += __shfl_xor(v, o);
    return v;
}
__device__ __forceinline__ float wave_max(float v) {
#pragma unroll
    for (int o = 1; o < 64; o <<= 1) v = fmaxf(v, __shfl_xor(v, o));
    return v;
}
#define LDS_WAIT() asm volatile("s_waitcnt lgkmcnt(0)" ::: "memory")
#define MFMA32(a, b, c) __builtin_amdgcn_mfma_f32_32x32x16_bf16((a), (b), (c), 0, 0, 0)
__device__ __forceinline__ int ridx16(int lane) { return ((lane >> 5) & 1) * 8 + ((lane >> 4) & 1) * 4 + ((lane >> 3) & 1) * 2 + ((lane >> 2) & 1); }
__device__ __forceinline__ void xreduce16(float (&v)[16], int lane) {
#pragma unroll
    for (int i = 0; i < 8; ++i) { const bool up = (lane & 32) != 0; const float snd = up ? v[i] : v[i + 8], kp = up ? v[i + 8] : v[i]; v[i] = kp + __shfl_xor(snd, 32); }
#pragma unroll
    for (int i = 0; i < 4; ++i) { const bool up = (lane & 16) != 0; const float snd = up ? v[i] : v[i + 4], kp = up ? v[i + 4] : v[i]; v[i] = kp + __shfl_xor(snd, 16); }
#pragma unroll
    for (int i = 0; i < 2; ++i) { const bool up = (lane & 8) != 0; const float snd = up ? v[i] : v[i + 2], kp = up ? v[i + 2] : v[i]; v[i] = kp + __shfl_xor(snd, 8); }
    { const bool up = (lane & 4) != 0; const float snd = up ? v[0] : v[1], kp = up ? v[1] : v[0]; v[0] = kp + __shfl_xor(snd, 4); }
    v[0] += __shfl_xor(v[0], 2); v[0] += __shfl_xor(v[0], 1);
}
__device__ __forceinline__ float gelu_exact(float v) {
    const float av = fabsf(v), t = __builtin_amdgcn_rcpf(av * 0.2316418882f + 1.0f);
    float q = t * 0.5307027145f + (-0.7265760135f); q = q * t + 0.7107068705f; q = q * t + (-0.142248368f); q = q * t + 0.127414796f; q = q * t;
    const float e = __builtin_amdgcn_exp2f((v * v) * (-0.72134752044f));
    const float m = v * (q * e);
    return v < 0.f ? m : v - m;
}

struct Ctx { LAS unsigned char* lds; int tid, lane, wave, G, gw, NGW; };

__device__ __forceinline__ void tr_item(const float* W, int K, int N, bf16* WT, int k0, int n0, int drow0, LAS float* scr, int lane) {
#pragma unroll 8
    for (int i = 0; i < 32; ++i) { const int kk = 2 * i + (lane >> 5); scr[kk * 33 + (lane & 31)] = ((const GAS float*)W)[(size_t)(k0 + kk) * N + n0 + (lane & 31)]; }
    LDS_WAIT();
    const int c = lane & 7;
#pragma unroll
    for (int j = 0; j < 4; ++j) { const int n = (lane >> 3) + 8 * j; const LAS float* s = scr + (8 * c) * 33 + n;
        v4u o; o.x = pk2c(s[0], s[33]); o.y = pk2c(s[66], s[99]); o.z = pk2c(s[132], s[165]); o.w = pk2c(s[198], s[231]);
        *(GAS v4u*)(WT + (size_t)(drow0 + n) * K + k0 + 8 * c) = o; }
    LDS_WAIT();
}
__device__ __forceinline__ unsigned pack_i8x4c(float a, float b, float c, float d) {
    const int ia = (int)__builtin_rintf(fminf(fmaxf(a, -127.f), 127.f)), ib = (int)__builtin_rintf(fminf(fmaxf(b, -127.f), 127.f)), ic = (int)__builtin_rintf(fminf(fmaxf(c, -127.f), 127.f)), id = (int)__builtin_rintf(fminf(fmaxf(d, -127.f), 127.f));
    return ((unsigned)ia & 255u) | (((unsigned)ib & 255u) << 8) | (((unsigned)ic & 255u) << 16) | ((unsigned)id << 24);
}
__device__ __forceinline__ void tr_item_i8(const float* W, int K, int N, unsigned char* WT, int k0, int n0, int drow0, float scale, LAS float* scr, int lane) {
#pragma unroll 8
    for (int i = 0; i < 32; ++i) { const int kk = 2 * i + (lane >> 5); scr[kk * 33 + (lane & 31)] = ((const GAS float*)W)[(size_t)(k0 + kk) * N + n0 + (lane & 31)]; }
    LDS_WAIT();
    const int c = lane & 7;
#pragma unroll
    for (int j = 0; j < 4; ++j) { const int n = (lane >> 3) + 8 * j; const LAS float* s = scr + (8 * c) * 33 + n;
        v2u o; o.x = pack_i8x4c(s[0] * scale, s[33] * scale, s[66] * scale, s[99] * scale); o.y = pack_i8x4c(s[132] * scale, s[165] * scale, s[198] * scale, s[231] * scale);
        *(GAS v2u*)(WT + (size_t)(drow0 + n) * K + k0 + 8 * c) = o; }
    LDS_WAIT();
}
__device__ __forceinline__ int win_drow(int n) { if (n < 7168 || n >= 9216) return n; const int r = n - 7168, isb = r >> 10, c = r & 1023; return 7168 + (c >> 7) * 256 + isb * 128 + (c & 127); }
__device__ __forceinline__ void cvt_copy(const Ctx& c, const float* src, bf16* dst, size_t n8) {
    const size_t NT = (size_t)c.G * 512;
    for (size_t i = (size_t)blockIdx.x * 512 + c.tid; i < n8; i += NT) {
        const f32x4 a = ((const GAS f32x4*)src)[2 * i], b = ((const GAS f32x4*)src)[2 * i + 1];
        v4u o; o.x = pk2c(a.x, a.y); o.y = pk2c(a.z, a.w); o.z = pk2c(b.x, b.y); o.w = pk2c(b.z, b.w);
        ((GAS v4u*)dst)[i] = o;
    }
}
__device__ __forceinline__ void rms_row(const float* xr, const float* w, bf16* o, int lane) {
    const GAS f32x4* xp = (const GAS f32x4*)xr + lane; f32x4 v[8]; float s = 0.f;
#pragma unroll
    for (int j = 0; j < 8; ++j) { v[j] = xp[64 * j]; s += (v[j].x * v[j].x + v[j].y * v[j].y) + (v[j].z * v[j].z + v[j].w * v[j].w); }
    const float r = __builtin_amdgcn_rsqf(wave_sum(s) * (1.0f / DM) + EPS);
    const GAS f32x4* wp = (const GAS f32x4*)w + lane; GAS v2u* op = (GAS v2u*)o + lane;
#pragma unroll
    for (int j = 0; j < 8; ++j) { const f32x4 wv = wp[64 * j]; v2u q; q.x = pk2c(v[j].x * r * wv.x, v[j].y * r * wv.y); q.y = pk2c(v[j].z * r * wv.z, v[j].w * r * wv.w); op[64 * j] = q; }
}
__device__ __forceinline__ void rms_row_i8(const float* xr, const float* w, unsigned char* o, float* sa, int lane) {
    const GAS f32x4* xp = (const GAS f32x4*)xr + lane; f32x4 v[8]; float s = 0.f;
#pragma unroll
    for (int j = 0; j < 8; ++j) { v[j] = xp[64 * j]; s += (v[j].x * v[j].x + v[j].y * v[j].y) + (v[j].z * v[j].z + v[j].w * v[j].w); }
    const float r = __builtin_amdgcn_rsqf(wave_sum(s) * (1.0f / DM) + EPS);
    const GAS f32x4* wp = (const GAS f32x4*)w + lane; float m = 0.f;
#pragma unroll
    for (int j = 0; j < 8; ++j) { const f32x4 wv = wp[64 * j]; v[j].x *= r * wv.x; v[j].y *= r * wv.y; v[j].z *= r * wv.z; v[j].w *= r * wv.w;
        m = fmaxf(fmaxf(m, fmaxf(fabsf(v[j].x), fabsf(v[j].y))), fmaxf(fabsf(v[j].z), fabsf(v[j].w))); }
    m = wave_max(m);
    const float inv = m > 0.f ? 127.0f / m : 0.f;
    if (lane == 0) *(GAS float*)sa = m * (1.0f / 127.0f);
#pragma unroll
    for (int j = 0; j < 8; ++j) ((GAS unsigned*)o)[lane + 64 * j] = pack_i8x4c(v[j].x * inv, v[j].y * inv, v[j].z * inv, v[j].w * inv);
}
__device__ __forceinline__ void rms_phase_i8(const Ctx& c, const float* x, const float* w, unsigned char* H8, float* SA) {
    for (int m = c.gw; m < NTOK; m += c.NGW) rms_row_i8(x + (size_t)m * DM, w, H8 + (size_t)m * DM, SA + m, c.lane);
}
__device__ __forceinline__ void rms_phase(const Ctx& c, const float* x, const float* w, bf16* H) {
    for (int m = c.gw; m < NTOK; m += c.NGW) rms_row(x + (size_t)m * DM, w, H + (size_t)m * DM, c.lane);
}
__device__ __forceinline__ void fp8_row(const float* src, unsigned char* dst, float* scale_out, int lane) {
    const GAS f32x4* xp = (const GAS f32x4*)src + lane; f32x4 v[8]; float m = 0.f;
#pragma unroll
    for (int j = 0; j < 8; ++j) { v[j] = xp[64 * j]; m = fmaxf(fmaxf(m, fmaxf(fabsf(v[j].x), fabsf(v[j].y))), fmaxf(fabsf(v[j].z), fabsf(v[j].w))); }
    m = wave_max(m);
    const float inv = m > 0.f ? 256.0f / m : 0.f;
    if (lane == 0) *(GAS float*)scale_out = m * (1.0f / 256.0f);
#pragma unroll
    for (int j = 0; j < 8; ++j) { int p = __builtin_amdgcn_cvt_pk_fp8_f32(v[j].x * inv, v[j].y * inv, 0, false); p = __builtin_amdgcn_cvt_pk_fp8_f32(v[j].z * inv, v[j].w * inv, p, true);
        ((GAS unsigned*)dst)[lane + 64 * j] = (unsigned)p; }
}
__device__ __forceinline__ unsigned pack_i8x4(float a, float b, float c, float d) {
    const int ia = (int)__builtin_rintf(a), ib = (int)__builtin_rintf(b), ic = (int)__builtin_rintf(c), id = (int)__builtin_rintf(d);
    return ((unsigned)ia & 255u) | (((unsigned)ib & 255u) << 8) | (((unsigned)ic & 255u) << 16) | ((unsigned)id << 24);
}
__device__ __forceinline__ void i8_row(const float* src, unsigned char* dst, float* scale_out, int lane) {
    const GAS f32x4* xp = (const GAS f32x4*)src + lane; f32x4 v[8]; float m = 0.f;
#pragma unroll
    for (int j = 0; j < 8; ++j) { v[j] = xp[64 * j]; m = fmaxf(fmaxf(m, fmaxf(fabsf(v[j].x), fabsf(v[j].y))), fmaxf(fabsf(v[j].z), fabsf(v[j].w))); }
    m = wave_max(m);
    const float inv = m > 0.f ? 127.0f / m : 0.f;
    if (lane == 0) *(GAS float*)scale_out = m * (1.0f / 127.0f);
#pragma unroll
    for (int j = 0; j < 8; ++j) ((GAS unsigned*)dst)[lane + 64 * j] = pack_i8x4(v[j].x * inv, v[j].y * inv, v[j].z * inv, v[j].w * inv);
}
__device__ __forceinline__ void fp6_row(const float* src, unsigned char* dst, float* scale_out, int lane) {
    const GAS f32x4* xp = (const GAS f32x4*)src + 8 * lane; f32x4 v[8]; float m = 0.f;
#pragma unroll
    for (int j = 0; j < 8; ++j) { v[j] = xp[j]; m = fmaxf(fmaxf(m, fmaxf(fabsf(v[j].x), fabsf(v[j].y))), fmaxf(fabsf(v[j].z), fabsf(v[j].w))); }
    m = wave_max(m);
    const float inv = m > 0.f ? 7.5f / m : 0.f;
    if (lane == 0) *(GAS float*)scale_out = m * (1.0f / 7.5f);
    v32h_t h;
#pragma unroll
    for (int j = 0; j < 8; ++j) { h[4 * j] = (_Float16)(v[j].x * inv); h[4 * j + 1] = (_Float16)(v[j].y * inv); h[4 * j + 2] = (_Float16)(v[j].z * inv); h[4 * j + 3] = (_Float16)(v[j].w * inv); }
    const v6u q = __builtin_amdgcn_cvt_scalef32_pk32_fp6_f16(h, 1.0f);
    GAS v2u* o = (GAS v2u*)(dst + 24 * lane);
    o[0] = (v2u){q[0], q[1]}; o[1] = (v2u){q[2], q[3]}; o[2] = (v2u){q[4], q[5]};
}
struct P0Args { const float *w_in, *w_br_sb, *w_br_hg, *w_br_conv, *w_o, *w_q, *u, *v, *lbp; bf16 *WinT, *WbrT, *WoT, *WqT; unsigned char *U, *V; float *US, *VS; float* LB; int layer; const float *k1, *k2; bf16* KB; };
__device__ __forceinline__ void p0_convert(const Ctx& c, const P0Args& a) {
    LAS float* scr = (LAS float*)(c.lds + c.wave * 16384);
    constexpr int I_IN = (DM / 64) * (INW / 32), I_BR = (BW / 64) * (DM / 32), I_SQ = (DM / 64) * (DM / 32);
    constexpr int NITEMS = I_IN + 3 * I_BR + 2 * I_SQ;
    for (int it = c.gw; it < NITEMS; it += c.NGW) {
        int r = it;
        if (r < I_IN) { const int kb = r / (INW / 32), nb = r % (INW / 32); tr_item_i8(a.w_in, DM, INW, (unsigned char*)a.WinT, kb * 64, nb * 32, win_drow(nb * 32), WIN_QS, scr, c.lane); continue; } r -= I_IN;
        if (r < I_BR) { const int kb = r / (DM / 32), nb = r % (DM / 32); tr_item(a.w_br_sb, BW, DM, a.WbrT, kb * 64, nb * 32, nb * 32, scr, c.lane); continue; } r -= I_BR;
        if (r < I_BR) { const int kb = r / (DM / 32), nb = r % (DM / 32); tr_item(a.w_br_hg, BW, DM, a.WbrT + (size_t)DM * BW, kb * 64, nb * 32, nb * 32, scr, c.lane); continue; } r -= I_BR;
        if (r < I_BR) { const int kb = r / (DM / 32), nb = r % (DM / 32); tr_item(a.w_br_conv, BW, DM, a.WbrT + (size_t)2 * DM * BW, kb * 64, nb * 32, nb * 32, scr, c.lane); continue; } r -= I_BR;
        if (r < I_SQ) { const int kb = r / (DM / 32), nb = r % (DM / 32); tr_item(a.w_o, DM, DM, a.WoT, kb * 64, nb * 32, nb * 32, scr, c.lane); continue; } r -= I_SQ;
        { const int kb = r / (DM / 32), nb = r % (DM / 32); tr_item(a.w_q, DM, DM, a.WqT, kb * 64, nb * 32, nb * 32, scr, c.lane); }
    }
    for (int r = c.gw; r < 2 * 16384; r += c.NGW) {
        if (r < 16384) i8_row(a.u + (size_t)r * 2048, a.U + (size_t)r * 2048, a.US + r, c.lane);
        else fp6_row(a.v + (size_t)(r - 16384) * 2048, a.V + (size_t)(r - 16384) * 1536, a.VS + (r - 16384), c.lane);
    }
    cvt_copy(c, a.k1, a.KB, (size_t)8 * 16384 / 8);
    cvt_copy(c, a.k2, a.KB + 8 * 16384, (size_t)8 * 16384 / 8);
    if (blockIdx.x == 0) for (int i = c.tid; i < 1024; i += 512) a.LB[i] = a.layer == 0 ? 0.f : sigm(a.lbp[1024 + i] - a.lbp[i]);
}

struct EpiIn {
    static constexpr bool PERM = true, AFTER_DRAIN = false;
    bf16* seg; bf16* gate; const float* lb; const float* sa;
    __device__ __forceinline__ float rowscale(int row) const { return ((const GAS float*)sa)[row] * (1.0f / WIN_QS); }
    __device__ __forceinline__ void operator()(const pg8::f32x4 (&acc)[2][2][4][2], const pg8::Unit& u, int wr, int wc, int fr, int fq) const {
        const int pn = u.pn; const int row0 = u.pm * 256 + wr * 64 + fr;
        if (pn >= 28 && pn < 36) {
            bf16* dst = seg + (size_t)7 * SEGSZ; const int col0 = (pn - 28) * 128 + wc * 32 + 8 * fq;
#pragma unroll
            for (int ai = 0; ai < 2; ++ai)
#pragma unroll
                for (int m = 0; m < 4; ++m) {
                    const pg8::f32x4 a0 = acc[ai][0][m][0], a1 = acc[ai][0][m][1], b0 = acc[ai][1][m][0], b1 = acc[ai][1][m][1];
                    v4u w; w.x = pk2c(a0[0] * sigm(b0[0]), a0[1] * sigm(b0[1])); w.y = pk2c(a0[2] * sigm(b0[2]), a0[3] * sigm(b0[3]));
                    w.z = pk2c(a1[0] * sigm(b1[0]), a1[1] * sigm(b1[1])); w.w = pk2c(a1[2] * sigm(b1[2]), a1[3] * sigm(b1[3]));
                    *(GAS v4u*)(dst + (size_t)(row0 + ai * 128 + m * 16) * 1024 + col0) = w; }
            return;
        }
        bf16* dst; int ld, colt, mode;
        if (pn < 28) { const int sg = pn >> 2; dst = seg + (size_t)sg * SEGSZ; ld = 1024; colt = (pn & 3) * 256; mode = (sg == 4) ? 2 : (sg == 6 ? 1 : 0); }
        else { const int q = pn - 36; dst = gate + (size_t)(q >> 3) * ((size_t)NTOK * 2048); ld = 2048; colt = (q & 7) * 256; mode = 1; }
        const int col0 = colt + wc * 32 + 8 * fq;
        if (mode == 0) {
#pragma unroll
            for (int ai = 0; ai < 2; ++ai)
#pragma unroll
                for (int m = 0; m < 4; ++m)
#pragma unroll
                    for (int bj = 0; bj < 2; ++bj) { const pg8::f32x4 v0 = acc[ai][bj][m][0], v1 = acc[ai][bj][m][1];
                        v4u w; w.x = pk2c(v0[0], v0[1]); w.y = pk2c(v0[2], v0[3]); w.z = pk2c(v1[0], v1[1]); w.w = pk2c(v1[2], v1[3]);
                        *(GAS v4u*)(dst + (size_t)(row0 + ai * 128 + m * 16) * ld + col0 + bj * 128) = w; }
        } else if (mode == 1) {
#pragma unroll
            for (int ai = 0; ai < 2; ++ai)
#pragma unroll
                for (int m = 0; m < 4; ++m)
#pragma unroll
                    for (int bj = 0; bj < 2; ++bj) { const pg8::f32x4 v0 = acc[ai][bj][m][0], v1 = acc[ai][bj][m][1];
                        v4u w; w.x = pk2c(sigm(v0[0]), sigm(v0[1])); w.y = pk2c(sigm(v0[2]), sigm(v0[3])); w.z = pk2c(sigm(v1[0]), sigm(v1[1])); w.w = pk2c(sigm(v1[2]), sigm(v1[3]));
                        *(GAS v4u*)(dst + (size_t)(row0 + ai * 128 + m * 16) * ld + col0 + bj * 128) = w; }
        } else {
            f32x4 l0[2], l1[2];
#pragma unroll
            for (int bj = 0; bj < 2; ++bj) { l0[bj] = *(const GAS f32x4*)(lb + col0 + bj * 128); l1[bj] = *(const GAS f32x4*)(lb + col0 + bj * 128 + 4); }
#pragma unroll
            for (int ai = 0; ai < 2; ++ai)
#pragma unroll
                for (int m = 0; m < 4; ++m)
#pragma unroll
                    for (int bj = 0; bj < 2; ++bj) { const pg8::f32x4 v0 = acc[ai][bj][m][0], v1 = acc[ai][bj][m][1]; float r[8];
#pragma unroll
                        for (int j = 0; j < 4; ++j) { r[j] = __logf(l0[bj][j] + (1.0f - l0[bj][j]) * sigm(v0[j])); r[4 + j] = __logf(l1[bj][j] + (1.0f - l1[bj][j]) * sigm(v1[j])); }
                        v4u w; w.x = pk2c(r[0], r[1]); w.y = pk2c(r[2], r[3]); w.z = pk2c(r[4], r[5]); w.w = pk2c(r[6], r[7]);
                        *(GAS v4u*)(dst + (size_t)(row0 + ai * 128 + m * 16) * ld + col0 + bj * 128) = w; }
        }
    }
};

__device__ __forceinline__ void conv_phase(const Ctx& c, const bf16* glu, const float* cw, const float* cb, const float* lnw, const float* lnb, bf16* out) {
    const int c0 = 2 * c.tid;
    float w0[31], w1[31];
#pragma unroll
    for (int j = 0; j < 31; ++j) { const f32x2v t = *(const GAS f32x2v*)(cw + j * 1024 + c0); w0[j] = t.x; w1[j] = t.y; }
    const f32x2v bv = *(const GAS f32x2v*)(cb + c0), lwv = *(const GAS f32x2v*)(lnw + c0), lbv = *(const GAS f32x2v*)(lnb + c0);
    LAS float* red = (LAS float*)c.lds;
    for (int tile = blockIdx.x; tile < NTOK / 8; tile += c.G) {
        const int n0 = tile * 8, tseq0 = n0 & (SEQ - 1);
        float a0[8], a1[8];
#pragma unroll
        for (int t = 0; t < 8; ++t) { a0[t] = bv.x; a1[t] = bv.y; }
#pragma unroll
        for (int r = 0; r < 38; ++r) {
            unsigned xv = 0u;
            if (tseq0 + r - 30 >= 0) xv = *(const GAS unsigned*)(glu + (size_t)(n0 + r - 30) * 1024 + c0);
            const float x0 = bflo(xv), x1 = bfhi(xv);
#pragma unroll
            for (int t = 0; t < 8; ++t) { const int j = r - t; if (j >= 0 && j <= 30) { a0[t] += w0[j] * x0; a1[t] += w1[j] * x1; } }
        }
        float st[16];
#pragma unroll
        for (int t = 0; t < 8; ++t) { st[2 * t] = a0[t] + a1[t]; st[2 * t + 1] = a0[t] * a0[t] + a1[t] * a1[t]; }
        xreduce16(st, c.lane);
        if ((c.lane & 3) == 0) red[c.wave * 16 + ridx16(c.lane)] = st[0];
        __syncthreads();
        if (c.tid < 16) { float s = 0.f;
#pragma unroll
            for (int w = 0; w < 8; ++w) s += red[w * 16 + c.tid];
            red[128 + c.tid] = s; }
        __syncthreads();
#pragma unroll
        for (int t = 0; t < 8; ++t) {
            const float mean = red[128 + 2 * t] * (1.0f / 1024.0f), var = red[128 + 2 * t + 1] * (1.0f / 1024.0f) - mean * mean;
            const float rstd = __builtin_amdgcn_rsqf(var + EPS);
            const float h0 = (a0[t] - mean) * rstd * lwv.x + lbv.x, h1 = (a1[t] - mean) * rstd * lwv.y + lbv.y;
            *(GAS unsigned*)(out + (size_t)(n0 + t) * 1024 + c0) = pk2c(h0 * sigm(h0), h1 * sigm(h1));
        }
        __syncthreads();
    }
}
__device__ __forceinline__ void hgrn_task(int task, int lane, const bf16* qhg, const bf16* logf, const bf16* ihg, bf16* out) {
    const int bh = task >> 6, dvb = task & 63, b = bh >> 3, h = bh & 7;
    const size_t rb = (size_t)b * SEQ * 1024;
    const GAS unsigned* qp = (const GAS unsigned*)(qhg + rb + h * 128) + lane;
    const GAS unsigned* lp = (const GAS unsigned*)(logf + rb + h * 128) + lane;
    const GAS unsigned* ip = (const GAS unsigned*)(ihg + rb + h * 128) + dvb;
    GAS bf16* op = (GAS bf16*)(out + rb + h * 128 + 2 * dvb);
    float S00 = 0.f, S01 = 0.f, S10 = 0.f, S11 = 0.f;
    unsigned qn[8], ln[8], inx[8];
#pragma unroll
    for (int j = 0; j < 8; ++j) { qn[j] = qp[(size_t)j * 512]; ln[j] = lp[(size_t)j * 512]; inx[j] = ip[(size_t)j * 512]; }
    for (int blk = 0; blk < SEQ / 8; ++blk) {
        unsigned qc[8], lc[8], ic[8];
#pragma unroll
        for (int j = 0; j < 8; ++j) { qc[j] = qn[j]; lc[j] = ln[j]; ic[j] = inx[j]; }
        if (blk + 1 < SEQ / 8) {
#pragma unroll
            for (int j = 0; j < 8; ++j) { const size_t o = (size_t)((blk + 1) * 8 + j) * 512; qn[j] = qp[o]; ln[j] = lp[o]; inx[j] = ip[o]; }
        }
        float pv[16];
#pragma unroll
        for (int j = 0; j < 8; ++j) {
            const float f0 = __expf(bflo(lc[j])), f1 = __expf(bfhi(lc[j])), k0 = 1.0f - f0, k1 = 1.0f - f1;
            const float i0 = bflo(ic[j]), i1 = bfhi(ic[j]), q0 = bflo(qc[j]), q1 = bfhi(qc[j]);
            S00 = f0 * S00 + k0 * i0; S01 = f0 * S01 + k0 * i1; S10 = f1 * S10 + k1 * i0; S11 = f1 * S11 + k1 * i1;
            pv[2 * j] = S00 * q0 + S10 * q1; pv[2 * j + 1] = S01 * q0 + S11 * q1;
        }
        xreduce16(pv, lane);
        if ((lane & 3) == 0) { const int idx = ridx16(lane); op[(size_t)(blk * 8 + (idx >> 1)) * 1024 + (idx & 1)] = (bf16)(pk2c(pv[0], 0.f) & 0xffffu); }
    }
}
constexpr int HG_TS = 272;
constexpr int HG_BS = 132;
__device__ __forceinline__ void hg_stage(LAS unsigned char* dst, const bf16* src, int tid) {
#pragma unroll
    for (int i = 0; i < 2; ++i) { const int p = tid + 512 * i, row = p >> 4, c16 = p & 15; *(LAS v4u*)(dst + row * HG_TS + c16 * 16) = *(const GAS v4u*)(src + (size_t)row * 1024 + c16 * 8); }
}
__device__ __forceinline__ void hg_scan(const LAS unsigned char* lft, int dk, int hf, float (&lf)[4][8], float (&b)[4][8], float& bl) {
    float bs[4], pb[4];
#pragma unroll
    for (int kk = 0; kk < 4; ++kk) { float run = 0.f;
#pragma unroll
        for (int j = 0; j < 8; ++j) { lf[kk][j] = __uint_as_float((unsigned)(*(const LAS unsigned short*)(lft + (16 * kk + 8 * hf + j) * HG_TS + dk * 2)) << 16); run += lf[kk][j]; b[kk][j] = run; }
        bs[kk] = run; }
#pragma unroll
    for (int kk = 0; kk < 4; ++kk) pb[kk] = __shfl_xor(bs[kk], 32);
    float pre = 0.f;
#pragma unroll
    for (int kk = 0; kk < 4; ++kk) { const float off = pre + (hf ? pb[kk] : 0.f);
#pragma unroll
        for (int j = 0; j < 8; ++j) b[kk][j] += off;
        pre += bs[kk] + pb[kk]; }
    bl = pre;
}
__device__ __forceinline__ bf16x8 pack8(const float (&v)[8]) { v4u t; t.x = pk2c(v[0], v[1]); t.y = pk2c(v[2], v[3]); t.z = pk2c(v[4], v[5]); t.w = pk2c(v[6], v[7]); return __builtin_bit_cast(bf16x8, t); }
__device__ __forceinline__ unsigned lds_u16(const LAS unsigned char* p) { return (unsigned)(*(const LAS unsigned short*)p); }
__device__ __forceinline__ void hgA_chunk(const Ctx& c, int ci, const bf16* LOGF, const bf16* IHG, bf16* ST, float* DEC) {
    const int bh = ci >> 6, ch = ci & 63, bb = bh >> 3, h = bh & 7; const size_t n0 = (size_t)bb * SEQ + ch * 64;
    LAS unsigned char* lft = c.lds; LAS unsigned char* itl = c.lds + 64 * HG_TS;
    hg_stage(lft, LOGF + n0 * 1024 + h * 128, c.tid); hg_stage(itl, IHG + n0 * 1024 + h * 128, c.tid);
    __syncthreads();
    const int dkt = c.wave & 3, dvh = c.wave >> 2, hf = c.lane >> 5, cl = c.lane & 31, dk = 32 * dkt + cl;
    float lf[4][8], b[4][8], bl; hg_scan(lft, dk, hf, lf, b, bl);
    bf16x8 kf[4];
#pragma unroll
    for (int kk = 0; kk < 4; ++kk) { float v[8];
#pragma unroll
        for (int j = 0; j < 8; ++j) v[j] = (1.0f - __expf(lf[kk][j])) * __expf(bl - b[kk][j]);
        kf[kk] = pack8(v); }
    if (dvh == 0 && hf == 0) ((GAS float*)DEC)[(size_t)ci * 128 + dk] = __expf(bl);
#pragma unroll
    for (int dvi = 0; dvi < 2; ++dvi) { const int dvt = dvh * 2 + dvi;
        f32x16 acc;
#pragma unroll
        for (int r = 0; r < 16; ++r) acc[r] = 0.f;
#pragma unroll
        for (int kk = 0; kk < 4; ++kk) { const LAS unsigned char* p = itl + (16 * kk + 8 * hf) * HG_TS + (32 * dvt + cl) * 2;
            v4u t; t.x = lds_u16(p) | (lds_u16(p + HG_TS) << 16); t.y = lds_u16(p + 2 * HG_TS) | (lds_u16(p + 3 * HG_TS) << 16); t.z = lds_u16(p + 4 * HG_TS) | (lds_u16(p + 5 * HG_TS) << 16); t.w = lds_u16(p + 6 * HG_TS) | (lds_u16(p + 7 * HG_TS) << 16);
            acc = MFMA32(kf[kk], __builtin_bit_cast(bf16x8, t), acc); }
        bf16* o = ST + (size_t)ci * 16384 + (size_t)(32 * dvt + cl) * 128 + 32 * dkt + 4 * hf;
#pragma unroll
        for (int g = 0; g < 4; ++g) { v2u q; q.x = pk2c(acc[4 * g], acc[4 * g + 1]); q.y = pk2c(acc[4 * g + 2], acc[4 * g + 3]); *(GAS v2u*)(o + 8 * g) = q; }
    }
    __syncthreads();
}
__device__ __forceinline__ void hgB(const Ctx& c, bf16* ST, const float* DEC) {
    for (int e = blockIdx.x * 512 + c.tid; e < 32 * 4096; e += c.G * 512) {
        const int bh = e >> 12, r = e & 4095, dv = r >> 5, dk4 = (r & 31) * 4;
        GAS v2u* p = (GAS v2u*)(ST + (size_t)bh * 64 * 16384 + (size_t)dv * 128 + dk4);
        const GAS f32x4* d = (const GAS f32x4*)(DEC + (size_t)bh * 64 * 128 + dk4);
        f32x4 S = {0.f, 0.f, 0.f, 0.f};
#pragma unroll 1
        for (int c0 = 0; c0 < 64; c0 += 8) {
            v2u Lv[8]; f32x4 D[8];
#pragma unroll
            for (int k = 0; k < 8; ++k) { Lv[k] = p[(size_t)(c0 + k) * 4096]; D[k] = d[(size_t)(c0 + k) * 32]; }
#pragma unroll
            for (int k = 0; k < 8; ++k) { v2u o; o.x = pk2c(S.x, S.y); o.y = pk2c(S.z, S.w); p[(size_t)(c0 + k) * 4096] = o;
                S.x = D[k].x * S.x + bflo(Lv[k].x); S.y = D[k].y * S.y + bfhi(Lv[k].x); S.z = D[k].z * S.z + bflo(Lv[k].y); S.w = D[k].w * S.w + bfhi(Lv[k].y); }
        }
    }
}
__device__ __forceinline__ void hgC_chunk(const Ctx& c, int ci, const bf16* QHG, const bf16* LOGF, const bf16* IHG, const bf16* GHG, const bf16* ST, const float* nw, bf16* OUT) {
    const int bh = ci >> 6, ch = ci & 63, bb = bh >> 3, h = bh & 7; const size_t n0 = (size_t)bb * SEQ + ch * 64;
    LAS unsigned char* lft = c.lds; LAS unsigned char* itl = c.lds + 64 * HG_TS; LAS float* bt = (LAS float*)(c.lds + 2 * 64 * HG_TS); LAS float* red = bt + 64 * HG_BS;
    LAS unsigned char* ktl = (LAS unsigned char*)(red + 256);
    hg_stage(lft, LOGF + n0 * 1024 + h * 128, c.tid); hg_stage(itl, IHG + n0 * 1024 + h * 128, c.tid);
    __syncthreads();
    const int hf = c.lane >> 5, cl = c.lane & 31;
    { const int dk = 32 * (c.wave & 3) + cl; float lf[4][8], b[4][8], bl; hg_scan(lft, dk, hf, lf, b, bl);
#pragma unroll
      for (int q = 0; q < 2; ++q) { const int kk = 2 * (c.wave >> 2) + q;
#pragma unroll
          for (int j = 0; j < 8; ++j) { bt[(16 * kk + 8 * hf + j) * HG_BS + dk] = (c.wave >> 2) ? b[2 + q][j] : b[q][j];
              *(LAS unsigned short*)(ktl + (16 * kk + 8 * hf + j) * HG_TS + dk * 2) = (unsigned short)(pk2c(1.0f - __expf((c.wave >> 2) ? lf[2 + q][j] : lf[q][j]), 0.f) & 0xffffu); } } }
    __syncthreads();
    const int dvt = c.wave & 3, tt = c.wave >> 2, t = 32 * tt + cl;
    bf16x8 qm[8];
    const bf16* qrow = QHG + (n0 + t) * 1024 + h * 128 + 8 * hf;
#pragma unroll
    for (int kk = 0; kk < 8; ++kk) { const int d0 = 16 * kk + 8 * hf;
        asm volatile("" ::: "memory");
        const v4u qv = *(const GAS v4u*)(qrow + 16 * kk);
        const f32x4 b0 = *(const LAS f32x4*)(bt + t * HG_BS + d0), b1 = *(const LAS f32x4*)(bt + t * HG_BS + d0 + 4), m0 = *(const LAS f32x4*)(bt + 31 * HG_BS + d0), m1 = *(const LAS f32x4*)(bt + 31 * HG_BS + d0 + 4);
        const float q[8] = {bflo(qv.x), bfhi(qv.x), bflo(qv.y), bfhi(qv.y), bflo(qv.z), bfhi(qv.z), bflo(qv.w), bfhi(qv.w)};
        const float bv[8] = {b0.x, b0.y, b0.z, b0.w, b1.x, b1.y, b1.z, b1.w}, mv[8] = {m0.x, m0.y, m0.z, m0.w, m1.x, m1.y, m1.z, m1.w};
        float vm[8];
#pragma unroll
        for (int j = 0; j < 8; ++j) vm[j] = q[j] * __expf(bv[j] - mv[j]);
        qm[kk] = pack8(vm); }
    f32x16 o;
#pragma unroll
    for (int r = 0; r < 16; ++r) o[r] = 0.f;
#pragma unroll 1
    for (int st = 0; st <= tt; ++st) {
        const int s = 32 * st + cl;
        f32x16 sa;
#pragma unroll
        for (int r = 0; r < 16; ++r) sa[r] = 0.f;
#pragma unroll
        for (int kk = 0; kk < 8; ++kk) { const int d0 = 16 * kk + 8 * hf;
            asm volatile("" ::: "memory");
            const v4u lv = *(const LAS v4u*)(ktl + s * HG_TS + d0 * 2);
            const f32x4 b0 = *(const LAS f32x4*)(bt + s * HG_BS + d0), b1 = *(const LAS f32x4*)(bt + s * HG_BS + d0 + 4), m0 = *(const LAS f32x4*)(bt + 31 * HG_BS + d0), m1 = *(const LAS f32x4*)(bt + 31 * HG_BS + d0 + 4);
            const float kv[8] = {bflo(lv.x), bfhi(lv.x), bflo(lv.y), bfhi(lv.y), bflo(lv.z), bfhi(lv.z), bflo(lv.w), bfhi(lv.w)};
            const float bv[8] = {b0.x, b0.y, b0.z, b0.w, b1.x, b1.y, b1.z, b1.w}, mv[8] = {m0.x, m0.y, m0.z, m0.w, m1.x, m1.y, m1.z, m1.w};
            float vk[8];
#pragma unroll
            for (int j = 0; j < 8; ++j) vk[j] = kv[j] * __expf(mv[j] - bv[j]);
            sa = MFMA32(pack8(vk), qm[kk], sa); }
        if (st == tt) {
#pragma unroll
            for (int r = 0; r < 16; ++r) if (((r & 3) + 8 * (r >> 2) + 4 * hf) > cl) sa[r] = 0.f;
        }
#pragma unroll
        for (int sp = 0; sp < 2; ++sp) {
            const float pv[8] = {sa[8 * sp], sa[8 * sp + 1], sa[8 * sp + 2], sa[8 * sp + 3], sa[8 * sp + 4], sa[8 * sp + 5], sa[8 * sp + 6], sa[8 * sp + 7]};
            const LAS unsigned char* p = itl + (32 * st + 16 * sp + 4 * hf) * HG_TS + (32 * dvt + cl) * 2;
            v4u tq; tq.x = lds_u16(p) | (lds_u16(p + HG_TS) << 16); tq.y = lds_u16(p + 2 * HG_TS) | (lds_u16(p + 3 * HG_TS) << 16);
            tq.z = lds_u16(p + 8 * HG_TS) | (lds_u16(p + 9 * HG_TS) << 16); tq.w = lds_u16(p + 10 * HG_TS) | (lds_u16(p + 11 * HG_TS) << 16);
            o = MFMA32(__builtin_bit_cast(bf16x8, tq), pack8(pv), o); }
    }
    { const bf16* strow = ST + (size_t)ci * 16384 + (size_t)(32 * dvt + cl) * 128 + 8 * hf;
#pragma unroll
      for (int kk = 0; kk < 8; ++kk) { const int d0 = 16 * kk + 8 * hf;
          asm volatile("" ::: "memory");
          const v4u qv = *(const GAS v4u*)(qrow + 16 * kk); const bf16x8 sf = *(const GAS bf16x8*)(strow + 16 * kk);
          const f32x4 b0 = *(const LAS f32x4*)(bt + t * HG_BS + d0), b1 = *(const LAS f32x4*)(bt + t * HG_BS + d0 + 4);
          float ve[8] = {bflo(qv.x) * __expf(b0.x), bfhi(qv.x) * __expf(b0.y), bflo(qv.y) * __expf(b0.z), bfhi(qv.y) * __expf(b0.w), bflo(qv.z) * __expf(b1.x), bfhi(qv.z) * __expf(b1.y), bflo(qv.w) * __expf(b1.z), bfhi(qv.w) * __expf(b1.w)};
          o = MFMA32(sf, pack8(ve), o); } }
    float ss = 0.f;
#pragma unroll
    for (int r = 0; r < 16; ++r) ss += o[r] * o[r];
    ss += __shfl_xor(ss, 32);
    if (hf == 0) red[(tt * 4 + dvt) * 32 + cl] = ss;
    __syncthreads();
    const float rstd = __builtin_amdgcn_rsqf(((red[(tt * 4 + 0) * 32 + cl] + red[(tt * 4 + 1) * 32 + cl]) + (red[(tt * 4 + 2) * 32 + cl] + red[(tt * 4 + 3) * 32 + cl])) * (1.0f / 128.0f) + EPS);
#pragma unroll
    for (int g = 0; g < 4; ++g) { const int dv0 = 32 * dvt + 8 * g + 4 * hf; const size_t off = (n0 + t) * 1024 + h * 128 + dv0;
        const v2u gg = *(const GAS v2u*)(GHG + off); const f32x4 w4 = *(const GAS f32x4*)(nw + dv0);
        v2u q; q.x = pk2c(o[4 * g] * rstd * w4.x * bflo(gg.x), o[4 * g + 1] * rstd * w4.y * bfhi(gg.x)); q.y = pk2c(o[4 * g + 2] * rstd * w4.z * bflo(gg.y), o[4 * g + 3] * rstd * w4.w * bfhi(gg.y));
        *(GAS v2u*)(OUT + off) = q; }
    __syncthreads();
}
__device__ __forceinline__ void qknorm_row(bf16* row, const float* w, float scale, int lane) {
#pragma unroll
    for (int j = 0; j < 2; ++j) {
        GAS v4u* p = (GAS v4u*)(row + 8 * lane + 512 * j); const v4u x = *p;
        float f[8] = {bflo(x.x), bfhi(x.x), bflo(x.y), bfhi(x.y), bflo(x.z), bfhi(x.z), bflo(x.w), bfhi(x.w)};
        float ss = 0.f;
#pragma unroll
        for (int k = 0; k < 8; ++k) ss += f[k] * f[k];
        ss += __shfl_xor(ss, 1); ss += __shfl_xor(ss, 2); ss += __shfl_xor(ss, 4); ss += __shfl_xor(ss, 8);
        const float r = __builtin_amdgcn_rsqf(ss * (1.0f / 128.0f) + EPS) * scale;
        const f32x4 wa = *(const GAS f32x4*)(w + ((8 * lane) & 127)), wb = *(const GAS f32x4*)(w + ((8 * lane) & 127) + 4);
        v4u o; o.x = pk2c(f[0] * r * wa.x, f[1] * r * wa.y); o.y = pk2c(f[2] * r * wa.z, f[3] * r * wa.w); o.z = pk2c(f[4] * r * wb.x, f[5] * r * wb.y); o.w = pk2c(f[6] * r * wb.z, f[7] * r * wb.w);
        *p = o;
    }
}
__device__ __forceinline__ void vt_item(int item, int lane, const bf16* vsb, bf16* vt, LAS unsigned short* scr) {
    const int db = item & 3, sb = (item >> 2) & 63, bh = item >> 8, b = bh >> 3, h = bh & 7;
    const bf16* src = vsb + ((size_t)b * SEQ + sb * 64) * 1024 + h * 128 + db * 32;
#pragma unroll 4
    for (int i = 0; i < 16; ++i) { const int r = 4 * i + (lane >> 4); *(LAS unsigned*)(scr + r * 34 + 2 * (lane & 15)) = *(const GAS unsigned*)(src + (size_t)r * 1024 + 2 * (lane & 15)); }
    LDS_WAIT();
    const int c = lane & 7;
#pragma unroll
    for (int j = 0; j < 4; ++j) { const int d = (lane >> 3) + 8 * j; const LAS unsigned short* s = scr + (8 * c) * 34 + d;
        v4u o; o.x = (unsigned)s[0] | ((unsigned)s[34] << 16); o.y = (unsigned)s[68] | ((unsigned)s[102] << 16); o.z = (unsigned)s[136] | ((unsigned)s[170] << 16); o.w = (unsigned)s[204] | ((unsigned)s[238] << 16);
        *(GAS v4u*)(vt + ((size_t)bh * 128 + db * 32 + d) * SEQ + sb * 64 + 8 * c) = o; }
    LDS_WAIT();
}

constexpr int AT_KS = 272, AT_VS = 136, AT_BUF = 64 * AT_KS + 128 * AT_VS;
__device__ __forceinline__ f32x16 attn_scores(const LAS unsigned char* kp, const bf16x8 (&qf)[8]) {
    f32x16 sa;
#pragma unroll
    for (int r = 0; r < 16; ++r) sa[r] = 0.f;
#pragma unroll
    for (int kk = 0; kk < 8; ++kk) sa = MFMA32(*(const LAS bf16x8*)(kp + 32 * kk), qf[kk], sa);
    return sa;
}
template <bool DIAG> __device__ __forceinline__ void attn_weights(const f32x16& sa, float& R, int hf, int cl, bf16x8 (&pf)[2]) {
    float om[16], be[16];
#pragma unroll
    for (int r = 0; r < 16; ++r) { const float e = __builtin_amdgcn_exp2f(sa[r] * 1.4426950408889634f); om[r] = __builtin_amdgcn_rcpf(1.0f + e); be[r] = e * om[r]; }
    if (DIAG) {
#pragma unroll
        for (int r = 0; r < 16; ++r) if (((r & 3) + 8 * (r >> 2) + 4 * hf) >= cl) { om[r] = 1.0f; be[r] = 0.f; }
    }
    float Gs[4], Gp[4];
#pragma unroll
    for (int g = 0; g < 4; ++g) { Gs[g] = (om[4 * g] * om[4 * g + 1]) * (om[4 * g + 2] * om[4 * g + 3]); Gp[g] = __shfl_xor(Gs[g], 32); }
    float tail = R; float w[16];
#pragma unroll
    for (int g = 3; g >= 0; --g) {
        const float c3 = tail * (hf == 0 ? Gp[g] : 1.0f), c2 = c3 * om[4 * g + 3], c1 = c2 * om[4 * g + 2], c0 = c1 * om[4 * g + 1];
        w[4 * g + 3] = be[4 * g + 3] * c3; w[4 * g + 2] = be[4 * g + 2] * c2; w[4 * g + 1] = be[4 * g + 1] * c1; w[4 * g] = be[4 * g] * c0;
        tail *= Gs[g] * Gp[g];
    }
    R = tail;
#pragma unroll
    for (int sp = 0; sp < 2; ++sp) { v4u t; t.x = pk2c(w[8 * sp], w[8 * sp + 1]); t.y = pk2c(w[8 * sp + 2], w[8 * sp + 3]); t.z = pk2c(w[8 * sp + 4], w[8 * sp + 5]); t.w = pk2c(w[8 * sp + 6], w[8 * sp + 7]); pf[sp] = __builtin_bit_cast(bf16x8, t); }
}
__device__ __forceinline__ void attn_pv(const LAS unsigned char* vp, const bf16x8 (&pf)[2], f32x16 (&o)[4]) {
#pragma unroll
    for (int d = 0; d < 4; ++d)
#pragma unroll
        for (int sp = 0; sp < 2; ++sp) { const v2u lo = *(const LAS v2u*)(vp + d * 32 * AT_VS + 32 * sp), hi = *(const LAS v2u*)(vp + d * 32 * AT_VS + 32 * sp + 16);
            v4u t; t.x = lo.x; t.y = lo.y; t.z = hi.x; t.w = hi.y; o[d] = MFMA32(__builtin_bit_cast(bf16x8, t), pf[sp], o[d]); }
}
__device__ __forceinline__ void attn_unit(const Ctx& c, int bh, int qb, const bf16* qsb, const bf16* ksb, const bf16* vt, bf16* outb) {
    const int b = bh >> 3, h = bh & 7, lane = c.lane, cl = lane & 31, hf = lane >> 5, tid = c.tid;
    const size_t rb = (size_t)b * SEQ; const int q0w = 256 * qb + 32 * c.wave;
    bf16x8 qf[8];
    { const bf16* qrow = qsb + (rb + q0w + cl) * 1024 + h * 128 + 8 * hf;
#pragma unroll
      for (int kk = 0; kk < 8; ++kk) qf[kk] = *(const GAS bf16x8*)(qrow + 16 * kk); }
    f32x16 o[4];
#pragma unroll
    for (int d = 0; d < 4; ++d)
#pragma unroll
        for (int r = 0; r < 16; ++r) o[d][r] = 0.f;
    float R = 1.0f;
    const bf16* kg = ksb + (rb + (tid >> 4)) * 1024 + h * 128 + (tid & 15) * 8;
    const bf16* vg = vt + ((size_t)bh * 128 + (tid >> 3)) * SEQ + (tid & 7) * 8;
    const int kl = (tid >> 4) * AT_KS + (tid & 15) * 16, vl = 64 * AT_KS + (tid >> 3) * AT_VS + (tid & 7) * 16;
    const int nkt = 4 * (qb + 1);
    v4u st[4];
    { const int kt = nkt - 1;
      st[0] = *(const GAS v4u*)(kg + (size_t)kt * 64 * 1024); st[1] = *(const GAS v4u*)(kg + (size_t)kt * 64 * 1024 + 32 * 1024);
      st[2] = *(const GAS v4u*)(vg + kt * 64); st[3] = *(const GAS v4u*)(vg + kt * 64 + (size_t)64 * SEQ);
      *(LAS v4u*)(c.lds + kl) = st[0]; *(LAS v4u*)(c.lds + kl + 32 * AT_KS) = st[1];
      *(LAS v2u*)(c.lds + vl) = (v2u){st[2].x, st[2].y}; *(LAS v2u*)(c.lds + vl + 8) = (v2u){st[2].z, st[2].w}; *(LAS v2u*)(c.lds + vl + 64 * AT_VS) = (v2u){st[3].x, st[3].y}; *(LAS v2u*)(c.lds + vl + 64 * AT_VS + 8) = (v2u){st[3].z, st[3].w}; }
    __syncthreads();
#pragma unroll 1
    for (int it = 0; it < nkt; ++it) {
        const int kt = nkt - 1 - it; LAS unsigned char* buf = c.lds + (it & 1) * AT_BUF; LAS unsigned char* nbuf = c.lds + ((it & 1) ^ 1) * AT_BUF;
        const bool more = (it + 1 < nkt);
        if (more) { const int k2 = kt - 1;
            st[0] = *(const GAS v4u*)(kg + (size_t)k2 * 64 * 1024); st[1] = *(const GAS v4u*)(kg + (size_t)k2 * 64 * 1024 + 32 * 1024);
            st[2] = *(const GAS v4u*)(vg + k2 * 64); st[3] = *(const GAS v4u*)(vg + k2 * 64 + (size_t)64 * SEQ); }
        const int rel = q0w - 64 * kt;
        const LAS unsigned char* kp0 = buf + cl * AT_KS + 16 * hf; const LAS unsigned char* kp1 = kp0 + 32 * AT_KS;
        const LAS unsigned char* vp0 = buf + 64 * AT_KS + cl * AT_VS + 8 * hf; const LAS unsigned char* vp1 = vp0 + 64;
        if (rel >= 64) {
            const f32x16 s1 = attn_scores(kp1, qf), s0 = attn_scores(kp0, qf);
            bf16x8 p1[2], p0[2];
            attn_weights<false>(s1, R, hf, cl, p1); attn_weights<false>(s0, R, hf, cl, p0);
            attn_pv(vp1, p1, o); attn_pv(vp0, p0, o);
        } else if (rel == 32) {
            const f32x16 s1 = attn_scores(kp1, qf), s0 = attn_scores(kp0, qf);
            bf16x8 p1[2], p0[2];
            attn_weights<true>(s1, R, hf, cl, p1); attn_weights<false>(s0, R, hf, cl, p0);
            attn_pv(vp1, p1, o); attn_pv(vp0, p0, o);
        } else if (rel == 0) {
            const f32x16 s0 = attn_scores(kp0, qf);
            bf16x8 p0[2];
            attn_weights<true>(s0, R, hf, cl, p0);
            attn_pv(vp0, p0, o);
        }
        if (more) { *(LAS v4u*)(nbuf + kl) = st[0]; *(LAS v4u*)(nbuf + kl + 32 * AT_KS) = st[1];
            *(LAS v2u*)(nbuf + vl) = (v2u){st[2].x, st[2].y}; *(LAS v2u*)(nbuf + vl + 8) = (v2u){st[2].z, st[2].w}; *(LAS v2u*)(nbuf + vl + 64 * AT_VS) = (v2u){st[3].x, st[3].y}; *(LAS v2u*)(nbuf + vl + 64 * AT_VS + 8) = (v2u){st[3].z, st[3].w}; }
        __syncthreads();
    }
    bf16* orow = outb + (rb + q0w + cl) * 1024 + h * 128 + 4 * hf;
#pragma unroll
    for (int d = 0; d < 4; ++d)
#pragma unroll
        for (int g = 0; g < 4; ++g) { v2u q; q.x = pk2c(o[d][4 * g], o[d][4 * g + 1]); q.y = pk2c(o[d][4 * g + 2], o[d][4 * g + 3]); *(GAS v2u*)(orow + 32 * d + 8 * g) = q; }
}
__device__ __forceinline__ void hgpost_row(bf16* row, const bf16* grow, const float* w, int lane) {
#pragma unroll
    for (int j = 0; j < 2; ++j) {
        GAS v4u* p = (GAS v4u*)(row + 8 * lane + 512 * j); const v4u x = *p; const v4u gg = *(const GAS v4u*)(grow + 8 * lane + 512 * j);
        float f[8] = {bflo(x.x), bfhi(x.x), bflo(x.y), bfhi(x.y), bflo(x.z), bfhi(x.z), bflo(x.w), bfhi(x.w)};
        const float g[8] = {bflo(gg.x), bfhi(gg.x), bflo(gg.y), bfhi(gg.y), bflo(gg.z), bfhi(gg.z), bflo(gg.w), bfhi(gg.w)};
        float ss = 0.f;
#pragma unroll
        for (int k = 0; k < 8; ++k) ss += f[k] * f[k];
        ss += __shfl_xor(ss, 1); ss += __shfl_xor(ss, 2); ss += __shfl_xor(ss, 4); ss += __shfl_xor(ss, 8);
        const float r = __builtin_amdgcn_rsqf(ss * (1.0f / 128.0f) + EPS);
        const f32x4 wa = *(const GAS f32x4*)(w + ((8 * lane) & 127)), wb = *(const GAS f32x4*)(w + ((8 * lane) & 127) + 4);
        v4u o; o.x = pk2c(f[0] * r * wa.x * g[0], f[1] * r * wa.y * g[1]); o.y = pk2c(f[2] * r * wa.z * g[2], f[3] * r * wa.w * g[3]);
        o.z = pk2c(f[4] * r * wb.x * g[4], f[5] * r * wb.y * g[5]); o.w = pk2c(f[6] * r * wb.z * g[6], f[7] * r * wb.w * g[7]);
        *p = o;
    }
}

template <bool FIRST> struct EpiMerge {
    static constexpr bool PERM = true, AFTER_DRAIN = false;
    const bf16* gate; bf16* merged;
    __device__ __forceinline__ void operator()(const pg8::f32x4 (&acc)[2][2][4][2], const pg8::Unit& u, int wr, int wc, int fr, int fq) const {
        const int row0 = u.pm * 256 + wr * 64 + fr, col0 = u.pn * 256 + wc * 32 + 8 * fq;
#pragma unroll
        for (int ai = 0; ai < 2; ++ai)
#pragma unroll
            for (int m = 0; m < 4; ++m) {
                if ((m & 1) == 0) asm volatile("" ::: "memory");
#pragma unroll
                for (int bj = 0; bj < 2; ++bj) {
                    const size_t off = (size_t)(row0 + ai * 128 + m * 16) * 2048 + col0 + bj * 128;
                    const v4u g = *(const GAS v4u*)(gate + off); const pg8::f32x4 v0 = acc[ai][bj][m][0], v1 = acc[ai][bj][m][1];
                    float r[8] = {bflo(g.x) * v0[0], bfhi(g.x) * v0[1], bflo(g.y) * v0[2], bfhi(g.y) * v0[3], bflo(g.z) * v1[0], bfhi(g.z) * v1[1], bflo(g.w) * v1[2], bfhi(g.w) * v1[3]};
                    if (!FIRST) { const v4u mo = *(const GAS v4u*)(merged + off);
                        r[0] += bflo(mo.x); r[1] += bfhi(mo.x); r[2] += bflo(mo.y); r[3] += bfhi(mo.y); r[4] += bflo(mo.z); r[5] += bfhi(mo.z); r[6] += bflo(mo.w); r[7] += bfhi(mo.w); }
                    v4u w; w.x = pk2c(r[0], r[1]); w.y = pk2c(r[2], r[3]); w.z = pk2c(r[4], r[5]); w.w = pk2c(r[6], r[7]);
                    *(GAS v4u*)(merged + off) = w; }
            }
    }
};
struct EpiStoreBf16 {
    static constexpr bool PERM = true, AFTER_DRAIN = false;
    bf16* out;
    __device__ __forceinline__ void operator()(const pg8::f32x4 (&acc)[2][2][4][2], const pg8::Unit& u, int wr, int wc, int fr, int fq) const {
        const int row0 = u.pm * 256 + wr * 64 + fr, col0 = u.pn * 256 + wc * 32 + 8 * fq;
#pragma unroll
        for (int ai = 0; ai < 2; ++ai)
#pragma unroll
            for (int m = 0; m < 4; ++m)
#pragma unroll
                for (int bj = 0; bj < 2; ++bj) { const pg8::f32x4 v0 = acc[ai][bj][m][0], v1 = acc[ai][bj][m][1];
                    v4u w; w.x = pk2c(v0[0], v0[1]); w.y = pk2c(v0[2], v0[3]); w.z = pk2c(v1[0], v1[1]); w.w = pk2c(v1[2], v1[3]);
                    *(GAS v4u*)(out + (size_t)(row0 + ai * 128 + m * 16) * 2048 + col0 + bj * 128) = w; }
    }
};
struct EpiResid {
    static constexpr bool PERM = false, AFTER_DRAIN = false;
    const float* xin; float* xout;
    __device__ __forceinline__ void operator()(const pg8::f32x4 (&acc)[2][2][4][2], const pg8::Unit& u, int wr, int wc, int fr, int fq) const {
        const int row0 = u.pm * 256 + wr * 64 + fr, col0 = u.pn * 256 + wc * 32 + 4 * fq;
#pragma unroll
        for (int ai = 0; ai < 2; ++ai)
#pragma unroll
            for (int m = 0; m < 4; ++m)
#pragma unroll
                for (int bj = 0; bj < 2; ++bj)
#pragma unroll
                    for (int n = 0; n < 2; ++n) { const size_t off = (size_t)(row0 + ai * 128 + m * 16) * 2048 + col0 + bj * 128 + n * 16;
                        f32x4 r = acc[ai][bj][m][n]; if (xin) r += *(const GAS f32x4*)(xin + off);
                        *(GAS f32x4*)(xout + off) = r; }
    }
};

__device__ __forceinline__ float rl_f(float v, int l) { return __uint_as_float((unsigned)__builtin_amdgcn_readlane((int)__float_as_uint(v), l)); }
__device__ __forceinline__ void ins16(float (&L)[16], float x) {
#pragma unroll
    for (int i = 0; i < 16; ++i) { const float hi = __builtin_fmaxf(L[i], x); x = __builtin_fminf(L[i], x); L[i] = hi; }
}
#define CE_DESC(a, b) do { const float hi_ = __builtin_fmaxf(a, b), lo_ = __builtin_fminf(a, b); a = hi_; b = lo_; } while (0)
__device__ __forceinline__ void sort16_desc(float (&v)[16]) {
#pragma unroll
    for (int k = 2; k <= 16; k <<= 1)
#pragma unroll
        for (int j = k >> 1; j > 0; j >>= 1)
#pragma unroll
            for (int i = 0; i < 16; ++i) { const int l = i ^ j; if (l > i) { if ((i & k) == 0) CE_DESC(v[i], v[l]); else CE_DESC(v[l], v[i]); } }
}
__device__ __forceinline__ void bitonic_merge16_desc(float (&v)[16]) {
#pragma unroll
    for (int j = 8; j > 0; j >>= 1)
#pragma unroll
        for (int i = 0; i < 16; ++i) { const int l = i ^ j; if (l > i) CE_DESC(v[i], v[l]); }
}
__device__ __forceinline__ void top16_merge(float (&L)[16], const float (&T)[16]) {
#pragma unroll
    for (int i = 0; i < 16; ++i) L[i] = __builtin_fmaxf(L[i], T[15 - i]);
    bitonic_merge16_desc(L);
}
__device__ __forceinline__ void peer_top16(const bf16* qrow  , const bf16* kb  , int hf, float (&L)[16]) {
    bf16x8 qf[8];
#pragma unroll
    for (int kk = 0; kk < 8; ++kk) qf[kk] = *(const GAS bf16x8*)(qrow + 16 * kk);
    bf16x8 kn[8];
#pragma unroll
    for (int kk = 0; kk < 8; ++kk) kn[kk] = *(const GAS bf16x8*)(kb + 16 * kk);
#pragma unroll 1
    for (int kt = 0; kt < 4; ++kt) {
        bf16x8 kc[8];
#pragma unroll
        for (int kk = 0; kk < 8; ++kk) kc[kk] = kn[kk];
        if (kt < 3) {
#pragma unroll
            for (int kk = 0; kk < 8; ++kk) kn[kk] = *(const GAS bf16x8*)(kb + (size_t)(kt + 1) * 32 * 128 + 16 * kk);
        }
        f32x16 sa;
#pragma unroll
        for (int r = 0; r < 16; ++r) sa[r] = 0.f;
#pragma unroll
        for (int kk = 0; kk < 8; ++kk) sa = MFMA32(kc[kk], qf[kk], sa);
        float T[16];
#pragma unroll
        for (int r = 0; r < 16; ++r) { const unsigned idx = (unsigned)(kt * 32 + (r & 3) + 8 * (r >> 2) + 4 * hf); T[r] = __uint_as_float((__float_as_uint(sa[r]) & ~127u) | idx); }
        sort16_desc(T);
        if (kt == 0) {
#pragma unroll
            for (int i = 0; i < 16; ++i) L[i] = T[i];
        } else top16_merge(L, T);
    }
    float P[16];
#pragma unroll
    for (int i = 0; i < 16; ++i) P[i] = __shfl_xor(L[i], 32);
    top16_merge(L, P);
}
__device__ __forceinline__ void peer_select32(int item, int lane, const bf16* qpeer, const bf16* KB, int* sel_e, float* sel_g, float* sel_s, LAS unsigned* ldsw) {
    const int hd = item & 7, n0 = (item >> 3) * 32, c = lane & 31, hf = lane >> 5, n = n0 + c;
    const bf16* qrow = qpeer + (size_t)n * 2048 + hd * 256 + 8 * hf;
    float A[16], B[16];
    peer_top16(qrow, KB + (size_t)hd * 16384 + c * 128 + 8 * hf, hf, A);
    peer_top16(qrow + 128, KB + (size_t)(8 + hd) * 16384 + c * 128 + 8 * hf, hf, B);
    float Av[16], Bv[16]; int Ai[16], Bi[16];
#pragma unroll
    for (int i = 0; i < 16; ++i) { const unsigned a = __float_as_uint(A[i]), b = __float_as_uint(B[i]); Av[i] = __uint_as_float(a & ~127u); Bv[i] = __uint_as_float(b & ~127u); Ai[i] = (int)(a & 127u); Bi[i] = (int)(b & 127u); }
    float W[16];
    { float C0[16], C1[16], C2[16], E0 = 0.f, E1 = 0.f; unsigned id = 0;
#pragma unroll
      for (int a = 0; a < 16; ++a)
#pragma unroll
        for (int b = 0; b < 16; ++b) if ((a + 1) * (b + 1) <= 16) { const float pk = __uint_as_float((__float_as_uint(Av[a] + Bv[b]) & ~63u) | id);
            if (id < 16) C0[id] = pk; else if (id < 32) C1[id - 16] = pk; else if (id < 48) C2[id - 32] = pk; else if (id == 48) E0 = pk; else E1 = pk;
            ++id; }
      sort16_desc(C0); sort16_desc(C1); sort16_desc(C2);
      top16_merge(C0, C1); top16_merge(C0, C2);
#pragma unroll
      for (int i = 0; i < 16; ++i) W[i] = C0[i];
      ins16(W, E0); ins16(W, E1); }
    const float thr = W[15], mx = W[0];
    int cnt = 0; float ssum = 0.f;
    LAS int* le = (LAS int*)ldsw + c * 16; LAS float* lg = (LAS float*)ldsw + 512 + c * 16;
    { unsigned id = 0;
#pragma unroll
      for (int a = 0; a < 16; ++a)
#pragma unroll
        for (int b = 0; b < 16; ++b) if ((a + 1) * (b + 1) <= 16) {
            const float cv = Av[a] + Bv[b]; const float pk = __uint_as_float((__float_as_uint(cv) & ~63u) | id); ++id;
            if (pk >= thr) { const float e = __expf(cv - mx); if (hf == 0) { le[cnt] = Ai[a] * 128 + Bi[b]; lg[cnt] = e; } ssum += e; ++cnt; }
        } }
    LDS_WAIT();
    { const int t = lane >> 1, part = lane & 1;
      const v4u e0 = *(const LAS v4u*)((LAS int*)ldsw + t * 16 + 8 * part), e1 = *(const LAS v4u*)((LAS int*)ldsw + t * 16 + 8 * part + 4);
      const v4u g0 = *(const LAS v4u*)((LAS int*)ldsw + 512 + t * 16 + 8 * part), g1 = *(const LAS v4u*)((LAS int*)ldsw + 512 + t * 16 + 8 * part + 4);
      GAS v4u* pe = (GAS v4u*)(sel_e + (size_t)(n0 + t) * 128 + hd * 16 + 8 * part); GAS v4u* pg = (GAS v4u*)(sel_g + (size_t)(n0 + t) * 128 + hd * 16 + 8 * part);
      pe[0] = e0; pe[1] = e1; pg[0] = g0; pg[1] = g1; }
    LDS_WAIT();
    if (hf == 0) ((GAS float*)sel_s)[(size_t)n * 8 + hd] = ssum;
}

__device__ __forceinline__ float dot2bf(unsigned a, unsigned b, float acc) {
    return __builtin_amdgcn_fdot2_f32_bf16(__builtin_bit_cast(bf16v2, a), __builtin_bit_cast(bf16v2, b), acc, false);
}
__device__ __forceinline__ float dot8bf(const v4u a, const v4u b, float acc) {
    const unsigned a0 = a.x, a1 = a.y, a2 = a.z, a3 = a.w, b0 = b.x, b1 = b.y, b2 = b.z, b3 = b.w;
    acc = dot2bf(a0, b0, acc); acc = dot2bf(a1, b1, acc); acc = dot2bf(a2, b2, acc); acc = dot2bf(a3, b3, acc);
    return acc;
}
__device__ __forceinline__ void unpack16(const v4u q, float (&f)[16]) {
    const unsigned d0 = q.x, d1 = q.y, d2 = q.z, d3 = q.w;
    f32x2v t;
    t = __builtin_amdgcn_cvt_pk_f32_fp8((int)d0, false); f[0] = t.x; f[1] = t.y; t = __builtin_amdgcn_cvt_pk_f32_fp8((int)d0, true); f[2] = t.x; f[3] = t.y;
    t = __builtin_amdgcn_cvt_pk_f32_fp8((int)d1, false); f[4] = t.x; f[5] = t.y; t = __builtin_amdgcn_cvt_pk_f32_fp8((int)d1, true); f[6] = t.x; f[7] = t.y;
    t = __builtin_amdgcn_cvt_pk_f32_fp8((int)d2, false); f[8] = t.x; f[9] = t.y; t = __builtin_amdgcn_cvt_pk_f32_fp8((int)d2, true); f[10] = t.x; f[11] = t.y;
    t = __builtin_amdgcn_cvt_pk_f32_fp8((int)d3, false); f[12] = t.x; f[13] = t.y; t = __builtin_amdgcn_cvt_pk_f32_fp8((int)d3, true); f[14] = t.x; f[15] = t.y;
}
struct SliceSched { int mode, xcc, rank, nloc; };
__device__ __forceinline__ SliceSched slice_sched_init(const Ctx& c, unsigned* ctl, const XcdBarrier& bar, int use) {
    LAS int* sh = (LAS int*)(c.lds + 1024);
    if (c.tid == 0) {
        int ok = 1; unsigned tot = 0;
        for (int j = 0; j < 16; ++j) { const unsigned n = xb_ld(&bar.bar[XB_XCNT(j)]); tot += n; if ((j < 8) != (n > 0u)) ok = 0; }
        if (tot != (unsigned)c.G) ok = 0;
        const int xcc = (int)xb_xcc_id();
        int rank = 0, nloc = 1;
        if (ok) { nloc = (int)xb_ld(&bar.bar[XB_XCNT(xcc)]); rank = (int)xb_add(&ctl[CW_RANK + (use * 16 + xcc) * 64], 1u); if (rank >= nloc) ok = 0; }
        sh[0] = ok; sh[1] = xcc; sh[2] = rank; sh[3] = nloc;
    }
    __syncthreads();
    SliceSched S; S.mode = sh[0]; S.xcc = sh[1]; S.rank = sh[2]; S.nloc = sh[3];
    __syncthreads();
    return S;
}
__device__ __forceinline__ bool slice_item(const SliceSched& S, const Ctx& c, int i, int& slice, int& tb) {
    if (S.mode) { const int it = S.rank + i * S.nloc; if (it >= 512) return false; slice = S.xcc + 8 * (it >> 8); tb = it & 255; return true; }
    const int it = (int)blockIdx.x + i * c.G; if (it >= 4096) return false; slice = it >> 8; tb = it & 255; return true;
}
__device__ __forceinline__ void unpack16p(const v4u q, f32x2v (&f)[8]) {
    const unsigned d0 = q.x, d1 = q.y, d2 = q.z, d3 = q.w;
    f[0] = __builtin_amdgcn_cvt_pk_f32_fp8((int)d0, false); f[1] = __builtin_amdgcn_cvt_pk_f32_fp8((int)d0, true);
    f[2] = __builtin_amdgcn_cvt_pk_f32_fp8((int)d1, false); f[3] = __builtin_amdgcn_cvt_pk_f32_fp8((int)d1, true);
    f[4] = __builtin_amdgcn_cvt_pk_f32_fp8((int)d2, false); f[5] = __builtin_amdgcn_cvt_pk_f32_fp8((int)d2, true);
    f[6] = __builtin_amdgcn_cvt_pk_f32_fp8((int)d3, false); f[7] = __builtin_amdgcn_cvt_pk_f32_fp8((int)d3, true);
}
__device__ __forceinline__ void peer_sddmm_wave(int t0, int s, int lane, const bf16* H, const unsigned char* UQ, const int* sel_e, float* part, LAS unsigned* ldsw) {
    const int cg = lane & 7, sg = lane >> 3;
#pragma unroll
    for (int j = 0; j < 4; ++j) *(LAS v4u*)(ldsw + 4 * (lane + 64 * j)) = *(const GAS v4u*)(sel_e + (size_t)t0 * 128 + 4 * (lane + 64 * j));
    LDS_WAIT();
    const unsigned char* ubase = UQ + s * 128 + cg * 16;
    v4u qn[16];
    { int id[16];
#pragma unroll
      for (int q = 0; q < 4; ++q) { const v4u v = *(const LAS v4u*)(ldsw + sg * 16 + 4 * q); id[4 * q] = (int)v.x; id[4 * q + 1] = (int)v.y; id[4 * q + 2] = (int)v.z; id[4 * q + 3] = (int)v.w; }
#pragma unroll
      for (int it = 0; it < 16; ++it) qn[it] = *(const GAS v4u*)(ubase + (size_t)id[it] * 2048); }
    const bf16* hbase = H + (size_t)t0 * 2048 + s * 128 + cg * 16;
    v4u han = *(const GAS v4u*)(hbase), hbn = *(const GAS v4u*)(hbase + 8);
#pragma unroll 1
    for (int k = 0; k < 8; ++k) {
        const int t = t0 + k;
        v4u qc[16];
#pragma unroll
        for (int it = 0; it < 16; ++it) qc[it] = qn[it];
        const v4u ha = han, hb = hbn;
        if (k < 7) { han = *(const GAS v4u*)(hbase + (size_t)(k + 1) * 2048); hbn = *(const GAS v4u*)(hbase + (size_t)(k + 1) * 2048 + 8); }
        if (k < 7) { int id[16];
#pragma unroll
            for (int q = 0; q < 4; ++q) { const v4u v = *(const LAS v4u*)(ldsw + (k + 1) * 128 + sg * 16 + 4 * q); id[4 * q] = (int)v.x; id[4 * q + 1] = (int)v.y; id[4 * q + 2] = (int)v.z; id[4 * q + 3] = (int)v.w; }
#pragma unroll
            for (int it = 0; it < 16; ++it) qn[it] = *(const GAS v4u*)(ubase + (size_t)id[it] * 2048); }
        float h[16] = {bflo(ha.x), bfhi(ha.x), bflo(ha.y), bfhi(ha.y), bflo(ha.z), bfhi(ha.z), bflo(ha.w), bfhi(ha.w), bflo(hb.x), bfhi(hb.x), bflo(hb.y), bfhi(hb.y), bflo(hb.z), bfhi(hb.z), bflo(hb.w), bfhi(hb.w)};
        float hm = 0.f;
#pragma unroll
        for (int j = 0; j < 16; ++j) hm = fmaxf(hm, fabsf(h[j]));
        hm = fmaxf(hm, __shfl_xor(hm, 1)); hm = fmaxf(hm, __shfl_xor(hm, 2)); hm = fmaxf(hm, __shfl_xor(hm, 4));
        const float hinv = hm > 0.f ? 127.0f / hm : 0.f, hs = hm * (1.0f / 127.0f);
        int hq[4];
#pragma unroll
        for (int j = 0; j < 4; ++j) hq[j] = (int)pack_i8x4(h[4 * j] * hinv, h[4 * j + 1] * hinv, h[4 * j + 2] * hinv, h[4 * j + 3] * hinv);
        float p[16];
#pragma unroll
        for (int it = 0; it < 16; ++it) { int a = __builtin_amdgcn_sdot4((int)qc[it].x, hq[0], 0, false); a = __builtin_amdgcn_sdot4((int)qc[it].y, hq[1], a, false);
            a = __builtin_amdgcn_sdot4((int)qc[it].z, hq[2], a, false); a = __builtin_amdgcn_sdot4((int)qc[it].w, hq[3], a, false);
            p[it] = (float)a * hs; }
#pragma unroll
        for (int i = 0; i < 8; ++i) { const bool up = (lane & 4) != 0; const float snd = up ? p[i] : p[i + 8], kp = up ? p[i + 8] : p[i]; p[i] = kp + __shfl_xor(snd, 4); }
#pragma unroll
        for (int i = 0; i < 4; ++i) { const bool up = (lane & 2) != 0; const float snd = up ? p[i] : p[i + 4], kp = up ? p[i + 4] : p[i]; p[i] = kp + __shfl_xor(snd, 2); }
#pragma unroll
        for (int i = 0; i < 2; ++i) { const bool up = (lane & 1) != 0; const float snd = up ? p[i] : p[i + 2], kp = up ? p[i + 2] : p[i]; p[i] = kp + __shfl_xor(snd, 1); }
        ((GAS unsigned*)part)[((size_t)t * 16 + s) * 64 + lane] = pk2c(p[0], p[1]);
    }
    LDS_WAIT();
}
__device__ __forceinline__ void peer_coef_token(int t, int lane, const float* part, const int* sel_e, float* sel_g, const float* sel_s, const float* US, const float* VS) {
    float a0 = 0.f, a1 = 0.f;
#pragma unroll
    for (int s = 0; s < 16; ++s) { const unsigned v = ((const GAS unsigned*)part)[((size_t)t * 16 + s) * 64 + lane]; a0 += bflo(v); a1 += bfhi(v); }
    const v2u e = *(const GAS v2u*)(sel_e + (size_t)t * 128 + 2 * lane);
    const f32x2v g = *(const GAS f32x2v*)(sel_g + (size_t)t * 128 + 2 * lane);
    const float inv = 1.0f / ((const GAS float*)sel_s)[(size_t)t * 8 + (lane >> 3)];
    f32x2v o; o.x = g.x * inv * gelu_exact(a0 * ((const GAS float*)US)[e.x]) * ((const GAS float*)VS)[e.x]; o.y = g.y * inv * gelu_exact(a1 * ((const GAS float*)US)[e.y]) * ((const GAS float*)VS)[e.y];
    const h2_t ha = {(_Float16)o.x, (_Float16)o.x}, hb = {(_Float16)o.y, (_Float16)o.y};
    *(GAS v2u*)(sel_g + (size_t)t * 128 + 2 * lane) = (v2u){__builtin_bit_cast(unsigned, ha), __builtin_bit_cast(unsigned, hb)};
}
__device__ __forceinline__ bool slice_item8(const SliceSched& S, const Ctx& c, int i, int& slice, int& tb) {
    if (S.mode) { const int it = S.rank + i * S.nloc; if (it >= 256) return false; slice = S.xcc; tb = it; return true; }
    const int it = (int)blockIdx.x + i * c.G; if (it >= 2048) return false; slice = it >> 8; tb = it & 255; return true;
}
__device__ __forceinline__ void spmm6_load(const unsigned char* vbase, const LAS unsigned* ids8, v4u (&qa)[8], v2u (&qb)[8]) {
    const v4u i0 = *(const LAS v4u*)(ids8), i1 = *(const LAS v4u*)(ids8 + 4);
    const unsigned id[8] = {i0.x, i0.y, i0.z, i0.w, i1.x, i1.y, i1.z, i1.w};
#pragma unroll
    for (int it = 0; it < 8; ++it) { const unsigned char* p = vbase + (size_t)id[it] * 1536; qa[it] = *(const GAS v4u*)p; qb[it] = *(const GAS v2u*)(p + 16); }
}
__device__ __forceinline__ void spmm6_fma(const v4u (&qa)[8], const v2u (&qb)[8], const LAS unsigned* cf8, h2_t (&y)[16]) {
    const v4u c0 = *(const LAS v4u*)(cf8), c1 = *(const LAS v4u*)(cf8 + 4);
    const unsigned cf[8] = {c0.x, c0.y, c0.z, c0.w, c1.x, c1.y, c1.z, c1.w};
#pragma unroll
    for (int it = 0; it < 8; ++it) { const v6u q = {qa[it].x, qa[it].y, qa[it].z, qa[it].w, qb[it].x, qb[it].y};
        const v32h_t f = __builtin_amdgcn_cvt_scalef32_pk32_f16_fp6(q, 1.0f); const h2_t c2 = __builtin_bit_cast(h2_t, cf[it]);
#pragma unroll
        for (int j = 0; j < 16; ++j) { const h2_t v = {f[2 * j], f[2 * j + 1]}; y[j] = __builtin_elementwise_fma(v, c2, y[j]); } }
}
__device__ __forceinline__ void peer_spmm6_wave(int t0, int s, int lane, const unsigned char* V6, const int* sel_e, const float* coef, const float* x1, float* xout, LAS unsigned* ldsw) {
    const int cg = lane & 7, sg = lane >> 3;
#pragma unroll
    for (int j = 0; j < 4; ++j) { *(LAS v4u*)(ldsw + 4 * (lane + 64 * j)) = *(const GAS v4u*)(sel_e + (size_t)t0 * 128 + 4 * (lane + 64 * j));
        *(LAS v4u*)(ldsw + 1024 + 4 * (lane + 64 * j)) = *(const GAS v4u*)(coef + (size_t)t0 * 128 + 4 * (lane + 64 * j)); }
    LDS_WAIT();
    const unsigned char* vbase = V6 + s * 192 + cg * 24;
    const LAS unsigned* idl = ldsw + sg * 16; const LAS unsigned* cfl = ldsw + 1024 + sg * 16;
    v4u qa0[8], qa1[8]; v2u qb0[8], qb1[8];
    spmm6_load(vbase, idl, qa0, qb0);
    const size_t xoff = (size_t)t0 * 2048 + s * 256 + cg * 32 + 4 * sg;
    f32x4 xn = *(const GAS f32x4*)(x1 + xoff);
#pragma unroll 1
    for (int k = 0; k < 8; ++k) {
        const f32x4 xv = xn;
        h2_t y[16];
#pragma unroll
        for (int j = 0; j < 16; ++j) y[j] = (h2_t){(_Float16)0.f, (_Float16)0.f};
        spmm6_load(vbase, idl + k * 128 + 8, qa1, qb1);
        if (k < 7) xn = *(const GAS f32x4*)(x1 + xoff + (size_t)(k + 1) * 2048);
        spmm6_fma(qa0, qb0, cfl + k * 128, y);
        if (k < 7) spmm6_load(vbase, idl + (k + 1) * 128, qa0, qb0);
        spmm6_fma(qa1, qb1, cfl + k * 128 + 8, y);
        unsigned u[16];
#pragma unroll
        for (int j = 0; j < 16; ++j) u[j] = __builtin_bit_cast(unsigned, y[j]);
#pragma unroll
        for (int i = 0; i < 8; ++i) { const bool up = (lane & 32) != 0; const unsigned snd = up ? u[i] : u[i + 8], kp = up ? u[i + 8] : u[i]; u[i] = __builtin_bit_cast(unsigned, __builtin_bit_cast(h2_t, kp) + __builtin_bit_cast(h2_t, (unsigned)__shfl_xor((int)snd, 32))); }
#pragma unroll
        for (int i = 0; i < 4; ++i) { const bool up = (lane & 16) != 0; const unsigned snd = up ? u[i] : u[i + 4], kp = up ? u[i + 4] : u[i]; u[i] = __builtin_bit_cast(unsigned, __builtin_bit_cast(h2_t, kp) + __builtin_bit_cast(h2_t, (unsigned)__shfl_xor((int)snd, 16))); }
#pragma unroll
        for (int i = 0; i < 2; ++i) { const bool up = (lane & 8) != 0; const unsigned snd = up ? u[i] : u[i + 2], kp = up ? u[i + 2] : u[i]; u[i] = __builtin_bit_cast(unsigned, __builtin_bit_cast(h2_t, kp) + __builtin_bit_cast(h2_t, (unsigned)__shfl_xor((int)snd, 8))); }
        const h2_t r0 = __builtin_bit_cast(h2_t, u[0]), r1 = __builtin_bit_cast(h2_t, u[1]);
        f32x4 o; o.x = xv.x + (float)r0[0]; o.y = xv.y + (float)r0[1]; o.z = xv.z + (float)r1[0]; o.w = xv.w + (float)r1[1];
        *(GAS f32x4*)(xout + xoff + (size_t)k * 2048) = o;
    }
    LDS_WAIT();
}

struct Args { const float* in[21]; float* out; unsigned char* ws; int lo, hi, li, pad; };
__global__ void __launch_bounds__(512, 2) mk_fwd(Args args) {
    extern __shared__ __attribute__((aligned(16))) unsigned char lds_raw[];
    Ctx c; c.lds = (LAS unsigned char*)lds_raw; c.tid = threadIdx.x; c.lane = c.tid & 63; c.wave = __builtin_amdgcn_readfirstlane(c.tid >> 6);
    c.G = gridDim.x; c.gw = blockIdx.x * 8 + c.wave; c.NGW = c.G * 8;
    volatile LAS unsigned* MISC = (volatile LAS unsigned*)(c.lds + MISC_OFF);
    if (c.tid < 32) MISC[c.tid] = 0u;
    __syncthreads();
    unsigned char* ws = args.ws;
    const int lo = args.lo, hi = args.hi;
    XcdBarrier bar; bar.bar = (unsigned*)(ws + WS_CTL) + CW_BAR + args.li * XCD_BAR_WORDS; bar.x = 0; bar.st = nullptr;
    if (hi - lo > 1) bar = xcd_barrier_post((unsigned*)(ws + WS_CTL) + CW_BAR + args.li * XCD_BAR_WORDS, MISC + 8);
#ifndef ATTN_REPS
#define ATTN_REPS 1
#endif
#ifndef PHMASK
#define PHMASK 0x1fff
#endif
#define IN(k) (((PHMASK >> ((k) % NPH)) & 1) && lo <= (k) && (k) < hi)
#define SEAM(k) do { if (IN(k) && IN((k) + 1)) xcd_barrier(bar); } while (0)
#define PH_BEGIN unsigned char* w = ws; float* outp = args.out; Ctx cc = c; int zi = 0; \
    asm volatile("" : "+s"(w), "+s"(outp), "+s"(zi), "+v"(cc.tid), "+v"(cc.lane)); (void)w; (void)outp;
#define INP(k) (args.in[(k) + zi])
#define WSP(T, off) ((T*)(w + (off)))
    for (int l = 0; l < 2; ++l) {
        const int pb = l * NPH;
        if (IN(pb + 0)) { PH_BEGIN
            P0Args a; a.w_in = INP(2) + (size_t)l * DM * INW; a.w_br_sb = INP(11) + (size_t)l * BW * DM; a.w_br_hg = INP(12) + (size_t)l * BW * DM; a.w_br_conv = INP(13) + (size_t)l * BW * DM;
            a.w_o = INP(14) + (size_t)l * DM * DM; a.w_q = INP(16) + (size_t)l * DM * DM; a.u = INP(19) + (size_t)l * 16384 * 2048; a.v = INP(20) + (size_t)l * 16384 * 2048; a.lbp = INP(5);
            a.WinT = WSP(bf16, WS_WIN); a.WbrT = WSP(bf16, WS_WBR); a.WoT = WSP(bf16, WS_WO); a.WqT = WSP(bf16, WS_WQ); a.U = WSP(unsigned char, WS_U); a.V = WSP(unsigned char, WS_V); a.US = WSP(float, WS_US); a.VS = WSP(float, WS_VS); a.LB = WSP(float, WS_LB); a.layer = l; a.k1 = INP(17) + (size_t)l * 8 * 16384; a.k2 = INP(18) + (size_t)l * 8 * 16384; a.KB = WSP(bf16, WS_KEYS);
            p0_convert(cc, a);
            rms_phase_i8(cc, l == 0 ? INP(0) : WSP(const float, WS_X2), INP(1) + (size_t)l * DM, WSP(unsigned char, WS_H), WSP(float, WS_SA));
        }
        SEAM(pb + 0);
        if (IN(pb + 1)) { PH_BEGIN
            pg8::Gemm g{WSP(bf16, WS_H), WSP(bf16, WS_WIN), NTOK, INW, DM}; pg8::StaticOrder S; S.init(NTOK, INW, cc.G, (int)blockIdx.x);
            EpiIn E{WSP(bf16, WS_SEG), WSP(bf16, WS_GATE), WSP(float, WS_LB), WSP(float, WS_SA)};
            pg8::gemm_phase<EpiIn, pg8::StaticOrder, true, true, true>(cc.lds, g, S, E);
        }
        SEAM(pb + 1);
        if (IN(pb + 2)) { PH_BEGIN
            bf16* SEG = WSP(bf16, WS_SEG);
            conv_phase(cc, SEG + 7 * SEGSZ, INP(7) + (size_t)l * 31 * 1024, INP(8) + (size_t)l * 1024, INP(9) + (size_t)l * 1024, INP(10) + (size_t)l * 1024, WSP(bf16, WS_CONV));
            for (int ci = blockIdx.x; ci < 2048; ci += cc.G) hgA_chunk(cc, ci, SEG + 4 * SEGSZ, SEG + 5 * SEGSZ, WSP(bf16, WS_ST), WSP(float, WS_DEC));
            for (int r = cc.gw; r < 2 * NTOK; r += cc.NGW) {
                if (r < NTOK) qknorm_row(SEG + (size_t)r * 1024, INP(3) + (size_t)l * 128, 0.08838834764831845f, cc.lane);
                else qknorm_row(SEG + SEGSZ + (size_t)(r - NTOK) * 1024, INP(4) + (size_t)l * 128, 1.0f, cc.lane);
            }
            LAS unsigned short* scr = (LAS unsigned short*)(cc.lds + 4096 + cc.wave * 8192);
            for (int it = cc.gw; it < 8192; it += cc.NGW) vt_item(it, cc.lane, SEG + 2 * SEGSZ, WSP(bf16, WS_MERGED), scr);
        }
        SEAM(pb + 2);
        if (IN(pb + 3)) { PH_BEGIN
            bf16* SEG = WSP(bf16, WS_SEG);
            hgB(cc, WSP(bf16, WS_ST), WSP(float, WS_DEC));
            for (int rep = 0; rep < ATTN_REPS; ++rep)
            for (int p = blockIdx.x; p < 256; p += cc.G) { const int bh = (p & 7) * 4 + (p >> 6), j = (p >> 3) & 7;
                attn_unit(cc, bh, 15 - j, SEG, SEG + SEGSZ, WSP(bf16, WS_MERGED), SEG + 2 * SEGSZ); attn_unit(cc, bh, j, SEG, SEG + SEGSZ, WSP(bf16, WS_MERGED), SEG + 2 * SEGSZ); }
        }
        SEAM(pb + 3);
        if (IN(pb + 4)) { PH_BEGIN
            bf16* SEG = WSP(bf16, WS_SEG);
            for (int ci = blockIdx.x; ci < 2048; ci += cc.G) hgC_chunk(cc, ci, SEG + 3 * SEGSZ, SEG + 4 * SEGSZ, SEG + 5 * SEGSZ, SEG + 6 * SEGSZ, WSP(bf16, WS_ST), INP(6) + (size_t)l * 128, WSP(bf16, WS_HGR));
        }
        SEAM(pb + 4);
        if (IN(pb + 5)) { PH_BEGIN
            pg8::StaticOrder S; S.init(NTOK, DM, cc.G, (int)blockIdx.x);
            { pg8::Gemm g{WSP(bf16, WS_SEG) + 2 * SEGSZ, WSP(bf16, WS_WBR), NTOK, DM, BW}; EpiMerge<true> E{WSP(bf16, WS_GATE), WSP(bf16, WS_MERGED)}; pg8::gemm_phase<EpiMerge<true>, pg8::StaticOrder, true, true>(cc.lds, g, S, E); }
            { pg8::Gemm g{WSP(bf16, WS_HGR), WSP(bf16, WS_WBR) + (size_t)DM * BW, NTOK, DM, BW}; EpiMerge<false> E{WSP(bf16, WS_GATE) + (size_t)NTOK * 2048, WSP(bf16, WS_MERGED)}; pg8::gemm_phase<EpiMerge<false>, pg8::StaticOrder, true, true>(cc.lds, g, S, E); }
            { pg8::Gemm g{WSP(bf16, WS_CONV), WSP(bf16, WS_WBR) + (size_t)2 * DM * BW, NTOK, DM, BW}; EpiMerge<false> E{WSP(bf16, WS_GATE) + (size_t)2 * NTOK * 2048, WSP(bf16, WS_MERGED)}; pg8::gemm_phase<EpiMerge<false>, pg8::StaticOrder, true, true>(cc.lds, g, S, E); }
        }
        SEAM(pb + 5);
        if (IN(pb + 6)) { PH_BEGIN
            pg8::Gemm g{WSP(bf16, WS_MERGED), WSP(bf16, WS_WO), NTOK, DM, DM}; pg8::StaticOrder S; S.init(NTOK, DM, cc.G, (int)blockIdx.x);
            EpiResid E{l == 0 ? INP(0) : WSP(const float, WS_X2), outp};
            pg8::gemm_phase<EpiResid, pg8::StaticOrder, true, true>(cc.lds, g, S, E);
        }
        SEAM(pb + 6);
        if (IN(pb + 7)) { PH_BEGIN rms_phase(cc, outp, INP(15) + (size_t)l * DM, WSP(bf16, WS_H)); }
        SEAM(pb + 7);
        if (IN(pb + 8)) { PH_BEGIN
            pg8::Gemm g{WSP(bf16, WS_H), WSP(bf16, WS_WQ), NTOK, DM, DM}; pg8::StaticOrder S; S.init(NTOK, DM, cc.G, (int)blockIdx.x);
            EpiStoreBf16 E{WSP(bf16, WS_QPEER)};
            pg8::gemm_phase<EpiStoreBf16, pg8::StaticOrder, true, true>(cc.lds, g, S, E);
        }
        SEAM(pb + 8);
        if (IN(pb + 9)) { PH_BEGIN
            for (int it = cc.gw; it < (NTOK / 32) * 8; it += cc.NGW)
                peer_select32(it, cc.lane, WSP(bf16, WS_QPEER), WSP(bf16, WS_KEYS), WSP(int, WS_SEL), WSP(float, WS_SEL + 8 * MiB), WSP(float, WS_SELS), (LAS unsigned*)(cc.lds + 4096 + cc.wave * 8192));
        }
        SEAM(pb + 9);
        if (IN(pb + 10)) { PH_BEGIN
            const SliceSched SS = slice_sched_init(cc, (unsigned*)(w + WS_CTL), bar, l * 2 + 0);
            for (int i = 0;; ++i) { int sl, tb; if (!slice_item(SS, cc, i, sl, tb)) break;
                peer_sddmm_wave(tb * 64 + cc.wave * 8, sl, cc.lane, WSP(bf16, WS_H), WSP(unsigned char, WS_U), WSP(int, WS_SEL), WSP(float, WS_PART), (LAS unsigned*)(cc.lds + 4096 + cc.wave * 8192)); }
        }
        SEAM(pb + 10);
        if (IN(pb + 11)) { PH_BEGIN
            for (int n = cc.gw; n < NTOK; n += cc.NGW) peer_coef_token(n, cc.lane, WSP(float, WS_PART), WSP(int, WS_SEL), WSP(float, WS_SEL + 8 * MiB), WSP(float, WS_SELS), WSP(float, WS_US), WSP(float, WS_VS));
        }
        SEAM(pb + 11);
        if (IN(pb + 12)) { PH_BEGIN
            float* xo = l == 0 ? WSP(float, WS_X2) : outp;
            const SliceSched SS = slice_sched_init(cc, (unsigned*)(w + WS_CTL), bar, l * 2 + 1);
            for (int i = 0;; ++i) { int sl, tb; if (!slice_item8(SS, cc, i, sl, tb)) break;
                peer_spmm6_wave(tb * 64 + cc.wave * 8, sl, cc.lane, WSP(unsigned char, WS_V), WSP(int, WS_SEL), WSP(float, WS_SEL + 8 * MiB), outp, xo, (LAS unsigned*)(cc.lds + 4096 + cc.wave * 8192)); }
        }
        SEAM(pb + 12);
    }
#undef PH_BEGIN
#undef INP
#undef WSP
#undef IN
#undef SEAM
}

#ifndef MK_SPLIT
#define MK_SPLIT 0
#endif
extern "C" void kernel_launch(void* const* d_in, const int* in_sizes, int n_in, void* d_out, int out_size, void* d_ws, size_t ws_size, hipStream_t stream) {
    static int grid = 0;
    if (grid == 0) {
        if (n_in != 21 || out_size != NTOK * DM || ws_size < WS_END) { fprintf(stderr, "kernel_launch: unexpected shapes (n_in %d, out %d, ws %zu < %zu); nothing launched\n", n_in, out_size, ws_size, (size_t)WS_END); grid = -1; return; }
        int dev = 0, cus = 0, per_cu = 0;
        if (hipGetDevice(&dev) != hipSuccess || hipDeviceGetAttribute(&cus, hipDeviceAttributeMultiprocessorCount, dev) != hipSuccess) { grid = -1; return; }
        if (hipFuncSetAttribute((const void*)mk_fwd, hipFuncAttributeMaxDynamicSharedMemorySize, LDS_BYTES) != hipSuccess) { fprintf(stderr, "kernel_launch: hipFuncSetAttribute failed\n"); grid = -1; return; }
        if (hipOccupancyMaxActiveBlocksPerMultiprocessor(&per_cu, (const void*)mk_fwd, 512, LDS_BYTES) != hipSuccess || per_cu < 1) fprintf(stderr, "kernel_launch: occupancy query reports %d\n", per_cu);
        (void)hipGetLastError();
        grid = cus;
    }
    if (grid < 0) return;
    if (hipMemsetAsync((char*)d_ws + WS_CTL, 0, 1 * MiB, stream) != hipSuccess) { fprintf(stderr, "kernel_launch: memset failed\n"); return; }
    Args a{};
    for (int i = 0; i < 21; ++i) a.in[i] = (const float*)d_in[i];
    a.out = (float*)d_out; a.ws = (unsigned char*)d_ws; a.pad = 0;
#if MK_SPLIT
    for (int p = 0; p < NPHASES; ++p) { a.lo = p; a.hi = p + 1; a.li = p; hipLaunchKernelGGL(mk_fwd, dim3(grid), dim3(512), LDS_BYTES, stream, a); }
#else
    a.lo = 0; a.hi = NPHASES; a.li = 0;
    hipLaunchKernelGGL(mk_fwd, dim3(grid), dim3(512), LDS_BYTES, stream, a);
#endif
    const hipError_t le = hipPeekAtLastError();
    if (le != hipSuccess) fprintf(stderr, "kernel_launch: launch failed: %s\n", hipGetErrorName(le));
}
```

```cpp
#include <hip/hip_runtime.h>
#include <cstdio>
#include <cstdint>
namespace pg8 {
#define PG8_LAS __attribute__((address_space(3)))
typedef unsigned short bf16_t;
typedef short bf16x8 __attribute__((ext_vector_type(8)));
typedef float f32x4 __attribute__((ext_vector_type(4)));
typedef unsigned u32x4 __attribute__((ext_vector_type(4)));
constexpr int BM = 256, BK = 64, HALF = 128, HTB = HALF * BK * 2  , STAGE_BYTES = 8 * HTB, NXCD = 8, WGM = 8;

__host__ __device__ __forceinline__ int lds_byte(int r, int c) { const int st = (r >> 4) * 2 + (c >> 5), rr = r & 15, cc = c & 31, ob = rr * 64 + cc * 2; return st * 1024 + (ob ^ (((ob >> 9) & 1) << 5)); }
__host__ __device__ __forceinline__ void stage_rc(int b, int& R, int& C) { const int st = b / 1024, sb = b % 1024, swz = sb ^ (((sb >> 9) & 1) << 5); R = (st >> 1) * 16 + swz / 64; C = (st & 1) * 32 + (swz % 64) / 2; }
__host__ __device__ __forceinline__ int perm32(int rho) { const int n = rho >> 4, i = rho & 15; return 8 * (i >> 2) + 4 * n + (i & 3); }

struct Unit { int pm, pn; };
struct Gemm { const bf16_t* A; const bf16_t* Bt; int M, N, K; };

struct StaticOrder {
    int nM, nN, nwg, G, c;
    __host__ __device__ void init(int M, int N, int G_, int c_) { nM = M / BM; nN = N / BM; nwg = nM * nN; G = G_; c = c_; }
    __host__ __device__ bool next(int i, Unit& u) const {
        const long L = (long)i * G + c; if (L >= nwg) return false;
        int wgid = (int)L; { const int q = nwg / NXCD, r = nwg % NXCD, xcd = wgid % NXCD, off = wgid / NXCD; wgid = (xcd < r ? xcd * (q + 1) : r * (q + 1) + (xcd - r) * q) + off; }
        const int nig = WGM * nN, gid = wgid / nig, fm = gid * WGM, gsz = (nM - fm) < WGM ? (nM - fm) : WGM;
        u.pm = fm + ((wgid % nig) % gsz); u.pn = (wgid % nig) / gsz; return true;
    }
    __device__ __forceinline__ void a_ready(const Unit&) const {}
    __device__ __forceinline__ void done(const Unit&) const {}
};

typedef float f32x2 __attribute__((ext_vector_type(2)));
template <class Epi, class Sched, bool ALIGN_EPI = false, bool SP2 = false, bool I8 = false>
__device__ __forceinline__ void gemm_phase(PG8_LAS unsigned char* lds, const Gemm g, const Sched& S, const Epi& E, int wave_) {
    unsigned z_ = 0u; asm volatile("" : "+s"(z_)); int tid_ = wave_ * 64 + (int)__builtin_amdgcn_mbcnt_hi(~0u, __builtin_amdgcn_mbcnt_lo(~0u, z_)); asm volatile("" : "+v"(tid_));     int K_ = g.K; asm volatile("" : "+s"(K_));
    const int tid = tid_, wid = __builtin_amdgcn_readfirstlane(tid >> 6), lane = tid & 63, wr = wid >> 2, wc = wid & 3, fr = lane & 15, fq = lane >> 4;
    const int K = I8 ? (K_ >> 1) : K_, nt = K / BK;
    unsigned voffA[2], voffB[2];
#pragma unroll
    for (int i = 0; i < 2; ++i) { int R, C; stage_rc(tid * 16 + i * 8192, R, C); const int Rb = Epi::PERM ? ((R & ~31) + perm32(R & 31)) : R;
        voffA[i] = (unsigned)(R * K + C) * 2u; voffB[i] = (unsigned)(Rb * K + C) * 2u; }
    const size_t kstep = (size_t)(BK * 2);
    const size_t hstep = (size_t)HALF * K * 2;
    const size_t tstep = 2 * hstep;
    const unsigned ldsw = (unsigned)wid * 1024u;
    const int aoff = lds_byte(wr * 64 + fr, fq * 8), boff = lds_byte(wc * 32 + fr, fq * 8);
#define PG8_SA(b, h) (((b) * 2 + (h)) * HTB)
#define PG8_SB(b, h) ((4 + (b) * 2 + (h)) * HTB)
#define PG8_STAGE(bufoff, gbase, voff) do { _Pragma("unroll") for (int _i = 0; _i < 2; ++_i) \
        __builtin_amdgcn_global_load_lds((const unsigned*)((const char*)(gbase) + (voff)[_i]), (PG8_LAS unsigned*)(lds + (bufoff) + ldsw + _i * 8192), 16, 0, 0); } while (0)
#define PG8_LDA(dst, b, h) do { _Pragma("unroll") for (int m = 0; m < 4; ++m) _Pragma("unroll") for (int k = 0; k < 2; ++k) dst[m][k] = *(const PG8_LAS bf16x8*)(lds + PG8_SA(b, h) + aoff + m * 2048 + k * 1024); } while (0)
#define PG8_LDB(dst, b, h) do { _Pragma("unroll") for (int n = 0; n < 2; ++n) _Pragma("unroll") for (int k = 0; k < 2; ++k) dst[n][k] = *(const PG8_LAS bf16x8*)(lds + PG8_SB(b, h) + boff + n * 2048 + k * 1024); } while (0)
#define PG8_MMA(ai, bj, At, Bt) do { __builtin_amdgcn_s_setprio(1); _Pragma("unroll") for (int m = 0; m < 4; ++m) _Pragma("unroll") for (int n = 0; n < 2; ++n) _Pragma("unroll") for (int k = 0; k < 2; ++k) { \
        if constexpr (I8) { typedef int v4i_t __attribute__((ext_vector_type(4))); \
            acc[ai][bj][m][n] = __builtin_bit_cast(f32x4, __builtin_amdgcn_mfma_i32_16x16x64_i8(__builtin_bit_cast(v4i_t, Bt[n][k]), __builtin_bit_cast(v4i_t, At[m][k]), __builtin_bit_cast(v4i_t, acc[ai][bj][m][n]), 0, 0, 0)); } \
        else acc[ai][bj][m][n] = __builtin_amdgcn_mfma_f32_16x16x32_bf16(Bt[n][k], At[m][k], acc[ai][bj][m][n], 0, 0, 0); } __builtin_amdgcn_s_setprio(0); } while (0)
#define PG8_WAIT_V(n) asm volatile("s_waitcnt vmcnt(" #n ")" ::: "memory")
#define PG8_WAIT_L(n) asm volatile("s_waitcnt lgkmcnt(" #n ")" ::: "memory")
#define PG8_BAR __builtin_amdgcn_s_barrier()
#define PG8_SCHED __builtin_amdgcn_sched_barrier(0)
    Unit cur, nxt; int ui = 0;
    if (!S.next(0, cur)) return;
    f32x4 acc[2][2][4][2];
#pragma unroll
    for (int a = 0; a < 2; ++a)
#pragma unroll
        for (int b = 0; b < 2; ++b)
#pragma unroll
            for (int m = 0; m < 4; ++m)
#pragma unroll
                for (int n = 0; n < 2; ++n) acc[a][b][m][n] = (f32x4){0.f, 0.f, 0.f, 0.f};
    bf16x8 At[4][2], B0[2][2], B1[2][2];
    const char* cA = (const char*)g.A + (size_t)cur.pm * tstep; const char* cB = (const char*)g.Bt + (size_t)cur.pn * tstep;
    S.a_ready(cur);
    if constexpr (SP2) {
        PG8_STAGE(PG8_SB(0, 0), cB, voffB); PG8_STAGE(PG8_SB(0, 1), cB + hstep, voffB); PG8_STAGE(PG8_SA(0, 0), cA, voffA); PG8_STAGE(PG8_SA(0, 1), cA + hstep, voffA);
        if (wr == 1) PG8_BAR;
        PG8_WAIT_V(2); PG8_BAR;
        PG8_STAGE(PG8_SB(1, 0), cB + kstep, voffB); PG8_STAGE(PG8_SA(1, 0), cA + kstep, voffA); PG8_STAGE(PG8_SB(1, 1), cB + hstep + kstep, voffB);
        PG8_WAIT_V(6); PG8_BAR;
    } else {
        PG8_STAGE(PG8_SB(0, 0), cB, voffB); PG8_STAGE(PG8_SA(0, 0), cA, voffA); PG8_STAGE(PG8_SB(0, 1), cB + hstep, voffB); PG8_STAGE(PG8_SA(0, 1), cA + hstep, voffA);
        if (wr == 1) PG8_BAR;
        PG8_WAIT_V(4); PG8_BAR;
        PG8_STAGE(PG8_SB(1, 0), cB + kstep, voffB); PG8_STAGE(PG8_SA(1, 0), cA + kstep, voffA); PG8_STAGE(PG8_SB(1, 1), cB + hstep + kstep, voffB);
        PG8_WAIT_V(6); PG8_BAR;
    }
    for (;;) {
        const bool has_next = S.next(ui + 1, nxt);
        const char* nA = has_next ? (const char*)g.A + (size_t)nxt.pm * tstep : cA; const char* nB = has_next ? (const char*)g.Bt + (size_t)nxt.pn * tstep : cB;
        for (int t = 0; t < nt; t += 2) {
            const bool last = (t == nt - 2);
            const char* a1 = cA + (size_t)(t + 1) * kstep;
            const char* a2 = last ? nA : cA + (size_t)(t + 2) * kstep; const char* b2 = last ? nB : cB + (size_t)(t + 2) * kstep;
            const char* a3 = a2 + kstep; const char* b3 = b2 + kstep;
            if (last && has_next) S.a_ready(nxt);
            if constexpr (SP2) {
            PG8_LDB(B0, 0, 0); PG8_LDB(B1, 0, 1); PG8_SCHED; PG8_LDA(At, 0, 0); PG8_STAGE(PG8_SA(1, 1), a1 + hstep, voffA);
            PG8_WAIT_V(8); PG8_WAIT_L(0); PG8_BAR; PG8_MMA(0, 0, At, B0); PG8_MMA(0, 1, At, B1); PG8_BAR; PG8_SCHED;
            PG8_LDA(At, 0, 1); PG8_STAGE(PG8_SB(0, 0), b2, voffB); PG8_STAGE(PG8_SB(0, 1), b2 + hstep, voffB); PG8_STAGE(PG8_SA(0, 0), a2, voffA);
            PG8_WAIT_V(8); PG8_WAIT_L(0); PG8_BAR; PG8_MMA(1, 0, At, B0); PG8_MMA(1, 1, At, B1); PG8_BAR; PG8_SCHED;
            PG8_LDB(B0, 1, 0); PG8_LDB(B1, 1, 1); PG8_SCHED; PG8_LDA(At, 1, 0); PG8_STAGE(PG8_SA(0, 1), a2 + hstep, voffA);
            PG8_WAIT_V(8); PG8_WAIT_L(0); PG8_BAR; PG8_MMA(0, 0, At, B0); PG8_MMA(0, 1, At, B1); PG8_BAR; PG8_SCHED;
            PG8_LDA(At, 1, 1); PG8_STAGE(PG8_SB(1, 0), b3, voffB); PG8_STAGE(PG8_SB(1, 1), b3 + hstep, voffB); PG8_STAGE(PG8_SA(1, 0), a3, voffA);
            PG8_WAIT_V(8); PG8_WAIT_L(0); PG8_BAR; PG8_MMA(1, 0, At, B0); PG8_MMA(1, 1, At, B1); PG8_BAR; PG8_SCHED;
            } else {
            PG8_LDB(B0, 0, 0); PG8_SCHED; PG8_LDA(At, 0, 0); PG8_STAGE(PG8_SA(1, 1), a1 + hstep, voffA);
            PG8_WAIT_L(8); PG8_BAR; PG8_WAIT_L(0); PG8_MMA(0, 0, At, B0); PG8_BAR; PG8_SCHED;
            PG8_LDB(B1, 0, 1); PG8_STAGE(PG8_SB(0, 0), b2, voffB);
            PG8_BAR; PG8_WAIT_L(0); PG8_MMA(0, 1, At, B1); PG8_BAR;
            PG8_LDA(At, 0, 1); PG8_STAGE(PG8_SA(0, 0), a2, voffA);
            PG8_BAR; PG8_WAIT_L(0); PG8_MMA(1, 0, At, B0); PG8_BAR; PG8_SCHED;
            PG8_STAGE(PG8_SB(0, 1), b2 + hstep, voffB);
            PG8_WAIT_V(6); PG8_BAR; PG8_MMA(1, 1, At, B1); PG8_BAR;
            PG8_LDB(B0, 1, 0); PG8_SCHED; PG8_LDA(At, 1, 0); PG8_STAGE(PG8_SA(0, 1), a2 + hstep, voffA);
            PG8_WAIT_L(8); PG8_BAR; PG8_WAIT_L(0); PG8_MMA(0, 0, At, B0); PG8_BAR; PG8_SCHED;
            PG8_LDB(B1, 1, 1); PG8_STAGE(PG8_SB(1, 0), b3, voffB);
            PG8_BAR; PG8_WAIT_L(0); PG8_MMA(0, 1, At, B1); PG8_BAR;
            PG8_LDA(At, 1, 1); PG8_STAGE(PG8_SA(1, 0), a3, voffA);
            PG8_BAR; PG8_WAIT_L(0); PG8_MMA(1, 0, At, B0); PG8_BAR; PG8_SCHED;
            PG8_STAGE(PG8_SB(1, 1), b3 + hstep, voffB);
            PG8_WAIT_V(6); PG8_BAR; PG8_MMA(1, 1, At, B1); PG8_BAR;
            }
        }
        if constexpr (ALIGN_EPI) { if (wr == 0) PG8_BAR; }
        if constexpr (I8) {
#pragma unroll
            for (int a = 0; a < 2; ++a)
#pragma unroll
                for (int m = 0; m < 4; ++m) { const float r_ = E.rowscale(cur.pm * BM + wr * 64 + fr + a * HALF + m * 16);
#pragma unroll
                    for (int b = 0; b < 2; ++b)
#pragma unroll
                        for (int n = 0; n < 2; ++n) { typedef int v4i2_t __attribute__((ext_vector_type(4))); const v4i2_t i_ = __builtin_bit_cast(v4i2_t, acc[a][b][m][n]);
                            acc[a][b][m][n] = (f32x4){(float)i_[0] * r_, (float)i_[1] * r_, (float)i_[2] * r_, (float)i_[3] * r_}; } }
        }
        if constexpr (!Epi::AFTER_DRAIN) { E(acc, cur, wr, wc, fr, fq); S.done(cur); }
        if (!has_next) break;
#pragma unroll
        for (int a = 0; a < 2; ++a)
#pragma unroll
            for (int b = 0; b < 2; ++b)
#pragma unroll
                for (int m = 0; m < 4; ++m)
#pragma unroll
                    for (int n = 0; n < 2; ++n) acc[a][b][m][n] = (f32x4){0.f, 0.f, 0.f, 0.f};
        cur = nxt; cA = nA; cB = nB; ++ui;
        if constexpr (ALIGN_EPI) { if (wr == 1) PG8_BAR; }
    }
    PG8_WAIT_V(0);
    if constexpr (!ALIGN_EPI) { if (wr == 0) PG8_BAR; }
    PG8_BAR;
    if constexpr (Epi::AFTER_DRAIN) { E.fused(acc, cur, wr, wc, fr, fq, lds, wid, lane); S.done(cur); }
#undef PG8_SA
#undef PG8_SB
#undef PG8_STAGE
#undef PG8_LDA
#undef PG8_LDB
#undef PG8_MMA
#undef PG8_WAIT_V
#undef PG8_WAIT_L
#undef PG8_BAR
#undef PG8_SCHED
}
}
#define XB_TMO      128
#define XB_XCNT(j)  (256  + 64 * (j))
#define XB_XSUB(j)  (1280 + 64 * (j))
#define XB_XGEN(j)  (2304 + 64 * (j))
#define XB_TOP      3328
#define XB_TOPGEN   3392
#define XCD_BAR_WORDS 3456
#define XB_SPIN_CAP (1u << 24)
#define LAS __attribute__((address_space(3)))

__device__ __forceinline__ unsigned xb_ld(unsigned* p)              { return __hip_atomic_load(p, __ATOMIC_RELAXED, __HIP_MEMORY_SCOPE_AGENT); }
__device__ __forceinline__ unsigned xb_add(unsigned* p, unsigned v) { return __hip_atomic_fetch_add(p, v, __ATOMIC_RELAXED, __HIP_MEMORY_SCOPE_AGENT); }
__device__ __forceinline__ unsigned xb_xcc_id() { return (unsigned)__builtin_amdgcn_s_getreg((3 << 11) | 20) & 0xFu; }
#define XB_SPIN(cond, bar) do { unsigned _sp = 0; while (cond) { __builtin_amdgcn_s_sleep(1); \
    if ((++_sp & 255u) == 0u) { if (xb_ld(&(bar)[XB_TMO])) break; if (_sp > XB_SPIN_CAP) { atomicAdd(&(bar)[XB_TMO], 1u); break; } } } } while (0)

__device__ __forceinline__ int xb_lane_id() { unsigned z = 0u; asm volatile("" : "+s"(z)); return (int)__builtin_amdgcn_mbcnt_hi(~0u, __builtin_amdgcn_mbcnt_lo(~0u, z)); }
struct XcdBarrier {
    unsigned w0;
    unsigned* bar; unsigned x;
    volatile LAS unsigned* st;
};

__device__ __forceinline__ XcdBarrier xcd_barrier_post(unsigned* bar, volatile LAS unsigned* st) {
    XcdBarrier b; b.bar = bar; b.x = xb_xcc_id(); b.st = st; b.w0 = (__builtin_amdgcn_readfirstlane((int)threadIdx.x >> 6) == 0) ? 1u : 0u;
    if (b.w0 && xb_lane_id() == 0) (void)xb_add(&bar[XB_XCNT(b.x)], 1u);
    return b;
}
__device__ __forceinline__ void xcd_barrier_complete(unsigned* bar, unsigned x, unsigned& nloc, unsigned& nx) {
    const unsigned G = gridDim.x * gridDim.y * gridDim.z;
    unsigned sum, cnt, mine, sp = 0u;
    for (;;) {
        sum = 0u; cnt = 0u; mine = 0u;
#pragma unroll
        for (unsigned j = 0; j < 16; ++j) { const unsigned c = xb_ld(&bar[XB_XCNT(j)]); sum += c; cnt += (c > 0u) ? 1u : 0u; mine = (j == x) ? c : mine; }
        if (sum == G) break;
        __builtin_amdgcn_s_sleep(1);
        if ((++sp & 255u) == 0u) { if (xb_ld(&bar[XB_TMO])) break; if (sp > XB_SPIN_CAP) { atomicAdd(&bar[XB_TMO], 1u); break; } }
    }
    nloc = mine > 0u ? mine : 1u; nx = cnt > 0u ? cnt : 1u;
}

__device__ __forceinline__ void xcd_barrier(const XcdBarrier& b) {
    asm volatile("s_waitcnt vmcnt(0)" ::: "memory");
    __syncthreads();
    if (b.w0 && xb_lane_id() == 0) {
        unsigned* bar = b.bar;
        __builtin_amdgcn_s_waitcnt(0);
        unsigned nloc = b.st[0], nx = b.st[1];
        if (nloc == 0u) { xcd_barrier_complete(bar, b.x, nloc, nx); b.st[0] = nloc; b.st[1] = nx; }
        const unsigned old = xb_add(&bar[XB_XSUB(b.x)], 1u);
        const unsigned gen = old / nloc;
        if (old + 1u == (gen + 1u) * nloc) {
            __builtin_amdgcn_fence(__ATOMIC_RELEASE, "agent");
            asm volatile("s_waitcnt vmcnt(0)" ::: "memory");
            const unsigned og = xb_add(&bar[XB_TOP], 1u);
            const unsigned tg = og / nx;
            if (og + 1u == (tg + 1u) * nx) xb_add(&bar[XB_TOPGEN], 1u);
            else XB_SPIN(xb_ld(&bar[XB_TOPGEN]) == tg, bar);
            __builtin_amdgcn_fence(__ATOMIC_ACQUIRE, "agent");
            xb_add(&bar[XB_XGEN(b.x)], 1u);
            asm volatile("s_waitcnt vmcnt(0)" ::: "memory");
        } else {
            XB_SPIN(xb_ld(&bar[XB_XGEN(b.x)]) == gen, bar);
            __builtin_amdgcn_fence(__ATOMIC_ACQUIRE, "agent");
            asm volatile("s_waitcnt vmcnt(0)" ::: "memory");
        }
    }
    __syncthreads();
}


#define GAS __attribute__((address_space(1)))
typedef unsigned short bf16;
typedef unsigned v4u __attribute__((ext_vector_type(4)));
typedef unsigned v2u __attribute__((ext_vector_type(2)));
typedef float f32x4 __attribute__((ext_vector_type(4)));
typedef float f32x2v __attribute__((ext_vector_type(2)));
typedef float f32x16 __attribute__((ext_vector_type(16)));
typedef short bf16x8 __attribute__((ext_vector_type(8)));
typedef __bf16 bf16v2 __attribute__((ext_vector_type(2)));
typedef _Float16 h2_t __attribute__((ext_vector_type(2)));
typedef _Float16 v32h_t __attribute__((ext_vector_type(32)));
typedef unsigned v6u __attribute__((ext_vector_type(6)));

constexpr int NTOK = 16384, DM = 2048, SEQ = 4096, INW = 15360, BW = 1024;
constexpr float EPS = 1e-6f;
constexpr float WIN_QS = 1024.0f;
constexpr int NPH = 13;
constexpr int NPHASES = 2 * NPH;

constexpr size_t MiB = 1u << 20;
constexpr size_t WS_CTL = 0;
constexpr size_t WS_LB = 1 * MiB;
constexpr size_t WS_SA = 1 * MiB + 192 * 1024;
constexpr size_t WS_US = 1 * MiB + 64 * 1024, WS_VS = 1 * MiB + 128 * 1024;
constexpr size_t WS_WIN = 2 * MiB;
constexpr size_t WS_WBR = 62 * MiB;
constexpr size_t WS_WO = 74 * MiB;
constexpr size_t WS_WQ = 82 * MiB;
constexpr size_t WS_U = 91 * MiB;
constexpr size_t WS_V = 155 * MiB;
constexpr size_t WS_H = 219 * MiB;
constexpr size_t WS_SEG = 283 * MiB;
constexpr size_t WS_GATE = 539 * MiB;
constexpr size_t WS_X2 = 731 * MiB;
constexpr size_t WS_CONV = 859 * MiB;
constexpr size_t WS_HGR = 891 * MiB;
constexpr size_t WS_MERGED = 923 * MiB;
constexpr size_t WS_SEL = 987 * MiB;
constexpr size_t WS_SELS = 1003 * MiB;
constexpr size_t WS_DEC = 1004 * MiB;
constexpr size_t WS_END = 1005 * MiB;
constexpr size_t WS_ST = WS_H;
constexpr size_t WS_KEYS = 90 * MiB;
constexpr size_t WS_PART = WS_GATE;
constexpr size_t WS_QPEER = WS_SEG;
constexpr size_t SEGSZ = (size_t)NTOK * 1024;
constexpr int CW_BAR = 4096;
constexpr int CW_RANK = 131072;

constexpr int RING_BYTES = 131072, MISC_OFF = RING_BYTES + 320, LDS_BYTES = 147456;

__device__ __forceinline__ unsigned pk2c(float lo, float hi) { f32x2v v = {lo, hi}; bf16v2 b = __builtin_convertvector(v, bf16v2); return __builtin_bit_cast(unsigned, b); }
__device__ __forceinline__ float bflo(unsigned x) { return __uint_as_float(x << 16); }
__device__ __forceinline__ float bfhi(unsigned x) { return __uint_as_float(x & 0xffff0000u); }
__device__ __forceinline__ float sigm(float x) { return __builtin_amdgcn_rcpf(1.0f + __expf(-x)); }
__device__ __forceinline__ float wave_sum(float v) {
#pragma unroll
    for (int o = 1; o < 64; o <<= 1) v += __shfl_xor(v, o);
    return v;
}
__device__ __forceinline__ float wave_max(float v) {
#pragma unroll
    for (int o = 1; o < 64; o <<= 1) v = fmaxf(v, __shfl_xor(v, o));
    return v;
}
#define LDS_WAIT() asm volatile("s_waitcnt lgkmcnt(0)" ::: "memory")
#define MFMA32(a, b, c) __builtin_amdgcn_mfma_f32_32x32x16_bf16((a), (b), (c), 0, 0, 0)
__device__ __forceinline__ int ridx16(int lane) { return ((lane >> 5) & 1) * 8 + ((lane >> 4) & 1) * 4 + ((lane >> 3) & 1) * 2 + ((lane >> 2) & 1); }
__device__ __forceinline__ void xreduce16(float (&v)[16], int lane) {
#pragma unroll
    for (int i = 0; i < 8; ++i) { const bool up = (lane & 32) != 0; const float snd = up ? v[i] : v[i + 8], kp = up ? v[i + 8] : v[i]; v[i] = kp + __shfl_xor(snd, 32); }
#pragma unroll
    for (int i = 0; i < 4; ++i) { const bool up = (lane & 16) != 0; const float snd = up ? v[i] : v[i + 4], kp = up ? v[i + 4] : v[i]; v[i] = kp + __shfl_xor(snd, 16); }
#pragma unroll
    for (int i = 0; i < 2; ++i) { const bool up = (lane & 8) != 0; const float snd = up ? v[i] : v[i + 2], kp = up ? v[i + 2] : v[i]; v[i] = kp + __shfl_xor(snd, 8); }
    { const bool up = (lane & 4) != 0; const float snd = up ? v[0] : v[1], kp = up ? v[1] : v[0]; v[0] = kp + __shfl_xor(snd, 4); }
    v[0] += __shfl_xor(v[0], 2); v[0] += __shfl_xor(v[0], 1);
}
__device__ __forceinline__ float gelu_exact(float v) {
    const float av = fabsf(v), t = __builtin_amdgcn_rcpf(av * 0.2316418882f + 1.0f);
    float q = t * 0.5307027145f + (-0.7265760135f); q = q * t + 0.7107068705f; q = q * t + (-0.142248368f); q = q * t + 0.127414796f; q = q * t;
    const float e = __builtin_amdgcn_exp2f((v * v) * (-0.72134752044f));
    const float m = v * (q * e);
    return v < 0.f ? m : v - m;
}

struct Ctx { LAS unsigned char* lds; int tid, lane, wave, G, gw, NGW; };

__device__ __forceinline__ void tr_item(const float* W, int K, int N, bf16* WT, int k0, int n0, int drow0, LAS float* scr, int lane) {
#pragma unroll 8
    for (int i = 0; i < 32; ++i) { const int kk = 2 * i + (lane >> 5); scr[kk * 33 + (lane & 31)] = ((const GAS float*)W)[(size_t)(k0 + kk) * N + n0 + (lane & 31)]; }
    LDS_WAIT();
    const int c = lane & 7;
#pragma unroll
    for (int j = 0; j < 4; ++j) { const int n = (lane >> 3) + 8 * j; const LAS float* s = scr + (8 * c) * 33 + n;
        v4u o; o.x = pk2c(s[0], s[33]); o.y = pk2c(s[66], s[99]); o.z = pk2c(s[132], s[165]); o.w = pk2c(s[198], s[231]);
        *(GAS v4u*)(WT + (size_t)(drow0 + n) * K + k0 + 8 * c) = o; }
    LDS_WAIT();
}
__device__ __forceinline__ unsigned pack_i8x4c(float a, float b, float c, float d) {
    const int ia = (int)__builtin_rintf(fminf(fmaxf(a, -127.f), 127.f)), ib = (int)__builtin_rintf(fminf(fmaxf(b, -127.f), 127.f)), ic = (int)__builtin_rintf(fminf(fmaxf(c, -127.f), 127.f)), id = (int)__builtin_rintf(fminf(fmaxf(d, -127.f), 127.f));
    return ((unsigned)ia & 255u) | (((unsigned)ib & 255u) << 8) | (((unsigned)ic & 255u) << 16) | ((unsigned)id << 24);
}
__device__ __forceinline__ void tr_item_i8(const float* W, int K, int N, unsigned char* WT, int k0, int n0, int drow0, float scale, LAS float* scr, int lane) {
#pragma unroll 8
    for (int i = 0; i < 32; ++i) { const int kk = 2 * i + (lane >> 5); scr[kk * 33 + (lane & 31)] = ((const GAS float*)W)[(size_t)(k0 + kk) * N + n0 + (lane & 31)]; }
    LDS_WAIT();
    const int c = lane & 7;
#pragma unroll
    for (int j = 0; j < 4; ++j) { const int n = (lane >> 3) + 8 * j; const LAS float* s = scr + (8 * c) * 33 + n;
        v2u o; o.x = pack_i8x4c(s[0] * scale, s[33] * scale, s[66] * scale, s[99] * scale); o.y = pack_i8x4c(s[132] * scale, s[165] * scale, s[198] * scale, s[231] * scale);
        *(GAS v2u*)(WT + (size_t)(drow0 + n) * K + k0 + 8 * c) = o; }
    LDS_WAIT();
}
__device__ __forceinline__ int win_drow(int n) { if (n < 7168 || n >= 9216) return n; const int r = n - 7168, isb = r >> 10, c = r & 1023; return 7168 + (c >> 7) * 256 + isb * 128 + (c & 127); }
__device__ __forceinline__ void cvt_copy(const Ctx& c, const float* src, bf16* dst, size_t n8) {
    const size_t NT = (size_t)c.G * 512;
    for (size_t i = (size_t)blockIdx.x * 512 + c.tid; i < n8; i += NT) {
        const f32x4 a = ((const GAS f32x4*)src)[2 * i], b = ((const GAS f32x4*)src)[2 * i + 1];
        v4u o; o.x = pk2c(a.x, a.y); o.y = pk2c(a.z, a.w); o.z = pk2c(b.x, b.y); o.w = pk2c(b.z, b.w);
        ((GAS v4u*)dst)[i] = o;
    }
}
__device__ __forceinline__ void rms_row(const float* xr, const float* w, bf16* o, int lane) {
    const GAS f32x4* xp = (const GAS f32x4*)xr + lane; f32x4 v[8]; float s = 0.f;
#pragma unroll
    for (int j = 0; j < 8; ++j) { v[j] = xp[64 * j]; s += (v[j].x * v[j].x + v[j].y * v[j].y) + (v[j].z * v[j].z + v[j].w * v[j].w); }
    const float r = __builtin_amdgcn_rsqf(wave_sum(s) * (1.0f / DM) + EPS);
    const GAS f32x4* wp = (const GAS f32x4*)w + lane; GAS v2u* op = (GAS v2u*)o + lane;
#pragma unroll
    for (int j = 0; j < 8; ++j) { const f32x4 wv = wp[64 * j]; v2u q; q.x = pk2c(v[j].x * r * wv.x, v[j].y * r * wv.y); q.y = pk2c(v[j].z * r * wv.z, v[j].w * r * wv.w); op[64 * j] = q; }
}
__device__ __forceinline__ void rms_row_i8(const float* xr, const float* w, unsigned char* o, float* sa, int lane) {
    const GAS f32x4* xp = (const GAS f32x4*)xr + lane; f32x4 v[8]; float s = 0.f;
#pragma unroll
    for (int j = 0; j < 8; ++j) { v[j] = xp[64 * j]; s += (v[j].x * v[j].x + v[j].y * v[j].y) + (v[j].z * v[j].z + v[j].w * v[j].w); }
    const float r = __builtin_amdgcn_rsqf(wave_sum(s) * (1.0f / DM) + EPS);
    const GAS f32x4* wp = (const GAS f32x4*)w + lane; float m = 0.f;
#pragma unroll
    for (int j = 0; j < 8; ++j) { const f32x4 wv = wp[64 * j]; v[j].x *= r * wv.x; v[j].y *= r * wv.y; v[j].z *= r * wv.z; v[j].w *= r * wv.w;
        m = fmaxf(fmaxf(m, fmaxf(fabsf(v[j].x), fabsf(v[j].y))), fmaxf(fabsf(v[j].z), fabsf(v[j].w))); }
    m = wave_max(m);
    const float inv = m > 0.f ? 127.0f / m : 0.f;
    if (lane == 0) *(GAS float*)sa = m * (1.0f / 127.0f);
#pragma unroll
    for (int j = 0; j < 8; ++j) ((GAS unsigned*)o)[lane + 64 * j] = pack_i8x4c(v[j].x * inv, v[j].y * inv, v[j].z * inv, v[j].w * inv);
}
__device__ __forceinline__ void rms_rows2_i8(const float* xa, const float* xb, const float* w, unsigned char* oa, unsigned char* ob, float* saa, float* sab, int lane) {
    const GAS f32x4* pa = (const GAS f32x4*)xa + lane; const GAS f32x4* pb = (const GAS f32x4*)xb + lane; f32x4 va[8], vb[8]; float s0 = 0.f, s1 = 0.f;
#pragma unroll
    for (int j = 0; j < 8; ++j) { va[j] = pa[64 * j]; vb[j] = pb[64 * j]; }
#pragma unroll
    for (int j = 0; j < 8; ++j) { s0 += (va[j].x * va[j].x + va[j].y * va[j].y) + (va[j].z * va[j].z + va[j].w * va[j].w); s1 += (vb[j].x * vb[j].x + vb[j].y * vb[j].y) + (vb[j].z * vb[j].z + vb[j].w * vb[j].w); }
#pragma unroll
    for (int o = 1; o < 64; o <<= 1) { s0 += __shfl_xor(s0, o); s1 += __shfl_xor(s1, o); }
    const float r0 = __builtin_amdgcn_rsqf(s0 * (1.0f / DM) + EPS), r1 = __builtin_amdgcn_rsqf(s1 * (1.0f / DM) + EPS);
    const GAS f32x4* wp = (const GAS f32x4*)w + lane; float m0 = 0.f, m1 = 0.f;
#pragma unroll
    for (int j = 0; j < 8; ++j) { const f32x4 wv = wp[64 * j];
        va[j].x *= r0 * wv.x; va[j].y *= r0 * wv.y; va[j].z *= r0 * wv.z; va[j].w *= r0 * wv.w; vb[j].x *= r1 * wv.x; vb[j].y *= r1 * wv.y; vb[j].z *= r1 * wv.z; vb[j].w *= r1 * wv.w;
        m0 = fmaxf(fmaxf(m0, fmaxf(fabsf(va[j].x), fabsf(va[j].y))), fmaxf(fabsf(va[j].z), fabsf(va[j].w))); m1 = fmaxf(fmaxf(m1, fmaxf(fabsf(vb[j].x), fabsf(vb[j].y))), fmaxf(fabsf(vb[j].z), fabsf(vb[j].w))); }
#pragma unroll
    for (int o = 1; o < 64; o <<= 1) { m0 = fmaxf(m0, __shfl_xor(m0, o)); m1 = fmaxf(m1, __shfl_xor(m1, o)); }
    const float i0 = m0 > 0.f ? 127.0f / m0 : 0.f, i1 = m1 > 0.f ? 127.0f / m1 : 0.f;
    if (lane == 0) { *(GAS float*)saa = m0 * (1.0f / 127.0f); *(GAS float*)sab = m1 * (1.0f / 127.0f); }
#pragma unroll
    for (int j = 0; j < 8; ++j) { ((GAS unsigned*)oa)[lane + 64 * j] = pack_i8x4c(va[j].x * i0, va[j].y * i0, va[j].z * i0, va[j].w * i0); ((GAS unsigned*)ob)[lane + 64 * j] = pack_i8x4c(vb[j].x * i1, vb[j].y * i1, vb[j].z * i1, vb[j].w * i1); }
}
__device__ __forceinline__ void rms_phase_i8(const Ctx& c, const float* x, const float* w, unsigned char* H8, float* SA) {
    for (int m = c.gw; m < NTOK / 2; m += c.NGW) rms_rows2_i8(x + (size_t)m * DM, x + (size_t)(m + NTOK / 2) * DM, w, H8 + (size_t)m * DM, H8 + (size_t)(m + NTOK / 2) * DM, SA + m, SA + m + NTOK / 2, c.lane);
}
__device__ __forceinline__ void rms_rows2(const float* xa, const float* xb, const float* w, bf16* oa, bf16* ob, int lane) {
    const GAS f32x4* pa = (const GAS f32x4*)xa + lane; const GAS f32x4* pb = (const GAS f32x4*)xb + lane; f32x4 va[8], vb[8]; float sa = 0.f, sb = 0.f;
#pragma unroll
    for (int j = 0; j < 8; ++j) { va[j] = pa[64 * j]; vb[j] = pb[64 * j]; }
#pragma unroll
    for (int j = 0; j < 8; ++j) { sa += (va[j].x * va[j].x + va[j].y * va[j].y) + (va[j].z * va[j].z + va[j].w * va[j].w); sb += (vb[j].x * vb[j].x + vb[j].y * vb[j].y) + (vb[j].z * vb[j].z + vb[j].w * vb[j].w); }
#pragma unroll
    for (int o = 1; o < 64; o <<= 1) { sa += __shfl_xor(sa, o); sb += __shfl_xor(sb, o); }
    const float ra = __builtin_amdgcn_rsqf(sa * (1.0f / DM) + EPS), rb = __builtin_amdgcn_rsqf(sb * (1.0f / DM) + EPS);
    const GAS f32x4* wp = (const GAS f32x4*)w + lane; GAS v2u* qa = (GAS v2u*)oa + lane; GAS v2u* qb = (GAS v2u*)ob + lane;
#pragma unroll
    for (int j = 0; j < 8; ++j) { const f32x4 wv = wp[64 * j];
        v2u q; q.x = pk2c(va[j].x * ra * wv.x, va[j].y * ra * wv.y); q.y = pk2c(va[j].z * ra * wv.z, va[j].w * ra * wv.w); qa[64 * j] = q;
        v2u p; p.x = pk2c(vb[j].x * rb * wv.x, vb[j].y * rb * wv.y); p.y = pk2c(vb[j].z * rb * wv.z, vb[j].w * rb * wv.w); qb[64 * j] = p; }
}
__device__ __forceinline__ void rms_phase(const Ctx& c, const float* x, const float* w, bf16* H) {
    for (int m = c.gw; m < NTOK / 2; m += c.NGW) rms_rows2(x + (size_t)m * DM, x + (size_t)(m + NTOK / 2) * DM, w, H + (size_t)m * DM, H + (size_t)(m + NTOK / 2) * DM, c.lane);
}
__device__ __forceinline__ void fp8_row(const float* src, unsigned char* dst, float* scale_out, int lane) {
    const GAS f32x4* xp = (const GAS f32x4*)src + lane; f32x4 v[8]; float m = 0.f;
#pragma unroll
    for (int j = 0; j < 8; ++j) { v[j] = xp[64 * j]; m = fmaxf(fmaxf(m, fmaxf(fabsf(v[j].x), fabsf(v[j].y))), fmaxf(fabsf(v[j].z), fabsf(v[j].w))); }
    m = wave_max(m);
    const float inv = m > 0.f ? 256.0f / m : 0.f;
    if (lane == 0) *(GAS float*)scale_out = m * (1.0f / 256.0f);
#pragma unroll
    for (int j = 0; j < 8; ++j) { int p = __builtin_amdgcn_cvt_pk_fp8_f32(v[j].x * inv, v[j].y * inv, 0, false); p = __builtin_amdgcn_cvt_pk_fp8_f32(v[j].z * inv, v[j].w * inv, p, true);
        ((GAS unsigned*)dst)[lane + 64 * j] = (unsigned)p; }
}
__device__ __forceinline__ unsigned pack_i8x4(float a, float b, float c, float d) {
    const int ia = (int)__builtin_rintf(a), ib = (int)__builtin_rintf(b), ic = (int)__builtin_rintf(c), id = (int)__builtin_rintf(d);
    return ((unsigned)ia & 255u) | (((unsigned)ib & 255u) << 8) | (((unsigned)ic & 255u) << 16) | ((unsigned)id << 24);
}
__device__ __forceinline__ void i8_row(const float* src, unsigned char* dst, float* scale_out, int lane) {
    const GAS f32x4* xp = (const GAS f32x4*)src + lane; f32x4 v[8]; float m = 0.f;
#pragma unroll
    for (int j = 0; j < 8; ++j) { v[j] = xp[64 * j]; m = fmaxf(fmaxf(m, fmaxf(fabsf(v[j].x), fabsf(v[j].y))), fmaxf(fabsf(v[j].z), fabsf(v[j].w))); }
    m = wave_max(m);
    const float inv = m > 0.f ? 127.0f / m : 0.f;
    if (lane == 0) *(GAS float*)scale_out = m * (1.0f / 127.0f);
#pragma unroll
    for (int j = 0; j < 8; ++j) ((GAS unsigned*)dst)[lane + 64 * j] = pack_i8x4(v[j].x * inv, v[j].y * inv, v[j].z * inv, v[j].w * inv);
}
__device__ __forceinline__ void fp6_row(const float* src, unsigned char* dst, float* scale_out, int lane) {
    const GAS f32x4* xp = (const GAS f32x4*)src + 8 * lane; f32x4 v[8]; float m = 0.f;
#pragma unroll
    for (int j = 0; j < 8; ++j) { v[j] = xp[j]; m = fmaxf(fmaxf(m, fmaxf(fabsf(v[j].x), fabsf(v[j].y))), fmaxf(fabsf(v[j].z), fabsf(v[j].w))); }
    m = wave_max(m);
    const float inv = m > 0.f ? 7.5f / m : 0.f;
    if (lane == 0) *(GAS float*)scale_out = m * (1.0f / 7.5f);
    v32h_t h;
#pragma unroll
    for (int j = 0; j < 8; ++j) { h[4 * j] = (_Float16)(v[j].x * inv); h[4 * j + 1] = (_Float16)(v[j].y * inv); h[4 * j + 2] = (_Float16)(v[j].z * inv); h[4 * j + 3] = (_Float16)(v[j].w * inv); }
    const v6u q = __builtin_amdgcn_cvt_scalef32_pk32_fp6_f16(h, 1.0f);
    GAS v2u* o = (GAS v2u*)(dst + 24 * lane);
    o[0] = (v2u){q[0], q[1]}; o[1] = (v2u){q[2], q[3]}; o[2] = (v2u){q[4], q[5]};
}
struct P0Args { const float *w_in, *w_br_sb, *w_br_hg, *w_br_conv, *w_o, *w_q, *u, *v, *lbp; bf16 *WinT, *WbrT, *WoT, *WqT; unsigned char *U, *V; float *US, *VS; float* LB; int layer; const float *k1, *k2; bf16* KB; };
__device__ __forceinline__ void p0_convert(const Ctx& c, const P0Args& a) {
    LAS float* scr = (LAS float*)(c.lds + c.wave * 16384);
    constexpr int I_IN = (DM / 64) * (INW / 32), I_BR = (BW / 64) * (DM / 32), I_SQ = (DM / 64) * (DM / 32);
    constexpr int NITEMS = I_IN + 3 * I_BR + 2 * I_SQ;
    for (int it = c.gw; it < NITEMS; it += c.NGW) {
        int r = it;
        if (r < I_IN) { const int kb = r / (INW / 32), nb = r % (INW / 32); tr_item_i8(a.w_in, DM, INW, (unsigned char*)a.WinT, kb * 64, nb * 32, win_drow(nb * 32), WIN_QS, scr, c.lane); continue; } r -= I_IN;
        if (r < I_BR) { const int kb = r / (DM / 32), nb = r % (DM / 32); tr_item(a.w_br_sb, BW, DM, a.WbrT, kb * 64, nb * 32, nb * 32, scr, c.lane); continue; } r -= I_BR;
        if (r < I_BR) { const int kb = r / (DM / 32), nb = r % (DM / 32); tr_item(a.w_br_hg, BW, DM, a.WbrT + (size_t)DM * BW, kb * 64, nb * 32, nb * 32, scr, c.lane); continue; } r -= I_BR;
        if (r < I_BR) { const int kb = r / (DM / 32), nb = r % (DM / 32); tr_item(a.w_br_conv, BW, DM, a.WbrT + (size_t)2 * DM * BW, kb * 64, nb * 32, nb * 32, scr, c.lane); continue; } r -= I_BR;
        if (r < I_SQ) { const int kb = r / (DM / 32), nb = r % (DM / 32); tr_item(a.w_o, DM, DM, a.WoT, kb * 64, nb * 32, nb * 32, scr, c.lane); continue; } r -= I_SQ;
        { const int kb = r / (DM / 32), nb = r % (DM / 32); tr_item(a.w_q, DM, DM, a.WqT, kb * 64, nb * 32, nb * 32, scr, c.lane); }
    }
    for (int r = c.gw; r < 2 * 16384; r += c.NGW) {
        if (r < 16384) i8_row(a.u + (size_t)r * 2048, a.U + (size_t)r * 2048, a.US + r, c.lane);
        else fp6_row(a.v + (size_t)(r - 16384) * 2048, a.V + (size_t)(r - 16384) * 1536, a.VS + (r - 16384), c.lane);
    }
    cvt_copy(c, a.k1, a.KB, (size_t)8 * 16384 / 8);
    cvt_copy(c, a.k2, a.KB + 8 * 16384, (size_t)8 * 16384 / 8);
    if (blockIdx.x == 0) for (int i = c.tid; i < 1024; i += 512) a.LB[i] = a.layer == 0 ? 0.f : sigm(a.lbp[1024 + i] - a.lbp[i]);
}

struct EpiIn {
    static constexpr bool PERM = true, AFTER_DRAIN = false;
    bf16* seg; bf16* gate; const float* lb; const float* sa;
    __device__ __forceinline__ float rowscale(int row) const { return ((const GAS float*)sa)[row] * (1.0f / WIN_QS); }
    __device__ __forceinline__ void operator()(const pg8::f32x4 (&acc)[2][2][4][2], const pg8::Unit& u, int wr, int wc, int fr, int fq) const {
        const int pn = u.pn; const int row0 = u.pm * 256 + wr * 64 + fr;
        if (pn >= 28 && pn < 36) {
            bf16* dst = seg + (size_t)7 * SEGSZ; const int col0 = (pn - 28) * 128 + wc * 32 + 8 * fq;
#pragma unroll
            for (int ai = 0; ai < 2; ++ai)
#pragma unroll
                for (int m = 0; m < 4; ++m) {
                    const pg8::f32x4 a0 = acc[ai][0][m][0], a1 = acc[ai][0][m][1], b0 = acc[ai][1][m][0], b1 = acc[ai][1][m][1];
                    v4u w; w.x = pk2c(a0[0] * sigm(b0[0]), a0[1] * sigm(b0[1])); w.y = pk2c(a0[2] * sigm(b0[2]), a0[3] * sigm(b0[3]));
                    w.z = pk2c(a1[0] * sigm(b1[0]), a1[1] * sigm(b1[1])); w.w = pk2c(a1[2] * sigm(b1[2]), a1[3] * sigm(b1[3]));
                    *(GAS v4u*)(dst + (size_t)(row0 + ai * 128 + m * 16) * 1024 + col0) = w; }
            return;
        }
        bf16* dst; int ld, colt, mode;
        if (pn < 28) { const int sg = pn >> 2; dst = seg + (size_t)sg * SEGSZ; ld = 1024; colt = (pn & 3) * 256; mode = (sg == 4) ? 2 : (sg == 6 ? 1 : 0); }
        else { const int q = pn - 36; dst = gate + (size_t)(q >> 3) * ((size_t)NTOK * 2048); ld = 2048; colt = (q & 7) * 256; mode = 1; }
        const int col0 = colt + wc * 32 + 8 * fq;
        if (mode == 0) {
#pragma unroll
            for (int ai = 0; ai < 2; ++ai)
#pragma unroll
                for (int m = 0; m < 4; ++m)
#pragma unroll
                    for (int bj = 0; bj < 2; ++bj) { const pg8::f32x4 v0 = acc[ai][bj][m][0], v1 = acc[ai][bj][m][1];
                        v4u w; w.x = pk2c(v0[0], v0[1]); w.y = pk2c(v0[2], v0[3]); w.z = pk2c(v1[0], v1[1]); w.w = pk2c(v1[2], v1[3]);
                        *(GAS v4u*)(dst + (size_t)(row0 + ai * 128 + m * 16) * ld + col0 + bj * 128) = w; }
        } else if (mode == 1) {
#pragma unroll
            for (int ai = 0; ai < 2; ++ai)
#pragma unroll
                for (int m = 0; m < 4; ++m)
#pragma unroll
                    for (int bj = 0; bj < 2; ++bj) { const pg8::f32x4 v0 = acc[ai][bj][m][0], v1 = acc[ai][bj][m][1];
                        v4u w; w.x = pk2c(sigm(v0[0]), sigm(v0[1])); w.y = pk2c(sigm(v0[2]), sigm(v0[3])); w.z = pk2c(sigm(v1[0]), sigm(v1[1])); w.w = pk2c(sigm(v1[2]), sigm(v1[3]));
                        *(GAS v4u*)(dst + (size_t)(row0 + ai * 128 + m * 16) * ld + col0 + bj * 128) = w; }
        } else {
            f32x4 l0[2], l1[2];
#pragma unroll
            for (int bj = 0; bj < 2; ++bj) { l0[bj] = *(const GAS f32x4*)(lb + col0 + bj * 128); l1[bj] = *(const GAS f32x4*)(lb + col0 + bj * 128 + 4); }
#pragma unroll
            for (int ai = 0; ai < 2; ++ai)
#pragma unroll
                for (int m = 0; m < 4; ++m)
#pragma unroll
                    for (int bj = 0; bj < 2; ++bj) { const pg8::f32x4 v0 = acc[ai][bj][m][0], v1 = acc[ai][bj][m][1]; float r[8];
#pragma unroll
                        for (int j = 0; j < 4; ++j) { r[j] = __logf(l0[bj][j] + (1.0f - l0[bj][j]) * sigm(v0[j])); r[4 + j] = __logf(l1[bj][j] + (1.0f - l1[bj][j]) * sigm(v1[j])); }
                        v4u w; w.x = pk2c(r[0], r[1]); w.y = pk2c(r[2], r[3]); w.z = pk2c(r[4], r[5]); w.w = pk2c(r[6], r[7]);
                        *(GAS v4u*)(dst + (size_t)(row0 + ai * 128 + m * 16) * ld + col0 + bj * 128) = w; }
        }
    }
};

__device__ __forceinline__ void conv_phase(const Ctx& c, const bf16* glu, const float* cw, const float* cb, const float* lnw, const float* lnb, bf16* out) {
    const int c0 = 2 * c.tid;
    float w0[31], w1[31];
#pragma unroll
    for (int j = 0; j < 31; ++j) { const f32x2v t = *(const GAS f32x2v*)(cw + j * 1024 + c0); w0[j] = t.x; w1[j] = t.y; }
    const f32x2v bv = *(const GAS f32x2v*)(cb + c0), lwv = *(const GAS f32x2v*)(lnw + c0), lbv = *(const GAS f32x2v*)(lnb + c0);
    LAS float* red = (LAS float*)c.lds;
    for (int tile = blockIdx.x; tile < NTOK / 8; tile += c.G) {
        const int n0 = tile * 8, tseq0 = n0 & (SEQ - 1);
        float a0[8], a1[8];
#pragma unroll
        for (int t = 0; t < 8; ++t) { a0[t] = bv.x; a1[t] = bv.y; }
#pragma unroll
        for (int r = 0; r < 38; ++r) {
            unsigned xv = 0u;
            if (tseq0 + r - 30 >= 0) xv = *(const GAS unsigned*)(glu + (size_t)(n0 + r - 30) * 1024 + c0);
            const float x0 = bflo(xv), x1 = bfhi(xv);
#pragma unroll
            for (int t = 0; t < 8; ++t) { const int j = r - t; if (j >= 0 && j <= 30) { a0[t] += w0[j] * x0; a1[t] += w1[j] * x1; } }
        }
        float st[16];
#pragma unroll
        for (int t = 0; t < 8; ++t) { st[2 * t] = a0[t] + a1[t]; st[2 * t + 1] = a0[t] * a0[t] + a1[t] * a1[t]; }
        xreduce16(st, c.lane);
        if ((c.lane & 3) == 0) red[c.wave * 16 + ridx16(c.lane)] = st[0];
        __syncthreads();
        if (c.tid < 16) { float s = 0.f;
#pragma unroll
            for (int w = 0; w < 8; ++w) s += red[w * 16 + c.tid];
            red[128 + c.tid] = s; }
        __syncthreads();
#pragma unroll
        for (int t = 0; t < 8; ++t) {
            const float mean = red[128 + 2 * t] * (1.0f / 1024.0f), var = red[128 + 2 * t + 1] * (1.0f / 1024.0f) - mean * mean;
            const float rstd = __builtin_amdgcn_rsqf(var + EPS);
            const float h0 = (a0[t] - mean) * rstd * lwv.x + lbv.x, h1 = (a1[t] - mean) * rstd * lwv.y + lbv.y;
            *(GAS unsigned*)(out + (size_t)(n0 + t) * 1024 + c0) = pk2c(h0 * sigm(h0), h1 * sigm(h1));
        }
        __syncthreads();
    }
}
__device__ __forceinline__ void hgrn_task(int task, int lane, const bf16* qhg, const bf16* logf, const bf16* ihg, bf16* out) {
    const int bh = task >> 6, dvb = task & 63, b = bh >> 3, h = bh & 7;
    const size_t rb = (size_t)b * SEQ * 1024;
    const GAS unsigned* qp = (const GAS unsigned*)(qhg + rb + h * 128) + lane;
    const GAS unsigned* lp = (const GAS unsigned*)(logf + rb + h * 128) + lane;
    const GAS unsigned* ip = (const GAS unsigned*)(ihg + rb + h * 128) + dvb;
    GAS bf16* op = (GAS bf16*)(out + rb + h * 128 + 2 * dvb);
    float S00 = 0.f, S01 = 0.f, S10 = 0.f, S11 = 0.f;
    unsigned qn[8], ln[8], inx[8];
#pragma unroll
    for (int j = 0; j < 8; ++j) { qn[j] = qp[(size_t)j * 512]; ln[j] = lp[(size_t)j * 512]; inx[j] = ip[(size_t)j * 512]; }
    for (int blk = 0; blk < SEQ / 8; ++blk) {
        unsigned qc[8], lc[8], ic[8];
#pragma unroll
        for (int j = 0; j < 8; ++j) { qc[j] = qn[j]; lc[j] = ln[j]; ic[j] = inx[j]; }
        if (blk + 1 < SEQ / 8) {
#pragma unroll
            for (int j = 0; j < 8; ++j) { const size_t o = (size_t)((blk + 1) * 8 + j) * 512; qn[j] = qp[o]; ln[j] = lp[o]; inx[j] = ip[o]; }
        }
        float pv[16];
#pragma unroll
        for (int j = 0; j < 8; ++j) {
            const float f0 = __expf(bflo(lc[j])), f1 = __expf(bfhi(lc[j])), k0 = 1.0f - f0, k1 = 1.0f - f1;
            const float i0 = bflo(ic[j]), i1 = bfhi(ic[j]), q0 = bflo(qc[j]), q1 = bfhi(qc[j]);
            S00 = f0 * S00 + k0 * i0; S01 = f0 * S01 + k0 * i1; S10 = f1 * S10 + k1 * i0; S11 = f1 * S11 + k1 * i1;
            pv[2 * j] = S00 * q0 + S10 * q1; pv[2 * j + 1] = S01 * q0 + S11 * q1;
        }
        xreduce16(pv, lane);
        if ((lane & 3) == 0) { const int idx = ridx16(lane); op[(size_t)(blk * 8 + (idx >> 1)) * 1024 + (idx & 1)] = (bf16)(pk2c(pv[0], 0.f) & 0xffffu); }
    }
}
constexpr int HG_TS = 272;
constexpr int HG_BS = 132;
__device__ __forceinline__ void hg_stage(LAS unsigned char* dst, const bf16* src, int tid) {
#pragma unroll
    for (int i = 0; i < 2; ++i) { const int p = tid + 512 * i, row = p >> 4, c16 = p & 15; *(LAS v4u*)(dst + row * HG_TS + c16 * 16) = *(const GAS v4u*)(src + (size_t)row * 1024 + c16 * 8); }
}
__device__ __forceinline__ void hg_scan(const LAS unsigned char* lft, int dk, int hf, float (&lf)[4][8], float (&b)[4][8], float& bl) {
    float bs[4], pb[4];
#pragma unroll
    for (int kk = 0; kk < 4; ++kk) { float run = 0.f;
#pragma unroll
        for (int j = 0; j < 8; ++j) { lf[kk][j] = __uint_as_float((unsigned)(*(const LAS unsigned short*)(lft + (16 * kk + 8 * hf + j) * HG_TS + dk * 2)) << 16); run += lf[kk][j]; b[kk][j] = run; }
        bs[kk] = run; }
#pragma unroll
    for (int kk = 0; kk < 4; ++kk) pb[kk] = __shfl_xor(bs[kk], 32);
    float pre = 0.f;
#pragma unroll
    for (int kk = 0; kk < 4; ++kk) { const float off = pre + (hf ? pb[kk] : 0.f);
#pragma unroll
        for (int j = 0; j < 8; ++j) b[kk][j] += off;
        pre += bs[kk] + pb[kk]; }
    bl = pre;
}
__device__ __forceinline__ bf16x8 pack8(const float (&v)[8]) { v4u t; t.x = pk2c(v[0], v[1]); t.y = pk2c(v[2], v[3]); t.z = pk2c(v[4], v[5]); t.w = pk2c(v[6], v[7]); return __builtin_bit_cast(bf16x8, t); }
__device__ __forceinline__ unsigned lds_u16(const LAS unsigned char* p) { return (unsigned)(*(const LAS unsigned short*)p); }
__device__ __forceinline__ void hgA_chunk(const Ctx& c, int ci, const bf16* LOGF, const bf16* IHG, bf16* ST, float* DEC) {
    const int bh = ci >> 6, ch = ci & 63, bb = bh >> 3, h = bh & 7; const size_t n0 = (size_t)bb * SEQ + ch * 64;
    LAS unsigned char* lft = c.lds; LAS unsigned char* itl = c.lds + 64 * HG_TS;
    hg_stage(lft, LOGF + n0 * 1024 + h * 128, c.tid); hg_stage(itl, IHG + n0 * 1024 + h * 128, c.tid);
    __syncthreads();
    const int dkt = c.wave & 3, dvh = c.wave >> 2, hf = c.lane >> 5, cl = c.lane & 31, dk = 32 * dkt + cl;
    float lf[4][8], b[4][8], bl; hg_scan(lft, dk, hf, lf, b, bl);
    bf16x8 kf[4];
#pragma unroll
    for (int kk = 0; kk < 4; ++kk) { float v[8];
#pragma unroll
        for (int j = 0; j < 8; ++j) v[j] = (1.0f - __expf(lf[kk][j])) * __expf(bl - b[kk][j]);
        kf[kk] = pack8(v); }
    if (dvh == 0 && hf == 0) ((GAS float*)DEC)[(size_t)ci * 128 + dk] = __expf(bl);
#pragma unroll
    for (int dvi = 0; dvi < 2; ++dvi) { const int dvt = dvh * 2 + dvi;
        f32x16 acc;
#pragma unroll
        for (int r = 0; r < 16; ++r) acc[r] = 0.f;
#pragma unroll
        for (int kk = 0; kk < 4; ++kk) { const LAS unsigned char* p = itl + (16 * kk + 8 * hf) * HG_TS + (32 * dvt + cl) * 2;
            v4u t; t.x = lds_u16(p) | (lds_u16(p + HG_TS) << 16); t.y = lds_u16(p + 2 * HG_TS) | (lds_u16(p + 3 * HG_TS) << 16); t.z = lds_u16(p + 4 * HG_TS) | (lds_u16(p + 5 * HG_TS) << 16); t.w = lds_u16(p + 6 * HG_TS) | (lds_u16(p + 7 * HG_TS) << 16);
            acc = MFMA32(kf[kk], __builtin_bit_cast(bf16x8, t), acc); }
        bf16* o = ST + (size_t)ci * 16384 + (size_t)(32 * dvt + cl) * 128 + 32 * dkt + 4 * hf;
#pragma unroll
        for (int g = 0; g < 4; ++g) { v2u q; q.x = pk2c(acc[4 * g], acc[4 * g + 1]); q.y = pk2c(acc[4 * g + 2], acc[4 * g + 3]); *(GAS v2u*)(o + 8 * g) = q; }
    }
    __syncthreads();
}
__device__ __forceinline__ void hgB(const Ctx& c, bf16* ST, const float* DEC) {
    for (int e = blockIdx.x * 512 + c.tid; e < 32 * 4096; e += c.G * 512) {
        const int bh = e >> 12, r = e & 4095, dv = r >> 5, dk4 = (r & 31) * 4;
        GAS v2u* p = (GAS v2u*)(ST + (size_t)bh * 64 * 16384 + (size_t)dv * 128 + dk4);
        const GAS f32x4* d = (const GAS f32x4*)(DEC + (size_t)bh * 64 * 128 + dk4);
        f32x4 S = {0.f, 0.f, 0.f, 0.f};
#pragma unroll 1
        for (int c0 = 0; c0 < 64; c0 += 8) {
            v2u Lv[8]; f32x4 D[8];
#pragma unroll
            for (int k = 0; k < 8; ++k) { Lv[k] = p[(size_t)(c0 + k) * 4096]; D[k] = d[(size_t)(c0 + k) * 32]; }
#pragma unroll
            for (int k = 0; k < 8; ++k) { v2u o; o.x = pk2c(S.x, S.y); o.y = pk2c(S.z, S.w); p[(size_t)(c0 + k) * 4096] = o;
                S.x = D[k].x * S.x + bflo(Lv[k].x); S.y = D[k].y * S.y + bfhi(Lv[k].x); S.z = D[k].z * S.z + bflo(Lv[k].y); S.w = D[k].w * S.w + bfhi(Lv[k].y); }
        }
    }
}
__device__ __forceinline__ void hgC_chunk(const Ctx& c, int ci, const bf16* QHG, const bf16* LOGF, const bf16* IHG, const bf16* GHG, const bf16* ST, const float* nw, bf16* OUT) {
    const int bh = ci >> 6, ch = ci & 63, bb = bh >> 3, h = bh & 7; const size_t n0 = (size_t)bb * SEQ + ch * 64;
    LAS unsigned char* lft = c.lds; LAS unsigned char* itl = c.lds + 64 * HG_TS; LAS float* bt = (LAS float*)(c.lds + 2 * 64 * HG_TS); LAS float* red = bt + 64 * HG_BS;
    LAS unsigned char* ktl = (LAS unsigned char*)(red + 256);
    hg_stage(lft, LOGF + n0 * 1024 + h * 128, c.tid); hg_stage(itl, IHG + n0 * 1024 + h * 128, c.tid);
    __syncthreads();
    const int hf = c.lane >> 5, cl = c.lane & 31;
    { const int dk = 32 * (c.wave & 3) + cl; float lf[4][8], b[4][8], bl; hg_scan(lft, dk, hf, lf, b, bl);
#pragma unroll
      for (int q = 0; q < 2; ++q) { const int kk = 2 * (c.wave >> 2) + q;
#pragma unroll
          for (int j = 0; j < 8; ++j) { bt[(16 * kk + 8 * hf + j) * HG_BS + dk] = (c.wave >> 2) ? b[2 + q][j] : b[q][j];
              *(LAS unsigned short*)(ktl + (16 * kk + 8 * hf + j) * HG_TS + dk * 2) = (unsigned short)(pk2c(1.0f - __expf((c.wave >> 2) ? lf[2 + q][j] : lf[q][j]), 0.f) & 0xffffu); } } }
    __syncthreads();
    const int dvt = c.wave & 3, tt = c.wave >> 2, t = 32 * tt + cl;
    bf16x8 qm[8];
    const bf16* qrow = QHG + (n0 + t) * 1024 + h * 128 + 8 * hf;
#pragma unroll
    for (int kk = 0; kk < 8; ++kk) { const int d0 = 16 * kk + 8 * hf;
        asm volatile("" ::: "memory");
        const v4u qv = *(const GAS v4u*)(qrow + 16 * kk);
        const f32x4 b0 = *(const LAS f32x4*)(bt + t * HG_BS + d0), b1 = *(const LAS f32x4*)(bt + t * HG_BS + d0 + 4), m0 = *(const LAS f32x4*)(bt + 31 * HG_BS + d0), m1 = *(const LAS f32x4*)(bt + 31 * HG_BS + d0 + 4);
        const float q[8] = {bflo(qv.x), bfhi(qv.x), bflo(qv.y), bfhi(qv.y), bflo(qv.z), bfhi(qv.z), bflo(qv.w), bfhi(qv.w)};
        const float bv[8] = {b0.x, b0.y, b0.z, b0.w, b1.x, b1.y, b1.z, b1.w}, mv[8] = {m0.x, m0.y, m0.z, m0.w, m1.x, m1.y, m1.z, m1.w};
        float vm[8];
#pragma unroll
        for (int j = 0; j < 8; ++j) vm[j] = q[j] * __expf(bv[j] - mv[j]);
        qm[kk] = pack8(vm); }
    f32x16 o;
#pragma unroll
    for (int r = 0; r < 16; ++r) o[r] = 0.f;
#pragma unroll 1
    for (int st = 0; st <= tt; ++st) {
        const int s = 32 * st + cl;
        f32x16 sa;
#pragma unroll
        for (int r = 0; r < 16; ++r) sa[r] = 0.f;
#pragma unroll
        for (int kk = 0; kk < 8; ++kk) { const int d0 = 16 * kk + 8 * hf;
            asm volatile("" ::: "memory");
            const v4u lv = *(const LAS v4u*)(ktl + s * HG_TS + d0 * 2);
            const f32x4 b0 = *(const LAS f32x4*)(bt + s * HG_BS + d0), b1 = *(const LAS f32x4*)(bt + s * HG_BS + d0 + 4), m0 = *(const LAS f32x4*)(bt + 31 * HG_BS + d0), m1 = *(const LAS f32x4*)(bt + 31 * HG_BS + d0 + 4);
            const float kv[8] = {bflo(lv.x), bfhi(lv.x), bflo(lv.y), bfhi(lv.y), bflo(lv.z), bfhi(lv.z), bflo(lv.w), bfhi(lv.w)};
            const float bv[8] = {b0.x, b0.y, b0.z, b0.w, b1.x, b1.y, b1.z, b1.w}, mv[8] = {m0.x, m0.y, m0.z, m0.w, m1.x, m1.y, m1.z, m1.w};
            float vk[8];
#pragma unroll
            for (int j = 0; j < 8; ++j) vk[j] = kv[j] * __expf(mv[j] - bv[j]);
            sa = MFMA32(pack8(vk), qm[kk], sa); }
        if (st == tt) {
#pragma unroll
            for (int r = 0; r < 16; ++r) if (((r & 3) + 8 * (r >> 2) + 4 * hf) > cl) sa[r] = 0.f;
        }
#pragma unroll
        for (int sp = 0; sp < 2; ++sp) {
            const float pv[8] = {sa[8 * sp], sa[8 * sp + 1], sa[8 * sp + 2], sa[8 * sp + 3], sa[8 * sp + 4], sa[8 * sp + 5], sa[8 * sp + 6], sa[8 * sp + 7]};
            const LAS unsigned char* p = itl + (32 * st + 16 * sp + 4 * hf) * HG_TS + (32 * dvt + cl) * 2;
            v4u tq; tq.x = lds_u16(p) | (lds_u16(p + HG_TS) << 16); tq.y = lds_u16(p + 2 * HG_TS) | (lds_u16(p + 3 * HG_TS) << 16);
            tq.z = lds_u16(p + 8 * HG_TS) | (lds_u16(p + 9 * HG_TS) << 16); tq.w = lds_u16(p + 10 * HG_TS) | (lds_u16(p + 11 * HG_TS) << 16);
            o = MFMA32(__builtin_bit_cast(bf16x8, tq), pack8(pv), o); }
    }
    { const bf16* strow = ST + (size_t)ci * 16384 + (size_t)(32 * dvt + cl) * 128 + 8 * hf;
#pragma unroll
      for (int kk = 0; kk < 8; ++kk) { const int d0 = 16 * kk + 8 * hf;
          asm volatile("" ::: "memory");
          const v4u qv = *(const GAS v4u*)(qrow + 16 * kk); const bf16x8 sf = *(const GAS bf16x8*)(strow + 16 * kk);
          const f32x4 b0 = *(const LAS f32x4*)(bt + t * HG_BS + d0), b1 = *(const LAS f32x4*)(bt + t * HG_BS + d0 + 4);
          float ve[8] = {bflo(qv.x) * __expf(b0.x), bfhi(qv.x) * __expf(b0.y), bflo(qv.y) * __expf(b0.z), bfhi(qv.y) * __expf(b0.w), bflo(qv.z) * __expf(b1.x), bfhi(qv.z) * __expf(b1.y), bflo(qv.w) * __expf(b1.z), bfhi(qv.w) * __expf(b1.w)};
          o = MFMA32(sf, pack8(ve), o); } }
    float ss = 0.f;
#pragma unroll
    for (int r = 0; r < 16; ++r) ss += o[r] * o[r];
    ss += __shfl_xor(ss, 32);
    if (hf == 0) red[(tt * 4 + dvt) * 32 + cl] = ss;
    __syncthreads();
    const float rstd = __builtin_amdgcn_rsqf(((red[(tt * 4 + 0) * 32 + cl] + red[(tt * 4 + 1) * 32 + cl]) + (red[(tt * 4 + 2) * 32 + cl] + red[(tt * 4 + 3) * 32 + cl])) * (1.0f / 128.0f) + EPS);
#pragma unroll
    for (int g = 0; g < 4; ++g) { const int dv0 = 32 * dvt + 8 * g + 4 * hf; const size_t off = (n0 + t) * 1024 + h * 128 + dv0;
        const v2u gg = *(const GAS v2u*)(GHG + off); const f32x4 w4 = *(const GAS f32x4*)(nw + dv0);
        v2u q; q.x = pk2c(o[4 * g] * rstd * w4.x * bflo(gg.x), o[4 * g + 1] * rstd * w4.y * bfhi(gg.x)); q.y = pk2c(o[4 * g + 2] * rstd * w4.z * bflo(gg.y), o[4 * g + 3] * rstd * w4.w * bfhi(gg.y));
        *(GAS v2u*)(OUT + off) = q; }
    __syncthreads();
}
__device__ __forceinline__ void qknorm_rows4(bf16* row0, size_t rstride, const float* w, float scale, int lane) {
    v4u x[4][2];
#pragma unroll
    for (int i = 0; i < 4; ++i)
#pragma unroll
        for (int j = 0; j < 2; ++j) x[i][j] = *(const GAS v4u*)(row0 + i * rstride + 8 * lane + 512 * j);
    const f32x4 wa = *(const GAS f32x4*)(w + ((8 * lane) & 127)), wb = *(const GAS f32x4*)(w + ((8 * lane) & 127) + 4);
#pragma unroll
    for (int i = 0; i < 4; ++i)
#pragma unroll
        for (int j = 0; j < 2; ++j) { const v4u xx = x[i][j];
            float f[8] = {bflo(xx.x), bfhi(xx.x), bflo(xx.y), bfhi(xx.y), bflo(xx.z), bfhi(xx.z), bflo(xx.w), bfhi(xx.w)};
            float ss = 0.f;
#pragma unroll
            for (int k = 0; k < 8; ++k) ss += f[k] * f[k];
            ss += __shfl_xor(ss, 1); ss += __shfl_xor(ss, 2); ss += __shfl_xor(ss, 4); ss += __shfl_xor(ss, 8);
            const float r = __builtin_amdgcn_rsqf(ss * (1.0f / 128.0f) + EPS) * scale;
            v4u o; o.x = pk2c(f[0] * r * wa.x, f[1] * r * wa.y); o.y = pk2c(f[2] * r * wa.z, f[3] * r * wa.w); o.z = pk2c(f[4] * r * wb.x, f[5] * r * wb.y); o.w = pk2c(f[6] * r * wb.z, f[7] * r * wb.w);
            *(GAS v4u*)(row0 + i * rstride + 8 * lane + 512 * j) = o; }
}
__device__ __forceinline__ void vt_item(int item, int lane, const bf16* vsb, bf16* vt, LAS unsigned short* scr) {
    const int db = item & 3, sb = (item >> 2) & 63, bh = item >> 8, b = bh >> 3, h = bh & 7;
    const bf16* src = vsb + ((size_t)b * SEQ + sb * 64) * 1024 + h * 128 + db * 32;
#pragma unroll 4
    for (int i = 0; i < 16; ++i) { const int r = 4 * i + (lane >> 4); *(LAS unsigned*)(scr + r * 34 + 2 * (lane & 15)) = *(const GAS unsigned*)(src + (size_t)r * 1024 + 2 * (lane & 15)); }
    LDS_WAIT();
    const int c = lane & 7;
#pragma unroll
    for (int j = 0; j < 4; ++j) { const int d = (lane >> 3) + 8 * j; const LAS unsigned short* s = scr + (8 * c) * 34 + d;
        v4u o; o.x = (unsigned)s[0] | ((unsigned)s[34] << 16); o.y = (unsigned)s[68] | ((unsigned)s[102] << 16); o.z = (unsigned)s[136] | ((unsigned)s[170] << 16); o.w = (unsigned)s[204] | ((unsigned)s[238] << 16);
        *(GAS v4u*)(vt + ((size_t)bh * 128 + db * 32 + d) * SEQ + sb * 64 + 8 * c) = o; }
    LDS_WAIT();
}

constexpr int AT_KS = 272, AT_VS = 136, AT_BUF = 64 * AT_KS + 128 * AT_VS;
__device__ __forceinline__ f32x16 attn_scores(const LAS unsigned char* kp, const bf16x8 (&qf)[8]) {
    f32x16 sa;
#pragma unroll
    for (int r = 0; r < 16; ++r) sa[r] = 0.f;
#pragma unroll
    for (int kk = 0; kk < 8; ++kk) sa = MFMA32(*(const LAS bf16x8*)(kp + 32 * kk), qf[kk], sa);
    return sa;
}
template <bool DIAG> __device__ __forceinline__ void attn_weights(const f32x16& sa, float& R, int hf, int cl, bf16x8 (&pf)[2]) {
    float om[16], be[16];
#pragma unroll
    for (int r = 0; r < 16; ++r) { const float e = __builtin_amdgcn_exp2f(sa[r] * 1.4426950408889634f); om[r] = __builtin_amdgcn_rcpf(1.0f + e); be[r] = e * om[r]; }
    if (DIAG) {
#pragma unroll
        for (int r = 0; r < 16; ++r) if (((r & 3) + 8 * (r >> 2) + 4 * hf) >= cl) { om[r] = 1.0f; be[r] = 0.f; }
    }
    float Gs[4], Gp[4];
#pragma unroll
    for (int g = 0; g < 4; ++g) { Gs[g] = (om[4 * g] * om[4 * g + 1]) * (om[4 * g + 2] * om[4 * g + 3]); Gp[g] = __shfl_xor(Gs[g], 32); }
    float tail = R; float w[16];
#pragma unroll
    for (int g = 3; g >= 0; --g) {
        const float c3 = tail * (hf == 0 ? Gp[g] : 1.0f), c2 = c3 * om[4 * g + 3], c1 = c2 * om[4 * g + 2], c0 = c1 * om[4 * g + 1];
        w[4 * g + 3] = be[4 * g + 3] * c3; w[4 * g + 2] = be[4 * g + 2] * c2; w[4 * g + 1] = be[4 * g + 1] * c1; w[4 * g] = be[4 * g] * c0;
        tail *= Gs[g] * Gp[g];
    }
    R = tail;
#pragma unroll
    for (int sp = 0; sp < 2; ++sp) { v4u t; t.x = pk2c(w[8 * sp], w[8 * sp + 1]); t.y = pk2c(w[8 * sp + 2], w[8 * sp + 3]); t.z = pk2c(w[8 * sp + 4], w[8 * sp + 5]); t.w = pk2c(w[8 * sp + 6], w[8 * sp + 7]); pf[sp] = __builtin_bit_cast(bf16x8, t); }
}
__device__ __forceinline__ void attn_pv(const LAS unsigned char* vp, const bf16x8 (&pf)[2], f32x16 (&o)[4]) {
#pragma unroll
    for (int d = 0; d < 4; ++d)
#pragma unroll
        for (int sp = 0; sp < 2; ++sp) { const v2u lo = *(const LAS v2u*)(vp + d * 32 * AT_VS + 32 * sp), hi = *(const LAS v2u*)(vp + d * 32 * AT_VS + 32 * sp + 16);
            v4u t; t.x = lo.x; t.y = lo.y; t.z = hi.x; t.w = hi.y; o[d] = MFMA32(__builtin_bit_cast(bf16x8, t), pf[sp], o[d]); }
}
__device__ __forceinline__ void attn_unit(const Ctx& c, int bh, int qb, const bf16* qsb, const bf16* ksb, const bf16* vt, bf16* outb) {
    const int b = bh >> 3, h = bh & 7, lane = c.lane, cl = lane & 31, hf = lane >> 5, tid = c.tid;
    const size_t rb = (size_t)b * SEQ; const int q0w = 256 * qb + 32 * c.wave;
    bf16x8 qf[8];
    { const bf16* qrow = qsb + (rb + q0w + cl) * 1024 + h * 128 + 8 * hf;
#pragma unroll
      for (int kk = 0; kk < 8; ++kk) qf[kk] = *(const GAS bf16x8*)(qrow + 16 * kk); }
    f32x16 o[4];
#pragma unroll
    for (int d = 0; d < 4; ++d)
#pragma unroll
        for (int r = 0; r < 16; ++r) o[d][r] = 0.f;
    float R = 1.0f;
    const bf16* kg = ksb + (rb + (tid >> 4)) * 1024 + h * 128 + (tid & 15) * 8;
    const bf16* vg = vt + ((size_t)bh * 128 + (tid >> 3)) * SEQ + (tid & 7) * 8;
    const int kl = (tid >> 4) * AT_KS + (tid & 15) * 16, vl = 64 * AT_KS + (tid >> 3) * AT_VS + (tid & 7) * 16;
    const int nkt = 4 * (qb + 1);
    v4u st[4];
    { const int kt = nkt - 1;
      st[0] = *(const GAS v4u*)(kg + (size_t)kt * 64 * 1024); st[1] = *(const GAS v4u*)(kg + (size_t)kt * 64 * 1024 + 32 * 1024);
      st[2] = *(const GAS v4u*)(vg + kt * 64); st[3] = *(const GAS v4u*)(vg + kt * 64 + (size_t)64 * SEQ);
      *(LAS v4u*)(c.lds + kl) = st[0]; *(LAS v4u*)(c.lds + kl + 32 * AT_KS) = st[1];
      *(LAS v2u*)(c.lds + vl) = (v2u){st[2].x, st[2].y}; *(LAS v2u*)(c.lds + vl + 8) = (v2u){st[2].z, st[2].w}; *(LAS v2u*)(c.lds + vl + 64 * AT_VS) = (v2u){st[3].x, st[3].y}; *(LAS v2u*)(c.lds + vl + 64 * AT_VS + 8) = (v2u){st[3].z, st[3].w}; }
    __syncthreads();
#pragma unroll 1
    for (int it = 0; it < nkt; ++it) {
        const int kt = nkt - 1 - it; LAS unsigned char* buf = c.lds + (it & 1) * AT_BUF; LAS unsigned char* nbuf = c.lds + ((it & 1) ^ 1) * AT_BUF;
        const bool more = (it + 1 < nkt);
        if (more) { const int k2 = kt - 1;
            st[0] = *(const GAS v4u*)(kg + (size_t)k2 * 64 * 1024); st[1] = *(const GAS v4u*)(kg + (size_t)k2 * 64 * 1024 + 32 * 1024);
            st[2] = *(const GAS v4u*)(vg + k2 * 64); st[3] = *(const GAS v4u*)(vg + k2 * 64 + (size_t)64 * SEQ); }
        const int rel = q0w - 64 * kt;
        const LAS unsigned char* kp0 = buf + cl * AT_KS + 16 * hf; const LAS unsigned char* kp1 = kp0 + 32 * AT_KS;
        const LAS unsigned char* vp0 = buf + 64 * AT_KS + cl * AT_VS + 8 * hf; const LAS unsigned char* vp1 = vp0 + 64;
        if (rel >= 64) {
            const f32x16 s1 = attn_scores(kp1, qf), s0 = attn_scores(kp0, qf);
            bf16x8 p1[2], p0[2];
            attn_weights<false>(s1, R, hf, cl, p1); attn_weights<false>(s0, R, hf, cl, p0);
            attn_pv(vp1, p1, o); attn_pv(vp0, p0, o);
        } else if (rel == 32) {
            const f32x16 s1 = attn_scores(kp1, qf), s0 = attn_scores(kp0, qf);
            bf16x8 p1[2], p0[2];
            attn_weights<true>(s1, R, hf, cl, p1); attn_weights<false>(s0, R, hf, cl, p0);
            attn_pv(vp1, p1, o); attn_pv(vp0, p0, o);
        } else if (rel == 0) {
            const f32x16 s0 = attn_scores(kp0, qf);
            bf16x8 p0[2];
            attn_weights<true>(s0, R, hf, cl, p0);
            attn_pv(vp0, p0, o);
        }
        if (more) { *(LAS v4u*)(nbuf + kl) = st[0]; *(LAS v4u*)(nbuf + kl + 32 * AT_KS) = st[1];
            *(LAS v2u*)(nbuf + vl) = (v2u){st[2].x, st[2].y}; *(LAS v2u*)(nbuf + vl + 8) = (v2u){st[2].z, st[2].w}; *(LAS v2u*)(nbuf + vl + 64 * AT_VS) = (v2u){st[3].x, st[3].y}; *(LAS v2u*)(nbuf + vl + 64 * AT_VS + 8) = (v2u){st[3].z, st[3].w}; }
        __syncthreads();
    }
    bf16* orow = outb + (rb + q0w + cl) * 1024 + h * 128 + 4 * hf;
#pragma unroll
    for (int d = 0; d < 4; ++d)
#pragma unroll
        for (int g = 0; g < 4; ++g) { v2u q; q.x = pk2c(o[d][4 * g], o[d][4 * g + 1]); q.y = pk2c(o[d][4 * g + 2], o[d][4 * g + 3]); *(GAS v2u*)(orow + 32 * d + 8 * g) = q; }
}
__device__ __forceinline__ void hgpost_row(bf16* row, const bf16* grow, const float* w, int lane) {
#pragma unroll
    for (int j = 0; j < 2; ++j) {
        GAS v4u* p = (GAS v4u*)(row + 8 * lane + 512 * j); const v4u x = *p; const v4u gg = *(const GAS v4u*)(grow + 8 * lane + 512 * j);
        float f[8] = {bflo(x.x), bfhi(x.x), bflo(x.y), bfhi(x.y), bflo(x.z), bfhi(x.z), bflo(x.w), bfhi(x.w)};
        const float g[8] = {bflo(gg.x), bfhi(gg.x), bflo(gg.y), bfhi(gg.y), bflo(gg.z), bfhi(gg.z), bflo(gg.w), bfhi(gg.w)};
        float ss = 0.f;
#pragma unroll
        for (int k = 0; k < 8; ++k) ss += f[k] * f[k];
        ss += __shfl_xor(ss, 1); ss += __shfl_xor(ss, 2); ss += __shfl_xor(ss, 4); ss += __shfl_xor(ss, 8);
        const float r = __builtin_amdgcn_rsqf(ss * (1.0f / 128.0f) + EPS);
        const f32x4 wa = *(const GAS f32x4*)(w + ((8 * lane) & 127)), wb = *(const GAS f32x4*)(w + ((8 * lane) & 127) + 4);
        v4u o; o.x = pk2c(f[0] * r * wa.x * g[0], f[1] * r * wa.y * g[1]); o.y = pk2c(f[2] * r * wa.z * g[2], f[3] * r * wa.w * g[3]);
        o.z = pk2c(f[4] * r * wb.x * g[4], f[5] * r * wb.y * g[5]); o.w = pk2c(f[6] * r * wb.z * g[6], f[7] * r * wb.w * g[7]);
        *p = o;
    }
}

template <bool FIRST> struct EpiMerge {
    static constexpr bool PERM = true, AFTER_DRAIN = false;
    const bf16* gate; bf16* merged;
    __device__ __forceinline__ void operator()(const pg8::f32x4 (&acc)[2][2][4][2], const pg8::Unit& u, int wr, int wc, int fr, int fq) const {
        const int row0 = u.pm * 256 + wr * 64 + fr, col0 = u.pn * 256 + wc * 32 + 8 * fq;
#pragma unroll
        for (int ai = 0; ai < 2; ++ai)
#pragma unroll
            for (int m = 0; m < 4; ++m) {
                if ((m & 1) == 0) asm volatile("" ::: "memory");
#pragma unroll
                for (int bj = 0; bj < 2; ++bj) {
                    const size_t off = (size_t)(row0 + ai * 128 + m * 16) * 2048 + col0 + bj * 128;
                    const v4u g = *(const GAS v4u*)(gate + off); const pg8::f32x4 v0 = acc[ai][bj][m][0], v1 = acc[ai][bj][m][1];
                    float r[8] = {bflo(g.x) * v0[0], bfhi(g.x) * v0[1], bflo(g.y) * v0[2], bfhi(g.y) * v0[3], bflo(g.z) * v1[0], bfhi(g.z) * v1[1], bflo(g.w) * v1[2], bfhi(g.w) * v1[3]};
                    if (!FIRST) { const v4u mo = *(const GAS v4u*)(merged + off);
                        r[0] += bflo(mo.x); r[1] += bfhi(mo.x); r[2] += bflo(mo.y); r[3] += bfhi(mo.y); r[4] += bflo(mo.z); r[5] += bfhi(mo.z); r[6] += bflo(mo.w); r[7] += bfhi(mo.w); }
                    v4u w; w.x = pk2c(r[0], r[1]); w.y = pk2c(r[2], r[3]); w.z = pk2c(r[4], r[5]); w.w = pk2c(r[6], r[7]);
                    *(GAS v4u*)(merged + off) = w; }
            }
    }
};
struct EpiStoreBf16 {
    static constexpr bool PERM = true, AFTER_DRAIN = false;
    bf16* out;
    __device__ __forceinline__ void operator()(const pg8::f32x4 (&acc)[2][2][4][2], const pg8::Unit& u, int wr, int wc, int fr, int fq) const {
        const int row0 = u.pm * 256 + wr * 64 + fr, col0 = u.pn * 256 + wc * 32 + 8 * fq;
#pragma unroll
        for (int ai = 0; ai < 2; ++ai)
#pragma unroll
            for (int m = 0; m < 4; ++m)
#pragma unroll
                for (int bj = 0; bj < 2; ++bj) { const pg8::f32x4 v0 = acc[ai][bj][m][0], v1 = acc[ai][bj][m][1];
                    v4u w; w.x = pk2c(v0[0], v0[1]); w.y = pk2c(v0[2], v0[3]); w.z = pk2c(v1[0], v1[1]); w.w = pk2c(v1[2], v1[3]);
                    *(GAS v4u*)(out + (size_t)(row0 + ai * 128 + m * 16) * 2048 + col0 + bj * 128) = w; }
    }
};
struct EpiResid {
    static constexpr bool PERM = false, AFTER_DRAIN = false;
    const float* xin; float* xout;
    __device__ __forceinline__ void operator()(const pg8::f32x4 (&acc)[2][2][4][2], const pg8::Unit& u, int wr, int wc, int fr, int fq) const {
        const int row0 = u.pm * 256 + wr * 64 + fr, col0 = u.pn * 256 + wc * 32 + 4 * fq;
#pragma unroll
        for (int ai = 0; ai < 2; ++ai)
#pragma unroll
            for (int m = 0; m < 4; ++m)
#pragma unroll
                for (int bj = 0; bj < 2; ++bj)
#pragma unroll
                    for (int n = 0; n < 2; ++n) { const size_t off = (size_t)(row0 + ai * 128 + m * 16) * 2048 + col0 + bj * 128 + n * 16;
                        f32x4 r = acc[ai][bj][m][n]; if (xin) r += *(const GAS f32x4*)(xin + off);
                        *(GAS f32x4*)(xout + off) = r; }
    }
};

__device__ __forceinline__ float rl_f(float v, int l) { return __uint_as_float((unsigned)__builtin_amdgcn_readlane((int)__float_as_uint(v), l)); }
__device__ __forceinline__ void ins16(float (&L)[16], float x) {
#pragma unroll
    for (int i = 0; i < 16; ++i) { const float hi = __builtin_fmaxf(L[i], x); x = __builtin_fminf(L[i], x); L[i] = hi; }
}
#define CE_DESC(a, b) do { const float hi_ = __builtin_fmaxf(a, b), lo_ = __builtin_fminf(a, b); a = hi_; b = lo_; } while (0)
__device__ __forceinline__ void sort16_desc(float (&v)[16]) {
#pragma unroll
    for (int k = 2; k <= 16; k <<= 1)
#pragma unroll
        for (int j = k >> 1; j > 0; j >>= 1)
#pragma unroll
            for (int i = 0; i < 16; ++i) { const int l = i ^ j; if (l > i) { if ((i & k) == 0) CE_DESC(v[i], v[l]); else CE_DESC(v[l], v[i]); } }
}
__device__ __forceinline__ void bitonic_merge16_desc(float (&v)[16]) {
#pragma unroll
    for (int j = 8; j > 0; j >>= 1)
#pragma unroll
        for (int i = 0; i < 16; ++i) { const int l = i ^ j; if (l > i) CE_DESC(v[i], v[l]); }
}
__device__ __forceinline__ void top16_merge(float (&L)[16], const float (&T)[16]) {
#pragma unroll
    for (int i = 0; i < 16; ++i) L[i] = __builtin_fmaxf(L[i], T[15 - i]);
    bitonic_merge16_desc(L);
}
constexpr int PK_KS = 272;
__device__ __forceinline__ void peer_top16(const bf16* qrow  , const LAS unsigned char* kl  , int hf, float (&L)[16]) {
    bf16x8 qf[8];
#pragma unroll
    for (int kk = 0; kk < 8; ++kk) qf[kk] = *(const GAS bf16x8*)(qrow + 16 * kk);
#pragma unroll 1
    for (int kt = 0; kt < 4; ++kt) {
        f32x16 sa;
#pragma unroll
        for (int r = 0; r < 16; ++r) sa[r] = 0.f;
#pragma unroll
        for (int kk = 0; kk < 8; ++kk) sa = MFMA32(*(const LAS bf16x8*)(kl + kt * 32 * PK_KS + 32 * kk), qf[kk], sa);
        float T[16];
#pragma unroll
        for (int r = 0; r < 16; ++r) { const unsigned idx = (unsigned)(kt * 32 + (r & 3) + 8 * (r >> 2) + 4 * hf); T[r] = __uint_as_float((__float_as_uint(sa[r]) & ~127u) | idx); }
        sort16_desc(T);
        if (kt == 0) {
#pragma unroll
            for (int i = 0; i < 16; ++i) L[i] = T[i];
        } else top16_merge(L, T);
    }
    float P[16];
#pragma unroll
    for (int i = 0; i < 16; ++i) P[i] = __shfl_xor(L[i], 32);
    top16_merge(L, P);
}
__device__ __forceinline__ void peer_select32(int hd, int n0, int lane, const bf16* qpeer, const LAS unsigned char* kl1, const LAS unsigned char* kl2, unsigned char* wsb, LAS unsigned* ldsw) {
    asm volatile("" : "+v"(lane));
    const int c = lane & 31, hf = lane >> 5, n = n0 + c;
    const bf16* qrow = qpeer + (size_t)n * 2048 + hd * 256 + 8 * hf;
    float A[16], B[16];
    peer_top16(qrow, kl1 + c * PK_KS + 16 * hf, hf, A);
    peer_top16(qrow + 128, kl2 + c * PK_KS + 16 * hf, hf, B);
#define PKV(x) __uint_as_float(__float_as_uint(x) & ~127u)
#define PKI(x) ((int)(__float_as_uint(x) & 127u))
    float W[16];
    { float C0[16], C1[16], C2[16], E0 = 0.f, E1 = 0.f; unsigned id = 0;
#pragma unroll
      for (int a = 0; a < 16; ++a)
#pragma unroll
        for (int b = 0; b < 16; ++b) if ((a + 1) * (b + 1) <= 16) { const float pk = __uint_as_float((__float_as_uint(PKV(A[a]) + PKV(B[b])) & ~63u) | id);
            if (id < 16) C0[id] = pk; else if (id < 32) C1[id - 16] = pk; else if (id < 48) C2[id - 32] = pk; else if (id == 48) E0 = pk; else E1 = pk;
            ++id; }
      sort16_desc(C0); sort16_desc(C1); sort16_desc(C2);
      top16_merge(C0, C1); top16_merge(C0, C2);
#pragma unroll
      for (int i = 0; i < 16; ++i) W[i] = C0[i];
      ins16(W, E0); ins16(W, E1); }
    const float thr = W[15], mx = W[0];
    int cnt = 0; float ssum = 0.f;
    LAS int* le = (LAS int*)ldsw + c * 16; LAS float* lg = (LAS float*)ldsw + 512 + c * 16;
    { unsigned id = 0;
#pragma unroll
      for (int a = 0; a < 16; ++a)
#pragma unroll
        for (int b = 0; b < 16; ++b) if ((a + 1) * (b + 1) <= 16) {
            const float cv = PKV(A[a]) + PKV(B[b]); const float pk = __uint_as_float((__float_as_uint(cv) & ~63u) | id); ++id;
            if (pk >= thr) { const float e = __expf(cv - mx); if (hf == 0) { le[cnt] = PKI(A[a]) * 128 + PKI(B[b]); lg[cnt] = e; } ssum += e; ++cnt; }
        } }
    LDS_WAIT();
    asm volatile("" : "+s"(wsb));
    int* sel_e = (int*)(wsb + WS_SEL); float* sel_g = (float*)(wsb + WS_SEL + 8 * MiB); float* sel_s = (float*)(wsb + WS_SELS);
    { int lane3 = lane; asm volatile("" : "+v"(lane3)); const int t = lane3 >> 1, part = lane3 & 1;
      const v4u e0 = *(const LAS v4u*)((LAS int*)ldsw + t * 16 + 8 * part), e1 = *(const LAS v4u*)((LAS int*)ldsw + t * 16 + 8 * part + 4);
      const v4u g0 = *(const LAS v4u*)((LAS int*)ldsw + 512 + t * 16 + 8 * part), g1 = *(const LAS v4u*)((LAS int*)ldsw + 512 + t * 16 + 8 * part + 4);
      GAS v4u* pe = (GAS v4u*)(sel_e + (size_t)(n0 + t) * 128 + hd * 16 + 8 * part); GAS v4u* pg = (GAS v4u*)(sel_g + (size_t)(n0 + t) * 128 + hd * 16 + 8 * part);
      pe[0] = e0; pe[1] = e1; pg[0] = g0; pg[1] = g1; }
    LDS_WAIT();
    { int lane4 = lane; asm volatile("" : "+v"(lane4)); if ((lane4 >> 5) == 0) ((GAS float*)sel_s)[(size_t)(n0 + (lane4 & 31)) * 8 + hd] = ssum; }
}

__device__ __forceinline__ float dot2bf(unsigned a, unsigned b, float acc) {
    return __builtin_amdgcn_fdot2_f32_bf16(__builtin_bit_cast(bf16v2, a), __builtin_bit_cast(bf16v2, b), acc, false);
}
__device__ __forceinline__ float dot8bf(const v4u a, const v4u b, float acc) {
    const unsigned a0 = a.x, a1 = a.y, a2 = a.z, a3 = a.w, b0 = b.x, b1 = b.y, b2 = b.z, b3 = b.w;
    acc = dot2bf(a0, b0, acc); acc = dot2bf(a1, b1, acc); acc = dot2bf(a2, b2, acc); acc = dot2bf(a3, b3, acc);
    return acc;
}
__device__ __forceinline__ void unpack16(const v4u q, float (&f)[16]) {
    const unsigned d0 = q.x, d1 = q.y, d2 = q.z, d3 = q.w;
    f32x2v t;
    t = __builtin_amdgcn_cvt_pk_f32_fp8((int)d0, false); f[0] = t.x; f[1] = t.y; t = __builtin_amdgcn_cvt_pk_f32_fp8((int)d0, true); f[2] = t.x; f[3] = t.y;
    t = __builtin_amdgcn_cvt_pk_f32_fp8((int)d1, false); f[4] = t.x; f[5] = t.y; t = __builtin_amdgcn_cvt_pk_f32_fp8((int)d1, true); f[6] = t.x; f[7] = t.y;
    t = __builtin_amdgcn_cvt_pk_f32_fp8((int)d2, false); f[8] = t.x; f[9] = t.y; t = __builtin_amdgcn_cvt_pk_f32_fp8((int)d2, true); f[10] = t.x; f[11] = t.y;
    t = __builtin_amdgcn_cvt_pk_f32_fp8((int)d3, false); f[12] = t.x; f[13] = t.y; t = __builtin_amdgcn_cvt_pk_f32_fp8((int)d3, true); f[14] = t.x; f[15] = t.y;
}
struct SliceSched { int mode, xcc, rank, nloc; };
__device__ __forceinline__ SliceSched slice_sched_init(const Ctx& c, unsigned* ctl, const XcdBarrier& bar, int use) {
    LAS int* sh = (LAS int*)(c.lds + 1024);
    if (c.tid == 0) {
        int ok = 1; unsigned tot = 0;
        for (int j = 0; j < 16; ++j) { const unsigned n = xb_ld(&bar.bar[XB_XCNT(j)]); tot += n; if ((j < 8) != (n > 0u)) ok = 0; }
        if (tot != (unsigned)c.G) ok = 0;
        const int xcc = (int)xb_xcc_id();
        int rank = 0, nloc = 1;
        if (ok) { nloc = (int)xb_ld(&bar.bar[XB_XCNT(xcc)]); rank = (int)xb_add(&ctl[CW_RANK + (use * 16 + xcc) * 64], 1u); if (rank >= nloc) ok = 0; }
        sh[0] = ok; sh[1] = xcc; sh[2] = rank; sh[3] = nloc;
    }
    __syncthreads();
    SliceSched S; S.mode = sh[0]; S.xcc = sh[1]; S.rank = sh[2]; S.nloc = sh[3];
    __syncthreads();
    return S;
}
__device__ __forceinline__ bool slice_item(const SliceSched& S, const Ctx& c, int i, int& slice, int& tb) {
    if (S.mode) { const int it = S.rank + i * S.nloc; if (it >= 512) return false; slice = S.xcc + 8 * (it >> 8); tb = it & 255; return true; }
    const int it = (int)blockIdx.x + i * c.G; if (it >= 4096) return false; slice = it >> 8; tb = it & 255; return true;
}
__device__ __forceinline__ void unpack16p(const v4u q, f32x2v (&f)[8]) {
    const unsigned d0 = q.x, d1 = q.y, d2 = q.z, d3 = q.w;
    f[0] = __builtin_amdgcn_cvt_pk_f32_fp8((int)d0, false); f[1] = __builtin_amdgcn_cvt_pk_f32_fp8((int)d0, true);
    f[2] = __builtin_amdgcn_cvt_pk_f32_fp8((int)d1, false); f[3] = __builtin_amdgcn_cvt_pk_f32_fp8((int)d1, true);
    f[4] = __builtin_amdgcn_cvt_pk_f32_fp8((int)d2, false); f[5] = __builtin_amdgcn_cvt_pk_f32_fp8((int)d2, true);
    f[6] = __builtin_amdgcn_cvt_pk_f32_fp8((int)d3, false); f[7] = __builtin_amdgcn_cvt_pk_f32_fp8((int)d3, true);
}
__device__ __forceinline__ void peer_sddmm_wave(int t0, int s, int lane, const bf16* H, const unsigned char* UQ, const int* sel_e, float* part, LAS unsigned* ldsw) {
    const int cg = lane & 7, sg = lane >> 3;
#pragma unroll
    for (int j = 0; j < 4; ++j) *(LAS v4u*)(ldsw + 4 * (lane + 64 * j)) = *(const GAS v4u*)(sel_e + (size_t)t0 * 128 + 4 * (lane + 64 * j));
    LDS_WAIT();
    const unsigned char* ubase = UQ + s * 128 + cg * 16;
    v4u qn[16];
    { int id[16];
#pragma unroll
      for (int q = 0; q < 4; ++q) { const v4u v = *(const LAS v4u*)(ldsw + sg * 16 + 4 * q); id[4 * q] = (int)v.x; id[4 * q + 1] = (int)v.y; id[4 * q + 2] = (int)v.z; id[4 * q + 3] = (int)v.w; }
#pragma unroll
      for (int it = 0; it < 16; ++it) qn[it] = *(const GAS v4u*)(ubase + (size_t)id[it] * 2048); }
    const bf16* hbase = H + (size_t)t0 * 2048 + s * 128 + cg * 16;
    v4u han = *(const GAS v4u*)(hbase), hbn = *(const GAS v4u*)(hbase + 8);
#pragma unroll 1
    for (int k = 0; k < 8; ++k) {
        const int t = t0 + k;
        v4u qc[16];
#pragma unroll
        for (int it = 0; it < 16; ++it) qc[it] = qn[it];
        const v4u ha = han, hb = hbn;
        if (k < 7) { han = *(const GAS v4u*)(hbase + (size_t)(k + 1) * 2048); hbn = *(const GAS v4u*)(hbase + (size_t)(k + 1) * 2048 + 8); }
        if (k < 7) { int id[16];
#pragma unroll
            for (int q = 0; q < 4; ++q) { const v4u v = *(const LAS v4u*)(ldsw + (k + 1) * 128 + sg * 16 + 4 * q); id[4 * q] = (int)v.x; id[4 * q + 1] = (int)v.y; id[4 * q + 2] = (int)v.z; id[4 * q + 3] = (int)v.w; }
#pragma unroll
            for (int it = 0; it < 16; ++it) qn[it] = *(const GAS v4u*)(ubase + (size_t)id[it] * 2048); }
        float h[16] = {bflo(ha.x), bfhi(ha.x), bflo(ha.y), bfhi(ha.y), bflo(ha.z), bfhi(ha.z), bflo(ha.w), bfhi(ha.w), bflo(hb.x), bfhi(hb.x), bflo(hb.y), bfhi(hb.y), bflo(hb.z), bfhi(hb.z), bflo(hb.w), bfhi(hb.w)};
        float hm = 0.f;
#pragma unroll
        for (int j = 0; j < 16; ++j) hm = fmaxf(hm, fabsf(h[j]));
        hm = fmaxf(hm, __shfl_xor(hm, 1)); hm = fmaxf(hm, __shfl_xor(hm, 2)); hm = fmaxf(hm, __shfl_xor(hm, 4));
        const float hinv = hm > 0.f ? 127.0f / hm : 0.f, hs = hm * (1.0f / 127.0f);
        int hq[4];
#pragma unroll
        for (int j = 0; j < 4; ++j) hq[j] = (int)pack_i8x4(h[4 * j] * hinv, h[4 * j + 1] * hinv, h[4 * j + 2] * hinv, h[4 * j + 3] * hinv);
        float p[16];
#pragma unroll
        for (int it = 0; it < 16; ++it) { int a = __builtin_amdgcn_sdot4((int)qc[it].x, hq[0], 0, false); a = __builtin_amdgcn_sdot4((int)qc[it].y, hq[1], a, false);
            a = __builtin_amdgcn_sdot4((int)qc[it].z, hq[2], a, false); a = __builtin_amdgcn_sdot4((int)qc[it].w, hq[3], a, false);
            p[it] = (float)a * hs; }
#pragma unroll
        for (int i = 0; i < 8; ++i) { const bool up = (lane & 4) != 0; const float snd = up ? p[i] : p[i + 8], kp = up ? p[i + 8] : p[i]; p[i] = kp + __shfl_xor(snd, 4); }
#pragma unroll
        for (int i = 0; i < 4; ++i) { const bool up = (lane & 2) != 0; const float snd = up ? p[i] : p[i + 4], kp = up ? p[i + 4] : p[i]; p[i] = kp + __shfl_xor(snd, 2); }
#pragma unroll
        for (int i = 0; i < 2; ++i) { const bool up = (lane & 1) != 0; const float snd = up ? p[i] : p[i + 2], kp = up ? p[i + 2] : p[i]; p[i] = kp + __shfl_xor(snd, 1); }
        ((GAS unsigned*)part)[((size_t)t * 16 + s) * 64 + lane] = pk2c(p[0], p[1]);
    }
    LDS_WAIT();
}
__device__ __forceinline__ void peer_coef_tokens4(int t0, int ts, int lane, const float* part, const int* sel_e, float* sel_g, const float* sel_s, const float* US, const float* VS) {
    unsigned pv[4][16]; v2u e[4]; f32x2v g[4]; float dn[4];
#pragma unroll
    for (int i = 0; i < 4; ++i) { const int t = t0 + i * ts;
#pragma unroll
        for (int s = 0; s < 16; ++s) pv[i][s] = ((const GAS unsigned*)part)[((size_t)t * 16 + s) * 64 + lane];
        e[i] = *(const GAS v2u*)(sel_e + (size_t)t * 128 + 2 * lane); g[i] = *(const GAS f32x2v*)(sel_g + (size_t)t * 128 + 2 * lane); dn[i] = ((const GAS float*)sel_s)[(size_t)t * 8 + (lane >> 3)]; }
    float ux[4], uy[4], vx[4], vy[4];
#pragma unroll
    for (int i = 0; i < 4; ++i) { ux[i] = ((const GAS float*)US)[e[i].x]; uy[i] = ((const GAS float*)US)[e[i].y]; vx[i] = ((const GAS float*)VS)[e[i].x]; vy[i] = ((const GAS float*)VS)[e[i].y]; }
#pragma unroll
    for (int i = 0; i < 4; ++i) { const int t = t0 + i * ts; float a0 = 0.f, a1 = 0.f;
#pragma unroll
        for (int s = 0; s < 16; ++s) { a0 += bflo(pv[i][s]); a1 += bfhi(pv[i][s]); }
        const float inv = 1.0f / dn[i];
        const float ox = g[i].x * inv * gelu_exact(a0 * ux[i]) * vx[i], oy = g[i].y * inv * gelu_exact(a1 * uy[i]) * vy[i];
        const h2_t ha = {(_Float16)ox, (_Float16)ox}, hb = {(_Float16)oy, (_Float16)oy};
        *(GAS v2u*)(sel_g + (size_t)t * 128 + 2 * lane) = (v2u){__builtin_bit_cast(unsigned, ha), __builtin_bit_cast(unsigned, hb)}; }
}
__device__ __forceinline__ bool slice_item8(const SliceSched& S, const Ctx& c, int i, int& slice, int& tb) {
    if (S.mode) { const int it = S.rank + i * S.nloc; if (it >= 256) return false; slice = S.xcc; tb = it; return true; }
    const int it = (int)blockIdx.x + i * c.G; if (it >= 2048) return false; slice = it >> 8; tb = it & 255; return true;
}
__device__ __forceinline__ void spmm6_load(const unsigned char* vbase, const LAS unsigned* ids8, v4u (&qa)[8], v2u (&qb)[8]) {
    const v4u i0 = *(const LAS v4u*)(ids8), i1 = *(const LAS v4u*)(ids8 + 4);
    const unsigned id[8] = {i0.x, i0.y, i0.z, i0.w, i1.x, i1.y, i1.z, i1.w};
#pragma unroll
    for (int it = 0; it < 8; ++it) { const unsigned char* p = vbase + (size_t)id[it] * 1536; qa[it] = *(const GAS v4u*)p; qb[it] = *(const GAS v2u*)(p + 16); }
}
__device__ __forceinline__ void spmm6_fma(const v4u (&qa)[8], const v2u (&qb)[8], const LAS unsigned* cf8, h2_t (&y)[16]) {
    const v4u c0 = *(const LAS v4u*)(cf8), c1 = *(const LAS v4u*)(cf8 + 4);
    const unsigned cf[8] = {c0.x, c0.y, c0.z, c0.w, c1.x, c1.y, c1.z, c1.w};
#pragma unroll
    for (int it = 0; it < 8; ++it) { const v6u q = {qa[it].x, qa[it].y, qa[it].z, qa[it].w, qb[it].x, qb[it].y};
        const v32h_t f = __builtin_amdgcn_cvt_scalef32_pk32_f16_fp6(q, 1.0f); const h2_t c2 = __builtin_bit_cast(h2_t, cf[it]);
#pragma unroll
        for (int j = 0; j < 16; ++j) { const h2_t v = {f[2 * j], f[2 * j + 1]}; y[j] = __builtin_elementwise_fma(v, c2, y[j]); } }
}
__device__ __forceinline__ void peer_spmm6_wave(int t0, int s, int lane, const unsigned char* V6, const int* sel_e, const float* coef, const float* x1, float* xout, LAS unsigned* ldsw) {
    const int cg = lane & 7, sg = lane >> 3;
#pragma unroll
    for (int j = 0; j < 4; ++j) { *(LAS v4u*)(ldsw + 4 * (lane + 64 * j)) = *(const GAS v4u*)(sel_e + (size_t)t0 * 128 + 4 * (lane + 64 * j));
        *(LAS v4u*)(ldsw + 1024 + 4 * (lane + 64 * j)) = *(const GAS v4u*)(coef + (size_t)t0 * 128 + 4 * (lane + 64 * j)); }
    LDS_WAIT();
    const unsigned char* vbase = V6 + s * 192 + cg * 24;
    const LAS unsigned* idl = ldsw + sg * 16; const LAS unsigned* cfl = ldsw + 1024 + sg * 16;
    v4u qa0[8], qa1[8]; v2u qb0[8], qb1[8];
    spmm6_load(vbase, idl, qa0, qb0);
    const size_t xoff = (size_t)t0 * 2048 + s * 256 + cg * 32 + 4 * sg;
    f32x4 xn = *(const GAS f32x4*)(x1 + xoff);
#pragma unroll 1
    for (int k = 0; k < 8; ++k) {
        const f32x4 xv = xn;
        h2_t y[16];
#pragma unroll
        for (int j = 0; j < 16; ++j) y[j] = (h2_t){(_Float16)0.f, (_Float16)0.f};
        spmm6_load(vbase, idl + k * 128 + 8, qa1, qb1);
        if (k < 7) xn = *(const GAS f32x4*)(x1 + xoff + (size_t)(k + 1) * 2048);
        spmm6_fma(qa0, qb0, cfl + k * 128, y);
        if (k < 7) spmm6_load(vbase, idl + (k + 1) * 128, qa0, qb0);
        spmm6_fma(qa1, qb1, cfl + k * 128 + 8, y);
        unsigned u[16];
#pragma unroll
        for (int j = 0; j < 16; ++j) u[j] = __builtin_bit_cast(unsigned, y[j]);
#pragma unroll
        for (int i = 0; i < 8; ++i) { const bool up = (lane & 32) != 0; const unsigned snd = up ? u[i] : u[i + 8], kp = up ? u[i + 8] : u[i]; u[i] = __builtin_bit_cast(unsigned, __builtin_bit_cast(h2_t, kp) + __builtin_bit_cast(h2_t, (unsigned)__shfl_xor((int)snd, 32))); }
#pragma unroll
        for (int i = 0; i < 4; ++i) { const bool up = (lane & 16) != 0; const unsigned snd = up ? u[i] : u[i + 4], kp = up ? u[i + 4] : u[i]; u[i] = __builtin_bit_cast(unsigned, __builtin_bit_cast(h2_t, kp) + __builtin_bit_cast(h2_t, (unsigned)__shfl_xor((int)snd, 16))); }
#pragma unroll
        for (int i = 0; i < 2; ++i) { const bool up = (lane & 8) != 0; const unsigned snd = up ? u[i] : u[i + 2], kp = up ? u[i + 2] : u[i]; u[i] = __builtin_bit_cast(unsigned, __builtin_bit_cast(h2_t, kp) + __builtin_bit_cast(h2_t, (unsigned)__shfl_xor((int)snd, 8))); }
        const h2_t r0 = __builtin_bit_cast(h2_t, u[0]), r1 = __builtin_bit_cast(h2_t, u[1]);
        f32x4 o; o.x = xv.x + (float)r0[0]; o.y = xv.y + (float)r0[1]; o.z = xv.z + (float)r1[0]; o.w = xv.w + (float)r1[1];
        *(GAS f32x4*)(xout + xoff + (size_t)k * 2048) = o;
    }
    LDS_WAIT();
}

struct Args { const float* in[21]; float* out; unsigned char* ws; int lo, hi, li, pad; };
__global__ void __launch_bounds__(512, 2) mk_fwd(Args args) {
    extern __shared__ __attribute__((aligned(16))) unsigned char lds_raw[];
    Ctx c; c.lds = (LAS unsigned char*)lds_raw; c.tid = threadIdx.x; c.lane = c.tid & 63; c.wave = __builtin_amdgcn_readfirstlane(c.tid >> 6);
    c.G = gridDim.x; c.gw = blockIdx.x * 8 + c.wave; c.NGW = c.G * 8;
    volatile LAS unsigned* MISC = (volatile LAS unsigned*)(c.lds + MISC_OFF);
    if (c.tid < 32) MISC[c.tid] = 0u;
    __syncthreads();
    unsigned char* ws = args.ws;
    const int lo = args.lo, hi = args.hi;
    XcdBarrier bar; bar.w0 = 0; bar.bar = (unsigned*)(ws + WS_CTL) + CW_BAR + args.li * XCD_BAR_WORDS; bar.x = 0; bar.st = nullptr;
    if (hi - lo > 1) bar = xcd_barrier_post((unsigned*)(ws + WS_CTL) + CW_BAR + args.li * XCD_BAR_WORDS, MISC + 8);
#ifndef ATTN_REPS
#define ATTN_REPS 1
#endif
#ifndef PHMASK
#define PHMASK 0x1fff
#endif
#define IN(k) (((PHMASK >> ((k) % NPH)) & 1) && lo <= (k) && (k) < hi)
#define SEAM(k) do { if (IN(k) && IN((k) + 1)) xcd_barrier(bar); } while (0)
#define PH_BEGIN unsigned char* w = ws; float* outp = args.out; Ctx cc = c; int zi = 0; cc.lane = xb_lane_id(); cc.tid = cc.wave * 64 + cc.lane; \
    asm volatile("" : "+s"(w), "+s"(outp), "+s"(zi), "+v"(cc.tid), "+v"(cc.lane)); (void)w; (void)outp;
#define INP(k) (args.in[(k) + zi])
#define WSP(T, off) ((T*)(w + (off)))
    for (int l = 0; l < 2; ++l) {
        const int pb = l * NPH;
        if (IN(pb + 0)) { PH_BEGIN
            P0Args a; a.w_in = INP(2) + (size_t)l * DM * INW; a.w_br_sb = INP(11) + (size_t)l * BW * DM; a.w_br_hg = INP(12) + (size_t)l * BW * DM; a.w_br_conv = INP(13) + (size_t)l * BW * DM;
            a.w_o = INP(14) + (size_t)l * DM * DM; a.w_q = INP(16) + (size_t)l * DM * DM; a.u = INP(19) + (size_t)l * 16384 * 2048; a.v = INP(20) + (size_t)l * 16384 * 2048; a.lbp = INP(5);
            a.WinT = WSP(bf16, WS_WIN); a.WbrT = WSP(bf16, WS_WBR); a.WoT = WSP(bf16, WS_WO); a.WqT = WSP(bf16, WS_WQ); a.U = WSP(unsigned char, WS_U); a.V = WSP(unsigned char, WS_V); a.US = WSP(float, WS_US); a.VS = WSP(float, WS_VS); a.LB = WSP(float, WS_LB); a.layer = l; a.k1 = INP(17) + (size_t)l * 8 * 16384; a.k2 = INP(18) + (size_t)l * 8 * 16384; a.KB = WSP(bf16, WS_KEYS);
            p0_convert(cc, a);
            rms_phase_i8(cc, l == 0 ? INP(0) : WSP(const float, WS_X2), INP(1) + (size_t)l * DM, WSP(unsigned char, WS_H), WSP(float, WS_SA));
        }
        SEAM(pb + 0);
        if (IN(pb + 1)) { PH_BEGIN
            pg8::Gemm g{WSP(bf16, WS_H), WSP(bf16, WS_WIN), NTOK, INW, DM}; pg8::StaticOrder S; S.init(NTOK, INW, cc.G, (int)blockIdx.x);
            EpiIn E{WSP(bf16, WS_SEG), WSP(bf16, WS_GATE), WSP(float, WS_LB), WSP(float, WS_SA)};
            pg8::gemm_phase<EpiIn, pg8::StaticOrder, true, true, true>(cc.lds, g, S, E, cc.wave);
        }
        SEAM(pb + 1);
        if (IN(pb + 2)) { PH_BEGIN
            bf16* SEG = WSP(bf16, WS_SEG);
            conv_phase(cc, SEG + 7 * SEGSZ, INP(7) + (size_t)l * 31 * 1024, INP(8) + (size_t)l * 1024, INP(9) + (size_t)l * 1024, INP(10) + (size_t)l * 1024, WSP(bf16, WS_CONV));
            for (int ci = blockIdx.x; ci < 2048; ci += cc.G) hgA_chunk(cc, ci, SEG + 4 * SEGSZ, SEG + 5 * SEGSZ, WSP(bf16, WS_ST), WSP(float, WS_DEC));
            for (int r = cc.gw; r < 2 * (NTOK / 4); r += cc.NGW) {
                if (r < NTOK / 4) qknorm_rows4(SEG + (size_t)r * 4 * 1024, 1024, INP(3) + (size_t)l * 128, 0.08838834764831845f, cc.lane);
                else qknorm_rows4(SEG + SEGSZ + (size_t)(r - NTOK / 4) * 4 * 1024, 1024, INP(4) + (size_t)l * 128, 1.0f, cc.lane);
            }
            LAS unsigned short* scr = (LAS unsigned short*)(cc.lds + 4096 + cc.wave * 8192);
            for (int it = cc.gw; it < 8192; it += cc.NGW) vt_item(it, cc.lane, SEG + 2 * SEGSZ, WSP(bf16, WS_MERGED), scr);
        }
        SEAM(pb + 2);
        if (IN(pb + 3)) { PH_BEGIN
            bf16* SEG = WSP(bf16, WS_SEG);
            hgB(cc, WSP(bf16, WS_ST), WSP(float, WS_DEC));
            for (int rep = 0; rep < ATTN_REPS; ++rep)
            for (int p = blockIdx.x; p < 256; p += cc.G) { const int bh = (p & 7) * 4 + (p >> 6), j = (p >> 3) & 7;
                attn_unit(cc, bh, 15 - j, SEG, SEG + SEGSZ, WSP(bf16, WS_MERGED), SEG + 2 * SEGSZ); attn_unit(cc, bh, j, SEG, SEG + SEGSZ, WSP(bf16, WS_MERGED), SEG + 2 * SEGSZ); }
        }
        SEAM(pb + 3);
        if (IN(pb + 4)) { PH_BEGIN
            bf16* SEG = WSP(bf16, WS_SEG);
            for (int ci = blockIdx.x; ci < 2048; ci += cc.G) hgC_chunk(cc, ci, SEG + 3 * SEGSZ, SEG + 4 * SEGSZ, SEG + 5 * SEGSZ, SEG + 6 * SEGSZ, WSP(bf16, WS_ST), INP(6) + (size_t)l * 128, WSP(bf16, WS_HGR));
        }
        SEAM(pb + 4);
        if (IN(pb + 5)) { PH_BEGIN
            pg8::StaticOrder S; S.init(NTOK, DM, cc.G, (int)blockIdx.x);
            { pg8::Gemm g{WSP(bf16, WS_SEG) + 2 * SEGSZ, WSP(bf16, WS_WBR), NTOK, DM, BW}; EpiMerge<true> E{WSP(bf16, WS_GATE), WSP(bf16, WS_MERGED)}; pg8::gemm_phase<EpiMerge<true>, pg8::StaticOrder, true, true>(cc.lds, g, S, E, cc.wave); }
            { pg8::Gemm g{WSP(bf16, WS_HGR), WSP(bf16, WS_WBR) + (size_t)DM * BW, NTOK, DM, BW}; EpiMerge<false> E{WSP(bf16, WS_GATE) + (size_t)NTOK * 2048, WSP(bf16, WS_MERGED)}; pg8::gemm_phase<EpiMerge<false>, pg8::StaticOrder, true, true>(cc.lds, g, S, E, cc.wave); }
            { pg8::Gemm g{WSP(bf16, WS_CONV), WSP(bf16, WS_WBR) + (size_t)2 * DM * BW, NTOK, DM, BW}; EpiMerge<false> E{WSP(bf16, WS_GATE) + (size_t)2 * NTOK * 2048, WSP(bf16, WS_MERGED)}; pg8::gemm_phase<EpiMerge<false>, pg8::StaticOrder, true, true>(cc.lds, g, S, E, cc.wave); }
        }
        SEAM(pb + 5);
        if (IN(pb + 6)) { PH_BEGIN
            pg8::Gemm g{WSP(bf16, WS_MERGED), WSP(bf16, WS_WO), NTOK, DM, DM}; pg8::StaticOrder S; S.init(NTOK, DM, cc.G, (int)blockIdx.x);
            EpiResid E{l == 0 ? INP(0) : WSP(const float, WS_X2), outp};
            pg8::gemm_phase<EpiResid, pg8::StaticOrder, true, true>(cc.lds, g, S, E, cc.wave);
        }
        SEAM(pb + 6);
        if (IN(pb + 7)) { PH_BEGIN rms_phase(cc, outp, INP(15) + (size_t)l * DM, WSP(bf16, WS_H)); }
        SEAM(pb + 7);
        if (IN(pb + 8)) { PH_BEGIN
            pg8::Gemm g{WSP(bf16, WS_H), WSP(bf16, WS_WQ), NTOK, DM, DM}; pg8::StaticOrder S; S.init(NTOK, DM, cc.G, (int)blockIdx.x);
            EpiStoreBf16 E{WSP(bf16, WS_QPEER)};
            pg8::gemm_phase<EpiStoreBf16, pg8::StaticOrder, true, true>(cc.lds, g, S, E, cc.wave);
        }
        SEAM(pb + 8);
        if (IN(pb + 9)) { PH_BEGIN
            for (int item = blockIdx.x; item < 512; item += cc.G) { const int hd = item & 7, tg = item >> 3;
                const bf16* KB = WSP(bf16, WS_KEYS);
#pragma unroll
                for (int i = 0; i < 8; ++i) { const int p = cc.tid + 512 * i, li = p >> 11, row = (p >> 4) & 127, c16 = p & 15;
                    *(LAS v4u*)(cc.lds + li * 128 * PK_KS + row * PK_KS + c16 * 16) = *(const GAS v4u*)(KB + (size_t)(li * 8 + hd) * 16384 + row * 128 + c16 * 8); }
                __syncthreads();
                peer_select32(hd, tg * 256 + cc.wave * 32, cc.lane, WSP(bf16, WS_QPEER), cc.lds, cc.lds + 128 * PK_KS, w, (LAS unsigned*)(cc.lds + 2 * 128 * PK_KS + cc.wave * 4096));
                __syncthreads(); }
        }
        SEAM(pb + 9);
        if (IN(pb + 10)) { PH_BEGIN
            const SliceSched SS = slice_sched_init(cc, (unsigned*)(w + WS_CTL), bar, l * 2 + 0);
            for (int i = 0;; ++i) { int sl, tb; if (!slice_item(SS, cc, i, sl, tb)) break;
                peer_sddmm_wave(tb * 64 + cc.wave * 8, sl, cc.lane, WSP(bf16, WS_H), WSP(unsigned char, WS_U), WSP(int, WS_SEL), WSP(float, WS_PART), (LAS unsigned*)(cc.lds + 4096 + cc.wave * 8192)); }
        }
        SEAM(pb + 10);
        if (IN(pb + 11)) { PH_BEGIN
            for (int n = cc.gw; n < NTOK / 4; n += cc.NGW) peer_coef_tokens4(n, NTOK / 4, cc.lane, WSP(float, WS_PART), WSP(int, WS_SEL), WSP(float, WS_SEL + 8 * MiB), WSP(float, WS_SELS), WSP(float, WS_US), WSP(float, WS_VS));
        }
        SEAM(pb + 11);
        if (IN(pb + 12)) { PH_BEGIN
            float* xo = l == 0 ? WSP(float, WS_X2) : outp;
            const SliceSched SS = slice_sched_init(cc, (unsigned*)(w + WS_CTL), bar, l * 2 + 1);
            for (int i = 0;; ++i) { int sl, tb; if (!slice_item8(SS, cc, i, sl, tb)) break;
                peer_spmm6_wave(tb * 64 + cc.wave * 8, sl, cc.lane, WSP(unsigned char, WS_V), WSP(int, WS_SEL), WSP(float, WS_SEL + 8 * MiB), outp, xo, (LAS unsigned*)(cc.lds + 4096 + cc.wave * 8192)); }
        }
        SEAM(pb + 12);
    }
#undef PH_BEGIN
#undef INP
#undef WSP
#undef IN
#undef SEAM
}

#ifndef MK_SPLIT
#define MK_SPLIT 0
#endif
extern "C" void kernel_launch(void* const* d_in, const int* in_sizes, int n_in, void* d_out, int out_size, void* d_ws, size_t ws_size, hipStream_t stream) {
    static int grid = 0;
    if (grid == 0) {
        if (n_in != 21 || out_size != NTOK * DM || ws_size < WS_END) { fprintf(stderr, "kernel_launch: unexpected shapes (n_in %d, out %d, ws %zu < %zu); nothing launched\n", n_in, out_size, ws_size, (size_t)WS_END); grid = -1; return; }
        int dev = 0, cus = 0, per_cu = 0;
        if (hipGetDevice(&dev) != hipSuccess || hipDeviceGetAttribute(&cus, hipDeviceAttributeMultiprocessorCount, dev) != hipSuccess) { grid = -1; return; }
        if (hipFuncSetAttribute((const void*)mk_fwd, hipFuncAttributeMaxDynamicSharedMemorySize, LDS_BYTES) != hipSuccess) { fprintf(stderr, "kernel_launch: hipFuncSetAttribute failed\n"); grid = -1; return; }
        if (hipOccupancyMaxActiveBlocksPerMultiprocessor(&per_cu, (const void*)mk_fwd, 512, LDS_BYTES) != hipSuccess || per_cu < 1) fprintf(stderr, "kernel_launch: occupancy query reports %d\n", per_cu);
        (void)hipGetLastError();
        grid = cus;
    }
    if (grid < 0) return;
    if (hipMemsetAsync((char*)d_ws + WS_CTL, 0, 1 * MiB, stream) != hipSuccess) { fprintf(stderr, "kernel_launch: memset failed\n"); return; }
    Args a{};
    for (int i = 0; i < 21; ++i) a.in[i] = (const float*)d_in[i];
    a.out = (float*)d_out; a.ws = (unsigned char*)d_ws; a.pad = 0;
#if MK_SPLIT
    for (int p = 0; p < NPHASES; ++p) { a.lo = p; a.hi = p + 1; a.li = p; hipLaunchKernelGGL(mk_fwd, dim3(grid), dim3(512), LDS_BYTES, stream, a); }
#else
    a.lo = 0; a.hi = NPHASES; a.li = 0;
    hipLaunchKernelGGL(mk_fwd, dim3(grid), dim3(512), LDS_BYTES, stream, a);
#endif
    const hipError_t le = hipPeekAtLastError();
    if (le != hipSuccess) fprintf(stderr, "kernel_launch: launch failed: %s\n", hipGetErrorName(le));
}
```

```cpp
#include <hip/hip_runtime.h>
#include <cstdio>
#include <cstdint>
namespace pg8 {
#define PG8_LAS __attribute__((address_space(3)))
typedef unsigned short bf16_t;
typedef short bf16x8 __attribute__((ext_vector_type(8)));
typedef float f32x4 __attribute__((ext_vector_type(4)));
typedef unsigned u32x4 __attribute__((ext_vector_type(4)));
constexpr int BM = 256, BK = 64, HALF = 128, HTB = HALF * BK * 2  , STAGE_BYTES = 8 * HTB, NXCD = 8, WGM = 8;

__host__ __device__ __forceinline__ int lds_byte(int r, int c) { const int st = (r >> 4) * 2 + (c >> 5), rr = r & 15, cc = c & 31, ob = rr * 64 + cc * 2; return st * 1024 + (ob ^ (((ob >> 9) & 1) << 5)); }
__host__ __device__ __forceinline__ void stage_rc(int b, int& R, int& C) { const int st = b / 1024, sb = b % 1024, swz = sb ^ (((sb >> 9) & 1) << 5); R = (st >> 1) * 16 + swz / 64; C = (st & 1) * 32 + (swz % 64) / 2; }
__host__ __device__ __forceinline__ int perm32(int rho) { const int n = rho >> 4, i = rho & 15; return 8 * (i >> 2) + 4 * n + (i & 3); }

struct Unit { int pm, pn; };
struct Gemm { const bf16_t* A; const bf16_t* Bt; int M, N, K; };

struct StaticOrder {
    int nM, nN, nwg, G, c;
    __host__ __device__ void init(int M, int N, int G_, int c_) { nM = M / BM; nN = N / BM; nwg = nM * nN; G = G_; c = c_; }
    __host__ __device__ bool next(int i, Unit& u) const {
        const long L = (long)i * G + c; if (L >= nwg) return false;
        int wgid = (int)L; { const int q = nwg / NXCD, r = nwg % NXCD, xcd = wgid % NXCD, off = wgid / NXCD; wgid = (xcd < r ? xcd * (q + 1) : r * (q + 1) + (xcd - r) * q) + off; }
        const int nig = WGM * nN, gid = wgid / nig, fm = gid * WGM, gsz = (nM - fm) < WGM ? (nM - fm) : WGM;
        u.pm = fm + ((wgid % nig) % gsz); u.pn = (wgid % nig) / gsz; return true;
    }
    __device__ __forceinline__ void a_ready(const Unit&) const {}
    __device__ __forceinline__ void done(const Unit&) const {}
};

typedef float f32x2 __attribute__((ext_vector_type(2)));
template <class Epi, class Sched, bool ALIGN_EPI = false, bool SP2 = false, bool I8 = false>
__device__ __forceinline__ void gemm_phase(PG8_LAS unsigned char* lds, const Gemm g, const Sched& S, const Epi& E, int wave_) {
    unsigned z_ = 0u; asm volatile("" : "+s"(z_)); int tid_ = wave_ * 64 + (int)__builtin_amdgcn_mbcnt_hi(~0u, __builtin_amdgcn_mbcnt_lo(~0u, z_)); asm volatile("" : "+v"(tid_));     int K_ = g.K; asm volatile("" : "+s"(K_));
    const int tid = tid_, wid = __builtin_amdgcn_readfirstlane(tid >> 6), lane = tid & 63, wr = wid >> 2, wc = wid & 3, fr = lane & 15, fq = lane >> 4;
    const int K = I8 ? (K_ >> 1) : K_, nt = K / BK;
    unsigned voffA[2], voffB[2];
#pragma unroll
    for (int i = 0; i < 2; ++i) { int R, C; stage_rc(tid * 16 + i * 8192, R, C); const int Rb = Epi::PERM ? ((R & ~31) + perm32(R & 31)) : R;
        voffA[i] = (unsigned)(R * K + C) * 2u; voffB[i] = (unsigned)(Rb * K + C) * 2u; }
    const size_t kstep = (size_t)(BK * 2);
    const size_t hstep = (size_t)HALF * K * 2;
    const size_t tstep = 2 * hstep;
    const unsigned ldsw = (unsigned)wid * 1024u;
    const int aoff = lds_byte(wr * 64 + fr, fq * 8), boff = lds_byte(wc * 32 + fr, fq * 8);
#define PG8_SA(b, h) (((b) * 2 + (h)) * HTB)
#define PG8_SB(b, h) ((4 + (b) * 2 + (h)) * HTB)
#define PG8_STAGE(bufoff, gbase, voff) do { _Pragma("unroll") for (int _i = 0; _i < 2; ++_i) \
        __builtin_amdgcn_global_load_lds((const unsigned*)((const char*)(gbase) + (voff)[_i]), (PG8_LAS unsigned*)(lds + (bufoff) + ldsw + _i * 8192), 16, 0, 0); } while (0)
#define PG8_LDA(dst, b, h) do { _Pragma("unroll") for (int m = 0; m < 4; ++m) _Pragma("unroll") for (int k = 0; k < 2; ++k) dst[m][k] = *(const PG8_LAS bf16x8*)(lds + PG8_SA(b, h) + aoff + m * 2048 + k * 1024); } while (0)
#define PG8_LDB(dst, b, h) do { _Pragma("unroll") for (int n = 0; n < 2; ++n) _Pragma("unroll") for (int k = 0; k < 2; ++k) dst[n][k] = *(const PG8_LAS bf16x8*)(lds + PG8_SB(b, h) + boff + n * 2048 + k * 1024); } while (0)
#define PG8_MMA(ai, bj, At, Bt) do { __builtin_amdgcn_s_setprio(1); _Pragma("unroll") for (int m = 0; m < 4; ++m) _Pragma("unroll") for (int n = 0; n < 2; ++n) _Pragma("unroll") for (int k = 0; k < 2; ++k) { \
        if constexpr (I8) { typedef int v4i_t __attribute__((ext_vector_type(4))); \
            acc[ai][bj][m][n] = __builtin_bit_cast(f32x4, __builtin_amdgcn_mfma_i32_16x16x64_i8(__builtin_bit_cast(v4i_t, Bt[n][k]), __builtin_bit_cast(v4i_t, At[m][k]), __builtin_bit_cast(v4i_t, acc[ai][bj][m][n]), 0, 0, 0)); } \
        else acc[ai][bj][m][n] = __builtin_amdgcn_mfma_f32_16x16x32_bf16(Bt[n][k], At[m][k], acc[ai][bj][m][n], 0, 0, 0); } __builtin_amdgcn_s_setprio(0); } while (0)
#define PG8_WAIT_V(n) asm volatile("s_waitcnt vmcnt(" #n ")" ::: "memory")
#define PG8_WAIT_L(n) asm volatile("s_waitcnt lgkmcnt(" #n ")" ::: "memory")
#define PG8_BAR __builtin_amdgcn_s_barrier()
#define PG8_SCHED __builtin_amdgcn_sched_barrier(0)
    Unit cur, nxt; int ui = 0;
    if (!S.next(0, cur)) return;
    f32x4 acc[2][2][4][2];
#pragma unroll
    for (int a = 0; a < 2; ++a)
#pragma unroll
        for (int b = 0; b < 2; ++b)
#pragma unroll
            for (int m = 0; m < 4; ++m)
#pragma unroll
                for (int n = 0; n < 2; ++n) acc[a][b][m][n] = (f32x4){0.f, 0.f, 0.f, 0.f};
    bf16x8 At[4][2], B0[2][2], B1[2][2];
    const char* cA = (const char*)g.A + (size_t)cur.pm * tstep; const char* cB = (const char*)g.Bt + (size_t)cur.pn * tstep;
    S.a_ready(cur);
    if constexpr (SP2) {
        PG8_STAGE(PG8_SB(0, 0), cB, voffB); PG8_STAGE(PG8_SB(0, 1), cB + hstep, voffB); PG8_STAGE(PG8_SA(0, 0), cA, voffA); PG8_STAGE(PG8_SA(0, 1), cA + hstep, voffA);
        if (wr == 1) PG8_BAR;
        PG8_WAIT_V(2); PG8_BAR;
        PG8_STAGE(PG8_SB(1, 0), cB + kstep, voffB); PG8_STAGE(PG8_SA(1, 0), cA + kstep, voffA); PG8_STAGE(PG8_SB(1, 1), cB + hstep + kstep, voffB);
        PG8_WAIT_V(6); PG8_BAR;
    } else {
        PG8_STAGE(PG8_SB(0, 0), cB, voffB); PG8_STAGE(PG8_SA(0, 0), cA, voffA); PG8_STAGE(PG8_SB(0, 1), cB + hstep, voffB); PG8_STAGE(PG8_SA(0, 1), cA + hstep, voffA);
        if (wr == 1) PG8_BAR;
        PG8_WAIT_V(4); PG8_BAR;
        PG8_STAGE(PG8_SB(1, 0), cB + kstep, voffB); PG8_STAGE(PG8_SA(1, 0), cA + kstep, voffA); PG8_STAGE(PG8_SB(1, 1), cB + hstep + kstep, voffB);
        PG8_WAIT_V(6); PG8_BAR;
    }
    for (;;) {
        const bool has_next = S.next(ui + 1, nxt);
        const char* nA = has_next ? (const char*)g.A + (size_t)nxt.pm * tstep : cA; const char* nB = has_next ? (const char*)g.Bt + (size_t)nxt.pn * tstep : cB;
        for (int t = 0; t < nt; t += 2) {
            const bool last = (t == nt - 2);
            const char* a1 = cA + (size_t)(t + 1) * kstep;
            const char* a2 = last ? nA : cA + (size_t)(t + 2) * kstep; const char* b2 = last ? nB : cB + (size_t)(t + 2) * kstep;
            const char* a3 = a2 + kstep; const char* b3 = b2 + kstep;
            if (last && has_next) S.a_ready(nxt);
            if constexpr (SP2) {
            PG8_LDB(B0, 0, 0); PG8_LDB(B1, 0, 1); PG8_SCHED; PG8_LDA(At, 0, 0); PG8_STAGE(PG8_SA(1, 1), a1 + hstep, voffA);
            PG8_WAIT_V(8); PG8_WAIT_L(0); PG8_BAR; PG8_MMA(0, 0, At, B0); PG8_MMA(0, 1, At, B1); PG8_BAR; PG8_SCHED;
            PG8_LDA(At, 0, 1); PG8_STAGE(PG8_SB(0, 0), b2, voffB); PG8_STAGE(PG8_SB(0, 1), b2 + hstep, voffB); PG8_STAGE(PG8_SA(0, 0), a2, voffA);
            PG8_WAIT_V(8); PG8_WAIT_L(0); PG8_BAR; PG8_MMA(1, 0, At, B0); PG8_MMA(1, 1, At, B1); PG8_BAR; PG8_SCHED;
            PG8_LDB(B0, 1, 0); PG8_LDB(B1, 1, 1); PG8_SCHED; PG8_LDA(At, 1, 0); PG8_STAGE(PG8_SA(0, 1), a2 + hstep, voffA);
            PG8_WAIT_V(8); PG8_WAIT_L(0); PG8_BAR; PG8_MMA(0, 0, At, B0); PG8_MMA(0, 1, At, B1); PG8_BAR; PG8_SCHED;
            PG8_LDA(At, 1, 1); PG8_STAGE(PG8_SB(1, 0), b3, voffB); PG8_STAGE(PG8_SB(1, 1), b3 + hstep, voffB); PG8_STAGE(PG8_SA(1, 0), a3, voffA);
            PG8_WAIT_V(8); PG8_WAIT_L(0); PG8_BAR; PG8_MMA(1, 0, At, B0); PG8_MMA(1, 1, At, B1); PG8_BAR; PG8_SCHED;
            } else {
            PG8_LDB(B0, 0, 0); PG8_SCHED; PG8_LDA(At, 0, 0); PG8_STAGE(PG8_SA(1, 1), a1 + hstep, voffA);
            PG8_WAIT_L(8); PG8_BAR; PG8_WAIT_L(0); PG8_MMA(0, 0, At, B0); PG8_BAR; PG8_SCHED;
            PG8_LDB(B1, 0, 1); PG8_STAGE(PG8_SB(0, 0), b2, voffB);
            PG8_BAR; PG8_WAIT_L(0); PG8_MMA(0, 1, At, B1); PG8_BAR;
            PG8_LDA(At, 0, 1); PG8_STAGE(PG8_SA(0, 0), a2, voffA);
            PG8_BAR; PG8_WAIT_L(0); PG8_MMA(1, 0, At, B0); PG8_BAR; PG8_SCHED;
            PG8_STAGE(PG8_SB(0, 1), b2 + hstep, voffB);
            PG8_WAIT_V(6); PG8_BAR; PG8_MMA(1, 1, At, B1); PG8_BAR;
            PG8_LDB(B0, 1, 0); PG8_SCHED; PG8_LDA(At, 1, 0); PG8_STAGE(PG8_SA(0, 1), a2 + hstep, voffA);
            PG8_WAIT_L(8); PG8_BAR; PG8_WAIT_L(0); PG8_MMA(0, 0, At, B0); PG8_BAR; PG8_SCHED;
            PG8_LDB(B1, 1, 1); PG8_STAGE(PG8_SB(1, 0), b3, voffB);
            PG8_BAR; PG8_WAIT_L(0); PG8_MMA(0, 1, At, B1); PG8_BAR;
            PG8_LDA(At, 1, 1); PG8_STAGE(PG8_SA(1, 0), a3, voffA);
            PG8_BAR; PG8_WAIT_L(0); PG8_MMA(1, 0, At, B0); PG8_BAR; PG8_SCHED;
            PG8_STAGE(PG8_SB(1, 1), b3 + hstep, voffB);
            PG8_WAIT_V(6); PG8_BAR; PG8_MMA(1, 1, At, B1); PG8_BAR;
            }
        }
        if constexpr (ALIGN_EPI) { if (wr == 0) PG8_BAR; }
        if constexpr (I8) {
#pragma unroll
            for (int a = 0; a < 2; ++a)
#pragma unroll
                for (int m = 0; m < 4; ++m) { const float r_ = E.rowscale(cur.pm * BM + wr * 64 + fr + a * HALF + m * 16);
#pragma unroll
                    for (int b = 0; b < 2; ++b)
#pragma unroll
                        for (int n = 0; n < 2; ++n) { typedef int v4i2_t __attribute__((ext_vector_type(4))); const v4i2_t i_ = __builtin_bit_cast(v4i2_t, acc[a][b][m][n]);
                            acc[a][b][m][n] = (f32x4){(float)i_[0] * r_, (float)i_[1] * r_, (float)i_[2] * r_, (float)i_[3] * r_}; } }
        }
        if constexpr (!Epi::AFTER_DRAIN) { E(acc, cur, wr, wc, fr, fq); S.done(cur); }
        if (!has_next) break;
#pragma unroll
        for (int a = 0; a < 2; ++a)
#pragma unroll
            for (int b = 0; b < 2; ++b)
#pragma unroll
                for (int m = 0; m < 4; ++m)
#pragma unroll
                    for (int n = 0; n < 2; ++n) acc[a][b][m][n] = (f32x4){0.f, 0.f, 0.f, 0.f};
        cur = nxt; cA = nA; cB = nB; ++ui;
        if constexpr (ALIGN_EPI) { if (wr == 1) PG8_BAR; }
    }
    PG8_WAIT_V(0);
    if constexpr (!ALIGN_EPI) { if (wr == 0) PG8_BAR; }
    PG8_BAR;
    if constexpr (Epi::AFTER_DRAIN) { E.fused(acc, cur, wr, wc, fr, fq, lds, wid, lane); S.done(cur); }
#undef PG8_SA
#undef PG8_SB
#undef PG8_STAGE
#undef PG8_LDA
#undef PG8_LDB
#undef PG8_MMA
#undef PG8_WAIT_V
#undef PG8_WAIT_L
#undef PG8_BAR
#undef PG8_SCHED
}
}
#define XB_TMO      128
#define XB_XCNT(j)  (256  + 64 * (j))
#define XB_XSUB(j)  (1280 + 64 * (j))
#define XB_XGEN(j)  (2304 + 64 * (j))
#define XB_TOP      3328
#define XB_TOPGEN   3392
#define XCD_BAR_WORDS 3456
#define XB_SPIN_CAP (1u << 24)
#define LAS __attribute__((address_space(3)))

__device__ __forceinline__ unsigned xb_ld(unsigned* p)              { return __hip_atomic_load(p, __ATOMIC_RELAXED, __HIP_MEMORY_SCOPE_AGENT); }
__device__ __forceinline__ unsigned xb_add(unsigned* p, unsigned v) { return __hip_atomic_fetch_add(p, v, __ATOMIC_RELAXED, __HIP_MEMORY_SCOPE_AGENT); }
__device__ __forceinline__ unsigned xb_xcc_id() { return (unsigned)__builtin_amdgcn_s_getreg((3 << 11) | 20) & 0xFu; }
#define XB_SPIN(cond, bar) do { unsigned _sp = 0; while (cond) { __builtin_amdgcn_s_sleep(1); \
    if ((++_sp & 255u) == 0u) { if (xb_ld(&(bar)[XB_TMO])) break; if (_sp > XB_SPIN_CAP) { atomicAdd(&(bar)[XB_TMO], 1u); break; } } } } while (0)

__device__ __forceinline__ int xb_lane_id() { unsigned z = 0u; asm volatile("" : "+s"(z)); return (int)__builtin_amdgcn_mbcnt_hi(~0u, __builtin_amdgcn_mbcnt_lo(~0u, z)); }
struct XcdBarrier {
    unsigned w0;
    unsigned* bar; unsigned x;
    volatile LAS unsigned* st;
};

__device__ __forceinline__ XcdBarrier xcd_barrier_post(unsigned* bar, volatile LAS unsigned* st) {
    XcdBarrier b; b.bar = bar; b.x = xb_xcc_id(); b.st = st; b.w0 = (__builtin_amdgcn_readfirstlane((int)threadIdx.x >> 6) == 0) ? 1u : 0u;
    if (b.w0 && xb_lane_id() == 0) (void)xb_add(&bar[XB_XCNT(b.x)], 1u);
    return b;
}
__device__ __forceinline__ void xcd_barrier_complete(unsigned* bar, unsigned x, unsigned& nloc, unsigned& nx) {
    const unsigned G = gridDim.x * gridDim.y * gridDim.z;
    unsigned sum, cnt, mine, sp = 0u;
    for (;;) {
        sum = 0u; cnt = 0u; mine = 0u;
#pragma unroll
        for (unsigned j = 0; j < 16; ++j) { const unsigned c = xb_ld(&bar[XB_XCNT(j)]); sum += c; cnt += (c > 0u) ? 1u : 0u; mine = (j == x) ? c : mine; }
        if (sum == G) break;
        __builtin_amdgcn_s_sleep(1);
        if ((++sp & 255u) == 0u) { if (xb_ld(&bar[XB_TMO])) break; if (sp > XB_SPIN_CAP) { atomicAdd(&bar[XB_TMO], 1u); break; } }
    }
    nloc = mine > 0u ? mine : 1u; nx = cnt > 0u ? cnt : 1u;
}

__device__ __forceinline__ void xcd_barrier(const XcdBarrier& b) {
    asm volatile("s_waitcnt vmcnt(0)" ::: "memory");
    __syncthreads();
    if (b.w0 && xb_lane_id() == 0) {
        unsigned* bar = b.bar;
        __builtin_amdgcn_s_waitcnt(0);
        unsigned nloc = b.st[0], nx = b.st[1];
        if (nloc == 0u) { xcd_barrier_complete(bar, b.x, nloc, nx); b.st[0] = nloc; b.st[1] = nx; }
        const unsigned old = xb_add(&bar[XB_XSUB(b.x)], 1u);
        const unsigned gen = old / nloc;
        if (old + 1u == (gen + 1u) * nloc) {
            __builtin_amdgcn_fence(__ATOMIC_RELEASE, "agent");
            asm volatile("s_waitcnt vmcnt(0)" ::: "memory");
            const unsigned og = xb_add(&bar[XB_TOP], 1u);
            const unsigned tg = og / nx;
            if (og + 1u == (tg + 1u) * nx) xb_add(&bar[XB_TOPGEN], 1u);
            else XB_SPIN(xb_ld(&bar[XB_TOPGEN]) == tg, bar);
            __builtin_amdgcn_fence(__ATOMIC_ACQUIRE, "agent");
            xb_add(&bar[XB_XGEN(b.x)], 1u);
            asm volatile("s_waitcnt vmcnt(0)" ::: "memory");
        } else {
            XB_SPIN(xb_ld(&bar[XB_XGEN(b.x)]) == gen, bar);
            __builtin_amdgcn_fence(__ATOMIC_ACQUIRE, "agent");
            asm volatile("s_waitcnt vmcnt(0)" ::: "memory");
        }
    }
    __syncthreads();
}


#define GAS __attribute__((address_space(1)))
typedef unsigned short bf16;
typedef unsigned v4u __attribute__((ext_vector_type(4)));
typedef unsigned v2u __attribute__((ext_vector_type(2)));
typedef float f32x4 __attribute__((ext_vector_type(4)));
typedef float f32x2v __attribute__((ext_vector_type(2)));
typedef float f32x16 __attribute__((ext_vector_type(16)));
typedef short bf16x8 __attribute__((ext_vector_type(8)));
typedef __bf16 bf16v2 __attribute__((ext_vector_type(2)));
typedef _Float16 h2_t __attribute__((ext_vector_type(2)));
typedef _Float16 v32h_t __attribute__((ext_vector_type(32)));
typedef unsigned v6u __attribute__((ext_vector_type(6)));

constexpr int NTOK = 16384, DM = 2048, SEQ = 4096, INW = 15360, BW = 1024;
constexpr float EPS = 1e-6f;
constexpr float WIN_QS = 1024.0f;
constexpr int NPH = 13;
constexpr int NPHASES = 2 * NPH;

constexpr size_t MiB = 1u << 20;
constexpr size_t WS_CTL = 0;
constexpr size_t WS_LB = 1 * MiB;
constexpr size_t WS_SA = 1 * MiB + 192 * 1024;
constexpr size_t WS_US = 1 * MiB + 64 * 1024, WS_VS = 1 * MiB + 128 * 1024;
constexpr size_t WS_WIN = 2 * MiB;
constexpr size_t WS_WBR = 62 * MiB;
constexpr size_t WS_WO = 74 * MiB;
constexpr size_t WS_WQ = 82 * MiB;
constexpr size_t WS_U = 91 * MiB;
constexpr size_t WS_V = 155 * MiB;
constexpr size_t WS_H = 219 * MiB;
constexpr size_t WS_SEG = 283 * MiB;
constexpr size_t WS_GATE = 539 * MiB;
constexpr size_t WS_X2 = 731 * MiB;
constexpr size_t WS_CONV = 859 * MiB;
constexpr size_t WS_HGR = 891 * MiB;
constexpr size_t WS_MERGED = 923 * MiB;
constexpr size_t WS_SEL = 987 * MiB;
constexpr size_t WS_SELS = 1003 * MiB;
constexpr size_t WS_DEC = 1004 * MiB;
constexpr size_t WS_END = 1005 * MiB;
constexpr size_t WS_ST = WS_H;
constexpr size_t WS_KEYS = 90 * MiB;
constexpr size_t WS_PART = WS_GATE;
constexpr size_t WS_QPEER = WS_SEG;
constexpr size_t SEGSZ = (size_t)NTOK * 1024;
constexpr int CW_BAR = 4096;
constexpr int CW_RANK = 131072;

constexpr int RING_BYTES = 131072, MISC_OFF = RING_BYTES + 320, LDS_BYTES = 147456;

__device__ __forceinline__ unsigned pk2c(float lo, float hi) { f32x2v v = {lo, hi}; bf16v2 b = __builtin_convertvector(v, bf16v2); return __builtin_bit_cast(unsigned, b); }
__device__ __forceinline__ float bflo(unsigned x) { return __uint_as_float(x << 16); }
__device__ __forceinline__ float bfhi(unsigned x) { return __uint_as_float(x & 0xffff0000u); }
__device__ __forceinline__ float sigm(float x) { return __builtin_amdgcn_rcpf(1.0f + __expf(-x)); }
__device__ __forceinline__ float wave_sum(float v) {
#pragma unroll
    for (int o = 1; o < 64; o <<= 1) v += __shfl_xor(v, o);
    return v;
}
__device__ __forceinline__ float wave_max(float v) {
#pragma unroll
    for (int o = 1; o < 64; o <<= 1) v = fmaxf(v, __shfl_xor(v, o));
    return v;
}
#define LDS_WAIT() asm volatile("s_waitcnt lgkmcnt(0)" ::: "memory")
#define MFMA32(a, b, c) __builtin_amdgcn_mfma_f32_32x32x16_bf16((a), (b), (c), 0, 0, 0)
__device__ __forceinline__ int ridx16(int lane) { return ((lane >> 5) & 1) * 8 + ((lane >> 4) & 1) * 4 + ((lane >> 3) & 1) * 2 + ((lane >> 2) & 1); }
__device__ __forceinline__ void xreduce16(float (&v)[16], int lane) {
#pragma unroll
    for (int i = 0; i < 8; ++i) { const bool up = (lane & 32) != 0; const float snd = up ? v[i] : v[i + 8], kp = up ? v[i + 8] : v[i]; v[i] = kp + __shfl_xor(snd, 32); }
#pragma unroll
    for (int i = 0; i < 4; ++i) { const bool up = (lane & 16) != 0; const float snd = up ? v[i] : v[i + 4], kp = up ? v[i + 4] : v[i]; v[i] = kp + __shfl_xor(snd, 16); }
#pragma unroll
    for (int i = 0; i < 2; ++i) { const bool up = (lane & 8) != 0; const float snd = up ? v[i] : v[i + 2], kp = up ? v[i + 2] : v[i]; v[i] = kp + __shfl_xor(snd, 8); }
    { const bool up = (lane & 4) != 0; const float snd = up ? v[0] : v[1], kp = up ? v[1] : v[0]; v[0] = kp + __shfl_xor(snd, 4); }
    v[0] += __shfl_xor(v[0], 2); v[0] += __shfl_xor(v[0], 1);
}
__device__ __forceinline__ float gelu_exact(float v) {
    const float av = fabsf(v), t = __builtin_amdgcn_rcpf(av * 0.2316418882f + 1.0f);
    float q = t * 0.5307027145f + (-0.7265760135f); q = q * t + 0.7107068705f; q = q * t + (-0.142248368f); q = q * t + 0.127414796f; q = q * t;
    const float e = __builtin_amdgcn_exp2f((v * v) * (-0.72134752044f));
    const float m = v * (q * e);
    return v < 0.f ? m : v - m;
}

struct Ctx { LAS unsigned char* lds; int tid, lane, wave, G, gw, NGW; };

__device__ __forceinline__ void tr_item(const float* W, int K, int N, bf16* WT, int k0, int n0, int drow0, LAS float* scr, int lane) {
#pragma unroll 8
    for (int i = 0; i < 32; ++i) { const int kk = 2 * i + (lane >> 5); scr[kk * 33 + (lane & 31)] = ((const GAS float*)W)[(size_t)(k0 + kk) * N + n0 + (lane & 31)]; }
    LDS_WAIT();
    const int c = lane & 7;
#pragma unroll
    for (int j = 0; j < 4; ++j) { const int n = (lane >> 3) + 8 * j; const LAS float* s = scr + (8 * c) * 33 + n;
        v4u o; o.x = pk2c(s[0], s[33]); o.y = pk2c(s[66], s[99]); o.z = pk2c(s[132], s[165]); o.w = pk2c(s[198], s[231]);
        *(GAS v4u*)(WT + (size_t)(drow0 + n) * K + k0 + 8 * c) = o; }
    LDS_WAIT();
}
__device__ __forceinline__ unsigned pack_i8x4c(float a, float b, float c, float d) {
    const int ia = (int)__builtin_rintf(fminf(fmaxf(a, -127.f), 127.f)), ib = (int)__builtin_rintf(fminf(fmaxf(b, -127.f), 127.f)), ic = (int)__builtin_rintf(fminf(fmaxf(c, -127.f), 127.f)), id = (int)__builtin_rintf(fminf(fmaxf(d, -127.f), 127.f));
    return ((unsigned)ia & 255u) | (((unsigned)ib & 255u) << 8) | (((unsigned)ic & 255u) << 16) | ((unsigned)id << 24);
}
__device__ __forceinline__ void tr_item_i8(const float* W, int K, int N, unsigned char* WT, int k0, int n0, int drow0, float scale, LAS float* scr, int lane) {
#pragma unroll 8
    for (int i = 0; i < 32; ++i) { const int kk = 2 * i + (lane >> 5); scr[kk * 33 + (lane & 31)] = ((const GAS float*)W)[(size_t)(k0 + kk) * N + n0 + (lane & 31)]; }
    LDS_WAIT();
    const int c = lane & 7;
#pragma unroll
    for (int j = 0; j < 4; ++j) { const int n = (lane >> 3) + 8 * j; const LAS float* s = scr + (8 * c) * 33 + n;
        v2u o; o.x = pack_i8x4c(s[0] * scale, s[33] * scale, s[66] * scale, s[99] * scale); o.y = pack_i8x4c(s[132] * scale, s[165] * scale, s[198] * scale, s[231] * scale);
        *(GAS v2u*)(WT + (size_t)(drow0 + n) * K + k0 + 8 * c) = o; }
    LDS_WAIT();
}
__device__ __forceinline__ int win_drow(int n) { if (n < 7168 || n >= 9216) return n; const int r = n - 7168, isb = r >> 10, c = r & 1023; return 7168 + (c >> 7) * 256 + isb * 128 + (c & 127); }
__device__ __forceinline__ void cvt_copy(const Ctx& c, const float* src, bf16* dst, size_t n8) {
    const size_t NT = (size_t)c.G * 512;
    for (size_t i = (size_t)blockIdx.x * 512 + c.tid; i < n8; i += NT) {
        const f32x4 a = ((const GAS f32x4*)src)[2 * i], b = ((const GAS f32x4*)src)[2 * i + 1];
        v4u o; o.x = pk2c(a.x, a.y); o.y = pk2c(a.z, a.w); o.z = pk2c(b.x, b.y); o.w = pk2c(b.z, b.w);
        ((GAS v4u*)dst)[i] = o;
    }
}
__device__ __forceinline__ void rms_row(const float* xr, const float* w, bf16* o, int lane) {
    const GAS f32x4* xp = (const GAS f32x4*)xr + lane; f32x4 v[8]; float s = 0.f;
#pragma unroll
    for (int j = 0; j < 8; ++j) { v[j] = xp[64 * j]; s += (v[j].x * v[j].x + v[j].y * v[j].y) + (v[j].z * v[j].z + v[j].w * v[j].w); }
    const float r = __builtin_amdgcn_rsqf(wave_sum(s) * (1.0f / DM) + EPS);
    const GAS f32x4* wp = (const GAS f32x4*)w + lane; GAS v2u* op = (GAS v2u*)o + lane;
#pragma unroll
    for (int j = 0; j < 8; ++j) { const f32x4 wv = wp[64 * j]; v2u q; q.x = pk2c(v[j].x * r * wv.x, v[j].y * r * wv.y); q.y = pk2c(v[j].z * r * wv.z, v[j].w * r * wv.w); op[64 * j] = q; }
}
__device__ __forceinline__ void rms_row_i8(const float* xr, const float* w, unsigned char* o, float* sa, int lane) {
    const GAS f32x4* xp = (const GAS f32x4*)xr + lane; f32x4 v[8]; float s = 0.f;
#pragma unroll
    for (int j = 0; j < 8; ++j) { v[j] = xp[64 * j]; s += (v[j].x * v[j].x + v[j].y * v[j].y) + (v[j].z * v[j].z + v[j].w * v[j].w); }
    const float r = __builtin_amdgcn_rsqf(wave_sum(s) * (1.0f / DM) + EPS);
    const GAS f32x4* wp = (const GAS f32x4*)w + lane; float m = 0.f;
#pragma unroll
    for (int j = 0; j < 8; ++j) { const f32x4 wv = wp[64 * j]; v[j].x *= r * wv.x; v[j].y *= r * wv.y; v[j].z *= r * wv.z; v[j].w *= r * wv.w;
        m = fmaxf(fmaxf(m, fmaxf(fabsf(v[j].x), fabsf(v[j].y))), fmaxf(fabsf(v[j].z), fabsf(v[j].w))); }
    m = wave_max(m);
    const float inv = m > 0.f ? 127.0f / m : 0.f;
    if (lane == 0) *(GAS float*)sa = m * (1.0f / 127.0f);
#pragma unroll
    for (int j = 0; j < 8; ++j) ((GAS unsigned*)o)[lane + 64 * j] = pack_i8x4c(v[j].x * inv, v[j].y * inv, v[j].z * inv, v[j].w * inv);
}
__device__ __forceinline__ void rms_rows2_i8(const float* xa, const float* xb, const float* w, unsigned char* oa, unsigned char* ob, float* saa, float* sab, int lane) {
    const GAS f32x4* pa = (const GAS f32x4*)xa + lane; const GAS f32x4* pb = (const GAS f32x4*)xb + lane; f32x4 va[8], vb[8]; float s0 = 0.f, s1 = 0.f;
#pragma unroll
    for (int j = 0; j < 8; ++j) { va[j] = pa[64 * j]; vb[j] = pb[64 * j]; }
#pragma unroll
    for (int j = 0; j < 8; ++j) { s0 += (va[j].x * va[j].x + va[j].y * va[j].y) + (va[j].z * va[j].z + va[j].w * va[j].w); s1 += (vb[j].x * vb[j].x + vb[j].y * vb[j].y) + (vb[j].z * vb[j].z + vb[j].w * vb[j].w); }
#pragma unroll
    for (int o = 1; o < 64; o <<= 1) { s0 += __shfl_xor(s0, o); s1 += __shfl_xor(s1, o); }
    const float r0 = __builtin_amdgcn_rsqf(s0 * (1.0f / DM) + EPS), r1 = __builtin_amdgcn_rsqf(s1 * (1.0f / DM) + EPS);
    const GAS f32x4* wp = (const GAS f32x4*)w + lane; float m0 = 0.f, m1 = 0.f;
#pragma unroll
    for (int j = 0; j < 8; ++j) { const f32x4 wv = wp[64 * j];
        va[j].x *= r0 * wv.x; va[j].y *= r0 * wv.y; va[j].z *= r0 * wv.z; va[j].w *= r0 * wv.w; vb[j].x *= r1 * wv.x; vb[j].y *= r1 * wv.y; vb[j].z *= r1 * wv.z; vb[j].w *= r1 * wv.w;
        m0 = fmaxf(fmaxf(m0, fmaxf(fabsf(va[j].x), fabsf(va[j].y))), fmaxf(fabsf(va[j].z), fabsf(va[j].w))); m1 = fmaxf(fmaxf(m1, fmaxf(fabsf(vb[j].x), fabsf(vb[j].y))), fmaxf(fabsf(vb[j].z), fabsf(vb[j].w))); }
#pragma unroll
    for (int o = 1; o < 64; o <<= 1) { m0 = fmaxf(m0, __shfl_xor(m0, o)); m1 = fmaxf(m1, __shfl_xor(m1, o)); }
    const float i0 = m0 > 0.f ? 127.0f / m0 : 0.f, i1 = m1 > 0.f ? 127.0f / m1 : 0.f;
    if (lane == 0) { *(GAS float*)saa = m0 * (1.0f / 127.0f); *(GAS float*)sab = m1 * (1.0f / 127.0f); }
#pragma unroll
    for (int j = 0; j < 8; ++j) { ((GAS unsigned*)oa)[lane + 64 * j] = pack_i8x4c(va[j].x * i0, va[j].y * i0, va[j].z * i0, va[j].w * i0); ((GAS unsigned*)ob)[lane + 64 * j] = pack_i8x4c(vb[j].x * i1, vb[j].y * i1, vb[j].z * i1, vb[j].w * i1); }
}
__device__ __forceinline__ void rms_phase_i8(const Ctx& c, const float* x, const float* w, unsigned char* H8, float* SA) {
    for (int m = c.gw; m < NTOK / 2; m += c.NGW) rms_rows2_i8(x + (size_t)m * DM, x + (size_t)(m + NTOK / 2) * DM, w, H8 + (size_t)m * DM, H8 + (size_t)(m + NTOK / 2) * DM, SA + m, SA + m + NTOK / 2, c.lane);
}
__device__ __forceinline__ void rms_rows2(const float* xa, const float* xb, const float* w, bf16* oa, bf16* ob, int lane) {
    const GAS f32x4* pa = (const GAS f32x4*)xa + lane; const GAS f32x4* pb = (const GAS f32x4*)xb + lane; f32x4 va[8], vb[8]; float sa = 0.f, sb = 0.f;
#pragma unroll
    for (int j = 0; j < 8; ++j) { va[j] = pa[64 * j]; vb[j] = pb[64 * j]; }
#pragma unroll
    for (int j = 0; j < 8; ++j) { sa += (va[j].x * va[j].x + va[j].y * va[j].y) + (va[j].z * va[j].z + va[j].w * va[j].w); sb += (vb[j].x * vb[j].x + vb[j].y * vb[j].y) + (vb[j].z * vb[j].z + vb[j].w * vb[j].w); }
#pragma unroll
    for (int o = 1; o < 64; o <<= 1) { sa += __shfl_xor(sa, o); sb += __shfl_xor(sb, o); }
    const float ra = __builtin_amdgcn_rsqf(sa * (1.0f / DM) + EPS), rb = __builtin_amdgcn_rsqf(sb * (1.0f / DM) + EPS);
    const GAS f32x4* wp = (const GAS f32x4*)w + lane; GAS v2u* qa = (GAS v2u*)oa + lane; GAS v2u* qb = (GAS v2u*)ob + lane;
#pragma unroll
    for (int j = 0; j < 8; ++j) { const f32x4 wv = wp[64 * j];
        v2u q; q.x = pk2c(va[j].x * ra * wv.x, va[j].y * ra * wv.y); q.y = pk2c(va[j].z * ra * wv.z, va[j].w * ra * wv.w); qa[64 * j] = q;
        v2u p; p.x = pk2c(vb[j].x * rb * wv.x, vb[j].y * rb * wv.y); p.y = pk2c(vb[j].z * rb * wv.z, vb[j].w * rb * wv.w); qb[64 * j] = p; }
}
__device__ __forceinline__ void rms_phase(const Ctx& c, const float* x, const float* w, bf16* H) {
    for (int m = c.gw; m < NTOK / 2; m += c.NGW) rms_rows2(x + (size_t)m * DM, x + (size_t)(m + NTOK / 2) * DM, w, H + (size_t)m * DM, H + (size_t)(m + NTOK / 2) * DM, c.lane);
}
__device__ __forceinline__ void fp8_row(const float* src, unsigned char* dst, float* scale_out, int lane) {
    const GAS f32x4* xp = (const GAS f32x4*)src + lane; f32x4 v[8]; float m = 0.f;
#pragma unroll
    for (int j = 0; j < 8; ++j) { v[j] = xp[64 * j]; m = fmaxf(fmaxf(m, fmaxf(fabsf(v[j].x), fabsf(v[j].y))), fmaxf(fabsf(v[j].z), fabsf(v[j].w))); }
    m = wave_max(m);
    const float inv = m > 0.f ? 256.0f / m : 0.f;
    if (lane == 0) *(GAS float*)scale_out = m * (1.0f / 256.0f);
#pragma unroll
    for (int j = 0; j < 8; ++j) { int p = __builtin_amdgcn_cvt_pk_fp8_f32(v[j].x * inv, v[j].y * inv, 0, false); p = __builtin_amdgcn_cvt_pk_fp8_f32(v[j].z * inv, v[j].w * inv, p, true);
        ((GAS unsigned*)dst)[lane + 64 * j] = (unsigned)p; }
}
__device__ __forceinline__ unsigned pack_i8x4(float a, float b, float c, float d) {
    const int ia = (int)__builtin_rintf(a), ib = (int)__builtin_rintf(b), ic = (int)__builtin_rintf(c), id = (int)__builtin_rintf(d);
    return ((unsigned)ia & 255u) | (((unsigned)ib & 255u) << 8) | (((unsigned)ic & 255u) << 16) | ((unsigned)id << 24);
}
__device__ __forceinline__ void i8_row(const float* src, unsigned char* dst, float* scale_out, int lane) {
    const GAS f32x4* xp = (const GAS f32x4*)src + lane; f32x4 v[8]; float m = 0.f;
#pragma unroll
    for (int j = 0; j < 8; ++j) { v[j] = xp[64 * j]; m = fmaxf(fmaxf(m, fmaxf(fabsf(v[j].x), fabsf(v[j].y))), fmaxf(fabsf(v[j].z), fabsf(v[j].w))); }
    m = wave_max(m);
    const float inv = m > 0.f ? 127.0f / m : 0.f;
    if (lane == 0) *(GAS float*)scale_out = m * (1.0f / 127.0f);
#pragma unroll
    for (int j = 0; j < 8; ++j) ((GAS unsigned*)dst)[lane + 64 * j] = pack_i8x4(v[j].x * inv, v[j].y * inv, v[j].z * inv, v[j].w * inv);
}
__device__ __forceinline__ void fp6_row(const float* src, unsigned char* dst, float* scale_out, int lane) {
    const GAS f32x4* xp = (const GAS f32x4*)src + 8 * lane; f32x4 v[8]; float m = 0.f;
#pragma unroll
    for (int j = 0; j < 8; ++j) { v[j] = xp[j]; m = fmaxf(fmaxf(m, fmaxf(fabsf(v[j].x), fabsf(v[j].y))), fmaxf(fabsf(v[j].z), fabsf(v[j].w))); }
    m = wave_max(m);
    const float inv = m > 0.f ? 7.5f / m : 0.f;
    if (lane == 0) *(GAS float*)scale_out = m * (1.0f / 7.5f);
    v32h_t h;
#pragma unroll
    for (int j = 0; j < 8; ++j) { h[4 * j] = (_Float16)(v[j].x * inv); h[4 * j + 1] = (_Float16)(v[j].y * inv); h[4 * j + 2] = (_Float16)(v[j].z * inv); h[4 * j + 3] = (_Float16)(v[j].w * inv); }
    const v6u q = __builtin_amdgcn_cvt_scalef32_pk32_fp6_f16(h, 1.0f);
    GAS v2u* o = (GAS v2u*)(dst + 24 * lane);
    o[0] = (v2u){q[0], q[1]}; o[1] = (v2u){q[2], q[3]}; o[2] = (v2u){q[4], q[5]};
}
struct P0Args { const float *w_in, *w_br_sb, *w_br_hg, *w_br_conv, *w_o, *w_q, *u, *v, *lbp; bf16 *WinT, *WbrT, *WoT, *WqT; unsigned char *U, *V; float *US, *VS; float* LB; int layer; const float *k1, *k2; bf16* KB; };
__device__ __forceinline__ void p0_convert(const Ctx& c, const P0Args& a) {
    LAS float* scr = (LAS float*)(c.lds + c.wave * 16384);
    constexpr int I_IN = (DM / 64) * (INW / 32), I_BR = (BW / 64) * (DM / 32), I_SQ = (DM / 64) * (DM / 32);
    constexpr int NITEMS = I_IN + 3 * I_BR + 2 * I_SQ;
    for (int it = c.gw; it < NITEMS; it += c.NGW) {
        int r = it;
        if (r < I_IN) { const int kb = r / (INW / 32), nb = r % (INW / 32); tr_item_i8(a.w_in, DM, INW, (unsigned char*)a.WinT, kb * 64, nb * 32, win_drow(nb * 32), WIN_QS, scr, c.lane); continue; } r -= I_IN;
        if (r < I_BR) { const int kb = r / (DM / 32), nb = r % (DM / 32); tr_item(a.w_br_sb, BW, DM, a.WbrT, kb * 64, nb * 32, nb * 32, scr, c.lane); continue; } r -= I_BR;
        if (r < I_BR) { const int kb = r / (DM / 32), nb = r % (DM / 32); tr_item(a.w_br_hg, BW, DM, a.WbrT + (size_t)DM * BW, kb * 64, nb * 32, nb * 32, scr, c.lane); continue; } r -= I_BR;
        if (r < I_BR) { const int kb = r / (DM / 32), nb = r % (DM / 32); tr_item(a.w_br_conv, BW, DM, a.WbrT + (size_t)2 * DM * BW, kb * 64, nb * 32, nb * 32, scr, c.lane); continue; } r -= I_BR;
        if (r < I_SQ) { const int kb = r / (DM / 32), nb = r % (DM / 32); tr_item(a.w_o, DM, DM, a.WoT, kb * 64, nb * 32, nb * 32, scr, c.lane); continue; } r -= I_SQ;
        { const int kb = r / (DM / 32), nb = r % (DM / 32); tr_item(a.w_q, DM, DM, a.WqT, kb * 64, nb * 32, nb * 32, scr, c.lane); }
    }
    for (int r = c.gw; r < 2 * 16384; r += c.NGW) {
        if (r < 16384) i8_row(a.u + (size_t)r * 2048, a.U + (size_t)r * 2048, a.US + r, c.lane);
        else fp6_row(a.v + (size_t)(r - 16384) * 2048, a.V + (size_t)(r - 16384) * 1536, a.VS + (r - 16384), c.lane);
    }
    cvt_copy(c, a.k1, a.KB, (size_t)8 * 16384 / 8);
    cvt_copy(c, a.k2, a.KB + 8 * 16384, (size_t)8 * 16384 / 8);
    if (blockIdx.x == 0) for (int i = c.tid; i < 1024; i += 512) a.LB[i] = a.layer == 0 ? 0.f : sigm(a.lbp[1024 + i] - a.lbp[i]);
}

struct EpiIn {
    static constexpr bool PERM = true, AFTER_DRAIN = false;
    bf16* seg; bf16* gate; const float* lb; const float* sa;
    __device__ __forceinline__ float rowscale(int row) const { return ((const GAS float*)sa)[row] * (1.0f / WIN_QS); }
    __device__ __forceinline__ void operator()(const pg8::f32x4 (&acc)[2][2][4][2], const pg8::Unit& u, int wr, int wc, int fr, int fq) const {
        const int pn = u.pn; const int row0 = u.pm * 256 + wr * 64 + fr;
        if (pn >= 28 && pn < 36) {
            bf16* dst = seg + (size_t)7 * SEGSZ; const int col0 = (pn - 28) * 128 + wc * 32 + 8 * fq;
#pragma unroll
            for (int ai = 0; ai < 2; ++ai)
#pragma unroll
                for (int m = 0; m < 4; ++m) {
                    const pg8::f32x4 a0 = acc[ai][0][m][0], a1 = acc[ai][0][m][1], b0 = acc[ai][1][m][0], b1 = acc[ai][1][m][1];
                    v4u w; w.x = pk2c(a0[0] * sigm(b0[0]), a0[1] * sigm(b0[1])); w.y = pk2c(a0[2] * sigm(b0[2]), a0[3] * sigm(b0[3]));
                    w.z = pk2c(a1[0] * sigm(b1[0]), a1[1] * sigm(b1[1])); w.w = pk2c(a1[2] * sigm(b1[2]), a1[3] * sigm(b1[3]));
                    *(GAS v4u*)(dst + (size_t)(row0 + ai * 128 + m * 16) * 1024 + col0) = w; }
            return;
        }
        bf16* dst; int ld, colt, mode;
        if (pn < 28) { const int sg = pn >> 2; dst = seg + (size_t)sg * SEGSZ; ld = 1024; colt = (pn & 3) * 256; mode = (sg == 4) ? 2 : (sg == 6 ? 1 : 0); }
        else { const int q = pn - 36; dst = gate + (size_t)(q >> 3) * ((size_t)NTOK * 2048); ld = 2048; colt = (q & 7) * 256; mode = 1; }
        const int col0 = colt + wc * 32 + 8 * fq;
        if (mode == 0) {
#pragma unroll
            for (int ai = 0; ai < 2; ++ai)
#pragma unroll
                for (int m = 0; m < 4; ++m)
#pragma unroll
                    for (int bj = 0; bj < 2; ++bj) { const pg8::f32x4 v0 = acc[ai][bj][m][0], v1 = acc[ai][bj][m][1];
                        v4u w; w.x = pk2c(v0[0], v0[1]); w.y = pk2c(v0[2], v0[3]); w.z = pk2c(v1[0], v1[1]); w.w = pk2c(v1[2], v1[3]);
                        *(GAS v4u*)(dst + (size_t)(row0 + ai * 128 + m * 16) * ld + col0 + bj * 128) = w; }
        } else if (mode == 1) {
#pragma unroll
            for (int ai = 0; ai < 2; ++ai)
#pragma unroll
                for (int m = 0; m < 4; ++m)
#pragma unroll
                    for (int bj = 0; bj < 2; ++bj) { const pg8::f32x4 v0 = acc[ai][bj][m][0], v1 = acc[ai][bj][m][1];
                        v4u w; w.x = pk2c(sigm(v0[0]), sigm(v0[1])); w.y = pk2c(sigm(v0[2]), sigm(v0[3])); w.z = pk2c(sigm(v1[0]), sigm(v1[1])); w.w = pk2c(sigm(v1[2]), sigm(v1[3]));
                        *(GAS v4u*)(dst + (size_t)(row0 + ai * 128 + m * 16) * ld + col0 + bj * 128) = w; }
        } else {
            f32x4 l0[2], l1[2];
#pragma unroll
            for (int bj = 0; bj < 2; ++bj) { l0[bj] = *(const GAS f32x4*)(lb + col0 + bj * 128); l1[bj] = *(const GAS f32x4*)(lb + col0 + bj * 128 + 4); }
#pragma unroll
            for (int ai = 0; ai < 2; ++ai)
#pragma unroll
                for (int m = 0; m < 4; ++m)
#pragma unroll
                    for (int bj = 0; bj < 2; ++bj) { const pg8::f32x4 v0 = acc[ai][bj][m][0], v1 = acc[ai][bj][m][1]; float r[8];
#pragma unroll
                        for (int j = 0; j < 4; ++j) { r[j] = __logf(l0[bj][j] + (1.0f - l0[bj][j]) * sigm(v0[j])); r[4 + j] = __logf(l1[bj][j] + (1.0f - l1[bj][j]) * sigm(v1[j])); }
                        v4u w; w.x = pk2c(r[0], r[1]); w.y = pk2c(r[2], r[3]); w.z = pk2c(r[4], r[5]); w.w = pk2c(r[6], r[7]);
                        *(GAS v4u*)(dst + (size_t)(row0 + ai * 128 + m * 16) * ld + col0 + bj * 128) = w; }
        }
    }
};

__device__ __forceinline__ void conv_phase(const Ctx& c, const bf16* glu, const float* cw, const float* cb, const float* lnw, const float* lnb, bf16* out) {
    const int c0 = 2 * c.tid;
    float w0[31], w1[31];
#pragma unroll
    for (int j = 0; j < 31; ++j) { const f32x2v t = *(const GAS f32x2v*)(cw + j * 1024 + c0); w0[j] = t.x; w1[j] = t.y; }
    const f32x2v bv = *(const GAS f32x2v*)(cb + c0), lwv = *(const GAS f32x2v*)(lnw + c0), lbv = *(const GAS f32x2v*)(lnb + c0);
    LAS float* red = (LAS float*)c.lds;
    for (int tile = blockIdx.x; tile < NTOK / 8; tile += c.G) {
        const int n0 = tile * 8, tseq0 = n0 & (SEQ - 1);
        float a0[8], a1[8];
#pragma unroll
        for (int t = 0; t < 8; ++t) { a0[t] = bv.x; a1[t] = bv.y; }
#pragma unroll
        for (int r = 0; r < 38; ++r) {
            unsigned xv = 0u;
            if (tseq0 + r - 30 >= 0) xv = *(const GAS unsigned*)(glu + (size_t)(n0 + r - 30) * 1024 + c0);
            const float x0 = bflo(xv), x1 = bfhi(xv);
#pragma unroll
            for (int t = 0; t < 8; ++t) { const int j = r - t; if (j >= 0 && j <= 30) { a0[t] += w0[j] * x0; a1[t] += w1[j] * x1; } }
        }
        float st[16];
#pragma unroll
        for (int t = 0; t < 8; ++t) { st[2 * t] = a0[t] + a1[t]; st[2 * t + 1] = a0[t] * a0[t] + a1[t] * a1[t]; }
        xreduce16(st, c.lane);
        if ((c.lane & 3) == 0) red[c.wave * 16 + ridx16(c.lane)] = st[0];
        __syncthreads();
        if (c.tid < 16) { float s = 0.f;
#pragma unroll
            for (int w = 0; w < 8; ++w) s += red[w * 16 + c.tid];
            red[128 + c.tid] = s; }
        __syncthreads();
#pragma unroll
        for (int t = 0; t < 8; ++t) {
            const float mean = red[128 + 2 * t] * (1.0f / 1024.0f), var = red[128 + 2 * t + 1] * (1.0f / 1024.0f) - mean * mean;
            const float rstd = __builtin_amdgcn_rsqf(var + EPS);
            const float h0 = (a0[t] - mean) * rstd * lwv.x + lbv.x, h1 = (a1[t] - mean) * rstd * lwv.y + lbv.y;
            *(GAS unsigned*)(out + (size_t)(n0 + t) * 1024 + c0) = pk2c(h0 * sigm(h0), h1 * sigm(h1));
        }
        __syncthreads();
    }
}
__device__ __forceinline__ void hgrn_task(int task, int lane, const bf16* qhg, const bf16* logf, const bf16* ihg, bf16* out) {
    const int bh = task >> 6, dvb = task & 63, b = bh >> 3, h = bh & 7;
    const size_t rb = (size_t)b * SEQ * 1024;
    const GAS unsigned* qp = (const GAS unsigned*)(qhg + rb + h * 128) + lane;
    const GAS unsigned* lp = (const GAS unsigned*)(logf + rb + h * 128) + lane;
    const GAS unsigned* ip = (const GAS unsigned*)(ihg + rb + h * 128) + dvb;
    GAS bf16* op = (GAS bf16*)(out + rb + h * 128 + 2 * dvb);
    float S00 = 0.f, S01 = 0.f, S10 = 0.f, S11 = 0.f;
    unsigned qn[8], ln[8], inx[8];
#pragma unroll
    for (int j = 0; j < 8; ++j) { qn[j] = qp[(size_t)j * 512]; ln[j] = lp[(size_t)j * 512]; inx[j] = ip[(size_t)j * 512]; }
    for (int blk = 0; blk < SEQ / 8; ++blk) {
        unsigned qc[8], lc[8], ic[8];
#pragma unroll
        for (int j = 0; j < 8; ++j) { qc[j] = qn[j]; lc[j] = ln[j]; ic[j] = inx[j]; }
        if (blk + 1 < SEQ / 8) {
#pragma unroll
            for (int j = 0; j < 8; ++j) { const size_t o = (size_t)((blk + 1) * 8 + j) * 512; qn[j] = qp[o]; ln[j] = lp[o]; inx[j] = ip[o]; }
        }
        float pv[16];
#pragma unroll
        for (int j = 0; j < 8; ++j) {
            const float f0 = __expf(bflo(lc[j])), f1 = __expf(bfhi(lc[j])), k0 = 1.0f - f0, k1 = 1.0f - f1;
            const float i0 = bflo(ic[j]), i1 = bfhi(ic[j]), q0 = bflo(qc[j]), q1 = bfhi(qc[j]);
            S00 = f0 * S00 + k0 * i0; S01 = f0 * S01 + k0 * i1; S10 = f1 * S10 + k1 * i0; S11 = f1 * S11 + k1 * i1;
            pv[2 * j] = S00 * q0 + S10 * q1; pv[2 * j + 1] = S01 * q0 + S11 * q1;
        }
        xreduce16(pv, lane);
        if ((lane & 3) == 0) { const int idx = ridx16(lane); op[(size_t)(blk * 8 + (idx >> 1)) * 1024 + (idx & 1)] = (bf16)(pk2c(pv[0], 0.f) & 0xffffu); }
    }
}
constexpr int HG_TS = 272;
constexpr int HG_BS = 132;
__device__ __forceinline__ void hg_stage(LAS unsigned char* dst, const bf16* src, int tid) {
#pragma unroll
    for (int i = 0; i < 2; ++i) { const int p = tid + 512 * i, row = p >> 4, c16 = p & 15; *(LAS v4u*)(dst + row * HG_TS + c16 * 16) = *(const GAS v4u*)(src + (size_t)row * 1024 + c16 * 8); }
}
__device__ __forceinline__ void hg_scan(const LAS unsigned char* lft, int dk, int hf, float (&lf)[4][8], float (&b)[4][8], float& bl) {
    float bs[4], pb[4];
#pragma unroll
    for (int kk = 0; kk < 4; ++kk) { float run = 0.f;
#pragma unroll
        for (int j = 0; j < 8; ++j) { lf[kk][j] = __uint_as_float((unsigned)(*(const LAS unsigned short*)(lft + (16 * kk + 8 * hf + j) * HG_TS + dk * 2)) << 16); run += lf[kk][j]; b[kk][j] = run; }
        bs[kk] = run; }
#pragma unroll
    for (int kk = 0; kk < 4; ++kk) pb[kk] = __shfl_xor(bs[kk], 32);
    float pre = 0.f;
#pragma unroll
    for (int kk = 0; kk < 4; ++kk) { const float off = pre + (hf ? pb[kk] : 0.f);
#pragma unroll
        for (int j = 0; j < 8; ++j) b[kk][j] += off;
        pre += bs[kk] + pb[kk]; }
    bl = pre;
}
__device__ __forceinline__ bf16x8 pack8(const float (&v)[8]) { v4u t; t.x = pk2c(v[0], v[1]); t.y = pk2c(v[2], v[3]); t.z = pk2c(v[4], v[5]); t.w = pk2c(v[6], v[7]); return __builtin_bit_cast(bf16x8, t); }
__device__ __forceinline__ unsigned lds_u16(const LAS unsigned char* p) { return (unsigned)(*(const LAS unsigned short*)p); }
__device__ __forceinline__ void hgA_chunk(const Ctx& c, int ci, const bf16* LOGF, const bf16* IHG, bf16* ST, float* DEC) {
    const int bh = ci >> 6, ch = ci & 63, bb = bh >> 3, h = bh & 7; const size_t n0 = (size_t)bb * SEQ + ch * 64;
    LAS unsigned char* lft = c.lds; LAS unsigned char* itl = c.lds + 64 * HG_TS;
    hg_stage(lft, LOGF + n0 * 1024 + h * 128, c.tid); hg_stage(itl, IHG + n0 * 1024 + h * 128, c.tid);
    __syncthreads();
    const int dkt = c.wave & 3, dvh = c.wave >> 2, hf = c.lane >> 5, cl = c.lane & 31, dk = 32 * dkt + cl;
    float lf[4][8], b[4][8], bl; hg_scan(lft, dk, hf, lf, b, bl);
    bf16x8 kf[4];
#pragma unroll
    for (int kk = 0; kk < 4; ++kk) { float v[8];
#pragma unroll
        for (int j = 0; j < 8; ++j) v[j] = (1.0f - __expf(lf[kk][j])) * __expf(bl - b[kk][j]);
        kf[kk] = pack8(v); }
    if (dvh == 0 && hf == 0) ((GAS float*)DEC)[(size_t)ci * 128 + dk] = __expf(bl);
#pragma unroll
    for (int dvi = 0; dvi < 2; ++dvi) { const int dvt = dvh * 2 + dvi;
        f32x16 acc;
#pragma unroll
        for (int r = 0; r < 16; ++r) acc[r] = 0.f;
#pragma unroll
        for (int kk = 0; kk < 4; ++kk) { const LAS unsigned char* p = itl + (16 * kk + 8 * hf) * HG_TS + (32 * dvt + cl) * 2;
            v4u t; t.x = lds_u16(p) | (lds_u16(p + HG_TS) << 16); t.y = lds_u16(p + 2 * HG_TS) | (lds_u16(p + 3 * HG_TS) << 16); t.z = lds_u16(p + 4 * HG_TS) | (lds_u16(p + 5 * HG_TS) << 16); t.w = lds_u16(p + 6 * HG_TS) | (lds_u16(p + 7 * HG_TS) << 16);
            acc = MFMA32(kf[kk], __builtin_bit_cast(bf16x8, t), acc); }
        bf16* o = ST + (size_t)ci * 16384 + (size_t)(32 * dvt + cl) * 128 + 32 * dkt + 4 * hf;
#pragma unroll
        for (int g = 0; g < 4; ++g) { v2u q; q.x = pk2c(acc[4 * g], acc[4 * g + 1]); q.y = pk2c(acc[4 * g + 2], acc[4 * g + 3]); *(GAS v2u*)(o + 8 * g) = q; }
    }
    __syncthreads();
}
__device__ __forceinline__ void hgB(const Ctx& c, bf16* ST, const float* DEC) {
    for (int e = blockIdx.x * 512 + c.tid; e < 32 * 4096; e += c.G * 512) {
        const int bh = e >> 12, r = e & 4095, dv = r >> 5, dk4 = (r & 31) * 4;
        GAS v2u* p = (GAS v2u*)(ST + (size_t)bh * 64 * 16384 + (size_t)dv * 128 + dk4);
        const GAS f32x4* d = (const GAS f32x4*)(DEC + (size_t)bh * 64 * 128 + dk4);
        f32x4 S = {0.f, 0.f, 0.f, 0.f};
#pragma unroll 1
        for (int c0 = 0; c0 < 64; c0 += 8) {
            v2u Lv[8]; f32x4 D[8];
#pragma unroll
            for (int k = 0; k < 8; ++k) { Lv[k] = p[(size_t)(c0 + k) * 4096]; D[k] = d[(size_t)(c0 + k) * 32]; }
#pragma unroll
            for (int k = 0; k < 8; ++k) { v2u o; o.x = pk2c(S.x, S.y); o.y = pk2c(S.z, S.w); p[(size_t)(c0 + k) * 4096] = o;
                S.x = D[k].x * S.x + bflo(Lv[k].x); S.y = D[k].y * S.y + bfhi(Lv[k].x); S.z = D[k].z * S.z + bflo(Lv[k].y); S.w = D[k].w * S.w + bfhi(Lv[k].y); }
        }
    }
}
__device__ __forceinline__ void hgC_chunk(const Ctx& c, int ci, const bf16* QHG, const bf16* LOGF, const bf16* IHG, const bf16* GHG, const bf16* ST, const float* nw, bf16* OUT) {
    const int bh = ci >> 6, ch = ci & 63, bb = bh >> 3, h = bh & 7; const size_t n0 = (size_t)bb * SEQ + ch * 64;
    LAS unsigned char* lft = c.lds; LAS unsigned char* itl = c.lds + 64 * HG_TS; LAS float* bt = (LAS float*)(c.lds + 2 * 64 * HG_TS); LAS float* red = bt + 64 * HG_BS;
    LAS unsigned char* ktl = (LAS unsigned char*)(red + 256);
    hg_stage(lft, LOGF + n0 * 1024 + h * 128, c.tid); hg_stage(itl, IHG + n0 * 1024 + h * 128, c.tid);
    __syncthreads();
    const int hf = c.lane >> 5, cl = c.lane & 31;
    { const int dk = 32 * (c.wave & 3) + cl; float lf[4][8], b[4][8], bl; hg_scan(lft, dk, hf, lf, b, bl);
#pragma unroll
      for (int q = 0; q < 2; ++q) { const int kk = 2 * (c.wave >> 2) + q;
#pragma unroll
          for (int j = 0; j < 8; ++j) { bt[(16 * kk + 8 * hf + j) * HG_BS + dk] = (c.wave >> 2) ? b[2 + q][j] : b[q][j];
              *(LAS unsigned short*)(ktl + (16 * kk + 8 * hf + j) * HG_TS + dk * 2) = (unsigned short)(pk2c(1.0f - __expf((c.wave >> 2) ? lf[2 + q][j] : lf[q][j]), 0.f) & 0xffffu); } } }
    __syncthreads();
    const int dvt = c.wave & 3, tt = c.wave >> 2, t = 32 * tt + cl;
    bf16x8 qm[8];
    const bf16* qrow = QHG + (n0 + t) * 1024 + h * 128 + 8 * hf;
#pragma unroll
    for (int kk = 0; kk < 8; ++kk) { const int d0 = 16 * kk + 8 * hf;
        asm volatile("" ::: "memory");
        const v4u qv = *(const GAS v4u*)(qrow + 16 * kk);
        const f32x4 b0 = *(const LAS f32x4*)(bt + t * HG_BS + d0), b1 = *(const LAS f32x4*)(bt + t * HG_BS + d0 + 4), m0 = *(const LAS f32x4*)(bt + 31 * HG_BS + d0), m1 = *(const LAS f32x4*)(bt + 31 * HG_BS + d0 + 4);
        const float q[8] = {bflo(qv.x), bfhi(qv.x), bflo(qv.y), bfhi(qv.y), bflo(qv.z), bfhi(qv.z), bflo(qv.w), bfhi(qv.w)};
        const float bv[8] = {b0.x, b0.y, b0.z, b0.w, b1.x, b1.y, b1.z, b1.w}, mv[8] = {m0.x, m0.y, m0.z, m0.w, m1.x, m1.y, m1.z, m1.w};
        float vm[8];
#pragma unroll
        for (int j = 0; j < 8; ++j) vm[j] = q[j] * __expf(bv[j] - mv[j]);
        qm[kk] = pack8(vm); }
    f32x16 o;
#pragma unroll
    for (int r = 0; r < 16; ++r) o[r] = 0.f;
#pragma unroll 1
    for (int st = 0; st <= tt; ++st) {
        const int s = 32 * st + cl;
        f32x16 sa;
#pragma unroll
        for (int r = 0; r < 16; ++r) sa[r] = 0.f;
#pragma unroll
        for (int kk = 0; kk < 8; ++kk) { const int d0 = 16 * kk + 8 * hf;
            asm volatile("" ::: "memory");
            const v4u lv = *(const LAS v4u*)(ktl + s * HG_TS + d0 * 2);
            const f32x4 b0 = *(const LAS f32x4*)(bt + s * HG_BS + d0), b1 = *(const LAS f32x4*)(bt + s * HG_BS + d0 + 4), m0 = *(const LAS f32x4*)(bt + 31 * HG_BS + d0), m1 = *(const LAS f32x4*)(bt + 31 * HG_BS + d0 + 4);
            const float kv[8] = {bflo(lv.x), bfhi(lv.x), bflo(lv.y), bfhi(lv.y), bflo(lv.z), bfhi(lv.z), bflo(lv.w), bfhi(lv.w)};
            const float bv[8] = {b0.x, b0.y, b0.z, b0.w, b1.x, b1.y, b1.z, b1.w}, mv[8] = {m0.x, m0.y, m0.z, m0.w, m1.x, m1.y, m1.z, m1.w};
            float vk[8];
#pragma unroll
            for (int j = 0; j < 8; ++j) vk[j] = kv[j] * __expf(mv[j] - bv[j]);
            sa = MFMA32(pack8(vk), qm[kk], sa); }
        if (st == tt) {
#pragma unroll
            for (int r = 0; r < 16; ++r) if (((r & 3) + 8 * (r >> 2) + 4 * hf) > cl) sa[r] = 0.f;
        }
#pragma unroll
        for (int sp = 0; sp < 2; ++sp) {
            const float pv[8] = {sa[8 * sp], sa[8 * sp + 1], sa[8 * sp + 2], sa[8 * sp + 3], sa[8 * sp + 4], sa[8 * sp + 5], sa[8 * sp + 6], sa[8 * sp + 7]};
            const LAS unsigned char* p = itl + (32 * st + 16 * sp + 4 * hf) * HG_TS + (32 * dvt + cl) * 2;
            v4u tq; tq.x = lds_u16(p) | (lds_u16(p + HG_TS) << 16); tq.y = lds_u16(p + 2 * HG_TS) | (lds_u16(p + 3 * HG_TS) << 16);
            tq.z = lds_u16(p + 8 * HG_TS) | (lds_u16(p + 9 * HG_TS) << 16); tq.w = lds_u16(p + 10 * HG_TS) | (lds_u16(p + 11 * HG_TS) << 16);
            o = MFMA32(__builtin_bit_cast(bf16x8, tq), pack8(pv), o); }
    }
    { const bf16* strow = ST + (size_t)ci * 16384 + (size_t)(32 * dvt + cl) * 128 + 8 * hf;
#pragma unroll
      for (int kk = 0; kk < 8; ++kk) { const int d0 = 16 * kk + 8 * hf;
          asm volatile("" ::: "memory");
          const v4u qv = *(const GAS v4u*)(qrow + 16 * kk); const bf16x8 sf = *(const GAS bf16x8*)(strow + 16 * kk);
          const f32x4 b0 = *(const LAS f32x4*)(bt + t * HG_BS + d0), b1 = *(const LAS f32x4*)(bt + t * HG_BS + d0 + 4);
          float ve[8] = {bflo(qv.x) * __expf(b0.x), bfhi(qv.x) * __expf(b0.y), bflo(qv.y) * __expf(b0.z), bfhi(qv.y) * __expf(b0.w), bflo(qv.z) * __expf(b1.x), bfhi(qv.z) * __expf(b1.y), bflo(qv.w) * __expf(b1.z), bfhi(qv.w) * __expf(b1.w)};
          o = MFMA32(sf, pack8(ve), o); } }
    float ss = 0.f;
#pragma unroll
    for (int r = 0; r < 16; ++r) ss += o[r] * o[r];
    ss += __shfl_xor(ss, 32);
    if (hf == 0) red[(tt * 4 + dvt) * 32 + cl] = ss;
    __syncthreads();
    const float rstd = __builtin_amdgcn_rsqf(((red[(tt * 4 + 0) * 32 + cl] + red[(tt * 4 + 1) * 32 + cl]) + (red[(tt * 4 + 2) * 32 + cl] + red[(tt * 4 + 3) * 32 + cl])) * (1.0f / 128.0f) + EPS);
#pragma unroll
    for (int g = 0; g < 4; ++g) { const int dv0 = 32 * dvt + 8 * g + 4 * hf; const size_t off = (n0 + t) * 1024 + h * 128 + dv0;
        const v2u gg = *(const GAS v2u*)(GHG + off); const f32x4 w4 = *(const GAS f32x4*)(nw + dv0);
        v2u q; q.x = pk2c(o[4 * g] * rstd * w4.x * bflo(gg.x), o[4 * g + 1] * rstd * w4.y * bfhi(gg.x)); q.y = pk2c(o[4 * g + 2] * rstd * w4.z * bflo(gg.y), o[4 * g + 3] * rstd * w4.w * bfhi(gg.y));
        *(GAS v2u*)(OUT + off) = q; }
    __syncthreads();
}
__device__ __forceinline__ void qknorm_rows4(bf16* row0, size_t rstride, const float* w, float scale, int lane) {
    v4u x[4][2];
#pragma unroll
    for (int i = 0; i < 4; ++i)
#pragma unroll
        for (int j = 0; j < 2; ++j) x[i][j] = *(const GAS v4u*)(row0 + i * rstride + 8 * lane + 512 * j);
    const f32x4 wa = *(const GAS f32x4*)(w + ((8 * lane) & 127)), wb = *(const GAS f32x4*)(w + ((8 * lane) & 127) + 4);
#pragma unroll
    for (int i = 0; i < 4; ++i)
#pragma unroll
        for (int j = 0; j < 2; ++j) { const v4u xx = x[i][j];
            float f[8] = {bflo(xx.x), bfhi(xx.x), bflo(xx.y), bfhi(xx.y), bflo(xx.z), bfhi(xx.z), bflo(xx.w), bfhi(xx.w)};
            float ss = 0.f;
#pragma unroll
            for (int k = 0; k < 8; ++k) ss += f[k] * f[k];
            ss += __shfl_xor(ss, 1); ss += __shfl_xor(ss, 2); ss += __shfl_xor(ss, 4); ss += __shfl_xor(ss, 8);
            const float r = __builtin_amdgcn_rsqf(ss * (1.0f / 128.0f) + EPS) * scale;
            v4u o; o.x = pk2c(f[0] * r * wa.x, f[1] * r * wa.y); o.y = pk2c(f[2] * r * wa.z, f[3] * r * wa.w); o.z = pk2c(f[4] * r * wb.x, f[5] * r * wb.y); o.w = pk2c(f[6] * r * wb.z, f[7] * r * wb.w);
            *(GAS v4u*)(row0 + i * rstride + 8 * lane + 512 * j) = o; }
}
__device__ __forceinline__ void vt_item(int item, int lane, const bf16* vsb, bf16* vt, LAS unsigned short* scr) {
    const int db = item & 3, sb = (item >> 2) & 63, bh = item >> 8, b = bh >> 3, h = bh & 7;
    const bf16* src = vsb + ((size_t)b * SEQ + sb * 64) * 1024 + h * 128 + db * 32;
#pragma unroll 4
    for (int i = 0; i < 16; ++i) { const int r = 4 * i + (lane >> 4); *(LAS unsigned*)(scr + r * 34 + 2 * (lane & 15)) = *(const GAS unsigned*)(src + (size_t)r * 1024 + 2 * (lane & 15)); }
    LDS_WAIT();
    const int c = lane & 7;
#pragma unroll
    for (int j = 0; j < 4; ++j) { const int d = (lane >> 3) + 8 * j; const LAS unsigned short* s = scr + (8 * c) * 34 + d;
        v4u o; o.x = (unsigned)s[0] | ((unsigned)s[34] << 16); o.y = (unsigned)s[68] | ((unsigned)s[102] << 16); o.z = (unsigned)s[136] | ((unsigned)s[170] << 16); o.w = (unsigned)s[204] | ((unsigned)s[238] << 16);
        *(GAS v4u*)(vt + ((size_t)bh * 128 + db * 32 + d) * SEQ + sb * 64 + 8 * c) = o; }
    LDS_WAIT();
}

constexpr int AT_BUF = 32768, AT_VOFF = 16384;
__device__ __forceinline__ f32x16 attn_scores(const LAS unsigned char* kt, int krow, int hf, const bf16x8 (&qf)[8]) {
    f32x16 sa;
#pragma unroll
    for (int r = 0; r < 16; ++r) sa[r] = 0.f;
    const LAS unsigned char* kp = kt + krow * 256; const int sw = krow & 15;
#pragma unroll
    for (int kk = 0; kk < 8; ++kk) sa = MFMA32(*(const LAS bf16x8*)(kp + (((2 * kk + hf) ^ sw) << 4)), qf[kk], sa);
    return sa;
}
template <bool DIAG> __device__ __forceinline__ void attn_weights(const f32x16& sa, float& R, int hf, int cl, bf16x8 (&pf)[2]) {
    float om[16];
#pragma unroll
    for (int r = 0; r < 16; ++r) om[r] = __builtin_amdgcn_rcpf(1.0f + __builtin_amdgcn_exp2f(sa[r] * 1.4426950408889634f));
    if (DIAG) {
#pragma unroll
        for (int r = 0; r < 16; ++r) if (((r & 3) + 8 * (r >> 2) + 4 * hf) >= cl) om[r] = 1.0f;
    }
    float Gs[4], Gp[4];
#pragma unroll
    for (int g = 0; g < 4; ++g) { Gs[g] = (om[4 * g] * om[4 * g + 1]) * (om[4 * g + 2] * om[4 * g + 3]); Gp[g] = __shfl_xor(Gs[g], 32); }
    float tail = R; float w[16];
#pragma unroll
    for (int g = 3; g >= 0; --g) {
        const float c3 = tail * (hf == 0 ? Gp[g] : 1.0f), c2 = c3 * om[4 * g + 3], c1 = c2 * om[4 * g + 2], c0 = c1 * om[4 * g + 1];
        w[4 * g + 3] = c3 - om[4 * g + 3] * c3; w[4 * g + 2] = c2 - om[4 * g + 2] * c2; w[4 * g + 1] = c1 - om[4 * g + 1] * c1; w[4 * g] = c0 - om[4 * g] * c0;
        tail *= Gs[g] * Gp[g];
    }
    R = tail;
#pragma unroll
    for (int sp = 0; sp < 2; ++sp) { v4u t; t.x = pk2c(w[8 * sp], w[8 * sp + 1]); t.y = pk2c(w[8 * sp + 2], w[8 * sp + 3]); t.z = pk2c(w[8 * sp + 4], w[8 * sp + 5]); t.w = pk2c(w[8 * sp + 6], w[8 * sp + 7]); pf[sp] = __builtin_bit_cast(bf16x8, t); }
}
__device__ __forceinline__ void attn_pv(const LAS unsigned char* vt, int sub, int cl, int hf, const bf16x8 (&pf)[2], f32x16 (&o)[4]) {
#pragma unroll
    for (int d = 0; d < 4; ++d) { const int row = 32 * d + cl; const LAS unsigned char* vp = vt + row * 128 + 8 * hf; const int sw = (row >> 1) & 7;
#pragma unroll
        for (int sp = 0; sp < 2; ++sp) { const int x = 4 * sub + 2 * sp;
            const v2u lo = *(const LAS v2u*)(vp + ((x ^ sw) << 4)), hi = *(const LAS v2u*)(vp + (((x + 1) ^ sw) << 4));
            v4u t; t.x = lo.x; t.y = lo.y; t.z = hi.x; t.w = hi.y; o[d] = MFMA32(__builtin_bit_cast(bf16x8, t), pf[sp], o[d]); } }
}
template <bool LAG> __device__ __forceinline__ void attn_unit(const Ctx& c, int bh, int qb, const bf16* qsb, const bf16* ksb, const bf16* vt, bf16* outb) {
    int lane_ = c.lane; asm volatile("" : "+v"(lane_));
    const int b = bh >> 3, h = bh & 7, lane = lane_, cl = lane & 31, hf = lane >> 5;
    const size_t rb = (size_t)b * SEQ; const int q0w = 256 * qb + 32 * c.wave;
    bf16x8 qf[8];
    { const bf16* qrow = qsb + (rb + q0w + cl) * 1024 + h * 128 + 8 * hf;
#pragma unroll
      for (int kk = 0; kk < 8; ++kk) qf[kk] = *(const GAS bf16x8*)(qrow + 16 * kk); }
    f32x16 o[4];
#pragma unroll
    for (int d = 0; d < 4; ++d)
#pragma unroll
        for (int r = 0; r < 16; ++r) o[d][r] = 0.f;
    float R = 1.0f;
    bf16x8 pd[2]; const LAS unsigned char* vimd = c.lds; int subd = 0; bool pending = false;
    const int kr0 = 8 * c.wave + (lane >> 4), kr1 = kr0 + 4;
    const bf16* kg0 = ksb + (rb + kr0) * 1024 + h * 128 + (((lane & 15) ^ (kr0 & 15)) << 3);
    const bf16* kg1 = ksb + (rb + kr1) * 1024 + h * 128 + (((lane & 15) ^ (kr1 & 15)) << 3);
    const int vr0 = 16 * c.wave + (lane >> 3), vr1 = vr0 + 8;
    const bf16* vg0 = vt + ((size_t)bh * 128 + vr0) * SEQ + (((lane & 7) ^ ((vr0 >> 1) & 7)) << 3);
    const bf16* vg1 = vt + ((size_t)bh * 128 + vr1) * SEQ + (((lane & 7) ^ ((vr1 >> 1) & 7)) << 3);
    LAS unsigned char* dk = c.lds + c.wave * 2048; LAS unsigned char* dv = c.lds + AT_VOFF + c.wave * 2048;
#define AT_DMA(kt_, bi_) do { const int ktt_ = (kt_); LAS unsigned char* bb_ = (LAS unsigned char*)0 + (bi_) * AT_BUF; \
        __builtin_amdgcn_global_load_lds((const unsigned*)(kg0 + (size_t)ktt_ * 64 * 1024), (LAS unsigned*)(dk + (bi_) * AT_BUF), 16, 0, 0); \
        __builtin_amdgcn_global_load_lds((const unsigned*)(kg1 + (size_t)ktt_ * 64 * 1024), (LAS unsigned*)(dk + (bi_) * AT_BUF + 1024), 16, 0, 0); \
        __builtin_amdgcn_global_load_lds((const unsigned*)(vg0 + ktt_ * 64), (LAS unsigned*)(dv + (bi_) * AT_BUF), 16, 0, 0); \
        __builtin_amdgcn_global_load_lds((const unsigned*)(vg1 + ktt_ * 64), (LAS unsigned*)(dv + (bi_) * AT_BUF + 1024), 16, 0, 0); (void)bb_; } while (0)
    const int nkt = 4 * (qb + 1);
    asm volatile("s_waitcnt vmcnt(0)" ::: "memory");
    AT_DMA(nkt - 1, 0); AT_DMA(nkt - 2, 1);
    asm volatile("s_waitcnt vmcnt(4)" ::: "memory"); __builtin_amdgcn_s_barrier(); asm volatile("" ::: "memory");
    int bi = 0;
#pragma unroll 1
    for (int it = 0; it < nkt; ++it) {
        const int kt = nkt - 1 - it;
        const int b2 = (bi + 2) & 3;
        if (it + 2 < nkt) AT_DMA(kt - 2, b2);
        const LAS unsigned char* kim = c.lds + bi * AT_BUF; const LAS unsigned char* vim = kim + AT_VOFF;
        const int rel = q0w - 64 * kt;
        if (rel >= 32) {
            if (LAG) { if (pending) attn_pv(vimd, subd, cl, hf, pd, o);
                const f32x16 s1 = attn_scores(kim, 32 + cl, hf, qf); if (rel == 32) attn_weights<true>(s1, R, hf, cl, pd); else attn_weights<false>(s1, R, hf, cl, pd);
                vimd = vim; subd = 1; pending = true;
            } else { bf16x8 p[2];
                { const f32x16 s1 = attn_scores(kim, 32 + cl, hf, qf); if (rel == 32) attn_weights<true>(s1, R, hf, cl, p); else attn_weights<false>(s1, R, hf, cl, p); }
                attn_pv(vim, 1, cl, hf, p, o); }
        }
        if (rel >= 0) {
            if (LAG) { if (pending) attn_pv(vimd, subd, cl, hf, pd, o);
                const f32x16 s0 = attn_scores(kim, cl, hf, qf); if (rel == 0) attn_weights<true>(s0, R, hf, cl, pd); else attn_weights<false>(s0, R, hf, cl, pd);
                vimd = vim; subd = 0; pending = true;
            } else { bf16x8 p[2];
                { const f32x16 s0 = attn_scores(kim, cl, hf, qf); if (rel == 0) attn_weights<true>(s0, R, hf, cl, p); else attn_weights<false>(s0, R, hf, cl, p); }
                attn_pv(vim, 0, cl, hf, p, o); }
        }
        if (it + 2 < nkt) asm volatile("s_waitcnt vmcnt(4)\n\ts_waitcnt lgkmcnt(0)" ::: "memory"); else asm volatile("s_waitcnt vmcnt(0)\n\ts_waitcnt lgkmcnt(0)" ::: "memory");
        __builtin_amdgcn_s_barrier(); asm volatile("" ::: "memory");
        bi = (bi + 1) & 3;
    }
#undef AT_DMA
    if (LAG && pending) attn_pv(vimd, subd, cl, hf, pd, o);
    bf16* orow = outb + (rb + q0w + cl) * 1024 + h * 128 + 4 * hf;
#pragma unroll
    for (int d = 0; d < 4; ++d)
#pragma unroll
        for (int g = 0; g < 4; ++g) { v2u q; q.x = pk2c(o[d][4 * g], o[d][4 * g + 1]); q.y = pk2c(o[d][4 * g + 2], o[d][4 * g + 3]); *(GAS v2u*)(orow + 32 * d + 8 * g) = q; }
    asm volatile("s_waitcnt vmcnt(0)" ::: "memory"); __builtin_amdgcn_s_barrier(); asm volatile("" ::: "memory");
}
__device__ __forceinline__ void hgpost_row(bf16* row, const bf16* grow, const float* w, int lane) {
#pragma unroll
    for (int j = 0; j < 2; ++j) {
        GAS v4u* p = (GAS v4u*)(row + 8 * lane + 512 * j); const v4u x = *p; const v4u gg = *(const GAS v4u*)(grow + 8 * lane + 512 * j);
        float f[8] = {bflo(x.x), bfhi(x.x), bflo(x.y), bfhi(x.y), bflo(x.z), bfhi(x.z), bflo(x.w), bfhi(x.w)};
        const float g[8] = {bflo(gg.x), bfhi(gg.x), bflo(gg.y), bfhi(gg.y), bflo(gg.z), bfhi(gg.z), bflo(gg.w), bfhi(gg.w)};
        float ss = 0.f;
#pragma unroll
        for (int k = 0; k < 8; ++k) ss += f[k] * f[k];
        ss += __shfl_xor(ss, 1); ss += __shfl_xor(ss, 2); ss += __shfl_xor(ss, 4); ss += __shfl_xor(ss, 8);
        const float r = __builtin_amdgcn_rsqf(ss * (1.0f / 128.0f) + EPS);
        const f32x4 wa = *(const GAS f32x4*)(w + ((8 * lane) & 127)), wb = *(const GAS f32x4*)(w + ((8 * lane) & 127) + 4);
        v4u o; o.x = pk2c(f[0] * r * wa.x * g[0], f[1] * r * wa.y * g[1]); o.y = pk2c(f[2] * r * wa.z * g[2], f[3] * r * wa.w * g[3]);
        o.z = pk2c(f[4] * r * wb.x * g[4], f[5] * r * wb.y * g[5]); o.w = pk2c(f[6] * r * wb.z * g[6], f[7] * r * wb.w * g[7]);
        *p = o;
    }
}

template <bool FIRST> struct EpiMerge {
    static constexpr bool PERM = true, AFTER_DRAIN = false;
    const bf16* gate; bf16* merged;
    __device__ __forceinline__ void operator()(const pg8::f32x4 (&acc)[2][2][4][2], const pg8::Unit& u, int wr, int wc, int fr, int fq) const {
        const int row0 = u.pm * 256 + wr * 64 + fr, col0 = u.pn * 256 + wc * 32 + 8 * fq;
#pragma unroll
        for (int ai = 0; ai < 2; ++ai)
#pragma unroll
            for (int m = 0; m < 4; ++m) {
                if ((m & 1) == 0) asm volatile("" ::: "memory");
#pragma unroll
                for (int bj = 0; bj < 2; ++bj) {
                    const size_t off = (size_t)(row0 + ai * 128 + m * 16) * 2048 + col0 + bj * 128;
                    const v4u g = *(const GAS v4u*)(gate + off); const pg8::f32x4 v0 = acc[ai][bj][m][0], v1 = acc[ai][bj][m][1];
                    float r[8] = {bflo(g.x) * v0[0], bfhi(g.x) * v0[1], bflo(g.y) * v0[2], bfhi(g.y) * v0[3], bflo(g.z) * v1[0], bfhi(g.z) * v1[1], bflo(g.w) * v1[2], bfhi(g.w) * v1[3]};
                    if (!FIRST) { const v4u mo = *(const GAS v4u*)(merged + off);
                        r[0] += bflo(mo.x); r[1] += bfhi(mo.x); r[2] += bflo(mo.y); r[3] += bfhi(mo.y); r[4] += bflo(mo.z); r[5] += bfhi(mo.z); r[6] += bflo(mo.w); r[7] += bfhi(mo.w); }
                    v4u w; w.x = pk2c(r[0], r[1]); w.y = pk2c(r[2], r[3]); w.z = pk2c(r[4], r[5]); w.w = pk2c(r[6], r[7]);
                    *(GAS v4u*)(merged + off) = w; }
            }
    }
};
struct EpiStoreBf16 {
    static constexpr bool PERM = true, AFTER_DRAIN = false;
    bf16* out;
    __device__ __forceinline__ void operator()(const pg8::f32x4 (&acc)[2][2][4][2], const pg8::Unit& u, int wr, int wc, int fr, int fq) const {
        const int row0 = u.pm * 256 + wr * 64 + fr, col0 = u.pn * 256 + wc * 32 + 8 * fq;
#pragma unroll
        for (int ai = 0; ai < 2; ++ai)
#pragma unroll
            for (int m = 0; m < 4; ++m)
#pragma unroll
                for (int bj = 0; bj < 2; ++bj) { const pg8::f32x4 v0 = acc[ai][bj][m][0], v1 = acc[ai][bj][m][1];
                    v4u w; w.x = pk2c(v0[0], v0[1]); w.y = pk2c(v0[2], v0[3]); w.z = pk2c(v1[0], v1[1]); w.w = pk2c(v1[2], v1[3]);
                    *(GAS v4u*)(out + (size_t)(row0 + ai * 128 + m * 16) * 2048 + col0 + bj * 128) = w; }
    }
};
struct EpiResid {
    static constexpr bool PERM = false, AFTER_DRAIN = false;
    const float* xin; float* xout;
    __device__ __forceinline__ void operator()(const pg8::f32x4 (&acc)[2][2][4][2], const pg8::Unit& u, int wr, int wc, int fr, int fq) const {
        const int row0 = u.pm * 256 + wr * 64 + fr, col0 = u.pn * 256 + wc * 32 + 4 * fq;
#pragma unroll
        for (int ai = 0; ai < 2; ++ai)
#pragma unroll
            for (int m = 0; m < 4; ++m)
#pragma unroll
                for (int bj = 0; bj < 2; ++bj)
#pragma unroll
                    for (int n = 0; n < 2; ++n) { const size_t off = (size_t)(row0 + ai * 128 + m * 16) * 2048 + col0 + bj * 128 + n * 16;
                        f32x4 r = acc[ai][bj][m][n]; if (xin) r += *(const GAS f32x4*)(xin + off);
                        *(GAS f32x4*)(xout + off) = r; }
    }
};

__device__ __forceinline__ float rl_f(float v, int l) { return __uint_as_float((unsigned)__builtin_amdgcn_readlane((int)__float_as_uint(v), l)); }
__device__ __forceinline__ void ins16(float (&L)[16], float x) {
#pragma unroll
    for (int i = 0; i < 16; ++i) { const float hi = __builtin_fmaxf(L[i], x); x = __builtin_fminf(L[i], x); L[i] = hi; }
}
#define CE_DESC(a, b) do { const float hi_ = __builtin_fmaxf(a, b), lo_ = __builtin_fminf(a, b); a = hi_; b = lo_; } while (0)
__device__ __forceinline__ void sort16_desc(float (&v)[16]) {
#pragma unroll
    for (int k = 2; k <= 16; k <<= 1)
#pragma unroll
        for (int j = k >> 1; j > 0; j >>= 1)
#pragma unroll
            for (int i = 0; i < 16; ++i) { const int l = i ^ j; if (l > i) { if ((i & k) == 0) CE_DESC(v[i], v[l]); else CE_DESC(v[l], v[i]); } }
}
__device__ __forceinline__ void bitonic_merge16_desc(float (&v)[16]) {
#pragma unroll
    for (int j = 8; j > 0; j >>= 1)
#pragma unroll
        for (int i = 0; i < 16; ++i) { const int l = i ^ j; if (l > i) CE_DESC(v[i], v[l]); }
}
__device__ __forceinline__ void top16_merge(float (&L)[16], const float (&T)[16]) {
#pragma unroll
    for (int i = 0; i < 16; ++i) L[i] = __builtin_fmaxf(L[i], T[15 - i]);
    bitonic_merge16_desc(L);
}
constexpr int PK_KS = 272;
__device__ __forceinline__ void peer_top16(const bf16* qrow  , const LAS unsigned char* kl  , int hf, float (&L)[16]) {
    bf16x8 qf[8];
#pragma unroll
    for (int kk = 0; kk < 8; ++kk) qf[kk] = *(const GAS bf16x8*)(qrow + 16 * kk);
#pragma unroll 1
    for (int kt = 0; kt < 4; ++kt) {
        f32x16 sa;
#pragma unroll
        for (int r = 0; r < 16; ++r) sa[r] = 0.f;
#pragma unroll
        for (int kk = 0; kk < 8; ++kk) sa = MFMA32(*(const LAS bf16x8*)(kl + kt * 32 * PK_KS + 32 * kk), qf[kk], sa);
        float T[16];
#pragma unroll
        for (int r = 0; r < 16; ++r) { const unsigned idx = (unsigned)(kt * 32 + (r & 3) + 8 * (r >> 2) + 4 * hf); T[r] = __uint_as_float((__float_as_uint(sa[r]) & ~127u) | idx); }
        sort16_desc(T);
        if (kt == 0) {
#pragma unroll
            for (int i = 0; i < 16; ++i) L[i] = T[i];
        } else top16_merge(L, T);
    }
    float P[16];
#pragma unroll
    for (int i = 0; i < 16; ++i) P[i] = __shfl_xor(L[i], 32);
    top16_merge(L, P);
}
__device__ __forceinline__ void peer_select32(int hd, int n0, int lane, const bf16* qpeer, const LAS unsigned char* kl1, const LAS unsigned char* kl2, unsigned char* wsb, LAS unsigned* ldsw) {
    asm volatile("" : "+v"(lane));
    const int c = lane & 31, hf = lane >> 5, n = n0 + c;
    const bf16* qrow = qpeer + (size_t)n * 2048 + hd * 256 + 8 * hf;
    float A[16], B[16];
    peer_top16(qrow, kl1 + c * PK_KS + 16 * hf, hf, A);
    peer_top16(qrow + 128, kl2 + c * PK_KS + 16 * hf, hf, B);
#define PKV(x) __uint_as_float(__float_as_uint(x) & ~127u)
#define PKI(x) ((int)(__float_as_uint(x) & 127u))
    float W[16];
    { float C0[16], C1[16], C2[16], E0 = 0.f, E1 = 0.f; unsigned id = 0;
#pragma unroll
      for (int a = 0; a < 16; ++a)
#pragma unroll
        for (int b = 0; b < 16; ++b) if ((a + 1) * (b + 1) <= 16) { const float pk = __uint_as_float((__float_as_uint(PKV(A[a]) + PKV(B[b])) & ~63u) | id);
            if (id < 16) C0[id] = pk; else if (id < 32) C1[id - 16] = pk; else if (id < 48) C2[id - 32] = pk; else if (id == 48) E0 = pk; else E1 = pk;
            ++id; }
      sort16_desc(C0); sort16_desc(C1); sort16_desc(C2);
      top16_merge(C0, C1); top16_merge(C0, C2);
#pragma unroll
      for (int i = 0; i < 16; ++i) W[i] = C0[i];
      ins16(W, E0); ins16(W, E1); }
    const float thr = W[15], mx = W[0];
    int cnt = 0; float ssum = 0.f;
    LAS int* le = (LAS int*)ldsw + c * 16; LAS float* lg = (LAS float*)ldsw + 512 + c * 16;
    { unsigned id = 0;
#pragma unroll
      for (int a = 0; a < 16; ++a)
#pragma unroll
        for (int b = 0; b < 16; ++b) if ((a + 1) * (b + 1) <= 16) {
            const float cv = PKV(A[a]) + PKV(B[b]); const float pk = __uint_as_float((__float_as_uint(cv) & ~63u) | id); ++id;
            if (pk >= thr) { const float e = __expf(cv - mx); if (hf == 0) { le[cnt] = PKI(A[a]) * 128 + PKI(B[b]); lg[cnt] = e; } ssum += e; ++cnt; }
        } }
    LDS_WAIT();
    asm volatile("" : "+s"(wsb));
    int* sel_e = (int*)(wsb + WS_SEL); float* sel_g = (float*)(wsb + WS_SEL + 8 * MiB); float* sel_s = (float*)(wsb + WS_SELS);
    { int lane3 = lane; asm volatile("" : "+v"(lane3)); const int t = lane3 >> 1, part = lane3 & 1;
      const v4u e0 = *(const LAS v4u*)((LAS int*)ldsw + t * 16 + 8 * part), e1 = *(const LAS v4u*)((LAS int*)ldsw + t * 16 + 8 * part + 4);
      const v4u g0 = *(const LAS v4u*)((LAS int*)ldsw + 512 + t * 16 + 8 * part), g1 = *(const LAS v4u*)((LAS int*)ldsw + 512 + t * 16 + 8 * part + 4);
      GAS v4u* pe = (GAS v4u*)(sel_e + (size_t)(n0 + t) * 128 + hd * 16 + 8 * part); GAS v4u* pg = (GAS v4u*)(sel_g + (size_t)(n0 + t) * 128 + hd * 16 + 8 * part);
      pe[0] = e0; pe[1] = e1; pg[0] = g0; pg[1] = g1; }
    LDS_WAIT();
    { int lane4 = lane; asm volatile("" : "+v"(lane4)); if ((lane4 >> 5) == 0) ((GAS float*)sel_s)[(size_t)(n0 + (lane4 & 31)) * 8 + hd] = ssum; }
}

__device__ __forceinline__ float dot2bf(unsigned a, unsigned b, float acc) {
    return __builtin_amdgcn_fdot2_f32_bf16(__builtin_bit_cast(bf16v2, a), __builtin_bit_cast(bf16v2, b), acc, false);
}
__device__ __forceinline__ float dot8bf(const v4u a, const v4u b, float acc) {
    const unsigned a0 = a.x, a1 = a.y, a2 = a.z, a3 = a.w, b0 = b.x, b1 = b.y, b2 = b.z, b3 = b.w;
    acc = dot2bf(a0, b0, acc); acc = dot2bf(a1, b1, acc); acc = dot2bf(a2, b2, acc); acc = dot2bf(a3, b3, acc);
    return acc;
}
__device__ __forceinline__ void unpack16(const v4u q, float (&f)[16]) {
    const unsigned d0 = q.x, d1 = q.y, d2 = q.z, d3 = q.w;
    f32x2v t;
    t = __builtin_amdgcn_cvt_pk_f32_fp8((int)d0, false); f[0] = t.x; f[1] = t.y; t = __builtin_amdgcn_cvt_pk_f32_fp8((int)d0, true); f[2] = t.x; f[3] = t.y;
    t = __builtin_amdgcn_cvt_pk_f32_fp8((int)d1, false); f[4] = t.x; f[5] = t.y; t = __builtin_amdgcn_cvt_pk_f32_fp8((int)d1, true); f[6] = t.x; f[7] = t.y;
    t = __builtin_amdgcn_cvt_pk_f32_fp8((int)d2, false); f[8] = t.x; f[9] = t.y; t = __builtin_amdgcn_cvt_pk_f32_fp8((int)d2, true); f[10] = t.x; f[11] = t.y;
    t = __builtin_amdgcn_cvt_pk_f32_fp8((int)d3, false); f[12] = t.x; f[13] = t.y; t = __builtin_amdgcn_cvt_pk_f32_fp8((int)d3, true); f[14] = t.x; f[15] = t.y;
}
struct SliceSched { int mode, xcc, rank, nloc; };
__device__ __forceinline__ SliceSched slice_sched_init(const Ctx& c, unsigned* ctl, const XcdBarrier& bar, int use) {
    LAS int* sh = (LAS int*)(c.lds + 1024);
    if (c.tid == 0) {
        int ok = 1; unsigned tot = 0;
        for (int j = 0; j < 16; ++j) { const unsigned n = xb_ld(&bar.bar[XB_XCNT(j)]); tot += n; if ((j < 8) != (n > 0u)) ok = 0; }
        if (tot != (unsigned)c.G) ok = 0;
        const int xcc = (int)xb_xcc_id();
        int rank = 0, nloc = 1;
        if (ok) { nloc = (int)xb_ld(&bar.bar[XB_XCNT(xcc)]); rank = (int)xb_add(&ctl[CW_RANK + (use * 16 + xcc) * 64], 1u); if (rank >= nloc) ok = 0; }
        sh[0] = ok; sh[1] = xcc; sh[2] = rank; sh[3] = nloc;
    }
    __syncthreads();
    SliceSched S; S.mode = sh[0]; S.xcc = sh[1]; S.rank = sh[2]; S.nloc = sh[3];
    __syncthreads();
    return S;
}
__device__ __forceinline__ bool slice_item(const SliceSched& S, const Ctx& c, int i, int& slice, int& tb) {
    if (S.mode) { const int it = S.rank + i * S.nloc; if (it >= 512) return false; slice = S.xcc + 8 * (it >> 8); tb = it & 255; return true; }
    const int it = (int)blockIdx.x + i * c.G; if (it >= 4096) return false; slice = it >> 8; tb = it & 255; return true;
}
__device__ __forceinline__ void unpack16p(const v4u q, f32x2v (&f)[8]) {
    const unsigned d0 = q.x, d1 = q.y, d2 = q.z, d3 = q.w;
    f[0] = __builtin_amdgcn_cvt_pk_f32_fp8((int)d0, false); f[1] = __builtin_amdgcn_cvt_pk_f32_fp8((int)d0, true);
    f[2] = __builtin_amdgcn_cvt_pk_f32_fp8((int)d1, false); f[3] = __builtin_amdgcn_cvt_pk_f32_fp8((int)d1, true);
    f[4] = __builtin_amdgcn_cvt_pk_f32_fp8((int)d2, false); f[5] = __builtin_amdgcn_cvt_pk_f32_fp8((int)d2, true);
    f[6] = __builtin_amdgcn_cvt_pk_f32_fp8((int)d3, false); f[7] = __builtin_amdgcn_cvt_pk_f32_fp8((int)d3, true);
}
__device__ __forceinline__ void peer_sddmm_wave(int t0, int s, int lane, const bf16* H, const unsigned char* UQ, const int* sel_e, float* part, LAS unsigned* ldsw) {
    const int cg = lane & 7, sg = lane >> 3;
#pragma unroll
    for (int j = 0; j < 4; ++j) *(LAS v4u*)(ldsw + 4 * (lane + 64 * j)) = *(const GAS v4u*)(sel_e + (size_t)t0 * 128 + 4 * (lane + 64 * j));
    LDS_WAIT();
    const unsigned char* ubase = UQ + s * 128 + cg * 16;
    v4u qn[16];
    { int id[16];
#pragma unroll
      for (int q = 0; q < 4; ++q) { const v4u v = *(const LAS v4u*)(ldsw + sg * 16 + 4 * q); id[4 * q] = (int)v.x; id[4 * q + 1] = (int)v.y; id[4 * q + 2] = (int)v.z; id[4 * q + 3] = (int)v.w; }
#pragma unroll
      for (int it = 0; it < 16; ++it) qn[it] = *(const GAS v4u*)(ubase + (size_t)id[it] * 2048); }
    const bf16* hbase = H + (size_t)t0 * 2048 + s * 128 + cg * 16;
    v4u han = *(const GAS v4u*)(hbase), hbn = *(const GAS v4u*)(hbase + 8);
#pragma unroll 1
    for (int k = 0; k < 8; ++k) {
        const int t = t0 + k;
        v4u qc[16];
#pragma unroll
        for (int it = 0; it < 16; ++it) qc[it] = qn[it];
        const v4u ha = han, hb = hbn;
        if (k < 7) { han = *(const GAS v4u*)(hbase + (size_t)(k + 1) * 2048); hbn = *(const GAS v4u*)(hbase + (size_t)(k + 1) * 2048 + 8); }
        if (k < 7) { int id[16];
#pragma unroll
            for (int q = 0; q < 4; ++q) { const v4u v = *(const LAS v4u*)(ldsw + (k + 1) * 128 + sg * 16 + 4 * q); id[4 * q] = (int)v.x; id[4 * q + 1] = (int)v.y; id[4 * q + 2] = (int)v.z; id[4 * q + 3] = (int)v.w; }
#pragma unroll
            for (int it = 0; it < 16; ++it) qn[it] = *(const GAS v4u*)(ubase + (size_t)id[it] * 2048); }
        float h[16] = {bflo(ha.x), bfhi(ha.x), bflo(ha.y), bfhi(ha.y), bflo(ha.z), bfhi(ha.z), bflo(ha.w), bfhi(ha.w), bflo(hb.x), bfhi(hb.x), bflo(hb.y), bfhi(hb.y), bflo(hb.z), bfhi(hb.z), bflo(hb.w), bfhi(hb.w)};
        float hm = 0.f;
#pragma unroll
        for (int j = 0; j < 16; ++j) hm = fmaxf(hm, fabsf(h[j]));
        hm = fmaxf(hm, __shfl_xor(hm, 1)); hm = fmaxf(hm, __shfl_xor(hm, 2)); hm = fmaxf(hm, __shfl_xor(hm, 4));
        const float hinv = hm > 0.f ? 127.0f / hm : 0.f, hs = hm * (1.0f / 127.0f);
        int hq[4];
#pragma unroll
        for (int j = 0; j < 4; ++j) hq[j] = (int)pack_i8x4(h[4 * j] * hinv, h[4 * j + 1] * hinv, h[4 * j + 2] * hinv, h[4 * j + 3] * hinv);
        float p[16];
#pragma unroll
        for (int it = 0; it < 16; ++it) { int a = __builtin_amdgcn_sdot4((int)qc[it].x, hq[0], 0, false); a = __builtin_amdgcn_sdot4((int)qc[it].y, hq[1], a, false);
            a = __builtin_amdgcn_sdot4((int)qc[it].z, hq[2], a, false); a = __builtin_amdgcn_sdot4((int)qc[it].w, hq[3], a, false);
            p[it] = (float)a * hs; }
#pragma unroll
        for (int i = 0; i < 8; ++i) { const bool up = (lane & 4) != 0; const float snd = up ? p[i] : p[i + 8], kp = up ? p[i + 8] : p[i]; p[i] = kp + __shfl_xor(snd, 4); }
#pragma unroll
        for (int i = 0; i < 4; ++i) { const bool up = (lane & 2) != 0; const float snd = up ? p[i] : p[i + 4], kp = up ? p[i + 4] : p[i]; p[i] = kp + __shfl_xor(snd, 2); }
#pragma unroll
        for (int i = 0; i < 2; ++i) { const bool up = (lane & 1) != 0; const float snd = up ? p[i] : p[i + 2], kp = up ? p[i + 2] : p[i]; p[i] = kp + __shfl_xor(snd, 1); }
        ((GAS unsigned*)part)[((size_t)t * 16 + s) * 64 + lane] = pk2c(p[0], p[1]);
    }
    LDS_WAIT();
}
__device__ __forceinline__ void peer_coef_tokens4(int t0, int ts, int lane, const float* part, const int* sel_e, float* sel_g, const float* sel_s, const float* US, const float* VS) {
    unsigned pv[4][16]; v2u e[4]; f32x2v g[4]; float dn[4];
#pragma unroll
    for (int i = 0; i < 4; ++i) { const int t = t0 + i * ts;
#pragma unroll
        for (int s = 0; s < 16; ++s) pv[i][s] = ((const GAS unsigned*)part)[((size_t)t * 16 + s) * 64 + lane];
        e[i] = *(const GAS v2u*)(sel_e + (size_t)t * 128 + 2 * lane); g[i] = *(const GAS f32x2v*)(sel_g + (size_t)t * 128 + 2 * lane); dn[i] = ((const GAS float*)sel_s)[(size_t)t * 8 + (lane >> 3)]; }
    float ux[4], uy[4], vx[4], vy[4];
#pragma unroll
    for (int i = 0; i < 4; ++i) { ux[i] = ((const GAS float*)US)[e[i].x]; uy[i] = ((const GAS float*)US)[e[i].y]; vx[i] = ((const GAS float*)VS)[e[i].x]; vy[i] = ((const GAS float*)VS)[e[i].y]; }
#pragma unroll
    for (int i = 0; i < 4; ++i) { const int t = t0 + i * ts; float a0 = 0.f, a1 = 0.f;
#pragma unroll
        for (int s = 0; s < 16; ++s) { a0 += bflo(pv[i][s]); a1 += bfhi(pv[i][s]); }
        const float inv = 1.0f / dn[i];
        const float ox = g[i].x * inv * gelu_exact(a0 * ux[i]) * vx[i], oy = g[i].y * inv * gelu_exact(a1 * uy[i]) * vy[i];
        const h2_t ha = {(_Float16)ox, (_Float16)ox}, hb = {(_Float16)oy, (_Float16)oy};
        *(GAS v2u*)(sel_g + (size_t)t * 128 + 2 * lane) = (v2u){__builtin_bit_cast(unsigned, ha), __builtin_bit_cast(unsigned, hb)}; }
}
__device__ __forceinline__ bool slice_item8(const SliceSched& S, const Ctx& c, int i, int& slice, int& tb) {
    if (S.mode) { const int it = S.rank + i * S.nloc; if (it >= 256) return false; slice = S.xcc; tb = it; return true; }
    const int it = (int)blockIdx.x + i * c.G; if (it >= 2048) return false; slice = it >> 8; tb = it & 255; return true;
}
__device__ __forceinline__ void spmm6_load(const unsigned char* vbase, const LAS unsigned* ids8, v4u (&qa)[8], v2u (&qb)[8]) {
    const v4u i0 = *(const LAS v4u*)(ids8), i1 = *(const LAS v4u*)(ids8 + 4);
    const unsigned id[8] = {i0.x, i0.y, i0.z, i0.w, i1.x, i1.y, i1.z, i1.w};
#pragma unroll
    for (int it = 0; it < 8; ++it) { const unsigned char* p = vbase + (size_t)id[it] * 1536; qa[it] = *(const GAS v4u*)p; qb[it] = *(const GAS v2u*)(p + 16); }
}
__device__ __forceinline__ void spmm6_fma(const v4u (&qa)[8], const v2u (&qb)[8], const LAS unsigned* cf8, h2_t (&y)[16]) {
    const v4u c0 = *(const LAS v4u*)(cf8), c1 = *(const LAS v4u*)(cf8 + 4);
    const unsigned cf[8] = {c0.x, c0.y, c0.z, c0.w, c1.x, c1.y, c1.z, c1.w};
#pragma unroll
    for (int it = 0; it < 8; ++it) { const v6u q = {qa[it].x, qa[it].y, qa[it].z, qa[it].w, qb[it].x, qb[it].y};
        const v32h_t f = __builtin_amdgcn_cvt_scalef32_pk32_f16_fp6(q, 1.0f); const h2_t c2 = __builtin_bit_cast(h2_t, cf[it]);
#pragma unroll
        for (int j = 0; j < 16; ++j) { const h2_t v = {f[2 * j], f[2 * j + 1]}; y[j] = __builtin_elementwise_fma(v, c2, y[j]); } }
}
__device__ __forceinline__ void peer_spmm6_wave(int t0, int s, int lane, const unsigned char* V6, const int* sel_e, const float* coef, const float* x1, float* xout, LAS unsigned* ldsw) {
    const int cg = lane & 7, sg = lane >> 3;
#pragma unroll
    for (int j = 0; j < 4; ++j) { *(LAS v4u*)(ldsw + 4 * (lane + 64 * j)) = *(const GAS v4u*)(sel_e + (size_t)t0 * 128 + 4 * (lane + 64 * j));
        *(LAS v4u*)(ldsw + 1024 + 4 * (lane + 64 * j)) = *(const GAS v4u*)(coef + (size_t)t0 * 128 + 4 * (lane + 64 * j)); }
    LDS_WAIT();
    const unsigned char* vbase = V6 + s * 192 + cg * 24;
    const LAS unsigned* idl = ldsw + sg * 16; const LAS unsigned* cfl = ldsw + 1024 + sg * 16;
    v4u qa0[8], qa1[8]; v2u qb0[8], qb1[8];
    spmm6_load(vbase, idl, qa0, qb0);
    const size_t xoff = (size_t)t0 * 2048 + s * 256 + cg * 32 + 4 * sg;
    f32x4 xn = *(const GAS f32x4*)(x1 + xoff);
#pragma unroll 1
    for (int k = 0; k < 8; ++k) {
        const f32x4 xv = xn;
        h2_t y[16];
#pragma unroll
        for (int j = 0; j < 16; ++j) y[j] = (h2_t){(_Float16)0.f, (_Float16)0.f};
        spmm6_load(vbase, idl + k * 128 + 8, qa1, qb1);
        if (k < 7) xn = *(const GAS f32x4*)(x1 + xoff + (size_t)(k + 1) * 2048);
        spmm6_fma(qa0, qb0, cfl + k * 128, y);
        if (k < 7) spmm6_load(vbase, idl + (k + 1) * 128, qa0, qb0);
        spmm6_fma(qa1, qb1, cfl + k * 128 + 8, y);
        unsigned u[16];
#pragma unroll
        for (int j = 0; j < 16; ++j) u[j] = __builtin_bit_cast(unsigned, y[j]);
#pragma unroll
        for (int i = 0; i < 8; ++i) { const bool up = (lane & 32) != 0; const unsigned snd = up ? u[i] : u[i + 8], kp = up ? u[i + 8] : u[i]; u[i] = __builtin_bit_cast(unsigned, __builtin_bit_cast(h2_t, kp) + __builtin_bit_cast(h2_t, (unsigned)__shfl_xor((int)snd, 32))); }
#pragma unroll
        for (int i = 0; i < 4; ++i) { const bool up = (lane & 16) != 0; const unsigned snd = up ? u[i] : u[i + 4], kp = up ? u[i + 4] : u[i]; u[i] = __builtin_bit_cast(unsigned, __builtin_bit_cast(h2_t, kp) + __builtin_bit_cast(h2_t, (unsigned)__shfl_xor((int)snd, 16))); }
#pragma unroll
        for (int i = 0; i < 2; ++i) { const bool up = (lane & 8) != 0; const unsigned snd = up ? u[i] : u[i + 2], kp = up ? u[i + 2] : u[i]; u[i] = __builtin_bit_cast(unsigned, __builtin_bit_cast(h2_t, kp) + __builtin_bit_cast(h2_t, (unsigned)__shfl_xor((int)snd, 8))); }
        const h2_t r0 = __builtin_bit_cast(h2_t, u[0]), r1 = __builtin_bit_cast(h2_t, u[1]);
        f32x4 o; o.x = xv.x + (float)r0[0]; o.y = xv.y + (float)r0[1]; o.z = xv.z + (float)r1[0]; o.w = xv.w + (float)r1[1];
        *(GAS f32x4*)(xout + xoff + (size_t)k * 2048) = o;
    }
    LDS_WAIT();
}

struct Args { const float* in[21]; float* out; unsigned char* ws; int lo, hi, li, pad; };
__global__ void __launch_bounds__(512, 2) mk_fwd(Args args) {
    extern __shared__ __attribute__((aligned(16))) unsigned char lds_raw[];
    Ctx c; c.lds = (LAS unsigned char*)lds_raw; c.tid = threadIdx.x; c.lane = c.tid & 63; c.wave = __builtin_amdgcn_readfirstlane(c.tid >> 6);
    c.G = gridDim.x; c.gw = blockIdx.x * 8 + c.wave; c.NGW = c.G * 8;
    volatile LAS unsigned* MISC = (volatile LAS unsigned*)(c.lds + MISC_OFF);
    if (c.tid < 32) MISC[c.tid] = 0u;
    __syncthreads();
    unsigned char* ws = args.ws;
    const int lo = args.lo, hi = args.hi;
    XcdBarrier bar; bar.w0 = 0; bar.bar = (unsigned*)(ws + WS_CTL) + CW_BAR + args.li * XCD_BAR_WORDS; bar.x = 0; bar.st = nullptr;
    if (hi - lo > 1) bar = xcd_barrier_post((unsigned*)(ws + WS_CTL) + CW_BAR + args.li * XCD_BAR_WORDS, MISC + 8);
#ifndef ATTN_REPS
#define ATTN_REPS 1
#endif
#ifndef PHMASK
#define PHMASK 0x1fff
#endif
#define IN(k) (((PHMASK >> ((k) % NPH)) & 1) && lo <= (k) && (k) < hi)
#define SEAM(k) do { if (IN(k) && IN((k) + 1)) xcd_barrier(bar); } while (0)
#define PH_BEGIN unsigned char* w = ws; float* outp = args.out; Ctx cc = c; int zi = 0; cc.lane = xb_lane_id(); cc.tid = cc.wave * 64 + cc.lane; \
    asm volatile("" : "+s"(w), "+s"(outp), "+s"(zi), "+v"(cc.tid), "+v"(cc.lane)); (void)w; (void)outp;
#define INP(k) (args.in[(k) + zi])
#define WSP(T, off) ((T*)(w + (off)))
    for (int l = 0; l < 2; ++l) {
        const int pb = l * NPH;
        if (IN(pb + 0)) { PH_BEGIN
            P0Args a; a.w_in = INP(2) + (size_t)l * DM * INW; a.w_br_sb = INP(11) + (size_t)l * BW * DM; a.w_br_hg = INP(12) + (size_t)l * BW * DM; a.w_br_conv = INP(13) + (size_t)l * BW * DM;
            a.w_o = INP(14) + (size_t)l * DM * DM; a.w_q = INP(16) + (size_t)l * DM * DM; a.u = INP(19) + (size_t)l * 16384 * 2048; a.v = INP(20) + (size_t)l * 16384 * 2048; a.lbp = INP(5);
            a.WinT = WSP(bf16, WS_WIN); a.WbrT = WSP(bf16, WS_WBR); a.WoT = WSP(bf16, WS_WO); a.WqT = WSP(bf16, WS_WQ); a.U = WSP(unsigned char, WS_U); a.V = WSP(unsigned char, WS_V); a.US = WSP(float, WS_US); a.VS = WSP(float, WS_VS); a.LB = WSP(float, WS_LB); a.layer = l; a.k1 = INP(17) + (size_t)l * 8 * 16384; a.k2 = INP(18) + (size_t)l * 8 * 16384; a.KB = WSP(bf16, WS_KEYS);
            p0_convert(cc, a);
            rms_phase_i8(cc, l == 0 ? INP(0) : WSP(const float, WS_X2), INP(1) + (size_t)l * DM, WSP(unsigned char, WS_H), WSP(float, WS_SA));
        }
        SEAM(pb + 0);
        if (IN(pb + 1)) { PH_BEGIN
            pg8::Gemm g{WSP(bf16, WS_H), WSP(bf16, WS_WIN), NTOK, INW, DM}; pg8::StaticOrder S; S.init(NTOK, INW, cc.G, (int)blockIdx.x);
            EpiIn E{WSP(bf16, WS_SEG), WSP(bf16, WS_GATE), WSP(float, WS_LB), WSP(float, WS_SA)};
            pg8::gemm_phase<EpiIn, pg8::StaticOrder, true, true, true>(cc.lds, g, S, E, cc.wave);
        }
        SEAM(pb + 1);
        if (IN(pb + 2)) { PH_BEGIN
            bf16* SEG = WSP(bf16, WS_SEG);
            conv_phase(cc, SEG + 7 * SEGSZ, INP(7) + (size_t)l * 31 * 1024, INP(8) + (size_t)l * 1024, INP(9) + (size_t)l * 1024, INP(10) + (size_t)l * 1024, WSP(bf16, WS_CONV));
            for (int ci = blockIdx.x; ci < 2048; ci += cc.G) hgA_chunk(cc, ci, SEG + 4 * SEGSZ, SEG + 5 * SEGSZ, WSP(bf16, WS_ST), WSP(float, WS_DEC));
            for (int r = cc.gw; r < 2 * (NTOK / 4); r += cc.NGW) {
                if (r < NTOK / 4) qknorm_rows4(SEG + (size_t)r * 4 * 1024, 1024, INP(3) + (size_t)l * 128, 0.08838834764831845f, cc.lane);
                else qknorm_rows4(SEG + SEGSZ + (size_t)(r - NTOK / 4) * 4 * 1024, 1024, INP(4) + (size_t)l * 128, 1.0f, cc.lane);
            }
            LAS unsigned short* scr = (LAS unsigned short*)(cc.lds + 4096 + cc.wave * 8192);
            for (int it = cc.gw; it < 8192; it += cc.NGW) vt_item(it, cc.lane, SEG + 2 * SEGSZ, WSP(bf16, WS_MERGED), scr);
        }
        SEAM(pb + 2);
        if (IN(pb + 3)) { PH_BEGIN
            bf16* SEG = WSP(bf16, WS_SEG);
            hgB(cc, WSP(bf16, WS_ST), WSP(float, WS_DEC));
            for (int rep = 0; rep < ATTN_REPS; ++rep)
            for (int p = blockIdx.x; p < 256; p += cc.G) { const int bh = (p & 7) * 4 + (p >> 6), j = (p >> 3) & 7;
                if (cc.wave >= 4) {
#pragma unroll 1
                    for (int u = 0; u < 2; ++u) attn_unit<true>(cc, bh, u ? j : 15 - j, SEG, SEG + SEGSZ, WSP(bf16, WS_MERGED), SEG + 2 * SEGSZ);
                } else {
#pragma unroll 1
                    for (int u = 0; u < 2; ++u) attn_unit<false>(cc, bh, u ? j : 15 - j, SEG, SEG + SEGSZ, WSP(bf16, WS_MERGED), SEG + 2 * SEGSZ);
                } }
        }
        SEAM(pb + 3);
        if (IN(pb + 4)) { PH_BEGIN
            bf16* SEG = WSP(bf16, WS_SEG);
            for (int ci = blockIdx.x; ci < 2048; ci += cc.G) hgC_chunk(cc, ci, SEG + 3 * SEGSZ, SEG + 4 * SEGSZ, SEG + 5 * SEGSZ, SEG + 6 * SEGSZ, WSP(bf16, WS_ST), INP(6) + (size_t)l * 128, WSP(bf16, WS_HGR));
        }
        SEAM(pb + 4);
        if (IN(pb + 5)) { PH_BEGIN
            pg8::StaticOrder S; S.init(NTOK, DM, cc.G, (int)blockIdx.x);
            { pg8::Gemm g{WSP(bf16, WS_SEG) + 2 * SEGSZ, WSP(bf16, WS_WBR), NTOK, DM, BW}; EpiMerge<true> E{WSP(bf16, WS_GATE), WSP(bf16, WS_MERGED)}; pg8::gemm_phase<EpiMerge<true>, pg8::StaticOrder, true, true>(cc.lds, g, S, E, cc.wave); }
            { pg8::Gemm g{WSP(bf16, WS_HGR), WSP(bf16, WS_WBR) + (size_t)DM * BW, NTOK, DM, BW}; EpiMerge<false> E{WSP(bf16, WS_GATE) + (size_t)NTOK * 2048, WSP(bf16, WS_MERGED)}; pg8::gemm_phase<EpiMerge<false>, pg8::StaticOrder, true, true>(cc.lds, g, S, E, cc.wave); }
            { pg8::Gemm g{WSP(bf16, WS_CONV), WSP(bf16, WS_WBR) + (size_t)2 * DM * BW, NTOK, DM, BW}; EpiMerge<false> E{WSP(bf16, WS_GATE) + (size_t)2 * NTOK * 2048, WSP(bf16, WS_MERGED)}; pg8::gemm_phase<EpiMerge<false>, pg8::StaticOrder, true, true>(cc.lds, g, S, E, cc.wave); }
        }
        SEAM(pb + 5);
        if (IN(pb + 6)) { PH_BEGIN
            pg8::Gemm g{WSP(bf16, WS_MERGED), WSP(bf16, WS_WO), NTOK, DM, DM}; pg8::StaticOrder S; S.init(NTOK, DM, cc.G, (int)blockIdx.x);
            EpiResid E{l == 0 ? INP(0) : WSP(const float, WS_X2), outp};
            pg8::gemm_phase<EpiResid, pg8::StaticOrder, true, true>(cc.lds, g, S, E, cc.wave);
        }
        SEAM(pb + 6);
        if (IN(pb + 7)) { PH_BEGIN rms_phase(cc, outp, INP(15) + (size_t)l * DM, WSP(bf16, WS_H)); }
        SEAM(pb + 7);
        if (IN(pb + 8)) { PH_BEGIN
            pg8::Gemm g{WSP(bf16, WS_H), WSP(bf16, WS_WQ), NTOK, DM, DM}; pg8::StaticOrder S; S.init(NTOK, DM, cc.G, (int)blockIdx.x);
            EpiStoreBf16 E{WSP(bf16, WS_QPEER)};
            pg8::gemm_phase<EpiStoreBf16, pg8::StaticOrder, true, true>(cc.lds, g, S, E, cc.wave);
        }
        SEAM(pb + 8);
        if (IN(pb + 9)) { PH_BEGIN
            for (int item = blockIdx.x; item < 512; item += cc.G) { const int hd = item & 7, tg = item >> 3;
                const bf16* KB = WSP(bf16, WS_KEYS);
#pragma unroll
                for (int i = 0; i < 8; ++i) { const int p = cc.tid + 512 * i, li = p >> 11, row = (p >> 4) & 127, c16 = p & 15;
                    *(LAS v4u*)(cc.lds + li * 128 * PK_KS + row * PK_KS + c16 * 16) = *(const GAS v4u*)(KB + (size_t)(li * 8 + hd) * 16384 + row * 128 + c16 * 8); }
                __syncthreads();
                peer_select32(hd, tg * 256 + cc.wave * 32, cc.lane, WSP(bf16, WS_QPEER), cc.lds, cc.lds + 128 * PK_KS, w, (LAS unsigned*)(cc.lds + 2 * 128 * PK_KS + cc.wave * 4096));
                __syncthreads(); }
        }
        SEAM(pb + 9);
        if (IN(pb + 10)) { PH_BEGIN
            const SliceSched SS = slice_sched_init(cc, (unsigned*)(w + WS_CTL), bar, l * 2 + 0);
            for (int i = 0;; ++i) { int sl, tb; if (!slice_item(SS, cc, i, sl, tb)) break;
                peer_sddmm_wave(tb * 64 + cc.wave * 8, sl, cc.lane, WSP(bf16, WS_H), WSP(unsigned char, WS_U), WSP(int, WS_SEL), WSP(float, WS_PART), (LAS unsigned*)(cc.lds + 4096 + cc.wave * 8192)); }
        }
        SEAM(pb + 10);
        if (IN(pb + 11)) { PH_BEGIN
            for (int n = cc.gw; n < NTOK / 4; n += cc.NGW) peer_coef_tokens4(n, NTOK / 4, cc.lane, WSP(float, WS_PART), WSP(int, WS_SEL), WSP(float, WS_SEL + 8 * MiB), WSP(float, WS_SELS), WSP(float, WS_US), WSP(float, WS_VS));
        }
        SEAM(pb + 11);
        if (IN(pb + 12)) { PH_BEGIN
            float* xo = l == 0 ? WSP(float, WS_X2) : outp;
            const SliceSched SS = slice_sched_init(cc, (unsigned*)(w + WS_CTL), bar, l * 2 + 1);
            for (int i = 0;; ++i) { int sl, tb; if (!slice_item8(SS, cc, i, sl, tb)) break;
                peer_spmm6_wave(tb * 64 + cc.wave * 8, sl, cc.lane, WSP(unsigned char, WS_V), WSP(int, WS_SEL), WSP(float, WS_SEL + 8 * MiB), outp, xo, (LAS unsigned*)(cc.lds + 4096 + cc.wave * 8192)); }
        }
        SEAM(pb + 12);
    }
#undef PH_BEGIN
#undef INP
#undef WSP
#undef IN
#undef SEAM
}

#ifndef MK_SPLIT
#define MK_SPLIT 0
#endif
extern "C" void kernel_launch(void* const* d_in, const int* in_sizes, int n_in, void* d_out, int out_size, void* d_ws, size_t ws_size, hipStream_t stream) {
    static int grid = 0;
    if (grid == 0) {
        if (n_in != 21 || out_size != NTOK * DM || ws_size < WS_END) { fprintf(stderr, "kernel_launch: unexpected shapes (n_in %d, out %d, ws %zu < %zu); nothing launched\n", n_in, out_size, ws_size, (size_t)WS_END); grid = -1; return; }
        int dev = 0, cus = 0, per_cu = 0;
        if (hipGetDevice(&dev) != hipSuccess || hipDeviceGetAttribute(&cus, hipDeviceAttributeMultiprocessorCount, dev) != hipSuccess) { grid = -1; return; }
        if (hipFuncSetAttribute((const void*)mk_fwd, hipFuncAttributeMaxDynamicSharedMemorySize, LDS_BYTES) != hipSuccess) { fprintf(stderr, "kernel_launch: hipFuncSetAttribute failed\n"); grid = -1; return; }
        if (hipOccupancyMaxActiveBlocksPerMultiprocessor(&per_cu, (const void*)mk_fwd, 512, LDS_BYTES) != hipSuccess || per_cu < 1) fprintf(stderr, "kernel_launch: occupancy query reports %d\n", per_cu);
        (void)hipGetLastError();
        grid = cus;
    }
    if (grid < 0) return;
    if (hipMemsetAsync((char*)d_ws + WS_CTL, 0, 1 * MiB, stream) != hipSuccess) { fprintf(stderr, "kernel_launch: memset failed\n"); return; }
    Args a{};
    for (int i = 0; i < 21; ++i) a.in[i] = (const float*)d_in[i];
    a.out = (float*)d_out; a.ws = (unsigned char*)d_ws; a.pad = 0;
#if MK_SPLIT
    for (int p = 0; p < NPHASES; ++p) { a.lo = p; a.hi = p + 1; a.li = p; hipLaunchKernelGGL(mk_fwd, dim3(grid), dim3(512), LDS_BYTES, stream, a); }
#else
    a.lo = 0; a.hi = NPHASES; a.li = 0;
    hipLaunchKernelGGL(mk_fwd, dim3(grid), dim3(512), LDS_BYTES, stream, a);
#endif
    const hipError_t le = hipPeekAtLastError();
    if (le != hipSuccess) fprintf(stderr, "kernel_launch: launch failed: %s\n", hipGetErrorName(le));
}
```

```cpp
#include <hip/hip_runtime.h>
#include <cstdio>
#include <cstdint>
namespace pg8 {
#define PG8_LAS __attribute__((address_space(3)))
typedef unsigned short bf16_t;
typedef short bf16x8 __attribute__((ext_vector_type(8)));
typedef float f32x4 __attribute__((ext_vector_type(4)));
typedef unsigned u32x4 __attribute__((ext_vector_type(4)));
constexpr int BM = 256, BK = 64, HALF = 128, HTB = HALF * BK * 2  , STAGE_BYTES = 8 * HTB, NXCD = 8, WGM = 8;

__host__ __device__ __forceinline__ int lds_byte(int r, int c) { const int st = (r >> 4) * 2 + (c >> 5), rr = r & 15, cc = c & 31, ob = rr * 64 + cc * 2; return st * 1024 + (ob ^ (((ob >> 9) & 1) << 5)); }
__host__ __device__ __forceinline__ void stage_rc(int b, int& R, int& C) { const int st = b / 1024, sb = b % 1024, swz = sb ^ (((sb >> 9) & 1) << 5); R = (st >> 1) * 16 + swz / 64; C = (st & 1) * 32 + (swz % 64) / 2; }
__host__ __device__ __forceinline__ int perm32(int rho) { const int n = rho >> 4, i = rho & 15; return 8 * (i >> 2) + 4 * n + (i & 3); }

struct Unit { int pm, pn; };
struct Gemm { const bf16_t* A; const bf16_t* Bt; int M, N, K; };

struct StaticOrder {
    int nM, nN, nwg, G, c;
    __host__ __device__ void init(int M, int N, int G_, int c_) { nM = M / BM; nN = N / BM; nwg = nM * nN; G = G_; c = c_; }
    __host__ __device__ bool next(int i, Unit& u) const {
        const long L = (long)i * G + c; if (L >= nwg) return false;
        int wgid = (int)L; { const int q = nwg / NXCD, r = nwg % NXCD, xcd = wgid % NXCD, off = wgid / NXCD; wgid = (xcd < r ? xcd * (q + 1) : r * (q + 1) + (xcd - r) * q) + off; }
        const int nig = WGM * nN, gid = wgid / nig, fm = gid * WGM, gsz = (nM - fm) < WGM ? (nM - fm) : WGM;
        u.pm = fm + ((wgid % nig) % gsz); u.pn = (wgid % nig) / gsz; return true;
    }
    __device__ __forceinline__ void a_ready(const Unit&) const {}
    __device__ __forceinline__ void done(const Unit&) const {}
};

typedef float f32x2 __attribute__((ext_vector_type(2)));
template <class Epi, class Sched, bool ALIGN_EPI = false, bool SP2 = false, bool I8 = false>
__device__ __forceinline__ void gemm_phase(PG8_LAS unsigned char* lds, const Gemm g, const Sched& S, const Epi& E, int wave_) {
    unsigned z_ = 0u; asm volatile("" : "+s"(z_)); int tid_ = wave_ * 64 + (int)__builtin_amdgcn_mbcnt_hi(~0u, __builtin_amdgcn_mbcnt_lo(~0u, z_)); asm volatile("" : "+v"(tid_));     int K_ = g.K; asm volatile("" : "+s"(K_));
    const int tid = tid_, wid = __builtin_amdgcn_readfirstlane(tid >> 6), lane = tid & 63, wr = wid >> 2, wc = wid & 3, fr = lane & 15, fq = lane >> 4;
    const int K = I8 ? (K_ >> 1) : K_, nt = K / BK;
    unsigned voffA[2], voffB[2];
#pragma unroll
    for (int i = 0; i < 2; ++i) { int R, C; stage_rc(tid * 16 + i * 8192, R, C); const int Rb = Epi::PERM ? ((R & ~31) + perm32(R & 31)) : R;
        voffA[i] = (unsigned)(R * K + C) * 2u; voffB[i] = (unsigned)(Rb * K + C) * 2u; }
    const size_t kstep = (size_t)(BK * 2);
    const size_t hstep = (size_t)HALF * K * 2;
    const size_t tstep = 2 * hstep;
    const unsigned ldsw = (unsigned)wid * 1024u;
    const int aoff = lds_byte(wr * 64 + fr, fq * 8), boff = lds_byte(wc * 32 + fr, fq * 8);
#define PG8_SA(b, h) (((b) * 2 + (h)) * HTB)
#define PG8_SB(b, h) ((4 + (b) * 2 + (h)) * HTB)
#define PG8_STAGE(bufoff, gbase, voff) do { _Pragma("unroll") for (int _i = 0; _i < 2; ++_i) \
        __builtin_amdgcn_global_load_lds((const unsigned*)((const char*)(gbase) + (voff)[_i]), (PG8_LAS unsigned*)(lds + (bufoff) + ldsw + _i * 8192), 16, 0, 0); } while (0)
#define PG8_LDA(dst, b, h) do { _Pragma("unroll") for (int m = 0; m < 4; ++m) _Pragma("unroll") for (int k = 0; k < 2; ++k) dst[m][k] = *(const PG8_LAS bf16x8*)(lds + PG8_SA(b, h) + aoff + m * 2048 + k * 1024); } while (0)
#define PG8_LDB(dst, b, h) do { _Pragma("unroll") for (int n = 0; n < 2; ++n) _Pragma("unroll") for (int k = 0; k < 2; ++k) dst[n][k] = *(const PG8_LAS bf16x8*)(lds + PG8_SB(b, h) + boff + n * 2048 + k * 1024); } while (0)
#define PG8_MMA(ai, bj, At, Bt) do { __builtin_amdgcn_s_setprio(1); _Pragma("unroll") for (int m = 0; m < 4; ++m) _Pragma("unroll") for (int n = 0; n < 2; ++n) _Pragma("unroll") for (int k = 0; k < 2; ++k) { \
        if constexpr (I8) { typedef int v4i_t __attribute__((ext_vector_type(4))); \
            acc[ai][bj][m][n] = __builtin_bit_cast(f32x4, __builtin_amdgcn_mfma_i32_16x16x64_i8(__builtin_bit_cast(v4i_t, Bt[n][k]), __builtin_bit_cast(v4i_t, At[m][k]), __builtin_bit_cast(v4i_t, acc[ai][bj][m][n]), 0, 0, 0)); } \
        else acc[ai][bj][m][n] = __builtin_amdgcn_mfma_f32_16x16x32_bf16(Bt[n][k], At[m][k], acc[ai][bj][m][n], 0, 0, 0); } __builtin_amdgcn_s_setprio(0); } while (0)
#define PG8_WAIT_V(n) asm volatile("s_waitcnt vmcnt(" #n ")" ::: "memory")
#define PG8_WAIT_L(n) asm volatile("s_waitcnt lgkmcnt(" #n ")" ::: "memory")
#define PG8_BAR __builtin_amdgcn_s_barrier()
#define PG8_SCHED __builtin_amdgcn_sched_barrier(0)
    Unit cur, nxt; int ui = 0;
    if (!S.next(0, cur)) return;
    f32x4 acc[2][2][4][2];
#pragma unroll
    for (int a = 0; a < 2; ++a)
#pragma unroll
        for (int b = 0; b < 2; ++b)
#pragma unroll
            for (int m = 0; m < 4; ++m)
#pragma unroll
                for (int n = 0; n < 2; ++n) acc[a][b][m][n] = (f32x4){0.f, 0.f, 0.f, 0.f};
    bf16x8 At[4][2], B0[2][2], B1[2][2];
    const char* cA = (const char*)g.A + (size_t)cur.pm * tstep; const char* cB = (const char*)g.Bt + (size_t)cur.pn * tstep;
    S.a_ready(cur);
    if constexpr (SP2) {
        PG8_STAGE(PG8_SB(0, 0), cB, voffB); PG8_STAGE(PG8_SB(0, 1), cB + hstep, voffB); PG8_STAGE(PG8_SA(0, 0), cA, voffA); PG8_STAGE(PG8_SA(0, 1), cA + hstep, voffA);
        if (wr == 1) PG8_BAR;
        PG8_WAIT_V(2); PG8_BAR;
        PG8_STAGE(PG8_SB(1, 0), cB + kstep, voffB); PG8_STAGE(PG8_SA(1, 0), cA + kstep, voffA); PG8_STAGE(PG8_SB(1, 1), cB + hstep + kstep, voffB);
        PG8_WAIT_V(6); PG8_BAR;
    } else {
        PG8_STAGE(PG8_SB(0, 0), cB, voffB); PG8_STAGE(PG8_SA(0, 0), cA, voffA); PG8_STAGE(PG8_SB(0, 1), cB + hstep, voffB); PG8_STAGE(PG8_SA(0, 1), cA + hstep, voffA);
        if (wr == 1) PG8_BAR;
        PG8_WAIT_V(4); PG8_BAR;
        PG8_STAGE(PG8_SB(1, 0), cB + kstep, voffB); PG8_STAGE(PG8_SA(1, 0), cA + kstep, voffA); PG8_STAGE(PG8_SB(1, 1), cB + hstep + kstep, voffB);
        PG8_WAIT_V(6); PG8_BAR;
    }
    for (;;) {
        const bool has_next = S.next(ui + 1, nxt);
        const char* nA = has_next ? (const char*)g.A + (size_t)nxt.pm * tstep : cA; const char* nB = has_next ? (const char*)g.Bt + (size_t)nxt.pn * tstep : cB;
        for (int t = 0; t < nt; t += 2) {
            const bool last = (t == nt - 2);
            const char* a1 = cA + (size_t)(t + 1) * kstep;
            const char* a2 = last ? nA : cA + (size_t)(t + 2) * kstep; const char* b2 = last ? nB : cB + (size_t)(t + 2) * kstep;
            const char* a3 = a2 + kstep; const char* b3 = b2 + kstep;
            if (last && has_next) S.a_ready(nxt);
            if constexpr (SP2) {
            PG8_LDB(B0, 0, 0); PG8_LDB(B1, 0, 1); PG8_SCHED; PG8_LDA(At, 0, 0); PG8_STAGE(PG8_SA(1, 1), a1 + hstep, voffA);
            PG8_WAIT_V(8); PG8_WAIT_L(0); PG8_BAR; PG8_MMA(0, 0, At, B0); PG8_MMA(0, 1, At, B1); PG8_BAR; PG8_SCHED;
            PG8_LDA(At, 0, 1); PG8_STAGE(PG8_SB(0, 0), b2, voffB); PG8_STAGE(PG8_SB(0, 1), b2 + hstep, voffB); PG8_STAGE(PG8_SA(0, 0), a2, voffA);
            PG8_WAIT_V(8); PG8_WAIT_L(0); PG8_BAR; PG8_MMA(1, 0, At, B0); PG8_MMA(1, 1, At, B1); PG8_BAR; PG8_SCHED;
            PG8_LDB(B0, 1, 0); PG8_LDB(B1, 1, 1); PG8_SCHED; PG8_LDA(At, 1, 0); PG8_STAGE(PG8_SA(0, 1), a2 + hstep, voffA);
            PG8_WAIT_V(8); PG8_WAIT_L(0); PG8_BAR; PG8_MMA(0, 0, At, B0); PG8_MMA(0, 1, At, B1); PG8_BAR; PG8_SCHED;
            PG8_LDA(At, 1, 1); PG8_STAGE(PG8_SB(1, 0), b3, voffB); PG8_STAGE(PG8_SB(1, 1), b3 + hstep, voffB); PG8_STAGE(PG8_SA(1, 0), a3, voffA);
            PG8_WAIT_V(8); PG8_WAIT_L(0); PG8_BAR; PG8_MMA(1, 0, At, B0); PG8_MMA(1, 1, At, B1); PG8_BAR; PG8_SCHED;
            } else {
            PG8_LDB(B0, 0, 0); PG8_SCHED; PG8_LDA(At, 0, 0); PG8_STAGE(PG8_SA(1, 1), a1 + hstep, voffA);
            PG8_WAIT_L(8); PG8_BAR; PG8_WAIT_L(0); PG8_MMA(0, 0, At, B0); PG8_BAR; PG8_SCHED;
            PG8_LDB(B1, 0, 1); PG8_STAGE(PG8_SB(0, 0), b2, voffB);
            PG8_BAR; PG8_WAIT_L(0); PG8_MMA(0, 1, At, B1); PG8_BAR;
            PG8_LDA(At, 0, 1); PG8_STAGE(PG8_SA(0, 0), a2, voffA);
            PG8_BAR; PG8_WAIT_L(0); PG8_MMA(1, 0, At, B0); PG8_BAR; PG8_SCHED;
            PG8_STAGE(PG8_SB(0, 1), b2 + hstep, voffB);
            PG8_WAIT_V(6); PG8_BAR; PG8_MMA(1, 1, At, B1); PG8_BAR;
            PG8_LDB(B0, 1, 0); PG8_SCHED; PG8_LDA(At, 1, 0); PG8_STAGE(PG8_SA(0, 1), a2 + hstep, voffA);
            PG8_WAIT_L(8); PG8_BAR; PG8_WAIT_L(0); PG8_MMA(0, 0, At, B0); PG8_BAR; PG8_SCHED;
            PG8_LDB(B1, 1, 1); PG8_STAGE(PG8_SB(1, 0), b3, voffB);
            PG8_BAR; PG8_WAIT_L(0); PG8_MMA(0, 1, At, B1); PG8_BAR;
            PG8_LDA(At, 1, 1); PG8_STAGE(PG8_SA(1, 0), a3, voffA);
            PG8_BAR; PG8_WAIT_L(0); PG8_MMA(1, 0, At, B0); PG8_BAR; PG8_SCHED;
            PG8_STAGE(PG8_SB(1, 1), b3 + hstep, voffB);
            PG8_WAIT_V(6); PG8_BAR; PG8_MMA(1, 1, At, B1); PG8_BAR;
            }
        }
        if constexpr (ALIGN_EPI) { if (wr == 0) PG8_BAR; }
        if constexpr (I8) {
#pragma unroll
            for (int a = 0; a < 2; ++a)
#pragma unroll
                for (int m = 0; m < 4; ++m) { const float r_ = E.rowscale(cur.pm * BM + wr * 64 + fr + a * HALF + m * 16);
#pragma unroll
                    for (int b = 0; b < 2; ++b)
#pragma unroll
                        for (int n = 0; n < 2; ++n) { typedef int v4i2_t __attribute__((ext_vector_type(4))); const v4i2_t i_ = __builtin_bit_cast(v4i2_t, acc[a][b][m][n]);
                            acc[a][b][m][n] = (f32x4){(float)i_[0] * r_, (float)i_[1] * r_, (float)i_[2] * r_, (float)i_[3] * r_}; } }
        }
        if constexpr (!Epi::AFTER_DRAIN) { E(acc, cur, wr, wc, fr, fq); S.done(cur); }
        if (!has_next) break;
#pragma unroll
        for (int a = 0; a < 2; ++a)
#pragma unroll
            for (int b = 0; b < 2; ++b)
#pragma unroll
                for (int m = 0; m < 4; ++m)
#pragma unroll
                    for (int n = 0; n < 2; ++n) acc[a][b][m][n] = (f32x4){0.f, 0.f, 0.f, 0.f};
        cur = nxt; cA = nA; cB = nB; ++ui;
        if constexpr (ALIGN_EPI) { if (wr == 1) PG8_BAR; }
    }
    PG8_WAIT_V(0);
    if constexpr (!ALIGN_EPI) { if (wr == 0) PG8_BAR; }
    PG8_BAR;
    if constexpr (Epi::AFTER_DRAIN) { E.fused(acc, cur, wr, wc, fr, fq, lds, wid, lane); S.done(cur); }
#undef PG8_SA
#undef PG8_SB
#undef PG8_STAGE
#undef PG8_LDA
#undef PG8_LDB
#undef PG8_MMA
#undef PG8_WAIT_V
#undef PG8_WAIT_L
#undef PG8_BAR
#undef PG8_SCHED
}
}
#define XB_TMO      128
#define XB_XCNT(j)  (256  + 64 * (j))
#define XB_XSUB(j)  (1280 + 64 * (j))
#define XB_XGEN(j)  (2304 + 64 * (j))
#define XB_TOP      3328
#define XB_TOPGEN   3392
#define XCD_BAR_WORDS 3456
#define XB_SPIN_CAP (1u << 24)
#define LAS __attribute__((address_space(3)))

__device__ __forceinline__ unsigned xb_ld(unsigned* p)              { return __hip_atomic_load(p, __ATOMIC_RELAXED, __HIP_MEMORY_SCOPE_AGENT); }
__device__ __forceinline__ unsigned xb_add(unsigned* p, unsigned v) { return __hip_atomic_fetch_add(p, v, __ATOMIC_RELAXED, __HIP_MEMORY_SCOPE_AGENT); }
__device__ __forceinline__ unsigned xb_xcc_id() { return (unsigned)__builtin_amdgcn_s_getreg((3 << 11) | 20) & 0xFu; }
#define XB_SPIN(cond, bar) do { unsigned _sp = 0; while (cond) { __builtin_amdgcn_s_sleep(1); \
    if ((++_sp & 255u) == 0u) { if (xb_ld(&(bar)[XB_TMO])) break; if (_sp > XB_SPIN_CAP) { atomicAdd(&(bar)[XB_TMO], 1u); break; } } } } while (0)

__device__ __forceinline__ int xb_lane_id() { unsigned z = 0u; asm volatile("" : "+s"(z)); return (int)__builtin_amdgcn_mbcnt_hi(~0u, __builtin_amdgcn_mbcnt_lo(~0u, z)); }
struct XcdBarrier {
    unsigned w0;
    unsigned* bar; unsigned x;
    volatile LAS unsigned* st;
};

__device__ __forceinline__ XcdBarrier xcd_barrier_post(unsigned* bar, volatile LAS unsigned* st) {
    XcdBarrier b; b.bar = bar; b.x = xb_xcc_id(); b.st = st; b.w0 = (__builtin_amdgcn_readfirstlane((int)threadIdx.x >> 6) == 0) ? 1u : 0u;
    if (b.w0 && xb_lane_id() == 0) (void)xb_add(&bar[XB_XCNT(b.x)], 1u);
    return b;
}
__device__ __forceinline__ void xcd_barrier_complete(unsigned* bar, unsigned x, unsigned& nloc, unsigned& nx) {
    const unsigned G = gridDim.x * gridDim.y * gridDim.z;
    unsigned sum, cnt, mine, sp = 0u;
    for (;;) {
        sum = 0u; cnt = 0u; mine = 0u;
#pragma unroll
        for (unsigned j = 0; j < 16; ++j) { const unsigned c = xb_ld(&bar[XB_XCNT(j)]); sum += c; cnt += (c > 0u) ? 1u : 0u; mine = (j == x) ? c : mine; }
        if (sum == G) break;
        __builtin_amdgcn_s_sleep(1);
        if ((++sp & 255u) == 0u) { if (xb_ld(&bar[XB_TMO])) break; if (sp > XB_SPIN_CAP) { atomicAdd(&bar[XB_TMO], 1u); break; } }
    }
    nloc = mine > 0u ? mine : 1u; nx = cnt > 0u ? cnt : 1u;
}

__device__ __forceinline__ void xcd_barrier(const XcdBarrier& b) {
    asm volatile("s_waitcnt vmcnt(0)" ::: "memory");
    __syncthreads();
    if (b.w0 && xb_lane_id() == 0) {
        unsigned* bar = b.bar;
        __builtin_amdgcn_s_waitcnt(0);
        unsigned nloc = b.st[0], nx = b.st[1];
        if (nloc == 0u) { xcd_barrier_complete(bar, b.x, nloc, nx); b.st[0] = nloc; b.st[1] = nx; }
        const unsigned old = xb_add(&bar[XB_XSUB(b.x)], 1u);
        const unsigned gen = old / nloc;
        if (old + 1u == (gen + 1u) * nloc) {
            __builtin_amdgcn_fence(__ATOMIC_RELEASE, "agent");
            asm volatile("s_waitcnt vmcnt(0)" ::: "memory");
            const unsigned og = xb_add(&bar[XB_TOP], 1u);
            const unsigned tg = og / nx;
            if (og + 1u == (tg + 1u) * nx) xb_add(&bar[XB_TOPGEN], 1u);
            else XB_SPIN(xb_ld(&bar[XB_TOPGEN]) == tg, bar);
            __builtin_amdgcn_fence(__ATOMIC_ACQUIRE, "agent");
            xb_add(&bar[XB_XGEN(b.x)], 1u);
            asm volatile("s_waitcnt vmcnt(0)" ::: "memory");
        } else {
            XB_SPIN(xb_ld(&bar[XB_XGEN(b.x)]) == gen, bar);
            __builtin_amdgcn_fence(__ATOMIC_ACQUIRE, "agent");
            asm volatile("s_waitcnt vmcnt(0)" ::: "memory");
        }
    }
    __syncthreads();
}


#define GAS __attribute__((address_space(1)))
typedef unsigned short bf16;
typedef unsigned v4u __attribute__((ext_vector_type(4)));
typedef unsigned v2u __attribute__((ext_vector_type(2)));
typedef float f32x4 __attribute__((ext_vector_type(4)));
typedef float f32x2v __attribute__((ext_vector_type(2)));
typedef float f32x16 __attribute__((ext_vector_type(16)));
typedef short bf16x8 __attribute__((ext_vector_type(8)));
typedef __bf16 bf16v2 __attribute__((ext_vector_type(2)));
typedef _Float16 h2_t __attribute__((ext_vector_type(2)));
typedef _Float16 v32h_t __attribute__((ext_vector_type(32)));
typedef unsigned v6u __attribute__((ext_vector_type(6)));

constexpr int NTOK = 16384, DM = 2048, SEQ = 4096, INW = 15360, BW = 1024;
constexpr float EPS = 1e-6f;
constexpr float WIN_QS = 1024.0f;
constexpr int NPH = 13;
constexpr int NPHASES = 2 * NPH;

constexpr size_t MiB = 1u << 20;
constexpr size_t WS_CTL = 0;
constexpr size_t WS_LB = 1 * MiB;
constexpr size_t WS_SA = 1 * MiB + 192 * 1024;
constexpr size_t WS_US = 1 * MiB + 64 * 1024, WS_VS = 1 * MiB + 128 * 1024;
constexpr size_t WS_WIN = 2 * MiB;
constexpr size_t WS_WBR = 62 * MiB;
constexpr size_t WS_WO = 74 * MiB;
constexpr size_t WS_WQ = 82 * MiB;
constexpr size_t WS_U = 91 * MiB;
constexpr size_t WS_V = 155 * MiB;
constexpr size_t WS_H = 219 * MiB;
constexpr size_t WS_SEG = 283 * MiB;
constexpr size_t WS_GATE = 539 * MiB;
constexpr size_t WS_X2 = 731 * MiB;
constexpr size_t WS_CONV = 859 * MiB;
constexpr size_t WS_HGR = 891 * MiB;
constexpr size_t WS_MERGED = 923 * MiB;
constexpr size_t WS_SEL = 987 * MiB;
constexpr size_t WS_SELS = 1003 * MiB;
constexpr size_t WS_DEC = 1004 * MiB;
constexpr size_t WS_END = 1005 * MiB;
constexpr size_t WS_ST = WS_H;
constexpr size_t WS_KEYS = 90 * MiB;
constexpr size_t WS_PART = WS_GATE;
constexpr size_t WS_QPEER = WS_SEG;
constexpr size_t SEGSZ = (size_t)NTOK * 1024;
constexpr int CW_BAR = 4096;
constexpr int CW_RANK = 131072;

constexpr int RING_BYTES = 131072, MISC_OFF = RING_BYTES + 320, LDS_BYTES = 147456;

__device__ __forceinline__ unsigned pk2c(float lo, float hi) { f32x2v v = {lo, hi}; bf16v2 b = __builtin_convertvector(v, bf16v2); return __builtin_bit_cast(unsigned, b); }
__device__ __forceinline__ float bflo(unsigned x) { return __uint_as_float(x << 16); }
__device__ __forceinline__ float bfhi(unsigned x) { return __uint_as_float(x & 0xffff0000u); }
__device__ __forceinline__ float sigm(float x) { return __builtin_amdgcn_rcpf(1.0f + __expf(-x)); }
__device__ __forceinline__ float wave_sum(float v) {
#pragma unroll
    for (int o = 1; o < 64; o <<= 1) v += __shfl_xor(v, o);
    return v;
}
__device__ __forceinline__ float wave_max(float v) {
#pragma unroll
    for (int o = 1; o < 64; o <<= 1) v = fmaxf(v, __shfl_xor(v, o));
    return v;
}
#define LDS_WAIT() asm volatile("s_waitcnt lgkmcnt(0)" ::: "memory")
#define MFMA32(a, b, c) __builtin_amdgcn_mfma_f32_32x32x16_bf16((a), (b), (c), 0, 0, 0)
__device__ __forceinline__ int ridx16(int lane) { return ((lane >> 5) & 1) * 8 + ((lane >> 4) & 1) * 4 + ((lane >> 3) & 1) * 2 + ((lane >> 2) & 1); }
__device__ __forceinline__ void xreduce16(float (&v)[16], int lane) {
#pragma unroll
    for (int i = 0; i < 8; ++i) { const bool up = (lane & 32) != 0; const float snd = up ? v[i] : v[i + 8], kp = up ? v[i + 8] : v[i]; v[i] = kp + __shfl_xor(snd, 32); }
#pragma unroll
    for (int i = 0; i < 4; ++i) { const bool up = (lane & 16) != 0; const float snd = up ? v[i] : v[i + 4], kp = up ? v[i + 4] : v[i]; v[i] = kp + __shfl_xor(snd, 16); }
#pragma unroll
    for (int i = 0; i < 2; ++i) { const bool up = (lane & 8) != 0; const float snd = up ? v[i] : v[i + 2], kp = up ? v[i + 2] : v[i]; v[i] = kp + __shfl_xor(snd, 8); }
    { const bool up = (lane & 4) != 0; const float snd = up ? v[0] : v[1], kp = up ? v[1] : v[0]; v[0] = kp + __shfl_xor(snd, 4); }
    v[0] += __shfl_xor(v[0], 2); v[0] += __shfl_xor(v[0], 1);
}
__device__ __forceinline__ float gelu_exact(float v) {
    const float av = fabsf(v), t = __builtin_amdgcn_rcpf(av * 0.2316418882f + 1.0f);
    float q = t * 0.5307027145f + (-0.7265760135f); q = q * t + 0.7107068705f; q = q * t + (-0.142248368f); q = q * t + 0.127414796f; q = q * t;
    const float e = __builtin_amdgcn_exp2f((v * v) * (-0.72134752044f));
    const float m = v * (q * e);
    return v < 0.f ? m : v - m;
}

struct Ctx { LAS unsigned char* lds; int tid, lane, wave, G, gw, NGW; };

__device__ __forceinline__ void tr_item(const float* W, int K, int N, bf16* WT, int k0, int n0, int drow0, LAS float* scr, int lane) {
#pragma unroll 8
    for (int i = 0; i < 32; ++i) { const int kk = 2 * i + (lane >> 5); scr[kk * 33 + (lane & 31)] = ((const GAS float*)W)[(size_t)(k0 + kk) * N + n0 + (lane & 31)]; }
    LDS_WAIT();
    const int c = lane & 7;
#pragma unroll
    for (int j = 0; j < 4; ++j) { const int n = (lane >> 3) + 8 * j; const LAS float* s = scr + (8 * c) * 33 + n;
        v4u o; o.x = pk2c(s[0], s[33]); o.y = pk2c(s[66], s[99]); o.z = pk2c(s[132], s[165]); o.w = pk2c(s[198], s[231]);
        *(GAS v4u*)(WT + (size_t)(drow0 + n) * K + k0 + 8 * c) = o; }
    LDS_WAIT();
}
__device__ __forceinline__ unsigned pack_i8x4c(float a, float b, float c, float d) {
    const int ia = (int)__builtin_rintf(fminf(fmaxf(a, -127.f), 127.f)), ib = (int)__builtin_rintf(fminf(fmaxf(b, -127.f), 127.f)), ic = (int)__builtin_rintf(fminf(fmaxf(c, -127.f), 127.f)), id = (int)__builtin_rintf(fminf(fmaxf(d, -127.f), 127.f));
    return ((unsigned)ia & 255u) | (((unsigned)ib & 255u) << 8) | (((unsigned)ic & 255u) << 16) | ((unsigned)id << 24);
}
__device__ __forceinline__ void tr_item_i8(const float* W, int K, int N, unsigned char* WT, int k0, int n0, int drow0, float scale, LAS float* scr, int lane) {
#pragma unroll 8
    for (int i = 0; i < 32; ++i) { const int kk = 2 * i + (lane >> 5); scr[kk * 33 + (lane & 31)] = ((const GAS float*)W)[(size_t)(k0 + kk) * N + n0 + (lane & 31)]; }
    LDS_WAIT();
    const int c = lane & 7;
#pragma unroll
    for (int j = 0; j < 4; ++j) { const int n = (lane >> 3) + 8 * j; const LAS float* s = scr + (8 * c) * 33 + n;
        v2u o; o.x = pack_i8x4c(s[0] * scale, s[33] * scale, s[66] * scale, s[99] * scale); o.y = pack_i8x4c(s[132] * scale, s[165] * scale, s[198] * scale, s[231] * scale);
        *(GAS v2u*)(WT + (size_t)(drow0 + n) * K + k0 + 8 * c) = o; }
    LDS_WAIT();
}
__device__ __forceinline__ int win_drow(int n) { if (n < 7168 || n >= 9216) return n; const int r = n - 7168, isb = r >> 10, c = r & 1023; return 7168 + (c >> 7) * 256 + isb * 128 + (c & 127); }
__device__ __forceinline__ void cvt_copy(const Ctx& c, const float* src, bf16* dst, size_t n8) {
    const size_t NT = (size_t)c.G * 512;
    for (size_t i = (size_t)blockIdx.x * 512 + c.tid; i < n8; i += NT) {
        const f32x4 a = ((const GAS f32x4*)src)[2 * i], b = ((const GAS f32x4*)src)[2 * i + 1];
        v4u o; o.x = pk2c(a.x, a.y); o.y = pk2c(a.z, a.w); o.z = pk2c(b.x, b.y); o.w = pk2c(b.z, b.w);
        ((GAS v4u*)dst)[i] = o;
    }
}
__device__ __forceinline__ void rms_row(const float* xr, const float* w, bf16* o, int lane) {
    const GAS f32x4* xp = (const GAS f32x4*)xr + lane; f32x4 v[8]; float s = 0.f;
#pragma unroll
    for (int j = 0; j < 8; ++j) { v[j] = xp[64 * j]; s += (v[j].x * v[j].x + v[j].y * v[j].y) + (v[j].z * v[j].z + v[j].w * v[j].w); }
    const float r = __builtin_amdgcn_rsqf(wave_sum(s) * (1.0f / DM) + EPS);
    const GAS f32x4* wp = (const GAS f32x4*)w + lane; GAS v2u* op = (GAS v2u*)o + lane;
#pragma unroll
    for (int j = 0; j < 8; ++j) { const f32x4 wv = wp[64 * j]; v2u q; q.x = pk2c(v[j].x * r * wv.x, v[j].y * r * wv.y); q.y = pk2c(v[j].z * r * wv.z, v[j].w * r * wv.w); op[64 * j] = q; }
}
__device__ __forceinline__ void rms_row_i8(const float* xr, const float* w, unsigned char* o, float* sa, int lane) {
    const GAS f32x4* xp = (const GAS f32x4*)xr + lane; f32x4 v[8]; float s = 0.f;
#pragma unroll
    for (int j = 0; j < 8; ++j) { v[j] = xp[64 * j]; s += (v[j].x * v[j].x + v[j].y * v[j].y) + (v[j].z * v[j].z + v[j].w * v[j].w); }
    const float r = __builtin_amdgcn_rsqf(wave_sum(s) * (1.0f / DM) + EPS);
    const GAS f32x4* wp = (const GAS f32x4*)w + lane; float m = 0.f;
#pragma unroll
    for (int j = 0; j < 8; ++j) { const f32x4 wv = wp[64 * j]; v[j].x *= r * wv.x; v[j].y *= r * wv.y; v[j].z *= r * wv.z; v[j].w *= r * wv.w;
        m = fmaxf(fmaxf(m, fmaxf(fabsf(v[j].x), fabsf(v[j].y))), fmaxf(fabsf(v[j].z), fabsf(v[j].w))); }
    m = wave_max(m);
    const float inv = m > 0.f ? 127.0f / m : 0.f;
    if (lane == 0) *(GAS float*)sa = m * (1.0f / 127.0f);
#pragma unroll
    for (int j = 0; j < 8; ++j) ((GAS unsigned*)o)[lane + 64 * j] = pack_i8x4c(v[j].x * inv, v[j].y * inv, v[j].z * inv, v[j].w * inv);
}
__device__ __forceinline__ void rms_rows2_i8(const float* xa, const float* xb, const float* w, unsigned char* oa, unsigned char* ob, float* saa, float* sab, int lane) {
    const GAS f32x4* pa = (const GAS f32x4*)xa + lane; const GAS f32x4* pb = (const GAS f32x4*)xb + lane; f32x4 va[8], vb[8]; float s0 = 0.f, s1 = 0.f;
#pragma unroll
    for (int j = 0; j < 8; ++j) { va[j] = pa[64 * j]; vb[j] = pb[64 * j]; }
#pragma unroll
    for (int j = 0; j < 8; ++j) { s0 += (va[j].x * va[j].x + va[j].y * va[j].y) + (va[j].z * va[j].z + va[j].w * va[j].w); s1 += (vb[j].x * vb[j].x + vb[j].y * vb[j].y) + (vb[j].z * vb[j].z + vb[j].w * vb[j].w); }
#pragma unroll
    for (int o = 1; o < 64; o <<= 1) { s0 += __shfl_xor(s0, o); s1 += __shfl_xor(s1, o); }
    const float r0 = __builtin_amdgcn_rsqf(s0 * (1.0f / DM) + EPS), r1 = __builtin_amdgcn_rsqf(s1 * (1.0f / DM) + EPS);
    const GAS f32x4* wp = (const GAS f32x4*)w + lane; float m0 = 0.f, m1 = 0.f;
#pragma unroll
    for (int j = 0; j < 8; ++j) { const f32x4 wv = wp[64 * j];
        va[j].x *= r0 * wv.x; va[j].y *= r0 * wv.y; va[j].z *= r0 * wv.z; va[j].w *= r0 * wv.w; vb[j].x *= r1 * wv.x; vb[j].y *= r1 * wv.y; vb[j].z *= r1 * wv.z; vb[j].w *= r1 * wv.w;
        m0 = fmaxf(fmaxf(m0, fmaxf(fabsf(va[j].x), fabsf(va[j].y))), fmaxf(fabsf(va[j].z), fabsf(va[j].w))); m1 = fmaxf(fmaxf(m1, fmaxf(fabsf(vb[j].x), fabsf(vb[j].y))), fmaxf(fabsf(vb[j].z), fabsf(vb[j].w))); }
#pragma unroll
    for (int o = 1; o < 64; o <<= 1) { m0 = fmaxf(m0, __shfl_xor(m0, o)); m1 = fmaxf(m1, __shfl_xor(m1, o)); }
    const float i0 = m0 > 0.f ? 127.0f / m0 : 0.f, i1 = m1 > 0.f ? 127.0f / m1 : 0.f;
    if (lane == 0) { *(GAS float*)saa = m0 * (1.0f / 127.0f); *(GAS float*)sab = m1 * (1.0f / 127.0f); }
#pragma unroll
    for (int j = 0; j < 8; ++j) { ((GAS unsigned*)oa)[lane + 64 * j] = pack_i8x4c(va[j].x * i0, va[j].y * i0, va[j].z * i0, va[j].w * i0); ((GAS unsigned*)ob)[lane + 64 * j] = pack_i8x4c(vb[j].x * i1, vb[j].y * i1, vb[j].z * i1, vb[j].w * i1); }
}
__device__ __forceinline__ void rms_phase_i8(const Ctx& c, const float* x, const float* w, unsigned char* H8, float* SA) {
    for (int m = c.gw; m < NTOK / 2; m += c.NGW) rms_rows2_i8(x + (size_t)m * DM, x + (size_t)(m + NTOK / 2) * DM, w, H8 + (size_t)m * DM, H8 + (size_t)(m + NTOK / 2) * DM, SA + m, SA + m + NTOK / 2, c.lane);
}
__device__ __forceinline__ void rms_rows2(const float* xa, const float* xb, const float* w, bf16* oa, bf16* ob, int lane) {
    const GAS f32x4* pa = (const GAS f32x4*)xa + lane; const GAS f32x4* pb = (const GAS f32x4*)xb + lane; f32x4 va[8], vb[8]; float sa = 0.f, sb = 0.f;
#pragma unroll
    for (int j = 0; j < 8; ++j) { va[j] = pa[64 * j]; vb[j] = pb[64 * j]; }
#pragma unroll
    for (int j = 0; j < 8; ++j) { sa += (va[j].x * va[j].x + va[j].y * va[j].y) + (va[j].z * va[j].z + va[j].w * va[j].w); sb += (vb[j].x * vb[j].x + vb[j].y * vb[j].y) + (vb[j].z * vb[j].z + vb[j].w * vb[j].w); }
#pragma unroll
    for (int o = 1; o < 64; o <<= 1) { sa += __shfl_xor(sa, o); sb += __shfl_xor(sb, o); }
    const float ra = __builtin_amdgcn_rsqf(sa * (1.0f / DM) + EPS), rb = __builtin_amdgcn_rsqf(sb * (1.0f / DM) + EPS);
    const GAS f32x4* wp = (const GAS f32x4*)w + lane; GAS v2u* qa = (GAS v2u*)oa + lane; GAS v2u* qb = (GAS v2u*)ob + lane;
#pragma unroll
    for (int j = 0; j < 8; ++j) { const f32x4 wv = wp[64 * j];
        v2u q; q.x = pk2c(va[j].x * ra * wv.x, va[j].y * ra * wv.y); q.y = pk2c(va[j].z * ra * wv.z, va[j].w * ra * wv.w); qa[64 * j] = q;
        v2u p; p.x = pk2c(vb[j].x * rb * wv.x, vb[j].y * rb * wv.y); p.y = pk2c(vb[j].z * rb * wv.z, vb[j].w * rb * wv.w); qb[64 * j] = p; }
}
__device__ __forceinline__ void rms_phase(const Ctx& c, const float* x, const float* w, bf16* H) {
    for (int m = c.gw; m < NTOK / 2; m += c.NGW) rms_rows2(x + (size_t)m * DM, x + (size_t)(m + NTOK / 2) * DM, w, H + (size_t)m * DM, H + (size_t)(m + NTOK / 2) * DM, c.lane);
}
__device__ __forceinline__ void fp8_row(const float* src, unsigned char* dst, float* scale_out, int lane) {
    const GAS f32x4* xp = (const GAS f32x4*)src + lane; f32x4 v[8]; float m = 0.f;
#pragma unroll
    for (int j = 0; j < 8; ++j) { v[j] = xp[64 * j]; m = fmaxf(fmaxf(m, fmaxf(fabsf(v[j].x), fabsf(v[j].y))), fmaxf(fabsf(v[j].z), fabsf(v[j].w))); }
    m = wave_max(m);
    const float inv = m > 0.f ? 256.0f / m : 0.f;
    if (lane == 0) *(GAS float*)scale_out = m * (1.0f / 256.0f);
#pragma unroll
    for (int j = 0; j < 8; ++j) { int p = __builtin_amdgcn_cvt_pk_fp8_f32(v[j].x * inv, v[j].y * inv, 0, false); p = __builtin_amdgcn_cvt_pk_fp8_f32(v[j].z * inv, v[j].w * inv, p, true);
        ((GAS unsigned*)dst)[lane + 64 * j] = (unsigned)p; }
}
constexpr size_t U8_SLICE = (size_t)16384 * 128;
__device__ __forceinline__ unsigned pack_i8x4(float a, float b, float c, float d) {
    const int ia = (int)__builtin_rintf(a), ib = (int)__builtin_rintf(b), ic = (int)__builtin_rintf(c), id = (int)__builtin_rintf(d);
    return ((unsigned)ia & 255u) | (((unsigned)ib & 255u) << 8) | (((unsigned)ic & 255u) << 16) | ((unsigned)id << 24);
}
__device__ __forceinline__ void i8_row(const float* src, unsigned char* dst, float* scale_out, int lane) {
    const GAS f32x4* xp = (const GAS f32x4*)src + lane; f32x4 v[8]; float m = 0.f;
#pragma unroll
    for (int j = 0; j < 8; ++j) { v[j] = xp[64 * j]; m = fmaxf(fmaxf(m, fmaxf(fabsf(v[j].x), fabsf(v[j].y))), fmaxf(fabsf(v[j].z), fabsf(v[j].w))); }
    m = wave_max(m);
    const float inv = m > 0.f ? 127.0f / m : 0.f;
    if (lane == 0) *(GAS float*)scale_out = m * (1.0f / 127.0f);
#pragma unroll
    for (int j = 0; j < 8; ++j) *(GAS unsigned*)(dst + (size_t)(2 * j + (lane >> 5)) * U8_SLICE + 4 * (lane & 31)) = pack_i8x4(v[j].x * inv, v[j].y * inv, v[j].z * inv, v[j].w * inv);
}
constexpr size_t V6_SLICE = (size_t)16384 * 192;
__device__ __forceinline__ void fp6_row(const float* src, unsigned char* dst, float* scale_out, int lane) {
    const GAS f32x4* xp = (const GAS f32x4*)src + 8 * lane; f32x4 v[8]; float m = 0.f;
#pragma unroll
    for (int j = 0; j < 8; ++j) { v[j] = xp[j]; m = fmaxf(fmaxf(m, fmaxf(fabsf(v[j].x), fabsf(v[j].y))), fmaxf(fabsf(v[j].z), fabsf(v[j].w))); }
    m = wave_max(m);
    const float inv = m > 0.f ? 7.5f / m : 0.f;
    if (lane == 0) *(GAS float*)scale_out = m * (1.0f / 7.5f);
    v32h_t h;
#pragma unroll
    for (int j = 0; j < 8; ++j) { h[4 * j] = (_Float16)(v[j].x * inv); h[4 * j + 1] = (_Float16)(v[j].y * inv); h[4 * j + 2] = (_Float16)(v[j].z * inv); h[4 * j + 3] = (_Float16)(v[j].w * inv); }
    const v6u q = __builtin_amdgcn_cvt_scalef32_pk32_fp6_f16(h, 1.0f);
    GAS v2u* o = (GAS v2u*)(dst + (size_t)(lane >> 3) * V6_SLICE + 24 * (lane & 7));
    o[0] = (v2u){q[0], q[1]}; o[1] = (v2u){q[2], q[3]}; o[2] = (v2u){q[4], q[5]};
}
struct P0Args { const float *w_in, *w_br_sb, *w_br_hg, *w_br_conv, *w_o, *w_q, *u, *v, *lbp; bf16 *WinT, *WbrT, *WoT, *WqT; unsigned char *U, *V; float *US, *VS; float* LB; int layer; const float *k1, *k2; bf16* KB; };
__device__ __forceinline__ void p0_convert(const Ctx& c, const P0Args& a) {
    LAS float* scr = (LAS float*)(c.lds + c.wave * 16384);
    constexpr int I_IN = (DM / 64) * (INW / 32), I_BR = (BW / 64) * (DM / 32), I_SQ = (DM / 64) * (DM / 32);
    constexpr int NITEMS = I_IN + 3 * I_BR + 2 * I_SQ;
    for (int it = c.gw; it < NITEMS; it += c.NGW) {
        int r = it;
        if (r < I_IN) { const int kb = r / (INW / 32), nb = r % (INW / 32); tr_item_i8(a.w_in, DM, INW, (unsigned char*)a.WinT, kb * 64, nb * 32, win_drow(nb * 32), WIN_QS, scr, c.lane); continue; } r -= I_IN;
        if (r < I_BR) { const int kb = r / (DM / 32), nb = r % (DM / 32); tr_item(a.w_br_sb, BW, DM, a.WbrT, kb * 64, nb * 32, nb * 32, scr, c.lane); continue; } r -= I_BR;
        if (r < I_BR) { const int kb = r / (DM / 32), nb = r % (DM / 32); tr_item(a.w_br_hg, BW, DM, a.WbrT + (size_t)DM * BW, kb * 64, nb * 32, nb * 32, scr, c.lane); continue; } r -= I_BR;
        if (r < I_BR) { const int kb = r / (DM / 32), nb = r % (DM / 32); tr_item(a.w_br_conv, BW, DM, a.WbrT + (size_t)2 * DM * BW, kb * 64, nb * 32, nb * 32, scr, c.lane); continue; } r -= I_BR;
        if (r < I_SQ) { const int kb = r / (DM / 32), nb = r % (DM / 32); tr_item(a.w_o, DM, DM, a.WoT, kb * 64, nb * 32, nb * 32, scr, c.lane); continue; } r -= I_SQ;
        { const int kb = r / (DM / 32), nb = r % (DM / 32); tr_item(a.w_q, DM, DM, a.WqT, kb * 64, nb * 32, nb * 32, scr, c.lane); }
    }
    for (int r = c.gw; r < 2 * 16384; r += c.NGW) {
        if (r < 16384) i8_row(a.u + (size_t)r * 2048, a.U + (size_t)r * 128, a.US + r, c.lane);
        else fp6_row(a.v + (size_t)(r - 16384) * 2048, a.V + (size_t)(r - 16384) * 192, a.VS + (r - 16384), c.lane);
    }
    cvt_copy(c, a.k1, a.KB, (size_t)8 * 16384 / 8);
    cvt_copy(c, a.k2, a.KB + 8 * 16384, (size_t)8 * 16384 / 8);
    if (blockIdx.x == 0) for (int i = c.tid; i < 1024; i += 512) a.LB[i] = a.layer == 0 ? 0.f : sigm(a.lbp[1024 + i] - a.lbp[i]);
}

struct EpiIn {
    static constexpr bool PERM = true, AFTER_DRAIN = false;
    bf16* seg; bf16* gate; const float* lb; const float* sa;
    __device__ __forceinline__ float rowscale(int row) const { return ((const GAS float*)sa)[row] * (1.0f / WIN_QS); }
    __device__ __forceinline__ void operator()(const pg8::f32x4 (&acc)[2][2][4][2], const pg8::Unit& u, int wr, int wc, int fr, int fq) const {
        const int pn = u.pn; const int row0 = u.pm * 256 + wr * 64 + fr;
        if (pn >= 28 && pn < 36) {
            bf16* dst = seg + (size_t)7 * SEGSZ; const int col0 = (pn - 28) * 128 + wc * 32 + 8 * fq;
#pragma unroll
            for (int ai = 0; ai < 2; ++ai)
#pragma unroll
                for (int m = 0; m < 4; ++m) {
                    const pg8::f32x4 a0 = acc[ai][0][m][0], a1 = acc[ai][0][m][1], b0 = acc[ai][1][m][0], b1 = acc[ai][1][m][1];
                    v4u w; w.x = pk2c(a0[0] * sigm(b0[0]), a0[1] * sigm(b0[1])); w.y = pk2c(a0[2] * sigm(b0[2]), a0[3] * sigm(b0[3]));
                    w.z = pk2c(a1[0] * sigm(b1[0]), a1[1] * sigm(b1[1])); w.w = pk2c(a1[2] * sigm(b1[2]), a1[3] * sigm(b1[3]));
                    *(GAS v4u*)(dst + (size_t)(row0 + ai * 128 + m * 16) * 1024 + col0) = w; }
            return;
        }
        bf16* dst; int ld, colt, mode;
        if (pn < 28) { const int sg = pn >> 2; dst = seg + (size_t)sg * SEGSZ; ld = 1024; colt = (pn & 3) * 256; mode = (sg == 4) ? 2 : (sg == 6 ? 1 : 0); }
        else { const int q = pn - 36; dst = gate + (size_t)(q >> 3) * ((size_t)NTOK * 2048); ld = 2048; colt = (q & 7) * 256; mode = 1; }
        const int col0 = colt + wc * 32 + 8 * fq;
        if (mode == 0) {
#pragma unroll
            for (int ai = 0; ai < 2; ++ai)
#pragma unroll
                for (int m = 0; m < 4; ++m)
#pragma unroll
                    for (int bj = 0; bj < 2; ++bj) { const pg8::f32x4 v0 = acc[ai][bj][m][0], v1 = acc[ai][bj][m][1];
                        v4u w; w.x = pk2c(v0[0], v0[1]); w.y = pk2c(v0[2], v0[3]); w.z = pk2c(v1[0], v1[1]); w.w = pk2c(v1[2], v1[3]);
                        *(GAS v4u*)(dst + (size_t)(row0 + ai * 128 + m * 16) * ld + col0 + bj * 128) = w; }
        } else if (mode == 1) {
#pragma unroll
            for (int ai = 0; ai < 2; ++ai)
#pragma unroll
                for (int m = 0; m < 4; ++m)
#pragma unroll
                    for (int bj = 0; bj < 2; ++bj) { const pg8::f32x4 v0 = acc[ai][bj][m][0], v1 = acc[ai][bj][m][1];
                        v4u w; w.x = pk2c(sigm(v0[0]), sigm(v0[1])); w.y = pk2c(sigm(v0[2]), sigm(v0[3])); w.z = pk2c(sigm(v1[0]), sigm(v1[1])); w.w = pk2c(sigm(v1[2]), sigm(v1[3]));
                        *(GAS v4u*)(dst + (size_t)(row0 + ai * 128 + m * 16) * ld + col0 + bj * 128) = w; }
        } else {
            f32x4 l0[2], l1[2];
#pragma unroll
            for (int bj = 0; bj < 2; ++bj) { l0[bj] = *(const GAS f32x4*)(lb + col0 + bj * 128); l1[bj] = *(const GAS f32x4*)(lb + col0 + bj * 128 + 4); }
#pragma unroll
            for (int ai = 0; ai < 2; ++ai)
#pragma unroll
                for (int m = 0; m < 4; ++m)
#pragma unroll
                    for (int bj = 0; bj < 2; ++bj) { const pg8::f32x4 v0 = acc[ai][bj][m][0], v1 = acc[ai][bj][m][1]; float r[8];
#pragma unroll
                        for (int j = 0; j < 4; ++j) { r[j] = __logf(l0[bj][j] + (1.0f - l0[bj][j]) * sigm(v0[j])); r[4 + j] = __logf(l1[bj][j] + (1.0f - l1[bj][j]) * sigm(v1[j])); }
                        v4u w; w.x = pk2c(r[0], r[1]); w.y = pk2c(r[2], r[3]); w.z = pk2c(r[4], r[5]); w.w = pk2c(r[6], r[7]);
                        *(GAS v4u*)(dst + (size_t)(row0 + ai * 128 + m * 16) * ld + col0 + bj * 128) = w; }
        }
    }
};

__device__ __forceinline__ void conv_phase(const Ctx& c, const bf16* glu, const float* cw, const float* cb, const float* lnw, const float* lnb, bf16* out) {
    const int c0 = 2 * c.tid;
    float w0[31], w1[31];
#pragma unroll
    for (int j = 0; j < 31; ++j) { const f32x2v t = *(const GAS f32x2v*)(cw + j * 1024 + c0); w0[j] = t.x; w1[j] = t.y; }
    const f32x2v bv = *(const GAS f32x2v*)(cb + c0), lwv = *(const GAS f32x2v*)(lnw + c0), lbv = *(const GAS f32x2v*)(lnb + c0);
    LAS float* red = (LAS float*)c.lds;
    for (int tile = blockIdx.x; tile < NTOK / 8; tile += c.G) {
        const int n0 = tile * 8, tseq0 = n0 & (SEQ - 1);
        float a0[8], a1[8];
#pragma unroll
        for (int t = 0; t < 8; ++t) { a0[t] = bv.x; a1[t] = bv.y; }
#pragma unroll
        for (int r = 0; r < 38; ++r) {
            unsigned xv = 0u;
            if (tseq0 + r - 30 >= 0) xv = *(const GAS unsigned*)(glu + (size_t)(n0 + r - 30) * 1024 + c0);
            const float x0 = bflo(xv), x1 = bfhi(xv);
#pragma unroll
            for (int t = 0; t < 8; ++t) { const int j = r - t; if (j >= 0 && j <= 30) { a0[t] += w0[j] * x0; a1[t] += w1[j] * x1; } }
        }
        float st[16];
#pragma unroll
        for (int t = 0; t < 8; ++t) { st[2 * t] = a0[t] + a1[t]; st[2 * t + 1] = a0[t] * a0[t] + a1[t] * a1[t]; }
        xreduce16(st, c.lane);
        if ((c.lane & 3) == 0) red[c.wave * 16 + ridx16(c.lane)] = st[0];
        __syncthreads();
        if (c.tid < 16) { float s = 0.f;
#pragma unroll
            for (int w = 0; w < 8; ++w) s += red[w * 16 + c.tid];
            red[128 + c.tid] = s; }
        __syncthreads();
#pragma unroll
        for (int t = 0; t < 8; ++t) {
            const float mean = red[128 + 2 * t] * (1.0f / 1024.0f), var = red[128 + 2 * t + 1] * (1.0f / 1024.0f) - mean * mean;
            const float rstd = __builtin_amdgcn_rsqf(var + EPS);
            const float h0 = (a0[t] - mean) * rstd * lwv.x + lbv.x, h1 = (a1[t] - mean) * rstd * lwv.y + lbv.y;
            *(GAS unsigned*)(out + (size_t)(n0 + t) * 1024 + c0) = pk2c(h0 * sigm(h0), h1 * sigm(h1));
        }
        __syncthreads();
    }
}
__device__ __forceinline__ void hgrn_task(int task, int lane, const bf16* qhg, const bf16* logf, const bf16* ihg, bf16* out) {
    const int bh = task >> 6, dvb = task & 63, b = bh >> 3, h = bh & 7;
    const size_t rb = (size_t)b * SEQ * 1024;
    const GAS unsigned* qp = (const GAS unsigned*)(qhg + rb + h * 128) + lane;
    const GAS unsigned* lp = (const GAS unsigned*)(logf + rb + h * 128) + lane;
    const GAS unsigned* ip = (const GAS unsigned*)(ihg + rb + h * 128) + dvb;
    GAS bf16* op = (GAS bf16*)(out + rb + h * 128 + 2 * dvb);
    float S00 = 0.f, S01 = 0.f, S10 = 0.f, S11 = 0.f;
    unsigned qn[8], ln[8], inx[8];
#pragma unroll
    for (int j = 0; j < 8; ++j) { qn[j] = qp[(size_t)j * 512]; ln[j] = lp[(size_t)j * 512]; inx[j] = ip[(size_t)j * 512]; }
    for (int blk = 0; blk < SEQ / 8; ++blk) {
        unsigned qc[8], lc[8], ic[8];
#pragma unroll
        for (int j = 0; j < 8; ++j) { qc[j] = qn[j]; lc[j] = ln[j]; ic[j] = inx[j]; }
        if (blk + 1 < SEQ / 8) {
#pragma unroll
            for (int j = 0; j < 8; ++j) { const size_t o = (size_t)((blk + 1) * 8 + j) * 512; qn[j] = qp[o]; ln[j] = lp[o]; inx[j] = ip[o]; }
        }
        float pv[16];
#pragma unroll
        for (int j = 0; j < 8; ++j) {
            const float f0 = __expf(bflo(lc[j])), f1 = __expf(bfhi(lc[j])), k0 = 1.0f - f0, k1 = 1.0f - f1;
            const float i0 = bflo(ic[j]), i1 = bfhi(ic[j]), q0 = bflo(qc[j]), q1 = bfhi(qc[j]);
            S00 = f0 * S00 + k0 * i0; S01 = f0 * S01 + k0 * i1; S10 = f1 * S10 + k1 * i0; S11 = f1 * S11 + k1 * i1;
            pv[2 * j] = S00 * q0 + S10 * q1; pv[2 * j + 1] = S01 * q0 + S11 * q1;
        }
        xreduce16(pv, lane);
        if ((lane & 3) == 0) { const int idx = ridx16(lane); op[(size_t)(blk * 8 + (idx >> 1)) * 1024 + (idx & 1)] = (bf16)(pk2c(pv[0], 0.f) & 0xffffu); }
    }
}
constexpr int HG_TS = 272;
constexpr int HG_BS = 132;
__device__ __forceinline__ void hg_stage(LAS unsigned char* dst, const bf16* src, int tid) {
#pragma unroll
    for (int i = 0; i < 2; ++i) { const int p = tid + 512 * i, row = p >> 4, c16 = p & 15; *(LAS v4u*)(dst + row * HG_TS + c16 * 16) = *(const GAS v4u*)(src + (size_t)row * 1024 + c16 * 8); }
}
__device__ __forceinline__ void hg_scan(const LAS unsigned char* lft, int dk, int hf, float (&lf)[4][8], float (&b)[4][8], float& bl) {
    float bs[4], pb[4];
#pragma unroll
    for (int kk = 0; kk < 4; ++kk) { float run = 0.f;
#pragma unroll
        for (int j = 0; j < 8; ++j) { lf[kk][j] = __uint_as_float((unsigned)(*(const LAS unsigned short*)(lft + (16 * kk + 8 * hf + j) * HG_TS + dk * 2)) << 16); run += lf[kk][j]; b[kk][j] = run; }
        bs[kk] = run; }
#pragma unroll
    for (int kk = 0; kk < 4; ++kk) pb[kk] = __shfl_xor(bs[kk], 32);
    float pre = 0.f;
#pragma unroll
    for (int kk = 0; kk < 4; ++kk) { const float off = pre + (hf ? pb[kk] : 0.f);
#pragma unroll
        for (int j = 0; j < 8; ++j) b[kk][j] += off;
        pre += bs[kk] + pb[kk]; }
    bl = pre;
}
__device__ __forceinline__ bf16x8 pack8(const float (&v)[8]) { v4u t; t.x = pk2c(v[0], v[1]); t.y = pk2c(v[2], v[3]); t.z = pk2c(v[4], v[5]); t.w = pk2c(v[6], v[7]); return __builtin_bit_cast(bf16x8, t); }
__device__ __forceinline__ unsigned lds_u16(const LAS unsigned char* p) { return (unsigned)(*(const LAS unsigned short*)p); }
__device__ __forceinline__ void hgA_chunk(const Ctx& c, int ci, const bf16* LOGF, const bf16* IHG, bf16* ST, float* DEC) {
    const int bh = ci >> 6, ch = ci & 63, bb = bh >> 3, h = bh & 7; const size_t n0 = (size_t)bb * SEQ + ch * 64;
    LAS unsigned char* lft = c.lds; LAS unsigned char* itl = c.lds + 64 * HG_TS;
    hg_stage(lft, LOGF + n0 * 1024 + h * 128, c.tid); hg_stage(itl, IHG + n0 * 1024 + h * 128, c.tid);
    __syncthreads();
    const int dkt = c.wave & 3, dvh = c.wave >> 2, hf = c.lane >> 5, cl = c.lane & 31, dk = 32 * dkt + cl;
    float lf[4][8], b[4][8], bl; hg_scan(lft, dk, hf, lf, b, bl);
    bf16x8 kf[4];
#pragma unroll
    for (int kk = 0; kk < 4; ++kk) { float v[8];
#pragma unroll
        for (int j = 0; j < 8; ++j) v[j] = (1.0f - __expf(lf[kk][j])) * __expf(bl - b[kk][j]);
        kf[kk] = pack8(v); }
    if (dvh == 0 && hf == 0) ((GAS float*)DEC)[(size_t)ci * 128 + dk] = __expf(bl);
#pragma unroll
    for (int dvi = 0; dvi < 2; ++dvi) { const int dvt = dvh * 2 + dvi;
        f32x16 acc;
#pragma unroll
        for (int r = 0; r < 16; ++r) acc[r] = 0.f;
#pragma unroll
        for (int kk = 0; kk < 4; ++kk) { const LAS unsigned char* p = itl + (16 * kk + 8 * hf) * HG_TS + (32 * dvt + cl) * 2;
            v4u t; t.x = lds_u16(p) | (lds_u16(p + HG_TS) << 16); t.y = lds_u16(p + 2 * HG_TS) | (lds_u16(p + 3 * HG_TS) << 16); t.z = lds_u16(p + 4 * HG_TS) | (lds_u16(p + 5 * HG_TS) << 16); t.w = lds_u16(p + 6 * HG_TS) | (lds_u16(p + 7 * HG_TS) << 16);
            acc = MFMA32(kf[kk], __builtin_bit_cast(bf16x8, t), acc); }
        bf16* o = ST + (size_t)ci * 16384 + (size_t)(32 * dvt + cl) * 128 + 32 * dkt + 4 * hf;
#pragma unroll
        for (int g = 0; g < 4; ++g) { v2u q; q.x = pk2c(acc[4 * g], acc[4 * g + 1]); q.y = pk2c(acc[4 * g + 2], acc[4 * g + 3]); *(GAS v2u*)(o + 8 * g) = q; }
    }
    __syncthreads();
}
__device__ __forceinline__ void hgB(const Ctx& c, bf16* ST, const float* DEC) {
    for (int e = blockIdx.x * 512 + c.tid; e < 32 * 4096; e += c.G * 512) {
        const int bh = e >> 12, r = e & 4095, dv = r >> 5, dk4 = (r & 31) * 4;
        GAS v2u* p = (GAS v2u*)(ST + (size_t)bh * 64 * 16384 + (size_t)dv * 128 + dk4);
        const GAS f32x4* d = (const GAS f32x4*)(DEC + (size_t)bh * 64 * 128 + dk4);
        f32x4 S = {0.f, 0.f, 0.f, 0.f};
#pragma unroll 1
        for (int c0 = 0; c0 < 64; c0 += 8) {
            v2u Lv[8]; f32x4 D[8];
#pragma unroll
            for (int k = 0; k < 8; ++k) { Lv[k] = p[(size_t)(c0 + k) * 4096]; D[k] = d[(size_t)(c0 + k) * 32]; }
#pragma unroll
            for (int k = 0; k < 8; ++k) { v2u o; o.x = pk2c(S.x, S.y); o.y = pk2c(S.z, S.w); p[(size_t)(c0 + k) * 4096] = o;
                S.x = D[k].x * S.x + bflo(Lv[k].x); S.y = D[k].y * S.y + bfhi(Lv[k].x); S.z = D[k].z * S.z + bflo(Lv[k].y); S.w = D[k].w * S.w + bfhi(Lv[k].y); }
        }
    }
}
__device__ __forceinline__ void hgC_chunk(const Ctx& c, int ci, const bf16* QHG, const bf16* LOGF, const bf16* IHG, const bf16* GHG, const bf16* ST, const float* nw, bf16* OUT) {
    const int bh = ci >> 6, ch = ci & 63, bb = bh >> 3, h = bh & 7; const size_t n0 = (size_t)bb * SEQ + ch * 64;
    LAS unsigned char* lft = c.lds; LAS unsigned char* itl = c.lds + 64 * HG_TS; LAS float* bt = (LAS float*)(c.lds + 2 * 64 * HG_TS); LAS float* red = bt + 64 * HG_BS;
    LAS unsigned char* ktl = (LAS unsigned char*)(red + 256);
    hg_stage(lft, LOGF + n0 * 1024 + h * 128, c.tid); hg_stage(itl, IHG + n0 * 1024 + h * 128, c.tid);
    __syncthreads();
    const int hf = c.lane >> 5, cl = c.lane & 31;
    { const int dk = 32 * (c.wave & 3) + cl; float lf[4][8], b[4][8], bl; hg_scan(lft, dk, hf, lf, b, bl);
#pragma unroll
      for (int q = 0; q < 2; ++q) { const int kk = 2 * (c.wave >> 2) + q;
#pragma unroll
          for (int j = 0; j < 8; ++j) { bt[(16 * kk + 8 * hf + j) * HG_BS + dk] = (c.wave >> 2) ? b[2 + q][j] : b[q][j];
              *(LAS unsigned short*)(ktl + (16 * kk + 8 * hf + j) * HG_TS + dk * 2) = (unsigned short)(pk2c(1.0f - __expf((c.wave >> 2) ? lf[2 + q][j] : lf[q][j]), 0.f) & 0xffffu); } } }
    __syncthreads();
    const int dvt = c.wave & 3, tt = c.wave >> 2, t = 32 * tt + cl;
    bf16x8 qm[8];
    const bf16* qrow = QHG + (n0 + t) * 1024 + h * 128 + 8 * hf;
#pragma unroll
    for (int kk = 0; kk < 8; ++kk) { const int d0 = 16 * kk + 8 * hf;
        asm volatile("" ::: "memory");
        const v4u qv = *(const GAS v4u*)(qrow + 16 * kk);
        const f32x4 b0 = *(const LAS f32x4*)(bt + t * HG_BS + d0), b1 = *(const LAS f32x4*)(bt + t * HG_BS + d0 + 4), m0 = *(const LAS f32x4*)(bt + 31 * HG_BS + d0), m1 = *(const LAS f32x4*)(bt + 31 * HG_BS + d0 + 4);
        const float q[8] = {bflo(qv.x), bfhi(qv.x), bflo(qv.y), bfhi(qv.y), bflo(qv.z), bfhi(qv.z), bflo(qv.w), bfhi(qv.w)};
        const float bv[8] = {b0.x, b0.y, b0.z, b0.w, b1.x, b1.y, b1.z, b1.w}, mv[8] = {m0.x, m0.y, m0.z, m0.w, m1.x, m1.y, m1.z, m1.w};
        float vm[8];
#pragma unroll
        for (int j = 0; j < 8; ++j) vm[j] = q[j] * __expf(bv[j] - mv[j]);
        qm[kk] = pack8(vm); }
    f32x16 o;
#pragma unroll
    for (int r = 0; r < 16; ++r) o[r] = 0.f;
#pragma unroll 1
    for (int st = 0; st <= tt; ++st) {
        const int s = 32 * st + cl;
        f32x16 sa;
#pragma unroll
        for (int r = 0; r < 16; ++r) sa[r] = 0.f;
#pragma unroll
        for (int kk = 0; kk < 8; ++kk) { const int d0 = 16 * kk + 8 * hf;
            asm volatile("" ::: "memory");
            const v4u lv = *(const LAS v4u*)(ktl + s * HG_TS + d0 * 2);
            const f32x4 b0 = *(const LAS f32x4*)(bt + s * HG_BS + d0), b1 = *(const LAS f32x4*)(bt + s * HG_BS + d0 + 4), m0 = *(const LAS f32x4*)(bt + 31 * HG_BS + d0), m1 = *(const LAS f32x4*)(bt + 31 * HG_BS + d0 + 4);
            const float kv[8] = {bflo(lv.x), bfhi(lv.x), bflo(lv.y), bfhi(lv.y), bflo(lv.z), bfhi(lv.z), bflo(lv.w), bfhi(lv.w)};
            const float bv[8] = {b0.x, b0.y, b0.z, b0.w, b1.x, b1.y, b1.z, b1.w}, mv[8] = {m0.x, m0.y, m0.z, m0.w, m1.x, m1.y, m1.z, m1.w};
            float vk[8];
#pragma unroll
            for (int j = 0; j < 8; ++j) vk[j] = kv[j] * __expf(mv[j] - bv[j]);
            sa = MFMA32(pack8(vk), qm[kk], sa); }
        if (st == tt) {
#pragma unroll
            for (int r = 0; r < 16; ++r) if (((r & 3) + 8 * (r >> 2) + 4 * hf) > cl) sa[r] = 0.f;
        }
#pragma unroll
        for (int sp = 0; sp < 2; ++sp) {
            const float pv[8] = {sa[8 * sp], sa[8 * sp + 1], sa[8 * sp + 2], sa[8 * sp + 3], sa[8 * sp + 4], sa[8 * sp + 5], sa[8 * sp + 6], sa[8 * sp + 7]};
            const LAS unsigned char* p = itl + (32 * st + 16 * sp + 4 * hf) * HG_TS + (32 * dvt + cl) * 2;
            v4u tq; tq.x = lds_u16(p) | (lds_u16(p + HG_TS) << 16); tq.y = lds_u16(p + 2 * HG_TS) | (lds_u16(p + 3 * HG_TS) << 16);
            tq.z = lds_u16(p + 8 * HG_TS) | (lds_u16(p + 9 * HG_TS) << 16); tq.w = lds_u16(p + 10 * HG_TS) | (lds_u16(p + 11 * HG_TS) << 16);
            o = MFMA32(__builtin_bit_cast(bf16x8, tq), pack8(pv), o); }
    }
    { const bf16* strow = ST + (size_t)ci * 16384 + (size_t)(32 * dvt + cl) * 128 + 8 * hf;
#pragma unroll
      for (int kk = 0; kk < 8; ++kk) { const int d0 = 16 * kk + 8 * hf;
          asm volatile("" ::: "memory");
          const v4u qv = *(const GAS v4u*)(qrow + 16 * kk); const bf16x8 sf = *(const GAS bf16x8*)(strow + 16 * kk);
          const f32x4 b0 = *(const LAS f32x4*)(bt + t * HG_BS + d0), b1 = *(const LAS f32x4*)(bt + t * HG_BS + d0 + 4);
          float ve[8] = {bflo(qv.x) * __expf(b0.x), bfhi(qv.x) * __expf(b0.y), bflo(qv.y) * __expf(b0.z), bfhi(qv.y) * __expf(b0.w), bflo(qv.z) * __expf(b1.x), bfhi(qv.z) * __expf(b1.y), bflo(qv.w) * __expf(b1.z), bfhi(qv.w) * __expf(b1.w)};
          o = MFMA32(sf, pack8(ve), o); } }
    float ss = 0.f;
#pragma unroll
    for (int r = 0; r < 16; ++r) ss += o[r] * o[r];
    ss += __shfl_xor(ss, 32);
    if (hf == 0) red[(tt * 4 + dvt) * 32 + cl] = ss;
    __syncthreads();
    const float rstd = __builtin_amdgcn_rsqf(((red[(tt * 4 + 0) * 32 + cl] + red[(tt * 4 + 1) * 32 + cl]) + (red[(tt * 4 + 2) * 32 + cl] + red[(tt * 4 + 3) * 32 + cl])) * (1.0f / 128.0f) + EPS);
#pragma unroll
    for (int g = 0; g < 4; ++g) { const int dv0 = 32 * dvt + 8 * g + 4 * hf; const size_t off = (n0 + t) * 1024 + h * 128 + dv0;
        const v2u gg = *(const GAS v2u*)(GHG + off); const f32x4 w4 = *(const GAS f32x4*)(nw + dv0);
        v2u q; q.x = pk2c(o[4 * g] * rstd * w4.x * bflo(gg.x), o[4 * g + 1] * rstd * w4.y * bfhi(gg.x)); q.y = pk2c(o[4 * g + 2] * rstd * w4.z * bflo(gg.y), o[4 * g + 3] * rstd * w4.w * bfhi(gg.y));
        *(GAS v2u*)(OUT + off) = q; }
    __syncthreads();
}
__device__ __forceinline__ void qknorm_rows4(bf16* row0, size_t rstride, const float* w, float scale, int lane) {
    v4u x[4][2];
#pragma unroll
    for (int i = 0; i < 4; ++i)
#pragma unroll
        for (int j = 0; j < 2; ++j) x[i][j] = *(const GAS v4u*)(row0 + i * rstride + 8 * lane + 512 * j);
    const f32x4 wa = *(const GAS f32x4*)(w + ((8 * lane) & 127)), wb = *(const GAS f32x4*)(w + ((8 * lane) & 127) + 4);
#pragma unroll
    for (int i = 0; i < 4; ++i)
#pragma unroll
        for (int j = 0; j < 2; ++j) { const v4u xx = x[i][j];
            float f[8] = {bflo(xx.x), bfhi(xx.x), bflo(xx.y), bfhi(xx.y), bflo(xx.z), bfhi(xx.z), bflo(xx.w), bfhi(xx.w)};
            float ss = 0.f;
#pragma unroll
            for (int k = 0; k < 8; ++k) ss += f[k] * f[k];
            ss += __shfl_xor(ss, 1); ss += __shfl_xor(ss, 2); ss += __shfl_xor(ss, 4); ss += __shfl_xor(ss, 8);
            const float r = __builtin_amdgcn_rsqf(ss * (1.0f / 128.0f) + EPS) * scale;
            v4u o; o.x = pk2c(f[0] * r * wa.x, f[1] * r * wa.y); o.y = pk2c(f[2] * r * wa.z, f[3] * r * wa.w); o.z = pk2c(f[4] * r * wb.x, f[5] * r * wb.y); o.w = pk2c(f[6] * r * wb.z, f[7] * r * wb.w);
            *(GAS v4u*)(row0 + i * rstride + 8 * lane + 512 * j) = o; }
}
__device__ __forceinline__ void vt_item(int item, int lane, const bf16* vsb, bf16* vt, LAS unsigned short* scr) {
    const int db = item & 3, sb = (item >> 2) & 63, bh = item >> 8, b = bh >> 3, h = bh & 7;
    const bf16* src = vsb + ((size_t)b * SEQ + sb * 64) * 1024 + h * 128 + db * 32;
#pragma unroll 4
    for (int i = 0; i < 16; ++i) { const int r = 4 * i + (lane >> 4); *(LAS unsigned*)(scr + r * 34 + 2 * (lane & 15)) = *(const GAS unsigned*)(src + (size_t)r * 1024 + 2 * (lane & 15)); }
    LDS_WAIT();
    const int c = lane & 7;
#pragma unroll
    for (int j = 0; j < 4; ++j) { const int d = (lane >> 3) + 8 * j; const LAS unsigned short* s = scr + (8 * c) * 34 + d;
        v4u o; o.x = (unsigned)s[0] | ((unsigned)s[34] << 16); o.y = (unsigned)s[68] | ((unsigned)s[102] << 16); o.z = (unsigned)s[136] | ((unsigned)s[170] << 16); o.w = (unsigned)s[204] | ((unsigned)s[238] << 16);
        *(GAS v4u*)(vt + ((size_t)bh * 128 + db * 32 + d) * SEQ + sb * 64 + 8 * c) = o; }
    LDS_WAIT();
}

constexpr int AT_BUF = 32768, AT_VOFF = 16384;
__device__ __forceinline__ f32x16 attn_scores(const LAS unsigned char* kt, int krow, int hf, const bf16x8 (&qf)[8]) {
    f32x16 sa;
#pragma unroll
    for (int r = 0; r < 16; ++r) sa[r] = 0.f;
    const LAS unsigned char* kp = kt + krow * 256; const int sw = krow & 15;
#pragma unroll
    for (int kk = 0; kk < 8; ++kk) sa = MFMA32(*(const LAS bf16x8*)(kp + (((2 * kk + hf) ^ sw) << 4)), qf[kk], sa);
    return sa;
}
template <bool DIAG> __device__ __forceinline__ void attn_weights(const f32x16& sa, float& R, int hf, int cl, bf16x8 (&pf)[2]) {
    float om[16];
#pragma unroll
    for (int r = 0; r < 16; ++r) om[r] = __builtin_amdgcn_rcpf(1.0f + __builtin_amdgcn_exp2f(sa[r] * 1.4426950408889634f));
    if (DIAG) {
#pragma unroll
        for (int r = 0; r < 16; ++r) if (((r & 3) + 8 * (r >> 2) + 4 * hf) >= cl) om[r] = 1.0f;
    }
    float Gs[4], Gp[4];
#pragma unroll
    for (int g = 0; g < 4; ++g) { Gs[g] = (om[4 * g] * om[4 * g + 1]) * (om[4 * g + 2] * om[4 * g + 3]); Gp[g] = __shfl_xor(Gs[g], 32); }
    float tail = R; float w[16];
#pragma unroll
    for (int g = 3; g >= 0; --g) {
        const float c3 = tail * (hf == 0 ? Gp[g] : 1.0f), c2 = c3 * om[4 * g + 3], c1 = c2 * om[4 * g + 2], c0 = c1 * om[4 * g + 1];
        w[4 * g + 3] = c3 - om[4 * g + 3] * c3; w[4 * g + 2] = c2 - om[4 * g + 2] * c2; w[4 * g + 1] = c1 - om[4 * g + 1] * c1; w[4 * g] = c0 - om[4 * g] * c0;
        tail *= Gs[g] * Gp[g];
    }
    R = tail;
#pragma unroll
    for (int sp = 0; sp < 2; ++sp) { v4u t; t.x = pk2c(w[8 * sp], w[8 * sp + 1]); t.y = pk2c(w[8 * sp + 2], w[8 * sp + 3]); t.z = pk2c(w[8 * sp + 4], w[8 * sp + 5]); t.w = pk2c(w[8 * sp + 6], w[8 * sp + 7]); pf[sp] = __builtin_bit_cast(bf16x8, t); }
}
__device__ __forceinline__ void attn_pv(const LAS unsigned char* vt, int sub, int cl, int hf, const bf16x8 (&pf)[2], f32x16 (&o)[4]) {
#pragma unroll
    for (int d = 0; d < 4; ++d) { const int row = 32 * d + cl; const LAS unsigned char* vp = vt + row * 128 + 8 * hf; const int sw = (row >> 1) & 7;
#pragma unroll
        for (int sp = 0; sp < 2; ++sp) { const int x = 4 * sub + 2 * sp;
            const v2u lo = *(const LAS v2u*)(vp + ((x ^ sw) << 4)), hi = *(const LAS v2u*)(vp + (((x + 1) ^ sw) << 4));
            v4u t; t.x = lo.x; t.y = lo.y; t.z = hi.x; t.w = hi.y; o[d] = MFMA32(__builtin_bit_cast(bf16x8, t), pf[sp], o[d]); } }
}
template <bool LAG> __device__ __forceinline__ void attn_unit(const Ctx& c, int bh, int qb, const bf16* qsb, const bf16* ksb, const bf16* vt, bf16* outb) {
    int lane_ = c.lane; asm volatile("" : "+v"(lane_));
    const int b = bh >> 3, h = bh & 7, lane = lane_, cl = lane & 31, hf = lane >> 5;
    const size_t rb = (size_t)b * SEQ; const int q0w = 256 * qb + 32 * c.wave;
    bf16x8 qf[8];
    { const bf16* qrow = qsb + (rb + q0w + cl) * 1024 + h * 128 + 8 * hf;
#pragma unroll
      for (int kk = 0; kk < 8; ++kk) qf[kk] = *(const GAS bf16x8*)(qrow + 16 * kk); }
    f32x16 o[4];
#pragma unroll
    for (int d = 0; d < 4; ++d)
#pragma unroll
        for (int r = 0; r < 16; ++r) o[d][r] = 0.f;
    float R = 1.0f;
    bf16x8 pd[2]; const LAS unsigned char* vimd = c.lds; int subd = 0; bool pending = false;
    const int kr0 = 8 * c.wave + (lane >> 4), kr1 = kr0 + 4;
    const bf16* kg0 = ksb + (rb + kr0) * 1024 + h * 128 + (((lane & 15) ^ (kr0 & 15)) << 3);
    const bf16* kg1 = ksb + (rb + kr1) * 1024 + h * 128 + (((lane & 15) ^ (kr1 & 15)) << 3);
    const int vr0 = 16 * c.wave + (lane >> 3), vr1 = vr0 + 8;
    const bf16* vg0 = vt + ((size_t)bh * 128 + vr0) * SEQ + (((lane & 7) ^ ((vr0 >> 1) & 7)) << 3);
    const bf16* vg1 = vt + ((size_t)bh * 128 + vr1) * SEQ + (((lane & 7) ^ ((vr1 >> 1) & 7)) << 3);
    LAS unsigned char* dk = c.lds + c.wave * 2048; LAS unsigned char* dv = c.lds + AT_VOFF + c.wave * 2048;
#define AT_DMA(kt_, bi_) do { const int ktt_ = (kt_); LAS unsigned char* bb_ = (LAS unsigned char*)0 + (bi_) * AT_BUF; \
        __builtin_amdgcn_global_load_lds((const unsigned*)(kg0 + (size_t)ktt_ * 64 * 1024), (LAS unsigned*)(dk + (bi_) * AT_BUF), 16, 0, 0); \
        __builtin_amdgcn_global_load_lds((const unsigned*)(kg1 + (size_t)ktt_ * 64 * 1024), (LAS unsigned*)(dk + (bi_) * AT_BUF + 1024), 16, 0, 0); \
        __builtin_amdgcn_global_load_lds((const unsigned*)(vg0 + ktt_ * 64), (LAS unsigned*)(dv + (bi_) * AT_BUF), 16, 0, 0); \
        __builtin_amdgcn_global_load_lds((const unsigned*)(vg1 + ktt_ * 64), (LAS unsigned*)(dv + (bi_) * AT_BUF + 1024), 16, 0, 0); (void)bb_; } while (0)
    const int nkt = 4 * (qb + 1);
    asm volatile("s_waitcnt vmcnt(0)" ::: "memory");
    AT_DMA(nkt - 1, 0); AT_DMA(nkt - 2, 1);
    asm volatile("s_waitcnt vmcnt(4)" ::: "memory"); __builtin_amdgcn_s_barrier(); asm volatile("" ::: "memory");
    int bi = 0;
#pragma unroll 1
    for (int it = 0; it < nkt; ++it) {
        const int kt = nkt - 1 - it;
        const int b2 = (bi + 2) & 3;
        if (it + 2 < nkt) AT_DMA(kt - 2, b2);
        const LAS unsigned char* kim = c.lds + bi * AT_BUF; const LAS unsigned char* vim = kim + AT_VOFF;
        const int rel = q0w - 64 * kt;
        if (rel >= 32) {
            if (LAG) { if (pending) attn_pv(vimd, subd, cl, hf, pd, o);
                const f32x16 s1 = attn_scores(kim, 32 + cl, hf, qf); if (rel == 32) attn_weights<true>(s1, R, hf, cl, pd); else attn_weights<false>(s1, R, hf, cl, pd);
                vimd = vim; subd = 1; pending = true;
            } else { bf16x8 p[2];
                { const f32x16 s1 = attn_scores(kim, 32 + cl, hf, qf); if (rel == 32) attn_weights<true>(s1, R, hf, cl, p); else attn_weights<false>(s1, R, hf, cl, p); }
                attn_pv(vim, 1, cl, hf, p, o); }
        }
        if (rel >= 0) {
            if (LAG) { if (pending) attn_pv(vimd, subd, cl, hf, pd, o);
                const f32x16 s0 = attn_scores(kim, cl, hf, qf); if (rel == 0) attn_weights<true>(s0, R, hf, cl, pd); else attn_weights<false>(s0, R, hf, cl, pd);
                vimd = vim; subd = 0; pending = true;
            } else { bf16x8 p[2];
                { const f32x16 s0 = attn_scores(kim, cl, hf, qf); if (rel == 0) attn_weights<true>(s0, R, hf, cl, p); else attn_weights<false>(s0, R, hf, cl, p); }
                attn_pv(vim, 0, cl, hf, p, o); }
        }
        if (it + 2 < nkt) asm volatile("s_waitcnt vmcnt(4)\n\ts_waitcnt lgkmcnt(0)" ::: "memory"); else asm volatile("s_waitcnt vmcnt(0)\n\ts_waitcnt lgkmcnt(0)" ::: "memory");
        __builtin_amdgcn_s_barrier(); asm volatile("" ::: "memory");
        bi = (bi + 1) & 3;
    }
#undef AT_DMA
    if (LAG && pending) attn_pv(vimd, subd, cl, hf, pd, o);
    bf16* orow = outb + (rb + q0w + cl) * 1024 + h * 128 + 4 * hf;
#pragma unroll
    for (int d = 0; d < 4; ++d)
#pragma unroll
        for (int g = 0; g < 4; ++g) { v2u q; q.x = pk2c(o[d][4 * g], o[d][4 * g + 1]); q.y = pk2c(o[d][4 * g + 2], o[d][4 * g + 3]); *(GAS v2u*)(orow + 32 * d + 8 * g) = q; }
    asm volatile("s_waitcnt vmcnt(0)" ::: "memory"); __builtin_amdgcn_s_barrier(); asm volatile("" ::: "memory");
}
__device__ __forceinline__ void hgpost_row(bf16* row, const bf16* grow, const float* w, int lane) {
#pragma unroll
    for (int j = 0; j < 2; ++j) {
        GAS v4u* p = (GAS v4u*)(row + 8 * lane + 512 * j); const v4u x = *p; const v4u gg = *(const GAS v4u*)(grow + 8 * lane + 512 * j);
        float f[8] = {bflo(x.x), bfhi(x.x), bflo(x.y), bfhi(x.y), bflo(x.z), bfhi(x.z), bflo(x.w), bfhi(x.w)};
        const float g[8] = {bflo(gg.x), bfhi(gg.x), bflo(gg.y), bfhi(gg.y), bflo(gg.z), bfhi(gg.z), bflo(gg.w), bfhi(gg.w)};
        float ss = 0.f;
#pragma unroll
        for (int k = 0; k < 8; ++k) ss += f[k] * f[k];
        ss += __shfl_xor(ss, 1); ss += __shfl_xor(ss, 2); ss += __shfl_xor(ss, 4); ss += __shfl_xor(ss, 8);
        const float r = __builtin_amdgcn_rsqf(ss * (1.0f / 128.0f) + EPS);
        const f32x4 wa = *(const GAS f32x4*)(w + ((8 * lane) & 127)), wb = *(const GAS f32x4*)(w + ((8 * lane) & 127) + 4);
        v4u o; o.x = pk2c(f[0] * r * wa.x * g[0], f[1] * r * wa.y * g[1]); o.y = pk2c(f[2] * r * wa.z * g[2], f[3] * r * wa.w * g[3]);
        o.z = pk2c(f[4] * r * wb.x * g[4], f[5] * r * wb.y * g[5]); o.w = pk2c(f[6] * r * wb.z * g[6], f[7] * r * wb.w * g[7]);
        *p = o;
    }
}

template <bool FIRST> struct EpiMerge {
    static constexpr bool PERM = true, AFTER_DRAIN = false;
    const bf16* gate; bf16* merged;
    __device__ __forceinline__ void operator()(const pg8::f32x4 (&acc)[2][2][4][2], const pg8::Unit& u, int wr, int wc, int fr, int fq) const {
        const int row0 = u.pm * 256 + wr * 64 + fr, col0 = u.pn * 256 + wc * 32 + 8 * fq;
#pragma unroll
        for (int ai = 0; ai < 2; ++ai)
#pragma unroll
            for (int m = 0; m < 4; ++m) {
                if ((m & 1) == 0) asm volatile("" ::: "memory");
#pragma unroll
                for (int bj = 0; bj < 2; ++bj) {
                    const size_t off = (size_t)(row0 + ai * 128 + m * 16) * 2048 + col0 + bj * 128;
                    const v4u g = *(const GAS v4u*)(gate + off); const pg8::f32x4 v0 = acc[ai][bj][m][0], v1 = acc[ai][bj][m][1];
                    float r[8] = {bflo(g.x) * v0[0], bfhi(g.x) * v0[1], bflo(g.y) * v0[2], bfhi(g.y) * v0[3], bflo(g.z) * v1[0], bfhi(g.z) * v1[1], bflo(g.w) * v1[2], bfhi(g.w) * v1[3]};
                    if (!FIRST) { const v4u mo = *(const GAS v4u*)(merged + off);
                        r[0] += bflo(mo.x); r[1] += bfhi(mo.x); r[2] += bflo(mo.y); r[3] += bfhi(mo.y); r[4] += bflo(mo.z); r[5] += bfhi(mo.z); r[6] += bflo(mo.w); r[7] += bfhi(mo.w); }
                    v4u w; w.x = pk2c(r[0], r[1]); w.y = pk2c(r[2], r[3]); w.z = pk2c(r[4], r[5]); w.w = pk2c(r[6], r[7]);
                    *(GAS v4u*)(merged + off) = w; }
            }
    }
};
struct EpiStoreBf16 {
    static constexpr bool PERM = true, AFTER_DRAIN = false;
    bf16* out;
    __device__ __forceinline__ void operator()(const pg8::f32x4 (&acc)[2][2][4][2], const pg8::Unit& u, int wr, int wc, int fr, int fq) const {
        const int row0 = u.pm * 256 + wr * 64 + fr, col0 = u.pn * 256 + wc * 32 + 8 * fq;
#pragma unroll
        for (int ai = 0; ai < 2; ++ai)
#pragma unroll
            for (int m = 0; m < 4; ++m)
#pragma unroll
                for (int bj = 0; bj < 2; ++bj) { const pg8::f32x4 v0 = acc[ai][bj][m][0], v1 = acc[ai][bj][m][1];
                    v4u w; w.x = pk2c(v0[0], v0[1]); w.y = pk2c(v0[2], v0[3]); w.z = pk2c(v1[0], v1[1]); w.w = pk2c(v1[2], v1[3]);
                    *(GAS v4u*)(out + (size_t)(row0 + ai * 128 + m * 16) * 2048 + col0 + bj * 128) = w; }
    }
};
struct EpiResid {
    static constexpr bool PERM = false, AFTER_DRAIN = false;
    const float* xin; float* xout;
    __device__ __forceinline__ void operator()(const pg8::f32x4 (&acc)[2][2][4][2], const pg8::Unit& u, int wr, int wc, int fr, int fq) const {
        const int row0 = u.pm * 256 + wr * 64 + fr, col0 = u.pn * 256 + wc * 32 + 4 * fq;
#pragma unroll
        for (int ai = 0; ai < 2; ++ai)
#pragma unroll
            for (int m = 0; m < 4; ++m)
#pragma unroll
                for (int bj = 0; bj < 2; ++bj)
#pragma unroll
                    for (int n = 0; n < 2; ++n) { const size_t off = (size_t)(row0 + ai * 128 + m * 16) * 2048 + col0 + bj * 128 + n * 16;
                        f32x4 r = acc[ai][bj][m][n]; if (xin) r += *(const GAS f32x4*)(xin + off);
                        *(GAS f32x4*)(xout + off) = r; }
    }
};

__device__ __forceinline__ float rl_f(float v, int l) { return __uint_as_float((unsigned)__builtin_amdgcn_readlane((int)__float_as_uint(v), l)); }
__device__ __forceinline__ void ins16(float (&L)[16], float x) {
#pragma unroll
    for (int i = 0; i < 16; ++i) { const float hi = __builtin_fmaxf(L[i], x); x = __builtin_fminf(L[i], x); L[i] = hi; }
}
#define CE_DESC(a, b) do { const float hi_ = __builtin_fmaxf(a, b), lo_ = __builtin_fminf(a, b); a = hi_; b = lo_; } while (0)
__device__ __forceinline__ void sort16_desc(float (&v)[16]) {
#pragma unroll
    for (int k = 2; k <= 16; k <<= 1)
#pragma unroll
        for (int j = k >> 1; j > 0; j >>= 1)
#pragma unroll
            for (int i = 0; i < 16; ++i) { const int l = i ^ j; if (l > i) { if ((i & k) == 0) CE_DESC(v[i], v[l]); else CE_DESC(v[l], v[i]); } }
}
__device__ __forceinline__ void bitonic_merge16_desc(float (&v)[16]) {
#pragma unroll
    for (int j = 8; j > 0; j >>= 1)
#pragma unroll
        for (int i = 0; i < 16; ++i) { const int l = i ^ j; if (l > i) CE_DESC(v[i], v[l]); }
}
__device__ __forceinline__ void top16_merge(float (&L)[16], const float (&T)[16]) {
#pragma unroll
    for (int i = 0; i < 16; ++i) L[i] = __builtin_fmaxf(L[i], T[15 - i]);
    bitonic_merge16_desc(L);
}
constexpr int PK_KS = 272;
__device__ __forceinline__ void peer_top16(const bf16* qrow  , const LAS unsigned char* kl  , int hf, float (&L)[16]) {
    bf16x8 qf[8];
#pragma unroll
    for (int kk = 0; kk < 8; ++kk) qf[kk] = *(const GAS bf16x8*)(qrow + 16 * kk);
#pragma unroll 1
    for (int kt = 0; kt < 4; ++kt) {
        f32x16 sa;
#pragma unroll
        for (int r = 0; r < 16; ++r) sa[r] = 0.f;
#pragma unroll
        for (int kk = 0; kk < 8; ++kk) sa = MFMA32(*(const LAS bf16x8*)(kl + kt * 32 * PK_KS + 32 * kk), qf[kk], sa);
        float T[16];
#pragma unroll
        for (int r = 0; r < 16; ++r) { const unsigned idx = (unsigned)(kt * 32 + (r & 3) + 8 * (r >> 2) + 4 * hf); T[r] = __uint_as_float((__float_as_uint(sa[r]) & ~127u) | idx); }
        sort16_desc(T);
        if (kt == 0) {
#pragma unroll
            for (int i = 0; i < 16; ++i) L[i] = T[i];
        } else top16_merge(L, T);
    }
    float P[16];
#pragma unroll
    for (int i = 0; i < 16; ++i) P[i] = __shfl_xor(L[i], 32);
    top16_merge(L, P);
}
__device__ __forceinline__ void peer_select32(int hd, int n0, int lane, const bf16* qpeer, const LAS unsigned char* kl1, const LAS unsigned char* kl2, unsigned char* wsb, LAS unsigned* ldsw) {
    asm volatile("" : "+v"(lane));
    const int c = lane & 31, hf = lane >> 5, n = n0 + c;
    const bf16* qrow = qpeer + (size_t)n * 2048 + hd * 256 + 8 * hf;
    float A[16], B[16];
    peer_top16(qrow, kl1 + c * PK_KS + 16 * hf, hf, A);
    peer_top16(qrow + 128, kl2 + c * PK_KS + 16 * hf, hf, B);
#define PKV(x) __uint_as_float(__float_as_uint(x) & ~127u)
#define PKI(x) ((int)(__float_as_uint(x) & 127u))
    float W[16];
    { float C0[16], C1[16], C2[16], E0 = 0.f, E1 = 0.f; unsigned id = 0;
#pragma unroll
      for (int a = 0; a < 16; ++a)
#pragma unroll
        for (int b = 0; b < 16; ++b) if ((a + 1) * (b + 1) <= 16) { const float pk = __uint_as_float((__float_as_uint(PKV(A[a]) + PKV(B[b])) & ~63u) | id);
            if (id < 16) C0[id] = pk; else if (id < 32) C1[id - 16] = pk; else if (id < 48) C2[id - 32] = pk; else if (id == 48) E0 = pk; else E1 = pk;
            ++id; }
      sort16_desc(C0); sort16_desc(C1); sort16_desc(C2);
      top16_merge(C0, C1); top16_merge(C0, C2);
#pragma unroll
      for (int i = 0; i < 16; ++i) W[i] = C0[i];
      ins16(W, E0); ins16(W, E1); }
    const float thr = W[15], mx = W[0];
    int cnt = 0; float ssum = 0.f;
    LAS int* le = (LAS int*)ldsw + c * 16; LAS float* lg = (LAS float*)ldsw + 512 + c * 16;
    { unsigned id = 0;
#pragma unroll
      for (int a = 0; a < 16; ++a)
#pragma unroll
        for (int b = 0; b < 16; ++b) if ((a + 1) * (b + 1) <= 16) {
            const float cv = PKV(A[a]) + PKV(B[b]); const float pk = __uint_as_float((__float_as_uint(cv) & ~63u) | id); ++id;
            if (pk >= thr) { const float e = __expf(cv - mx); if (hf == 0) { le[cnt] = PKI(A[a]) * 128 + PKI(B[b]); lg[cnt] = e; } ssum += e; ++cnt; }
        } }
    LDS_WAIT();
    asm volatile("" : "+s"(wsb));
    int* sel_e = (int*)(wsb + WS_SEL); float* sel_g = (float*)(wsb + WS_SEL + 8 * MiB); float* sel_s = (float*)(wsb + WS_SELS);
    { int lane3 = lane; asm volatile("" : "+v"(lane3)); const int t = lane3 >> 1, part = lane3 & 1;
      const v4u e0 = *(const LAS v4u*)((LAS int*)ldsw + t * 16 + 8 * part), e1 = *(const LAS v4u*)((LAS int*)ldsw + t * 16 + 8 * part + 4);
      const v4u g0 = *(const LAS v4u*)((LAS int*)ldsw + 512 + t * 16 + 8 * part), g1 = *(const LAS v4u*)((LAS int*)ldsw + 512 + t * 16 + 8 * part + 4);
      GAS v4u* pe = (GAS v4u*)(sel_e + (size_t)(n0 + t) * 128 + hd * 16 + 8 * part); GAS v4u* pg = (GAS v4u*)(sel_g + (size_t)(n0 + t) * 128 + hd * 16 + 8 * part);
      pe[0] = e0; pe[1] = e1; pg[0] = g0; pg[1] = g1; }
    LDS_WAIT();
    { int lane4 = lane; asm volatile("" : "+v"(lane4)); if ((lane4 >> 5) == 0) ((GAS float*)sel_s)[(size_t)(n0 + (lane4 & 31)) * 8 + hd] = ssum; }
}

__device__ __forceinline__ float dot2bf(unsigned a, unsigned b, float acc) {
    return __builtin_amdgcn_fdot2_f32_bf16(__builtin_bit_cast(bf16v2, a), __builtin_bit_cast(bf16v2, b), acc, false);
}
__device__ __forceinline__ float dot8bf(const v4u a, const v4u b, float acc) {
    const unsigned a0 = a.x, a1 = a.y, a2 = a.z, a3 = a.w, b0 = b.x, b1 = b.y, b2 = b.z, b3 = b.w;
    acc = dot2bf(a0, b0, acc); acc = dot2bf(a1, b1, acc); acc = dot2bf(a2, b2, acc); acc = dot2bf(a3, b3, acc);
    return acc;
}
__device__ __forceinline__ void unpack16(const v4u q, float (&f)[16]) {
    const unsigned d0 = q.x, d1 = q.y, d2 = q.z, d3 = q.w;
    f32x2v t;
    t = __builtin_amdgcn_cvt_pk_f32_fp8((int)d0, false); f[0] = t.x; f[1] = t.y; t = __builtin_amdgcn_cvt_pk_f32_fp8((int)d0, true); f[2] = t.x; f[3] = t.y;
    t = __builtin_amdgcn_cvt_pk_f32_fp8((int)d1, false); f[4] = t.x; f[5] = t.y; t = __builtin_amdgcn_cvt_pk_f32_fp8((int)d1, true); f[6] = t.x; f[7] = t.y;
    t = __builtin_amdgcn_cvt_pk_f32_fp8((int)d2, false); f[8] = t.x; f[9] = t.y; t = __builtin_amdgcn_cvt_pk_f32_fp8((int)d2, true); f[10] = t.x; f[11] = t.y;
    t = __builtin_amdgcn_cvt_pk_f32_fp8((int)d3, false); f[12] = t.x; f[13] = t.y; t = __builtin_amdgcn_cvt_pk_f32_fp8((int)d3, true); f[14] = t.x; f[15] = t.y;
}
struct SliceSched { int mode, xcc, rank, nloc; };
__device__ __forceinline__ SliceSched slice_sched_init(const Ctx& c, unsigned* ctl, const XcdBarrier& bar, int use) {
    LAS int* sh = (LAS int*)(c.lds + 1024);
    if (c.tid == 0) {
        int ok = 1; unsigned tot = 0;
        for (int j = 0; j < 16; ++j) { const unsigned n = xb_ld(&bar.bar[XB_XCNT(j)]); tot += n; if ((j < 8) != (n > 0u)) ok = 0; }
        if (tot != (unsigned)c.G) ok = 0;
        const int xcc = (int)xb_xcc_id();
        int rank = 0, nloc = 1;
        if (ok) { nloc = (int)xb_ld(&bar.bar[XB_XCNT(xcc)]); rank = (int)xb_add(&ctl[CW_RANK + (use * 16 + xcc) * 64], 1u); if (rank >= nloc) ok = 0; }
        sh[0] = ok; sh[1] = xcc; sh[2] = rank; sh[3] = nloc;
    }
    __syncthreads();
    SliceSched S; S.mode = sh[0]; S.xcc = sh[1]; S.rank = sh[2]; S.nloc = sh[3];
    __syncthreads();
    return S;
}
__device__ __forceinline__ bool slice_item(const SliceSched& S, const Ctx& c, int i, int& slice, int& tb) {
    if (S.mode) { const int it = S.rank + i * S.nloc; if (it >= 512) return false; slice = S.xcc + 8 * (it >> 8); tb = it & 255; return true; }
    const int it = (int)blockIdx.x + i * c.G; if (it >= 4096) return false; slice = it >> 8; tb = it & 255; return true;
}
__device__ __forceinline__ void unpack16p(const v4u q, f32x2v (&f)[8]) {
    const unsigned d0 = q.x, d1 = q.y, d2 = q.z, d3 = q.w;
    f[0] = __builtin_amdgcn_cvt_pk_f32_fp8((int)d0, false); f[1] = __builtin_amdgcn_cvt_pk_f32_fp8((int)d0, true);
    f[2] = __builtin_amdgcn_cvt_pk_f32_fp8((int)d1, false); f[3] = __builtin_amdgcn_cvt_pk_f32_fp8((int)d1, true);
    f[4] = __builtin_amdgcn_cvt_pk_f32_fp8((int)d2, false); f[5] = __builtin_amdgcn_cvt_pk_f32_fp8((int)d2, true);
    f[6] = __builtin_amdgcn_cvt_pk_f32_fp8((int)d3, false); f[7] = __builtin_amdgcn_cvt_pk_f32_fp8((int)d3, true);
}
__device__ __forceinline__ void peer_sddmm_wave(int t0, int s, int lane, const bf16* H, const unsigned char* UQ, const int* sel_e, float* part, LAS unsigned* ldsw) {
    const int cg = lane & 7, sg = lane >> 3;
#pragma unroll
    for (int j = 0; j < 4; ++j) *(LAS v4u*)(ldsw + 4 * (lane + 64 * j)) = *(const GAS v4u*)(sel_e + (size_t)t0 * 128 + 4 * (lane + 64 * j));
    LDS_WAIT();
    const unsigned char* ubase = UQ + (size_t)s * U8_SLICE + cg * 16;
    v4u qn[16];
    { int id[16];
#pragma unroll
      for (int q = 0; q < 4; ++q) { const v4u v = *(const LAS v4u*)(ldsw + sg * 16 + 4 * q); id[4 * q] = (int)v.x; id[4 * q + 1] = (int)v.y; id[4 * q + 2] = (int)v.z; id[4 * q + 3] = (int)v.w; }
#pragma unroll
      for (int it = 0; it < 16; ++it) qn[it] = *(const GAS v4u*)(ubase + (unsigned)id[it] * 128u); }
    const bf16* hbase = H + (size_t)t0 * 2048 + s * 128 + cg * 16;
    v4u han = *(const GAS v4u*)(hbase), hbn = *(const GAS v4u*)(hbase + 8);
#pragma unroll 1
    for (int k = 0; k < 8; ++k) {
        const int t = t0 + k;
        v4u qc[16];
#pragma unroll
        for (int it = 0; it < 16; ++it) qc[it] = qn[it];
        const v4u ha = han, hb = hbn;
        if (k < 7) { han = *(const GAS v4u*)(hbase + (size_t)(k + 1) * 2048); hbn = *(const GAS v4u*)(hbase + (size_t)(k + 1) * 2048 + 8); }
        if (k < 7) { int id[16];
#pragma unroll
            for (int q = 0; q < 4; ++q) { const v4u v = *(const LAS v4u*)(ldsw + (k + 1) * 128 + sg * 16 + 4 * q); id[4 * q] = (int)v.x; id[4 * q + 1] = (int)v.y; id[4 * q + 2] = (int)v.z; id[4 * q + 3] = (int)v.w; }
#pragma unroll
            for (int it = 0; it < 16; ++it) qn[it] = *(const GAS v4u*)(ubase + (unsigned)id[it] * 128u); }
        float h[16] = {bflo(ha.x), bfhi(ha.x), bflo(ha.y), bfhi(ha.y), bflo(ha.z), bfhi(ha.z), bflo(ha.w), bfhi(ha.w), bflo(hb.x), bfhi(hb.x), bflo(hb.y), bfhi(hb.y), bflo(hb.z), bfhi(hb.z), bflo(hb.w), bfhi(hb.w)};
        float hm = 0.f;
#pragma unroll
        for (int j = 0; j < 16; ++j) hm = fmaxf(hm, fabsf(h[j]));
        hm = fmaxf(hm, __shfl_xor(hm, 1)); hm = fmaxf(hm, __shfl_xor(hm, 2)); hm = fmaxf(hm, __shfl_xor(hm, 4));
        const float hinv = hm > 0.f ? 127.0f / hm : 0.f, hs = hm * (1.0f / 127.0f);
        int hq[4];
#pragma unroll
        for (int j = 0; j < 4; ++j) hq[j] = (int)pack_i8x4(h[4 * j] * hinv, h[4 * j + 1] * hinv, h[4 * j + 2] * hinv, h[4 * j + 3] * hinv);
        float p[16];
#pragma unroll
        for (int it = 0; it < 16; ++it) { int a = __builtin_amdgcn_sdot4((int)qc[it].x, hq[0], 0, false); a = __builtin_amdgcn_sdot4((int)qc[it].y, hq[1], a, false);
            a = __builtin_amdgcn_sdot4((int)qc[it].z, hq[2], a, false); a = __builtin_amdgcn_sdot4((int)qc[it].w, hq[3], a, false);
            p[it] = (float)a * hs; }
#pragma unroll
        for (int i = 0; i < 8; ++i) { const bool up = (lane & 4) != 0; const float snd = up ? p[i] : p[i + 8], kp = up ? p[i + 8] : p[i]; p[i] = kp + __shfl_xor(snd, 4); }
#pragma unroll
        for (int i = 0; i < 4; ++i) { const bool up = (lane & 2) != 0; const float snd = up ? p[i] : p[i + 4], kp = up ? p[i + 4] : p[i]; p[i] = kp + __shfl_xor(snd, 2); }
#pragma unroll
        for (int i = 0; i < 2; ++i) { const bool up = (lane & 1) != 0; const float snd = up ? p[i] : p[i + 2], kp = up ? p[i + 2] : p[i]; p[i] = kp + __shfl_xor(snd, 1); }
        ((GAS unsigned*)part)[((size_t)t * 16 + s) * 64 + lane] = pk2c(p[0], p[1]);
    }
    LDS_WAIT();
}
__device__ __forceinline__ void peer_coef_tokens4(int t0, int ts, int lane, const float* part, const int* sel_e, float* sel_g, const float* sel_s, const float* US, const float* VS) {
    unsigned pv[4][16]; v2u e[4]; f32x2v g[4]; float dn[4];
#pragma unroll
    for (int i = 0; i < 4; ++i) { const int t = t0 + i * ts;
#pragma unroll
        for (int s = 0; s < 16; ++s) pv[i][s] = ((const GAS unsigned*)part)[((size_t)t * 16 + s) * 64 + lane];
        e[i] = *(const GAS v2u*)(sel_e + (size_t)t * 128 + 2 * lane); g[i] = *(const GAS f32x2v*)(sel_g + (size_t)t * 128 + 2 * lane); dn[i] = ((const GAS float*)sel_s)[(size_t)t * 8 + (lane >> 3)]; }
    float ux[4], uy[4], vx[4], vy[4];
#pragma unroll
    for (int i = 0; i < 4; ++i) { ux[i] = ((const GAS float*)US)[e[i].x]; uy[i] = ((const GAS float*)US)[e[i].y]; vx[i] = ((const GAS float*)VS)[e[i].x]; vy[i] = ((const GAS float*)VS)[e[i].y]; }
#pragma unroll
    for (int i = 0; i < 4; ++i) { const int t = t0 + i * ts; float a0 = 0.f, a1 = 0.f;
#pragma unroll
        for (int s = 0; s < 16; ++s) { a0 += bflo(pv[i][s]); a1 += bfhi(pv[i][s]); }
        const float inv = 1.0f / dn[i];
        const float ox = g[i].x * inv * gelu_exact(a0 * ux[i]) * vx[i], oy = g[i].y * inv * gelu_exact(a1 * uy[i]) * vy[i];
        const h2_t ha = {(_Float16)ox, (_Float16)ox}, hb = {(_Float16)oy, (_Float16)oy};
        *(GAS v2u*)(sel_g + (size_t)t * 128 + 2 * lane) = (v2u){__builtin_bit_cast(unsigned, ha), __builtin_bit_cast(unsigned, hb)}; }
}
__device__ __forceinline__ bool slice_item8(const SliceSched& S, const Ctx& c, int i, int& slice, int& tb) {
    if (S.mode) { const int it = S.rank + i * S.nloc; if (it >= 256) return false; slice = S.xcc; tb = it; return true; }
    const int it = (int)blockIdx.x + i * c.G; if (it >= 2048) return false; slice = it >> 8; tb = it & 255; return true;
}
template <int MODE = 0>
__device__ __forceinline__ void spmm6_load(const unsigned char* vbase, const LAS unsigned* ids8, v4u (&qa)[8], v2u (&qb)[8]) {
    const v4u i0 = *(const LAS v4u*)(ids8), i1 = *(const LAS v4u*)(ids8 + 4);
    const unsigned id[8] = {i0.x, i0.y, i0.z, i0.w, i1.x, i1.y, i1.z, i1.w};
    if constexpr (MODE == 2) {
#pragma unroll
        for (int it = 0; it < 8; ++it) { qa[it] = (v4u){id[it], id[it] + 1u, id[it] + 2u, id[it] + 3u}; qb[it] = (v2u){id[it] + 4u, id[it] + 5u}; }
        return; }
#pragma unroll
    for (int it = 0; it < 8; ++it) { const unsigned char* p = vbase + id[it] * 192u; qa[it] = *(const GAS v4u*)p; qb[it] = *(const GAS v2u*)(p + 16); }
}
template <int MODE = 0>
__device__ __forceinline__ void spmm6_fma(const v4u (&qa)[8], const v2u (&qb)[8], const LAS unsigned* cf8, h2_t (&y)[16]) {
    const v4u c0 = *(const LAS v4u*)(cf8), c1 = *(const LAS v4u*)(cf8 + 4);
    const unsigned cf[8] = {c0.x, c0.y, c0.z, c0.w, c1.x, c1.y, c1.z, c1.w};
    if constexpr (MODE == 1) {
#pragma unroll
        for (int it = 0; it < 8; ++it) { const unsigned x = (qa[it].x ^ qa[it].y) ^ (qa[it].z ^ qa[it].w) ^ (qb[it].x ^ qb[it].y) ^ cf[it]; y[it] = __builtin_bit_cast(h2_t, __builtin_bit_cast(unsigned, y[it]) ^ x); }
        return; }
#pragma unroll
    for (int it = 0; it < 8; ++it) { const v6u q = {qa[it].x, qa[it].y, qa[it].z, qa[it].w, qb[it].x, qb[it].y};
        const v32h_t f = __builtin_amdgcn_cvt_scalef32_pk32_f16_fp6(q, 1.0f); const h2_t c2 = __builtin_bit_cast(h2_t, cf[it]);
#pragma unroll
        for (int j = 0; j < 16; ++j) { const h2_t v = {f[2 * j], f[2 * j + 1]}; y[j] = __builtin_elementwise_fma(v, c2, y[j]); } }
}
template <int MODE = 0>
__device__ __forceinline__ void peer_spmm6_wave(int t0, int s, int lane, const unsigned char* V6, const int* sel_e, const float* coef, const float* x1, float* xout, LAS unsigned* ldsw) {
    const int cg = lane & 7, sg = lane >> 3;
#pragma unroll
    for (int j = 0; j < 4; ++j) { *(LAS v4u*)(ldsw + 4 * (lane + 64 * j)) = *(const GAS v4u*)(sel_e + (size_t)t0 * 128 + 4 * (lane + 64 * j));
        *(LAS v4u*)(ldsw + 1024 + 4 * (lane + 64 * j)) = *(const GAS v4u*)(coef + (size_t)t0 * 128 + 4 * (lane + 64 * j)); }
    LDS_WAIT();
    const unsigned char* vbase = V6 + (size_t)s * V6_SLICE + cg * 24;
    const LAS unsigned* idl = ldsw + sg * 16; const LAS unsigned* cfl = ldsw + 1024 + sg * 16;
    v4u qa0[8], qa1[8]; v2u qb0[8], qb1[8];
    spmm6_load<MODE>(vbase, idl, qa0, qb0);
    const size_t xoff = (size_t)t0 * 2048 + s * 256 + cg * 32 + 4 * sg;
    f32x4 xn = *(const GAS f32x4*)(x1 + xoff);
#pragma unroll 1
    for (int k = 0; k < 8; ++k) {
        const f32x4 xv = xn;
        h2_t y[16];
#pragma unroll
        for (int j = 0; j < 16; ++j) y[j] = (h2_t){(_Float16)0.f, (_Float16)0.f};
        spmm6_load<MODE>(vbase, idl + k * 128 + 8, qa1, qb1);
        if (k < 7) xn = *(const GAS f32x4*)(x1 + xoff + (size_t)(k + 1) * 2048);
        spmm6_fma<MODE>(qa0, qb0, cfl + k * 128, y);
        if (k < 7) spmm6_load<MODE>(vbase, idl + (k + 1) * 128, qa0, qb0);
        spmm6_fma<MODE>(qa1, qb1, cfl + k * 128 + 8, y);
        unsigned u[16];
#pragma unroll
        for (int j = 0; j < 16; ++j) u[j] = __builtin_bit_cast(unsigned, y[j]);
#pragma unroll
        for (int i = 0; i < 8; ++i) { const bool up = (lane & 32) != 0; const unsigned snd = up ? u[i] : u[i + 8], kp = up ? u[i + 8] : u[i]; u[i] = __builtin_bit_cast(unsigned, __builtin_bit_cast(h2_t, kp) + __builtin_bit_cast(h2_t, (unsigned)__shfl_xor((int)snd, 32))); }
#pragma unroll
        for (int i = 0; i < 4; ++i) { const bool up = (lane & 16) != 0; const unsigned snd = up ? u[i] : u[i + 4], kp = up ? u[i + 4] : u[i]; u[i] = __builtin_bit_cast(unsigned, __builtin_bit_cast(h2_t, kp) + __builtin_bit_cast(h2_t, (unsigned)__shfl_xor((int)snd, 16))); }
#pragma unroll
        for (int i = 0; i < 2; ++i) { const bool up = (lane & 8) != 0; const unsigned snd = up ? u[i] : u[i + 2], kp = up ? u[i + 2] : u[i]; u[i] = __builtin_bit_cast(unsigned, __builtin_bit_cast(h2_t, kp) + __builtin_bit_cast(h2_t, (unsigned)__shfl_xor((int)snd, 8))); }
        const h2_t r0 = __builtin_bit_cast(h2_t, u[0]), r1 = __builtin_bit_cast(h2_t, u[1]);
        f32x4 o; o.x = xv.x + (float)r0[0]; o.y = xv.y + (float)r0[1]; o.z = xv.z + (float)r1[0]; o.w = xv.w + (float)r1[1];
        *(GAS f32x4*)(xout + xoff + (size_t)k * 2048) = o;
    }
    LDS_WAIT();
}

struct Args { const float* in[21]; float* out; unsigned char* ws; int lo, hi, li, pad; };
__global__ void __launch_bounds__(512, 2) mk_fwd(Args args) {
    extern __shared__ __attribute__((aligned(16))) unsigned char lds_raw[];
    Ctx c; c.lds = (LAS unsigned char*)lds_raw; c.tid = threadIdx.x; c.lane = c.tid & 63; c.wave = __builtin_amdgcn_readfirstlane(c.tid >> 6);
    c.G = gridDim.x; c.gw = blockIdx.x * 8 + c.wave; c.NGW = c.G * 8;
    volatile LAS unsigned* MISC = (volatile LAS unsigned*)(c.lds + MISC_OFF);
    if (c.tid < 32) MISC[c.tid] = 0u;
    __syncthreads();
    unsigned char* ws = args.ws;
    const int lo = args.lo, hi = args.hi;
    XcdBarrier bar; bar.w0 = 0; bar.bar = (unsigned*)(ws + WS_CTL) + CW_BAR + args.li * XCD_BAR_WORDS; bar.x = 0; bar.st = nullptr;
    if (hi - lo > 1) bar = xcd_barrier_post((unsigned*)(ws + WS_CTL) + CW_BAR + args.li * XCD_BAR_WORDS, MISC + 8);
#ifndef ATTN_REPS
#define ATTN_REPS 1
#endif
#ifndef PHMASK
#define PHMASK 0x1fff
#endif
#ifndef REP_PH
#define REP_PH (-1)
#endif
    int rep2 = 2; asm volatile("" : "+s"(rep2));
#define RLOOP(k, cond) for (int rp_ = 0; rp_ < ((((k) == REP_PH) && (cond)) ? rep2 : 1); ++rp_)
#define RSYNC do { if (rp_) xcd_barrier(bar); } while (0)
#define IN(k) (((PHMASK >> ((k) % NPH)) & 1) && lo <= (k) && (k) < hi)
#define SEAM(k) do { if (IN(k) && IN((k) + 1)) xcd_barrier(bar); } while (0)
#define PH_BEGIN unsigned char* w = ws; float* outp = args.out; Ctx cc = c; int zi = 0; cc.lane = xb_lane_id(); cc.tid = cc.wave * 64 + cc.lane; \
    asm volatile("" : "+s"(w), "+s"(outp), "+s"(zi), "+v"(cc.tid), "+v"(cc.lane)); (void)w; (void)outp;
#define INP(k) (args.in[(k) + zi])
#define WSP(T, off) ((T*)(w + (off)))
    for (int l = 0; l < 2; ++l) {
        const int pb = l * NPH;
        if (IN(pb + 0)) { PH_BEGIN
            P0Args a; a.w_in = INP(2) + (size_t)l * DM * INW; a.w_br_sb = INP(11) + (size_t)l * BW * DM; a.w_br_hg = INP(12) + (size_t)l * BW * DM; a.w_br_conv = INP(13) + (size_t)l * BW * DM;
            a.w_o = INP(14) + (size_t)l * DM * DM; a.w_q = INP(16) + (size_t)l * DM * DM; a.u = INP(19) + (size_t)l * 16384 * 2048; a.v = INP(20) + (size_t)l * 16384 * 2048; a.lbp = INP(5);
            a.WinT = WSP(bf16, WS_WIN); a.WbrT = WSP(bf16, WS_WBR); a.WoT = WSP(bf16, WS_WO); a.WqT = WSP(bf16, WS_WQ); a.U = WSP(unsigned char, WS_U); a.V = WSP(unsigned char, WS_V); a.US = WSP(float, WS_US); a.VS = WSP(float, WS_VS); a.LB = WSP(float, WS_LB); a.layer = l; a.k1 = INP(17) + (size_t)l * 8 * 16384; a.k2 = INP(18) + (size_t)l * 8 * 16384; a.KB = WSP(bf16, WS_KEYS);
            RLOOP(0, true) { RSYNC;
            p0_convert(cc, a);
            rms_phase_i8(cc, l == 0 ? INP(0) : WSP(const float, WS_X2), INP(1) + (size_t)l * DM, WSP(unsigned char, WS_H), WSP(float, WS_SA)); }
        }
        SEAM(pb + 0);
        if (IN(pb + 1)) { PH_BEGIN
            RLOOP(1, true) { RSYNC;
            pg8::Gemm g{WSP(bf16, WS_H), WSP(bf16, WS_WIN), NTOK, INW, DM}; pg8::StaticOrder S; S.init(NTOK, INW, cc.G, (int)blockIdx.x);
            EpiIn E{WSP(bf16, WS_SEG), WSP(bf16, WS_GATE), WSP(float, WS_LB), WSP(float, WS_SA)};
            pg8::gemm_phase<EpiIn, pg8::StaticOrder, true, true, true>(cc.lds, g, S, E, cc.wave); }
        }
        SEAM(pb + 1);
        if (IN(pb + 2)) { PH_BEGIN
            bf16* SEG = WSP(bf16, WS_SEG);
            RLOOP(2, true) { RSYNC;
            conv_phase(cc, SEG + 7 * SEGSZ, INP(7) + (size_t)l * 31 * 1024, INP(8) + (size_t)l * 1024, INP(9) + (size_t)l * 1024, INP(10) + (size_t)l * 1024, WSP(bf16, WS_CONV));
            for (int ci = blockIdx.x; ci < 2048; ci += cc.G) hgA_chunk(cc, ci, SEG + 4 * SEGSZ, SEG + 5 * SEGSZ, WSP(bf16, WS_ST), WSP(float, WS_DEC));
            if (!rp_)
            for (int r = cc.gw; r < 2 * (NTOK / 4); r += cc.NGW) {
                if (r < NTOK / 4) qknorm_rows4(SEG + (size_t)r * 4 * 1024, 1024, INP(3) + (size_t)l * 128, 0.08838834764831845f, cc.lane);
                else qknorm_rows4(SEG + SEGSZ + (size_t)(r - NTOK / 4) * 4 * 1024, 1024, INP(4) + (size_t)l * 128, 1.0f, cc.lane);
            }
            LAS unsigned short* scr = (LAS unsigned short*)(cc.lds + 4096 + cc.wave * 8192);
            for (int it = cc.gw; it < 8192; it += cc.NGW) vt_item(it, cc.lane, SEG + 2 * SEGSZ, WSP(bf16, WS_MERGED), scr); }
        }
        SEAM(pb + 2);
        if (IN(pb + 3)) { PH_BEGIN
            bf16* SEG = WSP(bf16, WS_SEG);
            RLOOP(3, true) { RSYNC;
            if (!rp_) hgB(cc, WSP(bf16, WS_ST), WSP(float, WS_DEC));
            for (int p = blockIdx.x; p < 256; p += cc.G) { const int bh = (p & 7) * 4 + (p >> 6), j = (p >> 3) & 7;
                if (cc.wave >= 4) {
#pragma unroll 1
                    for (int u = 0; u < 2; ++u) attn_unit<true>(cc, bh, u ? j : 15 - j, SEG, SEG + SEGSZ, WSP(bf16, WS_MERGED), SEG + 2 * SEGSZ);
                } else {
#pragma unroll 1
                    for (int u = 0; u < 2; ++u) attn_unit<false>(cc, bh, u ? j : 15 - j, SEG, SEG + SEGSZ, WSP(bf16, WS_MERGED), SEG + 2 * SEGSZ);
                } } }
        }
        SEAM(pb + 3);
        if (IN(pb + 4)) { PH_BEGIN
            bf16* SEG = WSP(bf16, WS_SEG);
            RLOOP(4, true) { RSYNC;
            for (int ci = blockIdx.x; ci < 2048; ci += cc.G) hgC_chunk(cc, ci, SEG + 3 * SEGSZ, SEG + 4 * SEGSZ, SEG + 5 * SEGSZ, SEG + 6 * SEGSZ, WSP(bf16, WS_ST), INP(6) + (size_t)l * 128, WSP(bf16, WS_HGR)); }
        }
        SEAM(pb + 4);
        if (IN(pb + 5)) { PH_BEGIN
            RLOOP(5, true) { RSYNC;
            pg8::StaticOrder S; S.init(NTOK, DM, cc.G, (int)blockIdx.x);
            { pg8::Gemm g{WSP(bf16, WS_SEG) + 2 * SEGSZ, WSP(bf16, WS_WBR), NTOK, DM, BW}; EpiMerge<true> E{WSP(bf16, WS_GATE), WSP(bf16, WS_MERGED)}; pg8::gemm_phase<EpiMerge<true>, pg8::StaticOrder, true, true>(cc.lds, g, S, E, cc.wave); }
            { pg8::Gemm g{WSP(bf16, WS_HGR), WSP(bf16, WS_WBR) + (size_t)DM * BW, NTOK, DM, BW}; EpiMerge<false> E{WSP(bf16, WS_GATE) + (size_t)NTOK * 2048, WSP(bf16, WS_MERGED)}; pg8::gemm_phase<EpiMerge<false>, pg8::StaticOrder, true, true>(cc.lds, g, S, E, cc.wave); }
            { pg8::Gemm g{WSP(bf16, WS_CONV), WSP(bf16, WS_WBR) + (size_t)2 * DM * BW, NTOK, DM, BW}; EpiMerge<false> E{WSP(bf16, WS_GATE) + (size_t)2 * NTOK * 2048, WSP(bf16, WS_MERGED)}; pg8::gemm_phase<EpiMerge<false>, pg8::StaticOrder, true, true>(cc.lds, g, S, E, cc.wave); } }
        }
        SEAM(pb + 5);
        if (IN(pb + 6)) { PH_BEGIN
            RLOOP(6, true) { RSYNC;
            pg8::Gemm g{WSP(bf16, WS_MERGED), WSP(bf16, WS_WO), NTOK, DM, DM}; pg8::StaticOrder S; S.init(NTOK, DM, cc.G, (int)blockIdx.x);
            EpiResid E{l == 0 ? INP(0) : WSP(const float, WS_X2), outp};
            pg8::gemm_phase<EpiResid, pg8::StaticOrder, true, true>(cc.lds, g, S, E, cc.wave); }
        }
        SEAM(pb + 6);
        if (IN(pb + 7)) { PH_BEGIN RLOOP(7, true) { RSYNC; rms_phase(cc, outp, INP(15) + (size_t)l * DM, WSP(bf16, WS_H)); } }
        SEAM(pb + 7);
        if (IN(pb + 8)) { PH_BEGIN
            RLOOP(8, true) { RSYNC;
            pg8::Gemm g{WSP(bf16, WS_H), WSP(bf16, WS_WQ), NTOK, DM, DM}; pg8::StaticOrder S; S.init(NTOK, DM, cc.G, (int)blockIdx.x);
            EpiStoreBf16 E{WSP(bf16, WS_QPEER)};
            pg8::gemm_phase<EpiStoreBf16, pg8::StaticOrder, true, true>(cc.lds, g, S, E, cc.wave); }
        }
        SEAM(pb + 8);
        if (IN(pb + 9)) { PH_BEGIN
            RLOOP(9, true) { RSYNC;
            for (int item = blockIdx.x; item < 512; item += cc.G) { const int hd = item & 7, tg = item >> 3;
                const bf16* KB = WSP(bf16, WS_KEYS);
#pragma unroll
                for (int i = 0; i < 8; ++i) { const int p = cc.tid + 512 * i, li = p >> 11, row = (p >> 4) & 127, c16 = p & 15;
                    *(LAS v4u*)(cc.lds + li * 128 * PK_KS + row * PK_KS + c16 * 16) = *(const GAS v4u*)(KB + (size_t)(li * 8 + hd) * 16384 + row * 128 + c16 * 8); }
                __syncthreads();
                peer_select32(hd, tg * 256 + cc.wave * 32, cc.lane, WSP(bf16, WS_QPEER), cc.lds, cc.lds + 128 * PK_KS, w, (LAS unsigned*)(cc.lds + 2 * 128 * PK_KS + cc.wave * 4096));
                __syncthreads(); } }
        }
        SEAM(pb + 9);
        if (IN(pb + 10)) { PH_BEGIN
            const SliceSched SS = slice_sched_init(cc, (unsigned*)(w + WS_CTL), bar, l * 2 + 0);
            RLOOP(10, true) { RSYNC;
            for (int i = 0;; ++i) { int sl, tb; if (!slice_item(SS, cc, i, sl, tb)) break;
                peer_sddmm_wave(tb * 64 + cc.wave * 8, sl, cc.lane, WSP(bf16, WS_H), WSP(unsigned char, WS_U), WSP(int, WS_SEL), WSP(float, WS_PART), (LAS unsigned*)(cc.lds + 4096 + cc.wave * 8192)); } }
        }
        SEAM(pb + 10);
        if (IN(pb + 11)) { PH_BEGIN
            for (int n = cc.gw; n < NTOK / 4; n += cc.NGW) peer_coef_tokens4(n, NTOK / 4, cc.lane, WSP(float, WS_PART), WSP(int, WS_SEL), WSP(float, WS_SEL + 8 * MiB), WSP(float, WS_SELS), WSP(float, WS_US), WSP(float, WS_VS));
        }
        SEAM(pb + 11);
        if (IN(pb + 12)) { PH_BEGIN
            float* xo = l == 0 ? WSP(float, WS_X2) : outp;
            const SliceSched SS = slice_sched_init(cc, (unsigned*)(w + WS_CTL), bar, l * 2 + 1);
#ifndef REP_MODE
#define REP_MODE 0
#endif
            RLOOP(12, l == 0) { RSYNC;
            if (REP_MODE && rp_) {
            for (int i = 0;; ++i) { int sl, tb; if (!slice_item8(SS, cc, i, sl, tb)) break;
                peer_spmm6_wave<REP_MODE>(tb * 64 + cc.wave * 8, sl, cc.lane, WSP(unsigned char, WS_V), WSP(int, WS_SEL), WSP(float, WS_SEL + 8 * MiB), outp, WSP(float, WS_SEG + 64 * MiB), (LAS unsigned*)(cc.lds + 4096 + cc.wave * 8192)); }
            } else
            for (int i = 0;; ++i) { int sl, tb; if (!slice_item8(SS, cc, i, sl, tb)) break;
                peer_spmm6_wave(tb * 64 + cc.wave * 8, sl, cc.lane, WSP(unsigned char, WS_V), WSP(int, WS_SEL), WSP(float, WS_SEL + 8 * MiB), outp, xo, (LAS unsigned*)(cc.lds + 4096 + cc.wave * 8192)); } }
        }
        SEAM(pb + 12);
    }
#undef PH_BEGIN
#undef INP
#undef WSP
#undef IN
#undef SEAM
}

#ifndef MK_SPLIT
#define MK_SPLIT 0
#endif
extern "C" void kernel_launch(void* const* d_in, const int* in_sizes, int n_in, void* d_out, int out_size, void* d_ws, size_t ws_size, hipStream_t stream) {
    static int grid = 0;
    if (grid == 0) {
        if (n_in != 21 || out_size != NTOK * DM || ws_size < WS_END) { fprintf(stderr, "kernel_launch: unexpected shapes (n_in %d, out %d, ws %zu < %zu); nothing launched\n", n_in, out_size, ws_size, (size_t)WS_END); grid = -1; return; }
        int dev = 0, cus = 0, per_cu = 0;
        if (hipGetDevice(&dev) != hipSuccess || hipDeviceGetAttribute(&cus, hipDeviceAttributeMultiprocessorCount, dev) != hipSuccess) { grid = -1; return; }
        if (hipFuncSetAttribute((const void*)mk_fwd, hipFuncAttributeMaxDynamicSharedMemorySize, LDS_BYTES) != hipSuccess) { fprintf(stderr, "kernel_launch: hipFuncSetAttribute failed\n"); grid = -1; return; }
        if (hipOccupancyMaxActiveBlocksPerMultiprocessor(&per_cu, (const void*)mk_fwd, 512, LDS_BYTES) != hipSuccess || per_cu < 1) fprintf(stderr, "kernel_launch: occupancy query reports %d\n", per_cu);
        (void)hipGetLastError();
        grid = cus;
    }
    if (grid < 0) return;
    if (hipMemsetAsync((char*)d_ws + WS_CTL, 0, 1 * MiB, stream) != hipSuccess) { fprintf(stderr, "kernel_launch: memset failed\n"); return; }
    Args a{};
    for (int i = 0; i < 21; ++i) a.in[i] = (const float*)d_in[i];
    a.out = (float*)d_out; a.ws = (unsigned char*)d_ws; a.pad = 0;
#if MK_SPLIT
    for (int p = 0; p < NPHASES; ++p) { a.lo = p; a.hi = p + 1; a.li = p; hipLaunchKernelGGL(mk_fwd, dim3(grid), dim3(512), LDS_BYTES, stream, a); }
#else
    a.lo = 0; a.hi = NPHASES; a.li = 0;
    hipLaunchKernelGGL(mk_fwd, dim3(grid), dim3(512), LDS_BYTES, stream, a);
#endif
    const hipError_t le = hipPeekAtLastError();
    if (le != hipSuccess) fprintf(stderr, "kernel_launch: launch failed: %s\n", hipGetErrorName(le));
}
```

```cpp
#include <hip/hip_runtime.h>
#include <cstdio>
#include <cstdint>
namespace pg8 {
#define PG8_LAS __attribute__((address_space(3)))
typedef unsigned short bf16_t;
typedef short bf16x8 __attribute__((ext_vector_type(8)));
typedef float f32x4 __attribute__((ext_vector_type(4)));
typedef unsigned u32x4 __attribute__((ext_vector_type(4)));
constexpr int BM = 256, BK = 64, HALF = 128, HTB = HALF * BK * 2  , STAGE_BYTES = 8 * HTB, NXCD = 8, WGM = 8;

__host__ __device__ __forceinline__ int lds_byte(int r, int c) { const int st = (r >> 4) * 2 + (c >> 5), rr = r & 15, cc = c & 31, ob = rr * 64 + cc * 2; return st * 1024 + (ob ^ (((ob >> 9) & 1) << 5)); }
__host__ __device__ __forceinline__ void stage_rc(int b, int& R, int& C) { const int st = b / 1024, sb = b % 1024, swz = sb ^ (((sb >> 9) & 1) << 5); R = (st >> 1) * 16 + swz / 64; C = (st & 1) * 32 + (swz % 64) / 2; }
__host__ __device__ __forceinline__ int perm32(int rho) { const int n = rho >> 4, i = rho & 15; return 8 * (i >> 2) + 4 * n + (i & 3); }

struct Unit { int pm, pn; };
struct Gemm { const bf16_t* A; const bf16_t* Bt; int M, N, K; };

struct StaticOrder {
    int nM, nN, nwg, G, c;
    __host__ __device__ void init(int M, int N, int G_, int c_) { nM = M / BM; nN = N / BM; nwg = nM * nN; G = G_; c = c_; }
    __host__ __device__ bool next(int i, Unit& u) const {
        const long L = (long)i * G + c; if (L >= nwg) return false;
        int wgid = (int)L; { const int q = nwg / NXCD, r = nwg % NXCD, xcd = wgid % NXCD, off = wgid / NXCD; wgid = (xcd < r ? xcd * (q + 1) : r * (q + 1) + (xcd - r) * q) + off; }
        const int nig = WGM * nN, gid = wgid / nig, fm = gid * WGM, gsz = (nM - fm) < WGM ? (nM - fm) : WGM;
        u.pm = fm + ((wgid % nig) % gsz); u.pn = (wgid % nig) / gsz; return true;
    }
    __device__ __forceinline__ void a_ready(const Unit&) const {}
    __device__ __forceinline__ void done(const Unit&) const {}
};

typedef float f32x2 __attribute__((ext_vector_type(2)));
template <class Epi, class Sched, bool ALIGN_EPI = false, bool SP2 = false, bool I8 = false>
__device__ __forceinline__ void gemm_phase(PG8_LAS unsigned char* lds, const Gemm g, const Sched& S, const Epi& E, int wave_) {
    unsigned z_ = 0u; asm volatile("" : "+s"(z_)); int tid_ = wave_ * 64 + (int)__builtin_amdgcn_mbcnt_hi(~0u, __builtin_amdgcn_mbcnt_lo(~0u, z_)); asm volatile("" : "+v"(tid_));     int K_ = g.K; asm volatile("" : "+s"(K_));
    const int tid = tid_, wid = __builtin_amdgcn_readfirstlane(tid >> 6), lane = tid & 63, wr = wid >> 2, wc = wid & 3, fr = lane & 15, fq = lane >> 4;
    const int K = I8 ? (K_ >> 1) : K_, nt = K / BK;
    unsigned voffA[2], voffB[2];
#pragma unroll
    for (int i = 0; i < 2; ++i) { int R, C; stage_rc(tid * 16 + i * 8192, R, C); const int Rb = Epi::PERM ? ((R & ~31) + perm32(R & 31)) : R;
        voffA[i] = (unsigned)(R * K + C) * 2u; voffB[i] = (unsigned)(Rb * K + C) * 2u; }
    const size_t kstep = (size_t)(BK * 2);
    const size_t hstep = (size_t)HALF * K * 2;
    const size_t tstep = 2 * hstep;
    const unsigned ldsw = (unsigned)wid * 1024u;
    const int aoff = lds_byte(wr * 64 + fr, fq * 8), boff = lds_byte(wc * 32 + fr, fq * 8);
#define PG8_SA(b, h) (((b) * 2 + (h)) * HTB)
#define PG8_SB(b, h) ((4 + (b) * 2 + (h)) * HTB)
#define PG8_STAGE(bufoff, gbase, voff) do { _Pragma("unroll") for (int _i = 0; _i < 2; ++_i) \
        __builtin_amdgcn_global_load_lds((const unsigned*)((const char*)(gbase) + (voff)[_i]), (PG8_LAS unsigned*)(lds + (bufoff) + ldsw + _i * 8192), 16, 0, 0); } while (0)
#define PG8_LDA(dst, b, h) do { _Pragma("unroll") for (int m = 0; m < 4; ++m) _Pragma("unroll") for (int k = 0; k < 2; ++k) dst[m][k] = *(const PG8_LAS bf16x8*)(lds + PG8_SA(b, h) + aoff + m * 2048 + k * 1024); } while (0)
#define PG8_LDB(dst, b, h) do { _Pragma("unroll") for (int n = 0; n < 2; ++n) _Pragma("unroll") for (int k = 0; k < 2; ++k) dst[n][k] = *(const PG8_LAS bf16x8*)(lds + PG8_SB(b, h) + boff + n * 2048 + k * 1024); } while (0)
#define PG8_MMA(ai, bj, At, Bt) do { __builtin_amdgcn_s_setprio(1); _Pragma("unroll") for (int m = 0; m < 4; ++m) _Pragma("unroll") for (int n = 0; n < 2; ++n) _Pragma("unroll") for (int k = 0; k < 2; ++k) { \
        if constexpr (I8) { typedef int v4i_t __attribute__((ext_vector_type(4))); \
            acc[ai][bj][m][n] = __builtin_bit_cast(f32x4, __builtin_amdgcn_mfma_i32_16x16x64_i8(__builtin_bit_cast(v4i_t, Bt[n][k]), __builtin_bit_cast(v4i_t, At[m][k]), __builtin_bit_cast(v4i_t, acc[ai][bj][m][n]), 0, 0, 0)); } \
        else acc[ai][bj][m][n] = __builtin_amdgcn_mfma_f32_16x16x32_bf16(Bt[n][k], At[m][k], acc[ai][bj][m][n], 0, 0, 0); } __builtin_amdgcn_s_setprio(0); } while (0)
#define PG8_WAIT_V(n) asm volatile("s_waitcnt vmcnt(" #n ")" ::: "memory")
#define PG8_WAIT_L(n) asm volatile("s_waitcnt lgkmcnt(" #n ")" ::: "memory")
#define PG8_BAR __builtin_amdgcn_s_barrier()
#define PG8_SCHED __builtin_amdgcn_sched_barrier(0)
    Unit cur, nxt; int ui = 0;
    if (!S.next(0, cur)) return;
    f32x4 acc[2][2][4][2];
#pragma unroll
    for (int a = 0; a < 2; ++a)
#pragma unroll
        for (int b = 0; b < 2; ++b)
#pragma unroll
            for (int m = 0; m < 4; ++m)
#pragma unroll
                for (int n = 0; n < 2; ++n) acc[a][b][m][n] = (f32x4){0.f, 0.f, 0.f, 0.f};
    bf16x8 At[4][2], B0[2][2], B1[2][2];
    const char* cA = (const char*)g.A + (size_t)cur.pm * tstep; const char* cB = (const char*)g.Bt + (size_t)cur.pn * tstep;
    S.a_ready(cur);
    if constexpr (SP2) {
        PG8_STAGE(PG8_SB(0, 0), cB, voffB); PG8_STAGE(PG8_SB(0, 1), cB + hstep, voffB); PG8_STAGE(PG8_SA(0, 0), cA, voffA); PG8_STAGE(PG8_SA(0, 1), cA + hstep, voffA);
        if (wr == 1) PG8_BAR;
        PG8_WAIT_V(2); PG8_BAR;
        PG8_STAGE(PG8_SB(1, 0), cB + kstep, voffB); PG8_STAGE(PG8_SA(1, 0), cA + kstep, voffA); PG8_STAGE(PG8_SB(1, 1), cB + hstep + kstep, voffB);
        PG8_WAIT_V(6); PG8_BAR;
    } else {
        PG8_STAGE(PG8_SB(0, 0), cB, voffB); PG8_STAGE(PG8_SA(0, 0), cA, voffA); PG8_STAGE(PG8_SB(0, 1), cB + hstep, voffB); PG8_STAGE(PG8_SA(0, 1), cA + hstep, voffA);
        if (wr == 1) PG8_BAR;
        PG8_WAIT_V(4); PG8_BAR;
        PG8_STAGE(PG8_SB(1, 0), cB + kstep, voffB); PG8_STAGE(PG8_SA(1, 0), cA + kstep, voffA); PG8_STAGE(PG8_SB(1, 1), cB + hstep + kstep, voffB);
        PG8_WAIT_V(6); PG8_BAR;
    }
    for (;;) {
        const bool has_next = S.next(ui + 1, nxt);
        const char* nA = has_next ? (const char*)g.A + (size_t)nxt.pm * tstep : cA; const char* nB = has_next ? (const char*)g.Bt + (size_t)nxt.pn * tstep : cB;
        for (int t = 0; t < nt; t += 2) {
            const bool last = (t == nt - 2);
            const char* a1 = cA + (size_t)(t + 1) * kstep;
            const char* a2 = last ? nA : cA + (size_t)(t + 2) * kstep; const char* b2 = last ? nB : cB + (size_t)(t + 2) * kstep;
            const char* a3 = a2 + kstep; const char* b3 = b2 + kstep;
            if (last && has_next) S.a_ready(nxt);
            if constexpr (SP2) {
            PG8_LDB(B0, 0, 0); PG8_LDB(B1, 0, 1); PG8_SCHED; PG8_LDA(At, 0, 0); PG8_STAGE(PG8_SA(1, 1), a1 + hstep, voffA);
            PG8_WAIT_V(8); PG8_WAIT_L(0); PG8_BAR; PG8_MMA(0, 0, At, B0); PG8_MMA(0, 1, At, B1); PG8_BAR; PG8_SCHED;
            PG8_LDA(At, 0, 1); PG8_STAGE(PG8_SB(0, 0), b2, voffB); PG8_STAGE(PG8_SB(0, 1), b2 + hstep, voffB); PG8_STAGE(PG8_SA(0, 0), a2, voffA);
            PG8_WAIT_V(8); PG8_WAIT_L(0); PG8_BAR; PG8_MMA(1, 0, At, B0); PG8_MMA(1, 1, At, B1); PG8_BAR; PG8_SCHED;
            PG8_LDB(B0, 1, 0); PG8_LDB(B1, 1, 1); PG8_SCHED; PG8_LDA(At, 1, 0); PG8_STAGE(PG8_SA(0, 1), a2 + hstep, voffA);
            PG8_WAIT_V(8); PG8_WAIT_L(0); PG8_BAR; PG8_MMA(0, 0, At, B0); PG8_MMA(0, 1, At, B1); PG8_BAR; PG8_SCHED;
            PG8_LDA(At, 1, 1); PG8_STAGE(PG8_SB(1, 0), b3, voffB); PG8_STAGE(PG8_SB(1, 1), b3 + hstep, voffB); PG8_STAGE(PG8_SA(1, 0), a3, voffA);
            PG8_WAIT_V(8); PG8_WAIT_L(0); PG8_BAR; PG8_MMA(1, 0, At, B0); PG8_MMA(1, 1, At, B1); PG8_BAR; PG8_SCHED;
            } else {
            PG8_LDB(B0, 0, 0); PG8_SCHED; PG8_LDA(At, 0, 0); PG8_STAGE(PG8_SA(1, 1), a1 + hstep, voffA);
            PG8_WAIT_L(8); PG8_BAR; PG8_WAIT_L(0); PG8_MMA(0, 0, At, B0); PG8_BAR; PG8_SCHED;
            PG8_LDB(B1, 0, 1); PG8_STAGE(PG8_SB(0, 0), b2, voffB);
            PG8_BAR; PG8_WAIT_L(0); PG8_MMA(0, 1, At, B1); PG8_BAR;
            PG8_LDA(At, 0, 1); PG8_STAGE(PG8_SA(0, 0), a2, voffA);
            PG8_BAR; PG8_WAIT_L(0); PG8_MMA(1, 0, At, B0); PG8_BAR; PG8_SCHED;
            PG8_STAGE(PG8_SB(0, 1), b2 + hstep, voffB);
            PG8_WAIT_V(6); PG8_BAR; PG8_MMA(1, 1, At, B1); PG8_BAR;
            PG8_LDB(B0, 1, 0); PG8_SCHED; PG8_LDA(At, 1, 0); PG8_STAGE(PG8_SA(0, 1), a2 + hstep, voffA);
            PG8_WAIT_L(8); PG8_BAR; PG8_WAIT_L(0); PG8_MMA(0, 0, At, B0); PG8_BAR; PG8_SCHED;
            PG8_LDB(B1, 1, 1); PG8_STAGE(PG8_SB(1, 0), b3, voffB);
            PG8_BAR; PG8_WAIT_L(0); PG8_MMA(0, 1, At, B1); PG8_BAR;
            PG8_LDA(At, 1, 1); PG8_STAGE(PG8_SA(1, 0), a3, voffA);
            PG8_BAR; PG8_WAIT_L(0); PG8_MMA(1, 0, At, B0); PG8_BAR; PG8_SCHED;
            PG8_STAGE(PG8_SB(1, 1), b3 + hstep, voffB);
            PG8_WAIT_V(6); PG8_BAR; PG8_MMA(1, 1, At, B1); PG8_BAR;
            }
        }
        if constexpr (ALIGN_EPI) { if (wr == 0) PG8_BAR; }
        if constexpr (I8) {
#pragma unroll
            for (int a = 0; a < 2; ++a)
#pragma unroll
                for (int m = 0; m < 4; ++m) { const float r_ = E.rowscale(cur.pm * BM + wr * 64 + fr + a * HALF + m * 16);
#pragma unroll
                    for (int b = 0; b < 2; ++b)
#pragma unroll
                        for (int n = 0; n < 2; ++n) { typedef int v4i2_t __attribute__((ext_vector_type(4))); const v4i2_t i_ = __builtin_bit_cast(v4i2_t, acc[a][b][m][n]);
                            acc[a][b][m][n] = (f32x4){(float)i_[0] * r_, (float)i_[1] * r_, (float)i_[2] * r_, (float)i_[3] * r_}; } }
        }
        if constexpr (!Epi::AFTER_DRAIN) { E(acc, cur, wr, wc, fr, fq); S.done(cur); }
        if (!has_next) break;
#pragma unroll
        for (int a = 0; a < 2; ++a)
#pragma unroll
            for (int b = 0; b < 2; ++b)
#pragma unroll
                for (int m = 0; m < 4; ++m)
#pragma unroll
                    for (int n = 0; n < 2; ++n) acc[a][b][m][n] = (f32x4){0.f, 0.f, 0.f, 0.f};
        cur = nxt; cA = nA; cB = nB; ++ui;
        if constexpr (ALIGN_EPI) { if (wr == 1) PG8_BAR; }
    }
    PG8_WAIT_V(0);
    if constexpr (!ALIGN_EPI) { if (wr == 0) PG8_BAR; }
    PG8_BAR;
    if constexpr (Epi::AFTER_DRAIN) { E.fused(acc, cur, wr, wc, fr, fq, lds, wid, lane); S.done(cur); }
#undef PG8_SA
#undef PG8_SB
#undef PG8_STAGE
#undef PG8_LDA
#undef PG8_LDB
#undef PG8_MMA
#undef PG8_WAIT_V
#undef PG8_WAIT_L
#undef PG8_BAR
#undef PG8_SCHED
}
}
#define XB_TMO      128
#define XB_XCNT(j)  (256  + 64 * (j))
#define XB_XSUB(j)  (1280 + 64 * (j))
#define XB_XGEN(j)  (2304 + 64 * (j))
#define XB_TOP      3328
#define XB_TOPGEN   3392
#define XCD_BAR_WORDS 3456
#define XB_SPIN_CAP (1u << 24)
#define LAS __attribute__((address_space(3)))

__device__ __forceinline__ unsigned xb_ld(unsigned* p)              { return __hip_atomic_load(p, __ATOMIC_RELAXED, __HIP_MEMORY_SCOPE_AGENT); }
__device__ __forceinline__ unsigned xb_add(unsigned* p, unsigned v) { return __hip_atomic_fetch_add(p, v, __ATOMIC_RELAXED, __HIP_MEMORY_SCOPE_AGENT); }
__device__ __forceinline__ unsigned xb_xcc_id() { return (unsigned)__builtin_amdgcn_s_getreg((3 << 11) | 20) & 0xFu; }
#define XB_SPIN(cond, bar) do { unsigned _sp = 0; while (cond) { __builtin_amdgcn_s_sleep(1); \
    if ((++_sp & 255u) == 0u) { if (xb_ld(&(bar)[XB_TMO])) break; if (_sp > XB_SPIN_CAP) { atomicAdd(&(bar)[XB_TMO], 1u); break; } } } } while (0)

__device__ __forceinline__ int xb_lane_id() { unsigned z = 0u; asm volatile("" : "+s"(z)); return (int)__builtin_amdgcn_mbcnt_hi(~0u, __builtin_amdgcn_mbcnt_lo(~0u, z)); }
struct XcdBarrier {
    unsigned w0;
    unsigned* bar; unsigned x;
    volatile LAS unsigned* st;
};

__device__ __forceinline__ XcdBarrier xcd_barrier_post(unsigned* bar, volatile LAS unsigned* st) {
    XcdBarrier b; b.bar = bar; b.x = xb_xcc_id(); b.st = st; b.w0 = (__builtin_amdgcn_readfirstlane((int)threadIdx.x >> 6) == 0) ? 1u : 0u;
    if (b.w0 && xb_lane_id() == 0) (void)xb_add(&bar[XB_XCNT(b.x)], 1u);
    return b;
}
__device__ __forceinline__ void xcd_barrier_complete(unsigned* bar, unsigned x, unsigned& nloc, unsigned& nx) {
    const unsigned G = gridDim.x * gridDim.y * gridDim.z;
    unsigned sum, cnt, mine, sp = 0u;
    for (;;) {
        sum = 0u; cnt = 0u; mine = 0u;
#pragma unroll
        for (unsigned j = 0; j < 16; ++j) { const unsigned c = xb_ld(&bar[XB_XCNT(j)]); sum += c; cnt += (c > 0u) ? 1u : 0u; mine = (j == x) ? c : mine; }
        if (sum == G) break;
        __builtin_amdgcn_s_sleep(1);
        if ((++sp & 255u) == 0u) { if (xb_ld(&bar[XB_TMO])) break; if (sp > XB_SPIN_CAP) { atomicAdd(&bar[XB_TMO], 1u); break; } }
    }
    nloc = mine > 0u ? mine : 1u; nx = cnt > 0u ? cnt : 1u;
}

__device__ __forceinline__ void xcd_barrier(const XcdBarrier& b) {
    asm volatile("s_waitcnt vmcnt(0)" ::: "memory");
    __syncthreads();
    if (b.w0 && xb_lane_id() == 0) {
        unsigned* bar = b.bar;
        __builtin_amdgcn_s_waitcnt(0);
        unsigned nloc = b.st[0], nx = b.st[1];
        if (nloc == 0u) { xcd_barrier_complete(bar, b.x, nloc, nx); b.st[0] = nloc; b.st[1] = nx; }
        const unsigned old = xb_add(&bar[XB_XSUB(b.x)], 1u);
        const unsigned gen = old / nloc;
        if (old + 1u == (gen + 1u) * nloc) {
            __builtin_amdgcn_fence(__ATOMIC_RELEASE, "agent");
            asm volatile("s_waitcnt vmcnt(0)" ::: "memory");
            const unsigned og = xb_add(&bar[XB_TOP], 1u);
            const unsigned tg = og / nx;
            if (og + 1u == (tg + 1u) * nx) xb_add(&bar[XB_TOPGEN], 1u);
            else XB_SPIN(xb_ld(&bar[XB_TOPGEN]) == tg, bar);
            __builtin_amdgcn_fence(__ATOMIC_ACQUIRE, "agent");
            xb_add(&bar[XB_XGEN(b.x)], 1u);
            asm volatile("s_waitcnt vmcnt(0)" ::: "memory");
        } else {
            XB_SPIN(xb_ld(&bar[XB_XGEN(b.x)]) == gen, bar);
            __builtin_amdgcn_fence(__ATOMIC_ACQUIRE, "agent");
            asm volatile("s_waitcnt vmcnt(0)" ::: "memory");
        }
    }
    __syncthreads();
}


#define GAS __attribute__((address_space(1)))
typedef unsigned short bf16;
typedef unsigned v4u __attribute__((ext_vector_type(4)));
typedef unsigned v2u __attribute__((ext_vector_type(2)));
typedef float f32x4 __attribute__((ext_vector_type(4)));
typedef float f32x2v __attribute__((ext_vector_type(2)));
typedef float f32x16 __attribute__((ext_vector_type(16)));
typedef short bf16x8 __attribute__((ext_vector_type(8)));
typedef __bf16 bf16v2 __attribute__((ext_vector_type(2)));
typedef _Float16 h2_t __attribute__((ext_vector_type(2)));
typedef _Float16 v32h_t __attribute__((ext_vector_type(32)));
typedef unsigned v6u __attribute__((ext_vector_type(6)));

constexpr int NTOK = 16384, DM = 2048, SEQ = 4096, INW = 15360, BW = 1024;
constexpr float EPS = 1e-6f;
constexpr float WIN_QS = 1024.0f;
constexpr int NPH = 13;
constexpr int NPHASES = 2 * NPH;

constexpr size_t MiB = 1u << 20;
constexpr size_t WS_CTL = 0;
constexpr size_t WS_LB = 1 * MiB;
constexpr size_t WS_SA = 1 * MiB + 192 * 1024;
constexpr size_t WS_US = 1 * MiB + 64 * 1024, WS_VS = 1 * MiB + 128 * 1024;
constexpr size_t WS_WIN = 2 * MiB;
constexpr size_t WS_WBR = 62 * MiB;
constexpr size_t WS_WO = 74 * MiB;
constexpr size_t WS_WQ = 82 * MiB;
constexpr size_t WS_U = 91 * MiB;
constexpr size_t WS_V = 155 * MiB;
constexpr size_t WS_H = 219 * MiB;
constexpr size_t WS_SEG = 283 * MiB;
constexpr size_t WS_GATE = 539 * MiB;
constexpr size_t WS_X2 = 731 * MiB;
constexpr size_t WS_CONV = 859 * MiB;
constexpr size_t WS_HGR = 891 * MiB;
constexpr size_t WS_MERGED = 923 * MiB;
constexpr size_t WS_SEL = 987 * MiB;
constexpr size_t WS_SELS = 1003 * MiB;
constexpr size_t WS_DEC = 1004 * MiB;
constexpr size_t WS_END = 1005 * MiB;
constexpr size_t WS_ST = WS_H;
constexpr size_t WS_KEYS = 90 * MiB;
constexpr size_t WS_PART = WS_GATE;
constexpr size_t WS_QPEER = WS_SEG;
constexpr size_t SEGSZ = (size_t)NTOK * 1024;
constexpr int CW_BAR = 4096;
constexpr int CW_RANK = 131072;

constexpr int RING_BYTES = 131072, MISC_OFF = RING_BYTES + 320, LDS_BYTES = 147456;

__device__ __forceinline__ unsigned pk2c(float lo, float hi) { f32x2v v = {lo, hi}; bf16v2 b = __builtin_convertvector(v, bf16v2); return __builtin_bit_cast(unsigned, b); }
__device__ __forceinline__ float bflo(unsigned x) { return __uint_as_float(x << 16); }
__device__ __forceinline__ float bfhi(unsigned x) { return __uint_as_float(x & 0xffff0000u); }
__device__ __forceinline__ float sigm(float x) { return __builtin_amdgcn_rcpf(1.0f + __expf(-x)); }
__device__ __forceinline__ float wave_sum(float v) {
#pragma unroll
    for (int o = 1; o < 64; o <<= 1) v += __shfl_xor(v, o);
    return v;
}
__device__ __forceinline__ float wave_max(float v) {
#pragma unroll
    for (int o = 1; o < 64; o <<= 1) v = fmaxf(v, __shfl_xor(v, o));
    return v;
}
#define LDS_WAIT() asm volatile("s_waitcnt lgkmcnt(0)" ::: "memory")
#define MFMA32(a, b, c) __builtin_amdgcn_mfma_f32_32x32x16_bf16((a), (b), (c), 0, 0, 0)
__device__ __forceinline__ int ridx16(int lane) { return ((lane >> 5) & 1) * 8 + ((lane >> 4) & 1) * 4 + ((lane >> 3) & 1) * 2 + ((lane >> 2) & 1); }
__device__ __forceinline__ void xreduce16(float (&v)[16], int lane) {
#pragma unroll
    for (int i = 0; i < 8; ++i) { const bool up = (lane & 32) != 0; const float snd = up ? v[i] : v[i + 8], kp = up ? v[i + 8] : v[i]; v[i] = kp + __shfl_xor(snd, 32); }
#pragma unroll
    for (int i = 0; i < 4; ++i) { const bool up = (lane & 16) != 0; const float snd = up ? v[i] : v[i + 4], kp = up ? v[i + 4] : v[i]; v[i] = kp + __shfl_xor(snd, 16); }
#pragma unroll
    for (int i = 0; i < 2; ++i) { const bool up = (lane & 8) != 0; const float snd = up ? v[i] : v[i + 2], kp = up ? v[i + 2] : v[i]; v[i] = kp + __shfl_xor(snd, 8); }
    { const bool up = (lane & 4) != 0; const float snd = up ? v[0] : v[1], kp = up ? v[1] : v[0]; v[0] = kp + __shfl_xor(snd, 4); }
    v[0] += __shfl_xor(v[0], 2); v[0] += __shfl_xor(v[0], 1);
}
__device__ __forceinline__ float gelu_exact(float v) {
    const float av = fabsf(v), t = __builtin_amdgcn_rcpf(av * 0.2316418882f + 1.0f);
    float q = t * 0.5307027145f + (-0.7265760135f); q = q * t + 0.7107068705f; q = q * t + (-0.142248368f); q = q * t + 0.127414796f; q = q * t;
    const float e = __builtin_amdgcn_exp2f((v * v) * (-0.72134752044f));
    const float m = v * (q * e);
    return v < 0.f ? m : v - m;
}

struct Ctx { LAS unsigned char* lds; int tid, lane, wave, G, gw, NGW; };

__device__ __forceinline__ void tr_item(const float* W, int K, int N, bf16* WT, int k0, int n0, int drow0, LAS float* scr, int lane) {
    { const int lr = lane >> 3, lc = (lane & 7) * 4; f32x4 v[8];
#pragma unroll
      for (int j = 0; j < 8; ++j) v[j] = *(const GAS f32x4*)(W + (size_t)(k0 + lr + 8 * j) * N + n0 + lc);
#pragma unroll
      for (int j = 0; j < 8; ++j) { LAS float* d = scr + (lr + 8 * j) * 33 + lc; d[0] = v[j].x; d[1] = v[j].y; d[2] = v[j].z; d[3] = v[j].w; } }
    LDS_WAIT();
    const int c = lane & 7;
#pragma unroll
    for (int j = 0; j < 4; ++j) { const int n = (lane >> 3) + 8 * j; const LAS float* s = scr + (8 * c) * 33 + n;
        v4u o; o.x = pk2c(s[0], s[33]); o.y = pk2c(s[66], s[99]); o.z = pk2c(s[132], s[165]); o.w = pk2c(s[198], s[231]);
        *(GAS v4u*)(WT + (size_t)(drow0 + n) * K + k0 + 8 * c) = o; }
    LDS_WAIT();
}
__device__ __forceinline__ unsigned pack_i8x4c(float a, float b, float c, float d) {
    const int ia = (int)__builtin_rintf(fminf(fmaxf(a, -127.f), 127.f)), ib = (int)__builtin_rintf(fminf(fmaxf(b, -127.f), 127.f)), ic = (int)__builtin_rintf(fminf(fmaxf(c, -127.f), 127.f)), id = (int)__builtin_rintf(fminf(fmaxf(d, -127.f), 127.f));
    return ((unsigned)ia & 255u) | (((unsigned)ib & 255u) << 8) | (((unsigned)ic & 255u) << 16) | ((unsigned)id << 24);
}
__device__ __forceinline__ void tr_item_i8(const float* W, int K, int N, unsigned char* WT, int k0, int n0, int drow0, float scale, LAS float* scr, int lane) {
    { const int lr = lane >> 3, lc = (lane & 7) * 4; f32x4 v[16];
#pragma unroll
      for (int j = 0; j < 16; ++j) v[j] = *(const GAS f32x4*)(W + (size_t)(k0 + lr + 8 * j) * N + n0 + lc);
#pragma unroll
      for (int j = 0; j < 16; ++j) { LAS float* d = scr + (lr + 8 * j) * 32 + (lc ^ ((j & 7) << 2)); const int x = lr & 3; d[x] = v[j].x; d[1 ^ x] = v[j].y; d[2 ^ x] = v[j].z; d[3 ^ x] = v[j].w; } }
    LDS_WAIT();
    const int c = lane & 15;
#pragma unroll
    for (int j = 0; j < 8; ++j) { const int n = (lane >> 4) + 4 * j, q = n ^ ((c & 7) << 2); const LAS float* s = scr + (8 * c) * 32;
        v2u o; o.x = pack_i8x4c(s[q] * scale, s[32 + (q ^ 1)] * scale, s[64 + (q ^ 2)] * scale, s[96 + (q ^ 3)] * scale); o.y = pack_i8x4c(s[128 + q] * scale, s[160 + (q ^ 1)] * scale, s[192 + (q ^ 2)] * scale, s[224 + (q ^ 3)] * scale);
        *(GAS v2u*)(WT + (size_t)(drow0 + n) * K + k0 + 8 * c) = o; }
    LDS_WAIT();
}
__device__ __forceinline__ int win_drow(int n) { if (n < 7168 || n >= 9216) return n; const int r = n - 7168, isb = r >> 10, c = r & 1023; return 7168 + (c >> 7) * 256 + isb * 128 + (c & 127); }
__device__ __forceinline__ void cvt_copy(const Ctx& c, const float* src, bf16* dst, size_t n8) {
    const size_t NT = (size_t)c.G * 512;
    for (size_t i = (size_t)blockIdx.x * 512 + c.tid; i < n8; i += NT) {
        const f32x4 a = ((const GAS f32x4*)src)[2 * i], b = ((const GAS f32x4*)src)[2 * i + 1];
        v4u o; o.x = pk2c(a.x, a.y); o.y = pk2c(a.z, a.w); o.z = pk2c(b.x, b.y); o.w = pk2c(b.z, b.w);
        ((GAS v4u*)dst)[i] = o;
    }
}
__device__ __forceinline__ void rms_row(const float* xr, const float* w, bf16* o, int lane) {
    const GAS f32x4* xp = (const GAS f32x4*)xr + lane; f32x4 v[8]; float s = 0.f;
#pragma unroll
    for (int j = 0; j < 8; ++j) { v[j] = xp[64 * j]; s += (v[j].x * v[j].x + v[j].y * v[j].y) + (v[j].z * v[j].z + v[j].w * v[j].w); }
    const float r = __builtin_amdgcn_rsqf(wave_sum(s) * (1.0f / DM) + EPS);
    const GAS f32x4* wp = (const GAS f32x4*)w + lane; GAS v2u* op = (GAS v2u*)o + lane;
#pragma unroll
    for (int j = 0; j < 8; ++j) { const f32x4 wv = wp[64 * j]; v2u q; q.x = pk2c(v[j].x * r * wv.x, v[j].y * r * wv.y); q.y = pk2c(v[j].z * r * wv.z, v[j].w * r * wv.w); op[64 * j] = q; }
}
__device__ __forceinline__ void rms_row_i8(const float* xr, const float* w, unsigned char* o, float* sa, int lane) {
    const GAS f32x4* xp = (const GAS f32x4*)xr + lane; f32x4 v[8]; float s = 0.f;
#pragma unroll
    for (int j = 0; j < 8; ++j) { v[j] = xp[64 * j]; s += (v[j].x * v[j].x + v[j].y * v[j].y) + (v[j].z * v[j].z + v[j].w * v[j].w); }
    const float r = __builtin_amdgcn_rsqf(wave_sum(s) * (1.0f / DM) + EPS);
    const GAS f32x4* wp = (const GAS f32x4*)w + lane; float m = 0.f;
#pragma unroll
    for (int j = 0; j < 8; ++j) { const f32x4 wv = wp[64 * j]; v[j].x *= r * wv.x; v[j].y *= r * wv.y; v[j].z *= r * wv.z; v[j].w *= r * wv.w;
        m = fmaxf(fmaxf(m, fmaxf(fabsf(v[j].x), fabsf(v[j].y))), fmaxf(fabsf(v[j].z), fabsf(v[j].w))); }
    m = wave_max(m);
    const float inv = m > 0.f ? 127.0f / m : 0.f;
    if (lane == 0) *(GAS float*)sa = m * (1.0f / 127.0f);
#pragma unroll
    for (int j = 0; j < 8; ++j) ((GAS unsigned*)o)[lane + 64 * j] = pack_i8x4c(v[j].x * inv, v[j].y * inv, v[j].z * inv, v[j].w * inv);
}
__device__ __forceinline__ void rms_rows2_i8(const float* xa, const float* xb, const float* w, unsigned char* oa, unsigned char* ob, float* saa, float* sab, int lane) {
    const GAS f32x4* pa = (const GAS f32x4*)xa + lane; const GAS f32x4* pb = (const GAS f32x4*)xb + lane; f32x4 va[8], vb[8]; float s0 = 0.f, s1 = 0.f;
#pragma unroll
    for (int j = 0; j < 8; ++j) { va[j] = pa[64 * j]; vb[j] = pb[64 * j]; }
#pragma unroll
    for (int j = 0; j < 8; ++j) { s0 += (va[j].x * va[j].x + va[j].y * va[j].y) + (va[j].z * va[j].z + va[j].w * va[j].w); s1 += (vb[j].x * vb[j].x + vb[j].y * vb[j].y) + (vb[j].z * vb[j].z + vb[j].w * vb[j].w); }
#pragma unroll
    for (int o = 1; o < 64; o <<= 1) { s0 += __shfl_xor(s0, o); s1 += __shfl_xor(s1, o); }
    const float r0 = __builtin_amdgcn_rsqf(s0 * (1.0f / DM) + EPS), r1 = __builtin_amdgcn_rsqf(s1 * (1.0f / DM) + EPS);
    const GAS f32x4* wp = (const GAS f32x4*)w + lane; float m0 = 0.f, m1 = 0.f;
#pragma unroll
    for (int j = 0; j < 8; ++j) { const f32x4 wv = wp[64 * j];
        va[j].x *= r0 * wv.x; va[j].y *= r0 * wv.y; va[j].z *= r0 * wv.z; va[j].w *= r0 * wv.w; vb[j].x *= r1 * wv.x; vb[j].y *= r1 * wv.y; vb[j].z *= r1 * wv.z; vb[j].w *= r1 * wv.w;
        m0 = fmaxf(fmaxf(m0, fmaxf(fabsf(va[j].x), fabsf(va[j].y))), fmaxf(fabsf(va[j].z), fabsf(va[j].w))); m1 = fmaxf(fmaxf(m1, fmaxf(fabsf(vb[j].x), fabsf(vb[j].y))), fmaxf(fabsf(vb[j].z), fabsf(vb[j].w))); }
#pragma unroll
    for (int o = 1; o < 64; o <<= 1) { m0 = fmaxf(m0, __shfl_xor(m0, o)); m1 = fmaxf(m1, __shfl_xor(m1, o)); }
    const float i0 = m0 > 0.f ? 127.0f / m0 : 0.f, i1 = m1 > 0.f ? 127.0f / m1 : 0.f;
    if (lane == 0) { *(GAS float*)saa = m0 * (1.0f / 127.0f); *(GAS float*)sab = m1 * (1.0f / 127.0f); }
#pragma unroll
    for (int j = 0; j < 8; ++j) { ((GAS unsigned*)oa)[lane + 64 * j] = pack_i8x4c(va[j].x * i0, va[j].y * i0, va[j].z * i0, va[j].w * i0); ((GAS unsigned*)ob)[lane + 64 * j] = pack_i8x4c(vb[j].x * i1, vb[j].y * i1, vb[j].z * i1, vb[j].w * i1); }
}
__device__ __forceinline__ void rms_phase_i8(const Ctx& c, const float* x, const float* w, unsigned char* H8, float* SA) {
    for (int m = c.gw; m < NTOK / 2; m += c.NGW) rms_rows2_i8(x + (size_t)m * DM, x + (size_t)(m + NTOK / 2) * DM, w, H8 + (size_t)m * DM, H8 + (size_t)(m + NTOK / 2) * DM, SA + m, SA + m + NTOK / 2, c.lane);
}
__device__ __forceinline__ void rms_rows2(const float* xa, const float* xb, const float* w, bf16* oa, bf16* ob, int lane) {
    const GAS f32x4* pa = (const GAS f32x4*)xa + lane; const GAS f32x4* pb = (const GAS f32x4*)xb + lane; f32x4 va[8], vb[8]; float sa = 0.f, sb = 0.f;
#pragma unroll
    for (int j = 0; j < 8; ++j) { va[j] = pa[64 * j]; vb[j] = pb[64 * j]; }
#pragma unroll
    for (int j = 0; j < 8; ++j) { sa += (va[j].x * va[j].x + va[j].y * va[j].y) + (va[j].z * va[j].z + va[j].w * va[j].w); sb += (vb[j].x * vb[j].x + vb[j].y * vb[j].y) + (vb[j].z * vb[j].z + vb[j].w * vb[j].w); }
#pragma unroll
    for (int o = 1; o < 64; o <<= 1) { sa += __shfl_xor(sa, o); sb += __shfl_xor(sb, o); }
    const float ra = __builtin_amdgcn_rsqf(sa * (1.0f / DM) + EPS), rb = __builtin_amdgcn_rsqf(sb * (1.0f / DM) + EPS);
    const GAS f32x4* wp = (const GAS f32x4*)w + lane; GAS v2u* qa = (GAS v2u*)oa + lane; GAS v2u* qb = (GAS v2u*)ob + lane;
#pragma unroll
    for (int j = 0; j < 8; ++j) { const f32x4 wv = wp[64 * j];
        v2u q; q.x = pk2c(va[j].x * ra * wv.x, va[j].y * ra * wv.y); q.y = pk2c(va[j].z * ra * wv.z, va[j].w * ra * wv.w); qa[64 * j] = q;
        v2u p; p.x = pk2c(vb[j].x * rb * wv.x, vb[j].y * rb * wv.y); p.y = pk2c(vb[j].z * rb * wv.z, vb[j].w * rb * wv.w); qb[64 * j] = p; }
}
__device__ __forceinline__ void rms_phase(const Ctx& c, const float* x, const float* w, bf16* H) {
    for (int m = c.gw; m < NTOK / 2; m += c.NGW) rms_rows2(x + (size_t)m * DM, x + (size_t)(m + NTOK / 2) * DM, w, H + (size_t)m * DM, H + (size_t)(m + NTOK / 2) * DM, c.lane);
}
__device__ __forceinline__ void fp8_row(const float* src, unsigned char* dst, float* scale_out, int lane) {
    const GAS f32x4* xp = (const GAS f32x4*)src + lane; f32x4 v[8]; float m = 0.f;
#pragma unroll
    for (int j = 0; j < 8; ++j) { v[j] = xp[64 * j]; m = fmaxf(fmaxf(m, fmaxf(fabsf(v[j].x), fabsf(v[j].y))), fmaxf(fabsf(v[j].z), fabsf(v[j].w))); }
    m = wave_max(m);
    const float inv = m > 0.f ? 256.0f / m : 0.f;
    if (lane == 0) *(GAS float*)scale_out = m * (1.0f / 256.0f);
#pragma unroll
    for (int j = 0; j < 8; ++j) { int p = __builtin_amdgcn_cvt_pk_fp8_f32(v[j].x * inv, v[j].y * inv, 0, false); p = __builtin_amdgcn_cvt_pk_fp8_f32(v[j].z * inv, v[j].w * inv, p, true);
        ((GAS unsigned*)dst)[lane + 64 * j] = (unsigned)p; }
}
constexpr size_t U8_SLICE = (size_t)16384 * 128;
__device__ __forceinline__ unsigned pack_i8x4(float a, float b, float c, float d) {
    const int ia = (int)__builtin_rintf(a), ib = (int)__builtin_rintf(b), ic = (int)__builtin_rintf(c), id = (int)__builtin_rintf(d);
    return ((unsigned)ia & 255u) | (((unsigned)ib & 255u) << 8) | (((unsigned)ic & 255u) << 16) | ((unsigned)id << 24);
}
__device__ __forceinline__ void row_load_strided(const float* src, int lane, f32x4 (&v)[8]) { const GAS f32x4* xp = (const GAS f32x4*)src + lane;
#pragma unroll
    for (int j = 0; j < 8; ++j) v[j] = xp[64 * j]; }
__device__ __forceinline__ void row_load_contig(const float* src, int lane, f32x4 (&v)[8]) { const GAS f32x4* xp = (const GAS f32x4*)src + 8 * lane;
#pragma unroll
    for (int j = 0; j < 8; ++j) v[j] = xp[j]; }
__device__ __forceinline__ void i8_row(const f32x4 (&v)[8], unsigned char* dst, float* scale_out, int lane) {
    float m = 0.f;
#pragma unroll
    for (int j = 0; j < 8; ++j) m = fmaxf(fmaxf(m, fmaxf(fabsf(v[j].x), fabsf(v[j].y))), fmaxf(fabsf(v[j].z), fabsf(v[j].w)));
    m = wave_max(m);
    const float inv = m > 0.f ? 127.0f / m : 0.f;
    if (lane == 0) *(GAS float*)scale_out = m * (1.0f / 127.0f);
#pragma unroll
    for (int j = 0; j < 8; ++j) *(GAS unsigned*)(dst + (size_t)(2 * j + (lane >> 5)) * U8_SLICE + 4 * (lane & 31)) = pack_i8x4(v[j].x * inv, v[j].y * inv, v[j].z * inv, v[j].w * inv);
}
constexpr size_t V6_SLICE = (size_t)16384 * 192;
__device__ __forceinline__ void fp6_row(const f32x4 (&v)[8], unsigned char* dst, float* scale_out, int lane) {
    float m = 0.f;
#pragma unroll
    for (int j = 0; j < 8; ++j) m = fmaxf(fmaxf(m, fmaxf(fabsf(v[j].x), fabsf(v[j].y))), fmaxf(fabsf(v[j].z), fabsf(v[j].w)));
    m = wave_max(m);
    const float inv = m > 0.f ? 7.5f / m : 0.f;
    if (lane == 0) *(GAS float*)scale_out = m * (1.0f / 7.5f);
    v32h_t h;
#pragma unroll
    for (int j = 0; j < 8; ++j) { h[4 * j] = (_Float16)(v[j].x * inv); h[4 * j + 1] = (_Float16)(v[j].y * inv); h[4 * j + 2] = (_Float16)(v[j].z * inv); h[4 * j + 3] = (_Float16)(v[j].w * inv); }
    const v6u q = __builtin_amdgcn_cvt_scalef32_pk32_fp6_f16(h, 1.0f);
    GAS v2u* o = (GAS v2u*)(dst + (size_t)(lane >> 3) * V6_SLICE + 24 * (lane & 7));
    o[0] = (v2u){q[0], q[1]}; o[1] = (v2u){q[2], q[3]}; o[2] = (v2u){q[4], q[5]};
}
struct P0Args { const float *w_in, *w_br_sb, *w_br_hg, *w_br_conv, *w_o, *w_q, *u, *v, *lbp; bf16 *WinT, *WbrT, *WoT, *WqT; unsigned char *U, *V; float *US, *VS; float* LB; int layer; const float *k1, *k2; bf16* KB; };
__device__ __forceinline__ void p0_convert(const Ctx& c, const P0Args& a, int parts = 7) {
    LAS float* scr = (LAS float*)(c.lds + c.wave * 16384);
    constexpr int I_IN = (DM / 128) * (INW / 32), I_BR = (BW / 64) * (DM / 32), I_SQ = (DM / 64) * (DM / 32);
    constexpr int NITEMS = I_IN + 3 * I_BR + 2 * I_SQ;
    if (parts & 1)
    for (int it = c.gw; it < NITEMS; it += c.NGW) {
        int r = it;
        if (r < I_IN) { const int kb = r / (INW / 32), nb = r % (INW / 32); tr_item_i8(a.w_in, DM, INW, (unsigned char*)a.WinT, kb * 128, nb * 32, win_drow(nb * 32), WIN_QS, scr, c.lane); continue; } r -= I_IN;
        if (r < I_BR) { const int kb = r / (DM / 32), nb = r % (DM / 32); tr_item(a.w_br_sb, BW, DM, a.WbrT, kb * 64, nb * 32, nb * 32, scr, c.lane); continue; } r -= I_BR;
        if (r < I_BR) { const int kb = r / (DM / 32), nb = r % (DM / 32); tr_item(a.w_br_hg, BW, DM, a.WbrT + (size_t)DM * BW, kb * 64, nb * 32, nb * 32, scr, c.lane); continue; } r -= I_BR;
        if (r < I_BR) { const int kb = r / (DM / 32), nb = r % (DM / 32); tr_item(a.w_br_conv, BW, DM, a.WbrT + (size_t)2 * DM * BW, kb * 64, nb * 32, nb * 32, scr, c.lane); continue; } r -= I_BR;
        if (r < I_SQ) { const int kb = r / (DM / 32), nb = r % (DM / 32); tr_item(a.w_o, DM, DM, a.WoT, kb * 64, nb * 32, nb * 32, scr, c.lane); continue; } r -= I_SQ;
        { const int kb = r / (DM / 32), nb = r % (DM / 32); tr_item(a.w_q, DM, DM, a.WqT, kb * 64, nb * 32, nb * 32, scr, c.lane); }
    }
    if (parts & 2)
    {
    for (int r = c.gw; r < 16384; r += 2 * c.NGW) { const int r2 = r + c.NGW; f32x4 va[8], vb[8];
        row_load_strided(a.u + (size_t)r * 2048, c.lane, va); if (r2 < 16384) row_load_strided(a.u + (size_t)r2 * 2048, c.lane, vb);
        i8_row(va, a.U + (size_t)r * 128, a.US + r, c.lane); if (r2 < 16384) i8_row(vb, a.U + (size_t)r2 * 128, a.US + r2, c.lane); }
    for (int r = c.gw; r < 16384; r += 2 * c.NGW) { const int r2 = r + c.NGW; f32x4 va[8], vb[8];
        row_load_contig(a.v + (size_t)r * 2048, c.lane, va); if (r2 < 16384) row_load_contig(a.v + (size_t)r2 * 2048, c.lane, vb);
        fp6_row(va, a.V + (size_t)r * 192, a.VS + r, c.lane); if (r2 < 16384) fp6_row(vb, a.V + (size_t)r2 * 192, a.VS + r2, c.lane); }
    }
    if (parts & 4) {
    cvt_copy(c, a.k1, a.KB, (size_t)8 * 16384 / 8);
    cvt_copy(c, a.k2, a.KB + 8 * 16384, (size_t)8 * 16384 / 8); }
    if (blockIdx.x == 0) for (int i = c.tid; i < 1024; i += 512) a.LB[i] = a.layer == 0 ? 0.f : sigm(a.lbp[1024 + i] - a.lbp[i]);
}

struct EpiIn {
    static constexpr bool PERM = true, AFTER_DRAIN = false;
    bf16* seg; bf16* gate; const float* lb; const float* sa;
    __device__ __forceinline__ float rowscale(int row) const { return ((const GAS float*)sa)[row] * (1.0f / WIN_QS); }
    __device__ __forceinline__ void operator()(const pg8::f32x4 (&acc)[2][2][4][2], const pg8::Unit& u, int wr, int wc, int fr, int fq) const {
        const int pn = u.pn; const int row0 = u.pm * 256 + wr * 64 + fr;
        if (pn >= 28 && pn < 36) {
            bf16* dst = seg + (size_t)7 * SEGSZ; const int col0 = (pn - 28) * 128 + wc * 32 + 8 * fq;
#pragma unroll
            for (int ai = 0; ai < 2; ++ai)
#pragma unroll
                for (int m = 0; m < 4; ++m) {
                    const pg8::f32x4 a0 = acc[ai][0][m][0], a1 = acc[ai][0][m][1], b0 = acc[ai][1][m][0], b1 = acc[ai][1][m][1];
                    v4u w; w.x = pk2c(a0[0] * sigm(b0[0]), a0[1] * sigm(b0[1])); w.y = pk2c(a0[2] * sigm(b0[2]), a0[3] * sigm(b0[3]));
                    w.z = pk2c(a1[0] * sigm(b1[0]), a1[1] * sigm(b1[1])); w.w = pk2c(a1[2] * sigm(b1[2]), a1[3] * sigm(b1[3]));
                    *(GAS v4u*)(dst + (size_t)(row0 + ai * 128 + m * 16) * 1024 + col0) = w; }
            return;
        }
        bf16* dst; int ld, colt, mode;
        if (pn < 28) { const int sg = pn >> 2; dst = seg + (size_t)sg * SEGSZ; ld = 1024; colt = (pn & 3) * 256; mode = (sg == 4) ? 2 : (sg == 6 ? 1 : 0); }
        else { const int q = pn - 36; dst = gate + (size_t)(q >> 3) * ((size_t)NTOK * 2048); ld = 2048; colt = (q & 7) * 256; mode = 1; }
        const int col0 = colt + wc * 32 + 8 * fq;
        if (mode == 0) {
#pragma unroll
            for (int ai = 0; ai < 2; ++ai)
#pragma unroll
                for (int m = 0; m < 4; ++m)
#pragma unroll
                    for (int bj = 0; bj < 2; ++bj) { const pg8::f32x4 v0 = acc[ai][bj][m][0], v1 = acc[ai][bj][m][1];
                        v4u w; w.x = pk2c(v0[0], v0[1]); w.y = pk2c(v0[2], v0[3]); w.z = pk2c(v1[0], v1[1]); w.w = pk2c(v1[2], v1[3]);
                        *(GAS v4u*)(dst + (size_t)(row0 + ai * 128 + m * 16) * ld + col0 + bj * 128) = w; }
        } else if (mode == 1) {
#pragma unroll
            for (int ai = 0; ai < 2; ++ai)
#pragma unroll
                for (int m = 0; m < 4; ++m)
#pragma unroll
                    for (int bj = 0; bj < 2; ++bj) { const pg8::f32x4 v0 = acc[ai][bj][m][0], v1 = acc[ai][bj][m][1];
                        v4u w; w.x = pk2c(sigm(v0[0]), sigm(v0[1])); w.y = pk2c(sigm(v0[2]), sigm(v0[3])); w.z = pk2c(sigm(v1[0]), sigm(v1[1])); w.w = pk2c(sigm(v1[2]), sigm(v1[3]));
                        *(GAS v4u*)(dst + (size_t)(row0 + ai * 128 + m * 16) * ld + col0 + bj * 128) = w; }
        } else {
            f32x4 l0[2], l1[2];
#pragma unroll
            for (int bj = 0; bj < 2; ++bj) { l0[bj] = *(const GAS f32x4*)(lb + col0 + bj * 128); l1[bj] = *(const GAS f32x4*)(lb + col0 + bj * 128 + 4); }
#pragma unroll
            for (int ai = 0; ai < 2; ++ai)
#pragma unroll
                for (int m = 0; m < 4; ++m)
#pragma unroll
                    for (int bj = 0; bj < 2; ++bj) { const pg8::f32x4 v0 = acc[ai][bj][m][0], v1 = acc[ai][bj][m][1]; float r[8];
#pragma unroll
                        for (int j = 0; j < 4; ++j) { r[j] = __logf(l0[bj][j] + (1.0f - l0[bj][j]) * sigm(v0[j])); r[4 + j] = __logf(l1[bj][j] + (1.0f - l1[bj][j]) * sigm(v1[j])); }
                        v4u w; w.x = pk2c(r[0], r[1]); w.y = pk2c(r[2], r[3]); w.z = pk2c(r[4], r[5]); w.w = pk2c(r[6], r[7]);
                        *(GAS v4u*)(dst + (size_t)(row0 + ai * 128 + m * 16) * ld + col0 + bj * 128) = w; }
        }
    }
};

__device__ __forceinline__ void conv_phase(const Ctx& c, const bf16* glu, const float* cw, const float* cb, const float* lnw, const float* lnb, bf16* out) {
    const int c0 = 2 * c.tid;
    float w0[31], w1[31];
#pragma unroll
    for (int j = 0; j < 31; ++j) { const f32x2v t = *(const GAS f32x2v*)(cw + j * 1024 + c0); w0[j] = t.x; w1[j] = t.y; }
    const f32x2v bv = *(const GAS f32x2v*)(cb + c0), lwv = *(const GAS f32x2v*)(lnw + c0), lbv = *(const GAS f32x2v*)(lnb + c0);
    LAS float* red = (LAS float*)c.lds;
    for (int tile = blockIdx.x; tile < NTOK / 8; tile += c.G) {
        const int n0 = tile * 8, tseq0 = n0 & (SEQ - 1);
        float a0[8], a1[8];
#pragma unroll
        for (int t = 0; t < 8; ++t) { a0[t] = bv.x; a1[t] = bv.y; }
#pragma unroll
        for (int r = 0; r < 38; ++r) {
            unsigned xv = 0u;
            if (tseq0 + r - 30 >= 0) xv = *(const GAS unsigned*)(glu + (size_t)(n0 + r - 30) * 1024 + c0);
            const float x0 = bflo(xv), x1 = bfhi(xv);
#pragma unroll
            for (int t = 0; t < 8; ++t) { const int j = r - t; if (j >= 0 && j <= 30) { a0[t] += w0[j] * x0; a1[t] += w1[j] * x1; } }
        }
        float st[16];
#pragma unroll
        for (int t = 0; t < 8; ++t) { st[2 * t] = a0[t] + a1[t]; st[2 * t + 1] = a0[t] * a0[t] + a1[t] * a1[t]; }
        xreduce16(st, c.lane);
        if ((c.lane & 3) == 0) red[c.wave * 16 + ridx16(c.lane)] = st[0];
        __syncthreads();
        if (c.tid < 16) { float s = 0.f;
#pragma unroll
            for (int w = 0; w < 8; ++w) s += red[w * 16 + c.tid];
            red[128 + c.tid] = s; }
        __syncthreads();
#pragma unroll
        for (int t = 0; t < 8; ++t) {
            const float mean = red[128 + 2 * t] * (1.0f / 1024.0f), var = red[128 + 2 * t + 1] * (1.0f / 1024.0f) - mean * mean;
            const float rstd = __builtin_amdgcn_rsqf(var + EPS);
            const float h0 = (a0[t] - mean) * rstd * lwv.x + lbv.x, h1 = (a1[t] - mean) * rstd * lwv.y + lbv.y;
            *(GAS unsigned*)(out + (size_t)(n0 + t) * 1024 + c0) = pk2c(h0 * sigm(h0), h1 * sigm(h1));
        }
        __syncthreads();
    }
}
__device__ __forceinline__ void hgrn_task(int task, int lane, const bf16* qhg, const bf16* logf, const bf16* ihg, bf16* out) {
    const int bh = task >> 6, dvb = task & 63, b = bh >> 3, h = bh & 7;
    const size_t rb = (size_t)b * SEQ * 1024;
    const GAS unsigned* qp = (const GAS unsigned*)(qhg + rb + h * 128) + lane;
    const GAS unsigned* lp = (const GAS unsigned*)(logf + rb + h * 128) + lane;
    const GAS unsigned* ip = (const GAS unsigned*)(ihg + rb + h * 128) + dvb;
    GAS bf16* op = (GAS bf16*)(out + rb + h * 128 + 2 * dvb);
    float S00 = 0.f, S01 = 0.f, S10 = 0.f, S11 = 0.f;
    unsigned qn[8], ln[8], inx[8];
#pragma unroll
    for (int j = 0; j < 8; ++j) { qn[j] = qp[(size_t)j * 512]; ln[j] = lp[(size_t)j * 512]; inx[j] = ip[(size_t)j * 512]; }
    for (int blk = 0; blk < SEQ / 8; ++blk) {
        unsigned qc[8], lc[8], ic[8];
#pragma unroll
        for (int j = 0; j < 8; ++j) { qc[j] = qn[j]; lc[j] = ln[j]; ic[j] = inx[j]; }
        if (blk + 1 < SEQ / 8) {
#pragma unroll
            for (int j = 0; j < 8; ++j) { const size_t o = (size_t)((blk + 1) * 8 + j) * 512; qn[j] = qp[o]; ln[j] = lp[o]; inx[j] = ip[o]; }
        }
        float pv[16];
#pragma unroll
        for (int j = 0; j < 8; ++j) {
            const float f0 = __expf(bflo(lc[j])), f1 = __expf(bfhi(lc[j])), k0 = 1.0f - f0, k1 = 1.0f - f1;
            const float i0 = bflo(ic[j]), i1 = bfhi(ic[j]), q0 = bflo(qc[j]), q1 = bfhi(qc[j]);
            S00 = f0 * S00 + k0 * i0; S01 = f0 * S01 + k0 * i1; S10 = f1 * S10 + k1 * i0; S11 = f1 * S11 + k1 * i1;
            pv[2 * j] = S00 * q0 + S10 * q1; pv[2 * j + 1] = S01 * q0 + S11 * q1;
        }
        xreduce16(pv, lane);
        if ((lane & 3) == 0) { const int idx = ridx16(lane); op[(size_t)(blk * 8 + (idx >> 1)) * 1024 + (idx & 1)] = (bf16)(pk2c(pv[0], 0.f) & 0xffffu); }
    }
}
constexpr int HG_TS = 272;
constexpr int HG_BS = 132;
__device__ __forceinline__ void hg_stage(LAS unsigned char* dst, const bf16* src, int tid) {
#pragma unroll
    for (int i = 0; i < 2; ++i) { const int p = tid + 512 * i, row = p >> 4, c16 = p & 15; *(LAS v4u*)(dst + row * HG_TS + c16 * 16) = *(const GAS v4u*)(src + (size_t)row * 1024 + c16 * 8); }
}
__device__ __forceinline__ void hg_scan(const LAS unsigned char* lft, int dk, int hf, float (&lf)[4][8], float (&b)[4][8], float& bl) {
    float bs[4], pb[4];
#pragma unroll
    for (int kk = 0; kk < 4; ++kk) { float run = 0.f;
#pragma unroll
        for (int j = 0; j < 8; ++j) { lf[kk][j] = __uint_as_float((unsigned)(*(const LAS unsigned short*)(lft + (16 * kk + 8 * hf + j) * HG_TS + dk * 2)) << 16); run += lf[kk][j]; b[kk][j] = run; }
        bs[kk] = run; }
#pragma unroll
    for (int kk = 0; kk < 4; ++kk) pb[kk] = __shfl_xor(bs[kk], 32);
    float pre = 0.f;
#pragma unroll
    for (int kk = 0; kk < 4; ++kk) { const float off = pre + (hf ? pb[kk] : 0.f);
#pragma unroll
        for (int j = 0; j < 8; ++j) b[kk][j] += off;
        pre += bs[kk] + pb[kk]; }
    bl = pre;
}
__device__ __forceinline__ bf16x8 pack8(const float (&v)[8]) { v4u t; t.x = pk2c(v[0], v[1]); t.y = pk2c(v[2], v[3]); t.z = pk2c(v[4], v[5]); t.w = pk2c(v[6], v[7]); return __builtin_bit_cast(bf16x8, t); }
__device__ __forceinline__ unsigned lds_u16(const LAS unsigned char* p) { return (unsigned)(*(const LAS unsigned short*)p); }
__device__ __forceinline__ void hgA_chunk(const Ctx& c, int ci, const bf16* LOGF, const bf16* IHG, bf16* ST, float* DEC) {
    const int bh = ci >> 6, ch = ci & 63, bb = bh >> 3, h = bh & 7; const size_t n0 = (size_t)bb * SEQ + ch * 64;
    LAS unsigned char* lft = c.lds; LAS unsigned char* itl = c.lds + 64 * HG_TS;
    hg_stage(lft, LOGF + n0 * 1024 + h * 128, c.tid); hg_stage(itl, IHG + n0 * 1024 + h * 128, c.tid);
    __syncthreads();
    const int dkt = c.wave & 3, dvh = c.wave >> 2, hf = c.lane >> 5, cl = c.lane & 31, dk = 32 * dkt + cl;
    float lf[4][8], b[4][8], bl; hg_scan(lft, dk, hf, lf, b, bl);
    bf16x8 kf[4];
#pragma unroll
    for (int kk = 0; kk < 4; ++kk) { float v[8];
#pragma unroll
        for (int j = 0; j < 8; ++j) v[j] = (1.0f - __expf(lf[kk][j])) * __expf(bl - b[kk][j]);
        kf[kk] = pack8(v); }
    if (dvh == 0 && hf == 0) ((GAS float*)DEC)[(size_t)ci * 128 + dk] = __expf(bl);
#pragma unroll
    for (int dvi = 0; dvi < 2; ++dvi) { const int dvt = dvh * 2 + dvi;
        f32x16 acc;
#pragma unroll
        for (int r = 0; r < 16; ++r) acc[r] = 0.f;
#pragma unroll
        for (int kk = 0; kk < 4; ++kk) { const LAS unsigned char* p = itl + (16 * kk + 8 * hf) * HG_TS + (32 * dvt + cl) * 2;
            v4u t; t.x = lds_u16(p) | (lds_u16(p + HG_TS) << 16); t.y = lds_u16(p + 2 * HG_TS) | (lds_u16(p + 3 * HG_TS) << 16); t.z = lds_u16(p + 4 * HG_TS) | (lds_u16(p + 5 * HG_TS) << 16); t.w = lds_u16(p + 6 * HG_TS) | (lds_u16(p + 7 * HG_TS) << 16);
            acc = MFMA32(kf[kk], __builtin_bit_cast(bf16x8, t), acc); }
        bf16* o = ST + (size_t)ci * 16384 + (size_t)(32 * dvt + cl) * 128 + 32 * dkt + 4 * hf;
#pragma unroll
        for (int g = 0; g < 4; ++g) { v2u q; q.x = pk2c(acc[4 * g], acc[4 * g + 1]); q.y = pk2c(acc[4 * g + 2], acc[4 * g + 3]); *(GAS v2u*)(o + 8 * g) = q; }
    }
    __syncthreads();
}
__device__ __forceinline__ void hgB(const Ctx& c, bf16* ST, const float* DEC) {
    for (int e = blockIdx.x * 512 + c.tid; e < 32 * 4096; e += c.G * 512) {
        const int bh = e >> 12, r = e & 4095, dv = r >> 5, dk4 = (r & 31) * 4;
        GAS v2u* p = (GAS v2u*)(ST + (size_t)bh * 64 * 16384 + (size_t)dv * 128 + dk4);
        const GAS f32x4* d = (const GAS f32x4*)(DEC + (size_t)bh * 64 * 128 + dk4);
        f32x4 S = {0.f, 0.f, 0.f, 0.f};
#pragma unroll 1
        for (int c0 = 0; c0 < 64; c0 += 8) {
            v2u Lv[8]; f32x4 D[8];
#pragma unroll
            for (int k = 0; k < 8; ++k) { Lv[k] = p[(size_t)(c0 + k) * 4096]; D[k] = d[(size_t)(c0 + k) * 32]; }
#pragma unroll
            for (int k = 0; k < 8; ++k) { v2u o; o.x = pk2c(S.x, S.y); o.y = pk2c(S.z, S.w); p[(size_t)(c0 + k) * 4096] = o;
                S.x = D[k].x * S.x + bflo(Lv[k].x); S.y = D[k].y * S.y + bfhi(Lv[k].x); S.z = D[k].z * S.z + bflo(Lv[k].y); S.w = D[k].w * S.w + bfhi(Lv[k].y); }
        }
    }
}
__device__ __forceinline__ void hgC_chunk(const Ctx& c, int ci, const bf16* QHG, const bf16* LOGF, const bf16* IHG, const bf16* GHG, const bf16* ST, const float* nw, bf16* OUT) {
    const int bh = ci >> 6, ch = ci & 63, bb = bh >> 3, h = bh & 7; const size_t n0 = (size_t)bb * SEQ + ch * 64;
    LAS unsigned char* lft = c.lds; LAS unsigned char* itl = c.lds + 64 * HG_TS; LAS float* bt = (LAS float*)(c.lds + 2 * 64 * HG_TS); LAS float* red = bt + 64 * HG_BS;
    LAS unsigned char* ktl = (LAS unsigned char*)(red + 256);
    hg_stage(lft, LOGF + n0 * 1024 + h * 128, c.tid); hg_stage(itl, IHG + n0 * 1024 + h * 128, c.tid);
    __syncthreads();
    const int hf = c.lane >> 5, cl = c.lane & 31;
    { const int dk = 32 * (c.wave & 3) + cl; float lf[4][8], b[4][8], bl; hg_scan(lft, dk, hf, lf, b, bl);
#pragma unroll
      for (int q = 0; q < 2; ++q) { const int kk = 2 * (c.wave >> 2) + q;
#pragma unroll
          for (int j = 0; j < 8; ++j) { bt[(16 * kk + 8 * hf + j) * HG_BS + dk] = (c.wave >> 2) ? b[2 + q][j] : b[q][j];
              *(LAS unsigned short*)(ktl + (16 * kk + 8 * hf + j) * HG_TS + dk * 2) = (unsigned short)(pk2c(1.0f - __expf((c.wave >> 2) ? lf[2 + q][j] : lf[q][j]), 0.f) & 0xffffu); } } }
    __syncthreads();
    const int dvt = c.wave & 3, tt = c.wave >> 2, t = 32 * tt + cl;
    bf16x8 qm[8];
    const bf16* qrow = QHG + (n0 + t) * 1024 + h * 128 + 8 * hf;
#pragma unroll
    for (int kk = 0; kk < 8; ++kk) { const int d0 = 16 * kk + 8 * hf;
        asm volatile("" ::: "memory");
        const v4u qv = *(const GAS v4u*)(qrow + 16 * kk);
        const f32x4 b0 = *(const LAS f32x4*)(bt + t * HG_BS + d0), b1 = *(const LAS f32x4*)(bt + t * HG_BS + d0 + 4), m0 = *(const LAS f32x4*)(bt + 31 * HG_BS + d0), m1 = *(const LAS f32x4*)(bt + 31 * HG_BS + d0 + 4);
        const float q[8] = {bflo(qv.x), bfhi(qv.x), bflo(qv.y), bfhi(qv.y), bflo(qv.z), bfhi(qv.z), bflo(qv.w), bfhi(qv.w)};
        const float bv[8] = {b0.x, b0.y, b0.z, b0.w, b1.x, b1.y, b1.z, b1.w}, mv[8] = {m0.x, m0.y, m0.z, m0.w, m1.x, m1.y, m1.z, m1.w};
        float vm[8];
#pragma unroll
        for (int j = 0; j < 8; ++j) vm[j] = q[j] * __expf(bv[j] - mv[j]);
        qm[kk] = pack8(vm); }
    f32x16 o;
#pragma unroll
    for (int r = 0; r < 16; ++r) o[r] = 0.f;
#pragma unroll 1
    for (int st = 0; st <= tt; ++st) {
        const int s = 32 * st + cl;
        f32x16 sa;
#pragma unroll
        for (int r = 0; r < 16; ++r) sa[r] = 0.f;
#pragma unroll
        for (int kk = 0; kk < 8; ++kk) { const int d0 = 16 * kk + 8 * hf;
            asm volatile("" ::: "memory");
            const v4u lv = *(const LAS v4u*)(ktl + s * HG_TS + d0 * 2);
            const f32x4 b0 = *(const LAS f32x4*)(bt + s * HG_BS + d0), b1 = *(const LAS f32x4*)(bt + s * HG_BS + d0 + 4), m0 = *(const LAS f32x4*)(bt + 31 * HG_BS + d0), m1 = *(const LAS f32x4*)(bt + 31 * HG_BS + d0 + 4);
            const float kv[8] = {bflo(lv.x), bfhi(lv.x), bflo(lv.y), bfhi(lv.y), bflo(lv.z), bfhi(lv.z), bflo(lv.w), bfhi(lv.w)};
            const float bv[8] = {b0.x, b0.y, b0.z, b0.w, b1.x, b1.y, b1.z, b1.w}, mv[8] = {m0.x, m0.y, m0.z, m0.w, m1.x, m1.y, m1.z, m1.w};
            float vk[8];
#pragma unroll
            for (int j = 0; j < 8; ++j) vk[j] = kv[j] * __expf(mv[j] - bv[j]);
            sa = MFMA32(pack8(vk), qm[kk], sa); }
        if (st == tt) {
#pragma unroll
            for (int r = 0; r < 16; ++r) if (((r & 3) + 8 * (r >> 2) + 4 * hf) > cl) sa[r] = 0.f;
        }
#pragma unroll
        for (int sp = 0; sp < 2; ++sp) {
            const float pv[8] = {sa[8 * sp], sa[8 * sp + 1], sa[8 * sp + 2], sa[8 * sp + 3], sa[8 * sp + 4], sa[8 * sp + 5], sa[8 * sp + 6], sa[8 * sp + 7]};
            const LAS unsigned char* p = itl + (32 * st + 16 * sp + 4 * hf) * HG_TS + (32 * dvt + cl) * 2;
            v4u tq; tq.x = lds_u16(p) | (lds_u16(p + HG_TS) << 16); tq.y = lds_u16(p + 2 * HG_TS) | (lds_u16(p + 3 * HG_TS) << 16);
            tq.z = lds_u16(p + 8 * HG_TS) | (lds_u16(p + 9 * HG_TS) << 16); tq.w = lds_u16(p + 10 * HG_TS) | (lds_u16(p + 11 * HG_TS) << 16);
            o = MFMA32(__builtin_bit_cast(bf16x8, tq), pack8(pv), o); }
    }
    { const bf16* strow = ST + (size_t)ci * 16384 + (size_t)(32 * dvt + cl) * 128 + 8 * hf;
#pragma unroll
      for (int kk = 0; kk < 8; ++kk) { const int d0 = 16 * kk + 8 * hf;
          asm volatile("" ::: "memory");
          const v4u qv = *(const GAS v4u*)(qrow + 16 * kk); const bf16x8 sf = *(const GAS bf16x8*)(strow + 16 * kk);
          const f32x4 b0 = *(const LAS f32x4*)(bt + t * HG_BS + d0), b1 = *(const LAS f32x4*)(bt + t * HG_BS + d0 + 4);
          float ve[8] = {bflo(qv.x) * __expf(b0.x), bfhi(qv.x) * __expf(b0.y), bflo(qv.y) * __expf(b0.z), bfhi(qv.y) * __expf(b0.w), bflo(qv.z) * __expf(b1.x), bfhi(qv.z) * __expf(b1.y), bflo(qv.w) * __expf(b1.z), bfhi(qv.w) * __expf(b1.w)};
          o = MFMA32(sf, pack8(ve), o); } }
    float ss = 0.f;
#pragma unroll
    for (int r = 0; r < 16; ++r) ss += o[r] * o[r];
    ss += __shfl_xor(ss, 32);
    if (hf == 0) red[(tt * 4 + dvt) * 32 + cl] = ss;
    __syncthreads();
    const float rstd = __builtin_amdgcn_rsqf(((red[(tt * 4 + 0) * 32 + cl] + red[(tt * 4 + 1) * 32 + cl]) + (red[(tt * 4 + 2) * 32 + cl] + red[(tt * 4 + 3) * 32 + cl])) * (1.0f / 128.0f) + EPS);
#pragma unroll
    for (int g = 0; g < 4; ++g) { const int dv0 = 32 * dvt + 8 * g + 4 * hf; const size_t off = (n0 + t) * 1024 + h * 128 + dv0;
        const v2u gg = *(const GAS v2u*)(GHG + off); const f32x4 w4 = *(const GAS f32x4*)(nw + dv0);
        v2u q; q.x = pk2c(o[4 * g] * rstd * w4.x * bflo(gg.x), o[4 * g + 1] * rstd * w4.y * bfhi(gg.x)); q.y = pk2c(o[4 * g + 2] * rstd * w4.z * bflo(gg.y), o[4 * g + 3] * rstd * w4.w * bfhi(gg.y));
        *(GAS v2u*)(OUT + off) = q; }
    __syncthreads();
}
__device__ __forceinline__ void qknorm_rows4(bf16* row0, size_t rstride, const float* w, float scale, int lane) {
    v4u x[4][2];
#pragma unroll
    for (int i = 0; i < 4; ++i)
#pragma unroll
        for (int j = 0; j < 2; ++j) x[i][j] = *(const GAS v4u*)(row0 + i * rstride + 8 * lane + 512 * j);
    const f32x4 wa = *(const GAS f32x4*)(w + ((8 * lane) & 127)), wb = *(const GAS f32x4*)(w + ((8 * lane) & 127) + 4);
#pragma unroll
    for (int i = 0; i < 4; ++i)
#pragma unroll
        for (int j = 0; j < 2; ++j) { const v4u xx = x[i][j];
            float f[8] = {bflo(xx.x), bfhi(xx.x), bflo(xx.y), bfhi(xx.y), bflo(xx.z), bfhi(xx.z), bflo(xx.w), bfhi(xx.w)};
            float ss = 0.f;
#pragma unroll
            for (int k = 0; k < 8; ++k) ss += f[k] * f[k];
            ss += __shfl_xor(ss, 1); ss += __shfl_xor(ss, 2); ss += __shfl_xor(ss, 4); ss += __shfl_xor(ss, 8);
            const float r = __builtin_amdgcn_rsqf(ss * (1.0f / 128.0f) + EPS) * scale;
            v4u o; o.x = pk2c(f[0] * r * wa.x, f[1] * r * wa.y); o.y = pk2c(f[2] * r * wa.z, f[3] * r * wa.w); o.z = pk2c(f[4] * r * wb.x, f[5] * r * wb.y); o.w = pk2c(f[6] * r * wb.z, f[7] * r * wb.w);
            *(GAS v4u*)(row0 + i * rstride + 8 * lane + 512 * j) = o; }
}
__device__ __forceinline__ void vt_item(int item, int lane, const bf16* vsb, bf16* vt, LAS unsigned short* scr) {
    const int db = item & 3, sb = (item >> 2) & 63, bh = item >> 8, b = bh >> 3, h = bh & 7;
    const bf16* src = vsb + ((size_t)b * SEQ + sb * 64) * 1024 + h * 128 + db * 32;
#pragma unroll 4
    for (int i = 0; i < 16; ++i) { const int r = 4 * i + (lane >> 4); *(LAS unsigned*)(scr + r * 34 + 2 * (lane & 15)) = *(const GAS unsigned*)(src + (size_t)r * 1024 + 2 * (lane & 15)); }
    LDS_WAIT();
    const int c = lane & 7;
#pragma unroll
    for (int j = 0; j < 4; ++j) { const int d = (lane >> 3) + 8 * j; const LAS unsigned short* s = scr + (8 * c) * 34 + d;
        v4u o; o.x = (unsigned)s[0] | ((unsigned)s[34] << 16); o.y = (unsigned)s[68] | ((unsigned)s[102] << 16); o.z = (unsigned)s[136] | ((unsigned)s[170] << 16); o.w = (unsigned)s[204] | ((unsigned)s[238] << 16);
        *(GAS v4u*)(vt + ((size_t)bh * 128 + db * 32 + d) * SEQ + sb * 64 + 8 * c) = o; }
    LDS_WAIT();
}

constexpr int AT_BUF = 32768, AT_VOFF = 16384;
__device__ __forceinline__ f32x16 attn_scores(const LAS unsigned char* kt, int krow, int hf, const bf16x8 (&qf)[8]) {
    f32x16 sa;
#pragma unroll
    for (int r = 0; r < 16; ++r) sa[r] = 0.f;
    const LAS unsigned char* kp = kt + krow * 256; const int sw = krow & 15;
#pragma unroll
    for (int kk = 0; kk < 8; ++kk) sa = MFMA32(*(const LAS bf16x8*)(kp + (((2 * kk + hf) ^ sw) << 4)), qf[kk], sa);
    return sa;
}
template <bool DIAG> __device__ __forceinline__ void attn_weights(const f32x16& sa, float& R, int hf, int cl, bf16x8 (&pf)[2]) {
    float om[16];
#pragma unroll
    for (int r = 0; r < 16; ++r) om[r] = __builtin_amdgcn_rcpf(1.0f + __builtin_amdgcn_exp2f(sa[r] * 1.4426950408889634f));
    if (DIAG) {
#pragma unroll
        for (int r = 0; r < 16; ++r) if (((r & 3) + 8 * (r >> 2) + 4 * hf) >= cl) om[r] = 1.0f;
    }
    float Gs[4], Gp[4];
#pragma unroll
    for (int g = 0; g < 4; ++g) { Gs[g] = (om[4 * g] * om[4 * g + 1]) * (om[4 * g + 2] * om[4 * g + 3]); Gp[g] = __shfl_xor(Gs[g], 32); }
    float tail = R; float w[16];
#pragma unroll
    for (int g = 3; g >= 0; --g) {
        const float c3 = tail * (hf == 0 ? Gp[g] : 1.0f), c2 = c3 * om[4 * g + 3], c1 = c2 * om[4 * g + 2], c0 = c1 * om[4 * g + 1];
        w[4 * g + 3] = c3 - om[4 * g + 3] * c3; w[4 * g + 2] = c2 - om[4 * g + 2] * c2; w[4 * g + 1] = c1 - om[4 * g + 1] * c1; w[4 * g] = c0 - om[4 * g] * c0;
        tail *= Gs[g] * Gp[g];
    }
    R = tail;
#pragma unroll
    for (int sp = 0; sp < 2; ++sp) { v4u t; t.x = pk2c(w[8 * sp], w[8 * sp + 1]); t.y = pk2c(w[8 * sp + 2], w[8 * sp + 3]); t.z = pk2c(w[8 * sp + 4], w[8 * sp + 5]); t.w = pk2c(w[8 * sp + 6], w[8 * sp + 7]); pf[sp] = __builtin_bit_cast(bf16x8, t); }
}
__device__ __forceinline__ void attn_pv(const LAS unsigned char* vt, int sub, int cl, int hf, const bf16x8 (&pf)[2], f32x16 (&o)[4]) {
#pragma unroll
    for (int d = 0; d < 4; ++d) { const int row = 32 * d + cl; const LAS unsigned char* vp = vt + row * 128 + 8 * hf; const int sw = (row >> 1) & 7;
#pragma unroll
        for (int sp = 0; sp < 2; ++sp) { const int x = 4 * sub + 2 * sp;
            const v2u lo = *(const LAS v2u*)(vp + ((x ^ sw) << 4)), hi = *(const LAS v2u*)(vp + (((x + 1) ^ sw) << 4));
            v4u t; t.x = lo.x; t.y = lo.y; t.z = hi.x; t.w = hi.y; o[d] = MFMA32(__builtin_bit_cast(bf16x8, t), pf[sp], o[d]); } }
}
template <bool LAG> __device__ __forceinline__ void attn_unit(const Ctx& c, int bh, int qb, const bf16* qsb, const bf16* ksb, const bf16* vt, bf16* outb) {
    int lane_ = c.lane; asm volatile("" : "+v"(lane_));
    const int b = bh >> 3, h = bh & 7, lane = lane_, cl = lane & 31, hf = lane >> 5;
    const size_t rb = (size_t)b * SEQ; const int q0w = 256 * qb + 32 * c.wave;
    bf16x8 qf[8];
    { const bf16* qrow = qsb + (rb + q0w + cl) * 1024 + h * 128 + 8 * hf;
#pragma unroll
      for (int kk = 0; kk < 8; ++kk) qf[kk] = *(const GAS bf16x8*)(qrow + 16 * kk); }
    f32x16 o[4];
#pragma unroll
    for (int d = 0; d < 4; ++d)
#pragma unroll
        for (int r = 0; r < 16; ++r) o[d][r] = 0.f;
    float R = 1.0f;
    bf16x8 pd[2]; const LAS unsigned char* vimd = c.lds; int subd = 0; bool pending = false;
    const int kr0 = 8 * c.wave + (lane >> 4), kr1 = kr0 + 4;
    const bf16* kg0 = ksb + (rb + kr0) * 1024 + h * 128 + (((lane & 15) ^ (kr0 & 15)) << 3);
    const bf16* kg1 = ksb + (rb + kr1) * 1024 + h * 128 + (((lane & 15) ^ (kr1 & 15)) << 3);
    const int vr0 = 16 * c.wave + (lane >> 3), vr1 = vr0 + 8;
    const bf16* vg0 = vt + ((size_t)bh * 128 + vr0) * SEQ + (((lane & 7) ^ ((vr0 >> 1) & 7)) << 3);
    const bf16* vg1 = vt + ((size_t)bh * 128 + vr1) * SEQ + (((lane & 7) ^ ((vr1 >> 1) & 7)) << 3);
    LAS unsigned char* dk = c.lds + c.wave * 2048; LAS unsigned char* dv = c.lds + AT_VOFF + c.wave * 2048;
#define AT_DMA(kt_, bi_) do { const int ktt_ = (kt_); LAS unsigned char* bb_ = (LAS unsigned char*)0 + (bi_) * AT_BUF; \
        __builtin_amdgcn_global_load_lds((const unsigned*)(kg0 + (size_t)ktt_ * 64 * 1024), (LAS unsigned*)(dk + (bi_) * AT_BUF), 16, 0, 0); \
        __builtin_amdgcn_global_load_lds((const unsigned*)(kg1 + (size_t)ktt_ * 64 * 1024), (LAS unsigned*)(dk + (bi_) * AT_BUF + 1024), 16, 0, 0); \
        __builtin_amdgcn_global_load_lds((const unsigned*)(vg0 + ktt_ * 64), (LAS unsigned*)(dv + (bi_) * AT_BUF), 16, 0, 0); \
        __builtin_amdgcn_global_load_lds((const unsigned*)(vg1 + ktt_ * 64), (LAS unsigned*)(dv + (bi_) * AT_BUF + 1024), 16, 0, 0); (void)bb_; } while (0)
    const int nkt = 4 * (qb + 1);
    asm volatile("s_waitcnt vmcnt(0)" ::: "memory");
    AT_DMA(nkt - 1, 0); AT_DMA(nkt - 2, 1);
    asm volatile("s_waitcnt vmcnt(4)" ::: "memory"); __builtin_amdgcn_s_barrier(); asm volatile("" ::: "memory");
    int bi = 0;
#pragma unroll 1
    for (int it = 0; it < nkt; ++it) {
        const int kt = nkt - 1 - it;
        const int b2 = (bi + 2) & 3;
        if (it + 2 < nkt) AT_DMA(kt - 2, b2);
        const LAS unsigned char* kim = c.lds + bi * AT_BUF; const LAS unsigned char* vim = kim + AT_VOFF;
        const int rel = q0w - 64 * kt;
        if (rel >= 32) {
            if (LAG) { if (pending) attn_pv(vimd, subd, cl, hf, pd, o);
                const f32x16 s1 = attn_scores(kim, 32 + cl, hf, qf); if (rel == 32) attn_weights<true>(s1, R, hf, cl, pd); else attn_weights<false>(s1, R, hf, cl, pd);
                vimd = vim; subd = 1; pending = true;
            } else { bf16x8 p[2];
                { const f32x16 s1 = attn_scores(kim, 32 + cl, hf, qf); if (rel == 32) attn_weights<true>(s1, R, hf, cl, p); else attn_weights<false>(s1, R, hf, cl, p); }
                attn_pv(vim, 1, cl, hf, p, o); }
        }
        if (rel >= 0) {
            if (LAG) { if (pending) attn_pv(vimd, subd, cl, hf, pd, o);
                const f32x16 s0 = attn_scores(kim, cl, hf, qf); if (rel == 0) attn_weights<true>(s0, R, hf, cl, pd); else attn_weights<false>(s0, R, hf, cl, pd);
                vimd = vim; subd = 0; pending = true;
            } else { bf16x8 p[2];
                { const f32x16 s0 = attn_scores(kim, cl, hf, qf); if (rel == 0) attn_weights<true>(s0, R, hf, cl, p); else attn_weights<false>(s0, R, hf, cl, p); }
                attn_pv(vim, 0, cl, hf, p, o); }
        }
        if (it + 2 < nkt) asm volatile("s_waitcnt vmcnt(4)\n\ts_waitcnt lgkmcnt(0)" ::: "memory"); else asm volatile("s_waitcnt vmcnt(0)\n\ts_waitcnt lgkmcnt(0)" ::: "memory");
        __builtin_amdgcn_s_barrier(); asm volatile("" ::: "memory");
        bi = (bi + 1) & 3;
    }
#undef AT_DMA
    if (LAG && pending) attn_pv(vimd, subd, cl, hf, pd, o);
    bf16* orow = outb + (rb + q0w + cl) * 1024 + h * 128 + 4 * hf;
#pragma unroll
    for (int d = 0; d < 4; ++d)
#pragma unroll
        for (int g = 0; g < 4; ++g) { v2u q; q.x = pk2c(o[d][4 * g], o[d][4 * g + 1]); q.y = pk2c(o[d][4 * g + 2], o[d][4 * g + 3]); *(GAS v2u*)(orow + 32 * d + 8 * g) = q; }
    asm volatile("s_waitcnt vmcnt(0)" ::: "memory"); __builtin_amdgcn_s_barrier(); asm volatile("" ::: "memory");
}
__device__ __forceinline__ void hgpost_row(bf16* row, const bf16* grow, const float* w, int lane) {
#pragma unroll
    for (int j = 0; j < 2; ++j) {
        GAS v4u* p = (GAS v4u*)(row + 8 * lane + 512 * j); const v4u x = *p; const v4u gg = *(const GAS v4u*)(grow + 8 * lane + 512 * j);
        float f[8] = {bflo(x.x), bfhi(x.x), bflo(x.y), bfhi(x.y), bflo(x.z), bfhi(x.z), bflo(x.w), bfhi(x.w)};
        const float g[8] = {bflo(gg.x), bfhi(gg.x), bflo(gg.y), bfhi(gg.y), bflo(gg.z), bfhi(gg.z), bflo(gg.w), bfhi(gg.w)};
        float ss = 0.f;
#pragma unroll
        for (int k = 0; k < 8; ++k) ss += f[k] * f[k];
        ss += __shfl_xor(ss, 1); ss += __shfl_xor(ss, 2); ss += __shfl_xor(ss, 4); ss += __shfl_xor(ss, 8);
        const float r = __builtin_amdgcn_rsqf(ss * (1.0f / 128.0f) + EPS);
        const f32x4 wa = *(const GAS f32x4*)(w + ((8 * lane) & 127)), wb = *(const GAS f32x4*)(w + ((8 * lane) & 127) + 4);
        v4u o; o.x = pk2c(f[0] * r * wa.x * g[0], f[1] * r * wa.y * g[1]); o.y = pk2c(f[2] * r * wa.z * g[2], f[3] * r * wa.w * g[3]);
        o.z = pk2c(f[4] * r * wb.x * g[4], f[5] * r * wb.y * g[5]); o.w = pk2c(f[6] * r * wb.z * g[6], f[7] * r * wb.w * g[7]);
        *p = o;
    }
}

template <bool FIRST> struct EpiMerge {
    static constexpr bool PERM = true, AFTER_DRAIN = false;
    const bf16* gate; bf16* merged;
    __device__ __forceinline__ void operator()(const pg8::f32x4 (&acc)[2][2][4][2], const pg8::Unit& u, int wr, int wc, int fr, int fq) const {
        const int row0 = u.pm * 256 + wr * 64 + fr, col0 = u.pn * 256 + wc * 32 + 8 * fq;
#pragma unroll
        for (int ai = 0; ai < 2; ++ai)
#pragma unroll
            for (int m = 0; m < 4; ++m) {
                if ((m & 1) == 0) asm volatile("" ::: "memory");
#pragma unroll
                for (int bj = 0; bj < 2; ++bj) {
                    const size_t off = (size_t)(row0 + ai * 128 + m * 16) * 2048 + col0 + bj * 128;
                    const v4u g = *(const GAS v4u*)(gate + off); const pg8::f32x4 v0 = acc[ai][bj][m][0], v1 = acc[ai][bj][m][1];
                    float r[8] = {bflo(g.x) * v0[0], bfhi(g.x) * v0[1], bflo(g.y) * v0[2], bfhi(g.y) * v0[3], bflo(g.z) * v1[0], bfhi(g.z) * v1[1], bflo(g.w) * v1[2], bfhi(g.w) * v1[3]};
                    if (!FIRST) { const v4u mo = *(const GAS v4u*)(merged + off);
                        r[0] += bflo(mo.x); r[1] += bfhi(mo.x); r[2] += bflo(mo.y); r[3] += bfhi(mo.y); r[4] += bflo(mo.z); r[5] += bfhi(mo.z); r[6] += bflo(mo.w); r[7] += bfhi(mo.w); }
                    v4u w; w.x = pk2c(r[0], r[1]); w.y = pk2c(r[2], r[3]); w.z = pk2c(r[4], r[5]); w.w = pk2c(r[6], r[7]);
                    *(GAS v4u*)(merged + off) = w; }
            }
    }
};
struct EpiStoreBf16 {
    static constexpr bool PERM = true, AFTER_DRAIN = false;
    bf16* out;
    __device__ __forceinline__ void operator()(const pg8::f32x4 (&acc)[2][2][4][2], const pg8::Unit& u, int wr, int wc, int fr, int fq) const {
        const int row0 = u.pm * 256 + wr * 64 + fr, col0 = u.pn * 256 + wc * 32 + 8 * fq;
#pragma unroll
        for (int ai = 0; ai < 2; ++ai)
#pragma unroll
            for (int m = 0; m < 4; ++m)
#pragma unroll
                for (int bj = 0; bj < 2; ++bj) { const pg8::f32x4 v0 = acc[ai][bj][m][0], v1 = acc[ai][bj][m][1];
                    v4u w; w.x = pk2c(v0[0], v0[1]); w.y = pk2c(v0[2], v0[3]); w.z = pk2c(v1[0], v1[1]); w.w = pk2c(v1[2], v1[3]);
                    *(GAS v4u*)(out + (size_t)(row0 + ai * 128 + m * 16) * 2048 + col0 + bj * 128) = w; }
    }
};
struct EpiResid {
    static constexpr bool PERM = false, AFTER_DRAIN = false;
    const float* xin; float* xout;
    __device__ __forceinline__ void operator()(const pg8::f32x4 (&acc)[2][2][4][2], const pg8::Unit& u, int wr, int wc, int fr, int fq) const {
        const int row0 = u.pm * 256 + wr * 64 + fr, col0 = u.pn * 256 + wc * 32 + 4 * fq;
#pragma unroll
        for (int ai = 0; ai < 2; ++ai)
#pragma unroll
            for (int m = 0; m < 4; ++m)
#pragma unroll
                for (int bj = 0; bj < 2; ++bj)
#pragma unroll
                    for (int n = 0; n < 2; ++n) { const size_t off = (size_t)(row0 + ai * 128 + m * 16) * 2048 + col0 + bj * 128 + n * 16;
                        f32x4 r = acc[ai][bj][m][n]; if (xin) r += *(const GAS f32x4*)(xin + off);
                        *(GAS f32x4*)(xout + off) = r; }
    }
};

__device__ __forceinline__ float rl_f(float v, int l) { return __uint_as_float((unsigned)__builtin_amdgcn_readlane((int)__float_as_uint(v), l)); }
__device__ __forceinline__ void ins16(float (&L)[16], float x) {
#pragma unroll
    for (int i = 0; i < 16; ++i) { const float hi = __builtin_fmaxf(L[i], x); x = __builtin_fminf(L[i], x); L[i] = hi; }
}
#define CE_DESC(a, b) do { const float hi_ = __builtin_fmaxf(a, b), lo_ = __builtin_fminf(a, b); a = hi_; b = lo_; } while (0)
__device__ __forceinline__ void sort16_desc(float (&v)[16]) {
#pragma unroll
    for (int k = 2; k <= 16; k <<= 1)
#pragma unroll
        for (int j = k >> 1; j > 0; j >>= 1)
#pragma unroll
            for (int i = 0; i < 16; ++i) { const int l = i ^ j; if (l > i) { if ((i & k) == 0) CE_DESC(v[i], v[l]); else CE_DESC(v[l], v[i]); } }
}
__device__ __forceinline__ void bitonic_merge16_desc(float (&v)[16]) {
#pragma unroll
    for (int j = 8; j > 0; j >>= 1)
#pragma unroll
        for (int i = 0; i < 16; ++i) { const int l = i ^ j; if (l > i) CE_DESC(v[i], v[l]); }
}
__device__ __forceinline__ void top16_merge(float (&L)[16], const float (&T)[16]) {
#pragma unroll
    for (int i = 0; i < 16; ++i) L[i] = __builtin_fmaxf(L[i], T[15 - i]);
    bitonic_merge16_desc(L);
}
constexpr int PK_KS = 272;
__device__ __forceinline__ void peer_top16(const bf16* qrow  , const LAS unsigned char* kl  , int hf, float (&L)[16]) {
    bf16x8 qf[8];
#pragma unroll
    for (int kk = 0; kk < 8; ++kk) qf[kk] = *(const GAS bf16x8*)(qrow + 16 * kk);
#pragma unroll 1
    for (int kt = 0; kt < 4; ++kt) {
        f32x16 sa;
#pragma unroll
        for (int r = 0; r < 16; ++r) sa[r] = 0.f;
#pragma unroll
        for (int kk = 0; kk < 8; ++kk) sa = MFMA32(*(const LAS bf16x8*)(kl + kt * 32 * PK_KS + 32 * kk), qf[kk], sa);
        float T[16];
#pragma unroll
        for (int r = 0; r < 16; ++r) { const unsigned idx = (unsigned)(kt * 32 + (r & 3) + 8 * (r >> 2) + 4 * hf); T[r] = __uint_as_float((__float_as_uint(sa[r]) & ~127u) | idx); }
        sort16_desc(T);
        if (kt == 0) {
#pragma unroll
            for (int i = 0; i < 16; ++i) L[i] = T[i];
        } else top16_merge(L, T);
    }
    float P[16];
#pragma unroll
    for (int i = 0; i < 16; ++i) P[i] = __shfl_xor(L[i], 32);
    top16_merge(L, P);
}
__device__ __forceinline__ void peer_select32(int hd, int n0, int lane, const bf16* qpeer, const LAS unsigned char* kl1, const LAS unsigned char* kl2, unsigned char* wsb, LAS unsigned* ldsw) {
    asm volatile("" : "+v"(lane));
    const int c = lane & 31, hf = lane >> 5, n = n0 + c;
    const bf16* qrow = qpeer + (size_t)n * 2048 + hd * 256 + 8 * hf;
    float A[16], B[16];
    peer_top16(qrow, kl1 + c * PK_KS + 16 * hf, hf, A);
    peer_top16(qrow + 128, kl2 + c * PK_KS + 16 * hf, hf, B);
#define PKV(x) __uint_as_float(__float_as_uint(x) & ~127u)
#define PKI(x) ((int)(__float_as_uint(x) & 127u))
    float W[16];
    { float C0[16], C1[16], C2[16], E0 = 0.f, E1 = 0.f; unsigned id = 0;
#pragma unroll
      for (int a = 0; a < 16; ++a)
#pragma unroll
        for (int b = 0; b < 16; ++b) if ((a + 1) * (b + 1) <= 16) { const float pk = __uint_as_float((__float_as_uint(PKV(A[a]) + PKV(B[b])) & ~63u) | id);
            if (id < 16) C0[id] = pk; else if (id < 32) C1[id - 16] = pk; else if (id < 48) C2[id - 32] = pk; else if (id == 48) E0 = pk; else E1 = pk;
            ++id; }
      sort16_desc(C0); sort16_desc(C1); sort16_desc(C2);
      top16_merge(C0, C1); top16_merge(C0, C2);
#pragma unroll
      for (int i = 0; i < 16; ++i) W[i] = C0[i];
      ins16(W, E0); ins16(W, E1); }
    const float thr = W[15], mx = W[0];
    int cnt = 0; float ssum = 0.f;
    LAS int* le = (LAS int*)ldsw + c * 16; LAS float* lg = (LAS float*)ldsw + 512 + c * 16;
    { unsigned id = 0;
#pragma unroll
      for (int a = 0; a < 16; ++a)
#pragma unroll
        for (int b = 0; b < 16; ++b) if ((a + 1) * (b + 1) <= 16) {
            const float cv = PKV(A[a]) + PKV(B[b]); const float pk = __uint_as_float((__float_as_uint(cv) & ~63u) | id); ++id;
            if (pk >= thr) { const float e = __expf(cv - mx); if (hf == 0) { le[cnt] = PKI(A[a]) * 128 + PKI(B[b]); lg[cnt] = e; } ssum += e; ++cnt; }
        } }
    LDS_WAIT();
    asm volatile("" : "+s"(wsb));
    int* sel_e = (int*)(wsb + WS_SEL); float* sel_g = (float*)(wsb + WS_SEL + 8 * MiB); float* sel_s = (float*)(wsb + WS_SELS);
    { int lane3 = lane; asm volatile("" : "+v"(lane3)); const int t = lane3 >> 1, part = lane3 & 1;
      const v4u e0 = *(const LAS v4u*)((LAS int*)ldsw + t * 16 + 8 * part), e1 = *(const LAS v4u*)((LAS int*)ldsw + t * 16 + 8 * part + 4);
      const v4u g0 = *(const LAS v4u*)((LAS int*)ldsw + 512 + t * 16 + 8 * part), g1 = *(const LAS v4u*)((LAS int*)ldsw + 512 + t * 16 + 8 * part + 4);
      GAS v4u* pe = (GAS v4u*)(sel_e + (size_t)(n0 + t) * 128 + hd * 16 + 8 * part); GAS v4u* pg = (GAS v4u*)(sel_g + (size_t)(n0 + t) * 128 + hd * 16 + 8 * part);
      pe[0] = e0; pe[1] = e1; pg[0] = g0; pg[1] = g1; }
    LDS_WAIT();
    { int lane4 = lane; asm volatile("" : "+v"(lane4)); if ((lane4 >> 5) == 0) ((GAS float*)sel_s)[(size_t)(n0 + (lane4 & 31)) * 8 + hd] = ssum; }
}

__device__ __forceinline__ float dot2bf(unsigned a, unsigned b, float acc) {
    return __builtin_amdgcn_fdot2_f32_bf16(__builtin_bit_cast(bf16v2, a), __builtin_bit_cast(bf16v2, b), acc, false);
}
__device__ __forceinline__ float dot8bf(const v4u a, const v4u b, float acc) {
    const unsigned a0 = a.x, a1 = a.y, a2 = a.z, a3 = a.w, b0 = b.x, b1 = b.y, b2 = b.z, b3 = b.w;
    acc = dot2bf(a0, b0, acc); acc = dot2bf(a1, b1, acc); acc = dot2bf(a2, b2, acc); acc = dot2bf(a3, b3, acc);
    return acc;
}
__device__ __forceinline__ void unpack16(const v4u q, float (&f)[16]) {
    const unsigned d0 = q.x, d1 = q.y, d2 = q.z, d3 = q.w;
    f32x2v t;
    t = __builtin_amdgcn_cvt_pk_f32_fp8((int)d0, false); f[0] = t.x; f[1] = t.y; t = __builtin_amdgcn_cvt_pk_f32_fp8((int)d0, true); f[2] = t.x; f[3] = t.y;
    t = __builtin_amdgcn_cvt_pk_f32_fp8((int)d1, false); f[4] = t.x; f[5] = t.y; t = __builtin_amdgcn_cvt_pk_f32_fp8((int)d1, true); f[6] = t.x; f[7] = t.y;
    t = __builtin_amdgcn_cvt_pk_f32_fp8((int)d2, false); f[8] = t.x; f[9] = t.y; t = __builtin_amdgcn_cvt_pk_f32_fp8((int)d2, true); f[10] = t.x; f[11] = t.y;
    t = __builtin_amdgcn_cvt_pk_f32_fp8((int)d3, false); f[12] = t.x; f[13] = t.y; t = __builtin_amdgcn_cvt_pk_f32_fp8((int)d3, true); f[14] = t.x; f[15] = t.y;
}
struct SliceSched { int mode, xcc, rank, nloc; };
__device__ __forceinline__ SliceSched slice_sched_init(const Ctx& c, unsigned* ctl, const XcdBarrier& bar, int use) {
    LAS int* sh = (LAS int*)(c.lds + 1024);
    if (c.tid == 0) {
        int ok = 1; unsigned tot = 0;
        for (int j = 0; j < 16; ++j) { const unsigned n = xb_ld(&bar.bar[XB_XCNT(j)]); tot += n; if ((j < 8) != (n > 0u)) ok = 0; }
        if (tot != (unsigned)c.G) ok = 0;
        const int xcc = (int)xb_xcc_id();
        int rank = 0, nloc = 1;
        if (ok) { nloc = (int)xb_ld(&bar.bar[XB_XCNT(xcc)]); rank = (int)xb_add(&ctl[CW_RANK + (use * 16 + xcc) * 64], 1u); if (rank >= nloc) ok = 0; }
        sh[0] = ok; sh[1] = xcc; sh[2] = rank; sh[3] = nloc;
    }
    __syncthreads();
    SliceSched S; S.mode = sh[0]; S.xcc = sh[1]; S.rank = sh[2]; S.nloc = sh[3];
    __syncthreads();
    return S;
}
__device__ __forceinline__ bool slice_item(const SliceSched& S, const Ctx& c, int i, int& slice, int& tb) {
    if (S.mode) { const int it = S.rank + i * S.nloc; if (it >= 512) return false; slice = S.xcc + 8 * (it >> 8); tb = it & 255; return true; }
    const int it = (int)blockIdx.x + i * c.G; if (it >= 4096) return false; slice = it >> 8; tb = it & 255; return true;
}
__device__ __forceinline__ void unpack16p(const v4u q, f32x2v (&f)[8]) {
    const unsigned d0 = q.x, d1 = q.y, d2 = q.z, d3 = q.w;
    f[0] = __builtin_amdgcn_cvt_pk_f32_fp8((int)d0, false); f[1] = __builtin_amdgcn_cvt_pk_f32_fp8((int)d0, true);
    f[2] = __builtin_amdgcn_cvt_pk_f32_fp8((int)d1, false); f[3] = __builtin_amdgcn_cvt_pk_f32_fp8((int)d1, true);
    f[4] = __builtin_amdgcn_cvt_pk_f32_fp8((int)d2, false); f[5] = __builtin_amdgcn_cvt_pk_f32_fp8((int)d2, true);
    f[6] = __builtin_amdgcn_cvt_pk_f32_fp8((int)d3, false); f[7] = __builtin_amdgcn_cvt_pk_f32_fp8((int)d3, true);
}
__device__ __forceinline__ void peer_sddmm_wave(int t0, int s, int lane, const bf16* H, const unsigned char* UQ, const int* sel_e, float* part, LAS unsigned* ldsw) {
    const int cg = lane & 7, sg = lane >> 3;
#pragma unroll
    for (int j = 0; j < 4; ++j) *(LAS v4u*)(ldsw + 4 * (lane + 64 * j)) = *(const GAS v4u*)(sel_e + (size_t)t0 * 128 + 4 * (lane + 64 * j));
    LDS_WAIT();
    const unsigned char* ubase = UQ + (size_t)s * U8_SLICE + cg * 16;
    v4u qn[16];
    { int id[16];
#pragma unroll
      for (int q = 0; q < 4; ++q) { const v4u v = *(const LAS v4u*)(ldsw + sg * 16 + 4 * q); id[4 * q] = (int)v.x; id[4 * q + 1] = (int)v.y; id[4 * q + 2] = (int)v.z; id[4 * q + 3] = (int)v.w; }
#pragma unroll
      for (int it = 0; it < 16; ++it) qn[it] = *(const GAS v4u*)(ubase + (unsigned)id[it] * 128u); }
    const bf16* hbase = H + (size_t)t0 * 2048 + s * 128 + cg * 16;
    v4u han = *(const GAS v4u*)(hbase), hbn = *(const GAS v4u*)(hbase + 8);
#pragma unroll 1
    for (int k = 0; k < 8; ++k) {
        const int t = t0 + k;
        v4u qc[16];
#pragma unroll
        for (int it = 0; it < 16; ++it) qc[it] = qn[it];
        const v4u ha = han, hb = hbn;
        if (k < 7) { han = *(const GAS v4u*)(hbase + (size_t)(k + 1) * 2048); hbn = *(const GAS v4u*)(hbase + (size_t)(k + 1) * 2048 + 8); }
        if (k < 7) { int id[16];
#pragma unroll
            for (int q = 0; q < 4; ++q) { const v4u v = *(const LAS v4u*)(ldsw + (k + 1) * 128 + sg * 16 + 4 * q); id[4 * q] = (int)v.x; id[4 * q + 1] = (int)v.y; id[4 * q + 2] = (int)v.z; id[4 * q + 3] = (int)v.w; }
#pragma unroll
            for (int it = 0; it < 16; ++it) qn[it] = *(const GAS v4u*)(ubase + (unsigned)id[it] * 128u); }
        float h[16] = {bflo(ha.x), bfhi(ha.x), bflo(ha.y), bfhi(ha.y), bflo(ha.z), bfhi(ha.z), bflo(ha.w), bfhi(ha.w), bflo(hb.x), bfhi(hb.x), bflo(hb.y), bfhi(hb.y), bflo(hb.z), bfhi(hb.z), bflo(hb.w), bfhi(hb.w)};
        float hm = 0.f;
#pragma unroll
        for (int j = 0; j < 16; ++j) hm = fmaxf(hm, fabsf(h[j]));
        hm = fmaxf(hm, __shfl_xor(hm, 1)); hm = fmaxf(hm, __shfl_xor(hm, 2)); hm = fmaxf(hm, __shfl_xor(hm, 4));
        const float hinv = hm > 0.f ? 127.0f / hm : 0.f, hs = hm * (1.0f / 127.0f);
        int hq[4];
#pragma unroll
        for (int j = 0; j < 4; ++j) hq[j] = (int)pack_i8x4(h[4 * j] * hinv, h[4 * j + 1] * hinv, h[4 * j + 2] * hinv, h[4 * j + 3] * hinv);
        float p[16];
#pragma unroll
        for (int it = 0; it < 16; ++it) { int a = __builtin_amdgcn_sdot4((int)qc[it].x, hq[0], 0, false); a = __builtin_amdgcn_sdot4((int)qc[it].y, hq[1], a, false);
            a = __builtin_amdgcn_sdot4((int)qc[it].z, hq[2], a, false); a = __builtin_amdgcn_sdot4((int)qc[it].w, hq[3], a, false);
            p[it] = (float)a * hs; }
#pragma unroll
        for (int i = 0; i < 8; ++i) { const bool up = (lane & 4) != 0; const float snd = up ? p[i] : p[i + 8], kp = up ? p[i + 8] : p[i]; p[i] = kp + __shfl_xor(snd, 4); }
#pragma unroll
        for (int i = 0; i < 4; ++i) { const bool up = (lane & 2) != 0; const float snd = up ? p[i] : p[i + 4], kp = up ? p[i + 4] : p[i]; p[i] = kp + __shfl_xor(snd, 2); }
#pragma unroll
        for (int i = 0; i < 2; ++i) { const bool up = (lane & 1) != 0; const float snd = up ? p[i] : p[i + 2], kp = up ? p[i + 2] : p[i]; p[i] = kp + __shfl_xor(snd, 1); }
        ((GAS unsigned*)part)[((size_t)t * 16 + s) * 64 + lane] = pk2c(p[0], p[1]);
    }
    LDS_WAIT();
}
__device__ __forceinline__ void peer_coef_tokens4(int t0, int ts, int lane, const float* part, const int* sel_e, float* sel_g, const float* sel_s, const float* US, const float* VS) {
    unsigned pv[4][16]; v2u e[4]; f32x2v g[4]; float dn[4];
#pragma unroll
    for (int i = 0; i < 4; ++i) { const int t = t0 + i * ts;
#pragma unroll
        for (int s = 0; s < 16; ++s) pv[i][s] = ((const GAS unsigned*)part)[((size_t)t * 16 + s) * 64 + lane];
        e[i] = *(const GAS v2u*)(sel_e + (size_t)t * 128 + 2 * lane); g[i] = *(const GAS f32x2v*)(sel_g + (size_t)t * 128 + 2 * lane); dn[i] = ((const GAS float*)sel_s)[(size_t)t * 8 + (lane >> 3)]; }
    float ux[4], uy[4], vx[4], vy[4];
#pragma unroll
    for (int i = 0; i < 4; ++i) { ux[i] = ((const GAS float*)US)[e[i].x]; uy[i] = ((const GAS float*)US)[e[i].y]; vx[i] = ((const GAS float*)VS)[e[i].x]; vy[i] = ((const GAS float*)VS)[e[i].y]; }
#pragma unroll
    for (int i = 0; i < 4; ++i) { const int t = t0 + i * ts; float a0 = 0.f, a1 = 0.f;
#pragma unroll
        for (int s = 0; s < 16; ++s) { a0 += bflo(pv[i][s]); a1 += bfhi(pv[i][s]); }
        const float inv = 1.0f / dn[i];
        const float ox = g[i].x * inv * gelu_exact(a0 * ux[i]) * vx[i], oy = g[i].y * inv * gelu_exact(a1 * uy[i]) * vy[i];
        const h2_t ha = {(_Float16)ox, (_Float16)ox}, hb = {(_Float16)oy, (_Float16)oy};
        *(GAS v2u*)(sel_g + (size_t)t * 128 + 2 * lane) = (v2u){__builtin_bit_cast(unsigned, ha), __builtin_bit_cast(unsigned, hb)}; }
}
__device__ __forceinline__ bool slice_item8(const SliceSched& S, const Ctx& c, int i, int& slice, int& tb) {
    if (S.mode) { const int it = S.rank + i * S.nloc; if (it >= 256) return false; slice = S.xcc; tb = it; return true; }
    const int it = (int)blockIdx.x + i * c.G; if (it >= 2048) return false; slice = it >> 8; tb = it & 255; return true;
}
template <int MODE = 0>
__device__ __forceinline__ void spmm6_load(const unsigned char* vbase, const LAS unsigned* ids8, v4u (&qa)[8], v2u (&qb)[8]) {
    const v4u i0 = *(const LAS v4u*)(ids8), i1 = *(const LAS v4u*)(ids8 + 4);
    const unsigned id[8] = {i0.x, i0.y, i0.z, i0.w, i1.x, i1.y, i1.z, i1.w};
    if constexpr (MODE == 2) {
#pragma unroll
        for (int it = 0; it < 8; ++it) { qa[it] = (v4u){id[it], id[it] + 1u, id[it] + 2u, id[it] + 3u}; qb[it] = (v2u){id[it] + 4u, id[it] + 5u}; }
        return; }
#pragma unroll
    for (int it = 0; it < 8; ++it) { const unsigned char* p = vbase + id[it] * 192u; qa[it] = *(const GAS v4u*)p; qb[it] = *(const GAS v2u*)(p + 16); }
}
template <int MODE = 0>
__device__ __forceinline__ void spmm6_fma(const v4u (&qa)[8], const v2u (&qb)[8], const LAS unsigned* cf8, h2_t (&y)[16]) {
    const v4u c0 = *(const LAS v4u*)(cf8), c1 = *(const LAS v4u*)(cf8 + 4);
    const unsigned cf[8] = {c0.x, c0.y, c0.z, c0.w, c1.x, c1.y, c1.z, c1.w};
    if constexpr (MODE == 1) {
#pragma unroll
        for (int it = 0; it < 8; ++it) { const unsigned x = (qa[it].x ^ qa[it].y) ^ (qa[it].z ^ qa[it].w) ^ (qb[it].x ^ qb[it].y) ^ cf[it]; y[it] = __builtin_bit_cast(h2_t, __builtin_bit_cast(unsigned, y[it]) ^ x); }
        return; }
#pragma unroll
    for (int it = 0; it < 8; ++it) { const v6u q = {qa[it].x, qa[it].y, qa[it].z, qa[it].w, qb[it].x, qb[it].y};
        const v32h_t f = __builtin_amdgcn_cvt_scalef32_pk32_f16_fp6(q, 1.0f); const h2_t c2 = __builtin_bit_cast(h2_t, cf[it]);
#pragma unroll
        for (int j = 0; j < 16; ++j) { const h2_t v = {f[2 * j], f[2 * j + 1]}; y[j] = __builtin_elementwise_fma(v, c2, y[j]); } }
}
template <int MODE = 0>
__device__ __forceinline__ void peer_spmm6_wave(int t0, int s, int lane, const unsigned char* V6, const int* sel_e, const float* coef, const float* x1, float* xout, LAS unsigned* ldsw) {
    const int cg = lane & 7, sg = lane >> 3;
#pragma unroll
    for (int j = 0; j < 4; ++j) { *(LAS v4u*)(ldsw + 4 * (lane + 64 * j)) = *(const GAS v4u*)(sel_e + (size_t)t0 * 128 + 4 * (lane + 64 * j));
        *(LAS v4u*)(ldsw + 1024 + 4 * (lane + 64 * j)) = *(const GAS v4u*)(coef + (size_t)t0 * 128 + 4 * (lane + 64 * j)); }
    LDS_WAIT();
    const unsigned char* vbase = V6 + (size_t)s * V6_SLICE + cg * 24;
    const LAS unsigned* idl = ldsw + sg * 16; const LAS unsigned* cfl = ldsw + 1024 + sg * 16;
    v4u qa0[8], qa1[8]; v2u qb0[8], qb1[8];
    spmm6_load<MODE>(vbase, idl, qa0, qb0);
    const size_t xoff = (size_t)t0 * 2048 + s * 256 + cg * 32 + 4 * sg;
    f32x4 xn = *(const GAS f32x4*)(x1 + xoff);
#pragma unroll 1
    for (int k = 0; k < 8; ++k) {
        const f32x4 xv = xn;
        h2_t y[16];
#pragma unroll
        for (int j = 0; j < 16; ++j) y[j] = (h2_t){(_Float16)0.f, (_Float16)0.f};
        spmm6_load<MODE>(vbase, idl + k * 128 + 8, qa1, qb1);
        if (k < 7) xn = *(const GAS f32x4*)(x1 + xoff + (size_t)(k + 1) * 2048);
        spmm6_fma<MODE>(qa0, qb0, cfl + k * 128, y);
        if (k < 7) spmm6_load<MODE>(vbase, idl + (k + 1) * 128, qa0, qb0);
        spmm6_fma<MODE>(qa1, qb1, cfl + k * 128 + 8, y);
        unsigned u[16];
#pragma unroll
        for (int j = 0; j < 16; ++j) u[j] = __builtin_bit_cast(unsigned, y[j]);
#pragma unroll
        for (int i = 0; i < 8; ++i) { const bool up = (lane & 32) != 0; const unsigned snd = up ? u[i] : u[i + 8], kp = up ? u[i + 8] : u[i]; u[i] = __builtin_bit_cast(unsigned, __builtin_bit_cast(h2_t, kp) + __builtin_bit_cast(h2_t, (unsigned)__shfl_xor((int)snd, 32))); }
#pragma unroll
        for (int i = 0; i < 4; ++i) { const bool up = (lane & 16) != 0; const unsigned snd = up ? u[i] : u[i + 4], kp = up ? u[i + 4] : u[i]; u[i] = __builtin_bit_cast(unsigned, __builtin_bit_cast(h2_t, kp) + __builtin_bit_cast(h2_t, (unsigned)__shfl_xor((int)snd, 16))); }
#pragma unroll
        for (int i = 0; i < 2; ++i) { const bool up = (lane & 8) != 0; const unsigned snd = up ? u[i] : u[i + 2], kp = up ? u[i + 2] : u[i]; u[i] = __builtin_bit_cast(unsigned, __builtin_bit_cast(h2_t, kp) + __builtin_bit_cast(h2_t, (unsigned)__shfl_xor((int)snd, 8))); }
        const h2_t r0 = __builtin_bit_cast(h2_t, u[0]), r1 = __builtin_bit_cast(h2_t, u[1]);
        f32x4 o; o.x = xv.x + (float)r0[0]; o.y = xv.y + (float)r0[1]; o.z = xv.z + (float)r1[0]; o.w = xv.w + (float)r1[1];
        *(GAS f32x4*)(xout + xoff + (size_t)k * 2048) = o;
    }
    LDS_WAIT();
}

struct Args { const float* in[21]; float* out; unsigned char* ws; int lo, hi, li, pad; };
__global__ void __launch_bounds__(512, 2) mk_fwd(Args args) {
    extern __shared__ __attribute__((aligned(16))) unsigned char lds_raw[];
    Ctx c; c.lds = (LAS unsigned char*)lds_raw; c.tid = threadIdx.x; c.lane = c.tid & 63; c.wave = __builtin_amdgcn_readfirstlane(c.tid >> 6);
    c.G = gridDim.x; c.gw = blockIdx.x * 8 + c.wave; c.NGW = c.G * 8;
    volatile LAS unsigned* MISC = (volatile LAS unsigned*)(c.lds + MISC_OFF);
    if (c.tid < 32) MISC[c.tid] = 0u;
    __syncthreads();
    unsigned char* ws = args.ws;
    const int lo = args.lo, hi = args.hi;
    XcdBarrier bar; bar.w0 = 0; bar.bar = (unsigned*)(ws + WS_CTL) + CW_BAR + args.li * XCD_BAR_WORDS; bar.x = 0; bar.st = nullptr;
    if (hi - lo > 1) bar = xcd_barrier_post((unsigned*)(ws + WS_CTL) + CW_BAR + args.li * XCD_BAR_WORDS, MISC + 8);
#ifndef ATTN_REPS
#define ATTN_REPS 1
#endif
#ifndef PHMASK
#define PHMASK 0x1fff
#endif
#ifndef REP_PH
#define REP_PH (-1)
#endif
    int rep2 = 2; asm volatile("" : "+s"(rep2));
#define RLOOP(k, cond) for (int rp_ = 0; rp_ < ((((k) == REP_PH) && (cond)) ? rep2 : 1); ++rp_)
#define RSYNC do { if (rp_) xcd_barrier(bar); } while (0)
#define IN(k) (((PHMASK >> ((k) % NPH)) & 1) && lo <= (k) && (k) < hi)
#define SEAM(k) do { if (IN(k) && IN((k) + 1)) xcd_barrier(bar); } while (0)
#define PH_BEGIN unsigned char* w = ws; float* outp = args.out; Ctx cc = c; int zi = 0; cc.lane = xb_lane_id(); cc.tid = cc.wave * 64 + cc.lane; \
    asm volatile("" : "+s"(w), "+s"(outp), "+s"(zi), "+v"(cc.tid), "+v"(cc.lane)); (void)w; (void)outp;
#define INP(k) (args.in[(k) + zi])
#define WSP(T, off) ((T*)(w + (off)))
    for (int l = 0; l < 2; ++l) {
        const int pb = l * NPH;
        if (IN(pb + 0)) { PH_BEGIN
            P0Args a; a.w_in = INP(2) + (size_t)l * DM * INW; a.w_br_sb = INP(11) + (size_t)l * BW * DM; a.w_br_hg = INP(12) + (size_t)l * BW * DM; a.w_br_conv = INP(13) + (size_t)l * BW * DM;
            a.w_o = INP(14) + (size_t)l * DM * DM; a.w_q = INP(16) + (size_t)l * DM * DM; a.u = INP(19) + (size_t)l * 16384 * 2048; a.v = INP(20) + (size_t)l * 16384 * 2048; a.lbp = INP(5);
            a.WinT = WSP(bf16, WS_WIN); a.WbrT = WSP(bf16, WS_WBR); a.WoT = WSP(bf16, WS_WO); a.WqT = WSP(bf16, WS_WQ); a.U = WSP(unsigned char, WS_U); a.V = WSP(unsigned char, WS_V); a.US = WSP(float, WS_US); a.VS = WSP(float, WS_VS); a.LB = WSP(float, WS_LB); a.layer = l; a.k1 = INP(17) + (size_t)l * 8 * 16384; a.k2 = INP(18) + (size_t)l * 8 * 16384; a.KB = WSP(bf16, WS_KEYS);
#ifndef REP_MODE0
#define REP_MODE0 15
#endif
            RLOOP(0, true) { RSYNC;
            int pm_ = 15; if (REP_PH == 0) { pm_ = rp_ ? REP_MODE0 : 15; asm volatile("" : "+s"(pm_)); }
            p0_convert(cc, a, pm_);
            if (pm_ & 8) rms_phase_i8(cc, l == 0 ? INP(0) : WSP(const float, WS_X2), INP(1) + (size_t)l * DM, WSP(unsigned char, WS_H), WSP(float, WS_SA)); }
        }
        SEAM(pb + 0);
        if (IN(pb + 1)) { PH_BEGIN
            RLOOP(1, true) { RSYNC;
            pg8::Gemm g{WSP(bf16, WS_H), WSP(bf16, WS_WIN), NTOK, INW, DM}; pg8::StaticOrder S; S.init(NTOK, INW, cc.G, (int)blockIdx.x);
            EpiIn E{WSP(bf16, WS_SEG), WSP(bf16, WS_GATE), WSP(float, WS_LB), WSP(float, WS_SA)};
            pg8::gemm_phase<EpiIn, pg8::StaticOrder, true, true, true>(cc.lds, g, S, E, cc.wave); }
        }
        SEAM(pb + 1);
        if (IN(pb + 2)) { PH_BEGIN
            bf16* SEG = WSP(bf16, WS_SEG);
            RLOOP(2, true) { RSYNC;
            conv_phase(cc, SEG + 7 * SEGSZ, INP(7) + (size_t)l * 31 * 1024, INP(8) + (size_t)l * 1024, INP(9) + (size_t)l * 1024, INP(10) + (size_t)l * 1024, WSP(bf16, WS_CONV));
            for (int ci = blockIdx.x; ci < 2048; ci += cc.G) hgA_chunk(cc, ci, SEG + 4 * SEGSZ, SEG + 5 * SEGSZ, WSP(bf16, WS_ST), WSP(float, WS_DEC));
            if (!rp_)
            for (int r = cc.gw; r < 2 * (NTOK / 4); r += cc.NGW) {
                if (r < NTOK / 4) qknorm_rows4(SEG + (size_t)r * 4 * 1024, 1024, INP(3) + (size_t)l * 128, 0.08838834764831845f, cc.lane);
                else qknorm_rows4(SEG + SEGSZ + (size_t)(r - NTOK / 4) * 4 * 1024, 1024, INP(4) + (size_t)l * 128, 1.0f, cc.lane);
            }
            LAS unsigned short* scr = (LAS unsigned short*)(cc.lds + 4096 + cc.wave * 8192);
            for (int it = cc.gw; it < 8192; it += cc.NGW) vt_item(it, cc.lane, SEG + 2 * SEGSZ, WSP(bf16, WS_MERGED), scr); }
        }
        SEAM(pb + 2);
        if (IN(pb + 3)) { PH_BEGIN
            bf16* SEG = WSP(bf16, WS_SEG);
            RLOOP(3, true) { RSYNC;
            if (!rp_) hgB(cc, WSP(bf16, WS_ST), WSP(float, WS_DEC));
            for (int p = blockIdx.x; p < 256; p += cc.G) { const int bh = (p & 7) * 4 + (p >> 6), j = (p >> 3) & 7;
                if (cc.wave >= 4) {
#pragma unroll 1
                    for (int u = 0; u < 2; ++u) attn_unit<true>(cc, bh, u ? j : 15 - j, SEG, SEG + SEGSZ, WSP(bf16, WS_MERGED), SEG + 2 * SEGSZ);
                } else {
#pragma unroll 1
                    for (int u = 0; u < 2; ++u) attn_unit<false>(cc, bh, u ? j : 15 - j, SEG, SEG + SEGSZ, WSP(bf16, WS_MERGED), SEG + 2 * SEGSZ);
                } } }
        }
        SEAM(pb + 3);
        if (IN(pb + 4)) { PH_BEGIN
            bf16* SEG = WSP(bf16, WS_SEG);
            RLOOP(4, true) { RSYNC;
            for (int ci = blockIdx.x; ci < 2048; ci += cc.G) hgC_chunk(cc, ci, SEG + 3 * SEGSZ, SEG + 4 * SEGSZ, SEG + 5 * SEGSZ, SEG + 6 * SEGSZ, WSP(bf16, WS_ST), INP(6) + (size_t)l * 128, WSP(bf16, WS_HGR)); }
        }
        SEAM(pb + 4);
        if (IN(pb + 5)) { PH_BEGIN
            RLOOP(5, true) { RSYNC;
            pg8::StaticOrder S; S.init(NTOK, DM, cc.G, (int)blockIdx.x);
            { pg8::Gemm g{WSP(bf16, WS_SEG) + 2 * SEGSZ, WSP(bf16, WS_WBR), NTOK, DM, BW}; EpiMerge<true> E{WSP(bf16, WS_GATE), WSP(bf16, WS_MERGED)}; pg8::gemm_phase<EpiMerge<true>, pg8::StaticOrder, true, true>(cc.lds, g, S, E, cc.wave); }
            { pg8::Gemm g{WSP(bf16, WS_HGR), WSP(bf16, WS_WBR) + (size_t)DM * BW, NTOK, DM, BW}; EpiMerge<false> E{WSP(bf16, WS_GATE) + (size_t)NTOK * 2048, WSP(bf16, WS_MERGED)}; pg8::gemm_phase<EpiMerge<false>, pg8::StaticOrder, true, true>(cc.lds, g, S, E, cc.wave); }
            { pg8::Gemm g{WSP(bf16, WS_CONV), WSP(bf16, WS_WBR) + (size_t)2 * DM * BW, NTOK, DM, BW}; EpiMerge<false> E{WSP(bf16, WS_GATE) + (size_t)2 * NTOK * 2048, WSP(bf16, WS_MERGED)}; pg8::gemm_phase<EpiMerge<false>, pg8::StaticOrder, true, true>(cc.lds, g, S, E, cc.wave); } }
        }
        SEAM(pb + 5);
        if (IN(pb + 6)) { PH_BEGIN
            RLOOP(6, true) { RSYNC;
            pg8::Gemm g{WSP(bf16, WS_MERGED), WSP(bf16, WS_WO), NTOK, DM, DM}; pg8::StaticOrder S; S.init(NTOK, DM, cc.G, (int)blockIdx.x);
            EpiResid E{l == 0 ? INP(0) : WSP(const float, WS_X2), outp};
            pg8::gemm_phase<EpiResid, pg8::StaticOrder, true, true>(cc.lds, g, S, E, cc.wave); }
        }
        SEAM(pb + 6);
        if (IN(pb + 7)) { PH_BEGIN RLOOP(7, true) { RSYNC; rms_phase(cc, outp, INP(15) + (size_t)l * DM, WSP(bf16, WS_H)); } }
        SEAM(pb + 7);
        if (IN(pb + 8)) { PH_BEGIN
            RLOOP(8, true) { RSYNC;
            pg8::Gemm g{WSP(bf16, WS_H), WSP(bf16, WS_WQ), NTOK, DM, DM}; pg8::StaticOrder S; S.init(NTOK, DM, cc.G, (int)blockIdx.x);
            EpiStoreBf16 E{WSP(bf16, WS_QPEER)};
            pg8::gemm_phase<EpiStoreBf16, pg8::StaticOrder, true, true>(cc.lds, g, S, E, cc.wave); }
        }
        SEAM(pb + 8);
        if (IN(pb + 9)) { PH_BEGIN
            RLOOP(9, true) { RSYNC;
            for (int item = blockIdx.x; item < 512; item += cc.G) { const int hd = item & 7, tg = item >> 3;
                const bf16* KB = WSP(bf16, WS_KEYS);
#pragma unroll
                for (int i = 0; i < 8; ++i) { const int p = cc.tid + 512 * i, li = p >> 11, row = (p >> 4) & 127, c16 = p & 15;
                    *(LAS v4u*)(cc.lds + li * 128 * PK_KS + row * PK_KS + c16 * 16) = *(const GAS v4u*)(KB + (size_t)(li * 8 + hd) * 16384 + row * 128 + c16 * 8); }
                __syncthreads();
                peer_select32(hd, tg * 256 + cc.wave * 32, cc.lane, WSP(bf16, WS_QPEER), cc.lds, cc.lds + 128 * PK_KS, w, (LAS unsigned*)(cc.lds + 2 * 128 * PK_KS + cc.wave * 4096));
                __syncthreads(); } }
        }
        SEAM(pb + 9);
        if (IN(pb + 10)) { PH_BEGIN
            const SliceSched SS = slice_sched_init(cc, (unsigned*)(w + WS_CTL), bar, l * 2 + 0);
            RLOOP(10, true) { RSYNC;
            for (int i = 0;; ++i) { int sl, tb; if (!slice_item(SS, cc, i, sl, tb)) break;
                peer_sddmm_wave(tb * 64 + cc.wave * 8, sl, cc.lane, WSP(bf16, WS_H), WSP(unsigned char, WS_U), WSP(int, WS_SEL), WSP(float, WS_PART), (LAS unsigned*)(cc.lds + 4096 + cc.wave * 8192)); } }
        }
        SEAM(pb + 10);
        if (IN(pb + 11)) { PH_BEGIN
            for (int n = cc.gw; n < NTOK / 4; n += cc.NGW) peer_coef_tokens4(n, NTOK / 4, cc.lane, WSP(float, WS_PART), WSP(int, WS_SEL), WSP(float, WS_SEL + 8 * MiB), WSP(float, WS_SELS), WSP(float, WS_US), WSP(float, WS_VS));
        }
        SEAM(pb + 11);
        if (IN(pb + 12)) { PH_BEGIN
            float* xo = l == 0 ? WSP(float, WS_X2) : outp;
            const SliceSched SS = slice_sched_init(cc, (unsigned*)(w + WS_CTL), bar, l * 2 + 1);
#ifndef REP_MODE
#define REP_MODE 0
#endif
            RLOOP(12, l == 0) { RSYNC;
            if (REP_MODE && rp_) {
            for (int i = 0;; ++i) { int sl, tb; if (!slice_item8(SS, cc, i, sl, tb)) break;
                peer_spmm6_wave<REP_MODE>(tb * 64 + cc.wave * 8, sl, cc.lane, WSP(unsigned char, WS_V), WSP(int, WS_SEL), WSP(float, WS_SEL + 8 * MiB), outp, WSP(float, WS_SEG + 64 * MiB), (LAS unsigned*)(cc.lds + 4096 + cc.wave * 8192)); }
            } else
            for (int i = 0;; ++i) { int sl, tb; if (!slice_item8(SS, cc, i, sl, tb)) break;
                peer_spmm6_wave(tb * 64 + cc.wave * 8, sl, cc.lane, WSP(unsigned char, WS_V), WSP(int, WS_SEL), WSP(float, WS_SEL + 8 * MiB), outp, xo, (LAS unsigned*)(cc.lds + 4096 + cc.wave * 8192)); } }
        }
        SEAM(pb + 12);
    }
#undef PH_BEGIN
#undef INP
#undef WSP
#undef IN
#undef SEAM
}

#ifndef MK_SPLIT
#define MK_SPLIT 0
#endif
extern "C" void kernel_launch(void* const* d_in, const int* in_sizes, int n_in, void* d_out, int out_size, void* d_ws, size_t ws_size, hipStream_t stream) {
    static int grid = 0;
    if (grid == 0) {
        if (n_in != 21 || out_size != NTOK * DM || ws_size < WS_END) { fprintf(stderr, "kernel_launch: unexpected shapes (n_in %d, out %d, ws %zu < %zu); nothing launched\n", n_in, out_size, ws_size, (size_t)WS_END); grid = -1; return; }
        int dev = 0, cus = 0, per_cu = 0;
        if (hipGetDevice(&dev) != hipSuccess || hipDeviceGetAttribute(&cus, hipDeviceAttributeMultiprocessorCount, dev) != hipSuccess) { grid = -1; return; }
        if (hipFuncSetAttribute((const void*)mk_fwd, hipFuncAttributeMaxDynamicSharedMemorySize, LDS_BYTES) != hipSuccess) { fprintf(stderr, "kernel_launch: hipFuncSetAttribute failed\n"); grid = -1; return; }
        if (hipOccupancyMaxActiveBlocksPerMultiprocessor(&per_cu, (const void*)mk_fwd, 512, LDS_BYTES) != hipSuccess || per_cu < 1) fprintf(stderr, "kernel_launch: occupancy query reports %d\n", per_cu);
        (void)hipGetLastError();
        grid = cus;
    }
    if (grid < 0) return;
    if (hipMemsetAsync((char*)d_ws + WS_CTL, 0, 1 * MiB, stream) != hipSuccess) { fprintf(stderr, "kernel_launch: memset failed\n"); return; }
    Args a{};
    for (int i = 0; i < 21; ++i) a.in[i] = (const float*)d_in[i];
    a.out = (float*)d_out; a.ws = (unsigned char*)d_ws; a.pad = 0;
#if MK_SPLIT
    for (int p = 0; p < NPHASES; ++p) { a.lo = p; a.hi = p + 1; a.li = p; hipLaunchKernelGGL(mk_fwd, dim3(grid), dim3(512), LDS_BYTES, stream, a); }
#else
    a.lo = 0; a.hi = NPHASES; a.li = 0;
    hipLaunchKernelGGL(mk_fwd, dim3(grid), dim3(512), LDS_BYTES, stream, a);
#endif
    const hipError_t le = hipPeekAtLastError();
    if (le != hipSuccess) fprintf(stderr, "kernel_launch: launch failed: %s\n", hipGetErrorName(le));
}
```

```cpp
#include <hip/hip_runtime.h>
#include <cstdio>
#include <cstdint>
namespace pg8 {
#define PG8_LAS __attribute__((address_space(3)))
typedef unsigned short bf16_t;
typedef short bf16x8 __attribute__((ext_vector_type(8)));
typedef float f32x4 __attribute__((ext_vector_type(4)));
typedef unsigned u32x4 __attribute__((ext_vector_type(4)));
constexpr int BM = 256, BK = 64, HALF = 128, HTB = HALF * BK * 2  , STAGE_BYTES = 8 * HTB, NXCD = 8, WGM = 8;

__host__ __device__ __forceinline__ int lds_byte(int r, int c) { const int st = (r >> 4) * 2 + (c >> 5), rr = r & 15, cc = c & 31, ob = rr * 64 + cc * 2; return st * 1024 + (ob ^ (((ob >> 9) & 1) << 5)); }
__host__ __device__ __forceinline__ void stage_rc(int b, int& R, int& C) { const int st = b / 1024, sb = b % 1024, swz = sb ^ (((sb >> 9) & 1) << 5); R = (st >> 1) * 16 + swz / 64; C = (st & 1) * 32 + (swz % 64) / 2; }
__host__ __device__ __forceinline__ int perm32(int rho) { const int n = rho >> 4, i = rho & 15; return 8 * (i >> 2) + 4 * n + (i & 3); }

struct Unit { int pm, pn; };
struct Gemm { const bf16_t* A; const bf16_t* Bt; int M, N, K; };

struct StaticOrder {
    int nM, nN, nwg, G, c;
    __host__ __device__ void init(int M, int N, int G_, int c_) { nM = M / BM; nN = N / BM; nwg = nM * nN; G = G_; c = c_; }
    __host__ __device__ bool next(int i, Unit& u) const {
        const long L = (long)i * G + c; if (L >= nwg) return false;
        int wgid = (int)L; { const int q = nwg / NXCD, r = nwg % NXCD, xcd = wgid % NXCD, off = wgid / NXCD; wgid = (xcd < r ? xcd * (q + 1) : r * (q + 1) + (xcd - r) * q) + off; }
        const int nig = WGM * nN, gid = wgid / nig, fm = gid * WGM, gsz = (nM - fm) < WGM ? (nM - fm) : WGM;
        u.pm = fm + ((wgid % nig) % gsz); u.pn = (wgid % nig) / gsz; return true;
    }
    __device__ __forceinline__ void a_ready(const Unit&) const {}
    __device__ __forceinline__ void done(const Unit&) const {}
};

typedef float f32x2 __attribute__((ext_vector_type(2)));
template <class Epi, class Sched, bool ALIGN_EPI = false, bool SP2 = false, bool I8 = false>
__device__ __forceinline__ void gemm_phase(PG8_LAS unsigned char* lds, const Gemm g, const Sched& S, const Epi& E, int wave_) {
    unsigned z_ = 0u; asm volatile("" : "+s"(z_)); int tid_ = wave_ * 64 + (int)__builtin_amdgcn_mbcnt_hi(~0u, __builtin_amdgcn_mbcnt_lo(~0u, z_)); asm volatile("" : "+v"(tid_));     int K_ = g.K; asm volatile("" : "+s"(K_));
    const int tid = tid_, wid = __builtin_amdgcn_readfirstlane(tid >> 6), lane = tid & 63, wr = wid >> 2, wc = wid & 3, fr = lane & 15, fq = lane >> 4;
    const int K = I8 ? (K_ >> 1) : K_, nt = K / BK;
    unsigned voffA[2], voffB[2];
#pragma unroll
    for (int i = 0; i < 2; ++i) { int R, C; stage_rc(tid * 16 + i * 8192, R, C); const int Rb = Epi::PERM ? ((R & ~31) + perm32(R & 31)) : R;
        voffA[i] = (unsigned)(R * K + C) * 2u; voffB[i] = (unsigned)(Rb * K + C) * 2u; }
    const size_t kstep = (size_t)(BK * 2);
    const size_t hstep = (size_t)HALF * K * 2;
    const size_t tstep = 2 * hstep;
    const unsigned ldsw = (unsigned)wid * 1024u;
    const int aoff = lds_byte(wr * 64 + fr, fq * 8), boff = lds_byte(wc * 32 + fr, fq * 8);
#define PG8_SA(b, h) (((b) * 2 + (h)) * HTB)
#define PG8_SB(b, h) ((4 + (b) * 2 + (h)) * HTB)
#define PG8_STAGE(bufoff, gbase, voff) do { _Pragma("unroll") for (int _i = 0; _i < 2; ++_i) \
        __builtin_amdgcn_global_load_lds((const unsigned*)((const char*)(gbase) + (voff)[_i]), (PG8_LAS unsigned*)(lds + (bufoff) + ldsw + _i * 8192), 16, 0, 0); } while (0)
#define PG8_LDA(dst, b, h) do { _Pragma("unroll") for (int m = 0; m < 4; ++m) _Pragma("unroll") for (int k = 0; k < 2; ++k) dst[m][k] = *(const PG8_LAS bf16x8*)(lds + PG8_SA(b, h) + aoff + m * 2048 + k * 1024); } while (0)
#define PG8_LDB(dst, b, h) do { _Pragma("unroll") for (int n = 0; n < 2; ++n) _Pragma("unroll") for (int k = 0; k < 2; ++k) dst[n][k] = *(const PG8_LAS bf16x8*)(lds + PG8_SB(b, h) + boff + n * 2048 + k * 1024); } while (0)
#define PG8_MMA(ai, bj, At, Bt) do { __builtin_amdgcn_s_setprio(1); _Pragma("unroll") for (int m = 0; m < 4; ++m) _Pragma("unroll") for (int n = 0; n < 2; ++n) _Pragma("unroll") for (int k = 0; k < 2; ++k) { \
        if constexpr (I8) { typedef int v4i_t __attribute__((ext_vector_type(4))); \
            acc[ai][bj][m][n] = __builtin_bit_cast(f32x4, __builtin_amdgcn_mfma_i32_16x16x64_i8(__builtin_bit_cast(v4i_t, Bt[n][k]), __builtin_bit_cast(v4i_t, At[m][k]), __builtin_bit_cast(v4i_t, acc[ai][bj][m][n]), 0, 0, 0)); } \
        else acc[ai][bj][m][n] = __builtin_amdgcn_mfma_f32_16x16x32_bf16(Bt[n][k], At[m][k], acc[ai][bj][m][n], 0, 0, 0); } __builtin_amdgcn_s_setprio(0); } while (0)
#define PG8_WAIT_V(n) asm volatile("s_waitcnt vmcnt(" #n ")" ::: "memory")
#define PG8_WAIT_L(n) asm volatile("s_waitcnt lgkmcnt(" #n ")" ::: "memory")
#define PG8_BAR __builtin_amdgcn_s_barrier()
#define PG8_SCHED __builtin_amdgcn_sched_barrier(0)
    Unit cur, nxt; int ui = 0;
    if (!S.next(0, cur)) return;
    f32x4 acc[2][2][4][2];
#pragma unroll
    for (int a = 0; a < 2; ++a)
#pragma unroll
        for (int b = 0; b < 2; ++b)
#pragma unroll
            for (int m = 0; m < 4; ++m)
#pragma unroll
                for (int n = 0; n < 2; ++n) acc[a][b][m][n] = (f32x4){0.f, 0.f, 0.f, 0.f};
    bf16x8 At[4][2], B0[2][2], B1[2][2];
    const char* cA = (const char*)g.A + (size_t)cur.pm * tstep; const char* cB = (const char*)g.Bt + (size_t)cur.pn * tstep;
    S.a_ready(cur);
    if constexpr (SP2) {
        PG8_STAGE(PG8_SB(0, 0), cB, voffB); PG8_STAGE(PG8_SB(0, 1), cB + hstep, voffB); PG8_STAGE(PG8_SA(0, 0), cA, voffA); PG8_STAGE(PG8_SA(0, 1), cA + hstep, voffA);
        if (wr == 1) PG8_BAR;
        PG8_WAIT_V(2); PG8_BAR;
        PG8_STAGE(PG8_SB(1, 0), cB + kstep, voffB); PG8_STAGE(PG8_SA(1, 0), cA + kstep, voffA); PG8_STAGE(PG8_SB(1, 1), cB + hstep + kstep, voffB);
        PG8_WAIT_V(6); PG8_BAR;
    } else {
        PG8_STAGE(PG8_SB(0, 0), cB, voffB); PG8_STAGE(PG8_SA(0, 0), cA, voffA); PG8_STAGE(PG8_SB(0, 1), cB + hstep, voffB); PG8_STAGE(PG8_SA(0, 1), cA + hstep, voffA);
        if (wr == 1) PG8_BAR;
        PG8_WAIT_V(4); PG8_BAR;
        PG8_STAGE(PG8_SB(1, 0), cB + kstep, voffB); PG8_STAGE(PG8_SA(1, 0), cA + kstep, voffA); PG8_STAGE(PG8_SB(1, 1), cB + hstep + kstep, voffB);
        PG8_WAIT_V(6); PG8_BAR;
    }
    for (;;) {
        const bool has_next = S.next(ui + 1, nxt);
        const char* nA = has_next ? (const char*)g.A + (size_t)nxt.pm * tstep : cA; const char* nB = has_next ? (const char*)g.Bt + (size_t)nxt.pn * tstep : cB;
        for (int t = 0; t < nt; t += 2) {
            const bool last = (t == nt - 2);
            const char* a1 = cA + (size_t)(t + 1) * kstep;
            const char* a2 = last ? nA : cA + (size_t)(t + 2) * kstep; const char* b2 = last ? nB : cB + (size_t)(t + 2) * kstep;
            const char* a3 = a2 + kstep; const char* b3 = b2 + kstep;
            if (last && has_next) S.a_ready(nxt);
            if constexpr (SP2) {
            PG8_LDB(B0, 0, 0); PG8_LDB(B1, 0, 1); PG8_SCHED; PG8_LDA(At, 0, 0); PG8_STAGE(PG8_SA(1, 1), a1 + hstep, voffA);
            PG8_WAIT_V(8); PG8_WAIT_L(0); PG8_BAR; PG8_MMA(0, 0, At, B0); PG8_MMA(0, 1, At, B1); PG8_BAR; PG8_SCHED;
            PG8_LDA(At, 0, 1); PG8_STAGE(PG8_SB(0, 0), b2, voffB); PG8_STAGE(PG8_SB(0, 1), b2 + hstep, voffB); PG8_STAGE(PG8_SA(0, 0), a2, voffA);
            PG8_WAIT_V(8); PG8_WAIT_L(0); PG8_BAR; PG8_MMA(1, 0, At, B0); PG8_MMA(1, 1, At, B1); PG8_BAR; PG8_SCHED;
            PG8_LDB(B0, 1, 0); PG8_LDB(B1, 1, 1); PG8_SCHED; PG8_LDA(At, 1, 0); PG8_STAGE(PG8_SA(0, 1), a2 + hstep, voffA);
            PG8_WAIT_V(8); PG8_WAIT_L(0); PG8_BAR; PG8_MMA(0, 0, At, B0); PG8_MMA(0, 1, At, B1); PG8_BAR; PG8_SCHED;
            PG8_LDA(At, 1, 1); PG8_STAGE(PG8_SB(1, 0), b3, voffB); PG8_STAGE(PG8_SB(1, 1), b3 + hstep, voffB); PG8_STAGE(PG8_SA(1, 0), a3, voffA);
            PG8_WAIT_V(8); PG8_WAIT_L(0); PG8_BAR; PG8_MMA(1, 0, At, B0); PG8_MMA(1, 1, At, B1); PG8_BAR; PG8_SCHED;
            } else {
            PG8_LDB(B0, 0, 0); PG8_SCHED; PG8_LDA(At, 0, 0); PG8_STAGE(PG8_SA(1, 1), a1 + hstep, voffA);
            PG8_WAIT_L(8); PG8_BAR; PG8_WAIT_L(0); PG8_MMA(0, 0, At, B0); PG8_BAR; PG8_SCHED;
            PG8_LDB(B1, 0, 1); PG8_STAGE(PG8_SB(0, 0), b2, voffB);
            PG8_BAR; PG8_WAIT_L(0); PG8_MMA(0, 1, At, B1); PG8_BAR;
            PG8_LDA(At, 0, 1); PG8_STAGE(PG8_SA(0, 0), a2, voffA);
            PG8_BAR; PG8_WAIT_L(0); PG8_MMA(1, 0, At, B0); PG8_BAR; PG8_SCHED;
            PG8_STAGE(PG8_SB(0, 1), b2 + hstep, voffB);
            PG8_WAIT_V(6); PG8_BAR; PG8_MMA(1, 1, At, B1); PG8_BAR;
            PG8_LDB(B0, 1, 0); PG8_SCHED; PG8_LDA(At, 1, 0); PG8_STAGE(PG8_SA(0, 1), a2 + hstep, voffA);
            PG8_WAIT_L(8); PG8_BAR; PG8_WAIT_L(0); PG8_MMA(0, 0, At, B0); PG8_BAR; PG8_SCHED;
            PG8_LDB(B1, 1, 1); PG8_STAGE(PG8_SB(1, 0), b3, voffB);
            PG8_BAR; PG8_WAIT_L(0); PG8_MMA(0, 1, At, B1); PG8_BAR;
            PG8_LDA(At, 1, 1); PG8_STAGE(PG8_SA(1, 0), a3, voffA);
            PG8_BAR; PG8_WAIT_L(0); PG8_MMA(1, 0, At, B0); PG8_BAR; PG8_SCHED;
            PG8_STAGE(PG8_SB(1, 1), b3 + hstep, voffB);
            PG8_WAIT_V(6); PG8_BAR; PG8_MMA(1, 1, At, B1); PG8_BAR;
            }
        }
        if constexpr (ALIGN_EPI) { if (wr == 0) PG8_BAR; }
        if constexpr (I8) {
#pragma unroll
            for (int a = 0; a < 2; ++a)
#pragma unroll
                for (int m = 0; m < 4; ++m) { const float r_ = E.rowscale(cur.pm * BM + wr * 64 + fr + a * HALF + m * 16);
#pragma unroll
                    for (int b = 0; b < 2; ++b)
#pragma unroll
                        for (int n = 0; n < 2; ++n) { typedef int v4i2_t __attribute__((ext_vector_type(4))); const v4i2_t i_ = __builtin_bit_cast(v4i2_t, acc[a][b][m][n]);
                            acc[a][b][m][n] = (f32x4){(float)i_[0] * r_, (float)i_[1] * r_, (float)i_[2] * r_, (float)i_[3] * r_}; } }
        }
        if constexpr (!Epi::AFTER_DRAIN) { E(acc, cur, wr, wc, fr, fq); S.done(cur); }
        if (!has_next) break;
#pragma unroll
        for (int a = 0; a < 2; ++a)
#pragma unroll
            for (int b = 0; b < 2; ++b)
#pragma unroll
                for (int m = 0; m < 4; ++m)
#pragma unroll
                    for (int n = 0; n < 2; ++n) acc[a][b][m][n] = (f32x4){0.f, 0.f, 0.f, 0.f};
        cur = nxt; cA = nA; cB = nB; ++ui;
        if constexpr (ALIGN_EPI) { if (wr == 1) PG8_BAR; }
    }
    PG8_WAIT_V(0);
    if constexpr (!ALIGN_EPI) { if (wr == 0) PG8_BAR; }
    PG8_BAR;
    if constexpr (Epi::AFTER_DRAIN) { E.fused(acc, cur, wr, wc, fr, fq, lds, wid, lane); S.done(cur); }
#undef PG8_SA
#undef PG8_SB
#undef PG8_STAGE
#undef PG8_LDA
#undef PG8_LDB
#undef PG8_MMA
#undef PG8_WAIT_V
#undef PG8_WAIT_L
#undef PG8_BAR
#undef PG8_SCHED
}
}
#define XB_TMO      128
#define XB_XCNT(j)  (256  + 64 * (j))
#define XB_XSUB(j)  (1280 + 64 * (j))
#define XB_XGEN(j)  (2304 + 64 * (j))
#define XB_TOP      3328
#define XB_TOPGEN   3392
#define XCD_BAR_WORDS 3456
#define XB_SPIN_CAP (1u << 24)
#define LAS __attribute__((address_space(3)))

__device__ __forceinline__ unsigned xb_ld(unsigned* p)              { return __hip_atomic_load(p, __ATOMIC_RELAXED, __HIP_MEMORY_SCOPE_AGENT); }
__device__ __forceinline__ unsigned xb_add(unsigned* p, unsigned v) { return __hip_atomic_fetch_add(p, v, __ATOMIC_RELAXED, __HIP_MEMORY_SCOPE_AGENT); }
__device__ __forceinline__ unsigned xb_xcc_id() { return (unsigned)__builtin_amdgcn_s_getreg((3 << 11) | 20) & 0xFu; }
#define XB_SPIN(cond, bar) do { unsigned _sp = 0; while (cond) { __builtin_amdgcn_s_sleep(1); \
    if ((++_sp & 255u) == 0u) { if (xb_ld(&(bar)[XB_TMO])) break; if (_sp > XB_SPIN_CAP) { atomicAdd(&(bar)[XB_TMO], 1u); break; } } } } while (0)

__device__ __forceinline__ int xb_lane_id() { unsigned z = 0u; asm volatile("" : "+s"(z)); return (int)__builtin_amdgcn_mbcnt_hi(~0u, __builtin_amdgcn_mbcnt_lo(~0u, z)); }
struct XcdBarrier {
    unsigned w0;
    unsigned* bar; unsigned x;
    volatile LAS unsigned* st;
};

__device__ __forceinline__ XcdBarrier xcd_barrier_post(unsigned* bar, volatile LAS unsigned* st) {
    XcdBarrier b; b.bar = bar; b.x = xb_xcc_id(); b.st = st; b.w0 = (__builtin_amdgcn_readfirstlane((int)threadIdx.x >> 6) == 0) ? 1u : 0u;
    if (b.w0 && xb_lane_id() == 0) (void)xb_add(&bar[XB_XCNT(b.x)], 1u);
    return b;
}
__device__ __forceinline__ void xcd_barrier_complete(unsigned* bar, unsigned x, unsigned& nloc, unsigned& nx) {
    const unsigned G = gridDim.x * gridDim.y * gridDim.z;
    unsigned sum, cnt, mine, sp = 0u;
    for (;;) {
        sum = 0u; cnt = 0u; mine = 0u;
#pragma unroll
        for (unsigned j = 0; j < 16; ++j) { const unsigned c = xb_ld(&bar[XB_XCNT(j)]); sum += c; cnt += (c > 0u) ? 1u : 0u; mine = (j == x) ? c : mine; }
        if (sum == G) break;
        __builtin_amdgcn_s_sleep(1);
        if ((++sp & 255u) == 0u) { if (xb_ld(&bar[XB_TMO])) break; if (sp > XB_SPIN_CAP) { atomicAdd(&bar[XB_TMO], 1u); break; } }
    }
    nloc = mine > 0u ? mine : 1u; nx = cnt > 0u ? cnt : 1u;
}

__device__ __forceinline__ void xcd_barrier(const XcdBarrier& b) {
    asm volatile("s_waitcnt vmcnt(0)" ::: "memory");
    __syncthreads();
    if (b.w0 && xb_lane_id() == 0) {
        unsigned* bar = b.bar;
        __builtin_amdgcn_s_waitcnt(0);
        unsigned nloc = b.st[0], nx = b.st[1];
        if (nloc == 0u) { xcd_barrier_complete(bar, b.x, nloc, nx); b.st[0] = nloc; b.st[1] = nx; }
        const unsigned old = xb_add(&bar[XB_XSUB(b.x)], 1u);
        const unsigned gen = old / nloc;
        if (old + 1u == (gen + 1u) * nloc) {
            __builtin_amdgcn_fence(__ATOMIC_RELEASE, "agent");
            asm volatile("s_waitcnt vmcnt(0)" ::: "memory");
            const unsigned og = xb_add(&bar[XB_TOP], 1u);
            const unsigned tg = og / nx;
            if (og + 1u == (tg + 1u) * nx) xb_add(&bar[XB_TOPGEN], 1u);
            else XB_SPIN(xb_ld(&bar[XB_TOPGEN]) == tg, bar);
            __builtin_amdgcn_fence(__ATOMIC_ACQUIRE, "agent");
            xb_add(&bar[XB_XGEN(b.x)], 1u);
            asm volatile("s_waitcnt vmcnt(0)" ::: "memory");
        } else {
            XB_SPIN(xb_ld(&bar[XB_XGEN(b.x)]) == gen, bar);
            __builtin_amdgcn_fence(__ATOMIC_ACQUIRE, "agent");
            asm volatile("s_waitcnt vmcnt(0)" ::: "memory");
        }
    }
    __syncthreads();
}


#define GAS __attribute__((address_space(1)))
typedef unsigned short bf16;
typedef unsigned v4u __attribute__((ext_vector_type(4)));
typedef unsigned v2u __attribute__((ext_vector_type(2)));
typedef float f32x4 __attribute__((ext_vector_type(4)));
typedef float f32x2v __attribute__((ext_vector_type(2)));
typedef float f32x16 __attribute__((ext_vector_type(16)));
typedef short bf16x8 __attribute__((ext_vector_type(8)));
typedef __bf16 bf16v2 __attribute__((ext_vector_type(2)));
typedef _Float16 h2_t __attribute__((ext_vector_type(2)));
typedef _Float16 v32h_t __attribute__((ext_vector_type(32)));
typedef unsigned v6u __attribute__((ext_vector_type(6)));

constexpr int NTOK = 16384, DM = 2048, SEQ = 4096, INW = 15360, BW = 1024;
constexpr float EPS = 1e-6f;
constexpr float WIN_QS = 1024.0f;
constexpr int NPH = 13;
constexpr int NPHASES = 2 * NPH;

constexpr size_t MiB = 1u << 20;
constexpr size_t WS_CTL = 0;
constexpr size_t WS_LB = 1 * MiB;
constexpr size_t WS_SA = 1 * MiB + 192 * 1024;
constexpr size_t WS_US = 1 * MiB + 64 * 1024, WS_VS = 1 * MiB + 128 * 1024;
constexpr size_t WS_WIN = 2 * MiB;
constexpr size_t WS_WBR = 62 * MiB;
constexpr size_t WS_WO = 74 * MiB;
constexpr size_t WS_WQ = 82 * MiB;
constexpr size_t WS_U = 91 * MiB;
constexpr size_t WS_V = 155 * MiB;
constexpr size_t WS_H = 219 * MiB;
constexpr size_t WS_SEG = 283 * MiB;
constexpr size_t WS_GATE = 539 * MiB;
constexpr size_t WS_X2 = 731 * MiB;
constexpr size_t WS_CONV = 859 * MiB;
constexpr size_t WS_HGR = 891 * MiB;
constexpr size_t WS_MERGED = 923 * MiB;
constexpr size_t WS_SEL = 987 * MiB;
constexpr size_t WS_SELS = 1003 * MiB;
constexpr size_t WS_DEC = 1004 * MiB;
constexpr size_t WS_END = 1005 * MiB;
constexpr size_t WS_ST = WS_H;
constexpr size_t WS_KEYS = 90 * MiB;
constexpr size_t WS_PART = WS_GATE;
constexpr size_t WS_QPEER = WS_SEG;
constexpr size_t SEGSZ = (size_t)NTOK * 1024;
constexpr int CW_BAR = 4096;
constexpr int CW_RANK = 131072;

constexpr int RING_BYTES = 131072, MISC_OFF = RING_BYTES + 320, LDS_BYTES = 147456;

__device__ __forceinline__ unsigned pk2c(float lo, float hi) { f32x2v v = {lo, hi}; bf16v2 b = __builtin_convertvector(v, bf16v2); return __builtin_bit_cast(unsigned, b); }
__device__ __forceinline__ float bflo(unsigned x) { return __uint_as_float(x << 16); }
__device__ __forceinline__ float bfhi(unsigned x) { return __uint_as_float(x & 0xffff0000u); }
__device__ __forceinline__ float sigm(float x) { return __builtin_amdgcn_rcpf(1.0f + __expf(-x)); }
__device__ __forceinline__ float wave_sum(float v) {
#pragma unroll
    for (int o = 1; o < 64; o <<= 1) v += __shfl_xor(v, o);
    return v;
}
__device__ __forceinline__ float wave_max(float v) {
#pragma unroll
    for (int o = 1; o < 64; o <<= 1) v = fmaxf(v, __shfl_xor(v, o));
    return v;
}
#define LDS_WAIT() asm volatile("s_waitcnt lgkmcnt(0)" ::: "memory")
#define MFMA32(a, b, c) __builtin_amdgcn_mfma_f32_32x32x16_bf16((a), (b), (c), 0, 0, 0)
__device__ __forceinline__ int ridx16(int lane) { return ((lane >> 5) & 1) * 8 + ((lane >> 4) & 1) * 4 + ((lane >> 3) & 1) * 2 + ((lane >> 2) & 1); }
__device__ __forceinline__ void xreduce16(float (&v)[16], int lane) {
#pragma unroll
    for (int i = 0; i < 8; ++i) { const bool up = (lane & 32) != 0; const float snd = up ? v[i] : v[i + 8], kp = up ? v[i + 8] : v[i]; v[i] = kp + __shfl_xor(snd, 32); }
#pragma unroll
    for (int i = 0; i < 4; ++i) { const bool up = (lane & 16) != 0; const float snd = up ? v[i] : v[i + 4], kp = up ? v[i + 4] : v[i]; v[i] = kp + __shfl_xor(snd, 16); }
#pragma unroll
    for (int i = 0; i < 2; ++i) { const bool up = (lane & 8) != 0; const float snd = up ? v[i] : v[i + 2], kp = up ? v[i + 2] : v[i]; v[i] = kp + __shfl_xor(snd, 8); }
    { const bool up = (lane & 4) != 0; const float snd = up ? v[0] : v[1], kp = up ? v[1] : v[0]; v[0] = kp + __shfl_xor(snd, 4); }
    v[0] += __shfl_xor(v[0], 2); v[0] += __shfl_xor(v[0], 1);
}
__device__ __forceinline__ float gelu_exact(float v) {
    const float av = fabsf(v), t = __builtin_amdgcn_rcpf(av * 0.2316418882f + 1.0f);
    float q = t * 0.5307027145f + (-0.7265760135f); q = q * t + 0.7107068705f; q = q * t + (-0.142248368f); q = q * t + 0.127414796f; q = q * t;
    const float e = __builtin_amdgcn_exp2f((v * v) * (-0.72134752044f));
    const float m = v * (q * e);
    return v < 0.f ? m : v - m;
}

struct Ctx { LAS unsigned char* lds; int tid, lane, wave, G, gw, NGW; };

__device__ __forceinline__ void tr_item(const float* W, int K, int N, bf16* WT, int k0, int n0, int drow0, LAS float* scr, int lane) {
    { const int lr = lane >> 3, lc = (lane & 7) * 4; f32x4 v[8];
#pragma unroll
      for (int j = 0; j < 8; ++j) v[j] = *(const GAS f32x4*)(W + (size_t)(k0 + lr + 8 * j) * N + n0 + lc);
#pragma unroll
      for (int j = 0; j < 8; ++j) { LAS float* d = scr + (lr + 8 * j) * 33 + lc; d[0] = v[j].x; d[1] = v[j].y; d[2] = v[j].z; d[3] = v[j].w; } }
    LDS_WAIT();
    const int c = lane & 7;
#pragma unroll
    for (int j = 0; j < 4; ++j) { const int n = (lane >> 3) + 8 * j; const LAS float* s = scr + (8 * c) * 33 + n;
        v4u o; o.x = pk2c(s[0], s[33]); o.y = pk2c(s[66], s[99]); o.z = pk2c(s[132], s[165]); o.w = pk2c(s[198], s[231]);
        *(GAS v4u*)(WT + (size_t)(drow0 + n) * K + k0 + 8 * c) = o; }
    LDS_WAIT();
}
__device__ __forceinline__ unsigned pack_i8x4c(float a, float b, float c, float d) {
    const int ia = (int)__builtin_rintf(fminf(fmaxf(a, -127.f), 127.f)), ib = (int)__builtin_rintf(fminf(fmaxf(b, -127.f), 127.f)), ic = (int)__builtin_rintf(fminf(fmaxf(c, -127.f), 127.f)), id = (int)__builtin_rintf(fminf(fmaxf(d, -127.f), 127.f));
    return ((unsigned)ia & 255u) | (((unsigned)ib & 255u) << 8) | (((unsigned)ic & 255u) << 16) | ((unsigned)id << 24);
}
__device__ __forceinline__ void tr_item_i8(const float* W, int K, int N, unsigned char* WT, int k0, int n0, int drow0, float scale, LAS float* scr, int lane) {
    { const int lr = lane >> 3, lc = (lane & 7) * 4; f32x4 v[16];
#pragma unroll
      for (int j = 0; j < 16; ++j) v[j] = *(const GAS f32x4*)(W + (size_t)(k0 + lr + 8 * j) * N + n0 + lc);
#pragma unroll
      for (int j = 0; j < 16; ++j) { LAS float* d = scr + (lr + 8 * j) * 32 + (lc ^ ((j & 7) << 2)); const int x = lr & 3; d[x] = v[j].x; d[1 ^ x] = v[j].y; d[2 ^ x] = v[j].z; d[3 ^ x] = v[j].w; } }
    LDS_WAIT();
    const int c = lane & 15;
#pragma unroll
    for (int j = 0; j < 8; ++j) { const int n = (lane >> 4) + 4 * j, q = n ^ ((c & 7) << 2); const LAS float* s = scr + (8 * c) * 32;
        v2u o; o.x = pack_i8x4c(s[q] * scale, s[32 + (q ^ 1)] * scale, s[64 + (q ^ 2)] * scale, s[96 + (q ^ 3)] * scale); o.y = pack_i8x4c(s[128 + q] * scale, s[160 + (q ^ 1)] * scale, s[192 + (q ^ 2)] * scale, s[224 + (q ^ 3)] * scale);
        *(GAS v2u*)(WT + (size_t)(drow0 + n) * K + k0 + 8 * c) = o; }
    LDS_WAIT();
}
__device__ __forceinline__ int win_drow(int n) { if (n < 7168 || n >= 9216) return n; const int r = n - 7168, isb = r >> 10, c = r & 1023; return 7168 + (c >> 7) * 256 + isb * 128 + (c & 127); }
__device__ __forceinline__ void cvt_copy(const Ctx& c, const float* src, bf16* dst, size_t n8) {
    const size_t NT = (size_t)c.G * 512;
    for (size_t i = (size_t)blockIdx.x * 512 + c.tid; i < n8; i += NT) {
        const f32x4 a = ((const GAS f32x4*)src)[2 * i], b = ((const GAS f32x4*)src)[2 * i + 1];
        v4u o; o.x = pk2c(a.x, a.y); o.y = pk2c(a.z, a.w); o.z = pk2c(b.x, b.y); o.w = pk2c(b.z, b.w);
        ((GAS v4u*)dst)[i] = o;
    }
}
__device__ __forceinline__ void rms_row(const float* xr, const float* w, bf16* o, int lane) {
    const GAS f32x4* xp = (const GAS f32x4*)xr + lane; f32x4 v[8]; float s = 0.f;
#pragma unroll
    for (int j = 0; j < 8; ++j) { v[j] = xp[64 * j]; s += (v[j].x * v[j].x + v[j].y * v[j].y) + (v[j].z * v[j].z + v[j].w * v[j].w); }
    const float r = __builtin_amdgcn_rsqf(wave_sum(s) * (1.0f / DM) + EPS);
    const GAS f32x4* wp = (const GAS f32x4*)w + lane; GAS v2u* op = (GAS v2u*)o + lane;
#pragma unroll
    for (int j = 0; j < 8; ++j) { const f32x4 wv = wp[64 * j]; v2u q; q.x = pk2c(v[j].x * r * wv.x, v[j].y * r * wv.y); q.y = pk2c(v[j].z * r * wv.z, v[j].w * r * wv.w); op[64 * j] = q; }
}
__device__ __forceinline__ void rms_row_i8(const float* xr, const float* w, unsigned char* o, float* sa, int lane) {
    const GAS f32x4* xp = (const GAS f32x4*)xr + lane; f32x4 v[8]; float s = 0.f;
#pragma unroll
    for (int j = 0; j < 8; ++j) { v[j] = xp[64 * j]; s += (v[j].x * v[j].x + v[j].y * v[j].y) + (v[j].z * v[j].z + v[j].w * v[j].w); }
    const float r = __builtin_amdgcn_rsqf(wave_sum(s) * (1.0f / DM) + EPS);
    const GAS f32x4* wp = (const GAS f32x4*)w + lane; float m = 0.f;
#pragma unroll
    for (int j = 0; j < 8; ++j) { const f32x4 wv = wp[64 * j]; v[j].x *= r * wv.x; v[j].y *= r * wv.y; v[j].z *= r * wv.z; v[j].w *= r * wv.w;
        m = fmaxf(fmaxf(m, fmaxf(fabsf(v[j].x), fabsf(v[j].y))), fmaxf(fabsf(v[j].z), fabsf(v[j].w))); }
    m = wave_max(m);
    const float inv = m > 0.f ? 127.0f / m : 0.f;
    if (lane == 0) *(GAS float*)sa = m * (1.0f / 127.0f);
#pragma unroll
    for (int j = 0; j < 8; ++j) ((GAS unsigned*)o)[lane + 64 * j] = pack_i8x4c(v[j].x * inv, v[j].y * inv, v[j].z * inv, v[j].w * inv);
}
__device__ __forceinline__ void rms_rows2_i8(const float* xa, const float* xb, const float* w, unsigned char* oa, unsigned char* ob, float* saa, float* sab, int lane) {
    const GAS f32x4* pa = (const GAS f32x4*)xa + lane; const GAS f32x4* pb = (const GAS f32x4*)xb + lane; f32x4 va[8], vb[8]; float s0 = 0.f, s1 = 0.f;
#pragma unroll
    for (int j = 0; j < 8; ++j) { va[j] = pa[64 * j]; vb[j] = pb[64 * j]; }
#pragma unroll
    for (int j = 0; j < 8; ++j) { s0 += (va[j].x * va[j].x + va[j].y * va[j].y) + (va[j].z * va[j].z + va[j].w * va[j].w); s1 += (vb[j].x * vb[j].x + vb[j].y * vb[j].y) + (vb[j].z * vb[j].z + vb[j].w * vb[j].w); }
#pragma unroll
    for (int o = 1; o < 64; o <<= 1) { s0 += __shfl_xor(s0, o); s1 += __shfl_xor(s1, o); }
    const float r0 = __builtin_amdgcn_rsqf(s0 * (1.0f / DM) + EPS), r1 = __builtin_amdgcn_rsqf(s1 * (1.0f / DM) + EPS);
    const GAS f32x4* wp = (const GAS f32x4*)w + lane; float m0 = 0.f, m1 = 0.f;
#pragma unroll
    for (int j = 0; j < 8; ++j) { const f32x4 wv = wp[64 * j];
        va[j].x *= r0 * wv.x; va[j].y *= r0 * wv.y; va[j].z *= r0 * wv.z; va[j].w *= r0 * wv.w; vb[j].x *= r1 * wv.x; vb[j].y *= r1 * wv.y; vb[j].z *= r1 * wv.z; vb[j].w *= r1 * wv.w;
        m0 = fmaxf(fmaxf(m0, fmaxf(fabsf(va[j].x), fabsf(va[j].y))), fmaxf(fabsf(va[j].z), fabsf(va[j].w))); m1 = fmaxf(fmaxf(m1, fmaxf(fabsf(vb[j].x), fabsf(vb[j].y))), fmaxf(fabsf(vb[j].z), fabsf(vb[j].w))); }
#pragma unroll
    for (int o = 1; o < 64; o <<= 1) { m0 = fmaxf(m0, __shfl_xor(m0, o)); m1 = fmaxf(m1, __shfl_xor(m1, o)); }
    const float i0 = m0 > 0.f ? 127.0f / m0 : 0.f, i1 = m1 > 0.f ? 127.0f / m1 : 0.f;
    if (lane == 0) { *(GAS float*)saa = m0 * (1.0f / 127.0f); *(GAS float*)sab = m1 * (1.0f / 127.0f); }
#pragma unroll
    for (int j = 0; j < 8; ++j) { ((GAS unsigned*)oa)[lane + 64 * j] = pack_i8x4c(va[j].x * i0, va[j].y * i0, va[j].z * i0, va[j].w * i0); ((GAS unsigned*)ob)[lane + 64 * j] = pack_i8x4c(vb[j].x * i1, vb[j].y * i1, vb[j].z * i1, vb[j].w * i1); }
}
__device__ __forceinline__ void rms_phase_i8(const Ctx& c, const float* x, const float* w, unsigned char* H8, float* SA) {
    for (int m = c.gw; m < NTOK / 2; m += c.NGW) rms_rows2_i8(x + (size_t)m * DM, x + (size_t)(m + NTOK / 2) * DM, w, H8 + (size_t)m * DM, H8 + (size_t)(m + NTOK / 2) * DM, SA + m, SA + m + NTOK / 2, c.lane);
}
__device__ __forceinline__ void rms_rows2(const float* xa, const float* xb, const float* w, bf16* oa, bf16* ob, int lane) {
    const GAS f32x4* pa = (const GAS f32x4*)xa + lane; const GAS f32x4* pb = (const GAS f32x4*)xb + lane; f32x4 va[8], vb[8]; float sa = 0.f, sb = 0.f;
#pragma unroll
    for (int j = 0; j < 8; ++j) { va[j] = pa[64 * j]; vb[j] = pb[64 * j]; }
#pragma unroll
    for (int j = 0; j < 8; ++j) { sa += (va[j].x * va[j].x + va[j].y * va[j].y) + (va[j].z * va[j].z + va[j].w * va[j].w); sb += (vb[j].x * vb[j].x + vb[j].y * vb[j].y) + (vb[j].z * vb[j].z + vb[j].w * vb[j].w); }
#pragma unroll
    for (int o = 1; o < 64; o <<= 1) { sa += __shfl_xor(sa, o); sb += __shfl_xor(sb, o); }
    const float ra = __builtin_amdgcn_rsqf(sa * (1.0f / DM) + EPS), rb = __builtin_amdgcn_rsqf(sb * (1.0f / DM) + EPS);
    const GAS f32x4* wp = (const GAS f32x4*)w + lane; GAS v2u* qa = (GAS v2u*)oa + lane; GAS v2u* qb = (GAS v2u*)ob + lane;
#pragma unroll
    for (int j = 0; j < 8; ++j) { const f32x4 wv = wp[64 * j];
        v2u q; q.x = pk2c(va[j].x * ra * wv.x, va[j].y * ra * wv.y); q.y = pk2c(va[j].z * ra * wv.z, va[j].w * ra * wv.w); qa[64 * j] = q;
        v2u p; p.x = pk2c(vb[j].x * rb * wv.x, vb[j].y * rb * wv.y); p.y = pk2c(vb[j].z * rb * wv.z, vb[j].w * rb * wv.w); qb[64 * j] = p; }
}
__device__ __forceinline__ void rms_phase(const Ctx& c, const float* x, const float* w, bf16* H) {
    for (int m = c.gw; m < NTOK / 2; m += c.NGW) rms_rows2(x + (size_t)m * DM, x + (size_t)(m + NTOK / 2) * DM, w, H + (size_t)m * DM, H + (size_t)(m + NTOK / 2) * DM, c.lane);
}
__device__ __forceinline__ void fp8_row(const float* src, unsigned char* dst, float* scale_out, int lane) {
    const GAS f32x4* xp = (const GAS f32x4*)src + lane; f32x4 v[8]; float m = 0.f;
#pragma unroll
    for (int j = 0; j < 8; ++j) { v[j] = xp[64 * j]; m = fmaxf(fmaxf(m, fmaxf(fabsf(v[j].x), fabsf(v[j].y))), fmaxf(fabsf(v[j].z), fabsf(v[j].w))); }
    m = wave_max(m);
    const float inv = m > 0.f ? 256.0f / m : 0.f;
    if (lane == 0) *(GAS float*)scale_out = m * (1.0f / 256.0f);
#pragma unroll
    for (int j = 0; j < 8; ++j) { int p = __builtin_amdgcn_cvt_pk_fp8_f32(v[j].x * inv, v[j].y * inv, 0, false); p = __builtin_amdgcn_cvt_pk_fp8_f32(v[j].z * inv, v[j].w * inv, p, true);
        ((GAS unsigned*)dst)[lane + 64 * j] = (unsigned)p; }
}
constexpr size_t U8_SLICE = (size_t)16384 * 128;
__device__ __forceinline__ unsigned pack_i8x4(float a, float b, float c, float d) {
    const int ia = (int)__builtin_rintf(a), ib = (int)__builtin_rintf(b), ic = (int)__builtin_rintf(c), id = (int)__builtin_rintf(d);
    return ((unsigned)ia & 255u) | (((unsigned)ib & 255u) << 8) | (((unsigned)ic & 255u) << 16) | ((unsigned)id << 24);
}
__device__ __forceinline__ void row_load_strided(const float* src, int lane, f32x4 (&v)[8]) { const GAS f32x4* xp = (const GAS f32x4*)src + lane;
#pragma unroll
    for (int j = 0; j < 8; ++j) v[j] = xp[64 * j]; }
__device__ __forceinline__ void row_load_contig(const float* src, int lane, f32x4 (&v)[8]) { const GAS f32x4* xp = (const GAS f32x4*)src + 8 * lane;
#pragma unroll
    for (int j = 0; j < 8; ++j) v[j] = xp[j]; }
__device__ __forceinline__ void i8_row(const f32x4 (&v)[8], unsigned char* dst, float* scale_out, int lane) {
    float m = 0.f;
#pragma unroll
    for (int j = 0; j < 8; ++j) m = fmaxf(fmaxf(m, fmaxf(fabsf(v[j].x), fabsf(v[j].y))), fmaxf(fabsf(v[j].z), fabsf(v[j].w)));
    m = wave_max(m);
    const float inv = m > 0.f ? 127.0f / m : 0.f;
    if (lane == 0) *(GAS float*)scale_out = m * (1.0f / 127.0f);
#pragma unroll
    for (int j = 0; j < 8; ++j) *(GAS unsigned*)(dst + (size_t)(2 * j + (lane >> 5)) * U8_SLICE + 4 * (lane & 31)) = pack_i8x4(v[j].x * inv, v[j].y * inv, v[j].z * inv, v[j].w * inv);
}
constexpr size_t V6_SLICE = (size_t)16384 * 192;
__device__ __forceinline__ void fp6_row(const f32x4 (&v)[8], unsigned char* dst, float* scale_out, int lane) {
    float m = 0.f;
#pragma unroll
    for (int j = 0; j < 8; ++j) m = fmaxf(fmaxf(m, fmaxf(fabsf(v[j].x), fabsf(v[j].y))), fmaxf(fabsf(v[j].z), fabsf(v[j].w)));
    m = wave_max(m);
    const float inv = m > 0.f ? 7.5f / m : 0.f;
    if (lane == 0) *(GAS float*)scale_out = m * (1.0f / 7.5f);
    v32h_t h;
#pragma unroll
    for (int j = 0; j < 8; ++j) { h[4 * j] = (_Float16)(v[j].x * inv); h[4 * j + 1] = (_Float16)(v[j].y * inv); h[4 * j + 2] = (_Float16)(v[j].z * inv); h[4 * j + 3] = (_Float16)(v[j].w * inv); }
    const v6u q = __builtin_amdgcn_cvt_scalef32_pk32_fp6_f16(h, 1.0f);
    GAS v2u* o = (GAS v2u*)(dst + (size_t)(lane >> 3) * V6_SLICE + 24 * (lane & 7));
    o[0] = (v2u){q[0], q[1]}; o[1] = (v2u){q[2], q[3]}; o[2] = (v2u){q[4], q[5]};
}
struct P0Args { const float *w_in, *w_br_sb, *w_br_hg, *w_br_conv, *w_o, *w_q, *u, *v, *lbp; bf16 *WinT, *WbrT, *WoT, *WqT; unsigned char *U, *V; float *US, *VS; float* LB; int layer; const float *k1, *k2; bf16* KB; };
__device__ __forceinline__ void p0_convert(const Ctx& c, const P0Args& a, int parts = 7) {
    LAS float* scr = (LAS float*)(c.lds + c.wave * 16384);
    constexpr int I_IN = (DM / 128) * (INW / 32), I_BR = (BW / 64) * (DM / 32), I_SQ = (DM / 64) * (DM / 32);
    constexpr int NITEMS = I_IN + 3 * I_BR + 2 * I_SQ;
    if (parts & 1)
    for (int it = c.gw; it < NITEMS; it += c.NGW) {
        int r = it;
        if (r < I_IN) { const int kb = r / (INW / 32), nb = r % (INW / 32); tr_item_i8(a.w_in, DM, INW, (unsigned char*)a.WinT, kb * 128, nb * 32, win_drow(nb * 32), WIN_QS, scr, c.lane); continue; } r -= I_IN;
        if (r < I_BR) { const int kb = r / (DM / 32), nb = r % (DM / 32); tr_item(a.w_br_sb, BW, DM, a.WbrT, kb * 64, nb * 32, nb * 32, scr, c.lane); continue; } r -= I_BR;
        if (r < I_BR) { const int kb = r / (DM / 32), nb = r % (DM / 32); tr_item(a.w_br_hg, BW, DM, a.WbrT + (size_t)DM * BW, kb * 64, nb * 32, nb * 32, scr, c.lane); continue; } r -= I_BR;
        if (r < I_BR) { const int kb = r / (DM / 32), nb = r % (DM / 32); tr_item(a.w_br_conv, BW, DM, a.WbrT + (size_t)2 * DM * BW, kb * 64, nb * 32, nb * 32, scr, c.lane); continue; } r -= I_BR;
        if (r < I_SQ) { const int kb = r / (DM / 32), nb = r % (DM / 32); tr_item(a.w_o, DM, DM, a.WoT, kb * 64, nb * 32, nb * 32, scr, c.lane); continue; } r -= I_SQ;
        { const int kb = r / (DM / 32), nb = r % (DM / 32); tr_item(a.w_q, DM, DM, a.WqT, kb * 64, nb * 32, nb * 32, scr, c.lane); }
    }
    if (parts & 2)
    {
    for (int r = c.gw; r < 16384; r += 2 * c.NGW) { const int r2 = r + c.NGW; f32x4 va[8], vb[8];
        row_load_strided(a.u + (size_t)r * 2048, c.lane, va); if (r2 < 16384) row_load_strided(a.u + (size_t)r2 * 2048, c.lane, vb);
        i8_row(va, a.U + (size_t)r * 128, a.US + r, c.lane); if (r2 < 16384) i8_row(vb, a.U + (size_t)r2 * 128, a.US + r2, c.lane); }
    for (int r = c.gw; r < 16384; r += 2 * c.NGW) { const int r2 = r + c.NGW; f32x4 va[8], vb[8];
        row_load_contig(a.v + (size_t)r * 2048, c.lane, va); if (r2 < 16384) row_load_contig(a.v + (size_t)r2 * 2048, c.lane, vb);
        fp6_row(va, a.V + (size_t)r * 192, a.VS + r, c.lane); if (r2 < 16384) fp6_row(vb, a.V + (size_t)r2 * 192, a.VS + r2, c.lane); }
    }
    if (parts & 4) {
    cvt_copy(c, a.k1, a.KB, (size_t)8 * 16384 / 8);
    cvt_copy(c, a.k2, a.KB + 8 * 16384, (size_t)8 * 16384 / 8); }
    if (blockIdx.x == 0) for (int i = c.tid; i < 1024; i += 512) a.LB[i] = a.layer == 0 ? 0.f : sigm(a.lbp[1024 + i] - a.lbp[i]);
}

struct EpiIn {
    static constexpr bool PERM = true, AFTER_DRAIN = false;
    bf16* seg; bf16* gate; const float* lb; const float* sa;
    __device__ __forceinline__ float rowscale(int row) const { return ((const GAS float*)sa)[row] * (1.0f / WIN_QS); }
    __device__ __forceinline__ void operator()(const pg8::f32x4 (&acc)[2][2][4][2], const pg8::Unit& u, int wr, int wc, int fr, int fq) const {
        const int pn = u.pn; const int row0 = u.pm * 256 + wr * 64 + fr;
        if (pn >= 28 && pn < 36) {
            bf16* dst = seg + (size_t)7 * SEGSZ; const int col0 = (pn - 28) * 128 + wc * 32 + 8 * fq;
#pragma unroll
            for (int ai = 0; ai < 2; ++ai)
#pragma unroll
                for (int m = 0; m < 4; ++m) {
                    const pg8::f32x4 a0 = acc[ai][0][m][0], a1 = acc[ai][0][m][1], b0 = acc[ai][1][m][0], b1 = acc[ai][1][m][1];
                    v4u w; w.x = pk2c(a0[0] * sigm(b0[0]), a0[1] * sigm(b0[1])); w.y = pk2c(a0[2] * sigm(b0[2]), a0[3] * sigm(b0[3]));
                    w.z = pk2c(a1[0] * sigm(b1[0]), a1[1] * sigm(b1[1])); w.w = pk2c(a1[2] * sigm(b1[2]), a1[3] * sigm(b1[3]));
                    *(GAS v4u*)(dst + (size_t)(row0 + ai * 128 + m * 16) * 1024 + col0) = w; }
            return;
        }
        bf16* dst; int ld, colt, mode;
        if (pn < 28) { const int sg = pn >> 2; dst = seg + (size_t)sg * SEGSZ; ld = 1024; colt = (pn & 3) * 256; mode = (sg == 4) ? 2 : (sg == 6 ? 1 : 0); }
        else { const int q = pn - 36; dst = gate + (size_t)(q >> 3) * ((size_t)NTOK * 2048); ld = 2048; colt = (q & 7) * 256; mode = 1; }
        const int col0 = colt + wc * 32 + 8 * fq;
        if (mode == 0) {
#pragma unroll
            for (int ai = 0; ai < 2; ++ai)
#pragma unroll
                for (int m = 0; m < 4; ++m)
#pragma unroll
                    for (int bj = 0; bj < 2; ++bj) { const pg8::f32x4 v0 = acc[ai][bj][m][0], v1 = acc[ai][bj][m][1];
                        v4u w; w.x = pk2c(v0[0], v0[1]); w.y = pk2c(v0[2], v0[3]); w.z = pk2c(v1[0], v1[1]); w.w = pk2c(v1[2], v1[3]);
                        *(GAS v4u*)(dst + (size_t)(row0 + ai * 128 + m * 16) * ld + col0 + bj * 128) = w; }
        } else if (mode == 1) {
#pragma unroll
            for (int ai = 0; ai < 2; ++ai)
#pragma unroll
                for (int m = 0; m < 4; ++m)
#pragma unroll
                    for (int bj = 0; bj < 2; ++bj) { const pg8::f32x4 v0 = acc[ai][bj][m][0], v1 = acc[ai][bj][m][1];
                        v4u w; w.x = pk2c(sigm(v0[0]), sigm(v0[1])); w.y = pk2c(sigm(v0[2]), sigm(v0[3])); w.z = pk2c(sigm(v1[0]), sigm(v1[1])); w.w = pk2c(sigm(v1[2]), sigm(v1[3]));
                        *(GAS v4u*)(dst + (size_t)(row0 + ai * 128 + m * 16) * ld + col0 + bj * 128) = w; }
        } else {
            f32x4 l0[2], l1[2];
#pragma unroll
            for (int bj = 0; bj < 2; ++bj) { l0[bj] = *(const GAS f32x4*)(lb + col0 + bj * 128); l1[bj] = *(const GAS f32x4*)(lb + col0 + bj * 128 + 4); }
#pragma unroll
            for (int ai = 0; ai < 2; ++ai)
#pragma unroll
                for (int m = 0; m < 4; ++m)
#pragma unroll
                    for (int bj = 0; bj < 2; ++bj) { const pg8::f32x4 v0 = acc[ai][bj][m][0], v1 = acc[ai][bj][m][1]; float r[8];
#pragma unroll
                        for (int j = 0; j < 4; ++j) { r[j] = __logf(l0[bj][j] + (1.0f - l0[bj][j]) * sigm(v0[j])); r[4 + j] = __logf(l1[bj][j] + (1.0f - l1[bj][j]) * sigm(v1[j])); }
                        v4u w; w.x = pk2c(r[0], r[1]); w.y = pk2c(r[2], r[3]); w.z = pk2c(r[4], r[5]); w.w = pk2c(r[6], r[7]);
                        *(GAS v4u*)(dst + (size_t)(row0 + ai * 128 + m * 16) * ld + col0 + bj * 128) = w; }
        }
    }
};

__device__ __forceinline__ void conv_phase(const Ctx& c, const bf16* glu, const float* cw, const float* cb, const float* lnw, const float* lnb, bf16* out) {
    const int c0 = 2 * c.tid;
    float w0[31], w1[31];
#pragma unroll
    for (int j = 0; j < 31; ++j) { const f32x2v t = *(const GAS f32x2v*)(cw + j * 1024 + c0); w0[j] = t.x; w1[j] = t.y; }
    const f32x2v bv = *(const GAS f32x2v*)(cb + c0), lwv = *(const GAS f32x2v*)(lnw + c0), lbv = *(const GAS f32x2v*)(lnb + c0);
    LAS float* red = (LAS float*)c.lds;
    for (int tile = blockIdx.x; tile < NTOK / 8; tile += c.G) {
        const int n0 = tile * 8, tseq0 = n0 & (SEQ - 1);
        float a0[8], a1[8];
#pragma unroll
        for (int t = 0; t < 8; ++t) { a0[t] = bv.x; a1[t] = bv.y; }
#pragma unroll
        for (int r = 0; r < 38; ++r) {
            unsigned xv = 0u;
            if (tseq0 + r - 30 >= 0) xv = *(const GAS unsigned*)(glu + (size_t)(n0 + r - 30) * 1024 + c0);
            const float x0 = bflo(xv), x1 = bfhi(xv);
#pragma unroll
            for (int t = 0; t < 8; ++t) { const int j = r - t; if (j >= 0 && j <= 30) { a0[t] += w0[j] * x0; a1[t] += w1[j] * x1; } }
        }
        float st[16];
#pragma unroll
        for (int t = 0; t < 8; ++t) { st[2 * t] = a0[t] + a1[t]; st[2 * t + 1] = a0[t] * a0[t] + a1[t] * a1[t]; }
        xreduce16(st, c.lane);
        if ((c.lane & 3) == 0) red[c.wave * 16 + ridx16(c.lane)] = st[0];
        __syncthreads();
        if (c.tid < 16) { float s = 0.f;
#pragma unroll
            for (int w = 0; w < 8; ++w) s += red[w * 16 + c.tid];
            red[128 + c.tid] = s; }
        __syncthreads();
#pragma unroll
        for (int t = 0; t < 8; ++t) {
            const float mean = red[128 + 2 * t] * (1.0f / 1024.0f), var = red[128 + 2 * t + 1] * (1.0f / 1024.0f) - mean * mean;
            const float rstd = __builtin_amdgcn_rsqf(var + EPS);
            const float h0 = (a0[t] - mean) * rstd * lwv.x + lbv.x, h1 = (a1[t] - mean) * rstd * lwv.y + lbv.y;
            *(GAS unsigned*)(out + (size_t)(n0 + t) * 1024 + c0) = pk2c(h0 * sigm(h0), h1 * sigm(h1));
        }
        __syncthreads();
    }
}
__device__ __forceinline__ void hgrn_task(int task, int lane, const bf16* qhg, const bf16* logf, const bf16* ihg, bf16* out) {
    const int bh = task >> 6, dvb = task & 63, b = bh >> 3, h = bh & 7;
    const size_t rb = (size_t)b * SEQ * 1024;
    const GAS unsigned* qp = (const GAS unsigned*)(qhg + rb + h * 128) + lane;
    const GAS unsigned* lp = (const GAS unsigned*)(logf + rb + h * 128) + lane;
    const GAS unsigned* ip = (const GAS unsigned*)(ihg + rb + h * 128) + dvb;
    GAS bf16* op = (GAS bf16*)(out + rb + h * 128 + 2 * dvb);
    float S00 = 0.f, S01 = 0.f, S10 = 0.f, S11 = 0.f;
    unsigned qn[8], ln[8], inx[8];
#pragma unroll
    for (int j = 0; j < 8; ++j) { qn[j] = qp[(size_t)j * 512]; ln[j] = lp[(size_t)j * 512]; inx[j] = ip[(size_t)j * 512]; }
    for (int blk = 0; blk < SEQ / 8; ++blk) {
        unsigned qc[8], lc[8], ic[8];
#pragma unroll
        for (int j = 0; j < 8; ++j) { qc[j] = qn[j]; lc[j] = ln[j]; ic[j] = inx[j]; }
        if (blk + 1 < SEQ / 8) {
#pragma unroll
            for (int j = 0; j < 8; ++j) { const size_t o = (size_t)((blk + 1) * 8 + j) * 512; qn[j] = qp[o]; ln[j] = lp[o]; inx[j] = ip[o]; }
        }
        float pv[16];
#pragma unroll
        for (int j = 0; j < 8; ++j) {
            const float f0 = __expf(bflo(lc[j])), f1 = __expf(bfhi(lc[j])), k0 = 1.0f - f0, k1 = 1.0f - f1;
            const float i0 = bflo(ic[j]), i1 = bfhi(ic[j]), q0 = bflo(qc[j]), q1 = bfhi(qc[j]);
            S00 = f0 * S00 + k0 * i0; S01 = f0 * S01 + k0 * i1; S10 = f1 * S10 + k1 * i0; S11 = f1 * S11 + k1 * i1;
            pv[2 * j] = S00 * q0 + S10 * q1; pv[2 * j + 1] = S01 * q0 + S11 * q1;
        }
        xreduce16(pv, lane);
        if ((lane & 3) == 0) { const int idx = ridx16(lane); op[(size_t)(blk * 8 + (idx >> 1)) * 1024 + (idx & 1)] = (bf16)(pk2c(pv[0], 0.f) & 0xffffu); }
    }
}
constexpr int HG_TS = 272;
constexpr int HG_BS = 132;
__device__ __forceinline__ void hg_stage(LAS unsigned char* dst, const bf16* src, int tid) {
#pragma unroll
    for (int i = 0; i < 2; ++i) { const int p = tid + 512 * i, row = p >> 4, c16 = p & 15; *(LAS v4u*)(dst + row * HG_TS + c16 * 16) = *(const GAS v4u*)(src + (size_t)row * 1024 + c16 * 8); }
}
__device__ __forceinline__ void hg_scan(const LAS unsigned char* lft, int dk, int hf, float (&lf)[4][8], float (&b)[4][8], float& bl) {
    float bs[4], pb[4];
#pragma unroll
    for (int kk = 0; kk < 4; ++kk) { float run = 0.f;
#pragma unroll
        for (int j = 0; j < 8; ++j) { lf[kk][j] = __uint_as_float((unsigned)(*(const LAS unsigned short*)(lft + (16 * kk + 8 * hf + j) * HG_TS + dk * 2)) << 16); run += lf[kk][j]; b[kk][j] = run; }
        bs[kk] = run; }
#pragma unroll
    for (int kk = 0; kk < 4; ++kk) pb[kk] = __shfl_xor(bs[kk], 32);
    float pre = 0.f;
#pragma unroll
    for (int kk = 0; kk < 4; ++kk) { const float off = pre + (hf ? pb[kk] : 0.f);
#pragma unroll
        for (int j = 0; j < 8; ++j) b[kk][j] += off;
        pre += bs[kk] + pb[kk]; }
    bl = pre;
}
__device__ __forceinline__ bf16x8 pack8(const float (&v)[8]) { v4u t; t.x = pk2c(v[0], v[1]); t.y = pk2c(v[2], v[3]); t.z = pk2c(v[4], v[5]); t.w = pk2c(v[6], v[7]); return __builtin_bit_cast(bf16x8, t); }
__device__ __forceinline__ unsigned lds_u16(const LAS unsigned char* p) { return (unsigned)(*(const LAS unsigned short*)p); }
__device__ __forceinline__ void hgA_chunk(const Ctx& c, int ci, const bf16* LOGF, const bf16* IHG, bf16* ST, float* DEC) {
    const int bh = ci >> 6, ch = ci & 63, bb = bh >> 3, h = bh & 7; const size_t n0 = (size_t)bb * SEQ + ch * 64;
    LAS unsigned char* lft = c.lds; LAS unsigned char* itl = c.lds + 64 * HG_TS;
    hg_stage(lft, LOGF + n0 * 1024 + h * 128, c.tid); hg_stage(itl, IHG + n0 * 1024 + h * 128, c.tid);
    __syncthreads();
    const int dkt = c.wave & 3, dvh = c.wave >> 2, hf = c.lane >> 5, cl = c.lane & 31, dk = 32 * dkt + cl;
    float lf[4][8], b[4][8], bl; hg_scan(lft, dk, hf, lf, b, bl);
    bf16x8 kf[4];
#pragma unroll
    for (int kk = 0; kk < 4; ++kk) { float v[8];
#pragma unroll
        for (int j = 0; j < 8; ++j) v[j] = (1.0f - __expf(lf[kk][j])) * __expf(bl - b[kk][j]);
        kf[kk] = pack8(v); }
    if (dvh == 0 && hf == 0) ((GAS float*)DEC)[(size_t)ci * 128 + dk] = __expf(bl);
#pragma unroll
    for (int dvi = 0; dvi < 2; ++dvi) { const int dvt = dvh * 2 + dvi;
        f32x16 acc;
#pragma unroll
        for (int r = 0; r < 16; ++r) acc[r] = 0.f;
#pragma unroll
        for (int kk = 0; kk < 4; ++kk) { const LAS unsigned char* p = itl + (16 * kk + 8 * hf) * HG_TS + (32 * dvt + cl) * 2;
            v4u t; t.x = lds_u16(p) | (lds_u16(p + HG_TS) << 16); t.y = lds_u16(p + 2 * HG_TS) | (lds_u16(p + 3 * HG_TS) << 16); t.z = lds_u16(p + 4 * HG_TS) | (lds_u16(p + 5 * HG_TS) << 16); t.w = lds_u16(p + 6 * HG_TS) | (lds_u16(p + 7 * HG_TS) << 16);
            acc = MFMA32(kf[kk], __builtin_bit_cast(bf16x8, t), acc); }
        bf16* o = ST + (size_t)ci * 16384 + (size_t)(32 * dvt + cl) * 128 + 32 * dkt + 4 * hf;
#pragma unroll
        for (int g = 0; g < 4; ++g) { v2u q; q.x = pk2c(acc[4 * g], acc[4 * g + 1]); q.y = pk2c(acc[4 * g + 2], acc[4 * g + 3]); *(GAS v2u*)(o + 8 * g) = q; }
    }
    __syncthreads();
}
__device__ __forceinline__ void hgB(const Ctx& c, bf16* ST, const float* DEC) {
    for (int e = blockIdx.x * 512 + c.tid; e < 32 * 4096; e += c.G * 512) {
        const int bh = e >> 12, r = e & 4095, dv = r >> 5, dk4 = (r & 31) * 4;
        GAS v2u* p = (GAS v2u*)(ST + (size_t)bh * 64 * 16384 + (size_t)dv * 128 + dk4);
        const GAS f32x4* d = (const GAS f32x4*)(DEC + (size_t)bh * 64 * 128 + dk4);
        f32x4 S = {0.f, 0.f, 0.f, 0.f};
#pragma unroll 1
        for (int c0 = 0; c0 < 64; c0 += 8) {
            v2u Lv[8]; f32x4 D[8];
#pragma unroll
            for (int k = 0; k < 8; ++k) { Lv[k] = p[(size_t)(c0 + k) * 4096]; D[k] = d[(size_t)(c0 + k) * 32]; }
#pragma unroll
            for (int k = 0; k < 8; ++k) { v2u o; o.x = pk2c(S.x, S.y); o.y = pk2c(S.z, S.w); p[(size_t)(c0 + k) * 4096] = o;
                S.x = D[k].x * S.x + bflo(Lv[k].x); S.y = D[k].y * S.y + bfhi(Lv[k].x); S.z = D[k].z * S.z + bflo(Lv[k].y); S.w = D[k].w * S.w + bfhi(Lv[k].y); }
        }
    }
}
__device__ __forceinline__ void hgC_chunk(const Ctx& c, int ci, const bf16* QHG, const bf16* LOGF, const bf16* IHG, const bf16* GHG, const bf16* ST, const float* nw, bf16* OUT) {
    const int bh = ci >> 6, ch = ci & 63, bb = bh >> 3, h = bh & 7; const size_t n0 = (size_t)bb * SEQ + ch * 64;
    LAS unsigned char* lft = c.lds; LAS unsigned char* itl = c.lds + 64 * HG_TS; LAS float* bt = (LAS float*)(c.lds + 2 * 64 * HG_TS); LAS float* red = bt + 64 * HG_BS;
    LAS unsigned char* ktl = (LAS unsigned char*)(red + 256);
    hg_stage(lft, LOGF + n0 * 1024 + h * 128, c.tid); hg_stage(itl, IHG + n0 * 1024 + h * 128, c.tid);
    __syncthreads();
    const int hf = c.lane >> 5, cl = c.lane & 31;
    { const int dk = 32 * (c.wave & 3) + cl; float lf[4][8], b[4][8], bl; hg_scan(lft, dk, hf, lf, b, bl);
#pragma unroll
      for (int q = 0; q < 2; ++q) { const int kk = 2 * (c.wave >> 2) + q;
#pragma unroll
          for (int j = 0; j < 8; ++j) { bt[(16 * kk + 8 * hf + j) * HG_BS + dk] = (c.wave >> 2) ? b[2 + q][j] : b[q][j];
              *(LAS unsigned short*)(ktl + (16 * kk + 8 * hf + j) * HG_TS + dk * 2) = (unsigned short)(pk2c(1.0f - __expf((c.wave >> 2) ? lf[2 + q][j] : lf[q][j]), 0.f) & 0xffffu); } } }
    __syncthreads();
    const int dvt = c.wave & 3, tt = c.wave >> 2, t = 32 * tt + cl;
    bf16x8 qm[8];
    const bf16* qrow = QHG + (n0 + t) * 1024 + h * 128 + 8 * hf;
#pragma unroll
    for (int kk = 0; kk < 8; ++kk) { const int d0 = 16 * kk + 8 * hf;
        asm volatile("" ::: "memory");
        const v4u qv = *(const GAS v4u*)(qrow + 16 * kk);
        const f32x4 b0 = *(const LAS f32x4*)(bt + t * HG_BS + d0), b1 = *(const LAS f32x4*)(bt + t * HG_BS + d0 + 4), m0 = *(const LAS f32x4*)(bt + 31 * HG_BS + d0), m1 = *(const LAS f32x4*)(bt + 31 * HG_BS + d0 + 4);
        const float q[8] = {bflo(qv.x), bfhi(qv.x), bflo(qv.y), bfhi(qv.y), bflo(qv.z), bfhi(qv.z), bflo(qv.w), bfhi(qv.w)};
        const float bv[8] = {b0.x, b0.y, b0.z, b0.w, b1.x, b1.y, b1.z, b1.w}, mv[8] = {m0.x, m0.y, m0.z, m0.w, m1.x, m1.y, m1.z, m1.w};
        float vm[8];
#pragma unroll
        for (int j = 0; j < 8; ++j) vm[j] = q[j] * __expf(bv[j] - mv[j]);
        qm[kk] = pack8(vm); }
    f32x16 o;
#pragma unroll
    for (int r = 0; r < 16; ++r) o[r] = 0.f;
#pragma unroll 1
    for (int st = 0; st <= tt; ++st) {
        const int s = 32 * st + cl;
        f32x16 sa;
#pragma unroll
        for (int r = 0; r < 16; ++r) sa[r] = 0.f;
#pragma unroll
        for (int kk = 0; kk < 8; ++kk) { const int d0 = 16 * kk + 8 * hf;
            asm volatile("" ::: "memory");
            const v4u lv = *(const LAS v4u*)(ktl + s * HG_TS + d0 * 2);
            const f32x4 b0 = *(const LAS f32x4*)(bt + s * HG_BS + d0), b1 = *(const LAS f32x4*)(bt + s * HG_BS + d0 + 4), m0 = *(const LAS f32x4*)(bt + 31 * HG_BS + d0), m1 = *(const LAS f32x4*)(bt + 31 * HG_BS + d0 + 4);
            const float kv[8] = {bflo(lv.x), bfhi(lv.x), bflo(lv.y), bfhi(lv.y), bflo(lv.z), bfhi(lv.z), bflo(lv.w), bfhi(lv.w)};
            const float bv[8] = {b0.x, b0.y, b0.z, b0.w, b1.x, b1.y, b1.z, b1.w}, mv[8] = {m0.x, m0.y, m0.z, m0.w, m1.x, m1.y, m1.z, m1.w};
            float vk[8];
#pragma unroll
            for (int j = 0; j < 8; ++j) vk[j] = kv[j] * __expf(mv[j] - bv[j]);
            sa = MFMA32(pack8(vk), qm[kk], sa); }
        if (st == tt) {
#pragma unroll
            for (int r = 0; r < 16; ++r) if (((r & 3) + 8 * (r >> 2) + 4 * hf) > cl) sa[r] = 0.f;
        }
#pragma unroll
        for (int sp = 0; sp < 2; ++sp) {
            const float pv[8] = {sa[8 * sp], sa[8 * sp + 1], sa[8 * sp + 2], sa[8 * sp + 3], sa[8 * sp + 4], sa[8 * sp + 5], sa[8 * sp + 6], sa[8 * sp + 7]};
            const LAS unsigned char* p = itl + (32 * st + 16 * sp + 4 * hf) * HG_TS + (32 * dvt + cl) * 2;
            v4u tq; tq.x = lds_u16(p) | (lds_u16(p + HG_TS) << 16); tq.y = lds_u16(p + 2 * HG_TS) | (lds_u16(p + 3 * HG_TS) << 16);
            tq.z = lds_u16(p + 8 * HG_TS) | (lds_u16(p + 9 * HG_TS) << 16); tq.w = lds_u16(p + 10 * HG_TS) | (lds_u16(p + 11 * HG_TS) << 16);
            o = MFMA32(__builtin_bit_cast(bf16x8, tq), pack8(pv), o); }
    }
    { const bf16* strow = ST + (size_t)ci * 16384 + (size_t)(32 * dvt + cl) * 128 + 8 * hf;
#pragma unroll
      for (int kk = 0; kk < 8; ++kk) { const int d0 = 16 * kk + 8 * hf;
          asm volatile("" ::: "memory");
          const v4u qv = *(const GAS v4u*)(qrow + 16 * kk); const bf16x8 sf = *(const GAS bf16x8*)(strow + 16 * kk);
          const f32x4 b0 = *(const LAS f32x4*)(bt + t * HG_BS + d0), b1 = *(const LAS f32x4*)(bt + t * HG_BS + d0 + 4);
          float ve[8] = {bflo(qv.x) * __expf(b0.x), bfhi(qv.x) * __expf(b0.y), bflo(qv.y) * __expf(b0.z), bfhi(qv.y) * __expf(b0.w), bflo(qv.z) * __expf(b1.x), bfhi(qv.z) * __expf(b1.y), bflo(qv.w) * __expf(b1.z), bfhi(qv.w) * __expf(b1.w)};
          o = MFMA32(sf, pack8(ve), o); } }
    float ss = 0.f;
#pragma unroll
    for (int r = 0; r < 16; ++r) ss += o[r] * o[r];
    ss += __shfl_xor(ss, 32);
    if (hf == 0) red[(tt * 4 + dvt) * 32 + cl] = ss;
    __syncthreads();
    const float rstd = __builtin_amdgcn_rsqf(((red[(tt * 4 + 0) * 32 + cl] + red[(tt * 4 + 1) * 32 + cl]) + (red[(tt * 4 + 2) * 32 + cl] + red[(tt * 4 + 3) * 32 + cl])) * (1.0f / 128.0f) + EPS);
#pragma unroll
    for (int g = 0; g < 4; ++g) { const int dv0 = 32 * dvt + 8 * g + 4 * hf; const size_t off = (n0 + t) * 1024 + h * 128 + dv0;
        const v2u gg = *(const GAS v2u*)(GHG + off); const f32x4 w4 = *(const GAS f32x4*)(nw + dv0);
        v2u q; q.x = pk2c(o[4 * g] * rstd * w4.x * bflo(gg.x), o[4 * g + 1] * rstd * w4.y * bfhi(gg.x)); q.y = pk2c(o[4 * g + 2] * rstd * w4.z * bflo(gg.y), o[4 * g + 3] * rstd * w4.w * bfhi(gg.y));
        *(GAS v2u*)(OUT + off) = q; }
    __syncthreads();
}
__device__ __forceinline__ void qknorm_rows4(bf16* row0, size_t rstride, const float* w, float scale, int lane) {
    v4u x[4][2];
#pragma unroll
    for (int i = 0; i < 4; ++i)
#pragma unroll
        for (int j = 0; j < 2; ++j) x[i][j] = *(const GAS v4u*)(row0 + i * rstride + 8 * lane + 512 * j);
    const f32x4 wa = *(const GAS f32x4*)(w + ((8 * lane) & 127)), wb = *(const GAS f32x4*)(w + ((8 * lane) & 127) + 4);
#pragma unroll
    for (int i = 0; i < 4; ++i)
#pragma unroll
        for (int j = 0; j < 2; ++j) { const v4u xx = x[i][j];
            float f[8] = {bflo(xx.x), bfhi(xx.x), bflo(xx.y), bfhi(xx.y), bflo(xx.z), bfhi(xx.z), bflo(xx.w), bfhi(xx.w)};
            float ss = 0.f;
#pragma unroll
            for (int k = 0; k < 8; ++k) ss += f[k] * f[k];
            ss += __shfl_xor(ss, 1); ss += __shfl_xor(ss, 2); ss += __shfl_xor(ss, 4); ss += __shfl_xor(ss, 8);
            const float r = __builtin_amdgcn_rsqf(ss * (1.0f / 128.0f) + EPS) * scale;
            v4u o; o.x = pk2c(f[0] * r * wa.x, f[1] * r * wa.y); o.y = pk2c(f[2] * r * wa.z, f[3] * r * wa.w); o.z = pk2c(f[4] * r * wb.x, f[5] * r * wb.y); o.w = pk2c(f[6] * r * wb.z, f[7] * r * wb.w);
            *(GAS v4u*)(row0 + i * rstride + 8 * lane + 512 * j) = o; }
}
__device__ __forceinline__ void vt_item(int item, int lane, const bf16* vsb, bf16* vt, LAS unsigned short* scr) {
    const int db = item & 3, sb = (item >> 2) & 63, bh = item >> 8, b = bh >> 3, h = bh & 7;
    const bf16* src = vsb + ((size_t)b * SEQ + sb * 64) * 1024 + h * 128 + db * 32;
#pragma unroll 4
    for (int i = 0; i < 16; ++i) { const int r = 4 * i + (lane >> 4); *(LAS unsigned*)(scr + r * 34 + 2 * (lane & 15)) = *(const GAS unsigned*)(src + (size_t)r * 1024 + 2 * (lane & 15)); }
    LDS_WAIT();
    const int c = lane & 7;
#pragma unroll
    for (int j = 0; j < 4; ++j) { const int d = (lane >> 3) + 8 * j; const LAS unsigned short* s = scr + (8 * c) * 34 + d;
        v4u o; o.x = (unsigned)s[0] | ((unsigned)s[34] << 16); o.y = (unsigned)s[68] | ((unsigned)s[102] << 16); o.z = (unsigned)s[136] | ((unsigned)s[170] << 16); o.w = (unsigned)s[204] | ((unsigned)s[238] << 16);
        *(GAS v4u*)(vt + ((size_t)bh * 128 + db * 32 + d) * SEQ + sb * 64 + 8 * c) = o; }
    LDS_WAIT();
}

constexpr int AT_BUF = 32768, AT_VOFF = 16384;
__device__ __forceinline__ f32x16 attn_scores(const LAS unsigned char* kt, int krow, int hf, const bf16x8 (&qf)[8]) {
    f32x16 sa;
#pragma unroll
    for (int r = 0; r < 16; ++r) sa[r] = 0.f;
    const LAS unsigned char* kp = kt + krow * 256; const int sw = krow & 15;
#pragma unroll
    for (int kk = 0; kk < 8; ++kk) sa = MFMA32(*(const LAS bf16x8*)(kp + (((2 * kk + hf) ^ sw) << 4)), qf[kk], sa);
    return sa;
}
template <bool DIAG> __device__ __forceinline__ void attn_weights(const f32x16& sa, float& R, int hf, int cl, bf16x8 (&pf)[2]) {
    float om[16];
#pragma unroll
    for (int r = 0; r < 16; ++r) om[r] = __builtin_amdgcn_rcpf(1.0f + __builtin_amdgcn_exp2f(sa[r] * 1.4426950408889634f));
    if (DIAG) {
#pragma unroll
        for (int r = 0; r < 16; ++r) if (((r & 3) + 8 * (r >> 2) + 4 * hf) >= cl) om[r] = 1.0f;
    }
    float Gs[4], Gp[4];
#pragma unroll
    for (int g = 0; g < 4; ++g) { Gs[g] = (om[4 * g] * om[4 * g + 1]) * (om[4 * g + 2] * om[4 * g + 3]); Gp[g] = __shfl_xor(Gs[g], 32); }
    float tail = R; float w[16];
#pragma unroll
    for (int g = 3; g >= 0; --g) {
        const float c3 = tail * (hf == 0 ? Gp[g] : 1.0f), c2 = c3 * om[4 * g + 3], c1 = c2 * om[4 * g + 2], c0 = c1 * om[4 * g + 1];
        w[4 * g + 3] = c3 - om[4 * g + 3] * c3; w[4 * g + 2] = c2 - om[4 * g + 2] * c2; w[4 * g + 1] = c1 - om[4 * g + 1] * c1; w[4 * g] = c0 - om[4 * g] * c0;
        tail *= Gs[g] * Gp[g];
    }
    R = tail;
#pragma unroll
    for (int sp = 0; sp < 2; ++sp) { v4u t; t.x = pk2c(w[8 * sp], w[8 * sp + 1]); t.y = pk2c(w[8 * sp + 2], w[8 * sp + 3]); t.z = pk2c(w[8 * sp + 4], w[8 * sp + 5]); t.w = pk2c(w[8 * sp + 6], w[8 * sp + 7]); pf[sp] = __builtin_bit_cast(bf16x8, t); }
}
__device__ __forceinline__ void attn_pv(const LAS unsigned char* vt, int sub, int cl, int hf, const bf16x8 (&pf)[2], f32x16 (&o)[4]) {
#pragma unroll
    for (int d = 0; d < 4; ++d) { const int row = 32 * d + cl; const LAS unsigned char* vp = vt + row * 128 + 8 * hf; const int sw = (row >> 1) & 7;
#pragma unroll
        for (int sp = 0; sp < 2; ++sp) { const int x = 4 * sub + 2 * sp;
            const v2u lo = *(const LAS v2u*)(vp + ((x ^ sw) << 4)), hi = *(const LAS v2u*)(vp + (((x + 1) ^ sw) << 4));
            v4u t; t.x = lo.x; t.y = lo.y; t.z = hi.x; t.w = hi.y; o[d] = MFMA32(__builtin_bit_cast(bf16x8, t), pf[sp], o[d]); } }
}
template <bool LAG> __device__ __forceinline__ void attn_unit(const Ctx& c, int bh, int qb, const bf16* qsb, const bf16* ksb, const bf16* vt, bf16* outb) {
    int lane_ = c.lane; asm volatile("" : "+v"(lane_));
    const int b = bh >> 3, h = bh & 7, lane = lane_, cl = lane & 31, hf = lane >> 5;
    const size_t rb = (size_t)b * SEQ; const int q0w = 256 * qb + 32 * c.wave;
    bf16x8 qf[8];
    { const bf16* qrow = qsb + (rb + q0w + cl) * 1024 + h * 128 + 8 * hf;
#pragma unroll
      for (int kk = 0; kk < 8; ++kk) qf[kk] = *(const GAS bf16x8*)(qrow + 16 * kk); }
    f32x16 o[4];
#pragma unroll
    for (int d = 0; d < 4; ++d)
#pragma unroll
        for (int r = 0; r < 16; ++r) o[d][r] = 0.f;
    float R = 1.0f;
    bf16x8 pd[2]; const LAS unsigned char* vimd = c.lds; int subd = 0; bool pending = false;
    const int kr0 = 8 * c.wave + (lane >> 4), kr1 = kr0 + 4;
    const bf16* kg0 = ksb + (rb + kr0) * 1024 + h * 128 + (((lane & 15) ^ (kr0 & 15)) << 3);
    const bf16* kg1 = ksb + (rb + kr1) * 1024 + h * 128 + (((lane & 15) ^ (kr1 & 15)) << 3);
    const int vr0 = 16 * c.wave + (lane >> 3), vr1 = vr0 + 8;
    const bf16* vg0 = vt + ((size_t)bh * 128 + vr0) * SEQ + (((lane & 7) ^ ((vr0 >> 1) & 7)) << 3);
    const bf16* vg1 = vt + ((size_t)bh * 128 + vr1) * SEQ + (((lane & 7) ^ ((vr1 >> 1) & 7)) << 3);
    LAS unsigned char* dk = c.lds + c.wave * 2048; LAS unsigned char* dv = c.lds + AT_VOFF + c.wave * 2048;
#define AT_DMA(kt_, bi_) do { const int ktt_ = (kt_); LAS unsigned char* bb_ = (LAS unsigned char*)0 + (bi_) * AT_BUF; \
        __builtin_amdgcn_global_load_lds((const unsigned*)(kg0 + (size_t)ktt_ * 64 * 1024), (LAS unsigned*)(dk + (bi_) * AT_BUF), 16, 0, 0); \
        __builtin_amdgcn_global_load_lds((const unsigned*)(kg1 + (size_t)ktt_ * 64 * 1024), (LAS unsigned*)(dk + (bi_) * AT_BUF + 1024), 16, 0, 0); \
        __builtin_amdgcn_global_load_lds((const unsigned*)(vg0 + ktt_ * 64), (LAS unsigned*)(dv + (bi_) * AT_BUF), 16, 0, 0); \
        __builtin_amdgcn_global_load_lds((const unsigned*)(vg1 + ktt_ * 64), (LAS unsigned*)(dv + (bi_) * AT_BUF + 1024), 16, 0, 0); (void)bb_; } while (0)
    const int nkt = 4 * (qb + 1);
    asm volatile("s_waitcnt vmcnt(0)" ::: "memory");
    AT_DMA(nkt - 1, 0); AT_DMA(nkt - 2, 1);
    asm volatile("s_waitcnt vmcnt(4)" ::: "memory"); __builtin_amdgcn_s_barrier(); asm volatile("" ::: "memory");
    int bi = 0;
#pragma unroll 1
    for (int it = 0; it < nkt; ++it) {
        const int kt = nkt - 1 - it;
        const int b2 = (bi + 2) & 3;
        if (it + 2 < nkt) AT_DMA(kt - 2, b2);
        const LAS unsigned char* kim = c.lds + bi * AT_BUF; const LAS unsigned char* vim = kim + AT_VOFF;
        const int rel = q0w - 64 * kt;
        if (rel >= 32) {
            if (LAG) { if (pending) attn_pv(vimd, subd, cl, hf, pd, o);
                const f32x16 s1 = attn_scores(kim, 32 + cl, hf, qf); if (rel == 32) attn_weights<true>(s1, R, hf, cl, pd); else attn_weights<false>(s1, R, hf, cl, pd);
                vimd = vim; subd = 1; pending = true;
            } else { bf16x8 p[2];
                { const f32x16 s1 = attn_scores(kim, 32 + cl, hf, qf); if (rel == 32) attn_weights<true>(s1, R, hf, cl, p); else attn_weights<false>(s1, R, hf, cl, p); }
                attn_pv(vim, 1, cl, hf, p, o); }
        }
        if (rel >= 0) {
            if (LAG) { if (pending) attn_pv(vimd, subd, cl, hf, pd, o);
                const f32x16 s0 = attn_scores(kim, cl, hf, qf); if (rel == 0) attn_weights<true>(s0, R, hf, cl, pd); else attn_weights<false>(s0, R, hf, cl, pd);
                vimd = vim; subd = 0; pending = true;
            } else { bf16x8 p[2];
                { const f32x16 s0 = attn_scores(kim, cl, hf, qf); if (rel == 0) attn_weights<true>(s0, R, hf, cl, p); else attn_weights<false>(s0, R, hf, cl, p); }
                attn_pv(vim, 0, cl, hf, p, o); }
        }
        if (it + 2 < nkt) asm volatile("s_waitcnt vmcnt(4)\n\ts_waitcnt lgkmcnt(0)" ::: "memory"); else asm volatile("s_waitcnt vmcnt(0)\n\ts_waitcnt lgkmcnt(0)" ::: "memory");
        __builtin_amdgcn_s_barrier(); asm volatile("" ::: "memory");
        bi = (bi + 1) & 3;
    }
#undef AT_DMA
    if (LAG && pending) attn_pv(vimd, subd, cl, hf, pd, o);
    bf16* orow = outb + (rb + q0w + cl) * 1024 + h * 128 + 4 * hf;
#pragma unroll
    for (int d = 0; d < 4; ++d)
#pragma unroll
        for (int g = 0; g < 4; ++g) { v2u q; q.x = pk2c(o[d][4 * g], o[d][4 * g + 1]); q.y = pk2c(o[d][4 * g + 2], o[d][4 * g + 3]); *(GAS v2u*)(orow + 32 * d + 8 * g) = q; }
    asm volatile("s_waitcnt vmcnt(0)" ::: "memory"); __builtin_amdgcn_s_barrier(); asm volatile("" ::: "memory");
}
__device__ __forceinline__ void hgpost_row(bf16* row, const bf16* grow, const float* w, int lane) {
#pragma unroll
    for (int j = 0; j < 2; ++j) {
        GAS v4u* p = (GAS v4u*)(row + 8 * lane + 512 * j); const v4u x = *p; const v4u gg = *(const GAS v4u*)(grow + 8 * lane + 512 * j);
        float f[8] = {bflo(x.x), bfhi(x.x), bflo(x.y), bfhi(x.y), bflo(x.z), bfhi(x.z), bflo(x.w), bfhi(x.w)};
        const float g[8] = {bflo(gg.x), bfhi(gg.x), bflo(gg.y), bfhi(gg.y), bflo(gg.z), bfhi(gg.z), bflo(gg.w), bfhi(gg.w)};
        float ss = 0.f;
#pragma unroll
        for (int k = 0; k < 8; ++k) ss += f[k] * f[k];
        ss += __shfl_xor(ss, 1); ss += __shfl_xor(ss, 2); ss += __shfl_xor(ss, 4); ss += __shfl_xor(ss, 8);
        const float r = __builtin_amdgcn_rsqf(ss * (1.0f / 128.0f) + EPS);
        const f32x4 wa = *(const GAS f32x4*)(w + ((8 * lane) & 127)), wb = *(const GAS f32x4*)(w + ((8 * lane) & 127) + 4);
        v4u o; o.x = pk2c(f[0] * r * wa.x * g[0], f[1] * r * wa.y * g[1]); o.y = pk2c(f[2] * r * wa.z * g[2], f[3] * r * wa.w * g[3]);
        o.z = pk2c(f[4] * r * wb.x * g[4], f[5] * r * wb.y * g[5]); o.w = pk2c(f[6] * r * wb.z * g[6], f[7] * r * wb.w * g[7]);
        *p = o;
    }
}

template <bool FIRST> struct EpiMerge {
    static constexpr bool PERM = true, AFTER_DRAIN = false;
    const bf16* gate; bf16* merged;
    __device__ __forceinline__ void operator()(const pg8::f32x4 (&acc)[2][2][4][2], const pg8::Unit& u, int wr, int wc, int fr, int fq) const {
        const int row0 = u.pm * 256 + wr * 64 + fr, col0 = u.pn * 256 + wc * 32 + 8 * fq;
#pragma unroll
        for (int ai = 0; ai < 2; ++ai)
#pragma unroll
            for (int m = 0; m < 4; ++m) {
                if ((m & 1) == 0) asm volatile("" ::: "memory");
#pragma unroll
                for (int bj = 0; bj < 2; ++bj) {
                    const size_t off = (size_t)(row0 + ai * 128 + m * 16) * 2048 + col0 + bj * 128;
                    const v4u g = *(const GAS v4u*)(gate + off); const pg8::f32x4 v0 = acc[ai][bj][m][0], v1 = acc[ai][bj][m][1];
                    float r[8] = {bflo(g.x) * v0[0], bfhi(g.x) * v0[1], bflo(g.y) * v0[2], bfhi(g.y) * v0[3], bflo(g.z) * v1[0], bfhi(g.z) * v1[1], bflo(g.w) * v1[2], bfhi(g.w) * v1[3]};
                    if (!FIRST) { const v4u mo = *(const GAS v4u*)(merged + off);
                        r[0] += bflo(mo.x); r[1] += bfhi(mo.x); r[2] += bflo(mo.y); r[3] += bfhi(mo.y); r[4] += bflo(mo.z); r[5] += bfhi(mo.z); r[6] += bflo(mo.w); r[7] += bfhi(mo.w); }
                    v4u w; w.x = pk2c(r[0], r[1]); w.y = pk2c(r[2], r[3]); w.z = pk2c(r[4], r[5]); w.w = pk2c(r[6], r[7]);
                    *(GAS v4u*)(merged + off) = w; }
            }
    }
};
struct EpiStoreBf16 {
    static constexpr bool PERM = true, AFTER_DRAIN = false;
    bf16* out;
    __device__ __forceinline__ void operator()(const pg8::f32x4 (&acc)[2][2][4][2], const pg8::Unit& u, int wr, int wc, int fr, int fq) const {
        const int row0 = u.pm * 256 + wr * 64 + fr, col0 = u.pn * 256 + wc * 32 + 8 * fq;
#pragma unroll
        for (int ai = 0; ai < 2; ++ai)
#pragma unroll
            for (int m = 0; m < 4; ++m)
#pragma unroll
                for (int bj = 0; bj < 2; ++bj) { const pg8::f32x4 v0 = acc[ai][bj][m][0], v1 = acc[ai][bj][m][1];
                    v4u w; w.x = pk2c(v0[0], v0[1]); w.y = pk2c(v0[2], v0[3]); w.z = pk2c(v1[0], v1[1]); w.w = pk2c(v1[2], v1[3]);
                    *(GAS v4u*)(out + (size_t)(row0 + ai * 128 + m * 16) * 2048 + col0 + bj * 128) = w; }
    }
};
struct EpiResid {
    static constexpr bool PERM = false, AFTER_DRAIN = false;
    const float* xin; float* xout;
    __device__ __forceinline__ void operator()(const pg8::f32x4 (&acc)[2][2][4][2], const pg8::Unit& u, int wr, int wc, int fr, int fq) const {
        const int row0 = u.pm * 256 + wr * 64 + fr, col0 = u.pn * 256 + wc * 32 + 4 * fq;
#pragma unroll
        for (int ai = 0; ai < 2; ++ai)
#pragma unroll
            for (int m = 0; m < 4; ++m)
#pragma unroll
                for (int bj = 0; bj < 2; ++bj)
#pragma unroll
                    for (int n = 0; n < 2; ++n) { const size_t off = (size_t)(row0 + ai * 128 + m * 16) * 2048 + col0 + bj * 128 + n * 16;
                        f32x4 r = acc[ai][bj][m][n]; if (xin) r += *(const GAS f32x4*)(xin + off);
                        *(GAS f32x4*)(xout + off) = r; }
    }
};

__device__ __forceinline__ float rl_f(float v, int l) { return __uint_as_float((unsigned)__builtin_amdgcn_readlane((int)__float_as_uint(v), l)); }
__device__ __forceinline__ void ins16(float (&L)[16], float x) {
#pragma unroll
    for (int i = 0; i < 16; ++i) { const float hi = __builtin_fmaxf(L[i], x); x = __builtin_fminf(L[i], x); L[i] = hi; }
}
#define CE_DESC(a, b) do { const float hi_ = __builtin_fmaxf(a, b), lo_ = __builtin_fminf(a, b); a = hi_; b = lo_; } while (0)
__device__ __forceinline__ void sort16_desc(float (&v)[16]) {
#pragma unroll
    for (int k = 2; k <= 16; k <<= 1)
#pragma unroll
        for (int j = k >> 1; j > 0; j >>= 1)
#pragma unroll
            for (int i = 0; i < 16; ++i) { const int l = i ^ j; if (l > i) { if ((i & k) == 0) CE_DESC(v[i], v[l]); else CE_DESC(v[l], v[i]); } }
}
__device__ __forceinline__ void bitonic_merge16_desc(float (&v)[16]) {
#pragma unroll
    for (int j = 8; j > 0; j >>= 1)
#pragma unroll
        for (int i = 0; i < 16; ++i) { const int l = i ^ j; if (l > i) CE_DESC(v[i], v[l]); }
}
__device__ __forceinline__ void top16_merge(float (&L)[16], const float (&T)[16]) {
#pragma unroll
    for (int i = 0; i < 16; ++i) L[i] = __builtin_fmaxf(L[i], T[15 - i]);
    bitonic_merge16_desc(L);
}
constexpr int PK_KS = 272;
__device__ __forceinline__ void peer_top16(const bf16* qrow  , const LAS unsigned char* kl  , int hf, float (&L)[16]) {
    bf16x8 qf[8];
#pragma unroll
    for (int kk = 0; kk < 8; ++kk) qf[kk] = *(const GAS bf16x8*)(qrow + 16 * kk);
#pragma unroll 1
    for (int kt = 0; kt < 4; ++kt) {
        f32x16 sa;
#pragma unroll
        for (int r = 0; r < 16; ++r) sa[r] = 0.f;
#pragma unroll
        for (int kk = 0; kk < 8; ++kk) sa = MFMA32(*(const LAS bf16x8*)(kl + kt * 32 * PK_KS + 32 * kk), qf[kk], sa);
        float T[16];
#pragma unroll
        for (int r = 0; r < 16; ++r) { const unsigned idx = (unsigned)(kt * 32 + (r & 3) + 8 * (r >> 2) + 4 * hf); T[r] = __uint_as_float((__float_as_uint(sa[r]) & ~127u) | idx); }
        sort16_desc(T);
        if (kt == 0) {
#pragma unroll
            for (int i = 0; i < 16; ++i) L[i] = T[i];
        } else top16_merge(L, T);
    }
    float P[16];
#pragma unroll
    for (int i = 0; i < 16; ++i) P[i] = __shfl_xor(L[i], 32);
    top16_merge(L, P);
}
__device__ __forceinline__ void peer_select32(int hd, int n0, int lane, const bf16* qpeer, const LAS unsigned char* kl1, const LAS unsigned char* kl2, unsigned char* wsb, LAS unsigned* ldsw) {
    asm volatile("" : "+v"(lane));
    const int c = lane & 31, hf = lane >> 5, n = n0 + c;
    const bf16* qrow = qpeer + (size_t)n * 2048 + hd * 256 + 8 * hf;
    float A[16], B[16];
    peer_top16(qrow, kl1 + c * PK_KS + 16 * hf, hf, A);
    peer_top16(qrow + 128, kl2 + c * PK_KS + 16 * hf, hf, B);
#define PKV(x) __uint_as_float(__float_as_uint(x) & ~127u)
#define PKI(x) ((int)(__float_as_uint(x) & 127u))
    float W[16];
    { float C0[16], C1[16], C2[16], E0 = 0.f, E1 = 0.f; unsigned id = 0;
#pragma unroll
      for (int a = 0; a < 16; ++a)
#pragma unroll
        for (int b = 0; b < 16; ++b) if ((a + 1) * (b + 1) <= 16) { const float pk = __uint_as_float((__float_as_uint(PKV(A[a]) + PKV(B[b])) & ~63u) | id);
            if (id < 16) C0[id] = pk; else if (id < 32) C1[id - 16] = pk; else if (id < 48) C2[id - 32] = pk; else if (id == 48) E0 = pk; else E1 = pk;
            ++id; }
      sort16_desc(C0); sort16_desc(C1); sort16_desc(C2);
      top16_merge(C0, C1); top16_merge(C0, C2);
#pragma unroll
      for (int i = 0; i < 16; ++i) W[i] = C0[i];
      ins16(W, E0); ins16(W, E1); }
    const float thr = W[15], mx = W[0];
    int cnt = 0; float ssum = 0.f;
    LAS int* le = (LAS int*)ldsw + c * 16; LAS float* lg = (LAS float*)ldsw + 512 + c * 16;
    { unsigned id = 0;
#pragma unroll
      for (int a = 0; a < 16; ++a)
#pragma unroll
        for (int b = 0; b < 16; ++b) if ((a + 1) * (b + 1) <= 16) {
            const float cv = PKV(A[a]) + PKV(B[b]); const float pk = __uint_as_float((__float_as_uint(cv) & ~63u) | id); ++id;
            if (pk >= thr) { const float e = __expf(cv - mx); if (hf == 0) { le[cnt] = PKI(A[a]) * 128 + PKI(B[b]); lg[cnt] = e; } ssum += e; ++cnt; }
        } }
    LDS_WAIT();
    asm volatile("" : "+s"(wsb));
    int* sel_e = (int*)(wsb + WS_SEL); float* sel_g = (float*)(wsb + WS_SEL + 8 * MiB); float* sel_s = (float*)(wsb + WS_SELS);
    { int lane3 = lane; asm volatile("" : "+v"(lane3)); const int t = lane3 >> 1, part = lane3 & 1;
      const v4u e0 = *(const LAS v4u*)((LAS int*)ldsw + t * 16 + 8 * part), e1 = *(const LAS v4u*)((LAS int*)ldsw + t * 16 + 8 * part + 4);
      const v4u g0 = *(const LAS v4u*)((LAS int*)ldsw + 512 + t * 16 + 8 * part), g1 = *(const LAS v4u*)((LAS int*)ldsw + 512 + t * 16 + 8 * part + 4);
      GAS v4u* pe = (GAS v4u*)(sel_e + (size_t)(n0 + t) * 128 + hd * 16 + 8 * part); GAS v4u* pg = (GAS v4u*)(sel_g + (size_t)(n0 + t) * 128 + hd * 16 + 8 * part);
      pe[0] = e0; pe[1] = e1; pg[0] = g0; pg[1] = g1; }
    LDS_WAIT();
    { int lane4 = lane; asm volatile("" : "+v"(lane4)); if ((lane4 >> 5) == 0) ((GAS float*)sel_s)[(size_t)(n0 + (lane4 & 31)) * 8 + hd] = ssum; }
}

__device__ __forceinline__ float dot2bf(unsigned a, unsigned b, float acc) {
    return __builtin_amdgcn_fdot2_f32_bf16(__builtin_bit_cast(bf16v2, a), __builtin_bit_cast(bf16v2, b), acc, false);
}
__device__ __forceinline__ float dot8bf(const v4u a, const v4u b, float acc) {
    const unsigned a0 = a.x, a1 = a.y, a2 = a.z, a3 = a.w, b0 = b.x, b1 = b.y, b2 = b.z, b3 = b.w;
    acc = dot2bf(a0, b0, acc); acc = dot2bf(a1, b1, acc); acc = dot2bf(a2, b2, acc); acc = dot2bf(a3, b3, acc);
    return acc;
}
__device__ __forceinline__ void unpack16(const v4u q, float (&f)[16]) {
    const unsigned d0 = q.x, d1 = q.y, d2 = q.z, d3 = q.w;
    f32x2v t;
    t = __builtin_amdgcn_cvt_pk_f32_fp8((int)d0, false); f[0] = t.x; f[1] = t.y; t = __builtin_amdgcn_cvt_pk_f32_fp8((int)d0, true); f[2] = t.x; f[3] = t.y;
    t = __builtin_amdgcn_cvt_pk_f32_fp8((int)d1, false); f[4] = t.x; f[5] = t.y; t = __builtin_amdgcn_cvt_pk_f32_fp8((int)d1, true); f[6] = t.x; f[7] = t.y;
    t = __builtin_amdgcn_cvt_pk_f32_fp8((int)d2, false); f[8] = t.x; f[9] = t.y; t = __builtin_amdgcn_cvt_pk_f32_fp8((int)d2, true); f[10] = t.x; f[11] = t.y;
    t = __builtin_amdgcn_cvt_pk_f32_fp8((int)d3, false); f[12] = t.x; f[13] = t.y; t = __builtin_amdgcn_cvt_pk_f32_fp8((int)d3, true); f[14] = t.x; f[15] = t.y;
}
struct SliceSched { int mode, xcc, rank, nloc; };
__device__ __forceinline__ SliceSched slice_sched_init(const Ctx& c, unsigned* ctl, const XcdBarrier& bar, int use) {
    LAS int* sh = (LAS int*)(c.lds + 1024);
    if (c.tid == 0) {
        int ok = 1; unsigned tot = 0;
        for (int j = 0; j < 16; ++j) { const unsigned n = xb_ld(&bar.bar[XB_XCNT(j)]); tot += n; if ((j < 8) != (n > 0u)) ok = 0; }
        if (tot != (unsigned)c.G) ok = 0;
        const int xcc = (int)xb_xcc_id();
        int rank = 0, nloc = 1;
        if (ok) { nloc = (int)xb_ld(&bar.bar[XB_XCNT(xcc)]); rank = (int)xb_add(&ctl[CW_RANK + (use * 16 + xcc) * 64], 1u); if (rank >= nloc) ok = 0; }
        sh[0] = ok; sh[1] = xcc; sh[2] = rank; sh[3] = nloc;
    }
    __syncthreads();
    SliceSched S; S.mode = sh[0]; S.xcc = sh[1]; S.rank = sh[2]; S.nloc = sh[3];
    __syncthreads();
    return S;
}
__device__ __forceinline__ bool slice_item(const SliceSched& S, const Ctx& c, int i, int& slice, int& tb) {
    if (S.mode) { const int it = S.rank + i * S.nloc; if (it >= 512) return false; slice = S.xcc + 8 * (it >> 8); tb = it & 255; return true; }
    const int it = (int)blockIdx.x + i * c.G; if (it >= 4096) return false; slice = it >> 8; tb = it & 255; return true;
}
__device__ __forceinline__ void unpack16p(const v4u q, f32x2v (&f)[8]) {
    const unsigned d0 = q.x, d1 = q.y, d2 = q.z, d3 = q.w;
    f[0] = __builtin_amdgcn_cvt_pk_f32_fp8((int)d0, false); f[1] = __builtin_amdgcn_cvt_pk_f32_fp8((int)d0, true);
    f[2] = __builtin_amdgcn_cvt_pk_f32_fp8((int)d1, false); f[3] = __builtin_amdgcn_cvt_pk_f32_fp8((int)d1, true);
    f[4] = __builtin_amdgcn_cvt_pk_f32_fp8((int)d2, false); f[5] = __builtin_amdgcn_cvt_pk_f32_fp8((int)d2, true);
    f[6] = __builtin_amdgcn_cvt_pk_f32_fp8((int)d3, false); f[7] = __builtin_amdgcn_cvt_pk_f32_fp8((int)d3, true);
}
__device__ __forceinline__ void sddmm_load(const unsigned char* ubase, const LAS unsigned* ids16, v4u (&q)[16]) {
    int id[16];
#pragma unroll
    for (int i = 0; i < 4; ++i) { const v4u v = *(const LAS v4u*)(ids16 + 4 * i); id[4 * i] = (int)v.x; id[4 * i + 1] = (int)v.y; id[4 * i + 2] = (int)v.z; id[4 * i + 3] = (int)v.w; }
#pragma unroll
    for (int it = 0; it < 16; ++it) q[it] = *(const GAS v4u*)(ubase + (unsigned)id[it] * 128u);
}
__device__ __forceinline__ void sddmm_token(const v4u (&qc)[16], const v4u ha, const v4u hb, int lane, unsigned* dst) {
    float h[16] = {bflo(ha.x), bfhi(ha.x), bflo(ha.y), bfhi(ha.y), bflo(ha.z), bfhi(ha.z), bflo(ha.w), bfhi(ha.w), bflo(hb.x), bfhi(hb.x), bflo(hb.y), bfhi(hb.y), bflo(hb.z), bfhi(hb.z), bflo(hb.w), bfhi(hb.w)};
    float hm = 0.f;
#pragma unroll
    for (int j = 0; j < 16; ++j) hm = fmaxf(hm, fabsf(h[j]));
    hm = fmaxf(hm, __shfl_xor(hm, 1)); hm = fmaxf(hm, __shfl_xor(hm, 2)); hm = fmaxf(hm, __shfl_xor(hm, 4));
    const float hinv = hm > 0.f ? 127.0f / hm : 0.f, hs = hm * (1.0f / 127.0f);
    int hq[4];
#pragma unroll
    for (int j = 0; j < 4; ++j) hq[j] = (int)pack_i8x4(h[4 * j] * hinv, h[4 * j + 1] * hinv, h[4 * j + 2] * hinv, h[4 * j + 3] * hinv);
    float p[16];
#pragma unroll
    for (int it = 0; it < 16; ++it) { int a = __builtin_amdgcn_sdot4((int)qc[it].x, hq[0], 0, false); a = __builtin_amdgcn_sdot4((int)qc[it].y, hq[1], a, false);
        a = __builtin_amdgcn_sdot4((int)qc[it].z, hq[2], a, false); a = __builtin_amdgcn_sdot4((int)qc[it].w, hq[3], a, false);
        p[it] = (float)a * hs; }
#pragma unroll
    for (int i = 0; i < 8; ++i) { const bool up = (lane & 4) != 0; const float snd = up ? p[i] : p[i + 8], kp = up ? p[i + 8] : p[i]; p[i] = kp + __shfl_xor(snd, 4); }
#pragma unroll
    for (int i = 0; i < 4; ++i) { const bool up = (lane & 2) != 0; const float snd = up ? p[i] : p[i + 4], kp = up ? p[i + 4] : p[i]; p[i] = kp + __shfl_xor(snd, 2); }
#pragma unroll
    for (int i = 0; i < 2; ++i) { const bool up = (lane & 1) != 0; const float snd = up ? p[i] : p[i + 2], kp = up ? p[i + 2] : p[i]; p[i] = kp + __shfl_xor(snd, 1); }
    *(GAS unsigned*)dst = pk2c(p[0], p[1]);
}
__device__ __forceinline__ void peer_sddmm_wave(int t0, int s, int lane, const bf16* H, const unsigned char* UQ, const int* sel_e, float* part, LAS unsigned* ldsw) {
    const int cg = lane & 7, sg = lane >> 3;
#pragma unroll
    for (int j = 0; j < 4; ++j) *(LAS v4u*)(ldsw + 4 * (lane + 64 * j)) = *(const GAS v4u*)(sel_e + (size_t)t0 * 128 + 4 * (lane + 64 * j));
    LDS_WAIT();
    const unsigned char* ubase = UQ + (size_t)s * U8_SLICE + cg * 16;
    const LAS unsigned* idl = ldsw + sg * 16;
    const bf16* hbase = H + (size_t)t0 * 2048 + s * 128 + cg * 16;
    unsigned* pbase = (unsigned*)part + ((size_t)t0 * 16 + s) * 64 + lane;
    v4u qa[16], qb[16];
    v4u haa = *(const GAS v4u*)(hbase), hab = *(const GAS v4u*)(hbase + 8), hba, hbb;
    sddmm_load(ubase, idl, qa);
#pragma unroll
    for (int k = 0; k < 6; k += 2) {
        hba = *(const GAS v4u*)(hbase + (size_t)(k + 1) * 2048); hbb = *(const GAS v4u*)(hbase + (size_t)(k + 1) * 2048 + 8);
        sddmm_load(ubase, idl + (k + 1) * 128, qb);
        sddmm_token(qa, haa, hab, lane, pbase + (size_t)k * 1024);
        haa = *(const GAS v4u*)(hbase + (size_t)(k + 2) * 2048); hab = *(const GAS v4u*)(hbase + (size_t)(k + 2) * 2048 + 8);
        sddmm_load(ubase, idl + (k + 2) * 128, qa);
        sddmm_token(qb, hba, hbb, lane, pbase + (size_t)(k + 1) * 1024);
    }
    hba = *(const GAS v4u*)(hbase + (size_t)7 * 2048); hbb = *(const GAS v4u*)(hbase + (size_t)7 * 2048 + 8);
    sddmm_load(ubase, idl + 7 * 128, qb);
    sddmm_token(qa, haa, hab, lane, pbase + (size_t)6 * 1024);
    sddmm_token(qb, hba, hbb, lane, pbase + (size_t)7 * 1024);
    LDS_WAIT();
}
__device__ __forceinline__ void peer_coef_tokens4(int t0, int ts, int lane, const float* part, const int* sel_e, float* sel_g, const float* sel_s, const float* US, const float* VS) {
    unsigned pv[4][16]; v2u e[4]; f32x2v g[4]; float dn[4];
#pragma unroll
    for (int i = 0; i < 4; ++i) { const int t = t0 + i * ts;
#pragma unroll
        for (int s = 0; s < 16; ++s) pv[i][s] = ((const GAS unsigned*)part)[((size_t)t * 16 + s) * 64 + lane];
        e[i] = *(const GAS v2u*)(sel_e + (size_t)t * 128 + 2 * lane); g[i] = *(const GAS f32x2v*)(sel_g + (size_t)t * 128 + 2 * lane); dn[i] = ((const GAS float*)sel_s)[(size_t)t * 8 + (lane >> 3)]; }
    float ux[4], uy[4], vx[4], vy[4];
#pragma unroll
    for (int i = 0; i < 4; ++i) { ux[i] = ((const GAS float*)US)[e[i].x]; uy[i] = ((const GAS float*)US)[e[i].y]; vx[i] = ((const GAS float*)VS)[e[i].x]; vy[i] = ((const GAS float*)VS)[e[i].y]; }
#pragma unroll
    for (int i = 0; i < 4; ++i) { const int t = t0 + i * ts; float a0 = 0.f, a1 = 0.f;
#pragma unroll
        for (int s = 0; s < 16; ++s) { a0 += bflo(pv[i][s]); a1 += bfhi(pv[i][s]); }
        const float inv = 1.0f / dn[i];
        const float ox = g[i].x * inv * gelu_exact(a0 * ux[i]) * vx[i], oy = g[i].y * inv * gelu_exact(a1 * uy[i]) * vy[i];
        const h2_t ha = {(_Float16)ox, (_Float16)ox}, hb = {(_Float16)oy, (_Float16)oy};
        *(GAS v2u*)(sel_g + (size_t)t * 128 + 2 * lane) = (v2u){__builtin_bit_cast(unsigned, ha), __builtin_bit_cast(unsigned, hb)}; }
}
__device__ __forceinline__ bool slice_item8(const SliceSched& S, const Ctx& c, int i, int& slice, int& tb) {
    if (S.mode) { const int it = S.rank + i * S.nloc; if (it >= 256) return false; slice = S.xcc; tb = it; return true; }
    const int it = (int)blockIdx.x + i * c.G; if (it >= 2048) return false; slice = it >> 8; tb = it & 255; return true;
}
template <int MODE = 0>
__device__ __forceinline__ void spmm6_load(const unsigned char* vbase, const LAS unsigned* ids8, v4u (&qa)[8], v2u (&qb)[8]) {
    const v4u i0 = *(const LAS v4u*)(ids8), i1 = *(const LAS v4u*)(ids8 + 4);
    const unsigned id[8] = {i0.x, i0.y, i0.z, i0.w, i1.x, i1.y, i1.z, i1.w};
    if constexpr (MODE == 2) {
#pragma unroll
        for (int it = 0; it < 8; ++it) { qa[it] = (v4u){id[it], id[it] + 1u, id[it] + 2u, id[it] + 3u}; qb[it] = (v2u){id[it] + 4u, id[it] + 5u}; }
        return; }
#pragma unroll
    for (int it = 0; it < 8; ++it) { const unsigned char* p = vbase + id[it] * 192u; qa[it] = *(const GAS v4u*)p; qb[it] = *(const GAS v2u*)(p + 16); }
}
template <int MODE = 0>
__device__ __forceinline__ void spmm6_fma(const v4u (&qa)[8], const v2u (&qb)[8], const LAS unsigned* cf8, h2_t (&y)[16]) {
    const v4u c0 = *(const LAS v4u*)(cf8), c1 = *(const LAS v4u*)(cf8 + 4);
    const unsigned cf[8] = {c0.x, c0.y, c0.z, c0.w, c1.x, c1.y, c1.z, c1.w};
    if constexpr (MODE == 1) {
#pragma unroll
        for (int it = 0; it < 8; ++it) { const unsigned x = (qa[it].x ^ qa[it].y) ^ (qa[it].z ^ qa[it].w) ^ (qb[it].x ^ qb[it].y) ^ cf[it]; y[it] = __builtin_bit_cast(h2_t, __builtin_bit_cast(unsigned, y[it]) ^ x); }
        return; }
#pragma unroll
    for (int it = 0; it < 8; ++it) { const v6u q = {qa[it].x, qa[it].y, qa[it].z, qa[it].w, qb[it].x, qb[it].y};
        const v32h_t f = __builtin_amdgcn_cvt_scalef32_pk32_f16_fp6(q, 1.0f); const h2_t c2 = __builtin_bit_cast(h2_t, cf[it]);
#pragma unroll
        for (int j = 0; j < 16; ++j) { const h2_t v = {f[2 * j], f[2 * j + 1]}; y[j] = __builtin_elementwise_fma(v, c2, y[j]); } }
}
template <int MODE = 0>
__device__ __forceinline__ void peer_spmm6_wave(int t0, int s, int lane, const unsigned char* V6, const int* sel_e, const float* coef, const float* x1, float* xout, LAS unsigned* ldsw) {
    const int cg = lane & 7, sg = lane >> 3;
#pragma unroll
    for (int j = 0; j < 4; ++j) { *(LAS v4u*)(ldsw + 4 * (lane + 64 * j)) = *(const GAS v4u*)(sel_e + (size_t)t0 * 128 + 4 * (lane + 64 * j));
        *(LAS v4u*)(ldsw + 1024 + 4 * (lane + 64 * j)) = *(const GAS v4u*)(coef + (size_t)t0 * 128 + 4 * (lane + 64 * j)); }
    LDS_WAIT();
    const unsigned char* vbase = V6 + (size_t)s * V6_SLICE + cg * 24;
    const LAS unsigned* idl = ldsw + sg * 16; const LAS unsigned* cfl = ldsw + 1024 + sg * 16;
    v4u qa0[8], qa1[8]; v2u qb0[8], qb1[8];
    spmm6_load<MODE>(vbase, idl, qa0, qb0);
    const size_t xoff = (size_t)t0 * 2048 + s * 256 + cg * 32 + 4 * sg;
    f32x4 xn = *(const GAS f32x4*)(x1 + xoff);
#pragma unroll 1
    for (int k = 0; k < 8; ++k) {
        const f32x4 xv = xn;
        h2_t y[16];
#pragma unroll
        for (int j = 0; j < 16; ++j) y[j] = (h2_t){(_Float16)0.f, (_Float16)0.f};
        spmm6_load<MODE>(vbase, idl + k * 128 + 8, qa1, qb1);
        if (k < 7) xn = *(const GAS f32x4*)(x1 + xoff + (size_t)(k + 1) * 2048);
        spmm6_fma<MODE>(qa0, qb0, cfl + k * 128, y);
        if (k < 7) spmm6_load<MODE>(vbase, idl + (k + 1) * 128, qa0, qb0);
        spmm6_fma<MODE>(qa1, qb1, cfl + k * 128 + 8, y);
        unsigned u[16];
#pragma unroll
        for (int j = 0; j < 16; ++j) u[j] = __builtin_bit_cast(unsigned, y[j]);
#pragma unroll
        for (int i = 0; i < 8; ++i) { const bool up = (lane & 32) != 0; const unsigned snd = up ? u[i] : u[i + 8], kp = up ? u[i + 8] : u[i]; u[i] = __builtin_bit_cast(unsigned, __builtin_bit_cast(h2_t, kp) + __builtin_bit_cast(h2_t, (unsigned)__shfl_xor((int)snd, 32))); }
#pragma unroll
        for (int i = 0; i < 4; ++i) { const bool up = (lane & 16) != 0; const unsigned snd = up ? u[i] : u[i + 4], kp = up ? u[i + 4] : u[i]; u[i] = __builtin_bit_cast(unsigned, __builtin_bit_cast(h2_t, kp) + __builtin_bit_cast(h2_t, (unsigned)__shfl_xor((int)snd, 16))); }
#pragma unroll
        for (int i = 0; i < 2; ++i) { const bool up = (lane & 8) != 0; const unsigned snd = up ? u[i] : u[i + 2], kp = up ? u[i + 2] : u[i]; u[i] = __builtin_bit_cast(unsigned, __builtin_bit_cast(h2_t, kp) + __builtin_bit_cast(h2_t, (unsigned)__shfl_xor((int)snd, 8))); }
        const h2_t r0 = __builtin_bit_cast(h2_t, u[0]), r1 = __builtin_bit_cast(h2_t, u[1]);
        f32x4 o; o.x = xv.x + (float)r0[0]; o.y = xv.y + (float)r0[1]; o.z = xv.z + (float)r1[0]; o.w = xv.w + (float)r1[1];
        *(GAS f32x4*)(xout + xoff + (size_t)k * 2048) = o;
    }
    LDS_WAIT();
}

struct Args { const float* in[21]; float* out; unsigned char* ws; int lo, hi, li, pad; };
__global__ void __launch_bounds__(512, 2) mk_fwd(Args args) {
    extern __shared__ __attribute__((aligned(16))) unsigned char lds_raw[];
    Ctx c; c.lds = (LAS unsigned char*)lds_raw; c.tid = threadIdx.x; c.lane = c.tid & 63; c.wave = __builtin_amdgcn_readfirstlane(c.tid >> 6);
    c.G = gridDim.x; c.gw = blockIdx.x * 8 + c.wave; c.NGW = c.G * 8;
    volatile LAS unsigned* MISC = (volatile LAS unsigned*)(c.lds + MISC_OFF);
    if (c.tid < 32) MISC[c.tid] = 0u;
    __syncthreads();
    unsigned char* ws = args.ws;
    const int lo = args.lo, hi = args.hi;
    XcdBarrier bar; bar.w0 = 0; bar.bar = (unsigned*)(ws + WS_CTL) + CW_BAR + args.li * XCD_BAR_WORDS; bar.x = 0; bar.st = nullptr;
    if (hi - lo > 1) bar = xcd_barrier_post((unsigned*)(ws + WS_CTL) + CW_BAR + args.li * XCD_BAR_WORDS, MISC + 8);
#ifndef ATTN_REPS
#define ATTN_REPS 1
#endif
#ifndef PHMASK
#define PHMASK 0x1fff
#endif
#ifndef REP_PH
#define REP_PH (-1)
#endif
    int rep2 = 2; asm volatile("" : "+s"(rep2));
#define RLOOP(k, cond) for (int rp_ = 0; rp_ < ((((k) == REP_PH) && (cond)) ? rep2 : 1); ++rp_)
#define RSYNC do { if (rp_) xcd_barrier(bar); } while (0)
#define IN(k) (((PHMASK >> ((k) % NPH)) & 1) && lo <= (k) && (k) < hi)
#define SEAM(k) do { if (IN(k) && IN((k) + 1)) xcd_barrier(bar); } while (0)
#define PH_BEGIN unsigned char* w = ws; float* outp = args.out; Ctx cc = c; int zi = 0; cc.lane = xb_lane_id(); cc.tid = cc.wave * 64 + cc.lane; \
    asm volatile("" : "+s"(w), "+s"(outp), "+s"(zi), "+v"(cc.tid), "+v"(cc.lane)); (void)w; (void)outp;
#define INP(k) (args.in[(k) + zi])
#define WSP(T, off) ((T*)(w + (off)))
    for (int l = 0; l < 2; ++l) {
        const int pb = l * NPH;
        if (IN(pb + 0)) { PH_BEGIN
            P0Args a; a.w_in = INP(2) + (size_t)l * DM * INW; a.w_br_sb = INP(11) + (size_t)l * BW * DM; a.w_br_hg = INP(12) + (size_t)l * BW * DM; a.w_br_conv = INP(13) + (size_t)l * BW * DM;
            a.w_o = INP(14) + (size_t)l * DM * DM; a.w_q = INP(16) + (size_t)l * DM * DM; a.u = INP(19) + (size_t)l * 16384 * 2048; a.v = INP(20) + (size_t)l * 16384 * 2048; a.lbp = INP(5);
            a.WinT = WSP(bf16, WS_WIN); a.WbrT = WSP(bf16, WS_WBR); a.WoT = WSP(bf16, WS_WO); a.WqT = WSP(bf16, WS_WQ); a.U = WSP(unsigned char, WS_U); a.V = WSP(unsigned char, WS_V); a.US = WSP(float, WS_US); a.VS = WSP(float, WS_VS); a.LB = WSP(float, WS_LB); a.layer = l; a.k1 = INP(17) + (size_t)l * 8 * 16384; a.k2 = INP(18) + (size_t)l * 8 * 16384; a.KB = WSP(bf16, WS_KEYS);
#ifndef REP_MODE0
#define REP_MODE0 15
#endif
            RLOOP(0, true) { RSYNC;
            int pm_ = 15; if (REP_PH == 0) { pm_ = rp_ ? REP_MODE0 : 15; asm volatile("" : "+s"(pm_)); }
            p0_convert(cc, a, pm_);
            if (pm_ & 8) rms_phase_i8(cc, l == 0 ? INP(0) : WSP(const float, WS_X2), INP(1) + (size_t)l * DM, WSP(unsigned char, WS_H), WSP(float, WS_SA)); }
        }
        SEAM(pb + 0);
        if (IN(pb + 1)) { PH_BEGIN
            RLOOP(1, true) { RSYNC;
            pg8::Gemm g{WSP(bf16, WS_H), WSP(bf16, WS_WIN), NTOK, INW, DM}; pg8::StaticOrder S; S.init(NTOK, INW, cc.G, (int)blockIdx.x);
            EpiIn E{WSP(bf16, WS_SEG), WSP(bf16, WS_GATE), WSP(float, WS_LB), WSP(float, WS_SA)};
            pg8::gemm_phase<EpiIn, pg8::StaticOrder, true, true, true>(cc.lds, g, S, E, cc.wave); }
        }
        SEAM(pb + 1);
        if (IN(pb + 2)) { PH_BEGIN
            bf16* SEG = WSP(bf16, WS_SEG);
#ifndef REP_MODE2
#define REP_MODE2 7
#endif
            RLOOP(2, true) { RSYNC;
            int pm_ = 7; if (REP_PH == 2) { pm_ = rp_ ? REP_MODE2 : 7; asm volatile("" : "+s"(pm_)); }
            if (pm_ & 1)
            conv_phase(cc, SEG + 7 * SEGSZ, INP(7) + (size_t)l * 31 * 1024, INP(8) + (size_t)l * 1024, INP(9) + (size_t)l * 1024, INP(10) + (size_t)l * 1024, WSP(bf16, WS_CONV));
            if (pm_ & 2)
            for (int ci = blockIdx.x; ci < 2048; ci += cc.G) hgA_chunk(cc, ci, SEG + 4 * SEGSZ, SEG + 5 * SEGSZ, WSP(bf16, WS_ST), WSP(float, WS_DEC));
            if (!rp_)
            for (int r = cc.gw; r < 2 * (NTOK / 4); r += cc.NGW) {
                if (r < NTOK / 4) qknorm_rows4(SEG + (size_t)r * 4 * 1024, 1024, INP(3) + (size_t)l * 128, 0.08838834764831845f, cc.lane);
                else qknorm_rows4(SEG + SEGSZ + (size_t)(r - NTOK / 4) * 4 * 1024, 1024, INP(4) + (size_t)l * 128, 1.0f, cc.lane);
            }
            LAS unsigned short* scr = (LAS unsigned short*)(cc.lds + 4096 + cc.wave * 8192);
            if (pm_ & 4)
            for (int it = cc.gw; it < 8192; it += cc.NGW) vt_item(it, cc.lane, SEG + 2 * SEGSZ, WSP(bf16, WS_MERGED), scr); }
        }
        SEAM(pb + 2);
        if (IN(pb + 3)) { PH_BEGIN
            bf16* SEG = WSP(bf16, WS_SEG);
            RLOOP(3, true) { RSYNC;
            if (!rp_) hgB(cc, WSP(bf16, WS_ST), WSP(float, WS_DEC));
            for (int p = blockIdx.x; p < 256; p += cc.G) { const int bh = (p & 7) * 4 + (p >> 6), j = (p >> 3) & 7;
                if (cc.wave >= 4) {
#pragma unroll 1
                    for (int u = 0; u < 2; ++u) attn_unit<true>(cc, bh, u ? j : 15 - j, SEG, SEG + SEGSZ, WSP(bf16, WS_MERGED), SEG + 2 * SEGSZ);
                } else {
#pragma unroll 1
                    for (int u = 0; u < 2; ++u) attn_unit<false>(cc, bh, u ? j : 15 - j, SEG, SEG + SEGSZ, WSP(bf16, WS_MERGED), SEG + 2 * SEGSZ);
                } } }
        }
        SEAM(pb + 3);
        if (IN(pb + 4)) { PH_BEGIN
            bf16* SEG = WSP(bf16, WS_SEG);
            RLOOP(4, true) { RSYNC;
            for (int ci = blockIdx.x; ci < 2048; ci += cc.G) hgC_chunk(cc, ci, SEG + 3 * SEGSZ, SEG + 4 * SEGSZ, SEG + 5 * SEGSZ, SEG + 6 * SEGSZ, WSP(bf16, WS_ST), INP(6) + (size_t)l * 128, WSP(bf16, WS_HGR)); }
        }
        SEAM(pb + 4);
        if (IN(pb + 5)) { PH_BEGIN
            RLOOP(5, true) { RSYNC;
            pg8::StaticOrder S; S.init(NTOK, DM, cc.G, (int)blockIdx.x);
            { pg8::Gemm g{WSP(bf16, WS_SEG) + 2 * SEGSZ, WSP(bf16, WS_WBR), NTOK, DM, BW}; EpiMerge<true> E{WSP(bf16, WS_GATE), WSP(bf16, WS_MERGED)}; pg8::gemm_phase<EpiMerge<true>, pg8::StaticOrder, true, true>(cc.lds, g, S, E, cc.wave); }
            { pg8::Gemm g{WSP(bf16, WS_HGR), WSP(bf16, WS_WBR) + (size_t)DM * BW, NTOK, DM, BW}; EpiMerge<false> E{WSP(bf16, WS_GATE) + (size_t)NTOK * 2048, WSP(bf16, WS_MERGED)}; pg8::gemm_phase<EpiMerge<false>, pg8::StaticOrder, true, true>(cc.lds, g, S, E, cc.wave); }
            { pg8::Gemm g{WSP(bf16, WS_CONV), WSP(bf16, WS_WBR) + (size_t)2 * DM * BW, NTOK, DM, BW}; EpiMerge<false> E{WSP(bf16, WS_GATE) + (size_t)2 * NTOK * 2048, WSP(bf16, WS_MERGED)}; pg8::gemm_phase<EpiMerge<false>, pg8::StaticOrder, true, true>(cc.lds, g, S, E, cc.wave); } }
        }
        SEAM(pb + 5);
        if (IN(pb + 6)) { PH_BEGIN
            RLOOP(6, true) { RSYNC;
            pg8::Gemm g{WSP(bf16, WS_MERGED), WSP(bf16, WS_WO), NTOK, DM, DM}; pg8::StaticOrder S; S.init(NTOK, DM, cc.G, (int)blockIdx.x);
            EpiResid E{l == 0 ? INP(0) : WSP(const float, WS_X2), outp};
            pg8::gemm_phase<EpiResid, pg8::StaticOrder, true, true>(cc.lds, g, S, E, cc.wave); }
        }
        SEAM(pb + 6);
        if (IN(pb + 7)) { PH_BEGIN RLOOP(7, true) { RSYNC; rms_phase(cc, outp, INP(15) + (size_t)l * DM, WSP(bf16, WS_H)); } }
        SEAM(pb + 7);
        if (IN(pb + 8)) { PH_BEGIN
            RLOOP(8, true) { RSYNC;
            pg8::Gemm g{WSP(bf16, WS_H), WSP(bf16, WS_WQ), NTOK, DM, DM}; pg8::StaticOrder S; S.init(NTOK, DM, cc.G, (int)blockIdx.x);
            EpiStoreBf16 E{WSP(bf16, WS_QPEER)};
            pg8::gemm_phase<EpiStoreBf16, pg8::StaticOrder, true, true>(cc.lds, g, S, E, cc.wave); }
        }
        SEAM(pb + 8);
        if (IN(pb + 9)) { PH_BEGIN
            RLOOP(9, true) { RSYNC;
            for (int item = blockIdx.x; item < 512; item += cc.G) { const int hd = item & 7, tg = item >> 3;
                const bf16* KB = WSP(bf16, WS_KEYS);
#pragma unroll
                for (int i = 0; i < 8; ++i) { const int p = cc.tid + 512 * i, li = p >> 11, row = (p >> 4) & 127, c16 = p & 15;
                    *(LAS v4u*)(cc.lds + li * 128 * PK_KS + row * PK_KS + c16 * 16) = *(const GAS v4u*)(KB + (size_t)(li * 8 + hd) * 16384 + row * 128 + c16 * 8); }
                __syncthreads();
                peer_select32(hd, tg * 256 + cc.wave * 32, cc.lane, WSP(bf16, WS_QPEER), cc.lds, cc.lds + 128 * PK_KS, w, (LAS unsigned*)(cc.lds + 2 * 128 * PK_KS + cc.wave * 4096));
                __syncthreads(); } }
        }
        SEAM(pb + 9);
        if (IN(pb + 10)) { PH_BEGIN
            const SliceSched SS = slice_sched_init(cc, (unsigned*)(w + WS_CTL), bar, l * 2 + 0);
            RLOOP(10, true) { RSYNC;
            for (int i = 0;; ++i) { int sl, tb; if (!slice_item(SS, cc, i, sl, tb)) break;
                peer_sddmm_wave(tb * 64 + cc.wave * 8, sl, cc.lane, WSP(bf16, WS_H), WSP(unsigned char, WS_U), WSP(int, WS_SEL), WSP(float, WS_PART), (LAS unsigned*)(cc.lds + 4096 + cc.wave * 8192)); } }
        }
        SEAM(pb + 10);
        if (IN(pb + 11)) { PH_BEGIN
            for (int n = cc.gw; n < NTOK / 4; n += cc.NGW) peer_coef_tokens4(n, NTOK / 4, cc.lane, WSP(float, WS_PART), WSP(int, WS_SEL), WSP(float, WS_SEL + 8 * MiB), WSP(float, WS_SELS), WSP(float, WS_US), WSP(float, WS_VS));
        }
        SEAM(pb + 11);
        if (IN(pb + 12)) { PH_BEGIN
            float* xo = l == 0 ? WSP(float, WS_X2) : outp;
            const SliceSched SS = slice_sched_init(cc, (unsigned*)(w + WS_CTL), bar, l * 2 + 1);
#ifndef REP_MODE
#define REP_MODE 0
#endif
            RLOOP(12, l == 0) { RSYNC;
            if (REP_MODE && rp_) {
            for (int i = 0;; ++i) { int sl, tb; if (!slice_item8(SS, cc, i, sl, tb)) break;
                peer_spmm6_wave<REP_MODE>(tb * 64 + cc.wave * 8, sl, cc.lane, WSP(unsigned char, WS_V), WSP(int, WS_SEL), WSP(float, WS_SEL + 8 * MiB), outp, WSP(float, WS_SEG + 64 * MiB), (LAS unsigned*)(cc.lds + 4096 + cc.wave * 8192)); }
            } else
            for (int i = 0;; ++i) { int sl, tb; if (!slice_item8(SS, cc, i, sl, tb)) break;
                peer_spmm6_wave(tb * 64 + cc.wave * 8, sl, cc.lane, WSP(unsigned char, WS_V), WSP(int, WS_SEL), WSP(float, WS_SEL + 8 * MiB), outp, xo, (LAS unsigned*)(cc.lds + 4096 + cc.wave * 8192)); } }
        }
        SEAM(pb + 12);
    }
#undef PH_BEGIN
#undef INP
#undef WSP
#undef IN
#undef SEAM
}

#ifndef MK_SPLIT
#define MK_SPLIT 0
#endif
extern "C" void kernel_launch(void* const* d_in, const int* in_sizes, int n_in, void* d_out, int out_size, void* d_ws, size_t ws_size, hipStream_t stream) {
    static int grid = 0;
    if (grid == 0) {
        if (n_in != 21 || out_size != NTOK * DM || ws_size < WS_END) { fprintf(stderr, "kernel_launch: unexpected shapes (n_in %d, out %d, ws %zu < %zu); nothing launched\n", n_in, out_size, ws_size, (size_t)WS_END); grid = -1; return; }
        int dev = 0, cus = 0, per_cu = 0;
        if (hipGetDevice(&dev) != hipSuccess || hipDeviceGetAttribute(&cus, hipDeviceAttributeMultiprocessorCount, dev) != hipSuccess) { grid = -1; return; }
        if (hipFuncSetAttribute((const void*)mk_fwd, hipFuncAttributeMaxDynamicSharedMemorySize, LDS_BYTES) != hipSuccess) { fprintf(stderr, "kernel_launch: hipFuncSetAttribute failed\n"); grid = -1; return; }
        if (hipOccupancyMaxActiveBlocksPerMultiprocessor(&per_cu, (const void*)mk_fwd, 512, LDS_BYTES) != hipSuccess || per_cu < 1) fprintf(stderr, "kernel_launch: occupancy query reports %d\n", per_cu);
        (void)hipGetLastError();
        grid = cus;
    }
    if (grid < 0) return;
    if (hipMemsetAsync((char*)d_ws + WS_CTL, 0, 1 * MiB, stream) != hipSuccess) { fprintf(stderr, "kernel_launch: memset failed\n"); return; }
    Args a{};
    for (int i = 0; i < 21; ++i) a.in[i] = (const float*)d_in[i];
    a.out = (float*)d_out; a.ws = (unsigned char*)d_ws; a.pad = 0;
#if MK_SPLIT
    for (int p = 0; p < NPHASES; ++p) { a.lo = p; a.hi = p + 1; a.li = p; hipLaunchKernelGGL(mk_fwd, dim3(grid), dim3(512), LDS_BYTES, stream, a); }
#else
    a.lo = 0; a.hi = NPHASES; a.li = 0;
    hipLaunchKernelGGL(mk_fwd, dim3(grid), dim3(512), LDS_BYTES, stream, a);
#endif
    const hipError_t le = hipPeekAtLastError();
    if (le != hipSuccess) fprintf(stderr, "kernel_launch: launch failed: %s\n", hipGetErrorName(le));
}
```

```cpp
#include <hip/hip_runtime.h>
#include <cstdio>
#include <cstdint>
namespace pg8 {
#define PG8_LAS __attribute__((address_space(3)))
typedef unsigned short bf16_t;
typedef short bf16x8 __attribute__((ext_vector_type(8)));
typedef float f32x4 __attribute__((ext_vector_type(4)));
typedef unsigned u32x4 __attribute__((ext_vector_type(4)));
constexpr int BM = 256, BK = 64, HALF = 128, HTB = HALF * BK * 2  , STAGE_BYTES = 8 * HTB, NXCD = 8, WGM = 8;

__host__ __device__ __forceinline__ int lds_byte(int r, int c) { const int st = (r >> 4) * 2 + (c >> 5), rr = r & 15, cc = c & 31, ob = rr * 64 + cc * 2; return st * 1024 + (ob ^ (((ob >> 9) & 1) << 5)); }
__host__ __device__ __forceinline__ void stage_rc(int b, int& R, int& C) { const int st = b / 1024, sb = b % 1024, swz = sb ^ (((sb >> 9) & 1) << 5); R = (st >> 1) * 16 + swz / 64; C = (st & 1) * 32 + (swz % 64) / 2; }
__host__ __device__ __forceinline__ int perm32(int rho) { const int n = rho >> 4, i = rho & 15; return 8 * (i >> 2) + 4 * n + (i & 3); }

struct Unit { int pm, pn; };
struct Gemm { const bf16_t* A; const bf16_t* Bt; int M, N, K; };

struct StaticOrder {
    int nM, nN, nwg, G, c;
    __host__ __device__ void init(int M, int N, int G_, int c_) { nM = M / BM; nN = N / BM; nwg = nM * nN; G = G_; c = c_; }
    __host__ __device__ bool next(int i, Unit& u) const {
        const long L = (long)i * G + c; if (L >= nwg) return false;
        int wgid = (int)L; { const int q = nwg / NXCD, r = nwg % NXCD, xcd = wgid % NXCD, off = wgid / NXCD; wgid = (xcd < r ? xcd * (q + 1) : r * (q + 1) + (xcd - r) * q) + off; }
        const int nig = WGM * nN, gid = wgid / nig, fm = gid * WGM, gsz = (nM - fm) < WGM ? (nM - fm) : WGM;
        u.pm = fm + ((wgid % nig) % gsz); u.pn = (wgid % nig) / gsz; return true;
    }
    __device__ __forceinline__ void a_ready(const Unit&) const {}
    __device__ __forceinline__ void done(const Unit&) const {}
};

typedef float f32x2 __attribute__((ext_vector_type(2)));
template <class Epi, class Sched, bool ALIGN_EPI = false, bool SP2 = false, bool I8 = false>
__device__ __forceinline__ void gemm_phase(PG8_LAS unsigned char* lds, const Gemm g, const Sched& S, const Epi& E, int wave_) {
    unsigned z_ = 0u; asm volatile("" : "+s"(z_)); int tid_ = wave_ * 64 + (int)__builtin_amdgcn_mbcnt_hi(~0u, __builtin_amdgcn_mbcnt_lo(~0u, z_)); asm volatile("" : "+v"(tid_));     int K_ = g.K; asm volatile("" : "+s"(K_));
    const int tid = tid_, wid = __builtin_amdgcn_readfirstlane(tid >> 6), lane = tid & 63, wr = wid >> 2, wc = wid & 3, fr = lane & 15, fq = lane >> 4;
    const int K = I8 ? (K_ >> 1) : K_, nt = K / BK;
    unsigned voffA[2], voffB[2];
#pragma unroll
    for (int i = 0; i < 2; ++i) { int R, C; stage_rc(tid * 16 + i * 8192, R, C); const int Rb = Epi::PERM ? ((R & ~31) + perm32(R & 31)) : R;
        voffA[i] = (unsigned)(R * K + C) * 2u; voffB[i] = (unsigned)(Rb * K + C) * 2u; }
    const size_t kstep = (size_t)(BK * 2);
    const size_t hstep = (size_t)HALF * K * 2;
    const size_t tstep = 2 * hstep;
    const unsigned ldsw = (unsigned)wid * 1024u;
    const int aoff = lds_byte(wr * 64 + fr, fq * 8), boff = lds_byte(wc * 32 + fr, fq * 8);
#define PG8_SA(b, h) (((b) * 2 + (h)) * HTB)
#define PG8_SB(b, h) ((4 + (b) * 2 + (h)) * HTB)
#define PG8_STAGE(bufoff, gbase, voff) do { _Pragma("unroll") for (int _i = 0; _i < 2; ++_i) \
        __builtin_amdgcn_global_load_lds((const unsigned*)((const char*)(gbase) + (voff)[_i]), (PG8_LAS unsigned*)(lds + (bufoff) + ldsw + _i * 8192), 16, 0, 0); } while (0)
#define PG8_LDA(dst, b, h) do { _Pragma("unroll") for (int m = 0; m < 4; ++m) _Pragma("unroll") for (int k = 0; k < 2; ++k) dst[m][k] = *(const PG8_LAS bf16x8*)(lds + PG8_SA(b, h) + aoff + m * 2048 + k * 1024); } while (0)
#define PG8_LDB(dst, b, h) do { _Pragma("unroll") for (int n = 0; n < 2; ++n) _Pragma("unroll") for (int k = 0; k < 2; ++k) dst[n][k] = *(const PG8_LAS bf16x8*)(lds + PG8_SB(b, h) + boff + n * 2048 + k * 1024); } while (0)
#define PG8_MMA(ai, bj, At, Bt) do { __builtin_amdgcn_s_setprio(1); _Pragma("unroll") for (int m = 0; m < 4; ++m) _Pragma("unroll") for (int n = 0; n < 2; ++n) _Pragma("unroll") for (int k = 0; k < 2; ++k) { \
        if constexpr (I8) { typedef int v4i_t __attribute__((ext_vector_type(4))); \
            acc[ai][bj][m][n] = __builtin_bit_cast(f32x4, __builtin_amdgcn_mfma_i32_16x16x64_i8(__builtin_bit_cast(v4i_t, Bt[n][k]), __builtin_bit_cast(v4i_t, At[m][k]), __builtin_bit_cast(v4i_t, acc[ai][bj][m][n]), 0, 0, 0)); } \
        else acc[ai][bj][m][n] = __builtin_amdgcn_mfma_f32_16x16x32_bf16(Bt[n][k], At[m][k], acc[ai][bj][m][n], 0, 0, 0); } __builtin_amdgcn_s_setprio(0); } while (0)
#define PG8_WAIT_V(n) asm volatile("s_waitcnt vmcnt(" #n ")" ::: "memory")
#define PG8_WAIT_L(n) asm volatile("s_waitcnt lgkmcnt(" #n ")" ::: "memory")
#define PG8_BAR __builtin_amdgcn_s_barrier()
#define PG8_SCHED __builtin_amdgcn_sched_barrier(0)
    Unit cur, nxt; int ui = 0;
    if (!S.next(0, cur)) return;
    f32x4 acc[2][2][4][2];
#pragma unroll
    for (int a = 0; a < 2; ++a)
#pragma unroll
        for (int b = 0; b < 2; ++b)
#pragma unroll
            for (int m = 0; m < 4; ++m)
#pragma unroll
                for (int n = 0; n < 2; ++n) acc[a][b][m][n] = (f32x4){0.f, 0.f, 0.f, 0.f};
    bf16x8 At[4][2], B0[2][2], B1[2][2];
    const char* cA = (const char*)g.A + (size_t)cur.pm * tstep; const char* cB = (const char*)g.Bt + (size_t)cur.pn * tstep;
    S.a_ready(cur);
    if constexpr (SP2) {
        PG8_STAGE(PG8_SB(0, 0), cB, voffB); PG8_STAGE(PG8_SB(0, 1), cB + hstep, voffB); PG8_STAGE(PG8_SA(0, 0), cA, voffA); PG8_STAGE(PG8_SA(0, 1), cA + hstep, voffA);
        if (wr == 1) PG8_BAR;
        PG8_WAIT_V(2); PG8_BAR;
        PG8_STAGE(PG8_SB(1, 0), cB + kstep, voffB); PG8_STAGE(PG8_SA(1, 0), cA + kstep, voffA); PG8_STAGE(PG8_SB(1, 1), cB + hstep + kstep, voffB);
        PG8_WAIT_V(6); PG8_BAR;
    } else {
        PG8_STAGE(PG8_SB(0, 0), cB, voffB); PG8_STAGE(PG8_SA(0, 0), cA, voffA); PG8_STAGE(PG8_SB(0, 1), cB + hstep, voffB); PG8_STAGE(PG8_SA(0, 1), cA + hstep, voffA);
        if (wr == 1) PG8_BAR;
        PG8_WAIT_V(4); PG8_BAR;
        PG8_STAGE(PG8_SB(1, 0), cB + kstep, voffB); PG8_STAGE(PG8_SA(1, 0), cA + kstep, voffA); PG8_STAGE(PG8_SB(1, 1), cB + hstep + kstep, voffB);
        PG8_WAIT_V(6); PG8_BAR;
    }
    for (;;) {
        const bool has_next = S.next(ui + 1, nxt);
        const char* nA = has_next ? (const char*)g.A + (size_t)nxt.pm * tstep : cA; const char* nB = has_next ? (const char*)g.Bt + (size_t)nxt.pn * tstep : cB;
        for (int t = 0; t < nt; t += 2) {
            const bool last = (t == nt - 2);
            const char* a1 = cA + (size_t)(t + 1) * kstep;
            const char* a2 = last ? nA : cA + (size_t)(t + 2) * kstep; const char* b2 = last ? nB : cB + (size_t)(t + 2) * kstep;
            const char* a3 = a2 + kstep; const char* b3 = b2 + kstep;
            if (last && has_next) S.a_ready(nxt);
            if constexpr (SP2) {
            PG8_LDB(B0, 0, 0); PG8_LDB(B1, 0, 1); PG8_SCHED; PG8_LDA(At, 0, 0); PG8_STAGE(PG8_SA(1, 1), a1 + hstep, voffA);
            PG8_WAIT_V(8); PG8_WAIT_L(0); PG8_BAR; PG8_MMA(0, 0, At, B0); PG8_MMA(0, 1, At, B1); PG8_BAR; PG8_SCHED;
            PG8_LDA(At, 0, 1); PG8_STAGE(PG8_SB(0, 0), b2, voffB); PG8_STAGE(PG8_SB(0, 1), b2 + hstep, voffB); PG8_STAGE(PG8_SA(0, 0), a2, voffA);
            PG8_WAIT_V(8); PG8_WAIT_L(0); PG8_BAR; PG8_MMA(1, 0, At, B0); PG8_MMA(1, 1, At, B1); PG8_BAR; PG8_SCHED;
            PG8_LDB(B0, 1, 0); PG8_LDB(B1, 1, 1); PG8_SCHED; PG8_LDA(At, 1, 0); PG8_STAGE(PG8_SA(0, 1), a2 + hstep, voffA);
            PG8_WAIT_V(8); PG8_WAIT_L(0); PG8_BAR; PG8_MMA(0, 0, At, B0); PG8_MMA(0, 1, At, B1); PG8_BAR; PG8_SCHED;
            PG8_LDA(At, 1, 1); PG8_STAGE(PG8_SB(1, 0), b3, voffB); PG8_STAGE(PG8_SB(1, 1), b3 + hstep, voffB); PG8_STAGE(PG8_SA(1, 0), a3, voffA);
            PG8_WAIT_V(8); PG8_WAIT_L(0); PG8_BAR; PG8_MMA(1, 0, At, B0); PG8_MMA(1, 1, At, B1); PG8_BAR; PG8_SCHED;
            } else {
            PG8_LDB(B0, 0, 0); PG8_SCHED; PG8_LDA(At, 0, 0); PG8_STAGE(PG8_SA(1, 1), a1 + hstep, voffA);
            PG8_WAIT_L(8); PG8_BAR; PG8_WAIT_L(0); PG8_MMA(0, 0, At, B0); PG8_BAR; PG8_SCHED;
            PG8_LDB(B1, 0, 1); PG8_STAGE(PG8_SB(0, 0), b2, voffB);
            PG8_BAR; PG8_WAIT_L(0); PG8_MMA(0, 1, At, B1); PG8_BAR;
            PG8_LDA(At, 0, 1); PG8_STAGE(PG8_SA(0, 0), a2, voffA);
            PG8_BAR; PG8_WAIT_L(0); PG8_MMA(1, 0, At, B0); PG8_BAR; PG8_SCHED;
            PG8_STAGE(PG8_SB(0, 1), b2 + hstep, voffB);
            PG8_WAIT_V(6); PG8_BAR; PG8_MMA(1, 1, At, B1); PG8_BAR;
            PG8_LDB(B0, 1, 0); PG8_SCHED; PG8_LDA(At, 1, 0); PG8_STAGE(PG8_SA(0, 1), a2 + hstep, voffA);
            PG8_WAIT_L(8); PG8_BAR; PG8_WAIT_L(0); PG8_MMA(0, 0, At, B0); PG8_BAR; PG8_SCHED;
            PG8_LDB(B1, 1, 1); PG8_STAGE(PG8_SB(1, 0), b3, voffB);
            PG8_BAR; PG8_WAIT_L(0); PG8_MMA(0, 1, At, B1); PG8_BAR;
            PG8_LDA(At, 1, 1); PG8_STAGE(PG8_SA(1, 0), a3, voffA);
            PG8_BAR; PG8_WAIT_L(0); PG8_MMA(1, 0, At, B0); PG8_BAR; PG8_SCHED;
            PG8_STAGE(PG8_SB(1, 1), b3 + hstep, voffB);
            PG8_WAIT_V(6); PG8_BAR; PG8_MMA(1, 1, At, B1); PG8_BAR;
            }
        }
        if constexpr (ALIGN_EPI) { if (wr == 0) PG8_BAR; }
        if constexpr (I8) {
#pragma unroll
            for (int a = 0; a < 2; ++a)
#pragma unroll
                for (int m = 0; m < 4; ++m) { const float r_ = E.rowscale(cur.pm * BM + wr * 64 + fr + a * HALF + m * 16);
#pragma unroll
                    for (int b = 0; b < 2; ++b)
#pragma unroll
                        for (int n = 0; n < 2; ++n) { typedef int v4i2_t __attribute__((ext_vector_type(4))); const v4i2_t i_ = __builtin_bit_cast(v4i2_t, acc[a][b][m][n]);
                            acc[a][b][m][n] = (f32x4){(float)i_[0] * r_, (float)i_[1] * r_, (float)i_[2] * r_, (float)i_[3] * r_}; } }
        }
        if constexpr (!Epi::AFTER_DRAIN) { E(acc, cur, wr, wc, fr, fq); S.done(cur); }
        if (!has_next) break;
#pragma unroll
        for (int a = 0; a < 2; ++a)
#pragma unroll
            for (int b = 0; b < 2; ++b)
#pragma unroll
                for (int m = 0; m < 4; ++m)
#pragma unroll
                    for (int n = 0; n < 2; ++n) acc[a][b][m][n] = (f32x4){0.f, 0.f, 0.f, 0.f};
        cur = nxt; cA = nA; cB = nB; ++ui;
        if constexpr (ALIGN_EPI) { if (wr == 1) PG8_BAR; }
    }
    PG8_WAIT_V(0);
    if constexpr (!ALIGN_EPI) { if (wr == 0) PG8_BAR; }
    PG8_BAR;
    if constexpr (Epi::AFTER_DRAIN) { E.fused(acc, cur, wr, wc, fr, fq, lds, wid, lane); S.done(cur); }
#undef PG8_SA
#undef PG8_SB
#undef PG8_STAGE
#undef PG8_LDA
#undef PG8_LDB
#undef PG8_MMA
#undef PG8_WAIT_V
#undef PG8_WAIT_L
#undef PG8_BAR
#undef PG8_SCHED
}
}
#define XB_TMO      128
#define XB_XCNT(j)  (256  + 64 * (j))
#define XB_XSUB(j)  (1280 + 64 * (j))
#define XB_XGEN(j)  (2304 + 64 * (j))
#define XB_TOP      3328
#define XB_TOPGEN   3392
#define XCD_BAR_WORDS 3456
#define XB_SPIN_CAP (1u << 24)
#define LAS __attribute__((address_space(3)))

__device__ __forceinline__ unsigned xb_ld(unsigned* p)              { return __hip_atomic_load(p, __ATOMIC_RELAXED, __HIP_MEMORY_SCOPE_AGENT); }
__device__ __forceinline__ unsigned xb_add(unsigned* p, unsigned v) { return __hip_atomic_fetch_add(p, v, __ATOMIC_RELAXED, __HIP_MEMORY_SCOPE_AGENT); }
__device__ __forceinline__ unsigned xb_xcc_id() { return (unsigned)__builtin_amdgcn_s_getreg((3 << 11) | 20) & 0xFu; }
#define XB_SPIN(cond, bar) do { unsigned _sp = 0; while (cond) { __builtin_amdgcn_s_sleep(1); \
    if ((++_sp & 255u) == 0u) { if (xb_ld(&(bar)[XB_TMO])) break; if (_sp > XB_SPIN_CAP) { atomicAdd(&(bar)[XB_TMO], 1u); break; } } } } while (0)

__device__ __forceinline__ int xb_lane_id() { unsigned z = 0u; asm volatile("" : "+s"(z)); return (int)__builtin_amdgcn_mbcnt_hi(~0u, __builtin_amdgcn_mbcnt_lo(~0u, z)); }
struct XcdBarrier {
    unsigned w0;
    unsigned* bar; unsigned x;
    volatile LAS unsigned* st;
};

__device__ __forceinline__ XcdBarrier xcd_barrier_post(unsigned* bar, volatile LAS unsigned* st) {
    XcdBarrier b; b.bar = bar; b.x = xb_xcc_id(); b.st = st; b.w0 = (__builtin_amdgcn_readfirstlane((int)threadIdx.x >> 6) == 0) ? 1u : 0u;
    if (b.w0 && xb_lane_id() == 0) (void)xb_add(&bar[XB_XCNT(b.x)], 1u);
    return b;
}
__device__ __forceinline__ void xcd_barrier_complete(unsigned* bar, unsigned x, unsigned& nloc, unsigned& nx) {
    const unsigned G = gridDim.x * gridDim.y * gridDim.z;
    unsigned sum, cnt, mine, sp = 0u;
    for (;;) {
        sum = 0u; cnt = 0u; mine = 0u;
#pragma unroll
        for (unsigned j = 0; j < 16; ++j) { const unsigned c = xb_ld(&bar[XB_XCNT(j)]); sum += c; cnt += (c > 0u) ? 1u : 0u; mine = (j == x) ? c : mine; }
        if (sum == G) break;
        __builtin_amdgcn_s_sleep(1);
        if ((++sp & 255u) == 0u) { if (xb_ld(&bar[XB_TMO])) break; if (sp > XB_SPIN_CAP) { atomicAdd(&bar[XB_TMO], 1u); break; } }
    }
    nloc = mine > 0u ? mine : 1u; nx = cnt > 0u ? cnt : 1u;
}

__device__ __forceinline__ void xcd_barrier(const XcdBarrier& b) {
    asm volatile("s_waitcnt vmcnt(0)" ::: "memory");
    __syncthreads();
    if (b.w0 && xb_lane_id() == 0) {
        unsigned* bar = b.bar;
        __builtin_amdgcn_s_waitcnt(0);
        unsigned nloc = b.st[0], nx = b.st[1];
        if (nloc == 0u) { xcd_barrier_complete(bar, b.x, nloc, nx); b.st[0] = nloc; b.st[1] = nx; }
        const unsigned old = xb_add(&bar[XB_XSUB(b.x)], 1u);
        const unsigned gen = old / nloc;
        if (old + 1u == (gen + 1u) * nloc) {
            __builtin_amdgcn_fence(__ATOMIC_RELEASE, "agent");
            asm volatile("s_waitcnt vmcnt(0)" ::: "memory");
            const unsigned og = xb_add(&bar[XB_TOP], 1u);
            const unsigned tg = og / nx;
            if (og + 1u == (tg + 1u) * nx) xb_add(&bar[XB_TOPGEN], 1u);
            else XB_SPIN(xb_ld(&bar[XB_TOPGEN]) == tg, bar);
            __builtin_amdgcn_fence(__ATOMIC_ACQUIRE, "agent");
            xb_add(&bar[XB_XGEN(b.x)], 1u);
            asm volatile("s_waitcnt vmcnt(0)" ::: "memory");
        } else {
            XB_SPIN(xb_ld(&bar[XB_XGEN(b.x)]) == gen, bar);
            __builtin_amdgcn_fence(__ATOMIC_ACQUIRE, "agent");
            asm volatile("s_waitcnt vmcnt(0)" ::: "memory");
        }
    }
    __syncthreads();
}


#define GAS __attribute__((address_space(1)))
typedef unsigned short bf16;
typedef unsigned v4u __attribute__((ext_vector_type(4)));
typedef unsigned v2u __attribute__((ext_vector_type(2)));
typedef float f32x4 __attribute__((ext_vector_type(4)));
typedef float f32x2v __attribute__((ext_vector_type(2)));
typedef float f32x16 __attribute__((ext_vector_type(16)));
typedef short bf16x8 __attribute__((ext_vector_type(8)));
typedef __bf16 bf16v2 __attribute__((ext_vector_type(2)));
typedef _Float16 h2_t __attribute__((ext_vector_type(2)));
typedef _Float16 v32h_t __attribute__((ext_vector_type(32)));
typedef unsigned v6u __attribute__((ext_vector_type(6)));

constexpr int NTOK = 16384, DM = 2048, SEQ = 4096, INW = 15360, BW = 1024;
constexpr float EPS = 1e-6f;
constexpr float WIN_QS = 1024.0f;
constexpr int NPH = 13;
constexpr int NPHASES = 2 * NPH;

constexpr size_t MiB = 1u << 20;
constexpr size_t WS_CTL = 0;
constexpr size_t WS_LB = 1 * MiB;
constexpr size_t WS_SA = 1 * MiB + 192 * 1024;
constexpr size_t WS_US = 1 * MiB + 64 * 1024, WS_VS = 1 * MiB + 128 * 1024;
constexpr size_t WS_WIN = 2 * MiB;
constexpr size_t WS_WBR = 62 * MiB;
constexpr size_t WS_WO = 74 * MiB;
constexpr size_t WS_WQ = 82 * MiB;
constexpr size_t WS_U = 91 * MiB;
constexpr size_t WS_V = 155 * MiB;
constexpr size_t WS_H = 219 * MiB;
constexpr size_t WS_SEG = 283 * MiB;
constexpr size_t WS_GATE = 539 * MiB;
constexpr size_t WS_X2 = 731 * MiB;
constexpr size_t WS_CONV = 859 * MiB;
constexpr size_t WS_HGR = 891 * MiB;
constexpr size_t WS_MERGED = 923 * MiB;
constexpr size_t WS_SEL = 987 * MiB;
constexpr size_t WS_SELS = 1003 * MiB;
constexpr size_t WS_DEC = 1004 * MiB;
constexpr size_t WS_END = 1005 * MiB;
constexpr size_t WS_ST = WS_H;
constexpr size_t WS_KEYS = 90 * MiB;
constexpr size_t WS_PART = WS_GATE;
constexpr size_t WS_QPEER = WS_SEG;
constexpr size_t SEGSZ = (size_t)NTOK * 1024;
constexpr int CW_BAR = 4096;
constexpr int CW_RANK = 131072;

constexpr int RING_BYTES = 131072, MISC_OFF = RING_BYTES + 320, LDS_BYTES = 147456;

__device__ __forceinline__ unsigned pk2c(float lo, float hi) { f32x2v v = {lo, hi}; bf16v2 b = __builtin_convertvector(v, bf16v2); return __builtin_bit_cast(unsigned, b); }
__device__ __forceinline__ float bflo(unsigned x) { return __uint_as_float(x << 16); }
__device__ __forceinline__ float bfhi(unsigned x) { return __uint_as_float(x & 0xffff0000u); }
__device__ __forceinline__ float sigm(float x) { return __builtin_amdgcn_rcpf(1.0f + __expf(-x)); }
__device__ __forceinline__ float wave_sum(float v) {
#pragma unroll
    for (int o = 1; o < 64; o <<= 1) v += __shfl_xor(v, o);
    return v;
}
__device__ __forceinline__ float wave_max(float v) {
#pragma unroll
    for (int o = 1; o < 64; o <<= 1) v = fmaxf(v, __shfl_xor(v, o));
    return v;
}
#define LDS_WAIT() asm volatile("s_waitcnt lgkmcnt(0)" ::: "memory")
#define MFMA32(a, b, c) __builtin_amdgcn_mfma_f32_32x32x16_bf16((a), (b), (c), 0, 0, 0)
__device__ __forceinline__ int ridx16(int lane) { return ((lane >> 5) & 1) * 8 + ((lane >> 4) & 1) * 4 + ((lane >> 3) & 1) * 2 + ((lane >> 2) & 1); }
__device__ __forceinline__ void xreduce16(float (&v)[16], int lane) {
#pragma unroll
    for (int i = 0; i < 8; ++i) { const bool up = (lane & 32) != 0; const float snd = up ? v[i] : v[i + 8], kp = up ? v[i + 8] : v[i]; v[i] = kp + __shfl_xor(snd, 32); }
#pragma unroll
    for (int i = 0; i < 4; ++i) { const bool up = (lane & 16) != 0; const float snd = up ? v[i] : v[i + 4], kp = up ? v[i + 4] : v[i]; v[i] = kp + __shfl_xor(snd, 16); }
#pragma unroll
    for (int i = 0; i < 2; ++i) { const bool up = (lane & 8) != 0; const float snd = up ? v[i] : v[i + 2], kp = up ? v[i + 2] : v[i]; v[i] = kp + __shfl_xor(snd, 8); }
    { const bool up = (lane & 4) != 0; const float snd = up ? v[0] : v[1], kp = up ? v[1] : v[0]; v[0] = kp + __shfl_xor(snd, 4); }
    v[0] += __shfl_xor(v[0], 2); v[0] += __shfl_xor(v[0], 1);
}
__device__ __forceinline__ float gelu_exact(float v) {
    const float av = fabsf(v), t = __builtin_amdgcn_rcpf(av * 0.2316418882f + 1.0f);
    float q = t * 0.5307027145f + (-0.7265760135f); q = q * t + 0.7107068705f; q = q * t + (-0.142248368f); q = q * t + 0.127414796f; q = q * t;
    const float e = __builtin_amdgcn_exp2f((v * v) * (-0.72134752044f));
    const float m = v * (q * e);
    return v < 0.f ? m : v - m;
}

struct Ctx { LAS unsigned char* lds; int tid, lane, wave, G, gw, NGW; };

__device__ __forceinline__ void tr_item(const float* W, int K, int N, bf16* WT, int k0, int n0, int drow0, LAS float* scr, int lane) {
    { const int lr = lane >> 3, lc = (lane & 7) * 4; f32x4 v[8];
#pragma unroll
      for (int j = 0; j < 8; ++j) v[j] = *(const GAS f32x4*)(W + (size_t)(k0 + lr + 8 * j) * N + n0 + lc);
#pragma unroll
      for (int j = 0; j < 8; ++j) { LAS float* d = scr + (lr + 8 * j) * 33 + lc; d[0] = v[j].x; d[1] = v[j].y; d[2] = v[j].z; d[3] = v[j].w; } }
    LDS_WAIT();
    const int c = lane & 7;
#pragma unroll
    for (int j = 0; j < 4; ++j) { const int n = (lane >> 3) + 8 * j; const LAS float* s = scr + (8 * c) * 33 + n;
        v4u o; o.x = pk2c(s[0], s[33]); o.y = pk2c(s[66], s[99]); o.z = pk2c(s[132], s[165]); o.w = pk2c(s[198], s[231]);
        *(GAS v4u*)(WT + (size_t)(drow0 + n) * K + k0 + 8 * c) = o; }
    LDS_WAIT();
}
__device__ __forceinline__ unsigned pack_i8x4c(float a, float b, float c, float d) {
    const int ia = (int)__builtin_rintf(fminf(fmaxf(a, -127.f), 127.f)), ib = (int)__builtin_rintf(fminf(fmaxf(b, -127.f), 127.f)), ic = (int)__builtin_rintf(fminf(fmaxf(c, -127.f), 127.f)), id = (int)__builtin_rintf(fminf(fmaxf(d, -127.f), 127.f));
    return ((unsigned)ia & 255u) | (((unsigned)ib & 255u) << 8) | (((unsigned)ic & 255u) << 16) | ((unsigned)id << 24);
}
__device__ __forceinline__ void tr_item_i8(const float* W, int K, int N, unsigned char* WT, int k0, int n0, int drow0, float scale, LAS float* scr, int lane) {
    { const int lr = lane >> 3, lc = (lane & 7) * 4; f32x4 v[16];
#pragma unroll
      for (int j = 0; j < 16; ++j) v[j] = *(const GAS f32x4*)(W + (size_t)(k0 + lr + 8 * j) * N + n0 + lc);
#pragma unroll
      for (int j = 0; j < 16; ++j) { LAS float* d = scr + (lr + 8 * j) * 32 + (lc ^ ((j & 7) << 2)); const int x = lr & 3; d[x] = v[j].x; d[1 ^ x] = v[j].y; d[2 ^ x] = v[j].z; d[3 ^ x] = v[j].w; } }
    LDS_WAIT();
    const int c = lane & 15;
#pragma unroll
    for (int j = 0; j < 8; ++j) { const int n = (lane >> 4) + 4 * j, q = n ^ ((c & 7) << 2); const LAS float* s = scr + (8 * c) * 32;
        v2u o; o.x = pack_i8x4c(s[q] * scale, s[32 + (q ^ 1)] * scale, s[64 + (q ^ 2)] * scale, s[96 + (q ^ 3)] * scale); o.y = pack_i8x4c(s[128 + q] * scale, s[160 + (q ^ 1)] * scale, s[192 + (q ^ 2)] * scale, s[224 + (q ^ 3)] * scale);
        *(GAS v2u*)(WT + (size_t)(drow0 + n) * K + k0 + 8 * c) = o; }
    LDS_WAIT();
}
__device__ __forceinline__ int win_drow(int n) { if (n < 7168 || n >= 9216) return n; const int r = n - 7168, isb = r >> 10, c = r & 1023; return 7168 + (c >> 7) * 256 + isb * 128 + (c & 127); }
__device__ __forceinline__ void cvt_copy(const Ctx& c, const float* src, bf16* dst, size_t n8) {
    const size_t NT = (size_t)c.G * 512;
    for (size_t i = (size_t)blockIdx.x * 512 + c.tid; i < n8; i += NT) {
        const f32x4 a = ((const GAS f32x4*)src)[2 * i], b = ((const GAS f32x4*)src)[2 * i + 1];
        v4u o; o.x = pk2c(a.x, a.y); o.y = pk2c(a.z, a.w); o.z = pk2c(b.x, b.y); o.w = pk2c(b.z, b.w);
        ((GAS v4u*)dst)[i] = o;
    }
}
__device__ __forceinline__ void rms_row(const float* xr, const float* w, bf16* o, int lane) {
    const GAS f32x4* xp = (const GAS f32x4*)xr + lane; f32x4 v[8]; float s = 0.f;
#pragma unroll
    for (int j = 0; j < 8; ++j) { v[j] = xp[64 * j]; s += (v[j].x * v[j].x + v[j].y * v[j].y) + (v[j].z * v[j].z + v[j].w * v[j].w); }
    const float r = __builtin_amdgcn_rsqf(wave_sum(s) * (1.0f / DM) + EPS);
    const GAS f32x4* wp = (const GAS f32x4*)w + lane; GAS v2u* op = (GAS v2u*)o + lane;
#pragma unroll
    for (int j = 0; j < 8; ++j) { const f32x4 wv = wp[64 * j]; v2u q; q.x = pk2c(v[j].x * r * wv.x, v[j].y * r * wv.y); q.y = pk2c(v[j].z * r * wv.z, v[j].w * r * wv.w); op[64 * j] = q; }
}
__device__ __forceinline__ void rms_row_i8(const float* xr, const float* w, unsigned char* o, float* sa, int lane) {
    const GAS f32x4* xp = (const GAS f32x4*)xr + lane; f32x4 v[8]; float s = 0.f;
#pragma unroll
    for (int j = 0; j < 8; ++j) { v[j] = xp[64 * j]; s += (v[j].x * v[j].x + v[j].y * v[j].y) + (v[j].z * v[j].z + v[j].w * v[j].w); }
    const float r = __builtin_amdgcn_rsqf(wave_sum(s) * (1.0f / DM) + EPS);
    const GAS f32x4* wp = (const GAS f32x4*)w + lane; float m = 0.f;
#pragma unroll
    for (int j = 0; j < 8; ++j) { const f32x4 wv = wp[64 * j]; v[j].x *= r * wv.x; v[j].y *= r * wv.y; v[j].z *= r * wv.z; v[j].w *= r * wv.w;
        m = fmaxf(fmaxf(m, fmaxf(fabsf(v[j].x), fabsf(v[j].y))), fmaxf(fabsf(v[j].z), fabsf(v[j].w))); }
    m = wave_max(m);
    const float inv = m > 0.f ? 127.0f / m : 0.f;
    if (lane == 0) *(GAS float*)sa = m * (1.0f / 127.0f);
#pragma unroll
    for (int j = 0; j < 8; ++j) ((GAS unsigned*)o)[lane + 64 * j] = pack_i8x4c(v[j].x * inv, v[j].y * inv, v[j].z * inv, v[j].w * inv);
}
__device__ __forceinline__ void rms_rows2_i8(const float* xa, const float* xb, const float* w, unsigned char* oa, unsigned char* ob, float* saa, float* sab, int lane) {
    const GAS f32x4* pa = (const GAS f32x4*)xa + lane; const GAS f32x4* pb = (const GAS f32x4*)xb + lane; f32x4 va[8], vb[8]; float s0 = 0.f, s1 = 0.f;
#pragma unroll
    for (int j = 0; j < 8; ++j) { va[j] = pa[64 * j]; vb[j] = pb[64 * j]; }
#pragma unroll
    for (int j = 0; j < 8; ++j) { s0 += (va[j].x * va[j].x + va[j].y * va[j].y) + (va[j].z * va[j].z + va[j].w * va[j].w); s1 += (vb[j].x * vb[j].x + vb[j].y * vb[j].y) + (vb[j].z * vb[j].z + vb[j].w * vb[j].w); }
#pragma unroll
    for (int o = 1; o < 64; o <<= 1) { s0 += __shfl_xor(s0, o); s1 += __shfl_xor(s1, o); }
    const float r0 = __builtin_amdgcn_rsqf(s0 * (1.0f / DM) + EPS), r1 = __builtin_amdgcn_rsqf(s1 * (1.0f / DM) + EPS);
    const GAS f32x4* wp = (const GAS f32x4*)w + lane; float m0 = 0.f, m1 = 0.f;
#pragma unroll
    for (int j = 0; j < 8; ++j) { const f32x4 wv = wp[64 * j];
        va[j].x *= r0 * wv.x; va[j].y *= r0 * wv.y; va[j].z *= r0 * wv.z; va[j].w *= r0 * wv.w; vb[j].x *= r1 * wv.x; vb[j].y *= r1 * wv.y; vb[j].z *= r1 * wv.z; vb[j].w *= r1 * wv.w;
        m0 = fmaxf(fmaxf(m0, fmaxf(fabsf(va[j].x), fabsf(va[j].y))), fmaxf(fabsf(va[j].z), fabsf(va[j].w))); m1 = fmaxf(fmaxf(m1, fmaxf(fabsf(vb[j].x), fabsf(vb[j].y))), fmaxf(fabsf(vb[j].z), fabsf(vb[j].w))); }
#pragma unroll
    for (int o = 1; o < 64; o <<= 1) { m0 = fmaxf(m0, __shfl_xor(m0, o)); m1 = fmaxf(m1, __shfl_xor(m1, o)); }
    const float i0 = m0 > 0.f ? 127.0f / m0 : 0.f, i1 = m1 > 0.f ? 127.0f / m1 : 0.f;
    if (lane == 0) { *(GAS float*)saa = m0 * (1.0f / 127.0f); *(GAS float*)sab = m1 * (1.0f / 127.0f); }
#pragma unroll
    for (int j = 0; j < 8; ++j) { ((GAS unsigned*)oa)[lane + 64 * j] = pack_i8x4c(va[j].x * i0, va[j].y * i0, va[j].z * i0, va[j].w * i0); ((GAS unsigned*)ob)[lane + 64 * j] = pack_i8x4c(vb[j].x * i1, vb[j].y * i1, vb[j].z * i1, vb[j].w * i1); }
}
__device__ __forceinline__ void rms_phase_i8(const Ctx& c, const float* x, const float* w, unsigned char* H8, float* SA) {
    for (int m = c.gw; m < NTOK / 2; m += c.NGW) rms_rows2_i8(x + (size_t)m * DM, x + (size_t)(m + NTOK / 2) * DM, w, H8 + (size_t)m * DM, H8 + (size_t)(m + NTOK / 2) * DM, SA + m, SA + m + NTOK / 2, c.lane);
}
__device__ __forceinline__ void rms_rows2(const float* xa, const float* xb, const float* w, bf16* oa, bf16* ob, int lane) {
    const GAS f32x4* pa = (const GAS f32x4*)xa + lane; const GAS f32x4* pb = (const GAS f32x4*)xb + lane; f32x4 va[8], vb[8]; float sa = 0.f, sb = 0.f;
#pragma unroll
    for (int j = 0; j < 8; ++j) { va[j] = pa[64 * j]; vb[j] = pb[64 * j]; }
#pragma unroll
    for (int j = 0; j < 8; ++j) { sa += (va[j].x * va[j].x + va[j].y * va[j].y) + (va[j].z * va[j].z + va[j].w * va[j].w); sb += (vb[j].x * vb[j].x + vb[j].y * vb[j].y) + (vb[j].z * vb[j].z + vb[j].w * vb[j].w); }
#pragma unroll
    for (int o = 1; o < 64; o <<= 1) { sa += __shfl_xor(sa, o); sb += __shfl_xor(sb, o); }
    const float ra = __builtin_amdgcn_rsqf(sa * (1.0f / DM) + EPS), rb = __builtin_amdgcn_rsqf(sb * (1.0f / DM) + EPS);
    const GAS f32x4* wp = (const GAS f32x4*)w + lane; GAS v2u* qa = (GAS v2u*)oa + lane; GAS v2u* qb = (GAS v2u*)ob + lane;
#pragma unroll
    for (int j = 0; j < 8; ++j) { const f32x4 wv = wp[64 * j];
        v2u q; q.x = pk2c(va[j].x * ra * wv.x, va[j].y * ra * wv.y); q.y = pk2c(va[j].z * ra * wv.z, va[j].w * ra * wv.w); qa[64 * j] = q;
        v2u p; p.x = pk2c(vb[j].x * rb * wv.x, vb[j].y * rb * wv.y); p.y = pk2c(vb[j].z * rb * wv.z, vb[j].w * rb * wv.w); qb[64 * j] = p; }
}
__device__ __forceinline__ void rms_phase(const Ctx& c, const float* x, const float* w, bf16* H) {
    for (int m = c.gw; m < NTOK / 2; m += c.NGW) rms_rows2(x + (size_t)m * DM, x + (size_t)(m + NTOK / 2) * DM, w, H + (size_t)m * DM, H + (size_t)(m + NTOK / 2) * DM, c.lane);
}
__device__ __forceinline__ void fp8_row(const float* src, unsigned char* dst, float* scale_out, int lane) {
    const GAS f32x4* xp = (const GAS f32x4*)src + lane; f32x4 v[8]; float m = 0.f;
#pragma unroll
    for (int j = 0; j < 8; ++j) { v[j] = xp[64 * j]; m = fmaxf(fmaxf(m, fmaxf(fabsf(v[j].x), fabsf(v[j].y))), fmaxf(fabsf(v[j].z), fabsf(v[j].w))); }
    m = wave_max(m);
    const float inv = m > 0.f ? 256.0f / m : 0.f;
    if (lane == 0) *(GAS float*)scale_out = m * (1.0f / 256.0f);
#pragma unroll
    for (int j = 0; j < 8; ++j) { int p = __builtin_amdgcn_cvt_pk_fp8_f32(v[j].x * inv, v[j].y * inv, 0, false); p = __builtin_amdgcn_cvt_pk_fp8_f32(v[j].z * inv, v[j].w * inv, p, true);
        ((GAS unsigned*)dst)[lane + 64 * j] = (unsigned)p; }
}
constexpr size_t U8_SLICE = (size_t)16384 * 128;
__device__ __forceinline__ unsigned pack_i8x4(float a, float b, float c, float d) {
    const int ia = (int)__builtin_rintf(a), ib = (int)__builtin_rintf(b), ic = (int)__builtin_rintf(c), id = (int)__builtin_rintf(d);
    return ((unsigned)ia & 255u) | (((unsigned)ib & 255u) << 8) | (((unsigned)ic & 255u) << 16) | ((unsigned)id << 24);
}
__device__ __forceinline__ void row_load_strided(const float* src, int lane, f32x4 (&v)[8]) { const GAS f32x4* xp = (const GAS f32x4*)src + lane;
#pragma unroll
    for (int j = 0; j < 8; ++j) v[j] = xp[64 * j]; }
__device__ __forceinline__ void row_load_contig(const float* src, int lane, f32x4 (&v)[8]) { const GAS f32x4* xp = (const GAS f32x4*)src + 8 * lane;
#pragma unroll
    for (int j = 0; j < 8; ++j) v[j] = xp[j]; }
__device__ __forceinline__ void i8_row(const f32x4 (&v)[8], unsigned char* dst, float* scale_out, int lane) {
    float m = 0.f;
#pragma unroll
    for (int j = 0; j < 8; ++j) m = fmaxf(fmaxf(m, fmaxf(fabsf(v[j].x), fabsf(v[j].y))), fmaxf(fabsf(v[j].z), fabsf(v[j].w)));
    m = wave_max(m);
    const float inv = m > 0.f ? 127.0f / m : 0.f;
    if (lane == 0) *(GAS float*)scale_out = m * (1.0f / 127.0f);
#pragma unroll
    for (int j = 0; j < 8; ++j) *(GAS unsigned*)(dst + (size_t)(2 * j + (lane >> 5)) * U8_SLICE + 4 * (lane & 31)) = pack_i8x4(v[j].x * inv, v[j].y * inv, v[j].z * inv, v[j].w * inv);
}
constexpr size_t V6_SLICE = (size_t)16384 * 192;
__device__ __forceinline__ void fp6_row(const f32x4 (&v)[8], unsigned char* dst, float* scale_out, int lane) {
    float m = 0.f;
#pragma unroll
    for (int j = 0; j < 8; ++j) m = fmaxf(fmaxf(m, fmaxf(fabsf(v[j].x), fabsf(v[j].y))), fmaxf(fabsf(v[j].z), fabsf(v[j].w)));
    m = wave_max(m);
    const float inv = m > 0.f ? 7.5f / m : 0.f;
    if (lane == 0) *(GAS float*)scale_out = m * (1.0f / 7.5f);
    v32h_t h;
#pragma unroll
    for (int j = 0; j < 8; ++j) { h[4 * j] = (_Float16)(v[j].x * inv); h[4 * j + 1] = (_Float16)(v[j].y * inv); h[4 * j + 2] = (_Float16)(v[j].z * inv); h[4 * j + 3] = (_Float16)(v[j].w * inv); }
    const v6u q = __builtin_amdgcn_cvt_scalef32_pk32_fp6_f16(h, 1.0f);
    GAS v2u* o = (GAS v2u*)(dst + (size_t)(lane >> 3) * V6_SLICE + 24 * (lane & 7));
    o[0] = (v2u){q[0], q[1]}; o[1] = (v2u){q[2], q[3]}; o[2] = (v2u){q[4], q[5]};
}
struct P0Args { const float *w_in, *w_br_sb, *w_br_hg, *w_br_conv, *w_o, *w_q, *u, *v, *lbp; bf16 *WinT, *WbrT, *WoT, *WqT; unsigned char *U, *V; float *US, *VS; float* LB; int layer; const float *k1, *k2; bf16* KB; };
__device__ __forceinline__ void p0_convert(const Ctx& c, const P0Args& a, int parts = 7) {
    LAS float* scr = (LAS float*)(c.lds + c.wave * 16384);
    constexpr int I_IN = (DM / 128) * (INW / 32), I_BR = (BW / 64) * (DM / 32), I_SQ = (DM / 64) * (DM / 32);
    constexpr int I_Q8 = (DM / 128) * (DM / 32);
    constexpr int NITEMS = I_IN + 3 * I_BR + I_SQ + I_Q8;
    if (parts & 1)
    for (int it = c.gw; it < NITEMS; it += c.NGW) {
        int r = it;
        if (r < I_IN) { const int kb = r / (INW / 32), nb = r % (INW / 32); tr_item_i8(a.w_in, DM, INW, (unsigned char*)a.WinT, kb * 128, nb * 32, win_drow(nb * 32), WIN_QS, scr, c.lane); continue; } r -= I_IN;
        if (r < I_BR) { const int kb = r / (DM / 32), nb = r % (DM / 32); tr_item(a.w_br_sb, BW, DM, a.WbrT, kb * 64, nb * 32, nb * 32, scr, c.lane); continue; } r -= I_BR;
        if (r < I_BR) { const int kb = r / (DM / 32), nb = r % (DM / 32); tr_item(a.w_br_hg, BW, DM, a.WbrT + (size_t)DM * BW, kb * 64, nb * 32, nb * 32, scr, c.lane); continue; } r -= I_BR;
        if (r < I_BR) { const int kb = r / (DM / 32), nb = r % (DM / 32); tr_item(a.w_br_conv, BW, DM, a.WbrT + (size_t)2 * DM * BW, kb * 64, nb * 32, nb * 32, scr, c.lane); continue; } r -= I_BR;
        if (r < I_SQ) { const int kb = r / (DM / 32), nb = r % (DM / 32); tr_item(a.w_o, DM, DM, a.WoT, kb * 64, nb * 32, nb * 32, scr, c.lane); continue; } r -= I_SQ;
        { const int kb = r / (DM / 32), nb = r % (DM / 32); tr_item_i8(a.w_q, DM, DM, (unsigned char*)a.WqT, kb * 128, nb * 32, nb * 32, WIN_QS, scr, c.lane); }
    }
    if (parts & 2)
    {
    for (int r = c.gw; r < 16384; r += 2 * c.NGW) { const int r2 = r + c.NGW; f32x4 va[8], vb[8];
        row_load_strided(a.u + (size_t)r * 2048, c.lane, va); if (r2 < 16384) row_load_strided(a.u + (size_t)r2 * 2048, c.lane, vb);
        i8_row(va, a.U + (size_t)r * 128, a.US + r, c.lane); if (r2 < 16384) i8_row(vb, a.U + (size_t)r2 * 128, a.US + r2, c.lane); }
    for (int r = c.gw; r < 16384; r += 2 * c.NGW) { const int r2 = r + c.NGW; f32x4 va[8], vb[8];
        row_load_contig(a.v + (size_t)r * 2048, c.lane, va); if (r2 < 16384) row_load_contig(a.v + (size_t)r2 * 2048, c.lane, vb);
        fp6_row(va, a.V + (size_t)r * 192, a.VS + r, c.lane); if (r2 < 16384) fp6_row(vb, a.V + (size_t)r2 * 192, a.VS + r2, c.lane); }
    }
    if (parts & 4) {
    cvt_copy(c, a.k1, a.KB, (size_t)8 * 16384 / 8);
    cvt_copy(c, a.k2, a.KB + 8 * 16384, (size_t)8 * 16384 / 8); }
    if (blockIdx.x == 0) for (int i = c.tid; i < 1024; i += 512) a.LB[i] = a.layer == 0 ? 0.f : sigm(a.lbp[1024 + i] - a.lbp[i]);
}

struct EpiIn {
    static constexpr bool PERM = true, AFTER_DRAIN = false;
    bf16* seg; bf16* gate; const float* lb; const float* sa;
    __device__ __forceinline__ float rowscale(int row) const { return ((const GAS float*)sa)[row] * (1.0f / WIN_QS); }
    __device__ __forceinline__ void operator()(const pg8::f32x4 (&acc)[2][2][4][2], const pg8::Unit& u, int wr, int wc, int fr, int fq) const {
        const int pn = u.pn; const int row0 = u.pm * 256 + wr * 64 + fr;
        if (pn >= 28 && pn < 36) {
            bf16* dst = seg + (size_t)7 * SEGSZ; const int col0 = (pn - 28) * 128 + wc * 32 + 8 * fq;
#pragma unroll
            for (int ai = 0; ai < 2; ++ai)
#pragma unroll
                for (int m = 0; m < 4; ++m) {
                    const pg8::f32x4 a0 = acc[ai][0][m][0], a1 = acc[ai][0][m][1], b0 = acc[ai][1][m][0], b1 = acc[ai][1][m][1];
                    v4u w; w.x = pk2c(a0[0] * sigm(b0[0]), a0[1] * sigm(b0[1])); w.y = pk2c(a0[2] * sigm(b0[2]), a0[3] * sigm(b0[3]));
                    w.z = pk2c(a1[0] * sigm(b1[0]), a1[1] * sigm(b1[1])); w.w = pk2c(a1[2] * sigm(b1[2]), a1[3] * sigm(b1[3]));
                    *(GAS v4u*)(dst + (size_t)(row0 + ai * 128 + m * 16) * 1024 + col0) = w; }
            return;
        }
        bf16* dst; int ld, colt, mode;
        if (pn < 28) { const int sg = pn >> 2; dst = seg + (size_t)sg * SEGSZ; ld = 1024; colt = (pn & 3) * 256; mode = (sg == 4) ? 2 : (sg == 6 ? 1 : 0); }
        else { const int q = pn - 36; dst = gate + (size_t)(q >> 3) * ((size_t)NTOK * 2048); ld = 2048; colt = (q & 7) * 256; mode = 1; }
        const int col0 = colt + wc * 32 + 8 * fq;
        if (mode == 0) {
#pragma unroll
            for (int ai = 0; ai < 2; ++ai)
#pragma unroll
                for (int m = 0; m < 4; ++m)
#pragma unroll
                    for (int bj = 0; bj < 2; ++bj) { const pg8::f32x4 v0 = acc[ai][bj][m][0], v1 = acc[ai][bj][m][1];
                        v4u w; w.x = pk2c(v0[0], v0[1]); w.y = pk2c(v0[2], v0[3]); w.z = pk2c(v1[0], v1[1]); w.w = pk2c(v1[2], v1[3]);
                        *(GAS v4u*)(dst + (size_t)(row0 + ai * 128 + m * 16) * ld + col0 + bj * 128) = w; }
        } else if (mode == 1) {
#pragma unroll
            for (int ai = 0; ai < 2; ++ai)
#pragma unroll
                for (int m = 0; m < 4; ++m)
#pragma unroll
                    for (int bj = 0; bj < 2; ++bj) { const pg8::f32x4 v0 = acc[ai][bj][m][0], v1 = acc[ai][bj][m][1];
                        v4u w; w.x = pk2c(sigm(v0[0]), sigm(v0[1])); w.y = pk2c(sigm(v0[2]), sigm(v0[3])); w.z = pk2c(sigm(v1[0]), sigm(v1[1])); w.w = pk2c(sigm(v1[2]), sigm(v1[3]));
                        *(GAS v4u*)(dst + (size_t)(row0 + ai * 128 + m * 16) * ld + col0 + bj * 128) = w; }
        } else {
            f32x4 l0[2], l1[2];
#pragma unroll
            for (int bj = 0; bj < 2; ++bj) { l0[bj] = *(const GAS f32x4*)(lb + col0 + bj * 128); l1[bj] = *(const GAS f32x4*)(lb + col0 + bj * 128 + 4); }
#pragma unroll
            for (int ai = 0; ai < 2; ++ai)
#pragma unroll
                for (int m = 0; m < 4; ++m)
#pragma unroll
                    for (int bj = 0; bj < 2; ++bj) { const pg8::f32x4 v0 = acc[ai][bj][m][0], v1 = acc[ai][bj][m][1]; float r[8];
#pragma unroll
                        for (int j = 0; j < 4; ++j) { r[j] = __logf(l0[bj][j] + (1.0f - l0[bj][j]) * sigm(v0[j])); r[4 + j] = __logf(l1[bj][j] + (1.0f - l1[bj][j]) * sigm(v1[j])); }
                        v4u w; w.x = pk2c(r[0], r[1]); w.y = pk2c(r[2], r[3]); w.z = pk2c(r[4], r[5]); w.w = pk2c(r[6], r[7]);
                        *(GAS v4u*)(dst + (size_t)(row0 + ai * 128 + m * 16) * ld + col0 + bj * 128) = w; }
        }
    }
};

__device__ __forceinline__ void conv_phase(const Ctx& c, const bf16* glu, const float* cw, const float* cb, const float* lnw, const float* lnb, bf16* out) {
    const int c0 = 2 * c.tid;
    float w0[31], w1[31];
#pragma unroll
    for (int j = 0; j < 31; ++j) { const f32x2v t = *(const GAS f32x2v*)(cw + j * 1024 + c0); w0[j] = t.x; w1[j] = t.y; }
    const f32x2v bv = *(const GAS f32x2v*)(cb + c0), lwv = *(const GAS f32x2v*)(lnw + c0), lbv = *(const GAS f32x2v*)(lnb + c0);
    LAS float* red = (LAS float*)c.lds;
    for (int tile = blockIdx.x; tile < NTOK / 8; tile += c.G) {
        const int n0 = tile * 8, tseq0 = n0 & (SEQ - 1);
        float a0[8], a1[8];
#pragma unroll
        for (int t = 0; t < 8; ++t) { a0[t] = bv.x; a1[t] = bv.y; }
#pragma unroll
        for (int r = 0; r < 38; ++r) {
            unsigned xv = 0u;
            if (tseq0 + r - 30 >= 0) xv = *(const GAS unsigned*)(glu + (size_t)(n0 + r - 30) * 1024 + c0);
            const float x0 = bflo(xv), x1 = bfhi(xv);
#pragma unroll
            for (int t = 0; t < 8; ++t) { const int j = r - t; if (j >= 0 && j <= 30) { a0[t] += w0[j] * x0; a1[t] += w1[j] * x1; } }
        }
        float st[16];
#pragma unroll
        for (int t = 0; t < 8; ++t) { st[2 * t] = a0[t] + a1[t]; st[2 * t + 1] = a0[t] * a0[t] + a1[t] * a1[t]; }
        xreduce16(st, c.lane);
        if ((c.lane & 3) == 0) red[c.wave * 16 + ridx16(c.lane)] = st[0];
        __syncthreads();
        if (c.tid < 16) { float s = 0.f;
#pragma unroll
            for (int w = 0; w < 8; ++w) s += red[w * 16 + c.tid];
            red[128 + c.tid] = s; }
        __syncthreads();
#pragma unroll
        for (int t = 0; t < 8; ++t) {
            const float mean = red[128 + 2 * t] * (1.0f / 1024.0f), var = red[128 + 2 * t + 1] * (1.0f / 1024.0f) - mean * mean;
            const float rstd = __builtin_amdgcn_rsqf(var + EPS);
            const float h0 = (a0[t] - mean) * rstd * lwv.x + lbv.x, h1 = (a1[t] - mean) * rstd * lwv.y + lbv.y;
            *(GAS unsigned*)(out + (size_t)(n0 + t) * 1024 + c0) = pk2c(h0 * sigm(h0), h1 * sigm(h1));
        }
        __syncthreads();
    }
}
__device__ __forceinline__ void hgrn_task(int task, int lane, const bf16* qhg, const bf16* logf, const bf16* ihg, bf16* out) {
    const int bh = task >> 6, dvb = task & 63, b = bh >> 3, h = bh & 7;
    const size_t rb = (size_t)b * SEQ * 1024;
    const GAS unsigned* qp = (const GAS unsigned*)(qhg + rb + h * 128) + lane;
    const GAS unsigned* lp = (const GAS unsigned*)(logf + rb + h * 128) + lane;
    const GAS unsigned* ip = (const GAS unsigned*)(ihg + rb + h * 128) + dvb;
    GAS bf16* op = (GAS bf16*)(out + rb + h * 128 + 2 * dvb);
    float S00 = 0.f, S01 = 0.f, S10 = 0.f, S11 = 0.f;
    unsigned qn[8], ln[8], inx[8];
#pragma unroll
    for (int j = 0; j < 8; ++j) { qn[j] = qp[(size_t)j * 512]; ln[j] = lp[(size_t)j * 512]; inx[j] = ip[(size_t)j * 512]; }
    for (int blk = 0; blk < SEQ / 8; ++blk) {
        unsigned qc[8], lc[8], ic[8];
#pragma unroll
        for (int j = 0; j < 8; ++j) { qc[j] = qn[j]; lc[j] = ln[j]; ic[j] = inx[j]; }
        if (blk + 1 < SEQ / 8) {
#pragma unroll
            for (int j = 0; j < 8; ++j) { const size_t o = (size_t)((blk + 1) * 8 + j) * 512; qn[j] = qp[o]; ln[j] = lp[o]; inx[j] = ip[o]; }
        }
        float pv[16];
#pragma unroll
        for (int j = 0; j < 8; ++j) {
            const float f0 = __expf(bflo(lc[j])), f1 = __expf(bfhi(lc[j])), k0 = 1.0f - f0, k1 = 1.0f - f1;
            const float i0 = bflo(ic[j]), i1 = bfhi(ic[j]), q0 = bflo(qc[j]), q1 = bfhi(qc[j]);
            S00 = f0 * S00 + k0 * i0; S01 = f0 * S01 + k0 * i1; S10 = f1 * S10 + k1 * i0; S11 = f1 * S11 + k1 * i1;
            pv[2 * j] = S00 * q0 + S10 * q1; pv[2 * j + 1] = S01 * q0 + S11 * q1;
        }
        xreduce16(pv, lane);
        if ((lane & 3) == 0) { const int idx = ridx16(lane); op[(size_t)(blk * 8 + (idx >> 1)) * 1024 + (idx & 1)] = (bf16)(pk2c(pv[0], 0.f) & 0xffffu); }
    }
}
constexpr int HG_TS = 272;
constexpr int HG_BS = 132;
__device__ __forceinline__ void hg_stage(LAS unsigned char* dst, const bf16* src, int tid) {
#pragma unroll
    for (int i = 0; i < 2; ++i) { const int p = tid + 512 * i, row = p >> 4, c16 = p & 15; *(LAS v4u*)(dst + row * HG_TS + c16 * 16) = *(const GAS v4u*)(src + (size_t)row * 1024 + c16 * 8); }
}
__device__ __forceinline__ void hg_scan(const LAS unsigned char* lft, int dk, int hf, float (&lf)[4][8], float (&b)[4][8], float& bl) {
    float bs[4], pb[4];
#pragma unroll
    for (int kk = 0; kk < 4; ++kk) { float run = 0.f;
#pragma unroll
        for (int j = 0; j < 8; ++j) { lf[kk][j] = __uint_as_float((unsigned)(*(const LAS unsigned short*)(lft + (16 * kk + 8 * hf + j) * HG_TS + dk * 2)) << 16); run += lf[kk][j]; b[kk][j] = run; }
        bs[kk] = run; }
#pragma unroll
    for (int kk = 0; kk < 4; ++kk) pb[kk] = __shfl_xor(bs[kk], 32);
    float pre = 0.f;
#pragma unroll
    for (int kk = 0; kk < 4; ++kk) { const float off = pre + (hf ? pb[kk] : 0.f);
#pragma unroll
        for (int j = 0; j < 8; ++j) b[kk][j] += off;
        pre += bs[kk] + pb[kk]; }
    bl = pre;
}
__device__ __forceinline__ bf16x8 pack8(const float (&v)[8]) { v4u t; t.x = pk2c(v[0], v[1]); t.y = pk2c(v[2], v[3]); t.z = pk2c(v[4], v[5]); t.w = pk2c(v[6], v[7]); return __builtin_bit_cast(bf16x8, t); }
__device__ __forceinline__ unsigned lds_u16(const LAS unsigned char* p) { return (unsigned)(*(const LAS unsigned short*)p); }
__device__ __forceinline__ void hgA_chunk(const Ctx& c, int ci, const bf16* LOGF, const bf16* IHG, bf16* ST, float* DEC) {
    const int bh = ci >> 6, ch = ci & 63, bb = bh >> 3, h = bh & 7; const size_t n0 = (size_t)bb * SEQ + ch * 64;
    LAS unsigned char* lft = c.lds; LAS unsigned char* itl = c.lds + 64 * HG_TS;
    hg_stage(lft, LOGF + n0 * 1024 + h * 128, c.tid); hg_stage(itl, IHG + n0 * 1024 + h * 128, c.tid);
    __syncthreads();
    const int dkt = c.wave & 3, dvh = c.wave >> 2, hf = c.lane >> 5, cl = c.lane & 31, dk = 32 * dkt + cl;
    float lf[4][8], b[4][8], bl; hg_scan(lft, dk, hf, lf, b, bl);
    bf16x8 kf[4];
#pragma unroll
    for (int kk = 0; kk < 4; ++kk) { float v[8];
#pragma unroll
        for (int j = 0; j < 8; ++j) v[j] = (1.0f - __expf(lf[kk][j])) * __expf(bl - b[kk][j]);
        kf[kk] = pack8(v); }
    if (dvh == 0 && hf == 0) ((GAS float*)DEC)[(size_t)ci * 128 + dk] = __expf(bl);
#pragma unroll
    for (int dvi = 0; dvi < 2; ++dvi) { const int dvt = dvh * 2 + dvi;
        f32x16 acc;
#pragma unroll
        for (int r = 0; r < 16; ++r) acc[r] = 0.f;
#pragma unroll
        for (int kk = 0; kk < 4; ++kk) { const LAS unsigned char* p = itl + (16 * kk + 8 * hf) * HG_TS + (32 * dvt + cl) * 2;
            v4u t; t.x = lds_u16(p) | (lds_u16(p + HG_TS) << 16); t.y = lds_u16(p + 2 * HG_TS) | (lds_u16(p + 3 * HG_TS) << 16); t.z = lds_u16(p + 4 * HG_TS) | (lds_u16(p + 5 * HG_TS) << 16); t.w = lds_u16(p + 6 * HG_TS) | (lds_u16(p + 7 * HG_TS) << 16);
            acc = MFMA32(kf[kk], __builtin_bit_cast(bf16x8, t), acc); }
        bf16* o = ST + (size_t)ci * 16384 + (size_t)(32 * dvt + cl) * 128 + 32 * dkt + 4 * hf;
#pragma unroll
        for (int g = 0; g < 4; ++g) { v2u q; q.x = pk2c(acc[4 * g], acc[4 * g + 1]); q.y = pk2c(acc[4 * g + 2], acc[4 * g + 3]); *(GAS v2u*)(o + 8 * g) = q; }
    }
    __syncthreads();
}
__device__ __forceinline__ void hgB(const Ctx& c, bf16* ST, const float* DEC) {
    for (int e = blockIdx.x * 512 + c.tid; e < 32 * 4096; e += c.G * 512) {
        const int bh = e >> 12, r = e & 4095, dv = r >> 5, dk4 = (r & 31) * 4;
        GAS v2u* p = (GAS v2u*)(ST + (size_t)bh * 64 * 16384 + (size_t)dv * 128 + dk4);
        const GAS f32x4* d = (const GAS f32x4*)(DEC + (size_t)bh * 64 * 128 + dk4);
        f32x4 S = {0.f, 0.f, 0.f, 0.f};
#pragma unroll 1
        for (int c0 = 0; c0 < 64; c0 += 8) {
            v2u Lv[8]; f32x4 D[8];
#pragma unroll
            for (int k = 0; k < 8; ++k) { Lv[k] = p[(size_t)(c0 + k) * 4096]; D[k] = d[(size_t)(c0 + k) * 32]; }
#pragma unroll
            for (int k = 0; k < 8; ++k) { v2u o; o.x = pk2c(S.x, S.y); o.y = pk2c(S.z, S.w); p[(size_t)(c0 + k) * 4096] = o;
                S.x = D[k].x * S.x + bflo(Lv[k].x); S.y = D[k].y * S.y + bfhi(Lv[k].x); S.z = D[k].z * S.z + bflo(Lv[k].y); S.w = D[k].w * S.w + bfhi(Lv[k].y); }
        }
    }
}
__device__ __forceinline__ void hgC_chunk(const Ctx& c, int ci, const bf16* QHG, const bf16* LOGF, const bf16* IHG, const bf16* GHG, const bf16* ST, const float* nw, bf16* OUT) {
    const int bh = ci >> 6, ch = ci & 63, bb = bh >> 3, h = bh & 7; const size_t n0 = (size_t)bb * SEQ + ch * 64;
    LAS unsigned char* lft = c.lds; LAS unsigned char* itl = c.lds + 64 * HG_TS; LAS float* bt = (LAS float*)(c.lds + 2 * 64 * HG_TS); LAS float* red = bt + 64 * HG_BS;
    LAS unsigned char* ktl = (LAS unsigned char*)(red + 256);
    hg_stage(lft, LOGF + n0 * 1024 + h * 128, c.tid); hg_stage(itl, IHG + n0 * 1024 + h * 128, c.tid);
    __syncthreads();
    const int hf = c.lane >> 5, cl = c.lane & 31;
    { const int dk = 32 * (c.wave & 3) + cl; float lf[4][8], b[4][8], bl; hg_scan(lft, dk, hf, lf, b, bl);
#pragma unroll
      for (int q = 0; q < 2; ++q) { const int kk = 2 * (c.wave >> 2) + q;
#pragma unroll
          for (int j = 0; j < 8; ++j) { bt[(16 * kk + 8 * hf + j) * HG_BS + dk] = (c.wave >> 2) ? b[2 + q][j] : b[q][j];
              *(LAS unsigned short*)(ktl + (16 * kk + 8 * hf + j) * HG_TS + dk * 2) = (unsigned short)(pk2c(1.0f - __expf((c.wave >> 2) ? lf[2 + q][j] : lf[q][j]), 0.f) & 0xffffu); } } }
    __syncthreads();
    const int dvt = c.wave & 3, tt = c.wave >> 2, t = 32 * tt + cl;
    bf16x8 qm[8];
    const bf16* qrow = QHG + (n0 + t) * 1024 + h * 128 + 8 * hf;
#pragma unroll
    for (int kk = 0; kk < 8; ++kk) { const int d0 = 16 * kk + 8 * hf;
        asm volatile("" ::: "memory");
        const v4u qv = *(const GAS v4u*)(qrow + 16 * kk);
        const f32x4 b0 = *(const LAS f32x4*)(bt + t * HG_BS + d0), b1 = *(const LAS f32x4*)(bt + t * HG_BS + d0 + 4), m0 = *(const LAS f32x4*)(bt + 31 * HG_BS + d0), m1 = *(const LAS f32x4*)(bt + 31 * HG_BS + d0 + 4);
        const float q[8] = {bflo(qv.x), bfhi(qv.x), bflo(qv.y), bfhi(qv.y), bflo(qv.z), bfhi(qv.z), bflo(qv.w), bfhi(qv.w)};
        const float bv[8] = {b0.x, b0.y, b0.z, b0.w, b1.x, b1.y, b1.z, b1.w}, mv[8] = {m0.x, m0.y, m0.z, m0.w, m1.x, m1.y, m1.z, m1.w};
        float vm[8];
#pragma unroll
        for (int j = 0; j < 8; ++j) vm[j] = q[j] * __expf(bv[j] - mv[j]);
        qm[kk] = pack8(vm); }
    f32x16 o;
#pragma unroll
    for (int r = 0; r < 16; ++r) o[r] = 0.f;
#pragma unroll 1
    for (int st = 0; st <= tt; ++st) {
        const int s = 32 * st + cl;
        f32x16 sa;
#pragma unroll
        for (int r = 0; r < 16; ++r) sa[r] = 0.f;
#pragma unroll
        for (int kk = 0; kk < 8; ++kk) { const int d0 = 16 * kk + 8 * hf;
            asm volatile("" ::: "memory");
            const v4u lv = *(const LAS v4u*)(ktl + s * HG_TS + d0 * 2);
            const f32x4 b0 = *(const LAS f32x4*)(bt + s * HG_BS + d0), b1 = *(const LAS f32x4*)(bt + s * HG_BS + d0 + 4), m0 = *(const LAS f32x4*)(bt + 31 * HG_BS + d0), m1 = *(const LAS f32x4*)(bt + 31 * HG_BS + d0 + 4);
            const float kv[8] = {bflo(lv.x), bfhi(lv.x), bflo(lv.y), bfhi(lv.y), bflo(lv.z), bfhi(lv.z), bflo(lv.w), bfhi(lv.w)};
            const float bv[8] = {b0.x, b0.y, b0.z, b0.w, b1.x, b1.y, b1.z, b1.w}, mv[8] = {m0.x, m0.y, m0.z, m0.w, m1.x, m1.y, m1.z, m1.w};
            float vk[8];
#pragma unroll
            for (int j = 0; j < 8; ++j) vk[j] = kv[j] * __expf(mv[j] - bv[j]);
            sa = MFMA32(pack8(vk), qm[kk], sa); }
        if (st == tt) {
#pragma unroll
            for (int r = 0; r < 16; ++r) if (((r & 3) + 8 * (r >> 2) + 4 * hf) > cl) sa[r] = 0.f;
        }
#pragma unroll
        for (int sp = 0; sp < 2; ++sp) {
            const float pv[8] = {sa[8 * sp], sa[8 * sp + 1], sa[8 * sp + 2], sa[8 * sp + 3], sa[8 * sp + 4], sa[8 * sp + 5], sa[8 * sp + 6], sa[8 * sp + 7]};
            const LAS unsigned char* p = itl + (32 * st + 16 * sp + 4 * hf) * HG_TS + (32 * dvt + cl) * 2;
            v4u tq; tq.x = lds_u16(p) | (lds_u16(p + HG_TS) << 16); tq.y = lds_u16(p + 2 * HG_TS) | (lds_u16(p + 3 * HG_TS) << 16);
            tq.z = lds_u16(p + 8 * HG_TS) | (lds_u16(p + 9 * HG_TS) << 16); tq.w = lds_u16(p + 10 * HG_TS) | (lds_u16(p + 11 * HG_TS) << 16);
            o = MFMA32(__builtin_bit_cast(bf16x8, tq), pack8(pv), o); }
    }
    { const bf16* strow = ST + (size_t)ci * 16384 + (size_t)(32 * dvt + cl) * 128 + 8 * hf;
#pragma unroll
      for (int kk = 0; kk < 8; ++kk) { const int d0 = 16 * kk + 8 * hf;
          asm volatile("" ::: "memory");
          const v4u qv = *(const GAS v4u*)(qrow + 16 * kk); const bf16x8 sf = *(const GAS bf16x8*)(strow + 16 * kk);
          const f32x4 b0 = *(const LAS f32x4*)(bt + t * HG_BS + d0), b1 = *(const LAS f32x4*)(bt + t * HG_BS + d0 + 4);
          float ve[8] = {bflo(qv.x) * __expf(b0.x), bfhi(qv.x) * __expf(b0.y), bflo(qv.y) * __expf(b0.z), bfhi(qv.y) * __expf(b0.w), bflo(qv.z) * __expf(b1.x), bfhi(qv.z) * __expf(b1.y), bflo(qv.w) * __expf(b1.z), bfhi(qv.w) * __expf(b1.w)};
          o = MFMA32(sf, pack8(ve), o); } }
    float ss = 0.f;
#pragma unroll
    for (int r = 0; r < 16; ++r) ss += o[r] * o[r];
    ss += __shfl_xor(ss, 32);
    if (hf == 0) red[(tt * 4 + dvt) * 32 + cl] = ss;
    __syncthreads();
    const float rstd = __builtin_amdgcn_rsqf(((red[(tt * 4 + 0) * 32 + cl] + red[(tt * 4 + 1) * 32 + cl]) + (red[(tt * 4 + 2) * 32 + cl] + red[(tt * 4 + 3) * 32 + cl])) * (1.0f / 128.0f) + EPS);
#pragma unroll
    for (int g = 0; g < 4; ++g) { const int dv0 = 32 * dvt + 8 * g + 4 * hf; const size_t off = (n0 + t) * 1024 + h * 128 + dv0;
        const v2u gg = *(const GAS v2u*)(GHG + off); const f32x4 w4 = *(const GAS f32x4*)(nw + dv0);
        v2u q; q.x = pk2c(o[4 * g] * rstd * w4.x * bflo(gg.x), o[4 * g + 1] * rstd * w4.y * bfhi(gg.x)); q.y = pk2c(o[4 * g + 2] * rstd * w4.z * bflo(gg.y), o[4 * g + 3] * rstd * w4.w * bfhi(gg.y));
        *(GAS v2u*)(OUT + off) = q; }
    __syncthreads();
}
__device__ __forceinline__ void qknorm_rows4(bf16* row0, size_t rstride, const float* w, float scale, int lane) {
    v4u x[4][2];
#pragma unroll
    for (int i = 0; i < 4; ++i)
#pragma unroll
        for (int j = 0; j < 2; ++j) x[i][j] = *(const GAS v4u*)(row0 + i * rstride + 8 * lane + 512 * j);
    const f32x4 wa = *(const GAS f32x4*)(w + ((8 * lane) & 127)), wb = *(const GAS f32x4*)(w + ((8 * lane) & 127) + 4);
#pragma unroll
    for (int i = 0; i < 4; ++i)
#pragma unroll
        for (int j = 0; j < 2; ++j) { const v4u xx = x[i][j];
            float f[8] = {bflo(xx.x), bfhi(xx.x), bflo(xx.y), bfhi(xx.y), bflo(xx.z), bfhi(xx.z), bflo(xx.w), bfhi(xx.w)};
            float ss = 0.f;
#pragma unroll
            for (int k = 0; k < 8; ++k) ss += f[k] * f[k];
            ss += __shfl_xor(ss, 1); ss += __shfl_xor(ss, 2); ss += __shfl_xor(ss, 4); ss += __shfl_xor(ss, 8);
            const float r = __builtin_amdgcn_rsqf(ss * (1.0f / 128.0f) + EPS) * scale;
            v4u o; o.x = pk2c(f[0] * r * wa.x, f[1] * r * wa.y); o.y = pk2c(f[2] * r * wa.z, f[3] * r * wa.w); o.z = pk2c(f[4] * r * wb.x, f[5] * r * wb.y); o.w = pk2c(f[6] * r * wb.z, f[7] * r * wb.w);
            *(GAS v4u*)(row0 + i * rstride + 8 * lane + 512 * j) = o; }
}
__device__ __forceinline__ void vt_item(int item, int lane, const bf16* vsb, bf16* vt, LAS unsigned short* scr) {
    const int db = item & 3, sb = (item >> 2) & 63, bh = item >> 8, b = bh >> 3, h = bh & 7;
    const bf16* src = vsb + ((size_t)b * SEQ + sb * 64) * 1024 + h * 128 + db * 32;
#pragma unroll 4
    for (int i = 0; i < 16; ++i) { const int r = 4 * i + (lane >> 4); *(LAS unsigned*)(scr + r * 34 + 2 * (lane & 15)) = *(const GAS unsigned*)(src + (size_t)r * 1024 + 2 * (lane & 15)); }
    LDS_WAIT();
    const int c = lane & 7;
#pragma unroll
    for (int j = 0; j < 4; ++j) { const int d = (lane >> 3) + 8 * j; const LAS unsigned short* s = scr + (8 * c) * 34 + d;
        v4u o; o.x = (unsigned)s[0] | ((unsigned)s[34] << 16); o.y = (unsigned)s[68] | ((unsigned)s[102] << 16); o.z = (unsigned)s[136] | ((unsigned)s[170] << 16); o.w = (unsigned)s[204] | ((unsigned)s[238] << 16);
        *(GAS v4u*)(vt + ((size_t)bh * 128 + db * 32 + d) * SEQ + sb * 64 + 8 * c) = o; }
    LDS_WAIT();
}

constexpr int AT_BUF = 32768, AT_VOFF = 16384;
__device__ __forceinline__ f32x16 attn_scores(const LAS unsigned char* kt, int krow, int hf, const bf16x8 (&qf)[8]) {
    f32x16 sa;
#pragma unroll
    for (int r = 0; r < 16; ++r) sa[r] = 0.f;
    const LAS unsigned char* kp = kt + krow * 256; const int sw = krow & 15;
#pragma unroll
    for (int kk = 0; kk < 8; ++kk) sa = MFMA32(*(const LAS bf16x8*)(kp + (((2 * kk + hf) ^ sw) << 4)), qf[kk], sa);
    return sa;
}
template <bool DIAG> __device__ __forceinline__ void attn_weights(const f32x16& sa, float& R, int hf, int cl, bf16x8 (&pf)[2]) {
    float om[16];
#pragma unroll
    for (int r = 0; r < 16; ++r) om[r] = __builtin_amdgcn_rcpf(1.0f + __builtin_amdgcn_exp2f(sa[r] * 1.4426950408889634f));
    if (DIAG) {
#pragma unroll
        for (int r = 0; r < 16; ++r) if (((r & 3) + 8 * (r >> 2) + 4 * hf) >= cl) om[r] = 1.0f;
    }
    float Gs[4], Gp[4];
#pragma unroll
    for (int g = 0; g < 4; ++g) { Gs[g] = (om[4 * g] * om[4 * g + 1]) * (om[4 * g + 2] * om[4 * g + 3]); Gp[g] = __shfl_xor(Gs[g], 32); }
    float tail = R; float w[16];
#pragma unroll
    for (int g = 3; g >= 0; --g) {
        const float c3 = tail * (hf == 0 ? Gp[g] : 1.0f), c2 = c3 * om[4 * g + 3], c1 = c2 * om[4 * g + 2], c0 = c1 * om[4 * g + 1];
        w[4 * g + 3] = c3 - om[4 * g + 3] * c3; w[4 * g + 2] = c2 - om[4 * g + 2] * c2; w[4 * g + 1] = c1 - om[4 * g + 1] * c1; w[4 * g] = c0 - om[4 * g] * c0;
        tail *= Gs[g] * Gp[g];
    }
    R = tail;
#pragma unroll
    for (int sp = 0; sp < 2; ++sp) { v4u t; t.x = pk2c(w[8 * sp], w[8 * sp + 1]); t.y = pk2c(w[8 * sp + 2], w[8 * sp + 3]); t.z = pk2c(w[8 * sp + 4], w[8 * sp + 5]); t.w = pk2c(w[8 * sp + 6], w[8 * sp + 7]); pf[sp] = __builtin_bit_cast(bf16x8, t); }
}
__device__ __forceinline__ void attn_pv(const LAS unsigned char* vt, int sub, int cl, int hf, const bf16x8 (&pf)[2], f32x16 (&o)[4]) {
#pragma unroll
    for (int d = 0; d < 4; ++d) { const int row = 32 * d + cl; const LAS unsigned char* vp = vt + row * 128 + 8 * hf; const int sw = (row >> 1) & 7;
#pragma unroll
        for (int sp = 0; sp < 2; ++sp) { const int x = 4 * sub + 2 * sp;
            const v2u lo = *(const LAS v2u*)(vp + ((x ^ sw) << 4)), hi = *(const LAS v2u*)(vp + (((x + 1) ^ sw) << 4));
            v4u t; t.x = lo.x; t.y = lo.y; t.z = hi.x; t.w = hi.y; o[d] = MFMA32(__builtin_bit_cast(bf16x8, t), pf[sp], o[d]); } }
}
template <bool LAG> __device__ __forceinline__ void attn_unit(const Ctx& c, int bh, int qb, const bf16* qsb, const bf16* ksb, const bf16* vt, bf16* outb) {
    int lane_ = c.lane; asm volatile("" : "+v"(lane_));
    const int b = bh >> 3, h = bh & 7, lane = lane_, cl = lane & 31, hf = lane >> 5;
    const size_t rb = (size_t)b * SEQ; const int q0w = 256 * qb + 32 * c.wave;
    bf16x8 qf[8];
    { const bf16* qrow = qsb + (rb + q0w + cl) * 1024 + h * 128 + 8 * hf;
#pragma unroll
      for (int kk = 0; kk < 8; ++kk) qf[kk] = *(const GAS bf16x8*)(qrow + 16 * kk); }
    f32x16 o[4];
#pragma unroll
    for (int d = 0; d < 4; ++d)
#pragma unroll
        for (int r = 0; r < 16; ++r) o[d][r] = 0.f;
    float R = 1.0f;
    bf16x8 pd[2]; const LAS unsigned char* vimd = c.lds; int subd = 0; bool pending = false;
    const int kr0 = 8 * c.wave + (lane >> 4), kr1 = kr0 + 4;
    const bf16* kg0 = ksb + (rb + kr0) * 1024 + h * 128 + (((lane & 15) ^ (kr0 & 15)) << 3);
    const bf16* kg1 = ksb + (rb + kr1) * 1024 + h * 128 + (((lane & 15) ^ (kr1 & 15)) << 3);
    const int vr0 = 16 * c.wave + (lane >> 3), vr1 = vr0 + 8;
    const bf16* vg0 = vt + ((size_t)bh * 128 + vr0) * SEQ + (((lane & 7) ^ ((vr0 >> 1) & 7)) << 3);
    const bf16* vg1 = vt + ((size_t)bh * 128 + vr1) * SEQ + (((lane & 7) ^ ((vr1 >> 1) & 7)) << 3);
    LAS unsigned char* dk = c.lds + c.wave * 2048; LAS unsigned char* dv = c.lds + AT_VOFF + c.wave * 2048;
#define AT_DMA(kt_, bi_) do { const int ktt_ = (kt_); LAS unsigned char* bb_ = (LAS unsigned char*)0 + (bi_) * AT_BUF; \
        __builtin_amdgcn_global_load_lds((const unsigned*)(kg0 + (size_t)ktt_ * 64 * 1024), (LAS unsigned*)(dk + (bi_) * AT_BUF), 16, 0, 0); \
        __builtin_amdgcn_global_load_lds((const unsigned*)(kg1 + (size_t)ktt_ * 64 * 1024), (LAS unsigned*)(dk + (bi_) * AT_BUF + 1024), 16, 0, 0); \
        __builtin_amdgcn_global_load_lds((const unsigned*)(vg0 + ktt_ * 64), (LAS unsigned*)(dv + (bi_) * AT_BUF), 16, 0, 0); \
        __builtin_amdgcn_global_load_lds((const unsigned*)(vg1 + ktt_ * 64), (LAS unsigned*)(dv + (bi_) * AT_BUF + 1024), 16, 0, 0); (void)bb_; } while (0)
    const int nkt = 4 * (qb + 1);
    asm volatile("s_waitcnt vmcnt(0)" ::: "memory");
    AT_DMA(nkt - 1, 0); AT_DMA(nkt - 2, 1);
    asm volatile("s_waitcnt vmcnt(4)" ::: "memory"); __builtin_amdgcn_s_barrier(); asm volatile("" ::: "memory");
    int bi = 0;
#pragma unroll 1
    for (int it = 0; it < nkt; ++it) {
        const int kt = nkt - 1 - it;
        const int b2 = (bi + 2) & 3;
        if (it + 2 < nkt) AT_DMA(kt - 2, b2);
        const LAS unsigned char* kim = c.lds + bi * AT_BUF; const LAS unsigned char* vim = kim + AT_VOFF;
        const int rel = q0w - 64 * kt;
        if (rel >= 32) {
            if (LAG) { if (pending) attn_pv(vimd, subd, cl, hf, pd, o);
                const f32x16 s1 = attn_scores(kim, 32 + cl, hf, qf); if (rel == 32) attn_weights<true>(s1, R, hf, cl, pd); else attn_weights<false>(s1, R, hf, cl, pd);
                vimd = vim; subd = 1; pending = true;
            } else { bf16x8 p[2];
                { const f32x16 s1 = attn_scores(kim, 32 + cl, hf, qf); if (rel == 32) attn_weights<true>(s1, R, hf, cl, p); else attn_weights<false>(s1, R, hf, cl, p); }
                attn_pv(vim, 1, cl, hf, p, o); }
        }
        if (rel >= 0) {
            if (LAG) { if (pending) attn_pv(vimd, subd, cl, hf, pd, o);
                const f32x16 s0 = attn_scores(kim, cl, hf, qf); if (rel == 0) attn_weights<true>(s0, R, hf, cl, pd); else attn_weights<false>(s0, R, hf, cl, pd);
                vimd = vim; subd = 0; pending = true;
            } else { bf16x8 p[2];
                { const f32x16 s0 = attn_scores(kim, cl, hf, qf); if (rel == 0) attn_weights<true>(s0, R, hf, cl, p); else attn_weights<false>(s0, R, hf, cl, p); }
                attn_pv(vim, 0, cl, hf, p, o); }
        }
        if (it + 2 < nkt) asm volatile("s_waitcnt vmcnt(4)\n\ts_waitcnt lgkmcnt(0)" ::: "memory"); else asm volatile("s_waitcnt vmcnt(0)\n\ts_waitcnt lgkmcnt(0)" ::: "memory");
        __builtin_amdgcn_s_barrier(); asm volatile("" ::: "memory");
        bi = (bi + 1) & 3;
    }
#undef AT_DMA
    if (LAG && pending) attn_pv(vimd, subd, cl, hf, pd, o);
    bf16* orow = outb + (rb + q0w + cl) * 1024 + h * 128 + 4 * hf;
#pragma unroll
    for (int d = 0; d < 4; ++d)
#pragma unroll
        for (int g = 0; g < 4; ++g) { v2u q; q.x = pk2c(o[d][4 * g], o[d][4 * g + 1]); q.y = pk2c(o[d][4 * g + 2], o[d][4 * g + 3]); *(GAS v2u*)(orow + 32 * d + 8 * g) = q; }
    asm volatile("s_waitcnt vmcnt(0)" ::: "memory"); __builtin_amdgcn_s_barrier(); asm volatile("" ::: "memory");
}
__device__ __forceinline__ void hgpost_row(bf16* row, const bf16* grow, const float* w, int lane) {
#pragma unroll
    for (int j = 0; j < 2; ++j) {
        GAS v4u* p = (GAS v4u*)(row + 8 * lane + 512 * j); const v4u x = *p; const v4u gg = *(const GAS v4u*)(grow + 8 * lane + 512 * j);
        float f[8] = {bflo(x.x), bfhi(x.x), bflo(x.y), bfhi(x.y), bflo(x.z), bfhi(x.z), bflo(x.w), bfhi(x.w)};
        const float g[8] = {bflo(gg.x), bfhi(gg.x), bflo(gg.y), bfhi(gg.y), bflo(gg.z), bfhi(gg.z), bflo(gg.w), bfhi(gg.w)};
        float ss = 0.f;
#pragma unroll
        for (int k = 0; k < 8; ++k) ss += f[k] * f[k];
        ss += __shfl_xor(ss, 1); ss += __shfl_xor(ss, 2); ss += __shfl_xor(ss, 4); ss += __shfl_xor(ss, 8);
        const float r = __builtin_amdgcn_rsqf(ss * (1.0f / 128.0f) + EPS);
        const f32x4 wa = *(const GAS f32x4*)(w + ((8 * lane) & 127)), wb = *(const GAS f32x4*)(w + ((8 * lane) & 127) + 4);
        v4u o; o.x = pk2c(f[0] * r * wa.x * g[0], f[1] * r * wa.y * g[1]); o.y = pk2c(f[2] * r * wa.z * g[2], f[3] * r * wa.w * g[3]);
        o.z = pk2c(f[4] * r * wb.x * g[4], f[5] * r * wb.y * g[5]); o.w = pk2c(f[6] * r * wb.z * g[6], f[7] * r * wb.w * g[7]);
        *p = o;
    }
}

template <bool FIRST> struct EpiMerge {
    static constexpr bool PERM = true, AFTER_DRAIN = false;
    const bf16* gate; bf16* merged;
    __device__ __forceinline__ void operator()(const pg8::f32x4 (&acc)[2][2][4][2], const pg8::Unit& u, int wr, int wc, int fr, int fq) const {
        const int row0 = u.pm * 256 + wr * 64 + fr, col0 = u.pn * 256 + wc * 32 + 8 * fq;
#pragma unroll
        for (int ai = 0; ai < 2; ++ai)
#pragma unroll
            for (int m = 0; m < 4; ++m) {
                if ((m & 1) == 0) asm volatile("" ::: "memory");
#pragma unroll
                for (int bj = 0; bj < 2; ++bj) {
                    const size_t off = (size_t)(row0 + ai * 128 + m * 16) * 2048 + col0 + bj * 128;
                    const v4u g = *(const GAS v4u*)(gate + off); const pg8::f32x4 v0 = acc[ai][bj][m][0], v1 = acc[ai][bj][m][1];
                    float r[8] = {bflo(g.x) * v0[0], bfhi(g.x) * v0[1], bflo(g.y) * v0[2], bfhi(g.y) * v0[3], bflo(g.z) * v1[0], bfhi(g.z) * v1[1], bflo(g.w) * v1[2], bfhi(g.w) * v1[3]};
                    if (!FIRST) { const v4u mo = *(const GAS v4u*)(merged + off);
                        r[0] += bflo(mo.x); r[1] += bfhi(mo.x); r[2] += bflo(mo.y); r[3] += bfhi(mo.y); r[4] += bflo(mo.z); r[5] += bfhi(mo.z); r[6] += bflo(mo.w); r[7] += bfhi(mo.w); }
                    v4u w; w.x = pk2c(r[0], r[1]); w.y = pk2c(r[2], r[3]); w.z = pk2c(r[4], r[5]); w.w = pk2c(r[6], r[7]);
                    *(GAS v4u*)(merged + off) = w; }
            }
    }
};
struct EpiStoreBf16 {
    static constexpr bool PERM = true, AFTER_DRAIN = false;
    bf16* out; const float* sa;
    __device__ __forceinline__ float rowscale(int row) const { return ((const GAS float*)sa)[row] * (1.0f / WIN_QS); }
    __device__ __forceinline__ void operator()(const pg8::f32x4 (&acc)[2][2][4][2], const pg8::Unit& u, int wr, int wc, int fr, int fq) const {
        const int row0 = u.pm * 256 + wr * 64 + fr, col0 = u.pn * 256 + wc * 32 + 8 * fq;
#pragma unroll
        for (int ai = 0; ai < 2; ++ai)
#pragma unroll
            for (int m = 0; m < 4; ++m)
#pragma unroll
                for (int bj = 0; bj < 2; ++bj) { const pg8::f32x4 v0 = acc[ai][bj][m][0], v1 = acc[ai][bj][m][1];
                    v4u w; w.x = pk2c(v0[0], v0[1]); w.y = pk2c(v0[2], v0[3]); w.z = pk2c(v1[0], v1[1]); w.w = pk2c(v1[2], v1[3]);
                    *(GAS v4u*)(out + (size_t)(row0 + ai * 128 + m * 16) * 2048 + col0 + bj * 128) = w; }
    }
};
struct EpiResid {
    static constexpr bool PERM = false, AFTER_DRAIN = false;
    const float* xin; float* xout;
    __device__ __forceinline__ void operator()(const pg8::f32x4 (&acc)[2][2][4][2], const pg8::Unit& u, int wr, int wc, int fr, int fq) const {
        const int row0 = u.pm * 256 + wr * 64 + fr, col0 = u.pn * 256 + wc * 32 + 4 * fq;
#pragma unroll
        for (int ai = 0; ai < 2; ++ai)
#pragma unroll
            for (int m = 0; m < 4; ++m)
#pragma unroll
                for (int bj = 0; bj < 2; ++bj)
#pragma unroll
                    for (int n = 0; n < 2; ++n) { const size_t off = (size_t)(row0 + ai * 128 + m * 16) * 2048 + col0 + bj * 128 + n * 16;
                        f32x4 r = acc[ai][bj][m][n]; if (xin) r += *(const GAS f32x4*)(xin + off);
                        *(GAS f32x4*)(xout + off) = r; }
    }
};

__device__ __forceinline__ float rl_f(float v, int l) { return __uint_as_float((unsigned)__builtin_amdgcn_readlane((int)__float_as_uint(v), l)); }
__device__ __forceinline__ void ins16(float (&L)[16], float x) {
#pragma unroll
    for (int i = 0; i < 16; ++i) { const float hi = __builtin_fmaxf(L[i], x); x = __builtin_fminf(L[i], x); L[i] = hi; }
}
#define CE_DESC(a, b) do { const float hi_ = __builtin_fmaxf(a, b), lo_ = __builtin_fminf(a, b); a = hi_; b = lo_; } while (0)
__device__ __forceinline__ void sort16_desc(float (&v)[16]) {
#pragma unroll
    for (int k = 2; k <= 16; k <<= 1)
#pragma unroll
        for (int j = k >> 1; j > 0; j >>= 1)
#pragma unroll
            for (int i = 0; i < 16; ++i) { const int l = i ^ j; if (l > i) { if ((i & k) == 0) CE_DESC(v[i], v[l]); else CE_DESC(v[l], v[i]); } }
}
__device__ __forceinline__ void bitonic_merge16_desc(float (&v)[16]) {
#pragma unroll
    for (int j = 8; j > 0; j >>= 1)
#pragma unroll
        for (int i = 0; i < 16; ++i) { const int l = i ^ j; if (l > i) CE_DESC(v[i], v[l]); }
}
__device__ __forceinline__ void top16_merge(float (&L)[16], const float (&T)[16]) {
#pragma unroll
    for (int i = 0; i < 16; ++i) L[i] = __builtin_fmaxf(L[i], T[15 - i]);
    bitonic_merge16_desc(L);
}
constexpr int PK_KS = 272;
__device__ __forceinline__ void peer_top16(const bf16* qrow  , const LAS unsigned char* kl  , int hf, float (&L)[16]) {
    bf16x8 qf[8];
#pragma unroll
    for (int kk = 0; kk < 8; ++kk) qf[kk] = *(const GAS bf16x8*)(qrow + 16 * kk);
#pragma unroll 1
    for (int kt = 0; kt < 4; ++kt) {
        f32x16 sa;
#pragma unroll
        for (int r = 0; r < 16; ++r) sa[r] = 0.f;
#pragma unroll
        for (int kk = 0; kk < 8; ++kk) sa = MFMA32(*(const LAS bf16x8*)(kl + kt * 32 * PK_KS + 32 * kk), qf[kk], sa);
        float T[16];
#pragma unroll
        for (int r = 0; r < 16; ++r) { const unsigned idx = (unsigned)(kt * 32 + (r & 3) + 8 * (r >> 2) + 4 * hf); T[r] = __uint_as_float((__float_as_uint(sa[r]) & ~127u) | idx); }
        sort16_desc(T);
        if (kt == 0) {
#pragma unroll
            for (int i = 0; i < 16; ++i) L[i] = T[i];
        } else top16_merge(L, T);
    }
    float P[16];
#pragma unroll
    for (int i = 0; i < 16; ++i) P[i] = __shfl_xor(L[i], 32);
    top16_merge(L, P);
}
__device__ __forceinline__ void peer_select32(int hd, int n0, int lane, const bf16* qpeer, const LAS unsigned char* kl1, const LAS unsigned char* kl2, unsigned char* wsb, LAS unsigned* ldsw) {
    asm volatile("" : "+v"(lane));
    const int c = lane & 31, hf = lane >> 5, n = n0 + c;
    const bf16* qrow = qpeer + (size_t)n * 2048 + hd * 256 + 8 * hf;
    float A[16], B[16];
    peer_top16(qrow, kl1 + c * PK_KS + 16 * hf, hf, A);
    peer_top16(qrow + 128, kl2 + c * PK_KS + 16 * hf, hf, B);
#define PKV(x) __uint_as_float(__float_as_uint(x) & ~127u)
#define PKI(x) ((int)(__float_as_uint(x) & 127u))
    float W[16];
    { float C0[16], C1[16], C2[16], E0 = 0.f, E1 = 0.f; unsigned id = 0;
#pragma unroll
      for (int a = 0; a < 16; ++a)
#pragma unroll
        for (int b = 0; b < 16; ++b) if ((a + 1) * (b + 1) <= 16) { const float pk = __uint_as_float((__float_as_uint(PKV(A[a]) + PKV(B[b])) & ~63u) | id);
            if (id < 16) C0[id] = pk; else if (id < 32) C1[id - 16] = pk; else if (id < 48) C2[id - 32] = pk; else if (id == 48) E0 = pk; else E1 = pk;
            ++id; }
      sort16_desc(C0); sort16_desc(C1); sort16_desc(C2);
      top16_merge(C0, C1); top16_merge(C0, C2);
#pragma unroll
      for (int i = 0; i < 16; ++i) W[i] = C0[i];
      ins16(W, E0); ins16(W, E1); }
    const float thr = W[15], mx = W[0];
    int cnt = 0; float ssum = 0.f;
    LAS int* le = (LAS int*)ldsw + c * 16; LAS float* lg = (LAS float*)ldsw + 512 + c * 16;
    { unsigned id = 0;
#pragma unroll
      for (int a = 0; a < 16; ++a)
#pragma unroll
        for (int b = 0; b < 16; ++b) if ((a + 1) * (b + 1) <= 16) {
            const float cv = PKV(A[a]) + PKV(B[b]); const float pk = __uint_as_float((__float_as_uint(cv) & ~63u) | id); ++id;
            if (pk >= thr) { const float e = __expf(cv - mx); if (hf == 0) { le[cnt] = PKI(A[a]) * 128 + PKI(B[b]); lg[cnt] = e; } ssum += e; ++cnt; }
        } }
    LDS_WAIT();
    asm volatile("" : "+s"(wsb));
    int* sel_e = (int*)(wsb + WS_SEL); float* sel_g = (float*)(wsb + WS_SEL + 8 * MiB); float* sel_s = (float*)(wsb + WS_SELS);
    { int lane3 = lane; asm volatile("" : "+v"(lane3)); const int t = lane3 >> 1, part = lane3 & 1;
      const v4u e0 = *(const LAS v4u*)((LAS int*)ldsw + t * 16 + 8 * part), e1 = *(const LAS v4u*)((LAS int*)ldsw + t * 16 + 8 * part + 4);
      const v4u g0 = *(const LAS v4u*)((LAS int*)ldsw + 512 + t * 16 + 8 * part), g1 = *(const LAS v4u*)((LAS int*)ldsw + 512 + t * 16 + 8 * part + 4);
      GAS v4u* pe = (GAS v4u*)(sel_e + (size_t)(n0 + t) * 128 + hd * 16 + 8 * part); GAS v4u* pg = (GAS v4u*)(sel_g + (size_t)(n0 + t) * 128 + hd * 16 + 8 * part);
      pe[0] = e0; pe[1] = e1; pg[0] = g0; pg[1] = g1; }
    LDS_WAIT();
    { int lane4 = lane; asm volatile("" : "+v"(lane4)); if ((lane4 >> 5) == 0) ((GAS float*)sel_s)[(size_t)(n0 + (lane4 & 31)) * 8 + hd] = ssum; }
}

__device__ __forceinline__ float dot2bf(unsigned a, unsigned b, float acc) {
    return __builtin_amdgcn_fdot2_f32_bf16(__builtin_bit_cast(bf16v2, a), __builtin_bit_cast(bf16v2, b), acc, false);
}
__device__ __forceinline__ float dot8bf(const v4u a, const v4u b, float acc) {
    const unsigned a0 = a.x, a1 = a.y, a2 = a.z, a3 = a.w, b0 = b.x, b1 = b.y, b2 = b.z, b3 = b.w;
    acc = dot2bf(a0, b0, acc); acc = dot2bf(a1, b1, acc); acc = dot2bf(a2, b2, acc); acc = dot2bf(a3, b3, acc);
    return acc;
}
__device__ __forceinline__ void unpack16(const v4u q, float (&f)[16]) {
    const unsigned d0 = q.x, d1 = q.y, d2 = q.z, d3 = q.w;
    f32x2v t;
    t = __builtin_amdgcn_cvt_pk_f32_fp8((int)d0, false); f[0] = t.x; f[1] = t.y; t = __builtin_amdgcn_cvt_pk_f32_fp8((int)d0, true); f[2] = t.x; f[3] = t.y;
    t = __builtin_amdgcn_cvt_pk_f32_fp8((int)d1, false); f[4] = t.x; f[5] = t.y; t = __builtin_amdgcn_cvt_pk_f32_fp8((int)d1, true); f[6] = t.x; f[7] = t.y;
    t = __builtin_amdgcn_cvt_pk_f32_fp8((int)d2, false); f[8] = t.x; f[9] = t.y; t = __builtin_amdgcn_cvt_pk_f32_fp8((int)d2, true); f[10] = t.x; f[11] = t.y;
    t = __builtin_amdgcn_cvt_pk_f32_fp8((int)d3, false); f[12] = t.x; f[13] = t.y; t = __builtin_amdgcn_cvt_pk_f32_fp8((int)d3, true); f[14] = t.x; f[15] = t.y;
}
struct SliceSched { int mode, xcc, rank, nloc; };
__device__ __forceinline__ SliceSched slice_sched_init(const Ctx& c, unsigned* ctl, const XcdBarrier& bar, int use) {
    LAS int* sh = (LAS int*)(c.lds + 1024);
    if (c.tid == 0) {
        int ok = 1; unsigned tot = 0;
        for (int j = 0; j < 16; ++j) { const unsigned n = xb_ld(&bar.bar[XB_XCNT(j)]); tot += n; if ((j < 8) != (n > 0u)) ok = 0; }
        if (tot != (unsigned)c.G) ok = 0;
        const int xcc = (int)xb_xcc_id();
        int rank = 0, nloc = 1;
        if (ok) { nloc = (int)xb_ld(&bar.bar[XB_XCNT(xcc)]); rank = (int)xb_add(&ctl[CW_RANK + (use * 16 + xcc) * 64], 1u); if (rank >= nloc) ok = 0; }
        sh[0] = ok; sh[1] = xcc; sh[2] = rank; sh[3] = nloc;
    }
    __syncthreads();
    SliceSched S; S.mode = sh[0]; S.xcc = sh[1]; S.rank = sh[2]; S.nloc = sh[3];
    __syncthreads();
    return S;
}
__device__ __forceinline__ bool slice_item(const SliceSched& S, const Ctx& c, int i, int& slice, int& tb) {
    if (S.mode) { const int it = S.rank + i * S.nloc; if (it >= 512) return false; slice = S.xcc + 8 * (it >> 8); tb = it & 255; return true; }
    const int it = (int)blockIdx.x + i * c.G; if (it >= 4096) return false; slice = it >> 8; tb = it & 255; return true;
}
__device__ __forceinline__ void unpack16p(const v4u q, f32x2v (&f)[8]) {
    const unsigned d0 = q.x, d1 = q.y, d2 = q.z, d3 = q.w;
    f[0] = __builtin_amdgcn_cvt_pk_f32_fp8((int)d0, false); f[1] = __builtin_amdgcn_cvt_pk_f32_fp8((int)d0, true);
    f[2] = __builtin_amdgcn_cvt_pk_f32_fp8((int)d1, false); f[3] = __builtin_amdgcn_cvt_pk_f32_fp8((int)d1, true);
    f[4] = __builtin_amdgcn_cvt_pk_f32_fp8((int)d2, false); f[5] = __builtin_amdgcn_cvt_pk_f32_fp8((int)d2, true);
    f[6] = __builtin_amdgcn_cvt_pk_f32_fp8((int)d3, false); f[7] = __builtin_amdgcn_cvt_pk_f32_fp8((int)d3, true);
}
__device__ __forceinline__ void sddmm_load(const unsigned char* ubase, const LAS unsigned* ids16, v4u (&q)[16]) {
    int id[16];
#pragma unroll
    for (int i = 0; i < 4; ++i) { const v4u v = *(const LAS v4u*)(ids16 + 4 * i); id[4 * i] = (int)v.x; id[4 * i + 1] = (int)v.y; id[4 * i + 2] = (int)v.z; id[4 * i + 3] = (int)v.w; }
#pragma unroll
    for (int it = 0; it < 16; ++it) q[it] = *(const GAS v4u*)(ubase + (unsigned)id[it] * 128u);
}
__device__ __forceinline__ void sddmm_token(const v4u (&qc)[16], const v4u hv, const float hs, int lane, unsigned* dst) {
    const int hq[4] = {(int)hv.x, (int)hv.y, (int)hv.z, (int)hv.w};
    float p[16];
#pragma unroll
    for (int it = 0; it < 16; ++it) { int a = __builtin_amdgcn_sdot4((int)qc[it].x, hq[0], 0, false); a = __builtin_amdgcn_sdot4((int)qc[it].y, hq[1], a, false);
        a = __builtin_amdgcn_sdot4((int)qc[it].z, hq[2], a, false); a = __builtin_amdgcn_sdot4((int)qc[it].w, hq[3], a, false);
        p[it] = (float)a * hs; }
#pragma unroll
    for (int i = 0; i < 8; ++i) { const bool up = (lane & 4) != 0; const float snd = up ? p[i] : p[i + 8], kp = up ? p[i + 8] : p[i]; p[i] = kp + __shfl_xor(snd, 4); }
#pragma unroll
    for (int i = 0; i < 4; ++i) { const bool up = (lane & 2) != 0; const float snd = up ? p[i] : p[i + 4], kp = up ? p[i + 4] : p[i]; p[i] = kp + __shfl_xor(snd, 2); }
#pragma unroll
    for (int i = 0; i < 2; ++i) { const bool up = (lane & 1) != 0; const float snd = up ? p[i] : p[i + 2], kp = up ? p[i + 2] : p[i]; p[i] = kp + __shfl_xor(snd, 1); }
    *(GAS unsigned*)dst = pk2c(p[0], p[1]);
}
__device__ __forceinline__ void peer_sddmm_wave(int t0, int s, int lane, const unsigned char* H8, const float* SA, const unsigned char* UQ, const int* sel_e, float* part, LAS unsigned* ldsw) {
    const int cg = lane & 7, sg = lane >> 3;
#pragma unroll
    for (int j = 0; j < 4; ++j) *(LAS v4u*)(ldsw + 4 * (lane + 64 * j)) = *(const GAS v4u*)(sel_e + (size_t)t0 * 128 + 4 * (lane + 64 * j));
    LDS_WAIT();
    const unsigned char* ubase = UQ + (size_t)s * U8_SLICE + cg * 16;
    const LAS unsigned* idl = ldsw + sg * 16;
    const unsigned char* hbase = H8 + (size_t)t0 * 2048 + s * 128 + cg * 16;
    unsigned* pbase = (unsigned*)part + ((size_t)t0 * 16 + s) * 64 + lane;
    v4u qa[16], qb[16];
    v4u ha = *(const GAS v4u*)(hbase), hb; float sa = ((const GAS float*)SA)[t0], sb;
    sddmm_load(ubase, idl, qa);
#pragma unroll
    for (int k = 0; k < 6; k += 2) {
        hb = *(const GAS v4u*)(hbase + (size_t)(k + 1) * 2048); sb = ((const GAS float*)SA)[t0 + k + 1];
        sddmm_load(ubase, idl + (k + 1) * 128, qb);
        sddmm_token(qa, ha, sa, lane, pbase + (size_t)k * 1024);
        ha = *(const GAS v4u*)(hbase + (size_t)(k + 2) * 2048); sa = ((const GAS float*)SA)[t0 + k + 2];
        sddmm_load(ubase, idl + (k + 2) * 128, qa);
        sddmm_token(qb, hb, sb, lane, pbase + (size_t)(k + 1) * 1024);
    }
    hb = *(const GAS v4u*)(hbase + (size_t)7 * 2048); sb = ((const GAS float*)SA)[t0 + 7];
    sddmm_load(ubase, idl + 7 * 128, qb);
    sddmm_token(qa, ha, sa, lane, pbase + (size_t)6 * 1024);
    sddmm_token(qb, hb, sb, lane, pbase + (size_t)7 * 1024);
    LDS_WAIT();
}
__device__ __forceinline__ void peer_coef_tokens4(int t0, int ts, int lane, const float* part, const int* sel_e, float* sel_g, const float* sel_s, const float* US, const float* VS) {
    unsigned pv[4][16]; v2u e[4]; f32x2v g[4]; float dn[4];
#pragma unroll
    for (int i = 0; i < 4; ++i) { const int t = t0 + i * ts;
#pragma unroll
        for (int s = 0; s < 16; ++s) pv[i][s] = ((const GAS unsigned*)part)[((size_t)t * 16 + s) * 64 + lane];
        e[i] = *(const GAS v2u*)(sel_e + (size_t)t * 128 + 2 * lane); g[i] = *(const GAS f32x2v*)(sel_g + (size_t)t * 128 + 2 * lane); dn[i] = ((const GAS float*)sel_s)[(size_t)t * 8 + (lane >> 3)]; }
    float ux[4], uy[4], vx[4], vy[4];
#pragma unroll
    for (int i = 0; i < 4; ++i) { ux[i] = ((const GAS float*)US)[e[i].x]; uy[i] = ((const GAS float*)US)[e[i].y]; vx[i] = ((const GAS float*)VS)[e[i].x]; vy[i] = ((const GAS float*)VS)[e[i].y]; }
#pragma unroll
    for (int i = 0; i < 4; ++i) { const int t = t0 + i * ts; float a0 = 0.f, a1 = 0.f;
#pragma unroll
        for (int s = 0; s < 16; ++s) { a0 += bflo(pv[i][s]); a1 += bfhi(pv[i][s]); }
        const float inv = 1.0f / dn[i];
        const float ox = g[i].x * inv * gelu_exact(a0 * ux[i]) * vx[i], oy = g[i].y * inv * gelu_exact(a1 * uy[i]) * vy[i];
        const h2_t ha = {(_Float16)ox, (_Float16)ox}, hb = {(_Float16)oy, (_Float16)oy};
        *(GAS v2u*)(sel_g + (size_t)t * 128 + 2 * lane) = (v2u){__builtin_bit_cast(unsigned, ha), __builtin_bit_cast(unsigned, hb)}; }
}
__device__ __forceinline__ bool slice_item8(const SliceSched& S, const Ctx& c, int i, int& slice, int& tb) {
    if (S.mode) { const int it = S.rank + i * S.nloc; if (it >= 256) return false; slice = S.xcc; tb = it; return true; }
    const int it = (int)blockIdx.x + i * c.G; if (it >= 2048) return false; slice = it >> 8; tb = it & 255; return true;
}
template <int MODE = 0>
__device__ __forceinline__ void spmm6_load(const unsigned char* vbase, const LAS unsigned* ids8, v4u (&qa)[8], v2u (&qb)[8]) {
    const v4u i0 = *(const LAS v4u*)(ids8), i1 = *(const LAS v4u*)(ids8 + 4);
    const unsigned id[8] = {i0.x, i0.y, i0.z, i0.w, i1.x, i1.y, i1.z, i1.w};
    if constexpr (MODE == 2) {
#pragma unroll
        for (int it = 0; it < 8; ++it) { qa[it] = (v4u){id[it], id[it] + 1u, id[it] + 2u, id[it] + 3u}; qb[it] = (v2u){id[it] + 4u, id[it] + 5u}; }
        return; }
#pragma unroll
    for (int it = 0; it < 8; ++it) { const unsigned char* p = vbase + id[it] * 192u; qa[it] = *(const GAS v4u*)p; qb[it] = *(const GAS v2u*)(p + 16); }
}
template <int MODE = 0>
__device__ __forceinline__ void spmm6_fma(const v4u (&qa)[8], const v2u (&qb)[8], const LAS unsigned* cf8, h2_t (&y)[16]) {
    const v4u c0 = *(const LAS v4u*)(cf8), c1 = *(const LAS v4u*)(cf8 + 4);
    const unsigned cf[8] = {c0.x, c0.y, c0.z, c0.w, c1.x, c1.y, c1.z, c1.w};
    if constexpr (MODE == 1) {
#pragma unroll
        for (int it = 0; it < 8; ++it) { const unsigned x = (qa[it].x ^ qa[it].y) ^ (qa[it].z ^ qa[it].w) ^ (qb[it].x ^ qb[it].y) ^ cf[it]; y[it] = __builtin_bit_cast(h2_t, __builtin_bit_cast(unsigned, y[it]) ^ x); }
        return; }
#pragma unroll
    for (int it = 0; it < 8; ++it) { const v6u q = {qa[it].x, qa[it].y, qa[it].z, qa[it].w, qb[it].x, qb[it].y};
        const v32h_t f = __builtin_amdgcn_cvt_scalef32_pk32_f16_fp6(q, 1.0f); const h2_t c2 = __builtin_bit_cast(h2_t, cf[it]);
#pragma unroll
        for (int j = 0; j < 16; ++j) { const h2_t v = {f[2 * j], f[2 * j + 1]}; y[j] = __builtin_elementwise_fma(v, c2, y[j]); } }
}
template <int MODE = 0>
__device__ __forceinline__ void peer_spmm6_wave(int t0, int s, int lane, const unsigned char* V6, const int* sel_e, const float* coef, const float* x1, float* xout, LAS unsigned* ldsw) {
    const int cg = lane & 7, sg = lane >> 3;
#pragma unroll
    for (int j = 0; j < 4; ++j) { *(LAS v4u*)(ldsw + 4 * (lane + 64 * j)) = *(const GAS v4u*)(sel_e + (size_t)t0 * 128 + 4 * (lane + 64 * j));
        *(LAS v4u*)(ldsw + 1024 + 4 * (lane + 64 * j)) = *(const GAS v4u*)(coef + (size_t)t0 * 128 + 4 * (lane + 64 * j)); }
    LDS_WAIT();
    const unsigned char* vbase = V6 + (size_t)s * V6_SLICE + cg * 24;
    const LAS unsigned* idl = ldsw + sg * 16; const LAS unsigned* cfl = ldsw + 1024 + sg * 16;
    v4u qa0[8], qa1[8]; v2u qb0[8], qb1[8];
    spmm6_load<MODE>(vbase, idl, qa0, qb0);
    const size_t xoff = (size_t)t0 * 2048 + s * 256 + cg * 32 + 4 * sg;
    f32x4 xn = *(const GAS f32x4*)(x1 + xoff);
#pragma unroll
    for (int k = 0; k < 8; ++k) {
        const f32x4 xv = xn;
        h2_t y[16];
#pragma unroll
        for (int j = 0; j < 16; ++j) y[j] = (h2_t){(_Float16)0.f, (_Float16)0.f};
        spmm6_load<MODE>(vbase, idl + k * 128 + 8, qa1, qb1);
        if (k < 7) xn = *(const GAS f32x4*)(x1 + xoff + (size_t)(k + 1) * 2048);
        spmm6_fma<MODE>(qa0, qb0, cfl + k * 128, y);
        if (k < 7) spmm6_load<MODE>(vbase, idl + (k + 1) * 128, qa0, qb0);
        spmm6_fma<MODE>(qa1, qb1, cfl + k * 128 + 8, y);
        unsigned u[16];
#pragma unroll
        for (int j = 0; j < 16; ++j) u[j] = __builtin_bit_cast(unsigned, y[j]);
#pragma unroll
        for (int i = 0; i < 8; ++i) { const bool up = (lane & 32) != 0; const unsigned snd = up ? u[i] : u[i + 8], kp = up ? u[i + 8] : u[i]; u[i] = __builtin_bit_cast(unsigned, __builtin_bit_cast(h2_t, kp) + __builtin_bit_cast(h2_t, (unsigned)__shfl_xor((int)snd, 32))); }
#pragma unroll
        for (int i = 0; i < 4; ++i) { const bool up = (lane & 16) != 0; const unsigned snd = up ? u[i] : u[i + 4], kp = up ? u[i + 4] : u[i]; u[i] = __builtin_bit_cast(unsigned, __builtin_bit_cast(h2_t, kp) + __builtin_bit_cast(h2_t, (unsigned)__shfl_xor((int)snd, 16))); }
#pragma unroll
        for (int i = 0; i < 2; ++i) { const bool up = (lane & 8) != 0; const unsigned snd = up ? u[i] : u[i + 2], kp = up ? u[i + 2] : u[i]; u[i] = __builtin_bit_cast(unsigned, __builtin_bit_cast(h2_t, kp) + __builtin_bit_cast(h2_t, (unsigned)__shfl_xor((int)snd, 8))); }
        const h2_t r0 = __builtin_bit_cast(h2_t, u[0]), r1 = __builtin_bit_cast(h2_t, u[1]);
        f32x4 o; o.x = xv.x + (float)r0[0]; o.y = xv.y + (float)r0[1]; o.z = xv.z + (float)r1[0]; o.w = xv.w + (float)r1[1];
        *(GAS f32x4*)(xout + xoff + (size_t)k * 2048) = o;
    }
    LDS_WAIT();
}

struct Args { const float* in[21]; float* out; unsigned char* ws; int lo, hi, li, pad; };
__global__ void __launch_bounds__(512, 2) mk_fwd(Args args) {
    extern __shared__ __attribute__((aligned(16))) unsigned char lds_raw[];
    Ctx c; c.lds = (LAS unsigned char*)lds_raw; c.tid = threadIdx.x; c.lane = c.tid & 63; c.wave = __builtin_amdgcn_readfirstlane(c.tid >> 6);
    c.G = gridDim.x; c.gw = blockIdx.x * 8 + c.wave; c.NGW = c.G * 8;
    volatile LAS unsigned* MISC = (volatile LAS unsigned*)(c.lds + MISC_OFF);
    if (c.tid < 32) MISC[c.tid] = 0u;
    __syncthreads();
    unsigned char* ws = args.ws;
    const int lo = args.lo, hi = args.hi;
    XcdBarrier bar; bar.w0 = 0; bar.bar = (unsigned*)(ws + WS_CTL) + CW_BAR + args.li * XCD_BAR_WORDS; bar.x = 0; bar.st = nullptr;
    if (hi - lo > 1) bar = xcd_barrier_post((unsigned*)(ws + WS_CTL) + CW_BAR + args.li * XCD_BAR_WORDS, MISC + 8);
#ifndef ATTN_REPS
#define ATTN_REPS 1
#endif
#ifndef PHMASK
#define PHMASK 0x1fff
#endif
#ifndef REP_PH
#define REP_PH (-1)
#endif
    int rep2 = 2; asm volatile("" : "+s"(rep2));
#define RLOOP(k, cond) for (int rp_ = 0; rp_ < ((((k) == REP_PH) && (cond)) ? rep2 : 1); ++rp_)
#define RSYNC do { if (rp_) xcd_barrier(bar); } while (0)
#define IN(k) (((PHMASK >> ((k) % NPH)) & 1) && lo <= (k) && (k) < hi)
#define SEAM(k) do { if (IN(k) && IN((k) + 1)) xcd_barrier(bar); } while (0)
#define PH_BEGIN unsigned char* w = ws; float* outp = args.out; Ctx cc = c; int zi = 0; cc.lane = xb_lane_id(); cc.tid = cc.wave * 64 + cc.lane; \
    asm volatile("" : "+s"(w), "+s"(outp), "+s"(zi), "+v"(cc.tid), "+v"(cc.lane)); (void)w; (void)outp;
#define INP(k) (args.in[(k) + zi])
#define WSP(T, off) ((T*)(w + (off)))
    for (int l = 0; l < 2; ++l) {
        const int pb = l * NPH;
        if (IN(pb + 0)) { PH_BEGIN
            P0Args a; a.w_in = INP(2) + (size_t)l * DM * INW; a.w_br_sb = INP(11) + (size_t)l * BW * DM; a.w_br_hg = INP(12) + (size_t)l * BW * DM; a.w_br_conv = INP(13) + (size_t)l * BW * DM;
            a.w_o = INP(14) + (size_t)l * DM * DM; a.w_q = INP(16) + (size_t)l * DM * DM; a.u = INP(19) + (size_t)l * 16384 * 2048; a.v = INP(20) + (size_t)l * 16384 * 2048; a.lbp = INP(5);
            a.WinT = WSP(bf16, WS_WIN); a.WbrT = WSP(bf16, WS_WBR); a.WoT = WSP(bf16, WS_WO); a.WqT = WSP(bf16, WS_WQ); a.U = WSP(unsigned char, WS_U); a.V = WSP(unsigned char, WS_V); a.US = WSP(float, WS_US); a.VS = WSP(float, WS_VS); a.LB = WSP(float, WS_LB); a.layer = l; a.k1 = INP(17) + (size_t)l * 8 * 16384; a.k2 = INP(18) + (size_t)l * 8 * 16384; a.KB = WSP(bf16, WS_KEYS);
#ifndef REP_MODE0
#define REP_MODE0 15
#endif
            RLOOP(0, true) { RSYNC;
            int pm_ = 15; if (REP_PH == 0) { pm_ = rp_ ? REP_MODE0 : 15; asm volatile("" : "+s"(pm_)); }
            p0_convert(cc, a, pm_);
            if (pm_ & 8) rms_phase_i8(cc, l == 0 ? INP(0) : WSP(const float, WS_X2), INP(1) + (size_t)l * DM, WSP(unsigned char, WS_H), WSP(float, WS_SA)); }
        }
        SEAM(pb + 0);
        if (IN(pb + 1)) { PH_BEGIN
            RLOOP(1, true) { RSYNC;
            pg8::Gemm g{WSP(bf16, WS_H), WSP(bf16, WS_WIN), NTOK, INW, DM}; pg8::StaticOrder S; S.init(NTOK, INW, cc.G, (int)blockIdx.x);
            EpiIn E{WSP(bf16, WS_SEG), WSP(bf16, WS_GATE), WSP(float, WS_LB), WSP(float, WS_SA)};
            pg8::gemm_phase<EpiIn, pg8::StaticOrder, true, true, true>(cc.lds, g, S, E, cc.wave); }
        }
        SEAM(pb + 1);
        if (IN(pb + 2)) { PH_BEGIN
            bf16* SEG = WSP(bf16, WS_SEG);
#ifndef REP_MODE2
#define REP_MODE2 7
#endif
            RLOOP(2, true) { RSYNC;
            int pm_ = 7; if (REP_PH == 2) { pm_ = rp_ ? REP_MODE2 : 7; asm volatile("" : "+s"(pm_)); }
            if (pm_ & 1)
            conv_phase(cc, SEG + 7 * SEGSZ, INP(7) + (size_t)l * 31 * 1024, INP(8) + (size_t)l * 1024, INP(9) + (size_t)l * 1024, INP(10) + (size_t)l * 1024, WSP(bf16, WS_CONV));
            if (pm_ & 2)
            for (int ci = blockIdx.x; ci < 2048; ci += cc.G) hgA_chunk(cc, ci, SEG + 4 * SEGSZ, SEG + 5 * SEGSZ, WSP(bf16, WS_ST), WSP(float, WS_DEC));
            if (!rp_)
            for (int r = cc.gw; r < 2 * (NTOK / 4); r += cc.NGW) {
                if (r < NTOK / 4) qknorm_rows4(SEG + (size_t)r * 4 * 1024, 1024, INP(3) + (size_t)l * 128, 0.08838834764831845f, cc.lane);
                else qknorm_rows4(SEG + SEGSZ + (size_t)(r - NTOK / 4) * 4 * 1024, 1024, INP(4) + (size_t)l * 128, 1.0f, cc.lane);
            }
            LAS unsigned short* scr = (LAS unsigned short*)(cc.lds + 4096 + cc.wave * 8192);
            if (pm_ & 4)
            for (int it = cc.gw; it < 8192; it += cc.NGW) vt_item(it, cc.lane, SEG + 2 * SEGSZ, WSP(bf16, WS_MERGED), scr); }
        }
        SEAM(pb + 2);
        if (IN(pb + 3)) { PH_BEGIN
            bf16* SEG = WSP(bf16, WS_SEG);
            RLOOP(3, true) { RSYNC;
            if (!rp_) hgB(cc, WSP(bf16, WS_ST), WSP(float, WS_DEC));
            for (int p = blockIdx.x; p < 256; p += cc.G) { const int bh = (p & 7) * 4 + (p >> 6), j = (p >> 3) & 7;
                if (cc.wave >= 4) {
#pragma unroll 1
                    for (int u = 0; u < 2; ++u) attn_unit<true>(cc, bh, u ? j : 15 - j, SEG, SEG + SEGSZ, WSP(bf16, WS_MERGED), SEG + 2 * SEGSZ);
                } else {
#pragma unroll 1
                    for (int u = 0; u < 2; ++u) attn_unit<false>(cc, bh, u ? j : 15 - j, SEG, SEG + SEGSZ, WSP(bf16, WS_MERGED), SEG + 2 * SEGSZ);
                } } }
        }
        SEAM(pb + 3);
        if (IN(pb + 4)) { PH_BEGIN
            bf16* SEG = WSP(bf16, WS_SEG);
            RLOOP(4, true) { RSYNC;
            for (int ci = blockIdx.x; ci < 2048; ci += cc.G) hgC_chunk(cc, ci, SEG + 3 * SEGSZ, SEG + 4 * SEGSZ, SEG + 5 * SEGSZ, SEG + 6 * SEGSZ, WSP(bf16, WS_ST), INP(6) + (size_t)l * 128, WSP(bf16, WS_HGR)); }
        }
        SEAM(pb + 4);
        if (IN(pb + 5)) { PH_BEGIN
            RLOOP(5, true) { RSYNC;
            pg8::StaticOrder S; S.init(NTOK, DM, cc.G, (int)blockIdx.x);
            { pg8::Gemm g{WSP(bf16, WS_SEG) + 2 * SEGSZ, WSP(bf16, WS_WBR), NTOK, DM, BW}; EpiMerge<true> E{WSP(bf16, WS_GATE), WSP(bf16, WS_MERGED)}; pg8::gemm_phase<EpiMerge<true>, pg8::StaticOrder, true, true>(cc.lds, g, S, E, cc.wave); }
            { pg8::Gemm g{WSP(bf16, WS_HGR), WSP(bf16, WS_WBR) + (size_t)DM * BW, NTOK, DM, BW}; EpiMerge<false> E{WSP(bf16, WS_GATE) + (size_t)NTOK * 2048, WSP(bf16, WS_MERGED)}; pg8::gemm_phase<EpiMerge<false>, pg8::StaticOrder, true, true>(cc.lds, g, S, E, cc.wave); }
            { pg8::Gemm g{WSP(bf16, WS_CONV), WSP(bf16, WS_WBR) + (size_t)2 * DM * BW, NTOK, DM, BW}; EpiMerge<false> E{WSP(bf16, WS_GATE) + (size_t)2 * NTOK * 2048, WSP(bf16, WS_MERGED)}; pg8::gemm_phase<EpiMerge<false>, pg8::StaticOrder, true, true>(cc.lds, g, S, E, cc.wave); } }
        }
        SEAM(pb + 5);
        if (IN(pb + 6)) { PH_BEGIN
            RLOOP(6, true) { RSYNC;
            pg8::Gemm g{WSP(bf16, WS_MERGED), WSP(bf16, WS_WO), NTOK, DM, DM}; pg8::StaticOrder S; S.init(NTOK, DM, cc.G, (int)blockIdx.x);
            EpiResid E{l == 0 ? INP(0) : WSP(const float, WS_X2), outp};
            pg8::gemm_phase<EpiResid, pg8::StaticOrder, true, true>(cc.lds, g, S, E, cc.wave); }
        }
        SEAM(pb + 6);
        if (IN(pb + 7)) { PH_BEGIN RLOOP(7, true) { RSYNC; rms_phase_i8(cc, outp, INP(15) + (size_t)l * DM, WSP(unsigned char, WS_H), WSP(float, WS_SA)); } }
        SEAM(pb + 7);
        if (IN(pb + 8)) { PH_BEGIN
            RLOOP(8, true) { RSYNC;
            pg8::Gemm g{WSP(bf16, WS_H), WSP(bf16, WS_WQ), NTOK, DM, DM}; pg8::StaticOrder S; S.init(NTOK, DM, cc.G, (int)blockIdx.x);
            EpiStoreBf16 E{WSP(bf16, WS_QPEER), WSP(float, WS_SA)};
            pg8::gemm_phase<EpiStoreBf16, pg8::StaticOrder, true, true, true>(cc.lds, g, S, E, cc.wave); }
        }
        SEAM(pb + 8);
        if (IN(pb + 9)) { PH_BEGIN
            RLOOP(9, true) { RSYNC;
            for (int item = blockIdx.x; item < 512; item += cc.G) { const int hd = item & 7, tg = item >> 3;
                const bf16* KB = WSP(bf16, WS_KEYS);
#pragma unroll
                for (int i = 0; i < 8; ++i) { const int p = cc.tid + 512 * i, li = p >> 11, row = (p >> 4) & 127, c16 = p & 15;
                    *(LAS v4u*)(cc.lds + li * 128 * PK_KS + row * PK_KS + c16 * 16) = *(const GAS v4u*)(KB + (size_t)(li * 8 + hd) * 16384 + row * 128 + c16 * 8); }
                __syncthreads();
                peer_select32(hd, tg * 256 + cc.wave * 32, cc.lane, WSP(bf16, WS_QPEER), cc.lds, cc.lds + 128 * PK_KS, w, (LAS unsigned*)(cc.lds + 2 * 128 * PK_KS + cc.wave * 4096));
                __syncthreads(); } }
        }
        SEAM(pb + 9);
        if (IN(pb + 10)) { PH_BEGIN
            const SliceSched SS = slice_sched_init(cc, (unsigned*)(w + WS_CTL), bar, l * 2 + 0);
            RLOOP(10, true) { RSYNC;
            for (int i = 0;; ++i) { int sl, tb; if (!slice_item(SS, cc, i, sl, tb)) break;
                peer_sddmm_wave(tb * 64 + cc.wave * 8, sl, cc.lane, WSP(unsigned char, WS_H), WSP(float, WS_SA), WSP(unsigned char, WS_U), WSP(int, WS_SEL), WSP(float, WS_PART), (LAS unsigned*)(cc.lds + 4096 + cc.wave * 8192)); } }
        }
        SEAM(pb + 10);
        if (IN(pb + 11)) { PH_BEGIN
            for (int n = cc.gw; n < NTOK / 4; n += cc.NGW) peer_coef_tokens4(n, NTOK / 4, cc.lane, WSP(float, WS_PART), WSP(int, WS_SEL), WSP(float, WS_SEL + 8 * MiB), WSP(float, WS_SELS), WSP(float, WS_US), WSP(float, WS_VS));
        }
        SEAM(pb + 11);
        if (IN(pb + 12)) { PH_BEGIN
            float* xo = l == 0 ? WSP(float, WS_X2) : outp;
            const SliceSched SS = slice_sched_init(cc, (unsigned*)(w + WS_CTL), bar, l * 2 + 1);
#ifndef REP_MODE
#define REP_MODE 0
#endif
            RLOOP(12, l == 0) { RSYNC;
            if (REP_MODE && rp_) {
            for (int i = 0;; ++i) { int sl, tb; if (!slice_item8(SS, cc, i, sl, tb)) break;
                peer_spmm6_wave<REP_MODE>(tb * 64 + cc.wave * 8, sl, cc.lane, WSP(unsigned char, WS_V), WSP(int, WS_SEL), WSP(float, WS_SEL + 8 * MiB), outp, WSP(float, WS_SEG + 64 * MiB), (LAS unsigned*)(cc.lds + 4096 + cc.wave * 8192)); }
            } else
            for (int i = 0;; ++i) { int sl, tb; if (!slice_item8(SS, cc, i, sl, tb)) break;
                peer_spmm6_wave(tb * 64 + cc.wave * 8, sl, cc.lane, WSP(unsigned char, WS_V), WSP(int, WS_SEL), WSP(float, WS_SEL + 8 * MiB), outp, xo, (LAS unsigned*)(cc.lds + 4096 + cc.wave * 8192)); } }
        }
        SEAM(pb + 12);
    }
#undef PH_BEGIN
#undef INP
#undef WSP
#undef IN
#undef SEAM
}

#ifndef MK_SPLIT
#define MK_SPLIT 0
#endif
extern "C" void kernel_launch(void* const* d_in, const int* in_sizes, int n_in, void* d_out, int out_size, void* d_ws, size_t ws_size, hipStream_t stream) {
    static int grid = 0;
    if (grid == 0) {
        if (n_in != 21 || out_size != NTOK * DM || ws_size < WS_END) { fprintf(stderr, "kernel_launch: unexpected shapes (n_in %d, out %d, ws %zu < %zu); nothing launched\n", n_in, out_size, ws_size, (size_t)WS_END); grid = -1; return; }
        int dev = 0, cus = 0, per_cu = 0;
        if (hipGetDevice(&dev) != hipSuccess || hipDeviceGetAttribute(&cus, hipDeviceAttributeMultiprocessorCount, dev) != hipSuccess) { grid = -1; return; }
        if (hipFuncSetAttribute((const void*)mk_fwd, hipFuncAttributeMaxDynamicSharedMemorySize, LDS_BYTES) != hipSuccess) { fprintf(stderr, "kernel_launch: hipFuncSetAttribute failed\n"); grid = -1; return; }
        if (hipOccupancyMaxActiveBlocksPerMultiprocessor(&per_cu, (const void*)mk_fwd, 512, LDS_BYTES) != hipSuccess || per_cu < 1) fprintf(stderr, "kernel_launch: occupancy query reports %d\n", per_cu);
        (void)hipGetLastError();
        grid = cus;
    }
    if (grid < 0) return;
    if (hipMemsetAsync((char*)d_ws + WS_CTL, 0, 1 * MiB, stream) != hipSuccess) { fprintf(stderr, "kernel_launch: memset failed\n"); return; }
    Args a{};
    for (int i = 0; i < 21; ++i) a.in[i] = (const float*)d_in[i];
    a.out = (float*)d_out; a.ws = (unsigned char*)d_ws; a.pad = 0;
#if MK_SPLIT
    for (int p = 0; p < NPHASES; ++p) { a.lo = p; a.hi = p + 1; a.li = p; hipLaunchKernelGGL(mk_fwd, dim3(grid), dim3(512), LDS_BYTES, stream, a); }
#else
    a.lo = 0; a.hi = NPHASES; a.li = 0;
    hipLaunchKernelGGL(mk_fwd, dim3(grid), dim3(512), LDS_BYTES, stream, a);
#endif
    const hipError_t le = hipPeekAtLastError();
    if (le != hipSuccess) fprintf(stderr, "kernel_launch: launch failed: %s\n", hipGetErrorName(le));
}
```

```cpp
#include <hip/hip_runtime.h>
#include <cstdio>
#include <cstdint>
namespace pg8 {
#define PG8_LAS __attribute__((address_space(3)))
typedef unsigned short bf16_t;
typedef short bf16x8 __attribute__((ext_vector_type(8)));
typedef float f32x4 __attribute__((ext_vector_type(4)));
typedef unsigned u32x4 __attribute__((ext_vector_type(4)));
constexpr int BM = 256, BK = 64, HALF = 128, HTB = HALF * BK * 2  , STAGE_BYTES = 8 * HTB, NXCD = 8, WGM = 8;

__host__ __device__ __forceinline__ int lds_byte(int r, int c) { const int st = (r >> 4) * 2 + (c >> 5), rr = r & 15, cc = c & 31, ob = rr * 64 + cc * 2; return st * 1024 + (ob ^ (((ob >> 9) & 1) << 5)); }
__host__ __device__ __forceinline__ void stage_rc(int b, int& R, int& C) { const int st = b / 1024, sb = b % 1024, swz = sb ^ (((sb >> 9) & 1) << 5); R = (st >> 1) * 16 + swz / 64; C = (st & 1) * 32 + (swz % 64) / 2; }
__host__ __device__ __forceinline__ int perm32(int rho) { const int n = rho >> 4, i = rho & 15; return 8 * (i >> 2) + 4 * n + (i & 3); }

struct Unit { int pm, pn; };
struct Gemm { const bf16_t* A; const bf16_t* Bt; int M, N, K; };

struct StaticOrder {
    int nM, nN, nwg, G, c;
    __host__ __device__ void init(int M, int N, int G_, int c_) { nM = M / BM; nN = N / BM; nwg = nM * nN; G = G_; c = c_; }
    __host__ __device__ bool next(int i, Unit& u) const {
        const long L = (long)i * G + c; if (L >= nwg) return false;
        int wgid = (int)L; { const int q = nwg / NXCD, r = nwg % NXCD, xcd = wgid % NXCD, off = wgid / NXCD; wgid = (xcd < r ? xcd * (q + 1) : r * (q + 1) + (xcd - r) * q) + off; }
        const int nig = WGM * nN, gid = wgid / nig, fm = gid * WGM, gsz = (nM - fm) < WGM ? (nM - fm) : WGM;
        u.pm = fm + ((wgid % nig) % gsz); u.pn = (wgid % nig) / gsz; return true;
    }
    __device__ __forceinline__ void a_ready(const Unit&) const {}
    __device__ __forceinline__ void done(const Unit&) const {}
};

typedef float f32x2 __attribute__((ext_vector_type(2)));
template <class Epi, class Sched, bool ALIGN_EPI = false, bool SP2 = false, bool I8 = false>
__device__ __forceinline__ void gemm_phase(PG8_LAS unsigned char* lds, const Gemm g, const Sched& S, const Epi& E, int wave_) {
    unsigned z_ = 0u; asm volatile("" : "+s"(z_)); int tid_ = wave_ * 64 + (int)__builtin_amdgcn_mbcnt_hi(~0u, __builtin_amdgcn_mbcnt_lo(~0u, z_)); asm volatile("" : "+v"(tid_));     int K_ = g.K; asm volatile("" : "+s"(K_));
    const int tid = tid_, wid = __builtin_amdgcn_readfirstlane(tid >> 6), lane = tid & 63, wr = wid >> 2, wc = wid & 3, fr = lane & 15, fq = lane >> 4;
    const int K = I8 ? (K_ >> 1) : K_, nt = K / BK;
    unsigned voffA[2], voffB[2];
#pragma unroll
    for (int i = 0; i < 2; ++i) { int R, C; stage_rc(tid * 16 + i * 8192, R, C); const int Rb = Epi::PERM ? ((R & ~31) + perm32(R & 31)) : R;
        voffA[i] = (unsigned)(R * K + C) * 2u; voffB[i] = (unsigned)(Rb * K + C) * 2u; }
    const size_t kstep = (size_t)(BK * 2);
    const size_t hstep = (size_t)HALF * K * 2;
    const size_t tstep = 2 * hstep;
    const unsigned ldsw = (unsigned)wid * 1024u;
    const int aoff = lds_byte(wr * 64 + fr, fq * 8), boff = lds_byte(wc * 32 + fr, fq * 8);
#define PG8_SA(b, h) (((b) * 2 + (h)) * HTB)
#define PG8_SB(b, h) ((4 + (b) * 2 + (h)) * HTB)
#define PG8_STAGE(bufoff, gbase, voff) do { _Pragma("unroll") for (int _i = 0; _i < 2; ++_i) \
        __builtin_amdgcn_global_load_lds((const unsigned*)((const char*)(gbase) + (voff)[_i]), (PG8_LAS unsigned*)(lds + (bufoff) + ldsw + _i * 8192), 16, 0, 0); } while (0)
#define PG8_LDA(dst, b, h) do { _Pragma("unroll") for (int m = 0; m < 4; ++m) _Pragma("unroll") for (int k = 0; k < 2; ++k) dst[m][k] = *(const PG8_LAS bf16x8*)(lds + PG8_SA(b, h) + aoff + m * 2048 + k * 1024); } while (0)
#define PG8_LDB(dst, b, h) do { _Pragma("unroll") for (int n = 0; n < 2; ++n) _Pragma("unroll") for (int k = 0; k < 2; ++k) dst[n][k] = *(const PG8_LAS bf16x8*)(lds + PG8_SB(b, h) + boff + n * 2048 + k * 1024); } while (0)
#define PG8_MMA(ai, bj, At, Bt) do { __builtin_amdgcn_s_setprio(1); _Pragma("unroll") for (int m = 0; m < 4; ++m) _Pragma("unroll") for (int n = 0; n < 2; ++n) _Pragma("unroll") for (int k = 0; k < 2; ++k) { \
        if constexpr (I8) { typedef int v4i_t __attribute__((ext_vector_type(4))); \
            acc[ai][bj][m][n] = __builtin_bit_cast(f32x4, __builtin_amdgcn_mfma_i32_16x16x64_i8(__builtin_bit_cast(v4i_t, Bt[n][k]), __builtin_bit_cast(v4i_t, At[m][k]), __builtin_bit_cast(v4i_t, acc[ai][bj][m][n]), 0, 0, 0)); } \
        else acc[ai][bj][m][n] = __builtin_amdgcn_mfma_f32_16x16x32_bf16(Bt[n][k], At[m][k], acc[ai][bj][m][n], 0, 0, 0); } __builtin_amdgcn_s_setprio(0); } while (0)
#define PG8_WAIT_V(n) asm volatile("s_waitcnt vmcnt(" #n ")" ::: "memory")
#define PG8_WAIT_L(n) asm volatile("s_waitcnt lgkmcnt(" #n ")" ::: "memory")
#define PG8_BAR __builtin_amdgcn_s_barrier()
#define PG8_SCHED __builtin_amdgcn_sched_barrier(0)
    Unit cur, nxt; int ui = 0;
    if (!S.next(0, cur)) return;
    cur.pm = __builtin_amdgcn_readfirstlane(cur.pm); cur.pn = __builtin_amdgcn_readfirstlane(cur.pn);
    f32x4 acc[2][2][4][2];
#pragma unroll
    for (int a = 0; a < 2; ++a)
#pragma unroll
        for (int b = 0; b < 2; ++b)
#pragma unroll
            for (int m = 0; m < 4; ++m)
#pragma unroll
                for (int n = 0; n < 2; ++n) acc[a][b][m][n] = (f32x4){0.f, 0.f, 0.f, 0.f};
    bf16x8 At[4][2], B0[2][2], B1[2][2];
    const char* cA = (const char*)g.A + (size_t)cur.pm * tstep; const char* cB = (const char*)g.Bt + (size_t)cur.pn * tstep;
    S.a_ready(cur);
    if constexpr (SP2) {
        PG8_STAGE(PG8_SB(0, 0), cB, voffB); PG8_STAGE(PG8_SB(0, 1), cB + hstep, voffB); PG8_STAGE(PG8_SA(0, 0), cA, voffA); PG8_STAGE(PG8_SA(0, 1), cA + hstep, voffA);
        if (wr == 1) PG8_BAR;
        PG8_WAIT_V(2); PG8_BAR;
        PG8_STAGE(PG8_SB(1, 0), cB + kstep, voffB); PG8_STAGE(PG8_SA(1, 0), cA + kstep, voffA); PG8_STAGE(PG8_SB(1, 1), cB + hstep + kstep, voffB);
        PG8_WAIT_V(6); PG8_BAR;
    } else {
        PG8_STAGE(PG8_SB(0, 0), cB, voffB); PG8_STAGE(PG8_SA(0, 0), cA, voffA); PG8_STAGE(PG8_SB(0, 1), cB + hstep, voffB); PG8_STAGE(PG8_SA(0, 1), cA + hstep, voffA);
        if (wr == 1) PG8_BAR;
        PG8_WAIT_V(4); PG8_BAR;
        PG8_STAGE(PG8_SB(1, 0), cB + kstep, voffB); PG8_STAGE(PG8_SA(1, 0), cA + kstep, voffA); PG8_STAGE(PG8_SB(1, 1), cB + hstep + kstep, voffB);
        PG8_WAIT_V(6); PG8_BAR;
    }
    for (;;) {
        const bool has_next = S.next(ui + 1, nxt);
        nxt.pm = __builtin_amdgcn_readfirstlane(nxt.pm); nxt.pn = __builtin_amdgcn_readfirstlane(nxt.pn);
        const char* nA = has_next ? (const char*)g.A + (size_t)nxt.pm * tstep : cA; const char* nB = has_next ? (const char*)g.Bt + (size_t)nxt.pn * tstep : cB;
        for (int t = 0; t < nt; t += 2) {
            const bool last = (t == nt - 2);
            const char* a1 = cA + (size_t)(t + 1) * kstep;
            const char* a2 = last ? nA : cA + (size_t)(t + 2) * kstep; const char* b2 = last ? nB : cB + (size_t)(t + 2) * kstep;
            const char* a3 = a2 + kstep; const char* b3 = b2 + kstep;
            if (last && has_next) S.a_ready(nxt);
            if constexpr (SP2) {
            PG8_LDB(B0, 0, 0); PG8_LDB(B1, 0, 1); PG8_SCHED; PG8_LDA(At, 0, 0); PG8_STAGE(PG8_SA(1, 1), a1 + hstep, voffA);
            PG8_WAIT_V(8); PG8_WAIT_L(0); PG8_BAR; PG8_MMA(0, 0, At, B0); PG8_MMA(0, 1, At, B1); PG8_BAR; PG8_SCHED;
            PG8_LDA(At, 0, 1); PG8_STAGE(PG8_SB(0, 0), b2, voffB); PG8_STAGE(PG8_SB(0, 1), b2 + hstep, voffB); PG8_STAGE(PG8_SA(0, 0), a2, voffA);
            PG8_WAIT_V(8); PG8_WAIT_L(0); PG8_BAR; PG8_MMA(1, 0, At, B0); PG8_MMA(1, 1, At, B1); PG8_BAR; PG8_SCHED;
            PG8_LDB(B0, 1, 0); PG8_LDB(B1, 1, 1); PG8_SCHED; PG8_LDA(At, 1, 0); PG8_STAGE(PG8_SA(0, 1), a2 + hstep, voffA);
            PG8_WAIT_V(8); PG8_WAIT_L(0); PG8_BAR; PG8_MMA(0, 0, At, B0); PG8_MMA(0, 1, At, B1); PG8_BAR; PG8_SCHED;
            PG8_LDA(At, 1, 1); PG8_STAGE(PG8_SB(1, 0), b3, voffB); PG8_STAGE(PG8_SB(1, 1), b3 + hstep, voffB); PG8_STAGE(PG8_SA(1, 0), a3, voffA);
            PG8_WAIT_V(8); PG8_WAIT_L(0); PG8_BAR; PG8_MMA(1, 0, At, B0); PG8_MMA(1, 1, At, B1); PG8_BAR; PG8_SCHED;
            } else {
            PG8_LDB(B0, 0, 0); PG8_SCHED; PG8_LDA(At, 0, 0); PG8_STAGE(PG8_SA(1, 1), a1 + hstep, voffA);
            PG8_WAIT_L(8); PG8_BAR; PG8_WAIT_L(0); PG8_MMA(0, 0, At, B0); PG8_BAR; PG8_SCHED;
            PG8_LDB(B1, 0, 1); PG8_STAGE(PG8_SB(0, 0), b2, voffB);
            PG8_BAR; PG8_WAIT_L(0); PG8_MMA(0, 1, At, B1); PG8_BAR;
            PG8_LDA(At, 0, 1); PG8_STAGE(PG8_SA(0, 0), a2, voffA);
            PG8_BAR; PG8_WAIT_L(0); PG8_MMA(1, 0, At, B0); PG8_BAR; PG8_SCHED;
            PG8_STAGE(PG8_SB(0, 1), b2 + hstep, voffB);
            PG8_WAIT_V(6); PG8_BAR; PG8_MMA(1, 1, At, B1); PG8_BAR;
            PG8_LDB(B0, 1, 0); PG8_SCHED; PG8_LDA(At, 1, 0); PG8_STAGE(PG8_SA(0, 1), a2 + hstep, voffA);
            PG8_WAIT_L(8); PG8_BAR; PG8_WAIT_L(0); PG8_MMA(0, 0, At, B0); PG8_BAR; PG8_SCHED;
            PG8_LDB(B1, 1, 1); PG8_STAGE(PG8_SB(1, 0), b3, voffB);
            PG8_BAR; PG8_WAIT_L(0); PG8_MMA(0, 1, At, B1); PG8_BAR;
            PG8_LDA(At, 1, 1); PG8_STAGE(PG8_SA(1, 0), a3, voffA);
            PG8_BAR; PG8_WAIT_L(0); PG8_MMA(1, 0, At, B0); PG8_BAR; PG8_SCHED;
            PG8_STAGE(PG8_SB(1, 1), b3 + hstep, voffB);
            PG8_WAIT_V(6); PG8_BAR; PG8_MMA(1, 1, At, B1); PG8_BAR;
            }
        }
        if constexpr (ALIGN_EPI) { if (wr == 0) PG8_BAR; }
        if constexpr (I8) {
#pragma unroll
            for (int a = 0; a < 2; ++a)
#pragma unroll
                for (int m = 0; m < 4; ++m) { const float r_ = E.rowscale(cur.pm * BM + wr * 64 + fr + a * HALF + m * 16);
#pragma unroll
                    for (int b = 0; b < 2; ++b)
#pragma unroll
                        for (int n = 0; n < 2; ++n) { typedef int v4i2_t __attribute__((ext_vector_type(4))); const v4i2_t i_ = __builtin_bit_cast(v4i2_t, acc[a][b][m][n]);
                            acc[a][b][m][n] = (f32x4){(float)i_[0] * r_, (float)i_[1] * r_, (float)i_[2] * r_, (float)i_[3] * r_}; } }
        }
        if constexpr (!Epi::AFTER_DRAIN) { E(acc, cur, wr, wc, fr, fq); S.done(cur); }
        if (!has_next) break;
#pragma unroll
        for (int a = 0; a < 2; ++a)
#pragma unroll
            for (int b = 0; b < 2; ++b)
#pragma unroll
                for (int m = 0; m < 4; ++m)
#pragma unroll
                    for (int n = 0; n < 2; ++n) acc[a][b][m][n] = (f32x4){0.f, 0.f, 0.f, 0.f};
        cur = nxt; cA = nA; cB = nB; ++ui;
        if constexpr (ALIGN_EPI) { if (wr == 1) PG8_BAR; }
    }
    PG8_WAIT_V(0);
    if constexpr (!ALIGN_EPI) { if (wr == 0) PG8_BAR; }
    PG8_BAR;
    if constexpr (Epi::AFTER_DRAIN) { E.fused(acc, cur, wr, wc, fr, fq, lds, wid, lane); S.done(cur); }
#undef PG8_SA
#undef PG8_SB
#undef PG8_STAGE
#undef PG8_LDA
#undef PG8_LDB
#undef PG8_MMA
#undef PG8_WAIT_V
#undef PG8_WAIT_L
#undef PG8_BAR
#undef PG8_SCHED
}
}
#define XB_TMO      128
#define XB_XCNT(j)  (256  + 64 * (j))
#define XB_XSUB(j)  (1280 + 64 * (j))
#define XB_XGEN(j)  (2304 + 64 * (j))
#define XB_TOP      3328
#define XB_TOPGEN   3392
#define XCD_BAR_WORDS 3456
#define XB_SPIN_CAP (1u << 24)
#define LAS __attribute__((address_space(3)))

__device__ __forceinline__ unsigned xb_ld(unsigned* p)              { return __hip_atomic_load(p, __ATOMIC_RELAXED, __HIP_MEMORY_SCOPE_AGENT); }
__device__ __forceinline__ unsigned xb_add(unsigned* p, unsigned v) { return __hip_atomic_fetch_add(p, v, __ATOMIC_RELAXED, __HIP_MEMORY_SCOPE_AGENT); }
__device__ __forceinline__ unsigned xb_xcc_id() { return (unsigned)__builtin_amdgcn_s_getreg((3 << 11) | 20) & 0xFu; }
#define XB_SPIN(cond, bar) do { unsigned _sp = 0; while (cond) { __builtin_amdgcn_s_sleep(1); \
    if ((++_sp & 255u) == 0u) { if (xb_ld(&(bar)[XB_TMO])) break; if (_sp > XB_SPIN_CAP) { atomicAdd(&(bar)[XB_TMO], 1u); break; } } } } while (0)

__device__ __forceinline__ int xb_lane_id() { unsigned z = 0u; asm volatile("" : "+s"(z)); return (int)__builtin_amdgcn_mbcnt_hi(~0u, __builtin_amdgcn_mbcnt_lo(~0u, z)); }
struct XcdBarrier {
    unsigned w0;
    unsigned* bar; unsigned x;
    volatile LAS unsigned* st;
};

__device__ __forceinline__ XcdBarrier xcd_barrier_post(unsigned* bar, volatile LAS unsigned* st) {
    XcdBarrier b; b.bar = bar; b.x = xb_xcc_id(); b.st = st; b.w0 = (__builtin_amdgcn_readfirstlane((int)threadIdx.x >> 6) == 0) ? 1u : 0u;
    if (b.w0 && xb_lane_id() == 0) (void)xb_add(&bar[XB_XCNT(b.x)], 1u);
    return b;
}
__device__ __forceinline__ void xcd_barrier_complete(unsigned* bar, unsigned x, unsigned& nloc, unsigned& nx) {
    const unsigned G = gridDim.x * gridDim.y * gridDim.z;
    unsigned sum, cnt, mine, sp = 0u;
    for (;;) {
        sum = 0u; cnt = 0u; mine = 0u;
#pragma unroll
        for (unsigned j = 0; j < 16; ++j) { const unsigned c = xb_ld(&bar[XB_XCNT(j)]); sum += c; cnt += (c > 0u) ? 1u : 0u; mine = (j == x) ? c : mine; }
        if (sum == G) break;
        __builtin_amdgcn_s_sleep(1);
        if ((++sp & 255u) == 0u) { if (xb_ld(&bar[XB_TMO])) break; if (sp > XB_SPIN_CAP) { atomicAdd(&bar[XB_TMO], 1u); break; } }
    }
    nloc = mine > 0u ? mine : 1u; nx = cnt > 0u ? cnt : 1u;
}

__device__ __forceinline__ void xcd_barrier(const XcdBarrier& b) {
    asm volatile("s_waitcnt vmcnt(0)" ::: "memory");
    __syncthreads();
    if (b.w0 && xb_lane_id() == 0) {
        unsigned* bar = b.bar;
        __builtin_amdgcn_s_waitcnt(0);
        unsigned nloc = b.st[0], nx = b.st[1];
        if (nloc == 0u) { xcd_barrier_complete(bar, b.x, nloc, nx); b.st[0] = nloc; b.st[1] = nx; }
        const unsigned old = xb_add(&bar[XB_XSUB(b.x)], 1u);
        const unsigned gen = old / nloc;
        if (old + 1u == (gen + 1u) * nloc) {
            __builtin_amdgcn_fence(__ATOMIC_RELEASE, "agent");
            asm volatile("s_waitcnt vmcnt(0)" ::: "memory");
            const unsigned og = xb_add(&bar[XB_TOP], 1u);
            const unsigned tg = og / nx;
            if (og + 1u == (tg + 1u) * nx) xb_add(&bar[XB_TOPGEN], 1u);
            else XB_SPIN(xb_ld(&bar[XB_TOPGEN]) == tg, bar);
            __builtin_amdgcn_fence(__ATOMIC_ACQUIRE, "agent");
            xb_add(&bar[XB_XGEN(b.x)], 1u);
            asm volatile("s_waitcnt vmcnt(0)" ::: "memory");
        } else {
            XB_SPIN(xb_ld(&bar[XB_XGEN(b.x)]) == gen, bar);
            __builtin_amdgcn_fence(__ATOMIC_ACQUIRE, "agent");
            asm volatile("s_waitcnt vmcnt(0)" ::: "memory");
        }
    }
    __syncthreads();
}


#define GAS __attribute__((address_space(1)))
typedef unsigned short bf16;
typedef unsigned v4u __attribute__((ext_vector_type(4)));
typedef unsigned v2u __attribute__((ext_vector_type(2)));
typedef float f32x4 __attribute__((ext_vector_type(4)));
typedef float f32x2v __attribute__((ext_vector_type(2)));
typedef float f32x16 __attribute__((ext_vector_type(16)));
typedef short bf16x8 __attribute__((ext_vector_type(8)));
typedef __bf16 bf16v2 __attribute__((ext_vector_type(2)));
typedef _Float16 h2_t __attribute__((ext_vector_type(2)));
typedef _Float16 v32h_t __attribute__((ext_vector_type(32)));
typedef unsigned v6u __attribute__((ext_vector_type(6)));

constexpr int NTOK = 16384, DM = 2048, SEQ = 4096, INW = 15360, BW = 1024;
constexpr float EPS = 1e-6f;
constexpr float WIN_QS = 1024.0f;
constexpr int NPH = 13;
constexpr int NPHASES = 2 * NPH;

constexpr size_t MiB = 1u << 20;
constexpr size_t WS_CTL = 0;
constexpr size_t WS_LB = 1 * MiB;
constexpr size_t WS_SA = 1 * MiB + 192 * 1024;
constexpr size_t WS_US = 1 * MiB + 64 * 1024, WS_VS = 1 * MiB + 128 * 1024;
constexpr size_t WS_WIN = 2 * MiB;
constexpr size_t WS_WBR = 62 * MiB;
constexpr size_t WS_WO = 74 * MiB;
constexpr size_t WS_WQ = 82 * MiB;
constexpr size_t WS_U = 91 * MiB;
constexpr size_t WS_V = 155 * MiB;
constexpr size_t WS_H = 219 * MiB;
constexpr size_t WS_SEG = 283 * MiB;
constexpr size_t WS_GATE = 539 * MiB;
constexpr size_t WS_X2 = 731 * MiB;
constexpr size_t WS_CONV = 859 * MiB;
constexpr size_t WS_HGR = 891 * MiB;
constexpr size_t WS_MERGED = 923 * MiB;
constexpr size_t WS_SEL = 987 * MiB;
constexpr size_t WS_SELS = 1003 * MiB;
constexpr size_t WS_DEC = 1004 * MiB;
constexpr size_t WS_END = 1005 * MiB;
constexpr size_t WS_ST = WS_H;
constexpr size_t WS_KEYS = 90 * MiB;
constexpr size_t WS_PART = WS_GATE;
constexpr size_t WS_QPEER = WS_SEG;
constexpr size_t SEGSZ = (size_t)NTOK * 1024;
constexpr int CW_BAR = 4096;
constexpr int CW_RANK = 131072;

constexpr int RING_BYTES = 131072, MISC_OFF = RING_BYTES + 320, LDS_BYTES = 147456;

__device__ __forceinline__ unsigned pk2c(float lo, float hi) { f32x2v v = {lo, hi}; bf16v2 b = __builtin_convertvector(v, bf16v2); return __builtin_bit_cast(unsigned, b); }
__device__ __forceinline__ float bflo(unsigned x) { return __uint_as_float(x << 16); }
__device__ __forceinline__ float bfhi(unsigned x) { return __uint_as_float(x & 0xffff0000u); }
__device__ __forceinline__ float sigm(float x) { return __builtin_amdgcn_rcpf(1.0f + __expf(-x)); }
__device__ __forceinline__ float wave_sum(float v) {
#pragma unroll
    for (int o = 1; o < 64; o <<= 1) v += __shfl_xor(v, o);
    return v;
}
__device__ __forceinline__ float wave_max(float v) {
#pragma unroll
    for (int o = 1; o < 64; o <<= 1) v = fmaxf(v, __shfl_xor(v, o));
    return v;
}
#define LDS_WAIT() asm volatile("s_waitcnt lgkmcnt(0)" ::: "memory")
#define MFMA32(a, b, c) __builtin_amdgcn_mfma_f32_32x32x16_bf16((a), (b), (c), 0, 0, 0)
__device__ __forceinline__ int ridx16(int lane) { return ((lane >> 5) & 1) * 8 + ((lane >> 4) & 1) * 4 + ((lane >> 3) & 1) * 2 + ((lane >> 2) & 1); }
__device__ __forceinline__ void xreduce16(float (&v)[16], int lane) {
#pragma unroll
    for (int i = 0; i < 8; ++i) { const bool up = (lane & 32) != 0; const float snd = up ? v[i] : v[i + 8], kp = up ? v[i + 8] : v[i]; v[i] = kp + __shfl_xor(snd, 32); }
#pragma unroll
    for (int i = 0; i < 4; ++i) { const bool up = (lane & 16) != 0; const float snd = up ? v[i] : v[i + 4], kp = up ? v[i + 4] : v[i]; v[i] = kp + __shfl_xor(snd, 16); }
#pragma unroll
    for (int i = 0; i < 2; ++i) { const bool up = (lane & 8) != 0; const float snd = up ? v[i] : v[i + 2], kp = up ? v[i + 2] : v[i]; v[i] = kp + __shfl_xor(snd, 8); }
    { const bool up = (lane & 4) != 0; const float snd = up ? v[0] : v[1], kp = up ? v[1] : v[0]; v[0] = kp + __shfl_xor(snd, 4); }
    v[0] += __shfl_xor(v[0], 2); v[0] += __shfl_xor(v[0], 1);
}
__device__ __forceinline__ float gelu_exact(float v) {
    const float av = fabsf(v), t = __builtin_amdgcn_rcpf(av * 0.2316418882f + 1.0f);
    float q = t * 0.5307027145f + (-0.7265760135f); q = q * t + 0.7107068705f; q = q * t + (-0.142248368f); q = q * t + 0.127414796f; q = q * t;
    const float e = __builtin_amdgcn_exp2f((v * v) * (-0.72134752044f));
    const float m = v * (q * e);
    return v < 0.f ? m : v - m;
}

struct Ctx { LAS unsigned char* lds; int tid, lane, wave, G, gw, NGW; };

__device__ __forceinline__ void tr_item(const float* W, int K, int N, bf16* WT, int k0, int n0, int drow0, LAS float* scr, int lane) {
    { const int lr = lane >> 3, lc = (lane & 7) * 4; f32x4 v[8];
#pragma unroll
      for (int j = 0; j < 8; ++j) v[j] = *(const GAS f32x4*)(W + (size_t)(k0 + lr + 8 * j) * N + n0 + lc);
#pragma unroll
      for (int j = 0; j < 8; ++j) { LAS float* d = scr + (lr + 8 * j) * 33 + lc; d[0] = v[j].x; d[1] = v[j].y; d[2] = v[j].z; d[3] = v[j].w; } }
    LDS_WAIT();
    const int c = lane & 7;
#pragma unroll
    for (int j = 0; j < 4; ++j) { const int n = (lane >> 3) + 8 * j; const LAS float* s = scr + (8 * c) * 33 + n;
        v4u o; o.x = pk2c(s[0], s[33]); o.y = pk2c(s[66], s[99]); o.z = pk2c(s[132], s[165]); o.w = pk2c(s[198], s[231]);
        *(GAS v4u*)(WT + (size_t)(drow0 + n) * K + k0 + 8 * c) = o; }
    LDS_WAIT();
}
__device__ __forceinline__ unsigned pack_i8x4c(float a, float b, float c, float d) {
    const int ia = (int)__builtin_rintf(fminf(fmaxf(a, -127.f), 127.f)), ib = (int)__builtin_rintf(fminf(fmaxf(b, -127.f), 127.f)), ic = (int)__builtin_rintf(fminf(fmaxf(c, -127.f), 127.f)), id = (int)__builtin_rintf(fminf(fmaxf(d, -127.f), 127.f));
    return ((unsigned)ia & 255u) | (((unsigned)ib & 255u) << 8) | (((unsigned)ic & 255u) << 16) | ((unsigned)id << 24);
}
__device__ __forceinline__ void tr_item_i8(const float* W, int K, int N, unsigned char* WT, int k0, int n0, int drow0, float scale, LAS float* scr, int lane) {
    { const int lr = lane >> 3, lc = (lane & 7) * 4; f32x4 v[16];
#pragma unroll
      for (int j = 0; j < 16; ++j) v[j] = *(const GAS f32x4*)(W + (size_t)(k0 + lr + 8 * j) * N + n0 + lc);
#pragma unroll
      for (int j = 0; j < 16; ++j) { LAS float* d = scr + (lr + 8 * j) * 32 + (lc ^ ((j & 7) << 2)); const int x = lr & 3; d[x] = v[j].x; d[1 ^ x] = v[j].y; d[2 ^ x] = v[j].z; d[3 ^ x] = v[j].w; } }
    LDS_WAIT();
    const int c = lane & 15;
#pragma unroll
    for (int j = 0; j < 8; ++j) { const int n = (lane >> 4) + 4 * j, q = n ^ ((c & 7) << 2); const LAS float* s = scr + (8 * c) * 32;
        v2u o; o.x = pack_i8x4c(s[q] * scale, s[32 + (q ^ 1)] * scale, s[64 + (q ^ 2)] * scale, s[96 + (q ^ 3)] * scale); o.y = pack_i8x4c(s[128 + q] * scale, s[160 + (q ^ 1)] * scale, s[192 + (q ^ 2)] * scale, s[224 + (q ^ 3)] * scale);
        *(GAS v2u*)(WT + (size_t)(drow0 + n) * K + k0 + 8 * c) = o; }
    LDS_WAIT();
}
__device__ __forceinline__ int win_drow(int n) { if (n < 7168 || n >= 9216) return n; const int r = n - 7168, isb = r >> 10, c = r & 1023; return 7168 + (c >> 7) * 256 + isb * 128 + (c & 127); }
__device__ __forceinline__ void cvt_copy(const Ctx& c, const float* src, bf16* dst, size_t n8) {
    const size_t NT = (size_t)c.G * 512;
    for (size_t i = (size_t)blockIdx.x * 512 + c.tid; i < n8; i += NT) {
        const f32x4 a = ((const GAS f32x4*)src)[2 * i], b = ((const GAS f32x4*)src)[2 * i + 1];
        v4u o; o.x = pk2c(a.x, a.y); o.y = pk2c(a.z, a.w); o.z = pk2c(b.x, b.y); o.w = pk2c(b.z, b.w);
        ((GAS v4u*)dst)[i] = o;
    }
}
__device__ __forceinline__ void rms_row(const float* xr, const float* w, bf16* o, int lane) {
    const GAS f32x4* xp = (const GAS f32x4*)xr + lane; f32x4 v[8]; float s = 0.f;
#pragma unroll
    for (int j = 0; j < 8; ++j) { v[j] = xp[64 * j]; s += (v[j].x * v[j].x + v[j].y * v[j].y) + (v[j].z * v[j].z + v[j].w * v[j].w); }
    const float r = __builtin_amdgcn_rsqf(wave_sum(s) * (1.0f / DM) + EPS);
    const GAS f32x4* wp = (const GAS f32x4*)w + lane; GAS v2u* op = (GAS v2u*)o + lane;
#pragma unroll
    for (int j = 0; j < 8; ++j) { const f32x4 wv = wp[64 * j]; v2u q; q.x = pk2c(v[j].x * r * wv.x, v[j].y * r * wv.y); q.y = pk2c(v[j].z * r * wv.z, v[j].w * r * wv.w); op[64 * j] = q; }
}
__device__ __forceinline__ void rms_row_i8(const float* xr, const float* w, unsigned char* o, float* sa, int lane) {
    const GAS f32x4* xp = (const GAS f32x4*)xr + lane; f32x4 v[8]; float s = 0.f;
#pragma unroll
    for (int j = 0; j < 8; ++j) { v[j] = xp[64 * j]; s += (v[j].x * v[j].x + v[j].y * v[j].y) + (v[j].z * v[j].z + v[j].w * v[j].w); }
    const float r = __builtin_amdgcn_rsqf(wave_sum(s) * (1.0f / DM) + EPS);
    const GAS f32x4* wp = (const GAS f32x4*)w + lane; float m = 0.f;
#pragma unroll
    for (int j = 0; j < 8; ++j) { const f32x4 wv = wp[64 * j]; v[j].x *= r * wv.x; v[j].y *= r * wv.y; v[j].z *= r * wv.z; v[j].w *= r * wv.w;
        m = fmaxf(fmaxf(m, fmaxf(fabsf(v[j].x), fabsf(v[j].y))), fmaxf(fabsf(v[j].z), fabsf(v[j].w))); }
    m = wave_max(m);
    const float inv = m > 0.f ? 127.0f / m : 0.f;
    if (lane == 0) *(GAS float*)sa = m * (1.0f / 127.0f);
#pragma unroll
    for (int j = 0; j < 8; ++j) ((GAS unsigned*)o)[lane + 64 * j] = pack_i8x4c(v[j].x * inv, v[j].y * inv, v[j].z * inv, v[j].w * inv);
}
__device__ __forceinline__ void rms_rows2_i8(const float* xa, const float* xb, const float* w, unsigned char* oa, unsigned char* ob, float* saa, float* sab, int lane) {
    const GAS f32x4* pa = (const GAS f32x4*)xa + lane; const GAS f32x4* pb = (const GAS f32x4*)xb + lane; f32x4 va[8], vb[8]; float s0 = 0.f, s1 = 0.f;
#pragma unroll
    for (int j = 0; j < 8; ++j) { va[j] = pa[64 * j]; vb[j] = pb[64 * j]; }
#pragma unroll
    for (int j = 0; j < 8; ++j) { s0 += (va[j].x * va[j].x + va[j].y * va[j].y) + (va[j].z * va[j].z + va[j].w * va[j].w); s1 += (vb[j].x * vb[j].x + vb[j].y * vb[j].y) + (vb[j].z * vb[j].z + vb[j].w * vb[j].w); }
#pragma unroll
    for (int o = 1; o < 64; o <<= 1) { s0 += __shfl_xor(s0, o); s1 += __shfl_xor(s1, o); }
    const float r0 = __builtin_amdgcn_rsqf(s0 * (1.0f / DM) + EPS), r1 = __builtin_amdgcn_rsqf(s1 * (1.0f / DM) + EPS);
    const GAS f32x4* wp = (const GAS f32x4*)w + lane; float m0 = 0.f, m1 = 0.f;
#pragma unroll
    for (int j = 0; j < 8; ++j) { const f32x4 wv = wp[64 * j];
        va[j].x *= r0 * wv.x; va[j].y *= r0 * wv.y; va[j].z *= r0 * wv.z; va[j].w *= r0 * wv.w; vb[j].x *= r1 * wv.x; vb[j].y *= r1 * wv.y; vb[j].z *= r1 * wv.z; vb[j].w *= r1 * wv.w;
        m0 = fmaxf(fmaxf(m0, fmaxf(fabsf(va[j].x), fabsf(va[j].y))), fmaxf(fabsf(va[j].z), fabsf(va[j].w))); m1 = fmaxf(fmaxf(m1, fmaxf(fabsf(vb[j].x), fabsf(vb[j].y))), fmaxf(fabsf(vb[j].z), fabsf(vb[j].w))); }
#pragma unroll
    for (int o = 1; o < 64; o <<= 1) { m0 = fmaxf(m0, __shfl_xor(m0, o)); m1 = fmaxf(m1, __shfl_xor(m1, o)); }
    const float i0 = m0 > 0.f ? 127.0f / m0 : 0.f, i1 = m1 > 0.f ? 127.0f / m1 : 0.f;
    if (lane == 0) { *(GAS float*)saa = m0 * (1.0f / 127.0f); *(GAS float*)sab = m1 * (1.0f / 127.0f); }
#pragma unroll
    for (int j = 0; j < 8; ++j) { ((GAS unsigned*)oa)[lane + 64 * j] = pack_i8x4c(va[j].x * i0, va[j].y * i0, va[j].z * i0, va[j].w * i0); ((GAS unsigned*)ob)[lane + 64 * j] = pack_i8x4c(vb[j].x * i1, vb[j].y * i1, vb[j].z * i1, vb[j].w * i1); }
}
__device__ __forceinline__ void rms_phase_i8(const Ctx& c, const float* x, const float* w, unsigned char* H8, float* SA) {
    for (int m = c.gw; m < NTOK / 2; m += c.NGW) rms_rows2_i8(x + (size_t)m * DM, x + (size_t)(m + NTOK / 2) * DM, w, H8 + (size_t)m * DM, H8 + (size_t)(m + NTOK / 2) * DM, SA + m, SA + m + NTOK / 2, c.lane);
}
__device__ __forceinline__ void rms_rows2(const float* xa, const float* xb, const float* w, bf16* oa, bf16* ob, int lane) {
    const GAS f32x4* pa = (const GAS f32x4*)xa + lane; const GAS f32x4* pb = (const GAS f32x4*)xb + lane; f32x4 va[8], vb[8]; float sa = 0.f, sb = 0.f;
#pragma unroll
    for (int j = 0; j < 8; ++j) { va[j] = pa[64 * j]; vb[j] = pb[64 * j]; }
#pragma unroll
    for (int j = 0; j < 8; ++j) { sa += (va[j].x * va[j].x + va[j].y * va[j].y) + (va[j].z * va[j].z + va[j].w * va[j].w); sb += (vb[j].x * vb[j].x + vb[j].y * vb[j].y) + (vb[j].z * vb[j].z + vb[j].w * vb[j].w); }
#pragma unroll
    for (int o = 1; o < 64; o <<= 1) { sa += __shfl_xor(sa, o); sb += __shfl_xor(sb, o); }
    const float ra = __builtin_amdgcn_rsqf(sa * (1.0f / DM) + EPS), rb = __builtin_amdgcn_rsqf(sb * (1.0f / DM) + EPS);
    const GAS f32x4* wp = (const GAS f32x4*)w + lane; GAS v2u* qa = (GAS v2u*)oa + lane; GAS v2u* qb = (GAS v2u*)ob + lane;
#pragma unroll
    for (int j = 0; j < 8; ++j) { const f32x4 wv = wp[64 * j];
        v2u q; q.x = pk2c(va[j].x * ra * wv.x, va[j].y * ra * wv.y); q.y = pk2c(va[j].z * ra * wv.z, va[j].w * ra * wv.w); qa[64 * j] = q;
        v2u p; p.x = pk2c(vb[j].x * rb * wv.x, vb[j].y * rb * wv.y); p.y = pk2c(vb[j].z * rb * wv.z, vb[j].w * rb * wv.w); qb[64 * j] = p; }
}
__device__ __forceinline__ void rms_phase(const Ctx& c, const float* x, const float* w, bf16* H) {
    for (int m = c.gw; m < NTOK / 2; m += c.NGW) rms_rows2(x + (size_t)m * DM, x + (size_t)(m + NTOK / 2) * DM, w, H + (size_t)m * DM, H + (size_t)(m + NTOK / 2) * DM, c.lane);
}
__device__ __forceinline__ void fp8_row(const float* src, unsigned char* dst, float* scale_out, int lane) {
    const GAS f32x4* xp = (const GAS f32x4*)src + lane; f32x4 v[8]; float m = 0.f;
#pragma unroll
    for (int j = 0; j < 8; ++j) { v[j] = xp[64 * j]; m = fmaxf(fmaxf(m, fmaxf(fabsf(v[j].x), fabsf(v[j].y))), fmaxf(fabsf(v[j].z), fabsf(v[j].w))); }
    m = wave_max(m);
    const float inv = m > 0.f ? 256.0f / m : 0.f;
    if (lane == 0) *(GAS float*)scale_out = m * (1.0f / 256.0f);
#pragma unroll
    for (int j = 0; j < 8; ++j) { int p = __builtin_amdgcn_cvt_pk_fp8_f32(v[j].x * inv, v[j].y * inv, 0, false); p = __builtin_amdgcn_cvt_pk_fp8_f32(v[j].z * inv, v[j].w * inv, p, true);
        ((GAS unsigned*)dst)[lane + 64 * j] = (unsigned)p; }
}
constexpr size_t U8_SLICE = (size_t)16384 * 128;
__device__ __forceinline__ unsigned pack_i8x4(float a, float b, float c, float d) {
    const int ia = (int)__builtin_rintf(a), ib = (int)__builtin_rintf(b), ic = (int)__builtin_rintf(c), id = (int)__builtin_rintf(d);
    return ((unsigned)ia & 255u) | (((unsigned)ib & 255u) << 8) | (((unsigned)ic & 255u) << 16) | ((unsigned)id << 24);
}
__device__ __forceinline__ void row_load_strided(const float* src, int lane, f32x4 (&v)[8]) { const GAS f32x4* xp = (const GAS f32x4*)src + lane;
#pragma unroll
    for (int j = 0; j < 8; ++j) v[j] = xp[64 * j]; }
__device__ __forceinline__ void row_load_contig(const float* src, int lane, f32x4 (&v)[8]) { const GAS f32x4* xp = (const GAS f32x4*)src + 8 * lane;
#pragma unroll
    for (int j = 0; j < 8; ++j) v[j] = xp[j]; }
__device__ __forceinline__ void i8_row(const f32x4 (&v)[8], unsigned char* dst, float* scale_out, int lane) {
    float m = 0.f;
#pragma unroll
    for (int j = 0; j < 8; ++j) m = fmaxf(fmaxf(m, fmaxf(fabsf(v[j].x), fabsf(v[j].y))), fmaxf(fabsf(v[j].z), fabsf(v[j].w)));
    m = wave_max(m);
    const float inv = m > 0.f ? 127.0f / m : 0.f;
    if (lane == 0) *(GAS float*)scale_out = m * (1.0f / 127.0f);
#pragma unroll
    for (int j = 0; j < 8; ++j) *(GAS unsigned*)(dst + (size_t)(2 * j + (lane >> 5)) * U8_SLICE + 4 * (lane & 31)) = pack_i8x4(v[j].x * inv, v[j].y * inv, v[j].z * inv, v[j].w * inv);
}
constexpr size_t V6_SLICE = (size_t)16384 * 192;
__device__ __forceinline__ void fp6_row(const f32x4 (&v)[8], unsigned char* dst, float* scale_out, int lane) {
    float m = 0.f;
#pragma unroll
    for (int j = 0; j < 8; ++j) m = fmaxf(fmaxf(m, fmaxf(fabsf(v[j].x), fabsf(v[j].y))), fmaxf(fabsf(v[j].z), fabsf(v[j].w)));
    m = wave_max(m);
    const float inv = m > 0.f ? 7.5f / m : 0.f;
    if (lane == 0) *(GAS float*)scale_out = m * (1.0f / 7.5f);
    v32h_t h;
#pragma unroll
    for (int j = 0; j < 8; ++j) { h[4 * j] = (_Float16)(v[j].x * inv); h[4 * j + 1] = (_Float16)(v[j].y * inv); h[4 * j + 2] = (_Float16)(v[j].z * inv); h[4 * j + 3] = (_Float16)(v[j].w * inv); }
    const v6u q = __builtin_amdgcn_cvt_scalef32_pk32_fp6_f16(h, 1.0f);
    GAS v2u* o = (GAS v2u*)(dst + (size_t)(lane >> 3) * V6_SLICE + 24 * (lane & 7));
    o[0] = (v2u){q[0], q[1]}; o[1] = (v2u){q[2], q[3]}; o[2] = (v2u){q[4], q[5]};
}
struct P0Args { const float *w_in, *w_br_sb, *w_br_hg, *w_br_conv, *w_o, *w_q, *u, *v, *lbp; bf16 *WinT, *WbrT, *WoT, *WqT; unsigned char *U, *V; float *US, *VS; float* LB; int layer; const float *k1, *k2; bf16* KB; };
__device__ __forceinline__ void p0_convert(const Ctx& c, const P0Args& a, int parts = 7) {
    LAS float* scr = (LAS float*)(c.lds + c.wave * 16384);
    constexpr int I_IN = (DM / 128) * (INW / 32), I_BR = (BW / 64) * (DM / 32), I_SQ = (DM / 64) * (DM / 32);
    constexpr int I_Q8 = (DM / 128) * (DM / 32);
    constexpr int NITEMS = I_IN + 3 * I_BR + I_SQ + I_Q8;
    if (parts & 1)
    for (int it = c.gw; it < NITEMS; it += c.NGW) {
        int r = it;
        if (r < I_IN) { const int kb = r / (INW / 32), nb = r % (INW / 32); tr_item_i8(a.w_in, DM, INW, (unsigned char*)a.WinT, kb * 128, nb * 32, win_drow(nb * 32), WIN_QS, scr, c.lane); continue; } r -= I_IN;
        if (r < I_BR) { const int kb = r / (DM / 32), nb = r % (DM / 32); tr_item(a.w_br_sb, BW, DM, a.WbrT, kb * 64, nb * 32, nb * 32, scr, c.lane); continue; } r -= I_BR;
        if (r < I_BR) { const int kb = r / (DM / 32), nb = r % (DM / 32); tr_item(a.w_br_hg, BW, DM, a.WbrT + (size_t)DM * BW, kb * 64, nb * 32, nb * 32, scr, c.lane); continue; } r -= I_BR;
        if (r < I_BR) { const int kb = r / (DM / 32), nb = r % (DM / 32); tr_item(a.w_br_conv, BW, DM, a.WbrT + (size_t)2 * DM * BW, kb * 64, nb * 32, nb * 32, scr, c.lane); continue; } r -= I_BR;
        if (r < I_SQ) { const int kb = r / (DM / 32), nb = r % (DM / 32); tr_item(a.w_o, DM, DM, a.WoT, kb * 64, nb * 32, nb * 32, scr, c.lane); continue; } r -= I_SQ;
        { const int kb = r / (DM / 32), nb = r % (DM / 32); tr_item_i8(a.w_q, DM, DM, (unsigned char*)a.WqT, kb * 128, nb * 32, nb * 32, WIN_QS, scr, c.lane); }
    }
    if (parts & 2)
    {
    for (int r = c.gw; r < 16384; r += 2 * c.NGW) { const int r2 = r + c.NGW; f32x4 va[8], vb[8];
        row_load_strided(a.u + (size_t)r * 2048, c.lane, va); if (r2 < 16384) row_load_strided(a.u + (size_t)r2 * 2048, c.lane, vb);
        i8_row(va, a.U + (size_t)r * 128, a.US + r, c.lane); if (r2 < 16384) i8_row(vb, a.U + (size_t)r2 * 128, a.US + r2, c.lane); }
    for (int r = c.gw; r < 16384; r += 2 * c.NGW) { const int r2 = r + c.NGW; f32x4 va[8], vb[8];
        row_load_contig(a.v + (size_t)r * 2048, c.lane, va); if (r2 < 16384) row_load_contig(a.v + (size_t)r2 * 2048, c.lane, vb);
        fp6_row(va, a.V + (size_t)r * 192, a.VS + r, c.lane); if (r2 < 16384) fp6_row(vb, a.V + (size_t)r2 * 192, a.VS + r2, c.lane); }
    }
    if (parts & 4) {
    cvt_copy(c, a.k1, a.KB, (size_t)8 * 16384 / 8);
    cvt_copy(c, a.k2, a.KB + 8 * 16384, (size_t)8 * 16384 / 8); }
    if (blockIdx.x == 0) for (int i = c.tid; i < 1024; i += 512) a.LB[i] = a.layer == 0 ? 0.f : sigm(a.lbp[1024 + i] - a.lbp[i]);
}

struct EpiIn {
    static constexpr bool PERM = true, AFTER_DRAIN = false;
    bf16* seg; bf16* gate; const float* lb; const float* sa;
    __device__ __forceinline__ float rowscale(int row) const { return ((const GAS float*)sa)[row] * (1.0f / WIN_QS); }
    __device__ __forceinline__ void operator()(const pg8::f32x4 (&acc)[2][2][4][2], const pg8::Unit& u, int wr, int wc, int fr, int fq) const {
        const int pn = u.pn; const int row0 = u.pm * 256 + wr * 64 + fr;
        if (pn >= 28 && pn < 36) {
            bf16* dst = seg + (size_t)7 * SEGSZ; const int col0 = (pn - 28) * 128 + wc * 32 + 8 * fq;
#pragma unroll
            for (int ai = 0; ai < 2; ++ai)
#pragma unroll
                for (int m = 0; m < 4; ++m) {
                    const pg8::f32x4 a0 = acc[ai][0][m][0], a1 = acc[ai][0][m][1], b0 = acc[ai][1][m][0], b1 = acc[ai][1][m][1];
                    v4u w; w.x = pk2c(a0[0] * sigm(b0[0]), a0[1] * sigm(b0[1])); w.y = pk2c(a0[2] * sigm(b0[2]), a0[3] * sigm(b0[3]));
                    w.z = pk2c(a1[0] * sigm(b1[0]), a1[1] * sigm(b1[1])); w.w = pk2c(a1[2] * sigm(b1[2]), a1[3] * sigm(b1[3]));
                    *(GAS v4u*)(dst + (size_t)(row0 + ai * 128 + m * 16) * 1024 + col0) = w; }
            return;
        }
        bf16* dst; int ld, colt, mode;
        if (pn < 28) { const int sg = pn >> 2; dst = seg + (size_t)sg * SEGSZ; ld = 1024; colt = (pn & 3) * 256; mode = (sg == 4) ? 2 : (sg == 6 ? 1 : 0); }
        else { const int q = pn - 36; dst = gate + (size_t)(q >> 3) * ((size_t)NTOK * 2048); ld = 2048; colt = (q & 7) * 256; mode = 1; }
        const int col0 = colt + wc * 32 + 8 * fq;
        if (mode == 0) {
#pragma unroll
            for (int ai = 0; ai < 2; ++ai)
#pragma unroll
                for (int m = 0; m < 4; ++m)
#pragma unroll
                    for (int bj = 0; bj < 2; ++bj) { const pg8::f32x4 v0 = acc[ai][bj][m][0], v1 = acc[ai][bj][m][1];
                        v4u w; w.x = pk2c(v0[0], v0[1]); w.y = pk2c(v0[2], v0[3]); w.z = pk2c(v1[0], v1[1]); w.w = pk2c(v1[2], v1[3]);
                        *(GAS v4u*)(dst + (size_t)(row0 + ai * 128 + m * 16) * ld + col0 + bj * 128) = w; }
        } else if (mode == 1) {
#pragma unroll
            for (int ai = 0; ai < 2; ++ai)
#pragma unroll
                for (int m = 0; m < 4; ++m)
#pragma unroll
                    for (int bj = 0; bj < 2; ++bj) { const pg8::f32x4 v0 = acc[ai][bj][m][0], v1 = acc[ai][bj][m][1];
                        v4u w; w.x = pk2c(sigm(v0[0]), sigm(v0[1])); w.y = pk2c(sigm(v0[2]), sigm(v0[3])); w.z = pk2c(sigm(v1[0]), sigm(v1[1])); w.w = pk2c(sigm(v1[2]), sigm(v1[3]));
                        *(GAS v4u*)(dst + (size_t)(row0 + ai * 128 + m * 16) * ld + col0 + bj * 128) = w; }
        } else {
            f32x4 l0[2], l1[2];
#pragma unroll
            for (int bj = 0; bj < 2; ++bj) { l0[bj] = *(const GAS f32x4*)(lb + col0 + bj * 128); l1[bj] = *(const GAS f32x4*)(lb + col0 + bj * 128 + 4); }
#pragma unroll
            for (int ai = 0; ai < 2; ++ai)
#pragma unroll
                for (int m = 0; m < 4; ++m)
#pragma unroll
                    for (int bj = 0; bj < 2; ++bj) { const pg8::f32x4 v0 = acc[ai][bj][m][0], v1 = acc[ai][bj][m][1]; float r[8];
#pragma unroll
                        for (int j = 0; j < 4; ++j) { r[j] = __logf(l0[bj][j] + (1.0f - l0[bj][j]) * sigm(v0[j])); r[4 + j] = __logf(l1[bj][j] + (1.0f - l1[bj][j]) * sigm(v1[j])); }
                        v4u w; w.x = pk2c(r[0], r[1]); w.y = pk2c(r[2], r[3]); w.z = pk2c(r[4], r[5]); w.w = pk2c(r[6], r[7]);
                        *(GAS v4u*)(dst + (size_t)(row0 + ai * 128 + m * 16) * ld + col0 + bj * 128) = w; }
        }
    }
};

__device__ __forceinline__ void conv_phase(const Ctx& c, const bf16* glu, const float* cw, const float* cb, const float* lnw, const float* lnb, bf16* out) {
    const int c0 = 2 * c.tid;
    float w0[31], w1[31];
#pragma unroll
    for (int j = 0; j < 31; ++j) { const f32x2v t = *(const GAS f32x2v*)(cw + j * 1024 + c0); w0[j] = t.x; w1[j] = t.y; }
    const f32x2v bv = *(const GAS f32x2v*)(cb + c0), lwv = *(const GAS f32x2v*)(lnw + c0), lbv = *(const GAS f32x2v*)(lnb + c0);
    LAS float* red = (LAS float*)c.lds;
    const int per = (NTOK / 8 + c.G - 1) / c.G, tile0 = (int)blockIdx.x * per;
    unsigned win[38];
    if (tile0 < NTOK / 8) {
#pragma unroll
        for (int r = 0; r < 38; ++r) { const int n = tile0 * 8 + r - 30; win[r] = *(const GAS unsigned*)(glu + (size_t)(n > 0 ? n : 0) * 1024 + c0); } }
    for (int ti = 0; ti < per; ++ti) { const int tile = tile0 + ti; if (tile >= NTOK / 8) break;
        const int n0 = tile * 8, tseq0 = n0 & (SEQ - 1);
        const bool more = (ti + 1 < per) && (tile + 1 < NTOK / 8);
        float a0[8], a1[8];
#pragma unroll
        for (int t = 0; t < 8; ++t) { a0[t] = bv.x; a1[t] = bv.y; }
#pragma unroll
        for (int r = 0; r < 38; ++r) {
            const unsigned xv = (tseq0 + r - 30 >= 0) ? win[r] : 0u;
            const float x0 = bflo(xv), x1 = bfhi(xv);
#pragma unroll
            for (int t = 0; t < 8; ++t) { const int j = r - t; if (j >= 0 && j <= 30) { a0[t] += w0[j] * x0; a1[t] += w1[j] * x1; } }
        }
#pragma unroll
        for (int r = 0; r < 30; ++r) win[r] = win[r + 8];
        if (more) {
#pragma unroll
            for (int i = 0; i < 8; ++i) win[30 + i] = *(const GAS unsigned*)(glu + (size_t)(n0 + 8 + i) * 1024 + c0); }
        float st[16];
#pragma unroll
        for (int t = 0; t < 8; ++t) { st[2 * t] = a0[t] + a1[t]; st[2 * t + 1] = a0[t] * a0[t] + a1[t] * a1[t]; }
        xreduce16(st, c.lane);
        if ((c.lane & 3) == 0) red[c.wave * 16 + ridx16(c.lane)] = st[0];
        __syncthreads();
        if (c.tid < 16) { float s = 0.f;
#pragma unroll
            for (int w = 0; w < 8; ++w) s += red[w * 16 + c.tid];
            red[128 + c.tid] = s; }
        __syncthreads();
#pragma unroll
        for (int t = 0; t < 8; ++t) {
            const float mean = red[128 + 2 * t] * (1.0f / 1024.0f), var = red[128 + 2 * t + 1] * (1.0f / 1024.0f) - mean * mean;
            const float rstd = __builtin_amdgcn_rsqf(var + EPS);
            const float h0 = (a0[t] - mean) * rstd * lwv.x + lbv.x, h1 = (a1[t] - mean) * rstd * lwv.y + lbv.y;
            *(GAS unsigned*)(out + (size_t)(n0 + t) * 1024 + c0) = pk2c(h0 * sigm(h0), h1 * sigm(h1));
        }
        __syncthreads();
    }
}
__device__ __forceinline__ void hgrn_task(int task, int lane, const bf16* qhg, const bf16* logf, const bf16* ihg, bf16* out) {
    const int bh = task >> 6, dvb = task & 63, b = bh >> 3, h = bh & 7;
    const size_t rb = (size_t)b * SEQ * 1024;
    const GAS unsigned* qp = (const GAS unsigned*)(qhg + rb + h * 128) + lane;
    const GAS unsigned* lp = (const GAS unsigned*)(logf + rb + h * 128) + lane;
    const GAS unsigned* ip = (const GAS unsigned*)(ihg + rb + h * 128) + dvb;
    GAS bf16* op = (GAS bf16*)(out + rb + h * 128 + 2 * dvb);
    float S00 = 0.f, S01 = 0.f, S10 = 0.f, S11 = 0.f;
    unsigned qn[8], ln[8], inx[8];
#pragma unroll
    for (int j = 0; j < 8; ++j) { qn[j] = qp[(size_t)j * 512]; ln[j] = lp[(size_t)j * 512]; inx[j] = ip[(size_t)j * 512]; }
    for (int blk = 0; blk < SEQ / 8; ++blk) {
        unsigned qc[8], lc[8], ic[8];
#pragma unroll
        for (int j = 0; j < 8; ++j) { qc[j] = qn[j]; lc[j] = ln[j]; ic[j] = inx[j]; }
        if (blk + 1 < SEQ / 8) {
#pragma unroll
            for (int j = 0; j < 8; ++j) { const size_t o = (size_t)((blk + 1) * 8 + j) * 512; qn[j] = qp[o]; ln[j] = lp[o]; inx[j] = ip[o]; }
        }
        float pv[16];
#pragma unroll
        for (int j = 0; j < 8; ++j) {
            const float f0 = __expf(bflo(lc[j])), f1 = __expf(bfhi(lc[j])), k0 = 1.0f - f0, k1 = 1.0f - f1;
            const float i0 = bflo(ic[j]), i1 = bfhi(ic[j]), q0 = bflo(qc[j]), q1 = bfhi(qc[j]);
            S00 = f0 * S00 + k0 * i0; S01 = f0 * S01 + k0 * i1; S10 = f1 * S10 + k1 * i0; S11 = f1 * S11 + k1 * i1;
            pv[2 * j] = S00 * q0 + S10 * q1; pv[2 * j + 1] = S01 * q0 + S11 * q1;
        }
        xreduce16(pv, lane);
        if ((lane & 3) == 0) { const int idx = ridx16(lane); op[(size_t)(blk * 8 + (idx >> 1)) * 1024 + (idx & 1)] = (bf16)(pk2c(pv[0], 0.f) & 0xffffu); }
    }
}
constexpr int HG_TS = 272;
constexpr int HG_BS = 132;
__device__ __forceinline__ void hg_stage(LAS unsigned char* dst, const bf16* src, int tid) {
#pragma unroll
    for (int i = 0; i < 2; ++i) { const int p = tid + 512 * i, row = p >> 4, c16 = p & 15; *(LAS v4u*)(dst + row * HG_TS + c16 * 16) = *(const GAS v4u*)(src + (size_t)row * 1024 + c16 * 8); }
}
__device__ __forceinline__ void hg_scan(const LAS unsigned char* lft, int dk, int hf, float (&lf)[4][8], float (&b)[4][8], float& bl) {
    float bs[4], pb[4];
#pragma unroll
    for (int kk = 0; kk < 4; ++kk) { float run = 0.f;
#pragma unroll
        for (int j = 0; j < 8; ++j) { lf[kk][j] = __uint_as_float((unsigned)(*(const LAS unsigned short*)(lft + (16 * kk + 8 * hf + j) * HG_TS + dk * 2)) << 16); run += lf[kk][j]; b[kk][j] = run; }
        bs[kk] = run; }
#pragma unroll
    for (int kk = 0; kk < 4; ++kk) pb[kk] = __shfl_xor(bs[kk], 32);
    float pre = 0.f;
#pragma unroll
    for (int kk = 0; kk < 4; ++kk) { const float off = pre + (hf ? pb[kk] : 0.f);
#pragma unroll
        for (int j = 0; j < 8; ++j) b[kk][j] += off;
        pre += bs[kk] + pb[kk]; }
    bl = pre;
}
__device__ __forceinline__ bf16x8 pack8(const float (&v)[8]) { v4u t; t.x = pk2c(v[0], v[1]); t.y = pk2c(v[2], v[3]); t.z = pk2c(v[4], v[5]); t.w = pk2c(v[6], v[7]); return __builtin_bit_cast(bf16x8, t); }
__device__ __forceinline__ unsigned lds_u16(const LAS unsigned char* p) { return (unsigned)(*(const LAS unsigned short*)p); }
__device__ __forceinline__ void hgA_chunk(const Ctx& c, int ci, const bf16* LOGF, const bf16* IHG, bf16* ST, float* DEC) {
    const int bh = ci >> 6, ch = ci & 63, bb = bh >> 3, h = bh & 7; const size_t n0 = (size_t)bb * SEQ + ch * 64;
    LAS unsigned char* lft = c.lds; LAS unsigned char* itl = c.lds + 64 * HG_TS;
    hg_stage(lft, LOGF + n0 * 1024 + h * 128, c.tid); hg_stage(itl, IHG + n0 * 1024 + h * 128, c.tid);
    __syncthreads();
    const int dkt = c.wave & 3, dvh = c.wave >> 2, hf = c.lane >> 5, cl = c.lane & 31, dk = 32 * dkt + cl;
    float lf[4][8], b[4][8], bl; hg_scan(lft, dk, hf, lf, b, bl);
    bf16x8 kf[4];
#pragma unroll
    for (int kk = 0; kk < 4; ++kk) { float v[8];
#pragma unroll
        for (int j = 0; j < 8; ++j) v[j] = (1.0f - __expf(lf[kk][j])) * __expf(bl - b[kk][j]);
        kf[kk] = pack8(v); }
    if (dvh == 0 && hf == 0) ((GAS float*)DEC)[(size_t)ci * 128 + dk] = __expf(bl);
#pragma unroll
    for (int dvi = 0; dvi < 2; ++dvi) { const int dvt = dvh * 2 + dvi;
        f32x16 acc;
#pragma unroll
        for (int r = 0; r < 16; ++r) acc[r] = 0.f;
#pragma unroll
        for (int kk = 0; kk < 4; ++kk) { const LAS unsigned char* p = itl + (16 * kk + 8 * hf) * HG_TS + (32 * dvt + cl) * 2;
            v4u t; t.x = lds_u16(p) | (lds_u16(p + HG_TS) << 16); t.y = lds_u16(p + 2 * HG_TS) | (lds_u16(p + 3 * HG_TS) << 16); t.z = lds_u16(p + 4 * HG_TS) | (lds_u16(p + 5 * HG_TS) << 16); t.w = lds_u16(p + 6 * HG_TS) | (lds_u16(p + 7 * HG_TS) << 16);
            acc = MFMA32(kf[kk], __builtin_bit_cast(bf16x8, t), acc); }
        bf16* o = ST + (size_t)ci * 16384 + (size_t)(32 * dvt + cl) * 128 + 32 * dkt + 4 * hf;
#pragma unroll
        for (int g = 0; g < 4; ++g) { v2u q; q.x = pk2c(acc[4 * g], acc[4 * g + 1]); q.y = pk2c(acc[4 * g + 2], acc[4 * g + 3]); *(GAS v2u*)(o + 8 * g) = q; }
    }
    __syncthreads();
}
__device__ __forceinline__ void hgB(const Ctx& c, bf16* ST, const float* DEC) {
    for (int e = blockIdx.x * 512 + c.tid; e < 32 * 4096; e += c.G * 512) {
        const int bh = e >> 12, r = e & 4095, dv = r >> 5, dk4 = (r & 31) * 4;
        GAS v2u* p = (GAS v2u*)(ST + (size_t)bh * 64 * 16384 + (size_t)dv * 128 + dk4);
        const GAS f32x4* d = (const GAS f32x4*)(DEC + (size_t)bh * 64 * 128 + dk4);
        f32x4 S = {0.f, 0.f, 0.f, 0.f};
#pragma unroll 1
        for (int c0 = 0; c0 < 64; c0 += 8) {
            v2u Lv[8]; f32x4 D[8];
#pragma unroll
            for (int k = 0; k < 8; ++k) { Lv[k] = p[(size_t)(c0 + k) * 4096]; D[k] = d[(size_t)(c0 + k) * 32]; }
#pragma unroll
            for (int k = 0; k < 8; ++k) { v2u o; o.x = pk2c(S.x, S.y); o.y = pk2c(S.z, S.w); p[(size_t)(c0 + k) * 4096] = o;
                S.x = D[k].x * S.x + bflo(Lv[k].x); S.y = D[k].y * S.y + bfhi(Lv[k].x); S.z = D[k].z * S.z + bflo(Lv[k].y); S.w = D[k].w * S.w + bfhi(Lv[k].y); }
        }
    }
}
__device__ __forceinline__ void hgC_chunk(const Ctx& c, int ci, const bf16* QHG, const bf16* LOGF, const bf16* IHG, const bf16* GHG, const bf16* ST, const float* nw, bf16* OUT) {
    const int bh = ci >> 6, ch = ci & 63, bb = bh >> 3, h = bh & 7; const size_t n0 = (size_t)bb * SEQ + ch * 64;
    LAS unsigned char* lft = c.lds; LAS unsigned char* itl = c.lds + 64 * HG_TS; LAS float* bt = (LAS float*)(c.lds + 2 * 64 * HG_TS); LAS float* red = bt + 64 * HG_BS;
    LAS unsigned char* ktl = (LAS unsigned char*)(red + 256);
    const int hf = c.lane >> 5, cl = c.lane & 31;
    const int dvt = c.wave & 3, tt = c.wave >> 2, t = 32 * tt + cl;
    const bf16* qrow = QHG + (n0 + t) * 1024 + h * 128 + 8 * hf;
    v4u qg[8];
#pragma unroll
    for (int kk = 0; kk < 8; ++kk) qg[kk] = *(const GAS v4u*)(qrow + 16 * kk);
    hg_stage(lft, LOGF + n0 * 1024 + h * 128, c.tid); hg_stage(itl, IHG + n0 * 1024 + h * 128, c.tid);
    __syncthreads();
    { const int dk = 32 * (c.wave & 3) + cl; float lf[4][8], b[4][8], bl; hg_scan(lft, dk, hf, lf, b, bl);
#pragma unroll
      for (int q = 0; q < 2; ++q) { const int kk = 2 * (c.wave >> 2) + q;
#pragma unroll
          for (int j = 0; j < 8; ++j) { bt[(16 * kk + 8 * hf + j) * HG_BS + dk] = (c.wave >> 2) ? b[2 + q][j] : b[q][j];
              *(LAS unsigned short*)(ktl + (16 * kk + 8 * hf + j) * HG_TS + dk * 2) = (unsigned short)(pk2c(1.0f - __expf((c.wave >> 2) ? lf[2 + q][j] : lf[q][j]), 0.f) & 0xffffu); } } }
    __syncthreads();
    bf16x8 qm[8];
    const bf16* strow = ST + (size_t)ci * 16384 + (size_t)(32 * dvt + cl) * 128 + 8 * hf;
    bf16x8 sf[8];
#pragma unroll
    for (int kk = 0; kk < 8; ++kk) sf[kk] = *(const GAS bf16x8*)(strow + 16 * kk);
#pragma unroll
    for (int kk = 0; kk < 8; ++kk) { const int d0 = 16 * kk + 8 * hf;
        const v4u qv = qg[kk];
        const f32x4 b0 = *(const LAS f32x4*)(bt + t * HG_BS + d0), b1 = *(const LAS f32x4*)(bt + t * HG_BS + d0 + 4), m0 = *(const LAS f32x4*)(bt + 31 * HG_BS + d0), m1 = *(const LAS f32x4*)(bt + 31 * HG_BS + d0 + 4);
        const float q[8] = {bflo(qv.x), bfhi(qv.x), bflo(qv.y), bfhi(qv.y), bflo(qv.z), bfhi(qv.z), bflo(qv.w), bfhi(qv.w)};
        const float bv[8] = {b0.x, b0.y, b0.z, b0.w, b1.x, b1.y, b1.z, b1.w}, mv[8] = {m0.x, m0.y, m0.z, m0.w, m1.x, m1.y, m1.z, m1.w};
        float vm[8];
#pragma unroll
        for (int j = 0; j < 8; ++j) vm[j] = q[j] * __expf(bv[j] - mv[j]);
        qm[kk] = pack8(vm); }
    f32x16 o;
#pragma unroll
    for (int r = 0; r < 16; ++r) o[r] = 0.f;
#pragma unroll 1
    for (int st = 0; st <= tt; ++st) {
        const int s = 32 * st + cl;
        f32x16 sa;
#pragma unroll
        for (int r = 0; r < 16; ++r) sa[r] = 0.f;
#pragma unroll
        for (int kk = 0; kk < 8; ++kk) { const int d0 = 16 * kk + 8 * hf;
            asm volatile("" ::: "memory");
            const v4u lv = *(const LAS v4u*)(ktl + s * HG_TS + d0 * 2);
            const f32x4 b0 = *(const LAS f32x4*)(bt + s * HG_BS + d0), b1 = *(const LAS f32x4*)(bt + s * HG_BS + d0 + 4), m0 = *(const LAS f32x4*)(bt + 31 * HG_BS + d0), m1 = *(const LAS f32x4*)(bt + 31 * HG_BS + d0 + 4);
            const float kv[8] = {bflo(lv.x), bfhi(lv.x), bflo(lv.y), bfhi(lv.y), bflo(lv.z), bfhi(lv.z), bflo(lv.w), bfhi(lv.w)};
            const float bv[8] = {b0.x, b0.y, b0.z, b0.w, b1.x, b1.y, b1.z, b1.w}, mv[8] = {m0.x, m0.y, m0.z, m0.w, m1.x, m1.y, m1.z, m1.w};
            float vk[8];
#pragma unroll
            for (int j = 0; j < 8; ++j) vk[j] = kv[j] * __expf(mv[j] - bv[j]);
            sa = MFMA32(pack8(vk), qm[kk], sa); }
        if (st == tt) {
#pragma unroll
            for (int r = 0; r < 16; ++r) if (((r & 3) + 8 * (r >> 2) + 4 * hf) > cl) sa[r] = 0.f;
        }
#pragma unroll
        for (int sp = 0; sp < 2; ++sp) {
            const float pv[8] = {sa[8 * sp], sa[8 * sp + 1], sa[8 * sp + 2], sa[8 * sp + 3], sa[8 * sp + 4], sa[8 * sp + 5], sa[8 * sp + 6], sa[8 * sp + 7]};
            const LAS unsigned char* p = itl + (32 * st + 16 * sp + 4 * hf) * HG_TS + (32 * dvt + cl) * 2;
            v4u tq; tq.x = lds_u16(p) | (lds_u16(p + HG_TS) << 16); tq.y = lds_u16(p + 2 * HG_TS) | (lds_u16(p + 3 * HG_TS) << 16);
            tq.z = lds_u16(p + 8 * HG_TS) | (lds_u16(p + 9 * HG_TS) << 16); tq.w = lds_u16(p + 10 * HG_TS) | (lds_u16(p + 11 * HG_TS) << 16);
            o = MFMA32(__builtin_bit_cast(bf16x8, tq), pack8(pv), o); }
    }
    {
#pragma unroll
      for (int kk = 0; kk < 8; ++kk) { const int d0 = 16 * kk + 8 * hf;
          const v4u qv = qg[kk];
          const f32x4 b0 = *(const LAS f32x4*)(bt + t * HG_BS + d0), b1 = *(const LAS f32x4*)(bt + t * HG_BS + d0 + 4);
          float ve[8] = {bflo(qv.x) * __expf(b0.x), bfhi(qv.x) * __expf(b0.y), bflo(qv.y) * __expf(b0.z), bfhi(qv.y) * __expf(b0.w), bflo(qv.z) * __expf(b1.x), bfhi(qv.z) * __expf(b1.y), bflo(qv.w) * __expf(b1.z), bfhi(qv.w) * __expf(b1.w)};
          o = MFMA32(sf[kk], pack8(ve), o); } }
    float ss = 0.f;
#pragma unroll
    for (int r = 0; r < 16; ++r) ss += o[r] * o[r];
    ss += __shfl_xor(ss, 32);
    if (hf == 0) red[(tt * 4 + dvt) * 32 + cl] = ss;
    __syncthreads();
    const float rstd = __builtin_amdgcn_rsqf(((red[(tt * 4 + 0) * 32 + cl] + red[(tt * 4 + 1) * 32 + cl]) + (red[(tt * 4 + 2) * 32 + cl] + red[(tt * 4 + 3) * 32 + cl])) * (1.0f / 128.0f) + EPS);
#pragma unroll
    for (int g = 0; g < 4; ++g) { const int dv0 = 32 * dvt + 8 * g + 4 * hf; const size_t off = (n0 + t) * 1024 + h * 128 + dv0;
        const v2u gg = *(const GAS v2u*)(GHG + off); const f32x4 w4 = *(const GAS f32x4*)(nw + dv0);
        v2u q; q.x = pk2c(o[4 * g] * rstd * w4.x * bflo(gg.x), o[4 * g + 1] * rstd * w4.y * bfhi(gg.x)); q.y = pk2c(o[4 * g + 2] * rstd * w4.z * bflo(gg.y), o[4 * g + 3] * rstd * w4.w * bfhi(gg.y));
        *(GAS v2u*)(OUT + off) = q; }
    __syncthreads();
}
__device__ __forceinline__ void qknorm_rows4(bf16* row0, size_t rstride, const float* w, float scale, int lane) {
    v4u x[4][2];
#pragma unroll
    for (int i = 0; i < 4; ++i)
#pragma unroll
        for (int j = 0; j < 2; ++j) x[i][j] = *(const GAS v4u*)(row0 + i * rstride + 8 * lane + 512 * j);
    const f32x4 wa = *(const GAS f32x4*)(w + ((8 * lane) & 127)), wb = *(const GAS f32x4*)(w + ((8 * lane) & 127) + 4);
#pragma unroll
    for (int i = 0; i < 4; ++i)
#pragma unroll
        for (int j = 0; j < 2; ++j) { const v4u xx = x[i][j];
            float f[8] = {bflo(xx.x), bfhi(xx.x), bflo(xx.y), bfhi(xx.y), bflo(xx.z), bfhi(xx.z), bflo(xx.w), bfhi(xx.w)};
            float ss = 0.f;
#pragma unroll
            for (int k = 0; k < 8; ++k) ss += f[k] * f[k];
            ss += __shfl_xor(ss, 1); ss += __shfl_xor(ss, 2); ss += __shfl_xor(ss, 4); ss += __shfl_xor(ss, 8);
            const float r = __builtin_amdgcn_rsqf(ss * (1.0f / 128.0f) + EPS) * scale;
            v4u o; o.x = pk2c(f[0] * r * wa.x, f[1] * r * wa.y); o.y = pk2c(f[2] * r * wa.z, f[3] * r * wa.w); o.z = pk2c(f[4] * r * wb.x, f[5] * r * wb.y); o.w = pk2c(f[6] * r * wb.z, f[7] * r * wb.w);
            *(GAS v4u*)(row0 + i * rstride + 8 * lane + 512 * j) = o; }
}
__device__ __forceinline__ void vt_item(int item, int lane, const bf16* vsb, bf16* vt, LAS unsigned short* scr) {
    const int db = item & 3, sb = (item >> 2) & 63, bh = item >> 8, b = bh >> 3, h = bh & 7;
    const bf16* src = vsb + ((size_t)b * SEQ + sb * 64) * 1024 + h * 128 + db * 32;
#pragma unroll 4
    for (int i = 0; i < 16; ++i) { const int r = 4 * i + (lane >> 4); *(LAS unsigned*)(scr + r * 34 + 2 * (lane & 15)) = *(const GAS unsigned*)(src + (size_t)r * 1024 + 2 * (lane & 15)); }
    LDS_WAIT();
    const int c = lane & 7;
#pragma unroll
    for (int j = 0; j < 4; ++j) { const int d = (lane >> 3) + 8 * j; const LAS unsigned short* s = scr + (8 * c) * 34 + d;
        v4u o; o.x = (unsigned)s[0] | ((unsigned)s[34] << 16); o.y = (unsigned)s[68] | ((unsigned)s[102] << 16); o.z = (unsigned)s[136] | ((unsigned)s[170] << 16); o.w = (unsigned)s[204] | ((unsigned)s[238] << 16);
        *(GAS v4u*)(vt + ((size_t)bh * 128 + db * 32 + d) * SEQ + sb * 64 + 8 * c) = o; }
    LDS_WAIT();
}

constexpr int AT_BUF = 32768, AT_VOFF = 16384;
__device__ __forceinline__ f32x16 attn_scores(const LAS unsigned char* kt, int krow, int hf, const bf16x8 (&qf)[8]) {
    f32x16 sa;
#pragma unroll
    for (int r = 0; r < 16; ++r) sa[r] = 0.f;
    const LAS unsigned char* kp = kt + krow * 256; const int sw = krow & 15;
#pragma unroll
    for (int kk = 0; kk < 8; ++kk) sa = MFMA32(*(const LAS bf16x8*)(kp + (((2 * kk + hf) ^ sw) << 4)), qf[kk], sa);
    return sa;
}
template <bool DIAG> __device__ __forceinline__ void attn_weights(const f32x16& sa, float& R, int hf, int cl, bf16x8 (&pf)[2]) {
    float om[16];
#pragma unroll
    for (int r = 0; r < 16; ++r) om[r] = __builtin_amdgcn_rcpf(1.0f + __builtin_amdgcn_exp2f(sa[r] * 1.4426950408889634f));
    if (DIAG) {
#pragma unroll
        for (int r = 0; r < 16; ++r) if (((r & 3) + 8 * (r >> 2) + 4 * hf) >= cl) om[r] = 1.0f;
    }
    float Gs[4], Gp[4];
#pragma unroll
    for (int g = 0; g < 4; ++g) { Gs[g] = (om[4 * g] * om[4 * g + 1]) * (om[4 * g + 2] * om[4 * g + 3]); Gp[g] = __shfl_xor(Gs[g], 32); }
    float tail = R; float w[16];
#pragma unroll
    for (int g = 3; g >= 0; --g) {
        const float c3 = tail * (hf == 0 ? Gp[g] : 1.0f), c2 = c3 * om[4 * g + 3], c1 = c2 * om[4 * g + 2], c0 = c1 * om[4 * g + 1];
        w[4 * g + 3] = c3 - om[4 * g + 3] * c3; w[4 * g + 2] = c2 - om[4 * g + 2] * c2; w[4 * g + 1] = c1 - om[4 * g + 1] * c1; w[4 * g] = c0 - om[4 * g] * c0;
        tail *= Gs[g] * Gp[g];
    }
    R = tail;
#pragma unroll
    for (int sp = 0; sp < 2; ++sp) { v4u t; t.x = pk2c(w[8 * sp], w[8 * sp + 1]); t.y = pk2c(w[8 * sp + 2], w[8 * sp + 3]); t.z = pk2c(w[8 * sp + 4], w[8 * sp + 5]); t.w = pk2c(w[8 * sp + 6], w[8 * sp + 7]); pf[sp] = __builtin_bit_cast(bf16x8, t); }
}
__device__ __forceinline__ void attn_pv(const LAS unsigned char* vt, int sub, int cl, int hf, const bf16x8 (&pf)[2], f32x16 (&o)[4]) {
#pragma unroll
    for (int d = 0; d < 4; ++d) { const int row = 32 * d + cl; const LAS unsigned char* vp = vt + row * 128 + 8 * hf; const int sw = (row >> 1) & 7;
#pragma unroll
        for (int sp = 0; sp < 2; ++sp) { const int x = 4 * sub + 2 * sp;
            const v2u lo = *(const LAS v2u*)(vp + ((x ^ sw) << 4)), hi = *(const LAS v2u*)(vp + (((x + 1) ^ sw) << 4));
            v4u t; t.x = lo.x; t.y = lo.y; t.z = hi.x; t.w = hi.y; o[d] = MFMA32(__builtin_bit_cast(bf16x8, t), pf[sp], o[d]); } }
}
template <bool LAG> __device__ __forceinline__ void attn_unit(const Ctx& c, int bh, int qb, const bf16* qsb, const bf16* ksb, const bf16* vt, bf16* outb) {
    int lane_ = c.lane; asm volatile("" : "+v"(lane_));
    const int b = bh >> 3, h = bh & 7, lane = lane_, cl = lane & 31, hf = lane >> 5;
    const size_t rb = (size_t)b * SEQ; const int q0w = 256 * qb + 32 * c.wave;
    bf16x8 qf[8];
    { const bf16* qrow = qsb + (rb + q0w + cl) * 1024 + h * 128 + 8 * hf;
#pragma unroll
      for (int kk = 0; kk < 8; ++kk) qf[kk] = *(const GAS bf16x8*)(qrow + 16 * kk); }
    f32x16 o[4];
#pragma unroll
    for (int d = 0; d < 4; ++d)
#pragma unroll
        for (int r = 0; r < 16; ++r) o[d][r] = 0.f;
    float R = 1.0f;
    bf16x8 pd[2]; const LAS unsigned char* vimd = c.lds; int subd = 0; bool pending = false;
    const int kr0 = 8 * c.wave + (lane >> 4), kr1 = kr0 + 4;
    const bf16* kg0 = ksb + (rb + kr0) * 1024 + h * 128 + (((lane & 15) ^ (kr0 & 15)) << 3);
    const bf16* kg1 = ksb + (rb + kr1) * 1024 + h * 128 + (((lane & 15) ^ (kr1 & 15)) << 3);
    const int vr0 = 16 * c.wave + (lane >> 3), vr1 = vr0 + 8;
    const bf16* vg0 = vt + ((size_t)bh * 128 + vr0) * SEQ + (((lane & 7) ^ ((vr0 >> 1) & 7)) << 3);
    const bf16* vg1 = vt + ((size_t)bh * 128 + vr1) * SEQ + (((lane & 7) ^ ((vr1 >> 1) & 7)) << 3);
    LAS unsigned char* dk = c.lds + c.wave * 2048; LAS unsigned char* dv = c.lds + AT_VOFF + c.wave * 2048;
#define AT_DMA(kt_, bi_) do { const int ktt_ = (kt_); LAS unsigned char* bb_ = (LAS unsigned char*)0 + (bi_) * AT_BUF; \
        __builtin_amdgcn_global_load_lds((const unsigned*)(kg0 + (size_t)ktt_ * 64 * 1024), (LAS unsigned*)(dk + (bi_) * AT_BUF), 16, 0, 0); \
        __builtin_amdgcn_global_load_lds((const unsigned*)(kg1 + (size_t)ktt_ * 64 * 1024), (LAS unsigned*)(dk + (bi_) * AT_BUF + 1024), 16, 0, 0); \
        __builtin_amdgcn_global_load_lds((const unsigned*)(vg0 + ktt_ * 64), (LAS unsigned*)(dv + (bi_) * AT_BUF), 16, 0, 0); \
        __builtin_amdgcn_global_load_lds((const unsigned*)(vg1 + ktt_ * 64), (LAS unsigned*)(dv + (bi_) * AT_BUF + 1024), 16, 0, 0); (void)bb_; } while (0)
    const int nkt = 4 * (qb + 1);
    asm volatile("s_waitcnt vmcnt(0)" ::: "memory");
    AT_DMA(nkt - 1, 0); AT_DMA(nkt - 2, 1);
    asm volatile("s_waitcnt vmcnt(4)" ::: "memory"); __builtin_amdgcn_s_barrier(); asm volatile("" ::: "memory");
    int bi = 0;
#pragma unroll 1
    for (int it = 0; it < nkt; ++it) {
        const int kt = nkt - 1 - it;
        const int b2 = (bi + 2) & 3;
        if (it + 2 < nkt) AT_DMA(kt - 2, b2);
        const LAS unsigned char* kim = c.lds + bi * AT_BUF; const LAS unsigned char* vim = kim + AT_VOFF;
        const int rel = q0w - 64 * kt;
        if (rel >= 32) {
            if (LAG) { if (pending) attn_pv(vimd, subd, cl, hf, pd, o);
                const f32x16 s1 = attn_scores(kim, 32 + cl, hf, qf); if (rel == 32) attn_weights<true>(s1, R, hf, cl, pd); else attn_weights<false>(s1, R, hf, cl, pd);
                vimd = vim; subd = 1; pending = true;
            } else { bf16x8 p[2];
                { const f32x16 s1 = attn_scores(kim, 32 + cl, hf, qf); if (rel == 32) attn_weights<true>(s1, R, hf, cl, p); else attn_weights<false>(s1, R, hf, cl, p); }
                attn_pv(vim, 1, cl, hf, p, o); }
        }
        if (rel >= 0) {
            if (LAG) { if (pending) attn_pv(vimd, subd, cl, hf, pd, o);
                const f32x16 s0 = attn_scores(kim, cl, hf, qf); if (rel == 0) attn_weights<true>(s0, R, hf, cl, pd); else attn_weights<false>(s0, R, hf, cl, pd);
                vimd = vim; subd = 0; pending = true;
            } else { bf16x8 p[2];
                { const f32x16 s0 = attn_scores(kim, cl, hf, qf); if (rel == 0) attn_weights<true>(s0, R, hf, cl, p); else attn_weights<false>(s0, R, hf, cl, p); }
                attn_pv(vim, 0, cl, hf, p, o); }
        }
        if (it + 2 < nkt) asm volatile("s_waitcnt vmcnt(4)\n\ts_waitcnt lgkmcnt(0)" ::: "memory"); else asm volatile("s_waitcnt vmcnt(0)\n\ts_waitcnt lgkmcnt(0)" ::: "memory");
        __builtin_amdgcn_s_barrier(); asm volatile("" ::: "memory");
        bi = (bi + 1) & 3;
    }
#undef AT_DMA
    if (LAG && pending) attn_pv(vimd, subd, cl, hf, pd, o);
    bf16* orow = outb + (rb + q0w + cl) * 1024 + h * 128 + 4 * hf;
#pragma unroll
    for (int d = 0; d < 4; ++d)
#pragma unroll
        for (int g = 0; g < 4; ++g) { v2u q; q.x = pk2c(o[d][4 * g], o[d][4 * g + 1]); q.y = pk2c(o[d][4 * g + 2], o[d][4 * g + 3]); *(GAS v2u*)(orow + 32 * d + 8 * g) = q; }
    asm volatile("s_waitcnt vmcnt(0)" ::: "memory"); __builtin_amdgcn_s_barrier(); asm volatile("" ::: "memory");
}
__device__ __forceinline__ void hgpost_row(bf16* row, const bf16* grow, const float* w, int lane) {
#pragma unroll
    for (int j = 0; j < 2; ++j) {
        GAS v4u* p = (GAS v4u*)(row + 8 * lane + 512 * j); const v4u x = *p; const v4u gg = *(const GAS v4u*)(grow + 8 * lane + 512 * j);
        float f[8] = {bflo(x.x), bfhi(x.x), bflo(x.y), bfhi(x.y), bflo(x.z), bfhi(x.z), bflo(x.w), bfhi(x.w)};
        const float g[8] = {bflo(gg.x), bfhi(gg.x), bflo(gg.y), bfhi(gg.y), bflo(gg.z), bfhi(gg.z), bflo(gg.w), bfhi(gg.w)};
        float ss = 0.f;
#pragma unroll
        for (int k = 0; k < 8; ++k) ss += f[k] * f[k];
        ss += __shfl_xor(ss, 1); ss += __shfl_xor(ss, 2); ss += __shfl_xor(ss, 4); ss += __shfl_xor(ss, 8);
        const float r = __builtin_amdgcn_rsqf(ss * (1.0f / 128.0f) + EPS);
        const f32x4 wa = *(const GAS f32x4*)(w + ((8 * lane) & 127)), wb = *(const GAS f32x4*)(w + ((8 * lane) & 127) + 4);
        v4u o; o.x = pk2c(f[0] * r * wa.x * g[0], f[1] * r * wa.y * g[1]); o.y = pk2c(f[2] * r * wa.z * g[2], f[3] * r * wa.w * g[3]);
        o.z = pk2c(f[4] * r * wb.x * g[4], f[5] * r * wb.y * g[5]); o.w = pk2c(f[6] * r * wb.z * g[6], f[7] * r * wb.w * g[7]);
        *p = o;
    }
}

template <bool FIRST> struct EpiMerge {
    static constexpr bool PERM = true, AFTER_DRAIN = false;
    const bf16* gate; bf16* merged;
    __device__ __forceinline__ void operator()(const pg8::f32x4 (&acc)[2][2][4][2], const pg8::Unit& u, int wr, int wc, int fr, int fq) const {
        const int row0 = u.pm * 256 + wr * 64 + fr, col0 = u.pn * 256 + wc * 32 + 8 * fq;
#pragma unroll
        for (int ai = 0; ai < 2; ++ai)
#pragma unroll
            for (int m = 0; m < 4; ++m) {
                if (m == 0) asm volatile("" ::: "memory");
#pragma unroll
                for (int bj = 0; bj < 2; ++bj) {
                    const size_t off = (size_t)(row0 + ai * 128 + m * 16) * 2048 + col0 + bj * 128;
                    const v4u g = *(const GAS v4u*)(gate + off); const pg8::f32x4 v0 = acc[ai][bj][m][0], v1 = acc[ai][bj][m][1];
                    float r[8] = {bflo(g.x) * v0[0], bfhi(g.x) * v0[1], bflo(g.y) * v0[2], bfhi(g.y) * v0[3], bflo(g.z) * v1[0], bfhi(g.z) * v1[1], bflo(g.w) * v1[2], bfhi(g.w) * v1[3]};
                    if (!FIRST) { const v4u mo = *(const GAS v4u*)(merged + off);
                        r[0] += bflo(mo.x); r[1] += bfhi(mo.x); r[2] += bflo(mo.y); r[3] += bfhi(mo.y); r[4] += bflo(mo.z); r[5] += bfhi(mo.z); r[6] += bflo(mo.w); r[7] += bfhi(mo.w); }
                    v4u w; w.x = pk2c(r[0], r[1]); w.y = pk2c(r[2], r[3]); w.z = pk2c(r[4], r[5]); w.w = pk2c(r[6], r[7]);
                    *(GAS v4u*)(merged + off) = w; }
            }
    }
};
struct EpiStoreBf16 {
    static constexpr bool PERM = true, AFTER_DRAIN = false;
    bf16* out; const float* sa;
    __device__ __forceinline__ float rowscale(int row) const { return ((const GAS float*)sa)[row] * (1.0f / WIN_QS); }
    __device__ __forceinline__ void operator()(const pg8::f32x4 (&acc)[2][2][4][2], const pg8::Unit& u, int wr, int wc, int fr, int fq) const {
        const int row0 = u.pm * 256 + wr * 64 + fr, col0 = u.pn * 256 + wc * 32 + 8 * fq;
#pragma unroll
        for (int ai = 0; ai < 2; ++ai)
#pragma unroll
            for (int m = 0; m < 4; ++m)
#pragma unroll
                for (int bj = 0; bj < 2; ++bj) { const pg8::f32x4 v0 = acc[ai][bj][m][0], v1 = acc[ai][bj][m][1];
                    v4u w; w.x = pk2c(v0[0], v0[1]); w.y = pk2c(v0[2], v0[3]); w.z = pk2c(v1[0], v1[1]); w.w = pk2c(v1[2], v1[3]);
                    *(GAS v4u*)(out + (size_t)(row0 + ai * 128 + m * 16) * 2048 + col0 + bj * 128) = w; }
    }
};
struct EpiResid {
    static constexpr bool PERM = false, AFTER_DRAIN = false;
    const float* xin; float* xout;
    __device__ __forceinline__ void operator()(const pg8::f32x4 (&acc)[2][2][4][2], const pg8::Unit& u, int wr, int wc, int fr, int fq) const {
        const int row0 = u.pm * 256 + wr * 64 + fr, col0 = u.pn * 256 + wc * 32 + 4 * fq;
#pragma unroll
        for (int ai = 0; ai < 2; ++ai)
#pragma unroll
            for (int m = 0; m < 4; ++m)
#pragma unroll
                for (int bj = 0; bj < 2; ++bj)
#pragma unroll
                    for (int n = 0; n < 2; ++n) { const size_t off = (size_t)(row0 + ai * 128 + m * 16) * 2048 + col0 + bj * 128 + n * 16;
                        f32x4 r = acc[ai][bj][m][n]; if (xin) r += *(const GAS f32x4*)(xin + off);
                        *(GAS f32x4*)(xout + off) = r; }
    }
};

__device__ __forceinline__ float rl_f(float v, int l) { return __uint_as_float((unsigned)__builtin_amdgcn_readlane((int)__float_as_uint(v), l)); }
__device__ __forceinline__ void ins16(float (&L)[16], float x) {
#pragma unroll
    for (int i = 0; i < 16; ++i) { const float hi = __builtin_fmaxf(L[i], x); x = __builtin_fminf(L[i], x); L[i] = hi; }
}
#define CE_DESC(a, b) do { const float hi_ = __builtin_fmaxf(a, b), lo_ = __builtin_fminf(a, b); a = hi_; b = lo_; } while (0)
__device__ __forceinline__ void sort16_desc(float (&v)[16]) {
#pragma unroll
    for (int k = 2; k <= 16; k <<= 1)
#pragma unroll
        for (int j = k >> 1; j > 0; j >>= 1)
#pragma unroll
            for (int i = 0; i < 16; ++i) { const int l = i ^ j; if (l > i) { if ((i & k) == 0) CE_DESC(v[i], v[l]); else CE_DESC(v[l], v[i]); } }
}
__device__ __forceinline__ void bitonic_merge16_desc(float (&v)[16]) {
#pragma unroll
    for (int j = 8; j > 0; j >>= 1)
#pragma unroll
        for (int i = 0; i < 16; ++i) { const int l = i ^ j; if (l > i) CE_DESC(v[i], v[l]); }
}
__device__ __forceinline__ void top16_merge(float (&L)[16], const float (&T)[16]) {
#pragma unroll
    for (int i = 0; i < 16; ++i) L[i] = __builtin_fmaxf(L[i], T[15 - i]);
    bitonic_merge16_desc(L);
}
constexpr int PK_KS = 272;
__device__ __forceinline__ void peer_top16(const bf16* qrow  , const LAS unsigned char* kl  , int hf, float (&L)[16]) {
    bf16x8 qf[8];
#pragma unroll
    for (int kk = 0; kk < 8; ++kk) qf[kk] = *(const GAS bf16x8*)(qrow + 16 * kk);
#pragma unroll 1
    for (int kt = 0; kt < 4; ++kt) {
        f32x16 sa;
#pragma unroll
        for (int r = 0; r < 16; ++r) sa[r] = 0.f;
#pragma unroll
        for (int kk = 0; kk < 8; ++kk) sa = MFMA32(*(const LAS bf16x8*)(kl + kt * 32 * PK_KS + 32 * kk), qf[kk], sa);
        float T[16];
#pragma unroll
        for (int r = 0; r < 16; ++r) { const unsigned idx = (unsigned)(kt * 32 + (r & 3) + 8 * (r >> 2) + 4 * hf); T[r] = __uint_as_float((__float_as_uint(sa[r]) & ~127u) | idx); }
        sort16_desc(T);
        if (kt == 0) {
#pragma unroll
            for (int i = 0; i < 16; ++i) L[i] = T[i];
        } else top16_merge(L, T);
    }
    float P[16];
#pragma unroll
    for (int i = 0; i < 16; ++i) P[i] = __shfl_xor(L[i], 32);
    top16_merge(L, P);
}
__device__ __forceinline__ void peer_select32(int hd, int n0, int lane, const bf16* qpeer, const LAS unsigned char* kl1, const LAS unsigned char* kl2, unsigned char* wsb, LAS unsigned* ldsw) {
    asm volatile("" : "+v"(lane));
    const int c = lane & 31, hf = lane >> 5, n = n0 + c;
    const bf16* qrow = qpeer + (size_t)n * 2048 + hd * 256 + 8 * hf;
    float A[16], B[16];
    peer_top16(qrow, kl1 + c * PK_KS + 16 * hf, hf, A);
    peer_top16(qrow + 128, kl2 + c * PK_KS + 16 * hf, hf, B);
#define PKV(x) __uint_as_float(__float_as_uint(x) & ~127u)
#define PKI(x) ((int)(__float_as_uint(x) & 127u))
    float W[16];
    { float C0[16], C1[16], C2[16], E0 = 0.f, E1 = 0.f; unsigned id = 0;
#pragma unroll
      for (int a = 0; a < 16; ++a)
#pragma unroll
        for (int b = 0; b < 16; ++b) if ((a + 1) * (b + 1) <= 16) { const float pk = __uint_as_float((__float_as_uint(PKV(A[a]) + PKV(B[b])) & ~63u) | id);
            if (id < 16) C0[id] = pk; else if (id < 32) C1[id - 16] = pk; else if (id < 48) C2[id - 32] = pk; else if (id == 48) E0 = pk; else E1 = pk;
            ++id; }
      sort16_desc(C0); sort16_desc(C1); sort16_desc(C2);
      top16_merge(C0, C1); top16_merge(C0, C2);
#pragma unroll
      for (int i = 0; i < 16; ++i) W[i] = C0[i];
      ins16(W, E0); ins16(W, E1); }
    const float thr = W[15], mx = W[0];
    int cnt = 0; float ssum = 0.f;
    LAS int* le = (LAS int*)ldsw + c * 16; LAS float* lg = (LAS float*)ldsw + 512 + c * 16;
    { unsigned id = 0;
#pragma unroll
      for (int a = 0; a < 16; ++a)
#pragma unroll
        for (int b = 0; b < 16; ++b) if ((a + 1) * (b + 1) <= 16) {
            const float cv = PKV(A[a]) + PKV(B[b]); const float pk = __uint_as_float((__float_as_uint(cv) & ~63u) | id); ++id;
            if (pk >= thr) { const float e = __expf(cv - mx); if (hf == 0) { le[cnt] = PKI(A[a]) * 128 + PKI(B[b]); lg[cnt] = e; } ssum += e; ++cnt; }
        } }
    LDS_WAIT();
    asm volatile("" : "+s"(wsb));
    int* sel_e = (int*)(wsb + WS_SEL); float* sel_g = (float*)(wsb + WS_SEL + 8 * MiB); float* sel_s = (float*)(wsb + WS_SELS);
    { int lane3 = lane; asm volatile("" : "+v"(lane3)); const int t = lane3 >> 1, part = lane3 & 1;
      const v4u e0 = *(const LAS v4u*)((LAS int*)ldsw + t * 16 + 8 * part), e1 = *(const LAS v4u*)((LAS int*)ldsw + t * 16 + 8 * part + 4);
      const v4u g0 = *(const LAS v4u*)((LAS int*)ldsw + 512 + t * 16 + 8 * part), g1 = *(const LAS v4u*)((LAS int*)ldsw + 512 + t * 16 + 8 * part + 4);
      GAS v4u* pe = (GAS v4u*)(sel_e + (size_t)(n0 + t) * 128 + hd * 16 + 8 * part); GAS v4u* pg = (GAS v4u*)(sel_g + (size_t)(n0 + t) * 128 + hd * 16 + 8 * part);
      pe[0] = e0; pe[1] = e1; pg[0] = g0; pg[1] = g1; }
    LDS_WAIT();
    { int lane4 = lane; asm volatile("" : "+v"(lane4)); if ((lane4 >> 5) == 0) ((GAS float*)sel_s)[(size_t)(n0 + (lane4 & 31)) * 8 + hd] = ssum; }
}

__device__ __forceinline__ float dot2bf(unsigned a, unsigned b, float acc) {
    return __builtin_amdgcn_fdot2_f32_bf16(__builtin_bit_cast(bf16v2, a), __builtin_bit_cast(bf16v2, b), acc, false);
}
__device__ __forceinline__ float dot8bf(const v4u a, const v4u b, float acc) {
    const unsigned a0 = a.x, a1 = a.y, a2 = a.z, a3 = a.w, b0 = b.x, b1 = b.y, b2 = b.z, b3 = b.w;
    acc = dot2bf(a0, b0, acc); acc = dot2bf(a1, b1, acc); acc = dot2bf(a2, b2, acc); acc = dot2bf(a3, b3, acc);
    return acc;
}
__device__ __forceinline__ void unpack16(const v4u q, float (&f)[16]) {
    const unsigned d0 = q.x, d1 = q.y, d2 = q.z, d3 = q.w;
    f32x2v t;
    t = __builtin_amdgcn_cvt_pk_f32_fp8((int)d0, false); f[0] = t.x; f[1] = t.y; t = __builtin_amdgcn_cvt_pk_f32_fp8((int)d0, true); f[2] = t.x; f[3] = t.y;
    t = __builtin_amdgcn_cvt_pk_f32_fp8((int)d1, false); f[4] = t.x; f[5] = t.y; t = __builtin_amdgcn_cvt_pk_f32_fp8((int)d1, true); f[6] = t.x; f[7] = t.y;
    t = __builtin_amdgcn_cvt_pk_f32_fp8((int)d2, false); f[8] = t.x; f[9] = t.y; t = __builtin_amdgcn_cvt_pk_f32_fp8((int)d2, true); f[10] = t.x; f[11] = t.y;
    t = __builtin_amdgcn_cvt_pk_f32_fp8((int)d3, false); f[12] = t.x; f[13] = t.y; t = __builtin_amdgcn_cvt_pk_f32_fp8((int)d3, true); f[14] = t.x; f[15] = t.y;
}
struct SliceSched { int mode, xcc, rank, nloc; };
__device__ __forceinline__ SliceSched slice_sched_init(const Ctx& c, unsigned* ctl, const XcdBarrier& bar, int use) {
    LAS int* sh = (LAS int*)(c.lds + 1024);
    if (c.tid == 0) {
        int ok = 1; unsigned tot = 0;
        for (int j = 0; j < 16; ++j) { const unsigned n = xb_ld(&bar.bar[XB_XCNT(j)]); tot += n; if ((j < 8) != (n > 0u)) ok = 0; }
        if (tot != (unsigned)c.G) ok = 0;
        const int xcc = (int)xb_xcc_id();
        int rank = 0, nloc = 1;
        if (ok) { nloc = (int)xb_ld(&bar.bar[XB_XCNT(xcc)]); rank = (int)xb_add(&ctl[CW_RANK + (use * 16 + xcc) * 64], 1u); if (rank >= nloc) ok = 0; }
        sh[0] = ok; sh[1] = xcc; sh[2] = rank; sh[3] = nloc;
    }
    __syncthreads();
    SliceSched S; S.mode = sh[0]; S.xcc = sh[1]; S.rank = sh[2]; S.nloc = sh[3];
    __syncthreads();
    return S;
}
__device__ __forceinline__ bool slice_item(const SliceSched& S, const Ctx& c, int i, int& slice, int& tb) {
    if (S.mode) { const int it = S.rank + i * S.nloc; if (it >= 512) return false; slice = S.xcc + 8 * (it >> 8); tb = it & 255; return true; }
    const int it = (int)blockIdx.x + i * c.G; if (it >= 4096) return false; slice = it >> 8; tb = it & 255; return true;
}
__device__ __forceinline__ void unpack16p(const v4u q, f32x2v (&f)[8]) {
    const unsigned d0 = q.x, d1 = q.y, d2 = q.z, d3 = q.w;
    f[0] = __builtin_amdgcn_cvt_pk_f32_fp8((int)d0, false); f[1] = __builtin_amdgcn_cvt_pk_f32_fp8((int)d0, true);
    f[2] = __builtin_amdgcn_cvt_pk_f32_fp8((int)d1, false); f[3] = __builtin_amdgcn_cvt_pk_f32_fp8((int)d1, true);
    f[4] = __builtin_amdgcn_cvt_pk_f32_fp8((int)d2, false); f[5] = __builtin_amdgcn_cvt_pk_f32_fp8((int)d2, true);
    f[6] = __builtin_amdgcn_cvt_pk_f32_fp8((int)d3, false); f[7] = __builtin_amdgcn_cvt_pk_f32_fp8((int)d3, true);
}
__device__ __forceinline__ void sddmm_load(const unsigned char* ubase, const LAS unsigned* ids16, v4u (&q)[16]) {
    int id[16];
#pragma unroll
    for (int i = 0; i < 4; ++i) { const v4u v = *(const LAS v4u*)(ids16 + 4 * i); id[4 * i] = (int)v.x; id[4 * i + 1] = (int)v.y; id[4 * i + 2] = (int)v.z; id[4 * i + 3] = (int)v.w; }
#pragma unroll
    for (int it = 0; it < 16; ++it) q[it] = *(const GAS v4u*)(ubase + (unsigned)id[it] * 128u);
}
__device__ __forceinline__ void sddmm_token(const v4u (&qc)[16], const v4u hv, const float hs, int lane, unsigned* dst) {
    const int hq[4] = {(int)hv.x, (int)hv.y, (int)hv.z, (int)hv.w};
    float p[16];
#pragma unroll
    for (int it = 0; it < 16; ++it) { int a = __builtin_amdgcn_sdot4((int)qc[it].x, hq[0], 0, false); a = __builtin_amdgcn_sdot4((int)qc[it].y, hq[1], a, false);
        a = __builtin_amdgcn_sdot4((int)qc[it].z, hq[2], a, false); a = __builtin_amdgcn_sdot4((int)qc[it].w, hq[3], a, false);
        p[it] = (float)a * hs; }
#pragma unroll
    for (int i = 0; i < 8; ++i) { const bool up = (lane & 4) != 0; const float snd = up ? p[i] : p[i + 8], kp = up ? p[i + 8] : p[i]; p[i] = kp + __shfl_xor(snd, 4); }
#pragma unroll
    for (int i = 0; i < 4; ++i) { const bool up = (lane & 2) != 0; const float snd = up ? p[i] : p[i + 4], kp = up ? p[i + 4] : p[i]; p[i] = kp + __shfl_xor(snd, 2); }
#pragma unroll
    for (int i = 0; i < 2; ++i) { const bool up = (lane & 1) != 0; const float snd = up ? p[i] : p[i + 2], kp = up ? p[i + 2] : p[i]; p[i] = kp + __shfl_xor(snd, 1); }
    *(GAS unsigned*)dst = pk2c(p[0], p[1]);
}
__device__ __forceinline__ void peer_sddmm_wave(int t0, int s, int lane, const unsigned char* H8, const float* SA, const unsigned char* UQ, const int* sel_e, float* part, LAS unsigned* ldsw) {
    const int cg = lane & 7, sg = lane >> 3;
#pragma unroll
    for (int j = 0; j < 4; ++j) *(LAS v4u*)(ldsw + 4 * (lane + 64 * j)) = *(const GAS v4u*)(sel_e + (size_t)t0 * 128 + 4 * (lane + 64 * j));
    LDS_WAIT();
    const unsigned char* ubase = UQ + (size_t)s * U8_SLICE + cg * 16;
    const LAS unsigned* idl = ldsw + sg * 16;
    const unsigned char* hbase = H8 + (size_t)t0 * 2048 + s * 128 + cg * 16;
    unsigned* pbase = (unsigned*)part + ((size_t)t0 * 16 + s) * 64 + lane;
    v4u qa[16], qb[16];
    v4u ha = *(const GAS v4u*)(hbase), hb; float sa = ((const GAS float*)SA)[t0], sb;
    sddmm_load(ubase, idl, qa);
#pragma unroll
    for (int k = 0; k < 6; k += 2) {
        hb = *(const GAS v4u*)(hbase + (size_t)(k + 1) * 2048); sb = ((const GAS float*)SA)[t0 + k + 1];
        sddmm_load(ubase, idl + (k + 1) * 128, qb);
        sddmm_token(qa, ha, sa, lane, pbase + (size_t)k * 1024);
        ha = *(const GAS v4u*)(hbase + (size_t)(k + 2) * 2048); sa = ((const GAS float*)SA)[t0 + k + 2];
        sddmm_load(ubase, idl + (k + 2) * 128, qa);
        sddmm_token(qb, hb, sb, lane, pbase + (size_t)(k + 1) * 1024);
    }
    hb = *(const GAS v4u*)(hbase + (size_t)7 * 2048); sb = ((const GAS float*)SA)[t0 + 7];
    sddmm_load(ubase, idl + 7 * 128, qb);
    sddmm_token(qa, ha, sa, lane, pbase + (size_t)6 * 1024);
    sddmm_token(qb, hb, sb, lane, pbase + (size_t)7 * 1024);
    LDS_WAIT();
}
__device__ __forceinline__ void peer_coef_tokens4(int t0, int ts, int lane, const float* part, const int* sel_e, float* sel_g, const float* sel_s, const float* US, const float* VS) {
    unsigned pv[4][16]; v2u e[4]; f32x2v g[4]; float dn[4];
#pragma unroll
    for (int i = 0; i < 4; ++i) { const int t = t0 + i * ts;
#pragma unroll
        for (int s = 0; s < 16; ++s) pv[i][s] = ((const GAS unsigned*)part)[((size_t)t * 16 + s) * 64 + lane];
        e[i] = *(const GAS v2u*)(sel_e + (size_t)t * 128 + 2 * lane); g[i] = *(const GAS f32x2v*)(sel_g + (size_t)t * 128 + 2 * lane); dn[i] = ((const GAS float*)sel_s)[(size_t)t * 8 + (lane >> 3)]; }
    float ux[4], uy[4], vx[4], vy[4];
#pragma unroll
    for (int i = 0; i < 4; ++i) { ux[i] = ((const GAS float*)US)[e[i].x]; uy[i] = ((const GAS float*)US)[e[i].y]; vx[i] = ((const GAS float*)VS)[e[i].x]; vy[i] = ((const GAS float*)VS)[e[i].y]; }
#pragma unroll
    for (int i = 0; i < 4; ++i) { const int t = t0 + i * ts; float a0 = 0.f, a1 = 0.f;
#pragma unroll
        for (int s = 0; s < 16; ++s) { a0 += bflo(pv[i][s]); a1 += bfhi(pv[i][s]); }
        const float inv = 1.0f / dn[i];
        const float ox = g[i].x * inv * gelu_exact(a0 * ux[i]) * vx[i], oy = g[i].y * inv * gelu_exact(a1 * uy[i]) * vy[i];
        const h2_t ha = {(_Float16)ox, (_Float16)ox}, hb = {(_Float16)oy, (_Float16)oy};
        *(GAS v2u*)(sel_g + (size_t)t * 128 + 2 * lane) = (v2u){__builtin_bit_cast(unsigned, ha), __builtin_bit_cast(unsigned, hb)}; }
}
__device__ __forceinline__ bool slice_item8(const SliceSched& S, const Ctx& c, int i, int& slice, int& tb) {
    if (S.mode) { const int it = S.rank + i * S.nloc; if (it >= 256) return false; slice = S.xcc; tb = it; return true; }
    const int it = (int)blockIdx.x + i * c.G; if (it >= 2048) return false; slice = it >> 8; tb = it & 255; return true;
}
template <int MODE = 0>
__device__ __forceinline__ void spmm6_load(const unsigned char* vbase, const LAS unsigned* ids8, v4u (&qa)[8], v2u (&qb)[8]) {
    const v4u i0 = *(const LAS v4u*)(ids8), i1 = *(const LAS v4u*)(ids8 + 4);
    const unsigned id[8] = {i0.x, i0.y, i0.z, i0.w, i1.x, i1.y, i1.z, i1.w};
    if constexpr (MODE == 2) {
#pragma unroll
        for (int it = 0; it < 8; ++it) { qa[it] = (v4u){id[it], id[it] + 1u, id[it] + 2u, id[it] + 3u}; qb[it] = (v2u){id[it] + 4u, id[it] + 5u}; }
        return; }
#pragma unroll
    for (int it = 0; it < 8; ++it) { const unsigned char* p = vbase + id[it] * 192u; qa[it] = *(const GAS v4u*)p; qb[it] = *(const GAS v2u*)(p + 16); }
}
template <int MODE = 0>
__device__ __forceinline__ void spmm6_fma(const v4u (&qa)[8], const v2u (&qb)[8], const LAS unsigned* cf8, h2_t (&y)[16]) {
    const v4u c0 = *(const LAS v4u*)(cf8), c1 = *(const LAS v4u*)(cf8 + 4);
    const unsigned cf[8] = {c0.x, c0.y, c0.z, c0.w, c1.x, c1.y, c1.z, c1.w};
    if constexpr (MODE == 1) {
#pragma unroll
        for (int it = 0; it < 8; ++it) { const unsigned x = (qa[it].x ^ qa[it].y) ^ (qa[it].z ^ qa[it].w) ^ (qb[it].x ^ qb[it].y) ^ cf[it]; y[it] = __builtin_bit_cast(h2_t, __builtin_bit_cast(unsigned, y[it]) ^ x); }
        return; }
#pragma unroll
    for (int it = 0; it < 8; ++it) { const v6u q = {qa[it].x, qa[it].y, qa[it].z, qa[it].w, qb[it].x, qb[it].y};
        const v32h_t f = __builtin_amdgcn_cvt_scalef32_pk32_f16_fp6(q, 1.0f); const h2_t c2 = __builtin_bit_cast(h2_t, cf[it]);
#pragma unroll
        for (int j = 0; j < 16; ++j) { const h2_t v = {f[2 * j], f[2 * j + 1]}; y[j] = __builtin_elementwise_fma(v, c2, y[j]); } }
}
template <int MODE = 0>
__device__ __forceinline__ void peer_spmm6_wave(int t0, int s, int lane, const unsigned char* V6, const int* sel_e, const float* coef, const float* x1, float* xout, LAS unsigned* ldsw) {
    const int cg = lane & 7, sg = lane >> 3;
#pragma unroll
    for (int j = 0; j < 4; ++j) { *(LAS v4u*)(ldsw + 4 * (lane + 64 * j)) = *(const GAS v4u*)(sel_e + (size_t)t0 * 128 + 4 * (lane + 64 * j));
        *(LAS v4u*)(ldsw + 1024 + 4 * (lane + 64 * j)) = *(const GAS v4u*)(coef + (size_t)t0 * 128 + 4 * (lane + 64 * j)); }
    LDS_WAIT();
    const unsigned char* vbase = V6 + (size_t)s * V6_SLICE + cg * 24;
    const LAS unsigned* idl = ldsw + sg * 16; const LAS unsigned* cfl = ldsw + 1024 + sg * 16;
    v4u qa0[8], qa1[8]; v2u qb0[8], qb1[8];
    spmm6_load<MODE>(vbase, idl, qa0, qb0);
    const size_t xoff = (size_t)t0 * 2048 + s * 256 + cg * 32 + 4 * sg;
    f32x4 xn = *(const GAS f32x4*)(x1 + xoff);
#pragma unroll
    for (int k = 0; k < 8; ++k) {
        const f32x4 xv = xn;
        h2_t y[16];
#pragma unroll
        for (int j = 0; j < 16; ++j) y[j] = (h2_t){(_Float16)0.f, (_Float16)0.f};
        spmm6_load<MODE>(vbase, idl + k * 128 + 8, qa1, qb1);
        if (k < 7) xn = *(const GAS f32x4*)(x1 + xoff + (size_t)(k + 1) * 2048);
        spmm6_fma<MODE>(qa0, qb0, cfl + k * 128, y);
        if (k < 7) spmm6_load<MODE>(vbase, idl + (k + 1) * 128, qa0, qb0);
        spmm6_fma<MODE>(qa1, qb1, cfl + k * 128 + 8, y);
        unsigned u[16];
#pragma unroll
        for (int j = 0; j < 16; ++j) u[j] = __builtin_bit_cast(unsigned, y[j]);
#pragma unroll
        for (int i = 0; i < 8; ++i) { const bool up = (lane & 32) != 0; const unsigned snd = up ? u[i] : u[i + 8], kp = up ? u[i + 8] : u[i]; u[i] = __builtin_bit_cast(unsigned, __builtin_bit_cast(h2_t, kp) + __builtin_bit_cast(h2_t, (unsigned)__shfl_xor((int)snd, 32))); }
#pragma unroll
        for (int i = 0; i < 4; ++i) { const bool up = (lane & 16) != 0; const unsigned snd = up ? u[i] : u[i + 4], kp = up ? u[i + 4] : u[i]; u[i] = __builtin_bit_cast(unsigned, __builtin_bit_cast(h2_t, kp) + __builtin_bit_cast(h2_t, (unsigned)__shfl_xor((int)snd, 16))); }
#pragma unroll
        for (int i = 0; i < 2; ++i) { const bool up = (lane & 8) != 0; const unsigned snd = up ? u[i] : u[i + 2], kp = up ? u[i + 2] : u[i]; u[i] = __builtin_bit_cast(unsigned, __builtin_bit_cast(h2_t, kp) + __builtin_bit_cast(h2_t, (unsigned)__shfl_xor((int)snd, 8))); }
        const h2_t r0 = __builtin_bit_cast(h2_t, u[0]), r1 = __builtin_bit_cast(h2_t, u[1]);
        f32x4 o; o.x = xv.x + (float)r0[0]; o.y = xv.y + (float)r0[1]; o.z = xv.z + (float)r1[0]; o.w = xv.w + (float)r1[1];
        *(GAS f32x4*)(xout + xoff + (size_t)k * 2048) = o;
    }
    LDS_WAIT();
}

struct Args { const float* in[21]; float* out; unsigned char* ws; int lo, hi, li, pad; };
__global__ void __launch_bounds__(512, 2) mk_fwd(Args args) {
    extern __shared__ __attribute__((aligned(16))) unsigned char lds_raw[];
    Ctx c; c.lds = (LAS unsigned char*)lds_raw; c.tid = threadIdx.x; c.lane = c.tid & 63; c.wave = __builtin_amdgcn_readfirstlane(c.tid >> 6);
    c.G = gridDim.x; c.gw = blockIdx.x * 8 + c.wave; c.NGW = c.G * 8;
    volatile LAS unsigned* MISC = (volatile LAS unsigned*)(c.lds + MISC_OFF);
    if (c.tid < 32) MISC[c.tid] = 0u;
    __syncthreads();
    unsigned char* ws = args.ws;
    const int lo = args.lo, hi = args.hi;
    XcdBarrier bar; bar.w0 = 0; bar.bar = (unsigned*)(ws + WS_CTL) + CW_BAR + args.li * XCD_BAR_WORDS; bar.x = 0; bar.st = nullptr;
    if (hi - lo > 1) bar = xcd_barrier_post((unsigned*)(ws + WS_CTL) + CW_BAR + args.li * XCD_BAR_WORDS, MISC + 8);
#ifndef ATTN_REPS
#define ATTN_REPS 1
#endif
#ifndef PHMASK
#define PHMASK 0x1fff
#endif
#ifndef REP_PH
#define REP_PH (-1)
#endif
    int rep2 = 2; asm volatile("" : "+s"(rep2));
#define RLOOP(k, cond) for (int rp_ = 0; rp_ < ((((k) == REP_PH) && (cond)) ? rep2 : 1); ++rp_)
#define RSYNC do { if (rp_) xcd_barrier(bar); } while (0)
#define IN(k) (((PHMASK >> ((k) % NPH)) & 1) && lo <= (k) && (k) < hi)
#define SEAM(k) do { if (IN(k) && IN((k) + 1)) xcd_barrier(bar); } while (0)
#define PH_BEGIN unsigned char* w = ws; float* outp = args.out; Ctx cc = c; int zi = 0; cc.lane = xb_lane_id(); cc.tid = cc.wave * 64 + cc.lane; \
    asm volatile("" : "+s"(w), "+s"(outp), "+s"(zi), "+v"(cc.tid), "+v"(cc.lane)); (void)w; (void)outp;
#define INP(k) (args.in[(k) + zi])
#define WSP(T, off) ((T*)(w + (off)))
    for (int l = 0; l < 2; ++l) {
        const int pb = l * NPH;
        if (IN(pb + 0)) { PH_BEGIN
            P0Args a; a.w_in = INP(2) + (size_t)l * DM * INW; a.w_br_sb = INP(11) + (size_t)l * BW * DM; a.w_br_hg = INP(12) + (size_t)l * BW * DM; a.w_br_conv = INP(13) + (size_t)l * BW * DM;
            a.w_o = INP(14) + (size_t)l * DM * DM; a.w_q = INP(16) + (size_t)l * DM * DM; a.u = INP(19) + (size_t)l * 16384 * 2048; a.v = INP(20) + (size_t)l * 16384 * 2048; a.lbp = INP(5);
            a.WinT = WSP(bf16, WS_WIN); a.WbrT = WSP(bf16, WS_WBR); a.WoT = WSP(bf16, WS_WO); a.WqT = WSP(bf16, WS_WQ); a.U = WSP(unsigned char, WS_U); a.V = WSP(unsigned char, WS_V); a.US = WSP(float, WS_US); a.VS = WSP(float, WS_VS); a.LB = WSP(float, WS_LB); a.layer = l; a.k1 = INP(17) + (size_t)l * 8 * 16384; a.k2 = INP(18) + (size_t)l * 8 * 16384; a.KB = WSP(bf16, WS_KEYS);
#ifndef REP_MODE0
#define REP_MODE0 15
#endif
            RLOOP(0, true) { RSYNC;
            int pm_ = 15; if (REP_PH == 0) { pm_ = rp_ ? REP_MODE0 : 15; asm volatile("" : "+s"(pm_)); }
            p0_convert(cc, a, pm_);
            if (pm_ & 8) rms_phase_i8(cc, l == 0 ? INP(0) : WSP(const float, WS_X2), INP(1) + (size_t)l * DM, WSP(unsigned char, WS_H), WSP(float, WS_SA)); }
        }
        SEAM(pb + 0);
        if (IN(pb + 1)) { PH_BEGIN
            RLOOP(1, true) { RSYNC;
            pg8::Gemm g{WSP(bf16, WS_H), WSP(bf16, WS_WIN), NTOK, INW, DM}; pg8::StaticOrder S; S.init(NTOK, INW, cc.G, (int)blockIdx.x);
            EpiIn E{WSP(bf16, WS_SEG), WSP(bf16, WS_GATE), WSP(float, WS_LB), WSP(float, WS_SA)};
            pg8::gemm_phase<EpiIn, pg8::StaticOrder, true, true, true>(cc.lds, g, S, E, cc.wave); }
        }
        SEAM(pb + 1);
        if (IN(pb + 2)) { PH_BEGIN
            bf16* SEG = WSP(bf16, WS_SEG);
#ifndef REP_MODE2
#define REP_MODE2 7
#endif
            RLOOP(2, true) { RSYNC;
            int pm_ = 7; if (REP_PH == 2) { pm_ = rp_ ? REP_MODE2 : 7; asm volatile("" : "+s"(pm_)); }
            if (pm_ & 1)
            conv_phase(cc, SEG + 7 * SEGSZ, INP(7) + (size_t)l * 31 * 1024, INP(8) + (size_t)l * 1024, INP(9) + (size_t)l * 1024, INP(10) + (size_t)l * 1024, WSP(bf16, WS_CONV));
            if (pm_ & 2)
            for (int ci = blockIdx.x; ci < 2048; ci += cc.G) hgA_chunk(cc, ci, SEG + 4 * SEGSZ, SEG + 5 * SEGSZ, WSP(bf16, WS_ST), WSP(float, WS_DEC));
            if (!rp_)
            for (int r = cc.gw; r < 2 * (NTOK / 4); r += cc.NGW) {
                if (r < NTOK / 4) qknorm_rows4(SEG + (size_t)r * 4 * 1024, 1024, INP(3) + (size_t)l * 128, 0.08838834764831845f, cc.lane);
                else qknorm_rows4(SEG + SEGSZ + (size_t)(r - NTOK / 4) * 4 * 1024, 1024, INP(4) + (size_t)l * 128, 1.0f, cc.lane);
            }
            LAS unsigned short* scr = (LAS unsigned short*)(cc.lds + 4096 + cc.wave * 8192);
            if (pm_ & 4)
            for (int it = cc.gw; it < 8192; it += cc.NGW) vt_item(it, cc.lane, SEG + 2 * SEGSZ, WSP(bf16, WS_MERGED), scr); }
        }
        SEAM(pb + 2);
        if (IN(pb + 3)) { PH_BEGIN
            bf16* SEG = WSP(bf16, WS_SEG);
            RLOOP(3, true) { RSYNC;
            if (!rp_) hgB(cc, WSP(bf16, WS_ST), WSP(float, WS_DEC));
            for (int p = blockIdx.x; p < 256; p += cc.G) { const int bh = (p & 7) * 4 + (p >> 6), j = (p >> 3) & 7;
                if (cc.wave >= 4) {
#pragma unroll 1
                    for (int u = 0; u < 2; ++u) attn_unit<true>(cc, bh, u ? j : 15 - j, SEG, SEG + SEGSZ, WSP(bf16, WS_MERGED), SEG + 2 * SEGSZ);
                } else {
#pragma unroll 1
                    for (int u = 0; u < 2; ++u) attn_unit<false>(cc, bh, u ? j : 15 - j, SEG, SEG + SEGSZ, WSP(bf16, WS_MERGED), SEG + 2 * SEGSZ);
                } } }
        }
        SEAM(pb + 3);
        if (IN(pb + 4)) { PH_BEGIN
            bf16* SEG = WSP(bf16, WS_SEG);
            RLOOP(4, true) { RSYNC;
            for (int ci = blockIdx.x; ci < 2048; ci += cc.G) hgC_chunk(cc, ci, SEG + 3 * SEGSZ, SEG + 4 * SEGSZ, SEG + 5 * SEGSZ, SEG + 6 * SEGSZ, WSP(bf16, WS_ST), INP(6) + (size_t)l * 128, WSP(bf16, WS_HGR)); }
        }
        SEAM(pb + 4);
        if (IN(pb + 5)) { PH_BEGIN
            RLOOP(5, true) { RSYNC;
            pg8::StaticOrder S; S.init(NTOK, DM, cc.G, (int)blockIdx.x);
            { pg8::Gemm g{WSP(bf16, WS_SEG) + 2 * SEGSZ, WSP(bf16, WS_WBR), NTOK, DM, BW}; EpiMerge<true> E{WSP(bf16, WS_GATE), WSP(bf16, WS_MERGED)}; pg8::gemm_phase<EpiMerge<true>, pg8::StaticOrder, true, true>(cc.lds, g, S, E, cc.wave); }
            { pg8::Gemm g{WSP(bf16, WS_HGR), WSP(bf16, WS_WBR) + (size_t)DM * BW, NTOK, DM, BW}; EpiMerge<false> E{WSP(bf16, WS_GATE) + (size_t)NTOK * 2048, WSP(bf16, WS_MERGED)}; pg8::gemm_phase<EpiMerge<false>, pg8::StaticOrder, true, true>(cc.lds, g, S, E, cc.wave); }
            { pg8::Gemm g{WSP(bf16, WS_CONV), WSP(bf16, WS_WBR) + (size_t)2 * DM * BW, NTOK, DM, BW}; EpiMerge<false> E{WSP(bf16, WS_GATE) + (size_t)2 * NTOK * 2048, WSP(bf16, WS_MERGED)}; pg8::gemm_phase<EpiMerge<false>, pg8::StaticOrder, true, true>(cc.lds, g, S, E, cc.wave); } }
        }
        SEAM(pb + 5);
        if (IN(pb + 6)) { PH_BEGIN
            RLOOP(6, true) { RSYNC;
            pg8::Gemm g{WSP(bf16, WS_MERGED), WSP(bf16, WS_WO), NTOK, DM, DM}; pg8::StaticOrder S; S.init(NTOK, DM, cc.G, (int)blockIdx.x);
            EpiResid E{l == 0 ? INP(0) : WSP(const float, WS_X2), outp};
            pg8::gemm_phase<EpiResid, pg8::StaticOrder, true, true>(cc.lds, g, S, E, cc.wave); }
        }
        SEAM(pb + 6);
        if (IN(pb + 7)) { PH_BEGIN RLOOP(7, true) { RSYNC; rms_phase_i8(cc, outp, INP(15) + (size_t)l * DM, WSP(unsigned char, WS_H), WSP(float, WS_SA)); } }
        SEAM(pb + 7);
        if (IN(pb + 8)) { PH_BEGIN
            RLOOP(8, true) { RSYNC;
            pg8::Gemm g{WSP(bf16, WS_H), WSP(bf16, WS_WQ), NTOK, DM, DM}; pg8::StaticOrder S; S.init(NTOK, DM, cc.G, (int)blockIdx.x);
            EpiStoreBf16 E{WSP(bf16, WS_QPEER), WSP(float, WS_SA)};
            pg8::gemm_phase<EpiStoreBf16, pg8::StaticOrder, true, true, true>(cc.lds, g, S, E, cc.wave); }
        }
        SEAM(pb + 8);
        if (IN(pb + 9)) { PH_BEGIN
            RLOOP(9, true) { RSYNC;
            for (int item = blockIdx.x; item < 512; item += cc.G) { const int hd = item & 7, tg = item >> 3;
                const bf16* KB = WSP(bf16, WS_KEYS);
#pragma unroll
                for (int i = 0; i < 8; ++i) { const int p = cc.tid + 512 * i, li = p >> 11, row = (p >> 4) & 127, c16 = p & 15;
                    *(LAS v4u*)(cc.lds + li * 128 * PK_KS + row * PK_KS + c16 * 16) = *(const GAS v4u*)(KB + (size_t)(li * 8 + hd) * 16384 + row * 128 + c16 * 8); }
                __syncthreads();
                peer_select32(hd, tg * 256 + cc.wave * 32, cc.lane, WSP(bf16, WS_QPEER), cc.lds, cc.lds + 128 * PK_KS, w, (LAS unsigned*)(cc.lds + 2 * 128 * PK_KS + cc.wave * 4096));
                __syncthreads(); } }
        }
        SEAM(pb + 9);
        if (IN(pb + 10)) { PH_BEGIN
            const SliceSched SS = slice_sched_init(cc, (unsigned*)(w + WS_CTL), bar, l * 2 + 0);
            RLOOP(10, true) { RSYNC;
            for (int i = 0;; ++i) { int sl, tb; if (!slice_item(SS, cc, i, sl, tb)) break;
                peer_sddmm_wave(tb * 64 + cc.wave * 8, sl, cc.lane, WSP(unsigned char, WS_H), WSP(float, WS_SA), WSP(unsigned char, WS_U), WSP(int, WS_SEL), WSP(float, WS_PART), (LAS unsigned*)(cc.lds + 4096 + cc.wave * 8192)); } }
        }
        SEAM(pb + 10);
        if (IN(pb + 11)) { PH_BEGIN
            for (int n = cc.gw; n < NTOK / 4; n += cc.NGW) peer_coef_tokens4(n, NTOK / 4, cc.lane, WSP(float, WS_PART), WSP(int, WS_SEL), WSP(float, WS_SEL + 8 * MiB), WSP(float, WS_SELS), WSP(float, WS_US), WSP(float, WS_VS));
        }
        SEAM(pb + 11);
        if (IN(pb + 12)) { PH_BEGIN
            float* xo = l == 0 ? WSP(float, WS_X2) : outp;
            const SliceSched SS = slice_sched_init(cc, (unsigned*)(w + WS_CTL), bar, l * 2 + 1);
#ifndef REP_MODE
#define REP_MODE 0
#endif
            RLOOP(12, l == 0) { RSYNC;
            if (REP_MODE && rp_) {
            for (int i = 0;; ++i) { int sl, tb; if (!slice_item8(SS, cc, i, sl, tb)) break;
                peer_spmm6_wave<REP_MODE>(tb * 64 + cc.wave * 8, sl, cc.lane, WSP(unsigned char, WS_V), WSP(int, WS_SEL), WSP(float, WS_SEL + 8 * MiB), outp, WSP(float, WS_SEG + 64 * MiB), (LAS unsigned*)(cc.lds + 4096 + cc.wave * 8192)); }
            } else
            for (int i = 0;; ++i) { int sl, tb; if (!slice_item8(SS, cc, i, sl, tb)) break;
                peer_spmm6_wave(tb * 64 + cc.wave * 8, sl, cc.lane, WSP(unsigned char, WS_V), WSP(int, WS_SEL), WSP(float, WS_SEL + 8 * MiB), outp, xo, (LAS unsigned*)(cc.lds + 4096 + cc.wave * 8192)); } }
        }
        SEAM(pb + 12);
    }
#undef PH_BEGIN
#undef INP
#undef WSP
#undef IN
#undef SEAM
}

#ifndef MK_SPLIT
#define MK_SPLIT 0
#endif
extern "C" void kernel_launch(void* const* d_in, const int* in_sizes, int n_in, void* d_out, int out_size, void* d_ws, size_t ws_size, hipStream_t stream) {
    static int grid = 0;
    if (grid == 0) {
        if (n_in != 21 || out_size != NTOK * DM || ws_size < WS_END) { fprintf(stderr, "kernel_launch: unexpected shapes (n_in %d, out %d, ws %zu < %zu); nothing launched\n", n_in, out_size, ws_size, (size_t)WS_END); grid = -1; return; }
        int dev = 0, cus = 0, per_cu = 0;
        if (hipGetDevice(&dev) != hipSuccess || hipDeviceGetAttribute(&cus, hipDeviceAttributeMultiprocessorCount, dev) != hipSuccess) { grid = -1; return; }
        if (hipFuncSetAttribute((const void*)mk_fwd, hipFuncAttributeMaxDynamicSharedMemorySize, LDS_BYTES) != hipSuccess) { fprintf(stderr, "kernel_launch: hipFuncSetAttribute failed\n"); grid = -1; return; }
        if (hipOccupancyMaxActiveBlocksPerMultiprocessor(&per_cu, (const void*)mk_fwd, 512, LDS_BYTES) != hipSuccess || per_cu < 1) fprintf(stderr, "kernel_launch: occupancy query reports %d\n", per_cu);
        (void)hipGetLastError();
        grid = cus;
    }
    if (grid < 0) return;
    if (hipMemsetAsync((char*)d_ws + WS_CTL, 0, 1 * MiB, stream) != hipSuccess) { fprintf(stderr, "kernel_launch: memset failed\n"); return; }
    Args a{};
    for (int i = 0; i < 21; ++i) a.in[i] = (const float*)d_in[i];
    a.out = (float*)d_out; a.ws = (unsigned char*)d_ws; a.pad = 0;
#if MK_SPLIT
    for (int p = 0; p < NPHASES; ++p) { a.lo = p; a.hi = p + 1; a.li = p; hipLaunchKernelGGL(mk_fwd, dim3(grid), dim3(512), LDS_BYTES, stream, a); }
#else
    a.lo = 0; a.hi = NPHASES; a.li = 0;
    hipLaunchKernelGGL(mk_fwd, dim3(grid), dim3(512), LDS_BYTES, stream, a);
#endif
    const hipError_t le = hipPeekAtLastError();
    if (le != hipSuccess) fprintf(stderr, "kernel_launch: launch failed: %s\n", hipGetErrorName(le));
}
```

```cpp
#include <hip/hip_runtime.h>
#include <cstdio>
#include <cstdint>
namespace pg8 {
#define PG8_LAS __attribute__((address_space(3)))
typedef unsigned short bf16_t;
typedef short bf16x8 __attribute__((ext_vector_type(8)));
typedef float f32x4 __attribute__((ext_vector_type(4)));
typedef unsigned u32x4 __attribute__((ext_vector_type(4)));
constexpr int BM = 256, BK = 64, HALF = 128, HTB = HALF * BK * 2  , STAGE_BYTES = 8 * HTB, NXCD = 8, WGM = 8;

__host__ __device__ __forceinline__ int lds_byte(int r, int c) { const int st = (r >> 4) * 2 + (c >> 5), rr = r & 15, cc = c & 31, ob = rr * 64 + cc * 2; return st * 1024 + (ob ^ (((ob >> 9) & 1) << 5)); }
__host__ __device__ __forceinline__ void stage_rc(int b, int& R, int& C) { const int st = b / 1024, sb = b % 1024, swz = sb ^ (((sb >> 9) & 1) << 5); R = (st >> 1) * 16 + swz / 64; C = (st & 1) * 32 + (swz % 64) / 2; }
__host__ __device__ __forceinline__ int perm32(int rho) { const int n = rho >> 4, i = rho & 15; return 8 * (i >> 2) + 4 * n + (i & 3); }

struct Unit { int pm, pn; };
struct Gemm { const bf16_t* A; const bf16_t* Bt; int M, N, K; };

struct StaticOrder {
    int nM, nN, nwg, G, c;
    __host__ __device__ void init(int M, int N, int G_, int c_) { nM = M / BM; nN = N / BM; nwg = nM * nN; G = G_; c = c_; }
    __host__ __device__ bool next(int i, Unit& u) const {
        const long L = (long)i * G + c; if (L >= nwg) return false;
        int wgid = (int)L; { const int q = nwg / NXCD, r = nwg % NXCD, xcd = wgid % NXCD, off = wgid / NXCD; wgid = (xcd < r ? xcd * (q + 1) : r * (q + 1) + (xcd - r) * q) + off; }
        const int nig = WGM * nN, gid = wgid / nig, fm = gid * WGM, gsz = (nM - fm) < WGM ? (nM - fm) : WGM;
        u.pm = fm + ((wgid % nig) % gsz); u.pn = (wgid % nig) / gsz; return true;
    }
    __device__ __forceinline__ void a_ready(const Unit&) const {}
    __device__ __forceinline__ void done(const Unit&) const {}
};

typedef float f32x2 __attribute__((ext_vector_type(2)));
template <class Epi, class Sched, bool ALIGN_EPI = false, bool SP2 = false, bool I8 = false>
__device__ __forceinline__ void gemm_phase(PG8_LAS unsigned char* lds, const Gemm g, const Sched& S, const Epi& E, int wave_) {
    unsigned z_ = 0u; asm volatile("" : "+s"(z_)); int tid_ = wave_ * 64 + (int)__builtin_amdgcn_mbcnt_hi(~0u, __builtin_amdgcn_mbcnt_lo(~0u, z_)); asm volatile("" : "+v"(tid_));     int K_ = g.K; asm volatile("" : "+s"(K_));
    const int tid = tid_, wid = __builtin_amdgcn_readfirstlane(tid >> 6), lane = tid & 63, wr = wid >> 2, wc = wid & 3, fr = lane & 15, fq = lane >> 4;
    const int K = I8 ? (K_ >> 1) : K_, nt = K / BK;
    unsigned voffA[2], voffB[2];
#pragma unroll
    for (int i = 0; i < 2; ++i) { int R, C; stage_rc(tid * 16 + i * 8192, R, C); const int Rb = Epi::PERM ? ((R & ~31) + perm32(R & 31)) : R;
        voffA[i] = (unsigned)(R * K + C) * 2u; voffB[i] = (unsigned)(Rb * K + C) * 2u; }
    const size_t kstep = (size_t)(BK * 2);
    const size_t hstep = (size_t)HALF * K * 2;
    const size_t tstep = 2 * hstep;
    const unsigned ldsw = (unsigned)wid * 1024u;
    const int aoff = lds_byte(wr * 64 + fr, fq * 8), boff = lds_byte(wc * 32 + fr, fq * 8);
#define PG8_SA(b, h) (((b) * 2 + (h)) * HTB)
#define PG8_SB(b, h) ((4 + (b) * 2 + (h)) * HTB)
#define PG8_STAGE(bufoff, gbase, voff) do { _Pragma("unroll") for (int _i = 0; _i < 2; ++_i) \
        __builtin_amdgcn_global_load_lds((const unsigned*)((const char*)(gbase) + (voff)[_i]), (PG8_LAS unsigned*)(lds + (bufoff) + ldsw + _i * 8192), 16, 0, 0); } while (0)
#define PG8_LDA(dst, b, h) do { _Pragma("unroll") for (int m = 0; m < 4; ++m) _Pragma("unroll") for (int k = 0; k < 2; ++k) dst[m][k] = *(const PG8_LAS bf16x8*)(lds + PG8_SA(b, h) + aoff + m * 2048 + k * 1024); } while (0)
#define PG8_LDB(dst, b, h) do { _Pragma("unroll") for (int n = 0; n < 2; ++n) _Pragma("unroll") for (int k = 0; k < 2; ++k) dst[n][k] = *(const PG8_LAS bf16x8*)(lds + PG8_SB(b, h) + boff + n * 2048 + k * 1024); } while (0)
#define PG8_MMA(ai, bj, At, Bt) do { __builtin_amdgcn_s_setprio(1); _Pragma("unroll") for (int m = 0; m < 4; ++m) _Pragma("unroll") for (int n = 0; n < 2; ++n) _Pragma("unroll") for (int k = 0; k < 2; ++k) { \
        if constexpr (I8) { typedef int v4i_t __attribute__((ext_vector_type(4))); \
            acc[ai][bj][m][n] = __builtin_bit_cast(f32x4, __builtin_amdgcn_mfma_i32_16x16x64_i8(__builtin_bit_cast(v4i_t, Bt[n][k]), __builtin_bit_cast(v4i_t, At[m][k]), __builtin_bit_cast(v4i_t, acc[ai][bj][m][n]), 0, 0, 0)); } \
        else acc[ai][bj][m][n] = __builtin_amdgcn_mfma_f32_16x16x32_bf16(Bt[n][k], At[m][k], acc[ai][bj][m][n], 0, 0, 0); } __builtin_amdgcn_s_setprio(0); } while (0)
#define PG8_WAIT_V(n) asm volatile("s_waitcnt vmcnt(" #n ")" ::: "memory")
#define PG8_WAIT_L(n) asm volatile("s_waitcnt lgkmcnt(" #n ")" ::: "memory")
#define PG8_BAR __builtin_amdgcn_s_barrier()
#define PG8_SCHED __builtin_amdgcn_sched_barrier(0)
    Unit cur, nxt; int ui = 0;
    if (!S.next(0, cur)) return;
    cur.pm = __builtin_amdgcn_readfirstlane(cur.pm); cur.pn = __builtin_amdgcn_readfirstlane(cur.pn);
    f32x4 acc[2][2][4][2];
#pragma unroll
    for (int a = 0; a < 2; ++a)
#pragma unroll
        for (int b = 0; b < 2; ++b)
#pragma unroll
            for (int m = 0; m < 4; ++m)
#pragma unroll
                for (int n = 0; n < 2; ++n) acc[a][b][m][n] = (f32x4){0.f, 0.f, 0.f, 0.f};
    bf16x8 At[4][2], B0[2][2], B1[2][2];
    const char* cA = (const char*)g.A + (size_t)cur.pm * tstep; const char* cB = (const char*)g.Bt + (size_t)cur.pn * tstep;
    S.a_ready(cur);
    if constexpr (SP2) {
        PG8_STAGE(PG8_SB(0, 0), cB, voffB); PG8_STAGE(PG8_SB(0, 1), cB + hstep, voffB); PG8_STAGE(PG8_SA(0, 0), cA, voffA); PG8_STAGE(PG8_SA(0, 1), cA + hstep, voffA);
        if (wr == 1) PG8_BAR;
        PG8_WAIT_V(2); PG8_BAR;
        PG8_STAGE(PG8_SB(1, 0), cB + kstep, voffB); PG8_STAGE(PG8_SA(1, 0), cA + kstep, voffA); PG8_STAGE(PG8_SB(1, 1), cB + hstep + kstep, voffB);
        PG8_WAIT_V(6); PG8_BAR;
    } else {
        PG8_STAGE(PG8_SB(0, 0), cB, voffB); PG8_STAGE(PG8_SA(0, 0), cA, voffA); PG8_STAGE(PG8_SB(0, 1), cB + hstep, voffB); PG8_STAGE(PG8_SA(0, 1), cA + hstep, voffA);
        if (wr == 1) PG8_BAR;
        PG8_WAIT_V(4); PG8_BAR;
        PG8_STAGE(PG8_SB(1, 0), cB + kstep, voffB); PG8_STAGE(PG8_SA(1, 0), cA + kstep, voffA); PG8_STAGE(PG8_SB(1, 1), cB + hstep + kstep, voffB);
        PG8_WAIT_V(6); PG8_BAR;
    }
    for (;;) {
        const bool has_next = S.next(ui + 1, nxt);
        nxt.pm = __builtin_amdgcn_readfirstlane(nxt.pm); nxt.pn = __builtin_amdgcn_readfirstlane(nxt.pn);
        const char* nA = has_next ? (const char*)g.A + (size_t)nxt.pm * tstep : cA; const char* nB = has_next ? (const char*)g.Bt + (size_t)nxt.pn * tstep : cB;
        for (int t = 0; t < nt; t += 2) {
            const bool last = (t == nt - 2);
            const char* a1 = cA + (size_t)(t + 1) * kstep;
            const char* a2 = last ? nA : cA + (size_t)(t + 2) * kstep; const char* b2 = last ? nB : cB + (size_t)(t + 2) * kstep;
            const char* a3 = a2 + kstep; const char* b3 = b2 + kstep;
            if (last && has_next) S.a_ready(nxt);
            if constexpr (SP2) {
            PG8_LDB(B0, 0, 0); PG8_LDB(B1, 0, 1); PG8_SCHED; PG8_LDA(At, 0, 0); PG8_STAGE(PG8_SA(1, 1), a1 + hstep, voffA);
            PG8_WAIT_V(8); PG8_WAIT_L(0); PG8_BAR; PG8_MMA(0, 0, At, B0); PG8_MMA(0, 1, At, B1); PG8_BAR; PG8_SCHED;
            PG8_LDA(At, 0, 1); PG8_STAGE(PG8_SB(0, 0), b2, voffB); PG8_STAGE(PG8_SB(0, 1), b2 + hstep, voffB); PG8_STAGE(PG8_SA(0, 0), a2, voffA);
            PG8_WAIT_V(8); PG8_WAIT_L(0); PG8_BAR; PG8_MMA(1, 0, At, B0); PG8_MMA(1, 1, At, B1); PG8_BAR; PG8_SCHED;
            PG8_LDB(B0, 1, 0); PG8_LDB(B1, 1, 1); PG8_SCHED; PG8_LDA(At, 1, 0); PG8_STAGE(PG8_SA(0, 1), a2 + hstep, voffA);
            PG8_WAIT_V(8); PG8_WAIT_L(0); PG8_BAR; PG8_MMA(0, 0, At, B0); PG8_MMA(0, 1, At, B1); PG8_BAR; PG8_SCHED;
            PG8_LDA(At, 1, 1); PG8_STAGE(PG8_SB(1, 0), b3, voffB); PG8_STAGE(PG8_SB(1, 1), b3 + hstep, voffB); PG8_STAGE(PG8_SA(1, 0), a3, voffA);
            PG8_WAIT_V(8); PG8_WAIT_L(0); PG8_BAR; PG8_MMA(1, 0, At, B0); PG8_MMA(1, 1, At, B1); PG8_BAR; PG8_SCHED;
            } else {
            PG8_LDB(B0, 0, 0); PG8_SCHED; PG8_LDA(At, 0, 0); PG8_STAGE(PG8_SA(1, 1), a1 + hstep, voffA);
            PG8_WAIT_L(8); PG8_BAR; PG8_WAIT_L(0); PG8_MMA(0, 0, At, B0); PG8_BAR; PG8_SCHED;
            PG8_LDB(B1, 0, 1); PG8_STAGE(PG8_SB(0, 0), b2, voffB);
            PG8_BAR; PG8_WAIT_L(0); PG8_MMA(0, 1, At, B1); PG8_BAR;
            PG8_LDA(At, 0, 1); PG8_STAGE(PG8_SA(0, 0), a2, voffA);
            PG8_BAR; PG8_WAIT_L(0); PG8_MMA(1, 0, At, B0); PG8_BAR; PG8_SCHED;
            PG8_STAGE(PG8_SB(0, 1), b2 + hstep, voffB);
            PG8_WAIT_V(6); PG8_BAR; PG8_MMA(1, 1, At, B1); PG8_BAR;
            PG8_LDB(B0, 1, 0); PG8_SCHED; PG8_LDA(At, 1, 0); PG8_STAGE(PG8_SA(0, 1), a2 + hstep, voffA);
            PG8_WAIT_L(8); PG8_BAR; PG8_WAIT_L(0); PG8_MMA(0, 0, At, B0); PG8_BAR; PG8_SCHED;
            PG8_LDB(B1, 1, 1); PG8_STAGE(PG8_SB(1, 0), b3, voffB);
            PG8_BAR; PG8_WAIT_L(0); PG8_MMA(0, 1, At, B1); PG8_BAR;
            PG8_LDA(At, 1, 1); PG8_STAGE(PG8_SA(1, 0), a3, voffA);
            PG8_BAR; PG8_WAIT_L(0); PG8_MMA(1, 0, At, B0); PG8_BAR; PG8_SCHED;
            PG8_STAGE(PG8_SB(1, 1), b3 + hstep, voffB);
            PG8_WAIT_V(6); PG8_BAR; PG8_MMA(1, 1, At, B1); PG8_BAR;
            }
        }
        if constexpr (ALIGN_EPI) { if (wr == 0) PG8_BAR; }
        if constexpr (I8) {
#pragma unroll
            for (int a = 0; a < 2; ++a)
#pragma unroll
                for (int m = 0; m < 4; ++m) { const float r_ = E.rowscale(cur.pm * BM + wr * 64 + fr + a * HALF + m * 16);
#pragma unroll
                    for (int b = 0; b < 2; ++b)
#pragma unroll
                        for (int n = 0; n < 2; ++n) { typedef int v4i2_t __attribute__((ext_vector_type(4))); const v4i2_t i_ = __builtin_bit_cast(v4i2_t, acc[a][b][m][n]);
                            acc[a][b][m][n] = (f32x4){(float)i_[0] * r_, (float)i_[1] * r_, (float)i_[2] * r_, (float)i_[3] * r_}; } }
        }
        if constexpr (!Epi::AFTER_DRAIN) { E(acc, cur, wr, wc, fr, fq); S.done(cur); }
        if (!has_next) break;
#pragma unroll
        for (int a = 0; a < 2; ++a)
#pragma unroll
            for (int b = 0; b < 2; ++b)
#pragma unroll
                for (int m = 0; m < 4; ++m)
#pragma unroll
                    for (int n = 0; n < 2; ++n) acc[a][b][m][n] = (f32x4){0.f, 0.f, 0.f, 0.f};
        cur = nxt; cA = nA; cB = nB; ++ui;
        if constexpr (ALIGN_EPI) { if (wr == 1) PG8_BAR; }
    }
    PG8_WAIT_V(0);
    if constexpr (!ALIGN_EPI) { if (wr == 0) PG8_BAR; }
    PG8_BAR;
    if constexpr (Epi::AFTER_DRAIN) { E.fused(acc, cur, wr, wc, fr, fq, lds, wid, lane); S.done(cur); }
#undef PG8_SA
#undef PG8_SB
#undef PG8_STAGE
#undef PG8_LDA
#undef PG8_LDB
#undef PG8_MMA
#undef PG8_WAIT_V
#undef PG8_WAIT_L
#undef PG8_BAR
#undef PG8_SCHED
}
}
#define XB_TMO      128
#define XB_XCNT(j)  (256  + 64 * (j))
#define XB_XSUB(j)  (1280 + 64 * (j))
#define XB_XGEN(j)  (2304 + 64 * (j))
#define XB_TOP      3328
#define XB_TOPGEN   3392
#define XCD_BAR_WORDS 3456
#define XB_SPIN_CAP (1u << 24)
#define LAS __attribute__((address_space(3)))

__device__ __forceinline__ unsigned xb_ld(unsigned* p)              { return __hip_atomic_load(p, __ATOMIC_RELAXED, __HIP_MEMORY_SCOPE_AGENT); }
__device__ __forceinline__ unsigned xb_add(unsigned* p, unsigned v) { return __hip_atomic_fetch_add(p, v, __ATOMIC_RELAXED, __HIP_MEMORY_SCOPE_AGENT); }
__device__ __forceinline__ unsigned xb_xcc_id() { return (unsigned)__builtin_amdgcn_s_getreg((3 << 11) | 20) & 0xFu; }
#define XB_SPIN(cond, bar) do { unsigned _sp = 0; while (cond) { __builtin_amdgcn_s_sleep(1); \
    if ((++_sp & 255u) == 0u) { if (xb_ld(&(bar)[XB_TMO])) break; if (_sp > XB_SPIN_CAP) { atomicAdd(&(bar)[XB_TMO], 1u); break; } } } } while (0)

__device__ __forceinline__ int xb_lane_id() { unsigned z = 0u; asm volatile("" : "+s"(z)); return (int)__builtin_amdgcn_mbcnt_hi(~0u, __builtin_amdgcn_mbcnt_lo(~0u, z)); }
struct XcdBarrier {
    unsigned w0;
    unsigned* bar; unsigned x;
    volatile LAS unsigned* st;
};

__device__ __forceinline__ XcdBarrier xcd_barrier_post(unsigned* bar, volatile LAS unsigned* st) {
    XcdBarrier b; b.bar = bar; b.x = xb_xcc_id(); b.st = st; b.w0 = (__builtin_amdgcn_readfirstlane((int)threadIdx.x >> 6) == 0) ? 1u : 0u;
    if (b.w0 && xb_lane_id() == 0) (void)xb_add(&bar[XB_XCNT(b.x)], 1u);
    return b;
}
__device__ __forceinline__ void xcd_barrier_complete(unsigned* bar, unsigned x, unsigned& nloc, unsigned& nx) {
    const unsigned G = gridDim.x * gridDim.y * gridDim.z;
    unsigned sum, cnt, mine, sp = 0u;
    for (;;) {
        sum = 0u; cnt = 0u; mine = 0u;
#pragma unroll
        for (unsigned j = 0; j < 16; ++j) { const unsigned c = xb_ld(&bar[XB_XCNT(j)]); sum += c; cnt += (c > 0u) ? 1u : 0u; mine = (j == x) ? c : mine; }
        if (sum == G) break;
        __builtin_amdgcn_s_sleep(1);
        if ((++sp & 255u) == 0u) { if (xb_ld(&bar[XB_TMO])) break; if (sp > XB_SPIN_CAP) { atomicAdd(&bar[XB_TMO], 1u); break; } }
    }
    nloc = mine > 0u ? mine : 1u; nx = cnt > 0u ? cnt : 1u;
}

__device__ __forceinline__ void xcd_barrier(const XcdBarrier& b) {
    asm volatile("s_waitcnt vmcnt(0)" ::: "memory");
    __syncthreads();
    if (b.w0 && xb_lane_id() == 0) {
        unsigned* bar = b.bar;
        __builtin_amdgcn_s_waitcnt(0);
        unsigned nloc = b.st[0], nx = b.st[1];
        if (nloc == 0u) { xcd_barrier_complete(bar, b.x, nloc, nx); b.st[0] = nloc; b.st[1] = nx; }
        const unsigned old = xb_add(&bar[XB_XSUB(b.x)], 1u);
        const unsigned gen = old / nloc;
        if (old + 1u == (gen + 1u) * nloc) {
            __builtin_amdgcn_fence(__ATOMIC_RELEASE, "agent");
            asm volatile("s_waitcnt vmcnt(0)" ::: "memory");
            const unsigned og = xb_add(&bar[XB_TOP], 1u);
            const unsigned tg = og / nx;
            if (og + 1u == (tg + 1u) * nx) xb_add(&bar[XB_TOPGEN], 1u);
            else XB_SPIN(xb_ld(&bar[XB_TOPGEN]) == tg, bar);
            __builtin_amdgcn_fence(__ATOMIC_ACQUIRE, "agent");
            xb_add(&bar[XB_XGEN(b.x)], 1u);
            asm volatile("s_waitcnt vmcnt(0)" ::: "memory");
        } else {
            XB_SPIN(xb_ld(&bar[XB_XGEN(b.x)]) == gen, bar);
            __builtin_amdgcn_fence(__ATOMIC_ACQUIRE, "agent");
            asm volatile("s_waitcnt vmcnt(0)" ::: "memory");
        }
    }
    __syncthreads();
}


#define GAS __attribute__((address_space(1)))
typedef unsigned short bf16;
typedef unsigned v4u __attribute__((ext_vector_type(4)));
typedef unsigned v2u __attribute__((ext_vector_type(2)));
typedef float f32x4 __attribute__((ext_vector_type(4)));
typedef float f32x2v __attribute__((ext_vector_type(2)));
typedef float f32x16 __attribute__((ext_vector_type(16)));
typedef short bf16x8 __attribute__((ext_vector_type(8)));
typedef __bf16 bf16v2 __attribute__((ext_vector_type(2)));
typedef _Float16 h2_t __attribute__((ext_vector_type(2)));
typedef _Float16 v32h_t __attribute__((ext_vector_type(32)));
typedef unsigned v6u __attribute__((ext_vector_type(6)));

constexpr int NTOK = 16384, DM = 2048, SEQ = 4096, INW = 15360, BW = 1024;
constexpr float EPS = 1e-6f;
constexpr float WIN_QS = 1024.0f;
constexpr int NPH = 13;
constexpr int NPHASES = 2 * NPH;

constexpr size_t MiB = 1u << 20;
constexpr size_t WS_CTL = 0;
constexpr size_t WS_LB = 1 * MiB;
constexpr size_t WS_SA = 1 * MiB + 192 * 1024;
constexpr size_t WS_US = 1 * MiB + 64 * 1024, WS_VS = 1 * MiB + 128 * 1024;
constexpr size_t WS_WIN = 2 * MiB;
constexpr size_t WS_WBR = 62 * MiB;
constexpr size_t WS_WO = 74 * MiB;
constexpr size_t WS_WQ = 82 * MiB;
constexpr size_t WS_U = 91 * MiB;
constexpr size_t WS_V = 155 * MiB;
constexpr size_t WS_H = 219 * MiB;
constexpr size_t WS_SEG = 283 * MiB;
constexpr size_t WS_GATE = 539 * MiB;
constexpr size_t WS_X2 = 731 * MiB;
constexpr size_t WS_CONV = 859 * MiB;
constexpr size_t WS_HGR = 891 * MiB;
constexpr size_t WS_MERGED = 923 * MiB;
constexpr size_t WS_SEL = 987 * MiB;
constexpr size_t WS_SELS = 1003 * MiB;
constexpr size_t WS_DEC = 1004 * MiB;
constexpr size_t WS_END = 1005 * MiB;
constexpr size_t WS_ST = WS_H;
constexpr size_t WS_KEYS = 90 * MiB;
constexpr size_t WS_PART = WS_GATE;
constexpr size_t WS_QPEER = WS_SEG;
constexpr size_t SEGSZ = (size_t)NTOK * 1024;
constexpr int CW_BAR = 4096;
constexpr int CW_RANK = 131072;

constexpr int RING_BYTES = 131072, MISC_OFF = RING_BYTES + 320, LDS_BYTES = 147456;

__device__ __forceinline__ unsigned pk2c(float lo, float hi) { f32x2v v = {lo, hi}; bf16v2 b = __builtin_convertvector(v, bf16v2); return __builtin_bit_cast(unsigned, b); }
__device__ __forceinline__ float bflo(unsigned x) { return __uint_as_float(x << 16); }
__device__ __forceinline__ float bfhi(unsigned x) { return __uint_as_float(x & 0xffff0000u); }
__device__ __forceinline__ float sigm(float x) { return __builtin_amdgcn_rcpf(1.0f + __expf(-x)); }
__device__ __forceinline__ float wave_sum(float v) {
#pragma unroll
    for (int o = 1; o < 64; o <<= 1) v += __shfl_xor(v, o);
    return v;
}
__device__ __forceinline__ float wave_max(float v) {
#pragma unroll
    for (int o = 1; o < 64; o <<= 1) v = fmaxf(v, __shfl_xor(v, o));
    return v;
}
#define LDS_WAIT() asm volatile("s_waitcnt lgkmcnt(0)" ::: "memory")
#define MFMA32(a, b, c) __builtin_amdgcn_mfma_f32_32x32x16_bf16((a), (b), (c), 0, 0, 0)
__device__ __forceinline__ int ridx16(int lane) { return ((lane >> 5) & 1) * 8 + ((lane >> 4) & 1) * 4 + ((lane >> 3) & 1) * 2 + ((lane >> 2) & 1); }
__device__ __forceinline__ void xreduce16(float (&v)[16], int lane) {
#pragma unroll
    for (int i = 0; i < 8; ++i) { const bool up = (lane & 32) != 0; const float snd = up ? v[i] : v[i + 8], kp = up ? v[i + 8] : v[i]; v[i] = kp + __shfl_xor(snd, 32); }
#pragma unroll
    for (int i = 0; i < 4; ++i) { const bool up = (lane & 16) != 0; const float snd = up ? v[i] : v[i + 4], kp = up ? v[i + 4] : v[i]; v[i] = kp + __shfl_xor(snd, 16); }
#pragma unroll
    for (int i = 0; i < 2; ++i) { const bool up = (lane & 8) != 0; const float snd = up ? v[i] : v[i + 2], kp = up ? v[i + 2] : v[i]; v[i] = kp + __shfl_xor(snd, 8); }
    { const bool up = (lane & 4) != 0; const float snd = up ? v[0] : v[1], kp = up ? v[1] : v[0]; v[0] = kp + __shfl_xor(snd, 4); }
    v[0] += __shfl_xor(v[0], 2); v[0] += __shfl_xor(v[0], 1);
}
__device__ __forceinline__ float gelu_exact(float v) {
    const float av = fabsf(v), t = __builtin_amdgcn_rcpf(av * 0.2316418882f + 1.0f);
    float q = t * 0.5307027145f + (-0.7265760135f); q = q * t + 0.7107068705f; q = q * t + (-0.142248368f); q = q * t + 0.127414796f; q = q * t;
    const float e = __builtin_amdgcn_exp2f((v * v) * (-0.72134752044f));
    const float m = v * (q * e);
    return v < 0.f ? m : v - m;
}

struct Ctx { LAS unsigned char* lds; int tid, lane, wave, G, gw, NGW; };

__device__ __forceinline__ void tr_item(const float* W, int K, int N, bf16* WT, int k0, int n0, int drow0, LAS float* scr, int lane) {
    { const int lr = lane >> 3, lc = (lane & 7) * 4; f32x4 v[8];
#pragma unroll
      for (int j = 0; j < 8; ++j) v[j] = *(const GAS f32x4*)(W + (size_t)(k0 + lr + 8 * j) * N + n0 + lc);
#pragma unroll
      for (int j = 0; j < 8; ++j) { LAS float* d = scr + (lr + 8 * j) * 33 + lc; d[0] = v[j].x; d[1] = v[j].y; d[2] = v[j].z; d[3] = v[j].w; } }
    LDS_WAIT();
    const int c = lane & 7;
#pragma unroll
    for (int j = 0; j < 4; ++j) { const int n = (lane >> 3) + 8 * j; const LAS float* s = scr + (8 * c) * 33 + n;
        v4u o; o.x = pk2c(s[0], s[33]); o.y = pk2c(s[66], s[99]); o.z = pk2c(s[132], s[165]); o.w = pk2c(s[198], s[231]);
        *(GAS v4u*)(WT + (size_t)(drow0 + n) * K + k0 + 8 * c) = o; }
    LDS_WAIT();
}
__device__ __forceinline__ unsigned pack_i8x4c(float a, float b, float c, float d) {
    const int ia = (int)__builtin_rintf(fminf(fmaxf(a, -127.f), 127.f)), ib = (int)__builtin_rintf(fminf(fmaxf(b, -127.f), 127.f)), ic = (int)__builtin_rintf(fminf(fmaxf(c, -127.f), 127.f)), id = (int)__builtin_rintf(fminf(fmaxf(d, -127.f), 127.f));
    return ((unsigned)ia & 255u) | (((unsigned)ib & 255u) << 8) | (((unsigned)ic & 255u) << 16) | ((unsigned)id << 24);
}
__device__ __forceinline__ void tr_item_i8(const float* W, int K, int N, unsigned char* WT, int k0, int n0, int drow0, float scale, LAS float* scr, int lane) {
    { const int lr = lane >> 3, lc = (lane & 7) * 4; f32x4 v[16];
#pragma unroll
      for (int j = 0; j < 16; ++j) v[j] = *(const GAS f32x4*)(W + (size_t)(k0 + lr + 8 * j) * N + n0 + lc);
#pragma unroll
      for (int j = 0; j < 16; ++j) { LAS float* d = scr + (lr + 8 * j) * 32 + (lc ^ ((j & 7) << 2)); const int x = lr & 3; d[x] = v[j].x; d[1 ^ x] = v[j].y; d[2 ^ x] = v[j].z; d[3 ^ x] = v[j].w; } }
    LDS_WAIT();
    const int c = lane & 15;
#pragma unroll
    for (int j = 0; j < 8; ++j) { const int n = (lane >> 4) + 4 * j, q = n ^ ((c & 7) << 2); const LAS float* s = scr + (8 * c) * 32;
        v2u o; o.x = pack_i8x4c(s[q] * scale, s[32 + (q ^ 1)] * scale, s[64 + (q ^ 2)] * scale, s[96 + (q ^ 3)] * scale); o.y = pack_i8x4c(s[128 + q] * scale, s[160 + (q ^ 1)] * scale, s[192 + (q ^ 2)] * scale, s[224 + (q ^ 3)] * scale);
        *(GAS v2u*)(WT + (size_t)(drow0 + n) * K + k0 + 8 * c) = o; }
    LDS_WAIT();
}
__device__ __forceinline__ int win_drow(int n) { if (n < 7168 || n >= 9216) return n; const int r = n - 7168, isb = r >> 10, c = r & 1023; return 7168 + (c >> 7) * 256 + isb * 128 + (c & 127); }
__device__ __forceinline__ void cvt_copy(const Ctx& c, const float* src, bf16* dst, size_t n8) {
    const size_t NT = (size_t)c.G * 512;
    for (size_t i = (size_t)blockIdx.x * 512 + c.tid; i < n8; i += NT) {
        const f32x4 a = ((const GAS f32x4*)src)[2 * i], b = ((const GAS f32x4*)src)[2 * i + 1];
        v4u o; o.x = pk2c(a.x, a.y); o.y = pk2c(a.z, a.w); o.z = pk2c(b.x, b.y); o.w = pk2c(b.z, b.w);
        ((GAS v4u*)dst)[i] = o;
    }
}
__device__ __forceinline__ void rms_row(const float* xr, const float* w, bf16* o, int lane) {
    const GAS f32x4* xp = (const GAS f32x4*)xr + lane; f32x4 v[8]; float s = 0.f;
#pragma unroll
    for (int j = 0; j < 8; ++j) { v[j] = xp[64 * j]; s += (v[j].x * v[j].x + v[j].y * v[j].y) + (v[j].z * v[j].z + v[j].w * v[j].w); }
    const float r = __builtin_amdgcn_rsqf(wave_sum(s) * (1.0f / DM) + EPS);
    const GAS f32x4* wp = (const GAS f32x4*)w + lane; GAS v2u* op = (GAS v2u*)o + lane;
#pragma unroll
    for (int j = 0; j < 8; ++j) { const f32x4 wv = wp[64 * j]; v2u q; q.x = pk2c(v[j].x * r * wv.x, v[j].y * r * wv.y); q.y = pk2c(v[j].z * r * wv.z, v[j].w * r * wv.w); op[64 * j] = q; }
}
__device__ __forceinline__ void rms_row_i8(const float* xr, const float* w, unsigned char* o, float* sa, int lane) {
    const GAS f32x4* xp = (const GAS f32x4*)xr + lane; f32x4 v[8]; float s = 0.f;
#pragma unroll
    for (int j = 0; j < 8; ++j) { v[j] = xp[64 * j]; s += (v[j].x * v[j].x + v[j].y * v[j].y) + (v[j].z * v[j].z + v[j].w * v[j].w); }
    const float r = __builtin_amdgcn_rsqf(wave_sum(s) * (1.0f / DM) + EPS);
    const GAS f32x4* wp = (const GAS f32x4*)w + lane; float m = 0.f;
#pragma unroll
    for (int j = 0; j < 8; ++j) { const f32x4 wv = wp[64 * j]; v[j].x *= r * wv.x; v[j].y *= r * wv.y; v[j].z *= r * wv.z; v[j].w *= r * wv.w;
        m = fmaxf(fmaxf(m, fmaxf(fabsf(v[j].x), fabsf(v[j].y))), fmaxf(fabsf(v[j].z), fabsf(v[j].w))); }
    m = wave_max(m);
    const float inv = m > 0.f ? 127.0f / m : 0.f;
    if (lane == 0) *(GAS float*)sa = m * (1.0f / 127.0f);
#pragma unroll
    for (int j = 0; j < 8; ++j) ((GAS unsigned*)o)[lane + 64 * j] = pack_i8x4c(v[j].x * inv, v[j].y * inv, v[j].z * inv, v[j].w * inv);
}
__device__ __forceinline__ void rms_rows2_i8(const float* xa, const float* xb, const float* w, unsigned char* oa, unsigned char* ob, float* saa, float* sab, int lane) {
    const GAS f32x4* pa = (const GAS f32x4*)xa + lane; const GAS f32x4* pb = (const GAS f32x4*)xb + lane; f32x4 va[8], vb[8]; float s0 = 0.f, s1 = 0.f;
#pragma unroll
    for (int j = 0; j < 8; ++j) { va[j] = pa[64 * j]; vb[j] = pb[64 * j]; }
#pragma unroll
    for (int j = 0; j < 8; ++j) { s0 += (va[j].x * va[j].x + va[j].y * va[j].y) + (va[j].z * va[j].z + va[j].w * va[j].w); s1 += (vb[j].x * vb[j].x + vb[j].y * vb[j].y) + (vb[j].z * vb[j].z + vb[j].w * vb[j].w); }
#pragma unroll
    for (int o = 1; o < 64; o <<= 1) { s0 += __shfl_xor(s0, o); s1 += __shfl_xor(s1, o); }
    const float r0 = __builtin_amdgcn_rsqf(s0 * (1.0f / DM) + EPS), r1 = __builtin_amdgcn_rsqf(s1 * (1.0f / DM) + EPS);
    const GAS f32x4* wp = (const GAS f32x4*)w + lane; float m0 = 0.f, m1 = 0.f;
#pragma unroll
    for (int j = 0; j < 8; ++j) { const f32x4 wv = wp[64 * j];
        va[j].x *= r0 * wv.x; va[j].y *= r0 * wv.y; va[j].z *= r0 * wv.z; va[j].w *= r0 * wv.w; vb[j].x *= r1 * wv.x; vb[j].y *= r1 * wv.y; vb[j].z *= r1 * wv.z; vb[j].w *= r1 * wv.w;
        m0 = fmaxf(fmaxf(m0, fmaxf(fabsf(va[j].x), fabsf(va[j].y))), fmaxf(fabsf(va[j].z), fabsf(va[j].w))); m1 = fmaxf(fmaxf(m1, fmaxf(fabsf(vb[j].x), fabsf(vb[j].y))), fmaxf(fabsf(vb[j].z), fabsf(vb[j].w))); }
#pragma unroll
    for (int o = 1; o < 64; o <<= 1) { m0 = fmaxf(m0, __shfl_xor(m0, o)); m1 = fmaxf(m1, __shfl_xor(m1, o)); }
    const float i0 = m0 > 0.f ? 127.0f / m0 : 0.f, i1 = m1 > 0.f ? 127.0f / m1 : 0.f;
    if (lane == 0) { *(GAS float*)saa = m0 * (1.0f / 127.0f); *(GAS float*)sab = m1 * (1.0f / 127.0f); }
#pragma unroll
    for (int j = 0; j < 8; ++j) { ((GAS unsigned*)oa)[lane + 64 * j] = pack_i8x4c(va[j].x * i0, va[j].y * i0, va[j].z * i0, va[j].w * i0); ((GAS unsigned*)ob)[lane + 64 * j] = pack_i8x4c(vb[j].x * i1, vb[j].y * i1, vb[j].z * i1, vb[j].w * i1); }
}
__device__ __forceinline__ void rms_phase_i8(const Ctx& c, const float* x, const float* w, unsigned char* H8, float* SA) {
    for (int m = c.gw; m < NTOK / 2; m += c.NGW) rms_rows2_i8(x + (size_t)m * DM, x + (size_t)(m + NTOK / 2) * DM, w, H8 + (size_t)m * DM, H8 + (size_t)(m + NTOK / 2) * DM, SA + m, SA + m + NTOK / 2, c.lane);
}
__device__ __forceinline__ void rms_rows2(const float* xa, const float* xb, const float* w, bf16* oa, bf16* ob, int lane) {
    const GAS f32x4* pa = (const GAS f32x4*)xa + lane; const GAS f32x4* pb = (const GAS f32x4*)xb + lane; f32x4 va[8], vb[8]; float sa = 0.f, sb = 0.f;
#pragma unroll
    for (int j = 0; j < 8; ++j) { va[j] = pa[64 * j]; vb[j] = pb[64 * j]; }
#pragma unroll
    for (int j = 0; j < 8; ++j) { sa += (va[j].x * va[j].x + va[j].y * va[j].y) + (va[j].z * va[j].z + va[j].w * va[j].w); sb += (vb[j].x * vb[j].x + vb[j].y * vb[j].y) + (vb[j].z * vb[j].z + vb[j].w * vb[j].w); }
#pragma unroll
    for (int o = 1; o < 64; o <<= 1) { sa += __shfl_xor(sa, o); sb += __shfl_xor(sb, o); }
    const float ra = __builtin_amdgcn_rsqf(sa * (1.0f / DM) + EPS), rb = __builtin_amdgcn_rsqf(sb * (1.0f / DM) + EPS);
    const GAS f32x4* wp = (const GAS f32x4*)w + lane; GAS v2u* qa = (GAS v2u*)oa + lane; GAS v2u* qb = (GAS v2u*)ob + lane;
#pragma unroll
    for (int j = 0; j < 8; ++j) { const f32x4 wv = wp[64 * j];
        v2u q; q.x = pk2c(va[j].x * ra * wv.x, va[j].y * ra * wv.y); q.y = pk2c(va[j].z * ra * wv.z, va[j].w * ra * wv.w); qa[64 * j] = q;
        v2u p; p.x = pk2c(vb[j].x * rb * wv.x, vb[j].y * rb * wv.y); p.y = pk2c(vb[j].z * rb * wv.z, vb[j].w * rb * wv.w); qb[64 * j] = p; }
}
__device__ __forceinline__ void rms_phase(const Ctx& c, const float* x, const float* w, bf16* H) {
    for (int m = c.gw; m < NTOK / 2; m += c.NGW) rms_rows2(x + (size_t)m * DM, x + (size_t)(m + NTOK / 2) * DM, w, H + (size_t)m * DM, H + (size_t)(m + NTOK / 2) * DM, c.lane);
}
__device__ __forceinline__ void fp8_row(const float* src, unsigned char* dst, float* scale_out, int lane) {
    const GAS f32x4* xp = (const GAS f32x4*)src + lane; f32x4 v[8]; float m = 0.f;
#pragma unroll
    for (int j = 0; j < 8; ++j) { v[j] = xp[64 * j]; m = fmaxf(fmaxf(m, fmaxf(fabsf(v[j].x), fabsf(v[j].y))), fmaxf(fabsf(v[j].z), fabsf(v[j].w))); }
    m = wave_max(m);
    const float inv = m > 0.f ? 256.0f / m : 0.f;
    if (lane == 0) *(GAS float*)scale_out = m * (1.0f / 256.0f);
#pragma unroll
    for (int j = 0; j < 8; ++j) { int p = __builtin_amdgcn_cvt_pk_fp8_f32(v[j].x * inv, v[j].y * inv, 0, false); p = __builtin_amdgcn_cvt_pk_fp8_f32(v[j].z * inv, v[j].w * inv, p, true);
        ((GAS unsigned*)dst)[lane + 64 * j] = (unsigned)p; }
}
constexpr size_t U8_SLICE = (size_t)16384 * 128;
__device__ __forceinline__ unsigned pack_i8x4(float a, float b, float c, float d) {
    const int ia = (int)__builtin_rintf(a), ib = (int)__builtin_rintf(b), ic = (int)__builtin_rintf(c), id = (int)__builtin_rintf(d);
    return ((unsigned)ia & 255u) | (((unsigned)ib & 255u) << 8) | (((unsigned)ic & 255u) << 16) | ((unsigned)id << 24);
}
__device__ __forceinline__ void row_load_strided(const float* src, int lane, f32x4 (&v)[8]) { const GAS f32x4* xp = (const GAS f32x4*)src + lane;
#pragma unroll
    for (int j = 0; j < 8; ++j) v[j] = xp[64 * j]; }
__device__ __forceinline__ void row_load_contig(const float* src, int lane, f32x4 (&v)[8]) { const GAS f32x4* xp = (const GAS f32x4*)src + 8 * lane;
#pragma unroll
    for (int j = 0; j < 8; ++j) v[j] = xp[j]; }
__device__ __forceinline__ void i8_row(const f32x4 (&v)[8], unsigned char* dst, float* scale_out, int lane) {
    float m = 0.f;
#pragma unroll
    for (int j = 0; j < 8; ++j) m = fmaxf(fmaxf(m, fmaxf(fabsf(v[j].x), fabsf(v[j].y))), fmaxf(fabsf(v[j].z), fabsf(v[j].w)));
    m = wave_max(m);
    const float inv = m > 0.f ? 127.0f / m : 0.f;
    if (lane == 0) *(GAS float*)scale_out = m * (1.0f / 127.0f);
#pragma unroll
    for (int j = 0; j < 8; ++j) *(GAS unsigned*)(dst + (size_t)(2 * j + (lane >> 5)) * U8_SLICE + 4 * (lane & 31)) = pack_i8x4(v[j].x * inv, v[j].y * inv, v[j].z * inv, v[j].w * inv);
}
constexpr size_t V6_SLICE = (size_t)16384 * 192;
__device__ __forceinline__ void fp6_row(const f32x4 (&v)[8], unsigned char* dst, float* scale_out, int lane) {
    float m = 0.f;
#pragma unroll
    for (int j = 0; j < 8; ++j) m = fmaxf(fmaxf(m, fmaxf(fabsf(v[j].x), fabsf(v[j].y))), fmaxf(fabsf(v[j].z), fabsf(v[j].w)));
    m = wave_max(m);
    const float inv = m > 0.f ? 7.5f / m : 0.f;
    if (lane == 0) *(GAS float*)scale_out = m * (1.0f / 7.5f);
    v32h_t h;
#pragma unroll
    for (int j = 0; j < 8; ++j) { h[4 * j] = (_Float16)(v[j].x * inv); h[4 * j + 1] = (_Float16)(v[j].y * inv); h[4 * j + 2] = (_Float16)(v[j].z * inv); h[4 * j + 3] = (_Float16)(v[j].w * inv); }
    const v6u q = __builtin_amdgcn_cvt_scalef32_pk32_fp6_f16(h, 1.0f);
    GAS v2u* o = (GAS v2u*)(dst + (size_t)(lane >> 3) * V6_SLICE + 24 * (lane & 7));
    o[0] = (v2u){q[0], q[1]}; o[1] = (v2u){q[2], q[3]}; o[2] = (v2u){q[4], q[5]};
}
struct P0Args { const float *w_in, *w_br_sb, *w_br_hg, *w_br_conv, *w_o, *w_q, *u, *v, *lbp; bf16 *WinT, *WbrT, *WoT, *WqT; unsigned char *U, *V; float *US, *VS; float* LB; int layer; const float *k1, *k2; bf16* KB; };
__device__ __forceinline__ void p0_convert(const Ctx& c, const P0Args& a, int parts = 7) {
    LAS float* scr = (LAS float*)(c.lds + c.wave * 16384);
    constexpr int I_IN = (DM / 128) * (INW / 32), I_BR = (BW / 64) * (DM / 32), I_SQ = (DM / 64) * (DM / 32);
    constexpr int I_Q8 = (DM / 128) * (DM / 32);
    constexpr int NITEMS = I_IN + 3 * I_BR + I_SQ + I_Q8;
    if (parts & 1)
    for (int it = c.gw; it < NITEMS; it += c.NGW) {
        int r = it;
        if (r < I_IN) { const int kb = r / (INW / 32), nb = r % (INW / 32); tr_item_i8(a.w_in, DM, INW, (unsigned char*)a.WinT, kb * 128, nb * 32, win_drow(nb * 32), WIN_QS, scr, c.lane); continue; } r -= I_IN;
        if (r < I_BR) { const int kb = r / (DM / 32), nb = r % (DM / 32); tr_item(a.w_br_sb, BW, DM, a.WbrT, kb * 64, nb * 32, nb * 32, scr, c.lane); continue; } r -= I_BR;
        if (r < I_BR) { const int kb = r / (DM / 32), nb = r % (DM / 32); tr_item(a.w_br_hg, BW, DM, a.WbrT + (size_t)DM * BW, kb * 64, nb * 32, nb * 32, scr, c.lane); continue; } r -= I_BR;
        if (r < I_BR) { const int kb = r / (DM / 32), nb = r % (DM / 32); tr_item(a.w_br_conv, BW, DM, a.WbrT + (size_t)2 * DM * BW, kb * 64, nb * 32, nb * 32, scr, c.lane); continue; } r -= I_BR;
        if (r < I_SQ) { const int kb = r / (DM / 32), nb = r % (DM / 32); tr_item(a.w_o, DM, DM, a.WoT, kb * 64, nb * 32, nb * 32, scr, c.lane); continue; } r -= I_SQ;
        { const int kb = r / (DM / 32), nb = r % (DM / 32); tr_item_i8(a.w_q, DM, DM, (unsigned char*)a.WqT, kb * 128, nb * 32, nb * 32, WIN_QS, scr, c.lane); }
    }
    if (parts & 2)
    {
    for (int r = c.gw; r < 16384; r += 2 * c.NGW) { const int r2 = r + c.NGW; f32x4 va[8], vb[8];
        row_load_strided(a.u + (size_t)r * 2048, c.lane, va); if (r2 < 16384) row_load_strided(a.u + (size_t)r2 * 2048, c.lane, vb);
        i8_row(va, a.U + (size_t)r * 128, a.US + r, c.lane); if (r2 < 16384) i8_row(vb, a.U + (size_t)r2 * 128, a.US + r2, c.lane); }
    for (int r = c.gw; r < 16384; r += 2 * c.NGW) { const int r2 = r + c.NGW; f32x4 va[8], vb[8];
        row_load_contig(a.v + (size_t)r * 2048, c.lane, va); if (r2 < 16384) row_load_contig(a.v + (size_t)r2 * 2048, c.lane, vb);
        fp6_row(va, a.V + (size_t)r * 192, a.VS + r, c.lane); if (r2 < 16384) fp6_row(vb, a.V + (size_t)r2 * 192, a.VS + r2, c.lane); }
    }
    if (parts & 4) {
    cvt_copy(c, a.k1, a.KB, (size_t)8 * 16384 / 8);
    cvt_copy(c, a.k2, a.KB + 8 * 16384, (size_t)8 * 16384 / 8); }
    if (blockIdx.x == 0) for (int i = c.tid; i < 1024; i += 512) a.LB[i] = a.layer == 0 ? 0.f : sigm(a.lbp[1024 + i] - a.lbp[i]);
}

struct EpiIn {
    static constexpr bool PERM = true, AFTER_DRAIN = false;
    bf16* seg; bf16* gate; const float* lb; const float* sa;
    __device__ __forceinline__ float rowscale(int row) const { return ((const GAS float*)sa)[row] * (1.0f / WIN_QS); }
    __device__ __forceinline__ void operator()(const pg8::f32x4 (&acc)[2][2][4][2], const pg8::Unit& u, int wr, int wc, int fr, int fq) const {
        const int pn = u.pn; const int row0 = u.pm * 256 + wr * 64 + fr;
        if (pn >= 28 && pn < 36) {
            bf16* dst = seg + (size_t)7 * SEGSZ; const int col0 = (pn - 28) * 128 + wc * 32 + 8 * fq;
#pragma unroll
            for (int ai = 0; ai < 2; ++ai)
#pragma unroll
                for (int m = 0; m < 4; ++m) {
                    const pg8::f32x4 a0 = acc[ai][0][m][0], a1 = acc[ai][0][m][1], b0 = acc[ai][1][m][0], b1 = acc[ai][1][m][1];
                    v4u w; w.x = pk2c(a0[0] * sigm(b0[0]), a0[1] * sigm(b0[1])); w.y = pk2c(a0[2] * sigm(b0[2]), a0[3] * sigm(b0[3]));
                    w.z = pk2c(a1[0] * sigm(b1[0]), a1[1] * sigm(b1[1])); w.w = pk2c(a1[2] * sigm(b1[2]), a1[3] * sigm(b1[3]));
                    *(GAS v4u*)(dst + (size_t)(row0 + ai * 128 + m * 16) * 1024 + col0) = w; }
            return;
        }
        bf16* dst; int ld, colt, mode;
        if (pn < 28) { const int sg = pn >> 2; dst = seg + (size_t)sg * SEGSZ; ld = 1024; colt = (pn & 3) * 256; mode = (sg == 4) ? 2 : (sg == 6 ? 1 : 0); }
        else { const int q = pn - 36; dst = gate + (size_t)(q >> 3) * ((size_t)NTOK * 2048); ld = 2048; colt = (q & 7) * 256; mode = 1; }
        const int col0 = colt + wc * 32 + 8 * fq;
        if (mode == 0) {
#pragma unroll
            for (int ai = 0; ai < 2; ++ai)
#pragma unroll
                for (int m = 0; m < 4; ++m)
#pragma unroll
                    for (int bj = 0; bj < 2; ++bj) { const pg8::f32x4 v0 = acc[ai][bj][m][0], v1 = acc[ai][bj][m][1];
                        v4u w; w.x = pk2c(v0[0], v0[1]); w.y = pk2c(v0[2], v0[3]); w.z = pk2c(v1[0], v1[1]); w.w = pk2c(v1[2], v1[3]);
                        *(GAS v4u*)(dst + (size_t)(row0 + ai * 128 + m * 16) * ld + col0 + bj * 128) = w; }
        } else if (mode == 1) {
#pragma unroll
            for (int ai = 0; ai < 2; ++ai)
#pragma unroll
                for (int m = 0; m < 4; ++m)
#pragma unroll
                    for (int bj = 0; bj < 2; ++bj) { const pg8::f32x4 v0 = acc[ai][bj][m][0], v1 = acc[ai][bj][m][1];
                        v4u w; w.x = pk2c(sigm(v0[0]), sigm(v0[1])); w.y = pk2c(sigm(v0[2]), sigm(v0[3])); w.z = pk2c(sigm(v1[0]), sigm(v1[1])); w.w = pk2c(sigm(v1[2]), sigm(v1[3]));
                        *(GAS v4u*)(dst + (size_t)(row0 + ai * 128 + m * 16) * ld + col0 + bj * 128) = w; }
        } else {
            f32x4 l0[2], l1[2];
#pragma unroll
            for (int bj = 0; bj < 2; ++bj) { l0[bj] = *(const GAS f32x4*)(lb + col0 + bj * 128); l1[bj] = *(const GAS f32x4*)(lb + col0 + bj * 128 + 4); }
#pragma unroll
            for (int ai = 0; ai < 2; ++ai)
#pragma unroll
                for (int m = 0; m < 4; ++m)
#pragma unroll
                    for (int bj = 0; bj < 2; ++bj) { const pg8::f32x4 v0 = acc[ai][bj][m][0], v1 = acc[ai][bj][m][1]; float r[8];
#pragma unroll
                        for (int j = 0; j < 4; ++j) { r[j] = __logf(l0[bj][j] + (1.0f - l0[bj][j]) * sigm(v0[j])); r[4 + j] = __logf(l1[bj][j] + (1.0f - l1[bj][j]) * sigm(v1[j])); }
                        v4u w; w.x = pk2c(r[0], r[1]); w.y = pk2c(r[2], r[3]); w.z = pk2c(r[4], r[5]); w.w = pk2c(r[6], r[7]);
                        *(GAS v4u*)(dst + (size_t)(row0 + ai * 128 + m * 16) * ld + col0 + bj * 128) = w; }
        }
    }
};

__device__ __forceinline__ void conv_phase(const Ctx& c, const bf16* glu, const float* cw, const float* cb, const float* lnw, const float* lnb, bf16* out) {
    const int c0 = 2 * c.tid;
    float w0[31], w1[31];
#pragma unroll
    for (int j = 0; j < 31; ++j) { const f32x2v t = *(const GAS f32x2v*)(cw + j * 1024 + c0); w0[j] = t.x; w1[j] = t.y; }
    const f32x2v bv = *(const GAS f32x2v*)(cb + c0), lwv = *(const GAS f32x2v*)(lnw + c0), lbv = *(const GAS f32x2v*)(lnb + c0);
    LAS float* red = (LAS float*)c.lds;
    const int per = (NTOK / 8 + c.G - 1) / c.G, tile0 = (int)blockIdx.x * per;
    unsigned win[38];
    if (tile0 < NTOK / 8) {
#pragma unroll
        for (int r = 0; r < 38; ++r) { const int n = tile0 * 8 + r - 30; win[r] = *(const GAS unsigned*)(glu + (size_t)(n > 0 ? n : 0) * 1024 + c0); } }
    for (int ti = 0; ti < per; ++ti) { const int tile = tile0 + ti; if (tile >= NTOK / 8) break;
        const int n0 = tile * 8, tseq0 = n0 & (SEQ - 1);
        const bool more = (ti + 1 < per) && (tile + 1 < NTOK / 8);
        float a0[8], a1[8];
#pragma unroll
        for (int t = 0; t < 8; ++t) { a0[t] = bv.x; a1[t] = bv.y; }
#pragma unroll
        for (int r = 0; r < 38; ++r) {
            const unsigned xv = (tseq0 + r - 30 >= 0) ? win[r] : 0u;
            const float x0 = bflo(xv), x1 = bfhi(xv);
#pragma unroll
            for (int t = 0; t < 8; ++t) { const int j = r - t; if (j >= 0 && j <= 30) { a0[t] += w0[j] * x0; a1[t] += w1[j] * x1; } }
        }
#pragma unroll
        for (int r = 0; r < 30; ++r) win[r] = win[r + 8];
        if (more) {
#pragma unroll
            for (int i = 0; i < 8; ++i) win[30 + i] = *(const GAS unsigned*)(glu + (size_t)(n0 + 8 + i) * 1024 + c0); }
        float st[16];
#pragma unroll
        for (int t = 0; t < 8; ++t) { st[2 * t] = a0[t] + a1[t]; st[2 * t + 1] = a0[t] * a0[t] + a1[t] * a1[t]; }
        xreduce16(st, c.lane);
        if ((c.lane & 3) == 0) red[c.wave * 16 + ridx16(c.lane)] = st[0];
        __syncthreads();
        if (c.tid < 16) { float s = 0.f;
#pragma unroll
            for (int w = 0; w < 8; ++w) s += red[w * 16 + c.tid];
            red[128 + c.tid] = s; }
        __syncthreads();
#pragma unroll
        for (int t = 0; t < 8; ++t) {
            const float mean = red[128 + 2 * t] * (1.0f / 1024.0f), var = red[128 + 2 * t + 1] * (1.0f / 1024.0f) - mean * mean;
            const float rstd = __builtin_amdgcn_rsqf(var + EPS);
            const float h0 = (a0[t] - mean) * rstd * lwv.x + lbv.x, h1 = (a1[t] - mean) * rstd * lwv.y + lbv.y;
            *(GAS unsigned*)(out + (size_t)(n0 + t) * 1024 + c0) = pk2c(h0 * sigm(h0), h1 * sigm(h1));
        }
        __syncthreads();
    }
}
__device__ __forceinline__ void hgrn_task(int task, int lane, const bf16* qhg, const bf16* logf, const bf16* ihg, bf16* out) {
    const int bh = task >> 6, dvb = task & 63, b = bh >> 3, h = bh & 7;
    const size_t rb = (size_t)b * SEQ * 1024;
    const GAS unsigned* qp = (const GAS unsigned*)(qhg + rb + h * 128) + lane;
    const GAS unsigned* lp = (const GAS unsigned*)(logf + rb + h * 128) + lane;
    const GAS unsigned* ip = (const GAS unsigned*)(ihg + rb + h * 128) + dvb;
    GAS bf16* op = (GAS bf16*)(out + rb + h * 128 + 2 * dvb);
    float S00 = 0.f, S01 = 0.f, S10 = 0.f, S11 = 0.f;
    unsigned qn[8], ln[8], inx[8];
#pragma unroll
    for (int j = 0; j < 8; ++j) { qn[j] = qp[(size_t)j * 512]; ln[j] = lp[(size_t)j * 512]; inx[j] = ip[(size_t)j * 512]; }
    for (int blk = 0; blk < SEQ / 8; ++blk) {
        unsigned qc[8], lc[8], ic[8];
#pragma unroll
        for (int j = 0; j < 8; ++j) { qc[j] = qn[j]; lc[j] = ln[j]; ic[j] = inx[j]; }
        if (blk + 1 < SEQ / 8) {
#pragma unroll
            for (int j = 0; j < 8; ++j) { const size_t o = (size_t)((blk + 1) * 8 + j) * 512; qn[j] = qp[o]; ln[j] = lp[o]; inx[j] = ip[o]; }
        }
        float pv[16];
#pragma unroll
        for (int j = 0; j < 8; ++j) {
            const float f0 = __expf(bflo(lc[j])), f1 = __expf(bfhi(lc[j])), k0 = 1.0f - f0, k1 = 1.0f - f1;
            const float i0 = bflo(ic[j]), i1 = bfhi(ic[j]), q0 = bflo(qc[j]), q1 = bfhi(qc[j]);
            S00 = f0 * S00 + k0 * i0; S01 = f0 * S01 + k0 * i1; S10 = f1 * S10 + k1 * i0; S11 = f1 * S11 + k1 * i1;
            pv[2 * j] = S00 * q0 + S10 * q1; pv[2 * j + 1] = S01 * q0 + S11 * q1;
        }
        xreduce16(pv, lane);
        if ((lane & 3) == 0) { const int idx = ridx16(lane); op[(size_t)(blk * 8 + (idx >> 1)) * 1024 + (idx & 1)] = (bf16)(pk2c(pv[0], 0.f) & 0xffffu); }
    }
}
constexpr int HG_TS = 272;
constexpr int HG_BS = 132;
__device__ __forceinline__ void hg_stage(LAS unsigned char* dst, const bf16* src, int tid) {
#pragma unroll
    for (int i = 0; i < 2; ++i) { const int p = tid + 512 * i, row = p >> 4, c16 = p & 15; *(LAS v4u*)(dst + row * HG_TS + c16 * 16) = *(const GAS v4u*)(src + (size_t)row * 1024 + c16 * 8); }
}
__device__ __forceinline__ void hg_scan(const LAS unsigned char* lft, int dk, int hf, float (&lf)[4][8], float (&b)[4][8], float& bl) {
    float bs[4], pb[4];
#pragma unroll
    for (int kk = 0; kk < 4; ++kk) { float run = 0.f;
#pragma unroll
        for (int j = 0; j < 8; ++j) { lf[kk][j] = __uint_as_float((unsigned)(*(const LAS unsigned short*)(lft + (16 * kk + 8 * hf + j) * HG_TS + dk * 2)) << 16); run += lf[kk][j]; b[kk][j] = run; }
        bs[kk] = run; }
#pragma unroll
    for (int kk = 0; kk < 4; ++kk) pb[kk] = __shfl_xor(bs[kk], 32);
    float pre = 0.f;
#pragma unroll
    for (int kk = 0; kk < 4; ++kk) { const float off = pre + (hf ? pb[kk] : 0.f);
#pragma unroll
        for (int j = 0; j < 8; ++j) b[kk][j] += off;
        pre += bs[kk] + pb[kk]; }
    bl = pre;
}
__device__ __forceinline__ bf16x8 pack8(const float (&v)[8]) { v4u t; t.x = pk2c(v[0], v[1]); t.y = pk2c(v[2], v[3]); t.z = pk2c(v[4], v[5]); t.w = pk2c(v[6], v[7]); return __builtin_bit_cast(bf16x8, t); }
__device__ __forceinline__ unsigned lds_u16(const LAS unsigned char* p) { return (unsigned)(*(const LAS unsigned short*)p); }
__device__ __forceinline__ void hgA_chunk(const Ctx& c, int ci, const bf16* LOGF, const bf16* IHG, bf16* ST, float* DEC) {
    const int bh = ci >> 6, ch = ci & 63, bb = bh >> 3, h = bh & 7; const size_t n0 = (size_t)bb * SEQ + ch * 64;
    LAS unsigned char* lft = c.lds; LAS unsigned char* itl = c.lds + 64 * HG_TS;
    hg_stage(lft, LOGF + n0 * 1024 + h * 128, c.tid); hg_stage(itl, IHG + n0 * 1024 + h * 128, c.tid);
    __syncthreads();
    const int dkt = c.wave & 3, dvh = c.wave >> 2, hf = c.lane >> 5, cl = c.lane & 31, dk = 32 * dkt + cl;
    float lf[4][8], b[4][8], bl; hg_scan(lft, dk, hf, lf, b, bl);
    bf16x8 kf[4];
#pragma unroll
    for (int kk = 0; kk < 4; ++kk) { float v[8];
#pragma unroll
        for (int j = 0; j < 8; ++j) v[j] = (1.0f - __expf(lf[kk][j])) * __expf(bl - b[kk][j]);
        kf[kk] = pack8(v); }
    if (dvh == 0 && hf == 0) ((GAS float*)DEC)[(size_t)ci * 128 + dk] = __expf(bl);
#pragma unroll
    for (int dvi = 0; dvi < 2; ++dvi) { const int dvt = dvh * 2 + dvi;
        f32x16 acc;
#pragma unroll
        for (int r = 0; r < 16; ++r) acc[r] = 0.f;
#pragma unroll
        for (int kk = 0; kk < 4; ++kk) { const LAS unsigned char* p = itl + (16 * kk + 8 * hf) * HG_TS + (32 * dvt + cl) * 2;
            v4u t; t.x = lds_u16(p) | (lds_u16(p + HG_TS) << 16); t.y = lds_u16(p + 2 * HG_TS) | (lds_u16(p + 3 * HG_TS) << 16); t.z = lds_u16(p + 4 * HG_TS) | (lds_u16(p + 5 * HG_TS) << 16); t.w = lds_u16(p + 6 * HG_TS) | (lds_u16(p + 7 * HG_TS) << 16);
            acc = MFMA32(kf[kk], __builtin_bit_cast(bf16x8, t), acc); }
        bf16* o = ST + (size_t)ci * 16384 + (size_t)(32 * dvt + cl) * 128 + 32 * dkt + 4 * hf;
#pragma unroll
        for (int g = 0; g < 4; ++g) { v2u q; q.x = pk2c(acc[4 * g], acc[4 * g + 1]); q.y = pk2c(acc[4 * g + 2], acc[4 * g + 3]); *(GAS v2u*)(o + 8 * g) = q; }
    }
    __syncthreads();
}
__device__ __forceinline__ void hgB(const Ctx& c, bf16* ST, const float* DEC) {
    for (int e = blockIdx.x * 512 + c.tid; e < 32 * 4096; e += c.G * 512) {
        const int bh = e >> 12, r = e & 4095, dv = r >> 5, dk4 = (r & 31) * 4;
        GAS v2u* p = (GAS v2u*)(ST + (size_t)bh * 64 * 16384 + (size_t)dv * 128 + dk4);
        const GAS f32x4* d = (const GAS f32x4*)(DEC + (size_t)bh * 64 * 128 + dk4);
        f32x4 S = {0.f, 0.f, 0.f, 0.f};
#pragma unroll 1
        for (int c0 = 0; c0 < 64; c0 += 8) {
            v2u Lv[8]; f32x4 D[8];
#pragma unroll
            for (int k = 0; k < 8; ++k) { Lv[k] = p[(size_t)(c0 + k) * 4096]; D[k] = d[(size_t)(c0 + k) * 32]; }
#pragma unroll
            for (int k = 0; k < 8; ++k) { v2u o; o.x = pk2c(S.x, S.y); o.y = pk2c(S.z, S.w); p[(size_t)(c0 + k) * 4096] = o;
                S.x = D[k].x * S.x + bflo(Lv[k].x); S.y = D[k].y * S.y + bfhi(Lv[k].x); S.z = D[k].z * S.z + bflo(Lv[k].y); S.w = D[k].w * S.w + bfhi(Lv[k].y); }
        }
    }
}
__device__ __forceinline__ void hgC_chunk(const Ctx& c, int ci, const bf16* QHG, const bf16* LOGF, const bf16* IHG, const bf16* GHG, const bf16* ST, const float* nw, bf16* OUT) {
    const int bh = ci >> 6, ch = ci & 63, bb = bh >> 3, h = bh & 7; const size_t n0 = (size_t)bb * SEQ + ch * 64;
    LAS unsigned char* lft = c.lds; LAS unsigned char* itl = c.lds + 64 * HG_TS; LAS float* bt = (LAS float*)(c.lds + 2 * 64 * HG_TS); LAS float* red = bt + 64 * HG_BS;
    LAS unsigned char* ktl = (LAS unsigned char*)(red + 256);
    const int hf = c.lane >> 5, cl = c.lane & 31;
    const int dvt = c.wave & 3, tt = c.wave >> 2, t = 32 * tt + cl;
    const bf16* qrow = QHG + (n0 + t) * 1024 + h * 128 + 8 * hf;
    v4u qg[8];
#pragma unroll
    for (int kk = 0; kk < 8; ++kk) qg[kk] = *(const GAS v4u*)(qrow + 16 * kk);
    hg_stage(lft, LOGF + n0 * 1024 + h * 128, c.tid); hg_stage(itl, IHG + n0 * 1024 + h * 128, c.tid);
    __syncthreads();
    { const int dk = 32 * (c.wave & 3) + cl; float lf[4][8], b[4][8], bl; hg_scan(lft, dk, hf, lf, b, bl);
#pragma unroll
      for (int q = 0; q < 2; ++q) { const int kk = 2 * (c.wave >> 2) + q;
#pragma unroll
          for (int j = 0; j < 8; ++j) { bt[(16 * kk + 8 * hf + j) * HG_BS + dk] = (c.wave >> 2) ? b[2 + q][j] : b[q][j];
              *(LAS unsigned short*)(ktl + (16 * kk + 8 * hf + j) * HG_TS + dk * 2) = (unsigned short)(pk2c(1.0f - __expf((c.wave >> 2) ? lf[2 + q][j] : lf[q][j]), 0.f) & 0xffffu); } } }
    __syncthreads();
    bf16x8 qm[8];
    const bf16* strow = ST + (size_t)ci * 16384 + (size_t)(32 * dvt + cl) * 128 + 8 * hf;
    bf16x8 sf[8];
#pragma unroll
    for (int kk = 0; kk < 8; ++kk) sf[kk] = *(const GAS bf16x8*)(strow + 16 * kk);
#pragma unroll
    for (int kk = 0; kk < 8; ++kk) { const int d0 = 16 * kk + 8 * hf;
        const v4u qv = qg[kk];
        const f32x4 b0 = *(const LAS f32x4*)(bt + t * HG_BS + d0), b1 = *(const LAS f32x4*)(bt + t * HG_BS + d0 + 4), m0 = *(const LAS f32x4*)(bt + 31 * HG_BS + d0), m1 = *(const LAS f32x4*)(bt + 31 * HG_BS + d0 + 4);
        const float q[8] = {bflo(qv.x), bfhi(qv.x), bflo(qv.y), bfhi(qv.y), bflo(qv.z), bfhi(qv.z), bflo(qv.w), bfhi(qv.w)};
        const float bv[8] = {b0.x, b0.y, b0.z, b0.w, b1.x, b1.y, b1.z, b1.w}, mv[8] = {m0.x, m0.y, m0.z, m0.w, m1.x, m1.y, m1.z, m1.w};
        float vm[8];
#pragma unroll
        for (int j = 0; j < 8; ++j) vm[j] = q[j] * __expf(bv[j] - mv[j]);
        qm[kk] = pack8(vm); }
    f32x16 o;
#pragma unroll
    for (int r = 0; r < 16; ++r) o[r] = 0.f;
#pragma unroll 1
    for (int st = 0; st <= tt; ++st) {
        const int s = 32 * st + cl;
        f32x16 sa;
#pragma unroll
        for (int r = 0; r < 16; ++r) sa[r] = 0.f;
#pragma unroll
        for (int kk = 0; kk < 8; ++kk) { const int d0 = 16 * kk + 8 * hf;
            asm volatile("" ::: "memory");
            const v4u lv = *(const LAS v4u*)(ktl + s * HG_TS + d0 * 2);
            const f32x4 b0 = *(const LAS f32x4*)(bt + s * HG_BS + d0), b1 = *(const LAS f32x4*)(bt + s * HG_BS + d0 + 4), m0 = *(const LAS f32x4*)(bt + 31 * HG_BS + d0), m1 = *(const LAS f32x4*)(bt + 31 * HG_BS + d0 + 4);
            const float kv[8] = {bflo(lv.x), bfhi(lv.x), bflo(lv.y), bfhi(lv.y), bflo(lv.z), bfhi(lv.z), bflo(lv.w), bfhi(lv.w)};
            const float bv[8] = {b0.x, b0.y, b0.z, b0.w, b1.x, b1.y, b1.z, b1.w}, mv[8] = {m0.x, m0.y, m0.z, m0.w, m1.x, m1.y, m1.z, m1.w};
            float vk[8];
#pragma unroll
            for (int j = 0; j < 8; ++j) vk[j] = kv[j] * __expf(mv[j] - bv[j]);
            sa = MFMA32(pack8(vk), qm[kk], sa); }
        if (st == tt) {
#pragma unroll
            for (int r = 0; r < 16; ++r) if (((r & 3) + 8 * (r >> 2) + 4 * hf) > cl) sa[r] = 0.f;
        }
#pragma unroll
        for (int sp = 0; sp < 2; ++sp) {
            const float pv[8] = {sa[8 * sp], sa[8 * sp + 1], sa[8 * sp + 2], sa[8 * sp + 3], sa[8 * sp + 4], sa[8 * sp + 5], sa[8 * sp + 6], sa[8 * sp + 7]};
            const LAS unsigned char* p = itl + (32 * st + 16 * sp + 4 * hf) * HG_TS + (32 * dvt + cl) * 2;
            v4u tq; tq.x = lds_u16(p) | (lds_u16(p + HG_TS) << 16); tq.y = lds_u16(p + 2 * HG_TS) | (lds_u16(p + 3 * HG_TS) << 16);
            tq.z = lds_u16(p + 8 * HG_TS) | (lds_u16(p + 9 * HG_TS) << 16); tq.w = lds_u16(p + 10 * HG_TS) | (lds_u16(p + 11 * HG_TS) << 16);
            o = MFMA32(__builtin_bit_cast(bf16x8, tq), pack8(pv), o); }
    }
    {
#pragma unroll
      for (int kk = 0; kk < 8; ++kk) { const int d0 = 16 * kk + 8 * hf;
          const v4u qv = qg[kk];
          const f32x4 b0 = *(const LAS f32x4*)(bt + t * HG_BS + d0), b1 = *(const LAS f32x4*)(bt + t * HG_BS + d0 + 4);
          float ve[8] = {bflo(qv.x) * __expf(b0.x), bfhi(qv.x) * __expf(b0.y), bflo(qv.y) * __expf(b0.z), bfhi(qv.y) * __expf(b0.w), bflo(qv.z) * __expf(b1.x), bfhi(qv.z) * __expf(b1.y), bflo(qv.w) * __expf(b1.z), bfhi(qv.w) * __expf(b1.w)};
          o = MFMA32(sf[kk], pack8(ve), o); } }
    float ss = 0.f;
#pragma unroll
    for (int r = 0; r < 16; ++r) ss += o[r] * o[r];
    ss += __shfl_xor(ss, 32);
    if (hf == 0) red[(tt * 4 + dvt) * 32 + cl] = ss;
    __syncthreads();
    const float rstd = __builtin_amdgcn_rsqf(((red[(tt * 4 + 0) * 32 + cl] + red[(tt * 4 + 1) * 32 + cl]) + (red[(tt * 4 + 2) * 32 + cl] + red[(tt * 4 + 3) * 32 + cl])) * (1.0f / 128.0f) + EPS);
#pragma unroll
    for (int g = 0; g < 4; ++g) { const int dv0 = 32 * dvt + 8 * g + 4 * hf; const size_t off = (n0 + t) * 1024 + h * 128 + dv0;
        const v2u gg = *(const GAS v2u*)(GHG + off); const f32x4 w4 = *(const GAS f32x4*)(nw + dv0);
        v2u q; q.x = pk2c(o[4 * g] * rstd * w4.x * bflo(gg.x), o[4 * g + 1] * rstd * w4.y * bfhi(gg.x)); q.y = pk2c(o[4 * g + 2] * rstd * w4.z * bflo(gg.y), o[4 * g + 3] * rstd * w4.w * bfhi(gg.y));
        *(GAS v2u*)(OUT + off) = q; }
    __syncthreads();
}
__device__ __forceinline__ void qknorm_rows4(bf16* row0, size_t rstride, const float* w, float scale, int lane) {
    v4u x[4][2];
#pragma unroll
    for (int i = 0; i < 4; ++i)
#pragma unroll
        for (int j = 0; j < 2; ++j) x[i][j] = *(const GAS v4u*)(row0 + i * rstride + 8 * lane + 512 * j);
    const f32x4 wa = *(const GAS f32x4*)(w + ((8 * lane) & 127)), wb = *(const GAS f32x4*)(w + ((8 * lane) & 127) + 4);
#pragma unroll
    for (int i = 0; i < 4; ++i)
#pragma unroll
        for (int j = 0; j < 2; ++j) { const v4u xx = x[i][j];
            float f[8] = {bflo(xx.x), bfhi(xx.x), bflo(xx.y), bfhi(xx.y), bflo(xx.z), bfhi(xx.z), bflo(xx.w), bfhi(xx.w)};
            float ss = 0.f;
#pragma unroll
            for (int k = 0; k < 8; ++k) ss += f[k] * f[k];
            ss += __shfl_xor(ss, 1); ss += __shfl_xor(ss, 2); ss += __shfl_xor(ss, 4); ss += __shfl_xor(ss, 8);
            const float r = __builtin_amdgcn_rsqf(ss * (1.0f / 128.0f) + EPS) * scale;
            v4u o; o.x = pk2c(f[0] * r * wa.x, f[1] * r * wa.y); o.y = pk2c(f[2] * r * wa.z, f[3] * r * wa.w); o.z = pk2c(f[4] * r * wb.x, f[5] * r * wb.y); o.w = pk2c(f[6] * r * wb.z, f[7] * r * wb.w);
            *(GAS v4u*)(row0 + i * rstride + 8 * lane + 512 * j) = o; }
}
__device__ __forceinline__ void vt_item(int item, int lane, const bf16* vsb, bf16* vt, LAS unsigned short* scr) {
    const int db = item & 3, sb = (item >> 2) & 63, bh = item >> 8, b = bh >> 3, h = bh & 7;
    const bf16* src = vsb + ((size_t)b * SEQ + sb * 64) * 1024 + h * 128 + db * 32;
#pragma unroll 4
    for (int i = 0; i < 16; ++i) { const int r = 4 * i + (lane >> 4); *(LAS unsigned*)(scr + r * 34 + 2 * (lane & 15)) = *(const GAS unsigned*)(src + (size_t)r * 1024 + 2 * (lane & 15)); }
    LDS_WAIT();
    const int c = lane & 7;
#pragma unroll
    for (int j = 0; j < 4; ++j) { const int d = (lane >> 3) + 8 * j; const LAS unsigned short* s = scr + (8 * c) * 34 + d;
        v4u o; o.x = (unsigned)s[0] | ((unsigned)s[34] << 16); o.y = (unsigned)s[68] | ((unsigned)s[102] << 16); o.z = (unsigned)s[136] | ((unsigned)s[170] << 16); o.w = (unsigned)s[204] | ((unsigned)s[238] << 16);
        *(GAS v4u*)(vt + ((size_t)bh * 128 + db * 32 + d) * SEQ + sb * 64 + 8 * c) = o; }
    LDS_WAIT();
}

constexpr int AT_BUF = 32768, AT_VOFF = 16384;
__device__ __forceinline__ f32x16 attn_scores(const LAS unsigned char* kt, int krow, int hf, const bf16x8 (&qf)[8]) {
    f32x16 sa;
#pragma unroll
    for (int r = 0; r < 16; ++r) sa[r] = 0.f;
    const LAS unsigned char* kp = kt + krow * 256; const int sw = krow & 15;
#pragma unroll
    for (int kk = 0; kk < 8; ++kk) sa = MFMA32(*(const LAS bf16x8*)(kp + (((2 * kk + hf) ^ sw) << 4)), qf[kk], sa);
    return sa;
}
template <bool DIAG> __device__ __forceinline__ void attn_weights(const f32x16& sa, float& R, int hf, int cl, bf16x8 (&pf)[2]) {
    float om[16];
#pragma unroll
    for (int r = 0; r < 16; ++r) om[r] = __builtin_amdgcn_rcpf(1.0f + __builtin_amdgcn_exp2f(sa[r]));
    if (DIAG) {
#pragma unroll
        for (int r = 0; r < 16; ++r) if (((r & 3) + 8 * (r >> 2) + 4 * hf) >= cl) om[r] = 1.0f;
    }
    float Gs[4], Gp[4];
#pragma unroll
    for (int g = 0; g < 4; ++g) { Gs[g] = (om[4 * g] * om[4 * g + 1]) * (om[4 * g + 2] * om[4 * g + 3]); Gp[g] = __shfl_xor(Gs[g], 32); }
    float tail = R; float w[16];
#pragma unroll
    for (int g = 3; g >= 0; --g) {
        const float c3 = tail * (hf == 0 ? Gp[g] : 1.0f), c2 = c3 * om[4 * g + 3], c1 = c2 * om[4 * g + 2], c0 = c1 * om[4 * g + 1];
        w[4 * g + 3] = c3 - om[4 * g + 3] * c3; w[4 * g + 2] = c2 - om[4 * g + 2] * c2; w[4 * g + 1] = c1 - om[4 * g + 1] * c1; w[4 * g] = c0 - om[4 * g] * c0;
        tail *= Gs[g] * Gp[g];
    }
    R = tail;
#pragma unroll
    for (int sp = 0; sp < 2; ++sp) { v4u t; t.x = pk2c(w[8 * sp], w[8 * sp + 1]); t.y = pk2c(w[8 * sp + 2], w[8 * sp + 3]); t.z = pk2c(w[8 * sp + 4], w[8 * sp + 5]); t.w = pk2c(w[8 * sp + 6], w[8 * sp + 7]); pf[sp] = __builtin_bit_cast(bf16x8, t); }
}
__device__ __forceinline__ void attn_pv(const LAS unsigned char* vt, int sub, int cl, int hf, const bf16x8 (&pf)[2], f32x16 (&o)[4]) {
#pragma unroll
    for (int d = 0; d < 4; ++d) { const int row = 32 * d + cl; const LAS unsigned char* vp = vt + row * 128 + 8 * hf; const int sw = (row >> 1) & 7;
#pragma unroll
        for (int sp = 0; sp < 2; ++sp) { const int x = 4 * sub + 2 * sp;
            const v2u lo = *(const LAS v2u*)(vp + ((x ^ sw) << 4)), hi = *(const LAS v2u*)(vp + (((x + 1) ^ sw) << 4));
            v4u t; t.x = lo.x; t.y = lo.y; t.z = hi.x; t.w = hi.y; o[d] = MFMA32(__builtin_bit_cast(bf16x8, t), pf[sp], o[d]); } }
}
template <bool LAG> __device__ __forceinline__ void attn_unit(const Ctx& c, int bh, int qb, const bf16* qsb, const bf16* ksb, const bf16* vt, bf16* outb) {
    int lane_ = c.lane; asm volatile("" : "+v"(lane_));
    const int b = bh >> 3, h = bh & 7, lane = lane_, cl = lane & 31, hf = lane >> 5;
    const size_t rb = (size_t)b * SEQ; const int q0w = 256 * qb + 32 * c.wave;
    bf16x8 qf[8];
    { const bf16* qrow = qsb + (rb + q0w + cl) * 1024 + h * 128 + 8 * hf;
#pragma unroll
      for (int kk = 0; kk < 8; ++kk) qf[kk] = *(const GAS bf16x8*)(qrow + 16 * kk); }
    f32x16 o[4];
#pragma unroll
    for (int d = 0; d < 4; ++d)
#pragma unroll
        for (int r = 0; r < 16; ++r) o[d][r] = 0.f;
    float R = 1.0f;
    bf16x8 pd[2]; const LAS unsigned char* vimd = c.lds; int subd = 0; bool pending = false;
    const int kr0 = 8 * c.wave + (lane >> 4), kr1 = kr0 + 4;
    const bf16* kg0 = ksb + (rb + kr0) * 1024 + h * 128 + (((lane & 15) ^ (kr0 & 15)) << 3);
    const bf16* kg1 = ksb + (rb + kr1) * 1024 + h * 128 + (((lane & 15) ^ (kr1 & 15)) << 3);
    const int vr0 = 16 * c.wave + (lane >> 3), vr1 = vr0 + 8;
    const bf16* vg0 = vt + ((size_t)bh * 128 + vr0) * SEQ + (((lane & 7) ^ ((vr0 >> 1) & 7)) << 3);
    const bf16* vg1 = vt + ((size_t)bh * 128 + vr1) * SEQ + (((lane & 7) ^ ((vr1 >> 1) & 7)) << 3);
    LAS unsigned char* dk = c.lds + c.wave * 2048; LAS unsigned char* dv = c.lds + AT_VOFF + c.wave * 2048;
#define AT_DMA(kt_, bi_) do { const int ktt_ = (kt_); LAS unsigned char* bb_ = (LAS unsigned char*)0 + (bi_) * AT_BUF; \
        __builtin_amdgcn_global_load_lds((const unsigned*)(kg0 + (size_t)ktt_ * 64 * 1024), (LAS unsigned*)(dk + (bi_) * AT_BUF), 16, 0, 0); \
        __builtin_amdgcn_global_load_lds((const unsigned*)(kg1 + (size_t)ktt_ * 64 * 1024), (LAS unsigned*)(dk + (bi_) * AT_BUF + 1024), 16, 0, 0); \
        __builtin_amdgcn_global_load_lds((const unsigned*)(vg0 + ktt_ * 64), (LAS unsigned*)(dv + (bi_) * AT_BUF), 16, 0, 0); \
        __builtin_amdgcn_global_load_lds((const unsigned*)(vg1 + ktt_ * 64), (LAS unsigned*)(dv + (bi_) * AT_BUF + 1024), 16, 0, 0); (void)bb_; } while (0)
    const int nkt = 4 * (qb + 1);
    asm volatile("s_waitcnt vmcnt(0)" ::: "memory");
    AT_DMA(nkt - 1, 0); AT_DMA(nkt - 2, 1);
    asm volatile("s_waitcnt vmcnt(4)" ::: "memory"); __builtin_amdgcn_s_barrier(); asm volatile("" ::: "memory");
    int bi = 0;
#pragma unroll 1
    for (int it = 0; it < nkt; ++it) {
        const int kt = nkt - 1 - it;
        const int b2 = (bi + 2) & 3;
        if (it + 2 < nkt) AT_DMA(kt - 2, b2);
        const LAS unsigned char* kim = c.lds + bi * AT_BUF; const LAS unsigned char* vim = kim + AT_VOFF;
        const int rel = q0w - 64 * kt;
        if (rel >= 32) {
            if (LAG) { if (pending) attn_pv(vimd, subd, cl, hf, pd, o);
                const f32x16 s1 = attn_scores(kim, 32 + cl, hf, qf); if (rel == 32) attn_weights<true>(s1, R, hf, cl, pd); else attn_weights<false>(s1, R, hf, cl, pd);
                vimd = vim; subd = 1; pending = true;
            } else { bf16x8 p[2];
                { const f32x16 s1 = attn_scores(kim, 32 + cl, hf, qf); if (rel == 32) attn_weights<true>(s1, R, hf, cl, p); else attn_weights<false>(s1, R, hf, cl, p); }
                attn_pv(vim, 1, cl, hf, p, o); }
        }
        if (rel >= 0) {
            if (LAG) { if (pending) attn_pv(vimd, subd, cl, hf, pd, o);
                const f32x16 s0 = attn_scores(kim, cl, hf, qf); if (rel == 0) attn_weights<true>(s0, R, hf, cl, pd); else attn_weights<false>(s0, R, hf, cl, pd);
                vimd = vim; subd = 0; pending = true;
            } else { bf16x8 p[2];
                { const f32x16 s0 = attn_scores(kim, cl, hf, qf); if (rel == 0) attn_weights<true>(s0, R, hf, cl, p); else attn_weights<false>(s0, R, hf, cl, p); }
                attn_pv(vim, 0, cl, hf, p, o); }
        }
        if (it + 2 < nkt) asm volatile("s_waitcnt vmcnt(4)\n\ts_waitcnt lgkmcnt(0)" ::: "memory"); else asm volatile("s_waitcnt vmcnt(0)\n\ts_waitcnt lgkmcnt(0)" ::: "memory");
        __builtin_amdgcn_s_barrier(); asm volatile("" ::: "memory");
        bi = (bi + 1) & 3;
    }
#undef AT_DMA
    if (LAG && pending) attn_pv(vimd, subd, cl, hf, pd, o);
    bf16* orow = outb + (rb + q0w + cl) * 1024 + h * 128 + 4 * hf;
#pragma unroll
    for (int d = 0; d < 4; ++d)
#pragma unroll
        for (int g = 0; g < 4; ++g) { v2u q; q.x = pk2c(o[d][4 * g], o[d][4 * g + 1]); q.y = pk2c(o[d][4 * g + 2], o[d][4 * g + 3]); *(GAS v2u*)(orow + 32 * d + 8 * g) = q; }
    asm volatile("s_waitcnt vmcnt(0)" ::: "memory"); __builtin_amdgcn_s_barrier(); asm volatile("" ::: "memory");
}
__device__ __forceinline__ void hgpost_row(bf16* row, const bf16* grow, const float* w, int lane) {
#pragma unroll
    for (int j = 0; j < 2; ++j) {
        GAS v4u* p = (GAS v4u*)(row + 8 * lane + 512 * j); const v4u x = *p; const v4u gg = *(const GAS v4u*)(grow + 8 * lane + 512 * j);
        float f[8] = {bflo(x.x), bfhi(x.x), bflo(x.y), bfhi(x.y), bflo(x.z), bfhi(x.z), bflo(x.w), bfhi(x.w)};
        const float g[8] = {bflo(gg.x), bfhi(gg.x), bflo(gg.y), bfhi(gg.y), bflo(gg.z), bfhi(gg.z), bflo(gg.w), bfhi(gg.w)};
        float ss = 0.f;
#pragma unroll
        for (int k = 0; k < 8; ++k) ss += f[k] * f[k];
        ss += __shfl_xor(ss, 1); ss += __shfl_xor(ss, 2); ss += __shfl_xor(ss, 4); ss += __shfl_xor(ss, 8);
        const float r = __builtin_amdgcn_rsqf(ss * (1.0f / 128.0f) + EPS);
        const f32x4 wa = *(const GAS f32x4*)(w + ((8 * lane) & 127)), wb = *(const GAS f32x4*)(w + ((8 * lane) & 127) + 4);
        v4u o; o.x = pk2c(f[0] * r * wa.x * g[0], f[1] * r * wa.y * g[1]); o.y = pk2c(f[2] * r * wa.z * g[2], f[3] * r * wa.w * g[3]);
        o.z = pk2c(f[4] * r * wb.x * g[4], f[5] * r * wb.y * g[5]); o.w = pk2c(f[6] * r * wb.z * g[6], f[7] * r * wb.w * g[7]);
        *p = o;
    }
}

template <bool FIRST> struct EpiMerge {
    static constexpr bool PERM = true, AFTER_DRAIN = false;
    const bf16* gate; bf16* merged;
    __device__ __forceinline__ void operator()(const pg8::f32x4 (&acc)[2][2][4][2], const pg8::Unit& u, int wr, int wc, int fr, int fq) const {
        const int row0 = u.pm * 256 + wr * 64 + fr, col0 = u.pn * 256 + wc * 32 + 8 * fq;
#pragma unroll
        for (int ai = 0; ai < 2; ++ai)
#pragma unroll
            for (int m = 0; m < 4; ++m) {
                if (m == 0) asm volatile("" ::: "memory");
#pragma unroll
                for (int bj = 0; bj < 2; ++bj) {
                    const size_t off = (size_t)(row0 + ai * 128 + m * 16) * 2048 + col0 + bj * 128;
                    const v4u g = *(const GAS v4u*)(gate + off); const pg8::f32x4 v0 = acc[ai][bj][m][0], v1 = acc[ai][bj][m][1];
                    float r[8] = {bflo(g.x) * v0[0], bfhi(g.x) * v0[1], bflo(g.y) * v0[2], bfhi(g.y) * v0[3], bflo(g.z) * v1[0], bfhi(g.z) * v1[1], bflo(g.w) * v1[2], bfhi(g.w) * v1[3]};
                    if (!FIRST) { const v4u mo = *(const GAS v4u*)(merged + off);
                        r[0] += bflo(mo.x); r[1] += bfhi(mo.x); r[2] += bflo(mo.y); r[3] += bfhi(mo.y); r[4] += bflo(mo.z); r[5] += bfhi(mo.z); r[6] += bflo(mo.w); r[7] += bfhi(mo.w); }
                    v4u w; w.x = pk2c(r[0], r[1]); w.y = pk2c(r[2], r[3]); w.z = pk2c(r[4], r[5]); w.w = pk2c(r[6], r[7]);
                    *(GAS v4u*)(merged + off) = w; }
            }
    }
};
struct EpiStoreBf16 {
    static constexpr bool PERM = true, AFTER_DRAIN = false;
    bf16* out; const float* sa;
    __device__ __forceinline__ float rowscale(int row) const { return ((const GAS float*)sa)[row] * (1.0f / WIN_QS); }
    __device__ __forceinline__ void operator()(const pg8::f32x4 (&acc)[2][2][4][2], const pg8::Unit& u, int wr, int wc, int fr, int fq) const {
        const int row0 = u.pm * 256 + wr * 64 + fr, col0 = u.pn * 256 + wc * 32 + 8 * fq;
#pragma unroll
        for (int ai = 0; ai < 2; ++ai)
#pragma unroll
            for (int m = 0; m < 4; ++m)
#pragma unroll
                for (int bj = 0; bj < 2; ++bj) { const pg8::f32x4 v0 = acc[ai][bj][m][0], v1 = acc[ai][bj][m][1];
                    v4u w; w.x = pk2c(v0[0], v0[1]); w.y = pk2c(v0[2], v0[3]); w.z = pk2c(v1[0], v1[1]); w.w = pk2c(v1[2], v1[3]);
                    *(GAS v4u*)(out + (size_t)(row0 + ai * 128 + m * 16) * 2048 + col0 + bj * 128) = w; }
    }
};
struct EpiResid {
    static constexpr bool PERM = false, AFTER_DRAIN = false;
    const float* xin; float* xout;
    __device__ __forceinline__ void operator()(const pg8::f32x4 (&acc)[2][2][4][2], const pg8::Unit& u, int wr, int wc, int fr, int fq) const {
        const int row0 = u.pm * 256 + wr * 64 + fr, col0 = u.pn * 256 + wc * 32 + 4 * fq;
#pragma unroll
        for (int ai = 0; ai < 2; ++ai)
#pragma unroll
            for (int m = 0; m < 4; ++m)
#pragma unroll
                for (int bj = 0; bj < 2; ++bj)
#pragma unroll
                    for (int n = 0; n < 2; ++n) { const size_t off = (size_t)(row0 + ai * 128 + m * 16) * 2048 + col0 + bj * 128 + n * 16;
                        f32x4 r = acc[ai][bj][m][n]; if (xin) r += *(const GAS f32x4*)(xin + off);
                        *(GAS f32x4*)(xout + off) = r; }
    }
};

__device__ __forceinline__ float rl_f(float v, int l) { return __uint_as_float((unsigned)__builtin_amdgcn_readlane((int)__float_as_uint(v), l)); }
__device__ __forceinline__ void ins16(float (&L)[16], float x) {
#pragma unroll
    for (int i = 0; i < 16; ++i) { const float hi = __builtin_fmaxf(L[i], x); x = __builtin_fminf(L[i], x); L[i] = hi; }
}
#define CE_DESC(a, b) do { const float hi_ = __builtin_fmaxf(a, b), lo_ = __builtin_fminf(a, b); a = hi_; b = lo_; } while (0)
__device__ __forceinline__ void sort16_desc(float (&v)[16]) {
#pragma unroll
    for (int k = 2; k <= 16; k <<= 1)
#pragma unroll
        for (int j = k >> 1; j > 0; j >>= 1)
#pragma unroll
            for (int i = 0; i < 16; ++i) { const int l = i ^ j; if (l > i) { if ((i & k) == 0) CE_DESC(v[i], v[l]); else CE_DESC(v[l], v[i]); } }
}
__device__ __forceinline__ void bitonic_merge16_desc(float (&v)[16]) {
#pragma unroll
    for (int j = 8; j > 0; j >>= 1)
#pragma unroll
        for (int i = 0; i < 16; ++i) { const int l = i ^ j; if (l > i) CE_DESC(v[i], v[l]); }
}
__device__ __forceinline__ void top16_merge(float (&L)[16], const float (&T)[16]) {
#pragma unroll
    for (int i = 0; i < 16; ++i) L[i] = __builtin_fmaxf(L[i], T[15 - i]);
    bitonic_merge16_desc(L);
}
constexpr int PK_KS = 272;
__device__ __forceinline__ void peer_top16(const bf16* qrow  , const LAS unsigned char* kl  , int hf, float (&L)[16]) {
    bf16x8 qf[8];
#pragma unroll
    for (int kk = 0; kk < 8; ++kk) qf[kk] = *(const GAS bf16x8*)(qrow + 16 * kk);
#pragma unroll 1
    for (int kt = 0; kt < 4; ++kt) {
        f32x16 sa;
#pragma unroll
        for (int r = 0; r < 16; ++r) sa[r] = 0.f;
#pragma unroll
        for (int kk = 0; kk < 8; ++kk) sa = MFMA32(*(const LAS bf16x8*)(kl + kt * 32 * PK_KS + 32 * kk), qf[kk], sa);
        float T[16];
#pragma unroll
        for (int r = 0; r < 16; ++r) { const unsigned idx = (unsigned)(kt * 32 + (r & 3) + 8 * (r >> 2) + 4 * hf); T[r] = __uint_as_float((__float_as_uint(sa[r]) & ~127u) | idx); }
        sort16_desc(T);
        if (kt == 0) {
#pragma unroll
            for (int i = 0; i < 16; ++i) L[i] = T[i];
        } else top16_merge(L, T);
    }
    float P[16];
#pragma unroll
    for (int i = 0; i < 16; ++i) P[i] = __shfl_xor(L[i], 32);
    top16_merge(L, P);
}
__device__ __forceinline__ void peer_select32(int hd, int n0, int lane, const bf16* qpeer, const LAS unsigned char* kl1, const LAS unsigned char* kl2, unsigned char* wsb, LAS unsigned* ldsw) {
    asm volatile("" : "+v"(lane));
    const int c = lane & 31, hf = lane >> 5, n = n0 + c;
    const bf16* qrow = qpeer + (size_t)n * 2048 + hd * 256 + 8 * hf;
    float A[16], B[16];
    peer_top16(qrow, kl1 + c * PK_KS + 16 * hf, hf, A);
    peer_top16(qrow + 128, kl2 + c * PK_KS + 16 * hf, hf, B);
#define PKV(x) __uint_as_float(__float_as_uint(x) & ~127u)
#define PKI(x) ((int)(__float_as_uint(x) & 127u))
    float W[16];
    { float C0[16], C1[16], C2[16], E0 = 0.f, E1 = 0.f; unsigned id = 0;
#pragma unroll
      for (int a = 0; a < 16; ++a)
#pragma unroll
        for (int b = 0; b < 16; ++b) if ((a + 1) * (b + 1) <= 16) { const float pk = __uint_as_float((__float_as_uint(PKV(A[a]) + PKV(B[b])) & ~63u) | id);
            if (id < 16) C0[id] = pk; else if (id < 32) C1[id - 16] = pk; else if (id < 48) C2[id - 32] = pk; else if (id == 48) E0 = pk; else E1 = pk;
            ++id; }
      sort16_desc(C0); sort16_desc(C1); sort16_desc(C2);
      top16_merge(C0, C1); top16_merge(C0, C2);
#pragma unroll
      for (int i = 0; i < 16; ++i) W[i] = C0[i];
      ins16(W, E0); ins16(W, E1); }
    const float thr = W[15], mx = W[0];
    int cnt = 0; float ssum = 0.f;
    LAS int* le = (LAS int*)ldsw + c * 16; LAS float* lg = (LAS float*)ldsw + 512 + c * 16;
    { unsigned id = 0;
#pragma unroll
      for (int a = 0; a < 16; ++a)
#pragma unroll
        for (int b = 0; b < 16; ++b) if ((a + 1) * (b + 1) <= 16) {
            const float cv = PKV(A[a]) + PKV(B[b]); const float pk = __uint_as_float((__float_as_uint(cv) & ~63u) | id); ++id;
            if (pk >= thr) { const float e = __expf(cv - mx); if (hf == 0) { le[cnt] = PKI(A[a]) * 128 + PKI(B[b]); lg[cnt] = e; } ssum += e; ++cnt; }
        } }
    LDS_WAIT();
    asm volatile("" : "+s"(wsb));
    int* sel_e = (int*)(wsb + WS_SEL); float* sel_g = (float*)(wsb + WS_SEL + 8 * MiB); float* sel_s = (float*)(wsb + WS_SELS);
    { int lane3 = lane; asm volatile("" : "+v"(lane3)); const int t = lane3 >> 1, part = lane3 & 1;
      const v4u e0 = *(const LAS v4u*)((LAS int*)ldsw + t * 16 + 8 * part), e1 = *(const LAS v4u*)((LAS int*)ldsw + t * 16 + 8 * part + 4);
      const v4u g0 = *(const LAS v4u*)((LAS int*)ldsw + 512 + t * 16 + 8 * part), g1 = *(const LAS v4u*)((LAS int*)ldsw + 512 + t * 16 + 8 * part + 4);
      GAS v4u* pe = (GAS v4u*)(sel_e + (size_t)(n0 + t) * 128 + hd * 16 + 8 * part); GAS v4u* pg = (GAS v4u*)(sel_g + (size_t)(n0 + t) * 128 + hd * 16 + 8 * part);
      pe[0] = e0; pe[1] = e1; pg[0] = g0; pg[1] = g1; }
    LDS_WAIT();
    { int lane4 = lane; asm volatile("" : "+v"(lane4)); if ((lane4 >> 5) == 0) ((GAS float*)sel_s)[(size_t)(n0 + (lane4 & 31)) * 8 + hd] = ssum; }
}

__device__ __forceinline__ float dot2bf(unsigned a, unsigned b, float acc) {
    return __builtin_amdgcn_fdot2_f32_bf16(__builtin_bit_cast(bf16v2, a), __builtin_bit_cast(bf16v2, b), acc, false);
}
__device__ __forceinline__ float dot8bf(const v4u a, const v4u b, float acc) {
    const unsigned a0 = a.x, a1 = a.y, a2 = a.z, a3 = a.w, b0 = b.x, b1 = b.y, b2 = b.z, b3 = b.w;
    acc = dot2bf(a0, b0, acc); acc = dot2bf(a1, b1, acc); acc = dot2bf(a2, b2, acc); acc = dot2bf(a3, b3, acc);
    return acc;
}
__device__ __forceinline__ void unpack16(const v4u q, float (&f)[16]) {
    const unsigned d0 = q.x, d1 = q.y, d2 = q.z, d3 = q.w;
    f32x2v t;
    t = __builtin_amdgcn_cvt_pk_f32_fp8((int)d0, false); f[0] = t.x; f[1] = t.y; t = __builtin_amdgcn_cvt_pk_f32_fp8((int)d0, true); f[2] = t.x; f[3] = t.y;
    t = __builtin_amdgcn_cvt_pk_f32_fp8((int)d1, false); f[4] = t.x; f[5] = t.y; t = __builtin_amdgcn_cvt_pk_f32_fp8((int)d1, true); f[6] = t.x; f[7] = t.y;
    t = __builtin_amdgcn_cvt_pk_f32_fp8((int)d2, false); f[8] = t.x; f[9] = t.y; t = __builtin_amdgcn_cvt_pk_f32_fp8((int)d2, true); f[10] = t.x; f[11] = t.y;
    t = __builtin_amdgcn_cvt_pk_f32_fp8((int)d3, false); f[12] = t.x; f[13] = t.y; t = __builtin_amdgcn_cvt_pk_f32_fp8((int)d3, true); f[14] = t.x; f[15] = t.y;
}
struct SliceSched { int mode, xcc, rank, nloc; };
__device__ __forceinline__ SliceSched slice_sched_init(const Ctx& c, unsigned* ctl, const XcdBarrier& bar, int use) {
    LAS int* sh = (LAS int*)(c.lds + 1024);
    if (c.tid == 0) {
        int ok = 1; unsigned tot = 0;
        for (int j = 0; j < 16; ++j) { const unsigned n = xb_ld(&bar.bar[XB_XCNT(j)]); tot += n; if ((j < 8) != (n > 0u)) ok = 0; }
        if (tot != (unsigned)c.G) ok = 0;
        const int xcc = (int)xb_xcc_id();
        int rank = 0, nloc = 1;
        if (ok) { nloc = (int)xb_ld(&bar.bar[XB_XCNT(xcc)]); rank = (int)xb_add(&ctl[CW_RANK + (use * 16 + xcc) * 64], 1u); if (rank >= nloc) ok = 0; }
        sh[0] = ok; sh[1] = xcc; sh[2] = rank; sh[3] = nloc;
    }
    __syncthreads();
    SliceSched S; S.mode = sh[0]; S.xcc = sh[1]; S.rank = sh[2]; S.nloc = sh[3];
    __syncthreads();
    return S;
}
__device__ __forceinline__ bool slice_item(const SliceSched& S, const Ctx& c, int i, int& slice, int& tb) {
    if (S.mode) { const int it = S.rank + i * S.nloc; if (it >= 512) return false; slice = S.xcc + 8 * (it >> 8); tb = it & 255; return true; }
    const int it = (int)blockIdx.x + i * c.G; if (it >= 4096) return false; slice = it >> 8; tb = it & 255; return true;
}
__device__ __forceinline__ void unpack16p(const v4u q, f32x2v (&f)[8]) {
    const unsigned d0 = q.x, d1 = q.y, d2 = q.z, d3 = q.w;
    f[0] = __builtin_amdgcn_cvt_pk_f32_fp8((int)d0, false); f[1] = __builtin_amdgcn_cvt_pk_f32_fp8((int)d0, true);
    f[2] = __builtin_amdgcn_cvt_pk_f32_fp8((int)d1, false); f[3] = __builtin_amdgcn_cvt_pk_f32_fp8((int)d1, true);
    f[4] = __builtin_amdgcn_cvt_pk_f32_fp8((int)d2, false); f[5] = __builtin_amdgcn_cvt_pk_f32_fp8((int)d2, true);
    f[6] = __builtin_amdgcn_cvt_pk_f32_fp8((int)d3, false); f[7] = __builtin_amdgcn_cvt_pk_f32_fp8((int)d3, true);
}
__device__ __forceinline__ void sddmm_load(const unsigned char* ubase, const LAS unsigned* ids16, v4u (&q)[16]) {
    int id[16];
#pragma unroll
    for (int i = 0; i < 4; ++i) { const v4u v = *(const LAS v4u*)(ids16 + 4 * i); id[4 * i] = (int)v.x; id[4 * i + 1] = (int)v.y; id[4 * i + 2] = (int)v.z; id[4 * i + 3] = (int)v.w; }
#pragma unroll
    for (int it = 0; it < 16; ++it) q[it] = *(const GAS v4u*)(ubase + (unsigned)id[it] * 128u);
}
__device__ __forceinline__ void sddmm_token(const v4u (&qc)[16], const v4u hv, const float hs, int lane, unsigned* dst) {
    const int hq[4] = {(int)hv.x, (int)hv.y, (int)hv.z, (int)hv.w};
    float p[16];
#pragma unroll
    for (int it = 0; it < 16; ++it) { int a = __builtin_amdgcn_sdot4((int)qc[it].x, hq[0], 0, false); a = __builtin_amdgcn_sdot4((int)qc[it].y, hq[1], a, false);
        a = __builtin_amdgcn_sdot4((int)qc[it].z, hq[2], a, false); a = __builtin_amdgcn_sdot4((int)qc[it].w, hq[3], a, false);
        p[it] = (float)a * hs; }
#pragma unroll
    for (int i = 0; i < 8; ++i) { const bool up = (lane & 4) != 0; const float snd = up ? p[i] : p[i + 8], kp = up ? p[i + 8] : p[i]; p[i] = kp + __shfl_xor(snd, 4); }
#pragma unroll
    for (int i = 0; i < 4; ++i) { const bool up = (lane & 2) != 0; const float snd = up ? p[i] : p[i + 4], kp = up ? p[i + 4] : p[i]; p[i] = kp + __shfl_xor(snd, 2); }
#pragma unroll
    for (int i = 0; i < 2; ++i) { const bool up = (lane & 1) != 0; const float snd = up ? p[i] : p[i + 2], kp = up ? p[i + 2] : p[i]; p[i] = kp + __shfl_xor(snd, 1); }
    *(GAS unsigned*)dst = pk2c(p[0], p[1]);
}
__device__ __forceinline__ void peer_sddmm_wave(int t0, int s, int lane, const unsigned char* H8, const float* SA, const unsigned char* UQ, const int* sel_e, float* part, LAS unsigned* ldsw) {
    const int cg = lane & 7, sg = lane >> 3;
#pragma unroll
    for (int j = 0; j < 4; ++j) *(LAS v4u*)(ldsw + 4 * (lane + 64 * j)) = *(const GAS v4u*)(sel_e + (size_t)t0 * 128 + 4 * (lane + 64 * j));
    LDS_WAIT();
    const unsigned char* ubase = UQ + (size_t)s * U8_SLICE + cg * 16;
    const LAS unsigned* idl = ldsw + sg * 16;
    const unsigned char* hbase = H8 + (size_t)t0 * 2048 + s * 128 + cg * 16;
    unsigned* pbase = (unsigned*)part + ((size_t)t0 * 16 + s) * 64 + lane;
    v4u qa[16], qb[16];
    v4u ha = *(const GAS v4u*)(hbase), hb; float sa = ((const GAS float*)SA)[t0], sb;
    sddmm_load(ubase, idl, qa);
#pragma unroll
    for (int k = 0; k < 6; k += 2) {
        hb = *(const GAS v4u*)(hbase + (size_t)(k + 1) * 2048); sb = ((const GAS float*)SA)[t0 + k + 1];
        sddmm_load(ubase, idl + (k + 1) * 128, qb);
        sddmm_token(qa, ha, sa, lane, pbase + (size_t)k * 1024);
        ha = *(const GAS v4u*)(hbase + (size_t)(k + 2) * 2048); sa = ((const GAS float*)SA)[t0 + k + 2];
        sddmm_load(ubase, idl + (k + 2) * 128, qa);
        sddmm_token(qb, hb, sb, lane, pbase + (size_t)(k + 1) * 1024);
    }
    hb = *(const GAS v4u*)(hbase + (size_t)7 * 2048); sb = ((const GAS float*)SA)[t0 + 7];
    sddmm_load(ubase, idl + 7 * 128, qb);
    sddmm_token(qa, ha, sa, lane, pbase + (size_t)6 * 1024);
    sddmm_token(qb, hb, sb, lane, pbase + (size_t)7 * 1024);
    LDS_WAIT();
}
__device__ __forceinline__ void peer_coef_tokens4(int t0, int ts, int lane, const float* part, const int* sel_e, float* sel_g, const float* sel_s, const float* US, const float* VS) {
    unsigned pv[4][16]; v2u e[4]; f32x2v g[4]; float dn[4];
#pragma unroll
    for (int i = 0; i < 4; ++i) { const int t = t0 + i * ts;
#pragma unroll
        for (int s = 0; s < 16; ++s) pv[i][s] = ((const GAS unsigned*)part)[((size_t)t * 16 + s) * 64 + lane];
        e[i] = *(const GAS v2u*)(sel_e + (size_t)t * 128 + 2 * lane); g[i] = *(const GAS f32x2v*)(sel_g + (size_t)t * 128 + 2 * lane); dn[i] = ((const GAS float*)sel_s)[(size_t)t * 8 + (lane >> 3)]; }
    float ux[4], uy[4], vx[4], vy[4];
#pragma unroll
    for (int i = 0; i < 4; ++i) { ux[i] = ((const GAS float*)US)[e[i].x]; uy[i] = ((const GAS float*)US)[e[i].y]; vx[i] = ((const GAS float*)VS)[e[i].x]; vy[i] = ((const GAS float*)VS)[e[i].y]; }
#pragma unroll
    for (int i = 0; i < 4; ++i) { const int t = t0 + i * ts; float a0 = 0.f, a1 = 0.f;
#pragma unroll
        for (int s = 0; s < 16; ++s) { a0 += bflo(pv[i][s]); a1 += bfhi(pv[i][s]); }
        const float inv = 1.0f / dn[i];
        const float ox = g[i].x * inv * gelu_exact(a0 * ux[i]) * vx[i], oy = g[i].y * inv * gelu_exact(a1 * uy[i]) * vy[i];
        const h2_t ha = {(_Float16)ox, (_Float16)ox}, hb = {(_Float16)oy, (_Float16)oy};
        *(GAS v2u*)(sel_g + (size_t)t * 128 + 2 * lane) = (v2u){__builtin_bit_cast(unsigned, ha), __builtin_bit_cast(unsigned, hb)}; }
}
__device__ __forceinline__ bool slice_item8(const SliceSched& S, const Ctx& c, int i, int& slice, int& tb) {
    if (S.mode) { const int it = S.rank + i * S.nloc; if (it >= 256) return false; slice = S.xcc; tb = it; return true; }
    const int it = (int)blockIdx.x + i * c.G; if (it >= 2048) return false; slice = it >> 8; tb = it & 255; return true;
}
template <int MODE = 0>
__device__ __forceinline__ void spmm6_load(const unsigned char* vbase, const LAS unsigned* ids8, v4u (&qa)[8], v2u (&qb)[8]) {
    const v4u i0 = *(const LAS v4u*)(ids8), i1 = *(const LAS v4u*)(ids8 + 4);
    const unsigned id[8] = {i0.x, i0.y, i0.z, i0.w, i1.x, i1.y, i1.z, i1.w};
    if constexpr (MODE == 2) {
#pragma unroll
        for (int it = 0; it < 8; ++it) { qa[it] = (v4u){id[it], id[it] + 1u, id[it] + 2u, id[it] + 3u}; qb[it] = (v2u){id[it] + 4u, id[it] + 5u}; }
        return; }
#pragma unroll
    for (int it = 0; it < 8; ++it) { const unsigned char* p = vbase + id[it] * 192u; qa[it] = *(const GAS v4u*)p; qb[it] = *(const GAS v2u*)(p + 16); }
}
template <int MODE = 0>
__device__ __forceinline__ void spmm6_fma(const v4u (&qa)[8], const v2u (&qb)[8], const LAS unsigned* cf8, h2_t (&y)[16]) {
    const v4u c0 = *(const LAS v4u*)(cf8), c1 = *(const LAS v4u*)(cf8 + 4);
    const unsigned cf[8] = {c0.x, c0.y, c0.z, c0.w, c1.x, c1.y, c1.z, c1.w};
    if constexpr (MODE == 1) {
#pragma unroll
        for (int it = 0; it < 8; ++it) { const unsigned x = (qa[it].x ^ qa[it].y) ^ (qa[it].z ^ qa[it].w) ^ (qb[it].x ^ qb[it].y) ^ cf[it]; y[it] = __builtin_bit_cast(h2_t, __builtin_bit_cast(unsigned, y[it]) ^ x); }
        return; }
#pragma unroll
    for (int it = 0; it < 8; ++it) { const v6u q = {qa[it].x, qa[it].y, qa[it].z, qa[it].w, qb[it].x, qb[it].y};
        const v32h_t f = __builtin_amdgcn_cvt_scalef32_pk32_f16_fp6(q, 1.0f); const h2_t c2 = __builtin_bit_cast(h2_t, cf[it]);
#pragma unroll
        for (int j = 0; j < 16; ++j) { const h2_t v = {f[2 * j], f[2 * j + 1]}; y[j] = __builtin_elementwise_fma(v, c2, y[j]); } }
}
template <int MODE = 0>
__device__ __forceinline__ void peer_spmm6_wave(int t0, int s, int lane, const unsigned char* V6, const int* sel_e, const float* coef, const float* x1, float* xout, LAS unsigned* ldsw) {
    const int cg = lane & 7, sg = lane >> 3;
#pragma unroll
    for (int j = 0; j < 4; ++j) { *(LAS v4u*)(ldsw + 4 * (lane + 64 * j)) = *(const GAS v4u*)(sel_e + (size_t)t0 * 128 + 4 * (lane + 64 * j));
        *(LAS v4u*)(ldsw + 1024 + 4 * (lane + 64 * j)) = *(const GAS v4u*)(coef + (size_t)t0 * 128 + 4 * (lane + 64 * j)); }
    LDS_WAIT();
    const unsigned char* vbase = V6 + (size_t)s * V6_SLICE + cg * 24;
    const LAS unsigned* idl = ldsw + sg * 16; const LAS unsigned* cfl = ldsw + 1024 + sg * 16;
    v4u qa0[8], qa1[8]; v2u qb0[8], qb1[8];
    spmm6_load<MODE>(vbase, idl, qa0, qb0);
    const size_t xoff = (size_t)t0 * 2048 + s * 256 + cg * 32 + 4 * sg;
    f32x4 xn = *(const GAS f32x4*)(x1 + xoff);
#pragma unroll
    for (int k = 0; k < 8; ++k) {
        const f32x4 xv = xn;
        h2_t y[16];
#pragma unroll
        for (int j = 0; j < 16; ++j) y[j] = (h2_t){(_Float16)0.f, (_Float16)0.f};
        spmm6_load<MODE>(vbase, idl + k * 128 + 8, qa1, qb1);
        if (k < 7) xn = *(const GAS f32x4*)(x1 + xoff + (size_t)(k + 1) * 2048);
        spmm6_fma<MODE>(qa0, qb0, cfl + k * 128, y);
        if (k < 7) spmm6_load<MODE>(vbase, idl + (k + 1) * 128, qa0, qb0);
        spmm6_fma<MODE>(qa1, qb1, cfl + k * 128 + 8, y);
        unsigned u[16];
#pragma unroll
        for (int j = 0; j < 16; ++j) u[j] = __builtin_bit_cast(unsigned, y[j]);
#pragma unroll
        for (int i = 0; i < 8; ++i) { const bool up = (lane & 32) != 0; const unsigned snd = up ? u[i] : u[i + 8], kp = up ? u[i + 8] : u[i]; u[i] = __builtin_bit_cast(unsigned, __builtin_bit_cast(h2_t, kp) + __builtin_bit_cast(h2_t, (unsigned)__shfl_xor((int)snd, 32))); }
#pragma unroll
        for (int i = 0; i < 4; ++i) { const bool up = (lane & 16) != 0; const unsigned snd = up ? u[i] : u[i + 4], kp = up ? u[i + 4] : u[i]; u[i] = __builtin_bit_cast(unsigned, __builtin_bit_cast(h2_t, kp) + __builtin_bit_cast(h2_t, (unsigned)__shfl_xor((int)snd, 16))); }
#pragma unroll
        for (int i = 0; i < 2; ++i) { const bool up = (lane & 8) != 0; const unsigned snd = up ? u[i] : u[i + 2], kp = up ? u[i + 2] : u[i]; u[i] = __builtin_bit_cast(unsigned, __builtin_bit_cast(h2_t, kp) + __builtin_bit_cast(h2_t, (unsigned)__shfl_xor((int)snd, 8))); }
        const h2_t r0 = __builtin_bit_cast(h2_t, u[0]), r1 = __builtin_bit_cast(h2_t, u[1]);
        f32x4 o; o.x = xv.x + (float)r0[0]; o.y = xv.y + (float)r0[1]; o.z = xv.z + (float)r1[0]; o.w = xv.w + (float)r1[1];
        *(GAS f32x4*)(xout + xoff + (size_t)k * 2048) = o;
    }
    LDS_WAIT();
}

struct Args { const float* in[21]; float* out; unsigned char* ws; int lo, hi, li, pad; };
__global__ void __launch_bounds__(512, 2) mk_fwd(Args args) {
    extern __shared__ __attribute__((aligned(16))) unsigned char lds_raw[];
    Ctx c; c.lds = (LAS unsigned char*)lds_raw; c.tid = threadIdx.x; c.lane = c.tid & 63; c.wave = __builtin_amdgcn_readfirstlane(c.tid >> 6);
    c.G = gridDim.x; c.gw = blockIdx.x * 8 + c.wave; c.NGW = c.G * 8;
    volatile LAS unsigned* MISC = (volatile LAS unsigned*)(c.lds + MISC_OFF);
    if (c.tid < 32) MISC[c.tid] = 0u;
    __syncthreads();
    unsigned char* ws = args.ws;
    const int lo = args.lo, hi = args.hi;
    XcdBarrier bar; bar.w0 = 0; bar.bar = (unsigned*)(ws + WS_CTL) + CW_BAR + args.li * XCD_BAR_WORDS; bar.x = 0; bar.st = nullptr;
    if (hi - lo > 1) bar = xcd_barrier_post((unsigned*)(ws + WS_CTL) + CW_BAR + args.li * XCD_BAR_WORDS, MISC + 8);
#ifndef ATTN_REPS
#define ATTN_REPS 1
#endif
#ifndef PHMASK
#define PHMASK 0x1fff
#endif
#ifndef REP_PH
#define REP_PH (-1)
#endif
    int rep2 = 2; asm volatile("" : "+s"(rep2));
#define RLOOP(k, cond) for (int rp_ = 0; rp_ < ((((k) == REP_PH) && (cond)) ? rep2 : 1); ++rp_)
#define RSYNC do { if (rp_) xcd_barrier(bar); } while (0)
#define IN(k) (((PHMASK >> ((k) % NPH)) & 1) && lo <= (k) && (k) < hi)
#define SEAM(k) do { if (IN(k) && IN((k) + 1)) xcd_barrier(bar); } while (0)
#define PH_BEGIN unsigned char* w = ws; float* outp = args.out; Ctx cc = c; int zi = 0; cc.lane = xb_lane_id(); cc.tid = cc.wave * 64 + cc.lane; \
    asm volatile("" : "+s"(w), "+s"(outp), "+s"(zi), "+v"(cc.tid), "+v"(cc.lane)); (void)w; (void)outp;
#define INP(k) (args.in[(k) + zi])
#define WSP(T, off) ((T*)(w + (off)))
    for (int l = 0; l < 2; ++l) {
        const int pb = l * NPH;
        if (IN(pb + 0)) { PH_BEGIN
            P0Args a; a.w_in = INP(2) + (size_t)l * DM * INW; a.w_br_sb = INP(11) + (size_t)l * BW * DM; a.w_br_hg = INP(12) + (size_t)l * BW * DM; a.w_br_conv = INP(13) + (size_t)l * BW * DM;
            a.w_o = INP(14) + (size_t)l * DM * DM; a.w_q = INP(16) + (size_t)l * DM * DM; a.u = INP(19) + (size_t)l * 16384 * 2048; a.v = INP(20) + (size_t)l * 16384 * 2048; a.lbp = INP(5);
            a.WinT = WSP(bf16, WS_WIN); a.WbrT = WSP(bf16, WS_WBR); a.WoT = WSP(bf16, WS_WO); a.WqT = WSP(bf16, WS_WQ); a.U = WSP(unsigned char, WS_U); a.V = WSP(unsigned char, WS_V); a.US = WSP(float, WS_US); a.VS = WSP(float, WS_VS); a.LB = WSP(float, WS_LB); a.layer = l; a.k1 = INP(17) + (size_t)l * 8 * 16384; a.k2 = INP(18) + (size_t)l * 8 * 16384; a.KB = WSP(bf16, WS_KEYS);
#ifndef REP_MODE0
#define REP_MODE0 15
#endif
            RLOOP(0, true) { RSYNC;
            int pm_ = 15; if (REP_PH == 0) { pm_ = rp_ ? REP_MODE0 : 15; asm volatile("" : "+s"(pm_)); }
            p0_convert(cc, a, pm_);
            if (pm_ & 8) rms_phase_i8(cc, l == 0 ? INP(0) : WSP(const float, WS_X2), INP(1) + (size_t)l * DM, WSP(unsigned char, WS_H), WSP(float, WS_SA)); }
        }
        SEAM(pb + 0);
        if (IN(pb + 1)) { PH_BEGIN
            RLOOP(1, true) { RSYNC;
            pg8::Gemm g{WSP(bf16, WS_H), WSP(bf16, WS_WIN), NTOK, INW, DM}; pg8::StaticOrder S; S.init(NTOK, INW, cc.G, (int)blockIdx.x);
            EpiIn E{WSP(bf16, WS_SEG), WSP(bf16, WS_GATE), WSP(float, WS_LB), WSP(float, WS_SA)};
            pg8::gemm_phase<EpiIn, pg8::StaticOrder, true, true, true>(cc.lds, g, S, E, cc.wave); }
        }
        SEAM(pb + 1);
        if (IN(pb + 2)) { PH_BEGIN
            bf16* SEG = WSP(bf16, WS_SEG);
#ifndef REP_MODE2
#define REP_MODE2 7
#endif
            RLOOP(2, true) { RSYNC;
            int pm_ = 7; if (REP_PH == 2) { pm_ = rp_ ? REP_MODE2 : 7; asm volatile("" : "+s"(pm_)); }
            if (pm_ & 1)
            conv_phase(cc, SEG + 7 * SEGSZ, INP(7) + (size_t)l * 31 * 1024, INP(8) + (size_t)l * 1024, INP(9) + (size_t)l * 1024, INP(10) + (size_t)l * 1024, WSP(bf16, WS_CONV));
            if (pm_ & 2)
            for (int ci = blockIdx.x; ci < 2048; ci += cc.G) hgA_chunk(cc, ci, SEG + 4 * SEGSZ, SEG + 5 * SEGSZ, WSP(bf16, WS_ST), WSP(float, WS_DEC));
            if (!rp_)
            for (int r = cc.gw; r < 2 * (NTOK / 4); r += cc.NGW) {
                if (r < NTOK / 4) qknorm_rows4(SEG + (size_t)r * 4 * 1024, 1024, INP(3) + (size_t)l * 128, 0.08838834764831845f * 1.4426950408889634f, cc.lane);
                else qknorm_rows4(SEG + SEGSZ + (size_t)(r - NTOK / 4) * 4 * 1024, 1024, INP(4) + (size_t)l * 128, 1.0f, cc.lane);
            }
            LAS unsigned short* scr = (LAS unsigned short*)(cc.lds + 4096 + cc.wave * 8192);
            if (pm_ & 4)
            for (int it = cc.gw; it < 8192; it += cc.NGW) vt_item(it, cc.lane, SEG + 2 * SEGSZ, WSP(bf16, WS_MERGED), scr); }
        }
        SEAM(pb + 2);
        if (IN(pb + 3)) { PH_BEGIN
            bf16* SEG = WSP(bf16, WS_SEG);
            RLOOP(3, true) { RSYNC;
            if (!rp_) hgB(cc, WSP(bf16, WS_ST), WSP(float, WS_DEC));
            for (int p = blockIdx.x; p < 256; p += cc.G) { const int bh = (p & 7) * 4 + (p >> 6), j = (p >> 3) & 7;
                if (cc.wave >= 4) {
#pragma unroll 1
                    for (int u = 0; u < 2; ++u) attn_unit<true>(cc, bh, u ? j : 15 - j, SEG, SEG + SEGSZ, WSP(bf16, WS_MERGED), SEG + 2 * SEGSZ);
                } else {
#pragma unroll 1
                    for (int u = 0; u < 2; ++u) attn_unit<false>(cc, bh, u ? j : 15 - j, SEG, SEG + SEGSZ, WSP(bf16, WS_MERGED), SEG + 2 * SEGSZ);
                } } }
        }
        SEAM(pb + 3);
        if (IN(pb + 4)) { PH_BEGIN
            bf16* SEG = WSP(bf16, WS_SEG);
            RLOOP(4, true) { RSYNC;
            for (int ci = blockIdx.x; ci < 2048; ci += cc.G) hgC_chunk(cc, ci, SEG + 3 * SEGSZ, SEG + 4 * SEGSZ, SEG + 5 * SEGSZ, SEG + 6 * SEGSZ, WSP(bf16, WS_ST), INP(6) + (size_t)l * 128, WSP(bf16, WS_HGR)); }
        }
        SEAM(pb + 4);
        if (IN(pb + 5)) { PH_BEGIN
            RLOOP(5, true) { RSYNC;
            pg8::StaticOrder S; S.init(NTOK, DM, cc.G, (int)blockIdx.x);
            { pg8::Gemm g{WSP(bf16, WS_SEG) + 2 * SEGSZ, WSP(bf16, WS_WBR), NTOK, DM, BW}; EpiMerge<true> E{WSP(bf16, WS_GATE), WSP(bf16, WS_MERGED)}; pg8::gemm_phase<EpiMerge<true>, pg8::StaticOrder, true, true>(cc.lds, g, S, E, cc.wave); }
            { pg8::Gemm g{WSP(bf16, WS_HGR), WSP(bf16, WS_WBR) + (size_t)DM * BW, NTOK, DM, BW}; EpiMerge<false> E{WSP(bf16, WS_GATE) + (size_t)NTOK * 2048, WSP(bf16, WS_MERGED)}; pg8::gemm_phase<EpiMerge<false>, pg8::StaticOrder, true, true>(cc.lds, g, S, E, cc.wave); }
            { pg8::Gemm g{WSP(bf16, WS_CONV), WSP(bf16, WS_WBR) + (size_t)2 * DM * BW, NTOK, DM, BW}; EpiMerge<false> E{WSP(bf16, WS_GATE) + (size_t)2 * NTOK * 2048, WSP(bf16, WS_MERGED)}; pg8::gemm_phase<EpiMerge<false>, pg8::StaticOrder, true, true>(cc.lds, g, S, E, cc.wave); } }
        }
        SEAM(pb + 5);
        if (IN(pb + 6)) { PH_BEGIN
            RLOOP(6, true) { RSYNC;
            pg8::Gemm g{WSP(bf16, WS_MERGED), WSP(bf16, WS_WO), NTOK, DM, DM}; pg8::StaticOrder S; S.init(NTOK, DM, cc.G, (int)blockIdx.x);
            EpiResid E{l == 0 ? INP(0) : WSP(const float, WS_X2), outp};
            pg8::gemm_phase<EpiResid, pg8::StaticOrder, true, true>(cc.lds, g, S, E, cc.wave); }
        }
        SEAM(pb + 6);
        if (IN(pb + 7)) { PH_BEGIN RLOOP(7, true) { RSYNC; rms_phase_i8(cc, outp, INP(15) + (size_t)l * DM, WSP(unsigned char, WS_H), WSP(float, WS_SA)); } }
        SEAM(pb + 7);
        if (IN(pb + 8)) { PH_BEGIN
            RLOOP(8, true) { RSYNC;
            pg8::Gemm g{WSP(bf16, WS_H), WSP(bf16, WS_WQ), NTOK, DM, DM}; pg8::StaticOrder S; S.init(NTOK, DM, cc.G, (int)blockIdx.x);
            EpiStoreBf16 E{WSP(bf16, WS_QPEER), WSP(float, WS_SA)};
            pg8::gemm_phase<EpiStoreBf16, pg8::StaticOrder, true, true, true>(cc.lds, g, S, E, cc.wave); }
        }
        SEAM(pb + 8);
        if (IN(pb + 9)) { PH_BEGIN
            RLOOP(9, true) { RSYNC;
            for (int item = blockIdx.x; item < 512; item += cc.G) { const int hd = item & 7, tg = item >> 3;
                const bf16* KB = WSP(bf16, WS_KEYS);
#pragma unroll
                for (int i = 0; i < 8; ++i) { const int p = cc.tid + 512 * i, li = p >> 11, row = (p >> 4) & 127, c16 = p & 15;
                    *(LAS v4u*)(cc.lds + li * 128 * PK_KS + row * PK_KS + c16 * 16) = *(const GAS v4u*)(KB + (size_t)(li * 8 + hd) * 16384 + row * 128 + c16 * 8); }
                __syncthreads();
                peer_select32(hd, tg * 256 + cc.wave * 32, cc.lane, WSP(bf16, WS_QPEER), cc.lds, cc.lds + 128 * PK_KS, w, (LAS unsigned*)(cc.lds + 2 * 128 * PK_KS + cc.wave * 4096));
                __syncthreads(); } }
        }
        SEAM(pb + 9);
        if (IN(pb + 10)) { PH_BEGIN
            const SliceSched SS = slice_sched_init(cc, (unsigned*)(w + WS_CTL), bar, l * 2 + 0);
            RLOOP(10, true) { RSYNC;
            for (int i = 0;; ++i) { int sl, tb; if (!slice_item(SS, cc, i, sl, tb)) break;
                peer_sddmm_wave(tb * 64 + cc.wave * 8, sl, cc.lane, WSP(unsigned char, WS_H), WSP(float, WS_SA), WSP(unsigned char, WS_U), WSP(int, WS_SEL), WSP(float, WS_PART), (LAS unsigned*)(cc.lds + 4096 + cc.wave * 8192)); } }
        }
        SEAM(pb + 10);
        if (IN(pb + 11)) { PH_BEGIN
            for (int n = cc.gw; n < NTOK / 4; n += cc.NGW) peer_coef_tokens4(n, NTOK / 4, cc.lane, WSP(float, WS_PART), WSP(int, WS_SEL), WSP(float, WS_SEL + 8 * MiB), WSP(float, WS_SELS), WSP(float, WS_US), WSP(float, WS_VS));
        }
        SEAM(pb + 11);
        if (IN(pb + 12)) { PH_BEGIN
            float* xo = l == 0 ? WSP(float, WS_X2) : outp;
            const SliceSched SS = slice_sched_init(cc, (unsigned*)(w + WS_CTL), bar, l * 2 + 1);
#ifndef REP_MODE
#define REP_MODE 0
#endif
            RLOOP(12, l == 0) { RSYNC;
            if (REP_MODE && rp_) {
            for (int i = 0;; ++i) { int sl, tb; if (!slice_item8(SS, cc, i, sl, tb)) break;
                peer_spmm6_wave<REP_MODE>(tb * 64 + cc.wave * 8, sl, cc.lane, WSP(unsigned char, WS_V), WSP(int, WS_SEL), WSP(float, WS_SEL + 8 * MiB), outp, WSP(float, WS_SEG + 64 * MiB), (LAS unsigned*)(cc.lds + 4096 + cc.wave * 8192)); }
            } else
            for (int i = 0;; ++i) { int sl, tb; if (!slice_item8(SS, cc, i, sl, tb)) break;
                peer_spmm6_wave(tb * 64 + cc.wave * 8, sl, cc.lane, WSP(unsigned char, WS_V), WSP(int, WS_SEL), WSP(float, WS_SEL + 8 * MiB), outp, xo, (LAS unsigned*)(cc.lds + 4096 + cc.wave * 8192)); } }
        }
        SEAM(pb + 12);
    }
#undef PH_BEGIN
#undef INP
#undef WSP
#undef IN
#undef SEAM
}

#ifndef MK_SPLIT
#define MK_SPLIT 0
#endif
extern "C" void kernel_launch(void* const* d_in, const int* in_sizes, int n_in, void* d_out, int out_size, void* d_ws, size_t ws_size, hipStream_t stream) {
    static int grid = 0;
    if (grid == 0) {
        if (n_in != 21 || out_size != NTOK * DM || ws_size < WS_END) { fprintf(stderr, "kernel_launch: unexpected shapes (n_in %d, out %d, ws %zu < %zu); nothing launched\n", n_in, out_size, ws_size, (size_t)WS_END); grid = -1; return; }
        int dev = 0, cus = 0, per_cu = 0;
        if (hipGetDevice(&dev) != hipSuccess || hipDeviceGetAttribute(&cus, hipDeviceAttributeMultiprocessorCount, dev) != hipSuccess) { grid = -1; return; }
        if (hipFuncSetAttribute((const void*)mk_fwd, hipFuncAttributeMaxDynamicSharedMemorySize, LDS_BYTES) != hipSuccess) { fprintf(stderr, "kernel_launch: hipFuncSetAttribute failed\n"); grid = -1; return; }
        if (hipOccupancyMaxActiveBlocksPerMultiprocessor(&per_cu, (const void*)mk_fwd, 512, LDS_BYTES) != hipSuccess || per_cu < 1) fprintf(stderr, "kernel_launch: occupancy query reports %d\n", per_cu);
        (void)hipGetLastError();
        grid = cus;
    }
    if (grid < 0) return;
    if (hipMemsetAsync((char*)d_ws + WS_CTL, 0, 1 * MiB, stream) != hipSuccess) { fprintf(stderr, "kernel_launch: memset failed\n"); return; }
    Args a{};
    for (int i = 0; i < 21; ++i) a.in[i] = (const float*)d_in[i];
    a.out = (float*)d_out; a.ws = (unsigned char*)d_ws; a.pad = 0;
#if MK_SPLIT
    for (int p = 0; p < NPHASES; ++p) { a.lo = p; a.hi = p + 1; a.li = p; hipLaunchKernelGGL(mk_fwd, dim3(grid), dim3(512), LDS_BYTES, stream, a); }
#else
    a.lo = 0; a.hi = NPHASES; a.li = 0;
    hipLaunchKernelGGL(mk_fwd, dim3(grid), dim3(512), LDS_BYTES, stream, a);
#endif
    const hipError_t le = hipPeekAtLastError();
    if (le != hipSuccess) fprintf(stderr, "kernel_launch: launch failed: %s\n", hipGetErrorName(le));
}
```

```cpp
#include <hip/hip_runtime.h>
#include <cstdio>
#include <cstdint>
namespace pg8 {
#define PG8_LAS __attribute__((address_space(3)))
typedef unsigned short bf16_t;
typedef short bf16x8 __attribute__((ext_vector_type(8)));
typedef float f32x4 __attribute__((ext_vector_type(4)));
typedef unsigned u32x4 __attribute__((ext_vector_type(4)));
constexpr int BM = 256, BK = 64, HALF = 128, HTB = HALF * BK * 2  , STAGE_BYTES = 8 * HTB, NXCD = 8, WGM = 8;

__host__ __device__ __forceinline__ int lds_byte(int r, int c) { const int st = (r >> 4) * 2 + (c >> 5), rr = r & 15, cc = c & 31, ob = rr * 64 + cc * 2; return st * 1024 + (ob ^ (((ob >> 9) & 1) << 5)); }
__host__ __device__ __forceinline__ void stage_rc(int b, int& R, int& C) { const int st = b / 1024, sb = b % 1024, swz = sb ^ (((sb >> 9) & 1) << 5); R = (st >> 1) * 16 + swz / 64; C = (st & 1) * 32 + (swz % 64) / 2; }
__host__ __device__ __forceinline__ int perm32(int rho) { const int n = rho >> 4, i = rho & 15; return 8 * (i >> 2) + 4 * n + (i & 3); }

struct Unit { int pm, pn; };
struct Gemm { const bf16_t* A; const bf16_t* Bt; int M, N, K; };

struct StaticOrder {
    int nM, nN, nwg, G, c;
    __host__ __device__ void init(int M, int N, int G_, int c_) { nM = M / BM; nN = N / BM; nwg = nM * nN; G = G_; c = c_; }
    __host__ __device__ bool next(int i, Unit& u) const {
        const long L = (long)i * G + c; if (L >= nwg) return false;
        int wgid = (int)L; { const int q = nwg / NXCD, r = nwg % NXCD, xcd = wgid % NXCD, off = wgid / NXCD; wgid = (xcd < r ? xcd * (q + 1) : r * (q + 1) + (xcd - r) * q) + off; }
        const int nig = WGM * nN, gid = wgid / nig, fm = gid * WGM, gsz = (nM - fm) < WGM ? (nM - fm) : WGM;
        u.pm = fm + ((wgid % nig) % gsz); u.pn = (wgid % nig) / gsz; return true;
    }
    __device__ __forceinline__ void a_ready(const Unit&) const {}
    __device__ __forceinline__ void done(const Unit&) const {}
};

typedef float f32x2 __attribute__((ext_vector_type(2)));
template <class Epi, class Sched, bool ALIGN_EPI = false, bool SP2 = false, bool I8 = false>
__device__ __forceinline__ void gemm_phase(PG8_LAS unsigned char* lds, const Gemm g, const Sched& S, const Epi& E, int wave_) {
    unsigned z_ = 0u; asm volatile("" : "+s"(z_)); int tid_ = wave_ * 64 + (int)__builtin_amdgcn_mbcnt_hi(~0u, __builtin_amdgcn_mbcnt_lo(~0u, z_)); asm volatile("" : "+v"(tid_));     int K_ = g.K; asm volatile("" : "+s"(K_));
    const int tid = tid_, wid = __builtin_amdgcn_readfirstlane(tid >> 6), lane = tid & 63, wr = wid >> 2, wc = wid & 3, fr = lane & 15, fq = lane >> 4;
    const int K = I8 ? (K_ >> 1) : K_, nt = K / BK;
    unsigned voffA[2], voffB[2];
#pragma unroll
    for (int i = 0; i < 2; ++i) { int R, C; stage_rc(tid * 16 + i * 8192, R, C); const int Rb = Epi::PERM ? ((R & ~31) + perm32(R & 31)) : R;
        voffA[i] = (unsigned)(R * K + C) * 2u; voffB[i] = (unsigned)(Rb * K + C) * 2u; }
    const size_t kstep = (size_t)(BK * 2);
    const size_t hstep = (size_t)HALF * K * 2;
    const size_t tstep = 2 * hstep;
    const unsigned ldsw = (unsigned)wid * 1024u;
    const int aoff = lds_byte(wr * 64 + fr, fq * 8), boff = lds_byte(wc * 32 + fr, fq * 8);
#define PG8_SA(b, h) (((b) * 2 + (h)) * HTB)
#define PG8_SB(b, h) ((4 + (b) * 2 + (h)) * HTB)
#define PG8_STAGE(bufoff, gbase, voff) do { _Pragma("unroll") for (int _i = 0; _i < 2; ++_i) \
        __builtin_amdgcn_global_load_lds((const unsigned*)((const char*)(gbase) + (voff)[_i]), (PG8_LAS unsigned*)(lds + (bufoff) + ldsw + _i * 8192), 16, 0, 0); } while (0)
#define PG8_LDA(dst, b, h) do { _Pragma("unroll") for (int m = 0; m < 4; ++m) _Pragma("unroll") for (int k = 0; k < 2; ++k) dst[m][k] = *(const PG8_LAS bf16x8*)(lds + PG8_SA(b, h) + aoff + m * 2048 + k * 1024); } while (0)
#define PG8_LDB(dst, b, h) do { _Pragma("unroll") for (int n = 0; n < 2; ++n) _Pragma("unroll") for (int k = 0; k < 2; ++k) dst[n][k] = *(const PG8_LAS bf16x8*)(lds + PG8_SB(b, h) + boff + n * 2048 + k * 1024); } while (0)
#define PG8_MMA(ai, bj, At, Bt) do { __builtin_amdgcn_s_setprio(1); _Pragma("unroll") for (int m = 0; m < 4; ++m) _Pragma("unroll") for (int n = 0; n < 2; ++n) _Pragma("unroll") for (int k = 0; k < 2; ++k) { \
        if constexpr (I8) { typedef int v4i_t __attribute__((ext_vector_type(4))); \
            acc[ai][bj][m][n] = __builtin_bit_cast(f32x4, __builtin_amdgcn_mfma_i32_16x16x64_i8(__builtin_bit_cast(v4i_t, Bt[n][k]), __builtin_bit_cast(v4i_t, At[m][k]), __builtin_bit_cast(v4i_t, acc[ai][bj][m][n]), 0, 0, 0)); } \
        else acc[ai][bj][m][n] = __builtin_amdgcn_mfma_f32_16x16x32_bf16(Bt[n][k], At[m][k], acc[ai][bj][m][n], 0, 0, 0); } __builtin_amdgcn_s_setprio(0); } while (0)
#define PG8_WAIT_V(n) asm volatile("s_waitcnt vmcnt(" #n ")" ::: "memory")
#define PG8_WAIT_L(n) asm volatile("s_waitcnt lgkmcnt(" #n ")" ::: "memory")
#define PG8_BAR __builtin_amdgcn_s_barrier()
#define PG8_SCHED __builtin_amdgcn_sched_barrier(0)
    Unit cur, nxt; int ui = 0;
    if (!S.next(0, cur)) return;
    cur.pm = __builtin_amdgcn_readfirstlane(cur.pm); cur.pn = __builtin_amdgcn_readfirstlane(cur.pn);
    f32x4 acc[2][2][4][2];
#pragma unroll
    for (int a = 0; a < 2; ++a)
#pragma unroll
        for (int b = 0; b < 2; ++b)
#pragma unroll
            for (int m = 0; m < 4; ++m)
#pragma unroll
                for (int n = 0; n < 2; ++n) acc[a][b][m][n] = (f32x4){0.f, 0.f, 0.f, 0.f};
    bf16x8 At[4][2], B0[2][2], B1[2][2];
    const char* cA = (const char*)g.A + (size_t)cur.pm * tstep; const char* cB = (const char*)g.Bt + (size_t)cur.pn * tstep;
    S.a_ready(cur);
    if constexpr (SP2) {
        PG8_STAGE(PG8_SB(0, 0), cB, voffB); PG8_STAGE(PG8_SB(0, 1), cB + hstep, voffB); PG8_STAGE(PG8_SA(0, 0), cA, voffA); PG8_STAGE(PG8_SA(0, 1), cA + hstep, voffA);
        if (wr == 1) PG8_BAR;
        PG8_WAIT_V(2); PG8_BAR;
        PG8_STAGE(PG8_SB(1, 0), cB + kstep, voffB); PG8_STAGE(PG8_SA(1, 0), cA + kstep, voffA); PG8_STAGE(PG8_SB(1, 1), cB + hstep + kstep, voffB);
        PG8_WAIT_V(6); PG8_BAR;
    } else {
        PG8_STAGE(PG8_SB(0, 0), cB, voffB); PG8_STAGE(PG8_SA(0, 0), cA, voffA); PG8_STAGE(PG8_SB(0, 1), cB + hstep, voffB); PG8_STAGE(PG8_SA(0, 1), cA + hstep, voffA);
        if (wr == 1) PG8_BAR;
        PG8_WAIT_V(4); PG8_BAR;
        PG8_STAGE(PG8_SB(1, 0), cB + kstep, voffB); PG8_STAGE(PG8_SA(1, 0), cA + kstep, voffA); PG8_STAGE(PG8_SB(1, 1), cB + hstep + kstep, voffB);
        PG8_WAIT_V(6); PG8_BAR;
    }
    for (;;) {
        const bool has_next = S.next(ui + 1, nxt);
        nxt.pm = __builtin_amdgcn_readfirstlane(nxt.pm); nxt.pn = __builtin_amdgcn_readfirstlane(nxt.pn);
        const char* nA = has_next ? (const char*)g.A + (size_t)nxt.pm * tstep : cA; const char* nB = has_next ? (const char*)g.Bt + (size_t)nxt.pn * tstep : cB;
        for (int t = 0; t < nt; t += 2) {
            const bool last = (t == nt - 2);
            const char* a1 = cA + (size_t)(t + 1) * kstep;
            const char* a2 = last ? nA : cA + (size_t)(t + 2) * kstep; const char* b2 = last ? nB : cB + (size_t)(t + 2) * kstep;
            const char* a3 = a2 + kstep; const char* b3 = b2 + kstep;
            if (last && has_next) S.a_ready(nxt);
            if constexpr (SP2) {
            PG8_LDB(B0, 0, 0); PG8_LDB(B1, 0, 1); PG8_SCHED; PG8_LDA(At, 0, 0); PG8_STAGE(PG8_SA(1, 1), a1 + hstep, voffA);
            PG8_WAIT_V(8); PG8_WAIT_L(0); PG8_BAR; PG8_MMA(0, 0, At, B0); PG8_MMA(0, 1, At, B1); PG8_BAR; PG8_SCHED;
            PG8_LDA(At, 0, 1); PG8_STAGE(PG8_SB(0, 0), b2, voffB); PG8_STAGE(PG8_SB(0, 1), b2 + hstep, voffB); PG8_STAGE(PG8_SA(0, 0), a2, voffA);
            PG8_WAIT_V(8); PG8_WAIT_L(0); PG8_BAR; PG8_MMA(1, 0, At, B0); PG8_MMA(1, 1, At, B1); PG8_BAR; PG8_SCHED;
            PG8_LDB(B0, 1, 0); PG8_LDB(B1, 1, 1); PG8_SCHED; PG8_LDA(At, 1, 0); PG8_STAGE(PG8_SA(0, 1), a2 + hstep, voffA);
            PG8_WAIT_V(8); PG8_WAIT_L(0); PG8_BAR; PG8_MMA(0, 0, At, B0); PG8_MMA(0, 1, At, B1); PG8_BAR; PG8_SCHED;
            PG8_LDA(At, 1, 1); PG8_STAGE(PG8_SB(1, 0), b3, voffB); PG8_STAGE(PG8_SB(1, 1), b3 + hstep, voffB); PG8_STAGE(PG8_SA(1, 0), a3, voffA);
            PG8_WAIT_V(8); PG8_WAIT_L(0); PG8_BAR; PG8_MMA(1, 0, At, B0); PG8_MMA(1, 1, At, B1); PG8_BAR; PG8_SCHED;
            } else {
            PG8_LDB(B0, 0, 0); PG8_SCHED; PG8_LDA(At, 0, 0); PG8_STAGE(PG8_SA(1, 1), a1 + hstep, voffA);
            PG8_WAIT_L(8); PG8_BAR; PG8_WAIT_L(0); PG8_MMA(0, 0, At, B0); PG8_BAR; PG8_SCHED;
            PG8_LDB(B1, 0, 1); PG8_STAGE(PG8_SB(0, 0), b2, voffB);
            PG8_BAR; PG8_WAIT_L(0); PG8_MMA(0, 1, At, B1); PG8_BAR;
            PG8_LDA(At, 0, 1); PG8_STAGE(PG8_SA(0, 0), a2, voffA);
            PG8_BAR; PG8_WAIT_L(0); PG8_MMA(1, 0, At, B0); PG8_BAR; PG8_SCHED;
            PG8_STAGE(PG8_SB(0, 1), b2 + hstep, voffB);
            PG8_WAIT_V(6); PG8_BAR; PG8_MMA(1, 1, At, B1); PG8_BAR;
            PG8_LDB(B0, 1, 0); PG8_SCHED; PG8_LDA(At, 1, 0); PG8_STAGE(PG8_SA(0, 1), a2 + hstep, voffA);
            PG8_WAIT_L(8); PG8_BAR; PG8_WAIT_L(0); PG8_MMA(0, 0, At, B0); PG8_BAR; PG8_SCHED;
            PG8_LDB(B1, 1, 1); PG8_STAGE(PG8_SB(1, 0), b3, voffB);
            PG8_BAR; PG8_WAIT_L(0); PG8_MMA(0, 1, At, B1); PG8_BAR;
            PG8_LDA(At, 1, 1); PG8_STAGE(PG8_SA(1, 0), a3, voffA);
            PG8_BAR; PG8_WAIT_L(0); PG8_MMA(1, 0, At, B0); PG8_BAR; PG8_SCHED;
            PG8_STAGE(PG8_SB(1, 1), b3 + hstep, voffB);
            PG8_WAIT_V(6); PG8_BAR; PG8_MMA(1, 1, At, B1); PG8_BAR;
            }
        }
        if constexpr (ALIGN_EPI) { if (wr == 0) PG8_BAR; }
        if constexpr (I8) {
#pragma unroll
            for (int a = 0; a < 2; ++a)
#pragma unroll
                for (int m = 0; m < 4; ++m) { const float r_ = E.rowscale(cur.pm * BM + wr * 64 + fr + a * HALF + m * 16);
#pragma unroll
                    for (int b = 0; b < 2; ++b)
#pragma unroll
                        for (int n = 0; n < 2; ++n) { typedef int v4i2_t __attribute__((ext_vector_type(4))); const v4i2_t i_ = __builtin_bit_cast(v4i2_t, acc[a][b][m][n]);
                            acc[a][b][m][n] = (f32x4){(float)i_[0] * r_, (float)i_[1] * r_, (float)i_[2] * r_, (float)i_[3] * r_}; } }
        }
        if constexpr (!Epi::AFTER_DRAIN) { E(acc, cur, wr, wc, fr, fq); S.done(cur); }
        if (!has_next) break;
#pragma unroll
        for (int a = 0; a < 2; ++a)
#pragma unroll
            for (int b = 0; b < 2; ++b)
#pragma unroll
                for (int m = 0; m < 4; ++m)
#pragma unroll
                    for (int n = 0; n < 2; ++n) acc[a][b][m][n] = (f32x4){0.f, 0.f, 0.f, 0.f};
        cur = nxt; cA = nA; cB = nB; ++ui;
        if constexpr (ALIGN_EPI) { if (wr == 1) PG8_BAR; }
    }
    PG8_WAIT_V(0);
    if constexpr (!ALIGN_EPI) { if (wr == 0) PG8_BAR; }
    PG8_BAR;
    if constexpr (Epi::AFTER_DRAIN) { E.fused(acc, cur, wr, wc, fr, fq, lds, wid, lane); S.done(cur); }
#undef PG8_SA
#undef PG8_SB
#undef PG8_STAGE
#undef PG8_LDA
#undef PG8_LDB
#undef PG8_MMA
#undef PG8_WAIT_V
#undef PG8_WAIT_L
#undef PG8_BAR
#undef PG8_SCHED
}
}
#define XB_TMO      128
#define XB_XCNT(j)  (256  + 64 * (j))
#define XB_XSUB(j)  (1280 + 64 * (j))
#define XB_XGEN(j)  (2304 + 64 * (j))
#define XB_TOP      3328
#define XB_TOPGEN   3392
#define XCD_BAR_WORDS 3456
#define XB_SPIN_CAP (1u << 24)
#define LAS __attribute__((address_space(3)))

__device__ __forceinline__ unsigned xb_ld(unsigned* p)              { return __hip_atomic_load(p, __ATOMIC_RELAXED, __HIP_MEMORY_SCOPE_AGENT); }
__device__ __forceinline__ unsigned xb_add(unsigned* p, unsigned v) { return __hip_atomic_fetch_add(p, v, __ATOMIC_RELAXED, __HIP_MEMORY_SCOPE_AGENT); }
__device__ __forceinline__ unsigned xb_xcc_id() { return (unsigned)__builtin_amdgcn_s_getreg((3 << 11) | 20) & 0xFu; }
#define XB_SPIN(cond, bar) do { unsigned _sp = 0; while (cond) { __builtin_amdgcn_s_sleep(1); \
    if ((++_sp & 255u) == 0u) { if (xb_ld(&(bar)[XB_TMO])) break; if (_sp > XB_SPIN_CAP) { atomicAdd(&(bar)[XB_TMO], 1u); break; } } } } while (0)

__device__ __forceinline__ int xb_lane_id() { unsigned z = 0u; asm volatile("" : "+s"(z)); return (int)__builtin_amdgcn_mbcnt_hi(~0u, __builtin_amdgcn_mbcnt_lo(~0u, z)); }
struct XcdBarrier {
    unsigned w0;
    unsigned* bar; unsigned x;
    volatile LAS unsigned* st;
};

__device__ __forceinline__ XcdBarrier xcd_barrier_post(unsigned* bar, volatile LAS unsigned* st) {
    XcdBarrier b; b.bar = bar; b.x = xb_xcc_id(); b.st = st; b.w0 = (__builtin_amdgcn_readfirstlane((int)threadIdx.x >> 6) == 0) ? 1u : 0u;
    if (b.w0 && xb_lane_id() == 0) (void)xb_add(&bar[XB_XCNT(b.x)], 1u);
    return b;
}
__device__ __forceinline__ void xcd_barrier_complete(unsigned* bar, unsigned x, unsigned& nloc, unsigned& nx) {
    const unsigned G = gridDim.x * gridDim.y * gridDim.z;
    unsigned sum, cnt, mine, sp = 0u;
    for (;;) {
        sum = 0u; cnt = 0u; mine = 0u;
#pragma unroll
        for (unsigned j = 0; j < 16; ++j) { const unsigned c = xb_ld(&bar[XB_XCNT(j)]); sum += c; cnt += (c > 0u) ? 1u : 0u; mine = (j == x) ? c : mine; }
        if (sum == G) break;
        __builtin_amdgcn_s_sleep(1);
        if ((++sp & 255u) == 0u) { if (xb_ld(&bar[XB_TMO])) break; if (sp > XB_SPIN_CAP) { atomicAdd(&bar[XB_TMO], 1u); break; } }
    }
    nloc = mine > 0u ? mine : 1u; nx = cnt > 0u ? cnt : 1u;
}

__device__ __forceinline__ void xcd_barrier(const XcdBarrier& b) {
    asm volatile("s_waitcnt vmcnt(0)" ::: "memory");
    __syncthreads();
    if (b.w0 && xb_lane_id() == 0) {
        unsigned* bar = b.bar;
        __builtin_amdgcn_s_waitcnt(0);
        unsigned nloc = b.st[0], nx = b.st[1];
        if (nloc == 0u) { xcd_barrier_complete(bar, b.x, nloc, nx); b.st[0] = nloc; b.st[1] = nx; }
        const unsigned old = xb_add(&bar[XB_XSUB(b.x)], 1u);
        const unsigned gen = old / nloc;
        if (old + 1u == (gen + 1u) * nloc) {
            __builtin_amdgcn_fence(__ATOMIC_RELEASE, "agent");
            asm volatile("s_waitcnt vmcnt(0)" ::: "memory");
            const unsigned og = xb_add(&bar[XB_TOP], 1u);
            const unsigned tg = og / nx;
            if (og + 1u == (tg + 1u) * nx) xb_add(&bar[XB_TOPGEN], 1u);
            else XB_SPIN(xb_ld(&bar[XB_TOPGEN]) == tg, bar);
            __builtin_amdgcn_fence(__ATOMIC_ACQUIRE, "agent");
            xb_add(&bar[XB_XGEN(b.x)], 1u);
            asm volatile("s_waitcnt vmcnt(0)" ::: "memory");
        } else {
            XB_SPIN(xb_ld(&bar[XB_XGEN(b.x)]) == gen, bar);
            __builtin_amdgcn_fence(__ATOMIC_ACQUIRE, "agent");
            asm volatile("s_waitcnt vmcnt(0)" ::: "memory");
        }
    }
    __syncthreads();
}


#define GAS __attribute__((address_space(1)))
typedef unsigned short bf16;
typedef unsigned v4u __attribute__((ext_vector_type(4)));
typedef unsigned v2u __attribute__((ext_vector_type(2)));
typedef float f32x4 __attribute__((ext_vector_type(4)));
typedef float f32x2v __attribute__((ext_vector_type(2)));
typedef float f32x16 __attribute__((ext_vector_type(16)));
typedef short bf16x8 __attribute__((ext_vector_type(8)));
typedef __bf16 bf16v2 __attribute__((ext_vector_type(2)));
typedef _Float16 h2_t __attribute__((ext_vector_type(2)));
typedef _Float16 v32h_t __attribute__((ext_vector_type(32)));
typedef unsigned v6u __attribute__((ext_vector_type(6)));

constexpr int NTOK = 16384, DM = 2048, SEQ = 4096, INW = 15360, BW = 1024;
constexpr float EPS = 1e-6f;
constexpr float WBR_QS = 768.0f;
constexpr float ACT_QS = 127.0f / 6.0f;
constexpr float WIN_QS = 1024.0f;
constexpr int NPH = 13;
constexpr int NPHASES = 2 * NPH;

constexpr size_t MiB = 1u << 20;
constexpr size_t WS_CTL = 0;
constexpr size_t WS_LB = 1 * MiB;
constexpr size_t WS_SA = 1 * MiB + 192 * 1024;
constexpr size_t WS_US = 1 * MiB + 64 * 1024, WS_VS = 1 * MiB + 128 * 1024;
constexpr size_t WS_WIN = 2 * MiB;
constexpr size_t WS_MS = 1 * MiB + 256 * 1024;
constexpr size_t WS_M8 = 859 * MiB;
constexpr size_t WS_WBR = 62 * MiB;
constexpr size_t WS_WO = 74 * MiB;
constexpr size_t WS_WQ = 82 * MiB;
constexpr size_t WS_U = 91 * MiB;
constexpr size_t WS_V = 155 * MiB;
constexpr size_t WS_H = 219 * MiB;
constexpr size_t WS_SEG = 283 * MiB;
constexpr size_t WS_GATE = 539 * MiB;
constexpr size_t WS_X2 = 731 * MiB;
constexpr size_t WS_CONV = 859 * MiB;
constexpr size_t WS_HGR = 891 * MiB;
constexpr size_t WS_MERGED = 923 * MiB;
constexpr size_t WS_SEL = 987 * MiB;
constexpr size_t WS_SELS = 1003 * MiB;
constexpr size_t WS_DEC = 1004 * MiB;
constexpr size_t WS_END = 1005 * MiB;
constexpr size_t WS_ST = WS_H;
constexpr size_t WS_KEYS = 90 * MiB;
constexpr size_t WS_PART = WS_GATE;
constexpr size_t WS_QPEER = WS_SEG;
constexpr size_t SEGSZ = (size_t)NTOK * 1024;
constexpr int CW_BAR = 4096;
constexpr int CW_RANK = 131072;

constexpr int RING_BYTES = 131072, MISC_OFF = RING_BYTES + 320, LDS_BYTES = 147456;

__device__ __forceinline__ unsigned pk2c(float lo, float hi) { f32x2v v = {lo, hi}; bf16v2 b = __builtin_convertvector(v, bf16v2); return __builtin_bit_cast(unsigned, b); }
__device__ __forceinline__ float bflo(unsigned x) { return __uint_as_float(x << 16); }
__device__ __forceinline__ float bfhi(unsigned x) { return __uint_as_float(x & 0xffff0000u); }
__device__ __forceinline__ float sigm(float x) { return __builtin_amdgcn_rcpf(1.0f + __expf(-x)); }
__device__ __forceinline__ float wave_sum(float v) {
#pragma unroll
    for (int o = 1; o < 64; o <<= 1) v += __shfl_xor(v, o);
    return v;
}
__device__ __forceinline__ float wave_max(float v) {
#pragma unroll
    for (int o = 1; o < 64; o <<= 1) v = fmaxf(v, __shfl_xor(v, o));
    return v;
}
#define LDS_WAIT() asm volatile("s_waitcnt lgkmcnt(0)" ::: "memory")
#define MFMA32(a, b, c) __builtin_amdgcn_mfma_f32_32x32x16_bf16((a), (b), (c), 0, 0, 0)
__device__ __forceinline__ int ridx16(int lane) { return ((lane >> 5) & 1) * 8 + ((lane >> 4) & 1) * 4 + ((lane >> 3) & 1) * 2 + ((lane >> 2) & 1); }
__device__ __forceinline__ void xreduce16(float (&v)[16], int lane) {
#pragma unroll
    for (int i = 0; i < 8; ++i) { const bool up = (lane & 32) != 0; const float snd = up ? v[i] : v[i + 8], kp = up ? v[i + 8] : v[i]; v[i] = kp + __shfl_xor(snd, 32); }
#pragma unroll
    for (int i = 0; i < 4; ++i) { const bool up = (lane & 16) != 0; const float snd = up ? v[i] : v[i + 4], kp = up ? v[i + 4] : v[i]; v[i] = kp + __shfl_xor(snd, 16); }
#pragma unroll
    for (int i = 0; i < 2; ++i) { const bool up = (lane & 8) != 0; const float snd = up ? v[i] : v[i + 2], kp = up ? v[i + 2] : v[i]; v[i] = kp + __shfl_xor(snd, 8); }
    { const bool up = (lane & 4) != 0; const float snd = up ? v[0] : v[1], kp = up ? v[1] : v[0]; v[0] = kp + __shfl_xor(snd, 4); }
    v[0] += __shfl_xor(v[0], 2); v[0] += __shfl_xor(v[0], 1);
}
__device__ __forceinline__ float gelu_exact(float v) {
    const float av = fabsf(v), t = __builtin_amdgcn_rcpf(av * 0.2316418882f + 1.0f);
    float q = t * 0.5307027145f + (-0.7265760135f); q = q * t + 0.7107068705f; q = q * t + (-0.142248368f); q = q * t + 0.127414796f; q = q * t;
    const float e = __builtin_amdgcn_exp2f((v * v) * (-0.72134752044f));
    const float m = v * (q * e);
    return v < 0.f ? m : v - m;
}

struct Ctx { LAS unsigned char* lds; int tid, lane, wave, G, gw, NGW; };

__device__ __forceinline__ void tr_item(const float* W, int K, int N, bf16* WT, int k0, int n0, int drow0, LAS float* scr, int lane) {
    { const int lr = lane >> 3, lc = (lane & 7) * 4; f32x4 v[8];
#pragma unroll
      for (int j = 0; j < 8; ++j) v[j] = *(const GAS f32x4*)(W + (size_t)(k0 + lr + 8 * j) * N + n0 + lc);
#pragma unroll
      for (int j = 0; j < 8; ++j) { LAS float* d = scr + (lr + 8 * j) * 33 + lc; d[0] = v[j].x; d[1] = v[j].y; d[2] = v[j].z; d[3] = v[j].w; } }
    LDS_WAIT();
    const int c = lane & 7;
#pragma unroll
    for (int j = 0; j < 4; ++j) { const int n = (lane >> 3) + 8 * j; const LAS float* s = scr + (8 * c) * 33 + n;
        v4u o; o.x = pk2c(s[0], s[33]); o.y = pk2c(s[66], s[99]); o.z = pk2c(s[132], s[165]); o.w = pk2c(s[198], s[231]);
        *(GAS v4u*)(WT + (size_t)(drow0 + n) * K + k0 + 8 * c) = o; }
    LDS_WAIT();
}
__device__ __forceinline__ unsigned pack_i8x4c(float a, float b, float c, float d) {
    const int ia = (int)__builtin_rintf(fminf(fmaxf(a, -127.f), 127.f)), ib = (int)__builtin_rintf(fminf(fmaxf(b, -127.f), 127.f)), ic = (int)__builtin_rintf(fminf(fmaxf(c, -127.f), 127.f)), id = (int)__builtin_rintf(fminf(fmaxf(d, -127.f), 127.f));
    return ((unsigned)ia & 255u) | (((unsigned)ib & 255u) << 8) | (((unsigned)ic & 255u) << 16) | ((unsigned)id << 24);
}
__device__ __forceinline__ void tr_item_i8(const float* W, int K, int N, unsigned char* WT, int k0, int n0, int drow0, float scale, LAS float* scr, int lane) {
    { const int lr = lane >> 3, lc = (lane & 7) * 4; f32x4 v[16];
#pragma unroll
      for (int j = 0; j < 16; ++j) v[j] = *(const GAS f32x4*)(W + (size_t)(k0 + lr + 8 * j) * N + n0 + lc);
#pragma unroll
      for (int j = 0; j < 16; ++j) { LAS float* d = scr + (lr + 8 * j) * 32 + (lc ^ ((j & 7) << 2)); const int x = lr & 3; d[x] = v[j].x; d[1 ^ x] = v[j].y; d[2 ^ x] = v[j].z; d[3 ^ x] = v[j].w; } }
    LDS_WAIT();
    const int c = lane & 15;
#pragma unroll
    for (int j = 0; j < 8; ++j) { const int n = (lane >> 4) + 4 * j, q = n ^ ((c & 7) << 2); const LAS float* s = scr + (8 * c) * 32;
        v2u o; o.x = pack_i8x4c(s[q] * scale, s[32 + (q ^ 1)] * scale, s[64 + (q ^ 2)] * scale, s[96 + (q ^ 3)] * scale); o.y = pack_i8x4c(s[128 + q] * scale, s[160 + (q ^ 1)] * scale, s[192 + (q ^ 2)] * scale, s[224 + (q ^ 3)] * scale);
        *(GAS v2u*)(WT + (size_t)(drow0 + n) * K + k0 + 8 * c) = o; }
    LDS_WAIT();
}
__device__ __forceinline__ int win_drow(int n) { if (n < 7168 || n >= 9216) return n; const int r = n - 7168, isb = r >> 10, c = r & 1023; return 7168 + (c >> 7) * 256 + isb * 128 + (c & 127); }
__device__ __forceinline__ void cvt_copy(const Ctx& c, const float* src, bf16* dst, size_t n8) {
    const size_t NT = (size_t)c.G * 512;
    for (size_t i = (size_t)blockIdx.x * 512 + c.tid; i < n8; i += NT) {
        const f32x4 a = ((const GAS f32x4*)src)[2 * i], b = ((const GAS f32x4*)src)[2 * i + 1];
        v4u o; o.x = pk2c(a.x, a.y); o.y = pk2c(a.z, a.w); o.z = pk2c(b.x, b.y); o.w = pk2c(b.z, b.w);
        ((GAS v4u*)dst)[i] = o;
    }
}
__device__ __forceinline__ void rms_row(const float* xr, const float* w, bf16* o, int lane) {
    const GAS f32x4* xp = (const GAS f32x4*)xr + lane; f32x4 v[8]; float s = 0.f;
#pragma unroll
    for (int j = 0; j < 8; ++j) { v[j] = xp[64 * j]; s += (v[j].x * v[j].x + v[j].y * v[j].y) + (v[j].z * v[j].z + v[j].w * v[j].w); }
    const float r = __builtin_amdgcn_rsqf(wave_sum(s) * (1.0f / DM) + EPS);
    const GAS f32x4* wp = (const GAS f32x4*)w + lane; GAS v2u* op = (GAS v2u*)o + lane;
#pragma unroll
    for (int j = 0; j < 8; ++j) { const f32x4 wv = wp[64 * j]; v2u q; q.x = pk2c(v[j].x * r * wv.x, v[j].y * r * wv.y); q.y = pk2c(v[j].z * r * wv.z, v[j].w * r * wv.w); op[64 * j] = q; }
}
__device__ __forceinline__ void rms_row_i8(const float* xr, const float* w, unsigned char* o, float* sa, int lane) {
    const GAS f32x4* xp = (const GAS f32x4*)xr + lane; f32x4 v[8]; float s = 0.f;
#pragma unroll
    for (int j = 0; j < 8; ++j) { v[j] = xp[64 * j]; s += (v[j].x * v[j].x + v[j].y * v[j].y) + (v[j].z * v[j].z + v[j].w * v[j].w); }
    const float r = __builtin_amdgcn_rsqf(wave_sum(s) * (1.0f / DM) + EPS);
    const GAS f32x4* wp = (const GAS f32x4*)w + lane; float m = 0.f;
#pragma unroll
    for (int j = 0; j < 8; ++j) { const f32x4 wv = wp[64 * j]; v[j].x *= r * wv.x; v[j].y *= r * wv.y; v[j].z *= r * wv.z; v[j].w *= r * wv.w;
        m = fmaxf(fmaxf(m, fmaxf(fabsf(v[j].x), fabsf(v[j].y))), fmaxf(fabsf(v[j].z), fabsf(v[j].w))); }
    m = wave_max(m);
    const float inv = m > 0.f ? 127.0f / m : 0.f;
    if (lane == 0) *(GAS float*)sa = m * (1.0f / 127.0f);
#pragma unroll
    for (int j = 0; j < 8; ++j) ((GAS unsigned*)o)[lane + 64 * j] = pack_i8x4c(v[j].x * inv, v[j].y * inv, v[j].z * inv, v[j].w * inv);
}
__device__ __forceinline__ void rms_rows2_i8(const float* xa, const float* xb, const float* w, unsigned char* oa, unsigned char* ob, float* saa, float* sab, int lane) {
    const GAS f32x4* pa = (const GAS f32x4*)xa + lane; const GAS f32x4* pb = (const GAS f32x4*)xb + lane; f32x4 va[8], vb[8]; float s0 = 0.f, s1 = 0.f;
#pragma unroll
    for (int j = 0; j < 8; ++j) { va[j] = pa[64 * j]; vb[j] = pb[64 * j]; }
#pragma unroll
    for (int j = 0; j < 8; ++j) { s0 += (va[j].x * va[j].x + va[j].y * va[j].y) + (va[j].z * va[j].z + va[j].w * va[j].w); s1 += (vb[j].x * vb[j].x + vb[j].y * vb[j].y) + (vb[j].z * vb[j].z + vb[j].w * vb[j].w); }
#pragma unroll
    for (int o = 1; o < 64; o <<= 1) { s0 += __shfl_xor(s0, o); s1 += __shfl_xor(s1, o); }
    const float r0 = __builtin_amdgcn_rsqf(s0 * (1.0f / DM) + EPS), r1 = __builtin_amdgcn_rsqf(s1 * (1.0f / DM) + EPS);
    const GAS f32x4* wp = (const GAS f32x4*)w + lane; float m0 = 0.f, m1 = 0.f;
#pragma unroll
    for (int j = 0; j < 8; ++j) { const f32x4 wv = wp[64 * j];
        va[j].x *= r0 * wv.x; va[j].y *= r0 * wv.y; va[j].z *= r0 * wv.z; va[j].w *= r0 * wv.w; vb[j].x *= r1 * wv.x; vb[j].y *= r1 * wv.y; vb[j].z *= r1 * wv.z; vb[j].w *= r1 * wv.w;
        m0 = fmaxf(fmaxf(m0, fmaxf(fabsf(va[j].x), fabsf(va[j].y))), fmaxf(fabsf(va[j].z), fabsf(va[j].w))); m1 = fmaxf(fmaxf(m1, fmaxf(fabsf(vb[j].x), fabsf(vb[j].y))), fmaxf(fabsf(vb[j].z), fabsf(vb[j].w))); }
#pragma unroll
    for (int o = 1; o < 64; o <<= 1) { m0 = fmaxf(m0, __shfl_xor(m0, o)); m1 = fmaxf(m1, __shfl_xor(m1, o)); }
    const float i0 = m0 > 0.f ? 127.0f / m0 : 0.f, i1 = m1 > 0.f ? 127.0f / m1 : 0.f;
    if (lane == 0) { *(GAS float*)saa = m0 * (1.0f / 127.0f); *(GAS float*)sab = m1 * (1.0f / 127.0f); }
#pragma unroll
    for (int j = 0; j < 8; ++j) { ((GAS unsigned*)oa)[lane + 64 * j] = pack_i8x4c(va[j].x * i0, va[j].y * i0, va[j].z * i0, va[j].w * i0); ((GAS unsigned*)ob)[lane + 64 * j] = pack_i8x4c(vb[j].x * i1, vb[j].y * i1, vb[j].z * i1, vb[j].w * i1); }
}
__device__ __forceinline__ void rms_phase_i8(const Ctx& c, const float* x, const float* w, unsigned char* H8, float* SA) {
    for (int m = c.gw; m < NTOK / 2; m += c.NGW) rms_rows2_i8(x + (size_t)m * DM, x + (size_t)(m + NTOK / 2) * DM, w, H8 + (size_t)m * DM, H8 + (size_t)(m + NTOK / 2) * DM, SA + m, SA + m + NTOK / 2, c.lane);
}
__device__ __forceinline__ void bf16_rows_i8(const Ctx& c, const bf16* X, unsigned char* X8, float* XS) {
    for (int r = c.gw; r < NTOK; r += 4 * c.NGW) { v4u x[4][4];
#pragma unroll
        for (int i = 0; i < 4; ++i) if (r + i * c.NGW < NTOK)
#pragma unroll
            for (int j = 0; j < 4; ++j) x[i][j] = *(const GAS v4u*)(X + (size_t)(r + i * c.NGW) * DM + 8 * (c.lane + 64 * j));
#pragma unroll
        for (int i = 0; i < 4; ++i) if (r + i * c.NGW < NTOK) { const int row = r + i * c.NGW; float m = 0.f;
#pragma unroll
            for (int j = 0; j < 4; ++j) { const v4u q = x[i][j];
                m = fmaxf(m, fmaxf(fmaxf(fmaxf(fabsf(bflo(q.x)), fabsf(bfhi(q.x))), fmaxf(fabsf(bflo(q.y)), fabsf(bfhi(q.y)))), fmaxf(fmaxf(fabsf(bflo(q.z)), fabsf(bfhi(q.z))), fmaxf(fabsf(bflo(q.w)), fabsf(bfhi(q.w)))))); }
            m = wave_max(m);
            const float inv = m > 0.f ? 127.0f / m : 0.f;
            if (c.lane == 0) *(GAS float*)(XS + row) = m * (1.0f / 127.0f);
#pragma unroll
            for (int j = 0; j < 4; ++j) { const v4u q = x[i][j]; v2u o;
                o.x = pack_i8x4c(bflo(q.x) * inv, bfhi(q.x) * inv, bflo(q.y) * inv, bfhi(q.y) * inv); o.y = pack_i8x4c(bflo(q.z) * inv, bfhi(q.z) * inv, bflo(q.w) * inv, bfhi(q.w) * inv);
                *(GAS v2u*)(X8 + (size_t)row * DM + 8 * (c.lane + 64 * j)) = o; } } }
}
__device__ __forceinline__ void rms_rows2(const float* xa, const float* xb, const float* w, bf16* oa, bf16* ob, int lane) {
    const GAS f32x4* pa = (const GAS f32x4*)xa + lane; const GAS f32x4* pb = (const GAS f32x4*)xb + lane; f32x4 va[8], vb[8]; float sa = 0.f, sb = 0.f;
#pragma unroll
    for (int j = 0; j < 8; ++j) { va[j] = pa[64 * j]; vb[j] = pb[64 * j]; }
#pragma unroll
    for (int j = 0; j < 8; ++j) { sa += (va[j].x * va[j].x + va[j].y * va[j].y) + (va[j].z * va[j].z + va[j].w * va[j].w); sb += (vb[j].x * vb[j].x + vb[j].y * vb[j].y) + (vb[j].z * vb[j].z + vb[j].w * vb[j].w); }
#pragma unroll
    for (int o = 1; o < 64; o <<= 1) { sa += __shfl_xor(sa, o); sb += __shfl_xor(sb, o); }
    const float ra = __builtin_amdgcn_rsqf(sa * (1.0f / DM) + EPS), rb = __builtin_amdgcn_rsqf(sb * (1.0f / DM) + EPS);
    const GAS f32x4* wp = (const GAS f32x4*)w + lane; GAS v2u* qa = (GAS v2u*)oa + lane; GAS v2u* qb = (GAS v2u*)ob + lane;
#pragma unroll
    for (int j = 0; j < 8; ++j) { const f32x4 wv = wp[64 * j];
        v2u q; q.x = pk2c(va[j].x * ra * wv.x, va[j].y * ra * wv.y); q.y = pk2c(va[j].z * ra * wv.z, va[j].w * ra * wv.w); qa[64 * j] = q;
        v2u p; p.x = pk2c(vb[j].x * rb * wv.x, vb[j].y * rb * wv.y); p.y = pk2c(vb[j].z * rb * wv.z, vb[j].w * rb * wv.w); qb[64 * j] = p; }
}
__device__ __forceinline__ void rms_phase(const Ctx& c, const float* x, const float* w, bf16* H) {
    for (int m = c.gw; m < NTOK / 2; m += c.NGW) rms_rows2(x + (size_t)m * DM, x + (size_t)(m + NTOK / 2) * DM, w, H + (size_t)m * DM, H + (size_t)(m + NTOK / 2) * DM, c.lane);
}
__device__ __forceinline__ void fp8_row(const float* src, unsigned char* dst, float* scale_out, int lane) {
    const GAS f32x4* xp = (const GAS f32x4*)src + lane; f32x4 v[8]; float m = 0.f;
#pragma unroll
    for (int j = 0; j < 8; ++j) { v[j] = xp[64 * j]; m = fmaxf(fmaxf(m, fmaxf(fabsf(v[j].x), fabsf(v[j].y))), fmaxf(fabsf(v[j].z), fabsf(v[j].w))); }
    m = wave_max(m);
    const float inv = m > 0.f ? 256.0f / m : 0.f;
    if (lane == 0) *(GAS float*)scale_out = m * (1.0f / 256.0f);
#pragma unroll
    for (int j = 0; j < 8; ++j) { int p = __builtin_amdgcn_cvt_pk_fp8_f32(v[j].x * inv, v[j].y * inv, 0, false); p = __builtin_amdgcn_cvt_pk_fp8_f32(v[j].z * inv, v[j].w * inv, p, true);
        ((GAS unsigned*)dst)[lane + 64 * j] = (unsigned)p; }
}
constexpr size_t U8_SLICE = (size_t)16384 * 128;
__device__ __forceinline__ unsigned pack_i8x4(float a, float b, float c, float d) {
    const int ia = (int)__builtin_rintf(a), ib = (int)__builtin_rintf(b), ic = (int)__builtin_rintf(c), id = (int)__builtin_rintf(d);
    return ((unsigned)ia & 255u) | (((unsigned)ib & 255u) << 8) | (((unsigned)ic & 255u) << 16) | ((unsigned)id << 24);
}
__device__ __forceinline__ void row_load_strided(const float* src, int lane, f32x4 (&v)[8]) { const GAS f32x4* xp = (const GAS f32x4*)src + lane;
#pragma unroll
    for (int j = 0; j < 8; ++j) v[j] = xp[64 * j]; }
__device__ __forceinline__ void row_load_contig(const float* src, int lane, f32x4 (&v)[8]) { const GAS f32x4* xp = (const GAS f32x4*)src + 8 * lane;
#pragma unroll
    for (int j = 0; j < 8; ++j) v[j] = xp[j]; }
__device__ __forceinline__ void i8_row(const f32x4 (&v)[8], unsigned char* dst, float* scale_out, int lane) {
    float m = 0.f;
#pragma unroll
    for (int j = 0; j < 8; ++j) m = fmaxf(fmaxf(m, fmaxf(fabsf(v[j].x), fabsf(v[j].y))), fmaxf(fabsf(v[j].z), fabsf(v[j].w)));
    m = wave_max(m);
    const float inv = m > 0.f ? 127.0f / m : 0.f;
    if (lane == 0) *(GAS float*)scale_out = m * (1.0f / 127.0f);
#pragma unroll
    for (int j = 0; j < 8; ++j) *(GAS unsigned*)(dst + (size_t)(2 * j + (lane >> 5)) * U8_SLICE + 4 * (lane & 31)) = pack_i8x4(v[j].x * inv, v[j].y * inv, v[j].z * inv, v[j].w * inv);
}
constexpr size_t V6_SLICE = (size_t)16384 * 192;
__device__ __forceinline__ void fp6_row(const f32x4 (&v)[8], unsigned char* dst, float* scale_out, int lane) {
    float m = 0.f;
#pragma unroll
    for (int j = 0; j < 8; ++j) m = fmaxf(fmaxf(m, fmaxf(fabsf(v[j].x), fabsf(v[j].y))), fmaxf(fabsf(v[j].z), fabsf(v[j].w)));
    m = wave_max(m);
    const float inv = m > 0.f ? 7.5f / m : 0.f;
    if (lane == 0) *(GAS float*)scale_out = m * (1.0f / 7.5f);
    v32h_t h;
#pragma unroll
    for (int j = 0; j < 8; ++j) { h[4 * j] = (_Float16)(v[j].x * inv); h[4 * j + 1] = (_Float16)(v[j].y * inv); h[4 * j + 2] = (_Float16)(v[j].z * inv); h[4 * j + 3] = (_Float16)(v[j].w * inv); }
    const v6u q = __builtin_amdgcn_cvt_scalef32_pk32_fp6_f16(h, 1.0f);
    GAS v2u* o = (GAS v2u*)(dst + (size_t)(lane >> 3) * V6_SLICE + 24 * (lane & 7));
    o[0] = (v2u){q[0], q[1]}; o[1] = (v2u){q[2], q[3]}; o[2] = (v2u){q[4], q[5]};
}
struct P0Args { const float *w_in, *w_br_sb, *w_br_hg, *w_br_conv, *w_o, *w_q, *u, *v, *lbp; bf16 *WinT, *WbrT, *WoT, *WqT; unsigned char *U, *V; float *US, *VS; float* LB; int layer; const float *k1, *k2; bf16* KB; };
__device__ __forceinline__ void p0_convert(const Ctx& c, const P0Args& a, int parts = 7) {
    LAS float* scr = (LAS float*)(c.lds + c.wave * 16384);
    constexpr int I_IN = (DM / 128) * (INW / 32), I_BR = (BW / 64) * (DM / 32), I_SQ = (DM / 64) * (DM / 32);
    constexpr int I_Q8 = (DM / 128) * (DM / 32);
    constexpr int I_B8 = (BW / 128) * (DM / 32);
    constexpr int NITEMS = I_IN + I_BR + 2 * I_B8 + 2 * I_Q8;
    if (parts & 1)
    for (int it = c.gw; it < NITEMS; it += c.NGW) {
        int r = it;
        if (r < I_IN) { const int kb = r / (INW / 32), nb = r % (INW / 32); tr_item_i8(a.w_in, DM, INW, (unsigned char*)a.WinT, kb * 128, nb * 32, win_drow(nb * 32), WIN_QS, scr, c.lane); continue; } r -= I_IN;
        if (r < I_BR) { const int kb = r / (DM / 32), nb = r % (DM / 32); tr_item(a.w_br_sb, BW, DM, a.WbrT, kb * 64, nb * 32, nb * 32, scr, c.lane); continue; } r -= I_BR;
        if (r < I_B8) { const int kb = r / (DM / 32), nb = r % (DM / 32); tr_item_i8(a.w_br_hg, BW, DM, (unsigned char*)(a.WbrT + (size_t)DM * BW), kb * 128, nb * 32, nb * 32, WBR_QS, scr, c.lane); continue; } r -= I_B8;
        if (r < I_B8) { const int kb = r / (DM / 32), nb = r % (DM / 32); tr_item_i8(a.w_br_conv, BW, DM, (unsigned char*)(a.WbrT + (size_t)2 * DM * BW), kb * 128, nb * 32, nb * 32, WBR_QS, scr, c.lane); continue; } r -= I_B8;
        if (r < I_Q8) { const int kb = r / (DM / 32), nb = r % (DM / 32); tr_item_i8(a.w_o, DM, DM, (unsigned char*)a.WoT, kb * 128, nb * 32, nb * 32, WIN_QS, scr, c.lane); continue; } r -= I_Q8;
        { const int kb = r / (DM / 32), nb = r % (DM / 32); tr_item_i8(a.w_q, DM, DM, (unsigned char*)a.WqT, kb * 128, nb * 32, nb * 32, WIN_QS, scr, c.lane); }
    }
    if (parts & 2)
    {
    for (int r = c.gw; r < 16384; r += 2 * c.NGW) { const int r2 = r + c.NGW; f32x4 va[8], vb[8];
        row_load_strided(a.u + (size_t)r * 2048, c.lane, va); if (r2 < 16384) row_load_strided(a.u + (size_t)r2 * 2048, c.lane, vb);
        i8_row(va, a.U + (size_t)r * 128, a.US + r, c.lane); if (r2 < 16384) i8_row(vb, a.U + (size_t)r2 * 128, a.US + r2, c.lane); }
    for (int r = c.gw; r < 16384; r += 2 * c.NGW) { const int r2 = r + c.NGW; f32x4 va[8], vb[8];
        row_load_contig(a.v + (size_t)r * 2048, c.lane, va); if (r2 < 16384) row_load_contig(a.v + (size_t)r2 * 2048, c.lane, vb);
        fp6_row(va, a.V + (size_t)r * 192, a.VS + r, c.lane); if (r2 < 16384) fp6_row(vb, a.V + (size_t)r2 * 192, a.VS + r2, c.lane); }
    }
    if (parts & 4) {
    cvt_copy(c, a.k1, a.KB, (size_t)8 * 16384 / 8);
    cvt_copy(c, a.k2, a.KB + 8 * 16384, (size_t)8 * 16384 / 8); }
    if (blockIdx.x == 0) for (int i = c.tid; i < 1024; i += 512) a.LB[i] = a.layer == 0 ? 0.f : sigm(a.lbp[1024 + i] - a.lbp[i]);
}

struct EpiIn {
    static constexpr bool PERM = true, AFTER_DRAIN = false;
    bf16* seg; bf16* gate; const float* lb; const float* sa;
    __device__ __forceinline__ float rowscale(int row) const { return ((const GAS float*)sa)[row] * (1.0f / WIN_QS); }
    __device__ __forceinline__ void operator()(const pg8::f32x4 (&acc)[2][2][4][2], const pg8::Unit& u, int wr, int wc, int fr, int fq) const {
        const int pn = u.pn; const int row0 = u.pm * 256 + wr * 64 + fr;
        if (pn >= 28 && pn < 36) {
            bf16* dst = seg + (size_t)7 * SEGSZ; const int col0 = (pn - 28) * 128 + wc * 32 + 8 * fq;
#pragma unroll
            for (int ai = 0; ai < 2; ++ai)
#pragma unroll
                for (int m = 0; m < 4; ++m) {
                    const pg8::f32x4 a0 = acc[ai][0][m][0], a1 = acc[ai][0][m][1], b0 = acc[ai][1][m][0], b1 = acc[ai][1][m][1];
                    v4u w; w.x = pk2c(a0[0] * sigm(b0[0]), a0[1] * sigm(b0[1])); w.y = pk2c(a0[2] * sigm(b0[2]), a0[3] * sigm(b0[3]));
                    w.z = pk2c(a1[0] * sigm(b1[0]), a1[1] * sigm(b1[1])); w.w = pk2c(a1[2] * sigm(b1[2]), a1[3] * sigm(b1[3]));
                    *(GAS v4u*)(dst + (size_t)(row0 + ai * 128 + m * 16) * 1024 + col0) = w; }
            return;
        }
        bf16* dst; int ld, colt, mode;
        if (pn < 28) { const int sg = pn >> 2; dst = seg + (size_t)sg * SEGSZ; ld = 1024; colt = (pn & 3) * 256; mode = (sg == 4) ? 2 : (sg == 6 ? 1 : 0); }
        else { const int q = pn - 36; dst = gate + (size_t)(q >> 3) * ((size_t)NTOK * 2048); ld = 2048; colt = (q & 7) * 256; mode = 1; }
        const int col0 = colt + wc * 32 + 8 * fq;
        if (mode == 0) {
#pragma unroll
            for (int ai = 0; ai < 2; ++ai)
#pragma unroll
                for (int m = 0; m < 4; ++m)
#pragma unroll
                    for (int bj = 0; bj < 2; ++bj) { const pg8::f32x4 v0 = acc[ai][bj][m][0], v1 = acc[ai][bj][m][1];
                        v4u w; w.x = pk2c(v0[0], v0[1]); w.y = pk2c(v0[2], v0[3]); w.z = pk2c(v1[0], v1[1]); w.w = pk2c(v1[2], v1[3]);
                        *(GAS v4u*)(dst + (size_t)(row0 + ai * 128 + m * 16) * ld + col0 + bj * 128) = w; }
        } else if (mode == 1) {
#pragma unroll
            for (int ai = 0; ai < 2; ++ai)
#pragma unroll
                for (int m = 0; m < 4; ++m)
#pragma unroll
                    for (int bj = 0; bj < 2; ++bj) { const pg8::f32x4 v0 = acc[ai][bj][m][0], v1 = acc[ai][bj][m][1];
                        v4u w; w.x = pk2c(sigm(v0[0]), sigm(v0[1])); w.y = pk2c(sigm(v0[2]), sigm(v0[3])); w.z = pk2c(sigm(v1[0]), sigm(v1[1])); w.w = pk2c(sigm(v1[2]), sigm(v1[3]));
                        *(GAS v4u*)(dst + (size_t)(row0 + ai * 128 + m * 16) * ld + col0 + bj * 128) = w; }
        } else {
            f32x4 l0[2], l1[2];
#pragma unroll
            for (int bj = 0; bj < 2; ++bj) { l0[bj] = *(const GAS f32x4*)(lb + col0 + bj * 128); l1[bj] = *(const GAS f32x4*)(lb + col0 + bj * 128 + 4); }
#pragma unroll
            for (int ai = 0; ai < 2; ++ai)
#pragma unroll
                for (int m = 0; m < 4; ++m)
#pragma unroll
                    for (int bj = 0; bj < 2; ++bj) { const pg8::f32x4 v0 = acc[ai][bj][m][0], v1 = acc[ai][bj][m][1]; float r[8];
#pragma unroll
                        for (int j = 0; j < 4; ++j) { r[j] = __logf(l0[bj][j] + (1.0f - l0[bj][j]) * sigm(v0[j])); r[4 + j] = __logf(l1[bj][j] + (1.0f - l1[bj][j]) * sigm(v1[j])); }
                        v4u w; w.x = pk2c(r[0], r[1]); w.y = pk2c(r[2], r[3]); w.z = pk2c(r[4], r[5]); w.w = pk2c(r[6], r[7]);
                        *(GAS v4u*)(dst + (size_t)(row0 + ai * 128 + m * 16) * ld + col0 + bj * 128) = w; }
        }
    }
};

__device__ __forceinline__ void conv_phase(const Ctx& c, const bf16* glu, const float* cw, const float* cb, const float* lnw, const float* lnb, bf16* out) {
    const int c0 = 2 * c.tid;
    float w0[31], w1[31];
#pragma unroll
    for (int j = 0; j < 31; ++j) { const f32x2v t = *(const GAS f32x2v*)(cw + j * 1024 + c0); w0[j] = t.x; w1[j] = t.y; }
    const f32x2v bv = *(const GAS f32x2v*)(cb + c0), lwv = *(const GAS f32x2v*)(lnw + c0), lbv = *(const GAS f32x2v*)(lnb + c0);
    LAS float* red = (LAS float*)c.lds;
    const int per = (NTOK / 8 + c.G - 1) / c.G, tile0 = (int)blockIdx.x * per;
    unsigned win[38];
    if (tile0 < NTOK / 8) {
#pragma unroll
        for (int r = 0; r < 38; ++r) { const int n = tile0 * 8 + r - 30; win[r] = *(const GAS unsigned*)(glu + (size_t)(n > 0 ? n : 0) * 1024 + c0); } }
    for (int ti = 0; ti < per; ++ti) { const int tile = tile0 + ti; if (tile >= NTOK / 8) break;
        const int n0 = tile * 8, tseq0 = n0 & (SEQ - 1);
        const bool more = (ti + 1 < per) && (tile + 1 < NTOK / 8);
        float a0[8], a1[8];
#pragma unroll
        for (int t = 0; t < 8; ++t) { a0[t] = bv.x; a1[t] = bv.y; }
#pragma unroll
        for (int r = 0; r < 38; ++r) {
            const unsigned xv = (tseq0 + r - 30 >= 0) ? win[r] : 0u;
            const float x0 = bflo(xv), x1 = bfhi(xv);
#pragma unroll
            for (int t = 0; t < 8; ++t) { const int j = r - t; if (j >= 0 && j <= 30) { a0[t] += w0[j] * x0; a1[t] += w1[j] * x1; } }
        }
#pragma unroll
        for (int r = 0; r < 30; ++r) win[r] = win[r + 8];
        if (more) {
#pragma unroll
            for (int i = 0; i < 8; ++i) win[30 + i] = *(const GAS unsigned*)(glu + (size_t)(n0 + 8 + i) * 1024 + c0); }
        float st[16];
#pragma unroll
        for (int t = 0; t < 8; ++t) { st[2 * t] = a0[t] + a1[t]; st[2 * t + 1] = a0[t] * a0[t] + a1[t] * a1[t]; }
        xreduce16(st, c.lane);
        if ((c.lane & 3) == 0) red[c.wave * 16 + ridx16(c.lane)] = st[0];
        __syncthreads();
        if (c.tid < 16) { float s = 0.f;
#pragma unroll
            for (int w = 0; w < 8; ++w) s += red[w * 16 + c.tid];
            red[128 + c.tid] = s; }
        __syncthreads();
#pragma unroll
        for (int t = 0; t < 8; ++t) {
            const float mean = red[128 + 2 * t] * (1.0f / 1024.0f), var = red[128 + 2 * t + 1] * (1.0f / 1024.0f) - mean * mean;
            const float rstd = __builtin_amdgcn_rsqf(var + EPS);
            const float h0 = (a0[t] - mean) * rstd * lwv.x + lbv.x, h1 = (a1[t] - mean) * rstd * lwv.y + lbv.y;
            const unsigned q4 = pack_i8x4c(h0 * sigm(h0) * ACT_QS, h1 * sigm(h1) * ACT_QS, 0.f, 0.f);
            *(GAS unsigned short*)((unsigned char*)out + (size_t)(n0 + t) * 1024 + c0) = (unsigned short)q4;
        }
        __syncthreads();
    }
}
__device__ __forceinline__ void hgrn_task(int task, int lane, const bf16* qhg, const bf16* logf, const bf16* ihg, bf16* out) {
    const int bh = task >> 6, dvb = task & 63, b = bh >> 3, h = bh & 7;
    const size_t rb = (size_t)b * SEQ * 1024;
    const GAS unsigned* qp = (const GAS unsigned*)(qhg + rb + h * 128) + lane;
    const GAS unsigned* lp = (const GAS unsigned*)(logf + rb + h * 128) + lane;
    const GAS unsigned* ip = (const GAS unsigned*)(ihg + rb + h * 128) + dvb;
    GAS bf16* op = (GAS bf16*)(out + rb + h * 128 + 2 * dvb);
    float S00 = 0.f, S01 = 0.f, S10 = 0.f, S11 = 0.f;
    unsigned qn[8], ln[8], inx[8];
#pragma unroll
    for (int j = 0; j < 8; ++j) { qn[j] = qp[(size_t)j * 512]; ln[j] = lp[(size_t)j * 512]; inx[j] = ip[(size_t)j * 512]; }
    for (int blk = 0; blk < SEQ / 8; ++blk) {
        unsigned qc[8], lc[8], ic[8];
#pragma unroll
        for (int j = 0; j < 8; ++j) { qc[j] = qn[j]; lc[j] = ln[j]; ic[j] = inx[j]; }
        if (blk + 1 < SEQ / 8) {
#pragma unroll
            for (int j = 0; j < 8; ++j) { const size_t o = (size_t)((blk + 1) * 8 + j) * 512; qn[j] = qp[o]; ln[j] = lp[o]; inx[j] = ip[o]; }
        }
        float pv[16];
#pragma unroll
        for (int j = 0; j < 8; ++j) {
            const float f0 = __expf(bflo(lc[j])), f1 = __expf(bfhi(lc[j])), k0 = 1.0f - f0, k1 = 1.0f - f1;
            const float i0 = bflo(ic[j]), i1 = bfhi(ic[j]), q0 = bflo(qc[j]), q1 = bfhi(qc[j]);
            S00 = f0 * S00 + k0 * i0; S01 = f0 * S01 + k0 * i1; S10 = f1 * S10 + k1 * i0; S11 = f1 * S11 + k1 * i1;
            pv[2 * j] = S00 * q0 + S10 * q1; pv[2 * j + 1] = S01 * q0 + S11 * q1;
        }
        xreduce16(pv, lane);
        if ((lane & 3) == 0) { const int idx = ridx16(lane); op[(size_t)(blk * 8 + (idx >> 1)) * 1024 + (idx & 1)] = (bf16)(pk2c(pv[0], 0.f) & 0xffffu); }
    }
}
constexpr int HG_TS = 272;
constexpr int HG_BS = 132;
__device__ __forceinline__ void hg_stage(LAS unsigned char* dst, const bf16* src, int tid) {
#pragma unroll
    for (int i = 0; i < 2; ++i) { const int p = tid + 512 * i, row = p >> 4, c16 = p & 15; *(LAS v4u*)(dst + row * HG_TS + c16 * 16) = *(const GAS v4u*)(src + (size_t)row * 1024 + c16 * 8); }
}
__device__ __forceinline__ void hg_scan(const LAS unsigned char* lft, int dk, int hf, float (&lf)[4][8], float (&b)[4][8], float& bl) {
    float bs[4], pb[4];
#pragma unroll
    for (int kk = 0; kk < 4; ++kk) { float run = 0.f;
#pragma unroll
        for (int j = 0; j < 8; ++j) { lf[kk][j] = __uint_as_float((unsigned)(*(const LAS unsigned short*)(lft + (16 * kk + 8 * hf + j) * HG_TS + dk * 2)) << 16); run += lf[kk][j]; b[kk][j] = run; }
        bs[kk] = run; }
#pragma unroll
    for (int kk = 0; kk < 4; ++kk) pb[kk] = __shfl_xor(bs[kk], 32);
    float pre = 0.f;
#pragma unroll
    for (int kk = 0; kk < 4; ++kk) { const float off = pre + (hf ? pb[kk] : 0.f);
#pragma unroll
        for (int j = 0; j < 8; ++j) b[kk][j] += off;
        pre += bs[kk] + pb[kk]; }
    bl = pre;
}
__device__ __forceinline__ bf16x8 pack8(const float (&v)[8]) { v4u t; t.x = pk2c(v[0], v[1]); t.y = pk2c(v[2], v[3]); t.z = pk2c(v[4], v[5]); t.w = pk2c(v[6], v[7]); return __builtin_bit_cast(bf16x8, t); }
__device__ __forceinline__ unsigned lds_u16(const LAS unsigned char* p) { return (unsigned)(*(const LAS unsigned short*)p); }
__device__ __forceinline__ void hgA_chunk(const Ctx& c, int ci, const bf16* LOGF, const bf16* IHG, bf16* ST, float* DEC) {
    const int bh = ci >> 6, ch = ci & 63, bb = bh >> 3, h = bh & 7; const size_t n0 = (size_t)bb * SEQ + ch * 64;
    LAS unsigned char* lft = c.lds; LAS unsigned char* itl = c.lds + 64 * HG_TS;
    hg_stage(lft, LOGF + n0 * 1024 + h * 128, c.tid); hg_stage(itl, IHG + n0 * 1024 + h * 128, c.tid);
    __syncthreads();
    const int dkt = c.wave & 3, dvh = c.wave >> 2, hf = c.lane >> 5, cl = c.lane & 31, dk = 32 * dkt + cl;
    float lf[4][8], b[4][8], bl; hg_scan(lft, dk, hf, lf, b, bl);
    bf16x8 kf[4];
#pragma unroll
    for (int kk = 0; kk < 4; ++kk) { float v[8];
#pragma unroll
        for (int j = 0; j < 8; ++j) v[j] = (1.0f - __expf(lf[kk][j])) * __expf(bl - b[kk][j]);
        kf[kk] = pack8(v); }
    if (dvh == 0 && hf == 0) ((GAS float*)DEC)[(size_t)ci * 128 + dk] = __expf(bl);
#pragma unroll
    for (int dvi = 0; dvi < 2; ++dvi) { const int dvt = dvh * 2 + dvi;
        f32x16 acc;
#pragma unroll
        for (int r = 0; r < 16; ++r) acc[r] = 0.f;
#pragma unroll
        for (int kk = 0; kk < 4; ++kk) { const LAS unsigned char* p = itl + (16 * kk + 8 * hf) * HG_TS + (32 * dvt + cl) * 2;
            v4u t; t.x = lds_u16(p) | (lds_u16(p + HG_TS) << 16); t.y = lds_u16(p + 2 * HG_TS) | (lds_u16(p + 3 * HG_TS) << 16); t.z = lds_u16(p + 4 * HG_TS) | (lds_u16(p + 5 * HG_TS) << 16); t.w = lds_u16(p + 6 * HG_TS) | (lds_u16(p + 7 * HG_TS) << 16);
            acc = MFMA32(kf[kk], __builtin_bit_cast(bf16x8, t), acc); }
        bf16* o = ST + (size_t)ci * 16384 + (size_t)(32 * dvt + cl) * 128 + 32 * dkt + 4 * hf;
#pragma unroll
        for (int g = 0; g < 4; ++g) { v2u q; q.x = pk2c(acc[4 * g], acc[4 * g + 1]); q.y = pk2c(acc[4 * g + 2], acc[4 * g + 3]); *(GAS v2u*)(o + 8 * g) = q; }
    }
    __syncthreads();
}
__device__ __forceinline__ void hgB(const Ctx& c, bf16* ST, const float* DEC) {
    for (int e = blockIdx.x * 512 + c.tid; e < 32 * 4096; e += c.G * 512) {
        const int bh = e >> 12, r = e & 4095, dv = r >> 5, dk4 = (r & 31) * 4;
        GAS v2u* p = (GAS v2u*)(ST + (size_t)bh * 64 * 16384 + (size_t)dv * 128 + dk4);
        const GAS f32x4* d = (const GAS f32x4*)(DEC + (size_t)bh * 64 * 128 + dk4);
        f32x4 S = {0.f, 0.f, 0.f, 0.f};
#pragma unroll
        for (int c0 = 0; c0 < 64; c0 += 8) {
            v2u Lv[8]; f32x4 D[8];
#pragma unroll
            for (int k = 0; k < 8; ++k) { Lv[k] = p[(size_t)(c0 + k) * 4096]; D[k] = d[(size_t)(c0 + k) * 32]; }
#pragma unroll
            for (int k = 0; k < 8; ++k) { v2u o; o.x = pk2c(S.x, S.y); o.y = pk2c(S.z, S.w); p[(size_t)(c0 + k) * 4096] = o;
                S.x = D[k].x * S.x + bflo(Lv[k].x); S.y = D[k].y * S.y + bfhi(Lv[k].x); S.z = D[k].z * S.z + bflo(Lv[k].y); S.w = D[k].w * S.w + bfhi(Lv[k].y); }
        }
    }
}
__device__ __forceinline__ void hgC_chunk(const Ctx& c, int ci, const bf16* QHG, const bf16* LOGF, const bf16* IHG, const bf16* GHG, const bf16* ST, const float* nw, bf16* OUT) {
    const int bh = ci >> 6, ch = ci & 63, bb = bh >> 3, h = bh & 7; const size_t n0 = (size_t)bb * SEQ + ch * 64;
    LAS unsigned char* lft = c.lds; LAS unsigned char* itl = c.lds + 64 * HG_TS; LAS float* bt = (LAS float*)(c.lds + 2 * 64 * HG_TS); LAS float* red = bt + 64 * HG_BS;
    LAS unsigned char* ktl = (LAS unsigned char*)(red + 256);
    const int hf = c.lane >> 5, cl = c.lane & 31;
    const int dvt = c.wave & 3, tt = c.wave >> 2, t = 32 * tt + cl;
    const bf16* qrow = QHG + (n0 + t) * 1024 + h * 128 + 8 * hf;
    v4u qg[8];
#pragma unroll
    for (int kk = 0; kk < 8; ++kk) qg[kk] = *(const GAS v4u*)(qrow + 16 * kk);
    hg_stage(lft, LOGF + n0 * 1024 + h * 128, c.tid); hg_stage(itl, IHG + n0 * 1024 + h * 128, c.tid);
    __syncthreads();
    { const int dk = 32 * (c.wave & 3) + cl; float lf[4][8], b[4][8], bl; hg_scan(lft, dk, hf, lf, b, bl);
#pragma unroll
      for (int q = 0; q < 2; ++q) { const int kk = 2 * (c.wave >> 2) + q;
#pragma unroll
          for (int j = 0; j < 8; ++j) { bt[(16 * kk + 8 * hf + j) * HG_BS + dk] = (c.wave >> 2) ? b[2 + q][j] : b[q][j];
              *(LAS unsigned short*)(ktl + (16 * kk + 8 * hf + j) * HG_TS + dk * 2) = (unsigned short)(pk2c(1.0f - __expf((c.wave >> 2) ? lf[2 + q][j] : lf[q][j]), 0.f) & 0xffffu); } } }
    __syncthreads();
    bf16x8 qm[8];
    const bf16* strow = ST + (size_t)ci * 16384 + (size_t)(32 * dvt + cl) * 128 + 8 * hf;
    bf16x8 sf[8];
#pragma unroll
    for (int kk = 0; kk < 8; ++kk) sf[kk] = *(const GAS bf16x8*)(strow + 16 * kk);
#pragma unroll
    for (int kk = 0; kk < 8; ++kk) { const int d0 = 16 * kk + 8 * hf;
        const v4u qv = qg[kk];
        const f32x4 b0 = *(const LAS f32x4*)(bt + t * HG_BS + d0), b1 = *(const LAS f32x4*)(bt + t * HG_BS + d0 + 4), m0 = *(const LAS f32x4*)(bt + 31 * HG_BS + d0), m1 = *(const LAS f32x4*)(bt + 31 * HG_BS + d0 + 4);
        const float q[8] = {bflo(qv.x), bfhi(qv.x), bflo(qv.y), bfhi(qv.y), bflo(qv.z), bfhi(qv.z), bflo(qv.w), bfhi(qv.w)};
        const float bv[8] = {b0.x, b0.y, b0.z, b0.w, b1.x, b1.y, b1.z, b1.w}, mv[8] = {m0.x, m0.y, m0.z, m0.w, m1.x, m1.y, m1.z, m1.w};
        float vm[8];
#pragma unroll
        for (int j = 0; j < 8; ++j) vm[j] = q[j] * __expf(bv[j] - mv[j]);
        qm[kk] = pack8(vm); }
    f32x16 o;
#pragma unroll
    for (int r = 0; r < 16; ++r) o[r] = 0.f;
#pragma unroll 1
    for (int st = 0; st <= tt; ++st) {
        const int s = 32 * st + cl;
        f32x16 sa;
#pragma unroll
        for (int r = 0; r < 16; ++r) sa[r] = 0.f;
#pragma unroll
        for (int kk = 0; kk < 8; ++kk) { const int d0 = 16 * kk + 8 * hf;
            asm volatile("" ::: "memory");
            const v4u lv = *(const LAS v4u*)(ktl + s * HG_TS + d0 * 2);
            const f32x4 b0 = *(const LAS f32x4*)(bt + s * HG_BS + d0), b1 = *(const LAS f32x4*)(bt + s * HG_BS + d0 + 4), m0 = *(const LAS f32x4*)(bt + 31 * HG_BS + d0), m1 = *(const LAS f32x4*)(bt + 31 * HG_BS + d0 + 4);
            const float kv[8] = {bflo(lv.x), bfhi(lv.x), bflo(lv.y), bfhi(lv.y), bflo(lv.z), bfhi(lv.z), bflo(lv.w), bfhi(lv.w)};
            const float bv[8] = {b0.x, b0.y, b0.z, b0.w, b1.x, b1.y, b1.z, b1.w}, mv[8] = {m0.x, m0.y, m0.z, m0.w, m1.x, m1.y, m1.z, m1.w};
            float vk[8];
#pragma unroll
            for (int j = 0; j < 8; ++j) vk[j] = kv[j] * __expf(mv[j] - bv[j]);
            sa = MFMA32(pack8(vk), qm[kk], sa); }
        if (st == tt) {
#pragma unroll
            for (int r = 0; r < 16; ++r) if (((r & 3) + 8 * (r >> 2) + 4 * hf) > cl) sa[r] = 0.f;
        }
#pragma unroll
        for (int sp = 0; sp < 2; ++sp) {
            const float pv[8] = {sa[8 * sp], sa[8 * sp + 1], sa[8 * sp + 2], sa[8 * sp + 3], sa[8 * sp + 4], sa[8 * sp + 5], sa[8 * sp + 6], sa[8 * sp + 7]};
            const LAS unsigned char* p = itl + (32 * st + 16 * sp + 4 * hf) * HG_TS + (32 * dvt + cl) * 2;
            v4u tq; tq.x = lds_u16(p) | (lds_u16(p + HG_TS) << 16); tq.y = lds_u16(p + 2 * HG_TS) | (lds_u16(p + 3 * HG_TS) << 16);
            tq.z = lds_u16(p + 8 * HG_TS) | (lds_u16(p + 9 * HG_TS) << 16); tq.w = lds_u16(p + 10 * HG_TS) | (lds_u16(p + 11 * HG_TS) << 16);
            o = MFMA32(__builtin_bit_cast(bf16x8, tq), pack8(pv), o); }
    }
    {
#pragma unroll
      for (int kk = 0; kk < 8; ++kk) { const int d0 = 16 * kk + 8 * hf;
          const v4u qv = qg[kk];
          const f32x4 b0 = *(const LAS f32x4*)(bt + t * HG_BS + d0), b1 = *(const LAS f32x4*)(bt + t * HG_BS + d0 + 4);
          float ve[8] = {bflo(qv.x) * __expf(b0.x), bfhi(qv.x) * __expf(b0.y), bflo(qv.y) * __expf(b0.z), bfhi(qv.y) * __expf(b0.w), bflo(qv.z) * __expf(b1.x), bfhi(qv.z) * __expf(b1.y), bflo(qv.w) * __expf(b1.z), bfhi(qv.w) * __expf(b1.w)};
          o = MFMA32(sf[kk], pack8(ve), o); } }
    float ss = 0.f;
#pragma unroll
    for (int r = 0; r < 16; ++r) ss += o[r] * o[r];
    ss += __shfl_xor(ss, 32);
    if (hf == 0) red[(tt * 4 + dvt) * 32 + cl] = ss;
    __syncthreads();
    const float rstd = __builtin_amdgcn_rsqf(((red[(tt * 4 + 0) * 32 + cl] + red[(tt * 4 + 1) * 32 + cl]) + (red[(tt * 4 + 2) * 32 + cl] + red[(tt * 4 + 3) * 32 + cl])) * (1.0f / 128.0f) + EPS);
#pragma unroll
    for (int g = 0; g < 4; ++g) { const int dv0 = 32 * dvt + 8 * g + 4 * hf; const size_t off = (n0 + t) * 1024 + h * 128 + dv0;
        const v2u gg = *(const GAS v2u*)(GHG + off); const f32x4 w4 = *(const GAS f32x4*)(nw + dv0);
        const float rq = rstd * ACT_QS;
        *(GAS unsigned*)((unsigned char*)OUT + off) = pack_i8x4c(o[4 * g] * rq * w4.x * bflo(gg.x), o[4 * g + 1] * rq * w4.y * bfhi(gg.x), o[4 * g + 2] * rq * w4.z * bflo(gg.y), o[4 * g + 3] * rq * w4.w * bfhi(gg.y)); }
    __syncthreads();
}
__device__ __forceinline__ void qknorm_rows4(bf16* row0, size_t rstride, const float* w, float scale, int lane) {
    v4u x[4][2];
#pragma unroll
    for (int i = 0; i < 4; ++i)
#pragma unroll
        for (int j = 0; j < 2; ++j) x[i][j] = *(const GAS v4u*)(row0 + i * rstride + 8 * lane + 512 * j);
    const f32x4 wa = *(const GAS f32x4*)(w + ((8 * lane) & 127)), wb = *(const GAS f32x4*)(w + ((8 * lane) & 127) + 4);
#pragma unroll
    for (int i = 0; i < 4; ++i)
#pragma unroll
        for (int j = 0; j < 2; ++j) { const v4u xx = x[i][j];
            float f[8] = {bflo(xx.x), bfhi(xx.x), bflo(xx.y), bfhi(xx.y), bflo(xx.z), bfhi(xx.z), bflo(xx.w), bfhi(xx.w)};
            float ss = 0.f;
#pragma unroll
            for (int k = 0; k < 8; ++k) ss += f[k] * f[k];
            ss += __shfl_xor(ss, 1); ss += __shfl_xor(ss, 2); ss += __shfl_xor(ss, 4); ss += __shfl_xor(ss, 8);
            const float r = __builtin_amdgcn_rsqf(ss * (1.0f / 128.0f) + EPS) * scale;
            v4u o; o.x = pk2c(f[0] * r * wa.x, f[1] * r * wa.y); o.y = pk2c(f[2] * r * wa.z, f[3] * r * wa.w); o.z = pk2c(f[4] * r * wb.x, f[5] * r * wb.y); o.w = pk2c(f[6] * r * wb.z, f[7] * r * wb.w);
            *(GAS v4u*)(row0 + i * rstride + 8 * lane + 512 * j) = o; }
}
__device__ __forceinline__ void vt_item(int item, int lane, const bf16* vsb, bf16* vt, LAS unsigned short* scr) {
    const int db = item & 3, sb = (item >> 2) & 63, bh = item >> 8, b = bh >> 3, h = bh & 7;
    const bf16* src = vsb + ((size_t)b * SEQ + sb * 64) * 1024 + h * 128 + db * 32;
#pragma unroll 4
    for (int i = 0; i < 16; ++i) { const int r = 4 * i + (lane >> 4); *(LAS unsigned*)(scr + r * 34 + 2 * (lane & 15)) = *(const GAS unsigned*)(src + (size_t)r * 1024 + 2 * (lane & 15)); }
    LDS_WAIT();
    const int c = lane & 7;
#pragma unroll
    for (int j = 0; j < 4; ++j) { const int d = (lane >> 3) + 8 * j; const LAS unsigned short* s = scr + (8 * c) * 34 + d;
        v4u o; o.x = (unsigned)s[0] | ((unsigned)s[34] << 16); o.y = (unsigned)s[68] | ((unsigned)s[102] << 16); o.z = (unsigned)s[136] | ((unsigned)s[170] << 16); o.w = (unsigned)s[204] | ((unsigned)s[238] << 16);
        *(GAS v4u*)(vt + ((size_t)bh * 128 + db * 32 + d) * SEQ + sb * 64 + 8 * c) = o; }
    LDS_WAIT();
}

constexpr int AT_BUF = 32768, AT_VOFF = 16384;
__device__ __forceinline__ f32x16 attn_scores(const LAS unsigned char* kt, int krow, int hf, const bf16x8 (&qf)[8]) {
    f32x16 sa;
#pragma unroll
    for (int r = 0; r < 16; ++r) sa[r] = 0.f;
    const LAS unsigned char* kp = kt + krow * 256; const int sw = krow & 15;
#pragma unroll
    for (int kk = 0; kk < 8; ++kk) sa = MFMA32(*(const LAS bf16x8*)(kp + (((2 * kk + hf) ^ sw) << 4)), qf[kk], sa);
    return sa;
}
template <bool DIAG> __device__ __forceinline__ void attn_weights(const f32x16& sa, float& R, int hf, int cl, bf16x8 (&pf)[2]) {
    float om[16];
#pragma unroll
    for (int r = 0; r < 16; ++r) om[r] = __builtin_amdgcn_rcpf(1.0f + __builtin_amdgcn_exp2f(sa[r]));
    if (DIAG) {
#pragma unroll
        for (int r = 0; r < 16; ++r) if (((r & 3) + 8 * (r >> 2) + 4 * hf) >= cl) om[r] = 1.0f;
    }
    float Gs[4], Gp[4];
#pragma unroll
    for (int g = 0; g < 4; ++g) { Gs[g] = (om[4 * g] * om[4 * g + 1]) * (om[4 * g + 2] * om[4 * g + 3]); Gp[g] = __shfl_xor(Gs[g], 32); }
    float tail = R; float w[16];
#pragma unroll
    for (int g = 3; g >= 0; --g) {
        const float c3 = tail * (hf == 0 ? Gp[g] : 1.0f), c2 = c3 * om[4 * g + 3], c1 = c2 * om[4 * g + 2], c0 = c1 * om[4 * g + 1];
        w[4 * g + 3] = c3 - om[4 * g + 3] * c3; w[4 * g + 2] = c2 - om[4 * g + 2] * c2; w[4 * g + 1] = c1 - om[4 * g + 1] * c1; w[4 * g] = c0 - om[4 * g] * c0;
        tail *= Gs[g] * Gp[g];
    }
    R = tail;
#pragma unroll
    for (int sp = 0; sp < 2; ++sp) { v4u t; t.x = pk2c(w[8 * sp], w[8 * sp + 1]); t.y = pk2c(w[8 * sp + 2], w[8 * sp + 3]); t.z = pk2c(w[8 * sp + 4], w[8 * sp + 5]); t.w = pk2c(w[8 * sp + 6], w[8 * sp + 7]); pf[sp] = __builtin_bit_cast(bf16x8, t); }
}
__device__ __forceinline__ void attn_pv(const LAS unsigned char* vt, int sub, int cl, int hf, const bf16x8 (&pf)[2], f32x16 (&o)[4]) {
#pragma unroll
    for (int d = 0; d < 4; ++d) { const int row = 32 * d + cl; const LAS unsigned char* vp = vt + row * 128 + 8 * hf; const int sw = (row >> 1) & 7;
#pragma unroll
        for (int sp = 0; sp < 2; ++sp) { const int x = 4 * sub + 2 * sp;
            const v2u lo = *(const LAS v2u*)(vp + ((x ^ sw) << 4)), hi = *(const LAS v2u*)(vp + (((x + 1) ^ sw) << 4));
            v4u t; t.x = lo.x; t.y = lo.y; t.z = hi.x; t.w = hi.y; o[d] = MFMA32(__builtin_bit_cast(bf16x8, t), pf[sp], o[d]); } }
}
template <bool LAG> __device__ __forceinline__ void attn_unit(const Ctx& c, int bh, int qb, const bf16* qsb, const bf16* ksb, const bf16* vt, bf16* outb) {
    int lane_ = c.lane; asm volatile("" : "+v"(lane_));
    const int b = bh >> 3, h = bh & 7, lane = lane_, cl = lane & 31, hf = lane >> 5;
    const size_t rb = (size_t)b * SEQ; const int q0w = 256 * qb + 32 * c.wave;
    bf16x8 qf[8];
    { const bf16* qrow = qsb + (rb + q0w + cl) * 1024 + h * 128 + 8 * hf;
#pragma unroll
      for (int kk = 0; kk < 8; ++kk) qf[kk] = *(const GAS bf16x8*)(qrow + 16 * kk); }
    f32x16 o[4];
#pragma unroll
    for (int d = 0; d < 4; ++d)
#pragma unroll
        for (int r = 0; r < 16; ++r) o[d][r] = 0.f;
    float R = 1.0f;
    bf16x8 pd[2]; const LAS unsigned char* vimd = c.lds; int subd = 0; bool pending = false;
    const int kr0 = 8 * c.wave + (lane >> 4), kr1 = kr0 + 4;
    const bf16* kg0 = ksb + (rb + kr0) * 1024 + h * 128 + (((lane & 15) ^ (kr0 & 15)) << 3);
    const bf16* kg1 = ksb + (rb + kr1) * 1024 + h * 128 + (((lane & 15) ^ (kr1 & 15)) << 3);
    const int vr0 = 16 * c.wave + (lane >> 3), vr1 = vr0 + 8;
    const bf16* vg0 = vt + ((size_t)bh * 128 + vr0) * SEQ + (((lane & 7) ^ ((vr0 >> 1) & 7)) << 3);
    const bf16* vg1 = vt + ((size_t)bh * 128 + vr1) * SEQ + (((lane & 7) ^ ((vr1 >> 1) & 7)) << 3);
    LAS unsigned char* dk = c.lds + c.wave * 2048; LAS unsigned char* dv = c.lds + AT_VOFF + c.wave * 2048;
#define AT_DMA(kt_, bi_) do { const int ktt_ = (kt_); LAS unsigned char* bb_ = (LAS unsigned char*)0 + (bi_) * AT_BUF; \
        __builtin_amdgcn_global_load_lds((const unsigned*)(kg0 + (size_t)ktt_ * 64 * 1024), (LAS unsigned*)(dk + (bi_) * AT_BUF), 16, 0, 0); \
        __builtin_amdgcn_global_load_lds((const unsigned*)(kg1 + (size_t)ktt_ * 64 * 1024), (LAS unsigned*)(dk + (bi_) * AT_BUF + 1024), 16, 0, 0); \
        __builtin_amdgcn_global_load_lds((const unsigned*)(vg0 + ktt_ * 64), (LAS unsigned*)(dv + (bi_) * AT_BUF), 16, 0, 0); \
        __builtin_amdgcn_global_load_lds((const unsigned*)(vg1 + ktt_ * 64), (LAS unsigned*)(dv + (bi_) * AT_BUF + 1024), 16, 0, 0); (void)bb_; } while (0)
    const int nkt = 4 * (qb + 1);
    asm volatile("s_waitcnt vmcnt(0)" ::: "memory");
    AT_DMA(nkt - 1, 0); AT_DMA(nkt - 2, 1);
    asm volatile("s_waitcnt vmcnt(4)" ::: "memory"); __builtin_amdgcn_s_barrier(); asm volatile("" ::: "memory");
    int bi = 0;
#pragma unroll 1
    for (int it = 0; it < nkt; ++it) {
        const int kt = nkt - 1 - it;
        const int b2 = (bi + 2) & 3;
        if (it + 2 < nkt) AT_DMA(kt - 2, b2);
        const LAS unsigned char* kim = c.lds + bi * AT_BUF; const LAS unsigned char* vim = kim + AT_VOFF;
        const int rel = q0w - 64 * kt;
        if (rel >= 32) {
            if (LAG) { if (pending) attn_pv(vimd, subd, cl, hf, pd, o);
                const f32x16 s1 = attn_scores(kim, 32 + cl, hf, qf); if (rel == 32) attn_weights<true>(s1, R, hf, cl, pd); else attn_weights<false>(s1, R, hf, cl, pd);
                vimd = vim; subd = 1; pending = true;
            } else { bf16x8 p[2];
                { const f32x16 s1 = attn_scores(kim, 32 + cl, hf, qf); if (rel == 32) attn_weights<true>(s1, R, hf, cl, p); else attn_weights<false>(s1, R, hf, cl, p); }
                attn_pv(vim, 1, cl, hf, p, o); }
        }
        if (rel >= 0) {
            if (LAG) { if (pending) attn_pv(vimd, subd, cl, hf, pd, o);
                const f32x16 s0 = attn_scores(kim, cl, hf, qf); if (rel == 0) attn_weights<true>(s0, R, hf, cl, pd); else attn_weights<false>(s0, R, hf, cl, pd);
                vimd = vim; subd = 0; pending = true;
            } else { bf16x8 p[2];
                { const f32x16 s0 = attn_scores(kim, cl, hf, qf); if (rel == 0) attn_weights<true>(s0, R, hf, cl, p); else attn_weights<false>(s0, R, hf, cl, p); }
                attn_pv(vim, 0, cl, hf, p, o); }
        }
        if (it + 2 < nkt) asm volatile("s_waitcnt vmcnt(4)\n\ts_waitcnt lgkmcnt(0)" ::: "memory"); else asm volatile("s_waitcnt vmcnt(0)\n\ts_waitcnt lgkmcnt(0)" ::: "memory");
        __builtin_amdgcn_s_barrier(); asm volatile("" ::: "memory");
        bi = (bi + 1) & 3;
    }
#undef AT_DMA
    if (LAG && pending) attn_pv(vimd, subd, cl, hf, pd, o);
    bf16* orow = outb + (rb + q0w + cl) * 1024 + h * 128 + 4 * hf;
#pragma unroll
    for (int d = 0; d < 4; ++d)
#pragma unroll
        for (int g = 0; g < 4; ++g) { v2u q; q.x = pk2c(o[d][4 * g], o[d][4 * g + 1]); q.y = pk2c(o[d][4 * g + 2], o[d][4 * g + 3]); *(GAS v2u*)(orow + 32 * d + 8 * g) = q; }
    asm volatile("s_waitcnt vmcnt(0)" ::: "memory"); __builtin_amdgcn_s_barrier(); asm volatile("" ::: "memory");
}
__device__ __forceinline__ void hgpost_row(bf16* row, const bf16* grow, const float* w, int lane) {
#pragma unroll
    for (int j = 0; j < 2; ++j) {
        GAS v4u* p = (GAS v4u*)(row + 8 * lane + 512 * j); const v4u x = *p; const v4u gg = *(const GAS v4u*)(grow + 8 * lane + 512 * j);
        float f[8] = {bflo(x.x), bfhi(x.x), bflo(x.y), bfhi(x.y), bflo(x.z), bfhi(x.z), bflo(x.w), bfhi(x.w)};
        const float g[8] = {bflo(gg.x), bfhi(gg.x), bflo(gg.y), bfhi(gg.y), bflo(gg.z), bfhi(gg.z), bflo(gg.w), bfhi(gg.w)};
        float ss = 0.f;
#pragma unroll
        for (int k = 0; k < 8; ++k) ss += f[k] * f[k];
        ss += __shfl_xor(ss, 1); ss += __shfl_xor(ss, 2); ss += __shfl_xor(ss, 4); ss += __shfl_xor(ss, 8);
        const float r = __builtin_amdgcn_rsqf(ss * (1.0f / 128.0f) + EPS);
        const f32x4 wa = *(const GAS f32x4*)(w + ((8 * lane) & 127)), wb = *(const GAS f32x4*)(w + ((8 * lane) & 127) + 4);
        v4u o; o.x = pk2c(f[0] * r * wa.x * g[0], f[1] * r * wa.y * g[1]); o.y = pk2c(f[2] * r * wa.z * g[2], f[3] * r * wa.w * g[3]);
        o.z = pk2c(f[4] * r * wb.x * g[4], f[5] * r * wb.y * g[5]); o.w = pk2c(f[6] * r * wb.z * g[6], f[7] * r * wb.w * g[7]);
        *p = o;
    }
}

template <bool FIRST> struct EpiMerge {
    static constexpr bool PERM = true, AFTER_DRAIN = false;
    const bf16* gate; bf16* merged;
    __device__ __forceinline__ float rowscale(int) const { return 1.0f / (ACT_QS * WBR_QS); }
    __device__ __forceinline__ void operator()(const pg8::f32x4 (&acc)[2][2][4][2], const pg8::Unit& u, int wr, int wc, int fr, int fq) const {
        const int row0 = u.pm * 256 + wr * 64 + fr, col0 = u.pn * 256 + wc * 32 + 8 * fq;
#pragma unroll
        for (int ai = 0; ai < 2; ++ai)
#pragma unroll
            for (int m = 0; m < 4; ++m) {
                if (m == 0) asm volatile("" ::: "memory");
#pragma unroll
                for (int bj = 0; bj < 2; ++bj) {
                    const size_t off = (size_t)(row0 + ai * 128 + m * 16) * 2048 + col0 + bj * 128;
                    const v4u g = *(const GAS v4u*)(gate + off); const pg8::f32x4 v0 = acc[ai][bj][m][0], v1 = acc[ai][bj][m][1];
                    float r[8] = {bflo(g.x) * v0[0], bfhi(g.x) * v0[1], bflo(g.y) * v0[2], bfhi(g.y) * v0[3], bflo(g.z) * v1[0], bfhi(g.z) * v1[1], bflo(g.w) * v1[2], bfhi(g.w) * v1[3]};
                    if (!FIRST) { const v4u mo = *(const GAS v4u*)(merged + off);
                        r[0] += bflo(mo.x); r[1] += bfhi(mo.x); r[2] += bflo(mo.y); r[3] += bfhi(mo.y); r[4] += bflo(mo.z); r[5] += bfhi(mo.z); r[6] += bflo(mo.w); r[7] += bfhi(mo.w); }
                    v4u w; w.x = pk2c(r[0], r[1]); w.y = pk2c(r[2], r[3]); w.z = pk2c(r[4], r[5]); w.w = pk2c(r[6], r[7]);
                    *(GAS v4u*)(merged + off) = w; }
            }
    }
};
struct EpiStoreBf16 {
    static constexpr bool PERM = true, AFTER_DRAIN = false;
    bf16* out; const float* sa;
    __device__ __forceinline__ float rowscale(int row) const { return ((const GAS float*)sa)[row] * (1.0f / WIN_QS); }
    __device__ __forceinline__ void operator()(const pg8::f32x4 (&acc)[2][2][4][2], const pg8::Unit& u, int wr, int wc, int fr, int fq) const {
        const int row0 = u.pm * 256 + wr * 64 + fr, col0 = u.pn * 256 + wc * 32 + 8 * fq;
#pragma unroll
        for (int ai = 0; ai < 2; ++ai)
#pragma unroll
            for (int m = 0; m < 4; ++m)
#pragma unroll
                for (int bj = 0; bj < 2; ++bj) { const pg8::f32x4 v0 = acc[ai][bj][m][0], v1 = acc[ai][bj][m][1];
                    v4u w; w.x = pk2c(v0[0], v0[1]); w.y = pk2c(v0[2], v0[3]); w.z = pk2c(v1[0], v1[1]); w.w = pk2c(v1[2], v1[3]);
                    *(GAS v4u*)(out + (size_t)(row0 + ai * 128 + m * 16) * 2048 + col0 + bj * 128) = w; }
    }
};
struct EpiResid {
    static constexpr bool PERM = false, AFTER_DRAIN = false;
    const float* xin; float* xout; const float* ms;
    __device__ __forceinline__ float rowscale(int row) const { return ((const GAS float*)ms)[row] * (1.0f / WIN_QS); }
    __device__ __forceinline__ void operator()(const pg8::f32x4 (&acc)[2][2][4][2], const pg8::Unit& u, int wr, int wc, int fr, int fq) const {
        const int row0 = u.pm * 256 + wr * 64 + fr, col0 = u.pn * 256 + wc * 32 + 4 * fq;
#pragma unroll
        for (int ai = 0; ai < 2; ++ai)
#pragma unroll
            for (int m = 0; m < 4; ++m)
#pragma unroll
                for (int bj = 0; bj < 2; ++bj)
#pragma unroll
                    for (int n = 0; n < 2; ++n) { const size_t off = (size_t)(row0 + ai * 128 + m * 16) * 2048 + col0 + bj * 128 + n * 16;
                        f32x4 r = acc[ai][bj][m][n]; if (xin) r += *(const GAS f32x4*)(xin + off);
                        *(GAS f32x4*)(xout + off) = r; }
    }
};

__device__ __forceinline__ float rl_f(float v, int l) { return __uint_as_float((unsigned)__builtin_amdgcn_readlane((int)__float_as_uint(v), l)); }
__device__ __forceinline__ void ins16(float (&L)[16], float x) {
#pragma unroll
    for (int i = 0; i < 16; ++i) { const float hi = __builtin_fmaxf(L[i], x); x = __builtin_fminf(L[i], x); L[i] = hi; }
}
#define CE_DESC(a, b) do { const float hi_ = __builtin_fmaxf(a, b), lo_ = __builtin_fminf(a, b); a = hi_; b = lo_; } while (0)
__device__ __forceinline__ void sort16_desc(float (&v)[16]) {
#pragma unroll
    for (int k = 2; k <= 16; k <<= 1)
#pragma unroll
        for (int j = k >> 1; j > 0; j >>= 1)
#pragma unroll
            for (int i = 0; i < 16; ++i) { const int l = i ^ j; if (l > i) { if ((i & k) == 0) CE_DESC(v[i], v[l]); else CE_DESC(v[l], v[i]); } }
}
__device__ __forceinline__ void bitonic_merge16_desc(float (&v)[16]) {
#pragma unroll
    for (int j = 8; j > 0; j >>= 1)
#pragma unroll
        for (int i = 0; i < 16; ++i) { const int l = i ^ j; if (l > i) CE_DESC(v[i], v[l]); }
}
__device__ __forceinline__ void top16_merge(float (&L)[16], const float (&T)[16]) {
#pragma unroll
    for (int i = 0; i < 16; ++i) L[i] = __builtin_fmaxf(L[i], T[15 - i]);
    bitonic_merge16_desc(L);
}
constexpr int PK_KS = 272;
__device__ __forceinline__ void peer_top16(const bf16* qrow  , const LAS unsigned char* kl  , int hf, float (&L)[16]) {
    bf16x8 qf[8];
#pragma unroll
    for (int kk = 0; kk < 8; ++kk) qf[kk] = *(const GAS bf16x8*)(qrow + 16 * kk);
#pragma unroll 1
    for (int kt = 0; kt < 4; ++kt) {
        f32x16 sa;
#pragma unroll
        for (int r = 0; r < 16; ++r) sa[r] = 0.f;
#pragma unroll
        for (int kk = 0; kk < 8; ++kk) sa = MFMA32(*(const LAS bf16x8*)(kl + kt * 32 * PK_KS + 32 * kk), qf[kk], sa);
        float T[16];
#pragma unroll
        for (int r = 0; r < 16; ++r) { const unsigned idx = (unsigned)(kt * 32 + (r & 3) + 8 * (r >> 2) + 4 * hf); T[r] = __uint_as_float((__float_as_uint(sa[r]) & ~127u) | idx); }
        sort16_desc(T);
        if (kt == 0) {
#pragma unroll
            for (int i = 0; i < 16; ++i) L[i] = T[i];
        } else top16_merge(L, T);
    }
    float P[16];
#pragma unroll
    for (int i = 0; i < 16; ++i) P[i] = __shfl_xor(L[i], 32);
    top16_merge(L, P);
}
__device__ __forceinline__ void peer_select32(int hd, int n0, int lane, const bf16* qpeer, const LAS unsigned char* kl1, const LAS unsigned char* kl2, unsigned char* wsb, LAS unsigned* ldsw) {
    asm volatile("" : "+v"(lane));
    const int c = lane & 31, hf = lane >> 5, n = n0 + c;
    const bf16* qrow = qpeer + (size_t)n * 2048 + hd * 256 + 8 * hf;
    float A[16], B[16];
    peer_top16(qrow, kl1 + c * PK_KS + 16 * hf, hf, A);
    peer_top16(qrow + 128, kl2 + c * PK_KS + 16 * hf, hf, B);
#define PKV(x) __uint_as_float(__float_as_uint(x) & ~127u)
#define PKI(x) ((int)(__float_as_uint(x) & 127u))
    float W[16];
    { float C0[16], C1[16], C2[16], E0 = 0.f, E1 = 0.f; unsigned id = 0;
#pragma unroll
      for (int a = 0; a < 16; ++a)
#pragma unroll
        for (int b = 0; b < 16; ++b) if ((a + 1) * (b + 1) <= 16) { const float pk = __uint_as_float((__float_as_uint(PKV(A[a]) + PKV(B[b])) & ~63u) | id);
            if (id < 16) C0[id] = pk; else if (id < 32) C1[id - 16] = pk; else if (id < 48) C2[id - 32] = pk; else if (id == 48) E0 = pk; else E1 = pk;
            ++id; }
      sort16_desc(C0); sort16_desc(C1); sort16_desc(C2);
      top16_merge(C0, C1); top16_merge(C0, C2);
#pragma unroll
      for (int i = 0; i < 16; ++i) W[i] = C0[i];
      ins16(W, E0); ins16(W, E1); }
    const float thr = W[15], mx = W[0];
    int cnt = 0; float ssum = 0.f;
    LAS int* le = (LAS int*)ldsw + c * 16; LAS float* lg = (LAS float*)ldsw + 512 + c * 16;
    { unsigned id = 0;
#pragma unroll
      for (int a = 0; a < 16; ++a)
#pragma unroll
        for (int b = 0; b < 16; ++b) if ((a + 1) * (b + 1) <= 16) {
            const float cv = PKV(A[a]) + PKV(B[b]); const float pk = __uint_as_float((__float_as_uint(cv) & ~63u) | id); ++id;
            if (pk >= thr) { const float e = __expf(cv - mx); if (hf == 0) { le[cnt] = PKI(A[a]) * 128 + PKI(B[b]); lg[cnt] = e; } ssum += e; ++cnt; }
        } }
    LDS_WAIT();
    asm volatile("" : "+s"(wsb));
    int* sel_e = (int*)(wsb + WS_SEL); float* sel_g = (float*)(wsb + WS_SEL + 8 * MiB); float* sel_s = (float*)(wsb + WS_SELS);
    { int lane3 = lane; asm volatile("" : "+v"(lane3)); const int t = lane3 >> 1, part = lane3 & 1;
      const v4u e0 = *(const LAS v4u*)((LAS int*)ldsw + t * 16 + 8 * part), e1 = *(const LAS v4u*)((LAS int*)ldsw + t * 16 + 8 * part + 4);
      const v4u g0 = *(const LAS v4u*)((LAS int*)ldsw + 512 + t * 16 + 8 * part), g1 = *(const LAS v4u*)((LAS int*)ldsw + 512 + t * 16 + 8 * part + 4);
      GAS v4u* pe = (GAS v4u*)(sel_e + (size_t)(n0 + t) * 128 + hd * 16 + 8 * part); GAS v4u* pg = (GAS v4u*)(sel_g + (size_t)(n0 + t) * 128 + hd * 16 + 8 * part);
      pe[0] = e0; pe[1] = e1; pg[0] = g0; pg[1] = g1; }
    LDS_WAIT();
    { int lane4 = lane; asm volatile("" : "+v"(lane4)); if ((lane4 >> 5) == 0) ((GAS float*)sel_s)[(size_t)(n0 + (lane4 & 31)) * 8 + hd] = ssum; }
}

__device__ __forceinline__ float dot2bf(unsigned a, unsigned b, float acc) {
    return __builtin_amdgcn_fdot2_f32_bf16(__builtin_bit_cast(bf16v2, a), __builtin_bit_cast(bf16v2, b), acc, false);
}
__device__ __forceinline__ float dot8bf(const v4u a, const v4u b, float acc) {
    const unsigned a0 = a.x, a1 = a.y, a2 = a.z, a3 = a.w, b0 = b.x, b1 = b.y, b2 = b.z, b3 = b.w;
    acc = dot2bf(a0, b0, acc); acc = dot2bf(a1, b1, acc); acc = dot2bf(a2, b2, acc); acc = dot2bf(a3, b3, acc);
    return acc;
}
__device__ __forceinline__ void unpack16(const v4u q, float (&f)[16]) {
    const unsigned d0 = q.x, d1 = q.y, d2 = q.z, d3 = q.w;
    f32x2v t;
    t = __builtin_amdgcn_cvt_pk_f32_fp8((int)d0, false); f[0] = t.x; f[1] = t.y; t = __builtin_amdgcn_cvt_pk_f32_fp8((int)d0, true); f[2] = t.x; f[3] = t.y;
    t = __builtin_amdgcn_cvt_pk_f32_fp8((int)d1, false); f[4] = t.x; f[5] = t.y; t = __builtin_amdgcn_cvt_pk_f32_fp8((int)d1, true); f[6] = t.x; f[7] = t.y;
    t = __builtin_amdgcn_cvt_pk_f32_fp8((int)d2, false); f[8] = t.x; f[9] = t.y; t = __builtin_amdgcn_cvt_pk_f32_fp8((int)d2, true); f[10] = t.x; f[11] = t.y;
    t = __builtin_amdgcn_cvt_pk_f32_fp8((int)d3, false); f[12] = t.x; f[13] = t.y; t = __builtin_amdgcn_cvt_pk_f32_fp8((int)d3, true); f[14] = t.x; f[15] = t.y;
}
struct SliceSched { int mode, xcc, rank, nloc; };
__device__ __forceinline__ SliceSched slice_sched_init(const Ctx& c, unsigned* ctl, const XcdBarrier& bar, int use) {
    LAS int* sh = (LAS int*)(c.lds + 1024);
    if (c.tid == 0) {
        int ok = 1; unsigned tot = 0;
        for (int j = 0; j < 16; ++j) { const unsigned n = xb_ld(&bar.bar[XB_XCNT(j)]); tot += n; if ((j < 8) != (n > 0u)) ok = 0; }
        if (tot != (unsigned)c.G) ok = 0;
        const int xcc = (int)xb_xcc_id();
        int rank = 0, nloc = 1;
        if (ok) { nloc = (int)xb_ld(&bar.bar[XB_XCNT(xcc)]); rank = (int)xb_add(&ctl[CW_RANK + (use * 16 + xcc) * 64], 1u); if (rank >= nloc) ok = 0; }
        sh[0] = ok; sh[1] = xcc; sh[2] = rank; sh[3] = nloc;
    }
    __syncthreads();
    SliceSched S; S.mode = sh[0]; S.xcc = sh[1]; S.rank = sh[2]; S.nloc = sh[3];
    __syncthreads();
    return S;
}
__device__ __forceinline__ bool slice_item(const SliceSched& S, const Ctx& c, int i, int& slice, int& tb) {
    if (S.mode) { const int it = S.rank + i * S.nloc; if (it >= 512) return false; slice = S.xcc + 8 * (it >> 8); tb = it & 255; return true; }
    const int it = (int)blockIdx.x + i * c.G; if (it >= 4096) return false; slice = it >> 8; tb = it & 255; return true;
}
__device__ __forceinline__ void unpack16p(const v4u q, f32x2v (&f)[8]) {
    const unsigned d0 = q.x, d1 = q.y, d2 = q.z, d3 = q.w;
    f[0] = __builtin_amdgcn_cvt_pk_f32_fp8((int)d0, false); f[1] = __builtin_amdgcn_cvt_pk_f32_fp8((int)d0, true);
    f[2] = __builtin_amdgcn_cvt_pk_f32_fp8((int)d1, false); f[3] = __builtin_amdgcn_cvt_pk_f32_fp8((int)d1, true);
    f[4] = __builtin_amdgcn_cvt_pk_f32_fp8((int)d2, false); f[5] = __builtin_amdgcn_cvt_pk_f32_fp8((int)d2, true);
    f[6] = __builtin_amdgcn_cvt_pk_f32_fp8((int)d3, false); f[7] = __builtin_amdgcn_cvt_pk_f32_fp8((int)d3, true);
}
__device__ __forceinline__ void sddmm_load(const unsigned char* ubase, const LAS unsigned* ids16, v4u (&q)[16]) {
    int id[16];
#pragma unroll
    for (int i = 0; i < 4; ++i) { const v4u v = *(const LAS v4u*)(ids16 + 4 * i); id[4 * i] = (int)v.x; id[4 * i + 1] = (int)v.y; id[4 * i + 2] = (int)v.z; id[4 * i + 3] = (int)v.w; }
#pragma unroll
    for (int it = 0; it < 16; ++it) q[it] = *(const GAS v4u*)(ubase + (unsigned)id[it] * 128u);
}
__device__ __forceinline__ void sddmm_token(const v4u (&qc)[16], const v4u hv, const float hs, int lane, unsigned* dst) {
    const int hq[4] = {(int)hv.x, (int)hv.y, (int)hv.z, (int)hv.w};
    float p[16];
#pragma unroll
    for (int it = 0; it < 16; ++it) { int a = __builtin_amdgcn_sdot4((int)qc[it].x, hq[0], 0, false); a = __builtin_amdgcn_sdot4((int)qc[it].y, hq[1], a, false);
        a = __builtin_amdgcn_sdot4((int)qc[it].z, hq[2], a, false); a = __builtin_amdgcn_sdot4((int)qc[it].w, hq[3], a, false);
        p[it] = (float)a * hs; }
#pragma unroll
    for (int i = 0; i < 8; ++i) { const bool up = (lane & 4) != 0; const float snd = up ? p[i] : p[i + 8], kp = up ? p[i + 8] : p[i]; p[i] = kp + __shfl_xor(snd, 4); }
#pragma unroll
    for (int i = 0; i < 4; ++i) { const bool up = (lane & 2) != 0; const float snd = up ? p[i] : p[i + 4], kp = up ? p[i + 4] : p[i]; p[i] = kp + __shfl_xor(snd, 2); }
#pragma unroll
    for (int i = 0; i < 2; ++i) { const bool up = (lane & 1) != 0; const float snd = up ? p[i] : p[i + 2], kp = up ? p[i + 2] : p[i]; p[i] = kp + __shfl_xor(snd, 1); }
    *(GAS unsigned*)dst = pk2c(p[0], p[1]);
}
__device__ __forceinline__ void peer_sddmm_wave(int t0, int s, int lane, const unsigned char* H8, const float* SA, const unsigned char* UQ, const int* sel_e, float* part, LAS unsigned* ldsw) {
    const int cg = lane & 7, sg = lane >> 3;
#pragma unroll
    for (int j = 0; j < 4; ++j) *(LAS v4u*)(ldsw + 4 * (lane + 64 * j)) = *(const GAS v4u*)(sel_e + (size_t)t0 * 128 + 4 * (lane + 64 * j));
    LDS_WAIT();
    const unsigned char* ubase = UQ + (size_t)s * U8_SLICE + cg * 16;
    const LAS unsigned* idl = ldsw + sg * 16;
    const unsigned char* hbase = H8 + (size_t)t0 * 2048 + s * 128 + cg * 16;
    unsigned* pbase = (unsigned*)part + ((size_t)t0 * 16 + s) * 64 + lane;
    v4u qa[16], qb[16];
    v4u ha = *(const GAS v4u*)(hbase), hb; float sa = ((const GAS float*)SA)[t0], sb;
    sddmm_load(ubase, idl, qa);
#pragma unroll
    for (int k = 0; k < 6; k += 2) {
        hb = *(const GAS v4u*)(hbase + (size_t)(k + 1) * 2048); sb = ((const GAS float*)SA)[t0 + k + 1];
        sddmm_load(ubase, idl + (k + 1) * 128, qb);
        sddmm_token(qa, ha, sa, lane, pbase + (size_t)k * 1024);
        ha = *(const GAS v4u*)(hbase + (size_t)(k + 2) * 2048); sa = ((const GAS float*)SA)[t0 + k + 2];
        sddmm_load(ubase, idl + (k + 2) * 128, qa);
        sddmm_token(qb, hb, sb, lane, pbase + (size_t)(k + 1) * 1024);
    }
    hb = *(const GAS v4u*)(hbase + (size_t)7 * 2048); sb = ((const GAS float*)SA)[t0 + 7];
    sddmm_load(ubase, idl + 7 * 128, qb);
    sddmm_token(qa, ha, sa, lane, pbase + (size_t)6 * 1024);
    sddmm_token(qb, hb, sb, lane, pbase + (size_t)7 * 1024);
    LDS_WAIT();
}
__device__ __forceinline__ void peer_coef_tokens4(int t0, int ts, int lane, const float* part, const int* sel_e, float* sel_g, const float* sel_s, const float* US, const float* VS) {
    unsigned pv[4][16]; v2u e[4]; f32x2v g[4]; float dn[4];
#pragma unroll
    for (int i = 0; i < 4; ++i) { const int t = t0 + i * ts;
#pragma unroll
        for (int s = 0; s < 16; ++s) pv[i][s] = ((const GAS unsigned*)part)[((size_t)t * 16 + s) * 64 + lane];
        e[i] = *(const GAS v2u*)(sel_e + (size_t)t * 128 + 2 * lane); g[i] = *(const GAS f32x2v*)(sel_g + (size_t)t * 128 + 2 * lane); dn[i] = ((const GAS float*)sel_s)[(size_t)t * 8 + (lane >> 3)]; }
    float ux[4], uy[4], vx[4], vy[4];
#pragma unroll
    for (int i = 0; i < 4; ++i) { ux[i] = ((const GAS float*)US)[e[i].x]; uy[i] = ((const GAS float*)US)[e[i].y]; vx[i] = ((const GAS float*)VS)[e[i].x]; vy[i] = ((const GAS float*)VS)[e[i].y]; }
#pragma unroll
    for (int i = 0; i < 4; ++i) { const int t = t0 + i * ts; float a0 = 0.f, a1 = 0.f;
#pragma unroll
        for (int s = 0; s < 16; ++s) { a0 += bflo(pv[i][s]); a1 += bfhi(pv[i][s]); }
        const float inv = 1.0f / dn[i];
        const float ox = g[i].x * inv * gelu_exact(a0 * ux[i]) * vx[i], oy = g[i].y * inv * gelu_exact(a1 * uy[i]) * vy[i];
        const h2_t ha = {(_Float16)ox, (_Float16)ox}, hb = {(_Float16)oy, (_Float16)oy};
        *(GAS v2u*)(sel_g + (size_t)t * 128 + 2 * lane) = (v2u){__builtin_bit_cast(unsigned, ha), __builtin_bit_cast(unsigned, hb)}; }
}
__device__ __forceinline__ bool slice_item8(const SliceSched& S, const Ctx& c, int i, int& slice, int& tb) {
    if (S.mode) { const int it = S.rank + i * S.nloc; if (it >= 256) return false; slice = S.xcc; tb = it; return true; }
    const int it = (int)blockIdx.x + i * c.G; if (it >= 2048) return false; slice = it >> 8; tb = it & 255; return true;
}
template <int MODE = 0>
__device__ __forceinline__ void spmm6_load(const unsigned char* vbase, const LAS unsigned* ids8, v4u (&qa)[8], v2u (&qb)[8]) {
    const v4u i0 = *(const LAS v4u*)(ids8), i1 = *(const LAS v4u*)(ids8 + 4);
    const unsigned id[8] = {i0.x, i0.y, i0.z, i0.w, i1.x, i1.y, i1.z, i1.w};
    if constexpr (MODE == 2) {
#pragma unroll
        for (int it = 0; it < 8; ++it) { qa[it] = (v4u){id[it], id[it] + 1u, id[it] + 2u, id[it] + 3u}; qb[it] = (v2u){id[it] + 4u, id[it] + 5u}; }
        return; }
#pragma unroll
    for (int it = 0; it < 8; ++it) { const unsigned char* p = vbase + id[it] * 192u; qa[it] = *(const GAS v4u*)p; qb[it] = *(const GAS v2u*)(p + 16); }
}
template <int MODE = 0>
__device__ __forceinline__ void spmm6_fma(const v4u (&qa)[8], const v2u (&qb)[8], const LAS unsigned* cf8, h2_t (&y)[16]) {
    const v4u c0 = *(const LAS v4u*)(cf8), c1 = *(const LAS v4u*)(cf8 + 4);
    const unsigned cf[8] = {c0.x, c0.y, c0.z, c0.w, c1.x, c1.y, c1.z, c1.w};
    if constexpr (MODE == 1) {
#pragma unroll
        for (int it = 0; it < 8; ++it) { const unsigned x = (qa[it].x ^ qa[it].y) ^ (qa[it].z ^ qa[it].w) ^ (qb[it].x ^ qb[it].y) ^ cf[it]; y[it] = __builtin_bit_cast(h2_t, __builtin_bit_cast(unsigned, y[it]) ^ x); }
        return; }
#pragma unroll
    for (int it = 0; it < 8; ++it) { const v6u q = {qa[it].x, qa[it].y, qa[it].z, qa[it].w, qb[it].x, qb[it].y};
        const v32h_t f = __builtin_amdgcn_cvt_scalef32_pk32_f16_fp6(q, 1.0f); const h2_t c2 = __builtin_bit_cast(h2_t, cf[it]);
#pragma unroll
        for (int j = 0; j < 16; ++j) { const h2_t v = {f[2 * j], f[2 * j + 1]}; y[j] = __builtin_elementwise_fma(v, c2, y[j]); } }
}
template <int MODE = 0>
__device__ __forceinline__ void peer_spmm6_wave(int t0, int s, int lane, const unsigned char* V6, const int* sel_e, const float* coef, const float* x1, float* xout, LAS unsigned* ldsw) {
    const int cg = lane & 7, sg = lane >> 3;
#pragma unroll
    for (int j = 0; j < 4; ++j) { *(LAS v4u*)(ldsw + 4 * (lane + 64 * j)) = *(const GAS v4u*)(sel_e + (size_t)t0 * 128 + 4 * (lane + 64 * j));
        *(LAS v4u*)(ldsw + 1024 + 4 * (lane + 64 * j)) = *(const GAS v4u*)(coef + (size_t)t0 * 128 + 4 * (lane + 64 * j)); }
    LDS_WAIT();
    const unsigned char* vbase = V6 + (size_t)s * V6_SLICE + cg * 24;
    const LAS unsigned* idl = ldsw + sg * 16; const LAS unsigned* cfl = ldsw + 1024 + sg * 16;
    v4u qa0[8], qa1[8]; v2u qb0[8], qb1[8];
    spmm6_load<MODE>(vbase, idl, qa0, qb0);
    const size_t xoff = (size_t)t0 * 2048 + s * 256 + cg * 32 + 4 * sg;
    f32x4 xn = *(const GAS f32x4*)(x1 + xoff);
#pragma unroll
    for (int k = 0; k < 8; ++k) {
        const f32x4 xv = xn;
        h2_t y[16];
#pragma unroll
        for (int j = 0; j < 16; ++j) y[j] = (h2_t){(_Float16)0.f, (_Float16)0.f};
        spmm6_load<MODE>(vbase, idl + k * 128 + 8, qa1, qb1);
        if (k < 7) xn = *(const GAS f32x4*)(x1 + xoff + (size_t)(k + 1) * 2048);
        spmm6_fma<MODE>(qa0, qb0, cfl + k * 128, y);
        if (k < 7) spmm6_load<MODE>(vbase, idl + (k + 1) * 128, qa0, qb0);
        spmm6_fma<MODE>(qa1, qb1, cfl + k * 128 + 8, y);
        unsigned u[16];
#pragma unroll
        for (int j = 0; j < 16; ++j) u[j] = __builtin_bit_cast(unsigned, y[j]);
#pragma unroll
        for (int i = 0; i < 8; ++i) { const bool up = (lane & 32) != 0; const unsigned snd = up ? u[i] : u[i + 8], kp = up ? u[i + 8] : u[i]; u[i] = __builtin_bit_cast(unsigned, __builtin_bit_cast(h2_t, kp) + __builtin_bit_cast(h2_t, (unsigned)__shfl_xor((int)snd, 32))); }
#pragma unroll
        for (int i = 0; i < 4; ++i) { const bool up = (lane & 16) != 0; const unsigned snd = up ? u[i] : u[i + 4], kp = up ? u[i + 4] : u[i]; u[i] = __builtin_bit_cast(unsigned, __builtin_bit_cast(h2_t, kp) + __builtin_bit_cast(h2_t, (unsigned)__shfl_xor((int)snd, 16))); }
#pragma unroll
        for (int i = 0; i < 2; ++i) { const bool up = (lane & 8) != 0; const unsigned snd = up ? u[i] : u[i + 2], kp = up ? u[i + 2] : u[i]; u[i] = __builtin_bit_cast(unsigned, __builtin_bit_cast(h2_t, kp) + __builtin_bit_cast(h2_t, (unsigned)__shfl_xor((int)snd, 8))); }
        const h2_t r0 = __builtin_bit_cast(h2_t, u[0]), r1 = __builtin_bit_cast(h2_t, u[1]);
        f32x4 o; o.x = xv.x + (float)r0[0]; o.y = xv.y + (float)r0[1]; o.z = xv.z + (float)r1[0]; o.w = xv.w + (float)r1[1];
        *(GAS f32x4*)(xout + xoff + (size_t)k * 2048) = o;
    }
    LDS_WAIT();
}

struct Args { const float* in[21]; float* out; unsigned char* ws; int lo, hi, li, pad; };
__global__ void __launch_bounds__(512, 2) mk_fwd(Args args) {
    extern __shared__ __attribute__((aligned(16))) unsigned char lds_raw[];
    Ctx c; c.lds = (LAS unsigned char*)lds_raw; c.tid = threadIdx.x; c.lane = c.tid & 63; c.wave = __builtin_amdgcn_readfirstlane(c.tid >> 6);
    c.G = gridDim.x; c.gw = blockIdx.x * 8 + c.wave; c.NGW = c.G * 8;
    volatile LAS unsigned* MISC = (volatile LAS unsigned*)(c.lds + MISC_OFF);
    if (c.tid < 32) MISC[c.tid] = 0u;
    __syncthreads();
    unsigned char* ws = args.ws;
    const int lo = args.lo, hi = args.hi;
    XcdBarrier bar; bar.w0 = 0; bar.bar = (unsigned*)(ws + WS_CTL) + CW_BAR + args.li * XCD_BAR_WORDS; bar.x = 0; bar.st = nullptr;
    if (hi - lo > 1) bar = xcd_barrier_post((unsigned*)(ws + WS_CTL) + CW_BAR + args.li * XCD_BAR_WORDS, MISC + 8);
#ifndef ATTN_REPS
#define ATTN_REPS 1
#endif
#ifndef PHMASK
#define PHMASK 0x1fff
#endif
#ifndef REP_PH
#define REP_PH (-1)
#endif
    int rep2 = 2; asm volatile("" : "+s"(rep2));
#define RLOOP(k, cond) for (int rp_ = 0; rp_ < ((((k) == REP_PH) && (cond)) ? rep2 : 1); ++rp_)
#define RSYNC do { if (rp_) xcd_barrier(bar); } while (0)
#define IN(k) (((PHMASK >> ((k) % NPH)) & 1) && lo <= (k) && (k) < hi)
#define SEAM(k) do { if (IN(k) && IN((k) + 1)) xcd_barrier(bar); } while (0)
#define PH_BEGIN unsigned char* w = ws; float* outp = args.out; Ctx cc = c; int zi = 0; cc.lane = xb_lane_id(); cc.tid = cc.wave * 64 + cc.lane; \
    asm volatile("" : "+s"(w), "+s"(outp), "+s"(zi), "+v"(cc.tid), "+v"(cc.lane)); (void)w; (void)outp;
#define INP(k) (args.in[(k) + zi])
#define WSP(T, off) ((T*)(w + (off)))
    for (int l = 0; l < 2; ++l) {
        const int pb = l * NPH;
        if (IN(pb + 0)) { PH_BEGIN
            P0Args a; a.w_in = INP(2) + (size_t)l * DM * INW; a.w_br_sb = INP(11) + (size_t)l * BW * DM; a.w_br_hg = INP(12) + (size_t)l * BW * DM; a.w_br_conv = INP(13) + (size_t)l * BW * DM;
            a.w_o = INP(14) + (size_t)l * DM * DM; a.w_q = INP(16) + (size_t)l * DM * DM; a.u = INP(19) + (size_t)l * 16384 * 2048; a.v = INP(20) + (size_t)l * 16384 * 2048; a.lbp = INP(5);
            a.WinT = WSP(bf16, WS_WIN); a.WbrT = WSP(bf16, WS_WBR); a.WoT = WSP(bf16, WS_WO); a.WqT = WSP(bf16, WS_WQ); a.U = WSP(unsigned char, WS_U); a.V = WSP(unsigned char, WS_V); a.US = WSP(float, WS_US); a.VS = WSP(float, WS_VS); a.LB = WSP(float, WS_LB); a.layer = l; a.k1 = INP(17) + (size_t)l * 8 * 16384; a.k2 = INP(18) + (size_t)l * 8 * 16384; a.KB = WSP(bf16, WS_KEYS);
#ifndef REP_MODE0
#define REP_MODE0 15
#endif
            RLOOP(0, true) { RSYNC;
            int pm_ = 15; if (REP_PH == 0) { pm_ = rp_ ? REP_MODE0 : 15; asm volatile("" : "+s"(pm_)); }
            p0_convert(cc, a, pm_);
            if (pm_ & 8) rms_phase_i8(cc, l == 0 ? INP(0) : WSP(const float, WS_X2), INP(1) + (size_t)l * DM, WSP(unsigned char, WS_H), WSP(float, WS_SA)); }
        }
        SEAM(pb + 0);
        if (IN(pb + 1)) { PH_BEGIN
            RLOOP(1, true) { RSYNC;
            pg8::Gemm g{WSP(bf16, WS_H), WSP(bf16, WS_WIN), NTOK, INW, DM}; pg8::StaticOrder S; S.init(NTOK, INW, cc.G, (int)blockIdx.x);
            EpiIn E{WSP(bf16, WS_SEG), WSP(bf16, WS_GATE), WSP(float, WS_LB), WSP(float, WS_SA)};
            pg8::gemm_phase<EpiIn, pg8::StaticOrder, true, true, true>(cc.lds, g, S, E, cc.wave); }
        }
        SEAM(pb + 1);
        if (IN(pb + 2)) { PH_BEGIN
            bf16* SEG = WSP(bf16, WS_SEG);
#ifndef REP_MODE2
#define REP_MODE2 7
#endif
            RLOOP(2, true) { RSYNC;
            int pm_ = 7; if (REP_PH == 2) { pm_ = rp_ ? REP_MODE2 : 7; asm volatile("" : "+s"(pm_)); }
            if (pm_ & 1)
            conv_phase(cc, SEG + 7 * SEGSZ, INP(7) + (size_t)l * 31 * 1024, INP(8) + (size_t)l * 1024, INP(9) + (size_t)l * 1024, INP(10) + (size_t)l * 1024, WSP(bf16, WS_CONV));
            if (pm_ & 2)
            for (int ci = blockIdx.x; ci < 2048; ci += cc.G) hgA_chunk(cc, ci, SEG + 4 * SEGSZ, SEG + 5 * SEGSZ, WSP(bf16, WS_ST), WSP(float, WS_DEC));
            if (!rp_)
            for (int r = cc.gw; r < 2 * (NTOK / 4); r += cc.NGW) {
                if (r < NTOK / 4) qknorm_rows4(SEG + (size_t)r * 4 * 1024, 1024, INP(3) + (size_t)l * 128, 0.08838834764831845f * 1.4426950408889634f, cc.lane);
                else qknorm_rows4(SEG + SEGSZ + (size_t)(r - NTOK / 4) * 4 * 1024, 1024, INP(4) + (size_t)l * 128, 1.0f, cc.lane);
            }
            LAS unsigned short* scr = (LAS unsigned short*)(cc.lds + 4096 + cc.wave * 8192);
            if (pm_ & 4)
            for (int it = cc.gw; it < 8192; it += cc.NGW) vt_item(it, cc.lane, SEG + 2 * SEGSZ, WSP(bf16, WS_MERGED), scr); }
        }
        SEAM(pb + 2);
        if (IN(pb + 3)) { PH_BEGIN
            bf16* SEG = WSP(bf16, WS_SEG);
            RLOOP(3, true) { RSYNC;
            if (!rp_) hgB(cc, WSP(bf16, WS_ST), WSP(float, WS_DEC));
            for (int p = blockIdx.x; p < 256; p += cc.G) { const int bh = (p & 7) * 4 + (p >> 6), j = (p >> 3) & 7;
                if (cc.wave >= 4) {
#pragma unroll 1
                    for (int u = 0; u < 2; ++u) attn_unit<true>(cc, bh, u ? j : 15 - j, SEG, SEG + SEGSZ, WSP(bf16, WS_MERGED), SEG + 2 * SEGSZ);
                } else {
#pragma unroll 1
                    for (int u = 0; u < 2; ++u) attn_unit<false>(cc, bh, u ? j : 15 - j, SEG, SEG + SEGSZ, WSP(bf16, WS_MERGED), SEG + 2 * SEGSZ);
                } } }
        }
        SEAM(pb + 3);
        if (IN(pb + 4)) { PH_BEGIN
            bf16* SEG = WSP(bf16, WS_SEG);
            RLOOP(4, true) { RSYNC;
            for (int ci = blockIdx.x; ci < 2048; ci += cc.G) hgC_chunk(cc, ci, SEG + 3 * SEGSZ, SEG + 4 * SEGSZ, SEG + 5 * SEGSZ, SEG + 6 * SEGSZ, WSP(bf16, WS_ST), INP(6) + (size_t)l * 128, WSP(bf16, WS_HGR)); }
        }
        SEAM(pb + 4);
        if (IN(pb + 5)) { PH_BEGIN
            RLOOP(5, true) { RSYNC;
            pg8::StaticOrder S; S.init(NTOK, DM, cc.G, (int)blockIdx.x);
            { pg8::Gemm g{WSP(bf16, WS_SEG) + 2 * SEGSZ, WSP(bf16, WS_WBR), NTOK, DM, BW}; EpiMerge<true> E{WSP(bf16, WS_GATE), WSP(bf16, WS_MERGED)}; pg8::gemm_phase<EpiMerge<true>, pg8::StaticOrder, true, true>(cc.lds, g, S, E, cc.wave); }
            { pg8::Gemm g{WSP(bf16, WS_HGR), WSP(bf16, WS_WBR) + (size_t)DM * BW, NTOK, DM, BW}; EpiMerge<false> E{WSP(bf16, WS_GATE) + (size_t)NTOK * 2048, WSP(bf16, WS_MERGED)}; pg8::gemm_phase<EpiMerge<false>, pg8::StaticOrder, true, true, true>(cc.lds, g, S, E, cc.wave); }
            { pg8::Gemm g{WSP(bf16, WS_CONV), WSP(bf16, WS_WBR) + (size_t)2 * DM * BW, NTOK, DM, BW}; EpiMerge<false> E{WSP(bf16, WS_GATE) + (size_t)2 * NTOK * 2048, WSP(bf16, WS_MERGED)}; pg8::gemm_phase<EpiMerge<false>, pg8::StaticOrder, true, true, true>(cc.lds, g, S, E, cc.wave); } }
        }
        SEAM(pb + 5);
        if (IN(pb + 6)) { PH_BEGIN
            RLOOP(6, true) { RSYNC;
            bf16_rows_i8(cc, WSP(bf16, WS_MERGED), WSP(unsigned char, WS_M8), WSP(float, WS_MS));
            xcd_barrier(bar);
            pg8::Gemm g{WSP(bf16, WS_M8), WSP(bf16, WS_WO), NTOK, DM, DM}; pg8::StaticOrder S; S.init(NTOK, DM, cc.G, (int)blockIdx.x);
            EpiResid E{l == 0 ? INP(0) : WSP(const float, WS_X2), outp, WSP(float, WS_MS)};
            pg8::gemm_phase<EpiResid, pg8::StaticOrder, true, true, true>(cc.lds, g, S, E, cc.wave); }
        }
        SEAM(pb + 6);
        if (IN(pb + 7)) { PH_BEGIN RLOOP(7, true) { RSYNC; rms_phase_i8(cc, outp, INP(15) + (size_t)l * DM, WSP(unsigned char, WS_H), WSP(float, WS_SA)); } }
        SEAM(pb + 7);
        if (IN(pb + 8)) { PH_BEGIN
            RLOOP(8, true) { RSYNC;
            pg8::Gemm g{WSP(bf16, WS_H), WSP(bf16, WS_WQ), NTOK, DM, DM}; pg8::StaticOrder S; S.init(NTOK, DM, cc.G, (int)blockIdx.x);
            EpiStoreBf16 E{WSP(bf16, WS_QPEER), WSP(float, WS_SA)};
            pg8::gemm_phase<EpiStoreBf16, pg8::StaticOrder, true, true, true>(cc.lds, g, S, E, cc.wave); }
        }
        SEAM(pb + 8);
        if (IN(pb + 9)) { PH_BEGIN
            RLOOP(9, true) { RSYNC;
            for (int item = blockIdx.x; item < 512; item += cc.G) { const int hd = item & 7, tg = item >> 3;
                const bf16* KB = WSP(bf16, WS_KEYS); unsigned qo_ = (unsigned)WS_QPEER; asm volatile("" : "+s"(qo_)); const bf16* QP = (const bf16*)(w + qo_);
#pragma unroll
                for (int i = 0; i < 8; ++i) { const int p = cc.tid + 512 * i, li = p >> 11, row = (p >> 4) & 127, c16 = p & 15;
                    *(LAS v4u*)(cc.lds + li * 128 * PK_KS + row * PK_KS + c16 * 16) = *(const GAS v4u*)(KB + (size_t)(li * 8 + hd) * 16384 + row * 128 + c16 * 8); }
                __syncthreads();
                peer_select32(hd, tg * 256 + cc.wave * 32, cc.lane, QP, cc.lds, cc.lds + 128 * PK_KS, w, (LAS unsigned*)(cc.lds + 2 * 128 * PK_KS + cc.wave * 4096));
                __syncthreads(); } }
        }
        SEAM(pb + 9);
        if (IN(pb + 10)) { PH_BEGIN
            const SliceSched SS = slice_sched_init(cc, (unsigned*)(w + WS_CTL), bar, l * 2 + 0);
            RLOOP(10, true) { RSYNC;
            for (int i = 0;; ++i) { int sl, tb; if (!slice_item(SS, cc, i, sl, tb)) break;
                peer_sddmm_wave(tb * 64 + cc.wave * 8, sl, cc.lane, WSP(unsigned char, WS_H), WSP(float, WS_SA), WSP(unsigned char, WS_U), WSP(int, WS_SEL), WSP(float, WS_PART), (LAS unsigned*)(cc.lds + 4096 + cc.wave * 8192)); } }
        }
        SEAM(pb + 10);
        if (IN(pb + 11)) { PH_BEGIN
            for (int n = cc.gw; n < NTOK / 4; n += cc.NGW) peer_coef_tokens4(n, NTOK / 4, cc.lane, WSP(float, WS_PART), WSP(int, WS_SEL), WSP(float, WS_SEL + 8 * MiB), WSP(float, WS_SELS), WSP(float, WS_US), WSP(float, WS_VS));
        }
        SEAM(pb + 11);
        if (IN(pb + 12)) { PH_BEGIN
            float* xo = l == 0 ? WSP(float, WS_X2) : outp;
            const SliceSched SS = slice_sched_init(cc, (unsigned*)(w + WS_CTL), bar, l * 2 + 1);
#ifndef REP_MODE
#define REP_MODE 0
#endif
            RLOOP(12, l == 0) { RSYNC;
            if (REP_MODE && rp_) {
            for (int i = 0;; ++i) { int sl, tb; if (!slice_item8(SS, cc, i, sl, tb)) break;
                peer_spmm6_wave<REP_MODE>(tb * 64 + cc.wave * 8, sl, cc.lane, WSP(unsigned char, WS_V), WSP(int, WS_SEL), WSP(float, WS_SEL + 8 * MiB), outp, WSP(float, WS_SEG + 64 * MiB), (LAS unsigned*)(cc.lds + 4096 + cc.wave * 8192)); }
            } else
            for (int i = 0;; ++i) { int sl, tb; if (!slice_item8(SS, cc, i, sl, tb)) break;
                peer_spmm6_wave(tb * 64 + cc.wave * 8, sl, cc.lane, WSP(unsigned char, WS_V), WSP(int, WS_SEL), WSP(float, WS_SEL + 8 * MiB), outp, xo, (LAS unsigned*)(cc.lds + 4096 + cc.wave * 8192)); } }
        }
        SEAM(pb + 12);
    }
#undef PH_BEGIN
#undef INP
#undef WSP
#undef IN
#undef SEAM
}

#ifndef MK_SPLIT
#define MK_SPLIT 0
#endif
extern "C" void kernel_launch(void* const* d_in, const int* in_sizes, int n_in, void* d_out, int out_size, void* d_ws, size_t ws_size, hipStream_t stream) {
    static int grid = 0;
    if (grid == 0) {
        if (n_in != 21 || out_size != NTOK * DM || ws_size < WS_END) { fprintf(stderr, "kernel_launch: unexpected shapes (n_in %d, out %d, ws %zu < %zu); nothing launched\n", n_in, out_size, ws_size, (size_t)WS_END); grid = -1; return; }
        int dev = 0, cus = 0, per_cu = 0;
        if (hipGetDevice(&dev) != hipSuccess || hipDeviceGetAttribute(&cus, hipDeviceAttributeMultiprocessorCount, dev) != hipSuccess) { grid = -1; return; }
        if (hipFuncSetAttribute((const void*)mk_fwd, hipFuncAttributeMaxDynamicSharedMemorySize, LDS_BYTES) != hipSuccess) { fprintf(stderr, "kernel_launch: hipFuncSetAttribute failed\n"); grid = -1; return; }
        if (hipOccupancyMaxActiveBlocksPerMultiprocessor(&per_cu, (const void*)mk_fwd, 512, LDS_BYTES) != hipSuccess || per_cu < 1) fprintf(stderr, "kernel_launch: occupancy query reports %d\n", per_cu);
        (void)hipGetLastError();
        grid = cus;
    }
    if (grid < 0) return;
    if (hipMemsetAsync((char*)d_ws + WS_CTL, 0, 1 * MiB, stream) != hipSuccess) { fprintf(stderr, "kernel_launch: memset failed\n"); return; }
    Args a{};
    for (int i = 0; i < 21; ++i) a.in[i] = (const float*)d_in[i];
    a.out = (float*)d_out; a.ws = (unsigned char*)d_ws; a.pad = 0;
#if MK_SPLIT
    for (int p = 0; p < NPHASES; ++p) { a.lo = p; a.hi = p + 1; a.li = p; hipLaunchKernelGGL(mk_fwd, dim3(grid), dim3(512), LDS_BYTES, stream, a); }
#else
    a.lo = 0; a.hi = NPHASES; a.li = 0;
    hipLaunchKernelGGL(mk_fwd, dim3(grid), dim3(512), LDS_BYTES, stream, a);
#endif
    const hipError_t le = hipPeekAtLastError();
    if (le != hipSuccess) fprintf(stderr, "kernel_launch: launch failed: %s\n", hipGetErrorName(le));
}
```

```cpp
#include <hip/hip_runtime.h>
#include <cstdio>
#include <cstdint>
namespace pg8 {
#define PG8_LAS __attribute__((address_space(3)))
typedef unsigned short bf16_t;
typedef short bf16x8 __attribute__((ext_vector_type(8)));
typedef float f32x4 __attribute__((ext_vector_type(4)));
typedef unsigned u32x4 __attribute__((ext_vector_type(4)));
constexpr int BM = 256, BK = 64, HALF = 128, HTB = HALF * BK * 2  , STAGE_BYTES = 8 * HTB, NXCD = 8, WGM = 8;

__host__ __device__ __forceinline__ int lds_byte(int r, int c) { const int st = (r >> 4) * 2 + (c >> 5), rr = r & 15, cc = c & 31, ob = rr * 64 + cc * 2; return st * 1024 + (ob ^ (((ob >> 9) & 1) << 5)); }
__host__ __device__ __forceinline__ void stage_rc(int b, int& R, int& C) { const int st = b / 1024, sb = b % 1024, swz = sb ^ (((sb >> 9) & 1) << 5); R = (st >> 1) * 16 + swz / 64; C = (st & 1) * 32 + (swz % 64) / 2; }
__host__ __device__ __forceinline__ int perm32(int rho) { const int n = rho >> 4, i = rho & 15; return 8 * (i >> 2) + 4 * n + (i & 3); }

struct Unit { int pm, pn; };
struct Gemm { const bf16_t* A; const bf16_t* Bt; int M, N, K; };

struct StaticOrder {
    int nM, nN, nwg, G, c;
    __host__ __device__ void init(int M, int N, int G_, int c_) { nM = M / BM; nN = N / BM; nwg = nM * nN; G = G_; c = c_; }
    __host__ __device__ bool next(int i, Unit& u) const {
        const long L = (long)i * G + c; if (L >= nwg) return false;
        int wgid = (int)L; { const int q = nwg / NXCD, r = nwg % NXCD, xcd = wgid % NXCD, off = wgid / NXCD; wgid = (xcd < r ? xcd * (q + 1) : r * (q + 1) + (xcd - r) * q) + off; }
        const int nig = WGM * nN, gid = wgid / nig, fm = gid * WGM, gsz = (nM - fm) < WGM ? (nM - fm) : WGM;
        u.pm = fm + ((wgid % nig) % gsz); u.pn = (wgid % nig) / gsz; return true;
    }
    __device__ __forceinline__ void a_ready(const Unit&) const {}
    __device__ __forceinline__ void done(const Unit&) const {}
};

typedef float f32x2 __attribute__((ext_vector_type(2)));
template <class Epi, class Sched, bool ALIGN_EPI = false, bool SP2 = false, bool I8 = false>
__device__ __forceinline__ void gemm_phase(PG8_LAS unsigned char* lds, const Gemm g, const Sched& S, const Epi& E, int wave_) {
    unsigned z_ = 0u; asm volatile("" : "+s"(z_)); int tid_ = wave_ * 64 + (int)__builtin_amdgcn_mbcnt_hi(~0u, __builtin_amdgcn_mbcnt_lo(~0u, z_)); asm volatile("" : "+v"(tid_));     int K_ = g.K; asm volatile("" : "+s"(K_));
    const int tid = tid_, wid = __builtin_amdgcn_readfirstlane(tid >> 6), lane = tid & 63, wr = wid >> 2, wc = wid & 3, fr = lane & 15, fq = lane >> 4;
    const int K = I8 ? (K_ >> 1) : K_, nt = K / BK;
    unsigned voffA[2], voffB[2];
#pragma unroll
    for (int i = 0; i < 2; ++i) { int R, C; stage_rc(tid * 16 + i * 8192, R, C); const int Rb = Epi::PERM ? ((R & ~31) + perm32(R & 31)) : R;
        voffA[i] = (unsigned)(R * K + C) * 2u; voffB[i] = (unsigned)(Rb * K + C) * 2u; }
    const size_t kstep = (size_t)(BK * 2);
    const size_t hstep = (size_t)HALF * K * 2;
    const size_t tstep = 2 * hstep;
    const unsigned lds_u32_ = (unsigned)(unsigned long long)lds;
    const unsigned ldsw = (unsigned)wid * 1024u;
    const int aoff = lds_byte(wr * 64 + fr, fq * 8), boff = lds_byte(wc * 32 + fr, fq * 8);
#define PG8_SA(b, h) (((b) * 2 + (h)) * HTB)
#define PG8_SB(b, h) ((4 + (b) * 2 + (h)) * HTB)
#define PG8_STAGE(bufoff, gbase, voff) do { _Pragma("unroll") for (int _i = 0; _i < 2; ++_i) { \
        const unsigned m0v_ = lds_u32_ + (unsigned)(bufoff) + ldsw + (unsigned)_i * 8192u; const char* gb_ = (const char*)(gbase); \
        asm volatile("s_mov_b32 m0, %0\n\ts_nop 0\n\tglobal_load_lds_dwordx4 %1, %2" :: "s"(m0v_), "v"((voff)[_i]), "s"(gb_) : "memory", "m0"); } } while (0)
#define PG8_LDA(dst, b, h) do { _Pragma("unroll") for (int m = 0; m < 4; ++m) _Pragma("unroll") for (int k = 0; k < 2; ++k) dst[m][k] = *(const PG8_LAS bf16x8*)(lds + PG8_SA(b, h) + aoff + m * 2048 + k * 1024); } while (0)
#define PG8_LDB(dst, b, h) do { _Pragma("unroll") for (int n = 0; n < 2; ++n) _Pragma("unroll") for (int k = 0; k < 2; ++k) dst[n][k] = *(const PG8_LAS bf16x8*)(lds + PG8_SB(b, h) + boff + n * 2048 + k * 1024); } while (0)
#define PG8_MMA(ai, bj, At, Bt) do { __builtin_amdgcn_s_setprio(1); _Pragma("unroll") for (int m = 0; m < 4; ++m) _Pragma("unroll") for (int n = 0; n < 2; ++n) _Pragma("unroll") for (int k = 0; k < 2; ++k) { \
        if constexpr (I8) { typedef int v4i_t __attribute__((ext_vector_type(4))); \
            acc[ai][bj][m][n] = __builtin_bit_cast(f32x4, __builtin_amdgcn_mfma_i32_16x16x64_i8(__builtin_bit_cast(v4i_t, Bt[n][k]), __builtin_bit_cast(v4i_t, At[m][k]), __builtin_bit_cast(v4i_t, acc[ai][bj][m][n]), 0, 0, 0)); } \
        else acc[ai][bj][m][n] = __builtin_amdgcn_mfma_f32_16x16x32_bf16(Bt[n][k], At[m][k], acc[ai][bj][m][n], 0, 0, 0); } __builtin_amdgcn_s_setprio(0); } while (0)
#define PG8_WAIT_V(n) asm volatile("s_waitcnt vmcnt(" #n ")" ::: "memory")
#define PG8_WAIT_L(n) asm volatile("s_waitcnt lgkmcnt(" #n ")" ::: "memory")
#define PG8_BAR __builtin_amdgcn_s_barrier()
#define PG8_SCHED __builtin_amdgcn_sched_barrier(0)
    Unit cur, nxt; int ui = 0;
    if (!S.next(0, cur)) return;
    cur.pm = __builtin_amdgcn_readfirstlane(cur.pm); cur.pn = __builtin_amdgcn_readfirstlane(cur.pn);
    f32x4 acc[2][2][4][2];
#pragma unroll
    for (int a = 0; a < 2; ++a)
#pragma unroll
        for (int b = 0; b < 2; ++b)
#pragma unroll
            for (int m = 0; m < 4; ++m)
#pragma unroll
                for (int n = 0; n < 2; ++n) acc[a][b][m][n] = (f32x4){0.f, 0.f, 0.f, 0.f};
    bf16x8 At[4][2], B0[2][2], B1[2][2];
    const char* gA_; const char* gB_;
    { const unsigned long long a_ = (unsigned long long)g.A, b_ = (unsigned long long)g.Bt;
      gA_ = (const char*)(((unsigned long long)(unsigned)__builtin_amdgcn_readfirstlane((int)(a_ >> 32)) << 32) | (unsigned)__builtin_amdgcn_readfirstlane((int)a_));
      gB_ = (const char*)(((unsigned long long)(unsigned)__builtin_amdgcn_readfirstlane((int)(b_ >> 32)) << 32) | (unsigned)__builtin_amdgcn_readfirstlane((int)b_)); }
    const char* cA = gA_ + (size_t)cur.pm * tstep; const char* cB = gB_ + (size_t)cur.pn * tstep;
    S.a_ready(cur);
    if constexpr (SP2) {
        PG8_STAGE(PG8_SB(0, 0), cB, voffB); PG8_STAGE(PG8_SB(0, 1), cB + hstep, voffB); PG8_STAGE(PG8_SA(0, 0), cA, voffA); PG8_STAGE(PG8_SA(0, 1), cA + hstep, voffA);
        if (wr == 1) PG8_BAR;
        PG8_WAIT_V(2); PG8_BAR;
        PG8_STAGE(PG8_SB(1, 0), cB + kstep, voffB); PG8_STAGE(PG8_SA(1, 0), cA + kstep, voffA); PG8_STAGE(PG8_SB(1, 1), cB + hstep + kstep, voffB);
        PG8_WAIT_V(6); PG8_BAR;
    } else {
        PG8_STAGE(PG8_SB(0, 0), cB, voffB); PG8_STAGE(PG8_SA(0, 0), cA, voffA); PG8_STAGE(PG8_SB(0, 1), cB + hstep, voffB); PG8_STAGE(PG8_SA(0, 1), cA + hstep, voffA);
        if (wr == 1) PG8_BAR;
        PG8_WAIT_V(4); PG8_BAR;
        PG8_STAGE(PG8_SB(1, 0), cB + kstep, voffB); PG8_STAGE(PG8_SA(1, 0), cA + kstep, voffA); PG8_STAGE(PG8_SB(1, 1), cB + hstep + kstep, voffB);
        PG8_WAIT_V(6); PG8_BAR;
    }
    for (;;) {
        const bool has_next = S.next(ui + 1, nxt);
        nxt.pm = __builtin_amdgcn_readfirstlane(nxt.pm); nxt.pn = __builtin_amdgcn_readfirstlane(nxt.pn);
        const char* nA = has_next ? gA_ + (size_t)nxt.pm * tstep : cA; const char* nB = has_next ? gB_ + (size_t)nxt.pn * tstep : cB;
        for (int t = 0; t < nt; t += 2) {
            const bool last = (t == nt - 2);
            const char* a1 = cA + (size_t)(t + 1) * kstep;
            const char* a2 = last ? nA : cA + (size_t)(t + 2) * kstep; const char* b2 = last ? nB : cB + (size_t)(t + 2) * kstep;
            const char* a3 = a2 + kstep; const char* b3 = b2 + kstep;
            if (last && has_next) S.a_ready(nxt);
            if constexpr (SP2) {
            PG8_LDB(B0, 0, 0); PG8_LDB(B1, 0, 1); PG8_SCHED; PG8_LDA(At, 0, 0); PG8_STAGE(PG8_SA(1, 1), a1 + hstep, voffA);
            PG8_WAIT_V(8); PG8_WAIT_L(0); PG8_BAR; PG8_MMA(0, 0, At, B0); PG8_MMA(0, 1, At, B1); PG8_BAR; PG8_SCHED;
            PG8_LDA(At, 0, 1); PG8_STAGE(PG8_SB(0, 0), b2, voffB); PG8_STAGE(PG8_SB(0, 1), b2 + hstep, voffB); PG8_STAGE(PG8_SA(0, 0), a2, voffA);
            PG8_WAIT_V(8); PG8_WAIT_L(0); PG8_BAR; PG8_MMA(1, 0, At, B0); PG8_MMA(1, 1, At, B1); PG8_BAR; PG8_SCHED;
            PG8_LDB(B0, 1, 0); PG8_LDB(B1, 1, 1); PG8_SCHED; PG8_LDA(At, 1, 0); PG8_STAGE(PG8_SA(0, 1), a2 + hstep, voffA);
            PG8_WAIT_V(8); PG8_WAIT_L(0); PG8_BAR; PG8_MMA(0, 0, At, B0); PG8_MMA(0, 1, At, B1); PG8_BAR; PG8_SCHED;
            PG8_LDA(At, 1, 1); PG8_STAGE(PG8_SB(1, 0), b3, voffB); PG8_STAGE(PG8_SB(1, 1), b3 + hstep, voffB); PG8_STAGE(PG8_SA(1, 0), a3, voffA);
            PG8_WAIT_V(8); PG8_WAIT_L(0); PG8_BAR; PG8_MMA(1, 0, At, B0); PG8_MMA(1, 1, At, B1); PG8_BAR; PG8_SCHED;
            } else {
            PG8_LDB(B0, 0, 0); PG8_SCHED; PG8_LDA(At, 0, 0); PG8_STAGE(PG8_SA(1, 1), a1 + hstep, voffA);
            PG8_WAIT_L(8); PG8_BAR; PG8_WAIT_L(0); PG8_MMA(0, 0, At, B0); PG8_BAR; PG8_SCHED;
            PG8_LDB(B1, 0, 1); PG8_STAGE(PG8_SB(0, 0), b2, voffB);
            PG8_BAR; PG8_WAIT_L(0); PG8_MMA(0, 1, At, B1); PG8_BAR;
            PG8_LDA(At, 0, 1); PG8_STAGE(PG8_SA(0, 0), a2, voffA);
            PG8_BAR; PG8_WAIT_L(0); PG8_MMA(1, 0, At, B0); PG8_BAR; PG8_SCHED;
            PG8_STAGE(PG8_SB(0, 1), b2 + hstep, voffB);
            PG8_WAIT_V(6); PG8_BAR; PG8_MMA(1, 1, At, B1); PG8_BAR;
            PG8_LDB(B0, 1, 0); PG8_SCHED; PG8_LDA(At, 1, 0); PG8_STAGE(PG8_SA(0, 1), a2 + hstep, voffA);
            PG8_WAIT_L(8); PG8_BAR; PG8_WAIT_L(0); PG8_MMA(0, 0, At, B0); PG8_BAR; PG8_SCHED;
            PG8_LDB(B1, 1, 1); PG8_STAGE(PG8_SB(1, 0), b3, voffB);
            PG8_BAR; PG8_WAIT_L(0); PG8_MMA(0, 1, At, B1); PG8_BAR;
            PG8_LDA(At, 1, 1); PG8_STAGE(PG8_SA(1, 0), a3, voffA);
            PG8_BAR; PG8_WAIT_L(0); PG8_MMA(1, 0, At, B0); PG8_BAR; PG8_SCHED;
            PG8_STAGE(PG8_SB(1, 1), b3 + hstep, voffB);
            PG8_WAIT_V(6); PG8_BAR; PG8_MMA(1, 1, At, B1); PG8_BAR;
            }
        }
        if constexpr (ALIGN_EPI) { if (wr == 0) PG8_BAR; }
        if constexpr (I8) {
#pragma unroll
            for (int a = 0; a < 2; ++a)
#pragma unroll
                for (int m = 0; m < 4; ++m) { const float r_ = E.rowscale(cur.pm * BM + wr * 64 + fr + a * HALF + m * 16);
#pragma unroll
                    for (int b = 0; b < 2; ++b)
#pragma unroll
                        for (int n = 0; n < 2; ++n) { typedef int v4i2_t __attribute__((ext_vector_type(4))); const v4i2_t i_ = __builtin_bit_cast(v4i2_t, acc[a][b][m][n]);
                            acc[a][b][m][n] = (f32x4){(float)i_[0] * r_, (float)i_[1] * r_, (float)i_[2] * r_, (float)i_[3] * r_}; } }
        }
        if constexpr (!Epi::AFTER_DRAIN) { E(acc, cur, wr, wc, fr, fq); S.done(cur); }
        if (!has_next) break;
#pragma unroll
        for (int a = 0; a < 2; ++a)
#pragma unroll
            for (int b = 0; b < 2; ++b)
#pragma unroll
                for (int m = 0; m < 4; ++m)
#pragma unroll
                    for (int n = 0; n < 2; ++n) acc[a][b][m][n] = (f32x4){0.f, 0.f, 0.f, 0.f};
        cur = nxt; cA = nA; cB = nB; ++ui;
        if constexpr (ALIGN_EPI) { if (wr == 1) PG8_BAR; }
    }
    PG8_WAIT_V(0);
    if constexpr (!ALIGN_EPI) { if (wr == 0) PG8_BAR; }
    PG8_BAR;
    if constexpr (Epi::AFTER_DRAIN) { E.fused(acc, cur, wr, wc, fr, fq, lds, wid, lane); S.done(cur); }
#undef PG8_SA
#undef PG8_SB
#undef PG8_STAGE
#undef PG8_LDA
#undef PG8_LDB
#undef PG8_MMA
#undef PG8_WAIT_V
#undef PG8_WAIT_L
#undef PG8_BAR
#undef PG8_SCHED
}
}
#define XB_TMO      128
#define XB_XCNT(j)  (256  + 64 * (j))
#define XB_XSUB(j)  (1280 + 64 * (j))
#define XB_XGEN(j)  (2304 + 64 * (j))
#define XB_TOP      3328
#define XB_TOPGEN   3392
#define XCD_BAR_WORDS 3456
#define XB_SPIN_CAP (1u << 24)
#define LAS __attribute__((address_space(3)))

__device__ __forceinline__ unsigned xb_ld(unsigned* p)              { return __hip_atomic_load(p, __ATOMIC_RELAXED, __HIP_MEMORY_SCOPE_AGENT); }
__device__ __forceinline__ unsigned xb_add(unsigned* p, unsigned v) { return __hip_atomic_fetch_add(p, v, __ATOMIC_RELAXED, __HIP_MEMORY_SCOPE_AGENT); }
__device__ __forceinline__ unsigned xb_xcc_id() { return (unsigned)__builtin_amdgcn_s_getreg((3 << 11) | 20) & 0xFu; }
#define XB_SPIN(cond, bar) do { unsigned _sp = 0; while (cond) { __builtin_amdgcn_s_sleep(1); \
    if ((++_sp & 255u) == 0u) { if (xb_ld(&(bar)[XB_TMO])) break; if (_sp > XB_SPIN_CAP) { atomicAdd(&(bar)[XB_TMO], 1u); break; } } } } while (0)

__device__ __forceinline__ int xb_lane_id() { unsigned z = 0u; asm volatile("" : "+s"(z)); return (int)__builtin_amdgcn_mbcnt_hi(~0u, __builtin_amdgcn_mbcnt_lo(~0u, z)); }
struct XcdBarrier {
    unsigned w0;
    unsigned* bar; unsigned x;
    volatile LAS unsigned* st;
};

__device__ __forceinline__ XcdBarrier xcd_barrier_post(unsigned* bar, volatile LAS unsigned* st) {
    XcdBarrier b; b.bar = bar; b.x = xb_xcc_id(); b.st = st; b.w0 = (__builtin_amdgcn_readfirstlane((int)threadIdx.x >> 6) == 0) ? 1u : 0u;
    if (b.w0 && xb_lane_id() == 0) (void)xb_add(&bar[XB_XCNT(b.x)], 1u);
    return b;
}
__device__ __forceinline__ void xcd_barrier_complete(unsigned* bar, unsigned x, unsigned& nloc, unsigned& nx) {
    const unsigned G = gridDim.x * gridDim.y * gridDim.z;
    unsigned sum, cnt, mine, sp = 0u;
    for (;;) {
        sum = 0u; cnt = 0u; mine = 0u;
#pragma unroll
        for (unsigned j = 0; j < 16; ++j) { const unsigned c = xb_ld(&bar[XB_XCNT(j)]); sum += c; cnt += (c > 0u) ? 1u : 0u; mine = (j == x) ? c : mine; }
        if (sum == G) break;
        __builtin_amdgcn_s_sleep(1);
        if ((++sp & 255u) == 0u) { if (xb_ld(&bar[XB_TMO])) break; if (sp > XB_SPIN_CAP) { atomicAdd(&bar[XB_TMO], 1u); break; } }
    }
    nloc = mine > 0u ? mine : 1u; nx = cnt > 0u ? cnt : 1u;
}

__device__ __forceinline__ void xcd_barrier(const XcdBarrier& b) {
    asm volatile("s_waitcnt vmcnt(0)" ::: "memory");
    __syncthreads();
    if (b.w0 && xb_lane_id() == 0) {
        unsigned* bar = b.bar;
        __builtin_amdgcn_s_waitcnt(0);
        unsigned nloc = b.st[0], nx = b.st[1];
        if (nloc == 0u) { xcd_barrier_complete(bar, b.x, nloc, nx); b.st[0] = nloc; b.st[1] = nx; }
        const unsigned old = xb_add(&bar[XB_XSUB(b.x)], 1u);
        const unsigned gen = old / nloc;
        if (old + 1u == (gen + 1u) * nloc) {
            __builtin_amdgcn_fence(__ATOMIC_RELEASE, "agent");
            asm volatile("s_waitcnt vmcnt(0)" ::: "memory");
            const unsigned og = xb_add(&bar[XB_TOP], 1u);
            const unsigned tg = og / nx;
            if (og + 1u == (tg + 1u) * nx) xb_add(&bar[XB_TOPGEN], 1u);
            else XB_SPIN(xb_ld(&bar[XB_TOPGEN]) == tg, bar);
            __builtin_amdgcn_fence(__ATOMIC_ACQUIRE, "agent");
            xb_add(&bar[XB_XGEN(b.x)], 1u);
            asm volatile("s_waitcnt vmcnt(0)" ::: "memory");
        } else {
            XB_SPIN(xb_ld(&bar[XB_XGEN(b.x)]) == gen, bar);
            __builtin_amdgcn_fence(__ATOMIC_ACQUIRE, "agent");
            asm volatile("s_waitcnt vmcnt(0)" ::: "memory");
        }
    }
    __syncthreads();
}


#define GAS __attribute__((address_space(1)))
typedef unsigned short bf16;
typedef unsigned v4u __attribute__((ext_vector_type(4)));
typedef unsigned v2u __attribute__((ext_vector_type(2)));
typedef float f32x4 __attribute__((ext_vector_type(4)));
typedef float f32x2v __attribute__((ext_vector_type(2)));
typedef float f32x16 __attribute__((ext_vector_type(16)));
typedef short bf16x8 __attribute__((ext_vector_type(8)));
typedef __bf16 bf16v2 __attribute__((ext_vector_type(2)));
typedef _Float16 h2_t __attribute__((ext_vector_type(2)));
typedef _Float16 v32h_t __attribute__((ext_vector_type(32)));
typedef unsigned v6u __attribute__((ext_vector_type(6)));

constexpr int NTOK = 16384, DM = 2048, SEQ = 4096, INW = 15360, BW = 1024;
constexpr float EPS = 1e-6f;
constexpr float WBR_QS = 768.0f;
constexpr float ACT_QS = 127.0f / 6.0f;
constexpr float WIN_QS = 1024.0f;
constexpr int NPH = 13;
constexpr int NPHASES = 2 * NPH;

constexpr size_t MiB = 1u << 20;
constexpr size_t WS_CTL = 0;
constexpr size_t WS_LB = 1 * MiB;
constexpr size_t WS_SA = 1 * MiB + 192 * 1024;
constexpr size_t WS_US = 1 * MiB + 64 * 1024, WS_VS = 1 * MiB + 128 * 1024;
constexpr size_t WS_WIN = 2 * MiB;
constexpr size_t WS_MS = 1 * MiB + 256 * 1024;
constexpr size_t WS_M8 = 859 * MiB;
constexpr size_t WS_WBR = 62 * MiB;
constexpr size_t WS_WO = 74 * MiB;
constexpr size_t WS_WQ = 82 * MiB;
constexpr size_t WS_U = 91 * MiB;
constexpr size_t WS_V = 155 * MiB;
constexpr size_t WS_H = 219 * MiB;
constexpr size_t WS_SEG = 283 * MiB;
constexpr size_t WS_GATE = 539 * MiB;
constexpr size_t WS_X2 = 731 * MiB;
constexpr size_t WS_X1 = 795 * MiB;
constexpr size_t WS_CONV = 859 * MiB;
constexpr size_t WS_HGR = 891 * MiB;
constexpr size_t WS_MERGED = 923 * MiB;
constexpr size_t WS_SEL = 987 * MiB;
constexpr size_t WS_SELS = 1003 * MiB;
constexpr size_t WS_DEC = 1004 * MiB;
constexpr size_t WS_END = 1005 * MiB;
constexpr size_t WS_ST = WS_H;
constexpr size_t WS_KEYS = 90 * MiB;
constexpr size_t WS_PART = WS_GATE;
constexpr size_t WS_QPEER = WS_SEG;
constexpr size_t SEGSZ = (size_t)NTOK * 1024;
constexpr int CW_BAR = 4096;
constexpr int CW_RANK = 131072;

constexpr int RING_BYTES = 131072, MISC_OFF = RING_BYTES + 320, LDS_BYTES = 147456;

__device__ __forceinline__ unsigned pk2c(float lo, float hi) { f32x2v v = {lo, hi}; bf16v2 b = __builtin_convertvector(v, bf16v2); return __builtin_bit_cast(unsigned, b); }
__device__ __forceinline__ float bflo(unsigned x) { return __uint_as_float(x << 16); }
__device__ __forceinline__ float bfhi(unsigned x) { return __uint_as_float(x & 0xffff0000u); }
__device__ __forceinline__ float sigm(float x) { return __builtin_amdgcn_rcpf(1.0f + __expf(-x)); }
__device__ __forceinline__ float wave_sum(float v) {
#pragma unroll
    for (int o = 1; o < 64; o <<= 1) v += __shfl_xor(v, o);
    return v;
}
__device__ __forceinline__ float wave_max(float v) {
#pragma unroll
    for (int o = 1; o < 64; o <<= 1) v = fmaxf(v, __shfl_xor(v, o));
    return v;
}
#define LDS_WAIT() asm volatile("s_waitcnt lgkmcnt(0)" ::: "memory")
#define MFMA32(a, b, c) __builtin_amdgcn_mfma_f32_32x32x16_bf16((a), (b), (c), 0, 0, 0)
__device__ __forceinline__ int ridx16(int lane) { return ((lane >> 5) & 1) * 8 + ((lane >> 4) & 1) * 4 + ((lane >> 3) & 1) * 2 + ((lane >> 2) & 1); }
__device__ __forceinline__ void xreduce16(float (&v)[16], int lane) {
#pragma unroll
    for (int i = 0; i < 8; ++i) { const bool up = (lane & 32) != 0; const float snd = up ? v[i] : v[i + 8], kp = up ? v[i + 8] : v[i]; v[i] = kp + __shfl_xor(snd, 32); }
#pragma unroll
    for (int i = 0; i < 4; ++i) { const bool up = (lane & 16) != 0; const float snd = up ? v[i] : v[i + 4], kp = up ? v[i + 4] : v[i]; v[i] = kp + __shfl_xor(snd, 16); }
#pragma unroll
    for (int i = 0; i < 2; ++i) { const bool up = (lane & 8) != 0; const float snd = up ? v[i] : v[i + 2], kp = up ? v[i + 2] : v[i]; v[i] = kp + __shfl_xor(snd, 8); }
    { const bool up = (lane & 4) != 0; const float snd = up ? v[0] : v[1], kp = up ? v[1] : v[0]; v[0] = kp + __shfl_xor(snd, 4); }
    v[0] += __shfl_xor(v[0], 2); v[0] += __shfl_xor(v[0], 1);
}
__device__ __forceinline__ float gelu_exact(float v) {
    const float av = fabsf(v), t = __builtin_amdgcn_rcpf(av * 0.2316418882f + 1.0f);
    float q = t * 0.5307027145f + (-0.7265760135f); q = q * t + 0.7107068705f; q = q * t + (-0.142248368f); q = q * t + 0.127414796f; q = q * t;
    const float e = __builtin_amdgcn_exp2f((v * v) * (-0.72134752044f));
    const float m = v * (q * e);
    return v < 0.f ? m : v - m;
}

struct Ctx { LAS unsigned char* lds; int tid, lane, wave, G, gw, NGW; };

__device__ __forceinline__ void tr_item(const float* W, int K, int N, bf16* WT, int k0, int n0, int drow0, LAS float* scr, int lane) {
    { const int lr = lane >> 3, lc = (lane & 7) * 4; f32x4 v[8];
#pragma unroll
      for (int j = 0; j < 8; ++j) v[j] = *(const GAS f32x4*)(W + (size_t)(k0 + lr + 8 * j) * N + n0 + lc);
#pragma unroll
      for (int j = 0; j < 8; ++j) { LAS float* d = scr + (lr + 8 * j) * 33 + lc; d[0] = v[j].x; d[1] = v[j].y; d[2] = v[j].z; d[3] = v[j].w; } }
    LDS_WAIT();
    const int c = lane & 7;
#pragma unroll
    for (int j = 0; j < 4; ++j) { const int n = (lane >> 3) + 8 * j; const LAS float* s = scr + (8 * c) * 33 + n;
        v4u o; o.x = pk2c(s[0], s[33]); o.y = pk2c(s[66], s[99]); o.z = pk2c(s[132], s[165]); o.w = pk2c(s[198], s[231]);
        *(GAS v4u*)(WT + (size_t)(drow0 + n) * K + k0 + 8 * c) = o; }
    LDS_WAIT();
}
__device__ __forceinline__ unsigned pack_i8x4c(float a, float b, float c, float d) {
    const int ia = (int)__builtin_rintf(fminf(fmaxf(a, -127.f), 127.f)), ib = (int)__builtin_rintf(fminf(fmaxf(b, -127.f), 127.f)), ic = (int)__builtin_rintf(fminf(fmaxf(c, -127.f), 127.f)), id = (int)__builtin_rintf(fminf(fmaxf(d, -127.f), 127.f));
    return ((unsigned)ia & 255u) | (((unsigned)ib & 255u) << 8) | (((unsigned)ic & 255u) << 16) | ((unsigned)id << 24);
}
__device__ __forceinline__ void tr_item_i8(const float* W, int K, int N, unsigned char* WT, int k0, int n0, int drow0, float scale, LAS float* scr, int lane) {
    { const int lr = lane >> 3, lc = (lane & 7) * 4; f32x4 v[16];
#pragma unroll
      for (int j = 0; j < 16; ++j) v[j] = *(const GAS f32x4*)(W + (size_t)(k0 + lr + 8 * j) * N + n0 + lc);
#pragma unroll
      for (int j = 0; j < 16; ++j) { LAS float* d = scr + (lr + 8 * j) * 32 + (lc ^ ((j & 7) << 2)); const int x = lr & 3; d[x] = v[j].x; d[1 ^ x] = v[j].y; d[2 ^ x] = v[j].z; d[3 ^ x] = v[j].w; } }
    LDS_WAIT();
    const int c = lane & 15;
#pragma unroll
    for (int j = 0; j < 8; ++j) { const int n = (lane >> 4) + 4 * j, q = n ^ ((c & 7) << 2); const LAS float* s = scr + (8 * c) * 32;
        v2u o; o.x = pack_i8x4c(s[q] * scale, s[32 + (q ^ 1)] * scale, s[64 + (q ^ 2)] * scale, s[96 + (q ^ 3)] * scale); o.y = pack_i8x4c(s[128 + q] * scale, s[160 + (q ^ 1)] * scale, s[192 + (q ^ 2)] * scale, s[224 + (q ^ 3)] * scale);
        *(GAS v2u*)(WT + (size_t)(drow0 + n) * K + k0 + 8 * c) = o; }
    LDS_WAIT();
}
__device__ __forceinline__ int win_drow(int n) { if (n < 7168 || n >= 9216) return n; const int r = n - 7168, isb = r >> 10, c = r & 1023; return 7168 + (c >> 7) * 256 + isb * 128 + (c & 127); }
__device__ __forceinline__ void cvt_copy(const Ctx& c, const float* src, bf16* dst, size_t n8) {
    const size_t NT = (size_t)c.G * 512;
    for (size_t i = (size_t)blockIdx.x * 512 + c.tid; i < n8; i += NT) {
        const f32x4 a = ((const GAS f32x4*)src)[2 * i], b = ((const GAS f32x4*)src)[2 * i + 1];
        v4u o; o.x = pk2c(a.x, a.y); o.y = pk2c(a.z, a.w); o.z = pk2c(b.x, b.y); o.w = pk2c(b.z, b.w);
        ((GAS v4u*)dst)[i] = o;
    }
}
__device__ __forceinline__ void rms_row(const float* xr, const float* w, bf16* o, int lane) {
    const GAS f32x4* xp = (const GAS f32x4*)xr + lane; f32x4 v[8]; float s = 0.f;
#pragma unroll
    for (int j = 0; j < 8; ++j) { v[j] = xp[64 * j]; s += (v[j].x * v[j].x + v[j].y * v[j].y) + (v[j].z * v[j].z + v[j].w * v[j].w); }
    const float r = __builtin_amdgcn_rsqf(wave_sum(s) * (1.0f / DM) + EPS);
    const GAS f32x4* wp = (const GAS f32x4*)w + lane; GAS v2u* op = (GAS v2u*)o + lane;
#pragma unroll
    for (int j = 0; j < 8; ++j) { const f32x4 wv = wp[64 * j]; v2u q; q.x = pk2c(v[j].x * r * wv.x, v[j].y * r * wv.y); q.y = pk2c(v[j].z * r * wv.z, v[j].w * r * wv.w); op[64 * j] = q; }
}
__device__ __forceinline__ void rms_row_i8(const float* xr, const float* w, unsigned char* o, float* sa, int lane) {
    const GAS f32x4* xp = (const GAS f32x4*)xr + lane; f32x4 v[8]; float s = 0.f;
#pragma unroll
    for (int j = 0; j < 8; ++j) { v[j] = xp[64 * j]; s += (v[j].x * v[j].x + v[j].y * v[j].y) + (v[j].z * v[j].z + v[j].w * v[j].w); }
    const float r = __builtin_amdgcn_rsqf(wave_sum(s) * (1.0f / DM) + EPS);
    const GAS f32x4* wp = (const GAS f32x4*)w + lane; float m = 0.f;
#pragma unroll
    for (int j = 0; j < 8; ++j) { const f32x4 wv = wp[64 * j]; v[j].x *= r * wv.x; v[j].y *= r * wv.y; v[j].z *= r * wv.z; v[j].w *= r * wv.w;
        m = fmaxf(fmaxf(m, fmaxf(fabsf(v[j].x), fabsf(v[j].y))), fmaxf(fabsf(v[j].z), fabsf(v[j].w))); }
    m = wave_max(m);
    const float inv = m > 0.f ? 127.0f / m : 0.f;
    if (lane == 0) *(GAS float*)sa = m * (1.0f / 127.0f);
#pragma unroll
    for (int j = 0; j < 8; ++j) ((GAS unsigned*)o)[lane + 64 * j] = pack_i8x4c(v[j].x * inv, v[j].y * inv, v[j].z * inv, v[j].w * inv);
}
__device__ __forceinline__ void rms_rows2_i8(const float* xa, const float* xb, const float* w, unsigned char* oa, unsigned char* ob, float* saa, float* sab, int lane) {
    const GAS f32x4* pa = (const GAS f32x4*)xa + lane; const GAS f32x4* pb = (const GAS f32x4*)xb + lane; f32x4 va[8], vb[8]; float s0 = 0.f, s1 = 0.f;
#pragma unroll
    for (int j = 0; j < 8; ++j) { va[j] = pa[64 * j]; vb[j] = pb[64 * j]; }
#pragma unroll
    for (int j = 0; j < 8; ++j) { s0 += (va[j].x * va[j].x + va[j].y * va[j].y) + (va[j].z * va[j].z + va[j].w * va[j].w); s1 += (vb[j].x * vb[j].x + vb[j].y * vb[j].y) + (vb[j].z * vb[j].z + vb[j].w * vb[j].w); }
#pragma unroll
    for (int o = 1; o < 64; o <<= 1) { s0 += __shfl_xor(s0, o); s1 += __shfl_xor(s1, o); }
    const float r0 = __builtin_amdgcn_rsqf(s0 * (1.0f / DM) + EPS), r1 = __builtin_amdgcn_rsqf(s1 * (1.0f / DM) + EPS);
    const GAS f32x4* wp = (const GAS f32x4*)w + lane; float m0 = 0.f, m1 = 0.f;
#pragma unroll
    for (int j = 0; j < 8; ++j) { const f32x4 wv = wp[64 * j];
        va[j].x *= r0 * wv.x; va[j].y *= r0 * wv.y; va[j].z *= r0 * wv.z; va[j].w *= r0 * wv.w; vb[j].x *= r1 * wv.x; vb[j].y *= r1 * wv.y; vb[j].z *= r1 * wv.z; vb[j].w *= r1 * wv.w;
        m0 = fmaxf(fmaxf(m0, fmaxf(fabsf(va[j].x), fabsf(va[j].y))), fmaxf(fabsf(va[j].z), fabsf(va[j].w))); m1 = fmaxf(fmaxf(m1, fmaxf(fabsf(vb[j].x), fabsf(vb[j].y))), fmaxf(fabsf(vb[j].z), fabsf(vb[j].w))); }
#pragma unroll
    for (int o = 1; o < 64; o <<= 1) { m0 = fmaxf(m0, __shfl_xor(m0, o)); m1 = fmaxf(m1, __shfl_xor(m1, o)); }
    const float i0 = m0 > 0.f ? 127.0f / m0 : 0.f, i1 = m1 > 0.f ? 127.0f / m1 : 0.f;
    if (lane == 0) { *(GAS float*)saa = m0 * (1.0f / 127.0f); *(GAS float*)sab = m1 * (1.0f / 127.0f); }
#pragma unroll
    for (int j = 0; j < 8; ++j) { ((GAS unsigned*)oa)[lane + 64 * j] = pack_i8x4c(va[j].x * i0, va[j].y * i0, va[j].z * i0, va[j].w * i0); ((GAS unsigned*)ob)[lane + 64 * j] = pack_i8x4c(vb[j].x * i1, vb[j].y * i1, vb[j].z * i1, vb[j].w * i1); }
}
__device__ __forceinline__ void rms_rows2_i8b(const bf16* xa, const bf16* xb, const float* w, unsigned char* oa, unsigned char* ob, float* saa, float* sab, int lane) {
    v4u qa[4], qb[4]; float va[4][8], vb[4][8], s0 = 0.f, s1 = 0.f;
#pragma unroll
    for (int j = 0; j < 4; ++j) { qa[j] = *(const GAS v4u*)(xa + 8 * (lane + 64 * j)); qb[j] = *(const GAS v4u*)(xb + 8 * (lane + 64 * j)); }
#pragma unroll
    for (int j = 0; j < 4; ++j) { const unsigned a[4] = {qa[j].x, qa[j].y, qa[j].z, qa[j].w}, b[4] = {qb[j].x, qb[j].y, qb[j].z, qb[j].w};
#pragma unroll
        for (int k = 0; k < 4; ++k) { va[j][2 * k] = bflo(a[k]); va[j][2 * k + 1] = bfhi(a[k]); vb[j][2 * k] = bflo(b[k]); vb[j][2 * k + 1] = bfhi(b[k]); }
#pragma unroll
        for (int k = 0; k < 8; ++k) { s0 += va[j][k] * va[j][k]; s1 += vb[j][k] * vb[j][k]; } }
#pragma unroll
    for (int o = 1; o < 64; o <<= 1) { s0 += __shfl_xor(s0, o); s1 += __shfl_xor(s1, o); }
    const float r0 = __builtin_amdgcn_rsqf(s0 * (1.0f / DM) + EPS), r1 = __builtin_amdgcn_rsqf(s1 * (1.0f / DM) + EPS);
    float m0 = 0.f, m1 = 0.f;
#pragma unroll
    for (int j = 0; j < 4; ++j) { const f32x4 w0 = *(const GAS f32x4*)(w + 8 * (lane + 64 * j)), w1 = *(const GAS f32x4*)(w + 8 * (lane + 64 * j) + 4); const float ww[8] = {w0.x, w0.y, w0.z, w0.w, w1.x, w1.y, w1.z, w1.w};
#pragma unroll
        for (int k = 0; k < 8; ++k) { va[j][k] *= r0 * ww[k]; vb[j][k] *= r1 * ww[k]; m0 = fmaxf(m0, fabsf(va[j][k])); m1 = fmaxf(m1, fabsf(vb[j][k])); } }
#pragma unroll
    for (int o = 1; o < 64; o <<= 1) { m0 = fmaxf(m0, __shfl_xor(m0, o)); m1 = fmaxf(m1, __shfl_xor(m1, o)); }
    const float i0 = m0 > 0.f ? 127.0f / m0 : 0.f, i1 = m1 > 0.f ? 127.0f / m1 : 0.f;
    if (lane == 0) { *(GAS float*)saa = m0 * (1.0f / 127.0f); *(GAS float*)sab = m1 * (1.0f / 127.0f); }
#pragma unroll
    for (int j = 0; j < 4; ++j) {
        *(GAS v2u*)(oa + 8 * (lane + 64 * j)) = (v2u){pack_i8x4c(va[j][0] * i0, va[j][1] * i0, va[j][2] * i0, va[j][3] * i0), pack_i8x4c(va[j][4] * i0, va[j][5] * i0, va[j][6] * i0, va[j][7] * i0)};
        *(GAS v2u*)(ob + 8 * (lane + 64 * j)) = (v2u){pack_i8x4c(vb[j][0] * i1, vb[j][1] * i1, vb[j][2] * i1, vb[j][3] * i1), pack_i8x4c(vb[j][4] * i1, vb[j][5] * i1, vb[j][6] * i1, vb[j][7] * i1)}; }
}
__device__ __forceinline__ void rms_phase_i8b(const Ctx& c, const bf16* x, const float* w, unsigned char* H8, float* SA) {
    for (int m = c.gw; m < NTOK / 2; m += c.NGW) rms_rows2_i8b(x + (size_t)m * DM, x + (size_t)(m + NTOK / 2) * DM, w, H8 + (size_t)m * DM, H8 + (size_t)(m + NTOK / 2) * DM, SA + m, SA + m + NTOK / 2, c.lane);
}
__device__ __forceinline__ void rms_phase_i8(const Ctx& c, const float* x, const float* w, unsigned char* H8, float* SA) {
    for (int m = c.gw; m < NTOK / 2; m += c.NGW) rms_rows2_i8(x + (size_t)m * DM, x + (size_t)(m + NTOK / 2) * DM, w, H8 + (size_t)m * DM, H8 + (size_t)(m + NTOK / 2) * DM, SA + m, SA + m + NTOK / 2, c.lane);
}
__device__ __forceinline__ void bf16_rows_i8(const Ctx& c, const bf16* X, unsigned char* X8, float* XS) {
    for (int r = c.gw; r < NTOK; r += 4 * c.NGW) { v4u x[4][4];
#pragma unroll
        for (int i = 0; i < 4; ++i) if (r + i * c.NGW < NTOK)
#pragma unroll
            for (int j = 0; j < 4; ++j) x[i][j] = *(const GAS v4u*)(X + (size_t)(r + i * c.NGW) * DM + 8 * (c.lane + 64 * j));
#pragma unroll
        for (int i = 0; i < 4; ++i) if (r + i * c.NGW < NTOK) { const int row = r + i * c.NGW; float m = 0.f;
#pragma unroll
            for (int j = 0; j < 4; ++j) { const v4u q = x[i][j];
                m = fmaxf(m, fmaxf(fmaxf(fmaxf(fabsf(bflo(q.x)), fabsf(bfhi(q.x))), fmaxf(fabsf(bflo(q.y)), fabsf(bfhi(q.y)))), fmaxf(fmaxf(fabsf(bflo(q.z)), fabsf(bfhi(q.z))), fmaxf(fabsf(bflo(q.w)), fabsf(bfhi(q.w)))))); }
            m = wave_max(m);
            const float inv = m > 0.f ? 127.0f / m : 0.f;
            if (c.lane == 0) *(GAS float*)(XS + row) = m * (1.0f / 127.0f);
#pragma unroll
            for (int j = 0; j < 4; ++j) { const v4u q = x[i][j]; v2u o;
                o.x = pack_i8x4c(bflo(q.x) * inv, bfhi(q.x) * inv, bflo(q.y) * inv, bfhi(q.y) * inv); o.y = pack_i8x4c(bflo(q.z) * inv, bfhi(q.z) * inv, bflo(q.w) * inv, bfhi(q.w) * inv);
                *(GAS v2u*)(X8 + (size_t)row * DM + 8 * (c.lane + 64 * j)) = o; } } }
}
__device__ __forceinline__ void rms_rows2(const float* xa, const float* xb, const float* w, bf16* oa, bf16* ob, int lane) {
    const GAS f32x4* pa = (const GAS f32x4*)xa + lane; const GAS f32x4* pb = (const GAS f32x4*)xb + lane; f32x4 va[8], vb[8]; float sa = 0.f, sb = 0.f;
#pragma unroll
    for (int j = 0; j < 8; ++j) { va[j] = pa[64 * j]; vb[j] = pb[64 * j]; }
#pragma unroll
    for (int j = 0; j < 8; ++j) { sa += (va[j].x * va[j].x + va[j].y * va[j].y) + (va[j].z * va[j].z + va[j].w * va[j].w); sb += (vb[j].x * vb[j].x + vb[j].y * vb[j].y) + (vb[j].z * vb[j].z + vb[j].w * vb[j].w); }
#pragma unroll
    for (int o = 1; o < 64; o <<= 1) { sa += __shfl_xor(sa, o); sb += __shfl_xor(sb, o); }
    const float ra = __builtin_amdgcn_rsqf(sa * (1.0f / DM) + EPS), rb = __builtin_amdgcn_rsqf(sb * (1.0f / DM) + EPS);
    const GAS f32x4* wp = (const GAS f32x4*)w + lane; GAS v2u* qa = (GAS v2u*)oa + lane; GAS v2u* qb = (GAS v2u*)ob + lane;
#pragma unroll
    for (int j = 0; j < 8; ++j) { const f32x4 wv = wp[64 * j];
        v2u q; q.x = pk2c(va[j].x * ra * wv.x, va[j].y * ra * wv.y); q.y = pk2c(va[j].z * ra * wv.z, va[j].w * ra * wv.w); qa[64 * j] = q;
        v2u p; p.x = pk2c(vb[j].x * rb * wv.x, vb[j].y * rb * wv.y); p.y = pk2c(vb[j].z * rb * wv.z, vb[j].w * rb * wv.w); qb[64 * j] = p; }
}
__device__ __forceinline__ void rms_phase(const Ctx& c, const float* x, const float* w, bf16* H) {
    for (int m = c.gw; m < NTOK / 2; m += c.NGW) rms_rows2(x + (size_t)m * DM, x + (size_t)(m + NTOK / 2) * DM, w, H + (size_t)m * DM, H + (size_t)(m + NTOK / 2) * DM, c.lane);
}
__device__ __forceinline__ void fp8_row(const float* src, unsigned char* dst, float* scale_out, int lane) {
    const GAS f32x4* xp = (const GAS f32x4*)src + lane; f32x4 v[8]; float m = 0.f;
#pragma unroll
    for (int j = 0; j < 8; ++j) { v[j] = xp[64 * j]; m = fmaxf(fmaxf(m, fmaxf(fabsf(v[j].x), fabsf(v[j].y))), fmaxf(fabsf(v[j].z), fabsf(v[j].w))); }
    m = wave_max(m);
    const float inv = m > 0.f ? 256.0f / m : 0.f;
    if (lane == 0) *(GAS float*)scale_out = m * (1.0f / 256.0f);
#pragma unroll
    for (int j = 0; j < 8; ++j) { int p = __builtin_amdgcn_cvt_pk_fp8_f32(v[j].x * inv, v[j].y * inv, 0, false); p = __builtin_amdgcn_cvt_pk_fp8_f32(v[j].z * inv, v[j].w * inv, p, true);
        ((GAS unsigned*)dst)[lane + 64 * j] = (unsigned)p; }
}
constexpr size_t U8_SLICE = (size_t)16384 * 128;
__device__ __forceinline__ unsigned pack_i8x4(float a, float b, float c, float d) {
    const int ia = (int)__builtin_rintf(a), ib = (int)__builtin_rintf(b), ic = (int)__builtin_rintf(c), id = (int)__builtin_rintf(d);
    return ((unsigned)ia & 255u) | (((unsigned)ib & 255u) << 8) | (((unsigned)ic & 255u) << 16) | ((unsigned)id << 24);
}
__device__ __forceinline__ void row_load_strided(const float* src, int lane, f32x4 (&v)[8]) { const GAS f32x4* xp = (const GAS f32x4*)src + lane;
#pragma unroll
    for (int j = 0; j < 8; ++j) v[j] = xp[64 * j]; }
__device__ __forceinline__ void row_load_contig(const float* src, int lane, f32x4 (&v)[8]) { const GAS f32x4* xp = (const GAS f32x4*)src + 8 * lane;
#pragma unroll
    for (int j = 0; j < 8; ++j) v[j] = xp[j]; }
__device__ __forceinline__ void i8_row(const f32x4 (&v)[8], unsigned char* dst, float* scale_out, int lane) {
    float m = 0.f;
#pragma unroll
    for (int j = 0; j < 8; ++j) m = fmaxf(fmaxf(m, fmaxf(fabsf(v[j].x), fabsf(v[j].y))), fmaxf(fabsf(v[j].z), fabsf(v[j].w)));
    m = wave_max(m);
    const float inv = m > 0.f ? 127.0f / m : 0.f;
    if (lane == 0) *(GAS float*)scale_out = m * (1.0f / 127.0f);
#pragma unroll
    for (int j = 0; j < 8; ++j) *(GAS unsigned*)(dst + (size_t)(2 * j + (lane >> 5)) * U8_SLICE + 4 * (lane & 31)) = pack_i8x4(v[j].x * inv, v[j].y * inv, v[j].z * inv, v[j].w * inv);
}
constexpr size_t V6_SLICE = (size_t)16384 * 192;
__device__ __forceinline__ void fp6_row(const f32x4 (&v)[8], unsigned char* dst, float* scale_out, int lane) {
    float m = 0.f;
#pragma unroll
    for (int j = 0; j < 8; ++j) m = fmaxf(fmaxf(m, fmaxf(fabsf(v[j].x), fabsf(v[j].y))), fmaxf(fabsf(v[j].z), fabsf(v[j].w)));
    m = wave_max(m);
    const float inv = m > 0.f ? 7.5f / m : 0.f;
    if (lane == 0) *(GAS float*)scale_out = m * (1.0f / 7.5f);
    v32h_t h;
#pragma unroll
    for (int j = 0; j < 8; ++j) { h[4 * j] = (_Float16)(v[j].x * inv); h[4 * j + 1] = (_Float16)(v[j].y * inv); h[4 * j + 2] = (_Float16)(v[j].z * inv); h[4 * j + 3] = (_Float16)(v[j].w * inv); }
    const v6u q = __builtin_amdgcn_cvt_scalef32_pk32_fp6_f16(h, 1.0f);
    GAS v2u* o = (GAS v2u*)(dst + (size_t)(lane >> 3) * V6_SLICE + 24 * (lane & 7));
    o[0] = (v2u){q[0], q[1]}; o[1] = (v2u){q[2], q[3]}; o[2] = (v2u){q[4], q[5]};
}
struct P0Args { const float *w_in, *w_br_sb, *w_br_hg, *w_br_conv, *w_o, *w_q, *u, *v, *lbp; bf16 *WinT, *WbrT, *WoT, *WqT; unsigned char *U, *V; float *US, *VS; float* LB; int layer; const float *k1, *k2; bf16* KB; };
__device__ __forceinline__ void p0_convert(const Ctx& c, const P0Args& a, int parts = 7) {
    LAS float* scr = (LAS float*)(c.lds + c.wave * 16384);
    constexpr int I_IN = (DM / 128) * (INW / 32), I_BR = (BW / 64) * (DM / 32), I_SQ = (DM / 64) * (DM / 32);
    constexpr int I_Q8 = (DM / 128) * (DM / 32);
    constexpr int I_B8 = (BW / 128) * (DM / 32);
    constexpr int NITEMS = I_IN + I_BR + 2 * I_B8 + 2 * I_Q8;
    if (parts & 1)
    for (int it = c.gw; it < NITEMS; it += c.NGW) {
        int r = it;
        if (r < I_IN) { const int kb = r / (INW / 32), nb = r % (INW / 32); tr_item_i8(a.w_in, DM, INW, (unsigned char*)a.WinT, kb * 128, nb * 32, win_drow(nb * 32), WIN_QS, scr, c.lane); continue; } r -= I_IN;
        if (r < I_BR) { const int kb = r / (DM / 32), nb = r % (DM / 32); tr_item(a.w_br_sb, BW, DM, a.WbrT, kb * 64, nb * 32, nb * 32, scr, c.lane); continue; } r -= I_BR;
        if (r < I_B8) { const int kb = r / (DM / 32), nb = r % (DM / 32); tr_item_i8(a.w_br_hg, BW, DM, (unsigned char*)(a.WbrT + (size_t)DM * BW), kb * 128, nb * 32, nb * 32, WBR_QS, scr, c.lane); continue; } r -= I_B8;
        if (r < I_B8) { const int kb = r / (DM / 32), nb = r % (DM / 32); tr_item_i8(a.w_br_conv, BW, DM, (unsigned char*)(a.WbrT + (size_t)2 * DM * BW), kb * 128, nb * 32, nb * 32, WBR_QS, scr, c.lane); continue; } r -= I_B8;
        if (r < I_Q8) { const int kb = r / (DM / 32), nb = r % (DM / 32); tr_item_i8(a.w_o, DM, DM, (unsigned char*)a.WoT, kb * 128, nb * 32, nb * 32, WIN_QS, scr, c.lane); continue; } r -= I_Q8;
        { const int kb = r / (DM / 32), nb = r % (DM / 32); tr_item_i8(a.w_q, DM, DM, (unsigned char*)a.WqT, kb * 128, nb * 32, nb * 32, WIN_QS, scr, c.lane); }
    }
    if (parts & 2)
    {
    for (int r = c.gw; r < 16384; r += 2 * c.NGW) { const int r2 = r + c.NGW; f32x4 va[8], vb[8];
        row_load_strided(a.u + (size_t)r * 2048, c.lane, va); if (r2 < 16384) row_load_strided(a.u + (size_t)r2 * 2048, c.lane, vb);
        i8_row(va, a.U + (size_t)r * 128, a.US + r, c.lane); if (r2 < 16384) i8_row(vb, a.U + (size_t)r2 * 128, a.US + r2, c.lane); }
    for (int r = c.gw; r < 16384; r += 2 * c.NGW) { const int r2 = r + c.NGW; f32x4 va[8], vb[8];
        row_load_contig(a.v + (size_t)r * 2048, c.lane, va); if (r2 < 16384) row_load_contig(a.v + (size_t)r2 * 2048, c.lane, vb);
        fp6_row(va, a.V + (size_t)r * 192, a.VS + r, c.lane); if (r2 < 16384) fp6_row(vb, a.V + (size_t)r2 * 192, a.VS + r2, c.lane); }
    }
    if (parts & 4) {
    cvt_copy(c, a.k1, a.KB, (size_t)8 * 16384 / 8);
    cvt_copy(c, a.k2, a.KB + 8 * 16384, (size_t)8 * 16384 / 8); }
    if (blockIdx.x == 0) for (int i = c.tid; i < 1024; i += 512) a.LB[i] = a.layer == 0 ? 0.f : sigm(a.lbp[1024 + i] - a.lbp[i]);
}

__device__ __forceinline__ unsigned pack_i8x4u(float a, float b, float c, float d) {
    return (unsigned)__builtin_rintf(a) | ((unsigned)__builtin_rintf(b) << 8) | ((unsigned)__builtin_rintf(c) << 16) | ((unsigned)__builtin_rintf(d) << 24);
}
struct EpiIn {
    static constexpr bool PERM = true, AFTER_DRAIN = false;
    bf16* seg; bf16* gate; const float* lb; const float* sa;
    __device__ __forceinline__ float rowscale(int row) const { return ((const GAS float*)sa)[row] * (1.0f / WIN_QS); }
    __device__ __forceinline__ void operator()(const pg8::f32x4 (&acc)[2][2][4][2], const pg8::Unit& u, int wr, int wc, int fr, int fq) const {
        const int pn = u.pn; const int row0 = u.pm * 256 + wr * 64 + fr;
        if (pn >= 28 && pn < 36) {
            bf16* dst = seg + (size_t)7 * SEGSZ; const int col0 = (pn - 28) * 128 + wc * 32 + 8 * fq;
#pragma unroll
            for (int ai = 0; ai < 2; ++ai)
#pragma unroll
                for (int m = 0; m < 4; ++m) {
                    const pg8::f32x4 a0 = acc[ai][0][m][0], a1 = acc[ai][0][m][1], b0 = acc[ai][1][m][0], b1 = acc[ai][1][m][1];
                    v4u w; w.x = pk2c(a0[0] * sigm(b0[0]), a0[1] * sigm(b0[1])); w.y = pk2c(a0[2] * sigm(b0[2]), a0[3] * sigm(b0[3]));
                    w.z = pk2c(a1[0] * sigm(b1[0]), a1[1] * sigm(b1[1])); w.w = pk2c(a1[2] * sigm(b1[2]), a1[3] * sigm(b1[3]));
                    *(GAS v4u*)(dst + (size_t)(row0 + ai * 128 + m * 16) * 1024 + col0) = w; }
            return;
        }
        if (pn >= 24 && pn < 28) {
            unsigned char* g8 = (unsigned char*)(seg + (size_t)6 * SEGSZ); const int c8 = (pn & 3) * 256 + wc * 32 + 8 * fq;
#pragma unroll
            for (int ai = 0; ai < 2; ++ai)
#pragma unroll
                for (int m = 0; m < 4; ++m)
#pragma unroll
                    for (int bj = 0; bj < 2; ++bj) { const pg8::f32x4 v0 = acc[ai][bj][m][0], v1 = acc[ai][bj][m][1];
                        v2u w; w.x = pack_i8x4u(sigm(v0[0]) * 255.0f, sigm(v0[1]) * 255.0f, sigm(v0[2]) * 255.0f, sigm(v0[3]) * 255.0f); w.y = pack_i8x4u(sigm(v1[0]) * 255.0f, sigm(v1[1]) * 255.0f, sigm(v1[2]) * 255.0f, sigm(v1[3]) * 255.0f);
                        *(GAS v2u*)(g8 + (size_t)(row0 + ai * 128 + m * 16) * 1024 + c8 + bj * 128) = w; }
            return; }
        bf16* dst; int ld, colt, mode;
        if (pn < 28) { const int sg = pn >> 2; dst = seg + (size_t)sg * SEGSZ; ld = 1024; colt = (pn & 3) * 256; mode = (sg == 4) ? 2 : 0; }
        else {
            const int q = pn - 36; unsigned char* g8 = (unsigned char*)gate + (size_t)(q >> 3) * ((size_t)NTOK * 2048); const int c8 = (q & 7) * 256 + wc * 32 + 8 * fq;
#pragma unroll
            for (int ai = 0; ai < 2; ++ai)
#pragma unroll
                for (int m = 0; m < 4; ++m)
#pragma unroll
                    for (int bj = 0; bj < 2; ++bj) { const pg8::f32x4 v0 = acc[ai][bj][m][0], v1 = acc[ai][bj][m][1];
                        v2u w; w.x = pack_i8x4u(sigm(v0[0]) * 255.0f, sigm(v0[1]) * 255.0f, sigm(v0[2]) * 255.0f, sigm(v0[3]) * 255.0f); w.y = pack_i8x4u(sigm(v1[0]) * 255.0f, sigm(v1[1]) * 255.0f, sigm(v1[2]) * 255.0f, sigm(v1[3]) * 255.0f);
                        *(GAS v2u*)(g8 + (size_t)(row0 + ai * 128 + m * 16) * 2048 + c8 + bj * 128) = w; }
            return; }
        const int col0 = colt + wc * 32 + 8 * fq;
        if (mode == 0) {
#pragma unroll
            for (int ai = 0; ai < 2; ++ai)
#pragma unroll
                for (int m = 0; m < 4; ++m)
#pragma unroll
                    for (int bj = 0; bj < 2; ++bj) { const pg8::f32x4 v0 = acc[ai][bj][m][0], v1 = acc[ai][bj][m][1];
                        v4u w; w.x = pk2c(v0[0], v0[1]); w.y = pk2c(v0[2], v0[3]); w.z = pk2c(v1[0], v1[1]); w.w = pk2c(v1[2], v1[3]);
                        *(GAS v4u*)(dst + (size_t)(row0 + ai * 128 + m * 16) * ld + col0 + bj * 128) = w; }
        } else if (mode == 1) {
#pragma unroll
            for (int ai = 0; ai < 2; ++ai)
#pragma unroll
                for (int m = 0; m < 4; ++m)
#pragma unroll
                    for (int bj = 0; bj < 2; ++bj) { const pg8::f32x4 v0 = acc[ai][bj][m][0], v1 = acc[ai][bj][m][1];
                        v4u w; w.x = pk2c(sigm(v0[0]), sigm(v0[1])); w.y = pk2c(sigm(v0[2]), sigm(v0[3])); w.z = pk2c(sigm(v1[0]), sigm(v1[1])); w.w = pk2c(sigm(v1[2]), sigm(v1[3]));
                        *(GAS v4u*)(dst + (size_t)(row0 + ai * 128 + m * 16) * ld + col0 + bj * 128) = w; }
        } else {
            f32x4 l0[2], l1[2];
#pragma unroll
            for (int bj = 0; bj < 2; ++bj) { l0[bj] = *(const GAS f32x4*)(lb + col0 + bj * 128); l1[bj] = *(const GAS f32x4*)(lb + col0 + bj * 128 + 4); }
#pragma unroll
            for (int ai = 0; ai < 2; ++ai)
#pragma unroll
                for (int m = 0; m < 4; ++m)
#pragma unroll
                    for (int bj = 0; bj < 2; ++bj) { const pg8::f32x4 v0 = acc[ai][bj][m][0], v1 = acc[ai][bj][m][1]; float r[8];
#pragma unroll
                        for (int j = 0; j < 4; ++j) { r[j] = __logf(l0[bj][j] + (1.0f - l0[bj][j]) * sigm(v0[j])); r[4 + j] = __logf(l1[bj][j] + (1.0f - l1[bj][j]) * sigm(v1[j])); }
                        v4u w; w.x = pk2c(r[0], r[1]); w.y = pk2c(r[2], r[3]); w.z = pk2c(r[4], r[5]); w.w = pk2c(r[6], r[7]);
                        *(GAS v4u*)(dst + (size_t)(row0 + ai * 128 + m * 16) * ld + col0 + bj * 128) = w; }
        }
    }
};

__device__ __forceinline__ void conv_phase(const Ctx& c, const bf16* glu, const float* cw, const float* cb, const float* lnw, const float* lnb, bf16* out) {
    const int c0 = 2 * c.tid;
    float w0[31], w1[31];
#pragma unroll
    for (int j = 0; j < 31; ++j) { const f32x2v t = *(const GAS f32x2v*)(cw + j * 1024 + c0); w0[j] = t.x; w1[j] = t.y; }
    const f32x2v bv = *(const GAS f32x2v*)(cb + c0), lwv = *(const GAS f32x2v*)(lnw + c0), lbv = *(const GAS f32x2v*)(lnb + c0);
    LAS float* red = (LAS float*)c.lds;
    const int per = (NTOK / 8 + c.G - 1) / c.G, tile0 = (int)blockIdx.x * per;
    unsigned win[38];
    if (tile0 < NTOK / 8) {
#pragma unroll
        for (int r = 0; r < 38; ++r) { const int n = tile0 * 8 + r - 30; win[r] = *(const GAS unsigned*)(glu + (size_t)(n > 0 ? n : 0) * 1024 + c0); } }
    for (int ti = 0; ti < per; ++ti) { const int tile = tile0 + ti; if (tile >= NTOK / 8) break;
        const int n0 = tile * 8, tseq0 = n0 & (SEQ - 1);
        const bool more = (ti + 1 < per) && (tile + 1 < NTOK / 8);
        float a0[8], a1[8];
#pragma unroll
        for (int t = 0; t < 8; ++t) { a0[t] = bv.x; a1[t] = bv.y; }
#pragma unroll
        for (int r = 0; r < 38; ++r) {
            const unsigned xv = (tseq0 + r - 30 >= 0) ? win[r] : 0u;
            const float x0 = bflo(xv), x1 = bfhi(xv);
#pragma unroll
            for (int t = 0; t < 8; ++t) { const int j = r - t; if (j >= 0 && j <= 30) { a0[t] += w0[j] * x0; a1[t] += w1[j] * x1; } }
        }
#pragma unroll
        for (int r = 0; r < 30; ++r) win[r] = win[r + 8];
        if (more) {
#pragma unroll
            for (int i = 0; i < 8; ++i) win[30 + i] = *(const GAS unsigned*)(glu + (size_t)(n0 + 8 + i) * 1024 + c0); }
        float st[16];
#pragma unroll
        for (int t = 0; t < 8; ++t) { st[2 * t] = a0[t] + a1[t]; st[2 * t + 1] = a0[t] * a0[t] + a1[t] * a1[t]; }
        xreduce16(st, c.lane);
        if ((c.lane & 3) == 0) red[c.wave * 16 + ridx16(c.lane)] = st[0];
        __syncthreads();
        if (c.tid < 16) { float s = 0.f;
#pragma unroll
            for (int w = 0; w < 8; ++w) s += red[w * 16 + c.tid];
            red[128 + c.tid] = s; }
        __syncthreads();
#pragma unroll
        for (int t = 0; t < 8; ++t) {
            const float mean = red[128 + 2 * t] * (1.0f / 1024.0f), var = red[128 + 2 * t + 1] * (1.0f / 1024.0f) - mean * mean;
            const float rstd = __builtin_amdgcn_rsqf(var + EPS);
            const float h0 = (a0[t] - mean) * rstd * lwv.x + lbv.x, h1 = (a1[t] - mean) * rstd * lwv.y + lbv.y;
            const unsigned q4 = pack_i8x4c(h0 * sigm(h0) * ACT_QS, h1 * sigm(h1) * ACT_QS, 0.f, 0.f);
            *(GAS unsigned short*)((unsigned char*)out + (size_t)(n0 + t) * 1024 + c0) = (unsigned short)q4;
        }
        __syncthreads();
    }
}
__device__ __forceinline__ void hgrn_task(int task, int lane, const bf16* qhg, const bf16* logf, const bf16* ihg, bf16* out) {
    const int bh = task >> 6, dvb = task & 63, b = bh >> 3, h = bh & 7;
    const size_t rb = (size_t)b * SEQ * 1024;
    const GAS unsigned* qp = (const GAS unsigned*)(qhg + rb + h * 128) + lane;
    const GAS unsigned* lp = (const GAS unsigned*)(logf + rb + h * 128) + lane;
    const GAS unsigned* ip = (const GAS unsigned*)(ihg + rb + h * 128) + dvb;
    GAS bf16* op = (GAS bf16*)(out + rb + h * 128 + 2 * dvb);
    float S00 = 0.f, S01 = 0.f, S10 = 0.f, S11 = 0.f;
    unsigned qn[8], ln[8], inx[8];
#pragma unroll
    for (int j = 0; j < 8; ++j) { qn[j] = qp[(size_t)j * 512]; ln[j] = lp[(size_t)j * 512]; inx[j] = ip[(size_t)j * 512]; }
    for (int blk = 0; blk < SEQ / 8; ++blk) {
        unsigned qc[8], lc[8], ic[8];
#pragma unroll
        for (int j = 0; j < 8; ++j) { qc[j] = qn[j]; lc[j] = ln[j]; ic[j] = inx[j]; }
        if (blk + 1 < SEQ / 8) {
#pragma unroll
            for (int j = 0; j < 8; ++j) { const size_t o = (size_t)((blk + 1) * 8 + j) * 512; qn[j] = qp[o]; ln[j] = lp[o]; inx[j] = ip[o]; }
        }
        float pv[16];
#pragma unroll
        for (int j = 0; j < 8; ++j) {
            const float f0 = __expf(bflo(lc[j])), f1 = __expf(bfhi(lc[j])), k0 = 1.0f - f0, k1 = 1.0f - f1;
            const float i0 = bflo(ic[j]), i1 = bfhi(ic[j]), q0 = bflo(qc[j]), q1 = bfhi(qc[j]);
            S00 = f0 * S00 + k0 * i0; S01 = f0 * S01 + k0 * i1; S10 = f1 * S10 + k1 * i0; S11 = f1 * S11 + k1 * i1;
            pv[2 * j] = S00 * q0 + S10 * q1; pv[2 * j + 1] = S01 * q0 + S11 * q1;
        }
        xreduce16(pv, lane);
        if ((lane & 3) == 0) { const int idx = ridx16(lane); op[(size_t)(blk * 8 + (idx >> 1)) * 1024 + (idx & 1)] = (bf16)(pk2c(pv[0], 0.f) & 0xffffu); }
    }
}
constexpr int HG_TS = 272;
constexpr int HG_TL = 256;
constexpr int HG_TILE = 64 * HG_TL;
constexpr int HG_BS = 132;
__device__ __forceinline__ void hg_stage(LAS unsigned char* dst, const bf16* src, int tid) {
#pragma unroll
    for (int i = 0; i < 2; ++i) { const int p = tid + 512 * i, row = p >> 4, c16 = p & 15; *(LAS v4u*)(dst + row * HG_TL + c16 * 16) = *(const GAS v4u*)(src + (size_t)row * 1024 + c16 * 8); }
}
__device__ __forceinline__ void hg_scan(const LAS unsigned char* lft, int dk, int hf, float (&lf)[4][8], float (&b)[4][8], float& bl) {
    float bs[4], pb[4];
#pragma unroll
    for (int kk = 0; kk < 4; ++kk) { float run = 0.f;
#pragma unroll
        for (int j = 0; j < 8; ++j) { lf[kk][j] = __uint_as_float((unsigned)(*(const LAS unsigned short*)(lft + (16 * kk + 8 * hf + j) * HG_TL + dk * 2)) << 16); run += lf[kk][j]; b[kk][j] = run; }
        bs[kk] = run; }
#pragma unroll
    for (int kk = 0; kk < 4; ++kk) pb[kk] = __shfl_xor(bs[kk], 32);
    float pre = 0.f;
#pragma unroll
    for (int kk = 0; kk < 4; ++kk) { const float off = pre + (hf ? pb[kk] : 0.f);
#pragma unroll
        for (int j = 0; j < 8; ++j) b[kk][j] += off;
        pre += bs[kk] + pb[kk]; }
    bl = pre;
}
__device__ __forceinline__ bf16x8 pack8(const float (&v)[8]) { v4u t; t.x = pk2c(v[0], v[1]); t.y = pk2c(v[2], v[3]); t.z = pk2c(v[4], v[5]); t.w = pk2c(v[6], v[7]); return __builtin_bit_cast(bf16x8, t); }
__device__ __forceinline__ unsigned lds_u16(const LAS unsigned char* p) { return (unsigned)(*(const LAS unsigned short*)p); }
__device__ __forceinline__ size_t hg_tile_off(int ci) { const int bh = ci >> 6, ch = ci & 63, bb = bh >> 3, h = bh & 7; return ((size_t)bb * SEQ + ch * 64) * 1024 + h * 128; }
__device__ __forceinline__ void hg_tile_dma(LAS unsigned char* dst, const bf16* src, int wave, int lane) {
    const unsigned long long a_ = (unsigned long long)src;
    const char* sb = (const char*)(((unsigned long long)(unsigned)__builtin_amdgcn_readfirstlane((int)(a_ >> 32)) << 32) | (unsigned)__builtin_amdgcn_readfirstlane((int)a_));
    const unsigned d0 = (unsigned)(unsigned long long)dst + (unsigned)wave * 2048u;
    const unsigned vo = (unsigned)wave * 16384u + (unsigned)(lane >> 4) * 2048u + (unsigned)(lane & 15) * 16u;
#pragma unroll
    for (int i = 0; i < 2; ++i) { const unsigned m0v = d0 + (unsigned)i * 1024u, vv = vo + (unsigned)i * 8192u;
        asm volatile("s_mov_b32 m0, %0\n\ts_nop 0\n\tglobal_load_lds_dwordx4 %1, %2" :: "s"(m0v), "v"(vv), "s"(sb) : "memory", "m0"); }
}
__device__ __forceinline__ void hgA_chunk(const Ctx& c, int ci, int cn, int par, bool first, const bf16* LOGF, const bf16* IHG, bf16* ST, float* DEC) {
    LAS unsigned char* lft = c.lds + par * 2 * HG_TILE; LAS unsigned char* itl = lft + HG_TILE; LAS unsigned char* nxt = c.lds + (par ^ 1) * 2 * HG_TILE;
    if (first) { const size_t o = hg_tile_off(ci); hg_stage(lft, LOGF + o, c.tid); hg_stage(itl, IHG + o, c.tid); }
    asm volatile("s_waitcnt vmcnt(0)" ::: "memory");
    __syncthreads();
    if (cn < 2048) { const size_t o = hg_tile_off(cn); hg_tile_dma(nxt, LOGF + o, c.wave, c.lane); hg_tile_dma(nxt + HG_TILE, IHG + o, c.wave, c.lane); }
    const int dkt = c.wave & 3, dvh = c.wave >> 2, hf = c.lane >> 5, cl = c.lane & 31, dk = 32 * dkt + cl;
    float lf[4][8], b[4][8], bl; hg_scan(lft, dk, hf, lf, b, bl);
    bf16x8 kf[4];
#pragma unroll
    for (int kk = 0; kk < 4; ++kk) { float v[8];
#pragma unroll
        for (int j = 0; j < 8; ++j) v[j] = (1.0f - __expf(lf[kk][j])) * __expf(bl - b[kk][j]);
        kf[kk] = pack8(v); }
    if (dvh == 0 && hf == 0) ((GAS float*)DEC)[(size_t)ci * 128 + dk] = __expf(bl);
#pragma unroll
    for (int dvi = 0; dvi < 2; ++dvi) { const int dvt = dvh * 2 + dvi;
        f32x16 acc;
#pragma unroll
        for (int r = 0; r < 16; ++r) acc[r] = 0.f;
#pragma unroll
        for (int kk = 0; kk < 4; ++kk) { const LAS unsigned char* p = itl + (16 * kk + 8 * hf) * HG_TL + (32 * dvt + cl) * 2;
            v4u t; t.x = lds_u16(p) | (lds_u16(p + HG_TL) << 16); t.y = lds_u16(p + 2 * HG_TL) | (lds_u16(p + 3 * HG_TL) << 16); t.z = lds_u16(p + 4 * HG_TL) | (lds_u16(p + 5 * HG_TL) << 16); t.w = lds_u16(p + 6 * HG_TL) | (lds_u16(p + 7 * HG_TL) << 16);
            acc = MFMA32(kf[kk], __builtin_bit_cast(bf16x8, t), acc); }
        bf16* o = ST + (size_t)ci * 16384 + (size_t)(32 * dvt + cl) * 128 + 32 * dkt + 4 * hf;
#pragma unroll
        for (int g = 0; g < 4; ++g) { v2u q; q.x = pk2c(acc[4 * g], acc[4 * g + 1]); q.y = pk2c(acc[4 * g + 2], acc[4 * g + 3]); *(GAS v2u*)(o + 8 * g) = q; }
    }
    __syncthreads();
}
__device__ __forceinline__ void hgB(const Ctx& c, bf16* ST, const float* DEC) {
    for (int e = blockIdx.x * 512 + c.tid; e < 32 * 4096; e += c.G * 512) {
        const int bh = e >> 12, r = e & 4095, dv = r >> 5, dk4 = (r & 31) * 4;
        GAS v2u* p = (GAS v2u*)(ST + (size_t)bh * 64 * 16384 + (size_t)dv * 128 + dk4);
        const GAS f32x4* d = (const GAS f32x4*)(DEC + (size_t)bh * 64 * 128 + dk4);
        f32x4 S = {0.f, 0.f, 0.f, 0.f};
#pragma unroll
        for (int c0 = 0; c0 < 64; c0 += 8) {
            v2u Lv[8]; f32x4 D[8];
#pragma unroll
            for (int k = 0; k < 8; ++k) { Lv[k] = p[(size_t)(c0 + k) * 4096]; D[k] = d[(size_t)(c0 + k) * 32]; }
#pragma unroll
            for (int k = 0; k < 8; ++k) { v2u o; o.x = pk2c(S.x, S.y); o.y = pk2c(S.z, S.w); p[(size_t)(c0 + k) * 4096] = o;
                S.x = D[k].x * S.x + bflo(Lv[k].x); S.y = D[k].y * S.y + bfhi(Lv[k].x); S.z = D[k].z * S.z + bflo(Lv[k].y); S.w = D[k].w * S.w + bfhi(Lv[k].y); }
        }
    }
}
__device__ __forceinline__ void hgC_chunk(const Ctx& c, int ci, int cn, int par, bool first, const bf16* QHG, const bf16* LOGF, const bf16* IHG, const bf16* GHG, const bf16* ST, const float* nw, bf16* OUT) {
    const int bh = ci >> 6, ch = ci & 63, bb = bh >> 3, h = bh & 7; const size_t n0 = (size_t)bb * SEQ + ch * 64;
    LAS unsigned char* lft = c.lds + par * 2 * HG_TILE; LAS unsigned char* itl = lft + HG_TILE; LAS unsigned char* nxt = c.lds + (par ^ 1) * 2 * HG_TILE;
    LAS float* bt = (LAS float*)(c.lds + 4 * HG_TILE); LAS float* red = bt + 64 * HG_BS;
    LAS unsigned char* ktl = (LAS unsigned char*)(red + 256);
    const int hf = c.lane >> 5, cl = c.lane & 31;
    const int dvt = c.wave & 3, tt = c.wave >> 2, t = 32 * tt + cl;
    const bf16* qrow = QHG + (n0 + t) * 1024 + h * 128 + 8 * hf;
    if (first) { hg_stage(lft, LOGF + n0 * 1024 + h * 128, c.tid); hg_stage(itl, IHG + n0 * 1024 + h * 128, c.tid); }
    asm volatile("s_waitcnt vmcnt(0)" ::: "memory");
    __syncthreads();
    v4u qg[8];
#pragma unroll
    for (int kk = 0; kk < 8; ++kk) qg[kk] = *(const GAS v4u*)(qrow + 16 * kk);
    { const int dk = 32 * (c.wave & 3) + cl; float lf[4][8], b[4][8], bl; hg_scan(lft, dk, hf, lf, b, bl);
#pragma unroll
      for (int q = 0; q < 2; ++q) { const int kk = 2 * (c.wave >> 2) + q;
#pragma unroll
          for (int j = 0; j < 8; ++j) { bt[(16 * kk + 8 * hf + j) * HG_BS + dk] = (c.wave >> 2) ? b[2 + q][j] : b[q][j];
              *(LAS unsigned short*)(ktl + (16 * kk + 8 * hf + j) * HG_TS + dk * 2) = (unsigned short)(pk2c(1.0f - __expf((c.wave >> 2) ? lf[2 + q][j] : lf[q][j]), 0.f) & 0xffffu); } } }
    __syncthreads();
    if (cn < 2048) { const size_t o = hg_tile_off(cn); hg_tile_dma(nxt, LOGF + o, c.wave, c.lane); hg_tile_dma(nxt + HG_TILE, IHG + o, c.wave, c.lane); }
    bf16x8 qm[8];
    const bf16* strow = ST + (size_t)ci * 16384 + (size_t)(32 * dvt + cl) * 128 + 8 * hf;
#pragma unroll
    for (int kk = 0; kk < 8; ++kk) { const int d0 = 16 * kk + 8 * hf;
        const v4u qv = qg[kk];
        const f32x4 b0 = *(const LAS f32x4*)(bt + t * HG_BS + d0), b1 = *(const LAS f32x4*)(bt + t * HG_BS + d0 + 4), m0 = *(const LAS f32x4*)(bt + 31 * HG_BS + d0), m1 = *(const LAS f32x4*)(bt + 31 * HG_BS + d0 + 4);
        const float q[8] = {bflo(qv.x), bfhi(qv.x), bflo(qv.y), bfhi(qv.y), bflo(qv.z), bfhi(qv.z), bflo(qv.w), bfhi(qv.w)};
        const float bv[8] = {b0.x, b0.y, b0.z, b0.w, b1.x, b1.y, b1.z, b1.w}, mv[8] = {m0.x, m0.y, m0.z, m0.w, m1.x, m1.y, m1.z, m1.w};
        float vm[8];
#pragma unroll
        for (int j = 0; j < 8; ++j) vm[j] = q[j] * __expf(bv[j] - mv[j]);
        qm[kk] = pack8(vm); }
    f32x16 o;
#pragma unroll
    for (int r = 0; r < 16; ++r) o[r] = 0.f;
#pragma unroll 1
    for (int st = 0; st <= tt; ++st) {
        const int s = 32 * st + cl;
        f32x16 sa;
#pragma unroll
        for (int r = 0; r < 16; ++r) sa[r] = 0.f;
#pragma unroll
        for (int kk = 0; kk < 8; ++kk) { const int d0 = 16 * kk + 8 * hf;
            asm volatile("" ::: "memory");
            const v4u lv = *(const LAS v4u*)(ktl + s * HG_TS + d0 * 2);
            const f32x4 b0 = *(const LAS f32x4*)(bt + s * HG_BS + d0), b1 = *(const LAS f32x4*)(bt + s * HG_BS + d0 + 4), m0 = *(const LAS f32x4*)(bt + 31 * HG_BS + d0), m1 = *(const LAS f32x4*)(bt + 31 * HG_BS + d0 + 4);
            const float kv[8] = {bflo(lv.x), bfhi(lv.x), bflo(lv.y), bfhi(lv.y), bflo(lv.z), bfhi(lv.z), bflo(lv.w), bfhi(lv.w)};
            const float bv[8] = {b0.x, b0.y, b0.z, b0.w, b1.x, b1.y, b1.z, b1.w}, mv[8] = {m0.x, m0.y, m0.z, m0.w, m1.x, m1.y, m1.z, m1.w};
            float vk[8];
#pragma unroll
            for (int j = 0; j < 8; ++j) vk[j] = kv[j] * __expf(mv[j] - bv[j]);
            sa = MFMA32(pack8(vk), qm[kk], sa); }
        if (st == tt) {
#pragma unroll
            for (int r = 0; r < 16; ++r) if (((r & 3) + 8 * (r >> 2) + 4 * hf) > cl) sa[r] = 0.f;
        }
#pragma unroll
        for (int sp = 0; sp < 2; ++sp) {
            const float pv[8] = {sa[8 * sp], sa[8 * sp + 1], sa[8 * sp + 2], sa[8 * sp + 3], sa[8 * sp + 4], sa[8 * sp + 5], sa[8 * sp + 6], sa[8 * sp + 7]};
            const LAS unsigned char* p = itl + (32 * st + 16 * sp + 4 * hf) * HG_TL + (32 * dvt + cl) * 2;
            v4u tq; tq.x = lds_u16(p) | (lds_u16(p + HG_TL) << 16); tq.y = lds_u16(p + 2 * HG_TL) | (lds_u16(p + 3 * HG_TL) << 16);
            tq.z = lds_u16(p + 8 * HG_TL) | (lds_u16(p + 9 * HG_TL) << 16); tq.w = lds_u16(p + 10 * HG_TL) | (lds_u16(p + 11 * HG_TL) << 16);
            o = MFMA32(__builtin_bit_cast(bf16x8, tq), pack8(pv), o); }
    }
    { bf16x8 sf[8];
#pragma unroll
      for (int kk = 0; kk < 8; ++kk) sf[kk] = *(const GAS bf16x8*)(strow + 16 * kk);
#pragma unroll
      for (int kk = 0; kk < 8; ++kk) { const int d0 = 16 * kk + 8 * hf;
          const v4u qv = qg[kk];
          const f32x4 b0 = *(const LAS f32x4*)(bt + t * HG_BS + d0), b1 = *(const LAS f32x4*)(bt + t * HG_BS + d0 + 4);
          float ve[8] = {bflo(qv.x) * __expf(b0.x), bfhi(qv.x) * __expf(b0.y), bflo(qv.y) * __expf(b0.z), bfhi(qv.y) * __expf(b0.w), bflo(qv.z) * __expf(b1.x), bfhi(qv.z) * __expf(b1.y), bflo(qv.w) * __expf(b1.z), bfhi(qv.w) * __expf(b1.w)};
          o = MFMA32(sf[kk], pack8(ve), o); } }
    float ss = 0.f;
#pragma unroll
    for (int r = 0; r < 16; ++r) ss += o[r] * o[r];
    ss += __shfl_xor(ss, 32);
    if (hf == 0) red[(tt * 4 + dvt) * 32 + cl] = ss;
    __syncthreads();
    const float rstd = __builtin_amdgcn_rsqf(((red[(tt * 4 + 0) * 32 + cl] + red[(tt * 4 + 1) * 32 + cl]) + (red[(tt * 4 + 2) * 32 + cl] + red[(tt * 4 + 3) * 32 + cl])) * (1.0f / 128.0f) + EPS);
#pragma unroll
    for (int g = 0; g < 4; ++g) { const int dv0 = 32 * dvt + 8 * g + 4 * hf; const size_t off = (n0 + t) * 1024 + h * 128 + dv0;
        const unsigned gg = *(const GAS unsigned*)((const unsigned char*)GHG + off); const f32x4 w4 = *(const GAS f32x4*)(nw + dv0);
        const float rq = rstd * (ACT_QS / 255.0f);
        *(GAS unsigned*)((unsigned char*)OUT + off) = pack_i8x4c(o[4 * g] * rq * w4.x * (float)(gg & 255u), o[4 * g + 1] * rq * w4.y * (float)((gg >> 8) & 255u), o[4 * g + 2] * rq * w4.z * (float)((gg >> 16) & 255u), o[4 * g + 3] * rq * w4.w * (float)(gg >> 24)); }
    __syncthreads();
}
__device__ __forceinline__ void qknorm_rows4(bf16* row0, size_t rstride, const float* w, float scale, int lane) {
    v4u x[4][2];
#pragma unroll
    for (int i = 0; i < 4; ++i)
#pragma unroll
        for (int j = 0; j < 2; ++j) x[i][j] = *(const GAS v4u*)(row0 + i * rstride + 8 * lane + 512 * j);
    const f32x4 wa = *(const GAS f32x4*)(w + ((8 * lane) & 127)), wb = *(const GAS f32x4*)(w + ((8 * lane) & 127) + 4);
#pragma unroll
    for (int i = 0; i < 4; ++i)
#pragma unroll
        for (int j = 0; j < 2; ++j) { const v4u xx = x[i][j];
            float f[8] = {bflo(xx.x), bfhi(xx.x), bflo(xx.y), bfhi(xx.y), bflo(xx.z), bfhi(xx.z), bflo(xx.w), bfhi(xx.w)};
            float ss = 0.f;
#pragma unroll
            for (int k = 0; k < 8; ++k) ss += f[k] * f[k];
            ss += __shfl_xor(ss, 1); ss += __shfl_xor(ss, 2); ss += __shfl_xor(ss, 4); ss += __shfl_xor(ss, 8);
            const float r = __builtin_amdgcn_rsqf(ss * (1.0f / 128.0f) + EPS) * scale;
            v4u o; o.x = pk2c(f[0] * r * wa.x, f[1] * r * wa.y); o.y = pk2c(f[2] * r * wa.z, f[3] * r * wa.w); o.z = pk2c(f[4] * r * wb.x, f[5] * r * wb.y); o.w = pk2c(f[6] * r * wb.z, f[7] * r * wb.w);
            *(GAS v4u*)(row0 + i * rstride + 8 * lane + 512 * j) = o; }
}
__device__ __forceinline__ void vt_item(int item, int lane, const bf16* vsb, bf16* vt, LAS unsigned short* scr) {
    const int db = item & 3, sb = (item >> 2) & 63, bh = item >> 8, b = bh >> 3, h = bh & 7;
    const bf16* src = vsb + ((size_t)b * SEQ + sb * 64) * 1024 + h * 128 + db * 32;
#pragma unroll 4
    for (int i = 0; i < 16; ++i) { const int r = 4 * i + (lane >> 4); *(LAS unsigned*)(scr + r * 34 + 2 * (lane & 15)) = *(const GAS unsigned*)(src + (size_t)r * 1024 + 2 * (lane & 15)); }
    LDS_WAIT();
    const int c = lane & 7, b0 = 16 * (c >> 1) + 4 * (c & 1);
#pragma unroll
    for (int j = 0; j < 4; ++j) { const int d = (lane >> 3) + 8 * j; const LAS unsigned short* s = scr + b0 * 34 + d;
        v4u o; o.x = (unsigned)s[0] | ((unsigned)s[34] << 16); o.y = (unsigned)s[68] | ((unsigned)s[102] << 16); o.z = (unsigned)s[8 * 34] | ((unsigned)s[9 * 34] << 16); o.w = (unsigned)s[10 * 34] | ((unsigned)s[11 * 34] << 16);
        *(GAS v4u*)(vt + ((size_t)bh * 128 + db * 32 + d) * SEQ + sb * 64 + 8 * c) = o; }
    LDS_WAIT();
}

constexpr int AT_BUF = 32768, AT_VOFF = 16384;
__device__ __forceinline__ f32x16 attn_scores(const LAS unsigned char* kt, int krow, int hf, const bf16x8 (&qf)[8]) {
    f32x16 sa;
#pragma unroll
    for (int r = 0; r < 16; ++r) sa[r] = 0.f;
    const LAS unsigned char* kp = kt + krow * 256; const int sw = krow & 15;
#pragma unroll
    for (int kk = 0; kk < 8; ++kk) sa = MFMA32(*(const LAS bf16x8*)(kp + (((2 * kk + hf) ^ sw) << 4)), qf[kk], sa);
    return sa;
}
template <bool DIAG> __device__ __forceinline__ void attn_weights(const f32x16& sa, float& R, int hf, int cl, bf16x8 (&pf)[2]) {
    float om[16], Gs[4], Gp[4];
    if (DIAG) {
#pragma unroll
        for (int r = 0; r < 16; ++r) om[r] = __builtin_amdgcn_rcpf(1.0f + __builtin_amdgcn_exp2f(sa[r]));
#pragma unroll
        for (int r = 0; r < 16; ++r) if (((r & 3) + 8 * (r >> 2) + 4 * hf) >= cl) om[r] = 1.0f;
#pragma unroll
        for (int g = 0; g < 4; ++g) Gs[g] = (om[4 * g] * om[4 * g + 1]) * (om[4 * g + 2] * om[4 * g + 3]);
    } else {
#pragma unroll
        for (int g = 0; g < 4; ++g) { const float t0 = 1.0f + __builtin_amdgcn_exp2f(sa[4 * g]), t1 = 1.0f + __builtin_amdgcn_exp2f(sa[4 * g + 1]), t2 = 1.0f + __builtin_amdgcn_exp2f(sa[4 * g + 2]), t3 = 1.0f + __builtin_amdgcn_exp2f(sa[4 * g + 3]);
            const float ra = __builtin_amdgcn_rcpf(t0 * t1), rb = __builtin_amdgcn_rcpf(t2 * t3);
            om[4 * g] = ra * t1; om[4 * g + 1] = ra * t0; om[4 * g + 2] = rb * t3; om[4 * g + 3] = rb * t2; Gs[g] = ra * rb; }
    }
#pragma unroll
    for (int g = 0; g < 4; ++g) Gp[g] = __shfl_xor(Gs[g], 32);
    float tail = R; float w[16];
#pragma unroll
    for (int g = 3; g >= 0; --g) {
        const float c3 = tail * (hf == 0 ? Gp[g] : 1.0f), c2 = c3 * om[4 * g + 3], c1 = c2 * om[4 * g + 2], c0 = c1 * om[4 * g + 1];
        w[4 * g + 3] = c3 - om[4 * g + 3] * c3; w[4 * g + 2] = c2 - om[4 * g + 2] * c2; w[4 * g + 1] = c1 - om[4 * g + 1] * c1; w[4 * g] = c0 - om[4 * g] * c0;
        tail *= Gs[g] * Gp[g];
    }
    R = tail;
#pragma unroll
    for (int sp = 0; sp < 2; ++sp) { v4u t; t.x = pk2c(w[8 * sp], w[8 * sp + 1]); t.y = pk2c(w[8 * sp + 2], w[8 * sp + 3]); t.z = pk2c(w[8 * sp + 4], w[8 * sp + 5]); t.w = pk2c(w[8 * sp + 6], w[8 * sp + 7]); pf[sp] = __builtin_bit_cast(bf16x8, t); }
}
__device__ __forceinline__ void attn_pv(const LAS unsigned char* vt, int sub, int cl, int hf, const bf16x8 (&pf)[2], f32x16 (&o)[4]) {
#pragma unroll
    for (int d = 0; d < 4; ++d) { const int row = 32 * d + cl; const LAS unsigned char* vp = vt + row * 128; const int sw = (row >> 1) & 7;
#pragma unroll
        for (int sp = 0; sp < 2; ++sp) { const int x = 4 * sub + 2 * sp + hf;
            o[d] = MFMA32(*(const LAS bf16x8*)(vp + ((x ^ sw) << 4)), pf[sp], o[d]); } }
}
template <bool LAG> __device__ __forceinline__ void attn_unit(const Ctx& c, int bh, int qb, const bf16* qsb, const bf16* ksb, const bf16* vt, bf16* outb) {
    int lane_ = c.lane; asm volatile("" : "+v"(lane_));
    const int b = bh >> 3, h = bh & 7, lane = lane_, cl = lane & 31, hf = lane >> 5;
    const size_t rb = (size_t)b * SEQ; const int q0w = 256 * qb + 32 * c.wave;
    bf16x8 qf[8];
    { const bf16* qrow = qsb + (rb + q0w + cl) * 1024 + h * 128 + 8 * hf;
#pragma unroll
      for (int kk = 0; kk < 8; ++kk) qf[kk] = *(const GAS bf16x8*)(qrow + 16 * kk); }
    f32x16 o[4];
#pragma unroll
    for (int d = 0; d < 4; ++d)
#pragma unroll
        for (int r = 0; r < 16; ++r) o[d][r] = 0.f;
    float R = 1.0f;
    bf16x8 pd[2]; const LAS unsigned char* vimd = c.lds; int subd = 0; bool pending = false;
    const int kr0 = 8 * c.wave + (lane >> 4), kr1 = kr0 + 4;
    const bf16* kg0 = ksb + (rb + kr0) * 1024 + h * 128 + (((lane & 15) ^ (kr0 & 15)) << 3);
    const bf16* kg1 = ksb + (rb + kr1) * 1024 + h * 128 + (((lane & 15) ^ (kr1 & 15)) << 3);
    const int vr0 = 16 * c.wave + (lane >> 3), vr1 = vr0 + 8;
    const bf16* vg0 = vt + ((size_t)bh * 128 + vr0) * SEQ + (((lane & 7) ^ ((vr0 >> 1) & 7)) << 3);
    const bf16* vg1 = vt + ((size_t)bh * 128 + vr1) * SEQ + (((lane & 7) ^ ((vr1 >> 1) & 7)) << 3);
    LAS unsigned char* dk = c.lds + c.wave * 2048; LAS unsigned char* dv = c.lds + AT_VOFF + c.wave * 2048;
#define AT_DMA(kt_, bi_) do { const int ktt_ = (kt_); LAS unsigned char* bb_ = (LAS unsigned char*)0 + (bi_) * AT_BUF; \
        __builtin_amdgcn_global_load_lds((const unsigned*)(kg0 + (size_t)ktt_ * 64 * 1024), (LAS unsigned*)(dk + (bi_) * AT_BUF), 16, 0, 0); \
        __builtin_amdgcn_global_load_lds((const unsigned*)(kg1 + (size_t)ktt_ * 64 * 1024), (LAS unsigned*)(dk + (bi_) * AT_BUF + 1024), 16, 0, 0); \
        __builtin_amdgcn_global_load_lds((const unsigned*)(vg0 + ktt_ * 64), (LAS unsigned*)(dv + (bi_) * AT_BUF), 16, 0, 0); \
        __builtin_amdgcn_global_load_lds((const unsigned*)(vg1 + ktt_ * 64), (LAS unsigned*)(dv + (bi_) * AT_BUF + 1024), 16, 0, 0); (void)bb_; } while (0)
    const int nkt = 4 * (qb + 1);
    asm volatile("s_waitcnt vmcnt(0)" ::: "memory");
    AT_DMA(nkt - 1, 0); AT_DMA(nkt - 2, 1);
    asm volatile("s_waitcnt vmcnt(4)" ::: "memory"); __builtin_amdgcn_s_barrier(); asm volatile("" ::: "memory");
    int bi = 0;
#pragma unroll 1
    for (int it = 0; it < nkt; ++it) {
        const int kt = nkt - 1 - it;
        const int b2 = (bi + 2) & 3;
        if (it + 2 < nkt) AT_DMA(kt - 2, b2);
        const LAS unsigned char* kim = c.lds + bi * AT_BUF; const LAS unsigned char* vim = kim + AT_VOFF;
        const int rel = q0w - 64 * kt;
        if (rel >= 32) {
            if (LAG) { if (pending) attn_pv(vimd, subd, cl, hf, pd, o);
                const f32x16 s1 = attn_scores(kim, 32 + cl, hf, qf); if (rel == 32) attn_weights<true>(s1, R, hf, cl, pd); else attn_weights<false>(s1, R, hf, cl, pd);
                vimd = vim; subd = 1; pending = true;
            } else { bf16x8 p[2];
                { const f32x16 s1 = attn_scores(kim, 32 + cl, hf, qf); if (rel == 32) attn_weights<true>(s1, R, hf, cl, p); else attn_weights<false>(s1, R, hf, cl, p); }
                attn_pv(vim, 1, cl, hf, p, o); }
        }
        if (rel >= 0) {
            if (LAG) { if (pending) attn_pv(vimd, subd, cl, hf, pd, o);
                const f32x16 s0 = attn_scores(kim, cl, hf, qf); if (rel == 0) attn_weights<true>(s0, R, hf, cl, pd); else attn_weights<false>(s0, R, hf, cl, pd);
                vimd = vim; subd = 0; pending = true;
            } else { bf16x8 p[2];
                { const f32x16 s0 = attn_scores(kim, cl, hf, qf); if (rel == 0) attn_weights<true>(s0, R, hf, cl, p); else attn_weights<false>(s0, R, hf, cl, p); }
                attn_pv(vim, 0, cl, hf, p, o); }
        }
        if (it + 2 < nkt) asm volatile("s_waitcnt vmcnt(4)\n\ts_waitcnt lgkmcnt(0)" ::: "memory"); else asm volatile("s_waitcnt vmcnt(0)\n\ts_waitcnt lgkmcnt(0)" ::: "memory");
        __builtin_amdgcn_s_barrier(); asm volatile("" ::: "memory");
        bi = (bi + 1) & 3;
    }
#undef AT_DMA
    if (LAG && pending) attn_pv(vimd, subd, cl, hf, pd, o);
    bf16* orow = outb + (rb + q0w + cl) * 1024 + h * 128 + 4 * hf;
#pragma unroll
    for (int d = 0; d < 4; ++d)
#pragma unroll
        for (int g = 0; g < 4; ++g) { v2u q; q.x = pk2c(o[d][4 * g], o[d][4 * g + 1]); q.y = pk2c(o[d][4 * g + 2], o[d][4 * g + 3]); *(GAS v2u*)(orow + 32 * d + 8 * g) = q; }
    asm volatile("s_waitcnt vmcnt(0)" ::: "memory"); __builtin_amdgcn_s_barrier(); asm volatile("" ::: "memory");
}
__device__ __forceinline__ void hgpost_row(bf16* row, const bf16* grow, const float* w, int lane) {
#pragma unroll
    for (int j = 0; j < 2; ++j) {
        GAS v4u* p = (GAS v4u*)(row + 8 * lane + 512 * j); const v4u x = *p; const v4u gg = *(const GAS v4u*)(grow + 8 * lane + 512 * j);
        float f[8] = {bflo(x.x), bfhi(x.x), bflo(x.y), bfhi(x.y), bflo(x.z), bfhi(x.z), bflo(x.w), bfhi(x.w)};
        const float g[8] = {bflo(gg.x), bfhi(gg.x), bflo(gg.y), bfhi(gg.y), bflo(gg.z), bfhi(gg.z), bflo(gg.w), bfhi(gg.w)};
        float ss = 0.f;
#pragma unroll
        for (int k = 0; k < 8; ++k) ss += f[k] * f[k];
        ss += __shfl_xor(ss, 1); ss += __shfl_xor(ss, 2); ss += __shfl_xor(ss, 4); ss += __shfl_xor(ss, 8);
        const float r = __builtin_amdgcn_rsqf(ss * (1.0f / 128.0f) + EPS);
        const f32x4 wa = *(const GAS f32x4*)(w + ((8 * lane) & 127)), wb = *(const GAS f32x4*)(w + ((8 * lane) & 127) + 4);
        v4u o; o.x = pk2c(f[0] * r * wa.x * g[0], f[1] * r * wa.y * g[1]); o.y = pk2c(f[2] * r * wa.z * g[2], f[3] * r * wa.w * g[3]);
        o.z = pk2c(f[4] * r * wb.x * g[4], f[5] * r * wb.y * g[5]); o.w = pk2c(f[6] * r * wb.z * g[6], f[7] * r * wb.w * g[7]);
        *p = o;
    }
}

template <bool FIRST> struct EpiMerge {
    static constexpr bool PERM = true, AFTER_DRAIN = false;
    const unsigned char* gate; bf16* merged;
    __device__ __forceinline__ float rowscale(int) const { return 1.0f / (ACT_QS * WBR_QS); }
    __device__ __forceinline__ void operator()(const pg8::f32x4 (&acc)[2][2][4][2], const pg8::Unit& u, int wr, int wc, int fr, int fq) const {
        const int row0 = u.pm * 256 + wr * 64 + fr, col0 = u.pn * 256 + wc * 32 + 8 * fq;
#pragma unroll
        for (int ai = 0; ai < 2; ++ai)
#pragma unroll
            for (int m = 0; m < 4; ++m) {
                if (m == 0) asm volatile("" ::: "memory");
#pragma unroll
                for (int bj = 0; bj < 2; ++bj) {
                    const size_t off = (size_t)(row0 + ai * 128 + m * 16) * 2048 + col0 + bj * 128;
                    const v2u g = *(const GAS v2u*)(gate + off); const pg8::f32x4 v0 = acc[ai][bj][m][0], v1 = acc[ai][bj][m][1]; constexpr float k = 1.0f / 255.0f;
                    float r[8] = {(float)(g.x & 255u) * (v0[0] * k), (float)((g.x >> 8) & 255u) * (v0[1] * k), (float)((g.x >> 16) & 255u) * (v0[2] * k), (float)(g.x >> 24) * (v0[3] * k),
                                  (float)(g.y & 255u) * (v1[0] * k), (float)((g.y >> 8) & 255u) * (v1[1] * k), (float)((g.y >> 16) & 255u) * (v1[2] * k), (float)(g.y >> 24) * (v1[3] * k)};
                    if (!FIRST) { const v4u mo = *(const GAS v4u*)(merged + off);
                        r[0] += bflo(mo.x); r[1] += bfhi(mo.x); r[2] += bflo(mo.y); r[3] += bfhi(mo.y); r[4] += bflo(mo.z); r[5] += bfhi(mo.z); r[6] += bflo(mo.w); r[7] += bfhi(mo.w); }
                    v4u w; w.x = pk2c(r[0], r[1]); w.y = pk2c(r[2], r[3]); w.z = pk2c(r[4], r[5]); w.w = pk2c(r[6], r[7]);
                    *(GAS v4u*)(merged + off) = w; }
            }
    }
};
struct EpiStoreBf16 {
    static constexpr bool PERM = true, AFTER_DRAIN = false;
    bf16* out; const float* sa;
    __device__ __forceinline__ float rowscale(int row) const { return ((const GAS float*)sa)[row] * (1.0f / WIN_QS); }
    __device__ __forceinline__ void operator()(const pg8::f32x4 (&acc)[2][2][4][2], const pg8::Unit& u, int wr, int wc, int fr, int fq) const {
        const int row0 = u.pm * 256 + wr * 64 + fr, col0 = u.pn * 256 + wc * 32 + 8 * fq;
#pragma unroll
        for (int ai = 0; ai < 2; ++ai)
#pragma unroll
            for (int m = 0; m < 4; ++m)
#pragma unroll
                for (int bj = 0; bj < 2; ++bj) { const pg8::f32x4 v0 = acc[ai][bj][m][0], v1 = acc[ai][bj][m][1];
                    v4u w; w.x = pk2c(v0[0], v0[1]); w.y = pk2c(v0[2], v0[3]); w.z = pk2c(v1[0], v1[1]); w.w = pk2c(v1[2], v1[3]);
                    *(GAS v4u*)(out + (size_t)(row0 + ai * 128 + m * 16) * 2048 + col0 + bj * 128) = w; }
    }
};
struct EpiResid {
    static constexpr bool PERM = true, AFTER_DRAIN = false;
    const void* xin; bf16* xout; const float* ms; int XIN_BF16;
    __device__ __forceinline__ float rowscale(int row) const { return ((const GAS float*)ms)[row] * (1.0f / WIN_QS); }
    __device__ __forceinline__ void operator()(const pg8::f32x4 (&acc)[2][2][4][2], const pg8::Unit& u, int wr, int wc, int fr, int fq) const {
        const int row0 = u.pm * 256 + wr * 64 + fr, col0 = u.pn * 256 + wc * 32 + 8 * fq;
#pragma unroll
        for (int ai = 0; ai < 2; ++ai)
#pragma unroll
            for (int m = 0; m < 4; ++m)
#pragma unroll
                for (int bj = 0; bj < 2; ++bj) { const size_t off = (size_t)(row0 + ai * 128 + m * 16) * 2048 + col0 + bj * 128;
                    const pg8::f32x4 v0 = acc[ai][bj][m][0], v1 = acc[ai][bj][m][1]; float r[8];
                    if (XIN_BF16) { const v4u x = *(const GAS v4u*)((const bf16*)xin + off);
                        r[0] = v0[0] + bflo(x.x); r[1] = v0[1] + bfhi(x.x); r[2] = v0[2] + bflo(x.y); r[3] = v0[3] + bfhi(x.y); r[4] = v1[0] + bflo(x.z); r[5] = v1[1] + bfhi(x.z); r[6] = v1[2] + bflo(x.w); r[7] = v1[3] + bfhi(x.w); }
                    else { const f32x4 x0 = *(const GAS f32x4*)((const float*)xin + off), x1 = *(const GAS f32x4*)((const float*)xin + off + 4);
                        r[0] = v0[0] + x0.x; r[1] = v0[1] + x0.y; r[2] = v0[2] + x0.z; r[3] = v0[3] + x0.w; r[4] = v1[0] + x1.x; r[5] = v1[1] + x1.y; r[6] = v1[2] + x1.z; r[7] = v1[3] + x1.w; }
                    v4u w; w.x = pk2c(r[0], r[1]); w.y = pk2c(r[2], r[3]); w.z = pk2c(r[4], r[5]); w.w = pk2c(r[6], r[7]);
                    *(GAS v4u*)(xout + off) = w; }
    }
};

__device__ __forceinline__ float rl_f(float v, int l) { return __uint_as_float((unsigned)__builtin_amdgcn_readlane((int)__float_as_uint(v), l)); }
__device__ __forceinline__ void ins16(float (&L)[16], float x) {
#pragma unroll
    for (int i = 0; i < 16; ++i) { const float hi = __builtin_fmaxf(L[i], x); x = __builtin_fminf(L[i], x); L[i] = hi; }
}
#define CE_DESC(a, b) do { const float hi_ = __builtin_fmaxf(a, b), lo_ = __builtin_fminf(a, b); a = hi_; b = lo_; } while (0)
__device__ __forceinline__ void sort16_desc(float (&v)[16]) {
#pragma unroll
    for (int k = 2; k <= 16; k <<= 1)
#pragma unroll
        for (int j = k >> 1; j > 0; j >>= 1)
#pragma unroll
            for (int i = 0; i < 16; ++i) { const int l = i ^ j; if (l > i) { if ((i & k) == 0) CE_DESC(v[i], v[l]); else CE_DESC(v[l], v[i]); } }
}
__device__ __forceinline__ void bitonic_merge16_desc(float (&v)[16]) {
#pragma unroll
    for (int j = 8; j > 0; j >>= 1)
#pragma unroll
        for (int i = 0; i < 16; ++i) { const int l = i ^ j; if (l > i) CE_DESC(v[i], v[l]); }
}
__device__ __forceinline__ void top16_merge(float (&L)[16], const float (&T)[16]) {
#pragma unroll
    for (int i = 0; i < 16; ++i) L[i] = __builtin_fmaxf(L[i], T[15 - i]);
    bitonic_merge16_desc(L);
}
constexpr int PK_KS = 272;
__device__ __forceinline__ void peer_top16(const bf16* qrow  , const LAS unsigned char* kl  , int hf, float (&L)[16]) {
    bf16x8 qf[8];
#pragma unroll
    for (int kk = 0; kk < 8; ++kk) qf[kk] = *(const GAS bf16x8*)(qrow + 16 * kk);
#pragma unroll 1
    for (int kt = 0; kt < 4; ++kt) {
        f32x16 sa;
#pragma unroll
        for (int r = 0; r < 16; ++r) sa[r] = 0.f;
#pragma unroll
        for (int kk = 0; kk < 8; ++kk) sa = MFMA32(*(const LAS bf16x8*)(kl + kt * 32 * PK_KS + 32 * kk), qf[kk], sa);
        float T[16];
#pragma unroll
        for (int r = 0; r < 16; ++r) { const unsigned idx = (unsigned)(kt * 32 + (r & 3) + 8 * (r >> 2) + 4 * hf); T[r] = __uint_as_float((__float_as_uint(sa[r]) & ~127u) | idx); }
        sort16_desc(T);
        if (kt == 0) {
#pragma unroll
            for (int i = 0; i < 16; ++i) L[i] = T[i];
        } else top16_merge(L, T);
    }
    float P[16];
#pragma unroll
    for (int i = 0; i < 16; ++i) P[i] = __shfl_xor(L[i], 32);
    top16_merge(L, P);
}
__device__ __forceinline__ void peer_select32(int hd, int n0, int lane, const bf16* qpeer, const LAS unsigned char* kl1, const LAS unsigned char* kl2, unsigned char* wsb, LAS unsigned* ldsw) {
    asm volatile("" : "+v"(lane));
    const int c = lane & 31, hf = lane >> 5, n = n0 + c;
    const bf16* qrow = qpeer + (size_t)n * 2048 + hd * 256 + 8 * hf;
    float A[16], B[16];
    peer_top16(qrow, kl1 + c * PK_KS + 16 * hf, hf, A);
    peer_top16(qrow + 128, kl2 + c * PK_KS + 16 * hf, hf, B);
#define PKV(x) __uint_as_float(__float_as_uint(x) & ~127u)
#define PKI(x) ((int)(__float_as_uint(x) & 127u))
    float W[16];
    { float C0[16], C1[16], C2[16], E0 = 0.f, E1 = 0.f; unsigned id = 0;
#pragma unroll
      for (int a = 0; a < 16; ++a)
#pragma unroll
        for (int b = 0; b < 16; ++b) if ((a + 1) * (b + 1) <= 16) { const float pk = __uint_as_float((__float_as_uint(PKV(A[a]) + PKV(B[b])) & ~63u) | id);
            if (id < 16) C0[id] = pk; else if (id < 32) C1[id - 16] = pk; else if (id < 48) C2[id - 32] = pk; else if (id == 48) E0 = pk; else E1 = pk;
            ++id; }
      sort16_desc(C0); sort16_desc(C1); sort16_desc(C2);
      top16_merge(C0, C1); top16_merge(C0, C2);
#pragma unroll
      for (int i = 0; i < 16; ++i) W[i] = C0[i];
      ins16(W, E0); ins16(W, E1); }
    const float thr = W[15], mx = W[0];
    int cnt = 0; float ssum = 0.f;
    LAS int* le = (LAS int*)ldsw + c * 16; LAS float* lg = (LAS float*)ldsw + 512 + c * 16;
    { unsigned id = 0;
#pragma unroll
      for (int a = 0; a < 16; ++a)
#pragma unroll
        for (int b = 0; b < 16; ++b) if ((a + 1) * (b + 1) <= 16) {
            const float cv = PKV(A[a]) + PKV(B[b]); const float pk = __uint_as_float((__float_as_uint(cv) & ~63u) | id); ++id;
            if (pk >= thr) { const float e = __expf(cv - mx); if (hf == 0) { le[cnt] = PKI(A[a]) * 128 + PKI(B[b]); lg[cnt] = e; } ssum += e; ++cnt; }
        } }
    LDS_WAIT();
    asm volatile("" : "+s"(wsb));
    int* sel_e = (int*)(wsb + WS_SEL); float* sel_g = (float*)(wsb + WS_SEL + 8 * MiB); float* sel_s = (float*)(wsb + WS_SELS);
    { int lane3 = lane; asm volatile("" : "+v"(lane3)); const int t = lane3 >> 1, part = lane3 & 1;
      const v4u e0 = *(const LAS v4u*)((LAS int*)ldsw + t * 16 + 8 * part), e1 = *(const LAS v4u*)((LAS int*)ldsw + t * 16 + 8 * part + 4);
      const v4u g0 = *(const LAS v4u*)((LAS int*)ldsw + 512 + t * 16 + 8 * part), g1 = *(const LAS v4u*)((LAS int*)ldsw + 512 + t * 16 + 8 * part + 4);
      GAS v4u* pe = (GAS v4u*)(sel_e + (size_t)(n0 + t) * 128 + hd * 16 + 8 * part); GAS v4u* pg = (GAS v4u*)(sel_g + (size_t)(n0 + t) * 128 + hd * 16 + 8 * part);
      pe[0] = e0; pe[1] = e1; pg[0] = g0; pg[1] = g1; }
    LDS_WAIT();
    { int lane4 = lane; asm volatile("" : "+v"(lane4)); if ((lane4 >> 5) == 0) ((GAS float*)sel_s)[(size_t)(n0 + (lane4 & 31)) * 8 + hd] = ssum; }
}

__device__ __forceinline__ float dot2bf(unsigned a, unsigned b, float acc) {
    return __builtin_amdgcn_fdot2_f32_bf16(__builtin_bit_cast(bf16v2, a), __builtin_bit_cast(bf16v2, b), acc, false);
}
__device__ __forceinline__ float dot8bf(const v4u a, const v4u b, float acc) {
    const unsigned a0 = a.x, a1 = a.y, a2 = a.z, a3 = a.w, b0 = b.x, b1 = b.y, b2 = b.z, b3 = b.w;
    acc = dot2bf(a0, b0, acc); acc = dot2bf(a1, b1, acc); acc = dot2bf(a2, b2, acc); acc = dot2bf(a3, b3, acc);
    return acc;
}
__device__ __forceinline__ void unpack16(const v4u q, float (&f)[16]) {
    const unsigned d0 = q.x, d1 = q.y, d2 = q.z, d3 = q.w;
    f32x2v t;
    t = __builtin_amdgcn_cvt_pk_f32_fp8((int)d0, false); f[0] = t.x; f[1] = t.y; t = __builtin_amdgcn_cvt_pk_f32_fp8((int)d0, true); f[2] = t.x; f[3] = t.y;
    t = __builtin_amdgcn_cvt_pk_f32_fp8((int)d1, false); f[4] = t.x; f[5] = t.y; t = __builtin_amdgcn_cvt_pk_f32_fp8((int)d1, true); f[6] = t.x; f[7] = t.y;
    t = __builtin_amdgcn_cvt_pk_f32_fp8((int)d2, false); f[8] = t.x; f[9] = t.y; t = __builtin_amdgcn_cvt_pk_f32_fp8((int)d2, true); f[10] = t.x; f[11] = t.y;
    t = __builtin_amdgcn_cvt_pk_f32_fp8((int)d3, false); f[12] = t.x; f[13] = t.y; t = __builtin_amdgcn_cvt_pk_f32_fp8((int)d3, true); f[14] = t.x; f[15] = t.y;
}
struct SliceSched { int mode, xcc, rank, nloc; };
__device__ __forceinline__ SliceSched slice_sched_init(const Ctx& c, unsigned* ctl, const XcdBarrier& bar, int use) {
    LAS int* sh = (LAS int*)(c.lds + 1024);
    if (c.tid == 0) {
        int ok = 1; unsigned tot = 0;
        for (int j = 0; j < 16; ++j) { const unsigned n = xb_ld(&bar.bar[XB_XCNT(j)]); tot += n; if ((j < 8) != (n > 0u)) ok = 0; }
        if (tot != (unsigned)c.G) ok = 0;
        const int xcc = (int)xb_xcc_id();
        int rank = 0, nloc = 1;
        if (ok) { nloc = (int)xb_ld(&bar.bar[XB_XCNT(xcc)]); rank = (int)xb_add(&ctl[CW_RANK + (use * 16 + xcc) * 64], 1u); if (rank >= nloc) ok = 0; }
        sh[0] = ok; sh[1] = xcc; sh[2] = rank; sh[3] = nloc;
    }
    __syncthreads();
    SliceSched S; S.mode = sh[0]; S.xcc = sh[1]; S.rank = sh[2]; S.nloc = sh[3];
    __syncthreads();
    return S;
}
__device__ __forceinline__ bool slice_item(const SliceSched& S, const Ctx& c, int i, int& slice, int& tb) {
    if (S.mode) { const int it = S.rank + i * S.nloc; if (it >= 512) return false; slice = S.xcc + 8 * (it >> 8); tb = it & 255; return true; }
    const int it = (int)blockIdx.x + i * c.G; if (it >= 4096) return false; slice = it >> 8; tb = it & 255; return true;
}
__device__ __forceinline__ void unpack16p(const v4u q, f32x2v (&f)[8]) {
    const unsigned d0 = q.x, d1 = q.y, d2 = q.z, d3 = q.w;
    f[0] = __builtin_amdgcn_cvt_pk_f32_fp8((int)d0, false); f[1] = __builtin_amdgcn_cvt_pk_f32_fp8((int)d0, true);
    f[2] = __builtin_amdgcn_cvt_pk_f32_fp8((int)d1, false); f[3] = __builtin_amdgcn_cvt_pk_f32_fp8((int)d1, true);
    f[4] = __builtin_amdgcn_cvt_pk_f32_fp8((int)d2, false); f[5] = __builtin_amdgcn_cvt_pk_f32_fp8((int)d2, true);
    f[6] = __builtin_amdgcn_cvt_pk_f32_fp8((int)d3, false); f[7] = __builtin_amdgcn_cvt_pk_f32_fp8((int)d3, true);
}
__device__ __forceinline__ void sddmm_load(const unsigned char* ubase, const LAS unsigned* ids16, v4u (&q)[16]) {
    int id[16];
#pragma unroll
    for (int i = 0; i < 4; ++i) { const v4u v = *(const LAS v4u*)(ids16 + 4 * i); id[4 * i] = (int)v.x; id[4 * i + 1] = (int)v.y; id[4 * i + 2] = (int)v.z; id[4 * i + 3] = (int)v.w; }
#pragma unroll
    for (int it = 0; it < 16; ++it) q[it] = *(const GAS v4u*)(ubase + (unsigned)id[it] * 128u);
}
__device__ __forceinline__ void sddmm_token(const v4u (&qc)[16], const v4u hv, const float hs, int lane, unsigned* dst) {
    const int hq[4] = {(int)hv.x, (int)hv.y, (int)hv.z, (int)hv.w};
    float p[16];
#pragma unroll
    for (int it = 0; it < 16; ++it) { int a = __builtin_amdgcn_sdot4((int)qc[it].x, hq[0], 0, false); a = __builtin_amdgcn_sdot4((int)qc[it].y, hq[1], a, false);
        a = __builtin_amdgcn_sdot4((int)qc[it].z, hq[2], a, false); a = __builtin_amdgcn_sdot4((int)qc[it].w, hq[3], a, false);
        p[it] = (float)a * hs; }
#pragma unroll
    for (int i = 0; i < 8; ++i) { const bool up = (lane & 4) != 0; const float snd = up ? p[i] : p[i + 8], kp = up ? p[i + 8] : p[i]; p[i] = kp + __shfl_xor(snd, 4); }
#pragma unroll
    for (int i = 0; i < 4; ++i) { const bool up = (lane & 2) != 0; const float snd = up ? p[i] : p[i + 4], kp = up ? p[i + 4] : p[i]; p[i] = kp + __shfl_xor(snd, 2); }
#pragma unroll
    for (int i = 0; i < 2; ++i) { const bool up = (lane & 1) != 0; const float snd = up ? p[i] : p[i + 2], kp = up ? p[i + 2] : p[i]; p[i] = kp + __shfl_xor(snd, 1); }
    *(GAS unsigned*)dst = pk2c(p[0], p[1]);
}
__device__ __forceinline__ void peer_sddmm_wave(int t0, int s, int lane, const unsigned char* H8, const float* SA, const unsigned char* UQ, const int* sel_e, float* part, LAS unsigned* ldsw) {
    const int cg = lane & 7, sg = lane >> 3;
#pragma unroll
    for (int j = 0; j < 4; ++j) *(LAS v4u*)(ldsw + 4 * (lane + 64 * j)) = *(const GAS v4u*)(sel_e + (size_t)t0 * 128 + 4 * (lane + 64 * j));
    LDS_WAIT();
    const unsigned char* ubase = UQ + (size_t)s * U8_SLICE + cg * 16;
    const LAS unsigned* idl = ldsw + sg * 16;
    const unsigned char* hbase = H8 + (size_t)t0 * 2048 + s * 128 + cg * 16;
    unsigned* pbase = (unsigned*)part + ((size_t)t0 * 16 + s) * 64 + lane;
    v4u qa[16], qb[16];
    v4u ha = *(const GAS v4u*)(hbase), hb; float sa = ((const GAS float*)SA)[t0], sb;
    sddmm_load(ubase, idl, qa);
#pragma unroll
    for (int k = 0; k < 6; k += 2) {
        hb = *(const GAS v4u*)(hbase + (size_t)(k + 1) * 2048); sb = ((const GAS float*)SA)[t0 + k + 1];
        sddmm_load(ubase, idl + (k + 1) * 128, qb);
        sddmm_token(qa, ha, sa, lane, pbase + (size_t)k * 1024);
        ha = *(const GAS v4u*)(hbase + (size_t)(k + 2) * 2048); sa = ((const GAS float*)SA)[t0 + k + 2];
        sddmm_load(ubase, idl + (k + 2) * 128, qa);
        sddmm_token(qb, hb, sb, lane, pbase + (size_t)(k + 1) * 1024);
    }
    hb = *(const GAS v4u*)(hbase + (size_t)7 * 2048); sb = ((const GAS float*)SA)[t0 + 7];
    sddmm_load(ubase, idl + 7 * 128, qb);
    sddmm_token(qa, ha, sa, lane, pbase + (size_t)6 * 1024);
    sddmm_token(qb, hb, sb, lane, pbase + (size_t)7 * 1024);
    LDS_WAIT();
}
__device__ __forceinline__ void peer_coef_tokens4(int t0, int ts, int lane, const float* part, const int* sel_e, float* sel_g, const float* sel_s, const float* US, const float* VS) {
    unsigned pv[4][16]; v2u e[4]; f32x2v g[4]; float dn[4];
#pragma unroll
    for (int i = 0; i < 4; ++i) { const int t = t0 + i * ts;
#pragma unroll
        for (int s = 0; s < 16; ++s) pv[i][s] = ((const GAS unsigned*)part)[((size_t)t * 16 + s) * 64 + lane];
        e[i] = *(const GAS v2u*)(sel_e + (size_t)t * 128 + 2 * lane); g[i] = *(const GAS f32x2v*)(sel_g + (size_t)t * 128 + 2 * lane); dn[i] = ((const GAS float*)sel_s)[(size_t)t * 8 + (lane >> 3)]; }
    float ux[4], uy[4], vx[4], vy[4];
#pragma unroll
    for (int i = 0; i < 4; ++i) { ux[i] = ((const GAS float*)US)[e[i].x]; uy[i] = ((const GAS float*)US)[e[i].y]; vx[i] = ((const GAS float*)VS)[e[i].x]; vy[i] = ((const GAS float*)VS)[e[i].y]; }
#pragma unroll
    for (int i = 0; i < 4; ++i) { const int t = t0 + i * ts; float a0 = 0.f, a1 = 0.f;
#pragma unroll
        for (int s = 0; s < 16; ++s) { a0 += bflo(pv[i][s]); a1 += bfhi(pv[i][s]); }
        const float inv = 1.0f / dn[i];
        const float ox = g[i].x * inv * gelu_exact(a0 * ux[i]) * vx[i], oy = g[i].y * inv * gelu_exact(a1 * uy[i]) * vy[i];
        const h2_t ha = {(_Float16)ox, (_Float16)ox}, hb = {(_Float16)oy, (_Float16)oy};
        *(GAS v2u*)(sel_g + (size_t)t * 128 + 2 * lane) = (v2u){__builtin_bit_cast(unsigned, ha), __builtin_bit_cast(unsigned, hb)}; }
}
__device__ __forceinline__ bool slice_item8(const SliceSched& S, const Ctx& c, int i, int& slice, int& tb) {
    if (S.mode) { const int it = S.rank + i * S.nloc; if (it >= 256) return false; slice = S.xcc; tb = it; return true; }
    const int it = (int)blockIdx.x + i * c.G; if (it >= 2048) return false; slice = it >> 8; tb = it & 255; return true;
}
template <int MODE = 0>
__device__ __forceinline__ void spmm6_load(const unsigned char* vbase, const LAS unsigned* ids8, v4u (&qa)[8], v2u (&qb)[8]) {
    const v4u i0 = *(const LAS v4u*)(ids8), i1 = *(const LAS v4u*)(ids8 + 4);
    const unsigned id[8] = {i0.x, i0.y, i0.z, i0.w, i1.x, i1.y, i1.z, i1.w};
    if constexpr (MODE == 2) {
#pragma unroll
        for (int it = 0; it < 8; ++it) { qa[it] = (v4u){id[it], id[it] + 1u, id[it] + 2u, id[it] + 3u}; qb[it] = (v2u){id[it] + 4u, id[it] + 5u}; }
        return; }
#pragma unroll
    for (int it = 0; it < 8; ++it) { const unsigned char* p = vbase + id[it] * 192u; qa[it] = *(const GAS v4u*)p; qb[it] = *(const GAS v2u*)(p + 16); }
}
template <int MODE = 0>
__device__ __forceinline__ void spmm6_fma(const v4u (&qa)[8], const v2u (&qb)[8], const LAS unsigned* cf8, h2_t (&y)[16]) {
    const v4u c0 = *(const LAS v4u*)(cf8), c1 = *(const LAS v4u*)(cf8 + 4);
    const unsigned cf[8] = {c0.x, c0.y, c0.z, c0.w, c1.x, c1.y, c1.z, c1.w};
    if constexpr (MODE == 1) {
#pragma unroll
        for (int it = 0; it < 8; ++it) { const unsigned x = (qa[it].x ^ qa[it].y) ^ (qa[it].z ^ qa[it].w) ^ (qb[it].x ^ qb[it].y) ^ cf[it]; y[it] = __builtin_bit_cast(h2_t, __builtin_bit_cast(unsigned, y[it]) ^ x); }
        return; }
#pragma unroll
    for (int it = 0; it < 8; ++it) { const v6u q = {qa[it].x, qa[it].y, qa[it].z, qa[it].w, qb[it].x, qb[it].y};
        const v32h_t f = __builtin_amdgcn_cvt_scalef32_pk32_f16_fp6(q, 1.0f); const h2_t c2 = __builtin_bit_cast(h2_t, cf[it]);
#pragma unroll
        for (int j = 0; j < 16; ++j) { const h2_t v = {f[2 * j], f[2 * j + 1]}; y[j] = __builtin_elementwise_fma(v, c2, y[j]); } }
}
template <int MODE = 0>
__device__ __forceinline__ void peer_spmm6_wave(int t0, int s, int lane, const unsigned char* V6, const int* sel_e, const float* coef, const bf16* x1, void* xout, int out_f32, LAS unsigned* ldsw) {
    const int cg = lane & 7, sg = lane >> 3;
#pragma unroll
    for (int j = 0; j < 4; ++j) { *(LAS v4u*)(ldsw + 4 * (lane + 64 * j)) = *(const GAS v4u*)(sel_e + (size_t)t0 * 128 + 4 * (lane + 64 * j));
        *(LAS v4u*)(ldsw + 1024 + 4 * (lane + 64 * j)) = *(const GAS v4u*)(coef + (size_t)t0 * 128 + 4 * (lane + 64 * j)); }
    LDS_WAIT();
    const unsigned char* vbase = V6 + (size_t)s * V6_SLICE + cg * 24;
    const LAS unsigned* idl = ldsw + sg * 16; const LAS unsigned* cfl = ldsw + 1024 + sg * 16;
    v4u qa0[8], qa1[8]; v2u qb0[8], qb1[8];
    spmm6_load<MODE>(vbase, idl, qa0, qb0);
    const size_t xoff = (size_t)t0 * 2048 + s * 256 + cg * 32 + 4 * sg;
    v2u xn = *(const GAS v2u*)(x1 + xoff);
#pragma unroll
    for (int k = 0; k < 8; ++k) {
        const v2u xv = xn;
        h2_t y[16];
#pragma unroll
        for (int j = 0; j < 16; ++j) y[j] = (h2_t){(_Float16)0.f, (_Float16)0.f};
        spmm6_load<MODE>(vbase, idl + k * 128 + 8, qa1, qb1);
        if (k < 7) xn = *(const GAS v2u*)(x1 + xoff + (size_t)(k + 1) * 2048);
        spmm6_fma<MODE>(qa0, qb0, cfl + k * 128, y);
        if (k < 7) spmm6_load<MODE>(vbase, idl + (k + 1) * 128, qa0, qb0);
        spmm6_fma<MODE>(qa1, qb1, cfl + k * 128 + 8, y);
        unsigned u[16];
#pragma unroll
        for (int j = 0; j < 16; ++j) u[j] = __builtin_bit_cast(unsigned, y[j]);
#pragma unroll
        for (int i = 0; i < 8; ++i) { const bool up = (lane & 32) != 0; const unsigned snd = up ? u[i] : u[i + 8], kp = up ? u[i + 8] : u[i]; u[i] = __builtin_bit_cast(unsigned, __builtin_bit_cast(h2_t, kp) + __builtin_bit_cast(h2_t, (unsigned)__shfl_xor((int)snd, 32))); }
#pragma unroll
        for (int i = 0; i < 4; ++i) { const bool up = (lane & 16) != 0; const unsigned snd = up ? u[i] : u[i + 4], kp = up ? u[i + 4] : u[i]; u[i] = __builtin_bit_cast(unsigned, __builtin_bit_cast(h2_t, kp) + __builtin_bit_cast(h2_t, (unsigned)__shfl_xor((int)snd, 16))); }
#pragma unroll
        for (int i = 0; i < 2; ++i) { const bool up = (lane & 8) != 0; const unsigned snd = up ? u[i] : u[i + 2], kp = up ? u[i + 2] : u[i]; u[i] = __builtin_bit_cast(unsigned, __builtin_bit_cast(h2_t, kp) + __builtin_bit_cast(h2_t, (unsigned)__shfl_xor((int)snd, 8))); }
        const h2_t r0 = __builtin_bit_cast(h2_t, u[0]), r1 = __builtin_bit_cast(h2_t, u[1]);
        f32x4 o; o.x = bflo(xv.x) + (float)r0[0]; o.y = bfhi(xv.x) + (float)r0[1]; o.z = bflo(xv.y) + (float)r1[0]; o.w = bfhi(xv.y) + (float)r1[1];
        if (out_f32) *(GAS f32x4*)((float*)xout + xoff + (size_t)k * 2048) = o;
        else *(GAS v2u*)((bf16*)xout + xoff + (size_t)k * 2048) = (v2u){pk2c(o.x, o.y), pk2c(o.z, o.w)};
    }
    LDS_WAIT();
}

struct Args { const float* in[21]; float* out; unsigned char* ws; int lo, hi, li, pad; };
__global__ void __launch_bounds__(512, 2) mk_fwd(Args args) {
    extern __shared__ __attribute__((aligned(16))) unsigned char lds_raw[];
    Ctx c; c.lds = (LAS unsigned char*)lds_raw; c.tid = threadIdx.x; c.lane = c.tid & 63; c.wave = __builtin_amdgcn_readfirstlane(c.tid >> 6);
    c.G = gridDim.x; c.gw = blockIdx.x * 8 + c.wave; c.NGW = c.G * 8;
    volatile LAS unsigned* MISC = (volatile LAS unsigned*)(c.lds + MISC_OFF);
    if (c.tid < 32) MISC[c.tid] = 0u;
    __syncthreads();
    unsigned char* ws = args.ws;
    const int lo = args.lo, hi = args.hi;
    XcdBarrier bar; bar.w0 = 0; bar.bar = (unsigned*)(ws + WS_CTL) + CW_BAR + args.li * XCD_BAR_WORDS; bar.x = 0; bar.st = nullptr;
    if (hi - lo > 1) bar = xcd_barrier_post((unsigned*)(ws + WS_CTL) + CW_BAR + args.li * XCD_BAR_WORDS, MISC + 8);
#ifndef ATTN_REPS
#define ATTN_REPS 1
#endif
#ifndef PHMASK
#define PHMASK 0x1fff
#endif
#ifndef REP_PH
#define REP_PH (-1)
#endif
    int rep2 = 2; asm volatile("" : "+s"(rep2));
#define RLOOP(k, cond) for (int rp_ = 0; rp_ < ((((k) == REP_PH) && (cond)) ? rep2 : 1); ++rp_)
#define RSYNC do { if (rp_) xcd_barrier(bar); } while (0)
#define IN(k) (((PHMASK >> ((k) % NPH)) & 1) && lo <= (k) && (k) < hi)
#define SEAM(k) do { if (IN(k) && IN((k) + 1)) xcd_barrier(bar); } while (0)
#define PH_BEGIN unsigned char* w = ws; float* outp = args.out; Ctx cc = c; int zi = 0; cc.lane = xb_lane_id(); cc.tid = cc.wave * 64 + cc.lane; \
    asm volatile("" : "+s"(w), "+s"(outp), "+s"(zi), "+v"(cc.tid), "+v"(cc.lane)); (void)w; (void)outp;
#define INP(k) (args.in[(k) + zi])
#define WSP(T, off) ((T*)(w + (off)))
    for (int l = 0; l < 2; ++l) {
        const int pb = l * NPH;
        if (IN(pb + 0)) { PH_BEGIN
            P0Args a; a.w_in = INP(2) + (size_t)l * DM * INW; a.w_br_sb = INP(11) + (size_t)l * BW * DM; a.w_br_hg = INP(12) + (size_t)l * BW * DM; a.w_br_conv = INP(13) + (size_t)l * BW * DM;
            a.w_o = INP(14) + (size_t)l * DM * DM; a.w_q = INP(16) + (size_t)l * DM * DM; a.u = INP(19) + (size_t)l * 16384 * 2048; a.v = INP(20) + (size_t)l * 16384 * 2048; a.lbp = INP(5);
            a.WinT = WSP(bf16, WS_WIN); a.WbrT = WSP(bf16, WS_WBR); a.WoT = WSP(bf16, WS_WO); a.WqT = WSP(bf16, WS_WQ); a.U = WSP(unsigned char, WS_U); a.V = WSP(unsigned char, WS_V); a.US = WSP(float, WS_US); a.VS = WSP(float, WS_VS); a.LB = WSP(float, WS_LB); a.layer = l; a.k1 = INP(17) + (size_t)l * 8 * 16384; a.k2 = INP(18) + (size_t)l * 8 * 16384; a.KB = WSP(bf16, WS_KEYS);
#ifndef REP_MODE0
#define REP_MODE0 15
#endif
            RLOOP(0, true) { RSYNC;
            int pm_ = 15; if (REP_PH == 0) { pm_ = rp_ ? REP_MODE0 : 15; asm volatile("" : "+s"(pm_)); }
            p0_convert(cc, a, pm_);
            if (pm_ & 8) { if (l == 0) rms_phase_i8(cc, INP(0), INP(1) + (size_t)l * DM, WSP(unsigned char, WS_H), WSP(float, WS_SA));
                           else rms_phase_i8b(cc, WSP(const bf16, WS_X2), INP(1) + (size_t)l * DM, WSP(unsigned char, WS_H), WSP(float, WS_SA)); } }
        }
        SEAM(pb + 0);
        if (IN(pb + 1)) { PH_BEGIN
            RLOOP(1, true) { RSYNC;
            pg8::Gemm g{WSP(bf16, WS_H), WSP(bf16, WS_WIN), NTOK, INW, DM}; pg8::StaticOrder S; S.init(NTOK, INW, cc.G, (int)blockIdx.x);
            EpiIn E{WSP(bf16, WS_SEG), WSP(bf16, WS_GATE), WSP(float, WS_LB), WSP(float, WS_SA)};
            pg8::gemm_phase<EpiIn, pg8::StaticOrder, true, true, true>(cc.lds, g, S, E, cc.wave); }
        }
        SEAM(pb + 1);
        if (IN(pb + 2)) { PH_BEGIN
            bf16* SEG = WSP(bf16, WS_SEG);
#ifndef REP_MODE2
#define REP_MODE2 7
#endif
            RLOOP(2, true) { RSYNC;
            int pm_ = 7; if (REP_PH == 2) { pm_ = rp_ ? REP_MODE2 : 7; asm volatile("" : "+s"(pm_)); }
            if (pm_ & 1)
            conv_phase(cc, SEG + 7 * SEGSZ, INP(7) + (size_t)l * 31 * 1024, INP(8) + (size_t)l * 1024, INP(9) + (size_t)l * 1024, INP(10) + (size_t)l * 1024, WSP(bf16, WS_CONV));
            if (pm_ & 2)
            for (int ci = blockIdx.x, par = 0; ci < 2048; ci += cc.G, par ^= 1) hgA_chunk(cc, ci, ci + cc.G, par, par == 0 && ci == (int)blockIdx.x, SEG + 4 * SEGSZ, SEG + 5 * SEGSZ, WSP(bf16, WS_ST), WSP(float, WS_DEC));
            if (!rp_)
            for (int r = cc.gw; r < 2 * (NTOK / 4); r += cc.NGW) {
                if (r < NTOK / 4) qknorm_rows4(SEG + (size_t)r * 4 * 1024, 1024, INP(3) + (size_t)l * 128, 0.08838834764831845f * 1.4426950408889634f, cc.lane);
                else qknorm_rows4(SEG + SEGSZ + (size_t)(r - NTOK / 4) * 4 * 1024, 1024, INP(4) + (size_t)l * 128, 1.0f, cc.lane);
            }
            LAS unsigned short* scr = (LAS unsigned short*)(cc.lds + 4096 + cc.wave * 8192);
            if (pm_ & 4)
            for (int it = cc.gw; it < 8192; it += cc.NGW) vt_item(it, cc.lane, SEG + 2 * SEGSZ, WSP(bf16, WS_MERGED), scr); }
        }
        SEAM(pb + 2);
        if (IN(pb + 3)) { PH_BEGIN
            bf16* SEG = WSP(bf16, WS_SEG);
            RLOOP(3, true) { RSYNC;
            if (!rp_) hgB(cc, WSP(bf16, WS_ST), WSP(float, WS_DEC));
            for (int p = blockIdx.x; p < 256; p += cc.G) { const int bh = (p & 7) * 4 + (p >> 6), j = (p >> 3) & 7;
                if (cc.wave >= 4) {
#pragma unroll 1
                    for (int u = 0; u < 2; ++u) attn_unit<true>(cc, bh, u ? j : 15 - j, SEG, SEG + SEGSZ, WSP(bf16, WS_MERGED), SEG + 2 * SEGSZ);
                } else {
#pragma unroll 1
                    for (int u = 0; u < 2; ++u) attn_unit<false>(cc, bh, u ? j : 15 - j, SEG, SEG + SEGSZ, WSP(bf16, WS_MERGED), SEG + 2 * SEGSZ);
                } } }
        }
        SEAM(pb + 3);
        if (IN(pb + 4)) { PH_BEGIN
            bf16* SEG = WSP(bf16, WS_SEG);
            RLOOP(4, true) { RSYNC;
            for (int ci = blockIdx.x, par = 0; ci < 2048; ci += cc.G, par ^= 1) hgC_chunk(cc, ci, ci + cc.G, par, par == 0 && ci == (int)blockIdx.x, SEG + 3 * SEGSZ, SEG + 4 * SEGSZ, SEG + 5 * SEGSZ, SEG + 6 * SEGSZ, WSP(bf16, WS_ST), INP(6) + (size_t)l * 128, WSP(bf16, WS_HGR)); }
        }
        SEAM(pb + 4);
        if (IN(pb + 5)) { PH_BEGIN
            RLOOP(5, true) { RSYNC;
            pg8::StaticOrder S; S.init(NTOK, DM, cc.G, (int)blockIdx.x);
            { pg8::Gemm g{WSP(bf16, WS_SEG) + 2 * SEGSZ, WSP(bf16, WS_WBR), NTOK, DM, BW}; EpiMerge<true> E{WSP(unsigned char, WS_GATE), WSP(bf16, WS_MERGED)}; pg8::gemm_phase<EpiMerge<true>, pg8::StaticOrder, true, true>(cc.lds, g, S, E, cc.wave); }
            { pg8::Gemm g{WSP(bf16, WS_HGR), WSP(bf16, WS_WBR) + (size_t)DM * BW, NTOK, DM, BW}; EpiMerge<false> E{WSP(unsigned char, WS_GATE) + (size_t)NTOK * 2048, WSP(bf16, WS_MERGED)}; pg8::gemm_phase<EpiMerge<false>, pg8::StaticOrder, true, true, true>(cc.lds, g, S, E, cc.wave); }
            { pg8::Gemm g{WSP(bf16, WS_CONV), WSP(bf16, WS_WBR) + (size_t)2 * DM * BW, NTOK, DM, BW}; EpiMerge<false> E{WSP(unsigned char, WS_GATE) + (size_t)2 * NTOK * 2048, WSP(bf16, WS_MERGED)}; pg8::gemm_phase<EpiMerge<false>, pg8::StaticOrder, true, true, true>(cc.lds, g, S, E, cc.wave); } }
        }
        SEAM(pb + 5);
        if (IN(pb + 6)) { PH_BEGIN
            RLOOP(6, true) { RSYNC;
            bf16_rows_i8(cc, WSP(bf16, WS_MERGED), WSP(unsigned char, WS_M8), WSP(float, WS_MS));
            xcd_barrier(bar);
            pg8::Gemm g{WSP(bf16, WS_M8), WSP(bf16, WS_WO), NTOK, DM, DM}; pg8::StaticOrder S; S.init(NTOK, DM, cc.G, (int)blockIdx.x);
            EpiResid E{l == 0 ? (const void*)INP(0) : (const void*)WSP(const bf16, WS_X2), WSP(bf16, WS_X1), WSP(float, WS_MS), l};
            pg8::gemm_phase<EpiResid, pg8::StaticOrder, true, true, true>(cc.lds, g, S, E, cc.wave); }
        }
        SEAM(pb + 6);
        if (IN(pb + 7)) { PH_BEGIN RLOOP(7, true) { RSYNC; rms_phase_i8b(cc, WSP(const bf16, WS_X1), INP(15) + (size_t)l * DM, WSP(unsigned char, WS_H), WSP(float, WS_SA)); } }
        SEAM(pb + 7);
        if (IN(pb + 8)) { PH_BEGIN
            RLOOP(8, true) { RSYNC;
            pg8::Gemm g{WSP(bf16, WS_H), WSP(bf16, WS_WQ), NTOK, DM, DM}; pg8::StaticOrder S; S.init(NTOK, DM, cc.G, (int)blockIdx.x);
            EpiStoreBf16 E{WSP(bf16, WS_QPEER), WSP(float, WS_SA)};
            pg8::gemm_phase<EpiStoreBf16, pg8::StaticOrder, true, true, true>(cc.lds, g, S, E, cc.wave); }
        }
        SEAM(pb + 8);
        if (IN(pb + 9)) { PH_BEGIN
            RLOOP(9, true) { RSYNC;
            for (int item = blockIdx.x; item < 512; item += cc.G) { const int hd = item & 7, tg = item >> 3;
                const bf16* KB = WSP(bf16, WS_KEYS); unsigned qo_ = (unsigned)WS_QPEER; asm volatile("" : "+s"(qo_)); const bf16* QP = (const bf16*)(w + qo_);
#pragma unroll
                for (int i = 0; i < 8; ++i) { const int p = cc.tid + 512 * i, li = p >> 11, row = (p >> 4) & 127, c16 = p & 15;
                    *(LAS v4u*)(cc.lds + li * 128 * PK_KS + row * PK_KS + c16 * 16) = *(const GAS v4u*)(KB + (size_t)(li * 8 + hd) * 16384 + row * 128 + c16 * 8); }
                __syncthreads();
                peer_select32(hd, tg * 256 + cc.wave * 32, cc.lane, QP, cc.lds, cc.lds + 128 * PK_KS, w, (LAS unsigned*)(cc.lds + 2 * 128 * PK_KS + cc.wave * 4096));
                __syncthreads(); } }
        }
        SEAM(pb + 9);
        if (IN(pb + 10)) { PH_BEGIN
            const SliceSched SS = slice_sched_init(cc, (unsigned*)(w + WS_CTL), bar, l * 2 + 0);
            RLOOP(10, true) { RSYNC;
            for (int i = 0;; ++i) { int sl, tb; if (!slice_item(SS, cc, i, sl, tb)) break;
                peer_sddmm_wave(tb * 64 + cc.wave * 8, sl, cc.lane, WSP(unsigned char, WS_H), WSP(float, WS_SA), WSP(unsigned char, WS_U), WSP(int, WS_SEL), WSP(float, WS_PART), (LAS unsigned*)(cc.lds + 4096 + cc.wave * 8192)); } }
        }
        SEAM(pb + 10);
        if (IN(pb + 11)) { PH_BEGIN
            for (int n = cc.gw; n < NTOK / 4; n += cc.NGW) peer_coef_tokens4(n, NTOK / 4, cc.lane, WSP(float, WS_PART), WSP(int, WS_SEL), WSP(float, WS_SEL + 8 * MiB), WSP(float, WS_SELS), WSP(float, WS_US), WSP(float, WS_VS));
        }
        SEAM(pb + 11);
        if (IN(pb + 12)) { PH_BEGIN
            void* xo = l == 0 ? (void*)WSP(bf16, WS_X2) : (void*)outp;
            const SliceSched SS = slice_sched_init(cc, (unsigned*)(w + WS_CTL), bar, l * 2 + 1);
            RLOOP(12, l == 0) { RSYNC;
            for (int i = 0;; ++i) { int sl, tb; if (!slice_item8(SS, cc, i, sl, tb)) break;
                peer_spmm6_wave(tb * 64 + cc.wave * 8, sl, cc.lane, WSP(unsigned char, WS_V), WSP(int, WS_SEL), WSP(float, WS_SEL + 8 * MiB), WSP(const bf16, WS_X1), xo, l, (LAS unsigned*)(cc.lds + 4096 + cc.wave * 8192)); } }
        }
        SEAM(pb + 12);
    }
#undef PH_BEGIN
#undef INP
#undef WSP
#undef IN
#undef SEAM
}

#ifndef MK_SPLIT
#define MK_SPLIT 0
#endif
extern "C" void kernel_launch(void* const* d_in, const int* in_sizes, int n_in, void* d_out, int out_size, void* d_ws, size_t ws_size, hipStream_t stream) {
    static int grid = 0;
    if (grid == 0) {
        if (n_in != 21 || out_size != NTOK * DM || ws_size < WS_END) { fprintf(stderr, "kernel_launch: unexpected shapes (n_in %d, out %d, ws %zu < %zu); nothing launched\n", n_in, out_size, ws_size, (size_t)WS_END); grid = -1; return; }
        int dev = 0, cus = 0, per_cu = 0;
        if (hipGetDevice(&dev) != hipSuccess || hipDeviceGetAttribute(&cus, hipDeviceAttributeMultiprocessorCount, dev) != hipSuccess) { grid = -1; return; }
        if (hipFuncSetAttribute((const void*)mk_fwd, hipFuncAttributeMaxDynamicSharedMemorySize, LDS_BYTES) != hipSuccess) { fprintf(stderr, "kernel_launch: hipFuncSetAttribute failed\n"); grid = -1; return; }
        if (hipOccupancyMaxActiveBlocksPerMultiprocessor(&per_cu, (const void*)mk_fwd, 512, LDS_BYTES) != hipSuccess || per_cu < 1) fprintf(stderr, "kernel_launch: occupancy query reports %d\n", per_cu);
        (void)hipGetLastError();
        grid = cus;
    }
    if (grid < 0) return;
    if (hipMemsetAsync((char*)d_ws + WS_CTL, 0, 1 * MiB, stream) != hipSuccess) { fprintf(stderr, "kernel_launch: memset failed\n"); return; }
    Args a{};
    for (int i = 0; i < 21; ++i) a.in[i] = (const float*)d_in[i];
    a.out = (float*)d_out; a.ws = (unsigned char*)d_ws; a.pad = 0;
#if MK_SPLIT
    for (int p = 0; p < NPHASES; ++p) { a.lo = p; a.hi = p + 1; a.li = p; hipLaunchKernelGGL(mk_fwd, dim3(grid), dim3(512), LDS_BYTES, stream, a); }
#else
    a.lo = 0; a.hi = NPHASES; a.li = 0;
    hipLaunchKernelGGL(mk_fwd, dim3(grid), dim3(512), LDS_BYTES, stream, a);
#endif
    const hipError_t le = hipPeekAtLastError();
    if (le != hipSuccess) fprintf(stderr, "kernel_launch: launch failed: %s\n", hipGetErrorName(le));
}
```

```cpp
#include <hip/hip_runtime.h>
#include <cstdio>
#include <cstdint>
namespace pg8 {
#define PG8_LAS __attribute__((address_space(3)))
typedef unsigned short bf16_t;
typedef short bf16x8 __attribute__((ext_vector_type(8)));
typedef float f32x4 __attribute__((ext_vector_type(4)));
typedef unsigned u32x4 __attribute__((ext_vector_type(4)));
constexpr int BM = 256, BK = 64, HALF = 128, HTB = HALF * BK * 2  , STAGE_BYTES = 8 * HTB, NXCD = 8, WGM = 8;

__host__ __device__ __forceinline__ int lds_byte(int r, int c) { const int st = (r >> 4) * 2 + (c >> 5), rr = r & 15, cc = c & 31, ob = rr * 64 + cc * 2; return st * 1024 + (ob ^ (((ob >> 9) & 1) << 5)); }
__host__ __device__ __forceinline__ void stage_rc(int b, int& R, int& C) { const int st = b / 1024, sb = b % 1024, swz = sb ^ (((sb >> 9) & 1) << 5); R = (st >> 1) * 16 + swz / 64; C = (st & 1) * 32 + (swz % 64) / 2; }
__host__ __device__ __forceinline__ int perm32(int rho) { const int n = rho >> 4, i = rho & 15; return 8 * (i >> 2) + 4 * n + (i & 3); }

struct Unit { int pm, pn; };
struct Gemm { const bf16_t* A; const bf16_t* Bt; int M, N, K; };

struct StaticOrder {
    int nM, nN, nwg, G, c;
    __host__ __device__ void init(int M, int N, int G_, int c_) { nM = M / BM; nN = N / BM; nwg = nM * nN; G = G_; c = c_; }
    __host__ __device__ bool next(int i, Unit& u) const {
        const long L = (long)i * G + c; if (L >= nwg) return false;
        int wgid = (int)L; { const int q = nwg / NXCD, r = nwg % NXCD, xcd = wgid % NXCD, off = wgid / NXCD; wgid = (xcd < r ? xcd * (q + 1) : r * (q + 1) + (xcd - r) * q) + off; }
        const int nig = WGM * nN, gid = wgid / nig, fm = gid * WGM, gsz = (nM - fm) < WGM ? (nM - fm) : WGM;
        u.pm = fm + ((wgid % nig) % gsz); u.pn = (wgid % nig) / gsz; return true;
    }
    __device__ __forceinline__ void a_ready(const Unit&) const {}
    __device__ __forceinline__ void done(const Unit&) const {}
};

typedef float f32x2 __attribute__((ext_vector_type(2)));
template <class Epi, class Sched, bool ALIGN_EPI = false, bool SP2 = false, bool I8 = false>
__device__ __forceinline__ void gemm_phase(PG8_LAS unsigned char* lds, const Gemm g, const Sched& S, const Epi& E, int wave_) {
    unsigned z_ = 0u; asm volatile("" : "+s"(z_)); int tid_ = wave_ * 64 + (int)__builtin_amdgcn_mbcnt_hi(~0u, __builtin_amdgcn_mbcnt_lo(~0u, z_)); asm volatile("" : "+v"(tid_));     int K_ = g.K; asm volatile("" : "+s"(K_));
    const int tid = tid_, wid = __builtin_amdgcn_readfirstlane(tid >> 6), lane = tid & 63, wr = wid >> 2, wc = wid & 3, fr = lane & 15, fq = lane >> 4;
    const int K = I8 ? (K_ >> 1) : K_, nt = K / BK;
    unsigned voffA[2], voffB[2];
#pragma unroll
    for (int i = 0; i < 2; ++i) { int R, C; stage_rc(tid * 16 + i * 8192, R, C); const int Rb = Epi::PERM ? ((R & ~31) + perm32(R & 31)) : R;
        voffA[i] = (unsigned)(R * K + C) * 2u; voffB[i] = (unsigned)(Rb * K + C) * 2u; }
    const size_t kstep = (size_t)(BK * 2);
    const size_t hstep = (size_t)HALF * K * 2;
    const size_t tstep = 2 * hstep;
    const unsigned lds_u32_ = (unsigned)(unsigned long long)lds;
    const unsigned ldsw = (unsigned)wid * 1024u;
    const int aoff = lds_byte(wr * 64 + fr, fq * 8), boff = lds_byte(wc * 32 + fr, fq * 8);
#define PG8_SA(b, h) (((b) * 2 + (h)) * HTB)
#define PG8_SB(b, h) ((4 + (b) * 2 + (h)) * HTB)
#define PG8_STAGE(bufoff, gbase, voff) do { _Pragma("unroll") for (int _i = 0; _i < 2; ++_i) { \
        const unsigned m0v_ = lds_u32_ + (unsigned)(bufoff) + ldsw + (unsigned)_i * 8192u; const char* gb_ = (const char*)(gbase); \
        asm volatile("s_mov_b32 m0, %0\n\ts_nop 0\n\tglobal_load_lds_dwordx4 %1, %2" :: "s"(m0v_), "v"((voff)[_i]), "s"(gb_) : "memory", "m0"); } } while (0)
#define PG8_LDA(dst, b, h) do { _Pragma("unroll") for (int m = 0; m < 4; ++m) _Pragma("unroll") for (int k = 0; k < 2; ++k) dst[m][k] = *(const PG8_LAS bf16x8*)(lds + PG8_SA(b, h) + aoff + m * 2048 + k * 1024); } while (0)
#define PG8_LDB(dst, b, h) do { _Pragma("unroll") for (int n = 0; n < 2; ++n) _Pragma("unroll") for (int k = 0; k < 2; ++k) dst[n][k] = *(const PG8_LAS bf16x8*)(lds + PG8_SB(b, h) + boff + n * 2048 + k * 1024); } while (0)
#define PG8_MMA(ai, bj, At, Bt) do { __builtin_amdgcn_s_setprio(1); _Pragma("unroll") for (int m = 0; m < 4; ++m) _Pragma("unroll") for (int n = 0; n < 2; ++n) _Pragma("unroll") for (int k = 0; k < 2; ++k) { \
        if constexpr (I8) { typedef int v4i_t __attribute__((ext_vector_type(4))); \
            acc[ai][bj][m][n] = __builtin_bit_cast(f32x4, __builtin_amdgcn_mfma_i32_16x16x64_i8(__builtin_bit_cast(v4i_t, Bt[n][k]), __builtin_bit_cast(v4i_t, At[m][k]), __builtin_bit_cast(v4i_t, acc[ai][bj][m][n]), 0, 0, 0)); } \
        else acc[ai][bj][m][n] = __builtin_amdgcn_mfma_f32_16x16x32_bf16(Bt[n][k], At[m][k], acc[ai][bj][m][n], 0, 0, 0); } __builtin_amdgcn_s_setprio(0); } while (0)
#define PG8_WAIT_V(n) asm volatile("s_waitcnt vmcnt(" #n ")" ::: "memory")
#define PG8_WAIT_L(n) asm volatile("s_waitcnt lgkmcnt(" #n ")" ::: "memory")
#define PG8_BAR __builtin_amdgcn_s_barrier()
#define PG8_SCHED __builtin_amdgcn_sched_barrier(0)
    Unit cur, nxt; int ui = 0;
    if (!S.next(0, cur)) return;
    cur.pm = __builtin_amdgcn_readfirstlane(cur.pm); cur.pn = __builtin_amdgcn_readfirstlane(cur.pn);
    f32x4 acc[2][2][4][2];
#pragma unroll
    for (int a = 0; a < 2; ++a)
#pragma unroll
        for (int b = 0; b < 2; ++b)
#pragma unroll
            for (int m = 0; m < 4; ++m)
#pragma unroll
                for (int n = 0; n < 2; ++n) acc[a][b][m][n] = (f32x4){0.f, 0.f, 0.f, 0.f};
    bf16x8 At[4][2], B0[2][2], B1[2][2];
    const char* gA_; const char* gB_;
    { const unsigned long long a_ = (unsigned long long)g.A, b_ = (unsigned long long)g.Bt;
      gA_ = (const char*)(((unsigned long long)(unsigned)__builtin_amdgcn_readfirstlane((int)(a_ >> 32)) << 32) | (unsigned)__builtin_amdgcn_readfirstlane((int)a_));
      gB_ = (const char*)(((unsigned long long)(unsigned)__builtin_amdgcn_readfirstlane((int)(b_ >> 32)) << 32) | (unsigned)__builtin_amdgcn_readfirstlane((int)b_)); }
    const char* cA = gA_ + (size_t)cur.pm * tstep; const char* cB = gB_ + (size_t)cur.pn * tstep;
    S.a_ready(cur);
    if constexpr (SP2) {
        PG8_STAGE(PG8_SB(0, 0), cB, voffB); PG8_STAGE(PG8_SB(0, 1), cB + hstep, voffB); PG8_STAGE(PG8_SA(0, 0), cA, voffA); PG8_STAGE(PG8_SA(0, 1), cA + hstep, voffA);
        if (wr == 1) PG8_BAR;
        PG8_WAIT_V(2); PG8_BAR;
        PG8_STAGE(PG8_SB(1, 0), cB + kstep, voffB); PG8_STAGE(PG8_SA(1, 0), cA + kstep, voffA); PG8_STAGE(PG8_SB(1, 1), cB + hstep + kstep, voffB);
        PG8_WAIT_V(6); PG8_BAR;
    } else {
        PG8_STAGE(PG8_SB(0, 0), cB, voffB); PG8_STAGE(PG8_SA(0, 0), cA, voffA); PG8_STAGE(PG8_SB(0, 1), cB + hstep, voffB); PG8_STAGE(PG8_SA(0, 1), cA + hstep, voffA);
        if (wr == 1) PG8_BAR;
        PG8_WAIT_V(4); PG8_BAR;
        PG8_STAGE(PG8_SB(1, 0), cB + kstep, voffB); PG8_STAGE(PG8_SA(1, 0), cA + kstep, voffA); PG8_STAGE(PG8_SB(1, 1), cB + hstep + kstep, voffB);
        PG8_WAIT_V(6); PG8_BAR;
    }
    for (;;) {
        const bool has_next = S.next(ui + 1, nxt);
        nxt.pm = __builtin_amdgcn_readfirstlane(nxt.pm); nxt.pn = __builtin_amdgcn_readfirstlane(nxt.pn);
        const char* nA = has_next ? gA_ + (size_t)nxt.pm * tstep : cA; const char* nB = has_next ? gB_ + (size_t)nxt.pn * tstep : cB;
        for (int t = 0; t < nt; t += 2) {
            const bool last = (t == nt - 2);
            const char* a1 = cA + (size_t)(t + 1) * kstep;
            const char* a2 = last ? nA : cA + (size_t)(t + 2) * kstep; const char* b2 = last ? nB : cB + (size_t)(t + 2) * kstep;
            const char* a3 = a2 + kstep; const char* b3 = b2 + kstep;
            if (last && has_next) S.a_ready(nxt);
            if constexpr (SP2) {
            PG8_LDB(B0, 0, 0); PG8_LDB(B1, 0, 1); PG8_SCHED; PG8_LDA(At, 0, 0); PG8_STAGE(PG8_SA(1, 1), a1 + hstep, voffA);
            PG8_WAIT_V(8); PG8_WAIT_L(0); PG8_BAR; PG8_MMA(0, 0, At, B0); PG8_MMA(0, 1, At, B1); PG8_BAR; PG8_SCHED;
            PG8_LDA(At, 0, 1); PG8_STAGE(PG8_SB(0, 0), b2, voffB); PG8_STAGE(PG8_SB(0, 1), b2 + hstep, voffB); PG8_STAGE(PG8_SA(0, 0), a2, voffA);
            PG8_WAIT_V(8); PG8_WAIT_L(0); PG8_BAR; PG8_MMA(1, 0, At, B0); PG8_MMA(1, 1, At, B1); PG8_BAR; PG8_SCHED;
            PG8_LDB(B0, 1, 0); PG8_LDB(B1, 1, 1); PG8_SCHED; PG8_LDA(At, 1, 0); PG8_STAGE(PG8_SA(0, 1), a2 + hstep, voffA);
            PG8_WAIT_V(8); PG8_WAIT_L(0); PG8_BAR; PG8_MMA(0, 0, At, B0); PG8_MMA(0, 1, At, B1); PG8_BAR; PG8_SCHED;
            PG8_LDA(At, 1, 1); PG8_STAGE(PG8_SB(1, 0), b3, voffB); PG8_STAGE(PG8_SB(1, 1), b3 + hstep, voffB); PG8_STAGE(PG8_SA(1, 0), a3, voffA);
            PG8_WAIT_V(8); PG8_WAIT_L(0); PG8_BAR; PG8_MMA(1, 0, At, B0); PG8_MMA(1, 1, At, B1); PG8_BAR; PG8_SCHED;
            } else {
            PG8_LDB(B0, 0, 0); PG8_SCHED; PG8_LDA(At, 0, 0); PG8_STAGE(PG8_SA(1, 1), a1 + hstep, voffA);
            PG8_WAIT_L(8); PG8_BAR; PG8_WAIT_L(0); PG8_MMA(0, 0, At, B0); PG8_BAR; PG8_SCHED;
            PG8_LDB(B1, 0, 1); PG8_STAGE(PG8_SB(0, 0), b2, voffB);
            PG8_BAR; PG8_WAIT_L(0); PG8_MMA(0, 1, At, B1); PG8_BAR;
            PG8_LDA(At, 0, 1); PG8_STAGE(PG8_SA(0, 0), a2, voffA);
            PG8_BAR; PG8_WAIT_L(0); PG8_MMA(1, 0, At, B0); PG8_BAR; PG8_SCHED;
            PG8_STAGE(PG8_SB(0, 1), b2 + hstep, voffB);
            PG8_WAIT_V(6); PG8_BAR; PG8_MMA(1, 1, At, B1); PG8_BAR;
            PG8_LDB(B0, 1, 0); PG8_SCHED; PG8_LDA(At, 1, 0); PG8_STAGE(PG8_SA(0, 1), a2 + hstep, voffA);
            PG8_WAIT_L(8); PG8_BAR; PG8_WAIT_L(0); PG8_MMA(0, 0, At, B0); PG8_BAR; PG8_SCHED;
            PG8_LDB(B1, 1, 1); PG8_STAGE(PG8_SB(1, 0), b3, voffB);
            PG8_BAR; PG8_WAIT_L(0); PG8_MMA(0, 1, At, B1); PG8_BAR;
            PG8_LDA(At, 1, 1); PG8_STAGE(PG8_SA(1, 0), a3, voffA);
            PG8_BAR; PG8_WAIT_L(0); PG8_MMA(1, 0, At, B0); PG8_BAR; PG8_SCHED;
            PG8_STAGE(PG8_SB(1, 1), b3 + hstep, voffB);
            PG8_WAIT_V(6); PG8_BAR; PG8_MMA(1, 1, At, B1); PG8_BAR;
            }
        }
        if constexpr (ALIGN_EPI) { if (wr == 0) PG8_BAR; }
        if constexpr (I8) {
#pragma unroll
            for (int a = 0; a < 2; ++a)
#pragma unroll
                for (int m = 0; m < 4; ++m) { const float r_ = E.rowscale(cur.pm * BM + wr * 64 + fr + a * HALF + m * 16);
#pragma unroll
                    for (int b = 0; b < 2; ++b)
#pragma unroll
                        for (int n = 0; n < 2; ++n) { typedef int v4i2_t __attribute__((ext_vector_type(4))); const v4i2_t i_ = __builtin_bit_cast(v4i2_t, acc[a][b][m][n]);
                            acc[a][b][m][n] = (f32x4){(float)i_[0] * r_, (float)i_[1] * r_, (float)i_[2] * r_, (float)i_[3] * r_}; } }
        }
        if constexpr (!Epi::AFTER_DRAIN) { E(acc, cur, wr, wc, fr, fq); S.done(cur); }
        if (!has_next) break;
#pragma unroll
        for (int a = 0; a < 2; ++a)
#pragma unroll
            for (int b = 0; b < 2; ++b)
#pragma unroll
                for (int m = 0; m < 4; ++m)
#pragma unroll
                    for (int n = 0; n < 2; ++n) acc[a][b][m][n] = (f32x4){0.f, 0.f, 0.f, 0.f};
        cur = nxt; cA = nA; cB = nB; ++ui;
        if constexpr (ALIGN_EPI) { if (wr == 1) PG8_BAR; }
    }
    PG8_WAIT_V(0);
    if constexpr (!ALIGN_EPI) { if (wr == 0) PG8_BAR; }
    PG8_BAR;
    if constexpr (Epi::AFTER_DRAIN) { E.fused(acc, cur, wr, wc, fr, fq, lds, wid, lane); S.done(cur); }
#undef PG8_SA
#undef PG8_SB
#undef PG8_STAGE
#undef PG8_LDA
#undef PG8_LDB
#undef PG8_MMA
#undef PG8_WAIT_V
#undef PG8_WAIT_L
#undef PG8_BAR
#undef PG8_SCHED
}
}
#define XB_TMO      128
#define XB_XCNT(j)  (256  + 64 * (j))
#define XB_XSUB(j)  (1280 + 64 * (j))
#define XB_XGEN(j)  (2304 + 64 * (j))
#define XB_TOP      3328
#define XB_TOPGEN   3392
#define XCD_BAR_WORDS 3456
#define XB_SPIN_CAP (1u << 24)
#define LAS __attribute__((address_space(3)))

__device__ __forceinline__ unsigned xb_ld(unsigned* p)              { return __hip_atomic_load(p, __ATOMIC_RELAXED, __HIP_MEMORY_SCOPE_AGENT); }
__device__ __forceinline__ unsigned xb_add(unsigned* p, unsigned v) { return __hip_atomic_fetch_add(p, v, __ATOMIC_RELAXED, __HIP_MEMORY_SCOPE_AGENT); }
__device__ __forceinline__ unsigned xb_xcc_id() { return (unsigned)__builtin_amdgcn_s_getreg((3 << 11) | 20) & 0xFu; }
#define XB_SPIN(cond, bar) do { unsigned _sp = 0; while (cond) { __builtin_amdgcn_s_sleep(1); \
    if ((++_sp & 255u) == 0u) { if (xb_ld(&(bar)[XB_TMO])) break; if (_sp > XB_SPIN_CAP) { atomicAdd(&(bar)[XB_TMO], 1u); break; } } } } while (0)

__device__ __forceinline__ int xb_lane_id() { unsigned z = 0u; asm volatile("" : "+s"(z)); return (int)__builtin_amdgcn_mbcnt_hi(~0u, __builtin_amdgcn_mbcnt_lo(~0u, z)); }
struct XcdBarrier {
    unsigned w0;
    unsigned* bar; unsigned x;
    volatile LAS unsigned* st;
};

__device__ __forceinline__ XcdBarrier xcd_barrier_post(unsigned* bar, volatile LAS unsigned* st) {
    XcdBarrier b; b.bar = bar; b.x = xb_xcc_id(); b.st = st; b.w0 = (__builtin_amdgcn_readfirstlane((int)threadIdx.x >> 6) == 0) ? 1u : 0u;
    if (b.w0 && xb_lane_id() == 0) (void)xb_add(&bar[XB_XCNT(b.x)], 1u);
    return b;
}
__device__ __forceinline__ void xcd_barrier_complete(unsigned* bar, unsigned x, unsigned& nloc, unsigned& nx) {
    const unsigned G = gridDim.x * gridDim.y * gridDim.z;
    unsigned sum, cnt, mine, sp = 0u;
    for (;;) {
        sum = 0u; cnt = 0u; mine = 0u;
#pragma unroll
        for (unsigned j = 0; j < 16; ++j) { const unsigned c = xb_ld(&bar[XB_XCNT(j)]); sum += c; cnt += (c > 0u) ? 1u : 0u; mine = (j == x) ? c : mine; }
        if (sum == G) break;
        __builtin_amdgcn_s_sleep(1);
        if ((++sp & 255u) == 0u) { if (xb_ld(&bar[XB_TMO])) break; if (sp > XB_SPIN_CAP) { atomicAdd(&bar[XB_TMO], 1u); break; } }
    }
    nloc = mine > 0u ? mine : 1u; nx = cnt > 0u ? cnt : 1u;
}

__device__ __forceinline__ void xcd_barrier(const XcdBarrier& b) {
    asm volatile("s_waitcnt vmcnt(0)" ::: "memory");
    __syncthreads();
    if (b.w0 && xb_lane_id() == 0) {
        unsigned* bar = b.bar;
        __builtin_amdgcn_s_waitcnt(0);
        unsigned nloc = b.st[0], nx = b.st[1];
        if (nloc == 0u) { xcd_barrier_complete(bar, b.x, nloc, nx); b.st[0] = nloc; b.st[1] = nx; }
        const unsigned old = xb_add(&bar[XB_XSUB(b.x)], 1u);
        const unsigned gen = old / nloc;
        if (old + 1u == (gen + 1u) * nloc) {
            __builtin_amdgcn_fence(__ATOMIC_RELEASE, "agent");
            asm volatile("s_waitcnt vmcnt(0)" ::: "memory");
            const unsigned og = xb_add(&bar[XB_TOP], 1u);
            const unsigned tg = og / nx;
            if (og + 1u == (tg + 1u) * nx) xb_add(&bar[XB_TOPGEN], 1u);
            else XB_SPIN(xb_ld(&bar[XB_TOPGEN]) == tg, bar);
            __builtin_amdgcn_fence(__ATOMIC_ACQUIRE, "agent");
            xb_add(&bar[XB_XGEN(b.x)], 1u);
            asm volatile("s_waitcnt vmcnt(0)" ::: "memory");
        } else {
            XB_SPIN(xb_ld(&bar[XB_XGEN(b.x)]) == gen, bar);
            __builtin_amdgcn_fence(__ATOMIC_ACQUIRE, "agent");
            asm volatile("s_waitcnt vmcnt(0)" ::: "memory");
        }
    }
    __syncthreads();
}


#define GAS __attribute__((address_space(1)))
typedef unsigned short bf16;
typedef unsigned v4u __attribute__((ext_vector_type(4)));
typedef unsigned v2u __attribute__((ext_vector_type(2)));
typedef float f32x4 __attribute__((ext_vector_type(4)));
typedef float f32x2v __attribute__((ext_vector_type(2)));
typedef float f32x16 __attribute__((ext_vector_type(16)));
typedef short bf16x8 __attribute__((ext_vector_type(8)));
typedef __bf16 bf16v2 __attribute__((ext_vector_type(2)));
typedef _Float16 h2_t __attribute__((ext_vector_type(2)));
typedef _Float16 v32h_t __attribute__((ext_vector_type(32)));
typedef unsigned v6u __attribute__((ext_vector_type(6)));

constexpr int NTOK = 16384, DM = 2048, SEQ = 4096, INW = 15360, BW = 1024;
constexpr float EPS = 1e-6f;
constexpr float WBR_QS = 768.0f;
constexpr float ACT_QS = 127.0f / 6.0f;
constexpr float WIN_QS = 1024.0f;
constexpr int NPH = 13;
constexpr int NPHASES = 2 * NPH;

constexpr size_t MiB = 1u << 20;
constexpr size_t WS_CTL = 0;
constexpr size_t WS_LB = 1 * MiB;
constexpr size_t WS_SA = 1 * MiB + 192 * 1024;
constexpr size_t WS_US = 1 * MiB + 64 * 1024, WS_VS = 1 * MiB + 128 * 1024;
constexpr size_t WS_WIN = 2 * MiB;
constexpr size_t WS_MS = 1 * MiB + 256 * 1024;
constexpr size_t WS_M8 = 859 * MiB;
constexpr size_t WS_WBR = 62 * MiB;
constexpr size_t WS_WO = 74 * MiB;
constexpr size_t WS_WQ = 82 * MiB;
constexpr size_t WS_U = 91 * MiB;
constexpr size_t WS_V = 155 * MiB;
constexpr size_t WS_H = 219 * MiB;
constexpr size_t WS_SEG = 283 * MiB;
constexpr size_t WS_GATE = 539 * MiB;
constexpr size_t WS_X2 = 731 * MiB;
constexpr size_t WS_X1 = 795 * MiB;
constexpr size_t WS_CONV = 859 * MiB;
constexpr size_t WS_HGR = 891 * MiB;
constexpr size_t WS_MERGED = 923 * MiB;
constexpr size_t WS_SEL = 987 * MiB;
constexpr size_t WS_SELS = 1003 * MiB;
constexpr size_t WS_DEC = 1004 * MiB;
constexpr size_t WS_END = 1005 * MiB;
constexpr size_t WS_ST = WS_H;
constexpr size_t WS_KEYS = 90 * MiB;
constexpr size_t WS_PART = WS_GATE;
constexpr size_t WS_QPEER = WS_SEG;
constexpr size_t SEGSZ = (size_t)NTOK * 1024;
constexpr int CW_BAR = 4096;
constexpr int CW_RANK = 131072;

constexpr int RING_BYTES = 131072, MISC_OFF = RING_BYTES + 320, LDS_BYTES = 147456;

__device__ __forceinline__ unsigned pk2c(float lo, float hi) { f32x2v v = {lo, hi}; bf16v2 b = __builtin_convertvector(v, bf16v2); return __builtin_bit_cast(unsigned, b); }
__device__ __forceinline__ float bflo(unsigned x) { return __uint_as_float(x << 16); }
__device__ __forceinline__ float bfhi(unsigned x) { return __uint_as_float(x & 0xffff0000u); }
__device__ __forceinline__ float sigm(float x) { return __builtin_amdgcn_rcpf(1.0f + __expf(-x)); }
__device__ __forceinline__ float wave_sum(float v) {
#pragma unroll
    for (int o = 1; o < 64; o <<= 1) v += __shfl_xor(v, o);
    return v;
}
__device__ __forceinline__ float wave_max(float v) {
#pragma unroll
    for (int o = 1; o < 64; o <<= 1) v = fmaxf(v, __shfl_xor(v, o));
    return v;
}
#define LDS_WAIT() asm volatile("s_waitcnt lgkmcnt(0)" ::: "memory")
#define MFMA32(a, b, c) __builtin_amdgcn_mfma_f32_32x32x16_bf16((a), (b), (c), 0, 0, 0)
typedef unsigned v2u_sw __attribute__((ext_vector_type(2)));
__device__ __forceinline__ float xsum32(float a, float b) { const auto r = __builtin_amdgcn_permlane32_swap(__float_as_uint(a), __float_as_uint(b), false, false); return __uint_as_float(r[0]) + __uint_as_float(r[1]); }
__device__ __forceinline__ float xsum16(float a, float b) { const auto r = __builtin_amdgcn_permlane16_swap(__float_as_uint(a), __float_as_uint(b), false, false); return __uint_as_float(r[0]) + __uint_as_float(r[1]); }
__device__ __forceinline__ float xor32f(float x, int hf) { const auto r = __builtin_amdgcn_permlane32_swap(__float_as_uint(x), __float_as_uint(x), false, false); return __uint_as_float(hf ? r[0] : r[1]); }
__device__ __forceinline__ int ridx16(int lane) { return ((lane >> 5) & 1) * 8 + ((lane >> 4) & 1) * 4 + ((lane >> 3) & 1) * 2 + ((lane >> 2) & 1); }
__device__ __forceinline__ void xreduce16(float (&v)[16], int lane) {
#pragma unroll
    for (int i = 0; i < 8; ++i) v[i] = xsum32(v[i], v[i + 8]);
#pragma unroll
    for (int i = 0; i < 4; ++i) v[i] = xsum16(v[i], v[i + 4]);
#pragma unroll
    for (int i = 0; i < 2; ++i) { const bool up = (lane & 8) != 0; const float snd = up ? v[i] : v[i + 2], kp = up ? v[i + 2] : v[i]; v[i] = kp + __shfl_xor(snd, 8); }
    { const bool up = (lane & 4) != 0; const float snd = up ? v[0] : v[1], kp = up ? v[1] : v[0]; v[0] = kp + __shfl_xor(snd, 4); }
    v[0] += __shfl_xor(v[0], 2); v[0] += __shfl_xor(v[0], 1);
}
__device__ __forceinline__ float gelu_exact(float v) {
    const float av = fabsf(v), t = __builtin_amdgcn_rcpf(av * 0.2316418882f + 1.0f);
    float q = t * 0.5307027145f + (-0.7265760135f); q = q * t + 0.7107068705f; q = q * t + (-0.142248368f); q = q * t + 0.127414796f; q = q * t;
    const float e = __builtin_amdgcn_exp2f((v * v) * (-0.72134752044f));
    const float m = v * (q * e);
    return v < 0.f ? m : v - m;
}

struct Ctx { LAS unsigned char* lds; int tid, lane, wave, G, gw, NGW; };

__device__ __forceinline__ void tr_item(const float* W, int K, int N, bf16* WT, int k0, int n0, int drow0, LAS float* scr, int lane) {
    { const int lr = lane >> 3, lc = (lane & 7) * 4; f32x4 v[8];
#pragma unroll
      for (int j = 0; j < 8; ++j) v[j] = *(const GAS f32x4*)(W + (size_t)(k0 + lr + 8 * j) * N + n0 + lc);
#pragma unroll
      for (int j = 0; j < 8; ++j) { LAS float* d = scr + (lr + 8 * j) * 33 + lc; d[0] = v[j].x; d[1] = v[j].y; d[2] = v[j].z; d[3] = v[j].w; } }
    LDS_WAIT();
    const int c = lane & 7;
#pragma unroll
    for (int j = 0; j < 4; ++j) { const int n = (lane >> 3) + 8 * j; const LAS float* s = scr + (8 * c) * 33 + n;
        v4u o; o.x = pk2c(s[0], s[33]); o.y = pk2c(s[66], s[99]); o.z = pk2c(s[132], s[165]); o.w = pk2c(s[198], s[231]);
        *(GAS v4u*)(WT + (size_t)(drow0 + n) * K + k0 + 8 * c) = o; }
    LDS_WAIT();
}
__device__ __forceinline__ unsigned pack_i8x4c(float a, float b, float c, float d) {
    const int ia = (int)__builtin_rintf(fminf(fmaxf(a, -127.f), 127.f)), ib = (int)__builtin_rintf(fminf(fmaxf(b, -127.f), 127.f)), ic = (int)__builtin_rintf(fminf(fmaxf(c, -127.f), 127.f)), id = (int)__builtin_rintf(fminf(fmaxf(d, -127.f), 127.f));
    return ((unsigned)ia & 255u) | (((unsigned)ib & 255u) << 8) | (((unsigned)ic & 255u) << 16) | ((unsigned)id << 24);
}
__device__ __forceinline__ void tr_item_i8(const float* W, int K, int N, unsigned char* WT, int k0, int n0, int drow0, float scale, LAS float* scr, int lane) {
    { const int lr = lane >> 3, lc = (lane & 7) * 4; f32x4 v[16];
#pragma unroll
      for (int j = 0; j < 16; ++j) v[j] = *(const GAS f32x4*)(W + (size_t)(k0 + lr + 8 * j) * N + n0 + lc);
#pragma unroll
      for (int j = 0; j < 16; ++j) { LAS float* d = scr + (lr + 8 * j) * 32 + (lc ^ ((j & 7) << 2)); const int x = lr & 3; d[x] = v[j].x; d[1 ^ x] = v[j].y; d[2 ^ x] = v[j].z; d[3 ^ x] = v[j].w; } }
    LDS_WAIT();
    const int c = lane & 15;
#pragma unroll
    for (int j = 0; j < 8; ++j) { const int n = (lane >> 4) + 4 * j, q = n ^ ((c & 7) << 2); const LAS float* s = scr + (8 * c) * 32;
        v2u o; o.x = pack_i8x4c(s[q] * scale, s[32 + (q ^ 1)] * scale, s[64 + (q ^ 2)] * scale, s[96 + (q ^ 3)] * scale); o.y = pack_i8x4c(s[128 + q] * scale, s[160 + (q ^ 1)] * scale, s[192 + (q ^ 2)] * scale, s[224 + (q ^ 3)] * scale);
        *(GAS v2u*)(WT + (size_t)(drow0 + n) * K + k0 + 8 * c) = o; }
    LDS_WAIT();
}
__device__ __forceinline__ int win_drow(int n) { if (n < 7168 || n >= 9216) return n; const int r = n - 7168, isb = r >> 10, c = r & 1023; return 7168 + (c >> 7) * 256 + isb * 128 + (c & 127); }
__device__ __forceinline__ void cvt_copy(const Ctx& c, const float* src, bf16* dst, size_t n8) {
    const size_t NT = (size_t)c.G * 512;
    for (size_t i = (size_t)blockIdx.x * 512 + c.tid; i < n8; i += NT) {
        const f32x4 a = ((const GAS f32x4*)src)[2 * i], b = ((const GAS f32x4*)src)[2 * i + 1];
        v4u o; o.x = pk2c(a.x, a.y); o.y = pk2c(a.z, a.w); o.z = pk2c(b.x, b.y); o.w = pk2c(b.z, b.w);
        ((GAS v4u*)dst)[i] = o;
    }
}
__device__ __forceinline__ void rms_row(const float* xr, const float* w, bf16* o, int lane) {
    const GAS f32x4* xp = (const GAS f32x4*)xr + lane; f32x4 v[8]; float s = 0.f;
#pragma unroll
    for (int j = 0; j < 8; ++j) { v[j] = xp[64 * j]; s += (v[j].x * v[j].x + v[j].y * v[j].y) + (v[j].z * v[j].z + v[j].w * v[j].w); }
    const float r = __builtin_amdgcn_rsqf(wave_sum(s) * (1.0f / DM) + EPS);
    const GAS f32x4* wp = (const GAS f32x4*)w + lane; GAS v2u* op = (GAS v2u*)o + lane;
#pragma unroll
    for (int j = 0; j < 8; ++j) { const f32x4 wv = wp[64 * j]; v2u q; q.x = pk2c(v[j].x * r * wv.x, v[j].y * r * wv.y); q.y = pk2c(v[j].z * r * wv.z, v[j].w * r * wv.w); op[64 * j] = q; }
}
__device__ __forceinline__ void rms_row_i8(const float* xr, const float* w, unsigned char* o, float* sa, int lane) {
    const GAS f32x4* xp = (const GAS f32x4*)xr + lane; f32x4 v[8]; float s = 0.f;
#pragma unroll
    for (int j = 0; j < 8; ++j) { v[j] = xp[64 * j]; s += (v[j].x * v[j].x + v[j].y * v[j].y) + (v[j].z * v[j].z + v[j].w * v[j].w); }
    const float r = __builtin_amdgcn_rsqf(wave_sum(s) * (1.0f / DM) + EPS);
    const GAS f32x4* wp = (const GAS f32x4*)w + lane; float m = 0.f;
#pragma unroll
    for (int j = 0; j < 8; ++j) { const f32x4 wv = wp[64 * j]; v[j].x *= r * wv.x; v[j].y *= r * wv.y; v[j].z *= r * wv.z; v[j].w *= r * wv.w;
        m = fmaxf(fmaxf(m, fmaxf(fabsf(v[j].x), fabsf(v[j].y))), fmaxf(fabsf(v[j].z), fabsf(v[j].w))); }
    m = wave_max(m);
    const float inv = m > 0.f ? 127.0f / m : 0.f;
    if (lane == 0) *(GAS float*)sa = m * (1.0f / 127.0f);
#pragma unroll
    for (int j = 0; j < 8; ++j) ((GAS unsigned*)o)[lane + 64 * j] = pack_i8x4c(v[j].x * inv, v[j].y * inv, v[j].z * inv, v[j].w * inv);
}
__device__ __forceinline__ void rms_rows2_i8(const float* xa, const float* xb, const float* w, unsigned char* oa, unsigned char* ob, float* saa, float* sab, int lane) {
    const GAS f32x4* pa = (const GAS f32x4*)xa + lane; const GAS f32x4* pb = (const GAS f32x4*)xb + lane; f32x4 va[8], vb[8]; float s0 = 0.f, s1 = 0.f;
#pragma unroll
    for (int j = 0; j < 8; ++j) { va[j] = pa[64 * j]; vb[j] = pb[64 * j]; }
#pragma unroll
    for (int j = 0; j < 8; ++j) { s0 += (va[j].x * va[j].x + va[j].y * va[j].y) + (va[j].z * va[j].z + va[j].w * va[j].w); s1 += (vb[j].x * vb[j].x + vb[j].y * vb[j].y) + (vb[j].z * vb[j].z + vb[j].w * vb[j].w); }
#pragma unroll
    for (int o = 1; o < 64; o <<= 1) { s0 += __shfl_xor(s0, o); s1 += __shfl_xor(s1, o); }
    const float r0 = __builtin_amdgcn_rsqf(s0 * (1.0f / DM) + EPS), r1 = __builtin_amdgcn_rsqf(s1 * (1.0f / DM) + EPS);
    const GAS f32x4* wp = (const GAS f32x4*)w + lane; float m0 = 0.f, m1 = 0.f;
#pragma unroll
    for (int j = 0; j < 8; ++j) { const f32x4 wv = wp[64 * j];
        va[j].x *= r0 * wv.x; va[j].y *= r0 * wv.y; va[j].z *= r0 * wv.z; va[j].w *= r0 * wv.w; vb[j].x *= r1 * wv.x; vb[j].y *= r1 * wv.y; vb[j].z *= r1 * wv.z; vb[j].w *= r1 * wv.w;
        m0 = fmaxf(fmaxf(m0, fmaxf(fabsf(va[j].x), fabsf(va[j].y))), fmaxf(fabsf(va[j].z), fabsf(va[j].w))); m1 = fmaxf(fmaxf(m1, fmaxf(fabsf(vb[j].x), fabsf(vb[j].y))), fmaxf(fabsf(vb[j].z), fabsf(vb[j].w))); }
#pragma unroll
    for (int o = 1; o < 64; o <<= 1) { m0 = fmaxf(m0, __shfl_xor(m0, o)); m1 = fmaxf(m1, __shfl_xor(m1, o)); }
    const float i0 = m0 > 0.f ? 127.0f / m0 : 0.f, i1 = m1 > 0.f ? 127.0f / m1 : 0.f;
    if (lane == 0) { *(GAS float*)saa = m0 * (1.0f / 127.0f); *(GAS float*)sab = m1 * (1.0f / 127.0f); }
#pragma unroll
    for (int j = 0; j < 8; ++j) { ((GAS unsigned*)oa)[lane + 64 * j] = pack_i8x4c(va[j].x * i0, va[j].y * i0, va[j].z * i0, va[j].w * i0); ((GAS unsigned*)ob)[lane + 64 * j] = pack_i8x4c(vb[j].x * i1, vb[j].y * i1, vb[j].z * i1, vb[j].w * i1); }
}
__device__ __forceinline__ void rms_rows2_i8b(const bf16* xa, const bf16* xb, const float* w, unsigned char* oa, unsigned char* ob, float* saa, float* sab, int lane) {
    v4u qa[4], qb[4]; float va[4][8], vb[4][8], s0 = 0.f, s1 = 0.f;
#pragma unroll
    for (int j = 0; j < 4; ++j) { qa[j] = *(const GAS v4u*)(xa + 8 * (lane + 64 * j)); qb[j] = *(const GAS v4u*)(xb + 8 * (lane + 64 * j)); }
#pragma unroll
    for (int j = 0; j < 4; ++j) { const unsigned a[4] = {qa[j].x, qa[j].y, qa[j].z, qa[j].w}, b[4] = {qb[j].x, qb[j].y, qb[j].z, qb[j].w};
#pragma unroll
        for (int k = 0; k < 4; ++k) { va[j][2 * k] = bflo(a[k]); va[j][2 * k + 1] = bfhi(a[k]); vb[j][2 * k] = bflo(b[k]); vb[j][2 * k + 1] = bfhi(b[k]); }
#pragma unroll
        for (int k = 0; k < 8; ++k) { s0 += va[j][k] * va[j][k]; s1 += vb[j][k] * vb[j][k]; } }
#pragma unroll
    for (int o = 1; o < 64; o <<= 1) { s0 += __shfl_xor(s0, o); s1 += __shfl_xor(s1, o); }
    const float r0 = __builtin_amdgcn_rsqf(s0 * (1.0f / DM) + EPS), r1 = __builtin_amdgcn_rsqf(s1 * (1.0f / DM) + EPS);
    float m0 = 0.f, m1 = 0.f;
#pragma unroll
    for (int j = 0; j < 4; ++j) { const f32x4 w0 = *(const GAS f32x4*)(w + 8 * (lane + 64 * j)), w1 = *(const GAS f32x4*)(w + 8 * (lane + 64 * j) + 4); const float ww[8] = {w0.x, w0.y, w0.z, w0.w, w1.x, w1.y, w1.z, w1.w};
#pragma unroll
        for (int k = 0; k < 8; ++k) { va[j][k] *= r0 * ww[k]; vb[j][k] *= r1 * ww[k]; m0 = fmaxf(m0, fabsf(va[j][k])); m1 = fmaxf(m1, fabsf(vb[j][k])); } }
#pragma unroll
    for (int o = 1; o < 64; o <<= 1) { m0 = fmaxf(m0, __shfl_xor(m0, o)); m1 = fmaxf(m1, __shfl_xor(m1, o)); }
    const float i0 = m0 > 0.f ? 127.0f / m0 : 0.f, i1 = m1 > 0.f ? 127.0f / m1 : 0.f;
    if (lane == 0) { *(GAS float*)saa = m0 * (1.0f / 127.0f); *(GAS float*)sab = m1 * (1.0f / 127.0f); }
#pragma unroll
    for (int j = 0; j < 4; ++j) {
        *(GAS v2u*)(oa + 8 * (lane + 64 * j)) = (v2u){pack_i8x4c(va[j][0] * i0, va[j][1] * i0, va[j][2] * i0, va[j][3] * i0), pack_i8x4c(va[j][4] * i0, va[j][5] * i0, va[j][6] * i0, va[j][7] * i0)};
        *(GAS v2u*)(ob + 8 * (lane + 64 * j)) = (v2u){pack_i8x4c(vb[j][0] * i1, vb[j][1] * i1, vb[j][2] * i1, vb[j][3] * i1), pack_i8x4c(vb[j][4] * i1, vb[j][5] * i1, vb[j][6] * i1, vb[j][7] * i1)}; }
}
__device__ __forceinline__ void rms_phase_i8b(const Ctx& c, const bf16* x, const float* w, unsigned char* H8, float* SA) {
    for (int m = c.gw; m < NTOK / 2; m += c.NGW) rms_rows2_i8b(x + (size_t)m * DM, x + (size_t)(m + NTOK / 2) * DM, w, H8 + (size_t)m * DM, H8 + (size_t)(m + NTOK / 2) * DM, SA + m, SA + m + NTOK / 2, c.lane);
}
__device__ __forceinline__ void rms_phase_i8(const Ctx& c, const float* x, const float* w, unsigned char* H8, float* SA) {
    for (int m = c.gw; m < NTOK / 2; m += c.NGW) rms_rows2_i8(x + (size_t)m * DM, x + (size_t)(m + NTOK / 2) * DM, w, H8 + (size_t)m * DM, H8 + (size_t)(m + NTOK / 2) * DM, SA + m, SA + m + NTOK / 2, c.lane);
}
__device__ __forceinline__ void bf16_rows_i8(const Ctx& c, const bf16* X, unsigned char* X8, float* XS) {
    for (int r = c.gw; r < NTOK; r += 4 * c.NGW) { v4u x[4][4];
#pragma unroll
        for (int i = 0; i < 4; ++i) if (r + i * c.NGW < NTOK)
#pragma unroll
            for (int j = 0; j < 4; ++j) x[i][j] = *(const GAS v4u*)(X + (size_t)(r + i * c.NGW) * DM + 8 * (c.lane + 64 * j));
#pragma unroll
        for (int i = 0; i < 4; ++i) if (r + i * c.NGW < NTOK) { const int row = r + i * c.NGW; float m = 0.f;
#pragma unroll
            for (int j = 0; j < 4; ++j) { const v4u q = x[i][j];
                m = fmaxf(m, fmaxf(fmaxf(fmaxf(fabsf(bflo(q.x)), fabsf(bfhi(q.x))), fmaxf(fabsf(bflo(q.y)), fabsf(bfhi(q.y)))), fmaxf(fmaxf(fabsf(bflo(q.z)), fabsf(bfhi(q.z))), fmaxf(fabsf(bflo(q.w)), fabsf(bfhi(q.w)))))); }
            m = wave_max(m);
            const float inv = m > 0.f ? 127.0f / m : 0.f;
            if (c.lane == 0) *(GAS float*)(XS + row) = m * (1.0f / 127.0f);
#pragma unroll
            for (int j = 0; j < 4; ++j) { const v4u q = x[i][j]; v2u o;
                o.x = pack_i8x4c(bflo(q.x) * inv, bfhi(q.x) * inv, bflo(q.y) * inv, bfhi(q.y) * inv); o.y = pack_i8x4c(bflo(q.z) * inv, bfhi(q.z) * inv, bflo(q.w) * inv, bfhi(q.w) * inv);
                *(GAS v2u*)(X8 + (size_t)row * DM + 8 * (c.lane + 64 * j)) = o; } } }
}
__device__ __forceinline__ void rms_rows2(const float* xa, const float* xb, const float* w, bf16* oa, bf16* ob, int lane) {
    const GAS f32x4* pa = (const GAS f32x4*)xa + lane; const GAS f32x4* pb = (const GAS f32x4*)xb + lane; f32x4 va[8], vb[8]; float sa = 0.f, sb = 0.f;
#pragma unroll
    for (int j = 0; j < 8; ++j) { va[j] = pa[64 * j]; vb[j] = pb[64 * j]; }
#pragma unroll
    for (int j = 0; j < 8; ++j) { sa += (va[j].x * va[j].x + va[j].y * va[j].y) + (va[j].z * va[j].z + va[j].w * va[j].w); sb += (vb[j].x * vb[j].x + vb[j].y * vb[j].y) + (vb[j].z * vb[j].z + vb[j].w * vb[j].w); }
#pragma unroll
    for (int o = 1; o < 64; o <<= 1) { sa += __shfl_xor(sa, o); sb += __shfl_xor(sb, o); }
    const float ra = __builtin_amdgcn_rsqf(sa * (1.0f / DM) + EPS), rb = __builtin_amdgcn_rsqf(sb * (1.0f / DM) + EPS);
    const GAS f32x4* wp = (const GAS f32x4*)w + lane; GAS v2u* qa = (GAS v2u*)oa + lane; GAS v2u* qb = (GAS v2u*)ob + lane;
#pragma unroll
    for (int j = 0; j < 8; ++j) { const f32x4 wv = wp[64 * j];
        v2u q; q.x = pk2c(va[j].x * ra * wv.x, va[j].y * ra * wv.y); q.y = pk2c(va[j].z * ra * wv.z, va[j].w * ra * wv.w); qa[64 * j] = q;
        v2u p; p.x = pk2c(vb[j].x * rb * wv.x, vb[j].y * rb * wv.y); p.y = pk2c(vb[j].z * rb * wv.z, vb[j].w * rb * wv.w); qb[64 * j] = p; }
}
__device__ __forceinline__ void rms_phase(const Ctx& c, const float* x, const float* w, bf16* H) {
    for (int m = c.gw; m < NTOK / 2; m += c.NGW) rms_rows2(x + (size_t)m * DM, x + (size_t)(m + NTOK / 2) * DM, w, H + (size_t)m * DM, H + (size_t)(m + NTOK / 2) * DM, c.lane);
}
__device__ __forceinline__ void fp8_row(const float* src, unsigned char* dst, float* scale_out, int lane) {
    const GAS f32x4* xp = (const GAS f32x4*)src + lane; f32x4 v[8]; float m = 0.f;
#pragma unroll
    for (int j = 0; j < 8; ++j) { v[j] = xp[64 * j]; m = fmaxf(fmaxf(m, fmaxf(fabsf(v[j].x), fabsf(v[j].y))), fmaxf(fabsf(v[j].z), fabsf(v[j].w))); }
    m = wave_max(m);
    const float inv = m > 0.f ? 256.0f / m : 0.f;
    if (lane == 0) *(GAS float*)scale_out = m * (1.0f / 256.0f);
#pragma unroll
    for (int j = 0; j < 8; ++j) { int p = __builtin_amdgcn_cvt_pk_fp8_f32(v[j].x * inv, v[j].y * inv, 0, false); p = __builtin_amdgcn_cvt_pk_fp8_f32(v[j].z * inv, v[j].w * inv, p, true);
        ((GAS unsigned*)dst)[lane + 64 * j] = (unsigned)p; }
}
constexpr size_t U8_SLICE = (size_t)16384 * 128;
__device__ __forceinline__ unsigned pack_i8x4(float a, float b, float c, float d) {
    const int ia = (int)__builtin_rintf(a), ib = (int)__builtin_rintf(b), ic = (int)__builtin_rintf(c), id = (int)__builtin_rintf(d);
    return ((unsigned)ia & 255u) | (((unsigned)ib & 255u) << 8) | (((unsigned)ic & 255u) << 16) | ((unsigned)id << 24);
}
__device__ __forceinline__ void row_load_strided(const float* src, int lane, f32x4 (&v)[8]) { const GAS f32x4* xp = (const GAS f32x4*)src + lane;
#pragma unroll
    for (int j = 0; j < 8; ++j) v[j] = xp[64 * j]; }
__device__ __forceinline__ void row_load_contig(const float* src, int lane, f32x4 (&v)[8]) { const GAS f32x4* xp = (const GAS f32x4*)src + 8 * lane;
#pragma unroll
    for (int j = 0; j < 8; ++j) v[j] = xp[j]; }
__device__ __forceinline__ void i8_row(const f32x4 (&v)[8], unsigned char* dst, float* scale_out, int lane) {
    float m = 0.f;
#pragma unroll
    for (int j = 0; j < 8; ++j) m = fmaxf(fmaxf(m, fmaxf(fabsf(v[j].x), fabsf(v[j].y))), fmaxf(fabsf(v[j].z), fabsf(v[j].w)));
    m = wave_max(m);
    const float inv = m > 0.f ? 127.0f / m : 0.f;
    if (lane == 0) *(GAS float*)scale_out = m * (1.0f / 127.0f);
#pragma unroll
    for (int j = 0; j < 8; ++j) *(GAS unsigned*)(dst + (size_t)(2 * j + (lane >> 5)) * U8_SLICE + 4 * (lane & 31)) = pack_i8x4(v[j].x * inv, v[j].y * inv, v[j].z * inv, v[j].w * inv);
}
constexpr size_t V6_SLICE = (size_t)16384 * 192;
__device__ __forceinline__ void fp6_row(const f32x4 (&v)[8], unsigned char* dst, float* scale_out, int lane) {
    float m = 0.f;
#pragma unroll
    for (int j = 0; j < 8; ++j) m = fmaxf(fmaxf(m, fmaxf(fabsf(v[j].x), fabsf(v[j].y))), fmaxf(fabsf(v[j].z), fabsf(v[j].w)));
    m = wave_max(m);
    const float inv = m > 0.f ? 7.5f / m : 0.f;
    if (lane == 0) *(GAS float*)scale_out = m * (1.0f / 7.5f);
    v32h_t h;
#pragma unroll
    for (int j = 0; j < 8; ++j) { h[4 * j] = (_Float16)(v[j].x * inv); h[4 * j + 1] = (_Float16)(v[j].y * inv); h[4 * j + 2] = (_Float16)(v[j].z * inv); h[4 * j + 3] = (_Float16)(v[j].w * inv); }
    const v6u q = __builtin_amdgcn_cvt_scalef32_pk32_fp6_f16(h, 1.0f);
    GAS v2u* o = (GAS v2u*)(dst + (size_t)(lane >> 3) * V6_SLICE + 24 * (lane & 7));
    o[0] = (v2u){q[0], q[1]}; o[1] = (v2u){q[2], q[3]}; o[2] = (v2u){q[4], q[5]};
}
struct P0Args { const float *w_in, *w_br_sb, *w_br_hg, *w_br_conv, *w_o, *w_q, *u, *v, *lbp; bf16 *WinT, *WbrT, *WoT, *WqT; unsigned char *U, *V; float *US, *VS; float* LB; int layer; const float *k1, *k2; bf16* KB; };
__device__ __forceinline__ void p0_convert(const Ctx& c, const P0Args& a, int parts = 7) {
    LAS float* scr = (LAS float*)(c.lds + c.wave * 16384);
    constexpr int I_IN = (DM / 128) * (INW / 32), I_BR = (BW / 64) * (DM / 32), I_SQ = (DM / 64) * (DM / 32);
    constexpr int I_Q8 = (DM / 128) * (DM / 32);
    constexpr int I_B8 = (BW / 128) * (DM / 32);
    constexpr int NITEMS = I_IN + I_BR + 2 * I_B8 + 2 * I_Q8;
    if (parts & 1)
    for (int it = c.gw; it < NITEMS; it += c.NGW) {
        int r = it;
        if (r < I_IN) { const int kb = r / (INW / 32), nb = r % (INW / 32); tr_item_i8(a.w_in, DM, INW, (unsigned char*)a.WinT, kb * 128, nb * 32, win_drow(nb * 32), WIN_QS, scr, c.lane); continue; } r -= I_IN;
        if (r < I_BR) { const int kb = r / (DM / 32), nb = r % (DM / 32); tr_item(a.w_br_sb, BW, DM, a.WbrT, kb * 64, nb * 32, nb * 32, scr, c.lane); continue; } r -= I_BR;
        if (r < I_B8) { const int kb = r / (DM / 32), nb = r % (DM / 32); tr_item_i8(a.w_br_hg, BW, DM, (unsigned char*)(a.WbrT + (size_t)DM * BW), kb * 128, nb * 32, nb * 32, WBR_QS, scr, c.lane); continue; } r -= I_B8;
        if (r < I_B8) { const int kb = r / (DM / 32), nb = r % (DM / 32); tr_item_i8(a.w_br_conv, BW, DM, (unsigned char*)(a.WbrT + (size_t)2 * DM * BW), kb * 128, nb * 32, nb * 32, WBR_QS, scr, c.lane); continue; } r -= I_B8;
        if (r < I_Q8) { const int kb = r / (DM / 32), nb = r % (DM / 32); tr_item_i8(a.w_o, DM, DM, (unsigned char*)a.WoT, kb * 128, nb * 32, nb * 32, WIN_QS, scr, c.lane); continue; } r -= I_Q8;
        { const int kb = r / (DM / 32), nb = r % (DM / 32); tr_item_i8(a.w_q, DM, DM, (unsigned char*)a.WqT, kb * 128, nb * 32, nb * 32, WIN_QS, scr, c.lane); }
    }
    if (parts & 2)
    {
    for (int r = c.gw; r < 16384; r += 2 * c.NGW) { const int r2 = r + c.NGW; f32x4 va[8], vb[8];
        row_load_strided(a.u + (size_t)r * 2048, c.lane, va); if (r2 < 16384) row_load_strided(a.u + (size_t)r2 * 2048, c.lane, vb);
        i8_row(va, a.U + (size_t)r * 128, a.US + r, c.lane); if (r2 < 16384) i8_row(vb, a.U + (size_t)r2 * 128, a.US + r2, c.lane); }
    for (int r = c.gw; r < 16384; r += 2 * c.NGW) { const int r2 = r + c.NGW; f32x4 va[8], vb[8];
        row_load_contig(a.v + (size_t)r * 2048, c.lane, va); if (r2 < 16384) row_load_contig(a.v + (size_t)r2 * 2048, c.lane, vb);
        fp6_row(va, a.V + (size_t)r * 192, a.VS + r, c.lane); if (r2 < 16384) fp6_row(vb, a.V + (size_t)r2 * 192, a.VS + r2, c.lane); }
    }
    if (parts & 4) {
    cvt_copy(c, a.k1, a.KB, (size_t)8 * 16384 / 8);
    cvt_copy(c, a.k2, a.KB + 8 * 16384, (size_t)8 * 16384 / 8); }
    if (blockIdx.x == 0) for (int i = c.tid; i < 1024; i += 512) a.LB[i] = a.layer == 0 ? 0.f : sigm(a.lbp[1024 + i] - a.lbp[i]);
}

__device__ __forceinline__ unsigned pack_i8x4u(float a, float b, float c, float d) {
    return (unsigned)__builtin_rintf(a) | ((unsigned)__builtin_rintf(b) << 8) | ((unsigned)__builtin_rintf(c) << 16) | ((unsigned)__builtin_rintf(d) << 24);
}
struct EpiIn {
    static constexpr bool PERM = true, AFTER_DRAIN = false;
    bf16* seg; bf16* gate; const float* lb; const float* sa;
    __device__ __forceinline__ float rowscale(int row) const { return ((const GAS float*)sa)[row] * (1.0f / WIN_QS); }
    __device__ __forceinline__ void operator()(const pg8::f32x4 (&acc)[2][2][4][2], const pg8::Unit& u, int wr, int wc, int fr, int fq) const {
        const int pn = u.pn; const int row0 = u.pm * 256 + wr * 64 + fr;
        if (pn >= 28 && pn < 36) {
            bf16* dst = seg + (size_t)7 * SEGSZ; const int col0 = (pn - 28) * 128 + wc * 32 + 8 * fq;
#pragma unroll
            for (int ai = 0; ai < 2; ++ai)
#pragma unroll
                for (int m = 0; m < 4; ++m) {
                    const pg8::f32x4 a0 = acc[ai][0][m][0], a1 = acc[ai][0][m][1], b0 = acc[ai][1][m][0], b1 = acc[ai][1][m][1];
                    v4u w; w.x = pk2c(a0[0] * sigm(b0[0]), a0[1] * sigm(b0[1])); w.y = pk2c(a0[2] * sigm(b0[2]), a0[3] * sigm(b0[3]));
                    w.z = pk2c(a1[0] * sigm(b1[0]), a1[1] * sigm(b1[1])); w.w = pk2c(a1[2] * sigm(b1[2]), a1[3] * sigm(b1[3]));
                    *(GAS v4u*)(dst + (size_t)(row0 + ai * 128 + m * 16) * 1024 + col0) = w; }
            return;
        }
        if (pn >= 24 && pn < 28) {
            unsigned char* g8 = (unsigned char*)(seg + (size_t)6 * SEGSZ); const int c8 = (pn & 3) * 256 + wc * 32 + 8 * fq;
#pragma unroll
            for (int ai = 0; ai < 2; ++ai)
#pragma unroll
                for (int m = 0; m < 4; ++m)
#pragma unroll
                    for (int bj = 0; bj < 2; ++bj) { const pg8::f32x4 v0 = acc[ai][bj][m][0], v1 = acc[ai][bj][m][1];
                        v2u w; w.x = pack_i8x4u(sigm(v0[0]) * 255.0f, sigm(v0[1]) * 255.0f, sigm(v0[2]) * 255.0f, sigm(v0[3]) * 255.0f); w.y = pack_i8x4u(sigm(v1[0]) * 255.0f, sigm(v1[1]) * 255.0f, sigm(v1[2]) * 255.0f, sigm(v1[3]) * 255.0f);
                        *(GAS v2u*)(g8 + (size_t)(row0 + ai * 128 + m * 16) * 1024 + c8 + bj * 128) = w; }
            return; }
        bf16* dst; int ld, colt, mode;
        if (pn < 28) { const int sg = pn >> 2; dst = seg + (size_t)sg * SEGSZ; ld = 1024; colt = (pn & 3) * 256; mode = (sg == 4) ? 2 : 0; }
        else {
            const int q = pn - 36; unsigned char* g8 = (unsigned char*)gate + (size_t)(q >> 3) * ((size_t)NTOK * 2048); const int c8 = (q & 7) * 256 + wc * 32 + 8 * fq;
#pragma unroll
            for (int ai = 0; ai < 2; ++ai)
#pragma unroll
                for (int m = 0; m < 4; ++m)
#pragma unroll
                    for (int bj = 0; bj < 2; ++bj) { const pg8::f32x4 v0 = acc[ai][bj][m][0], v1 = acc[ai][bj][m][1];
                        v2u w; w.x = pack_i8x4u(sigm(v0[0]) * 255.0f, sigm(v0[1]) * 255.0f, sigm(v0[2]) * 255.0f, sigm(v0[3]) * 255.0f); w.y = pack_i8x4u(sigm(v1[0]) * 255.0f, sigm(v1[1]) * 255.0f, sigm(v1[2]) * 255.0f, sigm(v1[3]) * 255.0f);
                        *(GAS v2u*)(g8 + (size_t)(row0 + ai * 128 + m * 16) * 2048 + c8 + bj * 128) = w; }
            return; }
        const int col0 = colt + wc * 32 + 8 * fq;
        if (mode == 0) {
#pragma unroll
            for (int ai = 0; ai < 2; ++ai)
#pragma unroll
                for (int m = 0; m < 4; ++m)
#pragma unroll
                    for (int bj = 0; bj < 2; ++bj) { const pg8::f32x4 v0 = acc[ai][bj][m][0], v1 = acc[ai][bj][m][1];
                        v4u w; w.x = pk2c(v0[0], v0[1]); w.y = pk2c(v0[2], v0[3]); w.z = pk2c(v1[0], v1[1]); w.w = pk2c(v1[2], v1[3]);
                        *(GAS v4u*)(dst + (size_t)(row0 + ai * 128 + m * 16) * ld + col0 + bj * 128) = w; }
        } else if (mode == 1) {
#pragma unroll
            for (int ai = 0; ai < 2; ++ai)
#pragma unroll
                for (int m = 0; m < 4; ++m)
#pragma unroll
                    for (int bj = 0; bj < 2; ++bj) { const pg8::f32x4 v0 = acc[ai][bj][m][0], v1 = acc[ai][bj][m][1];
                        v4u w; w.x = pk2c(sigm(v0[0]), sigm(v0[1])); w.y = pk2c(sigm(v0[2]), sigm(v0[3])); w.z = pk2c(sigm(v1[0]), sigm(v1[1])); w.w = pk2c(sigm(v1[2]), sigm(v1[3]));
                        *(GAS v4u*)(dst + (size_t)(row0 + ai * 128 + m * 16) * ld + col0 + bj * 128) = w; }
        } else {
            f32x4 l0[2], l1[2];
#pragma unroll
            for (int bj = 0; bj < 2; ++bj) { l0[bj] = *(const GAS f32x4*)(lb + col0 + bj * 128); l1[bj] = *(const GAS f32x4*)(lb + col0 + bj * 128 + 4); }
#pragma unroll
            for (int ai = 0; ai < 2; ++ai)
#pragma unroll
                for (int m = 0; m < 4; ++m)
#pragma unroll
                    for (int bj = 0; bj < 2; ++bj) { const pg8::f32x4 v0 = acc[ai][bj][m][0], v1 = acc[ai][bj][m][1]; float r[8];
#pragma unroll
                        for (int j = 0; j < 4; ++j) { r[j] = __logf(l0[bj][j] + (1.0f - l0[bj][j]) * sigm(v0[j])); r[4 + j] = __logf(l1[bj][j] + (1.0f - l1[bj][j]) * sigm(v1[j])); }
                        v4u w; w.x = pk2c(r[0], r[1]); w.y = pk2c(r[2], r[3]); w.z = pk2c(r[4], r[5]); w.w = pk2c(r[6], r[7]);
                        *(GAS v4u*)(dst + (size_t)(row0 + ai * 128 + m * 16) * ld + col0 + bj * 128) = w; }
        }
    }
};

__device__ __forceinline__ void conv_phase(const Ctx& c, const bf16* glu, const float* cw, const float* cb, const float* lnw, const float* lnb, bf16* out) {
    const int c0 = 2 * c.tid;
    float w0[31], w1[31];
#pragma unroll
    for (int j = 0; j < 31; ++j) { const f32x2v t = *(const GAS f32x2v*)(cw + j * 1024 + c0); w0[j] = t.x; w1[j] = t.y; }
    const f32x2v bv = *(const GAS f32x2v*)(cb + c0), lwv = *(const GAS f32x2v*)(lnw + c0), lbv = *(const GAS f32x2v*)(lnb + c0);
    LAS float* red = (LAS float*)c.lds;
    const int per = (NTOK / 8 + c.G - 1) / c.G, tile0 = (int)blockIdx.x * per;
    unsigned win[38];
    if (tile0 < NTOK / 8) {
#pragma unroll
        for (int r = 0; r < 38; ++r) { const int n = tile0 * 8 + r - 30; win[r] = *(const GAS unsigned*)(glu + (size_t)(n > 0 ? n : 0) * 1024 + c0); } }
    for (int ti = 0; ti < per; ++ti) { const int tile = tile0 + ti; if (tile >= NTOK / 8) break;
        const int n0 = tile * 8, tseq0 = n0 & (SEQ - 1);
        const bool more = (ti + 1 < per) && (tile + 1 < NTOK / 8);
        float a0[8], a1[8];
#pragma unroll
        for (int t = 0; t < 8; ++t) { a0[t] = bv.x; a1[t] = bv.y; }
#pragma unroll
        for (int r = 0; r < 38; ++r) {
            const unsigned xv = (tseq0 + r - 30 >= 0) ? win[r] : 0u;
            const float x0 = bflo(xv), x1 = bfhi(xv);
#pragma unroll
            for (int t = 0; t < 8; ++t) { const int j = r - t; if (j >= 0 && j <= 30) { a0[t] += w0[j] * x0; a1[t] += w1[j] * x1; } }
        }
#pragma unroll
        for (int r = 0; r < 30; ++r) win[r] = win[r + 8];
        if (more) {
#pragma unroll
            for (int i = 0; i < 8; ++i) win[30 + i] = *(const GAS unsigned*)(glu + (size_t)(n0 + 8 + i) * 1024 + c0); }
        float st[16];
#pragma unroll
        for (int t = 0; t < 8; ++t) { st[2 * t] = a0[t] + a1[t]; st[2 * t + 1] = a0[t] * a0[t] + a1[t] * a1[t]; }
        xreduce16(st, c.lane);
        if ((c.lane & 3) == 0) red[c.wave * 16 + ridx16(c.lane)] = st[0];
        __syncthreads();
        if (c.tid < 16) { float s = 0.f;
#pragma unroll
            for (int w = 0; w < 8; ++w) s += red[w * 16 + c.tid];
            red[128 + c.tid] = s; }
        __syncthreads();
#pragma unroll
        for (int t = 0; t < 8; ++t) {
            const float mean = red[128 + 2 * t] * (1.0f / 1024.0f), var = red[128 + 2 * t + 1] * (1.0f / 1024.0f) - mean * mean;
            const float rstd = __builtin_amdgcn_rsqf(var + EPS);
            const float h0 = (a0[t] - mean) * rstd * lwv.x + lbv.x, h1 = (a1[t] - mean) * rstd * lwv.y + lbv.y;
            const unsigned q4 = pack_i8x4c(h0 * sigm(h0) * ACT_QS, h1 * sigm(h1) * ACT_QS, 0.f, 0.f);
            *(GAS unsigned short*)((unsigned char*)out + (size_t)(n0 + t) * 1024 + c0) = (unsigned short)q4;
        }
        __syncthreads();
    }
}
__device__ __forceinline__ void hgrn_task(int task, int lane, const bf16* qhg, const bf16* logf, const bf16* ihg, bf16* out) {
    const int bh = task >> 6, dvb = task & 63, b = bh >> 3, h = bh & 7;
    const size_t rb = (size_t)b * SEQ * 1024;
    const GAS unsigned* qp = (const GAS unsigned*)(qhg + rb + h * 128) + lane;
    const GAS unsigned* lp = (const GAS unsigned*)(logf + rb + h * 128) + lane;
    const GAS unsigned* ip = (const GAS unsigned*)(ihg + rb + h * 128) + dvb;
    GAS bf16* op = (GAS bf16*)(out + rb + h * 128 + 2 * dvb);
    float S00 = 0.f, S01 = 0.f, S10 = 0.f, S11 = 0.f;
    unsigned qn[8], ln[8], inx[8];
#pragma unroll
    for (int j = 0; j < 8; ++j) { qn[j] = qp[(size_t)j * 512]; ln[j] = lp[(size_t)j * 512]; inx[j] = ip[(size_t)j * 512]; }
    for (int blk = 0; blk < SEQ / 8; ++blk) {
        unsigned qc[8], lc[8], ic[8];
#pragma unroll
        for (int j = 0; j < 8; ++j) { qc[j] = qn[j]; lc[j] = ln[j]; ic[j] = inx[j]; }
        if (blk + 1 < SEQ / 8) {
#pragma unroll
            for (int j = 0; j < 8; ++j) { const size_t o = (size_t)((blk + 1) * 8 + j) * 512; qn[j] = qp[o]; ln[j] = lp[o]; inx[j] = ip[o]; }
        }
        float pv[16];
#pragma unroll
        for (int j = 0; j < 8; ++j) {
            const float f0 = __expf(bflo(lc[j])), f1 = __expf(bfhi(lc[j])), k0 = 1.0f - f0, k1 = 1.0f - f1;
            const float i0 = bflo(ic[j]), i1 = bfhi(ic[j]), q0 = bflo(qc[j]), q1 = bfhi(qc[j]);
            S00 = f0 * S00 + k0 * i0; S01 = f0 * S01 + k0 * i1; S10 = f1 * S10 + k1 * i0; S11 = f1 * S11 + k1 * i1;
            pv[2 * j] = S00 * q0 + S10 * q1; pv[2 * j + 1] = S01 * q0 + S11 * q1;
        }
        xreduce16(pv, lane);
        if ((lane & 3) == 0) { const int idx = ridx16(lane); op[(size_t)(blk * 8 + (idx >> 1)) * 1024 + (idx & 1)] = (bf16)(pk2c(pv[0], 0.f) & 0xffffu); }
    }
}
constexpr int HG_TS = 272;
constexpr int HG_TL = 256;
constexpr int HG_TILE = 64 * HG_TL;
constexpr int HG_BS = 132;
__device__ __forceinline__ void hg_stage(LAS unsigned char* dst, const bf16* src, int tid) {
#pragma unroll
    for (int i = 0; i < 2; ++i) { const int p = tid + 512 * i, row = p >> 4, c16 = p & 15; *(LAS v4u*)(dst + row * HG_TL + c16 * 16) = *(const GAS v4u*)(src + (size_t)row * 1024 + c16 * 8); }
}
__device__ __forceinline__ void hg_scan(const LAS unsigned char* lft, int dk, int hf, float (&lf)[4][8], float (&b)[4][8], float& bl) {
    float bs[4], pb[4];
#pragma unroll
    for (int kk = 0; kk < 4; ++kk) { float run = 0.f;
#pragma unroll
        for (int j = 0; j < 8; ++j) { lf[kk][j] = __uint_as_float((unsigned)(*(const LAS unsigned short*)(lft + (16 * kk + 8 * hf + j) * HG_TL + dk * 2)) << 16); run += lf[kk][j]; b[kk][j] = run; }
        bs[kk] = run; }
#pragma unroll
    for (int kk = 0; kk < 4; ++kk) pb[kk] = xor32f(bs[kk], hf);
    float pre = 0.f;
#pragma unroll
    for (int kk = 0; kk < 4; ++kk) { const float off = pre + (hf ? pb[kk] : 0.f);
#pragma unroll
        for (int j = 0; j < 8; ++j) b[kk][j] += off;
        pre += bs[kk] + pb[kk]; }
    bl = pre;
}
__device__ __forceinline__ bf16x8 pack8(const float (&v)[8]) { v4u t; t.x = pk2c(v[0], v[1]); t.y = pk2c(v[2], v[3]); t.z = pk2c(v[4], v[5]); t.w = pk2c(v[6], v[7]); return __builtin_bit_cast(bf16x8, t); }
__device__ __forceinline__ unsigned lds_u16(const LAS unsigned char* p) { return (unsigned)(*(const LAS unsigned short*)p); }
__device__ __forceinline__ size_t hg_tile_off(int ci) { const int bh = ci >> 6, ch = ci & 63, bb = bh >> 3, h = bh & 7; return ((size_t)bb * SEQ + ch * 64) * 1024 + h * 128; }
__device__ __forceinline__ void hg_tile_dma(LAS unsigned char* dst, const bf16* src, int wave, int lane) {
    const unsigned long long a_ = (unsigned long long)src;
    const char* sb = (const char*)(((unsigned long long)(unsigned)__builtin_amdgcn_readfirstlane((int)(a_ >> 32)) << 32) | (unsigned)__builtin_amdgcn_readfirstlane((int)a_));
    const unsigned d0 = (unsigned)(unsigned long long)dst + (unsigned)wave * 2048u;
    const unsigned vo = (unsigned)wave * 16384u + (unsigned)(lane >> 4) * 2048u + (unsigned)(lane & 15) * 16u;
#pragma unroll
    for (int i = 0; i < 2; ++i) { const unsigned m0v = d0 + (unsigned)i * 1024u, vv = vo + (unsigned)i * 8192u;
        asm volatile("s_mov_b32 m0, %0\n\ts_nop 0\n\tglobal_load_lds_dwordx4 %1, %2" :: "s"(m0v), "v"(vv), "s"(sb) : "memory", "m0"); }
}
__device__ __forceinline__ void hgA_chunk(const Ctx& c, int ci, int cn, int par, bool first, const bf16* LOGF, const bf16* IHG, bf16* ST, float* DEC) {
    LAS unsigned char* lft = c.lds + par * 2 * HG_TILE; LAS unsigned char* itl = lft + HG_TILE; LAS unsigned char* nxt = c.lds + (par ^ 1) * 2 * HG_TILE;
    if (first) { const size_t o = hg_tile_off(ci); hg_stage(lft, LOGF + o, c.tid); hg_stage(itl, IHG + o, c.tid); }
    asm volatile("s_waitcnt vmcnt(0)" ::: "memory");
    __syncthreads();
    if (cn < 2048) { const size_t o = hg_tile_off(cn); hg_tile_dma(nxt, LOGF + o, c.wave, c.lane); hg_tile_dma(nxt + HG_TILE, IHG + o, c.wave, c.lane); }
    const int dkt = c.wave & 3, dvh = c.wave >> 2, hf = c.lane >> 5, cl = c.lane & 31, dk = 32 * dkt + cl;
    float lf[4][8], b[4][8], bl; hg_scan(lft, dk, hf, lf, b, bl);
    bf16x8 kf[4];
#pragma unroll
    for (int kk = 0; kk < 4; ++kk) { float v[8];
#pragma unroll
        for (int j = 0; j < 8; ++j) v[j] = (1.0f - __expf(lf[kk][j])) * __expf(bl - b[kk][j]);
        kf[kk] = pack8(v); }
    if (dvh == 0 && hf == 0) ((GAS float*)DEC)[(size_t)ci * 128 + dk] = __expf(bl);
#pragma unroll
    for (int dvi = 0; dvi < 2; ++dvi) { const int dvt = dvh * 2 + dvi;
        f32x16 acc;
#pragma unroll
        for (int r = 0; r < 16; ++r) acc[r] = 0.f;
#pragma unroll
        for (int kk = 0; kk < 4; ++kk) { const LAS unsigned char* p = itl + (16 * kk + 8 * hf) * HG_TL + (32 * dvt + cl) * 2;
            v4u t; t.x = lds_u16(p) | (lds_u16(p + HG_TL) << 16); t.y = lds_u16(p + 2 * HG_TL) | (lds_u16(p + 3 * HG_TL) << 16); t.z = lds_u16(p + 4 * HG_TL) | (lds_u16(p + 5 * HG_TL) << 16); t.w = lds_u16(p + 6 * HG_TL) | (lds_u16(p + 7 * HG_TL) << 16);
            acc = MFMA32(kf[kk], __builtin_bit_cast(bf16x8, t), acc); }
        bf16* o = ST + (size_t)ci * 16384 + (size_t)(32 * dvt + cl) * 128 + 32 * dkt + 4 * hf;
#pragma unroll
        for (int g = 0; g < 4; ++g) { v2u q; q.x = pk2c(acc[4 * g], acc[4 * g + 1]); q.y = pk2c(acc[4 * g + 2], acc[4 * g + 3]); *(GAS v2u*)(o + 8 * g) = q; }
    }
    __syncthreads();
}
__device__ __forceinline__ void hgB(const Ctx& c, bf16* ST, const float* DEC) {
    for (int e = blockIdx.x * 512 + c.tid; e < 32 * 4096; e += c.G * 512) {
        const int bh = e >> 12, r = e & 4095, dv = r >> 5, dk4 = (r & 31) * 4;
        GAS v2u* p = (GAS v2u*)(ST + (size_t)bh * 64 * 16384 + (size_t)dv * 128 + dk4);
        const GAS f32x4* d = (const GAS f32x4*)(DEC + (size_t)bh * 64 * 128 + dk4);
        f32x4 S = {0.f, 0.f, 0.f, 0.f};
#pragma unroll
        for (int c0 = 0; c0 < 64; c0 += 8) {
            v2u Lv[8]; f32x4 D[8];
#pragma unroll
            for (int k = 0; k < 8; ++k) { Lv[k] = p[(size_t)(c0 + k) * 4096]; D[k] = d[(size_t)(c0 + k) * 32]; }
#pragma unroll
            for (int k = 0; k < 8; ++k) { v2u o; o.x = pk2c(S.x, S.y); o.y = pk2c(S.z, S.w); p[(size_t)(c0 + k) * 4096] = o;
                S.x = D[k].x * S.x + bflo(Lv[k].x); S.y = D[k].y * S.y + bfhi(Lv[k].x); S.z = D[k].z * S.z + bflo(Lv[k].y); S.w = D[k].w * S.w + bfhi(Lv[k].y); }
        }
    }
}
__device__ __forceinline__ void hgC_chunk(const Ctx& c, int ci, int cn, int par, bool first, const bf16* QHG, const bf16* LOGF, const bf16* IHG, const bf16* GHG, const bf16* ST, const float* nw, bf16* OUT) {
    const int bh = ci >> 6, ch = ci & 63, bb = bh >> 3, h = bh & 7; const size_t n0 = (size_t)bb * SEQ + ch * 64;
    LAS unsigned char* lft = c.lds + par * 2 * HG_TILE; LAS unsigned char* itl = lft + HG_TILE; LAS unsigned char* nxt = c.lds + (par ^ 1) * 2 * HG_TILE;
    LAS float* bt = (LAS float*)(c.lds + 4 * HG_TILE); LAS float* red = bt + 64 * HG_BS;
    LAS unsigned char* ktl = (LAS unsigned char*)(red + 256);
    const int hf = c.lane >> 5, cl = c.lane & 31;
    const int dvt = c.wave & 3, tt = c.wave >> 2, t = 32 * tt + cl;
    const bf16* qrow = QHG + (n0 + t) * 1024 + h * 128 + 8 * hf;
    if (first) { hg_stage(lft, LOGF + n0 * 1024 + h * 128, c.tid); hg_stage(itl, IHG + n0 * 1024 + h * 128, c.tid); }
    asm volatile("s_waitcnt vmcnt(0)" ::: "memory");
    __syncthreads();
    v4u qg[8];
#pragma unroll
    for (int kk = 0; kk < 8; ++kk) qg[kk] = *(const GAS v4u*)(qrow + 16 * kk);
    { const int dk = 32 * (c.wave & 3) + cl; float lf[4][8], b[4][8], bl; hg_scan(lft, dk, hf, lf, b, bl);
#pragma unroll
      for (int q = 0; q < 2; ++q) { const int kk = 2 * (c.wave >> 2) + q;
#pragma unroll
          for (int j = 0; j < 8; ++j) { bt[(16 * kk + 8 * hf + j) * HG_BS + dk] = (c.wave >> 2) ? b[2 + q][j] : b[q][j];
              *(LAS unsigned short*)(ktl + (16 * kk + 8 * hf + j) * HG_TS + dk * 2) = (unsigned short)(pk2c(1.0f - __expf((c.wave >> 2) ? lf[2 + q][j] : lf[q][j]), 0.f) & 0xffffu); } } }
    __syncthreads();
    if (cn < 2048) { const size_t o = hg_tile_off(cn); hg_tile_dma(nxt, LOGF + o, c.wave, c.lane); hg_tile_dma(nxt + HG_TILE, IHG + o, c.wave, c.lane); }
    bf16x8 qm[8];
    const bf16* strow = ST + (size_t)ci * 16384 + (size_t)(32 * dvt + cl) * 128 + 8 * hf;
#pragma unroll
    for (int kk = 0; kk < 8; ++kk) { const int d0 = 16 * kk + 8 * hf;
        const v4u qv = qg[kk];
        const f32x4 b0 = *(const LAS f32x4*)(bt + t * HG_BS + d0), b1 = *(const LAS f32x4*)(bt + t * HG_BS + d0 + 4), m0 = *(const LAS f32x4*)(bt + 31 * HG_BS + d0), m1 = *(const LAS f32x4*)(bt + 31 * HG_BS + d0 + 4);
        const float q[8] = {bflo(qv.x), bfhi(qv.x), bflo(qv.y), bfhi(qv.y), bflo(qv.z), bfhi(qv.z), bflo(qv.w), bfhi(qv.w)};
        const float bv[8] = {b0.x, b0.y, b0.z, b0.w, b1.x, b1.y, b1.z, b1.w}, mv[8] = {m0.x, m0.y, m0.z, m0.w, m1.x, m1.y, m1.z, m1.w};
        float vm[8];
#pragma unroll
        for (int j = 0; j < 8; ++j) vm[j] = q[j] * __expf(bv[j] - mv[j]);
        qm[kk] = pack8(vm); }
    f32x16 o;
#pragma unroll
    for (int r = 0; r < 16; ++r) o[r] = 0.f;
#pragma unroll 1
    for (int st = 0; st <= tt; ++st) {
        const int s = 32 * st + cl;
        f32x16 sa;
#pragma unroll
        for (int r = 0; r < 16; ++r) sa[r] = 0.f;
#pragma unroll
        for (int kk = 0; kk < 8; ++kk) { const int d0 = 16 * kk + 8 * hf;
            asm volatile("" ::: "memory");
            const v4u lv = *(const LAS v4u*)(ktl + s * HG_TS + d0 * 2);
            const f32x4 b0 = *(const LAS f32x4*)(bt + s * HG_BS + d0), b1 = *(const LAS f32x4*)(bt + s * HG_BS + d0 + 4), m0 = *(const LAS f32x4*)(bt + 31 * HG_BS + d0), m1 = *(const LAS f32x4*)(bt + 31 * HG_BS + d0 + 4);
            const float kv[8] = {bflo(lv.x), bfhi(lv.x), bflo(lv.y), bfhi(lv.y), bflo(lv.z), bfhi(lv.z), bflo(lv.w), bfhi(lv.w)};
            const float bv[8] = {b0.x, b0.y, b0.z, b0.w, b1.x, b1.y, b1.z, b1.w}, mv[8] = {m0.x, m0.y, m0.z, m0.w, m1.x, m1.y, m1.z, m1.w};
            float vk[8];
#pragma unroll
            for (int j = 0; j < 8; ++j) vk[j] = kv[j] * __expf(mv[j] - bv[j]);
            sa = MFMA32(pack8(vk), qm[kk], sa); }
        if (st == tt) {
#pragma unroll
            for (int r = 0; r < 16; ++r) if (((r & 3) + 8 * (r >> 2) + 4 * hf) > cl) sa[r] = 0.f;
        }
#pragma unroll
        for (int sp = 0; sp < 2; ++sp) {
            const float pv[8] = {sa[8 * sp], sa[8 * sp + 1], sa[8 * sp + 2], sa[8 * sp + 3], sa[8 * sp + 4], sa[8 * sp + 5], sa[8 * sp + 6], sa[8 * sp + 7]};
            const LAS unsigned char* p = itl + (32 * st + 16 * sp + 4 * hf) * HG_TL + (32 * dvt + cl) * 2;
            v4u tq; tq.x = lds_u16(p) | (lds_u16(p + HG_TL) << 16); tq.y = lds_u16(p + 2 * HG_TL) | (lds_u16(p + 3 * HG_TL) << 16);
            tq.z = lds_u16(p + 8 * HG_TL) | (lds_u16(p + 9 * HG_TL) << 16); tq.w = lds_u16(p + 10 * HG_TL) | (lds_u16(p + 11 * HG_TL) << 16);
            o = MFMA32(__builtin_bit_cast(bf16x8, tq), pack8(pv), o); }
    }
    { bf16x8 sf[8];
#pragma unroll
      for (int kk = 0; kk < 8; ++kk) sf[kk] = *(const GAS bf16x8*)(strow + 16 * kk);
#pragma unroll
      for (int kk = 0; kk < 8; ++kk) { const int d0 = 16 * kk + 8 * hf;
          const v4u qv = qg[kk];
          const f32x4 b0 = *(const LAS f32x4*)(bt + t * HG_BS + d0), b1 = *(const LAS f32x4*)(bt + t * HG_BS + d0 + 4);
          float ve[8] = {bflo(qv.x) * __expf(b0.x), bfhi(qv.x) * __expf(b0.y), bflo(qv.y) * __expf(b0.z), bfhi(qv.y) * __expf(b0.w), bflo(qv.z) * __expf(b1.x), bfhi(qv.z) * __expf(b1.y), bflo(qv.w) * __expf(b1.z), bfhi(qv.w) * __expf(b1.w)};
          o = MFMA32(sf[kk], pack8(ve), o); } }
    float ss = 0.f;
#pragma unroll
    for (int r = 0; r < 16; ++r) ss += o[r] * o[r];
    ss += xor32f(ss, hf);
    if (hf == 0) red[(tt * 4 + dvt) * 32 + cl] = ss;
    __syncthreads();
    const float rstd = __builtin_amdgcn_rsqf(((red[(tt * 4 + 0) * 32 + cl] + red[(tt * 4 + 1) * 32 + cl]) + (red[(tt * 4 + 2) * 32 + cl] + red[(tt * 4 + 3) * 32 + cl])) * (1.0f / 128.0f) + EPS);
#pragma unroll
    for (int g = 0; g < 4; ++g) { const int dv0 = 32 * dvt + 8 * g + 4 * hf; const size_t off = (n0 + t) * 1024 + h * 128 + dv0;
        const unsigned gg = *(const GAS unsigned*)((const unsigned char*)GHG + off); const f32x4 w4 = *(const GAS f32x4*)(nw + dv0);
        const float rq = rstd * (ACT_QS / 255.0f);
        *(GAS unsigned*)((unsigned char*)OUT + off) = pack_i8x4c(o[4 * g] * rq * w4.x * (float)(gg & 255u), o[4 * g + 1] * rq * w4.y * (float)((gg >> 8) & 255u), o[4 * g + 2] * rq * w4.z * (float)((gg >> 16) & 255u), o[4 * g + 3] * rq * w4.w * (float)(gg >> 24)); }
    __syncthreads();
}
__device__ __forceinline__ void qknorm_rows4(bf16* row0, size_t rstride, const float* w, float scale, int lane) {
    v4u x[4][2];
#pragma unroll
    for (int i = 0; i < 4; ++i)
#pragma unroll
        for (int j = 0; j < 2; ++j) x[i][j] = *(const GAS v4u*)(row0 + i * rstride + 8 * lane + 512 * j);
    const f32x4 wa = *(const GAS f32x4*)(w + ((8 * lane) & 127)), wb = *(const GAS f32x4*)(w + ((8 * lane) & 127) + 4);
#pragma unroll
    for (int i = 0; i < 4; ++i)
#pragma unroll
        for (int j = 0; j < 2; ++j) { const v4u xx = x[i][j];
            float f[8] = {bflo(xx.x), bfhi(xx.x), bflo(xx.y), bfhi(xx.y), bflo(xx.z), bfhi(xx.z), bflo(xx.w), bfhi(xx.w)};
            float ss = 0.f;
#pragma unroll
            for (int k = 0; k < 8; ++k) ss += f[k] * f[k];
            ss += __shfl_xor(ss, 1); ss += __shfl_xor(ss, 2); ss += __shfl_xor(ss, 4); ss += __shfl_xor(ss, 8);
            const float r = __builtin_amdgcn_rsqf(ss * (1.0f / 128.0f) + EPS) * scale;
            v4u o; o.x = pk2c(f[0] * r * wa.x, f[1] * r * wa.y); o.y = pk2c(f[2] * r * wa.z, f[3] * r * wa.w); o.z = pk2c(f[4] * r * wb.x, f[5] * r * wb.y); o.w = pk2c(f[6] * r * wb.z, f[7] * r * wb.w);
            *(GAS v4u*)(row0 + i * rstride + 8 * lane + 512 * j) = o; }
}
__device__ __forceinline__ void vt_item(int item, int lane, const bf16* vsb, bf16* vt, LAS unsigned short* scr) {
    const int db = item & 3, sb = (item >> 2) & 63, bh = item >> 8, b = bh >> 3, h = bh & 7;
    const bf16* src = vsb + ((size_t)b * SEQ + sb * 64) * 1024 + h * 128 + db * 32;
#pragma unroll 4
    for (int i = 0; i < 16; ++i) { const int r = 4 * i + (lane >> 4); *(LAS unsigned*)(scr + r * 34 + 2 * (lane & 15)) = *(const GAS unsigned*)(src + (size_t)r * 1024 + 2 * (lane & 15)); }
    LDS_WAIT();
    const int c = lane & 7, b0 = 16 * (c >> 1) + 4 * (c & 1);
#pragma unroll
    for (int j = 0; j < 4; ++j) { const int d = (lane >> 3) + 8 * j; const LAS unsigned short* s = scr + b0 * 34 + d;
        v4u o; o.x = (unsigned)s[0] | ((unsigned)s[34] << 16); o.y = (unsigned)s[68] | ((unsigned)s[102] << 16); o.z = (unsigned)s[8 * 34] | ((unsigned)s[9 * 34] << 16); o.w = (unsigned)s[10 * 34] | ((unsigned)s[11 * 34] << 16);
        *(GAS v4u*)(vt + ((size_t)bh * 128 + db * 32 + d) * SEQ + sb * 64 + 8 * c) = o; }
    LDS_WAIT();
}

constexpr int AT_BUF = 32768, AT_VOFF = 16384;
__device__ __forceinline__ f32x16 attn_scores(const LAS unsigned char* kt, int krow, int hf, const bf16x8 (&qf)[8]) {
    f32x16 sa;
#pragma unroll
    for (int r = 0; r < 16; ++r) sa[r] = 0.f;
    const LAS unsigned char* kp = kt + krow * 256; const int sw = krow & 15;
#pragma unroll
    for (int kk = 0; kk < 8; ++kk) sa = MFMA32(*(const LAS bf16x8*)(kp + (((2 * kk + hf) ^ sw) << 4)), qf[kk], sa);
    return sa;
}
template <bool DIAG> __device__ __forceinline__ void attn_weights(const f32x16& sa, float& R, int hf, int cl, bf16x8 (&pf)[2]) {
    float om[16];
#pragma unroll
    for (int r = 0; r < 16; ++r) om[r] = __builtin_amdgcn_rcpf(1.0f + __builtin_amdgcn_exp2f(sa[r]));
    if (DIAG) {
#pragma unroll
        for (int r = 0; r < 16; ++r) if (((r & 3) + 8 * (r >> 2) + 4 * hf) >= cl) om[r] = 1.0f;
    }
    float Gs[4], Gp[4];
#pragma unroll
    for (int g = 0; g < 4; ++g) { Gs[g] = (om[4 * g] * om[4 * g + 1]) * (om[4 * g + 2] * om[4 * g + 3]); Gp[g] = xor32f(Gs[g], hf); }
    float tail = R; float w[16];
#pragma unroll
    for (int g = 3; g >= 0; --g) {
        const float c3 = tail * (hf == 0 ? Gp[g] : 1.0f), c2 = c3 * om[4 * g + 3], c1 = c2 * om[4 * g + 2], c0 = c1 * om[4 * g + 1];
        w[4 * g + 3] = c3 - om[4 * g + 3] * c3; w[4 * g + 2] = c2 - om[4 * g + 2] * c2; w[4 * g + 1] = c1 - om[4 * g + 1] * c1; w[4 * g] = c0 - om[4 * g] * c0;
        tail *= Gs[g] * Gp[g];
    }
    R = tail;
#pragma unroll
    for (int sp = 0; sp < 2; ++sp) { v4u t; t.x = pk2c(w[8 * sp], w[8 * sp + 1]); t.y = pk2c(w[8 * sp + 2], w[8 * sp + 3]); t.z = pk2c(w[8 * sp + 4], w[8 * sp + 5]); t.w = pk2c(w[8 * sp + 6], w[8 * sp + 7]); pf[sp] = __builtin_bit_cast(bf16x8, t); }
}
__device__ __forceinline__ void attn_pv(const LAS unsigned char* vt, int sub, int cl, int hf, const bf16x8 (&pf)[2], f32x16 (&o)[4]) {
#pragma unroll
    for (int d = 0; d < 4; ++d) { const int row = 32 * d + cl; const LAS unsigned char* vp = vt + row * 128; const int sw = (row >> 1) & 7;
#pragma unroll
        for (int sp = 0; sp < 2; ++sp) { const int x = 4 * sub + 2 * sp + hf;
            o[d] = MFMA32(*(const LAS bf16x8*)(vp + ((x ^ sw) << 4)), pf[sp], o[d]); } }
}
template <bool LAG> __device__ __forceinline__ void attn_unit(const Ctx& c, int bh, int qb, const bf16* qsb, const bf16* ksb, const bf16* vt, bf16* outb) {
    int lane_ = c.lane; asm volatile("" : "+v"(lane_));
    const int b = bh >> 3, h = bh & 7, lane = lane_, cl = lane & 31, hf = lane >> 5;
    const size_t rb = (size_t)b * SEQ; const int q0w = 256 * qb + 32 * c.wave;
    bf16x8 qf[8];
    { const bf16* qrow = qsb + (rb + q0w + cl) * 1024 + h * 128 + 8 * hf;
#pragma unroll
      for (int kk = 0; kk < 8; ++kk) qf[kk] = *(const GAS bf16x8*)(qrow + 16 * kk); }
    f32x16 o[4];
#pragma unroll
    for (int d = 0; d < 4; ++d)
#pragma unroll
        for (int r = 0; r < 16; ++r) o[d][r] = 0.f;
    float R = 1.0f;
    bf16x8 pd[2]; const LAS unsigned char* vimd = c.lds; int subd = 0; bool pending = false;
    const int kr0 = 8 * c.wave + (lane >> 4), kr1 = kr0 + 4;
    const bf16* kg0 = ksb + (rb + kr0) * 1024 + h * 128 + (((lane & 15) ^ (kr0 & 15)) << 3);
    const bf16* kg1 = ksb + (rb + kr1) * 1024 + h * 128 + (((lane & 15) ^ (kr1 & 15)) << 3);
    const int vr0 = 16 * c.wave + (lane >> 3), vr1 = vr0 + 8;
    const bf16* vg0 = vt + ((size_t)bh * 128 + vr0) * SEQ + (((lane & 7) ^ ((vr0 >> 1) & 7)) << 3);
    const bf16* vg1 = vt + ((size_t)bh * 128 + vr1) * SEQ + (((lane & 7) ^ ((vr1 >> 1) & 7)) << 3);
    LAS unsigned char* dk = c.lds + c.wave * 2048; LAS unsigned char* dv = c.lds + AT_VOFF + c.wave * 2048;
#define AT_DMA(kt_, bi_) do { const int ktt_ = (kt_); LAS unsigned char* bb_ = (LAS unsigned char*)0 + (bi_) * AT_BUF; \
        __builtin_amdgcn_global_load_lds((const unsigned*)(kg0 + (size_t)ktt_ * 64 * 1024), (LAS unsigned*)(dk + (bi_) * AT_BUF), 16, 0, 0); \
        __builtin_amdgcn_global_load_lds((const unsigned*)(kg1 + (size_t)ktt_ * 64 * 1024), (LAS unsigned*)(dk + (bi_) * AT_BUF + 1024), 16, 0, 0); \
        __builtin_amdgcn_global_load_lds((const unsigned*)(vg0 + ktt_ * 64), (LAS unsigned*)(dv + (bi_) * AT_BUF), 16, 0, 0); \
        __builtin_amdgcn_global_load_lds((const unsigned*)(vg1 + ktt_ * 64), (LAS unsigned*)(dv + (bi_) * AT_BUF + 1024), 16, 0, 0); (void)bb_; } while (0)
    const int nkt = 4 * (qb + 1);
    asm volatile("s_waitcnt vmcnt(0)" ::: "memory");
    AT_DMA(nkt - 1, 0); AT_DMA(nkt - 2, 1);
    asm volatile("s_waitcnt vmcnt(4)" ::: "memory"); __builtin_amdgcn_s_barrier(); asm volatile("" ::: "memory");
    int bi = 0;
#pragma unroll 1
    for (int it = 0; it < nkt; ++it) {
        const int kt = nkt - 1 - it;
        const int b2 = (bi + 2) & 3;
        if (it + 2 < nkt) AT_DMA(kt - 2, b2);
        const LAS unsigned char* kim = c.lds + bi * AT_BUF; const LAS unsigned char* vim = kim + AT_VOFF;
        const int rel = q0w - 64 * kt;
        if (rel >= 32) {
            if (LAG) { if (pending) attn_pv(vimd, subd, cl, hf, pd, o);
                const f32x16 s1 = attn_scores(kim, 32 + cl, hf, qf); if (rel == 32) attn_weights<true>(s1, R, hf, cl, pd); else attn_weights<false>(s1, R, hf, cl, pd);
                vimd = vim; subd = 1; pending = true;
            } else { bf16x8 p[2];
                { const f32x16 s1 = attn_scores(kim, 32 + cl, hf, qf); if (rel == 32) attn_weights<true>(s1, R, hf, cl, p); else attn_weights<false>(s1, R, hf, cl, p); }
                attn_pv(vim, 1, cl, hf, p, o); }
        }
        if (rel >= 0) {
            if (LAG) { if (pending) attn_pv(vimd, subd, cl, hf, pd, o);
                const f32x16 s0 = attn_scores(kim, cl, hf, qf); if (rel == 0) attn_weights<true>(s0, R, hf, cl, pd); else attn_weights<false>(s0, R, hf, cl, pd);
                vimd = vim; subd = 0; pending = true;
            } else { bf16x8 p[2];
                { const f32x16 s0 = attn_scores(kim, cl, hf, qf); if (rel == 0) attn_weights<true>(s0, R, hf, cl, p); else attn_weights<false>(s0, R, hf, cl, p); }
                attn_pv(vim, 0, cl, hf, p, o); }
        }
        if (it + 2 < nkt) asm volatile("s_waitcnt vmcnt(4)\n\ts_waitcnt lgkmcnt(0)" ::: "memory"); else asm volatile("s_waitcnt vmcnt(0)\n\ts_waitcnt lgkmcnt(0)" ::: "memory");
        __builtin_amdgcn_s_barrier(); asm volatile("" ::: "memory");
        bi = (bi + 1) & 3;
    }
#undef AT_DMA
    if (LAG && pending) attn_pv(vimd, subd, cl, hf, pd, o);
    bf16* orow = outb + (rb + q0w + cl) * 1024 + h * 128 + 4 * hf;
#pragma unroll
    for (int d = 0; d < 4; ++d)
#pragma unroll
        for (int g = 0; g < 4; ++g) { v2u q; q.x = pk2c(o[d][4 * g], o[d][4 * g + 1]); q.y = pk2c(o[d][4 * g + 2], o[d][4 * g + 3]); *(GAS v2u*)(orow + 32 * d + 8 * g) = q; }
    asm volatile("s_waitcnt vmcnt(0)" ::: "memory"); __builtin_amdgcn_s_barrier(); asm volatile("" ::: "memory");
}
__device__ __forceinline__ void hgpost_row(bf16* row, const bf16* grow, const float* w, int lane) {
#pragma unroll
    for (int j = 0; j < 2; ++j) {
        GAS v4u* p = (GAS v4u*)(row + 8 * lane + 512 * j); const v4u x = *p; const v4u gg = *(const GAS v4u*)(grow + 8 * lane + 512 * j);
        float f[8] = {bflo(x.x), bfhi(x.x), bflo(x.y), bfhi(x.y), bflo(x.z), bfhi(x.z), bflo(x.w), bfhi(x.w)};
        const float g[8] = {bflo(gg.x), bfhi(gg.x), bflo(gg.y), bfhi(gg.y), bflo(gg.z), bfhi(gg.z), bflo(gg.w), bfhi(gg.w)};
        float ss = 0.f;
#pragma unroll
        for (int k = 0; k < 8; ++k) ss += f[k] * f[k];
        ss += __shfl_xor(ss, 1); ss += __shfl_xor(ss, 2); ss += __shfl_xor(ss, 4); ss += __shfl_xor(ss, 8);
        const float r = __builtin_amdgcn_rsqf(ss * (1.0f / 128.0f) + EPS);
        const f32x4 wa = *(const GAS f32x4*)(w + ((8 * lane) & 127)), wb = *(const GAS f32x4*)(w + ((8 * lane) & 127) + 4);
        v4u o; o.x = pk2c(f[0] * r * wa.x * g[0], f[1] * r * wa.y * g[1]); o.y = pk2c(f[2] * r * wa.z * g[2], f[3] * r * wa.w * g[3]);
        o.z = pk2c(f[4] * r * wb.x * g[4], f[5] * r * wb.y * g[5]); o.w = pk2c(f[6] * r * wb.z * g[6], f[7] * r * wb.w * g[7]);
        *p = o;
    }
}

template <bool FIRST> struct EpiMerge {
    static constexpr bool PERM = true, AFTER_DRAIN = false;
    const unsigned char* gate; bf16* merged;
    __device__ __forceinline__ float rowscale(int) const { return 1.0f / (ACT_QS * WBR_QS); }
    __device__ __forceinline__ void operator()(const pg8::f32x4 (&acc)[2][2][4][2], const pg8::Unit& u, int wr, int wc, int fr, int fq) const {
        const int row0 = u.pm * 256 + wr * 64 + fr, col0 = u.pn * 256 + wc * 32 + 8 * fq;
#pragma unroll
        for (int ai = 0; ai < 2; ++ai)
#pragma unroll
            for (int m = 0; m < 4; ++m) {
                if (m == 0) asm volatile("" ::: "memory");
#pragma unroll
                for (int bj = 0; bj < 2; ++bj) {
                    const size_t off = (size_t)(row0 + ai * 128 + m * 16) * 2048 + col0 + bj * 128;
                    const v2u g = *(const GAS v2u*)(gate + off); const pg8::f32x4 v0 = acc[ai][bj][m][0], v1 = acc[ai][bj][m][1]; constexpr float k = 1.0f / 255.0f;
                    float r[8] = {(float)(g.x & 255u) * (v0[0] * k), (float)((g.x >> 8) & 255u) * (v0[1] * k), (float)((g.x >> 16) & 255u) * (v0[2] * k), (float)(g.x >> 24) * (v0[3] * k),
                                  (float)(g.y & 255u) * (v1[0] * k), (float)((g.y >> 8) & 255u) * (v1[1] * k), (float)((g.y >> 16) & 255u) * (v1[2] * k), (float)(g.y >> 24) * (v1[3] * k)};
                    if (!FIRST) { const v4u mo = *(const GAS v4u*)(merged + off);
                        r[0] += bflo(mo.x); r[1] += bfhi(mo.x); r[2] += bflo(mo.y); r[3] += bfhi(mo.y); r[4] += bflo(mo.z); r[5] += bfhi(mo.z); r[6] += bflo(mo.w); r[7] += bfhi(mo.w); }
                    v4u w; w.x = pk2c(r[0], r[1]); w.y = pk2c(r[2], r[3]); w.z = pk2c(r[4], r[5]); w.w = pk2c(r[6], r[7]);
                    *(GAS v4u*)(merged + off) = w; }
            }
    }
};
struct EpiStoreBf16 {
    static constexpr bool PERM = true, AFTER_DRAIN = false;
    bf16* out; const float* sa;
    __device__ __forceinline__ float rowscale(int row) const { return ((const GAS float*)sa)[row] * (1.0f / WIN_QS); }
    __device__ __forceinline__ void operator()(const pg8::f32x4 (&acc)[2][2][4][2], const pg8::Unit& u, int wr, int wc, int fr, int fq) const {
        const int row0 = u.pm * 256 + wr * 64 + fr, col0 = u.pn * 256 + wc * 32 + 8 * fq;
#pragma unroll
        for (int ai = 0; ai < 2; ++ai)
#pragma unroll
            for (int m = 0; m < 4; ++m)
#pragma unroll
                for (int bj = 0; bj < 2; ++bj) { const pg8::f32x4 v0 = acc[ai][bj][m][0], v1 = acc[ai][bj][m][1];
                    v4u w; w.x = pk2c(v0[0], v0[1]); w.y = pk2c(v0[2], v0[3]); w.z = pk2c(v1[0], v1[1]); w.w = pk2c(v1[2], v1[3]);
                    *(GAS v4u*)(out + (size_t)(row0 + ai * 128 + m * 16) * 2048 + col0 + bj * 128) = w; }
    }
};
struct EpiResid {
    static constexpr bool PERM = true, AFTER_DRAIN = false;
    const void* xin; bf16* xout; const float* ms; int XIN_BF16;
    __device__ __forceinline__ float rowscale(int row) const { return ((const GAS float*)ms)[row] * (1.0f / WIN_QS); }
    __device__ __forceinline__ void operator()(const pg8::f32x4 (&acc)[2][2][4][2], const pg8::Unit& u, int wr, int wc, int fr, int fq) const {
        const int row0 = u.pm * 256 + wr * 64 + fr, col0 = u.pn * 256 + wc * 32 + 8 * fq;
#pragma unroll
        for (int ai = 0; ai < 2; ++ai)
#pragma unroll
            for (int m = 0; m < 4; ++m)
#pragma unroll
                for (int bj = 0; bj < 2; ++bj) { const size_t off = (size_t)(row0 + ai * 128 + m * 16) * 2048 + col0 + bj * 128;
                    const pg8::f32x4 v0 = acc[ai][bj][m][0], v1 = acc[ai][bj][m][1]; float r[8];
                    if (XIN_BF16) { const v4u x = *(const GAS v4u*)((const bf16*)xin + off);
                        r[0] = v0[0] + bflo(x.x); r[1] = v0[1] + bfhi(x.x); r[2] = v0[2] + bflo(x.y); r[3] = v0[3] + bfhi(x.y); r[4] = v1[0] + bflo(x.z); r[5] = v1[1] + bfhi(x.z); r[6] = v1[2] + bflo(x.w); r[7] = v1[3] + bfhi(x.w); }
                    else { const f32x4 x0 = *(const GAS f32x4*)((const float*)xin + off), x1 = *(const GAS f32x4*)((const float*)xin + off + 4);
                        r[0] = v0[0] + x0.x; r[1] = v0[1] + x0.y; r[2] = v0[2] + x0.z; r[3] = v0[3] + x0.w; r[4] = v1[0] + x1.x; r[5] = v1[1] + x1.y; r[6] = v1[2] + x1.z; r[7] = v1[3] + x1.w; }
                    v4u w; w.x = pk2c(r[0], r[1]); w.y = pk2c(r[2], r[3]); w.z = pk2c(r[4], r[5]); w.w = pk2c(r[6], r[7]);
                    *(GAS v4u*)(xout + off) = w; }
    }
};

__device__ __forceinline__ float rl_f(float v, int l) { return __uint_as_float((unsigned)__builtin_amdgcn_readlane((int)__float_as_uint(v), l)); }
__device__ __forceinline__ void ins16(float (&L)[16], float x) {
#pragma unroll
    for (int i = 0; i < 16; ++i) { const float hi = __builtin_fmaxf(L[i], x); x = __builtin_fminf(L[i], x); L[i] = hi; }
}
#define CE_DESC(a, b) do { const float hi_ = __builtin_fmaxf(a, b), lo_ = __builtin_fminf(a, b); a = hi_; b = lo_; } while (0)
__device__ __forceinline__ void sort16_desc(float (&v)[16]) {
#pragma unroll
    for (int k = 2; k <= 16; k <<= 1)
#pragma unroll
        for (int j = k >> 1; j > 0; j >>= 1)
#pragma unroll
            for (int i = 0; i < 16; ++i) { const int l = i ^ j; if (l > i) { if ((i & k) == 0) CE_DESC(v[i], v[l]); else CE_DESC(v[l], v[i]); } }
}
__device__ __forceinline__ void bitonic_merge16_desc(float (&v)[16]) {
#pragma unroll
    for (int j = 8; j > 0; j >>= 1)
#pragma unroll
        for (int i = 0; i < 16; ++i) { const int l = i ^ j; if (l > i) CE_DESC(v[i], v[l]); }
}
__device__ __forceinline__ void top16_merge(float (&L)[16], const float (&T)[16]) {
#pragma unroll
    for (int i = 0; i < 16; ++i) L[i] = __builtin_fmaxf(L[i], T[15 - i]);
    bitonic_merge16_desc(L);
}
constexpr int PK_KS = 272;
__device__ __forceinline__ void peer_top16(const bf16* qrow  , const LAS unsigned char* kl  , int hf, float (&L)[16]) {
    bf16x8 qf[8];
#pragma unroll
    for (int kk = 0; kk < 8; ++kk) qf[kk] = *(const GAS bf16x8*)(qrow + 16 * kk);
#pragma unroll 1
    for (int kt = 0; kt < 4; ++kt) {
        f32x16 sa;
#pragma unroll
        for (int r = 0; r < 16; ++r) sa[r] = 0.f;
#pragma unroll
        for (int kk = 0; kk < 8; ++kk) sa = MFMA32(*(const LAS bf16x8*)(kl + kt * 32 * PK_KS + 32 * kk), qf[kk], sa);
        float T[16];
#pragma unroll
        for (int r = 0; r < 16; ++r) { const unsigned idx = (unsigned)(kt * 32 + (r & 3) + 8 * (r >> 2) + 4 * hf); T[r] = __uint_as_float((__float_as_uint(sa[r]) & ~127u) | idx); }
        sort16_desc(T);
        if (kt == 0) {
#pragma unroll
            for (int i = 0; i < 16; ++i) L[i] = T[i];
        } else top16_merge(L, T);
    }
    float P[16];
#pragma unroll
    for (int i = 0; i < 16; ++i) P[i] = __shfl_xor(L[i], 32);
    top16_merge(L, P);
}
__device__ __forceinline__ void peer_select32(int hd, int n0, int lane, const bf16* qpeer, const LAS unsigned char* kl1, const LAS unsigned char* kl2, unsigned char* wsb, LAS unsigned* ldsw) {
    asm volatile("" : "+v"(lane));
    const int c = lane & 31, hf = lane >> 5, n = n0 + c;
    const bf16* qrow = qpeer + (size_t)n * 2048 + hd * 256 + 8 * hf;
    float A[16], B[16];
    peer_top16(qrow, kl1 + c * PK_KS + 16 * hf, hf, A);
    peer_top16(qrow + 128, kl2 + c * PK_KS + 16 * hf, hf, B);
#define PKV(x) __uint_as_float(__float_as_uint(x) & ~127u)
#define PKI(x) ((int)(__float_as_uint(x) & 127u))
    float W[16];
    { float C0[16], C1[16], C2[16], E0 = 0.f, E1 = 0.f; unsigned id = 0;
#pragma unroll
      for (int a = 0; a < 16; ++a)
#pragma unroll
        for (int b = 0; b < 16; ++b) if ((a + 1) * (b + 1) <= 16) { const float pk = __uint_as_float((__float_as_uint(PKV(A[a]) + PKV(B[b])) & ~63u) | id);
            if (id < 16) C0[id] = pk; else if (id < 32) C1[id - 16] = pk; else if (id < 48) C2[id - 32] = pk; else if (id == 48) E0 = pk; else E1 = pk;
            ++id; }
      sort16_desc(C0); sort16_desc(C1); sort16_desc(C2);
      top16_merge(C0, C1); top16_merge(C0, C2);
#pragma unroll
      for (int i = 0; i < 16; ++i) W[i] = C0[i];
      ins16(W, E0); ins16(W, E1); }
    const float thr = W[15], mx = W[0];
    int cnt = 0; float ssum = 0.f;
    LAS int* le = (LAS int*)ldsw + c * 16; LAS float* lg = (LAS float*)ldsw + 512 + c * 16;
    { unsigned id = 0;
#pragma unroll
      for (int a = 0; a < 16; ++a)
#pragma unroll
        for (int b = 0; b < 16; ++b) if ((a + 1) * (b + 1) <= 16) {
            const float cv = PKV(A[a]) + PKV(B[b]); const float pk = __uint_as_float((__float_as_uint(cv) & ~63u) | id); ++id;
            if (pk >= thr) { const float e = __expf(cv - mx); if (hf == 0) { le[cnt] = PKI(A[a]) * 128 + PKI(B[b]); lg[cnt] = e; } ssum += e; ++cnt; }
        } }
    LDS_WAIT();
    asm volatile("" : "+s"(wsb));
    int* sel_e = (int*)(wsb + WS_SEL); float* sel_g = (float*)(wsb + WS_SEL + 8 * MiB); float* sel_s = (float*)(wsb + WS_SELS);
    { int lane3 = lane; asm volatile("" : "+v"(lane3)); const int t = lane3 >> 1, part = lane3 & 1;
      const v4u e0 = *(const LAS v4u*)((LAS int*)ldsw + t * 16 + 8 * part), e1 = *(const LAS v4u*)((LAS int*)ldsw + t * 16 + 8 * part + 4);
      const v4u g0 = *(const LAS v4u*)((LAS int*)ldsw + 512 + t * 16 + 8 * part), g1 = *(const LAS v4u*)((LAS int*)ldsw + 512 + t * 16 + 8 * part + 4);
      GAS v4u* pe = (GAS v4u*)(sel_e + (size_t)(n0 + t) * 128 + hd * 16 + 8 * part); GAS v4u* pg = (GAS v4u*)(sel_g + (size_t)(n0 + t) * 128 + hd * 16 + 8 * part);
      pe[0] = e0; pe[1] = e1; pg[0] = g0; pg[1] = g1; }
    LDS_WAIT();
    { int lane4 = lane; asm volatile("" : "+v"(lane4)); if ((lane4 >> 5) == 0) ((GAS float*)sel_s)[(size_t)(n0 + (lane4 & 31)) * 8 + hd] = ssum; }
}

__device__ __forceinline__ float dot2bf(unsigned a, unsigned b, float acc) {
    return __builtin_amdgcn_fdot2_f32_bf16(__builtin_bit_cast(bf16v2, a), __builtin_bit_cast(bf16v2, b), acc, false);
}
__device__ __forceinline__ float dot8bf(const v4u a, const v4u b, float acc) {
    const unsigned a0 = a.x, a1 = a.y, a2 = a.z, a3 = a.w, b0 = b.x, b1 = b.y, b2 = b.z, b3 = b.w;
    acc = dot2bf(a0, b0, acc); acc = dot2bf(a1, b1, acc); acc = dot2bf(a2, b2, acc); acc = dot2bf(a3, b3, acc);
    return acc;
}
__device__ __forceinline__ void unpack16(const v4u q, float (&f)[16]) {
    const unsigned d0 = q.x, d1 = q.y, d2 = q.z, d3 = q.w;
    f32x2v t;
    t = __builtin_amdgcn_cvt_pk_f32_fp8((int)d0, false); f[0] = t.x; f[1] = t.y; t = __builtin_amdgcn_cvt_pk_f32_fp8((int)d0, true); f[2] = t.x; f[3] = t.y;
    t = __builtin_amdgcn_cvt_pk_f32_fp8((int)d1, false); f[4] = t.x; f[5] = t.y; t = __builtin_amdgcn_cvt_pk_f32_fp8((int)d1, true); f[6] = t.x; f[7] = t.y;
    t = __builtin_amdgcn_cvt_pk_f32_fp8((int)d2, false); f[8] = t.x; f[9] = t.y; t = __builtin_amdgcn_cvt_pk_f32_fp8((int)d2, true); f[10] = t.x; f[11] = t.y;
    t = __builtin_amdgcn_cvt_pk_f32_fp8((int)d3, false); f[12] = t.x; f[13] = t.y; t = __builtin_amdgcn_cvt_pk_f32_fp8((int)d3, true); f[14] = t.x; f[15] = t.y;
}
struct SliceSched { int mode, xcc, rank, nloc; };
__device__ __forceinline__ SliceSched slice_sched_init(const Ctx& c, unsigned* ctl, const XcdBarrier& bar, int use) {
    LAS int* sh = (LAS int*)(c.lds + 1024);
    if (c.tid == 0) {
        int ok = 1; unsigned tot = 0;
        for (int j = 0; j < 16; ++j) { const unsigned n = xb_ld(&bar.bar[XB_XCNT(j)]); tot += n; if ((j < 8) != (n > 0u)) ok = 0; }
        if (tot != (unsigned)c.G) ok = 0;
        const int xcc = (int)xb_xcc_id();
        int rank = 0, nloc = 1;
        if (ok) { nloc = (int)xb_ld(&bar.bar[XB_XCNT(xcc)]); rank = (int)xb_add(&ctl[CW_RANK + (use * 16 + xcc) * 64], 1u); if (rank >= nloc) ok = 0; }
        sh[0] = ok; sh[1] = xcc; sh[2] = rank; sh[3] = nloc;
    }
    __syncthreads();
    SliceSched S; S.mode = sh[0]; S.xcc = sh[1]; S.rank = sh[2]; S.nloc = sh[3];
    __syncthreads();
    return S;
}
__device__ __forceinline__ bool slice_item(const SliceSched& S, const Ctx& c, int i, int& slice, int& tb) {
    if (S.mode) { const int it = S.rank + i * S.nloc; if (it >= 512) return false; slice = S.xcc + 8 * (it >> 8); tb = it & 255; return true; }
    const int it = (int)blockIdx.x + i * c.G; if (it >= 4096) return false; slice = it >> 8; tb = it & 255; return true;
}
__device__ __forceinline__ void unpack16p(const v4u q, f32x2v (&f)[8]) {
    const unsigned d0 = q.x, d1 = q.y, d2 = q.z, d3 = q.w;
    f[0] = __builtin_amdgcn_cvt_pk_f32_fp8((int)d0, false); f[1] = __builtin_amdgcn_cvt_pk_f32_fp8((int)d0, true);
    f[2] = __builtin_amdgcn_cvt_pk_f32_fp8((int)d1, false); f[3] = __builtin_amdgcn_cvt_pk_f32_fp8((int)d1, true);
    f[4] = __builtin_amdgcn_cvt_pk_f32_fp8((int)d2, false); f[5] = __builtin_amdgcn_cvt_pk_f32_fp8((int)d2, true);
    f[6] = __builtin_amdgcn_cvt_pk_f32_fp8((int)d3, false); f[7] = __builtin_amdgcn_cvt_pk_f32_fp8((int)d3, true);
}
__device__ __forceinline__ void sddmm_load(const unsigned char* ubase, const LAS unsigned* ids16, v4u (&q)[16]) {
    int id[16];
#pragma unroll
    for (int i = 0; i < 4; ++i) { const v4u v = *(const LAS v4u*)(ids16 + 4 * i); id[4 * i] = (int)v.x; id[4 * i + 1] = (int)v.y; id[4 * i + 2] = (int)v.z; id[4 * i + 3] = (int)v.w; }
#pragma unroll
    for (int it = 0; it < 16; ++it) q[it] = *(const GAS v4u*)(ubase + (unsigned)id[it] * 128u);
}
__device__ __forceinline__ void sddmm_token(const v4u (&qc)[16], const v4u hv, const float hs, int lane, unsigned* dst) {
    const int hq[4] = {(int)hv.x, (int)hv.y, (int)hv.z, (int)hv.w};
    float p[16];
#pragma unroll
    for (int it = 0; it < 16; ++it) { int a = __builtin_amdgcn_sdot4((int)qc[it].x, hq[0], 0, false); a = __builtin_amdgcn_sdot4((int)qc[it].y, hq[1], a, false);
        a = __builtin_amdgcn_sdot4((int)qc[it].z, hq[2], a, false); a = __builtin_amdgcn_sdot4((int)qc[it].w, hq[3], a, false);
        p[it] = (float)a * hs; }
#pragma unroll
    for (int i = 0; i < 8; ++i) { const bool up = (lane & 4) != 0; const float snd = up ? p[i] : p[i + 8], kp = up ? p[i + 8] : p[i]; p[i] = kp + __shfl_xor(snd, 4); }
#pragma unroll
    for (int i = 0; i < 4; ++i) { const bool up = (lane & 2) != 0; const float snd = up ? p[i] : p[i + 4], kp = up ? p[i + 4] : p[i]; p[i] = kp + __shfl_xor(snd, 2); }
#pragma unroll
    for (int i = 0; i < 2; ++i) { const bool up = (lane & 1) != 0; const float snd = up ? p[i] : p[i + 2], kp = up ? p[i + 2] : p[i]; p[i] = kp + __shfl_xor(snd, 1); }
    *(GAS unsigned*)dst = pk2c(p[0], p[1]);
}
__device__ __forceinline__ void peer_sddmm_wave(int t0, int s, int lane, const unsigned char* H8, const float* SA, const unsigned char* UQ, const int* sel_e, float* part, LAS unsigned* ldsw) {
    const int cg = lane & 7, sg = lane >> 3;
#pragma unroll
    for (int j = 0; j < 4; ++j) *(LAS v4u*)(ldsw + 4 * (lane + 64 * j)) = *(const GAS v4u*)(sel_e + (size_t)t0 * 128 + 4 * (lane + 64 * j));
    LDS_WAIT();
    const unsigned char* ubase = UQ + (size_t)s * U8_SLICE + cg * 16;
    const LAS unsigned* idl = ldsw + sg * 16;
    const unsigned char* hbase = H8 + (size_t)t0 * 2048 + s * 128 + cg * 16;
    unsigned* pbase = (unsigned*)part + ((size_t)t0 * 16 + s) * 64 + lane;
    v4u qa[16], qb[16];
    v4u ha = *(const GAS v4u*)(hbase), hb; float sa = ((const GAS float*)SA)[t0], sb;
    sddmm_load(ubase, idl, qa);
#pragma unroll
    for (int k = 0; k < 6; k += 2) {
        hb = *(const GAS v4u*)(hbase + (size_t)(k + 1) * 2048); sb = ((const GAS float*)SA)[t0 + k + 1];
        sddmm_load(ubase, idl + (k + 1) * 128, qb);
        sddmm_token(qa, ha, sa, lane, pbase + (size_t)k * 1024);
        ha = *(const GAS v4u*)(hbase + (size_t)(k + 2) * 2048); sa = ((const GAS float*)SA)[t0 + k + 2];
        sddmm_load(ubase, idl + (k + 2) * 128, qa);
        sddmm_token(qb, hb, sb, lane, pbase + (size_t)(k + 1) * 1024);
    }
    hb = *(const GAS v4u*)(hbase + (size_t)7 * 2048); sb = ((const GAS float*)SA)[t0 + 7];
    sddmm_load(ubase, idl + 7 * 128, qb);
    sddmm_token(qa, ha, sa, lane, pbase + (size_t)6 * 1024);
    sddmm_token(qb, hb, sb, lane, pbase + (size_t)7 * 1024);
    LDS_WAIT();
}
__device__ __forceinline__ void peer_coef_tokens4(int t0, int ts, int lane, const float* part, const int* sel_e, float* sel_g, const float* sel_s, const float* US, const float* VS) {
    unsigned pv[4][16]; v2u e[4]; f32x2v g[4]; float dn[4];
#pragma unroll
    for (int i = 0; i < 4; ++i) { const int t = t0 + i * ts;
#pragma unroll
        for (int s = 0; s < 16; ++s) pv[i][s] = ((const GAS unsigned*)part)[((size_t)t * 16 + s) * 64 + lane];
        e[i] = *(const GAS v2u*)(sel_e + (size_t)t * 128 + 2 * lane); g[i] = *(const GAS f32x2v*)(sel_g + (size_t)t * 128 + 2 * lane); dn[i] = ((const GAS float*)sel_s)[(size_t)t * 8 + (lane >> 3)]; }
    float ux[4], uy[4], vx[4], vy[4];
#pragma unroll
    for (int i = 0; i < 4; ++i) { ux[i] = ((const GAS float*)US)[e[i].x]; uy[i] = ((const GAS float*)US)[e[i].y]; vx[i] = ((const GAS float*)VS)[e[i].x]; vy[i] = ((const GAS float*)VS)[e[i].y]; }
#pragma unroll
    for (int i = 0; i < 4; ++i) { const int t = t0 + i * ts; float a0 = 0.f, a1 = 0.f;
#pragma unroll
        for (int s = 0; s < 16; ++s) { a0 += bflo(pv[i][s]); a1 += bfhi(pv[i][s]); }
        const float inv = 1.0f / dn[i];
        const float ox = g[i].x * inv * gelu_exact(a0 * ux[i]) * vx[i], oy = g[i].y * inv * gelu_exact(a1 * uy[i]) * vy[i];
        const h2_t ha = {(_Float16)ox, (_Float16)ox}, hb = {(_Float16)oy, (_Float16)oy};
        *(GAS v2u*)(sel_g + (size_t)t * 128 + 2 * lane) = (v2u){__builtin_bit_cast(unsigned, ha), __builtin_bit_cast(unsigned, hb)}; }
}
__device__ __forceinline__ bool slice_item8(const SliceSched& S, const Ctx& c, int i, int& slice, int& tb) {
    if (S.mode) { const int it = S.rank + i * S.nloc; if (it >= 256) return false; slice = S.xcc; tb = it; return true; }
    const int it = (int)blockIdx.x + i * c.G; if (it >= 2048) return false; slice = it >> 8; tb = it & 255; return true;
}
template <int MODE = 0>
__device__ __forceinline__ void spmm6_load(const unsigned char* vbase, const LAS unsigned* ids8, v4u (&qa)[8], v2u (&qb)[8]) {
    const v4u i0 = *(const LAS v4u*)(ids8), i1 = *(const LAS v4u*)(ids8 + 4);
    const unsigned id[8] = {i0.x, i0.y, i0.z, i0.w, i1.x, i1.y, i1.z, i1.w};
    if constexpr (MODE == 2) {
#pragma unroll
        for (int it = 0; it < 8; ++it) { qa[it] = (v4u){id[it], id[it] + 1u, id[it] + 2u, id[it] + 3u}; qb[it] = (v2u){id[it] + 4u, id[it] + 5u}; }
        return; }
#pragma unroll
    for (int it = 0; it < 8; ++it) { const unsigned char* p = vbase + id[it] * 192u; qa[it] = *(const GAS v4u*)p; qb[it] = *(const GAS v2u*)(p + 16); }
}
template <int MODE = 0>
__device__ __forceinline__ void spmm6_fma(const v4u (&qa)[8], const v2u (&qb)[8], const LAS unsigned* cf8, h2_t (&y)[16]) {
    const v4u c0 = *(const LAS v4u*)(cf8), c1 = *(const LAS v4u*)(cf8 + 4);
    const unsigned cf[8] = {c0.x, c0.y, c0.z, c0.w, c1.x, c1.y, c1.z, c1.w};
    if constexpr (MODE == 1) {
#pragma unroll
        for (int it = 0; it < 8; ++it) { const unsigned x = (qa[it].x ^ qa[it].y) ^ (qa[it].z ^ qa[it].w) ^ (qb[it].x ^ qb[it].y) ^ cf[it]; y[it] = __builtin_bit_cast(h2_t, __builtin_bit_cast(unsigned, y[it]) ^ x); }
        return; }
#pragma unroll
    for (int it = 0; it < 8; ++it) { const v6u q = {qa[it].x, qa[it].y, qa[it].z, qa[it].w, qb[it].x, qb[it].y};
        const v32h_t f = __builtin_amdgcn_cvt_scalef32_pk32_f16_fp6(q, 1.0f); const h2_t c2 = __builtin_bit_cast(h2_t, cf[it]);
#pragma unroll
        for (int j = 0; j < 16; ++j) { const h2_t v = {f[2 * j], f[2 * j + 1]}; y[j] = __builtin_elementwise_fma(v, c2, y[j]); } }
}
template <int MODE = 0>
__device__ __forceinline__ void peer_spmm6_wave(int t0, int s, int lane, const unsigned char* V6, const int* sel_e, const float* coef, const bf16* x1, void* xout, int out_f32, LAS unsigned* ldsw) {
    const int cg = lane & 7, sg = lane >> 3;
#pragma unroll
    for (int j = 0; j < 4; ++j) { *(LAS v4u*)(ldsw + 4 * (lane + 64 * j)) = *(const GAS v4u*)(sel_e + (size_t)t0 * 128 + 4 * (lane + 64 * j));
        *(LAS v4u*)(ldsw + 1024 + 4 * (lane + 64 * j)) = *(const GAS v4u*)(coef + (size_t)t0 * 128 + 4 * (lane + 64 * j)); }
    LDS_WAIT();
    const unsigned char* vbase = V6 + (size_t)s * V6_SLICE + cg * 24;
    const LAS unsigned* idl = ldsw + sg * 16; const LAS unsigned* cfl = ldsw + 1024 + sg * 16;
    v4u qa0[8], qa1[8]; v2u qb0[8], qb1[8];
    spmm6_load<MODE>(vbase, idl, qa0, qb0);
    const size_t xoff = (size_t)t0 * 2048 + s * 256 + cg * 32 + 4 * sg;
    v2u xn = *(const GAS v2u*)(x1 + xoff);
#pragma unroll
    for (int k = 0; k < 8; ++k) {
        const v2u xv = xn;
        h2_t y[16];
#pragma unroll
        for (int j = 0; j < 16; ++j) y[j] = (h2_t){(_Float16)0.f, (_Float16)0.f};
        spmm6_load<MODE>(vbase, idl + k * 128 + 8, qa1, qb1);
        if (k < 7) xn = *(const GAS v2u*)(x1 + xoff + (size_t)(k + 1) * 2048);
        spmm6_fma<MODE>(qa0, qb0, cfl + k * 128, y);
        if (k < 7) spmm6_load<MODE>(vbase, idl + (k + 1) * 128, qa0, qb0);
        spmm6_fma<MODE>(qa1, qb1, cfl + k * 128 + 8, y);
        unsigned u[16];
#pragma unroll
        for (int j = 0; j < 16; ++j) u[j] = __builtin_bit_cast(unsigned, y[j]);
#pragma unroll
        for (int i = 0; i < 8; ++i) { const auto r = __builtin_amdgcn_permlane32_swap(u[i], u[i + 8], false, false); u[i] = __builtin_bit_cast(unsigned, __builtin_bit_cast(h2_t, (unsigned)r[0]) + __builtin_bit_cast(h2_t, (unsigned)r[1])); }
#pragma unroll
        for (int i = 0; i < 4; ++i) { const auto r = __builtin_amdgcn_permlane16_swap(u[i], u[i + 4], false, false); u[i] = __builtin_bit_cast(unsigned, __builtin_bit_cast(h2_t, (unsigned)r[0]) + __builtin_bit_cast(h2_t, (unsigned)r[1])); }
#pragma unroll
        for (int i = 0; i < 2; ++i) { const bool up = (lane & 8) != 0; const unsigned snd = up ? u[i] : u[i + 2], kp = up ? u[i + 2] : u[i]; u[i] = __builtin_bit_cast(unsigned, __builtin_bit_cast(h2_t, kp) + __builtin_bit_cast(h2_t, (unsigned)__shfl_xor((int)snd, 8))); }
        const h2_t r0 = __builtin_bit_cast(h2_t, u[0]), r1 = __builtin_bit_cast(h2_t, u[1]);
        f32x4 o; o.x = bflo(xv.x) + (float)r0[0]; o.y = bfhi(xv.x) + (float)r0[1]; o.z = bflo(xv.y) + (float)r1[0]; o.w = bfhi(xv.y) + (float)r1[1];
        if (out_f32) *(GAS f32x4*)((float*)xout + xoff + (size_t)k * 2048) = o;
        else *(GAS v2u*)((bf16*)xout + xoff + (size_t)k * 2048) = (v2u){pk2c(o.x, o.y), pk2c(o.z, o.w)};
    }
    LDS_WAIT();
}

struct Args { const float* in[21]; float* out; unsigned char* ws; int lo, hi, li, pad; };
__global__ void __launch_bounds__(512, 2) mk_fwd(Args args) {
    extern __shared__ __attribute__((aligned(16))) unsigned char lds_raw[];
    Ctx c; c.lds = (LAS unsigned char*)lds_raw; c.tid = threadIdx.x; c.lane = c.tid & 63; c.wave = __builtin_amdgcn_readfirstlane(c.tid >> 6);
    c.G = gridDim.x; c.gw = blockIdx.x * 8 + c.wave; c.NGW = c.G * 8;
    volatile LAS unsigned* MISC = (volatile LAS unsigned*)(c.lds + MISC_OFF);
    if (c.tid < 32) MISC[c.tid] = 0u;
    __syncthreads();
    unsigned char* ws = args.ws;
    const int lo = args.lo, hi = args.hi;
    XcdBarrier bar; bar.w0 = 0; bar.bar = (unsigned*)(ws + WS_CTL) + CW_BAR + args.li * XCD_BAR_WORDS; bar.x = 0; bar.st = nullptr;
    if (hi - lo > 1) bar = xcd_barrier_post((unsigned*)(ws + WS_CTL) + CW_BAR + args.li * XCD_BAR_WORDS, MISC + 8);
#ifndef ATTN_REPS
#define ATTN_REPS 1
#endif
#ifndef PHMASK
#define PHMASK 0x1fff
#endif
#ifndef REP_PH
#define REP_PH (-1)
#endif
    int rep2 = 2; asm volatile("" : "+s"(rep2));
#define RLOOP(k, cond) for (int rp_ = 0; rp_ < ((((k) == REP_PH) && (cond)) ? rep2 : 1); ++rp_)
#define RSYNC do { if (rp_) xcd_barrier(bar); } while (0)
#define IN(k) (((PHMASK >> ((k) % NPH)) & 1) && lo <= (k) && (k) < hi)
#define SEAM(k) do { if (IN(k) && IN((k) + 1)) xcd_barrier(bar); } while (0)
#define PH_BEGIN unsigned char* w = ws; float* outp = args.out; Ctx cc = c; int zi = 0; cc.lane = xb_lane_id(); cc.tid = cc.wave * 64 + cc.lane; \
    asm volatile("" : "+s"(w), "+s"(outp), "+s"(zi), "+v"(cc.tid), "+v"(cc.lane)); (void)w; (void)outp;
#define INP(k) (args.in[(k) + zi])
#define WSP(T, off) ((T*)(w + (off)))
    for (int l = 0; l < 2; ++l) {
        const int pb = l * NPH;
        if (IN(pb + 0)) { PH_BEGIN
            P0Args a; a.w_in = INP(2) + (size_t)l * DM * INW; a.w_br_sb = INP(11) + (size_t)l * BW * DM; a.w_br_hg = INP(12) + (size_t)l * BW * DM; a.w_br_conv = INP(13) + (size_t)l * BW * DM;
            a.w_o = INP(14) + (size_t)l * DM * DM; a.w_q = INP(16) + (size_t)l * DM * DM; a.u = INP(19) + (size_t)l * 16384 * 2048; a.v = INP(20) + (size_t)l * 16384 * 2048; a.lbp = INP(5);
            a.WinT = WSP(bf16, WS_WIN); a.WbrT = WSP(bf16, WS_WBR); a.WoT = WSP(bf16, WS_WO); a.WqT = WSP(bf16, WS_WQ); a.U = WSP(unsigned char, WS_U); a.V = WSP(unsigned char, WS_V); a.US = WSP(float, WS_US); a.VS = WSP(float, WS_VS); a.LB = WSP(float, WS_LB); a.layer = l; a.k1 = INP(17) + (size_t)l * 8 * 16384; a.k2 = INP(18) + (size_t)l * 8 * 16384; a.KB = WSP(bf16, WS_KEYS);
#ifndef REP_MODE0
#define REP_MODE0 15
#endif
            RLOOP(0, true) { RSYNC;
            int pm_ = 15; if (REP_PH == 0) { pm_ = rp_ ? REP_MODE0 : 15; asm volatile("" : "+s"(pm_)); }
            p0_convert(cc, a, pm_);
            if (pm_ & 8) { if (l == 0) rms_phase_i8(cc, INP(0), INP(1) + (size_t)l * DM, WSP(unsigned char, WS_H), WSP(float, WS_SA));
                           else rms_phase_i8b(cc, WSP(const bf16, WS_X2), INP(1) + (size_t)l * DM, WSP(unsigned char, WS_H), WSP(float, WS_SA)); } }
        }
        SEAM(pb + 0);
        if (IN(pb + 1)) { PH_BEGIN
            RLOOP(1, true) { RSYNC;
            pg8::Gemm g{WSP(bf16, WS_H), WSP(bf16, WS_WIN), NTOK, INW, DM}; pg8::StaticOrder S; S.init(NTOK, INW, cc.G, (int)blockIdx.x);
            EpiIn E{WSP(bf16, WS_SEG), WSP(bf16, WS_GATE), WSP(float, WS_LB), WSP(float, WS_SA)};
            pg8::gemm_phase<EpiIn, pg8::StaticOrder, true, true, true>(cc.lds, g, S, E, cc.wave); }
        }
        SEAM(pb + 1);
        if (IN(pb + 2)) { PH_BEGIN
            bf16* SEG = WSP(bf16, WS_SEG);
#ifndef REP_MODE2
#define REP_MODE2 7
#endif
            RLOOP(2, true) { RSYNC;
            int pm_ = 7; if (REP_PH == 2) { pm_ = rp_ ? REP_MODE2 : 7; asm volatile("" : "+s"(pm_)); }
            if (pm_ & 1)
            conv_phase(cc, SEG + 7 * SEGSZ, INP(7) + (size_t)l * 31 * 1024, INP(8) + (size_t)l * 1024, INP(9) + (size_t)l * 1024, INP(10) + (size_t)l * 1024, WSP(bf16, WS_CONV));
            if (pm_ & 2)
            for (int ci = blockIdx.x, par = 0; ci < 2048; ci += cc.G, par ^= 1) hgA_chunk(cc, ci, ci + cc.G, par, par == 0 && ci == (int)blockIdx.x, SEG + 4 * SEGSZ, SEG + 5 * SEGSZ, WSP(bf16, WS_ST), WSP(float, WS_DEC));
            if (!rp_)
            for (int r = cc.gw; r < 2 * (NTOK / 4); r += cc.NGW) {
                if (r < NTOK / 4) qknorm_rows4(SEG + (size_t)r * 4 * 1024, 1024, INP(3) + (size_t)l * 128, 0.08838834764831845f * 1.4426950408889634f, cc.lane);
                else qknorm_rows4(SEG + SEGSZ + (size_t)(r - NTOK / 4) * 4 * 1024, 1024, INP(4) + (size_t)l * 128, 1.0f, cc.lane);
            }
            LAS unsigned short* scr = (LAS unsigned short*)(cc.lds + 4096 + cc.wave * 8192);
            if (pm_ & 4)
            for (int it = cc.gw; it < 8192; it += cc.NGW) vt_item(it, cc.lane, SEG + 2 * SEGSZ, WSP(bf16, WS_MERGED), scr); }
        }
        SEAM(pb + 2);
        if (IN(pb + 3)) { PH_BEGIN
            bf16* SEG = WSP(bf16, WS_SEG);
            RLOOP(3, true) { RSYNC;
            if (!rp_) hgB(cc, WSP(bf16, WS_ST), WSP(float, WS_DEC));
            for (int p = blockIdx.x; p < 256; p += cc.G) { const int bh = (p & 7) * 4 + (p >> 6), j = (p >> 3) & 7;
                if (cc.wave >= 4) {
#pragma unroll 1
                    for (int u = 0; u < 2; ++u) attn_unit<true>(cc, bh, u ? j : 15 - j, SEG, SEG + SEGSZ, WSP(bf16, WS_MERGED), SEG + 2 * SEGSZ);
                } else {
#pragma unroll 1
                    for (int u = 0; u < 2; ++u) attn_unit<false>(cc, bh, u ? j : 15 - j, SEG, SEG + SEGSZ, WSP(bf16, WS_MERGED), SEG + 2 * SEGSZ);
                } } }
        }
        SEAM(pb + 3);
        if (IN(pb + 4)) { PH_BEGIN
            bf16* SEG = WSP(bf16, WS_SEG);
            RLOOP(4, true) { RSYNC;
            for (int ci = blockIdx.x, par = 0; ci < 2048; ci += cc.G, par ^= 1) hgC_chunk(cc, ci, ci + cc.G, par, par == 0 && ci == (int)blockIdx.x, SEG + 3 * SEGSZ, SEG + 4 * SEGSZ, SEG + 5 * SEGSZ, SEG + 6 * SEGSZ, WSP(bf16, WS_ST), INP(6) + (size_t)l * 128, WSP(bf16, WS_HGR)); }
        }
        SEAM(pb + 4);
        if (IN(pb + 5)) { PH_BEGIN
            RLOOP(5, true) { RSYNC;
            pg8::StaticOrder S; S.init(NTOK, DM, cc.G, (int)blockIdx.x);
            { pg8::Gemm g{WSP(bf16, WS_SEG) + 2 * SEGSZ, WSP(bf16, WS_WBR), NTOK, DM, BW}; EpiMerge<true> E{WSP(unsigned char, WS_GATE), WSP(bf16, WS_MERGED)}; pg8::gemm_phase<EpiMerge<true>, pg8::StaticOrder, true, true>(cc.lds, g, S, E, cc.wave); }
            { pg8::Gemm g{WSP(bf16, WS_HGR), WSP(bf16, WS_WBR) + (size_t)DM * BW, NTOK, DM, BW}; EpiMerge<false> E{WSP(unsigned char, WS_GATE) + (size_t)NTOK * 2048, WSP(bf16, WS_MERGED)}; pg8::gemm_phase<EpiMerge<false>, pg8::StaticOrder, true, true, true>(cc.lds, g, S, E, cc.wave); }
            { pg8::Gemm g{WSP(bf16, WS_CONV), WSP(bf16, WS_WBR) + (size_t)2 * DM * BW, NTOK, DM, BW}; EpiMerge<false> E{WSP(unsigned char, WS_GATE) + (size_t)2 * NTOK * 2048, WSP(bf16, WS_MERGED)}; pg8::gemm_phase<EpiMerge<false>, pg8::StaticOrder, true, true, true>(cc.lds, g, S, E, cc.wave); } }
        }
        SEAM(pb + 5);
        if (IN(pb + 6)) { PH_BEGIN
            RLOOP(6, true) { RSYNC;
            bf16_rows_i8(cc, WSP(bf16, WS_MERGED), WSP(unsigned char, WS_M8), WSP(float, WS_MS));
            xcd_barrier(bar);
            pg8::Gemm g{WSP(bf16, WS_M8), WSP(bf16, WS_WO), NTOK, DM, DM}; pg8::StaticOrder S; S.init(NTOK, DM, cc.G, (int)blockIdx.x);
            EpiResid E{l == 0 ? (const void*)INP(0) : (const void*)WSP(const bf16, WS_X2), WSP(bf16, WS_X1), WSP(float, WS_MS), l};
            pg8::gemm_phase<EpiResid, pg8::StaticOrder, true, true, true>(cc.lds, g, S, E, cc.wave); }
        }
        SEAM(pb + 6);
        if (IN(pb + 7)) { PH_BEGIN RLOOP(7, true) { RSYNC; rms_phase_i8b(cc, WSP(const bf16, WS_X1), INP(15) + (size_t)l * DM, WSP(unsigned char, WS_H), WSP(float, WS_SA)); } }
        SEAM(pb + 7);
        if (IN(pb + 8)) { PH_BEGIN
            RLOOP(8, true) { RSYNC;
            pg8::Gemm g{WSP(bf16, WS_H), WSP(bf16, WS_WQ), NTOK, DM, DM}; pg8::StaticOrder S; S.init(NTOK, DM, cc.G, (int)blockIdx.x);
            EpiStoreBf16 E{WSP(bf16, WS_QPEER), WSP(float, WS_SA)};
            pg8::gemm_phase<EpiStoreBf16, pg8::StaticOrder, true, true, true>(cc.lds, g, S, E, cc.wave); }
        }
        SEAM(pb + 8);
        if (IN(pb + 9)) { PH_BEGIN
            RLOOP(9, true) { RSYNC;
            for (int item = blockIdx.x; item < 512; item += cc.G) { const int hd = item & 7, tg = item >> 3;
                const bf16* KB = WSP(bf16, WS_KEYS); unsigned qo_ = (unsigned)WS_QPEER; asm volatile("" : "+s"(qo_)); const bf16* QP = (const bf16*)(w + qo_);
#pragma unroll
                for (int i = 0; i < 8; ++i) { const int p = cc.tid + 512 * i, li = p >> 11, row = (p >> 4) & 127, c16 = p & 15;
                    *(LAS v4u*)(cc.lds + li * 128 * PK_KS + row * PK_KS + c16 * 16) = *(const GAS v4u*)(KB + (size_t)(li * 8 + hd) * 16384 + row * 128 + c16 * 8); }
                __syncthreads();
                peer_select32(hd, tg * 256 + cc.wave * 32, cc.lane, QP, cc.lds, cc.lds + 128 * PK_KS, w, (LAS unsigned*)(cc.lds + 2 * 128 * PK_KS + cc.wave * 4096));
                __syncthreads(); } }
        }
        SEAM(pb + 9);
        if (IN(pb + 10)) { PH_BEGIN
            const SliceSched SS = slice_sched_init(cc, (unsigned*)(w + WS_CTL), bar, l * 2 + 0);
            RLOOP(10, true) { RSYNC;
            for (int i = 0;; ++i) { int sl, tb; if (!slice_item(SS, cc, i, sl, tb)) break;
                peer_sddmm_wave(tb * 64 + cc.wave * 8, sl, cc.lane, WSP(unsigned char, WS_H), WSP(float, WS_SA), WSP(unsigned char, WS_U), WSP(int, WS_SEL), WSP(float, WS_PART), (LAS unsigned*)(cc.lds + 4096 + cc.wave * 8192)); } }
        }
        SEAM(pb + 10);
        if (IN(pb + 11)) { PH_BEGIN
            for (int n = cc.gw; n < NTOK / 4; n += cc.NGW) peer_coef_tokens4(n, NTOK / 4, cc.lane, WSP(float, WS_PART), WSP(int, WS_SEL), WSP(float, WS_SEL + 8 * MiB), WSP(float, WS_SELS), WSP(float, WS_US), WSP(float, WS_VS));
        }
        SEAM(pb + 11);
        if (IN(pb + 12)) { PH_BEGIN
            void* xo = l == 0 ? (void*)WSP(bf16, WS_X2) : (void*)outp;
            const SliceSched SS = slice_sched_init(cc, (unsigned*)(w + WS_CTL), bar, l * 2 + 1);
            RLOOP(12, l == 0) { RSYNC;
            for (int i = 0;; ++i) { int sl, tb; if (!slice_item8(SS, cc, i, sl, tb)) break;
                peer_spmm6_wave(tb * 64 + cc.wave * 8, sl, cc.lane, WSP(unsigned char, WS_V), WSP(int, WS_SEL), WSP(float, WS_SEL + 8 * MiB), WSP(const bf16, WS_X1), xo, l, (LAS unsigned*)(cc.lds + 4096 + cc.wave * 8192)); } }
        }
        SEAM(pb + 12);
    }
#undef PH_BEGIN
#undef INP
#undef WSP
#undef IN
#undef SEAM
}

#ifndef MK_SPLIT
#define MK_SPLIT 0
#endif
extern "C" void kernel_launch(void* const* d_in, const int* in_sizes, int n_in, void* d_out, int out_size, void* d_ws, size_t ws_size, hipStream_t stream) {
    static int grid = 0;
    if (grid == 0) {
        if (n_in != 21 || out_size != NTOK * DM || ws_size < WS_END) { fprintf(stderr, "kernel_launch: unexpected shapes (n_in %d, out %d, ws %zu < %zu); nothing launched\n", n_in, out_size, ws_size, (size_t)WS_END); grid = -1; return; }
        int dev = 0, cus = 0, per_cu = 0;
        if (hipGetDevice(&dev) != hipSuccess || hipDeviceGetAttribute(&cus, hipDeviceAttributeMultiprocessorCount, dev) != hipSuccess) { grid = -1; return; }
        if (hipFuncSetAttribute((const void*)mk_fwd, hipFuncAttributeMaxDynamicSharedMemorySize, LDS_BYTES) != hipSuccess) { fprintf(stderr, "kernel_launch: hipFuncSetAttribute failed\n"); grid = -1; return; }
        if (hipOccupancyMaxActiveBlocksPerMultiprocessor(&per_cu, (const void*)mk_fwd, 512, LDS_BYTES) != hipSuccess || per_cu < 1) fprintf(stderr, "kernel_launch: occupancy query reports %d\n", per_cu);
        (void)hipGetLastError();
        grid = cus;
    }
    if (grid < 0) return;
    if (hipMemsetAsync((char*)d_ws + WS_CTL, 0, 1 * MiB, stream) != hipSuccess) { fprintf(stderr, "kernel_launch: memset failed\n"); return; }
    Args a{};
    for (int i = 0; i < 21; ++i) a.in[i] = (const float*)d_in[i];
    a.out = (float*)d_out; a.ws = (unsigned char*)d_ws; a.pad = 0;
#if MK_SPLIT
    for (int p = 0; p < NPHASES; ++p) { a.lo = p; a.hi = p + 1; a.li = p; hipLaunchKernelGGL(mk_fwd, dim3(grid), dim3(512), LDS_BYTES, stream, a); }
#else
    a.lo = 0; a.hi = NPHASES; a.li = 0;
    hipLaunchKernelGGL(mk_fwd, dim3(grid), dim3(512), LDS_BYTES, stream, a);
#endif
    const hipError_t le = hipPeekAtLastError();
    if (le != hipSuccess) fprintf(stderr, "kernel_launch: launch failed: %s\n", hipGetErrorName(le));
}
```

```cpp
#include <hip/hip_runtime.h>
#include <cstdio>
#include <cstdint>
namespace pg8 {
#define PG8_LAS __attribute__((address_space(3)))
typedef unsigned short bf16_t;
typedef short bf16x8 __attribute__((ext_vector_type(8)));
typedef float f32x4 __attribute__((ext_vector_type(4)));
typedef unsigned u32x4 __attribute__((ext_vector_type(4)));
constexpr int BM = 256, BK = 64, HALF = 128, HTB = HALF * BK * 2  , STAGE_BYTES = 8 * HTB, NXCD = 8, WGM = 8;

__host__ __device__ __forceinline__ int lds_byte(int r, int c) { const int st = (r >> 4) * 2 + (c >> 5), rr = r & 15, cc = c & 31, ob = rr * 64 + cc * 2; return st * 1024 + (ob ^ (((ob >> 9) & 1) << 5)); }
__host__ __device__ __forceinline__ void stage_rc(int b, int& R, int& C) { const int st = b / 1024, sb = b % 1024, swz = sb ^ (((sb >> 9) & 1) << 5); R = (st >> 1) * 16 + swz / 64; C = (st & 1) * 32 + (swz % 64) / 2; }
__host__ __device__ __forceinline__ int perm32(int rho) { const int n = rho >> 4, i = rho & 15; return 8 * (i >> 2) + 4 * n + (i & 3); }

struct Unit { int pm, pn; };
struct Gemm { const bf16_t* A; const bf16_t* Bt; int M, N, K; };

struct StaticOrder {
    int nM, nN, nwg, G, c;
    __host__ __device__ void init(int M, int N, int G_, int c_) { nM = M / BM; nN = N / BM; nwg = nM * nN; G = G_; c = c_; }
    __host__ __device__ bool next(int i, Unit& u) const {
        const long L = (long)i * G + c; if (L >= nwg) return false;
        int wgid = (int)L; { const int q = nwg / NXCD, r = nwg % NXCD, xcd = wgid % NXCD, off = wgid / NXCD; wgid = (xcd < r ? xcd * (q + 1) : r * (q + 1) + (xcd - r) * q) + off; }
        const int nig = WGM * nN, gid = wgid / nig, fm = gid * WGM, gsz = (nM - fm) < WGM ? (nM - fm) : WGM;
        u.pm = fm + ((wgid % nig) % gsz); u.pn = (wgid % nig) / gsz; return true;
    }
    __device__ __forceinline__ void a_ready(const Unit&) const {}
    __device__ __forceinline__ void done(const Unit&) const {}
};

typedef float f32x2 __attribute__((ext_vector_type(2)));
template <class Epi, class Sched, bool ALIGN_EPI = false, bool SP2 = false, bool I8 = false>
__device__ __forceinline__ void gemm_phase(PG8_LAS unsigned char* lds, const Gemm g, const Sched& S, const Epi& E, int wave_) {
    unsigned z_ = 0u; asm volatile("" : "+s"(z_)); int tid_ = wave_ * 64 + (int)__builtin_amdgcn_mbcnt_hi(~0u, __builtin_amdgcn_mbcnt_lo(~0u, z_)); asm volatile("" : "+v"(tid_));     int K_ = g.K; asm volatile("" : "+s"(K_));
    const int tid = tid_, wid = __builtin_amdgcn_readfirstlane(tid >> 6), lane = tid & 63, wr = wid >> 2, wc = wid & 3, fr = lane & 15, fq = lane >> 4;
    const int K = I8 ? (K_ >> 1) : K_, nt = K / BK;
    unsigned voffA[2], voffB[2];
#pragma unroll
    for (int i = 0; i < 2; ++i) { int R, C; stage_rc(tid * 16 + i * 8192, R, C); const int Rb = Epi::PERM ? ((R & ~31) + perm32(R & 31)) : R;
        voffA[i] = (unsigned)(R * K + C) * 2u; voffB[i] = (unsigned)(Rb * K + C) * 2u; }
    const size_t kstep = (size_t)(BK * 2);
    const size_t hstep = (size_t)HALF * K * 2;
    const size_t tstep = 2 * hstep;
    const unsigned lds_u32_ = (unsigned)(unsigned long long)lds;
    const unsigned ldsw = (unsigned)wid * 1024u;
    const int aoff = lds_byte(wr * 64 + fr, fq * 8), boff = lds_byte(wc * 32 + fr, fq * 8);
#define PG8_SA(b, h) (((b) * 2 + (h)) * HTB)
#define PG8_SB(b, h) ((4 + (b) * 2 + (h)) * HTB)
#define PG8_STAGE(bufoff, gbase, voff) do { _Pragma("unroll") for (int _i = 0; _i < 2; ++_i) { \
        const unsigned m0v_ = lds_u32_ + (unsigned)(bufoff) + ldsw + (unsigned)_i * 8192u; const char* gb_ = (const char*)(gbase); \
        asm volatile("s_mov_b32 m0, %0\n\ts_nop 0\n\tglobal_load_lds_dwordx4 %1, %2" :: "s"(m0v_), "v"((voff)[_i]), "s"(gb_) : "memory", "m0"); } } while (0)
#define PG8_LDA(dst, b, h) do { _Pragma("unroll") for (int m = 0; m < 4; ++m) _Pragma("unroll") for (int k = 0; k < 2; ++k) dst[m][k] = *(const PG8_LAS bf16x8*)(lds + PG8_SA(b, h) + aoff + m * 2048 + k * 1024); } while (0)
#define PG8_LDB(dst, b, h) do { _Pragma("unroll") for (int n = 0; n < 2; ++n) _Pragma("unroll") for (int k = 0; k < 2; ++k) dst[n][k] = *(const PG8_LAS bf16x8*)(lds + PG8_SB(b, h) + boff + n * 2048 + k * 1024); } while (0)
#define PG8_MMA(ai, bj, At, Bt) do { __builtin_amdgcn_s_setprio(1); _Pragma("unroll") for (int m = 0; m < 4; ++m) _Pragma("unroll") for (int n = 0; n < 2; ++n) _Pragma("unroll") for (int k = 0; k < 2; ++k) { \
        if constexpr (I8) { typedef int v4i_t __attribute__((ext_vector_type(4))); \
            acc[ai][bj][m][n] = __builtin_bit_cast(f32x4, __builtin_amdgcn_mfma_i32_16x16x64_i8(__builtin_bit_cast(v4i_t, Bt[n][k]), __builtin_bit_cast(v4i_t, At[m][k]), __builtin_bit_cast(v4i_t, acc[ai][bj][m][n]), 0, 0, 0)); } \
        else acc[ai][bj][m][n] = __builtin_amdgcn_mfma_f32_16x16x32_bf16(Bt[n][k], At[m][k], acc[ai][bj][m][n], 0, 0, 0); } __builtin_amdgcn_s_setprio(0); } while (0)
#define PG8_WAIT_V(n) asm volatile("s_waitcnt vmcnt(" #n ")" ::: "memory")
#define PG8_WAIT_L(n) asm volatile("s_waitcnt lgkmcnt(" #n ")" ::: "memory")
#define PG8_BAR __builtin_amdgcn_s_barrier()
#define PG8_SCHED __builtin_amdgcn_sched_barrier(0)
    Unit cur, nxt; int ui = 0;
    if (!S.next(0, cur)) return;
    cur.pm = __builtin_amdgcn_readfirstlane(cur.pm); cur.pn = __builtin_amdgcn_readfirstlane(cur.pn);
    f32x4 acc[2][2][4][2];
#pragma unroll
    for (int a = 0; a < 2; ++a)
#pragma unroll
        for (int b = 0; b < 2; ++b)
#pragma unroll
            for (int m = 0; m < 4; ++m)
#pragma unroll
                for (int n = 0; n < 2; ++n) acc[a][b][m][n] = (f32x4){0.f, 0.f, 0.f, 0.f};
    bf16x8 At[4][2], B0[2][2], B1[2][2];
    const char* gA_; const char* gB_;
    { const unsigned long long a_ = (unsigned long long)g.A, b_ = (unsigned long long)g.Bt;
      gA_ = (const char*)(((unsigned long long)(unsigned)__builtin_amdgcn_readfirstlane((int)(a_ >> 32)) << 32) | (unsigned)__builtin_amdgcn_readfirstlane((int)a_));
      gB_ = (const char*)(((unsigned long long)(unsigned)__builtin_amdgcn_readfirstlane((int)(b_ >> 32)) << 32) | (unsigned)__builtin_amdgcn_readfirstlane((int)b_)); }
    const char* cA = gA_ + (size_t)cur.pm * tstep; const char* cB = gB_ + (size_t)cur.pn * tstep;
    S.a_ready(cur);
    if constexpr (SP2) {
        PG8_STAGE(PG8_SB(0, 0), cB, voffB); PG8_STAGE(PG8_SB(0, 1), cB + hstep, voffB); PG8_STAGE(PG8_SA(0, 0), cA, voffA); PG8_STAGE(PG8_SA(0, 1), cA + hstep, voffA);
        if (wr == 1) PG8_BAR;
        PG8_WAIT_V(2); PG8_BAR;
        PG8_STAGE(PG8_SB(1, 0), cB + kstep, voffB); PG8_STAGE(PG8_SA(1, 0), cA + kstep, voffA); PG8_STAGE(PG8_SB(1, 1), cB + hstep + kstep, voffB);
        PG8_WAIT_V(6); PG8_BAR;
    } else {
        PG8_STAGE(PG8_SB(0, 0), cB, voffB); PG8_STAGE(PG8_SA(0, 0), cA, voffA); PG8_STAGE(PG8_SB(0, 1), cB + hstep, voffB); PG8_STAGE(PG8_SA(0, 1), cA + hstep, voffA);
        if (wr == 1) PG8_BAR;
        PG8_WAIT_V(4); PG8_BAR;
        PG8_STAGE(PG8_SB(1, 0), cB + kstep, voffB); PG8_STAGE(PG8_SA(1, 0), cA + kstep, voffA); PG8_STAGE(PG8_SB(1, 1), cB + hstep + kstep, voffB);
        PG8_WAIT_V(6); PG8_BAR;
    }
    for (;;) {
        const bool has_next = S.next(ui + 1, nxt);
        nxt.pm = __builtin_amdgcn_readfirstlane(nxt.pm); nxt.pn = __builtin_amdgcn_readfirstlane(nxt.pn);
        const char* nA = has_next ? gA_ + (size_t)nxt.pm * tstep : cA; const char* nB = has_next ? gB_ + (size_t)nxt.pn * tstep : cB;
        for (int t = 0; t < nt; t += 2) {
            const bool last = (t == nt - 2);
            const char* a1 = cA + (size_t)(t + 1) * kstep;
            const char* a2 = last ? nA : cA + (size_t)(t + 2) * kstep; const char* b2 = last ? nB : cB + (size_t)(t + 2) * kstep;
            const char* a3 = a2 + kstep; const char* b3 = b2 + kstep;
            if (last && has_next) S.a_ready(nxt);
            if constexpr (SP2) {
            PG8_LDB(B0, 0, 0); PG8_LDB(B1, 0, 1); PG8_SCHED; PG8_LDA(At, 0, 0); PG8_STAGE(PG8_SA(1, 1), a1 + hstep, voffA);
            PG8_WAIT_V(8); PG8_WAIT_L(0); PG8_BAR; PG8_MMA(0, 0, At, B0); PG8_MMA(0, 1, At, B1); PG8_BAR; PG8_SCHED;
            PG8_LDA(At, 0, 1); PG8_STAGE(PG8_SB(0, 0), b2, voffB); PG8_STAGE(PG8_SB(0, 1), b2 + hstep, voffB); PG8_STAGE(PG8_SA(0, 0), a2, voffA);
            PG8_WAIT_V(8); PG8_WAIT_L(0); PG8_BAR; PG8_MMA(1, 0, At, B0); PG8_MMA(1, 1, At, B1); PG8_BAR; PG8_SCHED;
            PG8_LDB(B0, 1, 0); PG8_LDB(B1, 1, 1); PG8_SCHED; PG8_LDA(At, 1, 0); PG8_STAGE(PG8_SA(0, 1), a2 + hstep, voffA);
            PG8_WAIT_V(8); PG8_WAIT_L(0); PG8_BAR; PG8_MMA(0, 0, At, B0); PG8_MMA(0, 1, At, B1); PG8_BAR; PG8_SCHED;
            PG8_LDA(At, 1, 1); PG8_STAGE(PG8_SB(1, 0), b3, voffB); PG8_STAGE(PG8_SB(1, 1), b3 + hstep, voffB); PG8_STAGE(PG8_SA(1, 0), a3, voffA);
            PG8_WAIT_V(8); PG8_WAIT_L(0); PG8_BAR; PG8_MMA(1, 0, At, B0); PG8_MMA(1, 1, At, B1); PG8_BAR; PG8_SCHED;
            } else {
            PG8_LDB(B0, 0, 0); PG8_SCHED; PG8_LDA(At, 0, 0); PG8_STAGE(PG8_SA(1, 1), a1 + hstep, voffA);
            PG8_WAIT_L(8); PG8_BAR; PG8_WAIT_L(0); PG8_MMA(0, 0, At, B0); PG8_BAR; PG8_SCHED;
            PG8_LDB(B1, 0, 1); PG8_STAGE(PG8_SB(0, 0), b2, voffB);
            PG8_BAR; PG8_WAIT_L(0); PG8_MMA(0, 1, At, B1); PG8_BAR;
            PG8_LDA(At, 0, 1); PG8_STAGE(PG8_SA(0, 0), a2, voffA);
            PG8_BAR; PG8_WAIT_L(0); PG8_MMA(1, 0, At, B0); PG8_BAR; PG8_SCHED;
            PG8_STAGE(PG8_SB(0, 1), b2 + hstep, voffB);
            PG8_WAIT_V(6); PG8_BAR; PG8_MMA(1, 1, At, B1); PG8_BAR;
            PG8_LDB(B0, 1, 0); PG8_SCHED; PG8_LDA(At, 1, 0); PG8_STAGE(PG8_SA(0, 1), a2 + hstep, voffA);
            PG8_WAIT_L(8); PG8_BAR; PG8_WAIT_L(0); PG8_MMA(0, 0, At, B0); PG8_BAR; PG8_SCHED;
            PG8_LDB(B1, 1, 1); PG8_STAGE(PG8_SB(1, 0), b3, voffB);
            PG8_BAR; PG8_WAIT_L(0); PG8_MMA(0, 1, At, B1); PG8_BAR;
            PG8_LDA(At, 1, 1); PG8_STAGE(PG8_SA(1, 0), a3, voffA);
            PG8_BAR; PG8_WAIT_L(0); PG8_MMA(1, 0, At, B0); PG8_BAR; PG8_SCHED;
            PG8_STAGE(PG8_SB(1, 1), b3 + hstep, voffB);
            PG8_WAIT_V(6); PG8_BAR; PG8_MMA(1, 1, At, B1); PG8_BAR;
            }
        }
        if constexpr (ALIGN_EPI) { if (wr == 0) PG8_BAR; }
        if constexpr (I8) {
#pragma unroll
            for (int a = 0; a < 2; ++a)
#pragma unroll
                for (int m = 0; m < 4; ++m) { const float r_ = E.rowscale(cur.pm * BM + wr * 64 + fr + a * HALF + m * 16);
#pragma unroll
                    for (int b = 0; b < 2; ++b)
#pragma unroll
                        for (int n = 0; n < 2; ++n) { typedef int v4i2_t __attribute__((ext_vector_type(4))); const v4i2_t i_ = __builtin_bit_cast(v4i2_t, acc[a][b][m][n]);
                            acc[a][b][m][n] = (f32x4){(float)i_[0] * r_, (float)i_[1] * r_, (float)i_[2] * r_, (float)i_[3] * r_}; } }
        }
        if constexpr (!Epi::AFTER_DRAIN) { E(acc, cur, wr, wc, fr, fq); S.done(cur); }
        if (!has_next) break;
#pragma unroll
        for (int a = 0; a < 2; ++a)
#pragma unroll
            for (int b = 0; b < 2; ++b)
#pragma unroll
                for (int m = 0; m < 4; ++m)
#pragma unroll
                    for (int n = 0; n < 2; ++n) acc[a][b][m][n] = (f32x4){0.f, 0.f, 0.f, 0.f};
        cur = nxt; cA = nA; cB = nB; ++ui;
        if constexpr (ALIGN_EPI) { if (wr == 1) PG8_BAR; }
    }
    PG8_WAIT_V(0);
    if constexpr (!ALIGN_EPI) { if (wr == 0) PG8_BAR; }
    PG8_BAR;
    if constexpr (Epi::AFTER_DRAIN) { E.fused(acc, cur, wr, wc, fr, fq, lds, wid, lane); S.done(cur); }
#undef PG8_SA
#undef PG8_SB
#undef PG8_STAGE
#undef PG8_LDA
#undef PG8_LDB
#undef PG8_MMA
#undef PG8_WAIT_V
#undef PG8_WAIT_L
#undef PG8_BAR
#undef PG8_SCHED
}
}
#define XB_TMO      128
#define XB_XCNT(j)  (256  + 64 * (j))
#define XB_XSUB(j)  (1280 + 64 * (j))
#define XB_XGEN(j)  (2304 + 64 * (j))
#define XB_TOP      3328
#define XB_TOPGEN   3392
#define XCD_BAR_WORDS 3456
#define XB_SPIN_CAP (1u << 24)
#define LAS __attribute__((address_space(3)))

__device__ __forceinline__ unsigned xb_ld(unsigned* p)              { return __hip_atomic_load(p, __ATOMIC_RELAXED, __HIP_MEMORY_SCOPE_AGENT); }
__device__ __forceinline__ unsigned xb_add(unsigned* p, unsigned v) { return __hip_atomic_fetch_add(p, v, __ATOMIC_RELAXED, __HIP_MEMORY_SCOPE_AGENT); }
__device__ __forceinline__ unsigned xb_xcc_id() { return (unsigned)__builtin_amdgcn_s_getreg((3 << 11) | 20) & 0xFu; }
#define XB_SPIN(cond, bar) do { unsigned _sp = 0; while (cond) { __builtin_amdgcn_s_sleep(1); \
    if ((++_sp & 255u) == 0u) { if (xb_ld(&(bar)[XB_TMO])) break; if (_sp > XB_SPIN_CAP) { atomicAdd(&(bar)[XB_TMO], 1u); break; } } } } while (0)

__device__ __forceinline__ int xb_lane_id() { unsigned z = 0u; asm volatile("" : "+s"(z)); return (int)__builtin_amdgcn_mbcnt_hi(~0u, __builtin_amdgcn_mbcnt_lo(~0u, z)); }
struct XcdBarrier {
    unsigned w0;
    unsigned* bar; unsigned x;
    volatile LAS unsigned* st;
};

__device__ __forceinline__ XcdBarrier xcd_barrier_post(unsigned* bar, volatile LAS unsigned* st) {
    XcdBarrier b; b.bar = bar; b.x = xb_xcc_id(); b.st = st; b.w0 = (__builtin_amdgcn_readfirstlane((int)threadIdx.x >> 6) == 0) ? 1u : 0u;
    if (b.w0 && xb_lane_id() == 0) (void)xb_add(&bar[XB_XCNT(b.x)], 1u);
    return b;
}
__device__ __forceinline__ void xcd_barrier_complete(unsigned* bar, unsigned x, unsigned& nloc, unsigned& nx) {
    const unsigned G = gridDim.x * gridDim.y * gridDim.z;
    unsigned sum, cnt, mine, sp = 0u;
    for (;;) {
        sum = 0u; cnt = 0u; mine = 0u;
#pragma unroll
        for (unsigned j = 0; j < 16; ++j) { const unsigned c = xb_ld(&bar[XB_XCNT(j)]); sum += c; cnt += (c > 0u) ? 1u : 0u; mine = (j == x) ? c : mine; }
        if (sum == G) break;
        __builtin_amdgcn_s_sleep(1);
        if ((++sp & 255u) == 0u) { if (xb_ld(&bar[XB_TMO])) break; if (sp > XB_SPIN_CAP) { atomicAdd(&bar[XB_TMO], 1u); break; } }
    }
    nloc = mine > 0u ? mine : 1u; nx = cnt > 0u ? cnt : 1u;
}

__device__ __forceinline__ void xcd_barrier(const XcdBarrier& b) {
    asm volatile("s_waitcnt vmcnt(0)" ::: "memory");
    __syncthreads();
    if (b.w0 && xb_lane_id() == 0) {
        unsigned* bar = b.bar;
        __builtin_amdgcn_s_waitcnt(0);
        unsigned nloc = b.st[0], nx = b.st[1];
        if (nloc == 0u) { xcd_barrier_complete(bar, b.x, nloc, nx); b.st[0] = nloc; b.st[1] = nx; }
        const unsigned old = xb_add(&bar[XB_XSUB(b.x)], 1u);
        const unsigned gen = old / nloc;
        if (old + 1u == (gen + 1u) * nloc) {
            __builtin_amdgcn_fence(__ATOMIC_RELEASE, "agent");
            asm volatile("s_waitcnt vmcnt(0)" ::: "memory");
            const unsigned og = xb_add(&bar[XB_TOP], 1u);
            const unsigned tg = og / nx;
            if (og + 1u == (tg + 1u) * nx) xb_add(&bar[XB_TOPGEN], 1u);
            else XB_SPIN(xb_ld(&bar[XB_TOPGEN]) == tg, bar);
            __builtin_amdgcn_fence(__ATOMIC_ACQUIRE, "agent");
            xb_add(&bar[XB_XGEN(b.x)], 1u);
            asm volatile("s_waitcnt vmcnt(0)" ::: "memory");
        } else {
            XB_SPIN(xb_ld(&bar[XB_XGEN(b.x)]) == gen, bar);
            __builtin_amdgcn_fence(__ATOMIC_ACQUIRE, "agent");
            asm volatile("s_waitcnt vmcnt(0)" ::: "memory");
        }
    }
    __syncthreads();
}


#define GAS __attribute__((address_space(1)))
typedef unsigned short bf16;
typedef unsigned v4u __attribute__((ext_vector_type(4)));
typedef unsigned v2u __attribute__((ext_vector_type(2)));
typedef float f32x4 __attribute__((ext_vector_type(4)));
typedef float f32x2v __attribute__((ext_vector_type(2)));
typedef float f32x16 __attribute__((ext_vector_type(16)));
typedef short bf16x8 __attribute__((ext_vector_type(8)));
typedef __bf16 bf16v2 __attribute__((ext_vector_type(2)));
typedef _Float16 h2_t __attribute__((ext_vector_type(2)));
typedef _Float16 v32h_t __attribute__((ext_vector_type(32)));
typedef unsigned v6u __attribute__((ext_vector_type(6)));

constexpr int NTOK = 16384, DM = 2048, SEQ = 4096, INW = 15360, BW = 1024;
constexpr float EPS = 1e-6f;
constexpr float WBR_QS = 768.0f;
constexpr float ACT_QS = 127.0f / 6.0f;
constexpr float WIN_QS = 1024.0f;
constexpr int NPH = 13;
constexpr int NPHASES = 2 * NPH;

constexpr size_t MiB = 1u << 20;
constexpr size_t WS_CTL = 0;
constexpr size_t WS_LB = 1 * MiB;
constexpr size_t WS_SA = 1 * MiB + 192 * 1024;
constexpr size_t WS_US = 1 * MiB + 64 * 1024, WS_VS = 1 * MiB + 128 * 1024;
constexpr size_t WS_WIN = 2 * MiB;
constexpr size_t WS_MS = 1 * MiB + 256 * 1024;
constexpr size_t WS_M8 = 859 * MiB;
constexpr size_t WS_WBR = 62 * MiB;
constexpr size_t WS_WO = 74 * MiB;
constexpr size_t WS_WQ = 82 * MiB;
constexpr size_t WS_U = 91 * MiB;
constexpr size_t WS_V = 155 * MiB;
constexpr size_t WS_H = 219 * MiB;
constexpr size_t WS_SEG = 283 * MiB;
constexpr size_t WS_GATE = 539 * MiB;
constexpr size_t WS_X2 = 731 * MiB;
constexpr size_t WS_X1 = 795 * MiB;
constexpr size_t WS_CONV = 859 * MiB;
constexpr size_t WS_HGR = 891 * MiB;
constexpr size_t WS_MERGED = 923 * MiB;
constexpr size_t WS_SEL = 987 * MiB;
constexpr size_t WS_SELS = 1003 * MiB;
constexpr size_t WS_DEC = 1004 * MiB;
constexpr size_t WS_END = 1005 * MiB;
constexpr size_t WS_ST = WS_H;
constexpr size_t WS_KEYS = 90 * MiB;
constexpr size_t WS_PART = WS_GATE;
constexpr size_t WS_QPEER = WS_SEG;
constexpr size_t SEGSZ = (size_t)NTOK * 1024;
constexpr int CW_BAR = 4096;
constexpr int CW_RANK = 131072;

constexpr int RING_BYTES = 131072, MISC_OFF = RING_BYTES + 320, LDS_BYTES = 147456;

__device__ __forceinline__ unsigned pk2c(float lo, float hi) { f32x2v v = {lo, hi}; bf16v2 b = __builtin_convertvector(v, bf16v2); return __builtin_bit_cast(unsigned, b); }
__device__ __forceinline__ float bflo(unsigned x) { return __uint_as_float(x << 16); }
__device__ __forceinline__ float bfhi(unsigned x) { return __uint_as_float(x & 0xffff0000u); }
__device__ __forceinline__ float sigm(float x) { return __builtin_amdgcn_rcpf(1.0f + __expf(-x)); }
__device__ __forceinline__ float wave_sum(float v) {
#pragma unroll
    for (int o = 1; o < 64; o <<= 1) v += __shfl_xor(v, o);
    return v;
}
__device__ __forceinline__ float wave_max(float v) {
#pragma unroll
    for (int o = 1; o < 64; o <<= 1) v = fmaxf(v, __shfl_xor(v, o));
    return v;
}
#define LDS_WAIT() asm volatile("s_waitcnt lgkmcnt(0)" ::: "memory")
#define MFMA32(a, b, c) __builtin_amdgcn_mfma_f32_32x32x16_bf16((a), (b), (c), 0, 0, 0)
typedef unsigned v2u_sw __attribute__((ext_vector_type(2)));
__device__ __forceinline__ float xsum32(float a, float b) { const auto r = __builtin_amdgcn_permlane32_swap(__float_as_uint(a), __float_as_uint(b), false, false); return __uint_as_float(r[0]) + __uint_as_float(r[1]); }
__device__ __forceinline__ float xsum16(float a, float b) { const auto r = __builtin_amdgcn_permlane16_swap(__float_as_uint(a), __float_as_uint(b), false, false); return __uint_as_float(r[0]) + __uint_as_float(r[1]); }
__device__ __forceinline__ float xor32f(float x, int hf) { const auto r = __builtin_amdgcn_permlane32_swap(__float_as_uint(x), __float_as_uint(x), false, false); return __uint_as_float(hf ? r[0] : r[1]); }
__device__ __forceinline__ int ridx16(int lane) { return ((lane >> 5) & 1) * 8 + ((lane >> 4) & 1) * 4 + ((lane >> 3) & 1) * 2 + ((lane >> 2) & 1); }
__device__ __forceinline__ void xreduce16(float (&v)[16], int lane) {
#pragma unroll
    for (int i = 0; i < 8; ++i) v[i] = xsum32(v[i], v[i + 8]);
#pragma unroll
    for (int i = 0; i < 4; ++i) v[i] = xsum16(v[i], v[i + 4]);
#pragma unroll
    for (int i = 0; i < 2; ++i) { const bool up = (lane & 8) != 0; const float snd = up ? v[i] : v[i + 2], kp = up ? v[i + 2] : v[i]; v[i] = kp + __shfl_xor(snd, 8); }
    { const bool up = (lane & 4) != 0; const float snd = up ? v[0] : v[1], kp = up ? v[1] : v[0]; v[0] = kp + __shfl_xor(snd, 4); }
    v[0] += __shfl_xor(v[0], 2); v[0] += __shfl_xor(v[0], 1);
}
__device__ __forceinline__ float gelu_exact(float v) {
    const float av = fabsf(v), t = __builtin_amdgcn_rcpf(av * 0.2316418882f + 1.0f);
    float q = t * 0.5307027145f + (-0.7265760135f); q = q * t + 0.7107068705f; q = q * t + (-0.142248368f); q = q * t + 0.127414796f; q = q * t;
    const float e = __builtin_amdgcn_exp2f((v * v) * (-0.72134752044f));
    const float m = v * (q * e);
    return v < 0.f ? m : v - m;
}

struct Ctx { LAS unsigned char* lds; int tid, lane, wave, G, gw, NGW; };

__device__ __forceinline__ void tr_item(const float* W, int K, int N, bf16* WT, int k0, int n0, int drow0, LAS float* scr, int lane) {
    { const int lr = lane >> 3, lc = (lane & 7) * 4; f32x4 v[8];
#pragma unroll
      for (int j = 0; j < 8; ++j) v[j] = *(const GAS f32x4*)(W + (size_t)(k0 + lr + 8 * j) * N + n0 + lc);
#pragma unroll
      for (int j = 0; j < 8; ++j) { LAS float* d = scr + (lr + 8 * j) * 33 + lc; d[0] = v[j].x; d[1] = v[j].y; d[2] = v[j].z; d[3] = v[j].w; } }
    LDS_WAIT();
    const int c = lane & 7;
#pragma unroll
    for (int j = 0; j < 4; ++j) { const int n = (lane >> 3) + 8 * j; const LAS float* s = scr + (8 * c) * 33 + n;
        v4u o; o.x = pk2c(s[0], s[33]); o.y = pk2c(s[66], s[99]); o.z = pk2c(s[132], s[165]); o.w = pk2c(s[198], s[231]);
        *(GAS v4u*)(WT + (size_t)(drow0 + n) * K + k0 + 8 * c) = o; }
    LDS_WAIT();
}
__device__ __forceinline__ unsigned pack_i8x4c(float a, float b, float c, float d) {
    const int ia = (int)__builtin_rintf(fminf(fmaxf(a, -127.f), 127.f)), ib = (int)__builtin_rintf(fminf(fmaxf(b, -127.f), 127.f)), ic = (int)__builtin_rintf(fminf(fmaxf(c, -127.f), 127.f)), id = (int)__builtin_rintf(fminf(fmaxf(d, -127.f), 127.f));
    return ((unsigned)ia & 255u) | (((unsigned)ib & 255u) << 8) | (((unsigned)ic & 255u) << 16) | ((unsigned)id << 24);
}
__device__ __forceinline__ void tr_item_i8(const float* W, int K, int N, unsigned char* WT, int k0, int n0, int drow0, float scale, LAS float* scr, int lane) {
    { const int lr = lane >> 3, lc = (lane & 7) * 4; f32x4 v[16];
#pragma unroll
      for (int j = 0; j < 16; ++j) v[j] = *(const GAS f32x4*)(W + (size_t)(k0 + lr + 8 * j) * N + n0 + lc);
#pragma unroll
      for (int j = 0; j < 16; ++j) { LAS float* d = scr + (lr + 8 * j) * 32 + (lc ^ ((j & 7) << 2)); const int x = lr & 3; d[x] = v[j].x; d[1 ^ x] = v[j].y; d[2 ^ x] = v[j].z; d[3 ^ x] = v[j].w; } }
    LDS_WAIT();
    const int c = lane & 15;
#pragma unroll
    for (int j = 0; j < 8; ++j) { const int n = (lane >> 4) + 4 * j, q = n ^ ((c & 7) << 2); const LAS float* s = scr + (8 * c) * 32;
        v2u o; o.x = pack_i8x4c(s[q] * scale, s[32 + (q ^ 1)] * scale, s[64 + (q ^ 2)] * scale, s[96 + (q ^ 3)] * scale); o.y = pack_i8x4c(s[128 + q] * scale, s[160 + (q ^ 1)] * scale, s[192 + (q ^ 2)] * scale, s[224 + (q ^ 3)] * scale);
        *(GAS v2u*)(WT + (size_t)(drow0 + n) * K + k0 + 8 * c) = o; }
    LDS_WAIT();
}
__device__ __forceinline__ int win_drow(int n) { if (n < 7168 || n >= 9216) return n; const int r = n - 7168, isb = r >> 10, c = r & 1023; return 7168 + (c >> 7) * 256 + isb * 128 + (c & 127); }
__device__ __forceinline__ void cvt_copy(const Ctx& c, const float* src, bf16* dst, size_t n8) {
    const size_t NT = (size_t)c.G * 512;
    for (size_t i = (size_t)blockIdx.x * 512 + c.tid; i < n8; i += NT) {
        const f32x4 a = ((const GAS f32x4*)src)[2 * i], b = ((const GAS f32x4*)src)[2 * i + 1];
        v4u o; o.x = pk2c(a.x, a.y); o.y = pk2c(a.z, a.w); o.z = pk2c(b.x, b.y); o.w = pk2c(b.z, b.w);
        ((GAS v4u*)dst)[i] = o;
    }
}
__device__ __forceinline__ void rms_row(const float* xr, const float* w, bf16* o, int lane) {
    const GAS f32x4* xp = (const GAS f32x4*)xr + lane; f32x4 v[8]; float s = 0.f;
#pragma unroll
    for (int j = 0; j < 8; ++j) { v[j] = xp[64 * j]; s += (v[j].x * v[j].x + v[j].y * v[j].y) + (v[j].z * v[j].z + v[j].w * v[j].w); }
    const float r = __builtin_amdgcn_rsqf(wave_sum(s) * (1.0f / DM) + EPS);
    const GAS f32x4* wp = (const GAS f32x4*)w + lane; GAS v2u* op = (GAS v2u*)o + lane;
#pragma unroll
    for (int j = 0; j < 8; ++j) { const f32x4 wv = wp[64 * j]; v2u q; q.x = pk2c(v[j].x * r * wv.x, v[j].y * r * wv.y); q.y = pk2c(v[j].z * r * wv.z, v[j].w * r * wv.w); op[64 * j] = q; }
}
__device__ __forceinline__ void rms_row_i8(const float* xr, const float* w, unsigned char* o, float* sa, int lane) {
    const GAS f32x4* xp = (const GAS f32x4*)xr + lane; f32x4 v[8]; float s = 0.f;
#pragma unroll
    for (int j = 0; j < 8; ++j) { v[j] = xp[64 * j]; s += (v[j].x * v[j].x + v[j].y * v[j].y) + (v[j].z * v[j].z + v[j].w * v[j].w); }
    const float r = __builtin_amdgcn_rsqf(wave_sum(s) * (1.0f / DM) + EPS);
    const GAS f32x4* wp = (const GAS f32x4*)w + lane; float m = 0.f;
#pragma unroll
    for (int j = 0; j < 8; ++j) { const f32x4 wv = wp[64 * j]; v[j].x *= r * wv.x; v[j].y *= r * wv.y; v[j].z *= r * wv.z; v[j].w *= r * wv.w;
        m = fmaxf(fmaxf(m, fmaxf(fabsf(v[j].x), fabsf(v[j].y))), fmaxf(fabsf(v[j].z), fabsf(v[j].w))); }
    m = wave_max(m);
    const float inv = m > 0.f ? 127.0f / m : 0.f;
    if (lane == 0) *(GAS float*)sa = m * (1.0f / 127.0f);
#pragma unroll
    for (int j = 0; j < 8; ++j) ((GAS unsigned*)o)[lane + 64 * j] = pack_i8x4c(v[j].x * inv, v[j].y * inv, v[j].z * inv, v[j].w * inv);
}
__device__ __forceinline__ void rms_rows2_i8(const float* xa, const float* xb, const float* w, unsigned char* oa, unsigned char* ob, float* saa, float* sab, int lane) {
    const GAS f32x4* pa = (const GAS f32x4*)xa + lane; const GAS f32x4* pb = (const GAS f32x4*)xb + lane; f32x4 va[8], vb[8]; float s0 = 0.f, s1 = 0.f;
#pragma unroll
    for (int j = 0; j < 8; ++j) { va[j] = pa[64 * j]; vb[j] = pb[64 * j]; }
#pragma unroll
    for (int j = 0; j < 8; ++j) { s0 += (va[j].x * va[j].x + va[j].y * va[j].y) + (va[j].z * va[j].z + va[j].w * va[j].w); s1 += (vb[j].x * vb[j].x + vb[j].y * vb[j].y) + (vb[j].z * vb[j].z + vb[j].w * vb[j].w); }
#pragma unroll
    for (int o = 1; o < 64; o <<= 1) { s0 += __shfl_xor(s0, o); s1 += __shfl_xor(s1, o); }
    const float r0 = __builtin_amdgcn_rsqf(s0 * (1.0f / DM) + EPS), r1 = __builtin_amdgcn_rsqf(s1 * (1.0f / DM) + EPS);
    const GAS f32x4* wp = (const GAS f32x4*)w + lane; float m0 = 0.f, m1 = 0.f;
#pragma unroll
    for (int j = 0; j < 8; ++j) { const f32x4 wv = wp[64 * j];
        va[j].x *= r0 * wv.x; va[j].y *= r0 * wv.y; va[j].z *= r0 * wv.z; va[j].w *= r0 * wv.w; vb[j].x *= r1 * wv.x; vb[j].y *= r1 * wv.y; vb[j].z *= r1 * wv.z; vb[j].w *= r1 * wv.w;
        m0 = fmaxf(fmaxf(m0, fmaxf(fabsf(va[j].x), fabsf(va[j].y))), fmaxf(fabsf(va[j].z), fabsf(va[j].w))); m1 = fmaxf(fmaxf(m1, fmaxf(fabsf(vb[j].x), fabsf(vb[j].y))), fmaxf(fabsf(vb[j].z), fabsf(vb[j].w))); }
#pragma unroll
    for (int o = 1; o < 64; o <<= 1) { m0 = fmaxf(m0, __shfl_xor(m0, o)); m1 = fmaxf(m1, __shfl_xor(m1, o)); }
    const float i0 = m0 > 0.f ? 127.0f / m0 : 0.f, i1 = m1 > 0.f ? 127.0f / m1 : 0.f;
    if (lane == 0) { *(GAS float*)saa = m0 * (1.0f / 127.0f); *(GAS float*)sab = m1 * (1.0f / 127.0f); }
#pragma unroll
    for (int j = 0; j < 8; ++j) { ((GAS unsigned*)oa)[lane + 64 * j] = pack_i8x4c(va[j].x * i0, va[j].y * i0, va[j].z * i0, va[j].w * i0); ((GAS unsigned*)ob)[lane + 64 * j] = pack_i8x4c(vb[j].x * i1, vb[j].y * i1, vb[j].z * i1, vb[j].w * i1); }
}
__device__ __forceinline__ void rms_rows2_i8b(const bf16* xa, const bf16* xb, const float* w, unsigned char* oa, unsigned char* ob, float* saa, float* sab, int lane) {
    v4u qa[4], qb[4]; float va[4][8], vb[4][8], s0 = 0.f, s1 = 0.f;
#pragma unroll
    for (int j = 0; j < 4; ++j) { qa[j] = *(const GAS v4u*)(xa + 8 * (lane + 64 * j)); qb[j] = *(const GAS v4u*)(xb + 8 * (lane + 64 * j)); }
#pragma unroll
    for (int j = 0; j < 4; ++j) { const unsigned a[4] = {qa[j].x, qa[j].y, qa[j].z, qa[j].w}, b[4] = {qb[j].x, qb[j].y, qb[j].z, qb[j].w};
#pragma unroll
        for (int k = 0; k < 4; ++k) { va[j][2 * k] = bflo(a[k]); va[j][2 * k + 1] = bfhi(a[k]); vb[j][2 * k] = bflo(b[k]); vb[j][2 * k + 1] = bfhi(b[k]); }
#pragma unroll
        for (int k = 0; k < 8; ++k) { s0 += va[j][k] * va[j][k]; s1 += vb[j][k] * vb[j][k]; } }
#pragma unroll
    for (int o = 1; o < 64; o <<= 1) { s0 += __shfl_xor(s0, o); s1 += __shfl_xor(s1, o); }
    const float r0 = __builtin_amdgcn_rsqf(s0 * (1.0f / DM) + EPS), r1 = __builtin_amdgcn_rsqf(s1 * (1.0f / DM) + EPS);
    float m0 = 0.f, m1 = 0.f;
#pragma unroll
    for (int j = 0; j < 4; ++j) { const f32x4 w0 = *(const GAS f32x4*)(w + 8 * (lane + 64 * j)), w1 = *(const GAS f32x4*)(w + 8 * (lane + 64 * j) + 4); const float ww[8] = {w0.x, w0.y, w0.z, w0.w, w1.x, w1.y, w1.z, w1.w};
#pragma unroll
        for (int k = 0; k < 8; ++k) { va[j][k] *= r0 * ww[k]; vb[j][k] *= r1 * ww[k]; m0 = fmaxf(m0, fabsf(va[j][k])); m1 = fmaxf(m1, fabsf(vb[j][k])); } }
#pragma unroll
    for (int o = 1; o < 64; o <<= 1) { m0 = fmaxf(m0, __shfl_xor(m0, o)); m1 = fmaxf(m1, __shfl_xor(m1, o)); }
    const float i0 = m0 > 0.f ? 127.0f / m0 : 0.f, i1 = m1 > 0.f ? 127.0f / m1 : 0.f;
    if (lane == 0) { *(GAS float*)saa = m0 * (1.0f / 127.0f); *(GAS float*)sab = m1 * (1.0f / 127.0f); }
#pragma unroll
    for (int j = 0; j < 4; ++j) {
        *(GAS v2u*)(oa + 8 * (lane + 64 * j)) = (v2u){pack_i8x4c(va[j][0] * i0, va[j][1] * i0, va[j][2] * i0, va[j][3] * i0), pack_i8x4c(va[j][4] * i0, va[j][5] * i0, va[j][6] * i0, va[j][7] * i0)};
        *(GAS v2u*)(ob + 8 * (lane + 64 * j)) = (v2u){pack_i8x4c(vb[j][0] * i1, vb[j][1] * i1, vb[j][2] * i1, vb[j][3] * i1), pack_i8x4c(vb[j][4] * i1, vb[j][5] * i1, vb[j][6] * i1, vb[j][7] * i1)}; }
}
__device__ __forceinline__ void rms_phase_i8b(const Ctx& c, const bf16* x, const float* w, unsigned char* H8, float* SA) {
    for (int m = c.gw; m < NTOK / 2; m += c.NGW) rms_rows2_i8b(x + (size_t)m * DM, x + (size_t)(m + NTOK / 2) * DM, w, H8 + (size_t)m * DM, H8 + (size_t)(m + NTOK / 2) * DM, SA + m, SA + m + NTOK / 2, c.lane);
}
__device__ __forceinline__ void rms_phase_i8(const Ctx& c, const float* x, const float* w, unsigned char* H8, float* SA) {
    for (int m = c.gw; m < NTOK / 2; m += c.NGW) rms_rows2_i8(x + (size_t)m * DM, x + (size_t)(m + NTOK / 2) * DM, w, H8 + (size_t)m * DM, H8 + (size_t)(m + NTOK / 2) * DM, SA + m, SA + m + NTOK / 2, c.lane);
}
__device__ __forceinline__ void bf16_rows_i8(const Ctx& c, const bf16* X, unsigned char* X8, float* XS) {
    for (int r = c.gw; r < NTOK; r += 4 * c.NGW) { v4u x[4][4];
#pragma unroll
        for (int i = 0; i < 4; ++i) if (r + i * c.NGW < NTOK)
#pragma unroll
            for (int j = 0; j < 4; ++j) x[i][j] = *(const GAS v4u*)(X + (size_t)(r + i * c.NGW) * DM + 8 * (c.lane + 64 * j));
#pragma unroll
        for (int i = 0; i < 4; ++i) if (r + i * c.NGW < NTOK) { const int row = r + i * c.NGW; float m = 0.f;
#pragma unroll
            for (int j = 0; j < 4; ++j) { const v4u q = x[i][j];
                m = fmaxf(m, fmaxf(fmaxf(fmaxf(fabsf(bflo(q.x)), fabsf(bfhi(q.x))), fmaxf(fabsf(bflo(q.y)), fabsf(bfhi(q.y)))), fmaxf(fmaxf(fabsf(bflo(q.z)), fabsf(bfhi(q.z))), fmaxf(fabsf(bflo(q.w)), fabsf(bfhi(q.w)))))); }
            m = wave_max(m);
            const float inv = m > 0.f ? 127.0f / m : 0.f;
            if (c.lane == 0) *(GAS float*)(XS + row) = m * (1.0f / 127.0f);
#pragma unroll
            for (int j = 0; j < 4; ++j) { const v4u q = x[i][j]; v2u o;
                o.x = pack_i8x4c(bflo(q.x) * inv, bfhi(q.x) * inv, bflo(q.y) * inv, bfhi(q.y) * inv); o.y = pack_i8x4c(bflo(q.z) * inv, bfhi(q.z) * inv, bflo(q.w) * inv, bfhi(q.w) * inv);
                *(GAS v2u*)(X8 + (size_t)row * DM + 8 * (c.lane + 64 * j)) = o; } } }
}
__device__ __forceinline__ void rms_rows2(const float* xa, const float* xb, const float* w, bf16* oa, bf16* ob, int lane) {
    const GAS f32x4* pa = (const GAS f32x4*)xa + lane; const GAS f32x4* pb = (const GAS f32x4*)xb + lane; f32x4 va[8], vb[8]; float sa = 0.f, sb = 0.f;
#pragma unroll
    for (int j = 0; j < 8; ++j) { va[j] = pa[64 * j]; vb[j] = pb[64 * j]; }
#pragma unroll
    for (int j = 0; j < 8; ++j) { sa += (va[j].x * va[j].x + va[j].y * va[j].y) + (va[j].z * va[j].z + va[j].w * va[j].w); sb += (vb[j].x * vb[j].x + vb[j].y * vb[j].y) + (vb[j].z * vb[j].z + vb[j].w * vb[j].w); }
#pragma unroll
    for (int o = 1; o < 64; o <<= 1) { sa += __shfl_xor(sa, o); sb += __shfl_xor(sb, o); }
    const float ra = __builtin_amdgcn_rsqf(sa * (1.0f / DM) + EPS), rb = __builtin_amdgcn_rsqf(sb * (1.0f / DM) + EPS);
    const GAS f32x4* wp = (const GAS f32x4*)w + lane; GAS v2u* qa = (GAS v2u*)oa + lane; GAS v2u* qb = (GAS v2u*)ob + lane;
#pragma unroll
    for (int j = 0; j < 8; ++j) { const f32x4 wv = wp[64 * j];
        v2u q; q.x = pk2c(va[j].x * ra * wv.x, va[j].y * ra * wv.y); q.y = pk2c(va[j].z * ra * wv.z, va[j].w * ra * wv.w); qa[64 * j] = q;
        v2u p; p.x = pk2c(vb[j].x * rb * wv.x, vb[j].y * rb * wv.y); p.y = pk2c(vb[j].z * rb * wv.z, vb[j].w * rb * wv.w); qb[64 * j] = p; }
}
__device__ __forceinline__ void rms_phase(const Ctx& c, const float* x, const float* w, bf16* H) {
    for (int m = c.gw; m < NTOK / 2; m += c.NGW) rms_rows2(x + (size_t)m * DM, x + (size_t)(m + NTOK / 2) * DM, w, H + (size_t)m * DM, H + (size_t)(m + NTOK / 2) * DM, c.lane);
}
__device__ __forceinline__ void fp8_row(const float* src, unsigned char* dst, float* scale_out, int lane) {
    const GAS f32x4* xp = (const GAS f32x4*)src + lane; f32x4 v[8]; float m = 0.f;
#pragma unroll
    for (int j = 0; j < 8; ++j) { v[j] = xp[64 * j]; m = fmaxf(fmaxf(m, fmaxf(fabsf(v[j].x), fabsf(v[j].y))), fmaxf(fabsf(v[j].z), fabsf(v[j].w))); }
    m = wave_max(m);
    const float inv = m > 0.f ? 256.0f / m : 0.f;
    if (lane == 0) *(GAS float*)scale_out = m * (1.0f / 256.0f);
#pragma unroll
    for (int j = 0; j < 8; ++j) { int p = __builtin_amdgcn_cvt_pk_fp8_f32(v[j].x * inv, v[j].y * inv, 0, false); p = __builtin_amdgcn_cvt_pk_fp8_f32(v[j].z * inv, v[j].w * inv, p, true);
        ((GAS unsigned*)dst)[lane + 64 * j] = (unsigned)p; }
}
constexpr size_t U8_SLICE = (size_t)16384 * 128;
__device__ __forceinline__ unsigned pack_i8x4(float a, float b, float c, float d) {
    const int ia = (int)__builtin_rintf(a), ib = (int)__builtin_rintf(b), ic = (int)__builtin_rintf(c), id = (int)__builtin_rintf(d);
    return ((unsigned)ia & 255u) | (((unsigned)ib & 255u) << 8) | (((unsigned)ic & 255u) << 16) | ((unsigned)id << 24);
}
__device__ __forceinline__ void row_load_strided(const float* src, int lane, f32x4 (&v)[8]) { const GAS f32x4* xp = (const GAS f32x4*)src + lane;
#pragma unroll
    for (int j = 0; j < 8; ++j) v[j] = xp[64 * j]; }
__device__ __forceinline__ void row_load_contig(const float* src, int lane, f32x4 (&v)[8]) { const GAS f32x4* xp = (const GAS f32x4*)src + 8 * lane;
#pragma unroll
    for (int j = 0; j < 8; ++j) v[j] = xp[j]; }
__device__ __forceinline__ void i8_row(const f32x4 (&v)[8], unsigned char* dst, float* scale_out, int lane) {
    float m = 0.f;
#pragma unroll
    for (int j = 0; j < 8; ++j) m = fmaxf(fmaxf(m, fmaxf(fabsf(v[j].x), fabsf(v[j].y))), fmaxf(fabsf(v[j].z), fabsf(v[j].w)));
    m = wave_max(m);
    const float inv = m > 0.f ? 127.0f / m : 0.f;
    if (lane == 0) *(GAS float*)scale_out = m * (1.0f / 127.0f);
#pragma unroll
    for (int j = 0; j < 8; ++j) *(GAS unsigned*)(dst + (size_t)(2 * j + (lane >> 5)) * U8_SLICE + 4 * (lane & 31)) = pack_i8x4(v[j].x * inv, v[j].y * inv, v[j].z * inv, v[j].w * inv);
}
constexpr size_t V6_SLICE = (size_t)16384 * 192;
__device__ __forceinline__ void fp6_row(const f32x4 (&v)[8], unsigned char* dst, float* scale_out, int lane) {
    float m = 0.f;
#pragma unroll
    for (int j = 0; j < 8; ++j) m = fmaxf(fmaxf(m, fmaxf(fabsf(v[j].x), fabsf(v[j].y))), fmaxf(fabsf(v[j].z), fabsf(v[j].w)));
    m = wave_max(m);
    const float inv = m > 0.f ? 7.5f / m : 0.f;
    if (lane == 0) *(GAS float*)scale_out = m * (1.0f / 7.5f);
    v32h_t h;
#pragma unroll
    for (int j = 0; j < 8; ++j) { h[4 * j] = (_Float16)(v[j].x * inv); h[4 * j + 1] = (_Float16)(v[j].y * inv); h[4 * j + 2] = (_Float16)(v[j].z * inv); h[4 * j + 3] = (_Float16)(v[j].w * inv); }
    const v6u q = __builtin_amdgcn_cvt_scalef32_pk32_fp6_f16(h, 1.0f);
    GAS v2u* o = (GAS v2u*)(dst + (size_t)(lane >> 3) * V6_SLICE + 24 * (lane & 7));
    o[0] = (v2u){q[0], q[1]}; o[1] = (v2u){q[2], q[3]}; o[2] = (v2u){q[4], q[5]};
}
struct P0Args { const float *w_in, *w_br_sb, *w_br_hg, *w_br_conv, *w_o, *w_q, *u, *v, *lbp; bf16 *WinT, *WbrT, *WoT, *WqT; unsigned char *U, *V; float *US, *VS; float* LB; int layer; const float *k1, *k2; bf16* KB; };
__device__ __forceinline__ void p0_convert(const Ctx& c, const P0Args& a, int parts = 7) {
    LAS float* scr = (LAS float*)(c.lds + c.wave * 16384);
    constexpr int I_IN = (DM / 128) * (INW / 32), I_BR = (BW / 64) * (DM / 32), I_SQ = (DM / 64) * (DM / 32);
    constexpr int I_Q8 = (DM / 128) * (DM / 32);
    constexpr int I_B8 = (BW / 128) * (DM / 32);
    constexpr int NITEMS = I_IN + I_BR + 2 * I_B8 + 2 * I_Q8;
    if (parts & 1)
    for (int it = c.gw; it < NITEMS; it += c.NGW) {
        int r = it;
        if (r < I_IN) { const int kb = r / (INW / 32), nb = r % (INW / 32); tr_item_i8(a.w_in, DM, INW, (unsigned char*)a.WinT, kb * 128, nb * 32, win_drow(nb * 32), WIN_QS, scr, c.lane); continue; } r -= I_IN;
        if (r < I_BR) { const int kb = r / (DM / 32), nb = r % (DM / 32); tr_item(a.w_br_sb, BW, DM, a.WbrT, kb * 64, nb * 32, nb * 32, scr, c.lane); continue; } r -= I_BR;
        if (r < I_B8) { const int kb = r / (DM / 32), nb = r % (DM / 32); tr_item_i8(a.w_br_hg, BW, DM, (unsigned char*)(a.WbrT + (size_t)DM * BW), kb * 128, nb * 32, nb * 32, WBR_QS, scr, c.lane); continue; } r -= I_B8;
        if (r < I_B8) { const int kb = r / (DM / 32), nb = r % (DM / 32); tr_item_i8(a.w_br_conv, BW, DM, (unsigned char*)(a.WbrT + (size_t)2 * DM * BW), kb * 128, nb * 32, nb * 32, WBR_QS, scr, c.lane); continue; } r -= I_B8;
        if (r < I_Q8) { const int kb = r / (DM / 32), nb = r % (DM / 32); tr_item_i8(a.w_o, DM, DM, (unsigned char*)a.WoT, kb * 128, nb * 32, nb * 32, WIN_QS, scr, c.lane); continue; } r -= I_Q8;
        { const int kb = r / (DM / 32), nb = r % (DM / 32); tr_item_i8(a.w_q, DM, DM, (unsigned char*)a.WqT, kb * 128, nb * 32, nb * 32, WIN_QS, scr, c.lane); }
    }
    if (parts & 2)
    {
    for (int r = c.gw; r < 16384; r += 2 * c.NGW) { const int r2 = r + c.NGW; f32x4 va[8], vb[8];
        row_load_strided(a.u + (size_t)r * 2048, c.lane, va); if (r2 < 16384) row_load_strided(a.u + (size_t)r2 * 2048, c.lane, vb);
        i8_row(va, a.U + (size_t)r * 128, a.US + r, c.lane); if (r2 < 16384) i8_row(vb, a.U + (size_t)r2 * 128, a.US + r2, c.lane); }
    for (int r = c.gw; r < 16384; r += 2 * c.NGW) { const int r2 = r + c.NGW; f32x4 va[8], vb[8];
        row_load_contig(a.v + (size_t)r * 2048, c.lane, va); if (r2 < 16384) row_load_contig(a.v + (size_t)r2 * 2048, c.lane, vb);
        fp6_row(va, a.V + (size_t)r * 192, a.VS + r, c.lane); if (r2 < 16384) fp6_row(vb, a.V + (size_t)r2 * 192, a.VS + r2, c.lane); }
    }
    if (parts & 4) {
    cvt_copy(c, a.k1, a.KB, (size_t)8 * 16384 / 8);
    cvt_copy(c, a.k2, a.KB + 8 * 16384, (size_t)8 * 16384 / 8); }
    if (blockIdx.x == 0) for (int i = c.tid; i < 1024; i += 512) a.LB[i] = a.layer == 0 ? 0.f : sigm(a.lbp[1024 + i] - a.lbp[i]);
}

__device__ __forceinline__ unsigned pack_i8x4u(float a, float b, float c, float d) {
    return (unsigned)__builtin_rintf(a) | ((unsigned)__builtin_rintf(b) << 8) | ((unsigned)__builtin_rintf(c) << 16) | ((unsigned)__builtin_rintf(d) << 24);
}
struct EpiIn {
    static constexpr bool PERM = true, AFTER_DRAIN = false;
    bf16* seg; bf16* gate; const float* lb; const float* sa;
    __device__ __forceinline__ float rowscale(int row) const { return ((const GAS float*)sa)[row] * (1.0f / WIN_QS); }
    __device__ __forceinline__ void operator()(const pg8::f32x4 (&acc)[2][2][4][2], const pg8::Unit& u, int wr, int wc, int fr, int fq) const {
        const int pn = u.pn; const int row0 = u.pm * 256 + wr * 64 + fr;
        if (pn >= 28 && pn < 36) {
            bf16* dst = seg + (size_t)7 * SEGSZ; const int col0 = (pn - 28) * 128 + wc * 32 + 8 * fq;
#pragma unroll
            for (int ai = 0; ai < 2; ++ai)
#pragma unroll
                for (int m = 0; m < 4; ++m) {
                    const pg8::f32x4 a0 = acc[ai][0][m][0], a1 = acc[ai][0][m][1], b0 = acc[ai][1][m][0], b1 = acc[ai][1][m][1];
                    v4u w; w.x = pk2c(a0[0] * sigm(b0[0]), a0[1] * sigm(b0[1])); w.y = pk2c(a0[2] * sigm(b0[2]), a0[3] * sigm(b0[3]));
                    w.z = pk2c(a1[0] * sigm(b1[0]), a1[1] * sigm(b1[1])); w.w = pk2c(a1[2] * sigm(b1[2]), a1[3] * sigm(b1[3]));
                    *(GAS v4u*)(dst + (size_t)(row0 + ai * 128 + m * 16) * 1024 + col0) = w; }
            return;
        }
        if (pn >= 24 && pn < 28) {
            unsigned char* g8 = (unsigned char*)(seg + (size_t)6 * SEGSZ); const int c8 = (pn & 3) * 256 + wc * 32 + 8 * fq;
#pragma unroll
            for (int ai = 0; ai < 2; ++ai)
#pragma unroll
                for (int m = 0; m < 4; ++m)
#pragma unroll
                    for (int bj = 0; bj < 2; ++bj) { const pg8::f32x4 v0 = acc[ai][bj][m][0], v1 = acc[ai][bj][m][1];
                        v2u w; w.x = pack_i8x4u(sigm(v0[0]) * 255.0f, sigm(v0[1]) * 255.0f, sigm(v0[2]) * 255.0f, sigm(v0[3]) * 255.0f); w.y = pack_i8x4u(sigm(v1[0]) * 255.0f, sigm(v1[1]) * 255.0f, sigm(v1[2]) * 255.0f, sigm(v1[3]) * 255.0f);
                        *(GAS v2u*)(g8 + (size_t)(row0 + ai * 128 + m * 16) * 1024 + c8 + bj * 128) = w; }
            return; }
        bf16* dst; int ld, colt, mode;
        if (pn < 28) { const int sg = pn >> 2; dst = seg + (size_t)sg * SEGSZ; ld = 1024; colt = (pn & 3) * 256; mode = (sg == 4) ? 2 : 0; }
        else {
            const int q = pn - 36; unsigned char* g8 = (unsigned char*)gate + (size_t)(q >> 3) * ((size_t)NTOK * 2048); const int c8 = (q & 7) * 256 + wc * 32 + 8 * fq;
#pragma unroll
            for (int ai = 0; ai < 2; ++ai)
#pragma unroll
                for (int m = 0; m < 4; ++m)
#pragma unroll
                    for (int bj = 0; bj < 2; ++bj) { const pg8::f32x4 v0 = acc[ai][bj][m][0], v1 = acc[ai][bj][m][1];
                        v2u w; w.x = pack_i8x4u(sigm(v0[0]) * 255.0f, sigm(v0[1]) * 255.0f, sigm(v0[2]) * 255.0f, sigm(v0[3]) * 255.0f); w.y = pack_i8x4u(sigm(v1[0]) * 255.0f, sigm(v1[1]) * 255.0f, sigm(v1[2]) * 255.0f, sigm(v1[3]) * 255.0f);
                        *(GAS v2u*)(g8 + (size_t)(row0 + ai * 128 + m * 16) * 2048 + c8 + bj * 128) = w; }
            return; }
        const int col0 = colt + wc * 32 + 8 * fq;
        if (mode == 0) {
#pragma unroll
            for (int ai = 0; ai < 2; ++ai)
#pragma unroll
                for (int m = 0; m < 4; ++m)
#pragma unroll
                    for (int bj = 0; bj < 2; ++bj) { const pg8::f32x4 v0 = acc[ai][bj][m][0], v1 = acc[ai][bj][m][1];
                        v4u w; w.x = pk2c(v0[0], v0[1]); w.y = pk2c(v0[2], v0[3]); w.z = pk2c(v1[0], v1[1]); w.w = pk2c(v1[2], v1[3]);
                        *(GAS v4u*)(dst + (size_t)(row0 + ai * 128 + m * 16) * ld + col0 + bj * 128) = w; }
        } else if (mode == 1) {
#pragma unroll
            for (int ai = 0; ai < 2; ++ai)
#pragma unroll
                for (int m = 0; m < 4; ++m)
#pragma unroll
                    for (int bj = 0; bj < 2; ++bj) { const pg8::f32x4 v0 = acc[ai][bj][m][0], v1 = acc[ai][bj][m][1];
                        v4u w; w.x = pk2c(sigm(v0[0]), sigm(v0[1])); w.y = pk2c(sigm(v0[2]), sigm(v0[3])); w.z = pk2c(sigm(v1[0]), sigm(v1[1])); w.w = pk2c(sigm(v1[2]), sigm(v1[3]));
                        *(GAS v4u*)(dst + (size_t)(row0 + ai * 128 + m * 16) * ld + col0 + bj * 128) = w; }
        } else {
            f32x4 l0[2], l1[2];
#pragma unroll
            for (int bj = 0; bj < 2; ++bj) { l0[bj] = *(const GAS f32x4*)(lb + col0 + bj * 128); l1[bj] = *(const GAS f32x4*)(lb + col0 + bj * 128 + 4); }
#pragma unroll
            for (int ai = 0; ai < 2; ++ai)
#pragma unroll
                for (int m = 0; m < 4; ++m)
#pragma unroll
                    for (int bj = 0; bj < 2; ++bj) { const pg8::f32x4 v0 = acc[ai][bj][m][0], v1 = acc[ai][bj][m][1]; float r[8];
#pragma unroll
                        for (int j = 0; j < 4; ++j) { r[j] = __logf(l0[bj][j] + (1.0f - l0[bj][j]) * sigm(v0[j])); r[4 + j] = __logf(l1[bj][j] + (1.0f - l1[bj][j]) * sigm(v1[j])); }
                        v4u w; w.x = pk2c(r[0], r[1]); w.y = pk2c(r[2], r[3]); w.z = pk2c(r[4], r[5]); w.w = pk2c(r[6], r[7]);
                        *(GAS v4u*)(dst + (size_t)(row0 + ai * 128 + m * 16) * ld + col0 + bj * 128) = w; }
        }
    }
};

__device__ __forceinline__ void conv_phase(const Ctx& c, const bf16* glu, const float* cw, const float* cb, const float* lnw, const float* lnb, bf16* out) {
    const int c0 = 2 * c.tid;
    float w0[31], w1[31];
#pragma unroll
    for (int j = 0; j < 31; ++j) { const f32x2v t = *(const GAS f32x2v*)(cw + j * 1024 + c0); w0[j] = t.x; w1[j] = t.y; }
    const f32x2v bv = *(const GAS f32x2v*)(cb + c0), lwv = *(const GAS f32x2v*)(lnw + c0), lbv = *(const GAS f32x2v*)(lnb + c0);
    LAS float* red = (LAS float*)c.lds;
    const int per = (NTOK / 8 + c.G - 1) / c.G, tile0 = (int)blockIdx.x * per;
    unsigned win[38];
    if (tile0 < NTOK / 8) {
#pragma unroll
        for (int r = 0; r < 38; ++r) { const int n = tile0 * 8 + r - 30; win[r] = *(const GAS unsigned*)(glu + (size_t)(n > 0 ? n : 0) * 1024 + c0); } }
    for (int ti = 0; ti < per; ++ti) { const int tile = tile0 + ti; if (tile >= NTOK / 8) break;
        const int n0 = tile * 8, tseq0 = n0 & (SEQ - 1);
        const bool more = (ti + 1 < per) && (tile + 1 < NTOK / 8);
        float a0[8], a1[8];
#pragma unroll
        for (int t = 0; t < 8; ++t) { a0[t] = bv.x; a1[t] = bv.y; }
#pragma unroll
        for (int r = 0; r < 38; ++r) {
            const unsigned xv = (tseq0 + r - 30 >= 0) ? win[r] : 0u;
            const float x0 = bflo(xv), x1 = bfhi(xv);
#pragma unroll
            for (int t = 0; t < 8; ++t) { const int j = r - t; if (j >= 0 && j <= 30) { a0[t] += w0[j] * x0; a1[t] += w1[j] * x1; } }
        }
#pragma unroll
        for (int r = 0; r < 30; ++r) win[r] = win[r + 8];
        if (more) {
#pragma unroll
            for (int i = 0; i < 8; ++i) win[30 + i] = *(const GAS unsigned*)(glu + (size_t)(n0 + 8 + i) * 1024 + c0); }
        float st[16];
#pragma unroll
        for (int t = 0; t < 8; ++t) { st[2 * t] = a0[t] + a1[t]; st[2 * t + 1] = a0[t] * a0[t] + a1[t] * a1[t]; }
        xreduce16(st, c.lane);
        if ((c.lane & 3) == 0) red[c.wave * 16 + ridx16(c.lane)] = st[0];
        __syncthreads();
        if (c.tid < 16) { float s = 0.f;
#pragma unroll
            for (int w = 0; w < 8; ++w) s += red[w * 16 + c.tid];
            red[128 + c.tid] = s; }
        __syncthreads();
#pragma unroll
        for (int t = 0; t < 8; ++t) {
            const float mean = red[128 + 2 * t] * (1.0f / 1024.0f), var = red[128 + 2 * t + 1] * (1.0f / 1024.0f) - mean * mean;
            const float rstd = __builtin_amdgcn_rsqf(var + EPS);
            const float h0 = (a0[t] - mean) * rstd * lwv.x + lbv.x, h1 = (a1[t] - mean) * rstd * lwv.y + lbv.y;
            const unsigned q4 = pack_i8x4c(h0 * sigm(h0) * ACT_QS, h1 * sigm(h1) * ACT_QS, 0.f, 0.f);
            *(GAS unsigned short*)((unsigned char*)out + (size_t)(n0 + t) * 1024 + c0) = (unsigned short)q4;
        }
        __syncthreads();
    }
}
__device__ __forceinline__ void hgrn_task(int task, int lane, const bf16* qhg, const bf16* logf, const bf16* ihg, bf16* out) {
    const int bh = task >> 6, dvb = task & 63, b = bh >> 3, h = bh & 7;
    const size_t rb = (size_t)b * SEQ * 1024;
    const GAS unsigned* qp = (const GAS unsigned*)(qhg + rb + h * 128) + lane;
    const GAS unsigned* lp = (const GAS unsigned*)(logf + rb + h * 128) + lane;
    const GAS unsigned* ip = (const GAS unsigned*)(ihg + rb + h * 128) + dvb;
    GAS bf16* op = (GAS bf16*)(out + rb + h * 128 + 2 * dvb);
    float S00 = 0.f, S01 = 0.f, S10 = 0.f, S11 = 0.f;
    unsigned qn[8], ln[8], inx[8];
#pragma unroll
    for (int j = 0; j < 8; ++j) { qn[j] = qp[(size_t)j * 512]; ln[j] = lp[(size_t)j * 512]; inx[j] = ip[(size_t)j * 512]; }
    for (int blk = 0; blk < SEQ / 8; ++blk) {
        unsigned qc[8], lc[8], ic[8];
#pragma unroll
        for (int j = 0; j < 8; ++j) { qc[j] = qn[j]; lc[j] = ln[j]; ic[j] = inx[j]; }
        if (blk + 1 < SEQ / 8) {
#pragma unroll
            for (int j = 0; j < 8; ++j) { const size_t o = (size_t)((blk + 1) * 8 + j) * 512; qn[j] = qp[o]; ln[j] = lp[o]; inx[j] = ip[o]; }
        }
        float pv[16];
#pragma unroll
        for (int j = 0; j < 8; ++j) {
            const float f0 = __expf(bflo(lc[j])), f1 = __expf(bfhi(lc[j])), k0 = 1.0f - f0, k1 = 1.0f - f1;
            const float i0 = bflo(ic[j]), i1 = bfhi(ic[j]), q0 = bflo(qc[j]), q1 = bfhi(qc[j]);
            S00 = f0 * S00 + k0 * i0; S01 = f0 * S01 + k0 * i1; S10 = f1 * S10 + k1 * i0; S11 = f1 * S11 + k1 * i1;
            pv[2 * j] = S00 * q0 + S10 * q1; pv[2 * j + 1] = S01 * q0 + S11 * q1;
        }
        xreduce16(pv, lane);
        if ((lane & 3) == 0) { const int idx = ridx16(lane); op[(size_t)(blk * 8 + (idx >> 1)) * 1024 + (idx & 1)] = (bf16)(pk2c(pv[0], 0.f) & 0xffffu); }
    }
}
constexpr int HG_TS = 272;
constexpr int HG_TL = 256;
constexpr int HG_TILE = 64 * HG_TL;
constexpr int HG_BS = 132;
__device__ __forceinline__ void hg_stage(LAS unsigned char* dst, const bf16* src, int tid) {
#pragma unroll
    for (int i = 0; i < 2; ++i) { const int p = tid + 512 * i, row = p >> 4, c16 = p & 15; *(LAS v4u*)(dst + row * HG_TL + c16 * 16) = *(const GAS v4u*)(src + (size_t)row * 1024 + c16 * 8); }
}
__device__ __forceinline__ void hg_scan(const LAS unsigned char* lft, int dk, int hf, float (&lf)[4][8], float (&b)[4][8], float& bl) {
    float bs[4], pb[4];
#pragma unroll
    for (int kk = 0; kk < 4; ++kk) { float run = 0.f;
#pragma unroll
        for (int j = 0; j < 8; ++j) { lf[kk][j] = __uint_as_float((unsigned)(*(const LAS unsigned short*)(lft + (16 * kk + 8 * hf + j) * HG_TL + dk * 2)) << 16); run += lf[kk][j]; b[kk][j] = run; }
        bs[kk] = run; }
#pragma unroll
    for (int kk = 0; kk < 4; ++kk) pb[kk] = xor32f(bs[kk], hf);
    float pre = 0.f;
#pragma unroll
    for (int kk = 0; kk < 4; ++kk) { const float off = pre + (hf ? pb[kk] : 0.f);
#pragma unroll
        for (int j = 0; j < 8; ++j) b[kk][j] += off;
        pre += bs[kk] + pb[kk]; }
    bl = pre;
}
__device__ __forceinline__ bf16x8 pack8(const float (&v)[8]) { v4u t; t.x = pk2c(v[0], v[1]); t.y = pk2c(v[2], v[3]); t.z = pk2c(v[4], v[5]); t.w = pk2c(v[6], v[7]); return __builtin_bit_cast(bf16x8, t); }
__device__ __forceinline__ unsigned lds_u16(const LAS unsigned char* p) { return (unsigned)(*(const LAS unsigned short*)p); }
__device__ __forceinline__ size_t hg_tile_off(int ci) { const int bh = ci >> 6, ch = ci & 63, bb = bh >> 3, h = bh & 7; return ((size_t)bb * SEQ + ch * 64) * 1024 + h * 128; }
__device__ __forceinline__ void hg_tile_dma(LAS unsigned char* dst, const bf16* src, int wave, int lane) {
    const unsigned long long a_ = (unsigned long long)src;
    const char* sb = (const char*)(((unsigned long long)(unsigned)__builtin_amdgcn_readfirstlane((int)(a_ >> 32)) << 32) | (unsigned)__builtin_amdgcn_readfirstlane((int)a_));
    const unsigned d0 = (unsigned)(unsigned long long)dst + (unsigned)wave * 2048u;
    const unsigned vo = (unsigned)wave * 16384u + (unsigned)(lane >> 4) * 2048u + (unsigned)(lane & 15) * 16u;
#pragma unroll
    for (int i = 0; i < 2; ++i) { const unsigned m0v = d0 + (unsigned)i * 1024u, vv = vo + (unsigned)i * 8192u;
        asm volatile("s_mov_b32 m0, %0\n\ts_nop 0\n\tglobal_load_lds_dwordx4 %1, %2" :: "s"(m0v), "v"(vv), "s"(sb) : "memory", "m0"); }
}
__device__ __forceinline__ void hgA_chunk(const Ctx& c, int ci, int cn, int par, bool first, const bf16* LOGF, const bf16* IHG, bf16* ST, float* DEC) {
    LAS unsigned char* lft = c.lds + par * 2 * HG_TILE; LAS unsigned char* itl = lft + HG_TILE; LAS unsigned char* nxt = c.lds + (par ^ 1) * 2 * HG_TILE;
    if (first) { const size_t o = hg_tile_off(ci); hg_stage(lft, LOGF + o, c.tid); hg_stage(itl, IHG + o, c.tid); }
    asm volatile("s_waitcnt vmcnt(0)" ::: "memory");
    __syncthreads();
    if (cn < 2048) { const size_t o = hg_tile_off(cn); hg_tile_dma(nxt, LOGF + o, c.wave, c.lane); hg_tile_dma(nxt + HG_TILE, IHG + o, c.wave, c.lane); }
    const int dkt = c.wave & 3, dvh = c.wave >> 2, hf = c.lane >> 5, cl = c.lane & 31, dk = 32 * dkt + cl;
    float lf[4][8], b[4][8], bl; hg_scan(lft, dk, hf, lf, b, bl);
    bf16x8 kf[4];
#pragma unroll
    for (int kk = 0; kk < 4; ++kk) { float v[8];
#pragma unroll
        for (int j = 0; j < 8; ++j) v[j] = (1.0f - __expf(lf[kk][j])) * __expf(bl - b[kk][j]);
        kf[kk] = pack8(v); }
    if (dvh == 0 && hf == 0) ((GAS float*)DEC)[(size_t)ci * 128 + dk] = __expf(bl);
#pragma unroll
    for (int dvi = 0; dvi < 2; ++dvi) { const int dvt = dvh * 2 + dvi;
        f32x16 acc;
#pragma unroll
        for (int r = 0; r < 16; ++r) acc[r] = 0.f;
#pragma unroll
        for (int kk = 0; kk < 4; ++kk) { const LAS unsigned char* p = itl + (16 * kk + 8 * hf) * HG_TL + (32 * dvt + cl) * 2;
            v4u t; t.x = lds_u16(p) | (lds_u16(p + HG_TL) << 16); t.y = lds_u16(p + 2 * HG_TL) | (lds_u16(p + 3 * HG_TL) << 16); t.z = lds_u16(p + 4 * HG_TL) | (lds_u16(p + 5 * HG_TL) << 16); t.w = lds_u16(p + 6 * HG_TL) | (lds_u16(p + 7 * HG_TL) << 16);
            acc = MFMA32(kf[kk], __builtin_bit_cast(bf16x8, t), acc); }
        bf16* o = ST + (size_t)ci * 16384 + (size_t)(32 * dvt + cl) * 128 + 32 * dkt + 4 * hf;
#pragma unroll
        for (int g = 0; g < 4; ++g) { v2u q; q.x = pk2c(acc[4 * g], acc[4 * g + 1]); q.y = pk2c(acc[4 * g + 2], acc[4 * g + 3]); *(GAS v2u*)(o + 8 * g) = q; }
    }
    __syncthreads();
}
__device__ __forceinline__ void hgB(const Ctx& c, bf16* ST, const float* DEC) {
    for (int e = blockIdx.x * 512 + c.tid; e < 32 * 4096; e += c.G * 512) {
        const int bh = e >> 12, r = e & 4095, dv = r >> 5, dk4 = (r & 31) * 4;
        GAS v2u* p = (GAS v2u*)(ST + (size_t)bh * 64 * 16384 + (size_t)dv * 128 + dk4);
        const GAS f32x4* d = (const GAS f32x4*)(DEC + (size_t)bh * 64 * 128 + dk4);
        f32x4 S = {0.f, 0.f, 0.f, 0.f};
#pragma unroll
        for (int c0 = 0; c0 < 64; c0 += 8) {
            v2u Lv[8]; f32x4 D[8];
#pragma unroll
            for (int k = 0; k < 8; ++k) { Lv[k] = p[(size_t)(c0 + k) * 4096]; D[k] = d[(size_t)(c0 + k) * 32]; }
#pragma unroll
            for (int k = 0; k < 8; ++k) { v2u o; o.x = pk2c(S.x, S.y); o.y = pk2c(S.z, S.w); p[(size_t)(c0 + k) * 4096] = o;
                S.x = D[k].x * S.x + bflo(Lv[k].x); S.y = D[k].y * S.y + bfhi(Lv[k].x); S.z = D[k].z * S.z + bflo(Lv[k].y); S.w = D[k].w * S.w + bfhi(Lv[k].y); }
        }
    }
}
__device__ __forceinline__ void hgC_chunk(const Ctx& c, int ci, int cn, int par, bool first, const bf16* QHG, const bf16* LOGF, const bf16* IHG, const bf16* GHG, const bf16* ST, const float* nw, bf16* OUT) {
    const int bh = ci >> 6, ch = ci & 63, bb = bh >> 3, h = bh & 7; const size_t n0 = (size_t)bb * SEQ + ch * 64;
    LAS unsigned char* lft = c.lds + par * 2 * HG_TILE; LAS unsigned char* itl = lft + HG_TILE; LAS unsigned char* nxt = c.lds + (par ^ 1) * 2 * HG_TILE;
    LAS float* bt = (LAS float*)(c.lds + 4 * HG_TILE); LAS float* red = bt + 64 * HG_BS;
    LAS unsigned char* ktl = (LAS unsigned char*)(red + 256);
    const int hf = c.lane >> 5, cl = c.lane & 31;
    const int dvt = c.wave & 3, tt = c.wave >> 2, t = 32 * tt + cl;
    const bf16* qrow = QHG + (n0 + t) * 1024 + h * 128 + 8 * hf;
    if (first) { hg_stage(lft, LOGF + n0 * 1024 + h * 128, c.tid); hg_stage(itl, IHG + n0 * 1024 + h * 128, c.tid); }
    asm volatile("s_waitcnt vmcnt(0)" ::: "memory");
    __syncthreads();
    v4u qg[8];
#pragma unroll
    for (int kk = 0; kk < 8; ++kk) qg[kk] = *(const GAS v4u*)(qrow + 16 * kk);
    { const int dk = 32 * (c.wave & 3) + cl; float lf[4][8], b[4][8], bl; hg_scan(lft, dk, hf, lf, b, bl);
#pragma unroll
      for (int q = 0; q < 2; ++q) { const int kk = 2 * (c.wave >> 2) + q;
#pragma unroll
          for (int j = 0; j < 8; ++j) { bt[(16 * kk + 8 * hf + j) * HG_BS + dk] = (c.wave >> 2) ? b[2 + q][j] : b[q][j];
              *(LAS unsigned short*)(ktl + (16 * kk + 8 * hf + j) * HG_TS + dk * 2) = (unsigned short)(pk2c(1.0f - __expf((c.wave >> 2) ? lf[2 + q][j] : lf[q][j]), 0.f) & 0xffffu); } } }
    __syncthreads();
    if (cn < 2048) { const size_t o = hg_tile_off(cn); hg_tile_dma(nxt, LOGF + o, c.wave, c.lane); hg_tile_dma(nxt + HG_TILE, IHG + o, c.wave, c.lane); }
    bf16x8 qm[8];
    const bf16* strow = ST + (size_t)ci * 16384 + (size_t)(32 * dvt + cl) * 128 + 8 * hf;
#pragma unroll
    for (int kk = 0; kk < 8; ++kk) { const int d0 = 16 * kk + 8 * hf;
        const v4u qv = qg[kk];
        const f32x4 b0 = *(const LAS f32x4*)(bt + t * HG_BS + d0), b1 = *(const LAS f32x4*)(bt + t * HG_BS + d0 + 4), m0 = *(const LAS f32x4*)(bt + 31 * HG_BS + d0), m1 = *(const LAS f32x4*)(bt + 31 * HG_BS + d0 + 4);
        const float q[8] = {bflo(qv.x), bfhi(qv.x), bflo(qv.y), bfhi(qv.y), bflo(qv.z), bfhi(qv.z), bflo(qv.w), bfhi(qv.w)};
        const float bv[8] = {b0.x, b0.y, b0.z, b0.w, b1.x, b1.y, b1.z, b1.w}, mv[8] = {m0.x, m0.y, m0.z, m0.w, m1.x, m1.y, m1.z, m1.w};
        float vm[8];
#pragma unroll
        for (int j = 0; j < 8; ++j) vm[j] = q[j] * __expf(bv[j] - mv[j]);
        qm[kk] = pack8(vm); }
    f32x16 o;
#pragma unroll
    for (int r = 0; r < 16; ++r) o[r] = 0.f;
#pragma unroll 1
    for (int st = 0; st <= tt; ++st) {
        const int s = 32 * st + cl;
        f32x16 sa;
#pragma unroll
        for (int r = 0; r < 16; ++r) sa[r] = 0.f;
#pragma unroll
        for (int kk = 0; kk < 8; ++kk) { const int d0 = 16 * kk + 8 * hf;
            asm volatile("" ::: "memory");
            const v4u lv = *(const LAS v4u*)(ktl + s * HG_TS + d0 * 2);
            const f32x4 b0 = *(const LAS f32x4*)(bt + s * HG_BS + d0), b1 = *(const LAS f32x4*)(bt + s * HG_BS + d0 + 4), m0 = *(const LAS f32x4*)(bt + 31 * HG_BS + d0), m1 = *(const LAS f32x4*)(bt + 31 * HG_BS + d0 + 4);
            const float kv[8] = {bflo(lv.x), bfhi(lv.x), bflo(lv.y), bfhi(lv.y), bflo(lv.z), bfhi(lv.z), bflo(lv.w), bfhi(lv.w)};
            const float bv[8] = {b0.x, b0.y, b0.z, b0.w, b1.x, b1.y, b1.z, b1.w}, mv[8] = {m0.x, m0.y, m0.z, m0.w, m1.x, m1.y, m1.z, m1.w};
            float vk[8];
#pragma unroll
            for (int j = 0; j < 8; ++j) vk[j] = kv[j] * __expf(mv[j] - bv[j]);
            sa = MFMA32(pack8(vk), qm[kk], sa); }
        if (st == tt) {
#pragma unroll
            for (int r = 0; r < 16; ++r) if (((r & 3) + 8 * (r >> 2) + 4 * hf) > cl) sa[r] = 0.f;
        }
#pragma unroll
        for (int sp = 0; sp < 2; ++sp) {
            const float pv[8] = {sa[8 * sp], sa[8 * sp + 1], sa[8 * sp + 2], sa[8 * sp + 3], sa[8 * sp + 4], sa[8 * sp + 5], sa[8 * sp + 6], sa[8 * sp + 7]};
            const LAS unsigned char* p = itl + (32 * st + 16 * sp + 4 * hf) * HG_TL + (32 * dvt + cl) * 2;
            v4u tq; tq.x = lds_u16(p) | (lds_u16(p + HG_TL) << 16); tq.y = lds_u16(p + 2 * HG_TL) | (lds_u16(p + 3 * HG_TL) << 16);
            tq.z = lds_u16(p + 8 * HG_TL) | (lds_u16(p + 9 * HG_TL) << 16); tq.w = lds_u16(p + 10 * HG_TL) | (lds_u16(p + 11 * HG_TL) << 16);
            o = MFMA32(__builtin_bit_cast(bf16x8, tq), pack8(pv), o); }
    }
    { bf16x8 sf[8];
#pragma unroll
      for (int kk = 0; kk < 8; ++kk) sf[kk] = *(const GAS bf16x8*)(strow + 16 * kk);
#pragma unroll
      for (int kk = 0; kk < 8; ++kk) { const int d0 = 16 * kk + 8 * hf;
          const v4u qv = qg[kk];
          const f32x4 b0 = *(const LAS f32x4*)(bt + t * HG_BS + d0), b1 = *(const LAS f32x4*)(bt + t * HG_BS + d0 + 4);
          float ve[8] = {bflo(qv.x) * __expf(b0.x), bfhi(qv.x) * __expf(b0.y), bflo(qv.y) * __expf(b0.z), bfhi(qv.y) * __expf(b0.w), bflo(qv.z) * __expf(b1.x), bfhi(qv.z) * __expf(b1.y), bflo(qv.w) * __expf(b1.z), bfhi(qv.w) * __expf(b1.w)};
          o = MFMA32(sf[kk], pack8(ve), o); } }
    float ss = 0.f;
#pragma unroll
    for (int r = 0; r < 16; ++r) ss += o[r] * o[r];
    ss += xor32f(ss, hf);
    if (hf == 0) red[(tt * 4 + dvt) * 32 + cl] = ss;
    __syncthreads();
    const float rstd = __builtin_amdgcn_rsqf(((red[(tt * 4 + 0) * 32 + cl] + red[(tt * 4 + 1) * 32 + cl]) + (red[(tt * 4 + 2) * 32 + cl] + red[(tt * 4 + 3) * 32 + cl])) * (1.0f / 128.0f) + EPS);
#pragma unroll
    for (int g = 0; g < 4; ++g) { const int dv0 = 32 * dvt + 8 * g + 4 * hf; const size_t off = (n0 + t) * 1024 + h * 128 + dv0;
        const unsigned gg = *(const GAS unsigned*)((const unsigned char*)GHG + off); const f32x4 w4 = *(const GAS f32x4*)(nw + dv0);
        const float rq = rstd * (ACT_QS / 255.0f);
        *(GAS unsigned*)((unsigned char*)OUT + off) = pack_i8x4c(o[4 * g] * rq * w4.x * (float)(gg & 255u), o[4 * g + 1] * rq * w4.y * (float)((gg >> 8) & 255u), o[4 * g + 2] * rq * w4.z * (float)((gg >> 16) & 255u), o[4 * g + 3] * rq * w4.w * (float)(gg >> 24)); }
    __syncthreads();
}
__device__ __forceinline__ void qknorm_rows4(bf16* row0, size_t rstride, const float* w, float scale, int lane) {
    v4u x[4][2];
#pragma unroll
    for (int i = 0; i < 4; ++i)
#pragma unroll
        for (int j = 0; j < 2; ++j) x[i][j] = *(const GAS v4u*)(row0 + i * rstride + 8 * lane + 512 * j);
    const f32x4 wa = *(const GAS f32x4*)(w + ((8 * lane) & 127)), wb = *(const GAS f32x4*)(w + ((8 * lane) & 127) + 4);
#pragma unroll
    for (int i = 0; i < 4; ++i)
#pragma unroll
        for (int j = 0; j < 2; ++j) { const v4u xx = x[i][j];
            float f[8] = {bflo(xx.x), bfhi(xx.x), bflo(xx.y), bfhi(xx.y), bflo(xx.z), bfhi(xx.z), bflo(xx.w), bfhi(xx.w)};
            float ss = 0.f;
#pragma unroll
            for (int k = 0; k < 8; ++k) ss += f[k] * f[k];
            ss += __shfl_xor(ss, 1); ss += __shfl_xor(ss, 2); ss += __shfl_xor(ss, 4); ss += __shfl_xor(ss, 8);
            const float r = __builtin_amdgcn_rsqf(ss * (1.0f / 128.0f) + EPS) * scale;
            v4u o; o.x = pk2c(f[0] * r * wa.x, f[1] * r * wa.y); o.y = pk2c(f[2] * r * wa.z, f[3] * r * wa.w); o.z = pk2c(f[4] * r * wb.x, f[5] * r * wb.y); o.w = pk2c(f[6] * r * wb.z, f[7] * r * wb.w);
            *(GAS v4u*)(row0 + i * rstride + 8 * lane + 512 * j) = o; }
}
__device__ __forceinline__ void vt_item(int item, int lane, const bf16* vsb, bf16* vt, LAS unsigned short* scr) {
    const int db = item & 3, sb = (item >> 2) & 63, bh = item >> 8, b = bh >> 3, h = bh & 7;
    const bf16* src = vsb + ((size_t)b * SEQ + sb * 64) * 1024 + h * 128 + db * 32;
#pragma unroll 4
    for (int i = 0; i < 16; ++i) { const int r = 4 * i + (lane >> 4); *(LAS unsigned*)(scr + r * 34 + 2 * (lane & 15)) = *(const GAS unsigned*)(src + (size_t)r * 1024 + 2 * (lane & 15)); }
    LDS_WAIT();
    const int c = lane & 7, b0 = 16 * (c >> 1) + 4 * (c & 1);
#pragma unroll
    for (int j = 0; j < 4; ++j) { const int d = (lane >> 3) + 8 * j; const LAS unsigned short* s = scr + b0 * 34 + d;
        v4u o; o.x = (unsigned)s[0] | ((unsigned)s[34] << 16); o.y = (unsigned)s[68] | ((unsigned)s[102] << 16); o.z = (unsigned)s[8 * 34] | ((unsigned)s[9 * 34] << 16); o.w = (unsigned)s[10 * 34] | ((unsigned)s[11 * 34] << 16);
        *(GAS v4u*)(vt + ((size_t)bh * 128 + db * 32 + d) * SEQ + sb * 64 + 8 * c) = o; }
    LDS_WAIT();
}

constexpr int AT_BUF = 32768, AT_VOFF = 16384;
__device__ __forceinline__ f32x16 attn_scores(const LAS unsigned char* kt, int krow, int hf, const bf16x8 (&qf)[8]) {
    f32x16 sa;
#pragma unroll
    for (int r = 0; r < 16; ++r) sa[r] = 0.f;
    const LAS unsigned char* kp = kt + krow * 256; const int sw = krow & 15;
#pragma unroll
    for (int kk = 0; kk < 8; ++kk) sa = MFMA32(*(const LAS bf16x8*)(kp + (((2 * kk + hf) ^ sw) << 4)), qf[kk], sa);
    return sa;
}
template <bool DIAG> __device__ __forceinline__ void attn_weights(const f32x16& sa, float& R, int hf, int cl, bf16x8 (&pf)[2]) {
    float om[16];
#pragma unroll
    for (int r = 0; r < 16; ++r) om[r] = __builtin_amdgcn_rcpf(1.0f + __builtin_amdgcn_exp2f(sa[r]));
    if (DIAG) {
#pragma unroll
        for (int r = 0; r < 16; ++r) if (((r & 3) + 8 * (r >> 2) + 4 * hf) >= cl) om[r] = 1.0f;
    }
    float Gs[4], Gp[4];
#pragma unroll
    for (int g = 0; g < 4; ++g) { Gs[g] = (om[4 * g] * om[4 * g + 1]) * (om[4 * g + 2] * om[4 * g + 3]); Gp[g] = xor32f(Gs[g], hf); }
    float tail = R; float w[16];
#pragma unroll
    for (int g = 3; g >= 0; --g) {
        const float c3 = tail * (hf == 0 ? Gp[g] : 1.0f), c2 = c3 * om[4 * g + 3], c1 = c2 * om[4 * g + 2], c0 = c1 * om[4 * g + 1];
        w[4 * g + 3] = c3 - om[4 * g + 3] * c3; w[4 * g + 2] = c2 - om[4 * g + 2] * c2; w[4 * g + 1] = c1 - om[4 * g + 1] * c1; w[4 * g] = c0 - om[4 * g] * c0;
        tail *= Gs[g] * Gp[g];
    }
    R = tail;
#pragma unroll
    for (int sp = 0; sp < 2; ++sp) { v4u t; t.x = pk2c(w[8 * sp], w[8 * sp + 1]); t.y = pk2c(w[8 * sp + 2], w[8 * sp + 3]); t.z = pk2c(w[8 * sp + 4], w[8 * sp + 5]); t.w = pk2c(w[8 * sp + 6], w[8 * sp + 7]); pf[sp] = __builtin_bit_cast(bf16x8, t); }
}
__device__ __forceinline__ void attn_pv(const LAS unsigned char* vt, int sub, int cl, int hf, const bf16x8 (&pf)[2], f32x16 (&o)[4]) {
#pragma unroll
    for (int d = 0; d < 4; ++d) { const int row = 32 * d + cl; const LAS unsigned char* vp = vt + row * 128; const int sw = (row >> 1) & 7;
#pragma unroll
        for (int sp = 0; sp < 2; ++sp) { const int x = 4 * sub + 2 * sp + hf;
            o[d] = MFMA32(*(const LAS bf16x8*)(vp + ((x ^ sw) << 4)), pf[sp], o[d]); } }
}
template <bool LAG> __device__ __forceinline__ void attn_unit(const Ctx& c, int bh, int qb, const bf16* qsb, const bf16* ksb, const bf16* vt, bf16* outb) {
    int lane_ = c.lane; asm volatile("" : "+v"(lane_));
    const int b = bh >> 3, h = bh & 7, lane = lane_, cl = lane & 31, hf = lane >> 5;
    const size_t rb = (size_t)b * SEQ; const int q0w = 256 * qb + 32 * c.wave;
    bf16x8 qf[8];
    { const bf16* qrow = qsb + (rb + q0w + cl) * 1024 + h * 128 + 8 * hf;
#pragma unroll
      for (int kk = 0; kk < 8; ++kk) qf[kk] = *(const GAS bf16x8*)(qrow + 16 * kk); }
    f32x16 o[4];
#pragma unroll
    for (int d = 0; d < 4; ++d)
#pragma unroll
        for (int r = 0; r < 16; ++r) o[d][r] = 0.f;
    float R = 1.0f;
    bf16x8 pd[2]; const LAS unsigned char* vimd = c.lds; int subd = 0; bool pending = false;
    const int kr0 = 8 * c.wave + (lane >> 4), kr1 = kr0 + 4;
    const bf16* kg0 = ksb + (rb + kr0) * 1024 + h * 128 + (((lane & 15) ^ (kr0 & 15)) << 3);
    const bf16* kg1 = ksb + (rb + kr1) * 1024 + h * 128 + (((lane & 15) ^ (kr1 & 15)) << 3);
    const int vr0 = 16 * c.wave + (lane >> 3), vr1 = vr0 + 8;
    const bf16* vg0 = vt + ((size_t)bh * 128 + vr0) * SEQ + (((lane & 7) ^ ((vr0 >> 1) & 7)) << 3);
    const bf16* vg1 = vt + ((size_t)bh * 128 + vr1) * SEQ + (((lane & 7) ^ ((vr1 >> 1) & 7)) << 3);
    LAS unsigned char* dk = c.lds + c.wave * 2048; LAS unsigned char* dv = c.lds + AT_VOFF + c.wave * 2048;
#define AT_DMA(kt_, bi_) do { const int ktt_ = (kt_); LAS unsigned char* bb_ = (LAS unsigned char*)0 + (bi_) * AT_BUF; \
        __builtin_amdgcn_global_load_lds((const unsigned*)(kg0 + (size_t)ktt_ * 64 * 1024), (LAS unsigned*)(dk + (bi_) * AT_BUF), 16, 0, 0); \
        __builtin_amdgcn_global_load_lds((const unsigned*)(kg1 + (size_t)ktt_ * 64 * 1024), (LAS unsigned*)(dk + (bi_) * AT_BUF + 1024), 16, 0, 0); \
        __builtin_amdgcn_global_load_lds((const unsigned*)(vg0 + ktt_ * 64), (LAS unsigned*)(dv + (bi_) * AT_BUF), 16, 0, 0); \
        __builtin_amdgcn_global_load_lds((const unsigned*)(vg1 + ktt_ * 64), (LAS unsigned*)(dv + (bi_) * AT_BUF + 1024), 16, 0, 0); (void)bb_; } while (0)
    const int nkt = 4 * (qb + 1);
    asm volatile("s_waitcnt vmcnt(0)" ::: "memory");
    AT_DMA(nkt - 1, 0); AT_DMA(nkt - 2, 1);
    asm volatile("s_waitcnt vmcnt(4)" ::: "memory"); __builtin_amdgcn_s_barrier(); asm volatile("" ::: "memory");
    int bi = 0;
#pragma unroll 1
    for (int it = 0; it < nkt; ++it) {
        const int kt = nkt - 1 - it;
        const int b2 = (bi + 2) & 3;
        if (it + 2 < nkt) AT_DMA(kt - 2, b2);
        const LAS unsigned char* kim = c.lds + bi * AT_BUF; const LAS unsigned char* vim = kim + AT_VOFF;
        const int rel = q0w - 64 * kt;
        if (rel >= 32) {
            if (LAG) { if (pending) attn_pv(vimd, subd, cl, hf, pd, o);
                const f32x16 s1 = attn_scores(kim, 32 + cl, hf, qf); if (rel == 32) attn_weights<true>(s1, R, hf, cl, pd); else attn_weights<false>(s1, R, hf, cl, pd);
                vimd = vim; subd = 1; pending = true;
            } else { bf16x8 p[2];
                { const f32x16 s1 = attn_scores(kim, 32 + cl, hf, qf); if (rel == 32) attn_weights<true>(s1, R, hf, cl, p); else attn_weights<false>(s1, R, hf, cl, p); }
                attn_pv(vim, 1, cl, hf, p, o); }
        }
        if (rel >= 0) {
            if (LAG) { if (pending) attn_pv(vimd, subd, cl, hf, pd, o);
                const f32x16 s0 = attn_scores(kim, cl, hf, qf); if (rel == 0) attn_weights<true>(s0, R, hf, cl, pd); else attn_weights<false>(s0, R, hf, cl, pd);
                vimd = vim; subd = 0; pending = true;
            } else { bf16x8 p[2];
                { const f32x16 s0 = attn_scores(kim, cl, hf, qf); if (rel == 0) attn_weights<true>(s0, R, hf, cl, p); else attn_weights<false>(s0, R, hf, cl, p); }
                attn_pv(vim, 0, cl, hf, p, o); }
        }
        if (it + 2 < nkt) asm volatile("s_waitcnt vmcnt(4)\n\ts_waitcnt lgkmcnt(0)" ::: "memory"); else asm volatile("s_waitcnt vmcnt(0)\n\ts_waitcnt lgkmcnt(0)" ::: "memory");
        __builtin_amdgcn_s_barrier(); asm volatile("" ::: "memory");
        bi = (bi + 1) & 3;
    }
#undef AT_DMA
    if (LAG && pending) attn_pv(vimd, subd, cl, hf, pd, o);
    bf16* orow = outb + (rb + q0w + cl) * 1024 + h * 128 + 4 * hf;
#pragma unroll
    for (int d = 0; d < 4; ++d)
#pragma unroll
        for (int g = 0; g < 4; ++g) { v2u q; q.x = pk2c(o[d][4 * g], o[d][4 * g + 1]); q.y = pk2c(o[d][4 * g + 2], o[d][4 * g + 3]); *(GAS v2u*)(orow + 32 * d + 8 * g) = q; }
    asm volatile("s_waitcnt vmcnt(0)" ::: "memory"); __builtin_amdgcn_s_barrier(); asm volatile("" ::: "memory");
}
__device__ __forceinline__ void hgpost_row(bf16* row, const bf16* grow, const float* w, int lane) {
#pragma unroll
    for (int j = 0; j < 2; ++j) {
        GAS v4u* p = (GAS v4u*)(row + 8 * lane + 512 * j); const v4u x = *p; const v4u gg = *(const GAS v4u*)(grow + 8 * lane + 512 * j);
        float f[8] = {bflo(x.x), bfhi(x.x), bflo(x.y), bfhi(x.y), bflo(x.z), bfhi(x.z), bflo(x.w), bfhi(x.w)};
        const float g[8] = {bflo(gg.x), bfhi(gg.x), bflo(gg.y), bfhi(gg.y), bflo(gg.z), bfhi(gg.z), bflo(gg.w), bfhi(gg.w)};
        float ss = 0.f;
#pragma unroll
        for (int k = 0; k < 8; ++k) ss += f[k] * f[k];
        ss += __shfl_xor(ss, 1); ss += __shfl_xor(ss, 2); ss += __shfl_xor(ss, 4); ss += __shfl_xor(ss, 8);
        const float r = __builtin_amdgcn_rsqf(ss * (1.0f / 128.0f) + EPS);
        const f32x4 wa = *(const GAS f32x4*)(w + ((8 * lane) & 127)), wb = *(const GAS f32x4*)(w + ((8 * lane) & 127) + 4);
        v4u o; o.x = pk2c(f[0] * r * wa.x * g[0], f[1] * r * wa.y * g[1]); o.y = pk2c(f[2] * r * wa.z * g[2], f[3] * r * wa.w * g[3]);
        o.z = pk2c(f[4] * r * wb.x * g[4], f[5] * r * wb.y * g[5]); o.w = pk2c(f[6] * r * wb.z * g[6], f[7] * r * wb.w * g[7]);
        *p = o;
    }
}

template <bool FIRST> struct EpiMerge {
    static constexpr bool PERM = true, AFTER_DRAIN = false;
    const unsigned char* gate; bf16* merged;
    __device__ __forceinline__ float rowscale(int) const { return 1.0f / (ACT_QS * WBR_QS); }
    __device__ __forceinline__ void operator()(const pg8::f32x4 (&acc)[2][2][4][2], const pg8::Unit& u, int wr, int wc, int fr, int fq) const {
        const int row0 = u.pm * 256 + wr * 64 + fr, col0 = u.pn * 256 + wc * 32 + 8 * fq;
#pragma unroll
        for (int ai = 0; ai < 2; ++ai)
#pragma unroll
            for (int m = 0; m < 4; ++m) {
                if (m == 0) asm volatile("" ::: "memory");
#pragma unroll
                for (int bj = 0; bj < 2; ++bj) {
                    const size_t off = (size_t)(row0 + ai * 128 + m * 16) * 2048 + col0 + bj * 128;
                    const v2u g = *(const GAS v2u*)(gate + off); const pg8::f32x4 v0 = acc[ai][bj][m][0], v1 = acc[ai][bj][m][1]; constexpr float k = 1.0f / 255.0f;
                    float r[8] = {(float)(g.x & 255u) * (v0[0] * k), (float)((g.x >> 8) & 255u) * (v0[1] * k), (float)((g.x >> 16) & 255u) * (v0[2] * k), (float)(g.x >> 24) * (v0[3] * k),
                                  (float)(g.y & 255u) * (v1[0] * k), (float)((g.y >> 8) & 255u) * (v1[1] * k), (float)((g.y >> 16) & 255u) * (v1[2] * k), (float)(g.y >> 24) * (v1[3] * k)};
                    if (!FIRST) { const v4u mo = *(const GAS v4u*)(merged + off);
                        r[0] += bflo(mo.x); r[1] += bfhi(mo.x); r[2] += bflo(mo.y); r[3] += bfhi(mo.y); r[4] += bflo(mo.z); r[5] += bfhi(mo.z); r[6] += bflo(mo.w); r[7] += bfhi(mo.w); }
                    v4u w; w.x = pk2c(r[0], r[1]); w.y = pk2c(r[2], r[3]); w.z = pk2c(r[4], r[5]); w.w = pk2c(r[6], r[7]);
                    *(GAS v4u*)(merged + off) = w; }
            }
    }
};
struct EpiStoreBf16 {
    static constexpr bool PERM = true, AFTER_DRAIN = false;
    bf16* out; const float* sa;
    __device__ __forceinline__ float rowscale(int row) const { return ((const GAS float*)sa)[row] * (1.0f / WIN_QS); }
    __device__ __forceinline__ void operator()(const pg8::f32x4 (&acc)[2][2][4][2], const pg8::Unit& u, int wr, int wc, int fr, int fq) const {
        const int row0 = u.pm * 256 + wr * 64 + fr, col0 = u.pn * 256 + wc * 32 + 8 * fq;
#pragma unroll
        for (int ai = 0; ai < 2; ++ai)
#pragma unroll
            for (int m = 0; m < 4; ++m)
#pragma unroll
                for (int bj = 0; bj < 2; ++bj) { const pg8::f32x4 v0 = acc[ai][bj][m][0], v1 = acc[ai][bj][m][1];
                    v4u w; w.x = pk2c(v0[0], v0[1]); w.y = pk2c(v0[2], v0[3]); w.z = pk2c(v1[0], v1[1]); w.w = pk2c(v1[2], v1[3]);
                    *(GAS v4u*)(out + (size_t)(row0 + ai * 128 + m * 16) * 2048 + col0 + bj * 128) = w; }
    }
};
struct EpiResid {
    static constexpr bool PERM = true, AFTER_DRAIN = false;
    const void* xin; bf16* xout; const float* ms; int XIN_BF16;
    __device__ __forceinline__ float rowscale(int row) const { return ((const GAS float*)ms)[row] * (1.0f / WIN_QS); }
    __device__ __forceinline__ void operator()(const pg8::f32x4 (&acc)[2][2][4][2], const pg8::Unit& u, int wr, int wc, int fr, int fq) const {
        const int row0 = u.pm * 256 + wr * 64 + fr, col0 = u.pn * 256 + wc * 32 + 8 * fq;
#pragma unroll
        for (int ai = 0; ai < 2; ++ai)
#pragma unroll
            for (int m = 0; m < 4; ++m)
#pragma unroll
                for (int bj = 0; bj < 2; ++bj) { const size_t off = (size_t)(row0 + ai * 128 + m * 16) * 2048 + col0 + bj * 128;
                    const pg8::f32x4 v0 = acc[ai][bj][m][0], v1 = acc[ai][bj][m][1]; float r[8];
                    if (XIN_BF16) { const v4u x = *(const GAS v4u*)((const bf16*)xin + off);
                        r[0] = v0[0] + bflo(x.x); r[1] = v0[1] + bfhi(x.x); r[2] = v0[2] + bflo(x.y); r[3] = v0[3] + bfhi(x.y); r[4] = v1[0] + bflo(x.z); r[5] = v1[1] + bfhi(x.z); r[6] = v1[2] + bflo(x.w); r[7] = v1[3] + bfhi(x.w); }
                    else { const f32x4 x0 = *(const GAS f32x4*)((const float*)xin + off), x1 = *(const GAS f32x4*)((const float*)xin + off + 4);
                        r[0] = v0[0] + x0.x; r[1] = v0[1] + x0.y; r[2] = v0[2] + x0.z; r[3] = v0[3] + x0.w; r[4] = v1[0] + x1.x; r[5] = v1[1] + x1.y; r[6] = v1[2] + x1.z; r[7] = v1[3] + x1.w; }
                    v4u w; w.x = pk2c(r[0], r[1]); w.y = pk2c(r[2], r[3]); w.z = pk2c(r[4], r[5]); w.w = pk2c(r[6], r[7]);
                    *(GAS v4u*)(xout + off) = w; }
    }
};

__device__ __forceinline__ float rl_f(float v, int l) { return __uint_as_float((unsigned)__builtin_amdgcn_readlane((int)__float_as_uint(v), l)); }
__device__ __forceinline__ void ins16(float (&L)[16], float x) {
#pragma unroll
    for (int i = 0; i < 16; ++i) { const float hi = __builtin_fmaxf(L[i], x); x = __builtin_fminf(L[i], x); L[i] = hi; }
}
#define CE_DESC(a, b) do { const float hi_ = __builtin_fmaxf(a, b), lo_ = __builtin_fminf(a, b); a = hi_; b = lo_; } while (0)
__device__ __forceinline__ void sort16_desc(float (&v)[16]) {
#pragma unroll
    for (int k = 2; k <= 16; k <<= 1)
#pragma unroll
        for (int j = k >> 1; j > 0; j >>= 1)
#pragma unroll
            for (int i = 0; i < 16; ++i) { const int l = i ^ j; if (l > i) { if ((i & k) == 0) CE_DESC(v[i], v[l]); else CE_DESC(v[l], v[i]); } }
}
__device__ __forceinline__ void bitonic_merge16_desc(float (&v)[16]) {
#pragma unroll
    for (int j = 8; j > 0; j >>= 1)
#pragma unroll
        for (int i = 0; i < 16; ++i) { const int l = i ^ j; if (l > i) CE_DESC(v[i], v[l]); }
}
__device__ __forceinline__ void top16_merge(float (&L)[16], const float (&T)[16]) {
#pragma unroll
    for (int i = 0; i < 16; ++i) L[i] = __builtin_fmaxf(L[i], T[15 - i]);
    bitonic_merge16_desc(L);
}
constexpr int PK_KS = 272;
__device__ __forceinline__ void peer_top16(const bf16* qrow  , const LAS unsigned char* kl  , int hf, float (&L)[16]) {
    bf16x8 qf[8];
#pragma unroll
    for (int kk = 0; kk < 8; ++kk) qf[kk] = *(const GAS bf16x8*)(qrow + 16 * kk);
#pragma unroll 1
    for (int kt = 0; kt < 4; ++kt) {
        f32x16 sa;
#pragma unroll
        for (int r = 0; r < 16; ++r) sa[r] = 0.f;
#pragma unroll
        for (int kk = 0; kk < 8; ++kk) sa = MFMA32(*(const LAS bf16x8*)(kl + kt * 32 * PK_KS + 32 * kk), qf[kk], sa);
        float T[16];
#pragma unroll
        for (int r = 0; r < 16; ++r) { const unsigned idx = (unsigned)(kt * 32 + (r & 3) + 8 * (r >> 2) + 4 * hf); T[r] = __uint_as_float((__float_as_uint(sa[r]) & ~127u) | idx); }
        sort16_desc(T);
        if (kt == 0) {
#pragma unroll
            for (int i = 0; i < 16; ++i) L[i] = T[i];
        } else top16_merge(L, T);
    }
    float P[16];
#pragma unroll
    for (int i = 0; i < 16; ++i) P[i] = __shfl_xor(L[i], 32);
    top16_merge(L, P);
}
__device__ __forceinline__ void peer_select32(int hd, int n0, int lane, const bf16* qpeer, const LAS unsigned char* kl1, const LAS unsigned char* kl2, unsigned char* wsb, LAS unsigned* ldsw) {
    asm volatile("" : "+v"(lane));
    const int c = lane & 31, hf = lane >> 5, n = n0 + c;
    const bf16* qrow = qpeer + (size_t)n * 2048 + hd * 256 + 8 * hf;
    float A[16], B[16];
    peer_top16(qrow, kl1 + c * PK_KS + 16 * hf, hf, A);
    peer_top16(qrow + 128, kl2 + c * PK_KS + 16 * hf, hf, B);
#define PKV(x) __uint_as_float(__float_as_uint(x) & ~127u)
#define PKI(x) ((int)(__float_as_uint(x) & 127u))
    float W[16];
    { float C0[16], C1[16], C2[16], E0 = 0.f, E1 = 0.f; unsigned id = 0;
#pragma unroll
      for (int a = 0; a < 16; ++a)
#pragma unroll
        for (int b = 0; b < 16; ++b) if ((a + 1) * (b + 1) <= 16) { const float pk = __uint_as_float((__float_as_uint(PKV(A[a]) + PKV(B[b])) & ~63u) | id);
            if (id < 16) C0[id] = pk; else if (id < 32) C1[id - 16] = pk; else if (id < 48) C2[id - 32] = pk; else if (id == 48) E0 = pk; else E1 = pk;
            ++id; }
      sort16_desc(C0); sort16_desc(C1); sort16_desc(C2);
      top16_merge(C0, C1); top16_merge(C0, C2);
#pragma unroll
      for (int i = 0; i < 16; ++i) W[i] = C0[i];
      ins16(W, E0); ins16(W, E1); }
    const float thr = W[15], mx = W[0];
    int cnt = 0; float ssum = 0.f;
    LAS int* le = (LAS int*)ldsw + c * 16; LAS float* lg = (LAS float*)ldsw + 512 + c * 16;
    { unsigned id = 0;
#pragma unroll
      for (int a = 0; a < 16; ++a)
#pragma unroll
        for (int b = 0; b < 16; ++b) if ((a + 1) * (b + 1) <= 16) {
            const float cv = PKV(A[a]) + PKV(B[b]); const float pk = __uint_as_float((__float_as_uint(cv) & ~63u) | id); ++id;
            if (pk >= thr) { const float e = __expf(cv - mx); if (hf == 0) { le[cnt] = PKI(A[a]) * 128 + PKI(B[b]); lg[cnt] = e; } ssum += e; ++cnt; }
        } }
    LDS_WAIT();
    asm volatile("" : "+s"(wsb));
    int* sel_e = (int*)(wsb + WS_SEL); float* sel_g = (float*)(wsb + WS_SEL + 8 * MiB); float* sel_s = (float*)(wsb + WS_SELS);
    { int lane3 = lane; asm volatile("" : "+v"(lane3)); const int t = lane3 >> 1, part = lane3 & 1;
      const v4u e0 = *(const LAS v4u*)((LAS int*)ldsw + t * 16 + 8 * part), e1 = *(const LAS v4u*)((LAS int*)ldsw + t * 16 + 8 * part + 4);
      const v4u g0 = *(const LAS v4u*)((LAS int*)ldsw + 512 + t * 16 + 8 * part), g1 = *(const LAS v4u*)((LAS int*)ldsw + 512 + t * 16 + 8 * part + 4);
      GAS v4u* pe = (GAS v4u*)(sel_e + (size_t)(n0 + t) * 128 + hd * 16 + 8 * part); GAS v4u* pg = (GAS v4u*)(sel_g + (size_t)(n0 + t) * 128 + hd * 16 + 8 * part);
      pe[0] = e0; pe[1] = e1; pg[0] = g0; pg[1] = g1; }
    LDS_WAIT();
    { int lane4 = lane; asm volatile("" : "+v"(lane4)); if ((lane4 >> 5) == 0) ((GAS float*)sel_s)[(size_t)(n0 + (lane4 & 31)) * 8 + hd] = ssum; }
}

__device__ __forceinline__ float dot2bf(unsigned a, unsigned b, float acc) {
    return __builtin_amdgcn_fdot2_f32_bf16(__builtin_bit_cast(bf16v2, a), __builtin_bit_cast(bf16v2, b), acc, false);
}
__device__ __forceinline__ float dot8bf(const v4u a, const v4u b, float acc) {
    const unsigned a0 = a.x, a1 = a.y, a2 = a.z, a3 = a.w, b0 = b.x, b1 = b.y, b2 = b.z, b3 = b.w;
    acc = dot2bf(a0, b0, acc); acc = dot2bf(a1, b1, acc); acc = dot2bf(a2, b2, acc); acc = dot2bf(a3, b3, acc);
    return acc;
}
__device__ __forceinline__ void unpack16(const v4u q, float (&f)[16]) {
    const unsigned d0 = q.x, d1 = q.y, d2 = q.z, d3 = q.w;
    f32x2v t;
    t = __builtin_amdgcn_cvt_pk_f32_fp8((int)d0, false); f[0] = t.x; f[1] = t.y; t = __builtin_amdgcn_cvt_pk_f32_fp8((int)d0, true); f[2] = t.x; f[3] = t.y;
    t = __builtin_amdgcn_cvt_pk_f32_fp8((int)d1, false); f[4] = t.x; f[5] = t.y; t = __builtin_amdgcn_cvt_pk_f32_fp8((int)d1, true); f[6] = t.x; f[7] = t.y;
    t = __builtin_amdgcn_cvt_pk_f32_fp8((int)d2, false); f[8] = t.x; f[9] = t.y; t = __builtin_amdgcn_cvt_pk_f32_fp8((int)d2, true); f[10] = t.x; f[11] = t.y;
    t = __builtin_amdgcn_cvt_pk_f32_fp8((int)d3, false); f[12] = t.x; f[13] = t.y; t = __builtin_amdgcn_cvt_pk_f32_fp8((int)d3, true); f[14] = t.x; f[15] = t.y;
}
struct SliceSched { int mode, xcc, rank, nloc; };
__device__ __forceinline__ SliceSched slice_sched_init(const Ctx& c, unsigned* ctl, const XcdBarrier& bar, int use) {
    LAS int* sh = (LAS int*)(c.lds + 1024);
    if (c.tid == 0) {
        int ok = 1; unsigned tot = 0;
        for (int j = 0; j < 16; ++j) { const unsigned n = xb_ld(&bar.bar[XB_XCNT(j)]); tot += n; if ((j < 8) != (n > 0u)) ok = 0; }
        if (tot != (unsigned)c.G) ok = 0;
        const int xcc = (int)xb_xcc_id();
        int rank = 0, nloc = 1;
        if (ok) { nloc = (int)xb_ld(&bar.bar[XB_XCNT(xcc)]); rank = (int)xb_add(&ctl[CW_RANK + (use * 16 + xcc) * 64], 1u); if (rank >= nloc) ok = 0; }
        sh[0] = ok; sh[1] = xcc; sh[2] = rank; sh[3] = nloc;
    }
    __syncthreads();
    SliceSched S; S.mode = sh[0]; S.xcc = sh[1]; S.rank = sh[2]; S.nloc = sh[3];
    __syncthreads();
    return S;
}
__device__ __forceinline__ bool slice_item(const SliceSched& S, const Ctx& c, int i, int& slice, int& tb) {
    if (S.mode) { const int it = S.rank + i * S.nloc; if (it >= 512) return false; slice = S.xcc + 8 * (it >> 8); tb = it & 255; return true; }
    const int it = (int)blockIdx.x + i * c.G; if (it >= 4096) return false; slice = it >> 8; tb = it & 255; return true;
}
__device__ __forceinline__ void unpack16p(const v4u q, f32x2v (&f)[8]) {
    const unsigned d0 = q.x, d1 = q.y, d2 = q.z, d3 = q.w;
    f[0] = __builtin_amdgcn_cvt_pk_f32_fp8((int)d0, false); f[1] = __builtin_amdgcn_cvt_pk_f32_fp8((int)d0, true);
    f[2] = __builtin_amdgcn_cvt_pk_f32_fp8((int)d1, false); f[3] = __builtin_amdgcn_cvt_pk_f32_fp8((int)d1, true);
    f[4] = __builtin_amdgcn_cvt_pk_f32_fp8((int)d2, false); f[5] = __builtin_amdgcn_cvt_pk_f32_fp8((int)d2, true);
    f[6] = __builtin_amdgcn_cvt_pk_f32_fp8((int)d3, false); f[7] = __builtin_amdgcn_cvt_pk_f32_fp8((int)d3, true);
}
__device__ __forceinline__ void sddmm_load(const unsigned char* ubase, const LAS unsigned* ids16, v4u (&q)[16]) {
    int id[16];
#pragma unroll
    for (int i = 0; i < 4; ++i) { const v4u v = *(const LAS v4u*)(ids16 + 4 * i); id[4 * i] = (int)v.x; id[4 * i + 1] = (int)v.y; id[4 * i + 2] = (int)v.z; id[4 * i + 3] = (int)v.w; }
#pragma unroll
    for (int it = 0; it < 16; ++it) q[it] = *(const GAS v4u*)(ubase + (unsigned)id[it] * 128u);
}
__device__ __forceinline__ void sddmm_token(const v4u (&qc)[16], const v4u hv, const float hs, int lane, unsigned* dst) {
    const int hq[4] = {(int)hv.x, (int)hv.y, (int)hv.z, (int)hv.w};
    float p[16];
#pragma unroll
    for (int it = 0; it < 16; ++it) { int a = __builtin_amdgcn_sdot4((int)qc[it].x, hq[0], 0, false); a = __builtin_amdgcn_sdot4((int)qc[it].y, hq[1], a, false);
        a = __builtin_amdgcn_sdot4((int)qc[it].z, hq[2], a, false); a = __builtin_amdgcn_sdot4((int)qc[it].w, hq[3], a, false);
        p[it] = (float)a * hs; }
#pragma unroll
    for (int i = 0; i < 8; ++i) { const bool up = (lane & 4) != 0; const float snd = up ? p[i] : p[i + 8], kp = up ? p[i + 8] : p[i]; p[i] = kp + __shfl_xor(snd, 4); }
#pragma unroll
    for (int i = 0; i < 4; ++i) { const bool up = (lane & 2) != 0; const float snd = up ? p[i] : p[i + 4], kp = up ? p[i + 4] : p[i]; p[i] = kp + __shfl_xor(snd, 2); }
#pragma unroll
    for (int i = 0; i < 2; ++i) { const bool up = (lane & 1) != 0; const float snd = up ? p[i] : p[i + 2], kp = up ? p[i + 2] : p[i]; p[i] = kp + __shfl_xor(snd, 1); }
    *(GAS unsigned*)dst = pk2c(p[0], p[1]);
}
__device__ __forceinline__ void peer_sddmm_wave(int t0, int s, int lane, const unsigned char* H8, const float* SA, const unsigned char* UQ, const int* sel_e, float* part, LAS unsigned* ldsw) {
    const int cg = lane & 7, sg = lane >> 3;
#pragma unroll
    for (int j = 0; j < 4; ++j) *(LAS v4u*)(ldsw + 4 * (lane + 64 * j)) = *(const GAS v4u*)(sel_e + (size_t)t0 * 128 + 4 * (lane + 64 * j));
    LDS_WAIT();
    const unsigned char* ubase = UQ + (size_t)s * U8_SLICE + cg * 16;
    const LAS unsigned* idl = ldsw + sg * 16;
    const unsigned char* hbase = H8 + (size_t)t0 * 2048 + s * 128 + cg * 16;
    unsigned* pbase = (unsigned*)part + ((size_t)t0 * 16 + s) * 64 + lane;
    v4u qa[16], qb[16];
    v4u ha = *(const GAS v4u*)(hbase), hb; float sa = ((const GAS float*)SA)[t0], sb;
    sddmm_load(ubase, idl, qa);
#pragma unroll
    for (int k = 0; k < 6; k += 2) {
        hb = *(const GAS v4u*)(hbase + (size_t)(k + 1) * 2048); sb = ((const GAS float*)SA)[t0 + k + 1];
        sddmm_load(ubase, idl + (k + 1) * 128, qb);
        sddmm_token(qa, ha, sa, lane, pbase + (size_t)k * 1024);
        ha = *(const GAS v4u*)(hbase + (size_t)(k + 2) * 2048); sa = ((const GAS float*)SA)[t0 + k + 2];
        sddmm_load(ubase, idl + (k + 2) * 128, qa);
        sddmm_token(qb, hb, sb, lane, pbase + (size_t)(k + 1) * 1024);
    }
    hb = *(const GAS v4u*)(hbase + (size_t)7 * 2048); sb = ((const GAS float*)SA)[t0 + 7];
    sddmm_load(ubase, idl + 7 * 128, qb);
    sddmm_token(qa, ha, sa, lane, pbase + (size_t)6 * 1024);
    sddmm_token(qb, hb, sb, lane, pbase + (size_t)7 * 1024);
    LDS_WAIT();
}
__device__ __forceinline__ void peer_coef_tokens4(int t0, int ts, int lane, const float* part, const int* sel_e, float* sel_g, const float* sel_s, const float* US, const float* VS) {
    unsigned pv[4][16]; v2u e[4]; f32x2v g[4]; float dn[4];
#pragma unroll
    for (int i = 0; i < 4; ++i) { const int t = t0 + i * ts;
#pragma unroll
        for (int s = 0; s < 16; ++s) pv[i][s] = ((const GAS unsigned*)part)[((size_t)t * 16 + s) * 64 + lane];
        e[i] = *(const GAS v2u*)(sel_e + (size_t)t * 128 + 2 * lane); g[i] = *(const GAS f32x2v*)(sel_g + (size_t)t * 128 + 2 * lane); dn[i] = ((const GAS float*)sel_s)[(size_t)t * 8 + (lane >> 3)]; }
    float ux[4], uy[4], vx[4], vy[4];
#pragma unroll
    for (int i = 0; i < 4; ++i) { ux[i] = ((const GAS float*)US)[e[i].x]; uy[i] = ((const GAS float*)US)[e[i].y]; vx[i] = ((const GAS float*)VS)[e[i].x]; vy[i] = ((const GAS float*)VS)[e[i].y]; }
#pragma unroll
    for (int i = 0; i < 4; ++i) { const int t = t0 + i * ts; float a0 = 0.f, a1 = 0.f;
#pragma unroll
        for (int s = 0; s < 16; ++s) { a0 += bflo(pv[i][s]); a1 += bfhi(pv[i][s]); }
        const float inv = 1.0f / dn[i];
        const float ox = g[i].x * inv * gelu_exact(a0 * ux[i]) * vx[i], oy = g[i].y * inv * gelu_exact(a1 * uy[i]) * vy[i];
        const h2_t ha = {(_Float16)ox, (_Float16)ox}, hb = {(_Float16)oy, (_Float16)oy};
        *(GAS v2u*)(sel_g + (size_t)t * 128 + 2 * lane) = (v2u){__builtin_bit_cast(unsigned, ha), __builtin_bit_cast(unsigned, hb)}; }
}
__device__ __forceinline__ bool slice_item8(const SliceSched& S, const Ctx& c, int i, int& slice, int& tb) {
    if (S.mode) { const int it = S.rank + i * S.nloc; if (it >= 256) return false; slice = S.xcc; tb = it; return true; }
    const int it = (int)blockIdx.x + i * c.G; if (it >= 2048) return false; slice = it >> 8; tb = it & 255; return true;
}
__device__ __forceinline__ __amdgpu_buffer_rsrc_t slice_rsrc(const unsigned char* base, size_t slice_off, int bytes) {
    const unsigned long long a_ = (unsigned long long)base + slice_off;
    const unsigned long long u_ = ((unsigned long long)(unsigned)__builtin_amdgcn_readfirstlane((int)(a_ >> 32)) << 32) | (unsigned)__builtin_amdgcn_readfirstlane((int)a_);
    return __builtin_amdgcn_make_buffer_rsrc((void*)u_, (short)0, bytes, 0x00020000);
}
template <int MODE = 0>
__device__ __forceinline__ void spmm6_load(__amdgpu_buffer_rsrc_t rs, unsigned cgo, const LAS unsigned* ids8, v4u (&qa)[8], v2u (&qb)[8]) {
    const v4u i0 = *(const LAS v4u*)(ids8), i1 = *(const LAS v4u*)(ids8 + 4);
    const unsigned id[8] = {i0.x, i0.y, i0.z, i0.w, i1.x, i1.y, i1.z, i1.w};
    if constexpr (MODE == 2) {
#pragma unroll
        for (int it = 0; it < 8; ++it) { qa[it] = (v4u){id[it], id[it] + 1u, id[it] + 2u, id[it] + 3u}; qb[it] = (v2u){id[it] + 4u, id[it] + 5u}; }
        return; }
#pragma unroll
    for (int it = 0; it < 8; ++it) { const int o = (int)(id[it] + cgo);
        qa[it] = __builtin_bit_cast(v4u, __builtin_amdgcn_raw_buffer_load_b128(rs, o, 0, 0)); qb[it] = __builtin_bit_cast(v2u, __builtin_amdgcn_raw_buffer_load_b64(rs, o + 16, 0, 0)); }
}
template <int MODE = 0>
__device__ __forceinline__ void spmm6_fma(const v4u (&qa)[8], const v2u (&qb)[8], const LAS unsigned* cf8, h2_t (&y)[16]) {
    const v4u c0 = *(const LAS v4u*)(cf8), c1 = *(const LAS v4u*)(cf8 + 4);
    const unsigned cf[8] = {c0.x, c0.y, c0.z, c0.w, c1.x, c1.y, c1.z, c1.w};
    if constexpr (MODE == 1) {
#pragma unroll
        for (int it = 0; it < 8; ++it) { const unsigned x = (qa[it].x ^ qa[it].y) ^ (qa[it].z ^ qa[it].w) ^ (qb[it].x ^ qb[it].y) ^ cf[it]; y[it] = __builtin_bit_cast(h2_t, __builtin_bit_cast(unsigned, y[it]) ^ x); }
        return; }
    v32h_t f = __builtin_amdgcn_cvt_scalef32_pk32_f16_fp6((v6u){qa[0].x, qa[0].y, qa[0].z, qa[0].w, qb[0].x, qb[0].y}, 1.0f);
#pragma unroll
    for (int it = 0; it < 8; ++it) { v32h_t fn = f;
        if (it < 7) { fn = __builtin_amdgcn_cvt_scalef32_pk32_f16_fp6((v6u){qa[it + 1].x, qa[it + 1].y, qa[it + 1].z, qa[it + 1].w, qb[it + 1].x, qb[it + 1].y}, 1.0f); __builtin_amdgcn_sched_barrier(0); }
        const h2_t c2 = __builtin_bit_cast(h2_t, cf[it]);
#pragma unroll
        for (int j = 0; j < 16; ++j) { const h2_t v = {f[2 * j], f[2 * j + 1]}; y[j] = __builtin_elementwise_fma(v, c2, y[j]); }
        __builtin_amdgcn_sched_barrier(0);
        f = fn; }
}
template <int MODE = 0>
__device__ __forceinline__ void peer_spmm6_wave(int t0, int s, int lane, const unsigned char* V6, const int* sel_e, const float* coef, const bf16* x1, void* xout, int out_f32, LAS unsigned* ldsw) {
    const int cg = lane & 7, sg = lane >> 3;
#pragma unroll
    for (int j = 0; j < 4; ++j) { const v4u e4 = *(const GAS v4u*)(sel_e + (size_t)t0 * 128 + 4 * (lane + 64 * j));
        *(LAS v4u*)(ldsw + 4 * (lane + 64 * j)) = (v4u){e4.x * 192u, e4.y * 192u, e4.z * 192u, e4.w * 192u};
        *(LAS v4u*)(ldsw + 1024 + 4 * (lane + 64 * j)) = *(const GAS v4u*)(coef + (size_t)t0 * 128 + 4 * (lane + 64 * j)); }
    LDS_WAIT();
    const __amdgpu_buffer_rsrc_t vbase = slice_rsrc(V6, (size_t)__builtin_amdgcn_readfirstlane(s) * V6_SLICE, (int)V6_SLICE); const unsigned cgo = (unsigned)cg * 24u;
    const LAS unsigned* idl = ldsw + sg * 16; const LAS unsigned* cfl = ldsw + 1024 + sg * 16;
    v4u qa0[8], qa1[8]; v2u qb0[8], qb1[8];
    spmm6_load<MODE>(vbase, cgo, idl, qa0, qb0);
    const size_t xoff = (size_t)t0 * 2048 + s * 256 + cg * 32 + 4 * sg;
    v2u xn = *(const GAS v2u*)(x1 + xoff);
#pragma unroll
    for (int k = 0; k < 8; ++k) {
        const v2u xv = xn;
        h2_t y[16];
#pragma unroll
        for (int j = 0; j < 16; ++j) y[j] = (h2_t){(_Float16)0.f, (_Float16)0.f};
        spmm6_load<MODE>(vbase, cgo, idl + k * 128 + 8, qa1, qb1);
        if (k < 7) xn = *(const GAS v2u*)(x1 + xoff + (size_t)(k + 1) * 2048);
        spmm6_fma<MODE>(qa0, qb0, cfl + k * 128, y);
        if (k < 7) spmm6_load<MODE>(vbase, cgo, idl + (k + 1) * 128, qa0, qb0);
        spmm6_fma<MODE>(qa1, qb1, cfl + k * 128 + 8, y);
        unsigned u[16];
#pragma unroll
        for (int j = 0; j < 16; ++j) u[j] = __builtin_bit_cast(unsigned, y[j]);
#pragma unroll
        for (int i = 0; i < 8; ++i) { const auto r = __builtin_amdgcn_permlane32_swap(u[i], u[i + 8], false, false); u[i] = __builtin_bit_cast(unsigned, __builtin_bit_cast(h2_t, (unsigned)r[0]) + __builtin_bit_cast(h2_t, (unsigned)r[1])); }
#pragma unroll
        for (int i = 0; i < 4; ++i) { const auto r = __builtin_amdgcn_permlane16_swap(u[i], u[i + 4], false, false); u[i] = __builtin_bit_cast(unsigned, __builtin_bit_cast(h2_t, (unsigned)r[0]) + __builtin_bit_cast(h2_t, (unsigned)r[1])); }
#pragma unroll
        for (int i = 0; i < 2; ++i) { const bool up = (lane & 8) != 0; const unsigned snd = up ? u[i] : u[i + 2], kp = up ? u[i + 2] : u[i]; u[i] = __builtin_bit_cast(unsigned, __builtin_bit_cast(h2_t, kp) + __builtin_bit_cast(h2_t, (unsigned)__shfl_xor((int)snd, 8))); }
        const h2_t r0 = __builtin_bit_cast(h2_t, u[0]), r1 = __builtin_bit_cast(h2_t, u[1]);
        f32x4 o; o.x = bflo(xv.x) + (float)r0[0]; o.y = bfhi(xv.x) + (float)r0[1]; o.z = bflo(xv.y) + (float)r1[0]; o.w = bfhi(xv.y) + (float)r1[1];
        if (out_f32) *(GAS f32x4*)((float*)xout + xoff + (size_t)k * 2048) = o;
        else *(GAS v2u*)((bf16*)xout + xoff + (size_t)k * 2048) = (v2u){pk2c(o.x, o.y), pk2c(o.z, o.w)};
    }
    LDS_WAIT();
}

struct Args { const float* in[21]; float* out; unsigned char* ws; int lo, hi, li, pad; };
__global__ void __launch_bounds__(512, 2) mk_fwd(Args args) {
    extern __shared__ __attribute__((aligned(16))) unsigned char lds_raw[];
    Ctx c; c.lds = (LAS unsigned char*)lds_raw; c.tid = threadIdx.x; c.lane = c.tid & 63; c.wave = __builtin_amdgcn_readfirstlane(c.tid >> 6);
    c.G = gridDim.x; c.gw = blockIdx.x * 8 + c.wave; c.NGW = c.G * 8;
    volatile LAS unsigned* MISC = (volatile LAS unsigned*)(c.lds + MISC_OFF);
    if (c.tid < 32) MISC[c.tid] = 0u;
    __syncthreads();
    unsigned char* ws = args.ws;
    const int lo = args.lo, hi = args.hi;
    XcdBarrier bar; bar.w0 = 0; bar.bar = (unsigned*)(ws + WS_CTL) + CW_BAR + args.li * XCD_BAR_WORDS; bar.x = 0; bar.st = nullptr;
    if (hi - lo > 1) bar = xcd_barrier_post((unsigned*)(ws + WS_CTL) + CW_BAR + args.li * XCD_BAR_WORDS, MISC + 8);
#ifndef ATTN_REPS
#define ATTN_REPS 1
#endif
#ifndef PHMASK
#define PHMASK 0x1fff
#endif
#ifndef REP_PH
#define REP_PH (-1)
#endif
    int rep2 = 2; asm volatile("" : "+s"(rep2));
#define RLOOP(k, cond) for (int rp_ = 0; rp_ < ((((k) == REP_PH) && (cond)) ? rep2 : 1); ++rp_)
#define RSYNC do { if (rp_) xcd_barrier(bar); } while (0)
#define IN(k) (((PHMASK >> ((k) % NPH)) & 1) && lo <= (k) && (k) < hi)
#define SEAM(k) do { if (IN(k) && IN((k) + 1)) xcd_barrier(bar); } while (0)
#define PH_BEGIN unsigned char* w = ws; float* outp = args.out; Ctx cc = c; int zi = 0; cc.lane = xb_lane_id(); cc.tid = cc.wave * 64 + cc.lane; \
    asm volatile("" : "+s"(w), "+s"(outp), "+s"(zi), "+v"(cc.tid), "+v"(cc.lane)); (void)w; (void)outp;
#define INP(k) (args.in[(k) + zi])
#define WSP(T, off) ((T*)(w + (off)))
    for (int l = 0; l < 2; ++l) {
        const int pb = l * NPH;
        if (IN(pb + 0)) { PH_BEGIN
            P0Args a; a.w_in = INP(2) + (size_t)l * DM * INW; a.w_br_sb = INP(11) + (size_t)l * BW * DM; a.w_br_hg = INP(12) + (size_t)l * BW * DM; a.w_br_conv = INP(13) + (size_t)l * BW * DM;
            a.w_o = INP(14) + (size_t)l * DM * DM; a.w_q = INP(16) + (size_t)l * DM * DM; a.u = INP(19) + (size_t)l * 16384 * 2048; a.v = INP(20) + (size_t)l * 16384 * 2048; a.lbp = INP(5);
            a.WinT = WSP(bf16, WS_WIN); a.WbrT = WSP(bf16, WS_WBR); a.WoT = WSP(bf16, WS_WO); a.WqT = WSP(bf16, WS_WQ); a.U = WSP(unsigned char, WS_U); a.V = WSP(unsigned char, WS_V); a.US = WSP(float, WS_US); a.VS = WSP(float, WS_VS); a.LB = WSP(float, WS_LB); a.layer = l; a.k1 = INP(17) + (size_t)l * 8 * 16384; a.k2 = INP(18) + (size_t)l * 8 * 16384; a.KB = WSP(bf16, WS_KEYS);
#ifndef REP_MODE0
#define REP_MODE0 15
#endif
            RLOOP(0, true) { RSYNC;
            int pm_ = 15; if (REP_PH == 0) { pm_ = rp_ ? REP_MODE0 : 15; asm volatile("" : "+s"(pm_)); }
            p0_convert(cc, a, pm_);
            if (pm_ & 8) { if (l == 0) rms_phase_i8(cc, INP(0), INP(1) + (size_t)l * DM, WSP(unsigned char, WS_H), WSP(float, WS_SA));
                           else rms_phase_i8b(cc, WSP(const bf16, WS_X2), INP(1) + (size_t)l * DM, WSP(unsigned char, WS_H), WSP(float, WS_SA)); } }
        }
        SEAM(pb + 0);
        if (IN(pb + 1)) { PH_BEGIN
            RLOOP(1, true) { RSYNC;
            pg8::Gemm g{WSP(bf16, WS_H), WSP(bf16, WS_WIN), NTOK, INW, DM}; pg8::StaticOrder S; S.init(NTOK, INW, cc.G, (int)blockIdx.x);
            EpiIn E{WSP(bf16, WS_SEG), WSP(bf16, WS_GATE), WSP(float, WS_LB), WSP(float, WS_SA)};
            pg8::gemm_phase<EpiIn, pg8::StaticOrder, true, true, true>(cc.lds, g, S, E, cc.wave); }
        }
        SEAM(pb + 1);
        if (IN(pb + 2)) { PH_BEGIN
            bf16* SEG = WSP(bf16, WS_SEG);
#ifndef REP_MODE2
#define REP_MODE2 7
#endif
            RLOOP(2, true) { RSYNC;
            int pm_ = 7; if (REP_PH == 2) { pm_ = rp_ ? REP_MODE2 : 7; asm volatile("" : "+s"(pm_)); }
            if (pm_ & 1)
            conv_phase(cc, SEG + 7 * SEGSZ, INP(7) + (size_t)l * 31 * 1024, INP(8) + (size_t)l * 1024, INP(9) + (size_t)l * 1024, INP(10) + (size_t)l * 1024, WSP(bf16, WS_CONV));
            if (pm_ & 2)
            for (int ci = blockIdx.x, par = 0; ci < 2048; ci += cc.G, par ^= 1) hgA_chunk(cc, ci, ci + cc.G, par, par == 0 && ci == (int)blockIdx.x, SEG + 4 * SEGSZ, SEG + 5 * SEGSZ, WSP(bf16, WS_ST), WSP(float, WS_DEC));
            if (!rp_)
            for (int r = cc.gw; r < 2 * (NTOK / 4); r += cc.NGW) {
                if (r < NTOK / 4) qknorm_rows4(SEG + (size_t)r * 4 * 1024, 1024, INP(3) + (size_t)l * 128, 0.08838834764831845f * 1.4426950408889634f, cc.lane);
                else qknorm_rows4(SEG + SEGSZ + (size_t)(r - NTOK / 4) * 4 * 1024, 1024, INP(4) + (size_t)l * 128, 1.0f, cc.lane);
            }
            LAS unsigned short* scr = (LAS unsigned short*)(cc.lds + 4096 + cc.wave * 8192);
            if (pm_ & 4)
            for (int it = cc.gw; it < 8192; it += cc.NGW) vt_item(it, cc.lane, SEG + 2 * SEGSZ, WSP(bf16, WS_MERGED), scr); }
        }
        SEAM(pb + 2);
        if (IN(pb + 3)) { PH_BEGIN
            bf16* SEG = WSP(bf16, WS_SEG);
            RLOOP(3, true) { RSYNC;
            if (!rp_) hgB(cc, WSP(bf16, WS_ST), WSP(float, WS_DEC));
            for (int p = blockIdx.x; p < 256; p += cc.G) { const int bh = (p & 7) * 4 + (p >> 6), j = (p >> 3) & 7;
                if (cc.wave >= 4) {
#pragma unroll 1
                    for (int u = 0; u < 2; ++u) attn_unit<true>(cc, bh, u ? j : 15 - j, SEG, SEG + SEGSZ, WSP(bf16, WS_MERGED), SEG + 2 * SEGSZ);
                } else {
#pragma unroll 1
                    for (int u = 0; u < 2; ++u) attn_unit<false>(cc, bh, u ? j : 15 - j, SEG, SEG + SEGSZ, WSP(bf16, WS_MERGED), SEG + 2 * SEGSZ);
                } } }
        }
        SEAM(pb + 3);
        if (IN(pb + 4)) { PH_BEGIN
            bf16* SEG = WSP(bf16, WS_SEG);
            RLOOP(4, true) { RSYNC;
            for (int ci = blockIdx.x, par = 0; ci < 2048; ci += cc.G, par ^= 1) hgC_chunk(cc, ci, ci + cc.G, par, par == 0 && ci == (int)blockIdx.x, SEG + 3 * SEGSZ, SEG + 4 * SEGSZ, SEG + 5 * SEGSZ, SEG + 6 * SEGSZ, WSP(bf16, WS_ST), INP(6) + (size_t)l * 128, WSP(bf16, WS_HGR)); }
        }
        SEAM(pb + 4);
        if (IN(pb + 5)) { PH_BEGIN
            RLOOP(5, true) { RSYNC;
            pg8::StaticOrder S; S.init(NTOK, DM, cc.G, (int)blockIdx.x);
            { pg8::Gemm g{WSP(bf16, WS_SEG) + 2 * SEGSZ, WSP(bf16, WS_WBR), NTOK, DM, BW}; EpiMerge<true> E{WSP(unsigned char, WS_GATE), WSP(bf16, WS_MERGED)}; pg8::gemm_phase<EpiMerge<true>, pg8::StaticOrder, true, true>(cc.lds, g, S, E, cc.wave); }
            { pg8::Gemm g{WSP(bf16, WS_HGR), WSP(bf16, WS_WBR) + (size_t)DM * BW, NTOK, DM, BW}; EpiMerge<false> E{WSP(unsigned char, WS_GATE) + (size_t)NTOK * 2048, WSP(bf16, WS_MERGED)}; pg8::gemm_phase<EpiMerge<false>, pg8::StaticOrder, true, true, true>(cc.lds, g, S, E, cc.wave); }
            { pg8::Gemm g{WSP(bf16, WS_CONV), WSP(bf16, WS_WBR) + (size_t)2 * DM * BW, NTOK, DM, BW}; EpiMerge<false> E{WSP(unsigned char, WS_GATE) + (size_t)2 * NTOK * 2048, WSP(bf16, WS_MERGED)}; pg8::gemm_phase<EpiMerge<false>, pg8::StaticOrder, true, true, true>(cc.lds, g, S, E, cc.wave); } }
        }
        SEAM(pb + 5);
        if (IN(pb + 6)) { PH_BEGIN
            RLOOP(6, true) { RSYNC;
            bf16_rows_i8(cc, WSP(bf16, WS_MERGED), WSP(unsigned char, WS_M8), WSP(float, WS_MS));
            xcd_barrier(bar);
            pg8::Gemm g{WSP(bf16, WS_M8), WSP(bf16, WS_WO), NTOK, DM, DM}; pg8::StaticOrder S; S.init(NTOK, DM, cc.G, (int)blockIdx.x);
            EpiResid E{l == 0 ? (const void*)INP(0) : (const void*)WSP(const bf16, WS_X2), WSP(bf16, WS_X1), WSP(float, WS_MS), l};
            pg8::gemm_phase<EpiResid, pg8::StaticOrder, true, true, true>(cc.lds, g, S, E, cc.wave); }
        }
        SEAM(pb + 6);
        if (IN(pb + 7)) { PH_BEGIN RLOOP(7, true) { RSYNC; rms_phase_i8b(cc, WSP(const bf16, WS_X1), INP(15) + (size_t)l * DM, WSP(unsigned char, WS_H), WSP(float, WS_SA)); } }
        SEAM(pb + 7);
        if (IN(pb + 8)) { PH_BEGIN
            RLOOP(8, true) { RSYNC;
            pg8::Gemm g{WSP(bf16, WS_H), WSP(bf16, WS_WQ), NTOK, DM, DM}; pg8::StaticOrder S; S.init(NTOK, DM, cc.G, (int)blockIdx.x);
            EpiStoreBf16 E{WSP(bf16, WS_QPEER), WSP(float, WS_SA)};
            pg8::gemm_phase<EpiStoreBf16, pg8::StaticOrder, true, true, true>(cc.lds, g, S, E, cc.wave); }
        }
        SEAM(pb + 8);
        if (IN(pb + 9)) { PH_BEGIN
            RLOOP(9, true) { RSYNC;
            for (int item = blockIdx.x; item < 512; item += cc.G) { const int hd = item & 7, tg = item >> 3;
                const bf16* KB = WSP(bf16, WS_KEYS); unsigned qo_ = (unsigned)WS_QPEER; asm volatile("" : "+s"(qo_)); const bf16* QP = (const bf16*)(w + qo_);
#pragma unroll
                for (int i = 0; i < 8; ++i) { const int p = cc.tid + 512 * i, li = p >> 11, row = (p >> 4) & 127, c16 = p & 15;
                    *(LAS v4u*)(cc.lds + li * 128 * PK_KS + row * PK_KS + c16 * 16) = *(const GAS v4u*)(KB + (size_t)(li * 8 + hd) * 16384 + row * 128 + c16 * 8); }
                __syncthreads();
                peer_select32(hd, tg * 256 + cc.wave * 32, cc.lane, QP, cc.lds, cc.lds + 128 * PK_KS, w, (LAS unsigned*)(cc.lds + 2 * 128 * PK_KS + cc.wave * 4096));
                __syncthreads(); } }
        }
        SEAM(pb + 9);
        if (IN(pb + 10)) { PH_BEGIN
            const SliceSched SS = slice_sched_init(cc, (unsigned*)(w + WS_CTL), bar, l * 2 + 0);
            RLOOP(10, true) { RSYNC;
            for (int i = 0;; ++i) { int sl, tb; if (!slice_item(SS, cc, i, sl, tb)) break;
                peer_sddmm_wave(tb * 64 + cc.wave * 8, sl, cc.lane, WSP(unsigned char, WS_H), WSP(float, WS_SA), WSP(unsigned char, WS_U), WSP(int, WS_SEL), WSP(float, WS_PART), (LAS unsigned*)(cc.lds + 4096 + cc.wave * 8192)); } }
        }
        SEAM(pb + 10);
        if (IN(pb + 11)) { PH_BEGIN
            for (int n = cc.gw; n < NTOK / 4; n += cc.NGW) peer_coef_tokens4(n, NTOK / 4, cc.lane, WSP(float, WS_PART), WSP(int, WS_SEL), WSP(float, WS_SEL + 8 * MiB), WSP(float, WS_SELS), WSP(float, WS_US), WSP(float, WS_VS));
        }
        SEAM(pb + 11);
        if (IN(pb + 12)) { PH_BEGIN
            void* xo = l == 0 ? (void*)WSP(bf16, WS_X2) : (void*)outp;
            const SliceSched SS = slice_sched_init(cc, (unsigned*)(w + WS_CTL), bar, l * 2 + 1);
            RLOOP(12, l == 0) { RSYNC;
            for (int i = 0;; ++i) { int sl, tb; if (!slice_item8(SS, cc, i, sl, tb)) break;
                peer_spmm6_wave(tb * 64 + cc.wave * 8, sl, cc.lane, WSP(unsigned char, WS_V), WSP(int, WS_SEL), WSP(float, WS_SEL + 8 * MiB), WSP(const bf16, WS_X1), xo, l, (LAS unsigned*)(cc.lds + 4096 + cc.wave * 8192)); } }
        }
        SEAM(pb + 12);
    }
#undef PH_BEGIN
#undef INP
#undef WSP
#undef IN
#undef SEAM
}

#ifndef MK_SPLIT
#define MK_SPLIT 0
#endif
extern "C" void kernel_launch(void* const* d_in, const int* in_sizes, int n_in, void* d_out, int out_size, void* d_ws, size_t ws_size, hipStream_t stream) {
    static int grid = 0;
    if (grid == 0) {
        if (n_in != 21 || out_size != NTOK * DM || ws_size < WS_END) { fprintf(stderr, "kernel_launch: unexpected shapes (n_in %d, out %d, ws %zu < %zu); nothing launched\n", n_in, out_size, ws_size, (size_t)WS_END); grid = -1; return; }
        int dev = 0, cus = 0, per_cu = 0;
        if (hipGetDevice(&dev) != hipSuccess || hipDeviceGetAttribute(&cus, hipDeviceAttributeMultiprocessorCount, dev) != hipSuccess) { grid = -1; return; }
        if (hipFuncSetAttribute((const void*)mk_fwd, hipFuncAttributeMaxDynamicSharedMemorySize, LDS_BYTES) != hipSuccess) { fprintf(stderr, "kernel_launch: hipFuncSetAttribute failed\n"); grid = -1; return; }
        if (hipOccupancyMaxActiveBlocksPerMultiprocessor(&per_cu, (const void*)mk_fwd, 512, LDS_BYTES) != hipSuccess || per_cu < 1) fprintf(stderr, "kernel_launch: occupancy query reports %d\n", per_cu);
        (void)hipGetLastError();
        grid = cus;
    }
    if (grid < 0) return;
    if (hipMemsetAsync((char*)d_ws + WS_CTL, 0, 1 * MiB, stream) != hipSuccess) { fprintf(stderr, "kernel_launch: memset failed\n"); return; }
    Args a{};
    for (int i = 0; i < 21; ++i) a.in[i] = (const float*)d_in[i];
    a.out = (float*)d_out; a.ws = (unsigned char*)d_ws; a.pad = 0;
#if MK_SPLIT
    for (int p = 0; p < NPHASES; ++p) { a.lo = p; a.hi = p + 1; a.li = p; hipLaunchKernelGGL(mk_fwd, dim3(grid), dim3(512), LDS_BYTES, stream, a); }
#else
    a.lo = 0; a.hi = NPHASES; a.li = 0;
    hipLaunchKernelGGL(mk_fwd, dim3(grid), dim3(512), LDS_BYTES, stream, a);
#endif
    const hipError_t le = hipPeekAtLastError();
    if (le != hipSuccess) fprintf(stderr, "kernel_launch: launch failed: %s\n", hipGetErrorName(le));
}
```

```cpp
#include <hip/hip_runtime.h>
#include <cstdio>
#include <cstdint>
namespace pg8 {
#define PG8_LAS __attribute__((address_space(3)))
typedef unsigned short bf16_t;
typedef short bf16x8 __attribute__((ext_vector_type(8)));
typedef float f32x4 __attribute__((ext_vector_type(4)));
typedef unsigned u32x4 __attribute__((ext_vector_type(4)));
constexpr int BM = 256, BK = 64, HALF = 128, HTB = HALF * BK * 2  , STAGE_BYTES = 8 * HTB, NXCD = 8, WGM = 8;

__host__ __device__ __forceinline__ int lds_byte(int r, int c) { const int st = (r >> 4) * 2 + (c >> 5), rr = r & 15, cc = c & 31, ob = rr * 64 + cc * 2; return st * 1024 + (ob ^ (((ob >> 9) & 1) << 5)); }
__host__ __device__ __forceinline__ void stage_rc(int b, int& R, int& C) { const int st = b / 1024, sb = b % 1024, swz = sb ^ (((sb >> 9) & 1) << 5); R = (st >> 1) * 16 + swz / 64; C = (st & 1) * 32 + (swz % 64) / 2; }
__host__ __device__ __forceinline__ int perm32(int rho) { const int n = rho >> 4, i = rho & 15; return 8 * (i >> 2) + 4 * n + (i & 3); }

struct Unit { int pm, pn; };
struct Gemm { const bf16_t* A; const bf16_t* Bt; int M, N, K; };

struct StaticOrder {
    int nM, nN, nwg, G, c;
    __host__ __device__ void init(int M, int N, int G_, int c_) { nM = M / BM; nN = N / BM; nwg = nM * nN; G = G_; c = c_; }
    __host__ __device__ bool next(int i, Unit& u) const {
        const long L = (long)i * G + c; if (L >= nwg) return false;
        int wgid = (int)L; { const int q = nwg / NXCD, r = nwg % NXCD, xcd = wgid % NXCD, off = wgid / NXCD; wgid = (xcd < r ? xcd * (q + 1) : r * (q + 1) + (xcd - r) * q) + off; }
        const int nig = WGM * nN, gid = wgid / nig, fm = gid * WGM, gsz = (nM - fm) < WGM ? (nM - fm) : WGM;
        u.pm = fm + ((wgid % nig) % gsz); u.pn = (wgid % nig) / gsz; return true;
    }
    __device__ __forceinline__ void a_ready(const Unit&) const {}
    __device__ __forceinline__ void done(const Unit&) const {}
};

typedef float f32x2 __attribute__((ext_vector_type(2)));
template <class Epi, class Sched, bool ALIGN_EPI = false, bool SP2 = false, bool I8 = false>
__device__ __forceinline__ void gemm_phase(PG8_LAS unsigned char* lds, const Gemm g, const Sched& S, const Epi& E, int wave_) {
    unsigned z_ = 0u; asm volatile("" : "+s"(z_)); int tid_ = wave_ * 64 + (int)__builtin_amdgcn_mbcnt_hi(~0u, __builtin_amdgcn_mbcnt_lo(~0u, z_)); asm volatile("" : "+v"(tid_));     int K_ = g.K; asm volatile("" : "+s"(K_));
    const int tid = tid_, wid = __builtin_amdgcn_readfirstlane(tid >> 6), lane = tid & 63, wr = wid >> 2, wc = wid & 3, fr = lane & 15, fq = lane >> 4;
    const int K = I8 ? (K_ >> 1) : K_, nt = K / BK;
    unsigned voffA[2], voffB[2];
#pragma unroll
    for (int i = 0; i < 2; ++i) { int R, C; stage_rc(tid * 16 + i * 8192, R, C); const int Rb = Epi::PERM ? ((R & ~31) + perm32(R & 31)) : R;
        voffA[i] = (unsigned)(R * K + C) * 2u; voffB[i] = (unsigned)(Rb * K + C) * 2u; }
    const size_t kstep = (size_t)(BK * 2);
    const size_t hstep = (size_t)HALF * K * 2;
    const size_t tstep = 2 * hstep;
    const unsigned lds_u32_ = (unsigned)(unsigned long long)lds;
    const unsigned ldsw = (unsigned)wid * 1024u;
    const int aoff = lds_byte(wr * 64 + fr, fq * 8), boff = lds_byte(wc * 32 + fr, fq * 8);
#define PG8_SA(b, h) (((b) * 2 + (h)) * HTB)
#define PG8_SB(b, h) ((4 + (b) * 2 + (h)) * HTB)
#define PG8_STAGE(bufoff, gbase, voff) do { _Pragma("unroll") for (int _i = 0; _i < 2; ++_i) { \
        const unsigned m0v_ = lds_u32_ + (unsigned)(bufoff) + ldsw + (unsigned)_i * 8192u; const char* gb_ = (const char*)(gbase); \
        asm volatile("s_mov_b32 m0, %0\n\ts_nop 0\n\tglobal_load_lds_dwordx4 %1, %2" :: "s"(m0v_), "v"((voff)[_i]), "s"(gb_) : "memory", "m0"); } } while (0)
#define PG8_LDA(dst, b, h) do { _Pragma("unroll") for (int m = 0; m < 4; ++m) _Pragma("unroll") for (int k = 0; k < 2; ++k) dst[m][k] = *(const PG8_LAS bf16x8*)(lds + PG8_SA(b, h) + aoff + m * 2048 + k * 1024); } while (0)
#define PG8_LDB(dst, b, h) do { _Pragma("unroll") for (int n = 0; n < 2; ++n) _Pragma("unroll") for (int k = 0; k < 2; ++k) dst[n][k] = *(const PG8_LAS bf16x8*)(lds + PG8_SB(b, h) + boff + n * 2048 + k * 1024); } while (0)
#define PG8_MMA(ai, bj, At, Bt) do { __builtin_amdgcn_s_setprio(1); _Pragma("unroll") for (int m = 0; m < 4; ++m) _Pragma("unroll") for (int n = 0; n < 2; ++n) _Pragma("unroll") for (int k = 0; k < 2; ++k) { \
        if constexpr (I8) { typedef int v4i_t __attribute__((ext_vector_type(4))); \
            acc[ai][bj][m][n] = __builtin_bit_cast(f32x4, __builtin_amdgcn_mfma_i32_16x16x64_i8(__builtin_bit_cast(v4i_t, Bt[n][k]), __builtin_bit_cast(v4i_t, At[m][k]), __builtin_bit_cast(v4i_t, acc[ai][bj][m][n]), 0, 0, 0)); } \
        else acc[ai][bj][m][n] = __builtin_amdgcn_mfma_f32_16x16x32_bf16(Bt[n][k], At[m][k], acc[ai][bj][m][n], 0, 0, 0); } __builtin_amdgcn_s_setprio(0); } while (0)
#define PG8_WAIT_V(n) asm volatile("s_waitcnt vmcnt(" #n ")" ::: "memory")
#define PG8_WAIT_L(n) asm volatile("s_waitcnt lgkmcnt(" #n ")" ::: "memory")
#define PG8_BAR __builtin_amdgcn_s_barrier()
#define PG8_SCHED __builtin_amdgcn_sched_barrier(0)
    Unit cur, nxt; int ui = 0;
    if (!S.next(0, cur)) return;
    cur.pm = __builtin_amdgcn_readfirstlane(cur.pm); cur.pn = __builtin_amdgcn_readfirstlane(cur.pn);
    f32x4 acc[2][2][4][2];
#pragma unroll
    for (int a = 0; a < 2; ++a)
#pragma unroll
        for (int b = 0; b < 2; ++b)
#pragma unroll
            for (int m = 0; m < 4; ++m)
#pragma unroll
                for (int n = 0; n < 2; ++n) acc[a][b][m][n] = (f32x4){0.f, 0.f, 0.f, 0.f};
    bf16x8 At[4][2], B0[2][2], B1[2][2];
    const char* gA_; const char* gB_;
    { const unsigned long long a_ = (unsigned long long)g.A, b_ = (unsigned long long)g.Bt;
      gA_ = (const char*)(((unsigned long long)(unsigned)__builtin_amdgcn_readfirstlane((int)(a_ >> 32)) << 32) | (unsigned)__builtin_amdgcn_readfirstlane((int)a_));
      gB_ = (const char*)(((unsigned long long)(unsigned)__builtin_amdgcn_readfirstlane((int)(b_ >> 32)) << 32) | (unsigned)__builtin_amdgcn_readfirstlane((int)b_)); }
    const char* cA = gA_ + (size_t)cur.pm * tstep; const char* cB = gB_ + (size_t)cur.pn * tstep;
    S.a_ready(cur);
    if constexpr (SP2) {
        PG8_STAGE(PG8_SB(0, 0), cB, voffB); PG8_STAGE(PG8_SB(0, 1), cB + hstep, voffB); PG8_STAGE(PG8_SA(0, 0), cA, voffA); PG8_STAGE(PG8_SA(0, 1), cA + hstep, voffA);
        if (wr == 1) PG8_BAR;
        PG8_WAIT_V(2); PG8_BAR;
        PG8_STAGE(PG8_SB(1, 0), cB + kstep, voffB); PG8_STAGE(PG8_SA(1, 0), cA + kstep, voffA); PG8_STAGE(PG8_SB(1, 1), cB + hstep + kstep, voffB);
        PG8_WAIT_V(6); PG8_BAR;
    } else {
        PG8_STAGE(PG8_SB(0, 0), cB, voffB); PG8_STAGE(PG8_SA(0, 0), cA, voffA); PG8_STAGE(PG8_SB(0, 1), cB + hstep, voffB); PG8_STAGE(PG8_SA(0, 1), cA + hstep, voffA);
        if (wr == 1) PG8_BAR;
        PG8_WAIT_V(4); PG8_BAR;
        PG8_STAGE(PG8_SB(1, 0), cB + kstep, voffB); PG8_STAGE(PG8_SA(1, 0), cA + kstep, voffA); PG8_STAGE(PG8_SB(1, 1), cB + hstep + kstep, voffB);
        PG8_WAIT_V(6); PG8_BAR;
    }
    for (;;) {
        const bool has_next = S.next(ui + 1, nxt);
        nxt.pm = __builtin_amdgcn_readfirstlane(nxt.pm); nxt.pn = __builtin_amdgcn_readfirstlane(nxt.pn);
        const char* nA = has_next ? gA_ + (size_t)nxt.pm * tstep : cA; const char* nB = has_next ? gB_ + (size_t)nxt.pn * tstep : cB;
        for (int t = 0; t < nt; t += 2) {
            const bool last = (t == nt - 2);
            const char* a1 = cA + (size_t)(t + 1) * kstep;
            const char* a2 = last ? nA : cA + (size_t)(t + 2) * kstep; const char* b2 = last ? nB : cB + (size_t)(t + 2) * kstep;
            const char* a3 = a2 + kstep; const char* b3 = b2 + kstep;
            if (last && has_next) S.a_ready(nxt);
            if constexpr (SP2) {
            PG8_LDB(B0, 0, 0); PG8_LDB(B1, 0, 1); PG8_SCHED; PG8_LDA(At, 0, 0); PG8_STAGE(PG8_SA(1, 1), a1 + hstep, voffA);
            PG8_WAIT_V(8); PG8_WAIT_L(0); PG8_BAR; PG8_MMA(0, 0, At, B0); PG8_MMA(0, 1, At, B1); PG8_BAR; PG8_SCHED;
            PG8_LDA(At, 0, 1); PG8_STAGE(PG8_SB(0, 0), b2, voffB); PG8_STAGE(PG8_SB(0, 1), b2 + hstep, voffB); PG8_STAGE(PG8_SA(0, 0), a2, voffA);
            PG8_WAIT_V(8); PG8_WAIT_L(0); PG8_BAR; PG8_MMA(1, 0, At, B0); PG8_MMA(1, 1, At, B1); PG8_BAR; PG8_SCHED;
            PG8_LDB(B0, 1, 0); PG8_LDB(B1, 1, 1); PG8_SCHED; PG8_LDA(At, 1, 0); PG8_STAGE(PG8_SA(0, 1), a2 + hstep, voffA);
            PG8_WAIT_V(8); PG8_WAIT_L(0); PG8_BAR; PG8_MMA(0, 0, At, B0); PG8_MMA(0, 1, At, B1); PG8_BAR; PG8_SCHED;
            PG8_LDA(At, 1, 1); PG8_STAGE(PG8_SB(1, 0), b3, voffB); PG8_STAGE(PG8_SB(1, 1), b3 + hstep, voffB); PG8_STAGE(PG8_SA(1, 0), a3, voffA);
            PG8_WAIT_V(8); PG8_WAIT_L(0); PG8_BAR; PG8_MMA(1, 0, At, B0); PG8_MMA(1, 1, At, B1); PG8_BAR; PG8_SCHED;
            } else {
            PG8_LDB(B0, 0, 0); PG8_SCHED; PG8_LDA(At, 0, 0); PG8_STAGE(PG8_SA(1, 1), a1 + hstep, voffA);
            PG8_WAIT_L(8); PG8_BAR; PG8_WAIT_L(0); PG8_MMA(0, 0, At, B0); PG8_BAR; PG8_SCHED;
            PG8_LDB(B1, 0, 1); PG8_STAGE(PG8_SB(0, 0), b2, voffB);
            PG8_BAR; PG8_WAIT_L(0); PG8_MMA(0, 1, At, B1); PG8_BAR;
            PG8_LDA(At, 0, 1); PG8_STAGE(PG8_SA(0, 0), a2, voffA);
            PG8_BAR; PG8_WAIT_L(0); PG8_MMA(1, 0, At, B0); PG8_BAR; PG8_SCHED;
            PG8_STAGE(PG8_SB(0, 1), b2 + hstep, voffB);
            PG8_WAIT_V(6); PG8_BAR; PG8_MMA(1, 1, At, B1); PG8_BAR;
            PG8_LDB(B0, 1, 0); PG8_SCHED; PG8_LDA(At, 1, 0); PG8_STAGE(PG8_SA(0, 1), a2 + hstep, voffA);
            PG8_WAIT_L(8); PG8_BAR; PG8_WAIT_L(0); PG8_MMA(0, 0, At, B0); PG8_BAR; PG8_SCHED;
            PG8_LDB(B1, 1, 1); PG8_STAGE(PG8_SB(1, 0), b3, voffB);
            PG8_BAR; PG8_WAIT_L(0); PG8_MMA(0, 1, At, B1); PG8_BAR;
            PG8_LDA(At, 1, 1); PG8_STAGE(PG8_SA(1, 0), a3, voffA);
            PG8_BAR; PG8_WAIT_L(0); PG8_MMA(1, 0, At, B0); PG8_BAR; PG8_SCHED;
            PG8_STAGE(PG8_SB(1, 1), b3 + hstep, voffB);
            PG8_WAIT_V(6); PG8_BAR; PG8_MMA(1, 1, At, B1); PG8_BAR;
            }
        }
        if constexpr (ALIGN_EPI) { if (wr == 0) PG8_BAR; }
        if constexpr (I8) {
#pragma unroll
            for (int a = 0; a < 2; ++a)
#pragma unroll
                for (int m = 0; m < 4; ++m) { const float r_ = E.rowscale(cur.pm * BM + wr * 64 + fr + a * HALF + m * 16);
#pragma unroll
                    for (int b = 0; b < 2; ++b)
#pragma unroll
                        for (int n = 0; n < 2; ++n) { typedef int v4i2_t __attribute__((ext_vector_type(4))); const v4i2_t i_ = __builtin_bit_cast(v4i2_t, acc[a][b][m][n]);
                            acc[a][b][m][n] = (f32x4){(float)i_[0] * r_, (float)i_[1] * r_, (float)i_[2] * r_, (float)i_[3] * r_}; } }
        }
        if constexpr (!Epi::AFTER_DRAIN) { E(acc, cur, wr, wc, fr, fq); S.done(cur); }
        if (!has_next) break;
#pragma unroll
        for (int a = 0; a < 2; ++a)
#pragma unroll
            for (int b = 0; b < 2; ++b)
#pragma unroll
                for (int m = 0; m < 4; ++m)
#pragma unroll
                    for (int n = 0; n < 2; ++n) acc[a][b][m][n] = (f32x4){0.f, 0.f, 0.f, 0.f};
        cur = nxt; cA = nA; cB = nB; ++ui;
        if constexpr (ALIGN_EPI) { if (wr == 1) PG8_BAR; }
    }
    PG8_WAIT_V(0);
    if constexpr (!ALIGN_EPI) { if (wr == 0) PG8_BAR; }
    PG8_BAR;
    if constexpr (Epi::AFTER_DRAIN) { E.fused(acc, cur, wr, wc, fr, fq, lds, wid, lane); S.done(cur); }
#undef PG8_SA
#undef PG8_SB
#undef PG8_STAGE
#undef PG8_LDA
#undef PG8_LDB
#undef PG8_MMA
#undef PG8_WAIT_V
#undef PG8_WAIT_L
#undef PG8_BAR
#undef PG8_SCHED
}
}
#define XB_TMO      128
#define XB_XCNT(j)  (256  + 64 * (j))
#define XB_XSUB(j)  (1280 + 64 * (j))
#define XB_XGEN(j)  (2304 + 64 * (j))
#define XB_TOP      3328
#define XB_TOPGEN   3392
#define XCD_BAR_WORDS 3456
#define XB_SPIN_CAP (1u << 24)
#define LAS __attribute__((address_space(3)))

__device__ __forceinline__ unsigned xb_ld(unsigned* p)              { return __hip_atomic_load(p, __ATOMIC_RELAXED, __HIP_MEMORY_SCOPE_AGENT); }
__device__ __forceinline__ unsigned xb_add(unsigned* p, unsigned v) { return __hip_atomic_fetch_add(p, v, __ATOMIC_RELAXED, __HIP_MEMORY_SCOPE_AGENT); }
__device__ __forceinline__ unsigned xb_xcc_id() { return (unsigned)__builtin_amdgcn_s_getreg((3 << 11) | 20) & 0xFu; }
#define XB_SPIN(cond, bar) do { unsigned _sp = 0; while (cond) { __builtin_amdgcn_s_sleep(1); \
    if ((++_sp & 255u) == 0u) { if (xb_ld(&(bar)[XB_TMO])) break; if (_sp > XB_SPIN_CAP) { atomicAdd(&(bar)[XB_TMO], 1u); break; } } } } while (0)

__device__ __forceinline__ int xb_lane_id() { unsigned z = 0u; asm volatile("" : "+s"(z)); return (int)__builtin_amdgcn_mbcnt_hi(~0u, __builtin_amdgcn_mbcnt_lo(~0u, z)); }
struct XcdBarrier {
    unsigned w0;
    unsigned* bar; unsigned x;
    volatile LAS unsigned* st;
};

__device__ __forceinline__ XcdBarrier xcd_barrier_post(unsigned* bar, volatile LAS unsigned* st) {
    XcdBarrier b; b.bar = bar; b.x = xb_xcc_id(); b.st = st; b.w0 = (__builtin_amdgcn_readfirstlane((int)threadIdx.x >> 6) == 0) ? 1u : 0u;
    if (b.w0 && xb_lane_id() == 0) (void)xb_add(&bar[XB_XCNT(b.x)], 1u);
    return b;
}
__device__ __forceinline__ void xcd_barrier_complete(unsigned* bar, unsigned x, unsigned& nloc, unsigned& nx) {
    const unsigned G = gridDim.x * gridDim.y * gridDim.z;
    unsigned sum, cnt, mine, sp = 0u;
    for (;;) {
        sum = 0u; cnt = 0u; mine = 0u;
#pragma unroll
        for (unsigned j = 0; j < 16; ++j) { const unsigned c = xb_ld(&bar[XB_XCNT(j)]); sum += c; cnt += (c > 0u) ? 1u : 0u; mine = (j == x) ? c : mine; }
        if (sum == G) break;
        __builtin_amdgcn_s_sleep(1);
        if ((++sp & 255u) == 0u) { if (xb_ld(&bar[XB_TMO])) break; if (sp > XB_SPIN_CAP) { atomicAdd(&bar[XB_TMO], 1u); break; } }
    }
    nloc = mine > 0u ? mine : 1u; nx = cnt > 0u ? cnt : 1u;
}

__device__ __forceinline__ void xcd_barrier(const XcdBarrier& b) {
    asm volatile("s_waitcnt vmcnt(0)" ::: "memory");
    __syncthreads();
    if (b.w0 && xb_lane_id() == 0) {
        unsigned* bar = b.bar;
        __builtin_amdgcn_s_waitcnt(0);
        unsigned nloc = b.st[0], nx = b.st[1];
        if (nloc == 0u) { xcd_barrier_complete(bar, b.x, nloc, nx); b.st[0] = nloc; b.st[1] = nx; }
        const unsigned old = xb_add(&bar[XB_XSUB(b.x)], 1u);
        const unsigned gen = old / nloc;
        if (old + 1u == (gen + 1u) * nloc) {
            __builtin_amdgcn_fence(__ATOMIC_RELEASE, "agent");
            asm volatile("s_waitcnt vmcnt(0)" ::: "memory");
            const unsigned og = xb_add(&bar[XB_TOP], 1u);
            const unsigned tg = og / nx;
            if (og + 1u == (tg + 1u) * nx) xb_add(&bar[XB_TOPGEN], 1u);
            else XB_SPIN(xb_ld(&bar[XB_TOPGEN]) == tg, bar);
            __builtin_amdgcn_fence(__ATOMIC_ACQUIRE, "agent");
            xb_add(&bar[XB_XGEN(b.x)], 1u);
            asm volatile("s_waitcnt vmcnt(0)" ::: "memory");
        } else {
            XB_SPIN(xb_ld(&bar[XB_XGEN(b.x)]) == gen, bar);
            __builtin_amdgcn_fence(__ATOMIC_ACQUIRE, "agent");
            asm volatile("s_waitcnt vmcnt(0)" ::: "memory");
        }
    }
    __syncthreads();
}


#define GAS __attribute__((address_space(1)))
typedef unsigned short bf16;
typedef unsigned v4u __attribute__((ext_vector_type(4)));
typedef unsigned v2u __attribute__((ext_vector_type(2)));
typedef float f32x4 __attribute__((ext_vector_type(4)));
typedef float f32x2v __attribute__((ext_vector_type(2)));
typedef float f32x16 __attribute__((ext_vector_type(16)));
typedef short bf16x8 __attribute__((ext_vector_type(8)));
typedef __bf16 bf16v2 __attribute__((ext_vector_type(2)));
typedef _Float16 h2_t __attribute__((ext_vector_type(2)));
typedef _Float16 v32h_t __attribute__((ext_vector_type(32)));
typedef unsigned v6u __attribute__((ext_vector_type(6)));

constexpr int NTOK = 16384, DM = 2048, SEQ = 4096, INW = 15360, BW = 1024;
constexpr float EPS = 1e-6f;
constexpr float WBR_QS = 768.0f;
constexpr float ACT_QS = 127.0f / 6.0f;
constexpr float WIN_QS = 1024.0f;
constexpr int NPH = 13;
constexpr int NPHASES = 2 * NPH;

constexpr size_t MiB = 1u << 20;
constexpr size_t WS_CTL = 0;
constexpr size_t WS_LB = 1 * MiB;
constexpr size_t WS_SA = 1 * MiB + 192 * 1024;
constexpr size_t WS_US = 1 * MiB + 64 * 1024, WS_VS = 1 * MiB + 128 * 1024;
constexpr size_t WS_WIN = 2 * MiB;
constexpr size_t WS_MS = 1 * MiB + 256 * 1024;
constexpr size_t WS_M8 = 859 * MiB;
constexpr size_t WS_WBR = 62 * MiB;
constexpr size_t WS_WO = 74 * MiB;
constexpr size_t WS_WQ = 82 * MiB;
constexpr size_t WS_U = 91 * MiB;
constexpr size_t WS_V = 155 * MiB;
constexpr size_t WS_H = 219 * MiB;
constexpr size_t WS_SEG = 283 * MiB;
constexpr size_t WS_GATE = 539 * MiB;
constexpr size_t WS_X2 = 731 * MiB;
constexpr size_t WS_X1 = 795 * MiB;
constexpr size_t WS_CONV = 859 * MiB;
constexpr size_t WS_HGR = 891 * MiB;
constexpr size_t WS_MERGED = 923 * MiB;
constexpr size_t WS_SEL = 987 * MiB;
constexpr size_t WS_SELS = 1003 * MiB;
constexpr size_t WS_DEC = 1004 * MiB;
constexpr size_t WS_END = 1005 * MiB;
constexpr size_t WS_ST = WS_H;
constexpr size_t WS_KEYS = 90 * MiB;
constexpr size_t WS_PART = WS_GATE;
constexpr size_t WS_QPEER = WS_SEG;
constexpr size_t SEGSZ = (size_t)NTOK * 1024;
constexpr int CW_BAR = 4096;
constexpr int CW_RANK = 131072;

constexpr int RING_BYTES = 131072, MISC_OFF = RING_BYTES + 320, LDS_BYTES = 147456;

__device__ __forceinline__ unsigned pk2c(float lo, float hi) { f32x2v v = {lo, hi}; bf16v2 b = __builtin_convertvector(v, bf16v2); return __builtin_bit_cast(unsigned, b); }
__device__ __forceinline__ float bflo(unsigned x) { return __uint_as_float(x << 16); }
__device__ __forceinline__ float bfhi(unsigned x) { return __uint_as_float(x & 0xffff0000u); }
__device__ __forceinline__ float sigm(float x) { return __builtin_amdgcn_rcpf(1.0f + __expf(-x)); }
template <int M> __device__ __forceinline__ unsigned xoru(unsigned x) {
    if constexpr (M == 1) return (unsigned)__builtin_amdgcn_update_dpp((int)x, (int)x, 0xB1, 0xF, 0xF, true);
    else if constexpr (M == 2) return (unsigned)__builtin_amdgcn_update_dpp((int)x, (int)x, 0x4E, 0xF, 0xF, true);
    else if constexpr (M == 4) { const int t = __builtin_amdgcn_update_dpp((int)x, (int)x, 0x104, 0xF, 0x5, false);
        return (unsigned)__builtin_amdgcn_update_dpp(t, (int)x, 0x114, 0xF, 0xA, false); }
    else if constexpr (M == 8) return (unsigned)__builtin_amdgcn_update_dpp((int)x, (int)x, 0x128, 0xF, 0xF, true);
    else if constexpr (M == 16) { const auto r = __builtin_amdgcn_permlane16_swap(x, x, false, false); const unsigned l_ = (unsigned)xb_lane_id();     return (l_ & 16u) ? r[0] : r[1]; }
    else { const auto r = __builtin_amdgcn_permlane32_swap(x, x, false, false); const unsigned l_ = (unsigned)xb_lane_id();     return (l_ & 32u) ? r[0] : r[1]; }
}
template <int M> __device__ __forceinline__ float xorf(float x) { return __uint_as_float(xoru<M>(__float_as_uint(x))); }
__device__ __forceinline__ float wave_sum(float v) { v += xorf<1>(v); v += xorf<2>(v); v += xorf<4>(v); v += xorf<8>(v); v += xorf<16>(v); v += xorf<32>(v); return v; }
__device__ __forceinline__ float wave_max(float v) { v = fmaxf(v, xorf<1>(v)); v = fmaxf(v, xorf<2>(v)); v = fmaxf(v, xorf<4>(v)); v = fmaxf(v, xorf<8>(v)); v = fmaxf(v, xorf<16>(v)); v = fmaxf(v, xorf<32>(v)); return v; }
#define LDS_WAIT() asm volatile("s_waitcnt lgkmcnt(0)" ::: "memory")
#define MFMA32(a, b, c) __builtin_amdgcn_mfma_f32_32x32x16_bf16((a), (b), (c), 0, 0, 0)
typedef unsigned v2u_sw __attribute__((ext_vector_type(2)));
__device__ __forceinline__ float xsum32(float a, float b) { const auto r = __builtin_amdgcn_permlane32_swap(__float_as_uint(a), __float_as_uint(b), false, false); return __uint_as_float(r[0]) + __uint_as_float(r[1]); }
__device__ __forceinline__ float xsum16(float a, float b) { const auto r = __builtin_amdgcn_permlane16_swap(__float_as_uint(a), __float_as_uint(b), false, false); return __uint_as_float(r[0]) + __uint_as_float(r[1]); }
__device__ __forceinline__ float xor32f(float x, int hf) { const auto r = __builtin_amdgcn_permlane32_swap(__float_as_uint(x), __float_as_uint(x), false, false); return __uint_as_float(hf ? r[0] : r[1]); }
__device__ __forceinline__ int ridx16(int lane) { return ((lane >> 5) & 1) * 8 + ((lane >> 4) & 1) * 4 + ((lane >> 3) & 1) * 2 + ((lane >> 2) & 1); }
__device__ __forceinline__ void xreduce16(float (&v)[16], int lane) {
#pragma unroll
    for (int i = 0; i < 8; ++i) v[i] = xsum32(v[i], v[i + 8]);
#pragma unroll
    for (int i = 0; i < 4; ++i) v[i] = xsum16(v[i], v[i + 4]);
#pragma unroll
    for (int i = 0; i < 2; ++i) { const bool up = (lane & 8) != 0; const float snd = up ? v[i] : v[i + 2], kp = up ? v[i + 2] : v[i]; v[i] = kp + xorf<8>(snd); }
    { const bool up = (lane & 4) != 0; const float snd = up ? v[0] : v[1], kp = up ? v[1] : v[0]; v[0] = kp + xorf<4>(snd); }
    v[0] += xorf<2>(v[0]); v[0] += xorf<1>(v[0]);
}
__device__ __forceinline__ float gelu_exact(float v) {
    const float av = fabsf(v), t = __builtin_amdgcn_rcpf(av * 0.2316418882f + 1.0f);
    float q = t * 0.5307027145f + (-0.7265760135f); q = q * t + 0.7107068705f; q = q * t + (-0.142248368f); q = q * t + 0.127414796f; q = q * t;
    const float e = __builtin_amdgcn_exp2f((v * v) * (-0.72134752044f));
    const float m = v * (q * e);
    return v < 0.f ? m : v - m;
}

struct Ctx { LAS unsigned char* lds; int tid, lane, wave, G, gw, NGW; };

__device__ __forceinline__ void tr_item(const float* W, int K, int N, bf16* WT, int k0, int n0, int drow0, LAS float* scr, int lane) {
    { const int lr = lane >> 3, lc = (lane & 7) * 4; f32x4 v[8];
#pragma unroll
      for (int j = 0; j < 8; ++j) v[j] = *(const GAS f32x4*)(W + (size_t)(k0 + lr + 8 * j) * N + n0 + lc);
#pragma unroll
      for (int j = 0; j < 8; ++j) { LAS float* d = scr + (lr + 8 * j) * 33 + lc; d[0] = v[j].x; d[1] = v[j].y; d[2] = v[j].z; d[3] = v[j].w; } }
    LDS_WAIT();
    const int c = lane & 7;
#pragma unroll
    for (int j = 0; j < 4; ++j) { const int n = (lane >> 3) + 8 * j; const LAS float* s = scr + (8 * c) * 33 + n;
        v4u o; o.x = pk2c(s[0], s[33]); o.y = pk2c(s[66], s[99]); o.z = pk2c(s[132], s[165]); o.w = pk2c(s[198], s[231]);
        *(GAS v4u*)(WT + (size_t)(drow0 + n) * K + k0 + 8 * c) = o; }
    LDS_WAIT();
}
__device__ __forceinline__ unsigned pack_i8x4c(float a, float b, float c, float d) {
    const int ia = (int)__builtin_rintf(fminf(fmaxf(a, -127.f), 127.f)), ib = (int)__builtin_rintf(fminf(fmaxf(b, -127.f), 127.f)), ic = (int)__builtin_rintf(fminf(fmaxf(c, -127.f), 127.f)), id = (int)__builtin_rintf(fminf(fmaxf(d, -127.f), 127.f));
    return ((unsigned)ia & 255u) | (((unsigned)ib & 255u) << 8) | (((unsigned)ic & 255u) << 16) | ((unsigned)id << 24);
}
__device__ __forceinline__ void tr_item_i8(const float* W, int K, int N, unsigned char* WT, int k0, int n0, int drow0, float scale, LAS float* scr, int lane) {
    { const int lr = lane >> 3, lc = (lane & 7) * 4; f32x4 v[16];
#pragma unroll
      for (int j = 0; j < 16; ++j) v[j] = *(const GAS f32x4*)(W + (size_t)(k0 + lr + 8 * j) * N + n0 + lc);
#pragma unroll
      for (int j = 0; j < 16; ++j) { LAS float* d = scr + (lr + 8 * j) * 32 + (lc ^ ((j & 7) << 2)); const int x = lr & 3; d[x] = v[j].x; d[1 ^ x] = v[j].y; d[2 ^ x] = v[j].z; d[3 ^ x] = v[j].w; } }
    LDS_WAIT();
    const int c = lane & 15;
#pragma unroll
    for (int j = 0; j < 8; ++j) { const int n = (lane >> 4) + 4 * j, q = n ^ ((c & 7) << 2); const LAS float* s = scr + (8 * c) * 32;
        v2u o; o.x = pack_i8x4c(s[q] * scale, s[32 + (q ^ 1)] * scale, s[64 + (q ^ 2)] * scale, s[96 + (q ^ 3)] * scale); o.y = pack_i8x4c(s[128 + q] * scale, s[160 + (q ^ 1)] * scale, s[192 + (q ^ 2)] * scale, s[224 + (q ^ 3)] * scale);
        *(GAS v2u*)(WT + (size_t)(drow0 + n) * K + k0 + 8 * c) = o; }
    LDS_WAIT();
}
__device__ __forceinline__ int win_drow(int n) { if (n < 7168 || n >= 9216) return n; const int r = n - 7168, isb = r >> 10, c = r & 1023; return 7168 + (c >> 7) * 256 + isb * 128 + (c & 127); }
__device__ __forceinline__ void cvt_copy(const Ctx& c, const float* src, bf16* dst, size_t n8) {
    const size_t NT = (size_t)c.G * 512;
    for (size_t i = (size_t)blockIdx.x * 512 + c.tid; i < n8; i += NT) {
        const f32x4 a = ((const GAS f32x4*)src)[2 * i], b = ((const GAS f32x4*)src)[2 * i + 1];
        v4u o; o.x = pk2c(a.x, a.y); o.y = pk2c(a.z, a.w); o.z = pk2c(b.x, b.y); o.w = pk2c(b.z, b.w);
        ((GAS v4u*)dst)[i] = o;
    }
}
__device__ __forceinline__ void rms_row(const float* xr, const float* w, bf16* o, int lane) {
    const GAS f32x4* xp = (const GAS f32x4*)xr + lane; f32x4 v[8]; float s = 0.f;
#pragma unroll
    for (int j = 0; j < 8; ++j) { v[j] = xp[64 * j]; s += (v[j].x * v[j].x + v[j].y * v[j].y) + (v[j].z * v[j].z + v[j].w * v[j].w); }
    const float r = __builtin_amdgcn_rsqf(wave_sum(s) * (1.0f / DM) + EPS);
    const GAS f32x4* wp = (const GAS f32x4*)w + lane; GAS v2u* op = (GAS v2u*)o + lane;
#pragma unroll
    for (int j = 0; j < 8; ++j) { const f32x4 wv = wp[64 * j]; v2u q; q.x = pk2c(v[j].x * r * wv.x, v[j].y * r * wv.y); q.y = pk2c(v[j].z * r * wv.z, v[j].w * r * wv.w); op[64 * j] = q; }
}
__device__ __forceinline__ void rms_row_i8(const float* xr, const float* w, unsigned char* o, float* sa, int lane) {
    const GAS f32x4* xp = (const GAS f32x4*)xr + lane; f32x4 v[8]; float s = 0.f;
#pragma unroll
    for (int j = 0; j < 8; ++j) { v[j] = xp[64 * j]; s += (v[j].x * v[j].x + v[j].y * v[j].y) + (v[j].z * v[j].z + v[j].w * v[j].w); }
    const float r = __builtin_amdgcn_rsqf(wave_sum(s) * (1.0f / DM) + EPS);
    const GAS f32x4* wp = (const GAS f32x4*)w + lane; float m = 0.f;
#pragma unroll
    for (int j = 0; j < 8; ++j) { const f32x4 wv = wp[64 * j]; v[j].x *= r * wv.x; v[j].y *= r * wv.y; v[j].z *= r * wv.z; v[j].w *= r * wv.w;
        m = fmaxf(fmaxf(m, fmaxf(fabsf(v[j].x), fabsf(v[j].y))), fmaxf(fabsf(v[j].z), fabsf(v[j].w))); }
    m = wave_max(m);
    const float inv = m > 0.f ? 127.0f / m : 0.f;
    if (lane == 0) *(GAS float*)sa = m * (1.0f / 127.0f);
#pragma unroll
    for (int j = 0; j < 8; ++j) ((GAS unsigned*)o)[lane + 64 * j] = pack_i8x4c(v[j].x * inv, v[j].y * inv, v[j].z * inv, v[j].w * inv);
}
__device__ __forceinline__ void rms_rows2_i8(const float* xa, const float* xb, const float* w, unsigned char* oa, unsigned char* ob, float* saa, float* sab, int lane) {
    const GAS f32x4* pa = (const GAS f32x4*)xa + lane; const GAS f32x4* pb = (const GAS f32x4*)xb + lane; f32x4 va[8], vb[8]; float s0 = 0.f, s1 = 0.f;
#pragma unroll
    for (int j = 0; j < 8; ++j) { va[j] = pa[64 * j]; vb[j] = pb[64 * j]; }
#pragma unroll
    for (int j = 0; j < 8; ++j) { s0 += (va[j].x * va[j].x + va[j].y * va[j].y) + (va[j].z * va[j].z + va[j].w * va[j].w); s1 += (vb[j].x * vb[j].x + vb[j].y * vb[j].y) + (vb[j].z * vb[j].z + vb[j].w * vb[j].w); }
    s0 = wave_sum(s0); s1 = wave_sum(s1);
    const float r0 = __builtin_amdgcn_rsqf(s0 * (1.0f / DM) + EPS), r1 = __builtin_amdgcn_rsqf(s1 * (1.0f / DM) + EPS);
    const GAS f32x4* wp = (const GAS f32x4*)w + lane; float m0 = 0.f, m1 = 0.f;
#pragma unroll
    for (int j = 0; j < 8; ++j) { const f32x4 wv = wp[64 * j];
        va[j].x *= r0 * wv.x; va[j].y *= r0 * wv.y; va[j].z *= r0 * wv.z; va[j].w *= r0 * wv.w; vb[j].x *= r1 * wv.x; vb[j].y *= r1 * wv.y; vb[j].z *= r1 * wv.z; vb[j].w *= r1 * wv.w;
        m0 = fmaxf(fmaxf(m0, fmaxf(fabsf(va[j].x), fabsf(va[j].y))), fmaxf(fabsf(va[j].z), fabsf(va[j].w))); m1 = fmaxf(fmaxf(m1, fmaxf(fabsf(vb[j].x), fabsf(vb[j].y))), fmaxf(fabsf(vb[j].z), fabsf(vb[j].w))); }
    m0 = wave_max(m0); m1 = wave_max(m1);
    const float i0 = m0 > 0.f ? 127.0f / m0 : 0.f, i1 = m1 > 0.f ? 127.0f / m1 : 0.f;
    if (lane == 0) { *(GAS float*)saa = m0 * (1.0f / 127.0f); *(GAS float*)sab = m1 * (1.0f / 127.0f); }
#pragma unroll
    for (int j = 0; j < 8; ++j) { ((GAS unsigned*)oa)[lane + 64 * j] = pack_i8x4c(va[j].x * i0, va[j].y * i0, va[j].z * i0, va[j].w * i0); ((GAS unsigned*)ob)[lane + 64 * j] = pack_i8x4c(vb[j].x * i1, vb[j].y * i1, vb[j].z * i1, vb[j].w * i1); }
}
__device__ __forceinline__ void rms_rows2_i8b(const bf16* xa, const bf16* xb, const float* w, unsigned char* oa, unsigned char* ob, float* saa, float* sab, int lane) {
    v4u qa[4], qb[4]; float va[4][8], vb[4][8], s0 = 0.f, s1 = 0.f;
#pragma unroll
    for (int j = 0; j < 4; ++j) { qa[j] = *(const GAS v4u*)(xa + 8 * (lane + 64 * j)); qb[j] = *(const GAS v4u*)(xb + 8 * (lane + 64 * j)); }
#pragma unroll
    for (int j = 0; j < 4; ++j) { const unsigned a[4] = {qa[j].x, qa[j].y, qa[j].z, qa[j].w}, b[4] = {qb[j].x, qb[j].y, qb[j].z, qb[j].w};
#pragma unroll
        for (int k = 0; k < 4; ++k) { va[j][2 * k] = bflo(a[k]); va[j][2 * k + 1] = bfhi(a[k]); vb[j][2 * k] = bflo(b[k]); vb[j][2 * k + 1] = bfhi(b[k]); }
#pragma unroll
        for (int k = 0; k < 8; ++k) { s0 += va[j][k] * va[j][k]; s1 += vb[j][k] * vb[j][k]; } }
    s0 = wave_sum(s0); s1 = wave_sum(s1);
    const float r0 = __builtin_amdgcn_rsqf(s0 * (1.0f / DM) + EPS), r1 = __builtin_amdgcn_rsqf(s1 * (1.0f / DM) + EPS);
    float m0 = 0.f, m1 = 0.f;
#pragma unroll
    for (int j = 0; j < 4; ++j) { const f32x4 w0 = *(const GAS f32x4*)(w + 8 * (lane + 64 * j)), w1 = *(const GAS f32x4*)(w + 8 * (lane + 64 * j) + 4); const float ww[8] = {w0.x, w0.y, w0.z, w0.w, w1.x, w1.y, w1.z, w1.w};
#pragma unroll
        for (int k = 0; k < 8; ++k) { va[j][k] *= r0 * ww[k]; vb[j][k] *= r1 * ww[k]; m0 = fmaxf(m0, fabsf(va[j][k])); m1 = fmaxf(m1, fabsf(vb[j][k])); } }
    m0 = wave_max(m0); m1 = wave_max(m1);
    const float i0 = m0 > 0.f ? 127.0f / m0 : 0.f, i1 = m1 > 0.f ? 127.0f / m1 : 0.f;
    if (lane == 0) { *(GAS float*)saa = m0 * (1.0f / 127.0f); *(GAS float*)sab = m1 * (1.0f / 127.0f); }
#pragma unroll
    for (int j = 0; j < 4; ++j) {
        *(GAS v2u*)(oa + 8 * (lane + 64 * j)) = (v2u){pack_i8x4c(va[j][0] * i0, va[j][1] * i0, va[j][2] * i0, va[j][3] * i0), pack_i8x4c(va[j][4] * i0, va[j][5] * i0, va[j][6] * i0, va[j][7] * i0)};
        *(GAS v2u*)(ob + 8 * (lane + 64 * j)) = (v2u){pack_i8x4c(vb[j][0] * i1, vb[j][1] * i1, vb[j][2] * i1, vb[j][3] * i1), pack_i8x4c(vb[j][4] * i1, vb[j][5] * i1, vb[j][6] * i1, vb[j][7] * i1)}; }
}
__device__ __forceinline__ void rms_phase_i8b(const Ctx& c, const bf16* x, const float* w, unsigned char* H8, float* SA) {
    for (int m = c.gw; m < NTOK / 2; m += c.NGW) rms_rows2_i8b(x + (size_t)m * DM, x + (size_t)(m + NTOK / 2) * DM, w, H8 + (size_t)m * DM, H8 + (size_t)(m + NTOK / 2) * DM, SA + m, SA + m + NTOK / 2, c.lane);
}
__device__ __forceinline__ void rms_phase_i8(const Ctx& c, const float* x, const float* w, unsigned char* H8, float* SA) {
    for (int m = c.gw; m < NTOK / 2; m += c.NGW) rms_rows2_i8(x + (size_t)m * DM, x + (size_t)(m + NTOK / 2) * DM, w, H8 + (size_t)m * DM, H8 + (size_t)(m + NTOK / 2) * DM, SA + m, SA + m + NTOK / 2, c.lane);
}
__device__ __forceinline__ void bf16_rows_i8(const Ctx& c, const bf16* X, unsigned char* X8, float* XS) {
    for (int r = c.gw; r < NTOK; r += 4 * c.NGW) { v4u x[4][4];
#pragma unroll
        for (int i = 0; i < 4; ++i) if (r + i * c.NGW < NTOK)
#pragma unroll
            for (int j = 0; j < 4; ++j) x[i][j] = *(const GAS v4u*)(X + (size_t)(r + i * c.NGW) * DM + 8 * (c.lane + 64 * j));
#pragma unroll
        for (int i = 0; i < 4; ++i) if (r + i * c.NGW < NTOK) { const int row = r + i * c.NGW; float m = 0.f;
#pragma unroll
            for (int j = 0; j < 4; ++j) { const v4u q = x[i][j];
                m = fmaxf(m, fmaxf(fmaxf(fmaxf(fabsf(bflo(q.x)), fabsf(bfhi(q.x))), fmaxf(fabsf(bflo(q.y)), fabsf(bfhi(q.y)))), fmaxf(fmaxf(fabsf(bflo(q.z)), fabsf(bfhi(q.z))), fmaxf(fabsf(bflo(q.w)), fabsf(bfhi(q.w)))))); }
            m = wave_max(m);
            const float inv = m > 0.f ? 127.0f / m : 0.f;
            if (c.lane == 0) *(GAS float*)(XS + row) = m * (1.0f / 127.0f);
#pragma unroll
            for (int j = 0; j < 4; ++j) { const v4u q = x[i][j]; v2u o;
                o.x = pack_i8x4c(bflo(q.x) * inv, bfhi(q.x) * inv, bflo(q.y) * inv, bfhi(q.y) * inv); o.y = pack_i8x4c(bflo(q.z) * inv, bfhi(q.z) * inv, bflo(q.w) * inv, bfhi(q.w) * inv);
                *(GAS v2u*)(X8 + (size_t)row * DM + 8 * (c.lane + 64 * j)) = o; } } }
}
__device__ __forceinline__ void rms_rows2(const float* xa, const float* xb, const float* w, bf16* oa, bf16* ob, int lane) {
    const GAS f32x4* pa = (const GAS f32x4*)xa + lane; const GAS f32x4* pb = (const GAS f32x4*)xb + lane; f32x4 va[8], vb[8]; float sa = 0.f, sb = 0.f;
#pragma unroll
    for (int j = 0; j < 8; ++j) { va[j] = pa[64 * j]; vb[j] = pb[64 * j]; }
#pragma unroll
    for (int j = 0; j < 8; ++j) { sa += (va[j].x * va[j].x + va[j].y * va[j].y) + (va[j].z * va[j].z + va[j].w * va[j].w); sb += (vb[j].x * vb[j].x + vb[j].y * vb[j].y) + (vb[j].z * vb[j].z + vb[j].w * vb[j].w); }
    sa = wave_sum(sa); sb = wave_sum(sb);
    const float ra = __builtin_amdgcn_rsqf(sa * (1.0f / DM) + EPS), rb = __builtin_amdgcn_rsqf(sb * (1.0f / DM) + EPS);
    const GAS f32x4* wp = (const GAS f32x4*)w + lane; GAS v2u* qa = (GAS v2u*)oa + lane; GAS v2u* qb = (GAS v2u*)ob + lane;
#pragma unroll
    for (int j = 0; j < 8; ++j) { const f32x4 wv = wp[64 * j];
        v2u q; q.x = pk2c(va[j].x * ra * wv.x, va[j].y * ra * wv.y); q.y = pk2c(va[j].z * ra * wv.z, va[j].w * ra * wv.w); qa[64 * j] = q;
        v2u p; p.x = pk2c(vb[j].x * rb * wv.x, vb[j].y * rb * wv.y); p.y = pk2c(vb[j].z * rb * wv.z, vb[j].w * rb * wv.w); qb[64 * j] = p; }
}
__device__ __forceinline__ void rms_phase(const Ctx& c, const float* x, const float* w, bf16* H) {
    for (int m = c.gw; m < NTOK / 2; m += c.NGW) rms_rows2(x + (size_t)m * DM, x + (size_t)(m + NTOK / 2) * DM, w, H + (size_t)m * DM, H + (size_t)(m + NTOK / 2) * DM, c.lane);
}
__device__ __forceinline__ void fp8_row(const float* src, unsigned char* dst, float* scale_out, int lane) {
    const GAS f32x4* xp = (const GAS f32x4*)src + lane; f32x4 v[8]; float m = 0.f;
#pragma unroll
    for (int j = 0; j < 8; ++j) { v[j] = xp[64 * j]; m = fmaxf(fmaxf(m, fmaxf(fabsf(v[j].x), fabsf(v[j].y))), fmaxf(fabsf(v[j].z), fabsf(v[j].w))); }
    m = wave_max(m);
    const float inv = m > 0.f ? 256.0f / m : 0.f;
    if (lane == 0) *(GAS float*)scale_out = m * (1.0f / 256.0f);
#pragma unroll
    for (int j = 0; j < 8; ++j) { int p = __builtin_amdgcn_cvt_pk_fp8_f32(v[j].x * inv, v[j].y * inv, 0, false); p = __builtin_amdgcn_cvt_pk_fp8_f32(v[j].z * inv, v[j].w * inv, p, true);
        ((GAS unsigned*)dst)[lane + 64 * j] = (unsigned)p; }
}
constexpr size_t U8_SLICE = (size_t)16384 * 128;
__device__ __forceinline__ unsigned pack_i8x4(float a, float b, float c, float d) {
    const int ia = (int)__builtin_rintf(a), ib = (int)__builtin_rintf(b), ic = (int)__builtin_rintf(c), id = (int)__builtin_rintf(d);
    return ((unsigned)ia & 255u) | (((unsigned)ib & 255u) << 8) | (((unsigned)ic & 255u) << 16) | ((unsigned)id << 24);
}
__device__ __forceinline__ void row_load_strided(const float* src, int lane, f32x4 (&v)[8]) { const GAS f32x4* xp = (const GAS f32x4*)src + lane;
#pragma unroll
    for (int j = 0; j < 8; ++j) v[j] = xp[64 * j]; }
__device__ __forceinline__ void row_load_contig(const float* src, int lane, f32x4 (&v)[8]) { const GAS f32x4* xp = (const GAS f32x4*)src + 8 * lane;
#pragma unroll
    for (int j = 0; j < 8; ++j) v[j] = xp[j]; }
__device__ __forceinline__ void i8_row(const f32x4 (&v)[8], unsigned char* dst, float* scale_out, int lane) {
    float m = 0.f;
#pragma unroll
    for (int j = 0; j < 8; ++j) m = fmaxf(fmaxf(m, fmaxf(fabsf(v[j].x), fabsf(v[j].y))), fmaxf(fabsf(v[j].z), fabsf(v[j].w)));
    m = wave_max(m);
    const float inv = m > 0.f ? 127.0f / m : 0.f;
    if (lane == 0) *(GAS float*)scale_out = m * (1.0f / 127.0f);
#pragma unroll
    for (int j = 0; j < 8; ++j) *(GAS unsigned*)(dst + (size_t)(2 * j + (lane >> 5)) * U8_SLICE + 4 * (lane & 31)) = pack_i8x4(v[j].x * inv, v[j].y * inv, v[j].z * inv, v[j].w * inv);
}
constexpr size_t V6_SLICE = (size_t)16384 * 192;
__device__ __forceinline__ void fp6_row(const f32x4 (&v)[8], unsigned char* dst, float* scale_out, int lane) {
    float m = 0.f;
#pragma unroll
    for (int j = 0; j < 8; ++j) m = fmaxf(fmaxf(m, fmaxf(fabsf(v[j].x), fabsf(v[j].y))), fmaxf(fabsf(v[j].z), fabsf(v[j].w)));
    m = wave_max(m);
    const float inv = m > 0.f ? 7.5f / m : 0.f;
    if (lane == 0) *(GAS float*)scale_out = m * (1.0f / 7.5f);
    v32h_t h;
#pragma unroll
    for (int j = 0; j < 8; ++j) { h[4 * j] = (_Float16)(v[j].x * inv); h[4 * j + 1] = (_Float16)(v[j].y * inv); h[4 * j + 2] = (_Float16)(v[j].z * inv); h[4 * j + 3] = (_Float16)(v[j].w * inv); }
    const v6u q = __builtin_amdgcn_cvt_scalef32_pk32_fp6_f16(h, 1.0f);
    GAS v2u* o = (GAS v2u*)(dst + (size_t)(lane >> 3) * V6_SLICE + 24 * (lane & 7));
    o[0] = (v2u){q[0], q[1]}; o[1] = (v2u){q[2], q[3]}; o[2] = (v2u){q[4], q[5]};
}
struct P0Args { const float *w_in, *w_br_sb, *w_br_hg, *w_br_conv, *w_o, *w_q, *u, *v, *lbp; bf16 *WinT, *WbrT, *WoT, *WqT; unsigned char *U, *V; float *US, *VS; float* LB; int layer; const float *k1, *k2; bf16* KB; };
__device__ __forceinline__ void p0_convert(const Ctx& c, const P0Args& a, int parts = 7) {
    LAS float* scr = (LAS float*)(c.lds + c.wave * 16384);
    constexpr int I_IN = (DM / 128) * (INW / 32), I_BR = (BW / 64) * (DM / 32), I_SQ = (DM / 64) * (DM / 32);
    constexpr int I_Q8 = (DM / 128) * (DM / 32);
    constexpr int I_B8 = (BW / 128) * (DM / 32);
    constexpr int NITEMS = I_IN + I_BR + 2 * I_B8 + 2 * I_Q8;
    if (parts & 1)
    for (int it = c.gw; it < NITEMS; it += c.NGW) {
        int r = it;
        if (r < I_IN) { const int kb = r / (INW / 32), nb = r % (INW / 32); tr_item_i8(a.w_in, DM, INW, (unsigned char*)a.WinT, kb * 128, nb * 32, win_drow(nb * 32), WIN_QS, scr, c.lane); continue; } r -= I_IN;
        if (r < I_BR) { const int kb = r / (DM / 32), nb = r % (DM / 32); tr_item(a.w_br_sb, BW, DM, a.WbrT, kb * 64, nb * 32, nb * 32, scr, c.lane); continue; } r -= I_BR;
        if (r < I_B8) { const int kb = r / (DM / 32), nb = r % (DM / 32); tr_item_i8(a.w_br_hg, BW, DM, (unsigned char*)(a.WbrT + (size_t)DM * BW), kb * 128, nb * 32, nb * 32, WBR_QS, scr, c.lane); continue; } r -= I_B8;
        if (r < I_B8) { const int kb = r / (DM / 32), nb = r % (DM / 32); tr_item_i8(a.w_br_conv, BW, DM, (unsigned char*)(a.WbrT + (size_t)2 * DM * BW), kb * 128, nb * 32, nb * 32, WBR_QS, scr, c.lane); continue; } r -= I_B8;
        if (r < I_Q8) { const int kb = r / (DM / 32), nb = r % (DM / 32); tr_item_i8(a.w_o, DM, DM, (unsigned char*)a.WoT, kb * 128, nb * 32, nb * 32, WIN_QS, scr, c.lane); continue; } r -= I_Q8;
        { const int kb = r / (DM / 32), nb = r % (DM / 32); tr_item_i8(a.w_q, DM, DM, (unsigned char*)a.WqT, kb * 128, nb * 32, nb * 32, WIN_QS, scr, c.lane); }
    }
    if (parts & 2)
    {
    for (int r = c.gw; r < 16384; r += 2 * c.NGW) { const int r2 = r + c.NGW; f32x4 va[8], vb[8];
        row_load_strided(a.u + (size_t)r * 2048, c.lane, va); if (r2 < 16384) row_load_strided(a.u + (size_t)r2 * 2048, c.lane, vb);
        i8_row(va, a.U + (size_t)r * 128, a.US + r, c.lane); if (r2 < 16384) i8_row(vb, a.U + (size_t)r2 * 128, a.US + r2, c.lane); }
    for (int r = c.gw; r < 16384; r += 2 * c.NGW) { const int r2 = r + c.NGW; f32x4 va[8], vb[8];
        row_load_contig(a.v + (size_t)r * 2048, c.lane, va); if (r2 < 16384) row_load_contig(a.v + (size_t)r2 * 2048, c.lane, vb);
        fp6_row(va, a.V + (size_t)r * 192, a.VS + r, c.lane); if (r2 < 16384) fp6_row(vb, a.V + (size_t)r2 * 192, a.VS + r2, c.lane); }
    }
    if (parts & 4) {
    cvt_copy(c, a.k1, a.KB, (size_t)8 * 16384 / 8);
    cvt_copy(c, a.k2, a.KB + 8 * 16384, (size_t)8 * 16384 / 8); }
    if (blockIdx.x == 0) for (int i = c.tid; i < 1024; i += 512) a.LB[i] = a.layer == 0 ? 0.f : sigm(a.lbp[1024 + i] - a.lbp[i]);
}

__device__ __forceinline__ unsigned pack_i8x4u(float a, float b, float c, float d) {
    return (unsigned)__builtin_rintf(a) | ((unsigned)__builtin_rintf(b) << 8) | ((unsigned)__builtin_rintf(c) << 16) | ((unsigned)__builtin_rintf(d) << 24);
}
struct EpiIn {
    static constexpr bool PERM = true, AFTER_DRAIN = false;
    bf16* seg; bf16* gate; const float* lb; const float* sa;
    __device__ __forceinline__ float rowscale(int row) const { return ((const GAS float*)sa)[row] * (1.0f / WIN_QS); }
    __device__ __forceinline__ void operator()(const pg8::f32x4 (&acc)[2][2][4][2], const pg8::Unit& u, int wr, int wc, int fr, int fq) const {
        const int pn = u.pn; const int row0 = u.pm * 256 + wr * 64 + fr;
        if (pn >= 28 && pn < 36) {
            bf16* dst = seg + (size_t)7 * SEGSZ; const int col0 = (pn - 28) * 128 + wc * 32 + 8 * fq;
#pragma unroll
            for (int ai = 0; ai < 2; ++ai)
#pragma unroll
                for (int m = 0; m < 4; ++m) {
                    const pg8::f32x4 a0 = acc[ai][0][m][0], a1 = acc[ai][0][m][1], b0 = acc[ai][1][m][0], b1 = acc[ai][1][m][1];
                    v4u w; w.x = pk2c(a0[0] * sigm(b0[0]), a0[1] * sigm(b0[1])); w.y = pk2c(a0[2] * sigm(b0[2]), a0[3] * sigm(b0[3]));
                    w.z = pk2c(a1[0] * sigm(b1[0]), a1[1] * sigm(b1[1])); w.w = pk2c(a1[2] * sigm(b1[2]), a1[3] * sigm(b1[3]));
                    *(GAS v4u*)(dst + (size_t)(row0 + ai * 128 + m * 16) * 1024 + col0) = w; }
            return;
        }
        if (pn >= 24 && pn < 28) {
            unsigned char* g8 = (unsigned char*)(seg + (size_t)6 * SEGSZ); const int c8 = (pn & 3) * 256 + wc * 32 + 8 * fq;
#pragma unroll
            for (int ai = 0; ai < 2; ++ai)
#pragma unroll
                for (int m = 0; m < 4; ++m)
#pragma unroll
                    for (int bj = 0; bj < 2; ++bj) { const pg8::f32x4 v0 = acc[ai][bj][m][0], v1 = acc[ai][bj][m][1];
                        v2u w; w.x = pack_i8x4u(sigm(v0[0]) * 255.0f, sigm(v0[1]) * 255.0f, sigm(v0[2]) * 255.0f, sigm(v0[3]) * 255.0f); w.y = pack_i8x4u(sigm(v1[0]) * 255.0f, sigm(v1[1]) * 255.0f, sigm(v1[2]) * 255.0f, sigm(v1[3]) * 255.0f);
                        *(GAS v2u*)(g8 + (size_t)(row0 + ai * 128 + m * 16) * 1024 + c8 + bj * 128) = w; }
            return; }
        bf16* dst; int ld, colt, mode;
        if (pn < 28) { const int sg = pn >> 2; dst = seg + (size_t)sg * SEGSZ; ld = 1024; colt = (pn & 3) * 256; mode = (sg == 4) ? 2 : 0; }
        else {
            const int q = pn - 36; unsigned char* g8 = (unsigned char*)gate + (size_t)(q >> 3) * ((size_t)NTOK * 2048); const int c8 = (q & 7) * 256 + wc * 32 + 8 * fq;
#pragma unroll
            for (int ai = 0; ai < 2; ++ai)
#pragma unroll
                for (int m = 0; m < 4; ++m)
#pragma unroll
                    for (int bj = 0; bj < 2; ++bj) { const pg8::f32x4 v0 = acc[ai][bj][m][0], v1 = acc[ai][bj][m][1];
                        v2u w; w.x = pack_i8x4u(sigm(v0[0]) * 255.0f, sigm(v0[1]) * 255.0f, sigm(v0[2]) * 255.0f, sigm(v0[3]) * 255.0f); w.y = pack_i8x4u(sigm(v1[0]) * 255.0f, sigm(v1[1]) * 255.0f, sigm(v1[2]) * 255.0f, sigm(v1[3]) * 255.0f);
                        *(GAS v2u*)(g8 + (size_t)(row0 + ai * 128 + m * 16) * 2048 + c8 + bj * 128) = w; }
            return; }
        const int col0 = colt + wc * 32 + 8 * fq;
        if (mode == 0) {
#pragma unroll
            for (int ai = 0; ai < 2; ++ai)
#pragma unroll
                for (int m = 0; m < 4; ++m)
#pragma unroll
                    for (int bj = 0; bj < 2; ++bj) { const pg8::f32x4 v0 = acc[ai][bj][m][0], v1 = acc[ai][bj][m][1];
                        v4u w; w.x = pk2c(v0[0], v0[1]); w.y = pk2c(v0[2], v0[3]); w.z = pk2c(v1[0], v1[1]); w.w = pk2c(v1[2], v1[3]);
                        *(GAS v4u*)(dst + (size_t)(row0 + ai * 128 + m * 16) * ld + col0 + bj * 128) = w; }
        } else if (mode == 1) {
#pragma unroll
            for (int ai = 0; ai < 2; ++ai)
#pragma unroll
                for (int m = 0; m < 4; ++m)
#pragma unroll
                    for (int bj = 0; bj < 2; ++bj) { const pg8::f32x4 v0 = acc[ai][bj][m][0], v1 = acc[ai][bj][m][1];
                        v4u w; w.x = pk2c(sigm(v0[0]), sigm(v0[1])); w.y = pk2c(sigm(v0[2]), sigm(v0[3])); w.z = pk2c(sigm(v1[0]), sigm(v1[1])); w.w = pk2c(sigm(v1[2]), sigm(v1[3]));
                        *(GAS v4u*)(dst + (size_t)(row0 + ai * 128 + m * 16) * ld + col0 + bj * 128) = w; }
        } else {
            f32x4 l0[2], l1[2];
#pragma unroll
            for (int bj = 0; bj < 2; ++bj) { l0[bj] = *(const GAS f32x4*)(lb + col0 + bj * 128); l1[bj] = *(const GAS f32x4*)(lb + col0 + bj * 128 + 4); }
#pragma unroll
            for (int ai = 0; ai < 2; ++ai)
#pragma unroll
                for (int m = 0; m < 4; ++m)
#pragma unroll
                    for (int bj = 0; bj < 2; ++bj) { const pg8::f32x4 v0 = acc[ai][bj][m][0], v1 = acc[ai][bj][m][1]; float r[8];
#pragma unroll
                        for (int j = 0; j < 4; ++j) { r[j] = __logf(l0[bj][j] + (1.0f - l0[bj][j]) * sigm(v0[j])); r[4 + j] = __logf(l1[bj][j] + (1.0f - l1[bj][j]) * sigm(v1[j])); }
                        v4u w; w.x = pk2c(r[0], r[1]); w.y = pk2c(r[2], r[3]); w.z = pk2c(r[4], r[5]); w.w = pk2c(r[6], r[7]);
                        *(GAS v4u*)(dst + (size_t)(row0 + ai * 128 + m * 16) * ld + col0 + bj * 128) = w; }
        }
    }
};

__device__ __forceinline__ void conv_phase(const Ctx& c, const bf16* glu, const float* cw, const float* cb, const float* lnw, const float* lnb, bf16* out) {
    const int c0 = 2 * c.tid;
    float w0[31], w1[31];
#pragma unroll
    for (int j = 0; j < 31; ++j) { const f32x2v t = *(const GAS f32x2v*)(cw + j * 1024 + c0); w0[j] = t.x; w1[j] = t.y; }
    const f32x2v bv = *(const GAS f32x2v*)(cb + c0), lwv = *(const GAS f32x2v*)(lnw + c0), lbv = *(const GAS f32x2v*)(lnb + c0);
    LAS float* red = (LAS float*)c.lds;
    const int per = (NTOK / 8 + c.G - 1) / c.G, tile0 = (int)blockIdx.x * per;
    unsigned win[38];
    if (tile0 < NTOK / 8) {
#pragma unroll
        for (int r = 0; r < 38; ++r) { const int n = tile0 * 8 + r - 30; win[r] = *(const GAS unsigned*)(glu + (size_t)(n > 0 ? n : 0) * 1024 + c0); } }
    for (int ti = 0; ti < per; ++ti) { const int tile = tile0 + ti; if (tile >= NTOK / 8) break;
        const int n0 = tile * 8, tseq0 = n0 & (SEQ - 1);
        const bool more = (ti + 1 < per) && (tile + 1 < NTOK / 8);
        float a0[8], a1[8];
#pragma unroll
        for (int t = 0; t < 8; ++t) { a0[t] = bv.x; a1[t] = bv.y; }
#pragma unroll
        for (int r = 0; r < 38; ++r) {
            const unsigned xv = (tseq0 + r - 30 >= 0) ? win[r] : 0u;
            const float x0 = bflo(xv), x1 = bfhi(xv);
#pragma unroll
            for (int t = 0; t < 8; ++t) { const int j = r - t; if (j >= 0 && j <= 30) { a0[t] += w0[j] * x0; a1[t] += w1[j] * x1; } }
        }
#pragma unroll
        for (int r = 0; r < 30; ++r) win[r] = win[r + 8];
        if (more) {
#pragma unroll
            for (int i = 0; i < 8; ++i) win[30 + i] = *(const GAS unsigned*)(glu + (size_t)(n0 + 8 + i) * 1024 + c0); }
        float st[16];
#pragma unroll
        for (int t = 0; t < 8; ++t) { st[2 * t] = a0[t] + a1[t]; st[2 * t + 1] = a0[t] * a0[t] + a1[t] * a1[t]; }
        xreduce16(st, c.lane);
        if ((c.lane & 3) == 0) red[c.wave * 16 + ridx16(c.lane)] = st[0];
        __syncthreads();
        if (c.tid < 16) { float s = 0.f;
#pragma unroll
            for (int w = 0; w < 8; ++w) s += red[w * 16 + c.tid];
            red[128 + c.tid] = s; }
        __syncthreads();
#pragma unroll
        for (int t = 0; t < 8; ++t) {
            const float mean = red[128 + 2 * t] * (1.0f / 1024.0f), var = red[128 + 2 * t + 1] * (1.0f / 1024.0f) - mean * mean;
            const float rstd = __builtin_amdgcn_rsqf(var + EPS);
            const float h0 = (a0[t] - mean) * rstd * lwv.x + lbv.x, h1 = (a1[t] - mean) * rstd * lwv.y + lbv.y;
            const unsigned q4 = pack_i8x4c(h0 * sigm(h0) * ACT_QS, h1 * sigm(h1) * ACT_QS, 0.f, 0.f);
            *(GAS unsigned short*)((unsigned char*)out + (size_t)(n0 + t) * 1024 + c0) = (unsigned short)q4;
        }
        __syncthreads();
    }
}
__device__ __forceinline__ void hgrn_task(int task, int lane, const bf16* qhg, const bf16* logf, const bf16* ihg, bf16* out) {
    const int bh = task >> 6, dvb = task & 63, b = bh >> 3, h = bh & 7;
    const size_t rb = (size_t)b * SEQ * 1024;
    const GAS unsigned* qp = (const GAS unsigned*)(qhg + rb + h * 128) + lane;
    const GAS unsigned* lp = (const GAS unsigned*)(logf + rb + h * 128) + lane;
    const GAS unsigned* ip = (const GAS unsigned*)(ihg + rb + h * 128) + dvb;
    GAS bf16* op = (GAS bf16*)(out + rb + h * 128 + 2 * dvb);
    float S00 = 0.f, S01 = 0.f, S10 = 0.f, S11 = 0.f;
    unsigned qn[8], ln[8], inx[8];
#pragma unroll
    for (int j = 0; j < 8; ++j) { qn[j] = qp[(size_t)j * 512]; ln[j] = lp[(size_t)j * 512]; inx[j] = ip[(size_t)j * 512]; }
    for (int blk = 0; blk < SEQ / 8; ++blk) {
        unsigned qc[8], lc[8], ic[8];
#pragma unroll
        for (int j = 0; j < 8; ++j) { qc[j] = qn[j]; lc[j] = ln[j]; ic[j] = inx[j]; }
        if (blk + 1 < SEQ / 8) {
#pragma unroll
            for (int j = 0; j < 8; ++j) { const size_t o = (size_t)((blk + 1) * 8 + j) * 512; qn[j] = qp[o]; ln[j] = lp[o]; inx[j] = ip[o]; }
        }
        float pv[16];
#pragma unroll
        for (int j = 0; j < 8; ++j) {
            const float f0 = __expf(bflo(lc[j])), f1 = __expf(bfhi(lc[j])), k0 = 1.0f - f0, k1 = 1.0f - f1;
            const float i0 = bflo(ic[j]), i1 = bfhi(ic[j]), q0 = bflo(qc[j]), q1 = bfhi(qc[j]);
            S00 = f0 * S00 + k0 * i0; S01 = f0 * S01 + k0 * i1; S10 = f1 * S10 + k1 * i0; S11 = f1 * S11 + k1 * i1;
            pv[2 * j] = S00 * q0 + S10 * q1; pv[2 * j + 1] = S01 * q0 + S11 * q1;
        }
        xreduce16(pv, lane);
        if ((lane & 3) == 0) { const int idx = ridx16(lane); op[(size_t)(blk * 8 + (idx >> 1)) * 1024 + (idx & 1)] = (bf16)(pk2c(pv[0], 0.f) & 0xffffu); }
    }
}
constexpr int HG_TS = 272;
constexpr int HG_TL = 256;
constexpr int HG_TILE = 64 * HG_TL;
constexpr int HG_BS = 132;
__device__ __forceinline__ void hg_stage(LAS unsigned char* dst, const bf16* src, int tid) {
#pragma unroll
    for (int i = 0; i < 2; ++i) { const int p = tid + 512 * i, row = p >> 4, c16 = p & 15; *(LAS v4u*)(dst + row * HG_TL + c16 * 16) = *(const GAS v4u*)(src + (size_t)row * 1024 + c16 * 8); }
}
__device__ __forceinline__ void hg_scan(const LAS unsigned char* lft, int dk, int hf, float (&lf)[4][8], float (&b)[4][8], float& bl) {
    float bs[4], pb[4];
#pragma unroll
    for (int kk = 0; kk < 4; ++kk) { float run = 0.f;
#pragma unroll
        for (int j = 0; j < 8; ++j) { lf[kk][j] = __uint_as_float((unsigned)(*(const LAS unsigned short*)(lft + (16 * kk + 8 * hf + j) * HG_TL + dk * 2)) << 16); run += lf[kk][j]; b[kk][j] = run; }
        bs[kk] = run; }
#pragma unroll
    for (int kk = 0; kk < 4; ++kk) pb[kk] = xor32f(bs[kk], hf);
    float pre = 0.f;
#pragma unroll
    for (int kk = 0; kk < 4; ++kk) { const float off = pre + (hf ? pb[kk] : 0.f);
#pragma unroll
        for (int j = 0; j < 8; ++j) b[kk][j] += off;
        pre += bs[kk] + pb[kk]; }
    bl = pre;
}
__device__ __forceinline__ bf16x8 pack8(const float (&v)[8]) { v4u t; t.x = pk2c(v[0], v[1]); t.y = pk2c(v[2], v[3]); t.z = pk2c(v[4], v[5]); t.w = pk2c(v[6], v[7]); return __builtin_bit_cast(bf16x8, t); }
__device__ __forceinline__ unsigned lds_u16(const LAS unsigned char* p) { return (unsigned)(*(const LAS unsigned short*)p); }
__device__ __forceinline__ size_t hg_tile_off(int ci) { const int bh = ci >> 6, ch = ci & 63, bb = bh >> 3, h = bh & 7; return ((size_t)bb * SEQ + ch * 64) * 1024 + h * 128; }
__device__ __forceinline__ void hg_tile_dma(LAS unsigned char* dst, const bf16* src, int wave, int lane) {
    const unsigned long long a_ = (unsigned long long)src;
    const char* sb = (const char*)(((unsigned long long)(unsigned)__builtin_amdgcn_readfirstlane((int)(a_ >> 32)) << 32) | (unsigned)__builtin_amdgcn_readfirstlane((int)a_));
    const unsigned d0 = (unsigned)(unsigned long long)dst + (unsigned)wave * 2048u;
    const unsigned vo = (unsigned)wave * 16384u + (unsigned)(lane >> 4) * 2048u + (unsigned)(lane & 15) * 16u;
#pragma unroll
    for (int i = 0; i < 2; ++i) { const unsigned m0v = d0 + (unsigned)i * 1024u, vv = vo + (unsigned)i * 8192u;
        asm volatile("s_mov_b32 m0, %0\n\ts_nop 0\n\tglobal_load_lds_dwordx4 %1, %2" :: "s"(m0v), "v"(vv), "s"(sb) : "memory", "m0"); }
}
__device__ __forceinline__ void hgA_chunk(const Ctx& c, int ci, int cn, int par, bool first, const bf16* LOGF, const bf16* IHG, bf16* ST, float* DEC) {
    LAS unsigned char* lft = c.lds + par * 2 * HG_TILE; LAS unsigned char* itl = lft + HG_TILE; LAS unsigned char* nxt = c.lds + (par ^ 1) * 2 * HG_TILE;
    if (first) { const size_t o = hg_tile_off(ci); hg_stage(lft, LOGF + o, c.tid); hg_stage(itl, IHG + o, c.tid); }
    asm volatile("s_waitcnt vmcnt(0)" ::: "memory");
    __syncthreads();
    if (cn < 2048) { const size_t o = hg_tile_off(cn); hg_tile_dma(nxt, LOGF + o, c.wave, c.lane); hg_tile_dma(nxt + HG_TILE, IHG + o, c.wave, c.lane); }
    const int dkt = c.wave & 3, dvh = c.wave >> 2, hf = c.lane >> 5, cl = c.lane & 31, dk = 32 * dkt + cl;
    float lf[4][8], b[4][8], bl; hg_scan(lft, dk, hf, lf, b, bl);
    bf16x8 kf[4];
#pragma unroll
    for (int kk = 0; kk < 4; ++kk) { float v[8];
#pragma unroll
        for (int j = 0; j < 8; ++j) v[j] = (1.0f - __expf(lf[kk][j])) * __expf(bl - b[kk][j]);
        kf[kk] = pack8(v); }
    if (dvh == 0 && hf == 0) ((GAS float*)DEC)[(size_t)ci * 128 + dk] = __expf(bl);
#pragma unroll
    for (int dvi = 0; dvi < 2; ++dvi) { const int dvt = dvh * 2 + dvi;
        f32x16 acc;
#pragma unroll
        for (int r = 0; r < 16; ++r) acc[r] = 0.f;
#pragma unroll
        for (int kk = 0; kk < 4; ++kk) { const LAS unsigned char* p = itl + (16 * kk + 8 * hf) * HG_TL + (32 * dvt + cl) * 2;
            v4u t; t.x = lds_u16(p) | (lds_u16(p + HG_TL) << 16); t.y = lds_u16(p + 2 * HG_TL) | (lds_u16(p + 3 * HG_TL) << 16); t.z = lds_u16(p + 4 * HG_TL) | (lds_u16(p + 5 * HG_TL) << 16); t.w = lds_u16(p + 6 * HG_TL) | (lds_u16(p + 7 * HG_TL) << 16);
            acc = MFMA32(kf[kk], __builtin_bit_cast(bf16x8, t), acc); }
        bf16* o = ST + (size_t)ci * 16384 + (size_t)(32 * dvt + cl) * 128 + 32 * dkt + 4 * hf;
#pragma unroll
        for (int g = 0; g < 4; ++g) { v2u q; q.x = pk2c(acc[4 * g], acc[4 * g + 1]); q.y = pk2c(acc[4 * g + 2], acc[4 * g + 3]); *(GAS v2u*)(o + 8 * g) = q; }
    }
    __syncthreads();
}
__device__ __forceinline__ void hgB(const Ctx& c, bf16* ST, const float* DEC) {
    for (int e = blockIdx.x * 512 + c.tid; e < 32 * 4096; e += c.G * 512) {
        const int bh = e >> 12, r = e & 4095, dv = r >> 5, dk4 = (r & 31) * 4;
        GAS v2u* p = (GAS v2u*)(ST + (size_t)bh * 64 * 16384 + (size_t)dv * 128 + dk4);
        const GAS f32x4* d = (const GAS f32x4*)(DEC + (size_t)bh * 64 * 128 + dk4);
        f32x4 S = {0.f, 0.f, 0.f, 0.f};
#pragma unroll
        for (int c0 = 0; c0 < 64; c0 += 8) {
            v2u Lv[8]; f32x4 D[8];
#pragma unroll
            for (int k = 0; k < 8; ++k) { Lv[k] = p[(size_t)(c0 + k) * 4096]; D[k] = d[(size_t)(c0 + k) * 32]; }
#pragma unroll
            for (int k = 0; k < 8; ++k) { v2u o; o.x = pk2c(S.x, S.y); o.y = pk2c(S.z, S.w); p[(size_t)(c0 + k) * 4096] = o;
                S.x = D[k].x * S.x + bflo(Lv[k].x); S.y = D[k].y * S.y + bfhi(Lv[k].x); S.z = D[k].z * S.z + bflo(Lv[k].y); S.w = D[k].w * S.w + bfhi(Lv[k].y); }
        }
    }
}
__device__ __forceinline__ void hgC_chunk(const Ctx& c, int ci, int cn, int par, bool first, const bf16* QHG, const bf16* LOGF, const bf16* IHG, const bf16* GHG, const bf16* ST, const float* nw, bf16* OUT) {
    const int bh = ci >> 6, ch = ci & 63, bb = bh >> 3, h = bh & 7; const size_t n0 = (size_t)bb * SEQ + ch * 64;
    LAS unsigned char* lft = c.lds + par * 2 * HG_TILE; LAS unsigned char* itl = lft + HG_TILE; LAS unsigned char* nxt = c.lds + (par ^ 1) * 2 * HG_TILE;
    LAS float* bt = (LAS float*)(c.lds + 4 * HG_TILE); LAS float* red = bt + 64 * HG_BS;
    LAS unsigned char* ktl = (LAS unsigned char*)(red + 256);
    const int hf = c.lane >> 5, cl = c.lane & 31;
    const int dvt = c.wave & 3, tt = c.wave >> 2, t = 32 * tt + cl;
    const bf16* qrow = QHG + (n0 + t) * 1024 + h * 128 + 8 * hf;
    if (first) { hg_stage(lft, LOGF + n0 * 1024 + h * 128, c.tid); hg_stage(itl, IHG + n0 * 1024 + h * 128, c.tid); }
    asm volatile("s_waitcnt vmcnt(0)" ::: "memory");
    __syncthreads();
    v4u qg[8];
#pragma unroll
    for (int kk = 0; kk < 8; ++kk) qg[kk] = *(const GAS v4u*)(qrow + 16 * kk);
    { const int dk = 32 * (c.wave & 3) + cl; float lf[4][8], b[4][8], bl; hg_scan(lft, dk, hf, lf, b, bl);
#pragma unroll
      for (int q = 0; q < 2; ++q) { const int kk = 2 * (c.wave >> 2) + q;
#pragma unroll
          for (int j = 0; j < 8; ++j) { bt[(16 * kk + 8 * hf + j) * HG_BS + dk] = (c.wave >> 2) ? b[2 + q][j] : b[q][j];
              *(LAS unsigned short*)(ktl + (16 * kk + 8 * hf + j) * HG_TS + dk * 2) = (unsigned short)(pk2c(1.0f - __expf((c.wave >> 2) ? lf[2 + q][j] : lf[q][j]), 0.f) & 0xffffu); } } }
    __syncthreads();
    if (cn < 2048) { const size_t o = hg_tile_off(cn); hg_tile_dma(nxt, LOGF + o, c.wave, c.lane); hg_tile_dma(nxt + HG_TILE, IHG + o, c.wave, c.lane); }
    bf16x8 qm[8];
    const bf16* strow = ST + (size_t)ci * 16384 + (size_t)(32 * dvt + cl) * 128 + 8 * hf;
#pragma unroll
    for (int kk = 0; kk < 8; ++kk) { const int d0 = 16 * kk + 8 * hf;
        const v4u qv = qg[kk];
        const f32x4 b0 = *(const LAS f32x4*)(bt + t * HG_BS + d0), b1 = *(const LAS f32x4*)(bt + t * HG_BS + d0 + 4), m0 = *(const LAS f32x4*)(bt + 31 * HG_BS + d0), m1 = *(const LAS f32x4*)(bt + 31 * HG_BS + d0 + 4);
        const float q[8] = {bflo(qv.x), bfhi(qv.x), bflo(qv.y), bfhi(qv.y), bflo(qv.z), bfhi(qv.z), bflo(qv.w), bfhi(qv.w)};
        const float bv[8] = {b0.x, b0.y, b0.z, b0.w, b1.x, b1.y, b1.z, b1.w}, mv[8] = {m0.x, m0.y, m0.z, m0.w, m1.x, m1.y, m1.z, m1.w};
        float vm[8];
#pragma unroll
        for (int j = 0; j < 8; ++j) vm[j] = q[j] * __expf(bv[j] - mv[j]);
        qm[kk] = pack8(vm); }
    f32x16 o;
#pragma unroll
    for (int r = 0; r < 16; ++r) o[r] = 0.f;
#pragma unroll 1
    for (int st = 0; st <= tt; ++st) {
        const int s = 32 * st + cl;
        f32x16 sa;
#pragma unroll
        for (int r = 0; r < 16; ++r) sa[r] = 0.f;
#pragma unroll
        for (int kk = 0; kk < 8; ++kk) { const int d0 = 16 * kk + 8 * hf;
            asm volatile("" ::: "memory");
            const v4u lv = *(const LAS v4u*)(ktl + s * HG_TS + d0 * 2);
            const f32x4 b0 = *(const LAS f32x4*)(bt + s * HG_BS + d0), b1 = *(const LAS f32x4*)(bt + s * HG_BS + d0 + 4), m0 = *(const LAS f32x4*)(bt + 31 * HG_BS + d0), m1 = *(const LAS f32x4*)(bt + 31 * HG_BS + d0 + 4);
            const float kv[8] = {bflo(lv.x), bfhi(lv.x), bflo(lv.y), bfhi(lv.y), bflo(lv.z), bfhi(lv.z), bflo(lv.w), bfhi(lv.w)};
            const float bv[8] = {b0.x, b0.y, b0.z, b0.w, b1.x, b1.y, b1.z, b1.w}, mv[8] = {m0.x, m0.y, m0.z, m0.w, m1.x, m1.y, m1.z, m1.w};
            float vk[8];
#pragma unroll
            for (int j = 0; j < 8; ++j) vk[j] = kv[j] * __expf(mv[j] - bv[j]);
            sa = MFMA32(pack8(vk), qm[kk], sa); }
        if (st == tt) {
#pragma unroll
            for (int r = 0; r < 16; ++r) if (((r & 3) + 8 * (r >> 2) + 4 * hf) > cl) sa[r] = 0.f;
        }
#pragma unroll
        for (int sp = 0; sp < 2; ++sp) {
            const float pv[8] = {sa[8 * sp], sa[8 * sp + 1], sa[8 * sp + 2], sa[8 * sp + 3], sa[8 * sp + 4], sa[8 * sp + 5], sa[8 * sp + 6], sa[8 * sp + 7]};
            const LAS unsigned char* p = itl + (32 * st + 16 * sp + 4 * hf) * HG_TL + (32 * dvt + cl) * 2;
            v4u tq; tq.x = lds_u16(p) | (lds_u16(p + HG_TL) << 16); tq.y = lds_u16(p + 2 * HG_TL) | (lds_u16(p + 3 * HG_TL) << 16);
            tq.z = lds_u16(p + 8 * HG_TL) | (lds_u16(p + 9 * HG_TL) << 16); tq.w = lds_u16(p + 10 * HG_TL) | (lds_u16(p + 11 * HG_TL) << 16);
            o = MFMA32(__builtin_bit_cast(bf16x8, tq), pack8(pv), o); }
    }
    { bf16x8 sf[8];
#pragma unroll
      for (int kk = 0; kk < 8; ++kk) sf[kk] = *(const GAS bf16x8*)(strow + 16 * kk);
#pragma unroll
      for (int kk = 0; kk < 8; ++kk) { const int d0 = 16 * kk + 8 * hf;
          const v4u qv = qg[kk];
          const f32x4 b0 = *(const LAS f32x4*)(bt + t * HG_BS + d0), b1 = *(const LAS f32x4*)(bt + t * HG_BS + d0 + 4);
          float ve[8] = {bflo(qv.x) * __expf(b0.x), bfhi(qv.x) * __expf(b0.y), bflo(qv.y) * __expf(b0.z), bfhi(qv.y) * __expf(b0.w), bflo(qv.z) * __expf(b1.x), bfhi(qv.z) * __expf(b1.y), bflo(qv.w) * __expf(b1.z), bfhi(qv.w) * __expf(b1.w)};
          o = MFMA32(sf[kk], pack8(ve), o); } }
    float ss = 0.f;
#pragma unroll
    for (int r = 0; r < 16; ++r) ss += o[r] * o[r];
    ss += xor32f(ss, hf);
    if (hf == 0) red[(tt * 4 + dvt) * 32 + cl] = ss;
    __syncthreads();
    const float rstd = __builtin_amdgcn_rsqf(((red[(tt * 4 + 0) * 32 + cl] + red[(tt * 4 + 1) * 32 + cl]) + (red[(tt * 4 + 2) * 32 + cl] + red[(tt * 4 + 3) * 32 + cl])) * (1.0f / 128.0f) + EPS);
#pragma unroll
    for (int g = 0; g < 4; ++g) { const int dv0 = 32 * dvt + 8 * g + 4 * hf; const size_t off = (n0 + t) * 1024 + h * 128 + dv0;
        const unsigned gg = *(const GAS unsigned*)((const unsigned char*)GHG + off); const f32x4 w4 = *(const GAS f32x4*)(nw + dv0);
        const float rq = rstd * (ACT_QS / 255.0f);
        *(GAS unsigned*)((unsigned char*)OUT + off) = pack_i8x4c(o[4 * g] * rq * w4.x * (float)(gg & 255u), o[4 * g + 1] * rq * w4.y * (float)((gg >> 8) & 255u), o[4 * g + 2] * rq * w4.z * (float)((gg >> 16) & 255u), o[4 * g + 3] * rq * w4.w * (float)(gg >> 24)); }
    __syncthreads();
}
__device__ __forceinline__ void qknorm_rows4(bf16* row0, size_t rstride, const float* w, float scale, int lane) {
    v4u x[4][2];
#pragma unroll
    for (int i = 0; i < 4; ++i)
#pragma unroll
        for (int j = 0; j < 2; ++j) x[i][j] = *(const GAS v4u*)(row0 + i * rstride + 8 * lane + 512 * j);
    const f32x4 wa = *(const GAS f32x4*)(w + ((8 * lane) & 127)), wb = *(const GAS f32x4*)(w + ((8 * lane) & 127) + 4);
#pragma unroll
    for (int i = 0; i < 4; ++i)
#pragma unroll
        for (int j = 0; j < 2; ++j) { const v4u xx = x[i][j];
            float f[8] = {bflo(xx.x), bfhi(xx.x), bflo(xx.y), bfhi(xx.y), bflo(xx.z), bfhi(xx.z), bflo(xx.w), bfhi(xx.w)};
            float ss = 0.f;
#pragma unroll
            for (int k = 0; k < 8; ++k) ss += f[k] * f[k];
            ss += xorf<1>(ss); ss += xorf<2>(ss); ss += xorf<4>(ss); ss += xorf<8>(ss);
            const float r = __builtin_amdgcn_rsqf(ss * (1.0f / 128.0f) + EPS) * scale;
            v4u o; o.x = pk2c(f[0] * r * wa.x, f[1] * r * wa.y); o.y = pk2c(f[2] * r * wa.z, f[3] * r * wa.w); o.z = pk2c(f[4] * r * wb.x, f[5] * r * wb.y); o.w = pk2c(f[6] * r * wb.z, f[7] * r * wb.w);
            *(GAS v4u*)(row0 + i * rstride + 8 * lane + 512 * j) = o; }
}
__device__ __forceinline__ void vt_item(int item, int lane, const bf16* vsb, bf16* vt, LAS unsigned short* scr) {
    const int db = item & 3, sb = (item >> 2) & 63, bh = item >> 8, b = bh >> 3, h = bh & 7;
    const bf16* src = vsb + ((size_t)b * SEQ + sb * 64) * 1024 + h * 128 + db * 32;
#pragma unroll 4
    for (int i = 0; i < 16; ++i) { const int r = 4 * i + (lane >> 4); *(LAS unsigned*)(scr + r * 34 + 2 * (lane & 15)) = *(const GAS unsigned*)(src + (size_t)r * 1024 + 2 * (lane & 15)); }
    LDS_WAIT();
    const int c = lane & 7, b0 = 16 * (c >> 1) + 4 * (c & 1);
#pragma unroll
    for (int j = 0; j < 4; ++j) { const int d = (lane >> 3) + 8 * j; const LAS unsigned short* s = scr + b0 * 34 + d;
        v4u o; o.x = (unsigned)s[0] | ((unsigned)s[34] << 16); o.y = (unsigned)s[68] | ((unsigned)s[102] << 16); o.z = (unsigned)s[8 * 34] | ((unsigned)s[9 * 34] << 16); o.w = (unsigned)s[10 * 34] | ((unsigned)s[11 * 34] << 16);
        *(GAS v4u*)(vt + ((size_t)bh * 128 + db * 32 + d) * SEQ + sb * 64 + 8 * c) = o; }
    LDS_WAIT();
}

constexpr int AT_BUF = 32768, AT_VOFF = 16384;
__device__ __forceinline__ f32x16 attn_scores(const LAS unsigned char* kt, int krow, int hf, const bf16x8 (&qf)[8]) {
    f32x16 sa;
#pragma unroll
    for (int r = 0; r < 16; ++r) sa[r] = 0.f;
    const LAS unsigned char* kp = kt + krow * 256; const int sw = krow & 15;
#pragma unroll
    for (int kk = 0; kk < 8; ++kk) sa = MFMA32(*(const LAS bf16x8*)(kp + (((2 * kk + hf) ^ sw) << 4)), qf[kk], sa);
    return sa;
}
template <bool DIAG> __device__ __forceinline__ void attn_weights(const f32x16& sa, float& R, int hf, int cl, bf16x8 (&pf)[2]) {
    float om[16];
#pragma unroll
    for (int r = 0; r < 16; ++r) om[r] = __builtin_amdgcn_rcpf(1.0f + __builtin_amdgcn_exp2f(sa[r]));
    if (DIAG) {
#pragma unroll
        for (int r = 0; r < 16; ++r) if (((r & 3) + 8 * (r >> 2) + 4 * hf) >= cl) om[r] = 1.0f;
    }
    float Gs[4], Gp[4];
#pragma unroll
    for (int g = 0; g < 4; ++g) { Gs[g] = (om[4 * g] * om[4 * g + 1]) * (om[4 * g + 2] * om[4 * g + 3]); Gp[g] = xor32f(Gs[g], hf); }
    float tail = R; float w[16];
#pragma unroll
    for (int g = 3; g >= 0; --g) {
        const float c3 = tail * (hf == 0 ? Gp[g] : 1.0f), c2 = c3 * om[4 * g + 3], c1 = c2 * om[4 * g + 2], c0 = c1 * om[4 * g + 1];
        w[4 * g + 3] = c3 - om[4 * g + 3] * c3; w[4 * g + 2] = c2 - om[4 * g + 2] * c2; w[4 * g + 1] = c1 - om[4 * g + 1] * c1; w[4 * g] = c0 - om[4 * g] * c0;
        tail *= Gs[g] * Gp[g];
    }
    R = tail;
#pragma unroll
    for (int sp = 0; sp < 2; ++sp) { v4u t; t.x = pk2c(w[8 * sp], w[8 * sp + 1]); t.y = pk2c(w[8 * sp + 2], w[8 * sp + 3]); t.z = pk2c(w[8 * sp + 4], w[8 * sp + 5]); t.w = pk2c(w[8 * sp + 6], w[8 * sp + 7]); pf[sp] = __builtin_bit_cast(bf16x8, t); }
}
__device__ __forceinline__ void attn_pv(const LAS unsigned char* vt, int sub, int cl, int hf, const bf16x8 (&pf)[2], f32x16 (&o)[4]) {
#pragma unroll
    for (int d = 0; d < 4; ++d) { const int row = 32 * d + cl; const LAS unsigned char* vp = vt + row * 128; const int sw = (row >> 1) & 7;
#pragma unroll
        for (int sp = 0; sp < 2; ++sp) { const int x = 4 * sub + 2 * sp + hf;
            o[d] = MFMA32(*(const LAS bf16x8*)(vp + ((x ^ sw) << 4)), pf[sp], o[d]); } }
}
template <bool LAG> __device__ __forceinline__ void attn_unit(const Ctx& c, int bh, int qb, const bf16* qsb, const bf16* ksb, const bf16* vt, bf16* outb) {
    int lane_ = c.lane; asm volatile("" : "+v"(lane_));
    const int b = bh >> 3, h = bh & 7, lane = lane_, cl = lane & 31, hf = lane >> 5;
    const size_t rb = (size_t)b * SEQ; const int q0w = 256 * qb + 32 * c.wave;
    bf16x8 qf[8];
    { const bf16* qrow = qsb + (rb + q0w + cl) * 1024 + h * 128 + 8 * hf;
#pragma unroll
      for (int kk = 0; kk < 8; ++kk) qf[kk] = *(const GAS bf16x8*)(qrow + 16 * kk); }
    f32x16 o[4];
#pragma unroll
    for (int d = 0; d < 4; ++d)
#pragma unroll
        for (int r = 0; r < 16; ++r) o[d][r] = 0.f;
    float R = 1.0f;
    bf16x8 pd[2]; const LAS unsigned char* vimd = c.lds; int subd = 0; bool pending = false;
    const int kr0 = 8 * c.wave + (lane >> 4), kr1 = kr0 + 4;
    const bf16* kg0 = ksb + (rb + kr0) * 1024 + h * 128 + (((lane & 15) ^ (kr0 & 15)) << 3);
    const bf16* kg1 = ksb + (rb + kr1) * 1024 + h * 128 + (((lane & 15) ^ (kr1 & 15)) << 3);
    const int vr0 = 16 * c.wave + (lane >> 3), vr1 = vr0 + 8;
    const bf16* vg0 = vt + ((size_t)bh * 128 + vr0) * SEQ + (((lane & 7) ^ ((vr0 >> 1) & 7)) << 3);
    const bf16* vg1 = vt + ((size_t)bh * 128 + vr1) * SEQ + (((lane & 7) ^ ((vr1 >> 1) & 7)) << 3);
    LAS unsigned char* dk = c.lds + c.wave * 2048; LAS unsigned char* dv = c.lds + AT_VOFF + c.wave * 2048;
#define AT_DMA(kt_, bi_) do { const int ktt_ = (kt_); LAS unsigned char* bb_ = (LAS unsigned char*)0 + (bi_) * AT_BUF; \
        __builtin_amdgcn_global_load_lds((const unsigned*)(kg0 + (size_t)ktt_ * 64 * 1024), (LAS unsigned*)(dk + (bi_) * AT_BUF), 16, 0, 0); \
        __builtin_amdgcn_global_load_lds((const unsigned*)(kg1 + (size_t)ktt_ * 64 * 1024), (LAS unsigned*)(dk + (bi_) * AT_BUF + 1024), 16, 0, 0); \
        __builtin_amdgcn_global_load_lds((const unsigned*)(vg0 + ktt_ * 64), (LAS unsigned*)(dv + (bi_) * AT_BUF), 16, 0, 0); \
        __builtin_amdgcn_global_load_lds((const unsigned*)(vg1 + ktt_ * 64), (LAS unsigned*)(dv + (bi_) * AT_BUF + 1024), 16, 0, 0); (void)bb_; } while (0)
    const int nkt = 4 * (qb + 1);
    asm volatile("s_waitcnt vmcnt(0)" ::: "memory");
    AT_DMA(nkt - 1, 0); AT_DMA(nkt - 2, 1);
    asm volatile("s_waitcnt vmcnt(4)" ::: "memory"); __builtin_amdgcn_s_barrier(); asm volatile("" ::: "memory");
    int bi = 0;
#pragma unroll 1
    for (int it = 0; it < nkt; ++it) {
        const int kt = nkt - 1 - it;
        const int b2 = (bi + 2) & 3;
        if (it + 2 < nkt) AT_DMA(kt - 2, b2);
        const LAS unsigned char* kim = c.lds + bi * AT_BUF; const LAS unsigned char* vim = kim + AT_VOFF;
        const int rel = q0w - 64 * kt;
        if (rel >= 32) {
            if (LAG) { if (pending) attn_pv(vimd, subd, cl, hf, pd, o);
                const f32x16 s1 = attn_scores(kim, 32 + cl, hf, qf); if (rel == 32) attn_weights<true>(s1, R, hf, cl, pd); else attn_weights<false>(s1, R, hf, cl, pd);
                vimd = vim; subd = 1; pending = true;
            } else { bf16x8 p[2];
                { const f32x16 s1 = attn_scores(kim, 32 + cl, hf, qf); if (rel == 32) attn_weights<true>(s1, R, hf, cl, p); else attn_weights<false>(s1, R, hf, cl, p); }
                attn_pv(vim, 1, cl, hf, p, o); }
        }
        if (rel >= 0) {
            if (LAG) { if (pending) attn_pv(vimd, subd, cl, hf, pd, o);
                const f32x16 s0 = attn_scores(kim, cl, hf, qf); if (rel == 0) attn_weights<true>(s0, R, hf, cl, pd); else attn_weights<false>(s0, R, hf, cl, pd);
                vimd = vim; subd = 0; pending = true;
            } else { bf16x8 p[2];
                { const f32x16 s0 = attn_scores(kim, cl, hf, qf); if (rel == 0) attn_weights<true>(s0, R, hf, cl, p); else attn_weights<false>(s0, R, hf, cl, p); }
                attn_pv(vim, 0, cl, hf, p, o); }
        }
        if (it + 2 < nkt) asm volatile("s_waitcnt vmcnt(4)\n\ts_waitcnt lgkmcnt(0)" ::: "memory"); else asm volatile("s_waitcnt vmcnt(0)\n\ts_waitcnt lgkmcnt(0)" ::: "memory");
        __builtin_amdgcn_s_barrier(); asm volatile("" ::: "memory");
        bi = (bi + 1) & 3;
    }
#undef AT_DMA
    if (LAG && pending) attn_pv(vimd, subd, cl, hf, pd, o);
    bf16* orow = outb + (rb + q0w + cl) * 1024 + h * 128 + 4 * hf;
#pragma unroll
    for (int d = 0; d < 4; ++d)
#pragma unroll
        for (int g = 0; g < 4; ++g) { v2u q; q.x = pk2c(o[d][4 * g], o[d][4 * g + 1]); q.y = pk2c(o[d][4 * g + 2], o[d][4 * g + 3]); *(GAS v2u*)(orow + 32 * d + 8 * g) = q; }
    asm volatile("s_waitcnt vmcnt(0)" ::: "memory"); __builtin_amdgcn_s_barrier(); asm volatile("" ::: "memory");
}
__device__ __forceinline__ void hgpost_row(bf16* row, const bf16* grow, const float* w, int lane) {
#pragma unroll
    for (int j = 0; j < 2; ++j) {
        GAS v4u* p = (GAS v4u*)(row + 8 * lane + 512 * j); const v4u x = *p; const v4u gg = *(const GAS v4u*)(grow + 8 * lane + 512 * j);
        float f[8] = {bflo(x.x), bfhi(x.x), bflo(x.y), bfhi(x.y), bflo(x.z), bfhi(x.z), bflo(x.w), bfhi(x.w)};
        const float g[8] = {bflo(gg.x), bfhi(gg.x), bflo(gg.y), bfhi(gg.y), bflo(gg.z), bfhi(gg.z), bflo(gg.w), bfhi(gg.w)};
        float ss = 0.f;
#pragma unroll
        for (int k = 0; k < 8; ++k) ss += f[k] * f[k];
        ss += xorf<1>(ss); ss += xorf<2>(ss); ss += xorf<4>(ss); ss += xorf<8>(ss);
        const float r = __builtin_amdgcn_rsqf(ss * (1.0f / 128.0f) + EPS);
        const f32x4 wa = *(const GAS f32x4*)(w + ((8 * lane) & 127)), wb = *(const GAS f32x4*)(w + ((8 * lane) & 127) + 4);
        v4u o; o.x = pk2c(f[0] * r * wa.x * g[0], f[1] * r * wa.y * g[1]); o.y = pk2c(f[2] * r * wa.z * g[2], f[3] * r * wa.w * g[3]);
        o.z = pk2c(f[4] * r * wb.x * g[4], f[5] * r * wb.y * g[5]); o.w = pk2c(f[6] * r * wb.z * g[6], f[7] * r * wb.w * g[7]);
        *p = o;
    }
}

template <bool FIRST> struct EpiMerge {
    static constexpr bool PERM = true, AFTER_DRAIN = false;
    const unsigned char* gate; bf16* merged;
    __device__ __forceinline__ float rowscale(int) const { return 1.0f / (ACT_QS * WBR_QS); }
    __device__ __forceinline__ void operator()(const pg8::f32x4 (&acc)[2][2][4][2], const pg8::Unit& u, int wr, int wc, int fr, int fq) const {
        const int row0 = u.pm * 256 + wr * 64 + fr, col0 = u.pn * 256 + wc * 32 + 8 * fq;
#pragma unroll
        for (int ai = 0; ai < 2; ++ai)
#pragma unroll
            for (int m = 0; m < 4; ++m) {
                if (m == 0) asm volatile("" ::: "memory");
#pragma unroll
                for (int bj = 0; bj < 2; ++bj) {
                    const size_t off = (size_t)(row0 + ai * 128 + m * 16) * 2048 + col0 + bj * 128;
                    const v2u g = *(const GAS v2u*)(gate + off); const pg8::f32x4 v0 = acc[ai][bj][m][0], v1 = acc[ai][bj][m][1]; constexpr float k = 1.0f / 255.0f;
                    float r[8] = {(float)(g.x & 255u) * (v0[0] * k), (float)((g.x >> 8) & 255u) * (v0[1] * k), (float)((g.x >> 16) & 255u) * (v0[2] * k), (float)(g.x >> 24) * (v0[3] * k),
                                  (float)(g.y & 255u) * (v1[0] * k), (float)((g.y >> 8) & 255u) * (v1[1] * k), (float)((g.y >> 16) & 255u) * (v1[2] * k), (float)(g.y >> 24) * (v1[3] * k)};
                    if (!FIRST) { const v4u mo = *(const GAS v4u*)(merged + off);
                        r[0] += bflo(mo.x); r[1] += bfhi(mo.x); r[2] += bflo(mo.y); r[3] += bfhi(mo.y); r[4] += bflo(mo.z); r[5] += bfhi(mo.z); r[6] += bflo(mo.w); r[7] += bfhi(mo.w); }
                    v4u w; w.x = pk2c(r[0], r[1]); w.y = pk2c(r[2], r[3]); w.z = pk2c(r[4], r[5]); w.w = pk2c(r[6], r[7]);
                    *(GAS v4u*)(merged + off) = w; }
            }
    }
};
struct EpiStoreBf16 {
    static constexpr bool PERM = true, AFTER_DRAIN = false;
    bf16* out; const float* sa;
    __device__ __forceinline__ float rowscale(int row) const { return ((const GAS float*)sa)[row] * (1.0f / WIN_QS); }
    __device__ __forceinline__ void operator()(const pg8::f32x4 (&acc)[2][2][4][2], const pg8::Unit& u, int wr, int wc, int fr, int fq) const {
        const int row0 = u.pm * 256 + wr * 64 + fr, col0 = u.pn * 256 + wc * 32 + 8 * fq;
#pragma unroll
        for (int ai = 0; ai < 2; ++ai)
#pragma unroll
            for (int m = 0; m < 4; ++m)
#pragma unroll
                for (int bj = 0; bj < 2; ++bj) { const pg8::f32x4 v0 = acc[ai][bj][m][0], v1 = acc[ai][bj][m][1];
                    v4u w; w.x = pk2c(v0[0], v0[1]); w.y = pk2c(v0[2], v0[3]); w.z = pk2c(v1[0], v1[1]); w.w = pk2c(v1[2], v1[3]);
                    *(GAS v4u*)(out + (size_t)(row0 + ai * 128 + m * 16) * 2048 + col0 + bj * 128) = w; }
    }
};
struct EpiResid {
    static constexpr bool PERM = true, AFTER_DRAIN = false;
    const void* xin; bf16* xout; const float* ms; int XIN_BF16;
    __device__ __forceinline__ float rowscale(int row) const { return ((const GAS float*)ms)[row] * (1.0f / WIN_QS); }
    __device__ __forceinline__ void operator()(const pg8::f32x4 (&acc)[2][2][4][2], const pg8::Unit& u, int wr, int wc, int fr, int fq) const {
        const int row0 = u.pm * 256 + wr * 64 + fr, col0 = u.pn * 256 + wc * 32 + 8 * fq;
#pragma unroll
        for (int ai = 0; ai < 2; ++ai)
#pragma unroll
            for (int m = 0; m < 4; ++m)
#pragma unroll
                for (int bj = 0; bj < 2; ++bj) { const size_t off = (size_t)(row0 + ai * 128 + m * 16) * 2048 + col0 + bj * 128;
                    const pg8::f32x4 v0 = acc[ai][bj][m][0], v1 = acc[ai][bj][m][1]; float r[8];
                    if (XIN_BF16) { const v4u x = *(const GAS v4u*)((const bf16*)xin + off);
                        r[0] = v0[0] + bflo(x.x); r[1] = v0[1] + bfhi(x.x); r[2] = v0[2] + bflo(x.y); r[3] = v0[3] + bfhi(x.y); r[4] = v1[0] + bflo(x.z); r[5] = v1[1] + bfhi(x.z); r[6] = v1[2] + bflo(x.w); r[7] = v1[3] + bfhi(x.w); }
                    else { const f32x4 x0 = *(const GAS f32x4*)((const float*)xin + off), x1 = *(const GAS f32x4*)((const float*)xin + off + 4);
                        r[0] = v0[0] + x0.x; r[1] = v0[1] + x0.y; r[2] = v0[2] + x0.z; r[3] = v0[3] + x0.w; r[4] = v1[0] + x1.x; r[5] = v1[1] + x1.y; r[6] = v1[2] + x1.z; r[7] = v1[3] + x1.w; }
                    v4u w; w.x = pk2c(r[0], r[1]); w.y = pk2c(r[2], r[3]); w.z = pk2c(r[4], r[5]); w.w = pk2c(r[6], r[7]);
                    *(GAS v4u*)(xout + off) = w; }
    }
};

__device__ __forceinline__ float rl_f(float v, int l) { return __uint_as_float((unsigned)__builtin_amdgcn_readlane((int)__float_as_uint(v), l)); }
__device__ __forceinline__ void ins16(float (&L)[16], float x) {
#pragma unroll
    for (int i = 0; i < 16; ++i) { const float hi = __builtin_fmaxf(L[i], x); x = __builtin_fminf(L[i], x); L[i] = hi; }
}
#define CE_DESC(a, b) do { const float hi_ = __builtin_fmaxf(a, b), lo_ = __builtin_fminf(a, b); a = hi_; b = lo_; } while (0)
__device__ __forceinline__ void sort16_desc(float (&v)[16]) {
#pragma unroll
    for (int k = 2; k <= 16; k <<= 1)
#pragma unroll
        for (int j = k >> 1; j > 0; j >>= 1)
#pragma unroll
            for (int i = 0; i < 16; ++i) { const int l = i ^ j; if (l > i) { if ((i & k) == 0) CE_DESC(v[i], v[l]); else CE_DESC(v[l], v[i]); } }
}
__device__ __forceinline__ void bitonic_merge16_desc(float (&v)[16]) {
#pragma unroll
    for (int j = 8; j > 0; j >>= 1)
#pragma unroll
        for (int i = 0; i < 16; ++i) { const int l = i ^ j; if (l > i) CE_DESC(v[i], v[l]); }
}
__device__ __forceinline__ void top16_merge(float (&L)[16], const float (&T)[16]) {
#pragma unroll
    for (int i = 0; i < 16; ++i) L[i] = __builtin_fmaxf(L[i], T[15 - i]);
    bitonic_merge16_desc(L);
}
constexpr int PK_KS = 272;
__device__ __forceinline__ void peer_top16(const bf16* qrow  , const LAS unsigned char* kl  , int hf, float (&L)[16]) {
    bf16x8 qf[8];
#pragma unroll
    for (int kk = 0; kk < 8; ++kk) qf[kk] = *(const GAS bf16x8*)(qrow + 16 * kk);
#pragma unroll 1
    for (int kt = 0; kt < 4; ++kt) {
        f32x16 sa;
#pragma unroll
        for (int r = 0; r < 16; ++r) sa[r] = 0.f;
#pragma unroll
        for (int kk = 0; kk < 8; ++kk) sa = MFMA32(*(const LAS bf16x8*)(kl + kt * 32 * PK_KS + 32 * kk), qf[kk], sa);
        float T[16];
#pragma unroll
        for (int r = 0; r < 16; ++r) { const unsigned idx = (unsigned)(kt * 32 + (r & 3) + 8 * (r >> 2) + 4 * hf); T[r] = __uint_as_float((__float_as_uint(sa[r]) & ~127u) | idx); }
        sort16_desc(T);
        if (kt == 0) {
#pragma unroll
            for (int i = 0; i < 16; ++i) L[i] = T[i];
        } else top16_merge(L, T);
    }
    float P[16];
#pragma unroll
    for (int i = 0; i < 16; ++i) P[i] = xorf<32>(L[i]);
    top16_merge(L, P);
}
__device__ __forceinline__ void peer_select32(int hd, int n0, int lane, const bf16* qpeer, const LAS unsigned char* kl1, const LAS unsigned char* kl2, unsigned char* wsb, LAS unsigned* ldsw) {
    asm volatile("" : "+v"(lane));
    const int c = lane & 31, hf = lane >> 5, n = n0 + c;
    const bf16* qrow = qpeer + (size_t)n * 2048 + hd * 256 + 8 * hf;
    float A[16], B[16];
    peer_top16(qrow, kl1 + c * PK_KS + 16 * hf, hf, A);
    peer_top16(qrow + 128, kl2 + c * PK_KS + 16 * hf, hf, B);
#define PKV(x) __uint_as_float(__float_as_uint(x) & ~127u)
#define PKI(x) ((int)(__float_as_uint(x) & 127u))
    float W[16];
    { float C0[16], C1[16], C2[16], E0 = 0.f, E1 = 0.f; unsigned id = 0;
#pragma unroll
      for (int a = 0; a < 16; ++a)
#pragma unroll
        for (int b = 0; b < 16; ++b) if ((a + 1) * (b + 1) <= 16) { const float pk = __uint_as_float((__float_as_uint(PKV(A[a]) + PKV(B[b])) & ~63u) | id);
            if (id < 16) C0[id] = pk; else if (id < 32) C1[id - 16] = pk; else if (id < 48) C2[id - 32] = pk; else if (id == 48) E0 = pk; else E1 = pk;
            ++id; }
      sort16_desc(C0); sort16_desc(C1); sort16_desc(C2);
      top16_merge(C0, C1); top16_merge(C0, C2);
#pragma unroll
      for (int i = 0; i < 16; ++i) W[i] = C0[i];
      ins16(W, E0); ins16(W, E1); }
    const float thr = W[15], mx = W[0];
    int cnt = 0; float ssum = 0.f;
    LAS int* le = (LAS int*)ldsw + c * 16; LAS float* lg = (LAS float*)ldsw + 512 + c * 16;
    { unsigned id = 0;
#pragma unroll
      for (int a = 0; a < 16; ++a)
#pragma unroll
        for (int b = 0; b < 16; ++b) if ((a + 1) * (b + 1) <= 16) {
            const float cv = PKV(A[a]) + PKV(B[b]); const float pk = __uint_as_float((__float_as_uint(cv) & ~63u) | id); ++id;
            if (pk >= thr) { const float e = __expf(cv - mx); if (hf == 0) { le[cnt] = PKI(A[a]) * 128 + PKI(B[b]); lg[cnt] = e; } ssum += e; ++cnt; }
        } }
    LDS_WAIT();
    asm volatile("" : "+s"(wsb));
    int* sel_e = (int*)(wsb + WS_SEL); float* sel_g = (float*)(wsb + WS_SEL + 8 * MiB); float* sel_s = (float*)(wsb + WS_SELS);
    { int lane3 = lane; asm volatile("" : "+v"(lane3)); const int t = lane3 >> 1, part = lane3 & 1;
      const v4u e0 = *(const LAS v4u*)((LAS int*)ldsw + t * 16 + 8 * part), e1 = *(const LAS v4u*)((LAS int*)ldsw + t * 16 + 8 * part + 4);
      const v4u g0 = *(const LAS v4u*)((LAS int*)ldsw + 512 + t * 16 + 8 * part), g1 = *(const LAS v4u*)((LAS int*)ldsw + 512 + t * 16 + 8 * part + 4);
      GAS v4u* pe = (GAS v4u*)(sel_e + (size_t)(n0 + t) * 128 + hd * 16 + 8 * part); GAS v4u* pg = (GAS v4u*)(sel_g + (size_t)(n0 + t) * 128 + hd * 16 + 8 * part);
      pe[0] = e0; pe[1] = e1; pg[0] = g0; pg[1] = g1; }
    LDS_WAIT();
    { int lane4 = lane; asm volatile("" : "+v"(lane4)); if ((lane4 >> 5) == 0) ((GAS float*)sel_s)[(size_t)(n0 + (lane4 & 31)) * 8 + hd] = ssum; }
}

__device__ __forceinline__ float dot2bf(unsigned a, unsigned b, float acc) {
    return __builtin_amdgcn_fdot2_f32_bf16(__builtin_bit_cast(bf16v2, a), __builtin_bit_cast(bf16v2, b), acc, false);
}
__device__ __forceinline__ float dot8bf(const v4u a, const v4u b, float acc) {
    const unsigned a0 = a.x, a1 = a.y, a2 = a.z, a3 = a.w, b0 = b.x, b1 = b.y, b2 = b.z, b3 = b.w;
    acc = dot2bf(a0, b0, acc); acc = dot2bf(a1, b1, acc); acc = dot2bf(a2, b2, acc); acc = dot2bf(a3, b3, acc);
    return acc;
}
__device__ __forceinline__ void unpack16(const v4u q, float (&f)[16]) {
    const unsigned d0 = q.x, d1 = q.y, d2 = q.z, d3 = q.w;
    f32x2v t;
    t = __builtin_amdgcn_cvt_pk_f32_fp8((int)d0, false); f[0] = t.x; f[1] = t.y; t = __builtin_amdgcn_cvt_pk_f32_fp8((int)d0, true); f[2] = t.x; f[3] = t.y;
    t = __builtin_amdgcn_cvt_pk_f32_fp8((int)d1, false); f[4] = t.x; f[5] = t.y; t = __builtin_amdgcn_cvt_pk_f32_fp8((int)d1, true); f[6] = t.x; f[7] = t.y;
    t = __builtin_amdgcn_cvt_pk_f32_fp8((int)d2, false); f[8] = t.x; f[9] = t.y; t = __builtin_amdgcn_cvt_pk_f32_fp8((int)d2, true); f[10] = t.x; f[11] = t.y;
    t = __builtin_amdgcn_cvt_pk_f32_fp8((int)d3, false); f[12] = t.x; f[13] = t.y; t = __builtin_amdgcn_cvt_pk_f32_fp8((int)d3, true); f[14] = t.x; f[15] = t.y;
}
struct SliceSched { int mode, xcc, rank, nloc; };
__device__ __forceinline__ SliceSched slice_sched_init(const Ctx& c, unsigned* ctl, const XcdBarrier& bar, int use) {
    LAS int* sh = (LAS int*)(c.lds + 1024);
    if (c.tid == 0) {
        int ok = 1; unsigned tot = 0;
        for (int j = 0; j < 16; ++j) { const unsigned n = xb_ld(&bar.bar[XB_XCNT(j)]); tot += n; if ((j < 8) != (n > 0u)) ok = 0; }
        if (tot != (unsigned)c.G) ok = 0;
        const int xcc = (int)xb_xcc_id();
        int rank = 0, nloc = 1;
        if (ok) { nloc = (int)xb_ld(&bar.bar[XB_XCNT(xcc)]); rank = (int)xb_add(&ctl[CW_RANK + (use * 16 + xcc) * 64], 1u); if (rank >= nloc) ok = 0; }
        sh[0] = ok; sh[1] = xcc; sh[2] = rank; sh[3] = nloc;
    }
    __syncthreads();
    SliceSched S; S.mode = sh[0]; S.xcc = sh[1]; S.rank = sh[2]; S.nloc = sh[3];
    __syncthreads();
    return S;
}
__device__ __forceinline__ bool slice_item(const SliceSched& S, const Ctx& c, int i, int& slice, int& tb) {
    if (S.mode) { const int it = S.rank + i * S.nloc; if (it >= 512) return false; slice = S.xcc + 8 * (it >> 8); tb = it & 255; return true; }
    const int it = (int)blockIdx.x + i * c.G; if (it >= 4096) return false; slice = it >> 8; tb = it & 255; return true;
}
__device__ __forceinline__ void unpack16p(const v4u q, f32x2v (&f)[8]) {
    const unsigned d0 = q.x, d1 = q.y, d2 = q.z, d3 = q.w;
    f[0] = __builtin_amdgcn_cvt_pk_f32_fp8((int)d0, false); f[1] = __builtin_amdgcn_cvt_pk_f32_fp8((int)d0, true);
    f[2] = __builtin_amdgcn_cvt_pk_f32_fp8((int)d1, false); f[3] = __builtin_amdgcn_cvt_pk_f32_fp8((int)d1, true);
    f[4] = __builtin_amdgcn_cvt_pk_f32_fp8((int)d2, false); f[5] = __builtin_amdgcn_cvt_pk_f32_fp8((int)d2, true);
    f[6] = __builtin_amdgcn_cvt_pk_f32_fp8((int)d3, false); f[7] = __builtin_amdgcn_cvt_pk_f32_fp8((int)d3, true);
}
__device__ __forceinline__ __amdgpu_buffer_rsrc_t slice_rsrc(const unsigned char* base, size_t slice_off, int bytes);
__device__ __forceinline__ void sddmm_load(__amdgpu_buffer_rsrc_t rs, unsigned cgo, const LAS unsigned* ids16, v4u (&q)[16]) {
    int id[16];
#pragma unroll
    for (int i = 0; i < 4; ++i) { const v4u v = *(const LAS v4u*)(ids16 + 4 * i); id[4 * i] = (int)v.x; id[4 * i + 1] = (int)v.y; id[4 * i + 2] = (int)v.z; id[4 * i + 3] = (int)v.w; }
#pragma unroll
    for (int it = 0; it < 16; ++it) q[it] = __builtin_bit_cast(v4u, __builtin_amdgcn_raw_buffer_load_b128(rs, id[it] + (int)cgo, 0, 0));
}
__device__ __forceinline__ void sddmm_token(const v4u (&qc)[16], const v4u hv, const float hs, int lane, unsigned* dst) {
    const int hq[4] = {(int)hv.x, (int)hv.y, (int)hv.z, (int)hv.w};
    float p[16];
#pragma unroll
    for (int it = 0; it < 16; ++it) { int a = __builtin_amdgcn_sdot4((int)qc[it].x, hq[0], 0, false); a = __builtin_amdgcn_sdot4((int)qc[it].y, hq[1], a, false);
        a = __builtin_amdgcn_sdot4((int)qc[it].z, hq[2], a, false); a = __builtin_amdgcn_sdot4((int)qc[it].w, hq[3], a, false);
        p[it] = (float)a * hs; }
#pragma unroll
    for (int i = 0; i < 8; ++i) { const bool up = (lane & 4) != 0; const float snd = up ? p[i] : p[i + 8], kp = up ? p[i + 8] : p[i]; p[i] = kp + xorf<4>(snd); }
#pragma unroll
    for (int i = 0; i < 4; ++i) { const bool up = (lane & 2) != 0; const float snd = up ? p[i] : p[i + 4], kp = up ? p[i + 4] : p[i]; p[i] = kp + xorf<2>(snd); }
#pragma unroll
    for (int i = 0; i < 2; ++i) { const bool up = (lane & 1) != 0; const float snd = up ? p[i] : p[i + 2], kp = up ? p[i + 2] : p[i]; p[i] = kp + xorf<1>(snd); }
    *(GAS unsigned*)dst = pk2c(p[0], p[1]);
}
__device__ __forceinline__ void peer_sddmm_wave(int t0, int s, int lane, const unsigned char* H8, const float* SA, const unsigned char* UQ, const int* sel_e, float* part, LAS unsigned* ldsw) {
    const int cg = lane & 7, sg = lane >> 3;
#pragma unroll
    for (int j = 0; j < 4; ++j) { const v4u e4 = *(const GAS v4u*)(sel_e + (size_t)t0 * 128 + 4 * (lane + 64 * j)); *(LAS v4u*)(ldsw + 4 * (lane + 64 * j)) = (v4u){e4.x << 7, e4.y << 7, e4.z << 7, e4.w << 7}; }
    LDS_WAIT();
    const __amdgpu_buffer_rsrc_t ubase = slice_rsrc(UQ, (size_t)__builtin_amdgcn_readfirstlane(s) * U8_SLICE, (int)U8_SLICE); const unsigned cgo = (unsigned)cg * 16u;
    const LAS unsigned* idl = ldsw + sg * 16;
    const unsigned char* hbase = H8 + (size_t)t0 * 2048 + s * 128 + cg * 16;
    unsigned* pbase = (unsigned*)part + ((size_t)t0 * 16 + s) * 64 + lane;
    v4u qa[16], qb[16];
    v4u ha = *(const GAS v4u*)(hbase), hb; float sa = ((const GAS float*)SA)[t0], sb;
    sddmm_load(ubase, cgo, idl, qa);
#pragma unroll
    for (int k = 0; k < 6; k += 2) {
        hb = *(const GAS v4u*)(hbase + (size_t)(k + 1) * 2048); sb = ((const GAS float*)SA)[t0 + k + 1];
        sddmm_load(ubase, cgo, idl + (k + 1) * 128, qb);
        sddmm_token(qa, ha, sa, lane, pbase + (size_t)k * 1024);
        ha = *(const GAS v4u*)(hbase + (size_t)(k + 2) * 2048); sa = ((const GAS float*)SA)[t0 + k + 2];
        sddmm_load(ubase, cgo, idl + (k + 2) * 128, qa);
        sddmm_token(qb, hb, sb, lane, pbase + (size_t)(k + 1) * 1024);
    }
    hb = *(const GAS v4u*)(hbase + (size_t)7 * 2048); sb = ((const GAS float*)SA)[t0 + 7];
    sddmm_load(ubase, cgo, idl + 7 * 128, qb);
    sddmm_token(qa, ha, sa, lane, pbase + (size_t)6 * 1024);
    sddmm_token(qb, hb, sb, lane, pbase + (size_t)7 * 1024);
    LDS_WAIT();
}
__device__ __forceinline__ void peer_coef_tokens4(int t0, int ts, int lane, const float* part, const int* sel_e, float* sel_g, const float* sel_s, const float* US, const float* VS) {
    unsigned pv[4][16]; v2u e[4]; f32x2v g[4]; float dn[4];
#pragma unroll
    for (int i = 0; i < 4; ++i) { const int t = t0 + i * ts;
#pragma unroll
        for (int s = 0; s < 16; ++s) pv[i][s] = ((const GAS unsigned*)part)[((size_t)t * 16 + s) * 64 + lane];
        e[i] = *(const GAS v2u*)(sel_e + (size_t)t * 128 + 2 * lane); g[i] = *(const GAS f32x2v*)(sel_g + (size_t)t * 128 + 2 * lane); dn[i] = ((const GAS float*)sel_s)[(size_t)t * 8 + (lane >> 3)]; }
    float ux[4], uy[4], vx[4], vy[4];
#pragma unroll
    for (int i = 0; i < 4; ++i) { ux[i] = ((const GAS float*)US)[e[i].x]; uy[i] = ((const GAS float*)US)[e[i].y]; vx[i] = ((const GAS float*)VS)[e[i].x]; vy[i] = ((const GAS float*)VS)[e[i].y]; }
#pragma unroll
    for (int i = 0; i < 4; ++i) { const int t = t0 + i * ts; float a0 = 0.f, a1 = 0.f;
#pragma unroll
        for (int s = 0; s < 16; ++s) { a0 += bflo(pv[i][s]); a1 += bfhi(pv[i][s]); }
        const float inv = 1.0f / dn[i];
        const float ox = g[i].x * inv * gelu_exact(a0 * ux[i]) * vx[i], oy = g[i].y * inv * gelu_exact(a1 * uy[i]) * vy[i];
        const h2_t ha = {(_Float16)ox, (_Float16)ox}, hb = {(_Float16)oy, (_Float16)oy};
        *(GAS v2u*)(sel_g + (size_t)t * 128 + 2 * lane) = (v2u){__builtin_bit_cast(unsigned, ha), __builtin_bit_cast(unsigned, hb)}; }
}
__device__ __forceinline__ bool slice_item8(const SliceSched& S, const Ctx& c, int i, int& slice, int& tb) {
    if (S.mode) { const int it = S.rank + i * S.nloc; if (it >= 256) return false; slice = S.xcc; tb = it; return true; }
    const int it = (int)blockIdx.x + i * c.G; if (it >= 2048) return false; slice = it >> 8; tb = it & 255; return true;
}
__device__ __forceinline__ __amdgpu_buffer_rsrc_t slice_rsrc(const unsigned char* base, size_t slice_off, int bytes) {
    const unsigned long long a_ = (unsigned long long)base + slice_off;
    const unsigned long long u_ = ((unsigned long long)(unsigned)__builtin_amdgcn_readfirstlane((int)(a_ >> 32)) << 32) | (unsigned)__builtin_amdgcn_readfirstlane((int)a_);
    return __builtin_amdgcn_make_buffer_rsrc((void*)u_, (short)0, bytes, 0x00020000);
}
template <int MODE = 0>
__device__ __forceinline__ void spmm6_load(__amdgpu_buffer_rsrc_t rs, unsigned cgo, const LAS unsigned* ids8, v4u (&qa)[8], v2u (&qb)[8]) {
    const v4u i0 = *(const LAS v4u*)(ids8), i1 = *(const LAS v4u*)(ids8 + 4);
    const unsigned id[8] = {i0.x, i0.y, i0.z, i0.w, i1.x, i1.y, i1.z, i1.w};
    if constexpr (MODE == 2) {
#pragma unroll
        for (int it = 0; it < 8; ++it) { qa[it] = (v4u){id[it], id[it] + 1u, id[it] + 2u, id[it] + 3u}; qb[it] = (v2u){id[it] + 4u, id[it] + 5u}; }
        return; }
#pragma unroll
    for (int it = 0; it < 8; ++it) { const int o = (int)(id[it] + cgo);
        qa[it] = __builtin_bit_cast(v4u, __builtin_amdgcn_raw_buffer_load_b128(rs, o, 0, 0)); qb[it] = __builtin_bit_cast(v2u, __builtin_amdgcn_raw_buffer_load_b64(rs, o + 16, 0, 0)); }
}
template <int MODE = 0>
__device__ __forceinline__ void spmm6_fma(const v4u (&qa)[8], const v2u (&qb)[8], const LAS unsigned* cf8, h2_t (&y)[16]) {
    const v4u c0 = *(const LAS v4u*)(cf8), c1 = *(const LAS v4u*)(cf8 + 4);
    const unsigned cf[8] = {c0.x, c0.y, c0.z, c0.w, c1.x, c1.y, c1.z, c1.w};
    if constexpr (MODE == 1) {
#pragma unroll
        for (int it = 0; it < 8; ++it) { const unsigned x = (qa[it].x ^ qa[it].y) ^ (qa[it].z ^ qa[it].w) ^ (qb[it].x ^ qb[it].y) ^ cf[it]; y[it] = __builtin_bit_cast(h2_t, __builtin_bit_cast(unsigned, y[it]) ^ x); }
        return; }
    v32h_t f = __builtin_amdgcn_cvt_scalef32_pk32_f16_fp6((v6u){qa[0].x, qa[0].y, qa[0].z, qa[0].w, qb[0].x, qb[0].y}, 1.0f);
#pragma unroll
    for (int it = 0; it < 8; ++it) { v32h_t fn = f;
        if (it < 7) { fn = __builtin_amdgcn_cvt_scalef32_pk32_f16_fp6((v6u){qa[it + 1].x, qa[it + 1].y, qa[it + 1].z, qa[it + 1].w, qb[it + 1].x, qb[it + 1].y}, 1.0f); __builtin_amdgcn_sched_barrier(0); }
        const h2_t c2 = __builtin_bit_cast(h2_t, cf[it]);
#pragma unroll
        for (int j = 0; j < 16; ++j) { const h2_t v = {f[2 * j], f[2 * j + 1]}; y[j] = __builtin_elementwise_fma(v, c2, y[j]); }
        __builtin_amdgcn_sched_barrier(0);
        f = fn; }
}
template <int MODE = 0>
__device__ __forceinline__ void peer_spmm6_wave(int t0, int s, int lane, const unsigned char* V6, const int* sel_e, const float* coef, const bf16* x1, void* xout, int out_f32, LAS unsigned* ldsw) {
    const int cg = lane & 7, sg = lane >> 3;
#pragma unroll
    for (int j = 0; j < 4; ++j) { const v4u e4 = *(const GAS v4u*)(sel_e + (size_t)t0 * 128 + 4 * (lane + 64 * j));
        *(LAS v4u*)(ldsw + 4 * (lane + 64 * j)) = (v4u){e4.x * 192u, e4.y * 192u, e4.z * 192u, e4.w * 192u};
        *(LAS v4u*)(ldsw + 1024 + 4 * (lane + 64 * j)) = *(const GAS v4u*)(coef + (size_t)t0 * 128 + 4 * (lane + 64 * j)); }
    LDS_WAIT();
    const __amdgpu_buffer_rsrc_t vbase = slice_rsrc(V6, (size_t)__builtin_amdgcn_readfirstlane(s) * V6_SLICE, (int)V6_SLICE); const unsigned cgo = (unsigned)cg * 24u;
    const LAS unsigned* idl = ldsw + sg * 16; const LAS unsigned* cfl = ldsw + 1024 + sg * 16;
    v4u qa0[8], qa1[8]; v2u qb0[8], qb1[8];
    spmm6_load<MODE>(vbase, cgo, idl, qa0, qb0);
    const size_t xoff = (size_t)t0 * 2048 + s * 256 + cg * 32 + 4 * sg;
    v2u xn = *(const GAS v2u*)(x1 + xoff);
#pragma unroll
    for (int k = 0; k < 8; ++k) {
        const v2u xv = xn;
        h2_t y[16];
#pragma unroll
        for (int j = 0; j < 16; ++j) y[j] = (h2_t){(_Float16)0.f, (_Float16)0.f};
        spmm6_load<MODE>(vbase, cgo, idl + k * 128 + 8, qa1, qb1);
        if (k < 7) xn = *(const GAS v2u*)(x1 + xoff + (size_t)(k + 1) * 2048);
        spmm6_fma<MODE>(qa0, qb0, cfl + k * 128, y);
        if (k < 7) spmm6_load<MODE>(vbase, cgo, idl + (k + 1) * 128, qa0, qb0);
        spmm6_fma<MODE>(qa1, qb1, cfl + k * 128 + 8, y);
        unsigned u[16];
#pragma unroll
        for (int j = 0; j < 16; ++j) u[j] = __builtin_bit_cast(unsigned, y[j]);
#pragma unroll
        for (int i = 0; i < 8; ++i) { const auto r = __builtin_amdgcn_permlane32_swap(u[i], u[i + 8], false, false); u[i] = __builtin_bit_cast(unsigned, __builtin_bit_cast(h2_t, (unsigned)r[0]) + __builtin_bit_cast(h2_t, (unsigned)r[1])); }
#pragma unroll
        for (int i = 0; i < 4; ++i) { const auto r = __builtin_amdgcn_permlane16_swap(u[i], u[i + 4], false, false); u[i] = __builtin_bit_cast(unsigned, __builtin_bit_cast(h2_t, (unsigned)r[0]) + __builtin_bit_cast(h2_t, (unsigned)r[1])); }
#pragma unroll
        for (int i = 0; i < 2; ++i) { const bool up = (lane & 8) != 0; const unsigned snd = up ? u[i] : u[i + 2], kp = up ? u[i + 2] : u[i]; u[i] = __builtin_bit_cast(unsigned, __builtin_bit_cast(h2_t, kp) + __builtin_bit_cast(h2_t, xoru<8>(snd))); }
        const h2_t r0 = __builtin_bit_cast(h2_t, u[0]), r1 = __builtin_bit_cast(h2_t, u[1]);
        f32x4 o; o.x = bflo(xv.x) + (float)r0[0]; o.y = bfhi(xv.x) + (float)r0[1]; o.z = bflo(xv.y) + (float)r1[0]; o.w = bfhi(xv.y) + (float)r1[1];
        if (out_f32) *(GAS f32x4*)((float*)xout + xoff + (size_t)k * 2048) = o;
        else *(GAS v2u*)((bf16*)xout + xoff + (size_t)k * 2048) = (v2u){pk2c(o.x, o.y), pk2c(o.z, o.w)};
    }
    LDS_WAIT();
}

struct Args { const float* in[21]; float* out; unsigned char* ws; int lo, hi, li, pad; };
__global__ void __launch_bounds__(512, 2) mk_fwd(Args args) {
    extern __shared__ __attribute__((aligned(16))) unsigned char lds_raw[];
    Ctx c; c.lds = (LAS unsigned char*)lds_raw; c.tid = threadIdx.x; c.lane = c.tid & 63; c.wave = __builtin_amdgcn_readfirstlane(c.tid >> 6);
    c.G = gridDim.x; c.gw = blockIdx.x * 8 + c.wave; c.NGW = c.G * 8;
    volatile LAS unsigned* MISC = (volatile LAS unsigned*)(c.lds + MISC_OFF);
    if (c.tid < 32) MISC[c.tid] = 0u;
    __syncthreads();
    unsigned char* ws = args.ws;
    const int lo = args.lo, hi = args.hi;
    XcdBarrier bar; bar.w0 = 0; bar.bar = (unsigned*)(ws + WS_CTL) + CW_BAR + args.li * XCD_BAR_WORDS; bar.x = 0; bar.st = nullptr;
    if (hi - lo > 1) bar = xcd_barrier_post((unsigned*)(ws + WS_CTL) + CW_BAR + args.li * XCD_BAR_WORDS, MISC + 8);
#ifndef ATTN_REPS
#define ATTN_REPS 1
#endif
#ifndef PHMASK
#define PHMASK 0x1fff
#endif
#ifndef REP_PH
#define REP_PH (-1)
#endif
    int rep2 = 2; asm volatile("" : "+s"(rep2));
#define RLOOP(k, cond) for (int rp_ = 0; rp_ < ((((k) == REP_PH) && (cond)) ? rep2 : 1); ++rp_)
#define RSYNC do { if (rp_) xcd_barrier(bar); } while (0)
#define IN(k) (((PHMASK >> ((k) % NPH)) & 1) && lo <= (k) && (k) < hi)
#define SEAM(k) do { if (IN(k) && IN((k) + 1)) xcd_barrier(bar); } while (0)
#define PH_BEGIN unsigned char* w = ws; float* outp = args.out; Ctx cc = c; int zi = 0; cc.lane = xb_lane_id(); cc.tid = cc.wave * 64 + cc.lane; \
    asm volatile("" : "+s"(w), "+s"(outp), "+s"(zi), "+v"(cc.tid), "+v"(cc.lane)); (void)w; (void)outp;
#define INP(k) (args.in[(k) + zi])
#define WSP(T, off) ((T*)(w + (off)))
    for (int l = 0; l < 2; ++l) {
        const int pb = l * NPH;
        if (IN(pb + 0)) { PH_BEGIN
            P0Args a; a.w_in = INP(2) + (size_t)l * DM * INW; a.w_br_sb = INP(11) + (size_t)l * BW * DM; a.w_br_hg = INP(12) + (size_t)l * BW * DM; a.w_br_conv = INP(13) + (size_t)l * BW * DM;
            a.w_o = INP(14) + (size_t)l * DM * DM; a.w_q = INP(16) + (size_t)l * DM * DM; a.u = INP(19) + (size_t)l * 16384 * 2048; a.v = INP(20) + (size_t)l * 16384 * 2048; a.lbp = INP(5);
            a.WinT = WSP(bf16, WS_WIN); a.WbrT = WSP(bf16, WS_WBR); a.WoT = WSP(bf16, WS_WO); a.WqT = WSP(bf16, WS_WQ); a.U = WSP(unsigned char, WS_U); a.V = WSP(unsigned char, WS_V); a.US = WSP(float, WS_US); a.VS = WSP(float, WS_VS); a.LB = WSP(float, WS_LB); a.layer = l; a.k1 = INP(17) + (size_t)l * 8 * 16384; a.k2 = INP(18) + (size_t)l * 8 * 16384; a.KB = WSP(bf16, WS_KEYS);
#ifndef REP_MODE0
#define REP_MODE0 15
#endif
            RLOOP(0, true) { RSYNC;
            int pm_ = 15; if (REP_PH == 0) { pm_ = rp_ ? REP_MODE0 : 15; asm volatile("" : "+s"(pm_)); }
            p0_convert(cc, a, pm_);
            if (pm_ & 8) { if (l == 0) rms_phase_i8(cc, INP(0), INP(1) + (size_t)l * DM, WSP(unsigned char, WS_H), WSP(float, WS_SA));
                           else rms_phase_i8b(cc, WSP(const bf16, WS_X2), INP(1) + (size_t)l * DM, WSP(unsigned char, WS_H), WSP(float, WS_SA)); } }
        }
        SEAM(pb + 0);
        if (IN(pb + 1)) { PH_BEGIN
            RLOOP(1, true) { RSYNC;
            pg8::Gemm g{WSP(bf16, WS_H), WSP(bf16, WS_WIN), NTOK, INW, DM}; pg8::StaticOrder S; S.init(NTOK, INW, cc.G, (int)blockIdx.x);
            EpiIn E{WSP(bf16, WS_SEG), WSP(bf16, WS_GATE), WSP(float, WS_LB), WSP(float, WS_SA)};
            pg8::gemm_phase<EpiIn, pg8::StaticOrder, true, true, true>(cc.lds, g, S, E, cc.wave); }
        }
        SEAM(pb + 1);
        if (IN(pb + 2)) { PH_BEGIN
            bf16* SEG = WSP(bf16, WS_SEG);
#ifndef REP_MODE2
#define REP_MODE2 7
#endif
            RLOOP(2, true) { RSYNC;
            int pm_ = 7; if (REP_PH == 2) { pm_ = rp_ ? REP_MODE2 : 7; asm volatile("" : "+s"(pm_)); }
            if (pm_ & 1)
            conv_phase(cc, SEG + 7 * SEGSZ, INP(7) + (size_t)l * 31 * 1024, INP(8) + (size_t)l * 1024, INP(9) + (size_t)l * 1024, INP(10) + (size_t)l * 1024, WSP(bf16, WS_CONV));
            if (pm_ & 2)
            for (int ci = blockIdx.x, par = 0; ci < 2048; ci += cc.G, par ^= 1) hgA_chunk(cc, ci, ci + cc.G, par, par == 0 && ci == (int)blockIdx.x, SEG + 4 * SEGSZ, SEG + 5 * SEGSZ, WSP(bf16, WS_ST), WSP(float, WS_DEC));
            if (!rp_)
            for (int r = cc.gw; r < 2 * (NTOK / 4); r += cc.NGW) {
                if (r < NTOK / 4) qknorm_rows4(SEG + (size_t)r * 4 * 1024, 1024, INP(3) + (size_t)l * 128, 0.08838834764831845f * 1.4426950408889634f, cc.lane);
                else qknorm_rows4(SEG + SEGSZ + (size_t)(r - NTOK / 4) * 4 * 1024, 1024, INP(4) + (size_t)l * 128, 1.0f, cc.lane);
            }
            LAS unsigned short* scr = (LAS unsigned short*)(cc.lds + 4096 + cc.wave * 8192);
            if (pm_ & 4)
            for (int it = cc.gw; it < 8192; it += cc.NGW) vt_item(it, cc.lane, SEG + 2 * SEGSZ, WSP(bf16, WS_MERGED), scr); }
        }
        SEAM(pb + 2);
        if (IN(pb + 3)) { PH_BEGIN
            bf16* SEG = WSP(bf16, WS_SEG);
            RLOOP(3, true) { RSYNC;
            if (!rp_) hgB(cc, WSP(bf16, WS_ST), WSP(float, WS_DEC));
            for (int p = blockIdx.x; p < 256; p += cc.G) { const int bh = (p & 7) * 4 + (p >> 6), j = (p >> 3) & 7;
                if (cc.wave >= 4) {
#pragma unroll 1
                    for (int u = 0; u < 2; ++u) attn_unit<true>(cc, bh, u ? j : 15 - j, SEG, SEG + SEGSZ, WSP(bf16, WS_MERGED), SEG + 2 * SEGSZ);
                } else {
#pragma unroll 1
                    for (int u = 0; u < 2; ++u) attn_unit<false>(cc, bh, u ? j : 15 - j, SEG, SEG + SEGSZ, WSP(bf16, WS_MERGED), SEG + 2 * SEGSZ);
                } } }
        }
        SEAM(pb + 3);
        if (IN(pb + 4)) { PH_BEGIN
            bf16* SEG = WSP(bf16, WS_SEG);
            RLOOP(4, true) { RSYNC;
            for (int ci = blockIdx.x, par = 0; ci < 2048; ci += cc.G, par ^= 1) hgC_chunk(cc, ci, ci + cc.G, par, par == 0 && ci == (int)blockIdx.x, SEG + 3 * SEGSZ, SEG + 4 * SEGSZ, SEG + 5 * SEGSZ, SEG + 6 * SEGSZ, WSP(bf16, WS_ST), INP(6) + (size_t)l * 128, WSP(bf16, WS_HGR)); }
        }
        SEAM(pb + 4);
        if (IN(pb + 5)) { PH_BEGIN
            RLOOP(5, true) { RSYNC;
            pg8::StaticOrder S; S.init(NTOK, DM, cc.G, (int)blockIdx.x);
            { pg8::Gemm g{WSP(bf16, WS_SEG) + 2 * SEGSZ, WSP(bf16, WS_WBR), NTOK, DM, BW}; EpiMerge<true> E{WSP(unsigned char, WS_GATE), WSP(bf16, WS_MERGED)}; pg8::gemm_phase<EpiMerge<true>, pg8::StaticOrder, true, true>(cc.lds, g, S, E, cc.wave); }
            { pg8::Gemm g{WSP(bf16, WS_HGR), WSP(bf16, WS_WBR) + (size_t)DM * BW, NTOK, DM, BW}; EpiMerge<false> E{WSP(unsigned char, WS_GATE) + (size_t)NTOK * 2048, WSP(bf16, WS_MERGED)}; pg8::gemm_phase<EpiMerge<false>, pg8::StaticOrder, true, true, true>(cc.lds, g, S, E, cc.wave); }
            { pg8::Gemm g{WSP(bf16, WS_CONV), WSP(bf16, WS_WBR) + (size_t)2 * DM * BW, NTOK, DM, BW}; EpiMerge<false> E{WSP(unsigned char, WS_GATE) + (size_t)2 * NTOK * 2048, WSP(bf16, WS_MERGED)}; pg8::gemm_phase<EpiMerge<false>, pg8::StaticOrder, true, true, true>(cc.lds, g, S, E, cc.wave); } }
        }
        SEAM(pb + 5);
        if (IN(pb + 6)) { PH_BEGIN
            RLOOP(6, true) { RSYNC;
            bf16_rows_i8(cc, WSP(bf16, WS_MERGED), WSP(unsigned char, WS_M8), WSP(float, WS_MS));
            xcd_barrier(bar);
            pg8::Gemm g{WSP(bf16, WS_M8), WSP(bf16, WS_WO), NTOK, DM, DM}; pg8::StaticOrder S; S.init(NTOK, DM, cc.G, (int)blockIdx.x);
            EpiResid E{l == 0 ? (const void*)INP(0) : (const void*)WSP(const bf16, WS_X2), WSP(bf16, WS_X1), WSP(float, WS_MS), l};
            pg8::gemm_phase<EpiResid, pg8::StaticOrder, true, true, true>(cc.lds, g, S, E, cc.wave); }
        }
        SEAM(pb + 6);
        if (IN(pb + 7)) { PH_BEGIN RLOOP(7, true) { RSYNC; rms_phase_i8b(cc, WSP(const bf16, WS_X1), INP(15) + (size_t)l * DM, WSP(unsigned char, WS_H), WSP(float, WS_SA)); } }
        SEAM(pb + 7);
        if (IN(pb + 8)) { PH_BEGIN
            RLOOP(8, true) { RSYNC;
            pg8::Gemm g{WSP(bf16, WS_H), WSP(bf16, WS_WQ), NTOK, DM, DM}; pg8::StaticOrder S; S.init(NTOK, DM, cc.G, (int)blockIdx.x);
            EpiStoreBf16 E{WSP(bf16, WS_QPEER), WSP(float, WS_SA)};
            pg8::gemm_phase<EpiStoreBf16, pg8::StaticOrder, true, true, true>(cc.lds, g, S, E, cc.wave); }
        }
        SEAM(pb + 8);
        if (IN(pb + 9)) { PH_BEGIN
            RLOOP(9, true) { RSYNC;
            for (int item = blockIdx.x; item < 512; item += cc.G) { const int hd = item & 7, tg = item >> 3;
                const bf16* KB = WSP(bf16, WS_KEYS); unsigned qo_ = (unsigned)WS_QPEER; asm volatile("" : "+s"(qo_)); const bf16* QP = (const bf16*)(w + qo_);
#pragma unroll
                for (int i = 0; i < 8; ++i) { const int p = cc.tid + 512 * i, li = p >> 11, row = (p >> 4) & 127, c16 = p & 15;
                    *(LAS v4u*)(cc.lds + li * 128 * PK_KS + row * PK_KS + c16 * 16) = *(const GAS v4u*)(KB + (size_t)(li * 8 + hd) * 16384 + row * 128 + c16 * 8); }
                __syncthreads();
                peer_select32(hd, tg * 256 + cc.wave * 32, cc.lane, QP, cc.lds, cc.lds + 128 * PK_KS, w, (LAS unsigned*)(cc.lds + 2 * 128 * PK_KS + cc.wave * 4096));
                __syncthreads(); } }
        }
        SEAM(pb + 9);
        if (IN(pb + 10)) { PH_BEGIN
            const SliceSched SS = slice_sched_init(cc, (unsigned*)(w + WS_CTL), bar, l * 2 + 0);
            RLOOP(10, true) { RSYNC;
            for (int i = 0;; ++i) { int sl, tb; if (!slice_item(SS, cc, i, sl, tb)) break;
                peer_sddmm_wave(tb * 64 + cc.wave * 8, sl, cc.lane, WSP(unsigned char, WS_H), WSP(float, WS_SA), WSP(unsigned char, WS_U), WSP(int, WS_SEL), WSP(float, WS_PART), (LAS unsigned*)(cc.lds + 4096 + cc.wave * 8192)); } }
        }
        SEAM(pb + 10);
        if (IN(pb + 11)) { PH_BEGIN
            for (int n = cc.gw; n < NTOK / 4; n += cc.NGW) peer_coef_tokens4(n, NTOK / 4, cc.lane, WSP(float, WS_PART), WSP(int, WS_SEL), WSP(float, WS_SEL + 8 * MiB), WSP(float, WS_SELS), WSP(float, WS_US), WSP(float, WS_VS));
        }
        SEAM(pb + 11);
        if (IN(pb + 12)) { PH_BEGIN
            void* xo = l == 0 ? (void*)WSP(bf16, WS_X2) : (void*)outp;
            const SliceSched SS = slice_sched_init(cc, (unsigned*)(w + WS_CTL), bar, l * 2 + 1);
            RLOOP(12, l == 0) { RSYNC;
            for (int i = 0;; ++i) { int sl, tb; if (!slice_item8(SS, cc, i, sl, tb)) break;
                peer_spmm6_wave(tb * 64 + cc.wave * 8, sl, cc.lane, WSP(unsigned char, WS_V), WSP(int, WS_SEL), WSP(float, WS_SEL + 8 * MiB), WSP(const bf16, WS_X1), xo, l, (LAS unsigned*)(cc.lds + 4096 + cc.wave * 8192)); } }
        }
        SEAM(pb + 12);
    }
#undef PH_BEGIN
#undef INP
#undef WSP
#undef IN
#undef SEAM
}

#ifndef MK_SPLIT
#define MK_SPLIT 0
#endif
extern "C" void kernel_launch(void* const* d_in, const int* in_sizes, int n_in, void* d_out, int out_size, void* d_ws, size_t ws_size, hipStream_t stream) {
    static int grid = 0;
    if (grid == 0) {
        if (n_in != 21 || out_size != NTOK * DM || ws_size < WS_END) { fprintf(stderr, "kernel_launch: unexpected shapes (n_in %d, out %d, ws %zu < %zu); nothing launched\n", n_in, out_size, ws_size, (size_t)WS_END); grid = -1; return; }
        int dev = 0, cus = 0, per_cu = 0;
        if (hipGetDevice(&dev) != hipSuccess || hipDeviceGetAttribute(&cus, hipDeviceAttributeMultiprocessorCount, dev) != hipSuccess) { grid = -1; return; }
        if (hipFuncSetAttribute((const void*)mk_fwd, hipFuncAttributeMaxDynamicSharedMemorySize, LDS_BYTES) != hipSuccess) { fprintf(stderr, "kernel_launch: hipFuncSetAttribute failed\n"); grid = -1; return; }
        if (hipOccupancyMaxActiveBlocksPerMultiprocessor(&per_cu, (const void*)mk_fwd, 512, LDS_BYTES) != hipSuccess || per_cu < 1) fprintf(stderr, "kernel_launch: occupancy query reports %d\n", per_cu);
        (void)hipGetLastError();
        grid = cus;
    }
    if (grid < 0) return;
    if (hipMemsetAsync((char*)d_ws + WS_CTL, 0, 1 * MiB, stream) != hipSuccess) { fprintf(stderr, "kernel_launch: memset failed\n"); return; }
    Args a{};
    for (int i = 0; i < 21; ++i) a.in[i] = (const float*)d_in[i];
    a.out = (float*)d_out; a.ws = (unsigned char*)d_ws; a.pad = 0;
#if MK_SPLIT
    for (int p = 0; p < NPHASES; ++p) { a.lo = p; a.hi = p + 1; a.li = p; hipLaunchKernelGGL(mk_fwd, dim3(grid), dim3(512), LDS_BYTES, stream, a); }
#else
    a.lo = 0; a.hi = NPHASES; a.li = 0;
    hipLaunchKernelGGL(mk_fwd, dim3(grid), dim3(512), LDS_BYTES, stream, a);
#endif
    const hipError_t le = hipPeekAtLastError();
    if (le != hipSuccess) fprintf(stderr, "kernel_launch: launch failed: %s\n", hipGetErrorName(le));
}
```

```cpp
#include <hip/hip_runtime.h>
#include <cstdio>
#include <cstdint>
namespace pg8 {
#define PG8_LAS __attribute__((address_space(3)))
typedef unsigned short bf16_t;
typedef short bf16x8 __attribute__((ext_vector_type(8)));
typedef float f32x4 __attribute__((ext_vector_type(4)));
typedef unsigned u32x4 __attribute__((ext_vector_type(4)));
constexpr int BM = 256, BK = 64, HALF = 128, HTB = HALF * BK * 2  , STAGE_BYTES = 8 * HTB, NXCD = 8, WGM = 8;

__host__ __device__ __forceinline__ int lds_byte(int r, int c) { const int st = (r >> 4) * 2 + (c >> 5), rr = r & 15, cc = c & 31, ob = rr * 64 + cc * 2; return st * 1024 + (ob ^ (((ob >> 9) & 1) << 5)); }
__host__ __device__ __forceinline__ void stage_rc(int b, int& R, int& C) { const int st = b / 1024, sb = b % 1024, swz = sb ^ (((sb >> 9) & 1) << 5); R = (st >> 1) * 16 + swz / 64; C = (st & 1) * 32 + (swz % 64) / 2; }
__host__ __device__ __forceinline__ int perm32(int rho) { const int n = rho >> 4, i = rho & 15; return 8 * (i >> 2) + 4 * n + (i & 3); }

struct Unit { int pm, pn; };
struct Gemm { const bf16_t* A; const bf16_t* Bt; int M, N, K; };

struct StaticOrder {
    int nM, nN, nwg, G, c, wgm;
    __host__ __device__ void init(int M, int N, int G_, int c_, int wgm_ = WGM) { nM = M / BM; nN = N / BM; nwg = nM * nN; G = G_; c = c_; wgm = wgm_; }
    __host__ __device__ bool next(int i, Unit& u) const {
        const long L = (long)i * G + c; if (L >= nwg) return false;
        int wgid = (int)L; { const int q = nwg / NXCD, r = nwg % NXCD, xcd = wgid % NXCD, off = wgid / NXCD; wgid = (xcd < r ? xcd * (q + 1) : r * (q + 1) + (xcd - r) * q) + off; }
        const int nig = wgm * nN, gid = wgid / nig, fm = gid * wgm, gsz = (nM - fm) < wgm ? (nM - fm) : wgm;
        u.pm = fm + ((wgid % nig) % gsz); u.pn = (wgid % nig) / gsz; return true;
    }
    __device__ __forceinline__ void a_ready(const Unit&) const {}
    __device__ __forceinline__ void done(const Unit&) const {}
};

typedef float f32x2 __attribute__((ext_vector_type(2)));
template <class Epi, class Sched, bool ALIGN_EPI = false, bool SP2 = false, bool I8 = false>
__device__ __forceinline__ void gemm_phase(PG8_LAS unsigned char* lds, const Gemm g, const Sched& S, const Epi& E, int wave_) {
    unsigned z_ = 0u; asm volatile("" : "+s"(z_)); int tid_ = wave_ * 64 + (int)__builtin_amdgcn_mbcnt_hi(~0u, __builtin_amdgcn_mbcnt_lo(~0u, z_)); asm volatile("" : "+v"(tid_));     int K_ = g.K; asm volatile("" : "+s"(K_));
    const int tid = tid_, wid = __builtin_amdgcn_readfirstlane(tid >> 6), lane = tid & 63, wr = wid >> 2, wc = wid & 3, fr = lane & 15, fq = lane >> 4;
    const int K = I8 ? (K_ >> 1) : K_, nt = K / BK;
    unsigned voffA[2], voffB[2];
#pragma unroll
    for (int i = 0; i < 2; ++i) { int R, C; stage_rc(tid * 16 + i * 8192, R, C); const int Rb = Epi::PERM ? ((R & ~31) + perm32(R & 31)) : R;
        voffA[i] = (unsigned)(R * K + C) * 2u; voffB[i] = (unsigned)(Rb * K + C) * 2u; }
    const size_t kstep = (size_t)(BK * 2);
    const size_t hstep = (size_t)HALF * K * 2;
    const size_t tstep = 2 * hstep;
    const unsigned lds_u32_ = (unsigned)(unsigned long long)lds;
    const unsigned ldsw = (unsigned)wid * 1024u;
    const int aoff = lds_byte(wr * 64 + fr, fq * 8), boff = lds_byte(wc * 32 + fr, fq * 8);
#define PG8_SA(b, h) (((b) * 2 + (h)) * HTB)
#define PG8_SB(b, h) ((4 + (b) * 2 + (h)) * HTB)
#define PG8_STAGE(bufoff, gbase, voff) do { _Pragma("unroll") for (int _i = 0; _i < 2; ++_i) { \
        const unsigned m0v_ = lds_u32_ + (unsigned)(bufoff) + ldsw + (unsigned)_i * 8192u; const char* gb_ = (const char*)(gbase); \
        asm volatile("s_mov_b32 m0, %0\n\ts_nop 0\n\tglobal_load_lds_dwordx4 %1, %2" :: "s"(m0v_), "v"((voff)[_i]), "s"(gb_) : "memory", "m0"); } } while (0)
#define PG8_LDA(dst, b, h) do { _Pragma("unroll") for (int m = 0; m < 4; ++m) _Pragma("unroll") for (int k = 0; k < 2; ++k) dst[m][k] = *(const PG8_LAS bf16x8*)(lds + PG8_SA(b, h) + aoff + m * 2048 + k * 1024); } while (0)
#define PG8_LDB(dst, b, h) do { _Pragma("unroll") for (int n = 0; n < 2; ++n) _Pragma("unroll") for (int k = 0; k < 2; ++k) dst[n][k] = *(const PG8_LAS bf16x8*)(lds + PG8_SB(b, h) + boff + n * 2048 + k * 1024); } while (0)
#define PG8_MMA(ai, bj, At, Bt) do { __builtin_amdgcn_s_setprio(1); _Pragma("unroll") for (int m = 0; m < 4; ++m) _Pragma("unroll") for (int n = 0; n < 2; ++n) _Pragma("unroll") for (int k = 0; k < 2; ++k) { \
        if constexpr (I8) { typedef int v4i_t __attribute__((ext_vector_type(4))); \
            acc[ai][bj][m][n] = __builtin_bit_cast(f32x4, __builtin_amdgcn_mfma_i32_16x16x64_i8(__builtin_bit_cast(v4i_t, Bt[n][k]), __builtin_bit_cast(v4i_t, At[m][k]), __builtin_bit_cast(v4i_t, acc[ai][bj][m][n]), 0, 0, 0)); } \
        else acc[ai][bj][m][n] = __builtin_amdgcn_mfma_f32_16x16x32_bf16(Bt[n][k], At[m][k], acc[ai][bj][m][n], 0, 0, 0); } __builtin_amdgcn_s_setprio(0); } while (0)
#define PG8_WAIT_V(n) asm volatile("s_waitcnt vmcnt(" #n ")" ::: "memory")
#define PG8_WAIT_L(n) asm volatile("s_waitcnt lgkmcnt(" #n ")" ::: "memory")
#define PG8_BAR __builtin_amdgcn_s_barrier()
#define PG8_SCHED __builtin_amdgcn_sched_barrier(0)
    Unit cur, nxt; int ui = 0;
    if (!S.next(0, cur)) return;
    cur.pm = __builtin_amdgcn_readfirstlane(cur.pm); cur.pn = __builtin_amdgcn_readfirstlane(cur.pn);
    f32x4 acc[2][2][4][2];
#pragma unroll
    for (int a = 0; a < 2; ++a)
#pragma unroll
        for (int b = 0; b < 2; ++b)
#pragma unroll
            for (int m = 0; m < 4; ++m)
#pragma unroll
                for (int n = 0; n < 2; ++n) acc[a][b][m][n] = (f32x4){0.f, 0.f, 0.f, 0.f};
    bf16x8 At[4][2], B0[2][2], B1[2][2];
    const char* gA_; const char* gB_;
    { const unsigned long long a_ = (unsigned long long)g.A, b_ = (unsigned long long)g.Bt;
      gA_ = (const char*)(((unsigned long long)(unsigned)__builtin_amdgcn_readfirstlane((int)(a_ >> 32)) << 32) | (unsigned)__builtin_amdgcn_readfirstlane((int)a_));
      gB_ = (const char*)(((unsigned long long)(unsigned)__builtin_amdgcn_readfirstlane((int)(b_ >> 32)) << 32) | (unsigned)__builtin_amdgcn_readfirstlane((int)b_)); }
    const char* cA = gA_ + (size_t)cur.pm * tstep; const char* cB = gB_ + (size_t)cur.pn * tstep;
    S.a_ready(cur);
    if constexpr (SP2) {
        PG8_STAGE(PG8_SB(0, 0), cB, voffB); PG8_STAGE(PG8_SB(0, 1), cB + hstep, voffB); PG8_STAGE(PG8_SA(0, 0), cA, voffA); PG8_STAGE(PG8_SA(0, 1), cA + hstep, voffA);
        if (wr == 1) PG8_BAR;
        PG8_WAIT_V(2); PG8_BAR;
        PG8_STAGE(PG8_SB(1, 0), cB + kstep, voffB); PG8_STAGE(PG8_SA(1, 0), cA + kstep, voffA); PG8_STAGE(PG8_SB(1, 1), cB + hstep + kstep, voffB);
        PG8_WAIT_V(6); PG8_BAR;
    } else {
        PG8_STAGE(PG8_SB(0, 0), cB, voffB); PG8_STAGE(PG8_SA(0, 0), cA, voffA); PG8_STAGE(PG8_SB(0, 1), cB + hstep, voffB); PG8_STAGE(PG8_SA(0, 1), cA + hstep, voffA);
        if (wr == 1) PG8_BAR;
        PG8_WAIT_V(4); PG8_BAR;
        PG8_STAGE(PG8_SB(1, 0), cB + kstep, voffB); PG8_STAGE(PG8_SA(1, 0), cA + kstep, voffA); PG8_STAGE(PG8_SB(1, 1), cB + hstep + kstep, voffB);
        PG8_WAIT_V(6); PG8_BAR;
    }
    for (;;) {
        const bool has_next = S.next(ui + 1, nxt);
        nxt.pm = __builtin_amdgcn_readfirstlane(nxt.pm); nxt.pn = __builtin_amdgcn_readfirstlane(nxt.pn);
        const char* nA = has_next ? gA_ + (size_t)nxt.pm * tstep : cA; const char* nB = has_next ? gB_ + (size_t)nxt.pn * tstep : cB;
        for (int t = 0; t < nt; t += 2) {
            const bool last = (t == nt - 2);
            const char* a1 = cA + (size_t)(t + 1) * kstep;
            const char* a2 = last ? nA : cA + (size_t)(t + 2) * kstep; const char* b2 = last ? nB : cB + (size_t)(t + 2) * kstep;
            const char* a3 = a2 + kstep; const char* b3 = b2 + kstep;
            if (last && has_next) S.a_ready(nxt);
            if constexpr (SP2) {
            PG8_LDB(B0, 0, 0); PG8_LDB(B1, 0, 1); PG8_SCHED; PG8_LDA(At, 0, 0); PG8_STAGE(PG8_SA(1, 1), a1 + hstep, voffA);
            PG8_WAIT_V(8); PG8_WAIT_L(0); PG8_BAR; PG8_MMA(0, 0, At, B0); PG8_MMA(0, 1, At, B1); PG8_BAR; PG8_SCHED;
            PG8_LDA(At, 0, 1); PG8_STAGE(PG8_SB(0, 0), b2, voffB); PG8_STAGE(PG8_SB(0, 1), b2 + hstep, voffB); PG8_STAGE(PG8_SA(0, 0), a2, voffA);
            PG8_WAIT_V(8); PG8_WAIT_L(0); PG8_BAR; PG8_MMA(1, 0, At, B0); PG8_MMA(1, 1, At, B1); PG8_BAR; PG8_SCHED;
            PG8_LDB(B0, 1, 0); PG8_LDB(B1, 1, 1); PG8_SCHED; PG8_LDA(At, 1, 0); PG8_STAGE(PG8_SA(0, 1), a2 + hstep, voffA);
            PG8_WAIT_V(8); PG8_WAIT_L(0); PG8_BAR; PG8_MMA(0, 0, At, B0); PG8_MMA(0, 1, At, B1); PG8_BAR; PG8_SCHED;
            PG8_LDA(At, 1, 1); PG8_STAGE(PG8_SB(1, 0), b3, voffB); PG8_STAGE(PG8_SB(1, 1), b3 + hstep, voffB); PG8_STAGE(PG8_SA(1, 0), a3, voffA);
            PG8_WAIT_V(8); PG8_WAIT_L(0); PG8_BAR; PG8_MMA(1, 0, At, B0); PG8_MMA(1, 1, At, B1); PG8_BAR; PG8_SCHED;
            } else {
            PG8_LDB(B0, 0, 0); PG8_SCHED; PG8_LDA(At, 0, 0); PG8_STAGE(PG8_SA(1, 1), a1 + hstep, voffA);
            PG8_WAIT_L(8); PG8_BAR; PG8_WAIT_L(0); PG8_MMA(0, 0, At, B0); PG8_BAR; PG8_SCHED;
            PG8_LDB(B1, 0, 1); PG8_STAGE(PG8_SB(0, 0), b2, voffB);
            PG8_BAR; PG8_WAIT_L(0); PG8_MMA(0, 1, At, B1); PG8_BAR;
            PG8_LDA(At, 0, 1); PG8_STAGE(PG8_SA(0, 0), a2, voffA);
            PG8_BAR; PG8_WAIT_L(0); PG8_MMA(1, 0, At, B0); PG8_BAR; PG8_SCHED;
            PG8_STAGE(PG8_SB(0, 1), b2 + hstep, voffB);
            PG8_WAIT_V(6); PG8_BAR; PG8_MMA(1, 1, At, B1); PG8_BAR;
            PG8_LDB(B0, 1, 0); PG8_SCHED; PG8_LDA(At, 1, 0); PG8_STAGE(PG8_SA(0, 1), a2 + hstep, voffA);
            PG8_WAIT_L(8); PG8_BAR; PG8_WAIT_L(0); PG8_MMA(0, 0, At, B0); PG8_BAR; PG8_SCHED;
            PG8_LDB(B1, 1, 1); PG8_STAGE(PG8_SB(1, 0), b3, voffB);
            PG8_BAR; PG8_WAIT_L(0); PG8_MMA(0, 1, At, B1); PG8_BAR;
            PG8_LDA(At, 1, 1); PG8_STAGE(PG8_SA(1, 0), a3, voffA);
            PG8_BAR; PG8_WAIT_L(0); PG8_MMA(1, 0, At, B0); PG8_BAR; PG8_SCHED;
            PG8_STAGE(PG8_SB(1, 1), b3 + hstep, voffB);
            PG8_WAIT_V(6); PG8_BAR; PG8_MMA(1, 1, At, B1); PG8_BAR;
            }
        }
        if constexpr (ALIGN_EPI) { if (wr == 0) PG8_BAR; }
        if constexpr (I8) {
#pragma unroll
            for (int a = 0; a < 2; ++a)
#pragma unroll
                for (int m = 0; m < 4; ++m) { const float r_ = E.rowscale(cur.pm * BM + wr * 64 + fr + a * HALF + m * 16);
#pragma unroll
                    for (int b = 0; b < 2; ++b)
#pragma unroll
                        for (int n = 0; n < 2; ++n) { typedef int v4i2_t __attribute__((ext_vector_type(4))); const v4i2_t i_ = __builtin_bit_cast(v4i2_t, acc[a][b][m][n]);
                            acc[a][b][m][n] = (f32x4){(float)i_[0] * r_, (float)i_[1] * r_, (float)i_[2] * r_, (float)i_[3] * r_}; } }
        }
        if constexpr (!Epi::AFTER_DRAIN) { E(acc, cur, wr, wc, fr, fq); S.done(cur); }
        if (!has_next) break;
#pragma unroll
        for (int a = 0; a < 2; ++a)
#pragma unroll
            for (int b = 0; b < 2; ++b)
#pragma unroll
                for (int m = 0; m < 4; ++m)
#pragma unroll
                    for (int n = 0; n < 2; ++n) acc[a][b][m][n] = (f32x4){0.f, 0.f, 0.f, 0.f};
        cur = nxt; cA = nA; cB = nB; ++ui;
        if constexpr (ALIGN_EPI) { if (wr == 1) PG8_BAR; }
    }
    PG8_WAIT_V(0);
    if constexpr (!ALIGN_EPI) { if (wr == 0) PG8_BAR; }
    PG8_BAR;
    if constexpr (Epi::AFTER_DRAIN) { E.fused(acc, cur, wr, wc, fr, fq, lds, wid, lane); S.done(cur); }
#undef PG8_SA
#undef PG8_SB
#undef PG8_STAGE
#undef PG8_LDA
#undef PG8_LDB
#undef PG8_MMA
#undef PG8_WAIT_V
#undef PG8_WAIT_L
#undef PG8_BAR
#undef PG8_SCHED
}
}
#define XB_TMO      128
#define XB_XCNT(j)  (256  + 64 * (j))
#define XB_XSUB(j)  (1280 + 64 * (j))
#define XB_XGEN(j)  (2304 + 64 * (j))
#define XB_TOP      3328
#define XB_TOPGEN   3392
#define XCD_BAR_WORDS 3456
#define XB_SPIN_CAP (1u << 24)
#define LAS __attribute__((address_space(3)))

__device__ __forceinline__ unsigned xb_ld(unsigned* p)              { return __hip_atomic_load(p, __ATOMIC_RELAXED, __HIP_MEMORY_SCOPE_AGENT); }
__device__ __forceinline__ unsigned xb_add(unsigned* p, unsigned v) { return __hip_atomic_fetch_add(p, v, __ATOMIC_RELAXED, __HIP_MEMORY_SCOPE_AGENT); }
__device__ __forceinline__ unsigned xb_xcc_id() { return (unsigned)__builtin_amdgcn_s_getreg((3 << 11) | 20) & 0xFu; }
#define XB_SPIN(cond, bar) do { unsigned _sp = 0; while (cond) { __builtin_amdgcn_s_sleep(1); \
    if ((++_sp & 255u) == 0u) { if (xb_ld(&(bar)[XB_TMO])) break; if (_sp > XB_SPIN_CAP) { atomicAdd(&(bar)[XB_TMO], 1u); break; } } } } while (0)

__device__ __forceinline__ int xb_lane_id() { unsigned z = 0u; asm volatile("" : "+s"(z)); return (int)__builtin_amdgcn_mbcnt_hi(~0u, __builtin_amdgcn_mbcnt_lo(~0u, z)); }
struct XcdBarrier {
    unsigned w0;
    unsigned* bar; unsigned x;
    volatile LAS unsigned* st;
};

__device__ __forceinline__ XcdBarrier xcd_barrier_post(unsigned* bar, volatile LAS unsigned* st) {
    XcdBarrier b; b.bar = bar; b.x = xb_xcc_id(); b.st = st; b.w0 = (__builtin_amdgcn_readfirstlane((int)threadIdx.x >> 6) == 0) ? 1u : 0u;
    if (b.w0 && xb_lane_id() == 0) (void)xb_add(&bar[XB_XCNT(b.x)], 1u);
    return b;
}
__device__ __forceinline__ void xcd_barrier_complete(unsigned* bar, unsigned x, unsigned& nloc, unsigned& nx) {
    const unsigned G = gridDim.x * gridDim.y * gridDim.z;
    unsigned sum, cnt, mine, sp = 0u;
    for (;;) {
        sum = 0u; cnt = 0u; mine = 0u;
#pragma unroll
        for (unsigned j = 0; j < 16; ++j) { const unsigned c = xb_ld(&bar[XB_XCNT(j)]); sum += c; cnt += (c > 0u) ? 1u : 0u; mine = (j == x) ? c : mine; }
        if (sum == G) break;
        __builtin_amdgcn_s_sleep(1);
        if ((++sp & 255u) == 0u) { if (xb_ld(&bar[XB_TMO])) break; if (sp > XB_SPIN_CAP) { atomicAdd(&bar[XB_TMO], 1u); break; } }
    }
    nloc = mine > 0u ? mine : 1u; nx = cnt > 0u ? cnt : 1u;
}

__device__ __forceinline__ void xcd_barrier(const XcdBarrier& b) {
    asm volatile("s_waitcnt vmcnt(0)" ::: "memory");
    __syncthreads();
    if (b.w0 && xb_lane_id() == 0) {
        unsigned* bar = b.bar;
        __builtin_amdgcn_s_waitcnt(0);
        unsigned nloc = b.st[0], nx = b.st[1];
        if (nloc == 0u) { xcd_barrier_complete(bar, b.x, nloc, nx); b.st[0] = nloc; b.st[1] = nx; }
        const unsigned old = xb_add(&bar[XB_XSUB(b.x)], 1u);
        const unsigned gen = old / nloc;
        if (old + 1u == (gen + 1u) * nloc) {
            __builtin_amdgcn_fence(__ATOMIC_RELEASE, "agent");
            asm volatile("s_waitcnt vmcnt(0)" ::: "memory");
            const unsigned og = xb_add(&bar[XB_TOP], 1u);
            const unsigned tg = og / nx;
            if (og + 1u == (tg + 1u) * nx) xb_add(&bar[XB_TOPGEN], 1u);
            else XB_SPIN(xb_ld(&bar[XB_TOPGEN]) == tg, bar);
            __builtin_amdgcn_fence(__ATOMIC_ACQUIRE, "agent");
            xb_add(&bar[XB_XGEN(b.x)], 1u);
            asm volatile("s_waitcnt vmcnt(0)" ::: "memory");
        } else {
            XB_SPIN(xb_ld(&bar[XB_XGEN(b.x)]) == gen, bar);
            __builtin_amdgcn_fence(__ATOMIC_ACQUIRE, "agent");
            asm volatile("s_waitcnt vmcnt(0)" ::: "memory");
        }
    }
    __syncthreads();
}


#define GAS __attribute__((address_space(1)))
typedef unsigned short bf16;
typedef unsigned v4u __attribute__((ext_vector_type(4)));
typedef unsigned v2u __attribute__((ext_vector_type(2)));
typedef float f32x4 __attribute__((ext_vector_type(4)));
typedef float f32x2v __attribute__((ext_vector_type(2)));
typedef float f32x16 __attribute__((ext_vector_type(16)));
typedef short bf16x8 __attribute__((ext_vector_type(8)));
typedef __bf16 bf16v2 __attribute__((ext_vector_type(2)));
typedef _Float16 h2_t __attribute__((ext_vector_type(2)));
typedef _Float16 v32h_t __attribute__((ext_vector_type(32)));
typedef unsigned v6u __attribute__((ext_vector_type(6)));

constexpr int NTOK = 16384, DM = 2048, SEQ = 4096, INW = 15360, BW = 1024;
constexpr float EPS = 1e-6f;
#ifndef GEMM_WGM_IN
#define GEMM_WGM_IN 4
#endif
#ifndef GEMM_WGM
#define GEMM_WGM 4
#endif
constexpr float WBR_QS = 768.0f;
constexpr float ACT_QS = 127.0f / 6.0f;
constexpr float WIN_QS = 1024.0f;
constexpr int NPH = 13;
constexpr int NPHASES = 2 * NPH;

constexpr size_t MiB = 1u << 20;
constexpr size_t WS_CTL = 0;
constexpr size_t WS_LB = 1 * MiB;
constexpr size_t WS_SA = 1 * MiB + 192 * 1024;
constexpr size_t WS_US = 1 * MiB + 64 * 1024, WS_VS = 1 * MiB + 128 * 1024;
constexpr size_t WS_WIN = 2 * MiB;
constexpr size_t WS_MS = 1 * MiB + 256 * 1024;
constexpr size_t WS_M8 = 859 * MiB;
constexpr size_t WS_WBR = 62 * MiB;
constexpr size_t WS_WO = 74 * MiB;
constexpr size_t WS_WQ = 82 * MiB;
constexpr size_t WS_U = 91 * MiB;
constexpr size_t WS_V = 155 * MiB;
constexpr size_t WS_H = 219 * MiB;
constexpr size_t WS_SEG = 283 * MiB;
constexpr size_t WS_GATE = 539 * MiB;
constexpr size_t WS_X2 = 731 * MiB;
constexpr size_t WS_X1 = 795 * MiB;
constexpr size_t WS_CONV = 859 * MiB;
constexpr size_t WS_HGR = 891 * MiB;
constexpr size_t WS_MERGED = 923 * MiB;
constexpr size_t WS_SEL = 987 * MiB;
constexpr size_t WS_SELS = 1003 * MiB;
constexpr size_t WS_DEC = 1004 * MiB;
constexpr size_t WS_END = 1005 * MiB;
constexpr size_t WS_ST = WS_H;
constexpr size_t WS_KEYS = 90 * MiB;
constexpr size_t WS_PART = WS_GATE;
constexpr size_t WS_QPEER = WS_SEG;
constexpr size_t SEGSZ = (size_t)NTOK * 1024;
constexpr int CW_BAR = 4096;
constexpr int CW_RANK = 131072;

constexpr int RING_BYTES = 131072, MISC_OFF = RING_BYTES + 320, LDS_BYTES = 147456;

__device__ __forceinline__ unsigned pk2c(float lo, float hi) { f32x2v v = {lo, hi}; bf16v2 b = __builtin_convertvector(v, bf16v2); return __builtin_bit_cast(unsigned, b); }
__device__ __forceinline__ float bflo(unsigned x) { return __uint_as_float(x << 16); }
__device__ __forceinline__ float bfhi(unsigned x) { return __uint_as_float(x & 0xffff0000u); }
__device__ __forceinline__ float sigm(float x) { return __builtin_amdgcn_rcpf(1.0f + __expf(-x)); }
template <int M> __device__ __forceinline__ unsigned xoru(unsigned x) {
    if constexpr (M == 1) return (unsigned)__builtin_amdgcn_update_dpp((int)x, (int)x, 0xB1, 0xF, 0xF, true);
    else if constexpr (M == 2) return (unsigned)__builtin_amdgcn_update_dpp((int)x, (int)x, 0x4E, 0xF, 0xF, true);
    else if constexpr (M == 4) { const int t = __builtin_amdgcn_update_dpp((int)x, (int)x, 0x104, 0xF, 0x5, false);
        return (unsigned)__builtin_amdgcn_update_dpp(t, (int)x, 0x114, 0xF, 0xA, false); }
    else if constexpr (M == 8) return (unsigned)__builtin_amdgcn_update_dpp((int)x, (int)x, 0x128, 0xF, 0xF, true);
    else if constexpr (M == 16) { const auto r = __builtin_amdgcn_permlane16_swap(x, x, false, false); const unsigned l_ = (unsigned)xb_lane_id();     return (l_ & 16u) ? r[0] : r[1]; }
    else { const auto r = __builtin_amdgcn_permlane32_swap(x, x, false, false); const unsigned l_ = (unsigned)xb_lane_id();     return (l_ & 32u) ? r[0] : r[1]; }
}
template <int M> __device__ __forceinline__ float xorf(float x) { return __uint_as_float(xoru<M>(__float_as_uint(x))); }
__device__ __forceinline__ float wave_sum(float v) { v += xorf<1>(v); v += xorf<2>(v); v += xorf<4>(v); v += xorf<8>(v); v += xorf<16>(v); v += xorf<32>(v); return v; }
__device__ __forceinline__ float wave_max(float v) { v = fmaxf(v, xorf<1>(v)); v = fmaxf(v, xorf<2>(v)); v = fmaxf(v, xorf<4>(v)); v = fmaxf(v, xorf<8>(v)); v = fmaxf(v, xorf<16>(v)); v = fmaxf(v, xorf<32>(v)); return v; }
#define LDS_WAIT() asm volatile("s_waitcnt lgkmcnt(0)" ::: "memory")
#define MFMA32(a, b, c) __builtin_amdgcn_mfma_f32_32x32x16_bf16((a), (b), (c), 0, 0, 0)
typedef unsigned v2u_sw __attribute__((ext_vector_type(2)));
__device__ __forceinline__ float xsum32(float a, float b) { const auto r = __builtin_amdgcn_permlane32_swap(__float_as_uint(a), __float_as_uint(b), false, false); return __uint_as_float(r[0]) + __uint_as_float(r[1]); }
__device__ __forceinline__ float xsum16(float a, float b) { const auto r = __builtin_amdgcn_permlane16_swap(__float_as_uint(a), __float_as_uint(b), false, false); return __uint_as_float(r[0]) + __uint_as_float(r[1]); }
__device__ __forceinline__ float xor32f(float x, int hf) { const auto r = __builtin_amdgcn_permlane32_swap(__float_as_uint(x), __float_as_uint(x), false, false); return __uint_as_float(hf ? r[0] : r[1]); }
__device__ __forceinline__ int ridx16(int lane) { return ((lane >> 5) & 1) * 8 + ((lane >> 4) & 1) * 4 + ((lane >> 3) & 1) * 2 + ((lane >> 2) & 1); }
__device__ __forceinline__ void xreduce16(float (&v)[16], int lane) {
#pragma unroll
    for (int i = 0; i < 8; ++i) v[i] = xsum32(v[i], v[i + 8]);
#pragma unroll
    for (int i = 0; i < 4; ++i) v[i] = xsum16(v[i], v[i + 4]);
#pragma unroll
    for (int i = 0; i < 2; ++i) { const bool up = (lane & 8) != 0; const float snd = up ? v[i] : v[i + 2], kp = up ? v[i + 2] : v[i]; v[i] = kp + xorf<8>(snd); }
    { const bool up = (lane & 4) != 0; const float snd = up ? v[0] : v[1], kp = up ? v[1] : v[0]; v[0] = kp + xorf<4>(snd); }
    v[0] += xorf<2>(v[0]); v[0] += xorf<1>(v[0]);
}
__device__ __forceinline__ float gelu_exact(float v) {
    const float av = fabsf(v), t = __builtin_amdgcn_rcpf(av * 0.2316418882f + 1.0f);
    float q = t * 0.5307027145f + (-0.7265760135f); q = q * t + 0.7107068705f; q = q * t + (-0.142248368f); q = q * t + 0.127414796f; q = q * t;
    const float e = __builtin_amdgcn_exp2f((v * v) * (-0.72134752044f));
    const float m = v * (q * e);
    return v < 0.f ? m : v - m;
}

struct Ctx { LAS unsigned char* lds; int tid, lane, wave, G, gw, NGW; };

__device__ __forceinline__ void tr_item(const float* W, int K, int N, bf16* WT, int k0, int n0, int drow0, LAS float* scr, int lane) {
    { const int lr = lane >> 3, lc = (lane & 7) * 4; f32x4 v[8];
#pragma unroll
      for (int j = 0; j < 8; ++j) v[j] = *(const GAS f32x4*)(W + (size_t)(k0 + lr + 8 * j) * N + n0 + lc);
#pragma unroll
      for (int j = 0; j < 8; ++j) { LAS float* d = scr + (lr + 8 * j) * 33 + lc; d[0] = v[j].x; d[1] = v[j].y; d[2] = v[j].z; d[3] = v[j].w; } }
    LDS_WAIT();
    const int c = lane & 7;
#pragma unroll
    for (int j = 0; j < 4; ++j) { const int n = (lane >> 3) + 8 * j; const LAS float* s = scr + (8 * c) * 33 + n;
        v4u o; o.x = pk2c(s[0], s[33]); o.y = pk2c(s[66], s[99]); o.z = pk2c(s[132], s[165]); o.w = pk2c(s[198], s[231]);
        *(GAS v4u*)(WT + (size_t)(drow0 + n) * K + k0 + 8 * c) = o; }
    LDS_WAIT();
}
__device__ __forceinline__ unsigned pack_i8x4c(float a, float b, float c, float d) {
    const int ia = (int)__builtin_rintf(fminf(fmaxf(a, -127.f), 127.f)), ib = (int)__builtin_rintf(fminf(fmaxf(b, -127.f), 127.f)), ic = (int)__builtin_rintf(fminf(fmaxf(c, -127.f), 127.f)), id = (int)__builtin_rintf(fminf(fmaxf(d, -127.f), 127.f));
    return ((unsigned)ia & 255u) | (((unsigned)ib & 255u) << 8) | (((unsigned)ic & 255u) << 16) | ((unsigned)id << 24);
}
__device__ __forceinline__ void tr_item_i8(const float* W, int K, int N, unsigned char* WT, int k0, int n0, int drow0, float scale, LAS float* scr, int lane) {
    { const int lr = lane >> 3, lc = (lane & 7) * 4; f32x4 v[16];
#pragma unroll
      for (int j = 0; j < 16; ++j) v[j] = *(const GAS f32x4*)(W + (size_t)(k0 + lr + 8 * j) * N + n0 + lc);
#pragma unroll
      for (int j = 0; j < 16; ++j) { LAS float* d = scr + (lr + 8 * j) * 32 + (lc ^ ((j & 7) << 2)); const int x = lr & 3; d[x] = v[j].x; d[1 ^ x] = v[j].y; d[2 ^ x] = v[j].z; d[3 ^ x] = v[j].w; } }
    LDS_WAIT();
    const int c = lane & 15;
#pragma unroll
    for (int j = 0; j < 8; ++j) { const int n = (lane >> 4) + 4 * j, q = n ^ ((c & 7) << 2); const LAS float* s = scr + (8 * c) * 32;
        v2u o; o.x = pack_i8x4c(s[q] * scale, s[32 + (q ^ 1)] * scale, s[64 + (q ^ 2)] * scale, s[96 + (q ^ 3)] * scale); o.y = pack_i8x4c(s[128 + q] * scale, s[160 + (q ^ 1)] * scale, s[192 + (q ^ 2)] * scale, s[224 + (q ^ 3)] * scale);
        *(GAS v2u*)(WT + (size_t)(drow0 + n) * K + k0 + 8 * c) = o; }
    LDS_WAIT();
}
__device__ __forceinline__ int win_drow(int n) { if (n < 7168 || n >= 9216) return n; const int r = n - 7168, isb = r >> 10, c = r & 1023; return 7168 + (c >> 7) * 256 + isb * 128 + (c & 127); }
__device__ __forceinline__ void cvt_copy(const Ctx& c, const float* src, bf16* dst, size_t n8) {
    const size_t NT = (size_t)c.G * 512;
    for (size_t i = (size_t)blockIdx.x * 512 + c.tid; i < n8; i += NT) {
        const f32x4 a = ((const GAS f32x4*)src)[2 * i], b = ((const GAS f32x4*)src)[2 * i + 1];
        v4u o; o.x = pk2c(a.x, a.y); o.y = pk2c(a.z, a.w); o.z = pk2c(b.x, b.y); o.w = pk2c(b.z, b.w);
        ((GAS v4u*)dst)[i] = o;
    }
}
__device__ __forceinline__ void rms_row(const float* xr, const float* w, bf16* o, int lane) {
    const GAS f32x4* xp = (const GAS f32x4*)xr + lane; f32x4 v[8]; float s = 0.f;
#pragma unroll
    for (int j = 0; j < 8; ++j) { v[j] = xp[64 * j]; s += (v[j].x * v[j].x + v[j].y * v[j].y) + (v[j].z * v[j].z + v[j].w * v[j].w); }
    const float r = __builtin_amdgcn_rsqf(wave_sum(s) * (1.0f / DM) + EPS);
    const GAS f32x4* wp = (const GAS f32x4*)w + lane; GAS v2u* op = (GAS v2u*)o + lane;
#pragma unroll
    for (int j = 0; j < 8; ++j) { const f32x4 wv = wp[64 * j]; v2u q; q.x = pk2c(v[j].x * r * wv.x, v[j].y * r * wv.y); q.y = pk2c(v[j].z * r * wv.z, v[j].w * r * wv.w); op[64 * j] = q; }
}
__device__ __forceinline__ void rms_row_i8(const float* xr, const float* w, unsigned char* o, float* sa, int lane) {
    const GAS f32x4* xp = (const GAS f32x4*)xr + lane; f32x4 v[8]; float s = 0.f;
#pragma unroll
    for (int j = 0; j < 8; ++j) { v[j] = xp[64 * j]; s += (v[j].x * v[j].x + v[j].y * v[j].y) + (v[j].z * v[j].z + v[j].w * v[j].w); }
    const float r = __builtin_amdgcn_rsqf(wave_sum(s) * (1.0f / DM) + EPS);
    const GAS f32x4* wp = (const GAS f32x4*)w + lane; float m = 0.f;
#pragma unroll
    for (int j = 0; j < 8; ++j) { const f32x4 wv = wp[64 * j]; v[j].x *= r * wv.x; v[j].y *= r * wv.y; v[j].z *= r * wv.z; v[j].w *= r * wv.w;
        m = fmaxf(fmaxf(m, fmaxf(fabsf(v[j].x), fabsf(v[j].y))), fmaxf(fabsf(v[j].z), fabsf(v[j].w))); }
    m = wave_max(m);
    const float inv = m > 0.f ? 127.0f / m : 0.f;
    if (lane == 0) *(GAS float*)sa = m * (1.0f / 127.0f);
#pragma unroll
    for (int j = 0; j < 8; ++j) ((GAS unsigned*)o)[lane + 64 * j] = pack_i8x4c(v[j].x * inv, v[j].y * inv, v[j].z * inv, v[j].w * inv);
}
__device__ __forceinline__ void rms_rows2_i8(const float* xa, const float* xb, const float* w, unsigned char* oa, unsigned char* ob, float* saa, float* sab, int lane) {
    const GAS f32x4* pa = (const GAS f32x4*)xa + lane; const GAS f32x4* pb = (const GAS f32x4*)xb + lane; f32x4 va[8], vb[8]; float s0 = 0.f, s1 = 0.f;
#pragma unroll
    for (int j = 0; j < 8; ++j) { va[j] = pa[64 * j]; vb[j] = pb[64 * j]; }
#pragma unroll
    for (int j = 0; j < 8; ++j) { s0 += (va[j].x * va[j].x + va[j].y * va[j].y) + (va[j].z * va[j].z + va[j].w * va[j].w); s1 += (vb[j].x * vb[j].x + vb[j].y * vb[j].y) + (vb[j].z * vb[j].z + vb[j].w * vb[j].w); }
    s0 = wave_sum(s0); s1 = wave_sum(s1);
    const float r0 = __builtin_amdgcn_rsqf(s0 * (1.0f / DM) + EPS), r1 = __builtin_amdgcn_rsqf(s1 * (1.0f / DM) + EPS);
    const GAS f32x4* wp = (const GAS f32x4*)w + lane; float m0 = 0.f, m1 = 0.f;
#pragma unroll
    for (int j = 0; j < 8; ++j) { const f32x4 wv = wp[64 * j];
        va[j].x *= r0 * wv.x; va[j].y *= r0 * wv.y; va[j].z *= r0 * wv.z; va[j].w *= r0 * wv.w; vb[j].x *= r1 * wv.x; vb[j].y *= r1 * wv.y; vb[j].z *= r1 * wv.z; vb[j].w *= r1 * wv.w;
        m0 = fmaxf(fmaxf(m0, fmaxf(fabsf(va[j].x), fabsf(va[j].y))), fmaxf(fabsf(va[j].z), fabsf(va[j].w))); m1 = fmaxf(fmaxf(m1, fmaxf(fabsf(vb[j].x), fabsf(vb[j].y))), fmaxf(fabsf(vb[j].z), fabsf(vb[j].w))); }
    m0 = wave_max(m0); m1 = wave_max(m1);
    const float i0 = m0 > 0.f ? 127.0f / m0 : 0.f, i1 = m1 > 0.f ? 127.0f / m1 : 0.f;
    if (lane == 0) { *(GAS float*)saa = m0 * (1.0f / 127.0f); *(GAS float*)sab = m1 * (1.0f / 127.0f); }
#pragma unroll
    for (int j = 0; j < 8; ++j) { ((GAS unsigned*)oa)[lane + 64 * j] = pack_i8x4c(va[j].x * i0, va[j].y * i0, va[j].z * i0, va[j].w * i0); ((GAS unsigned*)ob)[lane + 64 * j] = pack_i8x4c(vb[j].x * i1, vb[j].y * i1, vb[j].z * i1, vb[j].w * i1); }
}
__device__ __forceinline__ void rms_rows2_i8b(const bf16* xa, const bf16* xb, const float* w, unsigned char* oa, unsigned char* ob, float* saa, float* sab, int lane) {
    v4u qa[4], qb[4]; float va[4][8], vb[4][8], s0 = 0.f, s1 = 0.f;
#pragma unroll
    for (int j = 0; j < 4; ++j) { qa[j] = *(const GAS v4u*)(xa + 8 * (lane + 64 * j)); qb[j] = *(const GAS v4u*)(xb + 8 * (lane + 64 * j)); }
#pragma unroll
    for (int j = 0; j < 4; ++j) { const unsigned a[4] = {qa[j].x, qa[j].y, qa[j].z, qa[j].w}, b[4] = {qb[j].x, qb[j].y, qb[j].z, qb[j].w};
#pragma unroll
        for (int k = 0; k < 4; ++k) { va[j][2 * k] = bflo(a[k]); va[j][2 * k + 1] = bfhi(a[k]); vb[j][2 * k] = bflo(b[k]); vb[j][2 * k + 1] = bfhi(b[k]); }
#pragma unroll
        for (int k = 0; k < 8; ++k) { s0 += va[j][k] * va[j][k]; s1 += vb[j][k] * vb[j][k]; } }
    s0 = wave_sum(s0); s1 = wave_sum(s1);
    const float r0 = __builtin_amdgcn_rsqf(s0 * (1.0f / DM) + EPS), r1 = __builtin_amdgcn_rsqf(s1 * (1.0f / DM) + EPS);
    float m0 = 0.f, m1 = 0.f;
#pragma unroll
    for (int j = 0; j < 4; ++j) { const f32x4 w0 = *(const GAS f32x4*)(w + 8 * (lane + 64 * j)), w1 = *(const GAS f32x4*)(w + 8 * (lane + 64 * j) + 4); const float ww[8] = {w0.x, w0.y, w0.z, w0.w, w1.x, w1.y, w1.z, w1.w};
#pragma unroll
        for (int k = 0; k < 8; ++k) { va[j][k] *= r0 * ww[k]; vb[j][k] *= r1 * ww[k]; m0 = fmaxf(m0, fabsf(va[j][k])); m1 = fmaxf(m1, fabsf(vb[j][k])); } }
    m0 = wave_max(m0); m1 = wave_max(m1);
    const float i0 = m0 > 0.f ? 127.0f / m0 : 0.f, i1 = m1 > 0.f ? 127.0f / m1 : 0.f;
    if (lane == 0) { *(GAS float*)saa = m0 * (1.0f / 127.0f); *(GAS float*)sab = m1 * (1.0f / 127.0f); }
#pragma unroll
    for (int j = 0; j < 4; ++j) {
        *(GAS v2u*)(oa + 8 * (lane + 64 * j)) = (v2u){pack_i8x4c(va[j][0] * i0, va[j][1] * i0, va[j][2] * i0, va[j][3] * i0), pack_i8x4c(va[j][4] * i0, va[j][5] * i0, va[j][6] * i0, va[j][7] * i0)};
        *(GAS v2u*)(ob + 8 * (lane + 64 * j)) = (v2u){pack_i8x4c(vb[j][0] * i1, vb[j][1] * i1, vb[j][2] * i1, vb[j][3] * i1), pack_i8x4c(vb[j][4] * i1, vb[j][5] * i1, vb[j][6] * i1, vb[j][7] * i1)}; }
}
__device__ __forceinline__ void rms_phase_i8b(const Ctx& c, const bf16* x, const float* w, unsigned char* H8, float* SA) {
    for (int m = c.gw; m < NTOK / 2; m += c.NGW) rms_rows2_i8b(x + (size_t)m * DM, x + (size_t)(m + NTOK / 2) * DM, w, H8 + (size_t)m * DM, H8 + (size_t)(m + NTOK / 2) * DM, SA + m, SA + m + NTOK / 2, c.lane);
}
__device__ __forceinline__ void rms_phase_i8(const Ctx& c, const float* x, const float* w, unsigned char* H8, float* SA) {
    for (int m = c.gw; m < NTOK / 2; m += c.NGW) rms_rows2_i8(x + (size_t)m * DM, x + (size_t)(m + NTOK / 2) * DM, w, H8 + (size_t)m * DM, H8 + (size_t)(m + NTOK / 2) * DM, SA + m, SA + m + NTOK / 2, c.lane);
}
__device__ __forceinline__ void bf16_rows_i8(const Ctx& c, const bf16* X, unsigned char* X8, float* XS) {
    for (int r = c.gw; r < NTOK; r += 4 * c.NGW) { v4u x[4][4];
#pragma unroll
        for (int i = 0; i < 4; ++i) if (r + i * c.NGW < NTOK)
#pragma unroll
            for (int j = 0; j < 4; ++j) x[i][j] = *(const GAS v4u*)(X + (size_t)(r + i * c.NGW) * DM + 8 * (c.lane + 64 * j));
#pragma unroll
        for (int i = 0; i < 4; ++i) if (r + i * c.NGW < NTOK) { const int row = r + i * c.NGW; float m = 0.f;
#pragma unroll
            for (int j = 0; j < 4; ++j) { const v4u q = x[i][j];
                m = fmaxf(m, fmaxf(fmaxf(fmaxf(fabsf(bflo(q.x)), fabsf(bfhi(q.x))), fmaxf(fabsf(bflo(q.y)), fabsf(bfhi(q.y)))), fmaxf(fmaxf(fabsf(bflo(q.z)), fabsf(bfhi(q.z))), fmaxf(fabsf(bflo(q.w)), fabsf(bfhi(q.w)))))); }
            m = wave_max(m);
            const float inv = m > 0.f ? 127.0f / m : 0.f;
            if (c.lane == 0) *(GAS float*)(XS + row) = m * (1.0f / 127.0f);
#pragma unroll
            for (int j = 0; j < 4; ++j) { const v4u q = x[i][j]; v2u o;
                o.x = pack_i8x4c(bflo(q.x) * inv, bfhi(q.x) * inv, bflo(q.y) * inv, bfhi(q.y) * inv); o.y = pack_i8x4c(bflo(q.z) * inv, bfhi(q.z) * inv, bflo(q.w) * inv, bfhi(q.w) * inv);
                *(GAS v2u*)(X8 + (size_t)row * DM + 8 * (c.lane + 64 * j)) = o; } } }
}
__device__ __forceinline__ void rms_rows2(const float* xa, const float* xb, const float* w, bf16* oa, bf16* ob, int lane) {
    const GAS f32x4* pa = (const GAS f32x4*)xa + lane; const GAS f32x4* pb = (const GAS f32x4*)xb + lane; f32x4 va[8], vb[8]; float sa = 0.f, sb = 0.f;
#pragma unroll
    for (int j = 0; j < 8; ++j) { va[j] = pa[64 * j]; vb[j] = pb[64 * j]; }
#pragma unroll
    for (int j = 0; j < 8; ++j) { sa += (va[j].x * va[j].x + va[j].y * va[j].y) + (va[j].z * va[j].z + va[j].w * va[j].w); sb += (vb[j].x * vb[j].x + vb[j].y * vb[j].y) + (vb[j].z * vb[j].z + vb[j].w * vb[j].w); }
    sa = wave_sum(sa); sb = wave_sum(sb);
    const float ra = __builtin_amdgcn_rsqf(sa * (1.0f / DM) + EPS), rb = __builtin_amdgcn_rsqf(sb * (1.0f / DM) + EPS);
    const GAS f32x4* wp = (const GAS f32x4*)w + lane; GAS v2u* qa = (GAS v2u*)oa + lane; GAS v2u* qb = (GAS v2u*)ob + lane;
#pragma unroll
    for (int j = 0; j < 8; ++j) { const f32x4 wv = wp[64 * j];
        v2u q; q.x = pk2c(va[j].x * ra * wv.x, va[j].y * ra * wv.y); q.y = pk2c(va[j].z * ra * wv.z, va[j].w * ra * wv.w); qa[64 * j] = q;
        v2u p; p.x = pk2c(vb[j].x * rb * wv.x, vb[j].y * rb * wv.y); p.y = pk2c(vb[j].z * rb * wv.z, vb[j].w * rb * wv.w); qb[64 * j] = p; }
}
__device__ __forceinline__ void rms_phase(const Ctx& c, const float* x, const float* w, bf16* H) {
    for (int m = c.gw; m < NTOK / 2; m += c.NGW) rms_rows2(x + (size_t)m * DM, x + (size_t)(m + NTOK / 2) * DM, w, H + (size_t)m * DM, H + (size_t)(m + NTOK / 2) * DM, c.lane);
}
__device__ __forceinline__ void fp8_row(const float* src, unsigned char* dst, float* scale_out, int lane) {
    const GAS f32x4* xp = (const GAS f32x4*)src + lane; f32x4 v[8]; float m = 0.f;
#pragma unroll
    for (int j = 0; j < 8; ++j) { v[j] = xp[64 * j]; m = fmaxf(fmaxf(m, fmaxf(fabsf(v[j].x), fabsf(v[j].y))), fmaxf(fabsf(v[j].z), fabsf(v[j].w))); }
    m = wave_max(m);
    const float inv = m > 0.f ? 256.0f / m : 0.f;
    if (lane == 0) *(GAS float*)scale_out = m * (1.0f / 256.0f);
#pragma unroll
    for (int j = 0; j < 8; ++j) { int p = __builtin_amdgcn_cvt_pk_fp8_f32(v[j].x * inv, v[j].y * inv, 0, false); p = __builtin_amdgcn_cvt_pk_fp8_f32(v[j].z * inv, v[j].w * inv, p, true);
        ((GAS unsigned*)dst)[lane + 64 * j] = (unsigned)p; }
}
constexpr size_t U8_SLICE = (size_t)16384 * 128;
__device__ __forceinline__ unsigned pack_i8x4(float a, float b, float c, float d) {
    const int ia = (int)__builtin_rintf(a), ib = (int)__builtin_rintf(b), ic = (int)__builtin_rintf(c), id = (int)__builtin_rintf(d);
    return ((unsigned)ia & 255u) | (((unsigned)ib & 255u) << 8) | (((unsigned)ic & 255u) << 16) | ((unsigned)id << 24);
}
__device__ __forceinline__ void row_load_strided(const float* src, int lane, f32x4 (&v)[8]) { const GAS f32x4* xp = (const GAS f32x4*)src + lane;
#pragma unroll
    for (int j = 0; j < 8; ++j) v[j] = xp[64 * j]; }
__device__ __forceinline__ void row_load_contig(const float* src, int lane, f32x4 (&v)[8]) { const GAS f32x4* xp = (const GAS f32x4*)src + 8 * lane;
#pragma unroll
    for (int j = 0; j < 8; ++j) v[j] = xp[j]; }
__device__ __forceinline__ void i8_row(const f32x4 (&v)[8], unsigned char* dst, float* scale_out, int lane) {
    float m = 0.f;
#pragma unroll
    for (int j = 0; j < 8; ++j) m = fmaxf(fmaxf(m, fmaxf(fabsf(v[j].x), fabsf(v[j].y))), fmaxf(fabsf(v[j].z), fabsf(v[j].w)));
    m = wave_max(m);
    const float inv = m > 0.f ? 127.0f / m : 0.f;
    if (lane == 0) *(GAS float*)scale_out = m * (1.0f / 127.0f);
#pragma unroll
    for (int j = 0; j < 8; ++j) *(GAS unsigned*)(dst + (size_t)(2 * j + (lane >> 5)) * U8_SLICE + 4 * (lane & 31)) = pack_i8x4(v[j].x * inv, v[j].y * inv, v[j].z * inv, v[j].w * inv);
}
constexpr size_t V6_SLICE = (size_t)16384 * 192;
__device__ __forceinline__ void fp6_row(const f32x4 (&v)[8], unsigned char* dst, float* scale_out, int lane) {
    float m = 0.f;
#pragma unroll
    for (int j = 0; j < 8; ++j) m = fmaxf(fmaxf(m, fmaxf(fabsf(v[j].x), fabsf(v[j].y))), fmaxf(fabsf(v[j].z), fabsf(v[j].w)));
    m = wave_max(m);
    const float inv = m > 0.f ? 7.5f / m : 0.f;
    if (lane == 0) *(GAS float*)scale_out = m * (1.0f / 7.5f);
    v32h_t h;
#pragma unroll
    for (int j = 0; j < 8; ++j) { h[4 * j] = (_Float16)(v[j].x * inv); h[4 * j + 1] = (_Float16)(v[j].y * inv); h[4 * j + 2] = (_Float16)(v[j].z * inv); h[4 * j + 3] = (_Float16)(v[j].w * inv); }
    const v6u q = __builtin_amdgcn_cvt_scalef32_pk32_fp6_f16(h, 1.0f);
    GAS v2u* o = (GAS v2u*)(dst + (size_t)(lane >> 3) * V6_SLICE + 24 * (lane & 7));
    o[0] = (v2u){q[0], q[1]}; o[1] = (v2u){q[2], q[3]}; o[2] = (v2u){q[4], q[5]};
}
struct P0Args { const float *w_in, *w_br_sb, *w_br_hg, *w_br_conv, *w_o, *w_q, *u, *v, *lbp; bf16 *WinT, *WbrT, *WoT, *WqT; unsigned char *U, *V; float *US, *VS; float* LB; int layer; const float *k1, *k2; bf16* KB; };
__device__ __forceinline__ void p0_convert(const Ctx& c, const P0Args& a, int parts = 7) {
    LAS float* scr = (LAS float*)(c.lds + c.wave * 16384);
    constexpr int I_IN = (DM / 128) * (INW / 32), I_BR = (BW / 64) * (DM / 32), I_SQ = (DM / 64) * (DM / 32);
    constexpr int I_Q8 = (DM / 128) * (DM / 32);
    constexpr int I_B8 = (BW / 128) * (DM / 32);
    constexpr int NITEMS = I_IN + I_BR + 2 * I_B8 + 2 * I_Q8;
    if (parts & 1)
    for (int it = c.gw; it < NITEMS; it += c.NGW) {
        int r = it;
        if (r < I_IN) { const int kb = r / (INW / 32), nb = r % (INW / 32); tr_item_i8(a.w_in, DM, INW, (unsigned char*)a.WinT, kb * 128, nb * 32, win_drow(nb * 32), WIN_QS, scr, c.lane); continue; } r -= I_IN;
        if (r < I_BR) { const int kb = r / (DM / 32), nb = r % (DM / 32); tr_item(a.w_br_sb, BW, DM, a.WbrT, kb * 64, nb * 32, nb * 32, scr, c.lane); continue; } r -= I_BR;
        if (r < I_B8) { const int kb = r / (DM / 32), nb = r % (DM / 32); tr_item_i8(a.w_br_hg, BW, DM, (unsigned char*)(a.WbrT + (size_t)DM * BW), kb * 128, nb * 32, nb * 32, WBR_QS, scr, c.lane); continue; } r -= I_B8;
        if (r < I_B8) { const int kb = r / (DM / 32), nb = r % (DM / 32); tr_item_i8(a.w_br_conv, BW, DM, (unsigned char*)(a.WbrT + (size_t)2 * DM * BW), kb * 128, nb * 32, nb * 32, WBR_QS, scr, c.lane); continue; } r -= I_B8;
        if (r < I_Q8) { const int kb = r / (DM / 32), nb = r % (DM / 32); tr_item_i8(a.w_o, DM, DM, (unsigned char*)a.WoT, kb * 128, nb * 32, nb * 32, WIN_QS, scr, c.lane); continue; } r -= I_Q8;
        { const int kb = r / (DM / 32), nb = r % (DM / 32); tr_item_i8(a.w_q, DM, DM, (unsigned char*)a.WqT, kb * 128, nb * 32, nb * 32, WIN_QS, scr, c.lane); }
    }
    if (parts & 2)
    {
    for (int r = c.gw; r < 16384; r += 2 * c.NGW) { const int r2 = r + c.NGW; f32x4 va[8], vb[8];
        row_load_strided(a.u + (size_t)r * 2048, c.lane, va); if (r2 < 16384) row_load_strided(a.u + (size_t)r2 * 2048, c.lane, vb);
        i8_row(va, a.U + (size_t)r * 128, a.US + r, c.lane); if (r2 < 16384) i8_row(vb, a.U + (size_t)r2 * 128, a.US + r2, c.lane); }
    for (int r = c.gw; r < 16384; r += 2 * c.NGW) { const int r2 = r + c.NGW; f32x4 va[8], vb[8];
        row_load_contig(a.v + (size_t)r * 2048, c.lane, va); if (r2 < 16384) row_load_contig(a.v + (size_t)r2 * 2048, c.lane, vb);
        fp6_row(va, a.V + (size_t)r * 192, a.VS + r, c.lane); if (r2 < 16384) fp6_row(vb, a.V + (size_t)r2 * 192, a.VS + r2, c.lane); }
    }
    if (parts & 4) {
    cvt_copy(c, a.k1, a.KB, (size_t)8 * 16384 / 8);
    cvt_copy(c, a.k2, a.KB + 8 * 16384, (size_t)8 * 16384 / 8); }
    if (blockIdx.x == 0) for (int i = c.tid; i < 1024; i += 512) a.LB[i] = a.layer == 0 ? 0.f : sigm(a.lbp[1024 + i] - a.lbp[i]);
}

__device__ __forceinline__ unsigned pack_i8x4u(float a, float b, float c, float d) {
    return (unsigned)__builtin_rintf(a) | ((unsigned)__builtin_rintf(b) << 8) | ((unsigned)__builtin_rintf(c) << 16) | ((unsigned)__builtin_rintf(d) << 24);
}
struct EpiIn {
    static constexpr bool PERM = true, AFTER_DRAIN = false;
    bf16* seg; bf16* gate; const float* lb; const float* sa;
    __device__ __forceinline__ float rowscale(int row) const { return ((const GAS float*)sa)[row] * (1.0f / WIN_QS); }
    __device__ __forceinline__ void operator()(const pg8::f32x4 (&acc)[2][2][4][2], const pg8::Unit& u, int wr, int wc, int fr, int fq) const {
        const int pn = u.pn; const int row0 = u.pm * 256 + wr * 64 + fr;
        if (pn >= 28 && pn < 36) {
            bf16* dst = seg + (size_t)7 * SEGSZ; const int col0 = (pn - 28) * 128 + wc * 32 + 8 * fq;
#pragma unroll
            for (int ai = 0; ai < 2; ++ai)
#pragma unroll
                for (int m = 0; m < 4; ++m) {
                    const pg8::f32x4 a0 = acc[ai][0][m][0], a1 = acc[ai][0][m][1], b0 = acc[ai][1][m][0], b1 = acc[ai][1][m][1];
                    v4u w; w.x = pk2c(a0[0] * sigm(b0[0]), a0[1] * sigm(b0[1])); w.y = pk2c(a0[2] * sigm(b0[2]), a0[3] * sigm(b0[3]));
                    w.z = pk2c(a1[0] * sigm(b1[0]), a1[1] * sigm(b1[1])); w.w = pk2c(a1[2] * sigm(b1[2]), a1[3] * sigm(b1[3]));
                    *(GAS v4u*)(dst + (size_t)(row0 + ai * 128 + m * 16) * 1024 + col0) = w; }
            return;
        }
        if (pn >= 24 && pn < 28) {
            unsigned char* g8 = (unsigned char*)(seg + (size_t)6 * SEGSZ); const int c8 = (pn & 3) * 256 + wc * 32 + 8 * fq;
#pragma unroll
            for (int ai = 0; ai < 2; ++ai)
#pragma unroll
                for (int m = 0; m < 4; ++m)
#pragma unroll
                    for (int bj = 0; bj < 2; ++bj) { const pg8::f32x4 v0 = acc[ai][bj][m][0], v1 = acc[ai][bj][m][1];
                        v2u w; w.x = pack_i8x4u(sigm(v0[0]) * 255.0f, sigm(v0[1]) * 255.0f, sigm(v0[2]) * 255.0f, sigm(v0[3]) * 255.0f); w.y = pack_i8x4u(sigm(v1[0]) * 255.0f, sigm(v1[1]) * 255.0f, sigm(v1[2]) * 255.0f, sigm(v1[3]) * 255.0f);
                        *(GAS v2u*)(g8 + (size_t)(row0 + ai * 128 + m * 16) * 1024 + c8 + bj * 128) = w; }
            return; }
        bf16* dst; int ld, colt, mode;
        if (pn < 28) { const int sg = pn >> 2; dst = seg + (size_t)sg * SEGSZ; ld = 1024; colt = (pn & 3) * 256; mode = (sg == 4) ? 2 : 0; }
        else {
            const int q = pn - 36; unsigned char* g8 = (unsigned char*)gate + (size_t)(q >> 3) * ((size_t)NTOK * 2048); const int c8 = (q & 7) * 256 + wc * 32 + 8 * fq;
#pragma unroll
            for (int ai = 0; ai < 2; ++ai)
#pragma unroll
                for (int m = 0; m < 4; ++m)
#pragma unroll
                    for (int bj = 0; bj < 2; ++bj) { const pg8::f32x4 v0 = acc[ai][bj][m][0], v1 = acc[ai][bj][m][1];
                        v2u w; w.x = pack_i8x4u(sigm(v0[0]) * 255.0f, sigm(v0[1]) * 255.0f, sigm(v0[2]) * 255.0f, sigm(v0[3]) * 255.0f); w.y = pack_i8x4u(sigm(v1[0]) * 255.0f, sigm(v1[1]) * 255.0f, sigm(v1[2]) * 255.0f, sigm(v1[3]) * 255.0f);
                        *(GAS v2u*)(g8 + (size_t)(row0 + ai * 128 + m * 16) * 2048 + c8 + bj * 128) = w; }
            return; }
        const int col0 = colt + wc * 32 + 8 * fq;
        if (mode == 0) {
#pragma unroll
            for (int ai = 0; ai < 2; ++ai)
#pragma unroll
                for (int m = 0; m < 4; ++m)
#pragma unroll
                    for (int bj = 0; bj < 2; ++bj) { const pg8::f32x4 v0 = acc[ai][bj][m][0], v1 = acc[ai][bj][m][1];
                        v4u w; w.x = pk2c(v0[0], v0[1]); w.y = pk2c(v0[2], v0[3]); w.z = pk2c(v1[0], v1[1]); w.w = pk2c(v1[2], v1[3]);
                        *(GAS v4u*)(dst + (size_t)(row0 + ai * 128 + m * 16) * ld + col0 + bj * 128) = w; }
        } else if (mode == 1) {
#pragma unroll
            for (int ai = 0; ai < 2; ++ai)
#pragma unroll
                for (int m = 0; m < 4; ++m)
#pragma unroll
                    for (int bj = 0; bj < 2; ++bj) { const pg8::f32x4 v0 = acc[ai][bj][m][0], v1 = acc[ai][bj][m][1];
                        v4u w; w.x = pk2c(sigm(v0[0]), sigm(v0[1])); w.y = pk2c(sigm(v0[2]), sigm(v0[3])); w.z = pk2c(sigm(v1[0]), sigm(v1[1])); w.w = pk2c(sigm(v1[2]), sigm(v1[3]));
                        *(GAS v4u*)(dst + (size_t)(row0 + ai * 128 + m * 16) * ld + col0 + bj * 128) = w; }
        } else {
            f32x4 l0[2], l1[2];
#pragma unroll
            for (int bj = 0; bj < 2; ++bj) { l0[bj] = *(const GAS f32x4*)(lb + col0 + bj * 128); l1[bj] = *(const GAS f32x4*)(lb + col0 + bj * 128 + 4); }
#pragma unroll
            for (int ai = 0; ai < 2; ++ai)
#pragma unroll
                for (int m = 0; m < 4; ++m)
#pragma unroll
                    for (int bj = 0; bj < 2; ++bj) { const pg8::f32x4 v0 = acc[ai][bj][m][0], v1 = acc[ai][bj][m][1]; float r[8];
#pragma unroll
                        for (int j = 0; j < 4; ++j) { r[j] = __logf(l0[bj][j] + (1.0f - l0[bj][j]) * sigm(v0[j])); r[4 + j] = __logf(l1[bj][j] + (1.0f - l1[bj][j]) * sigm(v1[j])); }
                        v4u w; w.x = pk2c(r[0], r[1]); w.y = pk2c(r[2], r[3]); w.z = pk2c(r[4], r[5]); w.w = pk2c(r[6], r[7]);
                        *(GAS v4u*)(dst + (size_t)(row0 + ai * 128 + m * 16) * ld + col0 + bj * 128) = w; }
        }
    }
};

__device__ __forceinline__ void conv_phase(const Ctx& c, const bf16* glu, const float* cw, const float* cb, const float* lnw, const float* lnb, bf16* out) {
    const int c0 = 2 * c.tid;
    float w0[31], w1[31];
#pragma unroll
    for (int j = 0; j < 31; ++j) { const f32x2v t = *(const GAS f32x2v*)(cw + j * 1024 + c0); w0[j] = t.x; w1[j] = t.y; }
    const f32x2v bv = *(const GAS f32x2v*)(cb + c0), lwv = *(const GAS f32x2v*)(lnw + c0), lbv = *(const GAS f32x2v*)(lnb + c0);
    LAS float* red = (LAS float*)c.lds;
    const int per = (NTOK / 8 + c.G - 1) / c.G, tile0 = (int)blockIdx.x * per;
    unsigned win[38];
    if (tile0 < NTOK / 8) {
#pragma unroll
        for (int r = 0; r < 38; ++r) { const int n = tile0 * 8 + r - 30; win[r] = *(const GAS unsigned*)(glu + (size_t)(n > 0 ? n : 0) * 1024 + c0); } }
    for (int ti = 0; ti < per; ++ti) { const int tile = tile0 + ti; if (tile >= NTOK / 8) break;
        const int n0 = tile * 8, tseq0 = n0 & (SEQ - 1);
        const bool more = (ti + 1 < per) && (tile + 1 < NTOK / 8);
        float a0[8], a1[8];
#pragma unroll
        for (int t = 0; t < 8; ++t) { a0[t] = bv.x; a1[t] = bv.y; }
#pragma unroll
        for (int r = 0; r < 38; ++r) {
            const unsigned xv = (tseq0 + r - 30 >= 0) ? win[r] : 0u;
            const float x0 = bflo(xv), x1 = bfhi(xv);
#pragma unroll
            for (int t = 0; t < 8; ++t) { const int j = r - t; if (j >= 0 && j <= 30) { a0[t] += w0[j] * x0; a1[t] += w1[j] * x1; } }
        }
#pragma unroll
        for (int r = 0; r < 30; ++r) win[r] = win[r + 8];
        if (more) {
#pragma unroll
            for (int i = 0; i < 8; ++i) win[30 + i] = *(const GAS unsigned*)(glu + (size_t)(n0 + 8 + i) * 1024 + c0); }
        float st[16];
#pragma unroll
        for (int t = 0; t < 8; ++t) { st[2 * t] = a0[t] + a1[t]; st[2 * t + 1] = a0[t] * a0[t] + a1[t] * a1[t]; }
        xreduce16(st, c.lane);
        if ((c.lane & 3) == 0) red[c.wave * 16 + ridx16(c.lane)] = st[0];
        __syncthreads();
        if (c.tid < 16) { float s = 0.f;
#pragma unroll
            for (int w = 0; w < 8; ++w) s += red[w * 16 + c.tid];
            red[128 + c.tid] = s; }
        __syncthreads();
#pragma unroll
        for (int t = 0; t < 8; ++t) {
            const float mean = red[128 + 2 * t] * (1.0f / 1024.0f), var = red[128 + 2 * t + 1] * (1.0f / 1024.0f) - mean * mean;
            const float rstd = __builtin_amdgcn_rsqf(var + EPS);
            const float h0 = (a0[t] - mean) * rstd * lwv.x + lbv.x, h1 = (a1[t] - mean) * rstd * lwv.y + lbv.y;
            const unsigned q4 = pack_i8x4c(h0 * sigm(h0) * ACT_QS, h1 * sigm(h1) * ACT_QS, 0.f, 0.f);
            *(GAS unsigned short*)((unsigned char*)out + (size_t)(n0 + t) * 1024 + c0) = (unsigned short)q4;
        }
        __syncthreads();
    }
}
__device__ __forceinline__ void hgrn_task(int task, int lane, const bf16* qhg, const bf16* logf, const bf16* ihg, bf16* out) {
    const int bh = task >> 6, dvb = task & 63, b = bh >> 3, h = bh & 7;
    const size_t rb = (size_t)b * SEQ * 1024;
    const GAS unsigned* qp = (const GAS unsigned*)(qhg + rb + h * 128) + lane;
    const GAS unsigned* lp = (const GAS unsigned*)(logf + rb + h * 128) + lane;
    const GAS unsigned* ip = (const GAS unsigned*)(ihg + rb + h * 128) + dvb;
    GAS bf16* op = (GAS bf16*)(out + rb + h * 128 + 2 * dvb);
    float S00 = 0.f, S01 = 0.f, S10 = 0.f, S11 = 0.f;
    unsigned qn[8], ln[8], inx[8];
#pragma unroll
    for (int j = 0; j < 8; ++j) { qn[j] = qp[(size_t)j * 512]; ln[j] = lp[(size_t)j * 512]; inx[j] = ip[(size_t)j * 512]; }
    for (int blk = 0; blk < SEQ / 8; ++blk) {
        unsigned qc[8], lc[8], ic[8];
#pragma unroll
        for (int j = 0; j < 8; ++j) { qc[j] = qn[j]; lc[j] = ln[j]; ic[j] = inx[j]; }
        if (blk + 1 < SEQ / 8) {
#pragma unroll
            for (int j = 0; j < 8; ++j) { const size_t o = (size_t)((blk + 1) * 8 + j) * 512; qn[j] = qp[o]; ln[j] = lp[o]; inx[j] = ip[o]; }
        }
        float pv[16];
#pragma unroll
        for (int j = 0; j < 8; ++j) {
            const float f0 = __expf(bflo(lc[j])), f1 = __expf(bfhi(lc[j])), k0 = 1.0f - f0, k1 = 1.0f - f1;
            const float i0 = bflo(ic[j]), i1 = bfhi(ic[j]), q0 = bflo(qc[j]), q1 = bfhi(qc[j]);
            S00 = f0 * S00 + k0 * i0; S01 = f0 * S01 + k0 * i1; S10 = f1 * S10 + k1 * i0; S11 = f1 * S11 + k1 * i1;
            pv[2 * j] = S00 * q0 + S10 * q1; pv[2 * j + 1] = S01 * q0 + S11 * q1;
        }
        xreduce16(pv, lane);
        if ((lane & 3) == 0) { const int idx = ridx16(lane); op[(size_t)(blk * 8 + (idx >> 1)) * 1024 + (idx & 1)] = (bf16)(pk2c(pv[0], 0.f) & 0xffffu); }
    }
}
constexpr int HG_TS = 272;
constexpr int HG_TL = 256;
constexpr int HG_TILE = 64 * HG_TL;
constexpr int HG_BS = 132;
__device__ __forceinline__ void hg_stage(LAS unsigned char* dst, const bf16* src, int tid) {
#pragma unroll
    for (int i = 0; i < 2; ++i) { const int p = tid + 512 * i, row = p >> 4, c16 = p & 15; *(LAS v4u*)(dst + row * HG_TL + c16 * 16) = *(const GAS v4u*)(src + (size_t)row * 1024 + c16 * 8); }
}
__device__ __forceinline__ void hg_scan(const LAS unsigned char* lft, int dk, int hf, float (&lf)[4][8], float (&b)[4][8], float& bl) {
    float bs[4], pb[4];
#pragma unroll
    for (int kk = 0; kk < 4; ++kk) { float run = 0.f;
#pragma unroll
        for (int j = 0; j < 8; ++j) { lf[kk][j] = __uint_as_float((unsigned)(*(const LAS unsigned short*)(lft + (16 * kk + 8 * hf + j) * HG_TL + dk * 2)) << 16); run += lf[kk][j]; b[kk][j] = run; }
        bs[kk] = run; }
#pragma unroll
    for (int kk = 0; kk < 4; ++kk) pb[kk] = xor32f(bs[kk], hf);
    float pre = 0.f;
#pragma unroll
    for (int kk = 0; kk < 4; ++kk) { const float off = pre + (hf ? pb[kk] : 0.f);
#pragma unroll
        for (int j = 0; j < 8; ++j) b[kk][j] += off;
        pre += bs[kk] + pb[kk]; }
    bl = pre;
}
__device__ __forceinline__ bf16x8 pack8(const float (&v)[8]) { v4u t; t.x = pk2c(v[0], v[1]); t.y = pk2c(v[2], v[3]); t.z = pk2c(v[4], v[5]); t.w = pk2c(v[6], v[7]); return __builtin_bit_cast(bf16x8, t); }
__device__ __forceinline__ unsigned lds_u16(const LAS unsigned char* p) { return (unsigned)(*(const LAS unsigned short*)p); }
__device__ __forceinline__ size_t hg_tile_off(int ci) { const int bh = ci >> 6, ch = ci & 63, bb = bh >> 3, h = bh & 7; return ((size_t)bb * SEQ + ch * 64) * 1024 + h * 128; }
__device__ __forceinline__ void hg_tile_dma(LAS unsigned char* dst, const bf16* src, int wave, int lane) {
    const unsigned long long a_ = (unsigned long long)src;
    const char* sb = (const char*)(((unsigned long long)(unsigned)__builtin_amdgcn_readfirstlane((int)(a_ >> 32)) << 32) | (unsigned)__builtin_amdgcn_readfirstlane((int)a_));
    const unsigned d0 = (unsigned)(unsigned long long)dst + (unsigned)wave * 2048u;
    const unsigned vo = (unsigned)wave * 16384u + (unsigned)(lane >> 4) * 2048u + (unsigned)(lane & 15) * 16u;
#pragma unroll
    for (int i = 0; i < 2; ++i) { const unsigned m0v = d0 + (unsigned)i * 1024u, vv = vo + (unsigned)i * 8192u;
        asm volatile("s_mov_b32 m0, %0\n\ts_nop 0\n\tglobal_load_lds_dwordx4 %1, %2" :: "s"(m0v), "v"(vv), "s"(sb) : "memory", "m0"); }
}
__device__ __forceinline__ void hgA_chunk(const Ctx& c, int ci, int cn, int par, bool first, const bf16* LOGF, const bf16* IHG, bf16* ST, float* DEC) {
    LAS unsigned char* lft = c.lds + par * 2 * HG_TILE; LAS unsigned char* itl = lft + HG_TILE; LAS unsigned char* nxt = c.lds + (par ^ 1) * 2 * HG_TILE;
    if (first) { const size_t o = hg_tile_off(ci); hg_stage(lft, LOGF + o, c.tid); hg_stage(itl, IHG + o, c.tid); }
    asm volatile("s_waitcnt vmcnt(0)" ::: "memory");
    __syncthreads();
    if (cn < 2048) { const size_t o = hg_tile_off(cn); hg_tile_dma(nxt, LOGF + o, c.wave, c.lane); hg_tile_dma(nxt + HG_TILE, IHG + o, c.wave, c.lane); }
    const int dkt = c.wave & 3, dvh = c.wave >> 2, hf = c.lane >> 5, cl = c.lane & 31, dk = 32 * dkt + cl;
    float lf[4][8], b[4][8], bl; hg_scan(lft, dk, hf, lf, b, bl);
    bf16x8 kf[4];
#pragma unroll
    for (int kk = 0; kk < 4; ++kk) { float v[8];
#pragma unroll
        for (int j = 0; j < 8; ++j) v[j] = (1.0f - __expf(lf[kk][j])) * __expf(bl - b[kk][j]);
        kf[kk] = pack8(v); }
    if (dvh == 0 && hf == 0) ((GAS float*)DEC)[(size_t)ci * 128 + dk] = __expf(bl);
#pragma unroll
    for (int dvi = 0; dvi < 2; ++dvi) { const int dvt = dvh * 2 + dvi;
        f32x16 acc;
#pragma unroll
        for (int r = 0; r < 16; ++r) acc[r] = 0.f;
#pragma unroll
        for (int kk = 0; kk < 4; ++kk) { const LAS unsigned char* p = itl + (16 * kk + 8 * hf) * HG_TL + (32 * dvt + cl) * 2;
            v4u t; t.x = lds_u16(p) | (lds_u16(p + HG_TL) << 16); t.y = lds_u16(p + 2 * HG_TL) | (lds_u16(p + 3 * HG_TL) << 16); t.z = lds_u16(p + 4 * HG_TL) | (lds_u16(p + 5 * HG_TL) << 16); t.w = lds_u16(p + 6 * HG_TL) | (lds_u16(p + 7 * HG_TL) << 16);
            acc = MFMA32(kf[kk], __builtin_bit_cast(bf16x8, t), acc); }
        bf16* o = ST + (size_t)ci * 16384 + (size_t)(32 * dvt + cl) * 128 + 32 * dkt + 4 * hf;
#pragma unroll
        for (int g = 0; g < 4; ++g) { v2u q; q.x = pk2c(acc[4 * g], acc[4 * g + 1]); q.y = pk2c(acc[4 * g + 2], acc[4 * g + 3]); *(GAS v2u*)(o + 8 * g) = q; }
    }
    __syncthreads();
}
__device__ __forceinline__ void hgB(const Ctx& c, bf16* ST, const float* DEC) {
    for (int e = blockIdx.x * 512 + c.tid; e < 32 * 4096; e += c.G * 512) {
        const int bh = e >> 12, r = e & 4095, dv = r >> 5, dk4 = (r & 31) * 4;
        GAS v2u* p = (GAS v2u*)(ST + (size_t)bh * 64 * 16384 + (size_t)dv * 128 + dk4);
        const GAS f32x4* d = (const GAS f32x4*)(DEC + (size_t)bh * 64 * 128 + dk4);
        f32x4 S = {0.f, 0.f, 0.f, 0.f};
#pragma unroll
        for (int c0 = 0; c0 < 64; c0 += 8) {
            v2u Lv[8]; f32x4 D[8];
#pragma unroll
            for (int k = 0; k < 8; ++k) { Lv[k] = p[(size_t)(c0 + k) * 4096]; D[k] = d[(size_t)(c0 + k) * 32]; }
#pragma unroll
            for (int k = 0; k < 8; ++k) { v2u o; o.x = pk2c(S.x, S.y); o.y = pk2c(S.z, S.w); p[(size_t)(c0 + k) * 4096] = o;
                S.x = D[k].x * S.x + bflo(Lv[k].x); S.y = D[k].y * S.y + bfhi(Lv[k].x); S.z = D[k].z * S.z + bflo(Lv[k].y); S.w = D[k].w * S.w + bfhi(Lv[k].y); }
        }
    }
}
__device__ __forceinline__ void hgC_chunk(const Ctx& c, int ci, int cn, int par, bool first, const bf16* QHG, const bf16* LOGF, const bf16* IHG, const bf16* GHG, const bf16* ST, const float* nw, bf16* OUT) {
    const int bh = ci >> 6, ch = ci & 63, bb = bh >> 3, h = bh & 7; const size_t n0 = (size_t)bb * SEQ + ch * 64;
    LAS unsigned char* lft = c.lds + par * 2 * HG_TILE; LAS unsigned char* itl = lft + HG_TILE; LAS unsigned char* nxt = c.lds + (par ^ 1) * 2 * HG_TILE;
    LAS float* bt = (LAS float*)(c.lds + 4 * HG_TILE); LAS float* red = bt + 64 * HG_BS;
    LAS unsigned char* ktl = (LAS unsigned char*)(red + 256);
    const int hf = c.lane >> 5, cl = c.lane & 31;
    const int dvt = c.wave & 3, tt = c.wave >> 2, t = 32 * tt + cl;
    const bf16* qrow = QHG + (n0 + t) * 1024 + h * 128 + 8 * hf;
    if (first) { hg_stage(lft, LOGF + n0 * 1024 + h * 128, c.tid); hg_stage(itl, IHG + n0 * 1024 + h * 128, c.tid); }
    asm volatile("s_waitcnt vmcnt(0)" ::: "memory");
    __syncthreads();
    v4u qg[8];
#pragma unroll
    for (int kk = 0; kk < 8; ++kk) qg[kk] = *(const GAS v4u*)(qrow + 16 * kk);
    { const int dk = 32 * (c.wave & 3) + cl; float lf[4][8], b[4][8], bl; hg_scan(lft, dk, hf, lf, b, bl);
#pragma unroll
      for (int q = 0; q < 2; ++q) { const int kk = 2 * (c.wave >> 2) + q;
#pragma unroll
          for (int j = 0; j < 8; ++j) { bt[(16 * kk + 8 * hf + j) * HG_BS + dk] = (c.wave >> 2) ? b[2 + q][j] : b[q][j];
              *(LAS unsigned short*)(ktl + (16 * kk + 8 * hf + j) * HG_TS + dk * 2) = (unsigned short)(pk2c(1.0f - __expf((c.wave >> 2) ? lf[2 + q][j] : lf[q][j]), 0.f) & 0xffffu); } } }
    __syncthreads();
    if (cn < 2048) { const size_t o = hg_tile_off(cn); hg_tile_dma(nxt, LOGF + o, c.wave, c.lane); hg_tile_dma(nxt + HG_TILE, IHG + o, c.wave, c.lane); }
    bf16x8 qm[8];
    const bf16* strow = ST + (size_t)ci * 16384 + (size_t)(32 * dvt + cl) * 128 + 8 * hf;
#pragma unroll
    for (int kk = 0; kk < 8; ++kk) { const int d0 = 16 * kk + 8 * hf;
        const v4u qv = qg[kk];
        const f32x4 b0 = *(const LAS f32x4*)(bt + t * HG_BS + d0), b1 = *(const LAS f32x4*)(bt + t * HG_BS + d0 + 4), m0 = *(const LAS f32x4*)(bt + 31 * HG_BS + d0), m1 = *(const LAS f32x4*)(bt + 31 * HG_BS + d0 + 4);
        const float q[8] = {bflo(qv.x), bfhi(qv.x), bflo(qv.y), bfhi(qv.y), bflo(qv.z), bfhi(qv.z), bflo(qv.w), bfhi(qv.w)};
        const float bv[8] = {b0.x, b0.y, b0.z, b0.w, b1.x, b1.y, b1.z, b1.w}, mv[8] = {m0.x, m0.y, m0.z, m0.w, m1.x, m1.y, m1.z, m1.w};
        float vm[8];
#pragma unroll
        for (int j = 0; j < 8; ++j) vm[j] = q[j] * __expf(bv[j] - mv[j]);
        qm[kk] = pack8(vm); }
    f32x16 o;
#pragma unroll
    for (int r = 0; r < 16; ++r) o[r] = 0.f;
#pragma unroll 1
    for (int st = 0; st <= tt; ++st) {
        const int s = 32 * st + cl;
        f32x16 sa;
#pragma unroll
        for (int r = 0; r < 16; ++r) sa[r] = 0.f;
#pragma unroll
        for (int kk = 0; kk < 8; ++kk) { const int d0 = 16 * kk + 8 * hf;
            asm volatile("" ::: "memory");
            const v4u lv = *(const LAS v4u*)(ktl + s * HG_TS + d0 * 2);
            const f32x4 b0 = *(const LAS f32x4*)(bt + s * HG_BS + d0), b1 = *(const LAS f32x4*)(bt + s * HG_BS + d0 + 4), m0 = *(const LAS f32x4*)(bt + 31 * HG_BS + d0), m1 = *(const LAS f32x4*)(bt + 31 * HG_BS + d0 + 4);
            const float kv[8] = {bflo(lv.x), bfhi(lv.x), bflo(lv.y), bfhi(lv.y), bflo(lv.z), bfhi(lv.z), bflo(lv.w), bfhi(lv.w)};
            const float bv[8] = {b0.x, b0.y, b0.z, b0.w, b1.x, b1.y, b1.z, b1.w}, mv[8] = {m0.x, m0.y, m0.z, m0.w, m1.x, m1.y, m1.z, m1.w};
            float vk[8];
#pragma unroll
            for (int j = 0; j < 8; ++j) vk[j] = kv[j] * __expf(mv[j] - bv[j]);
            sa = MFMA32(pack8(vk), qm[kk], sa); }
        if (st == tt) {
#pragma unroll
            for (int r = 0; r < 16; ++r) if (((r & 3) + 8 * (r >> 2) + 4 * hf) > cl) sa[r] = 0.f;
        }
#pragma unroll
        for (int sp = 0; sp < 2; ++sp) {
            const float pv[8] = {sa[8 * sp], sa[8 * sp + 1], sa[8 * sp + 2], sa[8 * sp + 3], sa[8 * sp + 4], sa[8 * sp + 5], sa[8 * sp + 6], sa[8 * sp + 7]};
            const LAS unsigned char* p = itl + (32 * st + 16 * sp + 4 * hf) * HG_TL + (32 * dvt + cl) * 2;
            v4u tq; tq.x = lds_u16(p) | (lds_u16(p + HG_TL) << 16); tq.y = lds_u16(p + 2 * HG_TL) | (lds_u16(p + 3 * HG_TL) << 16);
            tq.z = lds_u16(p + 8 * HG_TL) | (lds_u16(p + 9 * HG_TL) << 16); tq.w = lds_u16(p + 10 * HG_TL) | (lds_u16(p + 11 * HG_TL) << 16);
            o = MFMA32(__builtin_bit_cast(bf16x8, tq), pack8(pv), o); }
    }
    { bf16x8 sf[8];
#pragma unroll
      for (int kk = 0; kk < 8; ++kk) sf[kk] = *(const GAS bf16x8*)(strow + 16 * kk);
#pragma unroll
      for (int kk = 0; kk < 8; ++kk) { const int d0 = 16 * kk + 8 * hf;
          const v4u qv = qg[kk];
          const f32x4 b0 = *(const LAS f32x4*)(bt + t * HG_BS + d0), b1 = *(const LAS f32x4*)(bt + t * HG_BS + d0 + 4);
          float ve[8] = {bflo(qv.x) * __expf(b0.x), bfhi(qv.x) * __expf(b0.y), bflo(qv.y) * __expf(b0.z), bfhi(qv.y) * __expf(b0.w), bflo(qv.z) * __expf(b1.x), bfhi(qv.z) * __expf(b1.y), bflo(qv.w) * __expf(b1.z), bfhi(qv.w) * __expf(b1.w)};
          o = MFMA32(sf[kk], pack8(ve), o); } }
    float ss = 0.f;
#pragma unroll
    for (int r = 0; r < 16; ++r) ss += o[r] * o[r];
    ss += xor32f(ss, hf);
    if (hf == 0) red[(tt * 4 + dvt) * 32 + cl] = ss;
    __syncthreads();
    const float rstd = __builtin_amdgcn_rsqf(((red[(tt * 4 + 0) * 32 + cl] + red[(tt * 4 + 1) * 32 + cl]) + (red[(tt * 4 + 2) * 32 + cl] + red[(tt * 4 + 3) * 32 + cl])) * (1.0f / 128.0f) + EPS);
#pragma unroll
    for (int g = 0; g < 4; ++g) { const int dv0 = 32 * dvt + 8 * g + 4 * hf; const size_t off = (n0 + t) * 1024 + h * 128 + dv0;
        const unsigned gg = *(const GAS unsigned*)((const unsigned char*)GHG + off); const f32x4 w4 = *(const GAS f32x4*)(nw + dv0);
        const float rq = rstd * (ACT_QS / 255.0f);
        *(GAS unsigned*)((unsigned char*)OUT + off) = pack_i8x4c(o[4 * g] * rq * w4.x * (float)(gg & 255u), o[4 * g + 1] * rq * w4.y * (float)((gg >> 8) & 255u), o[4 * g + 2] * rq * w4.z * (float)((gg >> 16) & 255u), o[4 * g + 3] * rq * w4.w * (float)(gg >> 24)); }
    __syncthreads();
}
__device__ __forceinline__ void qknorm_rows4(bf16* row0, size_t rstride, const float* w, float scale, int lane) {
    v4u x[4][2];
#pragma unroll
    for (int i = 0; i < 4; ++i)
#pragma unroll
        for (int j = 0; j < 2; ++j) x[i][j] = *(const GAS v4u*)(row0 + i * rstride + 8 * lane + 512 * j);
    const f32x4 wa = *(const GAS f32x4*)(w + ((8 * lane) & 127)), wb = *(const GAS f32x4*)(w + ((8 * lane) & 127) + 4);
#pragma unroll
    for (int i = 0; i < 4; ++i)
#pragma unroll
        for (int j = 0; j < 2; ++j) { const v4u xx = x[i][j];
            float f[8] = {bflo(xx.x), bfhi(xx.x), bflo(xx.y), bfhi(xx.y), bflo(xx.z), bfhi(xx.z), bflo(xx.w), bfhi(xx.w)};
            float ss = 0.f;
#pragma unroll
            for (int k = 0; k < 8; ++k) ss += f[k] * f[k];
            ss += xorf<1>(ss); ss += xorf<2>(ss); ss += xorf<4>(ss); ss += xorf<8>(ss);
            const float r = __builtin_amdgcn_rsqf(ss * (1.0f / 128.0f) + EPS) * scale;
            v4u o; o.x = pk2c(f[0] * r * wa.x, f[1] * r * wa.y); o.y = pk2c(f[2] * r * wa.z, f[3] * r * wa.w); o.z = pk2c(f[4] * r * wb.x, f[5] * r * wb.y); o.w = pk2c(f[6] * r * wb.z, f[7] * r * wb.w);
            *(GAS v4u*)(row0 + i * rstride + 8 * lane + 512 * j) = o; }
}
__device__ __forceinline__ void vt_item(int item, int lane, const bf16* vsb, bf16* vt, LAS unsigned short* scr) {
    const int db = item & 3, sb = (item >> 2) & 63, bh = item >> 8, b = bh >> 3, h = bh & 7;
    const bf16* src = vsb + ((size_t)b * SEQ + sb * 64) * 1024 + h * 128 + db * 32;
#pragma unroll 4
    for (int i = 0; i < 16; ++i) { const int r = 4 * i + (lane >> 4); *(LAS unsigned*)(scr + r * 34 + 2 * (lane & 15)) = *(const GAS unsigned*)(src + (size_t)r * 1024 + 2 * (lane & 15)); }
    LDS_WAIT();
    const int c = lane & 7, b0 = 16 * (c >> 1) + 4 * (c & 1);
#pragma unroll
    for (int j = 0; j < 4; ++j) { const int d = (lane >> 3) + 8 * j; const LAS unsigned short* s = scr + b0 * 34 + d;
        v4u o; o.x = (unsigned)s[0] | ((unsigned)s[34] << 16); o.y = (unsigned)s[68] | ((unsigned)s[102] << 16); o.z = (unsigned)s[8 * 34] | ((unsigned)s[9 * 34] << 16); o.w = (unsigned)s[10 * 34] | ((unsigned)s[11 * 34] << 16);
        *(GAS v4u*)(vt + ((size_t)bh * 128 + db * 32 + d) * SEQ + sb * 64 + 8 * c) = o; }
    LDS_WAIT();
}

constexpr int AT_BUF = 32768, AT_VOFF = 16384;
__device__ __forceinline__ f32x16 attn_scores(const LAS unsigned char* kt, int krow, int hf, const bf16x8 (&qf)[8]) {
    f32x16 sa;
#pragma unroll
    for (int r = 0; r < 16; ++r) sa[r] = 0.f;
    const LAS unsigned char* kp = kt + krow * 256; const int sw = krow & 15;
#pragma unroll
    for (int kk = 0; kk < 8; ++kk) sa = MFMA32(*(const LAS bf16x8*)(kp + (((2 * kk + hf) ^ sw) << 4)), qf[kk], sa);
    return sa;
}
template <bool DIAG> __device__ __forceinline__ void attn_weights(const f32x16& sa, float& R, int hf, int cl, bf16x8 (&pf)[2]) {
    float om[16];
#pragma unroll
    for (int r = 0; r < 16; ++r) om[r] = __builtin_amdgcn_rcpf(1.0f + __builtin_amdgcn_exp2f(sa[r]));
    if (DIAG) {
#pragma unroll
        for (int r = 0; r < 16; ++r) if (((r & 3) + 8 * (r >> 2) + 4 * hf) >= cl) om[r] = 1.0f;
    }
    float Gs[4], Gp[4];
#pragma unroll
    for (int g = 0; g < 4; ++g) { Gs[g] = (om[4 * g] * om[4 * g + 1]) * (om[4 * g + 2] * om[4 * g + 3]); Gp[g] = xor32f(Gs[g], hf); }
    float tail = R; float w[16];
#pragma unroll
    for (int g = 3; g >= 0; --g) {
        const float c3 = tail * (hf == 0 ? Gp[g] : 1.0f), c2 = c3 * om[4 * g + 3], c1 = c2 * om[4 * g + 2], c0 = c1 * om[4 * g + 1];
        w[4 * g + 3] = c3 - om[4 * g + 3] * c3; w[4 * g + 2] = c2 - om[4 * g + 2] * c2; w[4 * g + 1] = c1 - om[4 * g + 1] * c1; w[4 * g] = c0 - om[4 * g] * c0;
        tail *= Gs[g] * Gp[g];
    }
    R = tail;
#pragma unroll
    for (int sp = 0; sp < 2; ++sp) { v4u t; t.x = pk2c(w[8 * sp], w[8 * sp + 1]); t.y = pk2c(w[8 * sp + 2], w[8 * sp + 3]); t.z = pk2c(w[8 * sp + 4], w[8 * sp + 5]); t.w = pk2c(w[8 * sp + 6], w[8 * sp + 7]); pf[sp] = __builtin_bit_cast(bf16x8, t); }
}
__device__ __forceinline__ void attn_pv(const LAS unsigned char* vt, int sub, int cl, int hf, const bf16x8 (&pf)[2], f32x16 (&o)[4]) {
#pragma unroll
    for (int d = 0; d < 4; ++d) { const int row = 32 * d + cl; const LAS unsigned char* vp = vt + row * 128; const int sw = (row >> 1) & 7;
#pragma unroll
        for (int sp = 0; sp < 2; ++sp) { const int x = 4 * sub + 2 * sp + hf;
            o[d] = MFMA32(*(const LAS bf16x8*)(vp + ((x ^ sw) << 4)), pf[sp], o[d]); } }
}
template <bool LAG> __device__ __forceinline__ void attn_unit(const Ctx& c, int bh, int qb, const bf16* qsb, const bf16* ksb, const bf16* vt, bf16* outb) {
    int lane_ = c.lane; asm volatile("" : "+v"(lane_));
    const int b = bh >> 3, h = bh & 7, lane = lane_, cl = lane & 31, hf = lane >> 5;
    const size_t rb = (size_t)b * SEQ; const int q0w = 256 * qb + 32 * c.wave;
    bf16x8 qf[8];
    { const bf16* qrow = qsb + (rb + q0w + cl) * 1024 + h * 128 + 8 * hf;
#pragma unroll
      for (int kk = 0; kk < 8; ++kk) qf[kk] = *(const GAS bf16x8*)(qrow + 16 * kk); }
    f32x16 o[4];
#pragma unroll
    for (int d = 0; d < 4; ++d)
#pragma unroll
        for (int r = 0; r < 16; ++r) o[d][r] = 0.f;
    float R = 1.0f;
    bf16x8 pd[2]; const LAS unsigned char* vimd = c.lds; int subd = 0; bool pending = false;
    const int kr0 = 8 * c.wave + (lane >> 4), kr1 = kr0 + 4;
    const bf16* kg0 = ksb + (rb + kr0) * 1024 + h * 128 + (((lane & 15) ^ (kr0 & 15)) << 3);
    const bf16* kg1 = ksb + (rb + kr1) * 1024 + h * 128 + (((lane & 15) ^ (kr1 & 15)) << 3);
    const int vr0 = 16 * c.wave + (lane >> 3), vr1 = vr0 + 8;
    const bf16* vg0 = vt + ((size_t)bh * 128 + vr0) * SEQ + (((lane & 7) ^ ((vr0 >> 1) & 7)) << 3);
    const bf16* vg1 = vt + ((size_t)bh * 128 + vr1) * SEQ + (((lane & 7) ^ ((vr1 >> 1) & 7)) << 3);
    LAS unsigned char* dk = c.lds + c.wave * 2048; LAS unsigned char* dv = c.lds + AT_VOFF + c.wave * 2048;
#define AT_DMA(kt_, bi_) do { const int ktt_ = (kt_); LAS unsigned char* bb_ = (LAS unsigned char*)0 + (bi_) * AT_BUF; \
        __builtin_amdgcn_global_load_lds((const unsigned*)(kg0 + (size_t)ktt_ * 64 * 1024), (LAS unsigned*)(dk + (bi_) * AT_BUF), 16, 0, 0); \
        __builtin_amdgcn_global_load_lds((const unsigned*)(kg1 + (size_t)ktt_ * 64 * 1024), (LAS unsigned*)(dk + (bi_) * AT_BUF + 1024), 16, 0, 0); \
        __builtin_amdgcn_global_load_lds((const unsigned*)(vg0 + ktt_ * 64), (LAS unsigned*)(dv + (bi_) * AT_BUF), 16, 0, 0); \
        __builtin_amdgcn_global_load_lds((const unsigned*)(vg1 + ktt_ * 64), (LAS unsigned*)(dv + (bi_) * AT_BUF + 1024), 16, 0, 0); (void)bb_; } while (0)
    const int nkt = 4 * (qb + 1);
    asm volatile("s_waitcnt vmcnt(0)" ::: "memory");
    AT_DMA(nkt - 1, 0); AT_DMA(nkt - 2, 1);
    asm volatile("s_waitcnt vmcnt(4)" ::: "memory"); __builtin_amdgcn_s_barrier(); asm volatile("" ::: "memory");
    int bi = 0;
#pragma unroll 1
    for (int it = 0; it < nkt; ++it) {
        const int kt = nkt - 1 - it;
        const int b2 = (bi + 2) & 3;
        if (it + 2 < nkt) AT_DMA(kt - 2, b2);
        const LAS unsigned char* kim = c.lds + bi * AT_BUF; const LAS unsigned char* vim = kim + AT_VOFF;
        const int rel = q0w - 64 * kt;
        if (rel >= 32) {
            if (LAG) { if (pending) attn_pv(vimd, subd, cl, hf, pd, o);
                const f32x16 s1 = attn_scores(kim, 32 + cl, hf, qf); if (rel == 32) attn_weights<true>(s1, R, hf, cl, pd); else attn_weights<false>(s1, R, hf, cl, pd);
                vimd = vim; subd = 1; pending = true;
            } else { bf16x8 p[2];
                { const f32x16 s1 = attn_scores(kim, 32 + cl, hf, qf); if (rel == 32) attn_weights<true>(s1, R, hf, cl, p); else attn_weights<false>(s1, R, hf, cl, p); }
                attn_pv(vim, 1, cl, hf, p, o); }
        }
        if (rel >= 0) {
            if (LAG) { if (pending) attn_pv(vimd, subd, cl, hf, pd, o);
                const f32x16 s0 = attn_scores(kim, cl, hf, qf); if (rel == 0) attn_weights<true>(s0, R, hf, cl, pd); else attn_weights<false>(s0, R, hf, cl, pd);
                vimd = vim; subd = 0; pending = true;
            } else { bf16x8 p[2];
                { const f32x16 s0 = attn_scores(kim, cl, hf, qf); if (rel == 0) attn_weights<true>(s0, R, hf, cl, p); else attn_weights<false>(s0, R, hf, cl, p); }
                attn_pv(vim, 0, cl, hf, p, o); }
        }
        if (it + 2 < nkt) asm volatile("s_waitcnt vmcnt(4)\n\ts_waitcnt lgkmcnt(0)" ::: "memory"); else asm volatile("s_waitcnt vmcnt(0)\n\ts_waitcnt lgkmcnt(0)" ::: "memory");
        __builtin_amdgcn_s_barrier(); asm volatile("" ::: "memory");
        bi = (bi + 1) & 3;
    }
#undef AT_DMA
    if (LAG && pending) attn_pv(vimd, subd, cl, hf, pd, o);
    bf16* orow = outb + (rb + q0w + cl) * 1024 + h * 128 + 4 * hf;
#pragma unroll
    for (int d = 0; d < 4; ++d)
#pragma unroll
        for (int g = 0; g < 4; ++g) { v2u q; q.x = pk2c(o[d][4 * g], o[d][4 * g + 1]); q.y = pk2c(o[d][4 * g + 2], o[d][4 * g + 3]); *(GAS v2u*)(orow + 32 * d + 8 * g) = q; }
    asm volatile("s_waitcnt vmcnt(0)" ::: "memory"); __builtin_amdgcn_s_barrier(); asm volatile("" ::: "memory");
}
__device__ __forceinline__ void hgpost_row(bf16* row, const bf16* grow, const float* w, int lane) {
#pragma unroll
    for (int j = 0; j < 2; ++j) {
        GAS v4u* p = (GAS v4u*)(row + 8 * lane + 512 * j); const v4u x = *p; const v4u gg = *(const GAS v4u*)(grow + 8 * lane + 512 * j);
        float f[8] = {bflo(x.x), bfhi(x.x), bflo(x.y), bfhi(x.y), bflo(x.z), bfhi(x.z), bflo(x.w), bfhi(x.w)};
        const float g[8] = {bflo(gg.x), bfhi(gg.x), bflo(gg.y), bfhi(gg.y), bflo(gg.z), bfhi(gg.z), bflo(gg.w), bfhi(gg.w)};
        float ss = 0.f;
#pragma unroll
        for (int k = 0; k < 8; ++k) ss += f[k] * f[k];
        ss += xorf<1>(ss); ss += xorf<2>(ss); ss += xorf<4>(ss); ss += xorf<8>(ss);
        const float r = __builtin_amdgcn_rsqf(ss * (1.0f / 128.0f) + EPS);
        const f32x4 wa = *(const GAS f32x4*)(w + ((8 * lane) & 127)), wb = *(const GAS f32x4*)(w + ((8 * lane) & 127) + 4);
        v4u o; o.x = pk2c(f[0] * r * wa.x * g[0], f[1] * r * wa.y * g[1]); o.y = pk2c(f[2] * r * wa.z * g[2], f[3] * r * wa.w * g[3]);
        o.z = pk2c(f[4] * r * wb.x * g[4], f[5] * r * wb.y * g[5]); o.w = pk2c(f[6] * r * wb.z * g[6], f[7] * r * wb.w * g[7]);
        *p = o;
    }
}

template <bool FIRST> struct EpiMerge {
    static constexpr bool PERM = true, AFTER_DRAIN = false;
    const unsigned char* gate; bf16* merged;
    __device__ __forceinline__ float rowscale(int) const { return 1.0f / (ACT_QS * WBR_QS); }
    __device__ __forceinline__ void operator()(const pg8::f32x4 (&acc)[2][2][4][2], const pg8::Unit& u, int wr, int wc, int fr, int fq) const {
        const int row0 = u.pm * 256 + wr * 64 + fr, col0 = u.pn * 256 + wc * 32 + 8 * fq;
#pragma unroll
        for (int ai = 0; ai < 2; ++ai)
#pragma unroll
            for (int m = 0; m < 4; ++m) {
                if (m == 0) asm volatile("" ::: "memory");
#pragma unroll
                for (int bj = 0; bj < 2; ++bj) {
                    const size_t off = (size_t)(row0 + ai * 128 + m * 16) * 2048 + col0 + bj * 128;
                    const v2u g = *(const GAS v2u*)(gate + off); const pg8::f32x4 v0 = acc[ai][bj][m][0], v1 = acc[ai][bj][m][1]; constexpr float k = 1.0f / 255.0f;
                    float r[8] = {(float)(g.x & 255u) * (v0[0] * k), (float)((g.x >> 8) & 255u) * (v0[1] * k), (float)((g.x >> 16) & 255u) * (v0[2] * k), (float)(g.x >> 24) * (v0[3] * k),
                                  (float)(g.y & 255u) * (v1[0] * k), (float)((g.y >> 8) & 255u) * (v1[1] * k), (float)((g.y >> 16) & 255u) * (v1[2] * k), (float)(g.y >> 24) * (v1[3] * k)};
                    if (!FIRST) { const v4u mo = *(const GAS v4u*)(merged + off);
                        r[0] += bflo(mo.x); r[1] += bfhi(mo.x); r[2] += bflo(mo.y); r[3] += bfhi(mo.y); r[4] += bflo(mo.z); r[5] += bfhi(mo.z); r[6] += bflo(mo.w); r[7] += bfhi(mo.w); }
                    v4u w; w.x = pk2c(r[0], r[1]); w.y = pk2c(r[2], r[3]); w.z = pk2c(r[4], r[5]); w.w = pk2c(r[6], r[7]);
                    *(GAS v4u*)(merged + off) = w; }
            }
    }
};
struct EpiStoreBf16 {
    static constexpr bool PERM = true, AFTER_DRAIN = false;
    bf16* out; const float* sa;
    __device__ __forceinline__ float rowscale(int row) const { return ((const GAS float*)sa)[row] * (1.0f / WIN_QS); }
    __device__ __forceinline__ void operator()(const pg8::f32x4 (&acc)[2][2][4][2], const pg8::Unit& u, int wr, int wc, int fr, int fq) const {
        const int row0 = u.pm * 256 + wr * 64 + fr, col0 = u.pn * 256 + wc * 32 + 8 * fq;
#pragma unroll
        for (int ai = 0; ai < 2; ++ai)
#pragma unroll
            for (int m = 0; m < 4; ++m)
#pragma unroll
                for (int bj = 0; bj < 2; ++bj) { const pg8::f32x4 v0 = acc[ai][bj][m][0], v1 = acc[ai][bj][m][1];
                    v4u w; w.x = pk2c(v0[0], v0[1]); w.y = pk2c(v0[2], v0[3]); w.z = pk2c(v1[0], v1[1]); w.w = pk2c(v1[2], v1[3]);
                    *(GAS v4u*)(out + (size_t)(row0 + ai * 128 + m * 16) * 2048 + col0 + bj * 128) = w; }
    }
};
struct EpiResid {
    static constexpr bool PERM = true, AFTER_DRAIN = false;
    const void* xin; bf16* xout; const float* ms; int XIN_BF16;
    __device__ __forceinline__ float rowscale(int row) const { return ((const GAS float*)ms)[row] * (1.0f / WIN_QS); }
    __device__ __forceinline__ void operator()(const pg8::f32x4 (&acc)[2][2][4][2], const pg8::Unit& u, int wr, int wc, int fr, int fq) const {
        const int row0 = u.pm * 256 + wr * 64 + fr, col0 = u.pn * 256 + wc * 32 + 8 * fq;
#pragma unroll
        for (int ai = 0; ai < 2; ++ai)
#pragma unroll
            for (int m = 0; m < 4; ++m)
#pragma unroll
                for (int bj = 0; bj < 2; ++bj) { const size_t off = (size_t)(row0 + ai * 128 + m * 16) * 2048 + col0 + bj * 128;
                    const pg8::f32x4 v0 = acc[ai][bj][m][0], v1 = acc[ai][bj][m][1]; float r[8];
                    if (XIN_BF16) { const v4u x = *(const GAS v4u*)((const bf16*)xin + off);
                        r[0] = v0[0] + bflo(x.x); r[1] = v0[1] + bfhi(x.x); r[2] = v0[2] + bflo(x.y); r[3] = v0[3] + bfhi(x.y); r[4] = v1[0] + bflo(x.z); r[5] = v1[1] + bfhi(x.z); r[6] = v1[2] + bflo(x.w); r[7] = v1[3] + bfhi(x.w); }
                    else { const f32x4 x0 = *(const GAS f32x4*)((const float*)xin + off), x1 = *(const GAS f32x4*)((const float*)xin + off + 4);
                        r[0] = v0[0] + x0.x; r[1] = v0[1] + x0.y; r[2] = v0[2] + x0.z; r[3] = v0[3] + x0.w; r[4] = v1[0] + x1.x; r[5] = v1[1] + x1.y; r[6] = v1[2] + x1.z; r[7] = v1[3] + x1.w; }
                    v4u w; w.x = pk2c(r[0], r[1]); w.y = pk2c(r[2], r[3]); w.z = pk2c(r[4], r[5]); w.w = pk2c(r[6], r[7]);
                    *(GAS v4u*)(xout + off) = w; }
    }
};

__device__ __forceinline__ float rl_f(float v, int l) { return __uint_as_float((unsigned)__builtin_amdgcn_readlane((int)__float_as_uint(v), l)); }
__device__ __forceinline__ void ins16(float (&L)[16], float x) {
#pragma unroll
    for (int i = 0; i < 16; ++i) { const float hi = __builtin_fmaxf(L[i], x); x = __builtin_fminf(L[i], x); L[i] = hi; }
}
#define CE_DESC(a, b) do { const float hi_ = __builtin_fmaxf(a, b), lo_ = __builtin_fminf(a, b); a = hi_; b = lo_; } while (0)
__device__ __forceinline__ void sort16_desc(float (&v)[16]) {
#pragma unroll
    for (int k = 2; k <= 16; k <<= 1)
#pragma unroll
        for (int j = k >> 1; j > 0; j >>= 1)
#pragma unroll
            for (int i = 0; i < 16; ++i) { const int l = i ^ j; if (l > i) { if ((i & k) == 0) CE_DESC(v[i], v[l]); else CE_DESC(v[l], v[i]); } }
}
__device__ __forceinline__ void bitonic_merge16_desc(float (&v)[16]) {
#pragma unroll
    for (int j = 8; j > 0; j >>= 1)
#pragma unroll
        for (int i = 0; i < 16; ++i) { const int l = i ^ j; if (l > i) CE_DESC(v[i], v[l]); }
}
__device__ __forceinline__ void top16_merge(float (&L)[16], const float (&T)[16]) {
#pragma unroll
    for (int i = 0; i < 16; ++i) L[i] = __builtin_fmaxf(L[i], T[15 - i]);
    bitonic_merge16_desc(L);
}
constexpr int PK_KS = 272;
__device__ __forceinline__ void peer_top16(const bf16* qrow  , const LAS unsigned char* kl  , int hf, float (&L)[16]) {
    bf16x8 qf[8];
#pragma unroll
    for (int kk = 0; kk < 8; ++kk) qf[kk] = *(const GAS bf16x8*)(qrow + 16 * kk);
#pragma unroll 1
    for (int kt = 0; kt < 4; ++kt) {
        f32x16 sa;
#pragma unroll
        for (int r = 0; r < 16; ++r) sa[r] = 0.f;
#pragma unroll
        for (int kk = 0; kk < 8; ++kk) sa = MFMA32(*(const LAS bf16x8*)(kl + kt * 32 * PK_KS + 32 * kk), qf[kk], sa);
        float T[16];
#pragma unroll
        for (int r = 0; r < 16; ++r) { const unsigned idx = (unsigned)(kt * 32 + (r & 3) + 8 * (r >> 2) + 4 * hf); T[r] = __uint_as_float((__float_as_uint(sa[r]) & ~127u) | idx); }
        sort16_desc(T);
        if (kt == 0) {
#pragma unroll
            for (int i = 0; i < 16; ++i) L[i] = T[i];
        } else top16_merge(L, T);
    }
    float P[16];
#pragma unroll
    for (int i = 0; i < 16; ++i) P[i] = xorf<32>(L[i]);
    top16_merge(L, P);
}
__device__ __forceinline__ void peer_select32(int hd, int n0, int lane, const bf16* qpeer, const LAS unsigned char* kl1, const LAS unsigned char* kl2, unsigned char* wsb, LAS unsigned* ldsw) {
    asm volatile("" : "+v"(lane));
    const int c = lane & 31, hf = lane >> 5, n = n0 + c;
    const bf16* qrow = qpeer + (size_t)n * 2048 + hd * 256 + 8 * hf;
    float A[16], B[16];
    peer_top16(qrow, kl1 + c * PK_KS + 16 * hf, hf, A);
    peer_top16(qrow + 128, kl2 + c * PK_KS + 16 * hf, hf, B);
#define PKV(x) __uint_as_float(__float_as_uint(x) & ~127u)
#define PKI(x) ((int)(__float_as_uint(x) & 127u))
    float W[16];
    { float C0[16], C1[16], C2[16], E0 = 0.f, E1 = 0.f; unsigned id = 0;
#pragma unroll
      for (int a = 0; a < 16; ++a)
#pragma unroll
        for (int b = 0; b < 16; ++b) if ((a + 1) * (b + 1) <= 16) { const float pk = __uint_as_float((__float_as_uint(PKV(A[a]) + PKV(B[b])) & ~63u) | id);
            if (id < 16) C0[id] = pk; else if (id < 32) C1[id - 16] = pk; else if (id < 48) C2[id - 32] = pk; else if (id == 48) E0 = pk; else E1 = pk;
            ++id; }
      sort16_desc(C0); sort16_desc(C1); sort16_desc(C2);
      top16_merge(C0, C1); top16_merge(C0, C2);
#pragma unroll
      for (int i = 0; i < 16; ++i) W[i] = C0[i];
      ins16(W, E0); ins16(W, E1); }
    const float thr = W[15], mx = W[0];
    int cnt = 0; float ssum = 0.f;
    LAS int* le = (LAS int*)ldsw + c * 16; LAS float* lg = (LAS float*)ldsw + 512 + c * 16;
    { unsigned id = 0;
#pragma unroll
      for (int a = 0; a < 16; ++a)
#pragma unroll
        for (int b = 0; b < 16; ++b) if ((a + 1) * (b + 1) <= 16) {
            const float cv = PKV(A[a]) + PKV(B[b]); const float pk = __uint_as_float((__float_as_uint(cv) & ~63u) | id); ++id;
            if (pk >= thr) { const float e = __expf(cv - mx); if (hf == 0) { le[cnt] = PKI(A[a]) * 128 + PKI(B[b]); lg[cnt] = e; } ssum += e; ++cnt; }
        } }
    LDS_WAIT();
    asm volatile("" : "+s"(wsb));
    int* sel_e = (int*)(wsb + WS_SEL); float* sel_g = (float*)(wsb + WS_SEL + 8 * MiB); float* sel_s = (float*)(wsb + WS_SELS);
    { int lane3 = lane; asm volatile("" : "+v"(lane3)); const int t = lane3 >> 1, part = lane3 & 1;
      const v4u e0 = *(const LAS v4u*)((LAS int*)ldsw + t * 16 + 8 * part), e1 = *(const LAS v4u*)((LAS int*)ldsw + t * 16 + 8 * part + 4);
      const v4u g0 = *(const LAS v4u*)((LAS int*)ldsw + 512 + t * 16 + 8 * part), g1 = *(const LAS v4u*)((LAS int*)ldsw + 512 + t * 16 + 8 * part + 4);
      GAS v4u* pe = (GAS v4u*)(sel_e + (size_t)(n0 + t) * 128 + hd * 16 + 8 * part); GAS v4u* pg = (GAS v4u*)(sel_g + (size_t)(n0 + t) * 128 + hd * 16 + 8 * part);
      pe[0] = e0; pe[1] = e1; pg[0] = g0; pg[1] = g1; }
    LDS_WAIT();
    { int lane4 = lane; asm volatile("" : "+v"(lane4)); if ((lane4 >> 5) == 0) ((GAS float*)sel_s)[(size_t)(n0 + (lane4 & 31)) * 8 + hd] = ssum; }
}

__device__ __forceinline__ float dot2bf(unsigned a, unsigned b, float acc) {
    return __builtin_amdgcn_fdot2_f32_bf16(__builtin_bit_cast(bf16v2, a), __builtin_bit_cast(bf16v2, b), acc, false);
}
__device__ __forceinline__ float dot8bf(const v4u a, const v4u b, float acc) {
    const unsigned a0 = a.x, a1 = a.y, a2 = a.z, a3 = a.w, b0 = b.x, b1 = b.y, b2 = b.z, b3 = b.w;
    acc = dot2bf(a0, b0, acc); acc = dot2bf(a1, b1, acc); acc = dot2bf(a2, b2, acc); acc = dot2bf(a3, b3, acc);
    return acc;
}
__device__ __forceinline__ void unpack16(const v4u q, float (&f)[16]) {
    const unsigned d0 = q.x, d1 = q.y, d2 = q.z, d3 = q.w;
    f32x2v t;
    t = __builtin_amdgcn_cvt_pk_f32_fp8((int)d0, false); f[0] = t.x; f[1] = t.y; t = __builtin_amdgcn_cvt_pk_f32_fp8((int)d0, true); f[2] = t.x; f[3] = t.y;
    t = __builtin_amdgcn_cvt_pk_f32_fp8((int)d1, false); f[4] = t.x; f[5] = t.y; t = __builtin_amdgcn_cvt_pk_f32_fp8((int)d1, true); f[6] = t.x; f[7] = t.y;
    t = __builtin_amdgcn_cvt_pk_f32_fp8((int)d2, false); f[8] = t.x; f[9] = t.y; t = __builtin_amdgcn_cvt_pk_f32_fp8((int)d2, true); f[10] = t.x; f[11] = t.y;
    t = __builtin_amdgcn_cvt_pk_f32_fp8((int)d3, false); f[12] = t.x; f[13] = t.y; t = __builtin_amdgcn_cvt_pk_f32_fp8((int)d3, true); f[14] = t.x; f[15] = t.y;
}
struct SliceSched { int mode, xcc, rank, nloc; };
__device__ __forceinline__ SliceSched slice_sched_init(const Ctx& c, unsigned* ctl, const XcdBarrier& bar, int use) {
    LAS int* sh = (LAS int*)(c.lds + 1024);
    if (c.tid == 0) {
        int ok = 1; unsigned tot = 0;
        for (int j = 0; j < 16; ++j) { const unsigned n = xb_ld(&bar.bar[XB_XCNT(j)]); tot += n; if ((j < 8) != (n > 0u)) ok = 0; }
        if (tot != (unsigned)c.G) ok = 0;
        const int xcc = (int)xb_xcc_id();
        int rank = 0, nloc = 1;
        if (ok) { nloc = (int)xb_ld(&bar.bar[XB_XCNT(xcc)]); rank = (int)xb_add(&ctl[CW_RANK + (use * 16 + xcc) * 64], 1u); if (rank >= nloc) ok = 0; }
        sh[0] = ok; sh[1] = xcc; sh[2] = rank; sh[3] = nloc;
    }
    __syncthreads();
    SliceSched S; S.mode = sh[0]; S.xcc = sh[1]; S.rank = sh[2]; S.nloc = sh[3];
    __syncthreads();
    return S;
}
__device__ __forceinline__ bool slice_item(const SliceSched& S, const Ctx& c, int i, int& slice, int& tb) {
    if (S.mode) { const int it = S.rank + i * S.nloc; if (it >= 512) return false; slice = S.xcc + 8 * (it >> 8); tb = it & 255; return true; }
    const int it = (int)blockIdx.x + i * c.G; if (it >= 4096) return false; slice = it >> 8; tb = it & 255; return true;
}
__device__ __forceinline__ void unpack16p(const v4u q, f32x2v (&f)[8]) {
    const unsigned d0 = q.x, d1 = q.y, d2 = q.z, d3 = q.w;
    f[0] = __builtin_amdgcn_cvt_pk_f32_fp8((int)d0, false); f[1] = __builtin_amdgcn_cvt_pk_f32_fp8((int)d0, true);
    f[2] = __builtin_amdgcn_cvt_pk_f32_fp8((int)d1, false); f[3] = __builtin_amdgcn_cvt_pk_f32_fp8((int)d1, true);
    f[4] = __builtin_amdgcn_cvt_pk_f32_fp8((int)d2, false); f[5] = __builtin_amdgcn_cvt_pk_f32_fp8((int)d2, true);
    f[6] = __builtin_amdgcn_cvt_pk_f32_fp8((int)d3, false); f[7] = __builtin_amdgcn_cvt_pk_f32_fp8((int)d3, true);
}
__device__ __forceinline__ __amdgpu_buffer_rsrc_t slice_rsrc(const unsigned char* base, size_t slice_off, int bytes);
__device__ __forceinline__ void sddmm_load(__amdgpu_buffer_rsrc_t rs, unsigned cgo, const LAS unsigned* ids16, v4u (&q)[16]) {
    int id[16];
#pragma unroll
    for (int i = 0; i < 4; ++i) { const v4u v = *(const LAS v4u*)(ids16 + 4 * i); id[4 * i] = (int)v.x; id[4 * i + 1] = (int)v.y; id[4 * i + 2] = (int)v.z; id[4 * i + 3] = (int)v.w; }
#pragma unroll
    for (int it = 0; it < 16; ++it) q[it] = __builtin_bit_cast(v4u, __builtin_amdgcn_raw_buffer_load_b128(rs, id[it] + (int)cgo, 0, 0));
}
__device__ __forceinline__ void sddmm_token(const v4u (&qc)[16], const v4u hv, const float hs, int lane, unsigned* dst) {
    const int hq[4] = {(int)hv.x, (int)hv.y, (int)hv.z, (int)hv.w};
    float p[16];
#pragma unroll
    for (int it = 0; it < 16; ++it) { int a = __builtin_amdgcn_sdot4((int)qc[it].x, hq[0], 0, false); a = __builtin_amdgcn_sdot4((int)qc[it].y, hq[1], a, false);
        a = __builtin_amdgcn_sdot4((int)qc[it].z, hq[2], a, false); a = __builtin_amdgcn_sdot4((int)qc[it].w, hq[3], a, false);
        p[it] = (float)a * hs; }
#pragma unroll
    for (int i = 0; i < 8; ++i) { const bool up = (lane & 4) != 0; const float snd = up ? p[i] : p[i + 8], kp = up ? p[i + 8] : p[i]; p[i] = kp + xorf<4>(snd); }
#pragma unroll
    for (int i = 0; i < 4; ++i) { const bool up = (lane & 2) != 0; const float snd = up ? p[i] : p[i + 4], kp = up ? p[i + 4] : p[i]; p[i] = kp + xorf<2>(snd); }
#pragma unroll
    for (int i = 0; i < 2; ++i) { const bool up = (lane & 1) != 0; const float snd = up ? p[i] : p[i + 2], kp = up ? p[i + 2] : p[i]; p[i] = kp + xorf<1>(snd); }
    *(GAS unsigned*)dst = pk2c(p[0], p[1]);
}
__device__ __forceinline__ void peer_sddmm_wave(int t0, int s, int lane, const unsigned char* H8, const float* SA, const unsigned char* UQ, const int* sel_e, float* part, LAS unsigned* ldsw) {
    const int cg = lane & 7, sg = lane >> 3;
#pragma unroll
    for (int j = 0; j < 4; ++j) { const v4u e4 = *(const GAS v4u*)(sel_e + (size_t)t0 * 128 + 4 * (lane + 64 * j)); *(LAS v4u*)(ldsw + 4 * (lane + 64 * j)) = (v4u){e4.x << 7, e4.y << 7, e4.z << 7, e4.w << 7}; }
    LDS_WAIT();
    const __amdgpu_buffer_rsrc_t ubase = slice_rsrc(UQ, (size_t)__builtin_amdgcn_readfirstlane(s) * U8_SLICE, (int)U8_SLICE); const unsigned cgo = (unsigned)cg * 16u;
    const LAS unsigned* idl = ldsw + sg * 16;
    const unsigned char* hbase = H8 + (size_t)t0 * 2048 + s * 128 + cg * 16;
    unsigned* pbase = (unsigned*)part + ((size_t)t0 * 16 + s) * 64 + lane;
    v4u qa[16], qb[16];
    v4u ha = *(const GAS v4u*)(hbase), hb; float sa = ((const GAS float*)SA)[t0], sb;
    sddmm_load(ubase, cgo, idl, qa);
#pragma unroll
    for (int k = 0; k < 6; k += 2) {
        hb = *(const GAS v4u*)(hbase + (size_t)(k + 1) * 2048); sb = ((const GAS float*)SA)[t0 + k + 1];
        sddmm_load(ubase, cgo, idl + (k + 1) * 128, qb);
        sddmm_token(qa, ha, sa, lane, pbase + (size_t)k * 1024);
        ha = *(const GAS v4u*)(hbase + (size_t)(k + 2) * 2048); sa = ((const GAS float*)SA)[t0 + k + 2];
        sddmm_load(ubase, cgo, idl + (k + 2) * 128, qa);
        sddmm_token(qb, hb, sb, lane, pbase + (size_t)(k + 1) * 1024);
    }
    hb = *(const GAS v4u*)(hbase + (size_t)7 * 2048); sb = ((const GAS float*)SA)[t0 + 7];
    sddmm_load(ubase, cgo, idl + 7 * 128, qb);
    sddmm_token(qa, ha, sa, lane, pbase + (size_t)6 * 1024);
    sddmm_token(qb, hb, sb, lane, pbase + (size_t)7 * 1024);
    LDS_WAIT();
}
__device__ __forceinline__ void peer_coef_tokens4(int t0, int ts, int lane, const float* part, const int* sel_e, float* sel_g, const float* sel_s, const float* US, const float* VS) {
    unsigned pv[4][16]; v2u e[4]; f32x2v g[4]; float dn[4];
#pragma unroll
    for (int i = 0; i < 4; ++i) { const int t = t0 + i * ts;
#pragma unroll
        for (int s = 0; s < 16; ++s) pv[i][s] = ((const GAS unsigned*)part)[((size_t)t * 16 + s) * 64 + lane];
        e[i] = *(const GAS v2u*)(sel_e + (size_t)t * 128 + 2 * lane); g[i] = *(const GAS f32x2v*)(sel_g + (size_t)t * 128 + 2 * lane); dn[i] = ((const GAS float*)sel_s)[(size_t)t * 8 + (lane >> 3)]; }
    float ux[4], uy[4], vx[4], vy[4];
#pragma unroll
    for (int i = 0; i < 4; ++i) { ux[i] = ((const GAS float*)US)[e[i].x]; uy[i] = ((const GAS float*)US)[e[i].y]; vx[i] = ((const GAS float*)VS)[e[i].x]; vy[i] = ((const GAS float*)VS)[e[i].y]; }
#pragma unroll
    for (int i = 0; i < 4; ++i) { const int t = t0 + i * ts; float a0 = 0.f, a1 = 0.f;
#pragma unroll
        for (int s = 0; s < 16; ++s) { a0 += bflo(pv[i][s]); a1 += bfhi(pv[i][s]); }
        const float inv = 1.0f / dn[i];
        const float ox = g[i].x * inv * gelu_exact(a0 * ux[i]) * vx[i], oy = g[i].y * inv * gelu_exact(a1 * uy[i]) * vy[i];
        const h2_t ha = {(_Float16)ox, (_Float16)ox}, hb = {(_Float16)oy, (_Float16)oy};
        *(GAS v2u*)(sel_g + (size_t)t * 128 + 2 * lane) = (v2u){__builtin_bit_cast(unsigned, ha), __builtin_bit_cast(unsigned, hb)}; }
}
__device__ __forceinline__ bool slice_item8(const SliceSched& S, const Ctx& c, int i, int& slice, int& tb) {
    if (S.mode) { const int it = S.rank + i * S.nloc; if (it >= 256) return false; slice = S.xcc; tb = it; return true; }
    const int it = (int)blockIdx.x + i * c.G; if (it >= 2048) return false; slice = it >> 8; tb = it & 255; return true;
}
__device__ __forceinline__ __amdgpu_buffer_rsrc_t slice_rsrc(const unsigned char* base, size_t slice_off, int bytes) {
    const unsigned long long a_ = (unsigned long long)base + slice_off;
    const unsigned long long u_ = ((unsigned long long)(unsigned)__builtin_amdgcn_readfirstlane((int)(a_ >> 32)) << 32) | (unsigned)__builtin_amdgcn_readfirstlane((int)a_);
    return __builtin_amdgcn_make_buffer_rsrc((void*)u_, (short)0, bytes, 0x00020000);
}
template <int MODE = 0>
__device__ __forceinline__ void spmm6_load(__amdgpu_buffer_rsrc_t rs, unsigned cgo, const LAS unsigned* ids8, v4u (&qa)[8], v2u (&qb)[8]) {
    const v4u i0 = *(const LAS v4u*)(ids8), i1 = *(const LAS v4u*)(ids8 + 4);
    const unsigned id[8] = {i0.x, i0.y, i0.z, i0.w, i1.x, i1.y, i1.z, i1.w};
    if constexpr (MODE == 2) {
#pragma unroll
        for (int it = 0; it < 8; ++it) { qa[it] = (v4u){id[it], id[it] + 1u, id[it] + 2u, id[it] + 3u}; qb[it] = (v2u){id[it] + 4u, id[it] + 5u}; }
        return; }
#pragma unroll
    for (int it = 0; it < 8; ++it) { const int o = (int)(id[it] + cgo);
        qa[it] = __builtin_bit_cast(v4u, __builtin_amdgcn_raw_buffer_load_b128(rs, o, 0, 0)); qb[it] = __builtin_bit_cast(v2u, __builtin_amdgcn_raw_buffer_load_b64(rs, o + 16, 0, 0)); }
}
template <int MODE = 0>
__device__ __forceinline__ void spmm6_fma(const v4u (&qa)[8], const v2u (&qb)[8], const LAS unsigned* cf8, h2_t (&y)[16]) {
    const v4u c0 = *(const LAS v4u*)(cf8), c1 = *(const LAS v4u*)(cf8 + 4);
    const unsigned cf[8] = {c0.x, c0.y, c0.z, c0.w, c1.x, c1.y, c1.z, c1.w};
    if constexpr (MODE == 1) {
#pragma unroll
        for (int it = 0; it < 8; ++it) { const unsigned x = (qa[it].x ^ qa[it].y) ^ (qa[it].z ^ qa[it].w) ^ (qb[it].x ^ qb[it].y) ^ cf[it]; y[it] = __builtin_bit_cast(h2_t, __builtin_bit_cast(unsigned, y[it]) ^ x); }
        return; }
    v32h_t f = __builtin_amdgcn_cvt_scalef32_pk32_f16_fp6((v6u){qa[0].x, qa[0].y, qa[0].z, qa[0].w, qb[0].x, qb[0].y}, 1.0f);
#pragma unroll
    for (int it = 0; it < 8; ++it) { v32h_t fn = f;
        if (it < 7) { fn = __builtin_amdgcn_cvt_scalef32_pk32_f16_fp6((v6u){qa[it + 1].x, qa[it + 1].y, qa[it + 1].z, qa[it + 1].w, qb[it + 1].x, qb[it + 1].y}, 1.0f); __builtin_amdgcn_sched_barrier(0); }
        const h2_t c2 = __builtin_bit_cast(h2_t, cf[it]);
#pragma unroll
        for (int j = 0; j < 16; ++j) { const h2_t v = {f[2 * j], f[2 * j + 1]}; y[j] = __builtin_elementwise_fma(v, c2, y[j]); }
        __builtin_amdgcn_sched_barrier(0);
        f = fn; }
}
template <int MODE = 0>
__device__ __forceinline__ void peer_spmm6_wave(int t0, int s, int lane, const unsigned char* V6, const int* sel_e, const float* coef, const bf16* x1, void* xout, int out_f32, LAS unsigned* ldsw) {
    const int cg = lane & 7, sg = lane >> 3;
#pragma unroll
    for (int j = 0; j < 4; ++j) { const v4u e4 = *(const GAS v4u*)(sel_e + (size_t)t0 * 128 + 4 * (lane + 64 * j));
        *(LAS v4u*)(ldsw + 4 * (lane + 64 * j)) = (v4u){e4.x * 192u, e4.y * 192u, e4.z * 192u, e4.w * 192u};
        *(LAS v4u*)(ldsw + 1024 + 4 * (lane + 64 * j)) = *(const GAS v4u*)(coef + (size_t)t0 * 128 + 4 * (lane + 64 * j)); }
    LDS_WAIT();
    const __amdgpu_buffer_rsrc_t vbase = slice_rsrc(V6, (size_t)__builtin_amdgcn_readfirstlane(s) * V6_SLICE, (int)V6_SLICE); const unsigned cgo = (unsigned)cg * 24u;
    const LAS unsigned* idl = ldsw + sg * 16; const LAS unsigned* cfl = ldsw + 1024 + sg * 16;
    v4u qa0[8], qa1[8]; v2u qb0[8], qb1[8];
    spmm6_load<MODE>(vbase, cgo, idl, qa0, qb0);
    const size_t xoff = (size_t)t0 * 2048 + s * 256 + cg * 32 + 4 * sg;
    v2u xn = *(const GAS v2u*)(x1 + xoff);
#pragma unroll
    for (int k = 0; k < 8; ++k) {
        const v2u xv = xn;
        h2_t y[16];
#pragma unroll
        for (int j = 0; j < 16; ++j) y[j] = (h2_t){(_Float16)0.f, (_Float16)0.f};
        spmm6_load<MODE>(vbase, cgo, idl + k * 128 + 8, qa1, qb1);
        if (k < 7) xn = *(const GAS v2u*)(x1 + xoff + (size_t)(k + 1) * 2048);
        spmm6_fma<MODE>(qa0, qb0, cfl + k * 128, y);
        if (k < 7) spmm6_load<MODE>(vbase, cgo, idl + (k + 1) * 128, qa0, qb0);
        spmm6_fma<MODE>(qa1, qb1, cfl + k * 128 + 8, y);
        unsigned u[16];
#pragma unroll
        for (int j = 0; j < 16; ++j) u[j] = __builtin_bit_cast(unsigned, y[j]);
#pragma unroll
        for (int i = 0; i < 8; ++i) { const auto r = __builtin_amdgcn_permlane32_swap(u[i], u[i + 8], false, false); u[i] = __builtin_bit_cast(unsigned, __builtin_bit_cast(h2_t, (unsigned)r[0]) + __builtin_bit_cast(h2_t, (unsigned)r[1])); }
#pragma unroll
        for (int i = 0; i < 4; ++i) { const auto r = __builtin_amdgcn_permlane16_swap(u[i], u[i + 4], false, false); u[i] = __builtin_bit_cast(unsigned, __builtin_bit_cast(h2_t, (unsigned)r[0]) + __builtin_bit_cast(h2_t, (unsigned)r[1])); }
#pragma unroll
        for (int i = 0; i < 2; ++i) { const bool up = (lane & 8) != 0; const unsigned snd = up ? u[i] : u[i + 2], kp = up ? u[i + 2] : u[i]; u[i] = __builtin_bit_cast(unsigned, __builtin_bit_cast(h2_t, kp) + __builtin_bit_cast(h2_t, xoru<8>(snd))); }
        const h2_t r0 = __builtin_bit_cast(h2_t, u[0]), r1 = __builtin_bit_cast(h2_t, u[1]);
        f32x4 o; o.x = bflo(xv.x) + (float)r0[0]; o.y = bfhi(xv.x) + (float)r0[1]; o.z = bflo(xv.y) + (float)r1[0]; o.w = bfhi(xv.y) + (float)r1[1];
        if (out_f32) *(GAS f32x4*)((float*)xout + xoff + (size_t)k * 2048) = o;
        else *(GAS v2u*)((bf16*)xout + xoff + (size_t)k * 2048) = (v2u){pk2c(o.x, o.y), pk2c(o.z, o.w)};
    }
    LDS_WAIT();
}

struct Args { const float* in[21]; float* out; unsigned char* ws; int lo, hi, li, pad; };
__global__ void __launch_bounds__(512, 2) mk_fwd(Args args) {
    extern __shared__ __attribute__((aligned(16))) unsigned char lds_raw[];
    Ctx c; c.lds = (LAS unsigned char*)lds_raw; c.tid = threadIdx.x; c.lane = c.tid & 63; c.wave = __builtin_amdgcn_readfirstlane(c.tid >> 6);
    c.G = gridDim.x; c.gw = blockIdx.x * 8 + c.wave; c.NGW = c.G * 8;
    volatile LAS unsigned* MISC = (volatile LAS unsigned*)(c.lds + MISC_OFF);
    if (c.tid < 32) MISC[c.tid] = 0u;
    __syncthreads();
    unsigned char* ws = args.ws;
    const int lo = args.lo, hi = args.hi;
    XcdBarrier bar; bar.w0 = 0; bar.bar = (unsigned*)(ws + WS_CTL) + CW_BAR + args.li * XCD_BAR_WORDS; bar.x = 0; bar.st = nullptr;
    if (hi - lo > 1) bar = xcd_barrier_post((unsigned*)(ws + WS_CTL) + CW_BAR + args.li * XCD_BAR_WORDS, MISC + 8);
#ifndef ATTN_REPS
#define ATTN_REPS 1
#endif
#ifndef PHMASK
#define PHMASK 0x1fff
#endif
#ifndef REP_PH
#define REP_PH (-1)
#endif
    int rep2 = 2; asm volatile("" : "+s"(rep2));
#define RLOOP(k, cond) for (int rp_ = 0; rp_ < ((((k) == REP_PH) && (cond)) ? rep2 : 1); ++rp_)
#define RSYNC do { if (rp_) xcd_barrier(bar); } while (0)
#define IN(k) (((PHMASK >> ((k) % NPH)) & 1) && lo <= (k) && (k) < hi)
#define SEAM(k) do { if (IN(k) && IN((k) + 1)) xcd_barrier(bar); } while (0)
#define PH_BEGIN unsigned char* w = ws; float* outp = args.out; Ctx cc = c; int zi = 0; cc.lane = xb_lane_id(); cc.tid = cc.wave * 64 + cc.lane; \
    asm volatile("" : "+s"(w), "+s"(outp), "+s"(zi), "+v"(cc.tid), "+v"(cc.lane)); (void)w; (void)outp;
#define INP(k) (args.in[(k) + zi])
#define WSP(T, off) ((T*)(w + (off)))
    for (int l = 0; l < 2; ++l) {
        const int pb = l * NPH;
        if (IN(pb + 0)) { PH_BEGIN
            P0Args a; a.w_in = INP(2) + (size_t)l * DM * INW; a.w_br_sb = INP(11) + (size_t)l * BW * DM; a.w_br_hg = INP(12) + (size_t)l * BW * DM; a.w_br_conv = INP(13) + (size_t)l * BW * DM;
            a.w_o = INP(14) + (size_t)l * DM * DM; a.w_q = INP(16) + (size_t)l * DM * DM; a.u = INP(19) + (size_t)l * 16384 * 2048; a.v = INP(20) + (size_t)l * 16384 * 2048; a.lbp = INP(5);
            a.WinT = WSP(bf16, WS_WIN); a.WbrT = WSP(bf16, WS_WBR); a.WoT = WSP(bf16, WS_WO); a.WqT = WSP(bf16, WS_WQ); a.U = WSP(unsigned char, WS_U); a.V = WSP(unsigned char, WS_V); a.US = WSP(float, WS_US); a.VS = WSP(float, WS_VS); a.LB = WSP(float, WS_LB); a.layer = l; a.k1 = INP(17) + (size_t)l * 8 * 16384; a.k2 = INP(18) + (size_t)l * 8 * 16384; a.KB = WSP(bf16, WS_KEYS);
#ifndef REP_MODE0
#define REP_MODE0 15
#endif
            RLOOP(0, true) { RSYNC;
            int pm_ = 15; if (REP_PH == 0) { pm_ = rp_ ? REP_MODE0 : 15; asm volatile("" : "+s"(pm_)); }
            p0_convert(cc, a, pm_);
            if (pm_ & 8) { if (l == 0) rms_phase_i8(cc, INP(0), INP(1) + (size_t)l * DM, WSP(unsigned char, WS_H), WSP(float, WS_SA));
                           else rms_phase_i8b(cc, WSP(const bf16, WS_X2), INP(1) + (size_t)l * DM, WSP(unsigned char, WS_H), WSP(float, WS_SA)); } }
        }
        SEAM(pb + 0);
        if (IN(pb + 1)) { PH_BEGIN
            RLOOP(1, true) { RSYNC;
            pg8::Gemm g{WSP(bf16, WS_H), WSP(bf16, WS_WIN), NTOK, INW, DM}; pg8::StaticOrder S; S.init(NTOK, INW, cc.G, (int)blockIdx.x, GEMM_WGM_IN);
            EpiIn E{WSP(bf16, WS_SEG), WSP(bf16, WS_GATE), WSP(float, WS_LB), WSP(float, WS_SA)};
            pg8::gemm_phase<EpiIn, pg8::StaticOrder, true, true, true>(cc.lds, g, S, E, cc.wave); }
        }
        SEAM(pb + 1);
        if (IN(pb + 2)) { PH_BEGIN
            bf16* SEG = WSP(bf16, WS_SEG);
#ifndef REP_MODE2
#define REP_MODE2 7
#endif
            RLOOP(2, true) { RSYNC;
            int pm_ = 7; if (REP_PH == 2) { pm_ = rp_ ? REP_MODE2 : 7; asm volatile("" : "+s"(pm_)); }
            if (pm_ & 1)
            conv_phase(cc, SEG + 7 * SEGSZ, INP(7) + (size_t)l * 31 * 1024, INP(8) + (size_t)l * 1024, INP(9) + (size_t)l * 1024, INP(10) + (size_t)l * 1024, WSP(bf16, WS_CONV));
            if (pm_ & 2)
            for (int ci = blockIdx.x, par = 0; ci < 2048; ci += cc.G, par ^= 1) hgA_chunk(cc, ci, ci + cc.G, par, par == 0 && ci == (int)blockIdx.x, SEG + 4 * SEGSZ, SEG + 5 * SEGSZ, WSP(bf16, WS_ST), WSP(float, WS_DEC));
            if (!rp_)
            for (int r = cc.gw; r < 2 * (NTOK / 4); r += cc.NGW) {
                if (r < NTOK / 4) qknorm_rows4(SEG + (size_t)r * 4 * 1024, 1024, INP(3) + (size_t)l * 128, 0.08838834764831845f * 1.4426950408889634f, cc.lane);
                else qknorm_rows4(SEG + SEGSZ + (size_t)(r - NTOK / 4) * 4 * 1024, 1024, INP(4) + (size_t)l * 128, 1.0f, cc.lane);
            }
            LAS unsigned short* scr = (LAS unsigned short*)(cc.lds + 4096 + cc.wave * 8192);
            if (pm_ & 4)
            for (int it = cc.gw; it < 8192; it += cc.NGW) vt_item(it, cc.lane, SEG + 2 * SEGSZ, WSP(bf16, WS_MERGED), scr); }
        }
        SEAM(pb + 2);
        if (IN(pb + 3)) { PH_BEGIN
            bf16* SEG = WSP(bf16, WS_SEG);
            RLOOP(3, true) { RSYNC;
            if (!rp_) hgB(cc, WSP(bf16, WS_ST), WSP(float, WS_DEC));
            for (int p = blockIdx.x; p < 256; p += cc.G) { const int bh = (p & 7) * 4 + (p >> 6), j = (p >> 3) & 7;
                if (cc.wave >= 4) {
#pragma unroll 1
                    for (int u = 0; u < 2; ++u) attn_unit<true>(cc, bh, u ? j : 15 - j, SEG, SEG + SEGSZ, WSP(bf16, WS_MERGED), SEG + 2 * SEGSZ);
                } else {
#pragma unroll 1
                    for (int u = 0; u < 2; ++u) attn_unit<false>(cc, bh, u ? j : 15 - j, SEG, SEG + SEGSZ, WSP(bf16, WS_MERGED), SEG + 2 * SEGSZ);
                } } }
        }
        SEAM(pb + 3);
        if (IN(pb + 4)) { PH_BEGIN
            bf16* SEG = WSP(bf16, WS_SEG);
            RLOOP(4, true) { RSYNC;
            for (int ci = blockIdx.x, par = 0; ci < 2048; ci += cc.G, par ^= 1) hgC_chunk(cc, ci, ci + cc.G, par, par == 0 && ci == (int)blockIdx.x, SEG + 3 * SEGSZ, SEG + 4 * SEGSZ, SEG + 5 * SEGSZ, SEG + 6 * SEGSZ, WSP(bf16, WS_ST), INP(6) + (size_t)l * 128, WSP(bf16, WS_HGR)); }
        }
        SEAM(pb + 4);
        if (IN(pb + 5)) { PH_BEGIN
            RLOOP(5, true) { RSYNC;
            pg8::StaticOrder S; S.init(NTOK, DM, cc.G, (int)blockIdx.x, GEMM_WGM);
            { pg8::Gemm g{WSP(bf16, WS_SEG) + 2 * SEGSZ, WSP(bf16, WS_WBR), NTOK, DM, BW}; EpiMerge<true> E{WSP(unsigned char, WS_GATE), WSP(bf16, WS_MERGED)}; pg8::gemm_phase<EpiMerge<true>, pg8::StaticOrder, true, true>(cc.lds, g, S, E, cc.wave); }
            { pg8::Gemm g{WSP(bf16, WS_HGR), WSP(bf16, WS_WBR) + (size_t)DM * BW, NTOK, DM, BW}; EpiMerge<false> E{WSP(unsigned char, WS_GATE) + (size_t)NTOK * 2048, WSP(bf16, WS_MERGED)}; pg8::gemm_phase<EpiMerge<false>, pg8::StaticOrder, true, true, true>(cc.lds, g, S, E, cc.wave); }
            { pg8::Gemm g{WSP(bf16, WS_CONV), WSP(bf16, WS_WBR) + (size_t)2 * DM * BW, NTOK, DM, BW}; EpiMerge<false> E{WSP(unsigned char, WS_GATE) + (size_t)2 * NTOK * 2048, WSP(bf16, WS_MERGED)}; pg8::gemm_phase<EpiMerge<false>, pg8::StaticOrder, true, true, true>(cc.lds, g, S, E, cc.wave); } }
        }
        SEAM(pb + 5);
        if (IN(pb + 6)) { PH_BEGIN
            RLOOP(6, true) { RSYNC;
            bf16_rows_i8(cc, WSP(bf16, WS_MERGED), WSP(unsigned char, WS_M8), WSP(float, WS_MS));
            xcd_barrier(bar);
            pg8::Gemm g{WSP(bf16, WS_M8), WSP(bf16, WS_WO), NTOK, DM, DM}; pg8::StaticOrder S; S.init(NTOK, DM, cc.G, (int)blockIdx.x, GEMM_WGM);
            EpiResid E{l == 0 ? (const void*)INP(0) : (const void*)WSP(const bf16, WS_X2), WSP(bf16, WS_X1), WSP(float, WS_MS), l};
            pg8::gemm_phase<EpiResid, pg8::StaticOrder, true, true, true>(cc.lds, g, S, E, cc.wave); }
        }
        SEAM(pb + 6);
        if (IN(pb + 7)) { PH_BEGIN RLOOP(7, true) { RSYNC; rms_phase_i8b(cc, WSP(const bf16, WS_X1), INP(15) + (size_t)l * DM, WSP(unsigned char, WS_H), WSP(float, WS_SA)); } }
        SEAM(pb + 7);
        if (IN(pb + 8)) { PH_BEGIN
            RLOOP(8, true) { RSYNC;
            pg8::Gemm g{WSP(bf16, WS_H), WSP(bf16, WS_WQ), NTOK, DM, DM}; pg8::StaticOrder S; S.init(NTOK, DM, cc.G, (int)blockIdx.x, GEMM_WGM);
            EpiStoreBf16 E{WSP(bf16, WS_QPEER), WSP(float, WS_SA)};
            pg8::gemm_phase<EpiStoreBf16, pg8::StaticOrder, true, true, true>(cc.lds, g, S, E, cc.wave); }
        }
        SEAM(pb + 8);
        if (IN(pb + 9)) { PH_BEGIN
            RLOOP(9, true) { RSYNC;
            for (int item = blockIdx.x; item < 512; item += cc.G) { const int hd = item & 7, tg = item >> 3;
                const bf16* KB = WSP(bf16, WS_KEYS); unsigned qo_ = (unsigned)WS_QPEER; asm volatile("" : "+s"(qo_)); const bf16* QP = (const bf16*)(w + qo_);
#pragma unroll
                for (int i = 0; i < 8; ++i) { const int p = cc.tid + 512 * i, li = p >> 11, row = (p >> 4) & 127, c16 = p & 15;
                    *(LAS v4u*)(cc.lds + li * 128 * PK_KS + row * PK_KS + c16 * 16) = *(const GAS v4u*)(KB + (size_t)(li * 8 + hd) * 16384 + row * 128 + c16 * 8); }
                __syncthreads();
                peer_select32(hd, tg * 256 + cc.wave * 32, cc.lane, QP, cc.lds, cc.lds + 128 * PK_KS, w, (LAS unsigned*)(cc.lds + 2 * 128 * PK_KS + cc.wave * 4096));
                __syncthreads(); } }
        }
        SEAM(pb + 9);
        if (IN(pb + 10)) { PH_BEGIN
            const SliceSched SS = slice_sched_init(cc, (unsigned*)(w + WS_CTL), bar, l * 2 + 0);
            RLOOP(10, true) { RSYNC;
            for (int i = 0;; ++i) { int sl, tb; if (!slice_item(SS, cc, i, sl, tb)) break;
                peer_sddmm_wave(tb * 64 + cc.wave * 8, sl, cc.lane, WSP(unsigned char, WS_H), WSP(float, WS_SA), WSP(unsigned char, WS_U), WSP(int, WS_SEL), WSP(float, WS_PART), (LAS unsigned*)(cc.lds + 4096 + cc.wave * 8192)); } }
        }
        SEAM(pb + 10);
        if (IN(pb + 11)) { PH_BEGIN
            for (int n = cc.gw; n < NTOK / 4; n += cc.NGW) peer_coef_tokens4(n, NTOK / 4, cc.lane, WSP(float, WS_PART), WSP(int, WS_SEL), WSP(float, WS_SEL + 8 * MiB), WSP(float, WS_SELS), WSP(float, WS_US), WSP(float, WS_VS));
        }
        SEAM(pb + 11);
        if (IN(pb + 12)) { PH_BEGIN
            void* xo = l == 0 ? (void*)WSP(bf16, WS_X2) : (void*)outp;
            const SliceSched SS = slice_sched_init(cc, (unsigned*)(w + WS_CTL), bar, l * 2 + 1);
            RLOOP(12, l == 0) { RSYNC;
            for (int i = 0;; ++i) { int sl, tb; if (!slice_item8(SS, cc, i, sl, tb)) break;
                peer_spmm6_wave(tb * 64 + cc.wave * 8, sl, cc.lane, WSP(unsigned char, WS_V), WSP(int, WS_SEL), WSP(float, WS_SEL + 8 * MiB), WSP(const bf16, WS_X1), xo, l, (LAS unsigned*)(cc.lds + 4096 + cc.wave * 8192)); } }
        }
        SEAM(pb + 12);
    }
#undef PH_BEGIN
#undef INP
#undef WSP
#undef IN
#undef SEAM
}

#ifndef MK_SPLIT
#define MK_SPLIT 0
#endif
extern "C" void kernel_launch(void* const* d_in, const int* in_sizes, int n_in, void* d_out, int out_size, void* d_ws, size_t ws_size, hipStream_t stream) {
    static int grid = 0;
    if (grid == 0) {
        if (n_in != 21 || out_size != NTOK * DM || ws_size < WS_END) { fprintf(stderr, "kernel_launch: unexpected shapes (n_in %d, out %d, ws %zu < %zu); nothing launched\n", n_in, out_size, ws_size, (size_t)WS_END); grid = -1; return; }
        int dev = 0, cus = 0, per_cu = 0;
        if (hipGetDevice(&dev) != hipSuccess || hipDeviceGetAttribute(&cus, hipDeviceAttributeMultiprocessorCount, dev) != hipSuccess) { grid = -1; return; }
        if (hipFuncSetAttribute((const void*)mk_fwd, hipFuncAttributeMaxDynamicSharedMemorySize, LDS_BYTES) != hipSuccess) { fprintf(stderr, "kernel_launch: hipFuncSetAttribute failed\n"); grid = -1; return; }
        if (hipOccupancyMaxActiveBlocksPerMultiprocessor(&per_cu, (const void*)mk_fwd, 512, LDS_BYTES) != hipSuccess || per_cu < 1) fprintf(stderr, "kernel_launch: occupancy query reports %d\n", per_cu);
        (void)hipGetLastError();
        grid = cus;
    }
    if (grid < 0) return;
    if (hipMemsetAsync((char*)d_ws + WS_CTL, 0, 1 * MiB, stream) != hipSuccess) { fprintf(stderr, "kernel_launch: memset failed\n"); return; }
    Args a{};
    for (int i = 0; i < 21; ++i) a.in[i] = (const float*)d_in[i];
    a.out = (float*)d_out; a.ws = (unsigned char*)d_ws; a.pad = 0;
#if MK_SPLIT
    for (int p = 0; p < NPHASES; ++p) { a.lo = p; a.hi = p + 1; a.li = p; hipLaunchKernelGGL(mk_fwd, dim3(grid), dim3(512), LDS_BYTES, stream, a); }
#else
    a.lo = 0; a.hi = NPHASES; a.li = 0;
    hipLaunchKernelGGL(mk_fwd, dim3(grid), dim3(512), LDS_BYTES, stream, a);
#endif
    const hipError_t le = hipPeekAtLastError();
    if (le != hipSuccess) fprintf(stderr, "kernel_launch: launch failed: %s\n", hipGetErrorName(le));
}
```
